# Optimizing an MI355X kernel written in HIP

```python
import math
import jax, jax.numpy as jnp
from jax import lax
import numpy as np

D_MODEL = 2048
BATCH = 2
SEQ = 8192
DEPTH = 2

D_MIX = D_MODEL
D_LRU = D_MIX // 2
LRU_BLOCKS = 8
LRU_BLOCK_W = D_LRU // LRU_BLOCKS
LRU_C = 8.0
CONV_W = 4
D_DN = D_MIX - D_LRU
DN_HEAD_DIM = 128
DN_HEADS = D_DN // DN_HEAD_DIM
DN_CHUNK = 64
D_IN = 2 * D_LRU + 4 * D_DN + 2 * DN_HEADS
D_FF = 3 * D_MODEL
N_EXPERTS = 8
TOP_K = 2
D_FF_EXPERT = 3 * D_MODEL // 2
MOE_BLOCK = 128
N_DENSE = (DEPTH + 1) // 2
N_MOE = DEPTH // 2
EPS = 1e-6

kernel_name = 'hybrid_rglru_gdn_moe'


def rms_norm(x, gain):
    xf = x.astype(jnp.float32)
    y = xf * lax.rsqrt(jnp.mean(xf * xf, axis=-1, keepdims=True) + EPS)
    return (y * gain.astype(jnp.float32)).astype(x.dtype)


def causal_depthwise_conv(x, w):
    k_w = w.shape[0]
    s = x.shape[1]
    xp = jnp.pad(x, ((0, 0), (k_w - 1, 0), (0, 0)))
    y = xp[:, 0:s] * w[0]
    for k in range(1, k_w):
        y = y + xp[:, k:k + s] * w[k]
    return y


def l2_normalize(x):
    return x * lax.rsqrt(jnp.sum(x * x, axis=-1, keepdims=True) + EPS)


def lru_combine(c1, c2):
    a1, b1 = c1
    a2, b2 = c2
    return a1 * a2, a2 * b1 + b2


def rg_lru_group(x_in, gate_in, conv_w, conv_b, w_r, b_r, w_i, b_i, lam, out_norm):
    bsz, s, _ = x_in.shape
    xc = (causal_depthwise_conv(x_in, conv_w) + conv_b).astype(jnp.float32)
    xb = xc.reshape(bsz, s, LRU_BLOCKS, LRU_BLOCK_W)
    r = jax.nn.sigmoid(jnp.einsum('bsnc,ncd->bsnd', xb, w_r.astype(jnp.float32)) + b_r.astype(jnp.float32))
    i = jax.nn.sigmoid(jnp.einsum('bsnc,ncd->bsnd', xb, w_i.astype(jnp.float32)) + b_i.astype(jnp.float32))
    r = r.reshape(bsz, s, D_LRU)
    i = i.reshape(bsz, s, D_LRU)
    log_a = -LRU_C * r * jax.nn.softplus(-lam.astype(jnp.float32))
    a = jnp.exp(log_a)
    mult = jnp.sqrt(-jnp.expm1(2.0 * log_a))
    b = mult * (i * xc)
    _, h = lax.associative_scan(lru_combine, (a, b), axis=1)
    y = h * jax.nn.gelu(gate_in.astype(jnp.float32), approximate=True)
    return rms_norm(y, out_norm)


def chunk_gated_delta_rule(q, k, v, g, beta):
    bsz, nh, s, dk = q.shape
    dv = v.shape[-1]
    c = DN_CHUNK
    n = s // c
    q = q.reshape(bsz, nh, n, c, dk)
    k = k.reshape(bsz, nh, n, c, dk)
    v = v.reshape(bsz, nh, n, c, dv)
    g = jnp.cumsum(g.reshape(bsz, nh, n, c), axis=-1)
    beta = beta.reshape(bsz, nh, n, c)
    causal = jnp.tril(jnp.ones((c, c), dtype=bool))
    strict = jnp.tril(jnp.ones((c, c), dtype=bool), -1)
    diff = g[..., :, None] - g[..., None, :]
    decay = jnp.where(causal, jnp.exp(jnp.where(causal, diff, 0.0)), 0.0)
    k_beta = k * beta[..., None]
    v_beta = v * beta[..., None]
    lower = jnp.where(strict, jnp.einsum('bhncd,bhnmd->bhncm', k_beta, k) * decay, 0.0)
    a_mat = lower + jnp.eye(c, dtype=jnp.float32)
    rhs = jnp.concatenate([v_beta, k_beta * jnp.exp(g)[..., None]], axis=-1)
    sol = lax.linalg.triangular_solve(a_mat, rhs, left_side=True, lower=True, unit_diagonal=True)
    u = sol[..., :dv]
    w = sol[..., dv:]
    qk = jnp.where(causal, jnp.einsum('bhncd,bhnmd->bhncm', q, k) * decay, 0.0)
    q_dec = q * jnp.exp(g)[..., None]
    k_dec = k * jnp.exp(g[..., -1:] - g)[..., None]
    g_last = jnp.exp(g[..., -1])

    def step(state, inp):
        q_i, k_i, u_i, w_i, qk_i, gl_i = inp
        v_new = u_i - jnp.einsum('bhck,bhkv->bhcv', w_i, state)
        o = jnp.einsum('bhck,bhkv->bhcv', q_i, state) + jnp.einsum('bhcm,bhmv->bhcv', qk_i, v_new)
        state = state * gl_i[..., None, None] + jnp.einsum('bhck,bhcv->bhkv', k_i, v_new)
        return state, o

    xs = tuple(jnp.moveaxis(t, 2, 0) for t in (q_dec, k_dec, u, w, qk, g_last))
    state0 = jnp.zeros((bsz, nh, dk, dv), jnp.float32)
    _, o = lax.scan(step, state0, xs)
    return jnp.moveaxis(o, 0, 2).reshape(bsz, nh, s, dv)


def gated_deltanet_group(q_in, k_in, v_in, gate_in, beta_in, alpha_in, conv_w, a_log, dt_bias, out_norm):
    bsz, s, _ = q_in.shape
    qkv = jnp.concatenate([q_in, k_in, v_in], axis=-1)
    qkv = jax.nn.silu(causal_depthwise_conv(qkv, conv_w)).astype(jnp.float32)
    q, k, v = jnp.split(qkv, 3, axis=-1)
    to_heads = lambda t: t.reshape(bsz, s, DN_HEADS, DN_HEAD_DIM).transpose(0, 2, 1, 3)
    q = l2_normalize(to_heads(q)) * (DN_HEAD_DIM ** -0.5)
    k = l2_normalize(to_heads(k))
    v = to_heads(v)
    beta = jax.nn.sigmoid(beta_in.astype(jnp.float32)).transpose(0, 2, 1)
    g = (-jnp.exp(a_log.astype(jnp.float32))
         * jax.nn.softplus(alpha_in.astype(jnp.float32) + dt_bias.astype(jnp.float32))).transpose(0, 2, 1)
    o = chunk_gated_delta_rule(q, k, v, g, beta).transpose(0, 2, 1, 3)
    gate = gate_in.astype(jnp.float32).reshape(bsz, s, DN_HEADS, DN_HEAD_DIM)
    o = rms_norm(o, out_norm) * jax.nn.silu(gate)
    return o.reshape(bsz, s, D_DN)


def swiglu(h, w_gate, w_up, w_down):
    return (jax.nn.silu(h @ w_gate) * (h @ w_up)) @ w_down


def moe_swiglu(h, router, w_gate, w_up, w_down):
    bsz, s, d = h.shape
    t = bsz * s
    xt = h.reshape(t, d)
    logits = (xt @ router).astype(jnp.float32)
    top_logits, top_e = lax.top_k(logits, TOP_K)
    top_w = jax.nn.softmax(top_logits, axis=-1)
    n_assign = t * TOP_K
    flat_e = top_e.reshape(n_assign).astype(jnp.int32)
    flat_tok = jnp.repeat(jnp.arange(t, dtype=jnp.int32), TOP_K)
    flat_w = top_w.reshape(n_assign)
    order = jnp.argsort(flat_e)
    sorted_e = flat_e[order]
    sorted_tok = flat_tok[order]
    sorted_w = flat_w[order]
    counts = jnp.zeros((N_EXPERTS,), jnp.int32).at[flat_e].add(1)
    padded = (counts + MOE_BLOCK - 1) // MOE_BLOCK * MOE_BLOCK
    pad_end = jnp.cumsum(padded)
    pad_start = pad_end - padded
    start = jnp.cumsum(counts) - counts
    rank = jnp.arange(n_assign, dtype=jnp.int32) - start[sorted_e]
    dest = pad_start[sorted_e] + rank
    n_slots = (n_assign + MOE_BLOCK - 1) // MOE_BLOCK * MOE_BLOCK + N_EXPERTS * MOE_BLOCK
    n_blocks = n_slots // MOE_BLOCK
    slot_tok = jnp.zeros((n_slots,), jnp.int32).at[dest].set(sorted_tok)
    block_expert = jnp.minimum(
        jnp.searchsorted(pad_end, jnp.arange(n_blocks, dtype=jnp.int32) * MOE_BLOCK, side='right'),
        N_EXPERTS - 1).astype(jnp.int32)
    x_blocks = xt[slot_tok].reshape(n_blocks, MOE_BLOCK, d)

    def expert_fn(args):
        xb, e = args
        return swiglu(xb, w_gate[e], w_up[e], w_down[e])

    y_blocks = lax.map(expert_fn, (x_blocks, block_expert))
    y_assign = y_blocks.reshape(n_slots, d)[dest] * sorted_w[:, None].astype(h.dtype)
    out = jnp.zeros((t, d), h.dtype).at[sorted_tok].add(y_assign)
    return out.reshape(bsz, s, d)


def setup_inputs(seed: int = 0) -> dict:
    key = jax.random.key(seed)
    ks = jax.random.split(key, 24)
    nrm = lambda k, shape, scale: jax.random.normal(k, shape, jnp.float32) * scale
    lam_u = jax.random.uniform(ks[9], (DEPTH, D_LRU), jnp.float32, 0.9, 0.999)
    lam_p = lam_u ** (1.0 / LRU_C)
    dt = jnp.exp(jax.random.uniform(ks[13], (DEPTH, DN_HEADS), jnp.float32, math.log(1e-3), math.log(1e-1)))
    return {
        'x': jax.random.normal(ks[0], (BATCH, SEQ, D_MODEL), jnp.float32),
        'norm_mix': 1.0 + nrm(ks[1], (DEPTH, D_MODEL), 0.02),
        'w_in': nrm(ks[2], (DEPTH, D_MODEL, D_IN), D_MODEL ** -0.5),
        'conv_lru_w': nrm(ks[3], (DEPTH, CONV_W, D_LRU), CONV_W ** -0.5),
        'conv_lru_b': nrm(ks[4], (DEPTH, D_LRU), 0.02),
        'lru_w_r': nrm(ks[5], (DEPTH, LRU_BLOCKS, LRU_BLOCK_W, LRU_BLOCK_W), LRU_BLOCK_W ** -0.5),
        'lru_b_r': nrm(ks[6], (DEPTH, LRU_BLOCKS, LRU_BLOCK_W), 0.02),
        'lru_w_i': nrm(ks[7], (DEPTH, LRU_BLOCKS, LRU_BLOCK_W, LRU_BLOCK_W), LRU_BLOCK_W ** -0.5),
        'lru_b_i': nrm(ks[8], (DEPTH, LRU_BLOCKS, LRU_BLOCK_W), 0.02),
        'lru_lambda': jnp.log(lam_p) - jnp.log1p(-lam_p),
        'lru_out_norm': 1.0 + nrm(ks[10], (DEPTH, D_LRU), 0.02),
        'conv_qkv_w': nrm(ks[11], (DEPTH, CONV_W, 3 * D_DN), CONV_W ** -0.5),
        'dn_a_log': jnp.log(jax.random.uniform(ks[12], (DEPTH, DN_HEADS), jnp.float32, 1.0, 16.0)),
        'dn_dt_bias': dt + jnp.log(-jnp.expm1(-dt)),
        'dn_out_norm': 1.0 + nrm(ks[14], (DEPTH, DN_HEAD_DIM), 0.02),
        'w_out': nrm(ks[15], (DEPTH, D_MIX, D_MODEL), D_MIX ** -0.5),
        'norm_ffn': 1.0 + nrm(ks[16], (DEPTH, D_MODEL), 0.02),
        'ffn_w_gate': nrm(ks[17], (N_DENSE, D_MODEL, D_FF), D_MODEL ** -0.5),
        'ffn_w_up': nrm(ks[18], (N_DENSE, D_MODEL, D_FF), D_MODEL ** -0.5),
        'ffn_w_down': nrm(ks[19], (N_DENSE, D_FF, D_MODEL), D_FF ** -0.5),
        'moe_router': nrm(ks[20], (N_MOE, D_MODEL, N_EXPERTS), D_MODEL ** -0.5),
        'moe_w_gate': nrm(ks[21], (N_MOE, N_EXPERTS, D_MODEL, D_FF_EXPERT), D_MODEL ** -0.5),
        'moe_w_up': nrm(ks[22], (N_MOE, N_EXPERTS, D_MODEL, D_FF_EXPERT), D_MODEL ** -0.5),
        'moe_w_down': nrm(ks[23], (N_MOE, N_EXPERTS, D_FF_EXPERT, D_MODEL), D_FF_EXPERT ** -0.5),
        'norm_final': 1.0 + nrm(jax.random.fold_in(key, 99), (D_MODEL,), 0.02),
    }


def reference(x, norm_mix, w_in, conv_lru_w, conv_lru_b, lru_w_r, lru_b_r, lru_w_i, lru_b_i,
              lru_lambda, lru_out_norm, conv_qkv_w, dn_a_log, dn_dt_bias, dn_out_norm, w_out,
              norm_ffn, ffn_w_gate, ffn_w_up, ffn_w_down, moe_router, moe_w_gate, moe_w_up,
              moe_w_down, norm_final):
    split_points = list(np.cumsum([D_LRU, D_LRU, D_DN, D_DN, D_DN, D_DN, DN_HEADS]))
    for l in range(DEPTH):
        h = rms_norm(x, norm_mix[l])
        proj = h @ w_in[l]
        lru_x, lru_g, dn_q, dn_k, dn_v, dn_g, dn_beta, dn_alpha = jnp.split(proj, split_points, axis=-1)
        y_lru = rg_lru_group(lru_x, lru_g, conv_lru_w[l], conv_lru_b[l], lru_w_r[l], lru_b_r[l],
                             lru_w_i[l], lru_b_i[l], lru_lambda[l], lru_out_norm[l])
        y_dn = gated_deltanet_group(dn_q, dn_k, dn_v, dn_g, dn_beta, dn_alpha, conv_qkv_w[l],
                                    dn_a_log[l], dn_dt_bias[l], dn_out_norm[l])
        y_mix = jnp.concatenate([y_lru.astype(x.dtype), y_dn.astype(x.dtype)], axis=-1)
        x = x + y_mix @ w_out[l]
        h2 = rms_norm(x, norm_ffn[l])
        if l % 2 == 0:
            j = l // 2
            x = x + swiglu(h2, ffn_w_gate[j], ffn_w_up[j], ffn_w_down[j])
        else:
            j = l // 2
            x = x + moe_swiglu(h2, moe_router[j], moe_w_gate[j], moe_w_up[j], moe_w_down[j])
    return rms_norm(x, norm_final)
```

```cpp
#include <hip/hip_runtime.h>
#include <cstdio>
#include <cstdint>
namespace pg8 {
#define PG8_LAS __attribute__((address_space(3)))
typedef unsigned short bf16_t;
typedef short bf16x8 __attribute__((ext_vector_type(8)));
typedef float f32x4 __attribute__((ext_vector_type(4)));
typedef unsigned u32x4 __attribute__((ext_vector_type(4)));
constexpr int BM = 256, BK = 64, HALF = 128, HTB = HALF * BK * 2  , STAGE_BYTES = 8 * HTB, NXCD = 8, WGM = 8;

__host__ __device__ __forceinline__ int lds_byte(int r, int c) { const int st = (r >> 4) * 2 + (c >> 5), rr = r & 15, cc = c & 31, ob = rr * 64 + cc * 2; return st * 1024 + (ob ^ (((ob >> 9) & 1) << 5)); }
__host__ __device__ __forceinline__ void stage_rc(int b, int& R, int& C) { const int st = b / 1024, sb = b % 1024, swz = sb ^ (((sb >> 9) & 1) << 5); R = (st >> 1) * 16 + swz / 64; C = (st & 1) * 32 + (swz % 64) / 2; }
__host__ __device__ __forceinline__ int perm32(int rho) { const int n = rho >> 4, i = rho & 15; return 8 * (i >> 2) + 4 * n + (i & 3); }

struct Unit { int pm, pn; };
struct Gemm { const bf16_t* A; const bf16_t* Bt; int M, N, K, pad; };

struct StaticOrder {
    int nM, nN, nwg, G, c;
    __host__ __device__ void init(int M, int N, int G_, int c_) { nM = M / BM; nN = N / BM; nwg = nM * nN; G = G_; c = c_; }
    __host__ __device__ bool next(int i, Unit& u) const {
        const long L = (long)i * G + c; if (L >= nwg) return false;
        int wgid = (int)L; { const int q = nwg / NXCD, r = nwg % NXCD, xcd = wgid % NXCD, off = wgid / NXCD; wgid = (xcd < r ? xcd * (q + 1) : r * (q + 1) + (xcd - r) * q) + off; }
        const int nig = WGM * nN, gid = wgid / nig, fm = gid * WGM, gsz = (nM - fm) < WGM ? (nM - fm) : WGM;
        u.pm = fm + ((wgid % nig) % gsz); u.pn = (wgid % nig) / gsz; return true;
    }
    __device__ __forceinline__ void a_ready(const Unit&) const {}
    __device__ __forceinline__ void done(const Unit&) const {}
};


__device__ __forceinline__ unsigned cvt_pk_bf16(float lo, float hi) { unsigned r; asm volatile("v_cvt_pk_bf16_f32 %0, %1, %2" : "=v"(r) : "v"(lo), "v"(hi)); return r; }
__device__ __forceinline__ float silu_f(float x) { return x / (1.0f + __expf(-x)); }

struct EpiScaleBf16 {
    static constexpr bool PERM = true, AFTER_DRAIN = false;
    bf16_t* O; const float* rs; int ldc; int pad;
    __device__ __forceinline__ void operator()(const f32x4 (&acc)[2][2][4][2], const Unit& u, int wr, int wc, int fr, int fq) const {
        const int row0 = u.pm * BM + wr * 64 + fr, col0 = u.pn * BM + wc * 32 + 8 * fq;
#pragma unroll
        for (int ai = 0; ai < 2; ++ai)
#pragma unroll
            for (int m = 0; m < 4; ++m) { const int r = row0 + ai * HALF + m * 16; const float s = rs[r]; bf16_t* rowp = O + (size_t)r * ldc + col0;
#pragma unroll
                for (int bj = 0; bj < 2; ++bj) { const f32x4 v0 = acc[ai][bj][m][0] * s, v1 = acc[ai][bj][m][1] * s;
                    u32x4 w; w.x = cvt_pk_bf16(v0[0], v0[1]); w.y = cvt_pk_bf16(v0[2], v0[3]); w.z = cvt_pk_bf16(v1[0], v1[1]); w.w = cvt_pk_bf16(v1[2], v1[3]);
                    *(u32x4*)(rowp + bj * HALF) = w; } }
    }
};
struct EpiSwiGLU {
    static constexpr bool PERM = true, AFTER_DRAIN = false;
    bf16_t* O; const float* rs; int ldc; int pad;
    __device__ __forceinline__ void operator()(const f32x4 (&acc)[2][2][4][2], const Unit& u, int wr, int wc, int fr, int fq) const {
        const int row0 = u.pm * BM + wr * 64 + fr, col0 = u.pn * HALF + wc * 32 + 8 * fq;
#pragma unroll
        for (int ai = 0; ai < 2; ++ai)
#pragma unroll
            for (int m = 0; m < 4; ++m) { const int r = row0 + ai * HALF + m * 16; const float s = rs ? rs[r] : 1.0f; bf16_t* rowp = O + (size_t)r * ldc + col0;
                f32x4 h0, h1;
#pragma unroll
                for (int j = 0; j < 4; ++j) { h0[j] = silu_f(acc[ai][0][m][0][j] * s) * (acc[ai][1][m][0][j] * s); h1[j] = silu_f(acc[ai][0][m][1][j] * s) * (acc[ai][1][m][1][j] * s); }
                u32x4 w; w.x = cvt_pk_bf16(h0[0], h0[1]); w.y = cvt_pk_bf16(h0[2], h0[3]); w.z = cvt_pk_bf16(h1[0], h1[1]); w.w = cvt_pk_bf16(h1[2], h1[3]);
                *(u32x4*)rowp = w; }
    }
};
struct EpiResidual {
    static constexpr bool PERM = false, AFTER_DRAIN = false;
    const float* base; float* out; const float* roww; int ldc; int pad;
    __device__ __forceinline__ void operator()(const f32x4 (&acc)[2][2][4][2], const Unit& u, int wr, int wc, int fr, int fq) const {
        const int row0 = u.pm * BM + wr * 64 + fr, col0 = u.pn * BM + wc * 32 + 4 * fq;
#pragma unroll
        for (int ai = 0; ai < 2; ++ai)
#pragma unroll
            for (int m = 0; m < 4; ++m) { const int r = row0 + ai * HALF + m * 16; const float w = roww ? roww[r] : 1.0f; const size_t off = (size_t)r * ldc + col0;
#pragma unroll
                for (int bj = 0; bj < 2; ++bj)
#pragma unroll
                    for (int n = 0; n < 2; ++n) { const f32x4 bs = *(const f32x4*)(base + off + bj * HALF + n * 16); *(f32x4*)(out + off + bj * HALF + n * 16) = bs + acc[ai][bj][m][n] * w; } }
    }
};
template <class Epi, class Sched, bool ALIGN_EPI = false, bool SP2 = false>
__device__ __forceinline__ void gemm_phase(PG8_LAS unsigned char* lds, const Gemm g, const Sched& S, const Epi& E) {
    const int tid = threadIdx.x, wid = __builtin_amdgcn_readfirstlane(tid >> 6), lane = tid & 63, wr = wid >> 2, wc = wid & 3, fr = lane & 15, fq = lane >> 4;
    const int K = g.K, nt = K / BK;
    unsigned voffA[2], voffB[2];
#pragma unroll
    for (int i = 0; i < 2; ++i) { int R, C; stage_rc(tid * 16 + i * 8192, R, C); const int Rb = Epi::PERM ? ((R & ~31) + perm32(R & 31)) : R;
        voffA[i] = (unsigned)(R * K + C) * 2u; voffB[i] = (unsigned)(Rb * K + C) * 2u; }
    const size_t kstep = (size_t)(BK * 2);
    const size_t hstep = (size_t)HALF * K * 2;
    const size_t tstep = 2 * hstep;
    const unsigned ldsw = (unsigned)wid * 1024u;
    const int aoff = lds_byte(wr * 64 + fr, fq * 8), boff = lds_byte(wc * 32 + fr, fq * 8);
#define PG8_SA(b, h) (((b) * 2 + (h)) * HTB)
#define PG8_SB(b, h) ((4 + (b) * 2 + (h)) * HTB)
#define PG8_STAGE(bufoff, gbase, voff) do { _Pragma("unroll") for (int _i = 0; _i < 2; ++_i) \
        __builtin_amdgcn_global_load_lds((const unsigned*)((const char*)(gbase) + (voff)[_i]), (PG8_LAS unsigned*)(lds + (bufoff) + ldsw + _i * 8192), 16, 0, 0); } while (0)
#define PG8_LDA(dst, b, h) do { _Pragma("unroll") for (int m = 0; m < 4; ++m) _Pragma("unroll") for (int k = 0; k < 2; ++k) dst[m][k] = *(const PG8_LAS bf16x8*)(lds + PG8_SA(b, h) + aoff + m * 2048 + k * 1024); } while (0)
#define PG8_LDB(dst, b, h) do { _Pragma("unroll") for (int n = 0; n < 2; ++n) _Pragma("unroll") for (int k = 0; k < 2; ++k) dst[n][k] = *(const PG8_LAS bf16x8*)(lds + PG8_SB(b, h) + boff + n * 2048 + k * 1024); } while (0)
#define PG8_MMA(ai, bj, At, Bt) do { __builtin_amdgcn_s_setprio(1); _Pragma("unroll") for (int m = 0; m < 4; ++m) _Pragma("unroll") for (int n = 0; n < 2; ++n) _Pragma("unroll") for (int k = 0; k < 2; ++k) \
        acc[ai][bj][m][n] = __builtin_amdgcn_mfma_f32_16x16x32_bf16(Bt[n][k], At[m][k], acc[ai][bj][m][n], 0, 0, 0); __builtin_amdgcn_s_setprio(0); } while (0)
#define PG8_WAIT_V(n) asm volatile("s_waitcnt vmcnt(" #n ")" ::: "memory")
#define PG8_WAIT_L(n) asm volatile("s_waitcnt lgkmcnt(" #n ")" ::: "memory")
#define PG8_BAR __builtin_amdgcn_s_barrier()
#define PG8_SCHED __builtin_amdgcn_sched_barrier(0)
    Unit cur, nxt; int ui = 0;
    if (!S.next(0, cur)) return;
    f32x4 acc[2][2][4][2];
#pragma unroll
    for (int a = 0; a < 2; ++a)
#pragma unroll
        for (int b = 0; b < 2; ++b)
#pragma unroll
            for (int m = 0; m < 4; ++m)
#pragma unroll
                for (int n = 0; n < 2; ++n) acc[a][b][m][n] = (f32x4){0.f, 0.f, 0.f, 0.f};
    bf16x8 At[4][2], B0[2][2], B1[2][2];
    const char* cA = (const char*)g.A + (size_t)cur.pm * tstep; const char* cB = (const char*)g.Bt + (size_t)cur.pn * tstep;
    S.a_ready(cur);
    if constexpr (SP2) {
        PG8_STAGE(PG8_SB(0, 0), cB, voffB); PG8_STAGE(PG8_SB(0, 1), cB + hstep, voffB); PG8_STAGE(PG8_SA(0, 0), cA, voffA); PG8_STAGE(PG8_SA(0, 1), cA + hstep, voffA);
        if (wr == 1) PG8_BAR;
        PG8_WAIT_V(2); PG8_BAR;
        PG8_STAGE(PG8_SB(1, 0), cB + kstep, voffB); PG8_STAGE(PG8_SA(1, 0), cA + kstep, voffA); PG8_STAGE(PG8_SB(1, 1), cB + hstep + kstep, voffB);
        PG8_WAIT_V(6); PG8_BAR;
    } else {
        PG8_STAGE(PG8_SB(0, 0), cB, voffB); PG8_STAGE(PG8_SA(0, 0), cA, voffA); PG8_STAGE(PG8_SB(0, 1), cB + hstep, voffB); PG8_STAGE(PG8_SA(0, 1), cA + hstep, voffA);
        if (wr == 1) PG8_BAR;
        PG8_WAIT_V(4); PG8_BAR;
        PG8_STAGE(PG8_SB(1, 0), cB + kstep, voffB); PG8_STAGE(PG8_SA(1, 0), cA + kstep, voffA); PG8_STAGE(PG8_SB(1, 1), cB + hstep + kstep, voffB);
        PG8_WAIT_V(6); PG8_BAR;
    }
    for (;;) {
        const bool has_next = S.next(ui + 1, nxt);
        const char* nA = has_next ? (const char*)g.A + (size_t)nxt.pm * tstep : cA; const char* nB = has_next ? (const char*)g.Bt + (size_t)nxt.pn * tstep : cB;
        for (int t = 0; t < nt; t += 2) {
            const bool last = (t == nt - 2);
            const char* a1 = cA + (size_t)(t + 1) * kstep;
            const char* a2 = last ? nA : cA + (size_t)(t + 2) * kstep; const char* b2 = last ? nB : cB + (size_t)(t + 2) * kstep;
            const char* a3 = a2 + kstep; const char* b3 = b2 + kstep;
            if (last && has_next) S.a_ready(nxt);
            if constexpr (SP2) {
            PG8_LDB(B0, 0, 0); PG8_LDB(B1, 0, 1); PG8_SCHED; PG8_LDA(At, 0, 0); PG8_STAGE(PG8_SA(1, 1), a1 + hstep, voffA);
            PG8_WAIT_V(8); PG8_WAIT_L(0); PG8_BAR; PG8_MMA(0, 0, At, B0); PG8_MMA(0, 1, At, B1); PG8_BAR; PG8_SCHED;
            PG8_LDA(At, 0, 1); PG8_STAGE(PG8_SB(0, 0), b2, voffB); PG8_STAGE(PG8_SB(0, 1), b2 + hstep, voffB); PG8_STAGE(PG8_SA(0, 0), a2, voffA);
            PG8_WAIT_V(8); PG8_WAIT_L(0); PG8_BAR; PG8_MMA(1, 0, At, B0); PG8_MMA(1, 1, At, B1); PG8_BAR; PG8_SCHED;
            PG8_LDB(B0, 1, 0); PG8_LDB(B1, 1, 1); PG8_SCHED; PG8_LDA(At, 1, 0); PG8_STAGE(PG8_SA(0, 1), a2 + hstep, voffA);
            PG8_WAIT_V(8); PG8_WAIT_L(0); PG8_BAR; PG8_MMA(0, 0, At, B0); PG8_MMA(0, 1, At, B1); PG8_BAR; PG8_SCHED;
            PG8_LDA(At, 1, 1); PG8_STAGE(PG8_SB(1, 0), b3, voffB); PG8_STAGE(PG8_SB(1, 1), b3 + hstep, voffB); PG8_STAGE(PG8_SA(1, 0), a3, voffA);
            PG8_WAIT_V(8); PG8_WAIT_L(0); PG8_BAR; PG8_MMA(1, 0, At, B0); PG8_MMA(1, 1, At, B1); PG8_BAR; PG8_SCHED;
            } else {
            PG8_LDB(B0, 0, 0); PG8_SCHED; PG8_LDA(At, 0, 0); PG8_STAGE(PG8_SA(1, 1), a1 + hstep, voffA);
            PG8_WAIT_L(8); PG8_BAR; PG8_WAIT_L(0); PG8_MMA(0, 0, At, B0); PG8_BAR; PG8_SCHED;
            PG8_LDB(B1, 0, 1); PG8_STAGE(PG8_SB(0, 0), b2, voffB);
            PG8_BAR; PG8_WAIT_L(0); PG8_MMA(0, 1, At, B1); PG8_BAR;
            PG8_LDA(At, 0, 1); PG8_STAGE(PG8_SA(0, 0), a2, voffA);
            PG8_BAR; PG8_WAIT_L(0); PG8_MMA(1, 0, At, B0); PG8_BAR; PG8_SCHED;
            PG8_STAGE(PG8_SB(0, 1), b2 + hstep, voffB);
            PG8_WAIT_V(6); PG8_BAR; PG8_MMA(1, 1, At, B1); PG8_BAR;
            PG8_LDB(B0, 1, 0); PG8_SCHED; PG8_LDA(At, 1, 0); PG8_STAGE(PG8_SA(0, 1), a2 + hstep, voffA);
            PG8_WAIT_L(8); PG8_BAR; PG8_WAIT_L(0); PG8_MMA(0, 0, At, B0); PG8_BAR; PG8_SCHED;
            PG8_LDB(B1, 1, 1); PG8_STAGE(PG8_SB(1, 0), b3, voffB);
            PG8_BAR; PG8_WAIT_L(0); PG8_MMA(0, 1, At, B1); PG8_BAR;
            PG8_LDA(At, 1, 1); PG8_STAGE(PG8_SA(1, 0), a3, voffA);
            PG8_BAR; PG8_WAIT_L(0); PG8_MMA(1, 0, At, B0); PG8_BAR; PG8_SCHED;
            PG8_STAGE(PG8_SB(1, 1), b3 + hstep, voffB);
            PG8_WAIT_V(6); PG8_BAR; PG8_MMA(1, 1, At, B1); PG8_BAR;
            }
        }
        if constexpr (ALIGN_EPI) { if (wr == 0) PG8_BAR; }
        if constexpr (!Epi::AFTER_DRAIN) { E(acc, cur, wr, wc, fr, fq); S.done(cur); }
        if (!has_next) break;
#pragma unroll
        for (int a = 0; a < 2; ++a)
#pragma unroll
            for (int b = 0; b < 2; ++b)
#pragma unroll
                for (int m = 0; m < 4; ++m)
#pragma unroll
                    for (int n = 0; n < 2; ++n) acc[a][b][m][n] = (f32x4){0.f, 0.f, 0.f, 0.f};
        cur = nxt; cA = nA; cB = nB; ++ui;
        if constexpr (ALIGN_EPI) { if (wr == 1) PG8_BAR; }
    }
    PG8_WAIT_V(0);
    if constexpr (!ALIGN_EPI) { if (wr == 0) PG8_BAR; }
    PG8_BAR;
    if constexpr (Epi::AFTER_DRAIN) { E.fused(acc, cur, wr, wc, fr, fq, lds, wid, lane); S.done(cur); }
#undef PG8_SA
#undef PG8_SB
#undef PG8_STAGE
#undef PG8_LDA
#undef PG8_LDB
#undef PG8_MMA
#undef PG8_WAIT_V
#undef PG8_WAIT_L
#undef PG8_BAR
#undef PG8_SCHED
}
}

constexpr int T = 16384, SEQ = 8192, D = 2048, DLRU = 1024, DDN = 1024, NH = 8, HD = 128, NPROJ = 6144, DIN = 6160;
constexpr int DFF = 6144, NEXP = 8, DFFE = 3072;
constexpr float EPS = 1e-6f;
typedef unsigned short bf16;
typedef float f32x4 __attribute__((ext_vector_type(4)));
typedef unsigned u32x4 __attribute__((ext_vector_type(4)));
typedef unsigned u32x2 __attribute__((ext_vector_type(2)));

__device__ __forceinline__ float bf2f(bf16 b) { return __uint_as_float(((unsigned)b) << 16); }
__device__ __forceinline__ unsigned f2bf(float f) { unsigned u = __float_as_uint(f); return (u + 0x7fffu + ((u >> 16) & 1u)) >> 16; }
__device__ __forceinline__ unsigned pk2(float lo, float hi) { return f2bf(lo) | (f2bf(hi) << 16); }
__device__ __forceinline__ float wave_sum(float v) {
#pragma unroll
    for (int o = 1; o < 64; o <<= 1) v += __shfl_xor(v, o);
    return v;
}
using pg8::silu_f;
__device__ __forceinline__ float sigmoid_f(float x) { return 1.0f / (1.0f + __expf(-x)); }
__device__ __forceinline__ float softplus_f(float x) { return fmaxf(x, 0.0f) + log1pf(__expf(-fabsf(x))); }
__device__ __forceinline__ float gelu_tanh_f(float x) { const float u = 0.7978845608028654f * (x + 0.044715f * x * x * x); return 0.5f * x * (1.0f + tanhf(u)); }

__global__ void __launch_bounds__(256) k_convert_t(const float* __restrict__ W, int ldw, int col_off, int K, const float* __restrict__ gain, bf16* __restrict__ Bt, int blk, int blk_stride, int row_off) {
    __shared__ float tile[64][65];
    const int k0 = blockIdx.x * 64, n0 = blockIdx.y * 64, tx = threadIdx.x & 63, ty = threadIdx.x >> 6;
#pragma unroll
    for (int i = 0; i < 16; ++i) { const int kk = ty + 4 * i; const float g = gain ? gain[k0 + kk] : 1.0f; tile[kk][tx] = W[(size_t)(k0 + kk) * ldw + col_off + n0 + tx] * g; }
    __syncthreads();
    const int nn = threadIdx.x >> 2, kc = (threadIdx.x & 3) * 16, n = n0 + nn;
    const int drow = (n / blk) * blk_stride + (n % blk) + row_off;
    u32x4 a, b;
    a.x = pk2(tile[kc + 0][nn], tile[kc + 1][nn]); a.y = pk2(tile[kc + 2][nn], tile[kc + 3][nn]); a.z = pk2(tile[kc + 4][nn], tile[kc + 5][nn]); a.w = pk2(tile[kc + 6][nn], tile[kc + 7][nn]);
    b.x = pk2(tile[kc + 8][nn], tile[kc + 9][nn]); b.y = pk2(tile[kc + 10][nn], tile[kc + 11][nn]); b.z = pk2(tile[kc + 12][nn], tile[kc + 13][nn]); b.w = pk2(tile[kc + 14][nn], tile[kc + 15][nn]);
    u32x4* dst = (u32x4*)(Bt + (size_t)drow * K + k0 + kc);
    dst[0] = a; dst[1] = b;
}
__global__ void k_convert_ba(const float* __restrict__ W, const float* __restrict__ gain, float* __restrict__ Wba) {
    const int idx = blockIdx.x * 256 + threadIdx.x; if (idx >= 16 * D) return; const int j = idx / D, k = idx % D;
    Wba[idx] = W[(size_t)k * DIN + NPROJ + j] * gain[k];
}
__global__ void __launch_bounds__(256) k_rowprep(const float* __restrict__ x, bf16* __restrict__ xb, float* __restrict__ rstd, const float* __restrict__ Wba, float* __restrict__ ba) {
    const int row = blockIdx.x * 4 + (threadIdx.x >> 6), lane = threadIdx.x & 63;
    const f32x4* xr = (const f32x4*)(x + (size_t)row * D) + lane;
    f32x4 v[8]; float ss = 0.f;
#pragma unroll
    for (int j = 0; j < 8; ++j) { v[j] = xr[64 * j]; ss += (v[j][0] * v[j][0] + v[j][1] * v[j][1]) + (v[j][2] * v[j][2] + v[j][3] * v[j][3]); }
    ss = wave_sum(ss);
    const float rs = 1.0f / sqrtf(ss * (1.0f / D) + EPS);
    u32x2* o = (u32x2*)(xb + (size_t)row * D) + lane;
#pragma unroll
    for (int j = 0; j < 8; ++j) { u32x2 w; w.x = pk2(v[j][0], v[j][1]); w.y = pk2(v[j][2], v[j][3]); o[64 * j] = w; }
    if (lane == 0) rstd[row] = rs;
    if (Wba) {
        for (int c = 0; c < 16; ++c) { const f32x4* wr = (const f32x4*)(Wba + (size_t)c * D) + lane; float a = 0.f;
#pragma unroll
            for (int j = 0; j < 8; ++j) { const f32x4 w = wr[64 * j]; a += (v[j][0] * w[0] + v[j][1] * w[1]) + (v[j][2] * w[2] + v[j][3] * w[3]); }
            a = wave_sum(a); if (lane == 0) ba[(size_t)row * 16 + c] = a * rs; }
    }
}
__global__ void __launch_bounds__(256) k_lru_conv(const bf16* __restrict__ proj, const float* __restrict__ cw, const float* __restrict__ cb, float* __restrict__ xc) {
    const size_t idx = (size_t)blockIdx.x * 256 + threadIdx.x; const int t = (int)(idx / DLRU), ch = (int)(idx % DLRU), s = t % SEQ;
    float a = cb[ch];
#pragma unroll
    for (int k = 0; k < 4; ++k) { const int sp = s - 3 + k; if (sp >= 0) a += cw[k * DLRU + ch] * bf2f(proj[(size_t)(t - 3 + k) * NPROJ + ch]); }
    xc[idx] = a;
}
__global__ void __launch_bounds__(256) k_lru_gate(const float* __restrict__ xc, const float* __restrict__ w_r, const float* __restrict__ b_r, const float* __restrict__ w_i, const float* __restrict__ b_i,
                                                   const float* __restrict__ lam, float* __restrict__ av, float* __restrict__ bv) {
    const size_t idx = (size_t)blockIdx.x * 256 + threadIdx.x; const int t = (int)(idx / DLRU), ch = (int)(idx % DLRU), n = ch >> 7, d = ch & 127;
    float ar = b_r[ch], ai = b_i[ch];
    const float* xr = xc + (size_t)t * DLRU + n * 128; const float* wr = w_r + (size_t)n * 128 * 128 + d; const float* wi = w_i + (size_t)n * 128 * 128 + d;
    for (int c = 0; c < 128; ++c) { const float xv = xr[c]; ar += xv * wr[c * 128]; ai += xv * wi[c * 128]; }
    const float r = sigmoid_f(ar), ig = sigmoid_f(ai);
    const float log_a = -8.0f * r * softplus_f(-lam[ch]);
    const float a = expf(log_a), mult = sqrtf(-expm1f(2.0f * log_a));
    av[idx] = a; bv[idx] = mult * (ig * xc[idx]);
}
__global__ void __launch_bounds__(64) k_lru_scan(float* __restrict__ av, const float* __restrict__ bv, const bf16* __restrict__ proj) {
    const int idx = blockIdx.x * 64 + threadIdx.x, b = idx / DLRU, ch = idx % DLRU;
    float h = 0.f;
    for (int s0 = 0; s0 < SEQ; s0 += 8) {
        float a8[8], b8[8], g8[8];
#pragma unroll
        for (int j = 0; j < 8; ++j) { const size_t t = (size_t)b * SEQ + s0 + j; a8[j] = av[t * DLRU + ch]; b8[j] = bv[t * DLRU + ch]; g8[j] = bf2f(proj[t * NPROJ + DLRU + ch]); }
#pragma unroll
        for (int j = 0; j < 8; ++j) { const size_t t = (size_t)b * SEQ + s0 + j; h = a8[j] * h + b8[j]; av[t * DLRU + ch] = h * gelu_tanh_f(g8[j]); }
    }
}
__global__ void __launch_bounds__(256) k_lru_norm(const float* __restrict__ y, const float* __restrict__ gain, bf16* __restrict__ ymix) {
    const int row = blockIdx.x * 4 + (threadIdx.x >> 6), lane = threadIdx.x & 63;
    const f32x4* yr = (const f32x4*)(y + (size_t)row * DLRU) + lane; const f32x4* gr = (const f32x4*)gain + lane;
    f32x4 v[4]; float ss = 0.f;
#pragma unroll
    for (int j = 0; j < 4; ++j) { v[j] = yr[64 * j]; ss += (v[j][0] * v[j][0] + v[j][1] * v[j][1]) + (v[j][2] * v[j][2] + v[j][3] * v[j][3]); }
    ss = wave_sum(ss); const float rs = 1.0f / sqrtf(ss * (1.0f / DLRU) + EPS);
    u32x2* o = (u32x2*)(ymix + (size_t)row * D) + lane;
#pragma unroll
    for (int j = 0; j < 4; ++j) { const f32x4 g = gr[64 * j]; u32x2 w; w.x = pk2(v[j][0] * rs * g[0], v[j][1] * rs * g[1]); w.y = pk2(v[j][2] * rs * g[2], v[j][3] * rs * g[3]); o[64 * j] = w; }
}
__global__ void __launch_bounds__(256) k_dn_prep(const bf16* __restrict__ proj, const float* __restrict__ cw, const float* __restrict__ ba, const float* __restrict__ a_log, const float* __restrict__ dt_bias,
                                                  float* __restrict__ qn, float* __restrict__ kn, float* __restrict__ vn, float* __restrict__ beta, float* __restrict__ gg) {
    const int w = blockIdx.x * 4 + (threadIdx.x >> 6), lane = threadIdx.x & 63, t = w >> 3, h = w & 7, s = t % SEQ;
    float val[3][2];
#pragma unroll
    for (int p = 0; p < 3; ++p)
#pragma unroll
        for (int e = 0; e < 2; ++e) { const int d = lane * 2 + e, c = p * DDN + h * HD + d; float a = 0.f;
#pragma unroll
            for (int k = 0; k < 4; ++k) { const int sp = s - 3 + k; if (sp >= 0) a += cw[k * 3 * DDN + c] * bf2f(proj[(size_t)(t - 3 + k) * NPROJ + 2048 + c]); }
            val[p][e] = silu_f(a); }
    const float sq = wave_sum(val[0][0] * val[0][0] + val[0][1] * val[0][1]), sk = wave_sum(val[1][0] * val[1][0] + val[1][1] * val[1][1]);
    const float rq = (1.0f / sqrtf(sq + EPS)) * 0.08838834764831845f, rk = 1.0f / sqrtf(sk + EPS);
    const size_t o = ((size_t)t * NH + h) * HD + lane * 2;
    qn[o] = val[0][0] * rq; qn[o + 1] = val[0][1] * rq; kn[o] = val[1][0] * rk; kn[o + 1] = val[1][1] * rk; vn[o] = val[2][0]; vn[o + 1] = val[2][1];
    if (lane == 0) { beta[t * NH + h] = sigmoid_f(ba[(size_t)t * 16 + h]); gg[t * NH + h] = -__expf(a_log[h]) * softplus_f(ba[(size_t)t * 16 + 8 + h] + dt_bias[h]); }
}
__global__ void __launch_bounds__(128) k_dn_rec(const float* __restrict__ qn, const float* __restrict__ kn, const float* __restrict__ vn, const float* __restrict__ beta, const float* __restrict__ gg, float* __restrict__ o) {
    __shared__ float sk[2][128], sq[2][128];
    const int b = blockIdx.x >> 3, h = blockIdx.x & 7, j = threadIdx.x;
    float st[128];
#pragma unroll
    for (int k = 0; k < 128; ++k) st[k] = 0.f;
    size_t base = ((size_t)(b * SEQ) * NH + h) * HD;
    float nk = kn[base + j], nq = qn[base + j], nv = vn[base + j], nb = beta[(b * SEQ) * NH + h], ng = gg[(b * SEQ) * NH + h];
    for (int s = 0; s < SEQ; ++s) {
        const int buf = s & 1;
        sk[buf][j] = nk; sq[buf][j] = nq; const float vj = nv, be = nb, ge = __expf(ng);
        __syncthreads();
        if (s + 1 < SEQ) { const size_t nb_ = ((size_t)(b * SEQ + s + 1) * NH + h) * HD; nk = kn[nb_ + j]; nq = qn[nb_ + j]; nv = vn[nb_ + j]; nb = beta[(b * SEQ + s + 1) * NH + h]; ng = gg[(b * SEQ + s + 1) * NH + h]; }
        float ks = 0.f;
#pragma unroll
        for (int k = 0; k < 128; ++k) ks += sk[buf][k] * st[k];
        const float vnew = be * (vj - ge * ks);
        float oo = 0.f;
#pragma unroll
        for (int k = 0; k < 128; ++k) { st[k] = ge * st[k] + sk[buf][k] * vnew; oo += sq[buf][k] * st[k]; }
        o[((size_t)(b * SEQ + s) * NH + h) * HD + j] = oo;
    }
}
__global__ void __launch_bounds__(256) k_dn_out(const float* __restrict__ o, const float* __restrict__ gain, const bf16* __restrict__ proj, bf16* __restrict__ ymix) {
    const int w = blockIdx.x * 4 + (threadIdx.x >> 6), lane = threadIdx.x & 63, t = w >> 3, h = w & 7;
    const size_t ob = ((size_t)t * NH + h) * HD + lane * 2;
    const float o0 = o[ob], o1 = o[ob + 1];
    const float ss = wave_sum(o0 * o0 + o1 * o1), rs = 1.0f / sqrtf(ss * (1.0f / HD) + EPS);
    const int c = h * HD + lane * 2;
    const float g0 = bf2f(proj[(size_t)t * NPROJ + 5120 + c]), g1 = bf2f(proj[(size_t)t * NPROJ + 5120 + c + 1]);
    *(unsigned*)(ymix + (size_t)t * D + DLRU + c) = pk2(o0 * rs * gain[lane * 2] * silu_f(g0), o1 * rs * gain[lane * 2 + 1] * silu_f(g1));
}
__global__ void __launch_bounds__(256) k_route(const float* __restrict__ x, const float* __restrict__ rstd, const float* __restrict__ gain, const float* __restrict__ router, float* __restrict__ roww) {
    const int row = blockIdx.x * 4 + (threadIdx.x >> 6), lane = threadIdx.x & 63;
    float acc[8];
#pragma unroll
    for (int e = 0; e < 8; ++e) acc[e] = 0.f;
    for (int j = 0; j < 32; ++j) { const int k = lane + 64 * j; const float xv = x[(size_t)row * D + k] * gain[k]; const f32x4 r0 = *(const f32x4*)(router + (size_t)k * 8), r1 = *(const f32x4*)(router + (size_t)k * 8 + 4);
        acc[0] += xv * r0[0]; acc[1] += xv * r0[1]; acc[2] += xv * r0[2]; acc[3] += xv * r0[3]; acc[4] += xv * r1[0]; acc[5] += xv * r1[1]; acc[6] += xv * r1[2]; acc[7] += xv * r1[3]; }
    const float rs = rstd[row];
#pragma unroll
    for (int e = 0; e < 8; ++e) acc[e] = wave_sum(acc[e]) * rs;
    int e1 = 0; float l1 = acc[0];
#pragma unroll
    for (int e = 1; e < 8; ++e) if (acc[e] > l1) { l1 = acc[e]; e1 = e; }
    int e2 = -1; float l2 = -3.4e38f;
#pragma unroll
    for (int e = 0; e < 8; ++e) if (e != e1 && acc[e] > l2) { l2 = acc[e]; e2 = e; }
    const float w1 = 1.0f / (1.0f + __expf(l2 - l1)), w2 = 1.0f - w1;
    if (lane < 8) roww[(size_t)lane * T + row] = lane == e1 ? w1 : (lane == e2 ? w2 : 0.0f);
}
__global__ void __launch_bounds__(256) k_final(const float* __restrict__ x, const float* __restrict__ gain, float* __restrict__ out) {
    const int row = blockIdx.x * 4 + (threadIdx.x >> 6), lane = threadIdx.x & 63;
    const f32x4* xr = (const f32x4*)(x + (size_t)row * D) + lane; const f32x4* gr = (const f32x4*)gain + lane;
    f32x4 v[8]; float ss = 0.f;
#pragma unroll
    for (int j = 0; j < 8; ++j) { v[j] = xr[64 * j]; ss += (v[j][0] * v[j][0] + v[j][1] * v[j][1]) + (v[j][2] * v[j][2] + v[j][3] * v[j][3]); }
    ss = wave_sum(ss); const float rs = 1.0f / sqrtf(ss * (1.0f / D) + EPS);
    f32x4* o = (f32x4*)(out + (size_t)row * D) + lane;
#pragma unroll
    for (int j = 0; j < 8; ++j) o[64 * j] = v[j] * rs * gr[64 * j];
}
template <class Epi> __global__ void __launch_bounds__(512, 2) k_gemm(pg8::Gemm g, Epi E) {
    extern __shared__ __attribute__((aligned(16))) unsigned char shm[];
    pg8::StaticOrder S; S.init(g.M, g.N, (int)gridDim.x, (int)blockIdx.x);
    pg8::gemm_phase<Epi, pg8::StaticOrder, true, true>((PG8_LAS unsigned char*)shm, g, S, E);
}
template <class Epi> static void launch_gemm(const bf16* A, const bf16* Bt, int M, int N, int K, const Epi& E, hipStream_t st) {
    static bool attr = false; if (!attr) { (void)hipFuncSetAttribute((const void*)k_gemm<Epi>, hipFuncAttributeMaxDynamicSharedMemorySize, pg8::STAGE_BYTES); attr = true; }
    pg8::Gemm g{A, Bt, M, N, K, 0};
    hipLaunchKernelGGL((k_gemm<Epi>), dim3(256), dim3(512), pg8::STAGE_BYTES, st, g, E);
}
constexpr size_t MiB = 1u << 20;
constexpr size_t al(size_t x) { return (x + MiB - 1) / MiB * MiB; }
constexpr size_t WS_CTL = 0;
constexpr size_t WS_WIN = 1 * MiB;
constexpr size_t WS_WBA = WS_WIN + al((size_t)2 * NPROJ * D * 2);
constexpr size_t WS_WOUT = WS_WBA + al((size_t)2 * 16 * D * 4);
constexpr size_t WS_WGU = WS_WOUT + al((size_t)2 * D * D * 2);
constexpr size_t WS_WD = WS_WGU + al((size_t)2 * DFF * D * 2);
constexpr size_t WS_MGU = WS_WD + al((size_t)D * DFF * 2);
constexpr size_t WS_MD = WS_MGU + al((size_t)2 * DFFE * D * 2);
constexpr size_t WS_XB = WS_MD + al((size_t)D * DFFE * 2);
constexpr size_t WS_RSTD = WS_XB + al((size_t)T * D * 2);
constexpr size_t WS_BA = WS_RSTD + al((size_t)T * 4);
constexpr size_t WS_BETA = WS_BA + al((size_t)T * 16 * 4);
constexpr size_t WS_G = WS_BETA + al((size_t)T * 8 * 4);
constexpr size_t WS_ROWW = WS_G + al((size_t)T * 8 * 4);
constexpr size_t WS_PROJ = WS_ROWW + al((size_t)8 * T * 4);
constexpr size_t WS_YMIX = WS_PROJ + al((size_t)T * NPROJ * 2);
constexpr size_t WS_C = WS_YMIX + al((size_t)T * D * 2);
constexpr size_t WS_END = WS_C + al((size_t)4 * T * 1024 * 4);

extern "C" void kernel_launch(void* const* d_in, const int* in_sizes, int n_in, void* d_out, int out_size, void* d_ws, size_t ws_size, hipStream_t stream) {
    if (n_in != 25 || ws_size < WS_END) { fprintf(stderr, "kernel_launch: unexpected n_in %d / ws_size %zu (need %zu)\n", n_in, ws_size, (size_t)WS_END); return; }
    const float* x_in = (const float*)d_in[0]; const float* norm_mix = (const float*)d_in[1]; const float* w_in = (const float*)d_in[2];
    const float* conv_lru_w = (const float*)d_in[3]; const float* conv_lru_b = (const float*)d_in[4]; const float* lru_w_r = (const float*)d_in[5]; const float* lru_b_r = (const float*)d_in[6];
    const float* lru_w_i = (const float*)d_in[7]; const float* lru_b_i = (const float*)d_in[8]; const float* lru_lambda = (const float*)d_in[9]; const float* lru_out_norm = (const float*)d_in[10];
    const float* conv_qkv_w = (const float*)d_in[11]; const float* dn_a_log = (const float*)d_in[12]; const float* dn_dt_bias = (const float*)d_in[13]; const float* dn_out_norm = (const float*)d_in[14];
    const float* w_out = (const float*)d_in[15]; const float* norm_ffn = (const float*)d_in[16]; const float* ffn_w_gate = (const float*)d_in[17]; const float* ffn_w_up = (const float*)d_in[18];
    const float* ffn_w_down = (const float*)d_in[19]; const float* moe_router = (const float*)d_in[20]; const float* moe_w_gate = (const float*)d_in[21]; const float* moe_w_up = (const float*)d_in[22];
    const float* moe_w_down = (const float*)d_in[23]; const float* norm_final = (const float*)d_in[24];
    unsigned char* ws = (unsigned char*)d_ws; float* xres = (float*)d_out;
    bf16* Win = (bf16*)(ws + WS_WIN); float* Wba = (float*)(ws + WS_WBA); bf16* Wout = (bf16*)(ws + WS_WOUT); bf16* Wgu = (bf16*)(ws + WS_WGU); bf16* Wd = (bf16*)(ws + WS_WD);
    bf16* Mgu = (bf16*)(ws + WS_MGU); bf16* Md = (bf16*)(ws + WS_MD); bf16* xb = (bf16*)(ws + WS_XB); float* rstd = (float*)(ws + WS_RSTD); float* ba = (float*)(ws + WS_BA);
    float* beta = (float*)(ws + WS_BETA); float* gg = (float*)(ws + WS_G); float* roww = (float*)(ws + WS_ROWW); bf16* proj = (bf16*)(ws + WS_PROJ); bf16* hid = (bf16*)(ws + WS_PROJ); bf16* ymix = (bf16*)(ws + WS_YMIX);
    float* c0 = (float*)(ws + WS_C); float* c1 = c0 + (size_t)T * 1024; float* c2 = c1 + (size_t)T * 1024; float* c3 = c2 + (size_t)T * 1024;
    const int BIG = 1 << 30;
    for (int l = 0; l < 2; ++l) {
        hipLaunchKernelGGL(k_convert_t, dim3(D / 64, NPROJ / 64), dim3(256), 0, stream, w_in + (size_t)l * D * DIN, DIN, 0, D, norm_mix + l * D, Win + (size_t)l * NPROJ * D, BIG, 0, 0);
        hipLaunchKernelGGL(k_convert_ba, dim3(16 * D / 256), dim3(256), 0, stream, w_in + (size_t)l * D * DIN, norm_mix + l * D, Wba + (size_t)l * 16 * D);
        hipLaunchKernelGGL(k_convert_t, dim3(D / 64, D / 64), dim3(256), 0, stream, w_out + (size_t)l * D * D, D, 0, D, (const float*)nullptr, Wout + (size_t)l * D * D, BIG, 0, 0);
    }
    hipLaunchKernelGGL(k_convert_t, dim3(D / 64, DFF / 64), dim3(256), 0, stream, ffn_w_gate, DFF, 0, D, norm_ffn, Wgu, 128, 256, 0);
    hipLaunchKernelGGL(k_convert_t, dim3(D / 64, DFF / 64), dim3(256), 0, stream, ffn_w_up, DFF, 0, D, norm_ffn, Wgu, 128, 256, 128);
    hipLaunchKernelGGL(k_convert_t, dim3(DFF / 64, D / 64), dim3(256), 0, stream, ffn_w_down, D, 0, DFF, (const float*)nullptr, Wd, BIG, 0, 0);
    const float* xcur = x_in;
    for (int l = 0; l < 2; ++l) {
        hipLaunchKernelGGL(k_rowprep, dim3(T / 4), dim3(256), 0, stream, xcur, xb, rstd, (const float*)(Wba + (size_t)l * 16 * D), ba);
        launch_gemm(xb, Win + (size_t)l * NPROJ * D, T, NPROJ, D, pg8::EpiScaleBf16{proj, rstd, NPROJ, 0}, stream);
        hipLaunchKernelGGL(k_lru_conv, dim3(T * DLRU / 256), dim3(256), 0, stream, proj, conv_lru_w + (size_t)l * 4 * DLRU, conv_lru_b + l * DLRU, c2);
        hipLaunchKernelGGL(k_lru_gate, dim3(T * DLRU / 256), dim3(256), 0, stream, c2, lru_w_r + (size_t)l * 8 * 128 * 128, lru_b_r + l * DLRU, lru_w_i + (size_t)l * 8 * 128 * 128, lru_b_i + l * DLRU, lru_lambda + l * DLRU, c0, c1);
        hipLaunchKernelGGL(k_lru_scan, dim3(2 * DLRU / 64), dim3(64), 0, stream, c0, c1, proj);
        hipLaunchKernelGGL(k_lru_norm, dim3(T / 4), dim3(256), 0, stream, c0, lru_out_norm + l * DLRU, ymix);
        hipLaunchKernelGGL(k_dn_prep, dim3(T * NH / 4), dim3(256), 0, stream, proj, conv_qkv_w + (size_t)l * 4 * 3 * DDN, ba, dn_a_log + l * NH, dn_dt_bias + l * NH, c0, c1, c2, beta, gg);
        hipLaunchKernelGGL(k_dn_rec, dim3(2 * NH), dim3(128), 0, stream, c0, c1, c2, beta, gg, c3);
        hipLaunchKernelGGL(k_dn_out, dim3(T * NH / 4), dim3(256), 0, stream, c3, dn_out_norm + l * HD, proj, ymix);
        launch_gemm(ymix, Wout + (size_t)l * D * D, T, D, D, pg8::EpiResidual{xcur, xres, nullptr, D, 0}, stream);
        xcur = xres;
        hipLaunchKernelGGL(k_rowprep, dim3(T / 4), dim3(256), 0, stream, xcur, xb, rstd, (const float*)nullptr, (float*)nullptr);
        if (l == 0) {
            launch_gemm(xb, Wgu, T, 2 * DFF, D, pg8::EpiSwiGLU{hid, rstd, DFF, 0}, stream);
            launch_gemm(hid, Wd, T, D, DFF, pg8::EpiResidual{xcur, xres, nullptr, D, 0}, stream);
        } else {
            hipLaunchKernelGGL(k_route, dim3(T / 4), dim3(256), 0, stream, xcur, rstd, norm_ffn + D, moe_router, roww);
            for (int e = 0; e < NEXP; ++e) {
                hipLaunchKernelGGL(k_convert_t, dim3(D / 64, DFFE / 64), dim3(256), 0, stream, moe_w_gate + (size_t)e * D * DFFE, DFFE, 0, D, norm_ffn + D, Mgu, 128, 256, 0);
                hipLaunchKernelGGL(k_convert_t, dim3(D / 64, DFFE / 64), dim3(256), 0, stream, moe_w_up + (size_t)e * D * DFFE, DFFE, 0, D, norm_ffn + D, Mgu, 128, 256, 128);
                hipLaunchKernelGGL(k_convert_t, dim3(DFFE / 64, D / 64), dim3(256), 0, stream, moe_w_down + (size_t)e * DFFE * D, D, 0, DFFE, (const float*)nullptr, Md, BIG, 0, 0);
                launch_gemm(xb, Mgu, T, 2 * DFFE, D, pg8::EpiSwiGLU{hid, rstd, DFFE, 0}, stream);
                launch_gemm(hid, Md, T, D, DFFE, pg8::EpiResidual{xcur, xres, roww + (size_t)e * T, D, 0}, stream);
            }
        }
    }
    hipLaunchKernelGGL(k_final, dim3(T / 4), dim3(256), 0, stream, xcur, norm_final, xres);
}
```

```cpp
#include <hip/hip_runtime.h>
#include <cstdio>
#include <cstdint>
namespace pg8 {
#define PG8_LAS __attribute__((address_space(3)))
typedef unsigned short bf16_t;
typedef short bf16x8 __attribute__((ext_vector_type(8)));
typedef float f32x4 __attribute__((ext_vector_type(4)));
typedef unsigned u32x4 __attribute__((ext_vector_type(4)));
constexpr int BM = 256, BK = 64, HALF = 128, HTB = HALF * BK * 2  , STAGE_BYTES = 8 * HTB, NXCD = 8, WGM = 8;

__host__ __device__ __forceinline__ int lds_byte(int r, int c) { const int st = (r >> 4) * 2 + (c >> 5), rr = r & 15, cc = c & 31, ob = rr * 64 + cc * 2; return st * 1024 + (ob ^ (((ob >> 9) & 1) << 5)); }
__host__ __device__ __forceinline__ void stage_rc(int b, int& R, int& C) { const int st = b / 1024, sb = b % 1024, swz = sb ^ (((sb >> 9) & 1) << 5); R = (st >> 1) * 16 + swz / 64; C = (st & 1) * 32 + (swz % 64) / 2; }
__host__ __device__ __forceinline__ int perm32(int rho) { const int n = rho >> 4, i = rho & 15; return 8 * (i >> 2) + 4 * n + (i & 3); }

struct Unit { int pm, pn; };
struct Gemm { const bf16_t* A; const bf16_t* Bt; int M, N, K, pad; };

struct StaticOrder {
    int nM, nN, nwg, G, c;
    __host__ __device__ void init(int M, int N, int G_, int c_) { nM = M / BM; nN = N / BM; nwg = nM * nN; G = G_; c = c_; }
    __host__ __device__ bool next(int i, Unit& u) const {
        const long L = (long)i * G + c; if (L >= nwg) return false;
        int wgid = (int)L; { const int q = nwg / NXCD, r = nwg % NXCD, xcd = wgid % NXCD, off = wgid / NXCD; wgid = (xcd < r ? xcd * (q + 1) : r * (q + 1) + (xcd - r) * q) + off; }
        const int nig = WGM * nN, gid = wgid / nig, fm = gid * WGM, gsz = (nM - fm) < WGM ? (nM - fm) : WGM;
        u.pm = fm + ((wgid % nig) % gsz); u.pn = (wgid % nig) / gsz; return true;
    }
    __device__ __forceinline__ void a_ready(const Unit&) const {}
    __device__ __forceinline__ void done(const Unit&) const {}
};


__device__ __forceinline__ unsigned cvt_pk_bf16(float lo, float hi) { unsigned r; asm volatile("v_cvt_pk_bf16_f32 %0, %1, %2" : "=v"(r) : "v"(lo), "v"(hi)); return r; }
__device__ __forceinline__ float silu_f(float x) { return x / (1.0f + __expf(-x)); }

struct EpiScaleBf16 {
    static constexpr bool PERM = true, AFTER_DRAIN = false;
    bf16_t* O; const float* rs; int ldc; int pad;
    __device__ __forceinline__ void operator()(const f32x4 (&acc)[2][2][4][2], const Unit& u, int wr, int wc, int fr, int fq) const {
        const int row0 = u.pm * BM + wr * 64 + fr, col0 = u.pn * BM + wc * 32 + 8 * fq;
#pragma unroll
        for (int ai = 0; ai < 2; ++ai)
#pragma unroll
            for (int m = 0; m < 4; ++m) { const int r = row0 + ai * HALF + m * 16; const float s = rs[r]; bf16_t* rowp = O + (size_t)r * ldc + col0;
#pragma unroll
                for (int bj = 0; bj < 2; ++bj) { const f32x4 v0 = acc[ai][bj][m][0] * s, v1 = acc[ai][bj][m][1] * s;
                    u32x4 w; w.x = cvt_pk_bf16(v0[0], v0[1]); w.y = cvt_pk_bf16(v0[2], v0[3]); w.z = cvt_pk_bf16(v1[0], v1[1]); w.w = cvt_pk_bf16(v1[2], v1[3]);
                    *(u32x4*)(rowp + bj * HALF) = w; } }
    }
};
struct EpiSwiGLU {
    static constexpr bool PERM = true, AFTER_DRAIN = false;
    bf16_t* O; const float* rs; int ldc; int pad;
    __device__ __forceinline__ void operator()(const f32x4 (&acc)[2][2][4][2], const Unit& u, int wr, int wc, int fr, int fq) const {
        const int row0 = u.pm * BM + wr * 64 + fr, col0 = u.pn * HALF + wc * 32 + 8 * fq;
#pragma unroll
        for (int ai = 0; ai < 2; ++ai)
#pragma unroll
            for (int m = 0; m < 4; ++m) { const int r = row0 + ai * HALF + m * 16; const float s = rs ? rs[r] : 1.0f; bf16_t* rowp = O + (size_t)r * ldc + col0;
                f32x4 h0, h1;
#pragma unroll
                for (int j = 0; j < 4; ++j) { h0[j] = silu_f(acc[ai][0][m][0][j] * s) * (acc[ai][1][m][0][j] * s); h1[j] = silu_f(acc[ai][0][m][1][j] * s) * (acc[ai][1][m][1][j] * s); }
                u32x4 w; w.x = cvt_pk_bf16(h0[0], h0[1]); w.y = cvt_pk_bf16(h0[2], h0[3]); w.z = cvt_pk_bf16(h1[0], h1[1]); w.w = cvt_pk_bf16(h1[2], h1[3]);
                *(u32x4*)rowp = w; }
    }
};
struct EpiResidual {
    static constexpr bool PERM = false, AFTER_DRAIN = false;
    const float* base; float* out; const float* roww; int ldc; int pad;
    __device__ __forceinline__ void operator()(const f32x4 (&acc)[2][2][4][2], const Unit& u, int wr, int wc, int fr, int fq) const {
        const int row0 = u.pm * BM + wr * 64 + fr, col0 = u.pn * BM + wc * 32 + 4 * fq;
#pragma unroll
        for (int ai = 0; ai < 2; ++ai)
#pragma unroll
            for (int m = 0; m < 4; ++m) { const int r = row0 + ai * HALF + m * 16; const float w = roww ? roww[r] : 1.0f; const size_t off = (size_t)r * ldc + col0;
#pragma unroll
                for (int bj = 0; bj < 2; ++bj)
#pragma unroll
                    for (int n = 0; n < 2; ++n) { const f32x4 bs = *(const f32x4*)(base + off + bj * HALF + n * 16); *(f32x4*)(out + off + bj * HALF + n * 16) = bs + acc[ai][bj][m][n] * w; } }
    }
};
template <class Epi, class Sched, bool ALIGN_EPI = false, bool SP2 = false>
__device__ __forceinline__ void gemm_phase(PG8_LAS unsigned char* lds, const Gemm g, const Sched& S, const Epi& E) {
    int tid_o = threadIdx.x; asm volatile("" : "+v"(tid_o));
    const int tid = tid_o, wid = __builtin_amdgcn_readfirstlane(tid >> 6), lane = tid & 63, wr = wid >> 2, wc = wid & 3, fr = lane & 15, fq = lane >> 4;
    const int K = g.K, nt = K / BK;
    unsigned voffA[2], voffB[2];
#pragma unroll
    for (int i = 0; i < 2; ++i) { int R, C; stage_rc(tid * 16 + i * 8192, R, C); const int Rb = Epi::PERM ? ((R & ~31) + perm32(R & 31)) : R;
        voffA[i] = (unsigned)(R * K + C) * 2u; voffB[i] = (unsigned)(Rb * K + C) * 2u; }
    const size_t kstep = (size_t)(BK * 2);
    const size_t hstep = (size_t)HALF * K * 2;
    const size_t tstep = 2 * hstep;
    const unsigned ldsw = (unsigned)wid * 1024u;
    const int aoff = lds_byte(wr * 64 + fr, fq * 8), boff = lds_byte(wc * 32 + fr, fq * 8);
#define PG8_SA(b, h) (((b) * 2 + (h)) * HTB)
#define PG8_SB(b, h) ((4 + (b) * 2 + (h)) * HTB)
#define PG8_STAGE(bufoff, gbase, voff) do { _Pragma("unroll") for (int _i = 0; _i < 2; ++_i) \
        __builtin_amdgcn_global_load_lds((const unsigned*)((const char*)(gbase) + (voff)[_i]), (PG8_LAS unsigned*)(lds + (bufoff) + ldsw + _i * 8192), 16, 0, 0); } while (0)
#define PG8_LDA(dst, b, h) do { _Pragma("unroll") for (int m = 0; m < 4; ++m) _Pragma("unroll") for (int k = 0; k < 2; ++k) dst[m][k] = *(const PG8_LAS bf16x8*)(lds + PG8_SA(b, h) + aoff + m * 2048 + k * 1024); } while (0)
#define PG8_LDB(dst, b, h) do { _Pragma("unroll") for (int n = 0; n < 2; ++n) _Pragma("unroll") for (int k = 0; k < 2; ++k) dst[n][k] = *(const PG8_LAS bf16x8*)(lds + PG8_SB(b, h) + boff + n * 2048 + k * 1024); } while (0)
#define PG8_MMA(ai, bj, At, Bt) do { __builtin_amdgcn_s_setprio(1); _Pragma("unroll") for (int m = 0; m < 4; ++m) _Pragma("unroll") for (int n = 0; n < 2; ++n) _Pragma("unroll") for (int k = 0; k < 2; ++k) \
        acc[ai][bj][m][n] = __builtin_amdgcn_mfma_f32_16x16x32_bf16(Bt[n][k], At[m][k], acc[ai][bj][m][n], 0, 0, 0); __builtin_amdgcn_s_setprio(0); } while (0)
#define PG8_WAIT_V(n) asm volatile("s_waitcnt vmcnt(" #n ")" ::: "memory")
#define PG8_WAIT_L(n) asm volatile("s_waitcnt lgkmcnt(" #n ")" ::: "memory")
#define PG8_BAR __builtin_amdgcn_s_barrier()
#define PG8_SCHED __builtin_amdgcn_sched_barrier(0)
    Unit cur, nxt; int ui = 0;
    if (!S.next(0, cur)) return;
    f32x4 acc[2][2][4][2];
#pragma unroll
    for (int a = 0; a < 2; ++a)
#pragma unroll
        for (int b = 0; b < 2; ++b)
#pragma unroll
            for (int m = 0; m < 4; ++m)
#pragma unroll
                for (int n = 0; n < 2; ++n) acc[a][b][m][n] = (f32x4){0.f, 0.f, 0.f, 0.f};
    bf16x8 At[4][2], B0[2][2], B1[2][2];
    const char* cA = (const char*)g.A + (size_t)cur.pm * tstep; const char* cB = (const char*)g.Bt + (size_t)cur.pn * tstep;
    S.a_ready(cur);
    if constexpr (SP2) {
        PG8_STAGE(PG8_SB(0, 0), cB, voffB); PG8_STAGE(PG8_SB(0, 1), cB + hstep, voffB); PG8_STAGE(PG8_SA(0, 0), cA, voffA); PG8_STAGE(PG8_SA(0, 1), cA + hstep, voffA);
        if (wr == 1) PG8_BAR;
        PG8_WAIT_V(2); PG8_BAR;
        PG8_STAGE(PG8_SB(1, 0), cB + kstep, voffB); PG8_STAGE(PG8_SA(1, 0), cA + kstep, voffA); PG8_STAGE(PG8_SB(1, 1), cB + hstep + kstep, voffB);
        PG8_WAIT_V(6); PG8_BAR;
    } else {
        PG8_STAGE(PG8_SB(0, 0), cB, voffB); PG8_STAGE(PG8_SA(0, 0), cA, voffA); PG8_STAGE(PG8_SB(0, 1), cB + hstep, voffB); PG8_STAGE(PG8_SA(0, 1), cA + hstep, voffA);
        if (wr == 1) PG8_BAR;
        PG8_WAIT_V(4); PG8_BAR;
        PG8_STAGE(PG8_SB(1, 0), cB + kstep, voffB); PG8_STAGE(PG8_SA(1, 0), cA + kstep, voffA); PG8_STAGE(PG8_SB(1, 1), cB + hstep + kstep, voffB);
        PG8_WAIT_V(6); PG8_BAR;
    }
    for (;;) {
        const bool has_next = S.next(ui + 1, nxt);
        const char* nA = has_next ? (const char*)g.A + (size_t)nxt.pm * tstep : cA; const char* nB = has_next ? (const char*)g.Bt + (size_t)nxt.pn * tstep : cB;
        for (int t = 0; t < nt; t += 2) {
            const bool last = (t == nt - 2);
            const char* a1 = cA + (size_t)(t + 1) * kstep;
            const char* a2 = last ? nA : cA + (size_t)(t + 2) * kstep; const char* b2 = last ? nB : cB + (size_t)(t + 2) * kstep;
            const char* a3 = a2 + kstep; const char* b3 = b2 + kstep;
            if (last && has_next) S.a_ready(nxt);
            if constexpr (SP2) {
            PG8_LDB(B0, 0, 0); PG8_LDB(B1, 0, 1); PG8_SCHED; PG8_LDA(At, 0, 0); PG8_STAGE(PG8_SA(1, 1), a1 + hstep, voffA);
            PG8_WAIT_V(8); PG8_WAIT_L(0); PG8_BAR; PG8_MMA(0, 0, At, B0); PG8_MMA(0, 1, At, B1); PG8_BAR; PG8_SCHED;
            PG8_LDA(At, 0, 1); PG8_STAGE(PG8_SB(0, 0), b2, voffB); PG8_STAGE(PG8_SB(0, 1), b2 + hstep, voffB); PG8_STAGE(PG8_SA(0, 0), a2, voffA);
            PG8_WAIT_V(8); PG8_WAIT_L(0); PG8_BAR; PG8_MMA(1, 0, At, B0); PG8_MMA(1, 1, At, B1); PG8_BAR; PG8_SCHED;
            PG8_LDB(B0, 1, 0); PG8_LDB(B1, 1, 1); PG8_SCHED; PG8_LDA(At, 1, 0); PG8_STAGE(PG8_SA(0, 1), a2 + hstep, voffA);
            PG8_WAIT_V(8); PG8_WAIT_L(0); PG8_BAR; PG8_MMA(0, 0, At, B0); PG8_MMA(0, 1, At, B1); PG8_BAR; PG8_SCHED;
            PG8_LDA(At, 1, 1); PG8_STAGE(PG8_SB(1, 0), b3, voffB); PG8_STAGE(PG8_SB(1, 1), b3 + hstep, voffB); PG8_STAGE(PG8_SA(1, 0), a3, voffA);
            PG8_WAIT_V(8); PG8_WAIT_L(0); PG8_BAR; PG8_MMA(1, 0, At, B0); PG8_MMA(1, 1, At, B1); PG8_BAR; PG8_SCHED;
            } else {
            PG8_LDB(B0, 0, 0); PG8_SCHED; PG8_LDA(At, 0, 0); PG8_STAGE(PG8_SA(1, 1), a1 + hstep, voffA);
            PG8_WAIT_L(8); PG8_BAR; PG8_WAIT_L(0); PG8_MMA(0, 0, At, B0); PG8_BAR; PG8_SCHED;
            PG8_LDB(B1, 0, 1); PG8_STAGE(PG8_SB(0, 0), b2, voffB);
            PG8_BAR; PG8_WAIT_L(0); PG8_MMA(0, 1, At, B1); PG8_BAR;
            PG8_LDA(At, 0, 1); PG8_STAGE(PG8_SA(0, 0), a2, voffA);
            PG8_BAR; PG8_WAIT_L(0); PG8_MMA(1, 0, At, B0); PG8_BAR; PG8_SCHED;
            PG8_STAGE(PG8_SB(0, 1), b2 + hstep, voffB);
            PG8_WAIT_V(6); PG8_BAR; PG8_MMA(1, 1, At, B1); PG8_BAR;
            PG8_LDB(B0, 1, 0); PG8_SCHED; PG8_LDA(At, 1, 0); PG8_STAGE(PG8_SA(0, 1), a2 + hstep, voffA);
            PG8_WAIT_L(8); PG8_BAR; PG8_WAIT_L(0); PG8_MMA(0, 0, At, B0); PG8_BAR; PG8_SCHED;
            PG8_LDB(B1, 1, 1); PG8_STAGE(PG8_SB(1, 0), b3, voffB);
            PG8_BAR; PG8_WAIT_L(0); PG8_MMA(0, 1, At, B1); PG8_BAR;
            PG8_LDA(At, 1, 1); PG8_STAGE(PG8_SA(1, 0), a3, voffA);
            PG8_BAR; PG8_WAIT_L(0); PG8_MMA(1, 0, At, B0); PG8_BAR; PG8_SCHED;
            PG8_STAGE(PG8_SB(1, 1), b3 + hstep, voffB);
            PG8_WAIT_V(6); PG8_BAR; PG8_MMA(1, 1, At, B1); PG8_BAR;
            }
        }
        if constexpr (ALIGN_EPI) { if (wr == 0) PG8_BAR; }
        if constexpr (!Epi::AFTER_DRAIN) { E(acc, cur, wr, wc, fr, fq); S.done(cur); }
        if (!has_next) break;
#pragma unroll
        for (int a = 0; a < 2; ++a)
#pragma unroll
            for (int b = 0; b < 2; ++b)
#pragma unroll
                for (int m = 0; m < 4; ++m)
#pragma unroll
                    for (int n = 0; n < 2; ++n) acc[a][b][m][n] = (f32x4){0.f, 0.f, 0.f, 0.f};
        cur = nxt; cA = nA; cB = nB; ++ui;
        if constexpr (ALIGN_EPI) { if (wr == 1) PG8_BAR; }
    }
    PG8_WAIT_V(0);
    if constexpr (!ALIGN_EPI) { if (wr == 0) PG8_BAR; }
    PG8_BAR;
    if constexpr (Epi::AFTER_DRAIN) { E.fused(acc, cur, wr, wc, fr, fq, lds, wid, lane); S.done(cur); }
#undef PG8_SA
#undef PG8_SB
#undef PG8_STAGE
#undef PG8_LDA
#undef PG8_LDB
#undef PG8_MMA
#undef PG8_WAIT_V
#undef PG8_WAIT_L
#undef PG8_BAR
#undef PG8_SCHED
}
}

#define GAS __attribute__((address_space(1)))
#define LAS __attribute__((address_space(3)))
#define XB_TMO      128
#define XB_XCNT(j)  (256  + 64 * (j))
#define XB_XSUB(j)  (1280 + 64 * (j))
#define XB_XGEN(j)  (2304 + 64 * (j))
#define XB_TOP      3328
#define XB_TOPGEN   3392
#define XCD_BAR_WORDS 3456
#define XB_SPIN_CAP (1u << 23)

__device__ __forceinline__ unsigned xb_ld(unsigned* p)              { return __hip_atomic_load(p, __ATOMIC_RELAXED, __HIP_MEMORY_SCOPE_AGENT); }
__device__ __forceinline__ unsigned xb_add(unsigned* p, unsigned v) { return __hip_atomic_fetch_add(p, v, __ATOMIC_RELAXED, __HIP_MEMORY_SCOPE_AGENT); }
__device__ __forceinline__ unsigned xb_xcc_id() { return (unsigned)__builtin_amdgcn_s_getreg((3 << 11) | 20) & 0xFu; }
#define XB_SPIN(cond, bar) do { unsigned _sp = 0; while (cond) { __builtin_amdgcn_s_sleep(1); \
    if ((++_sp & 255u) == 0u) { if (xb_ld(&(bar)[XB_TMO])) break; if (_sp > XB_SPIN_CAP) { atomicAdd(&(bar)[XB_TMO], 1u); break; } } } } while (0)

struct XcdBarrier {
    unsigned* bar; unsigned x;
    volatile LAS unsigned* st;
};

__device__ __forceinline__ XcdBarrier xcd_barrier_post(unsigned* bar, volatile LAS unsigned* st) {
    XcdBarrier b; b.bar = bar; b.x = xb_xcc_id(); b.st = st;
    if (threadIdx.x == 0) (void)xb_add(&bar[XB_XCNT(b.x)], 1u);
    return b;
}
__device__ __forceinline__ void xcd_barrier_complete(unsigned* bar, unsigned x, unsigned& nloc, unsigned& nx) {
    const unsigned G = gridDim.x * gridDim.y * gridDim.z;
    unsigned sum, cnt, mine, sp = 0u;
    for (;;) {
        sum = 0u; cnt = 0u; mine = 0u;
#pragma unroll
        for (unsigned j = 0; j < 16; ++j) { const unsigned c = xb_ld(&bar[XB_XCNT(j)]); sum += c; cnt += (c > 0u) ? 1u : 0u; mine = (j == x) ? c : mine; }
        if (sum == G) break;
        __builtin_amdgcn_s_sleep(1);
        if ((++sp & 255u) == 0u) { if (xb_ld(&bar[XB_TMO])) break; if (sp > XB_SPIN_CAP) { atomicAdd(&bar[XB_TMO], 1u); break; } }
    }
    nloc = mine > 0u ? mine : 1u; nx = cnt > 0u ? cnt : 1u;
}

__device__ __forceinline__ void xcd_barrier(const XcdBarrier& b) {
    asm volatile("s_waitcnt vmcnt(0)" ::: "memory");
    __syncthreads();
    if (threadIdx.x == 0) {
        unsigned* bar = b.bar;
        __builtin_amdgcn_s_waitcnt(0);
        unsigned nloc = b.st[0], nx = b.st[1];
        if (nloc == 0u) { xcd_barrier_complete(bar, b.x, nloc, nx); b.st[0] = nloc; b.st[1] = nx; }
        const unsigned old = xb_add(&bar[XB_XSUB(b.x)], 1u);
        const unsigned gen = old / nloc;
        if (old + 1u == (gen + 1u) * nloc) {
            __builtin_amdgcn_fence(__ATOMIC_RELEASE, "agent");
            asm volatile("s_waitcnt vmcnt(0)" ::: "memory");
            const unsigned og = xb_add(&bar[XB_TOP], 1u);
            const unsigned tg = og / nx;
            if (og + 1u == (tg + 1u) * nx) xb_add(&bar[XB_TOPGEN], 1u);
            else XB_SPIN(xb_ld(&bar[XB_TOPGEN]) == tg, bar);
            __builtin_amdgcn_fence(__ATOMIC_ACQUIRE, "agent");
            xb_add(&bar[XB_XGEN(b.x)], 1u);
            asm volatile("s_waitcnt vmcnt(0)" ::: "memory");
        } else {
            XB_SPIN(xb_ld(&bar[XB_XGEN(b.x)]) == gen, bar);
            __builtin_amdgcn_fence(__ATOMIC_ACQUIRE, "agent");
            asm volatile("s_waitcnt vmcnt(0)" ::: "memory");
        }
    }
    __syncthreads();
}

constexpr int T = 16384, SEQ = 8192, D = 2048, DLRU = 1024, DDN = 1024, NH = 8, HD = 128, NPROJ = 6144, DIN = 6160;
constexpr int DFF = 6144, NEXP = 8, DFFE = 3072;
constexpr float EPS = 1e-6f;
typedef unsigned short bf16;
typedef float f32x4 __attribute__((ext_vector_type(4)));
typedef unsigned u32x4 __attribute__((ext_vector_type(4)));
typedef unsigned u32x2 __attribute__((ext_vector_type(2)));
#define LDS_WAIT() asm volatile("s_waitcnt lgkmcnt(0)" ::: "memory")

__device__ __forceinline__ float bf2f(bf16 b) { return __uint_as_float(((unsigned)b) << 16); }
__device__ __forceinline__ unsigned f2bf(float f) { unsigned u = __float_as_uint(f); return (u + 0x7fffu + ((u >> 16) & 1u)) >> 16; }
__device__ __forceinline__ unsigned pk2(float lo, float hi) { return f2bf(lo) | (f2bf(hi) << 16); }
__device__ __forceinline__ float wave_sum(float v) {
#pragma unroll
    for (int o = 1; o < 64; o <<= 1) v += __shfl_xor(v, o);
    return v;
}
using pg8::silu_f;
__device__ __forceinline__ float sigmoid_f(float x) { return 1.0f / (1.0f + __expf(-x)); }
__device__ __forceinline__ float softplus_f(float x) { return fmaxf(x, 0.0f) + log1pf(__expf(-fabsf(x))); }
__device__ __forceinline__ float gelu_tanh_f(float x) { const float u = 0.7978845608028654f * (x + 0.044715f * x * x * x); return 0.5f * x * (1.0f + tanhf(u)); }

constexpr size_t MiB = 1u << 20;
constexpr size_t al(size_t x) { return (x + MiB - 1) / MiB * MiB; }
constexpr size_t WS_CTL = 0, CTL_ZERO_BYTES = 1 * MiB;
constexpr int CW_BAR = 4096;
constexpr size_t WS_WIN = 1 * MiB;
constexpr size_t WS_WBA = WS_WIN + al((size_t)2 * NPROJ * D * 2);
constexpr size_t WS_WOUT = WS_WBA + al((size_t)2 * 16 * D * 4);
constexpr size_t WS_WGU = WS_WOUT + al((size_t)2 * D * D * 2);
constexpr size_t WS_WD = WS_WGU + al((size_t)2 * DFF * D * 2);
constexpr size_t WS_MGU = WS_WD + al((size_t)D * DFF * 2);
constexpr size_t WS_MD = WS_MGU + al((size_t)2 * DFFE * D * 2);
constexpr size_t WS_XB = WS_MD + al((size_t)D * DFFE * 2);
constexpr size_t WS_RSTD = WS_XB + al((size_t)T * D * 2);
constexpr size_t WS_BA = WS_RSTD + al((size_t)T * 4);
constexpr size_t WS_BETA = WS_BA + al((size_t)T * 16 * 4);
constexpr size_t WS_G = WS_BETA + al((size_t)T * 8 * 4);
constexpr size_t WS_ROWW = WS_G + al((size_t)T * 8 * 4);
constexpr size_t WS_PROJ = WS_ROWW + al((size_t)8 * T * 4);
constexpr size_t WS_YMIX = WS_PROJ + al((size_t)T * NPROJ * 2);
constexpr size_t WS_C = WS_YMIX + al((size_t)T * D * 2);
constexpr size_t WS_END = WS_C + al((size_t)4 * T * 1024 * 4);
constexpr int RING_BYTES = 131072, LDSCTL_OFF = RING_BYTES, MISC_OFF = LDSCTL_OFF + 320, LDS_BYTES = 147456;

__device__ __forceinline__ void transpose_item(const float* W, int ldw, int col_off, int K, int nblk, const float* gain, bf16* WT, int blk, int blk_stride, int row_off, LAS float* scr, int item, int lane) {
    const int kb = item / nblk, nb = item % nblk, k0 = 64 * kb, n0 = 32 * nb;
#pragma unroll 8
    for (int i = 0; i < 32; ++i) { const int kk = 2 * i + (lane >> 5); const float g = gain ? gain[k0 + kk] : 1.0f; scr[kk * 33 + (lane & 31)] = W[(size_t)(k0 + kk) * ldw + col_off + n0 + (lane & 31)] * g; }
    LDS_WAIT(); asm volatile("" ::: "memory");
    const int c = lane & 7;
#pragma unroll
    for (int j = 0; j < 4; ++j) { const int nl = (lane >> 3) + 8 * j, n = n0 + nl; const LAS float* s = scr + (8 * c) * 33 + nl;
        u32x4 o; o.x = pk2(s[0 * 33], s[1 * 33]); o.y = pk2(s[2 * 33], s[3 * 33]); o.z = pk2(s[4 * 33], s[5 * 33]); o.w = pk2(s[6 * 33], s[7 * 33]);
        const int drow = (n / blk) * blk_stride + (n % blk) + row_off;
        *(u32x4*)(WT + (size_t)drow * K + k0 + 8 * c) = o; }
    LDS_WAIT(); asm volatile("" ::: "memory");
}
__device__ __forceinline__ void convert_matrix(const float* W, int ldw, int col_off, int K, int N, const float* gain, bf16* WT, int blk, int blk_stride, int row_off, LAS float* scr, int gw, int NGW, int lane) {
    const int nblk = N / 32, nitems = (K / 64) * nblk;
    for (int it = gw; it < nitems; it += NGW) transpose_item(W, ldw, col_off, K, nblk, gain, WT, blk, blk_stride, row_off, scr, it, lane);
}
__device__ __forceinline__ void rowprep_row(const float* x, bf16* xb, float* rstd, const float* Wba, float* ba, int row, int lane) {
    const f32x4* xr = (const f32x4*)(x + (size_t)row * D) + lane;
    f32x4 v[8]; float ss = 0.f;
#pragma unroll
    for (int j = 0; j < 8; ++j) { v[j] = xr[64 * j]; ss += (v[j][0] * v[j][0] + v[j][1] * v[j][1]) + (v[j][2] * v[j][2] + v[j][3] * v[j][3]); }
    ss = wave_sum(ss);
    const float rs = 1.0f / sqrtf(ss * (1.0f / D) + EPS);
    u32x2* o = (u32x2*)(xb + (size_t)row * D) + lane;
#pragma unroll
    for (int j = 0; j < 8; ++j) { u32x2 w; w.x = pk2(v[j][0], v[j][1]); w.y = pk2(v[j][2], v[j][3]); o[64 * j] = w; }
    if (lane == 0) rstd[row] = rs;
    if (Wba) {
        for (int c = 0; c < 16; ++c) { const f32x4* wr = (const f32x4*)(Wba + (size_t)c * D) + lane; float a = 0.f;
#pragma unroll
            for (int j = 0; j < 8; ++j) { const f32x4 w = wr[64 * j]; a += (v[j][0] * w[0] + v[j][1] * w[1]) + (v[j][2] * w[2] + v[j][3] * w[3]); }
            a = wave_sum(a); if (lane == 0) ba[(size_t)row * 16 + c] = a * rs; }
    }
}
__device__ __forceinline__ void lru_conv_elem(const bf16* proj, const float* cw, const float* cb, float* xc, size_t idx) {
    const int t = (int)(idx / DLRU), ch = (int)(idx % DLRU), s = t % SEQ;
    float a = cb[ch];
#pragma unroll
    for (int k = 0; k < 4; ++k) { const int sp = s - 3 + k; if (sp >= 0) a += cw[k * DLRU + ch] * bf2f(proj[(size_t)(t - 3 + k) * NPROJ + ch]); }
    xc[idx] = a;
}
__device__ __forceinline__ void lru_gate_elem(const float* xc, const float* w_r, const float* b_r, const float* w_i, const float* b_i, const float* lam, float* av, float* bv, size_t idx) {
    const int t = (int)(idx / DLRU), ch = (int)(idx % DLRU), n = ch >> 7, d = ch & 127;
    float ar = b_r[ch], ai = b_i[ch];
    const float* xr = xc + (size_t)t * DLRU + n * 128; const float* wr = w_r + (size_t)n * 128 * 128 + d; const float* wi = w_i + (size_t)n * 128 * 128 + d;
    for (int c = 0; c < 128; ++c) { const float xv = xr[c]; ar += xv * wr[c * 128]; ai += xv * wi[c * 128]; }
    const float r = sigmoid_f(ar), ig = sigmoid_f(ai);
    const float log_a = -8.0f * r * softplus_f(-lam[ch]);
    const float a = expf(log_a), mult = sqrtf(-expm1f(2.0f * log_a));
    av[idx] = a; bv[idx] = mult * (ig * xc[idx]);
}
__device__ __forceinline__ void lru_scan_chan(float* av, const float* bv, const bf16* proj, int idx) {
    const int b = idx / DLRU, ch = idx % DLRU;
    float h = 0.f;
    for (int s0 = 0; s0 < SEQ; s0 += 8) {
        float a8[8], b8[8], g8[8];
#pragma unroll
        for (int j = 0; j < 8; ++j) { const size_t t = (size_t)b * SEQ + s0 + j; a8[j] = av[t * DLRU + ch]; b8[j] = bv[t * DLRU + ch]; g8[j] = bf2f(proj[t * NPROJ + DLRU + ch]); }
#pragma unroll
        for (int j = 0; j < 8; ++j) { const size_t t = (size_t)b * SEQ + s0 + j; h = a8[j] * h + b8[j]; av[t * DLRU + ch] = h * gelu_tanh_f(g8[j]); }
    }
}
__device__ __forceinline__ void lru_norm_row(const float* y, const float* gain, bf16* ymix, int row, int lane) {
    const f32x4* yr = (const f32x4*)(y + (size_t)row * DLRU) + lane; const f32x4* gr = (const f32x4*)gain + lane;
    f32x4 v[4]; float ss = 0.f;
#pragma unroll
    for (int j = 0; j < 4; ++j) { v[j] = yr[64 * j]; ss += (v[j][0] * v[j][0] + v[j][1] * v[j][1]) + (v[j][2] * v[j][2] + v[j][3] * v[j][3]); }
    ss = wave_sum(ss); const float rs = 1.0f / sqrtf(ss * (1.0f / DLRU) + EPS);
    u32x2* o = (u32x2*)(ymix + (size_t)row * D) + lane;
#pragma unroll
    for (int j = 0; j < 4; ++j) { const f32x4 g = gr[64 * j]; u32x2 w; w.x = pk2(v[j][0] * rs * g[0], v[j][1] * rs * g[1]); w.y = pk2(v[j][2] * rs * g[2], v[j][3] * rs * g[3]); o[64 * j] = w; }
}
__device__ __forceinline__ void dn_prep_item(const bf16* proj, const float* cw, const float* ba, const float* a_log, const float* dt_bias, float* qn, float* kn, float* vn, float* beta, float* gg, int w, int lane) {
    const int t = w >> 3, h = w & 7, s = t % SEQ;
    float val[3][2];
#pragma unroll
    for (int p = 0; p < 3; ++p)
#pragma unroll
        for (int e = 0; e < 2; ++e) { const int d = lane * 2 + e, c = p * DDN + h * HD + d; float a = 0.f;
#pragma unroll
            for (int k = 0; k < 4; ++k) { const int sp = s - 3 + k; if (sp >= 0) a += cw[k * 3 * DDN + c] * bf2f(proj[(size_t)(t - 3 + k) * NPROJ + 2048 + c]); }
            val[p][e] = silu_f(a); }
    const float sq = wave_sum(val[0][0] * val[0][0] + val[0][1] * val[0][1]), sk = wave_sum(val[1][0] * val[1][0] + val[1][1] * val[1][1]);
    const float rq = (1.0f / sqrtf(sq + EPS)) * 0.08838834764831845f, rk = 1.0f / sqrtf(sk + EPS);
    const size_t o = ((size_t)t * NH + h) * HD + lane * 2;
    qn[o] = val[0][0] * rq; qn[o + 1] = val[0][1] * rq; kn[o] = val[1][0] * rk; kn[o + 1] = val[1][1] * rk; vn[o] = val[2][0]; vn[o + 1] = val[2][1];
    if (lane == 0) { beta[t * NH + h] = sigmoid_f(ba[(size_t)t * 16 + h]); gg[t * NH + h] = -__expf(a_log[h]) * softplus_f(ba[(size_t)t * 16 + 8 + h] + dt_bias[h]); }
}
__device__ __forceinline__ void dn_rec_seq(const float* qn, const float* kn, const float* vn, const float* beta, const float* gg, float* o, int bh, LAS float* sk, LAS float* sq, LAS float* st, int tid) {
    const int b = bh >> 3, h = bh & 7, j = tid & 127; const bool act = tid < 128;
    if (act) for (int k = 0; k < 128; ++k) st[k * 128 + j] = 0.f;
    const size_t base = ((size_t)(b * SEQ) * NH + h) * HD;
    float nk = kn[base + j], nq = qn[base + j], nv = vn[base + j], nb = beta[(b * SEQ) * NH + h], ng = gg[(b * SEQ) * NH + h];
    for (int s = 0; s < SEQ; ++s) {
        const int buf = (s & 1) * 128;
        if (act) { sk[buf + j] = nk; sq[buf + j] = nq; }
        const float vj = nv, be = nb, ge = __expf(ng);
        __syncthreads();
        if (act) {
            if (s + 1 < SEQ) { const size_t nb_ = ((size_t)(b * SEQ + s + 1) * NH + h) * HD; nk = kn[nb_ + j]; nq = qn[nb_ + j]; nv = vn[nb_ + j]; nb = beta[(b * SEQ + s + 1) * NH + h]; ng = gg[(b * SEQ + s + 1) * NH + h]; }
            float ks = 0.f;
#pragma unroll 8
            for (int k = 0; k < 128; ++k) ks += sk[buf + k] * st[k * 128 + j];
            const float vnew = be * (vj - ge * ks);
            float oo = 0.f;
#pragma unroll 8
            for (int k = 0; k < 128; ++k) { const float sv = ge * st[k * 128 + j] + sk[buf + k] * vnew; st[k * 128 + j] = sv; oo += sq[buf + k] * sv; }
            o[((size_t)(b * SEQ + s) * NH + h) * HD + j] = oo;
        }
    }
    __syncthreads();
}
__device__ __forceinline__ void dn_out_item(const float* o, const float* gain, const bf16* proj, bf16* ymix, int w, int lane) {
    const int t = w >> 3, h = w & 7;
    const size_t ob = ((size_t)t * NH + h) * HD + lane * 2;
    const float o0 = o[ob], o1 = o[ob + 1];
    const float ss = wave_sum(o0 * o0 + o1 * o1), rs = 1.0f / sqrtf(ss * (1.0f / HD) + EPS);
    const int c = h * HD + lane * 2;
    const float g0 = bf2f(proj[(size_t)t * NPROJ + 5120 + c]), g1 = bf2f(proj[(size_t)t * NPROJ + 5120 + c + 1]);
    *(unsigned*)(ymix + (size_t)t * D + DLRU + c) = pk2(o0 * rs * gain[lane * 2] * silu_f(g0), o1 * rs * gain[lane * 2 + 1] * silu_f(g1));
}
__device__ __forceinline__ void route_row(const float* x, const float* rstd, const float* gain, const float* router, float* roww, int row, int lane) {
    float acc[8];
#pragma unroll
    for (int e = 0; e < 8; ++e) acc[e] = 0.f;
    for (int j = 0; j < 32; ++j) { const int k = lane + 64 * j; const float xv = x[(size_t)row * D + k] * gain[k]; const f32x4 r0 = *(const f32x4*)(router + (size_t)k * 8), r1 = *(const f32x4*)(router + (size_t)k * 8 + 4);
        acc[0] += xv * r0[0]; acc[1] += xv * r0[1]; acc[2] += xv * r0[2]; acc[3] += xv * r0[3]; acc[4] += xv * r1[0]; acc[5] += xv * r1[1]; acc[6] += xv * r1[2]; acc[7] += xv * r1[3]; }
    const float rs = rstd[row];
#pragma unroll
    for (int e = 0; e < 8; ++e) acc[e] = wave_sum(acc[e]) * rs;
    int e1 = 0; float l1 = acc[0];
#pragma unroll
    for (int e = 1; e < 8; ++e) if (acc[e] > l1) { l1 = acc[e]; e1 = e; }
    int e2 = -1; float l2 = -3.4e38f;
#pragma unroll
    for (int e = 0; e < 8; ++e) if (e != e1 && acc[e] > l2) { l2 = acc[e]; e2 = e; }
    const float w1 = 1.0f / (1.0f + __expf(l2 - l1)), w2 = 1.0f - w1;
    if (lane < 8) roww[(size_t)lane * T + row] = lane == e1 ? w1 : (lane == e2 ? w2 : 0.0f);
}
__device__ __forceinline__ void final_row(const float* x, const float* gain, float* out, int row, int lane) {
    const f32x4* xr = (const f32x4*)(x + (size_t)row * D) + lane; const f32x4* gr = (const f32x4*)gain + lane;
    f32x4 v[8]; float ss = 0.f;
#pragma unroll
    for (int j = 0; j < 8; ++j) { v[j] = xr[64 * j]; ss += (v[j][0] * v[j][0] + v[j][1] * v[j][1]) + (v[j][2] * v[j][2] + v[j][3] * v[j][3]); }
    ss = wave_sum(ss); const float rs = 1.0f / sqrtf(ss * (1.0f / D) + EPS);
    f32x4* o = (f32x4*)(out + (size_t)row * D) + lane;
#pragma unroll
    for (int j = 0; j < 8; ++j) o[64 * j] = v[j] * rs * gr[64 * j];
}

struct Args { const float* in[25]; float* out; unsigned char* ws; int ph_lo, ph_hi; };
typedef const __attribute__((address_space(4))) unsigned long long* kaptr_t;
__device__ __forceinline__ unsigned long long ldka(int i) { kaptr_t ka = (kaptr_t)__builtin_amdgcn_kernarg_segment_ptr(); asm volatile("" : "+s"(i)); return ka[i]; }
__device__ __forceinline__ const float* ldin(const Args&, int i) { return (const float*)ldka(i); }
__device__ __forceinline__ unsigned char* ldws(const Args&) { return (unsigned char*)ldka(26); }
__device__ __forceinline__ float* ldout(const Args&) { return (float*)ldka(25); }
__global__ void __launch_bounds__(512, 2) mega(Args args) {
    extern __shared__ __attribute__((aligned(16))) unsigned char lds_raw[];
    LAS unsigned char* lds = (LAS unsigned char*)lds_raw;
    volatile LAS unsigned* MISC = (volatile LAS unsigned*)(lds + MISC_OFF);
    const int tid = threadIdx.x, lane = tid & 63, wave = __builtin_amdgcn_readfirstlane(tid >> 6);
    const int G = gridDim.x, bid = blockIdx.x, gw = bid * 8 + wave, NGW = G * 8;
    const size_t gt = (size_t)bid * 512 + tid, NGT = (size_t)G * 512;
    unsigned char* ws = ldws(args);
    for (int u = tid; u < (LDS_BYTES - LDSCTL_OFF) / 4; u += 512) ((LAS unsigned*)(lds + LDSCTL_OFF))[u] = 0u;
    __syncthreads();
    XcdBarrier bar = xcd_barrier_post((unsigned*)(ws + WS_CTL) + CW_BAR, MISC + 8);
    const int lo = args.ph_lo, hi = args.ph_hi;
#define RUN(id) (lo <= (id) && (id) < hi)
#define SEAM(id) do { if (RUN(id) && (id) + 1 < hi) xcd_barrier(bar); } while (0)
#define INP(i) ldin(args, (i))
#define WSP(off) (ldws(args) + (off))
#define x_in INP(0)
#define norm_mix INP(1)
#define w_in INP(2)
#define conv_lru_w INP(3)
#define conv_lru_b INP(4)
#define lru_w_r INP(5)
#define lru_b_r INP(6)
#define lru_w_i INP(7)
#define lru_b_i INP(8)
#define lru_lambda INP(9)
#define lru_out_norm INP(10)
#define conv_qkv_w INP(11)
#define dn_a_log INP(12)
#define dn_dt_bias INP(13)
#define dn_out_norm INP(14)
#define w_out INP(15)
#define norm_ffn INP(16)
#define ffn_w_gate INP(17)
#define ffn_w_up INP(18)
#define ffn_w_down INP(19)
#define moe_router INP(20)
#define moe_w_gate INP(21)
#define moe_w_up INP(22)
#define moe_w_down INP(23)
#define norm_final INP(24)
#define xres (ldout(args))
#define Win ((bf16*)WSP(WS_WIN))
#define Wba ((float*)WSP(WS_WBA))
#define Wout ((bf16*)WSP(WS_WOUT))
#define Wgu ((bf16*)WSP(WS_WGU))
#define Wd ((bf16*)WSP(WS_WD))
#define Mgu ((bf16*)WSP(WS_MGU))
#define Md ((bf16*)WSP(WS_MD))
#define xb ((bf16*)WSP(WS_XB))
#define rstd ((float*)WSP(WS_RSTD))
#define ba ((float*)WSP(WS_BA))
#define beta ((float*)WSP(WS_BETA))
#define gg ((float*)WSP(WS_G))
#define roww ((float*)WSP(WS_ROWW))
#define proj ((bf16*)WSP(WS_PROJ))
#define hid ((bf16*)WSP(WS_PROJ))
#define ymix ((bf16*)WSP(WS_YMIX))
#define c0 ((float*)WSP(WS_C))
#define c1 ((float*)WSP(WS_C + (size_t)T * 1024 * 4))
#define c2 ((float*)WSP(WS_C + (size_t)2 * T * 1024 * 4))
#define c3 ((float*)WSP(WS_C + (size_t)3 * T * 1024 * 4))
    const int BIG = 1 << 30;
    int ph = 0;
#define PHL int lane_ = lane, tid_ = tid, gw_ = gw, bid_ = bid; size_t gt_ = gt; asm volatile("" : "+v"(lane_), "+v"(tid_)); asm volatile("" : "+s"(gw_), "+s"(bid_)); asm volatile("" : "+v"(gt_)); LAS float* scr = (LAS float*)(lds + (gw_ & 7) * 16384);
    if (RUN(ph)) { PHL
        for (int l = 0; l < 2; ++l) {
            convert_matrix(w_in + (size_t)l * D * DIN, DIN, 0, D, NPROJ, norm_mix + l * D, Win + (size_t)l * NPROJ * D, BIG, 0, 0, scr, gw_, NGW, lane_);
            convert_matrix(w_out + (size_t)l * D * D, D, 0, D, D, nullptr, Wout + (size_t)l * D * D, BIG, 0, 0, scr, gw_, NGW, lane_);
            for (size_t i = gt_; i < (size_t)16 * D; i += NGT) { const int j = (int)(i / D), k = (int)(i % D); Wba[(size_t)l * 16 * D + i] = w_in[(size_t)l * D * DIN + (size_t)k * DIN + NPROJ + j] * norm_mix[l * D + k]; }
        }
        convert_matrix(ffn_w_gate, DFF, 0, D, DFF, norm_ffn, Wgu, 128, 256, 0, scr, gw_, NGW, lane_);
        convert_matrix(ffn_w_up, DFF, 0, D, DFF, norm_ffn, Wgu, 128, 256, 128, scr, gw_, NGW, lane_);
        convert_matrix(ffn_w_down, D, 0, DFF, D, nullptr, Wd, BIG, 0, 0, scr, gw_, NGW, lane_);
    }
    SEAM(ph); ++ph;
    int xsel = 0;
#define xcur (xsel ? (const float*)xres : x_in)
    for (int l = 0; l < 2; ++l) {
        if (RUN(ph)) { PHL for (int r = gw_; r < T; r += NGW) rowprep_row(xcur, xb, rstd, Wba + (size_t)l * 16 * D, ba, r, lane_); }
        SEAM(ph); ++ph;
        if (RUN(ph)) { pg8::Gemm g{xb, Win + (size_t)l * NPROJ * D, T, NPROJ, D, 0}; pg8::StaticOrder S; S.init(T, NPROJ, G, bid); pg8::EpiScaleBf16 E{proj, rstd, NPROJ, 0};
            pg8::gemm_phase<pg8::EpiScaleBf16, pg8::StaticOrder, true, true>(lds, g, S, E); }
        SEAM(ph); ++ph;
        if (RUN(ph)) { PHL for (size_t i = gt_; i < (size_t)T * DLRU; i += NGT) lru_conv_elem(proj, conv_lru_w + (size_t)l * 4 * DLRU, conv_lru_b + l * DLRU, c2, i); }
        SEAM(ph); ++ph;
        if (RUN(ph)) { PHL for (size_t i = gt_; i < (size_t)T * DLRU; i += NGT) lru_gate_elem(c2, lru_w_r + (size_t)l * 8 * 128 * 128, lru_b_r + l * DLRU, lru_w_i + (size_t)l * 8 * 128 * 128, lru_b_i + l * DLRU, lru_lambda + l * DLRU, c0, c1, i); }
        SEAM(ph); ++ph;
        if (RUN(ph)) { PHL if ((gw_ & 7) == 0 && bid_ < 32) lru_scan_chan(c0, c1, proj, bid_ * 64 + lane_); }
        SEAM(ph); ++ph;
        if (RUN(ph)) { PHL for (int r = gw_; r < T; r += NGW) lru_norm_row(c0, lru_out_norm + l * DLRU, ymix, r, lane_); }
        SEAM(ph); ++ph;
        if (RUN(ph)) { PHL for (int w = gw_; w < T * NH; w += NGW) dn_prep_item(proj, conv_qkv_w + (size_t)l * 4 * 3 * DDN, ba, dn_a_log + l * NH, dn_dt_bias + l * NH, c0, c1, c2, beta, gg, w, lane_); }
        SEAM(ph); ++ph;
        if (RUN(ph)) { PHL if (bid_ < 16) dn_rec_seq(c0, c1, c2, beta, gg, c3, bid_, (LAS float*)lds, (LAS float*)lds + 256, (LAS float*)lds + 512, tid_); }
        SEAM(ph); ++ph;
        if (RUN(ph)) { PHL for (int w = gw_; w < T * NH; w += NGW) dn_out_item(c3, dn_out_norm + l * HD, proj, ymix, w, lane_); }
        SEAM(ph); ++ph;
        if (RUN(ph)) { pg8::Gemm g{ymix, Wout + (size_t)l * D * D, T, D, D, 0}; pg8::StaticOrder S; S.init(T, D, G, bid); pg8::EpiResidual E{xcur, xres, nullptr, D, 0};
            pg8::gemm_phase<pg8::EpiResidual, pg8::StaticOrder, true, true>(lds, g, S, E); }
        SEAM(ph); ++ph;
        xsel = 1;
        if (RUN(ph)) { PHL for (int r = gw_; r < T; r += NGW) rowprep_row(xcur, xb, rstd, nullptr, nullptr, r, lane_); }
        SEAM(ph); ++ph;
        if (l == 1) { if (RUN(ph)) { PHL for (int r = gw_; r < T; r += NGW) route_row(xcur, rstd, norm_ffn + D, moe_router, roww, r, lane_); } }
        SEAM(ph); ++ph;
        const int ne = l == 0 ? 1 : NEXP, dff = l == 0 ? DFF : DFFE;
        for (int e = 0; e < ne; ++e) {
            if (l == 1) { if (RUN(ph)) { PHL
                convert_matrix(moe_w_gate + (size_t)e * D * DFFE, DFFE, 0, D, DFFE, norm_ffn + D, Mgu, 128, 256, 0, scr, gw_, NGW, lane_);
                convert_matrix(moe_w_up + (size_t)e * D * DFFE, DFFE, 0, D, DFFE, norm_ffn + D, Mgu, 128, 256, 128, scr, gw_, NGW, lane_);
                convert_matrix(moe_w_down + (size_t)e * DFFE * D, D, 0, DFFE, D, nullptr, Md, BIG, 0, 0, scr, gw_, NGW, lane_); } }
            SEAM(ph); ++ph;
            if (RUN(ph)) { pg8::Gemm g{xb, l == 0 ? Wgu : Mgu, T, 2 * dff, D, 0}; pg8::StaticOrder S; S.init(T, 2 * dff, G, bid); pg8::EpiSwiGLU E{hid, rstd, dff, 0};
                pg8::gemm_phase<pg8::EpiSwiGLU, pg8::StaticOrder, true, true>(lds, g, S, E); }
            SEAM(ph); ++ph;
            if (RUN(ph)) { pg8::Gemm g{hid, l == 0 ? Wd : Md, T, D, dff, 0}; pg8::StaticOrder S; S.init(T, D, G, bid); pg8::EpiResidual E{xcur, xres, l == 0 ? nullptr : roww + (size_t)e * T, D, 0};
                pg8::gemm_phase<pg8::EpiResidual, pg8::StaticOrder, true, true>(lds, g, S, E); }
            SEAM(ph); ++ph;
        }
    }
    if (RUN(ph)) { PHL for (int r = gw_; r < T; r += NGW) final_row(xcur, norm_final, xres, r, lane_); }
#undef RUN
#undef SEAM
}

extern "C" void kernel_launch(void* const* d_in, const int* in_sizes, int n_in, void* d_out, int out_size, void* d_ws, size_t ws_size, hipStream_t stream) {
    static int grid = 0;
    if (grid == 0) {
        if (n_in != 25 || ws_size < WS_END) { fprintf(stderr, "kernel_launch: unexpected n_in %d / ws_size %zu (need %zu)\n", n_in, ws_size, (size_t)WS_END); grid = -1; return; }
        int dev = 0, cus = 0, per_cu = 0;
        if (hipGetDevice(&dev) != hipSuccess || hipDeviceGetAttribute(&cus, hipDeviceAttributeMultiprocessorCount, dev) != hipSuccess) { grid = -1; return; }
        if (hipFuncSetAttribute((const void*)mega, hipFuncAttributeMaxDynamicSharedMemorySize, LDS_BYTES) != hipSuccess) { fprintf(stderr, "kernel_launch: hipFuncSetAttribute failed\n"); grid = -1; return; }
        if (hipOccupancyMaxActiveBlocksPerMultiprocessor(&per_cu, (const void*)mega, 512, LDS_BYTES) != hipSuccess || per_cu < 1) { fprintf(stderr, "kernel_launch: occupancy query says %d\n", per_cu); }
        (void)hipGetLastError();
        grid = cus;
    }
    if (grid < 0) return;
    if (hipMemsetAsync((char*)d_ws + WS_CTL, 0, CTL_ZERO_BYTES, stream) != hipSuccess) return;
    Args a{};
    for (int i = 0; i < 25; ++i) a.in[i] = (const float*)d_in[i];
    a.out = (float*)d_out; a.ws = (unsigned char*)d_ws; a.ph_lo = 0; a.ph_hi = 1 << 30;
    hipLaunchKernelGGL(mega, dim3(grid), dim3(512), LDS_BYTES, stream, a);
}
```

```cpp
#include <hip/hip_runtime.h>
#include <cstdio>
#include <cstdint>
namespace pg8 {
#define PG8_LAS __attribute__((address_space(3)))
typedef unsigned short bf16_t;
typedef short bf16x8 __attribute__((ext_vector_type(8)));
typedef float f32x4 __attribute__((ext_vector_type(4)));
typedef unsigned u32x4 __attribute__((ext_vector_type(4)));
constexpr int BM = 256, BK = 64, HALF = 128, HTB = HALF * BK * 2  , STAGE_BYTES = 8 * HTB, NXCD = 8, WGM = 8;

__host__ __device__ __forceinline__ int lds_byte(int r, int c) { const int st = (r >> 4) * 2 + (c >> 5), rr = r & 15, cc = c & 31, ob = rr * 64 + cc * 2; return st * 1024 + (ob ^ (((ob >> 9) & 1) << 5)); }
__host__ __device__ __forceinline__ void stage_rc(int b, int& R, int& C) { const int st = b / 1024, sb = b % 1024, swz = sb ^ (((sb >> 9) & 1) << 5); R = (st >> 1) * 16 + swz / 64; C = (st & 1) * 32 + (swz % 64) / 2; }
__host__ __device__ __forceinline__ int perm32(int rho) { const int n = rho >> 4, i = rho & 15; return 8 * (i >> 2) + 4 * n + (i & 3); }

struct Unit { int pm, pn; };
struct Gemm { const bf16_t* A; const bf16_t* Bt; int M, N, K, pad; };

struct StaticOrder {
    int nM, nN, nwg, G, c;
    __host__ __device__ void init(int M, int N, int G_, int c_) { nM = M / BM; nN = N / BM; nwg = nM * nN; G = G_; c = c_; }
    __host__ __device__ bool next(int i, Unit& u) const {
        const long L = (long)i * G + c; if (L >= nwg) return false;
        int wgid = (int)L; { const int q = nwg / NXCD, r = nwg % NXCD, xcd = wgid % NXCD, off = wgid / NXCD; wgid = (xcd < r ? xcd * (q + 1) : r * (q + 1) + (xcd - r) * q) + off; }
        const int nig = WGM * nN, gid = wgid / nig, fm = gid * WGM, gsz = (nM - fm) < WGM ? (nM - fm) : WGM;
        u.pm = fm + ((wgid % nig) % gsz); u.pn = (wgid % nig) / gsz; return true;
    }
    __device__ __forceinline__ void a_ready(const Unit&) const {}
    __device__ __forceinline__ void done(const Unit&) const {}
};


__device__ __forceinline__ unsigned cvt_pk_bf16(float lo, float hi) { unsigned r; asm volatile("v_cvt_pk_bf16_f32 %0, %1, %2" : "=v"(r) : "v"(lo), "v"(hi)); return r; }
__device__ __forceinline__ float silu_f(float x) { return x / (1.0f + __expf(-x)); }

struct EpiScaleBf16 {
    static constexpr bool PERM = true, AFTER_DRAIN = false;
    bf16_t* O; const float* rs; int ldc; int pad;
    __device__ __forceinline__ void operator()(const f32x4 (&acc)[2][2][4][2], const Unit& u, int wr, int wc, int fr, int fq) const {
        const int row0 = u.pm * BM + wr * 64 + fr, col0 = u.pn * BM + wc * 32 + 8 * fq;
#pragma unroll
        for (int ai = 0; ai < 2; ++ai)
#pragma unroll
            for (int m = 0; m < 4; ++m) { const int r = row0 + ai * HALF + m * 16; const float s = rs[r]; bf16_t* rowp = O + (size_t)r * ldc + col0;
#pragma unroll
                for (int bj = 0; bj < 2; ++bj) { const f32x4 v0 = acc[ai][bj][m][0] * s, v1 = acc[ai][bj][m][1] * s;
                    u32x4 w; w.x = cvt_pk_bf16(v0[0], v0[1]); w.y = cvt_pk_bf16(v0[2], v0[3]); w.z = cvt_pk_bf16(v1[0], v1[1]); w.w = cvt_pk_bf16(v1[2], v1[3]);
                    *(u32x4*)(rowp + bj * HALF) = w; } }
    }
};
struct EpiSwiGLU {
    static constexpr bool PERM = true, AFTER_DRAIN = false;
    bf16_t* O; const float* rs; int ldc; int pad;
    __device__ __forceinline__ void operator()(const f32x4 (&acc)[2][2][4][2], const Unit& u, int wr, int wc, int fr, int fq) const {
        const int row0 = u.pm * BM + wr * 64 + fr, col0 = u.pn * HALF + wc * 32 + 8 * fq;
#pragma unroll
        for (int ai = 0; ai < 2; ++ai)
#pragma unroll
            for (int m = 0; m < 4; ++m) { const int r = row0 + ai * HALF + m * 16; const float s = rs ? rs[r] : 1.0f; bf16_t* rowp = O + (size_t)r * ldc + col0;
                f32x4 h0, h1;
#pragma unroll
                for (int j = 0; j < 4; ++j) { h0[j] = silu_f(acc[ai][0][m][0][j] * s) * (acc[ai][1][m][0][j] * s); h1[j] = silu_f(acc[ai][0][m][1][j] * s) * (acc[ai][1][m][1][j] * s); }
                u32x4 w; w.x = cvt_pk_bf16(h0[0], h0[1]); w.y = cvt_pk_bf16(h0[2], h0[3]); w.z = cvt_pk_bf16(h1[0], h1[1]); w.w = cvt_pk_bf16(h1[2], h1[3]);
                *(u32x4*)rowp = w; }
    }
};
struct EpiResidual {
    static constexpr bool PERM = false, AFTER_DRAIN = false;
    const float* base; float* out; const float* roww; int ldc; int pad;
    __device__ __forceinline__ void operator()(const f32x4 (&acc)[2][2][4][2], const Unit& u, int wr, int wc, int fr, int fq) const {
        const int row0 = u.pm * BM + wr * 64 + fr, col0 = u.pn * BM + wc * 32 + 4 * fq;
#pragma unroll
        for (int ai = 0; ai < 2; ++ai)
#pragma unroll
            for (int m = 0; m < 4; ++m) { const int r = row0 + ai * HALF + m * 16; const float w = roww ? roww[r] : 1.0f; const size_t off = (size_t)r * ldc + col0;
#pragma unroll
                for (int bj = 0; bj < 2; ++bj)
#pragma unroll
                    for (int n = 0; n < 2; ++n) { const f32x4 bs = *(const f32x4*)(base + off + bj * HALF + n * 16); *(f32x4*)(out + off + bj * HALF + n * 16) = bs + acc[ai][bj][m][n] * w; } }
    }
};
template <class Epi, class Sched, bool ALIGN_EPI = false, bool SP2 = false>
__device__ __forceinline__ void gemm_phase(PG8_LAS unsigned char* lds, const Gemm g, const Sched& S, const Epi& E) {
    int tid_o = threadIdx.x; asm volatile("" : "+v"(tid_o));
    const int tid = tid_o, wid = __builtin_amdgcn_readfirstlane(tid >> 6), lane = tid & 63, wr = wid >> 2, wc = wid & 3, fr = lane & 15, fq = lane >> 4;
    const int K = g.K, nt = K / BK;
    unsigned voffA[2], voffB[2];
#pragma unroll
    for (int i = 0; i < 2; ++i) { int R, C; stage_rc(tid * 16 + i * 8192, R, C); const int Rb = Epi::PERM ? ((R & ~31) + perm32(R & 31)) : R;
        voffA[i] = (unsigned)(R * K + C) * 2u; voffB[i] = (unsigned)(Rb * K + C) * 2u; }
    const size_t kstep = (size_t)(BK * 2);
    const size_t hstep = (size_t)HALF * K * 2;
    const size_t tstep = 2 * hstep;
    const unsigned ldsw = (unsigned)wid * 1024u;
    const int aoff = lds_byte(wr * 64 + fr, fq * 8), boff = lds_byte(wc * 32 + fr, fq * 8);
#define PG8_SA(b, h) (((b) * 2 + (h)) * HTB)
#define PG8_SB(b, h) ((4 + (b) * 2 + (h)) * HTB)
#define PG8_STAGE(bufoff, gbase, voff) do { _Pragma("unroll") for (int _i = 0; _i < 2; ++_i) \
        __builtin_amdgcn_global_load_lds((const unsigned*)((const char*)(gbase) + (voff)[_i]), (PG8_LAS unsigned*)(lds + (bufoff) + ldsw + _i * 8192), 16, 0, 0); } while (0)
#define PG8_LDA(dst, b, h) do { _Pragma("unroll") for (int m = 0; m < 4; ++m) _Pragma("unroll") for (int k = 0; k < 2; ++k) dst[m][k] = *(const PG8_LAS bf16x8*)(lds + PG8_SA(b, h) + aoff + m * 2048 + k * 1024); } while (0)
#define PG8_LDB(dst, b, h) do { _Pragma("unroll") for (int n = 0; n < 2; ++n) _Pragma("unroll") for (int k = 0; k < 2; ++k) dst[n][k] = *(const PG8_LAS bf16x8*)(lds + PG8_SB(b, h) + boff + n * 2048 + k * 1024); } while (0)
#define PG8_MMA(ai, bj, At, Bt) do { __builtin_amdgcn_s_setprio(1); _Pragma("unroll") for (int m = 0; m < 4; ++m) _Pragma("unroll") for (int n = 0; n < 2; ++n) _Pragma("unroll") for (int k = 0; k < 2; ++k) \
        acc[ai][bj][m][n] = __builtin_amdgcn_mfma_f32_16x16x32_bf16(Bt[n][k], At[m][k], acc[ai][bj][m][n], 0, 0, 0); __builtin_amdgcn_s_setprio(0); } while (0)
#define PG8_WAIT_V(n) asm volatile("s_waitcnt vmcnt(" #n ")" ::: "memory")
#define PG8_WAIT_L(n) asm volatile("s_waitcnt lgkmcnt(" #n ")" ::: "memory")
#define PG8_BAR __builtin_amdgcn_s_barrier()
#define PG8_SCHED __builtin_amdgcn_sched_barrier(0)
    Unit cur, nxt; int ui = 0;
    if (!S.next(0, cur)) return;
    f32x4 acc[2][2][4][2];
#pragma unroll
    for (int a = 0; a < 2; ++a)
#pragma unroll
        for (int b = 0; b < 2; ++b)
#pragma unroll
            for (int m = 0; m < 4; ++m)
#pragma unroll
                for (int n = 0; n < 2; ++n) acc[a][b][m][n] = (f32x4){0.f, 0.f, 0.f, 0.f};
    bf16x8 At[4][2], B0[2][2], B1[2][2];
    const char* cA = (const char*)g.A + (size_t)cur.pm * tstep; const char* cB = (const char*)g.Bt + (size_t)cur.pn * tstep;
    S.a_ready(cur);
    if constexpr (SP2) {
        PG8_STAGE(PG8_SB(0, 0), cB, voffB); PG8_STAGE(PG8_SB(0, 1), cB + hstep, voffB); PG8_STAGE(PG8_SA(0, 0), cA, voffA); PG8_STAGE(PG8_SA(0, 1), cA + hstep, voffA);
        if (wr == 1) PG8_BAR;
        PG8_WAIT_V(2); PG8_BAR;
        PG8_STAGE(PG8_SB(1, 0), cB + kstep, voffB); PG8_STAGE(PG8_SA(1, 0), cA + kstep, voffA); PG8_STAGE(PG8_SB(1, 1), cB + hstep + kstep, voffB);
        PG8_WAIT_V(6); PG8_BAR;
    } else {
        PG8_STAGE(PG8_SB(0, 0), cB, voffB); PG8_STAGE(PG8_SA(0, 0), cA, voffA); PG8_STAGE(PG8_SB(0, 1), cB + hstep, voffB); PG8_STAGE(PG8_SA(0, 1), cA + hstep, voffA);
        if (wr == 1) PG8_BAR;
        PG8_WAIT_V(4); PG8_BAR;
        PG8_STAGE(PG8_SB(1, 0), cB + kstep, voffB); PG8_STAGE(PG8_SA(1, 0), cA + kstep, voffA); PG8_STAGE(PG8_SB(1, 1), cB + hstep + kstep, voffB);
        PG8_WAIT_V(6); PG8_BAR;
    }
    for (;;) {
        const bool has_next = S.next(ui + 1, nxt);
        const char* nA = has_next ? (const char*)g.A + (size_t)nxt.pm * tstep : cA; const char* nB = has_next ? (const char*)g.Bt + (size_t)nxt.pn * tstep : cB;
        for (int t = 0; t < nt; t += 2) {
            const bool last = (t == nt - 2);
            const char* a1 = cA + (size_t)(t + 1) * kstep;
            const char* a2 = last ? nA : cA + (size_t)(t + 2) * kstep; const char* b2 = last ? nB : cB + (size_t)(t + 2) * kstep;
            const char* a3 = a2 + kstep; const char* b3 = b2 + kstep;
            if (last && has_next) S.a_ready(nxt);
            if constexpr (SP2) {
            PG8_LDB(B0, 0, 0); PG8_LDB(B1, 0, 1); PG8_SCHED; PG8_LDA(At, 0, 0); PG8_STAGE(PG8_SA(1, 1), a1 + hstep, voffA);
            PG8_WAIT_V(8); PG8_WAIT_L(0); PG8_BAR; PG8_MMA(0, 0, At, B0); PG8_MMA(0, 1, At, B1); PG8_BAR; PG8_SCHED;
            PG8_LDA(At, 0, 1); PG8_STAGE(PG8_SB(0, 0), b2, voffB); PG8_STAGE(PG8_SB(0, 1), b2 + hstep, voffB); PG8_STAGE(PG8_SA(0, 0), a2, voffA);
            PG8_WAIT_V(8); PG8_WAIT_L(0); PG8_BAR; PG8_MMA(1, 0, At, B0); PG8_MMA(1, 1, At, B1); PG8_BAR; PG8_SCHED;
            PG8_LDB(B0, 1, 0); PG8_LDB(B1, 1, 1); PG8_SCHED; PG8_LDA(At, 1, 0); PG8_STAGE(PG8_SA(0, 1), a2 + hstep, voffA);
            PG8_WAIT_V(8); PG8_WAIT_L(0); PG8_BAR; PG8_MMA(0, 0, At, B0); PG8_MMA(0, 1, At, B1); PG8_BAR; PG8_SCHED;
            PG8_LDA(At, 1, 1); PG8_STAGE(PG8_SB(1, 0), b3, voffB); PG8_STAGE(PG8_SB(1, 1), b3 + hstep, voffB); PG8_STAGE(PG8_SA(1, 0), a3, voffA);
            PG8_WAIT_V(8); PG8_WAIT_L(0); PG8_BAR; PG8_MMA(1, 0, At, B0); PG8_MMA(1, 1, At, B1); PG8_BAR; PG8_SCHED;
            } else {
            PG8_LDB(B0, 0, 0); PG8_SCHED; PG8_LDA(At, 0, 0); PG8_STAGE(PG8_SA(1, 1), a1 + hstep, voffA);
            PG8_WAIT_L(8); PG8_BAR; PG8_WAIT_L(0); PG8_MMA(0, 0, At, B0); PG8_BAR; PG8_SCHED;
            PG8_LDB(B1, 0, 1); PG8_STAGE(PG8_SB(0, 0), b2, voffB);
            PG8_BAR; PG8_WAIT_L(0); PG8_MMA(0, 1, At, B1); PG8_BAR;
            PG8_LDA(At, 0, 1); PG8_STAGE(PG8_SA(0, 0), a2, voffA);
            PG8_BAR; PG8_WAIT_L(0); PG8_MMA(1, 0, At, B0); PG8_BAR; PG8_SCHED;
            PG8_STAGE(PG8_SB(0, 1), b2 + hstep, voffB);
            PG8_WAIT_V(6); PG8_BAR; PG8_MMA(1, 1, At, B1); PG8_BAR;
            PG8_LDB(B0, 1, 0); PG8_SCHED; PG8_LDA(At, 1, 0); PG8_STAGE(PG8_SA(0, 1), a2 + hstep, voffA);
            PG8_WAIT_L(8); PG8_BAR; PG8_WAIT_L(0); PG8_MMA(0, 0, At, B0); PG8_BAR; PG8_SCHED;
            PG8_LDB(B1, 1, 1); PG8_STAGE(PG8_SB(1, 0), b3, voffB);
            PG8_BAR; PG8_WAIT_L(0); PG8_MMA(0, 1, At, B1); PG8_BAR;
            PG8_LDA(At, 1, 1); PG8_STAGE(PG8_SA(1, 0), a3, voffA);
            PG8_BAR; PG8_WAIT_L(0); PG8_MMA(1, 0, At, B0); PG8_BAR; PG8_SCHED;
            PG8_STAGE(PG8_SB(1, 1), b3 + hstep, voffB);
            PG8_WAIT_V(6); PG8_BAR; PG8_MMA(1, 1, At, B1); PG8_BAR;
            }
        }
        if constexpr (ALIGN_EPI) { if (wr == 0) PG8_BAR; }
        if constexpr (!Epi::AFTER_DRAIN) { E(acc, cur, wr, wc, fr, fq); S.done(cur); }
        if (!has_next) break;
#pragma unroll
        for (int a = 0; a < 2; ++a)
#pragma unroll
            for (int b = 0; b < 2; ++b)
#pragma unroll
                for (int m = 0; m < 4; ++m)
#pragma unroll
                    for (int n = 0; n < 2; ++n) acc[a][b][m][n] = (f32x4){0.f, 0.f, 0.f, 0.f};
        cur = nxt; cA = nA; cB = nB; ++ui;
        if constexpr (ALIGN_EPI) { if (wr == 1) PG8_BAR; }
    }
    PG8_WAIT_V(0);
    if constexpr (!ALIGN_EPI) { if (wr == 0) PG8_BAR; }
    PG8_BAR;
    if constexpr (Epi::AFTER_DRAIN) { E.fused(acc, cur, wr, wc, fr, fq, lds, wid, lane); S.done(cur); }
#undef PG8_SA
#undef PG8_SB
#undef PG8_STAGE
#undef PG8_LDA
#undef PG8_LDB
#undef PG8_MMA
#undef PG8_WAIT_V
#undef PG8_WAIT_L
#undef PG8_BAR
#undef PG8_SCHED
}
}

#define GAS __attribute__((address_space(1)))
#define LAS __attribute__((address_space(3)))
#define XB_TMO      128
#define XB_XCNT(j)  (256  + 64 * (j))
#define XB_XSUB(j)  (1280 + 64 * (j))
#define XB_XGEN(j)  (2304 + 64 * (j))
#define XB_TOP      3328
#define XB_TOPGEN   3392
#define XCD_BAR_WORDS 3456
#define XB_SPIN_CAP (1u << 23)

__device__ __forceinline__ unsigned xb_ld(unsigned* p)              { return __hip_atomic_load(p, __ATOMIC_RELAXED, __HIP_MEMORY_SCOPE_AGENT); }
__device__ __forceinline__ unsigned xb_add(unsigned* p, unsigned v) { return __hip_atomic_fetch_add(p, v, __ATOMIC_RELAXED, __HIP_MEMORY_SCOPE_AGENT); }
__device__ __forceinline__ unsigned xb_xcc_id() { return (unsigned)__builtin_amdgcn_s_getreg((3 << 11) | 20) & 0xFu; }
#define XB_SPIN(cond, bar) do { unsigned _sp = 0; while (cond) { __builtin_amdgcn_s_sleep(1); \
    if ((++_sp & 255u) == 0u) { if (xb_ld(&(bar)[XB_TMO])) break; if (_sp > XB_SPIN_CAP) { atomicAdd(&(bar)[XB_TMO], 1u); break; } } } } while (0)

struct XcdBarrier {
    unsigned* bar; unsigned x;
    volatile LAS unsigned* st;
};

__device__ __forceinline__ XcdBarrier xcd_barrier_post(unsigned* bar, volatile LAS unsigned* st) {
    XcdBarrier b; b.bar = bar; b.x = xb_xcc_id(); b.st = st;
    if (threadIdx.x == 0) (void)xb_add(&bar[XB_XCNT(b.x)], 1u);
    return b;
}
__device__ __forceinline__ void xcd_barrier_complete(unsigned* bar, unsigned x, unsigned& nloc, unsigned& nx) {
    const unsigned G = gridDim.x * gridDim.y * gridDim.z;
    unsigned sum, cnt, mine, sp = 0u;
    for (;;) {
        sum = 0u; cnt = 0u; mine = 0u;
#pragma unroll
        for (unsigned j = 0; j < 16; ++j) { const unsigned c = xb_ld(&bar[XB_XCNT(j)]); sum += c; cnt += (c > 0u) ? 1u : 0u; mine = (j == x) ? c : mine; }
        if (sum == G) break;
        __builtin_amdgcn_s_sleep(1);
        if ((++sp & 255u) == 0u) { if (xb_ld(&bar[XB_TMO])) break; if (sp > XB_SPIN_CAP) { atomicAdd(&bar[XB_TMO], 1u); break; } }
    }
    nloc = mine > 0u ? mine : 1u; nx = cnt > 0u ? cnt : 1u;
}

__device__ __forceinline__ void xcd_barrier(const XcdBarrier& b) {
    asm volatile("s_waitcnt vmcnt(0)" ::: "memory");
    __syncthreads();
    if (threadIdx.x == 0) {
        unsigned* bar = b.bar; asm volatile("" : "+s"(bar));
        __builtin_amdgcn_s_waitcnt(0);
        unsigned nloc = b.st[0], nx = b.st[1];
        if (nloc == 0u) { xcd_barrier_complete(bar, b.x, nloc, nx); b.st[0] = nloc; b.st[1] = nx; }
        const unsigned old = xb_add(&bar[XB_XSUB(b.x)], 1u);
        const unsigned gen = old / nloc;
        if (old + 1u == (gen + 1u) * nloc) {
            __builtin_amdgcn_fence(__ATOMIC_RELEASE, "agent");
            asm volatile("s_waitcnt vmcnt(0)" ::: "memory");
            const unsigned og = xb_add(&bar[XB_TOP], 1u);
            const unsigned tg = og / nx;
            if (og + 1u == (tg + 1u) * nx) xb_add(&bar[XB_TOPGEN], 1u);
            else XB_SPIN(xb_ld(&bar[XB_TOPGEN]) == tg, bar);
            __builtin_amdgcn_fence(__ATOMIC_ACQUIRE, "agent");
            xb_add(&bar[XB_XGEN(b.x)], 1u);
            asm volatile("s_waitcnt vmcnt(0)" ::: "memory");
        } else {
            XB_SPIN(xb_ld(&bar[XB_XGEN(b.x)]) == gen, bar);
            __builtin_amdgcn_fence(__ATOMIC_ACQUIRE, "agent");
            asm volatile("s_waitcnt vmcnt(0)" ::: "memory");
        }
    }
    __syncthreads();
}

constexpr int T = 16384, SEQ = 8192, D = 2048, DLRU = 1024, DDN = 1024, NH = 8, HD = 128, NPROJ = 6144, DIN = 6160;
constexpr int DFF = 6144, NEXP = 8, DFFE = 3072;
constexpr float EPS = 1e-6f;
typedef unsigned short bf16;
typedef float f32x4 __attribute__((ext_vector_type(4)));
typedef unsigned u32x4 __attribute__((ext_vector_type(4)));
typedef unsigned u32x2 __attribute__((ext_vector_type(2)));
#define LDS_WAIT() asm volatile("s_waitcnt lgkmcnt(0)" ::: "memory")

__device__ __forceinline__ float bf2f(bf16 b) { return __uint_as_float(((unsigned)b) << 16); }
__device__ __forceinline__ unsigned f2bf(float f) { unsigned u = __float_as_uint(f); return (u + 0x7fffu + ((u >> 16) & 1u)) >> 16; }
__device__ __forceinline__ unsigned pk2(float lo, float hi) { return f2bf(lo) | (f2bf(hi) << 16); }
__device__ __forceinline__ float wave_sum(float v) {
#pragma unroll
    for (int o = 1; o < 64; o <<= 1) v += __shfl_xor(v, o);
    return v;
}
using pg8::silu_f;
__device__ __forceinline__ float sigmoid_f(float x) { return 1.0f / (1.0f + __expf(-x)); }
__device__ __forceinline__ float softplus_f(float x) { return fmaxf(x, 0.0f) + log1pf(__expf(-fabsf(x))); }
__device__ __forceinline__ float gelu_tanh_f(float x) { const float u = 0.7978845608028654f * (x + 0.044715f * x * x * x); return 0.5f * x * (1.0f + tanhf(u)); }

constexpr size_t MiB = 1u << 20;
constexpr size_t al(size_t x) { return (x + MiB - 1) / MiB * MiB; }
constexpr size_t WS_CTL = 0, CTL_ZERO_BYTES = 1 * MiB;
constexpr int CW_BAR = 4096;
constexpr size_t WS_WIN = 1 * MiB;
constexpr size_t WS_WBA = WS_WIN + al((size_t)2 * NPROJ * D * 2);
constexpr size_t WS_WOUT = WS_WBA + al((size_t)2 * 16 * D * 4);
constexpr size_t WS_WGU = WS_WOUT + al((size_t)2 * D * D * 2);
constexpr size_t WS_WD = WS_WGU + al((size_t)2 * DFF * D * 2);
constexpr size_t WS_MGU = WS_WD + al((size_t)D * DFF * 2);
constexpr size_t WS_MD = WS_MGU + al((size_t)2 * DFFE * D * 2);
constexpr size_t WS_XB = WS_MD + al((size_t)D * DFFE * 2);
constexpr size_t WS_RSTD = WS_XB + al((size_t)T * D * 2);
constexpr size_t WS_BA = WS_RSTD + al((size_t)T * 4);
constexpr size_t WS_BETA = WS_BA + al((size_t)T * 16 * 4);
constexpr size_t WS_G = WS_BETA + al((size_t)T * 8 * 4);
constexpr size_t WS_ROWW = WS_G + al((size_t)T * 8 * 4);
constexpr size_t WS_PROJ = WS_ROWW + al((size_t)8 * T * 4);
constexpr size_t WS_YMIX = WS_PROJ + al((size_t)T * NPROJ * 2);
constexpr size_t WS_C = WS_YMIX + al((size_t)T * D * 2);
constexpr size_t WS_END = WS_C + al((size_t)4 * T * 1024 * 4);
constexpr int RING_BYTES = 131072, LDSCTL_OFF = RING_BYTES, MISC_OFF = LDSCTL_OFF + 320, LDS_BYTES = 147456;

__device__ __forceinline__ void transpose_item(const float* W, int ldw, int col_off, int K, int nblk, const float* gain, bf16* WT, int blk, int blk_stride, int row_off, LAS float* scr, int item, int lane) {
    const int kb = item / nblk, nb = item % nblk, k0 = 64 * kb, n0 = 32 * nb;
#pragma unroll 8
    for (int i = 0; i < 32; ++i) { const int kk = 2 * i + (lane >> 5); const float g = gain ? gain[k0 + kk] : 1.0f; scr[kk * 33 + (lane & 31)] = W[(size_t)(k0 + kk) * ldw + col_off + n0 + (lane & 31)] * g; }
    LDS_WAIT(); asm volatile("" ::: "memory");
    const int c = lane & 7;
#pragma unroll
    for (int j = 0; j < 4; ++j) { const int nl = (lane >> 3) + 8 * j, n = n0 + nl; const LAS float* s = scr + (8 * c) * 33 + nl;
        u32x4 o; o.x = pk2(s[0 * 33], s[1 * 33]); o.y = pk2(s[2 * 33], s[3 * 33]); o.z = pk2(s[4 * 33], s[5 * 33]); o.w = pk2(s[6 * 33], s[7 * 33]);
        const int drow = (n / blk) * blk_stride + (n % blk) + row_off;
        *(u32x4*)(WT + (size_t)drow * K + k0 + 8 * c) = o; }
    LDS_WAIT(); asm volatile("" ::: "memory");
}
__device__ __forceinline__ void convert_matrix(const float* W, int ldw, int col_off, int K, int N, const float* gain, bf16* WT, int blk, int blk_stride, int row_off, LAS float* scr, int gw, int NGW, int lane) {
    const int nblk = N / 32, nitems = (K / 64) * nblk;
    for (int it = gw; it < nitems; it += NGW) transpose_item(W, ldw, col_off, K, nblk, gain, WT, blk, blk_stride, row_off, scr, it, lane);
}
__device__ __forceinline__ void rowprep_row(const float* x, bf16* xb, float* rstd, const float* Wba, float* ba, int row, int lane) {
    const f32x4* xr = (const f32x4*)(x + (size_t)row * D) + lane;
    f32x4 v[8]; float ss = 0.f;
#pragma unroll
    for (int j = 0; j < 8; ++j) { v[j] = xr[64 * j]; ss += (v[j][0] * v[j][0] + v[j][1] * v[j][1]) + (v[j][2] * v[j][2] + v[j][3] * v[j][3]); }
    ss = wave_sum(ss);
    const float rs = 1.0f / sqrtf(ss * (1.0f / D) + EPS);
    u32x2* o = (u32x2*)(xb + (size_t)row * D) + lane;
#pragma unroll
    for (int j = 0; j < 8; ++j) { u32x2 w; w.x = pk2(v[j][0], v[j][1]); w.y = pk2(v[j][2], v[j][3]); o[64 * j] = w; }
    if (lane == 0) rstd[row] = rs;
    if (Wba) {
        for (int c = 0; c < 16; ++c) { const f32x4* wr = (const f32x4*)(Wba + (size_t)c * D) + lane; float a = 0.f;
#pragma unroll
            for (int j = 0; j < 8; ++j) { const f32x4 w = wr[64 * j]; a += (v[j][0] * w[0] + v[j][1] * w[1]) + (v[j][2] * w[2] + v[j][3] * w[3]); }
            a = wave_sum(a); if (lane == 0) ba[(size_t)row * 16 + c] = a * rs; }
    }
}
__device__ __forceinline__ void lru_conv_elem(const bf16* proj, const float* cw, const float* cb, float* xc, size_t idx) {
    const int t = (int)(idx / DLRU), ch = (int)(idx % DLRU), s = t % SEQ;
    float a = cb[ch];
#pragma unroll
    for (int k = 0; k < 4; ++k) { const int sp = s - 3 + k; if (sp >= 0) a += cw[k * DLRU + ch] * bf2f(proj[(size_t)(t - 3 + k) * NPROJ + ch]); }
    xc[idx] = a;
}
__device__ __forceinline__ void lru_gate_elem(const float* xc, const float* w_r, const float* b_r, const float* w_i, const float* b_i, const float* lam, float* av, float* bv, size_t idx) {
    const int t = (int)(idx / DLRU), ch = (int)(idx % DLRU), n = ch >> 7, d = ch & 127;
    float ar = b_r[ch], ai = b_i[ch];
    const float* xr = xc + (size_t)t * DLRU + n * 128; const float* wr = w_r + (size_t)n * 128 * 128 + d; const float* wi = w_i + (size_t)n * 128 * 128 + d;
    for (int c = 0; c < 128; ++c) { const float xv = xr[c]; ar += xv * wr[c * 128]; ai += xv * wi[c * 128]; }
    const float r = sigmoid_f(ar), ig = sigmoid_f(ai);
    const float log_a = -8.0f * r * softplus_f(-lam[ch]);
    const float a = expf(log_a), mult = sqrtf(-expm1f(2.0f * log_a));
    av[idx] = a; bv[idx] = mult * (ig * xc[idx]);
}
__device__ __forceinline__ void lru_scan_chan(float* av, const float* bv, const bf16* proj, int idx) {
    const int b = idx / DLRU, ch = idx % DLRU;
    float h = 0.f;
    for (int s0 = 0; s0 < SEQ; s0 += 8) {
        float a8[8], b8[8], g8[8];
#pragma unroll
        for (int j = 0; j < 8; ++j) { const size_t t = (size_t)b * SEQ + s0 + j; a8[j] = av[t * DLRU + ch]; b8[j] = bv[t * DLRU + ch]; g8[j] = bf2f(proj[t * NPROJ + DLRU + ch]); }
#pragma unroll
        for (int j = 0; j < 8; ++j) { const size_t t = (size_t)b * SEQ + s0 + j; h = a8[j] * h + b8[j]; av[t * DLRU + ch] = h * gelu_tanh_f(g8[j]); }
    }
}
__device__ __forceinline__ void lru_norm_row(const float* y, const float* gain, bf16* ymix, int row, int lane) {
    const f32x4* yr = (const f32x4*)(y + (size_t)row * DLRU) + lane; const f32x4* gr = (const f32x4*)gain + lane;
    f32x4 v[4]; float ss = 0.f;
#pragma unroll
    for (int j = 0; j < 4; ++j) { v[j] = yr[64 * j]; ss += (v[j][0] * v[j][0] + v[j][1] * v[j][1]) + (v[j][2] * v[j][2] + v[j][3] * v[j][3]); }
    ss = wave_sum(ss); const float rs = 1.0f / sqrtf(ss * (1.0f / DLRU) + EPS);
    u32x2* o = (u32x2*)(ymix + (size_t)row * D) + lane;
#pragma unroll
    for (int j = 0; j < 4; ++j) { const f32x4 g = gr[64 * j]; u32x2 w; w.x = pk2(v[j][0] * rs * g[0], v[j][1] * rs * g[1]); w.y = pk2(v[j][2] * rs * g[2], v[j][3] * rs * g[3]); o[64 * j] = w; }
}
__device__ __forceinline__ void dn_prep_item(const bf16* proj, const float* cw, const float* ba, const float* a_log, const float* dt_bias, float* qn, float* kn, float* vn, float* beta, float* gg, int w, int lane) {
    const int t = w >> 3, h = w & 7, s = t % SEQ;
    float val[3][2];
#pragma unroll
    for (int p = 0; p < 3; ++p)
#pragma unroll
        for (int e = 0; e < 2; ++e) { const int d = lane * 2 + e, c = p * DDN + h * HD + d; float a = 0.f;
#pragma unroll
            for (int k = 0; k < 4; ++k) { const int sp = s - 3 + k; if (sp >= 0) a += cw[k * 3 * DDN + c] * bf2f(proj[(size_t)(t - 3 + k) * NPROJ + 2048 + c]); }
            val[p][e] = silu_f(a); }
    const float sq = wave_sum(val[0][0] * val[0][0] + val[0][1] * val[0][1]), sk = wave_sum(val[1][0] * val[1][0] + val[1][1] * val[1][1]);
    const float rq = (1.0f / sqrtf(sq + EPS)) * 0.08838834764831845f, rk = 1.0f / sqrtf(sk + EPS);
    const size_t o = ((size_t)t * NH + h) * HD + lane * 2;
    qn[o] = val[0][0] * rq; qn[o + 1] = val[0][1] * rq; kn[o] = val[1][0] * rk; kn[o + 1] = val[1][1] * rk; vn[o] = val[2][0]; vn[o + 1] = val[2][1];
    if (lane == 0) { beta[t * NH + h] = sigmoid_f(ba[(size_t)t * 16 + h]); gg[t * NH + h] = -__expf(a_log[h]) * softplus_f(ba[(size_t)t * 16 + 8 + h] + dt_bias[h]); }
}
__device__ __forceinline__ void dn_rec_seq(const float* qn, const float* kn, const float* vn, const float* beta, const float* gg, float* o, int bh, LAS float* sk, LAS float* sq, LAS float* st, int tid) {
    const int b = bh >> 3, h = bh & 7, j = tid & 127; const bool act = tid < 128;
    if (act) for (int k = 0; k < 128; ++k) st[k * 128 + j] = 0.f;
    const size_t base = ((size_t)(b * SEQ) * NH + h) * HD;
    float nk = kn[base + j], nq = qn[base + j], nv = vn[base + j], nb = beta[(b * SEQ) * NH + h], ng = gg[(b * SEQ) * NH + h];
    for (int s = 0; s < SEQ; ++s) {
        const int buf = (s & 1) * 128;
        if (act) { sk[buf + j] = nk; sq[buf + j] = nq; }
        const float vj = nv, be = nb, ge = __expf(ng);
        __syncthreads();
        if (act) {
            if (s + 1 < SEQ) { const size_t nb_ = ((size_t)(b * SEQ + s + 1) * NH + h) * HD; nk = kn[nb_ + j]; nq = qn[nb_ + j]; nv = vn[nb_ + j]; nb = beta[(b * SEQ + s + 1) * NH + h]; ng = gg[(b * SEQ + s + 1) * NH + h]; }
            float ks = 0.f;
#pragma unroll 8
            for (int k = 0; k < 128; ++k) ks += sk[buf + k] * st[k * 128 + j];
            const float vnew = be * (vj - ge * ks);
            float oo = 0.f;
#pragma unroll 8
            for (int k = 0; k < 128; ++k) { const float sv = ge * st[k * 128 + j] + sk[buf + k] * vnew; st[k * 128 + j] = sv; oo += sq[buf + k] * sv; }
            o[((size_t)(b * SEQ + s) * NH + h) * HD + j] = oo;
        }
    }
    __syncthreads();
}
typedef short bf16x8 __attribute__((ext_vector_type(8)));
__device__ __forceinline__ f32x4 mfma16(bf16x8 a, bf16x8 b, f32x4 c) { return __builtin_amdgcn_mfma_f32_16x16x32_bf16(a, b, c, 0, 0, 0); }
__device__ __forceinline__ float bflo(unsigned x) { return __uint_as_float(x << 16); }
__device__ __forceinline__ float bfhi(unsigned x) { return __uint_as_float(x & 0xffff0000u); }
constexpr int DA_G = 0, DA_KN = 1024, DA_QN = DA_KN + 17408, DA_VBT = DA_QN + 17408, DA_KBET = DA_VBT + 18432, DA_KDT = DA_KBET + 18432, DA_L = DA_KDT + 18432, DA_TB = DA_L + 16384, DA_QK = DA_TB + 9216, DA_END = DA_QK + 9216;
static_assert(DA_END <= RING_BYTES, "DN-A LDS map");
__device__ __forceinline__ void dna_unit(const bf16* proj, const float* cw, const float* ba, const float* a_log, const float* dt_bias,
                                         bf16* Wf, bf16* Qf, bf16* KdTf, bf16* QKf, bf16* Uf, float* glb, int uid, LAS unsigned char* lds, int tid, int lane, int wave) {
    const int h = uid & 7, n = (uid >> 3) & 127, b = uid >> 10, t0 = b * SEQ + n * 64;
    asm volatile("" : "+v"(lds));
    LAS float* Gs = (LAS float*)(lds + DA_G);
    const int fr = lane & 15, fq = lane >> 4;
    if (wave == 0) {
        const size_t t = (size_t)(t0 + lane);
        const float be = sigmoid_f(ba[t * 16 + h]); float Gc = -__expf(a_log[h]) * softplus_f(ba[t * 16 + 8 + h] + dt_bias[h]);
#pragma unroll
        for (int off = 1; off < 64; off <<= 1) { const float tmp = __shfl_up(Gc, off); if (lane >= off) Gc += tmp; }
        const float GL = __shfl(Gc, 63);
        Gs[lane] = Gc; Gs[64 + lane] = be; Gs[128 + lane] = __expf(Gc); Gs[192 + lane] = __expf(GL - Gc);
        if (lane == 63) glb[uid] = __expf(Gc);
    }
    __syncthreads();
    {
        const int r = tid >> 3, cg = tid & 7;
        const float be = Gs[64 + r], eg = Gs[128 + r], egl = Gs[192 + r];
        float val[3][16];
#pragma unroll
        for (int p = 0; p < 3; ++p) {
            const int ccol = p * DDN + h * HD + cg * 16;
            float acc[16];
#pragma unroll
            for (int i = 0; i < 16; ++i) acc[i] = 0.f;
#pragma unroll
            for (int k = 0; k < 4; ++k) { const int row = r - 3 + k;
                if (n * 64 + row >= 0) {
                    const bf16* src = proj + (size_t)(t0 + row) * NPROJ + 2048 + ccol;
                    const u32x4 x0 = *(const u32x4*)src, x1 = *(const u32x4*)(src + 8);
                    const float* wp = cw + k * 3 * DDN + ccol;
                    const f32x4 w0 = *(const f32x4*)wp, w1 = *(const f32x4*)(wp + 4), w2 = *(const f32x4*)(wp + 8), w3 = *(const f32x4*)(wp + 12);
                    acc[0] += w0[0] * bflo(x0.x); acc[1] += w0[1] * bfhi(x0.x); acc[2] += w0[2] * bflo(x0.y); acc[3] += w0[3] * bfhi(x0.y);
                    acc[4] += w1[0] * bflo(x0.z); acc[5] += w1[1] * bfhi(x0.z); acc[6] += w1[2] * bflo(x0.w); acc[7] += w1[3] * bfhi(x0.w);
                    acc[8] += w2[0] * bflo(x1.x); acc[9] += w2[1] * bfhi(x1.x); acc[10] += w2[2] * bflo(x1.y); acc[11] += w2[3] * bfhi(x1.y);
                    acc[12] += w3[0] * bflo(x1.z); acc[13] += w3[1] * bfhi(x1.z); acc[14] += w3[2] * bflo(x1.w); acc[15] += w3[3] * bfhi(x1.w);
                } }
#pragma unroll
            for (int i = 0; i < 16; ++i) val[p][i] = silu_f(acc[i]);
        }
        float sq = 0.f, sk = 0.f;
#pragma unroll
        for (int i = 0; i < 16; ++i) { sq += val[0][i] * val[0][i]; sk += val[1][i] * val[1][i]; }
        sq += __shfl_xor(sq, 1); sq += __shfl_xor(sq, 2); sq += __shfl_xor(sq, 4);
        sk += __shfl_xor(sk, 1); sk += __shfl_xor(sk, 2); sk += __shfl_xor(sk, 4);
        const float rq = (1.0f / sqrtf(sq + EPS)) * 0.08838834764831845f, rk = 1.0f / sqrtf(sk + EPS);
#pragma unroll
        for (int i = 0; i < 16; ++i) { val[0][i] *= rq; val[1][i] *= rk; }
        u32x4 o0, o1;
        o0.x = pk2(val[1][0], val[1][1]); o0.y = pk2(val[1][2], val[1][3]); o0.z = pk2(val[1][4], val[1][5]); o0.w = pk2(val[1][6], val[1][7]);
        o1.x = pk2(val[1][8], val[1][9]); o1.y = pk2(val[1][10], val[1][11]); o1.z = pk2(val[1][12], val[1][13]); o1.w = pk2(val[1][14], val[1][15]);
        *(LAS u32x4*)(lds + DA_KN + r * 272 + cg * 32) = o0; *(LAS u32x4*)(lds + DA_KN + r * 272 + cg * 32 + 16) = o1;
        o0.x = pk2(val[0][0], val[0][1]); o0.y = pk2(val[0][2], val[0][3]); o0.z = pk2(val[0][4], val[0][5]); o0.w = pk2(val[0][6], val[0][7]);
        o1.x = pk2(val[0][8], val[0][9]); o1.y = pk2(val[0][10], val[0][11]); o1.z = pk2(val[0][12], val[0][13]); o1.w = pk2(val[0][14], val[0][15]);
        *(LAS u32x4*)(lds + DA_QN + r * 272 + cg * 32) = o0; *(LAS u32x4*)(lds + DA_QN + r * 272 + cg * 32 + 16) = o1;
#pragma unroll
        for (int i = 0; i < 16; ++i) { const int f = cg * 16 + i;
            *(LAS unsigned short*)(lds + DA_VBT + f * 144 + r * 2) = (unsigned short)f2bf(val[2][i] * be);
            *(LAS unsigned short*)(lds + DA_KBET + f * 144 + r * 2) = (unsigned short)f2bf(val[1][i] * (be * eg));
            *(LAS unsigned short*)(lds + DA_KDT + f * 144 + r * 2) = (unsigned short)f2bf(val[1][i] * egl); }
    }
    __syncthreads();
    {
        const int p = wave >> 2, ti = wave & 3;
        const int abase = p == 0 ? DA_KN : DA_QN;
        bf16x8 af[4];
#pragma unroll
        for (int ks = 0; ks < 4; ++ks) af[ks] = *(const LAS bf16x8*)(lds + abase + (ti * 16 + fr) * 272 + (ks * 32 + fq * 8) * 2);
        for (int tj = 0; tj < 4; ++tj) {
            f32x4 acc = {0.f, 0.f, 0.f, 0.f};
            if (tj <= ti) {
#pragma unroll
                for (int ks = 0; ks < 4; ++ks) { const bf16x8 bb = *(const LAS bf16x8*)(lds + DA_KN + (tj * 16 + fr) * 272 + (ks * 32 + fq * 8) * 2); acc = mfma16(af[ks], bb, acc); }
            }
            const int j = tj * 16 + fr; const float Gj = Gs[j];
#pragma unroll
            for (int r = 0; r < 4; ++r) { const int i = ti * 16 + fq * 4 + r; float v = 0.f;
                if (p == 0) { if (i > j) v = Gs[64 + i] * acc[r] * __expf(Gs[i] - Gj); *(LAS float*)(lds + DA_L + (i * 64 + j) * 4) = v; }
                else { if (i >= j) v = acc[r] * __expf(Gs[i] - Gj); *(LAS unsigned short*)(lds + DA_QK + i * 144 + j * 2) = (unsigned short)f2bf(v); } }
        }
    }
    __syncthreads();
    if (wave == 0) {
        float Tc[64]; int lc = lane; asm volatile("" : "+v"(lc)); const float fl = (float)lc;
#pragma unroll
        for (int i = 0; i < 64; ++i) {
            float a = fmaxf(0.f, 1.f - fabsf(fl - (float)i));
            const LAS float* Lr = (const LAS float*)(lds + DA_L) + i * 64;
#pragma unroll
            for (int j = 0; j < i; ++j) a -= Lr[j] * Tc[j];
            Tc[i] = a;
        }
#pragma unroll
        for (int i = 0; i < 64; ++i) *(LAS unsigned short*)(lds + DA_TB + i * 144 + lc * 2) = (unsigned short)f2bf(Tc[i]);
    } else {
        for (int fi = wave - 1; fi < 40; fi += 7) {
            if (fi < 8) { const int mt = fi >> 1, ks = fi & 1;
                const u32x4 v = *(const LAS u32x4*)(lds + DA_QK + (mt * 16 + fr) * 144 + (ks * 32 + fq * 8) * 2);
                *(u32x4*)(QKf + (((size_t)uid * 4 + mt) * 2 + ks) * 512 + lane * 8) = v; }
            else if (fi < 24) { const int f2 = fi - 8, mt = f2 >> 2, ks = f2 & 3; const float eg = Gs[128 + mt * 16 + fr];
                const u32x4 v = *(const LAS u32x4*)(lds + DA_QN + (mt * 16 + fr) * 272 + (ks * 32 + fq * 8) * 2); u32x4 o;
                o.x = pk2(bflo(v.x) * eg, bfhi(v.x) * eg); o.y = pk2(bflo(v.y) * eg, bfhi(v.y) * eg); o.z = pk2(bflo(v.z) * eg, bfhi(v.z) * eg); o.w = pk2(bflo(v.w) * eg, bfhi(v.w) * eg);
                *(u32x4*)(Qf + (((size_t)uid * 4 + mt) * 4 + ks) * 512 + lane * 8) = o; }
            else { const int f2 = fi - 24, ft = f2 >> 1, ks = f2 & 1;
                const u32x4 v = *(const LAS u32x4*)(lds + DA_KDT + (ft * 16 + fr) * 144 + (ks * 32 + fq * 8) * 2);
                *(u32x4*)(KdTf + (((size_t)uid * 8 + ft) * 2 + ks) * 512 + lane * 8) = v; }
        }
    }
    __syncthreads();
    {
        bf16x8 ta[4][2];
#pragma unroll
        for (int mt = 0; mt < 4; ++mt)
#pragma unroll
            for (int ks = 0; ks < 2; ++ks) ta[mt][ks] = *(const LAS bf16x8*)(lds + DA_TB + (mt * 16 + fr) * 144 + (ks * 32 + fq * 8) * 2);
#pragma unroll
        for (int c2 = 0; c2 < 2; ++c2) { const int ct = wave * 2 + c2, img = ct < 8 ? DA_VBT : DA_KBET, cr = (ct & 7) * 16 + fr;
            bf16x8 bb[2];
#pragma unroll
            for (int ks = 0; ks < 2; ++ks) bb[ks] = *(const LAS bf16x8*)(lds + img + cr * 144 + (ks * 32 + fq * 8) * 2);
#pragma unroll
            for (int mt = 0; mt < 4; ++mt) { f32x4 acc = {0.f, 0.f, 0.f, 0.f};
#pragma unroll
                for (int ks = 0; ks < 2; ++ks) acc = mfma16(ta[mt][ks], bb[ks], acc);
                if (ct < 8) { u32x2 o; o.x = pk2(acc[0], acc[1]); o.y = pk2(acc[2], acc[3]); *(u32x2*)(Uf + ((((size_t)uid * 8 + ct) * 4 + mt) * 64 + lane) * 4) = o; }
                else { const int f = (ct - 8) * 16 + fr;
#pragma unroll
                    for (int r = 0; r < 4; ++r) *(LAS unsigned short*)(lds + DA_KN + (mt * 16 + fq * 4 + r) * 272 + f * 2) = (unsigned short)f2bf(acc[r]); } }
        }
    }
    __syncthreads();
#pragma unroll
    for (int q2 = 0; q2 < 2; ++q2) { const int fi = wave * 2 + q2, mt = fi >> 2, ks = fi & 3;
        const u32x4 v = *(const LAS u32x4*)(lds + DA_KN + (mt * 16 + fr) * 272 + (ks * 32 + fq * 8) * 2);
        *(u32x4*)(Wf + (((size_t)uid * 4 + mt) * 4 + ks) * 512 + lane * 8) = v; }
    __syncthreads();
}
struct DnbFrag { bf16x8 a1[4]; bf16x8 a2[2]; bf16x8 kd[2]; u32x2 u; float gl; };
__device__ __forceinline__ DnbFrag dnb_load(const bf16* A1, const bf16* QKf, const bf16* KdTf, const bf16* Uf, const float* glb, int uid, int ds, int wave, int lane) {
    DnbFrag f; const int mt = wave & 3;
#pragma unroll
    for (int ks = 0; ks < 4; ++ks) f.a1[ks] = *(const bf16x8*)(A1 + (((size_t)uid * 4 + mt) * 4 + ks) * 512 + lane * 8);
#pragma unroll
    for (int ks = 0; ks < 2; ++ks) f.kd[ks] = *(const bf16x8*)(KdTf + (((size_t)uid * 8 + wave) * 2 + ks) * 512 + lane * 8);
    if (wave >= 4) {
#pragma unroll
        for (int ks = 0; ks < 2; ++ks) f.a2[ks] = *(const bf16x8*)(QKf + (((size_t)uid * 4 + mt) * 2 + ks) * 512 + lane * 8);
        f.u = (u32x2){0u, 0u};
    } else {
        f.a2[0] = f.a1[0]; f.a2[1] = f.a1[1];
        f.u = *(const u32x2*)(Uf + ((((size_t)uid * 8 + ds) * 4 + mt) * 64 + lane) * 4);
    }
    f.gl = glb[uid];
    return f;
}
__device__ __forceinline__ void dnb_run(const bf16* Wf, const bf16* Qf, const bf16* KdTf, const bf16* QKf, const bf16* Uf, const float* glb, float* o, int bh, int ds, LAS unsigned char* lds, int tid, int lane, int wave) {
    const int b = bh >> 3, h = bh & 7, fr = lane & 15, fq = lane >> 4, mt = wave & 3;
    asm volatile("" : "+v"(lds));
    LAS unsigned char* ST = lds; LAS unsigned char* VNT = lds + 4608;
    for (int i = tid; i < 4608 / 4; i += 512) ((LAS unsigned*)ST)[i] = 0u;
    f32x4 accS = {0.f, 0.f, 0.f, 0.f};
    const bf16* A1 = wave < 4 ? Wf : Qf;
    DnbFrag nx = dnb_load(A1, QKf, KdTf, Uf, glb, (b * 128 + 0) * 8 + h, ds, wave, lane);
    __syncthreads();
    for (int n = 0; n < 128; ++n) {
        const DnbFrag cu = nx;
        if (n + 1 < 128) nx = dnb_load(A1, QKf, KdTf, Uf, glb, (b * 128 + n + 1) * 8 + h, ds, wave, lane);
        f32x4 acc = {0.f, 0.f, 0.f, 0.f};
#pragma unroll
        for (int ks = 0; ks < 4; ++ks) { const bf16x8 sb = *(const LAS bf16x8*)(ST + fr * 272 + (ks * 32 + fq * 8) * 2); acc = mfma16(cu.a1[ks], sb, acc); }
        if (wave < 4) {
            const float v0 = bflo(cu.u.x) - acc[0], v1 = bfhi(cu.u.x) - acc[1], v2 = bflo(cu.u.y) - acc[2], v3 = bfhi(cu.u.y) - acc[3];
            u32x2 w; w.x = pk2(v0, v1); w.y = pk2(v2, v3);
            *(LAS u32x2*)(VNT + fr * 144 + (mt * 16 + fq * 4) * 2) = w;
        }
        __syncthreads();
        bf16x8 vb[2];
#pragma unroll
        for (int ks = 0; ks < 2; ++ks) vb[ks] = *(const LAS bf16x8*)(VNT + fr * 144 + (ks * 32 + fq * 8) * 2);
        if (wave >= 4) {
#pragma unroll
            for (int ks = 0; ks < 2; ++ks) acc = mfma16(cu.a2[ks], vb[ks], acc);
            const size_t ob = ((size_t)(b * SEQ + n * 64 + mt * 16 + fq * 4) * NH + h) * HD + ds * 16 + fr;
#pragma unroll
            for (int r = 0; r < 4; ++r) o[ob + (size_t)r * NH * HD] = acc[r];
        }
        accS = accS * cu.gl;
#pragma unroll
        for (int ks = 0; ks < 2; ++ks) accS = mfma16(cu.kd[ks], vb[ks], accS);
        { u32x2 w; w.x = pk2(accS[0], accS[1]); w.y = pk2(accS[2], accS[3]); *(LAS u32x2*)(ST + fr * 272 + (wave * 16 + fq * 4) * 2) = w; }
        __syncthreads();
    }
}
__device__ __forceinline__ void dn_out_item(const float* o, const float* gain, const bf16* proj, bf16* ymix, int w, int lane) {
    const int t = w >> 3, h = w & 7;
    const size_t ob = ((size_t)t * NH + h) * HD + lane * 2;
    const float o0 = o[ob], o1 = o[ob + 1];
    const float ss = wave_sum(o0 * o0 + o1 * o1), rs = 1.0f / sqrtf(ss * (1.0f / HD) + EPS);
    const int c = h * HD + lane * 2;
    const float g0 = bf2f(proj[(size_t)t * NPROJ + 5120 + c]), g1 = bf2f(proj[(size_t)t * NPROJ + 5120 + c + 1]);
    *(unsigned*)(ymix + (size_t)t * D + DLRU + c) = pk2(o0 * rs * gain[lane * 2] * silu_f(g0), o1 * rs * gain[lane * 2 + 1] * silu_f(g1));
}
__device__ __forceinline__ void route_row(const float* x, const float* rstd, const float* gain, const float* router, float* roww, int row, int lane) {
    float acc[8];
#pragma unroll
    for (int e = 0; e < 8; ++e) acc[e] = 0.f;
    for (int j = 0; j < 32; ++j) { const int k = lane + 64 * j; const float xv = x[(size_t)row * D + k] * gain[k]; const f32x4 r0 = *(const f32x4*)(router + (size_t)k * 8), r1 = *(const f32x4*)(router + (size_t)k * 8 + 4);
        acc[0] += xv * r0[0]; acc[1] += xv * r0[1]; acc[2] += xv * r0[2]; acc[3] += xv * r0[3]; acc[4] += xv * r1[0]; acc[5] += xv * r1[1]; acc[6] += xv * r1[2]; acc[7] += xv * r1[3]; }
    const float rs = rstd[row];
#pragma unroll
    for (int e = 0; e < 8; ++e) acc[e] = wave_sum(acc[e]) * rs;
    int e1 = 0; float l1 = acc[0];
#pragma unroll
    for (int e = 1; e < 8; ++e) if (acc[e] > l1) { l1 = acc[e]; e1 = e; }
    int e2 = -1; float l2 = -3.4e38f;
#pragma unroll
    for (int e = 0; e < 8; ++e) if (e != e1 && acc[e] > l2) { l2 = acc[e]; e2 = e; }
    const float w1 = 1.0f / (1.0f + __expf(l2 - l1)), w2 = 1.0f - w1;
    if (lane < 8) roww[(size_t)lane * T + row] = lane == e1 ? w1 : (lane == e2 ? w2 : 0.0f);
}
__device__ __forceinline__ void final_row(const float* x, const float* gain, float* out, int row, int lane) {
    const f32x4* xr = (const f32x4*)(x + (size_t)row * D) + lane; const f32x4* gr = (const f32x4*)gain + lane;
    f32x4 v[8]; float ss = 0.f;
#pragma unroll
    for (int j = 0; j < 8; ++j) { v[j] = xr[64 * j]; ss += (v[j][0] * v[j][0] + v[j][1] * v[j][1]) + (v[j][2] * v[j][2] + v[j][3] * v[j][3]); }
    ss = wave_sum(ss); const float rs = 1.0f / sqrtf(ss * (1.0f / D) + EPS);
    f32x4* o = (f32x4*)(out + (size_t)row * D) + lane;
#pragma unroll
    for (int j = 0; j < 8; ++j) o[64 * j] = v[j] * rs * gr[64 * j];
}

struct Args { const float* in[25]; float* out; unsigned char* ws; int ph_lo, ph_hi; };
typedef const __attribute__((address_space(4))) unsigned long long* kaptr_t;
__device__ __forceinline__ unsigned long long ldka(int i) { kaptr_t ka = (kaptr_t)__builtin_amdgcn_kernarg_segment_ptr(); asm volatile("" : "+s"(i)); return ka[i]; }
__device__ __forceinline__ const float* ldin(const Args&, int i) { return (const float*)ldka(i); }
__device__ __forceinline__ unsigned char* ldws(const Args&) { return (unsigned char*)ldka(26); }
__device__ __forceinline__ float* ldout(const Args&) { return (float*)ldka(25); }
__global__ void __launch_bounds__(512, 2) mega(Args args) {
    extern __shared__ __attribute__((aligned(16))) unsigned char lds_raw[];
    LAS unsigned char* lds = (LAS unsigned char*)lds_raw;
    volatile LAS unsigned* MISC = (volatile LAS unsigned*)(lds + MISC_OFF);
    const int tid = threadIdx.x, lane = tid & 63, wave = __builtin_amdgcn_readfirstlane(tid >> 6);
    const int G = gridDim.x, bid = blockIdx.x, gw = bid * 8 + wave, NGW = G * 8;
    const size_t gt = (size_t)bid * 512 + tid, NGT = (size_t)G * 512;
    unsigned char* ws = ldws(args);
    for (int u = tid; u < (LDS_BYTES - LDSCTL_OFF) / 4; u += 512) ((LAS unsigned*)(lds + LDSCTL_OFF))[u] = 0u;
    __syncthreads();
    XcdBarrier bar = xcd_barrier_post((unsigned*)(ws + WS_CTL) + CW_BAR, MISC + 8);
    const int lo = args.ph_lo, hi = args.ph_hi;
#define RUN(id) (lo <= (id) && (id) < hi)
#define SEAM(id) do { if (RUN(id) && (id) + 1 < hi) xcd_barrier(bar); } while (0)
#define INP(i) ldin(args, (i))
#define WSP(off) (ldws(args) + (off))
#define x_in INP(0)
#define norm_mix INP(1)
#define w_in INP(2)
#define conv_lru_w INP(3)
#define conv_lru_b INP(4)
#define lru_w_r INP(5)
#define lru_b_r INP(6)
#define lru_w_i INP(7)
#define lru_b_i INP(8)
#define lru_lambda INP(9)
#define lru_out_norm INP(10)
#define conv_qkv_w INP(11)
#define dn_a_log INP(12)
#define dn_dt_bias INP(13)
#define dn_out_norm INP(14)
#define w_out INP(15)
#define norm_ffn INP(16)
#define ffn_w_gate INP(17)
#define ffn_w_up INP(18)
#define ffn_w_down INP(19)
#define moe_router INP(20)
#define moe_w_gate INP(21)
#define moe_w_up INP(22)
#define moe_w_down INP(23)
#define norm_final INP(24)
#define xres (ldout(args))
#define Win ((bf16*)WSP(WS_WIN))
#define Wba ((float*)WSP(WS_WBA))
#define Wout ((bf16*)WSP(WS_WOUT))
#define Wgu ((bf16*)WSP(WS_WGU))
#define Wd ((bf16*)WSP(WS_WD))
#define Mgu ((bf16*)WSP(WS_MGU))
#define Md ((bf16*)WSP(WS_MD))
#define xb ((bf16*)WSP(WS_XB))
#define rstd ((float*)WSP(WS_RSTD))
#define ba ((float*)WSP(WS_BA))
#define beta ((float*)WSP(WS_BETA))
#define gg ((float*)WSP(WS_G))
#define roww ((float*)WSP(WS_ROWW))
#define proj ((bf16*)WSP(WS_PROJ))
#define hid ((bf16*)WSP(WS_PROJ))
#define ymix ((bf16*)WSP(WS_YMIX))
#define c0 ((float*)WSP(WS_C))
#define c1 ((float*)WSP(WS_C + (size_t)T * 1024 * 4))
#define c2 ((float*)WSP(WS_C + (size_t)2 * T * 1024 * 4))
#define c3 ((float*)WSP(WS_C + (size_t)3 * T * 1024 * 4))
#define DN_WF ((bf16*)WSP(WS_C))
#define DN_QF ((bf16*)WSP(WS_C + (size_t)32 * MiB))
#define DN_KDTF ((bf16*)WSP(WS_C + (size_t)64 * MiB))
#define DN_UF ((bf16*)WSP(WS_C + (size_t)96 * MiB))
#define DN_QKF ((bf16*)WSP(WS_C + (size_t)128 * MiB))
#define DN_GL ((float*)WSP(WS_C + (size_t)144 * MiB))
    const int BIG = 1 << 30;
    int ph = 0;
#define PHL int lane_ = lane, tid_ = tid, gw_ = gw, bid_ = bid; size_t gt_ = gt; asm volatile("" : "+v"(lane_), "+v"(tid_)); asm volatile("" : "+s"(gw_), "+s"(bid_)); asm volatile("" : "+v"(gt_)); LAS float* scr = (LAS float*)(lds + (gw_ & 7) * 16384);
    if (RUN(ph)) { PHL
        for (int l = 0; l < 2; ++l) {
            convert_matrix(w_in + (size_t)l * D * DIN, DIN, 0, D, NPROJ, norm_mix + l * D, Win + (size_t)l * NPROJ * D, BIG, 0, 0, scr, gw_, NGW, lane_);
            convert_matrix(w_out + (size_t)l * D * D, D, 0, D, D, nullptr, Wout + (size_t)l * D * D, BIG, 0, 0, scr, gw_, NGW, lane_);
            for (size_t i = gt_; i < (size_t)16 * D; i += NGT) { const int j = (int)(i / D), k = (int)(i % D); Wba[(size_t)l * 16 * D + i] = w_in[(size_t)l * D * DIN + (size_t)k * DIN + NPROJ + j] * norm_mix[l * D + k]; }
        }
        convert_matrix(ffn_w_gate, DFF, 0, D, DFF, norm_ffn, Wgu, 128, 256, 0, scr, gw_, NGW, lane_);
        convert_matrix(ffn_w_up, DFF, 0, D, DFF, norm_ffn, Wgu, 128, 256, 128, scr, gw_, NGW, lane_);
        convert_matrix(ffn_w_down, D, 0, DFF, D, nullptr, Wd, BIG, 0, 0, scr, gw_, NGW, lane_);
    }
    SEAM(ph); ++ph;
    int xsel = 0;
#define xcur (xsel ? (const float*)xres : x_in)
    for (int l = 0; l < 2; ++l) {
        if (RUN(ph)) { PHL for (int r = gw_; r < T; r += NGW) rowprep_row(xcur, xb, rstd, Wba + (size_t)l * 16 * D, ba, r, lane_); }
        SEAM(ph); ++ph;
        if (RUN(ph)) { pg8::Gemm g{xb, Win + (size_t)l * NPROJ * D, T, NPROJ, D, 0}; pg8::StaticOrder S; S.init(T, NPROJ, G, bid); pg8::EpiScaleBf16 E{proj, rstd, NPROJ, 0};
            pg8::gemm_phase<pg8::EpiScaleBf16, pg8::StaticOrder, true, true>(lds, g, S, E); }
        SEAM(ph); ++ph;
        if (RUN(ph)) { PHL for (size_t i = gt_; i < (size_t)T * DLRU; i += NGT) lru_conv_elem(proj, conv_lru_w + (size_t)l * 4 * DLRU, conv_lru_b + l * DLRU, c2, i); }
        SEAM(ph); ++ph;
        if (RUN(ph)) { PHL for (size_t i = gt_; i < (size_t)T * DLRU; i += NGT) lru_gate_elem(c2, lru_w_r + (size_t)l * 8 * 128 * 128, lru_b_r + l * DLRU, lru_w_i + (size_t)l * 8 * 128 * 128, lru_b_i + l * DLRU, lru_lambda + l * DLRU, c0, c1, i); }
        SEAM(ph); ++ph;
        if (RUN(ph)) { PHL if ((gw_ & 7) == 0 && bid_ < 32) lru_scan_chan(c0, c1, proj, bid_ * 64 + lane_); }
        SEAM(ph); ++ph;
        if (RUN(ph)) { PHL for (int r = gw_; r < T; r += NGW) lru_norm_row(c0, lru_out_norm + l * DLRU, ymix, r, lane_); }
        SEAM(ph); ++ph;
        if (RUN(ph)) { PHL for (int uid = bid_; uid < 2048; uid += G) dna_unit(proj, conv_qkv_w + (size_t)l * 4 * 3 * DDN, ba, dn_a_log + l * NH, dn_dt_bias + l * NH, DN_WF, DN_QF, DN_KDTF, DN_QKF, DN_UF, DN_GL, uid, lds, tid_, lane_, gw_ & 7); }
        SEAM(ph); ++ph;
        if (RUN(ph)) { PHL if (bid_ < 128) dnb_run(DN_WF, DN_QF, DN_KDTF, DN_QKF, DN_UF, DN_GL, c3, (bid_ & 7) + 8 * (bid_ >> 6), (bid_ >> 3) & 7, lds, tid_, lane_, gw_ & 7); }
        SEAM(ph); ++ph;
        if (RUN(ph)) { PHL for (int w = gw_; w < T * NH; w += NGW) dn_out_item(c3, dn_out_norm + l * HD, proj, ymix, w, lane_); }
        SEAM(ph); ++ph;
        if (RUN(ph)) { pg8::Gemm g{ymix, Wout + (size_t)l * D * D, T, D, D, 0}; pg8::StaticOrder S; S.init(T, D, G, bid); pg8::EpiResidual E{xcur, xres, nullptr, D, 0};
            pg8::gemm_phase<pg8::EpiResidual, pg8::StaticOrder, true, true>(lds, g, S, E); }
        SEAM(ph); ++ph;
        xsel = 1;
        if (RUN(ph)) { PHL for (int r = gw_; r < T; r += NGW) rowprep_row(xcur, xb, rstd, nullptr, nullptr, r, lane_); }
        SEAM(ph); ++ph;
        if (l == 1) { if (RUN(ph)) { PHL for (int r = gw_; r < T; r += NGW) route_row(xcur, rstd, norm_ffn + D, moe_router, roww, r, lane_); } }
        SEAM(ph); ++ph;
        const int ne = l == 0 ? 1 : NEXP, dff = l == 0 ? DFF : DFFE;
        for (int e = 0; e < ne; ++e) {
            if (l == 1) { if (RUN(ph)) { PHL
                convert_matrix(moe_w_gate + (size_t)e * D * DFFE, DFFE, 0, D, DFFE, norm_ffn + D, Mgu, 128, 256, 0, scr, gw_, NGW, lane_);
                convert_matrix(moe_w_up + (size_t)e * D * DFFE, DFFE, 0, D, DFFE, norm_ffn + D, Mgu, 128, 256, 128, scr, gw_, NGW, lane_);
                convert_matrix(moe_w_down + (size_t)e * DFFE * D, D, 0, DFFE, D, nullptr, Md, BIG, 0, 0, scr, gw_, NGW, lane_); } }
            SEAM(ph); ++ph;
            if (RUN(ph)) { pg8::Gemm g{xb, l == 0 ? Wgu : Mgu, T, 2 * dff, D, 0}; pg8::StaticOrder S; S.init(T, 2 * dff, G, bid); pg8::EpiSwiGLU E{hid, rstd, dff, 0};
                pg8::gemm_phase<pg8::EpiSwiGLU, pg8::StaticOrder, true, true>(lds, g, S, E); }
            SEAM(ph); ++ph;
            if (RUN(ph)) { pg8::Gemm g{hid, l == 0 ? Wd : Md, T, D, dff, 0}; pg8::StaticOrder S; S.init(T, D, G, bid); pg8::EpiResidual E{xcur, xres, l == 0 ? nullptr : roww + (size_t)e * T, D, 0};
                pg8::gemm_phase<pg8::EpiResidual, pg8::StaticOrder, true, true>(lds, g, S, E); }
            SEAM(ph); ++ph;
        }
    }
    if (RUN(ph)) { PHL for (int r = gw_; r < T; r += NGW) final_row(xcur, norm_final, xres, r, lane_); }
#undef RUN
#undef SEAM
}

extern "C" void kernel_launch(void* const* d_in, const int* in_sizes, int n_in, void* d_out, int out_size, void* d_ws, size_t ws_size, hipStream_t stream) {
    static int grid = 0;
    if (grid == 0) {
        if (n_in != 25 || ws_size < WS_END) { fprintf(stderr, "kernel_launch: unexpected n_in %d / ws_size %zu (need %zu)\n", n_in, ws_size, (size_t)WS_END); grid = -1; return; }
        int dev = 0, cus = 0, per_cu = 0;
        if (hipGetDevice(&dev) != hipSuccess || hipDeviceGetAttribute(&cus, hipDeviceAttributeMultiprocessorCount, dev) != hipSuccess) { grid = -1; return; }
        if (hipFuncSetAttribute((const void*)mega, hipFuncAttributeMaxDynamicSharedMemorySize, LDS_BYTES) != hipSuccess) { fprintf(stderr, "kernel_launch: hipFuncSetAttribute failed\n"); grid = -1; return; }
        if (hipOccupancyMaxActiveBlocksPerMultiprocessor(&per_cu, (const void*)mega, 512, LDS_BYTES) != hipSuccess || per_cu < 1) { fprintf(stderr, "kernel_launch: occupancy query says %d\n", per_cu); }
        (void)hipGetLastError();
        grid = cus;
    }
    if (grid < 0) return;
    if (hipMemsetAsync((char*)d_ws + WS_CTL, 0, CTL_ZERO_BYTES, stream) != hipSuccess) return;
    Args a{};
    for (int i = 0; i < 25; ++i) a.in[i] = (const float*)d_in[i];
    a.out = (float*)d_out; a.ws = (unsigned char*)d_ws; a.ph_lo = 0; a.ph_hi = 1 << 30;
    hipLaunchKernelGGL(mega, dim3(grid), dim3(512), LDS_BYTES, stream, a);
}
```

```cpp
#include <hip/hip_runtime.h>
#include <cstdio>
#include <cstdint>
namespace pg8 {
#define PG8_LAS __attribute__((address_space(3)))
typedef unsigned short bf16_t;
typedef short bf16x8 __attribute__((ext_vector_type(8)));
typedef float f32x4 __attribute__((ext_vector_type(4)));
typedef unsigned u32x4 __attribute__((ext_vector_type(4)));
constexpr int BM = 256, BK = 64, HALF = 128, HTB = HALF * BK * 2  , STAGE_BYTES = 8 * HTB, NXCD = 8, WGM = 8;

__host__ __device__ __forceinline__ int lds_byte(int r, int c) { const int st = (r >> 4) * 2 + (c >> 5), rr = r & 15, cc = c & 31, ob = rr * 64 + cc * 2; return st * 1024 + (ob ^ (((ob >> 9) & 1) << 5)); }
__host__ __device__ __forceinline__ void stage_rc(int b, int& R, int& C) { const int st = b / 1024, sb = b % 1024, swz = sb ^ (((sb >> 9) & 1) << 5); R = (st >> 1) * 16 + swz / 64; C = (st & 1) * 32 + (swz % 64) / 2; }
__host__ __device__ __forceinline__ int perm32(int rho) { const int n = rho >> 4, i = rho & 15; return 8 * (i >> 2) + 4 * n + (i & 3); }

struct Unit { int pm, pn; };
struct Gemm { const bf16_t* A; const bf16_t* Bt; int M, N, K, pad; };

struct StaticOrder {
    int nM, nN, nwg, G, c;
    __host__ __device__ void init(int M, int N, int G_, int c_) { nM = M / BM; nN = N / BM; nwg = nM * nN; G = G_; c = c_; }
    __host__ __device__ bool next(int i, Unit& u) const {
        const long L = (long)i * G + c; if (L >= nwg) return false;
        int wgid = (int)L; { const int q = nwg / NXCD, r = nwg % NXCD, xcd = wgid % NXCD, off = wgid / NXCD; wgid = (xcd < r ? xcd * (q + 1) : r * (q + 1) + (xcd - r) * q) + off; }
        const int nig = WGM * nN, gid = wgid / nig, fm = gid * WGM, gsz = (nM - fm) < WGM ? (nM - fm) : WGM;
        u.pm = fm + ((wgid % nig) % gsz); u.pn = (wgid % nig) / gsz; return true;
    }
    __device__ __forceinline__ void a_ready(const Unit&) const {}
    __device__ __forceinline__ void done(const Unit&) const {}
};


__device__ __forceinline__ unsigned cvt_pk_bf16(float lo, float hi) { unsigned r; asm volatile("v_cvt_pk_bf16_f32 %0, %1, %2" : "=v"(r) : "v"(lo), "v"(hi)); return r; }
__device__ __forceinline__ float silu_f(float x) { return x / (1.0f + __expf(-x)); }

struct EpiScaleBf16 {
    static constexpr bool PERM = true, AFTER_DRAIN = false;
    bf16_t* O; const float* rs; int ldc; int pad;
    __device__ __forceinline__ void operator()(const f32x4 (&acc)[2][2][4][2], const Unit& u, int wr, int wc, int fr, int fq) const {
        const int row0 = u.pm * BM + wr * 64 + fr, col0 = u.pn * BM + wc * 32 + 8 * fq;
#pragma unroll
        for (int ai = 0; ai < 2; ++ai)
#pragma unroll
            for (int m = 0; m < 4; ++m) { const int r = row0 + ai * HALF + m * 16; const float s = rs[r]; bf16_t* rowp = O + (size_t)r * ldc + col0;
#pragma unroll
                for (int bj = 0; bj < 2; ++bj) { const f32x4 v0 = acc[ai][bj][m][0] * s, v1 = acc[ai][bj][m][1] * s;
                    u32x4 w; w.x = cvt_pk_bf16(v0[0], v0[1]); w.y = cvt_pk_bf16(v0[2], v0[3]); w.z = cvt_pk_bf16(v1[0], v1[1]); w.w = cvt_pk_bf16(v1[2], v1[3]);
                    *(u32x4*)(rowp + bj * HALF) = w; } }
    }
};
struct EpiSwiGLU {
    static constexpr bool PERM = true, AFTER_DRAIN = false;
    bf16_t* O; const float* rs; int ldc; int pad;
    __device__ __forceinline__ void operator()(const f32x4 (&acc)[2][2][4][2], const Unit& u, int wr, int wc, int fr, int fq) const {
        const int row0 = u.pm * BM + wr * 64 + fr, col0 = u.pn * HALF + wc * 32 + 8 * fq;
#pragma unroll
        for (int ai = 0; ai < 2; ++ai)
#pragma unroll
            for (int m = 0; m < 4; ++m) { const int r = row0 + ai * HALF + m * 16; const float s = rs ? rs[r] : 1.0f; bf16_t* rowp = O + (size_t)r * ldc + col0;
                f32x4 h0, h1;
#pragma unroll
                for (int j = 0; j < 4; ++j) { h0[j] = silu_f(acc[ai][0][m][0][j] * s) * (acc[ai][1][m][0][j] * s); h1[j] = silu_f(acc[ai][0][m][1][j] * s) * (acc[ai][1][m][1][j] * s); }
                u32x4 w; w.x = cvt_pk_bf16(h0[0], h0[1]); w.y = cvt_pk_bf16(h0[2], h0[3]); w.z = cvt_pk_bf16(h1[0], h1[1]); w.w = cvt_pk_bf16(h1[2], h1[3]);
                *(u32x4*)rowp = w; }
    }
};
struct EpiResidual {
    static constexpr bool PERM = false, AFTER_DRAIN = false;
    const float* base; float* out; const float* roww; int ldc; int pad;
    __device__ __forceinline__ void operator()(const f32x4 (&acc)[2][2][4][2], const Unit& u, int wr, int wc, int fr, int fq) const {
        const int row0 = u.pm * BM + wr * 64 + fr, col0 = u.pn * BM + wc * 32 + 4 * fq;
#pragma unroll
        for (int ai = 0; ai < 2; ++ai)
#pragma unroll
            for (int m = 0; m < 4; ++m) { const int r = row0 + ai * HALF + m * 16; const float w = roww ? roww[r] : 1.0f; const size_t off = (size_t)r * ldc + col0;
#pragma unroll
                for (int bj = 0; bj < 2; ++bj)
#pragma unroll
                    for (int n = 0; n < 2; ++n) { const f32x4 bs = *(const f32x4*)(base + off + bj * HALF + n * 16); *(f32x4*)(out + off + bj * HALF + n * 16) = bs + acc[ai][bj][m][n] * w; } }
    }
};
template <class Epi, class Sched, bool ALIGN_EPI = false, bool SP2 = false>
__device__ __forceinline__ void gemm_phase(PG8_LAS unsigned char* lds, const Gemm g, const Sched& S, const Epi& E) {
    int tid_o = threadIdx.x; asm volatile("" : "+v"(tid_o));
    const int tid = tid_o, wid = __builtin_amdgcn_readfirstlane(tid >> 6), lane = tid & 63, wr = wid >> 2, wc = wid & 3, fr = lane & 15, fq = lane >> 4;
    const int K = g.K, nt = K / BK;
    unsigned voffA[2], voffB[2];
#pragma unroll
    for (int i = 0; i < 2; ++i) { int R, C; stage_rc(tid * 16 + i * 8192, R, C); const int Rb = Epi::PERM ? ((R & ~31) + perm32(R & 31)) : R;
        voffA[i] = (unsigned)(R * K + C) * 2u; voffB[i] = (unsigned)(Rb * K + C) * 2u; }
    const size_t kstep = (size_t)(BK * 2);
    const size_t hstep = (size_t)HALF * K * 2;
    const size_t tstep = 2 * hstep;
    const unsigned ldsw = (unsigned)wid * 1024u;
    const int aoff = lds_byte(wr * 64 + fr, fq * 8), boff = lds_byte(wc * 32 + fr, fq * 8);
#define PG8_SA(b, h) (((b) * 2 + (h)) * HTB)
#define PG8_SB(b, h) ((4 + (b) * 2 + (h)) * HTB)
#define PG8_STAGE(bufoff, gbase, voff) do { _Pragma("unroll") for (int _i = 0; _i < 2; ++_i) \
        __builtin_amdgcn_global_load_lds((const unsigned*)((const char*)(gbase) + (voff)[_i]), (PG8_LAS unsigned*)(lds + (bufoff) + ldsw + _i * 8192), 16, 0, 0); } while (0)
#define PG8_LDA(dst, b, h) do { _Pragma("unroll") for (int m = 0; m < 4; ++m) _Pragma("unroll") for (int k = 0; k < 2; ++k) dst[m][k] = *(const PG8_LAS bf16x8*)(lds + PG8_SA(b, h) + aoff + m * 2048 + k * 1024); } while (0)
#define PG8_LDB(dst, b, h) do { _Pragma("unroll") for (int n = 0; n < 2; ++n) _Pragma("unroll") for (int k = 0; k < 2; ++k) dst[n][k] = *(const PG8_LAS bf16x8*)(lds + PG8_SB(b, h) + boff + n * 2048 + k * 1024); } while (0)
#define PG8_MMA(ai, bj, At, Bt) do { __builtin_amdgcn_s_setprio(1); _Pragma("unroll") for (int m = 0; m < 4; ++m) _Pragma("unroll") for (int n = 0; n < 2; ++n) _Pragma("unroll") for (int k = 0; k < 2; ++k) \
        acc[ai][bj][m][n] = __builtin_amdgcn_mfma_f32_16x16x32_bf16(Bt[n][k], At[m][k], acc[ai][bj][m][n], 0, 0, 0); __builtin_amdgcn_s_setprio(0); } while (0)
#define PG8_WAIT_V(n) asm volatile("s_waitcnt vmcnt(" #n ")" ::: "memory")
#define PG8_WAIT_L(n) asm volatile("s_waitcnt lgkmcnt(" #n ")" ::: "memory")
#define PG8_BAR __builtin_amdgcn_s_barrier()
#define PG8_SCHED __builtin_amdgcn_sched_barrier(0)
    Unit cur, nxt; int ui = 0;
    if (!S.next(0, cur)) return;
    f32x4 acc[2][2][4][2];
#pragma unroll
    for (int a = 0; a < 2; ++a)
#pragma unroll
        for (int b = 0; b < 2; ++b)
#pragma unroll
            for (int m = 0; m < 4; ++m)
#pragma unroll
                for (int n = 0; n < 2; ++n) acc[a][b][m][n] = (f32x4){0.f, 0.f, 0.f, 0.f};
    bf16x8 At[4][2], B0[2][2], B1[2][2];
    const char* cA = (const char*)g.A + (size_t)cur.pm * tstep; const char* cB = (const char*)g.Bt + (size_t)cur.pn * tstep;
    S.a_ready(cur);
    if constexpr (SP2) {
        PG8_STAGE(PG8_SB(0, 0), cB, voffB); PG8_STAGE(PG8_SB(0, 1), cB + hstep, voffB); PG8_STAGE(PG8_SA(0, 0), cA, voffA); PG8_STAGE(PG8_SA(0, 1), cA + hstep, voffA);
        if (wr == 1) PG8_BAR;
        PG8_WAIT_V(2); PG8_BAR;
        PG8_STAGE(PG8_SB(1, 0), cB + kstep, voffB); PG8_STAGE(PG8_SA(1, 0), cA + kstep, voffA); PG8_STAGE(PG8_SB(1, 1), cB + hstep + kstep, voffB);
        PG8_WAIT_V(6); PG8_BAR;
    } else {
        PG8_STAGE(PG8_SB(0, 0), cB, voffB); PG8_STAGE(PG8_SA(0, 0), cA, voffA); PG8_STAGE(PG8_SB(0, 1), cB + hstep, voffB); PG8_STAGE(PG8_SA(0, 1), cA + hstep, voffA);
        if (wr == 1) PG8_BAR;
        PG8_WAIT_V(4); PG8_BAR;
        PG8_STAGE(PG8_SB(1, 0), cB + kstep, voffB); PG8_STAGE(PG8_SA(1, 0), cA + kstep, voffA); PG8_STAGE(PG8_SB(1, 1), cB + hstep + kstep, voffB);
        PG8_WAIT_V(6); PG8_BAR;
    }
    for (;;) {
        const bool has_next = S.next(ui + 1, nxt);
        const char* nA = has_next ? (const char*)g.A + (size_t)nxt.pm * tstep : cA; const char* nB = has_next ? (const char*)g.Bt + (size_t)nxt.pn * tstep : cB;
        for (int t = 0; t < nt; t += 2) {
            const bool last = (t == nt - 2);
            const char* a1 = cA + (size_t)(t + 1) * kstep;
            const char* a2 = last ? nA : cA + (size_t)(t + 2) * kstep; const char* b2 = last ? nB : cB + (size_t)(t + 2) * kstep;
            const char* a3 = a2 + kstep; const char* b3 = b2 + kstep;
            if (last && has_next) S.a_ready(nxt);
            if constexpr (SP2) {
            PG8_LDB(B0, 0, 0); PG8_LDB(B1, 0, 1); PG8_SCHED; PG8_LDA(At, 0, 0); PG8_STAGE(PG8_SA(1, 1), a1 + hstep, voffA);
            PG8_WAIT_V(8); PG8_WAIT_L(0); PG8_BAR; PG8_MMA(0, 0, At, B0); PG8_MMA(0, 1, At, B1); PG8_BAR; PG8_SCHED;
            PG8_LDA(At, 0, 1); PG8_STAGE(PG8_SB(0, 0), b2, voffB); PG8_STAGE(PG8_SB(0, 1), b2 + hstep, voffB); PG8_STAGE(PG8_SA(0, 0), a2, voffA);
            PG8_WAIT_V(8); PG8_WAIT_L(0); PG8_BAR; PG8_MMA(1, 0, At, B0); PG8_MMA(1, 1, At, B1); PG8_BAR; PG8_SCHED;
            PG8_LDB(B0, 1, 0); PG8_LDB(B1, 1, 1); PG8_SCHED; PG8_LDA(At, 1, 0); PG8_STAGE(PG8_SA(0, 1), a2 + hstep, voffA);
            PG8_WAIT_V(8); PG8_WAIT_L(0); PG8_BAR; PG8_MMA(0, 0, At, B0); PG8_MMA(0, 1, At, B1); PG8_BAR; PG8_SCHED;
            PG8_LDA(At, 1, 1); PG8_STAGE(PG8_SB(1, 0), b3, voffB); PG8_STAGE(PG8_SB(1, 1), b3 + hstep, voffB); PG8_STAGE(PG8_SA(1, 0), a3, voffA);
            PG8_WAIT_V(8); PG8_WAIT_L(0); PG8_BAR; PG8_MMA(1, 0, At, B0); PG8_MMA(1, 1, At, B1); PG8_BAR; PG8_SCHED;
            } else {
            PG8_LDB(B0, 0, 0); PG8_SCHED; PG8_LDA(At, 0, 0); PG8_STAGE(PG8_SA(1, 1), a1 + hstep, voffA);
            PG8_WAIT_L(8); PG8_BAR; PG8_WAIT_L(0); PG8_MMA(0, 0, At, B0); PG8_BAR; PG8_SCHED;
            PG8_LDB(B1, 0, 1); PG8_STAGE(PG8_SB(0, 0), b2, voffB);
            PG8_BAR; PG8_WAIT_L(0); PG8_MMA(0, 1, At, B1); PG8_BAR;
            PG8_LDA(At, 0, 1); PG8_STAGE(PG8_SA(0, 0), a2, voffA);
            PG8_BAR; PG8_WAIT_L(0); PG8_MMA(1, 0, At, B0); PG8_BAR; PG8_SCHED;
            PG8_STAGE(PG8_SB(0, 1), b2 + hstep, voffB);
            PG8_WAIT_V(6); PG8_BAR; PG8_MMA(1, 1, At, B1); PG8_BAR;
            PG8_LDB(B0, 1, 0); PG8_SCHED; PG8_LDA(At, 1, 0); PG8_STAGE(PG8_SA(0, 1), a2 + hstep, voffA);
            PG8_WAIT_L(8); PG8_BAR; PG8_WAIT_L(0); PG8_MMA(0, 0, At, B0); PG8_BAR; PG8_SCHED;
            PG8_LDB(B1, 1, 1); PG8_STAGE(PG8_SB(1, 0), b3, voffB);
            PG8_BAR; PG8_WAIT_L(0); PG8_MMA(0, 1, At, B1); PG8_BAR;
            PG8_LDA(At, 1, 1); PG8_STAGE(PG8_SA(1, 0), a3, voffA);
            PG8_BAR; PG8_WAIT_L(0); PG8_MMA(1, 0, At, B0); PG8_BAR; PG8_SCHED;
            PG8_STAGE(PG8_SB(1, 1), b3 + hstep, voffB);
            PG8_WAIT_V(6); PG8_BAR; PG8_MMA(1, 1, At, B1); PG8_BAR;
            }
        }
        if constexpr (ALIGN_EPI) { if (wr == 0) PG8_BAR; }
        if constexpr (!Epi::AFTER_DRAIN) { E(acc, cur, wr, wc, fr, fq); S.done(cur); }
        if (!has_next) break;
#pragma unroll
        for (int a = 0; a < 2; ++a)
#pragma unroll
            for (int b = 0; b < 2; ++b)
#pragma unroll
                for (int m = 0; m < 4; ++m)
#pragma unroll
                    for (int n = 0; n < 2; ++n) acc[a][b][m][n] = (f32x4){0.f, 0.f, 0.f, 0.f};
        cur = nxt; cA = nA; cB = nB; ++ui;
        if constexpr (ALIGN_EPI) { if (wr == 1) PG8_BAR; }
    }
    PG8_WAIT_V(0);
    if constexpr (!ALIGN_EPI) { if (wr == 0) PG8_BAR; }
    PG8_BAR;
    if constexpr (Epi::AFTER_DRAIN) { E.fused(acc, cur, wr, wc, fr, fq, lds, wid, lane); S.done(cur); }
#undef PG8_SA
#undef PG8_SB
#undef PG8_STAGE
#undef PG8_LDA
#undef PG8_LDB
#undef PG8_MMA
#undef PG8_WAIT_V
#undef PG8_WAIT_L
#undef PG8_BAR
#undef PG8_SCHED
}
}

#define GAS __attribute__((address_space(1)))
#define LAS __attribute__((address_space(3)))
#define XB_TMO      128
#define XB_XCNT(j)  (256  + 64 * (j))
#define XB_XSUB(j)  (1280 + 64 * (j))
#define XB_XGEN(j)  (2304 + 64 * (j))
#define XB_TOP      3328
#define XB_TOPGEN   3392
#define XCD_BAR_WORDS 3456
#define XB_SPIN_CAP (1u << 23)

__device__ __forceinline__ unsigned xb_ld(unsigned* p)              { return __hip_atomic_load(p, __ATOMIC_RELAXED, __HIP_MEMORY_SCOPE_AGENT); }
__device__ __forceinline__ unsigned xb_add(unsigned* p, unsigned v) { return __hip_atomic_fetch_add(p, v, __ATOMIC_RELAXED, __HIP_MEMORY_SCOPE_AGENT); }
__device__ __forceinline__ unsigned xb_xcc_id() { return (unsigned)__builtin_amdgcn_s_getreg((3 << 11) | 20) & 0xFu; }
#define XB_SPIN(cond, bar) do { unsigned _sp = 0; while (cond) { __builtin_amdgcn_s_sleep(1); \
    if ((++_sp & 255u) == 0u) { if (xb_ld(&(bar)[XB_TMO])) break; if (_sp > XB_SPIN_CAP) { atomicAdd(&(bar)[XB_TMO], 1u); break; } } } } while (0)

struct XcdBarrier {
    unsigned* bar; unsigned x;
    volatile LAS unsigned* st;
};

__device__ __forceinline__ XcdBarrier xcd_barrier_post(unsigned* bar, volatile LAS unsigned* st) {
    XcdBarrier b; b.bar = bar; b.x = xb_xcc_id(); b.st = st;
    if (threadIdx.x == 0) (void)xb_add(&bar[XB_XCNT(b.x)], 1u);
    return b;
}
__device__ __forceinline__ void xcd_barrier_complete(unsigned* bar, unsigned x, unsigned& nloc, unsigned& nx) {
    const unsigned G = gridDim.x * gridDim.y * gridDim.z;
    unsigned sum, cnt, mine, sp = 0u;
    for (;;) {
        sum = 0u; cnt = 0u; mine = 0u;
#pragma unroll
        for (unsigned j = 0; j < 16; ++j) { const unsigned c = xb_ld(&bar[XB_XCNT(j)]); sum += c; cnt += (c > 0u) ? 1u : 0u; mine = (j == x) ? c : mine; }
        if (sum == G) break;
        __builtin_amdgcn_s_sleep(1);
        if ((++sp & 255u) == 0u) { if (xb_ld(&bar[XB_TMO])) break; if (sp > XB_SPIN_CAP) { atomicAdd(&bar[XB_TMO], 1u); break; } }
    }
    nloc = mine > 0u ? mine : 1u; nx = cnt > 0u ? cnt : 1u;
}

__device__ __forceinline__ void xcd_barrier(const XcdBarrier& b) {
    asm volatile("s_waitcnt vmcnt(0)" ::: "memory");
    __syncthreads();
    if (threadIdx.x == 0) {
        unsigned* bar = b.bar; asm volatile("" : "+s"(bar));
        __builtin_amdgcn_s_waitcnt(0);
        unsigned nloc = b.st[0], nx = b.st[1];
        if (nloc == 0u) { xcd_barrier_complete(bar, b.x, nloc, nx); b.st[0] = nloc; b.st[1] = nx; }
        const unsigned old = xb_add(&bar[XB_XSUB(b.x)], 1u);
        const unsigned gen = old / nloc;
        if (old + 1u == (gen + 1u) * nloc) {
            __builtin_amdgcn_fence(__ATOMIC_RELEASE, "agent");
            asm volatile("s_waitcnt vmcnt(0)" ::: "memory");
            const unsigned og = xb_add(&bar[XB_TOP], 1u);
            const unsigned tg = og / nx;
            if (og + 1u == (tg + 1u) * nx) xb_add(&bar[XB_TOPGEN], 1u);
            else XB_SPIN(xb_ld(&bar[XB_TOPGEN]) == tg, bar);
            __builtin_amdgcn_fence(__ATOMIC_ACQUIRE, "agent");
            xb_add(&bar[XB_XGEN(b.x)], 1u);
            asm volatile("s_waitcnt vmcnt(0)" ::: "memory");
        } else {
            XB_SPIN(xb_ld(&bar[XB_XGEN(b.x)]) == gen, bar);
            __builtin_amdgcn_fence(__ATOMIC_ACQUIRE, "agent");
            asm volatile("s_waitcnt vmcnt(0)" ::: "memory");
        }
    }
    __syncthreads();
}

constexpr int T = 16384, SEQ = 8192, D = 2048, DLRU = 1024, DDN = 1024, NH = 8, HD = 128, NPROJ = 6144, DIN = 6160;
constexpr int DFF = 6144, NEXP = 8, DFFE = 3072;
constexpr float EPS = 1e-6f;
typedef unsigned short bf16;
typedef float f32x4 __attribute__((ext_vector_type(4)));
typedef unsigned u32x4 __attribute__((ext_vector_type(4)));
typedef unsigned u32x2 __attribute__((ext_vector_type(2)));
#define LDS_WAIT() asm volatile("s_waitcnt lgkmcnt(0)" ::: "memory")

__device__ __forceinline__ float bf2f(bf16 b) { return __uint_as_float(((unsigned)b) << 16); }
__device__ __forceinline__ unsigned f2bf(float f) { unsigned u = __float_as_uint(f); return (u + 0x7fffu + ((u >> 16) & 1u)) >> 16; }
__device__ __forceinline__ unsigned pk2(float lo, float hi) { return f2bf(lo) | (f2bf(hi) << 16); }
__device__ __forceinline__ float shfl_xor_l(float v, int o, int lane) { return __int_as_float(__builtin_amdgcn_ds_bpermute((lane ^ o) << 2, __float_as_int(v))); }
__device__ __forceinline__ float shfl_up_l(float v, int d, int lane) { return __int_as_float(__builtin_amdgcn_ds_bpermute((lane - d) << 2, __float_as_int(v))); }
__device__ __forceinline__ float shfl_idx_l(float v, int src) { return __int_as_float(__builtin_amdgcn_ds_bpermute(src << 2, __float_as_int(v))); }
__device__ __forceinline__ float wave_sum(float v, int lane) {
#pragma unroll
    for (int o = 1; o < 64; o <<= 1) v += shfl_xor_l(v, o, lane);
    return v;
}
using pg8::silu_f;
__device__ __forceinline__ float sigmoid_f(float x) { return 1.0f / (1.0f + __expf(-x)); }
__device__ __forceinline__ float softplus_f(float x) { return fmaxf(x, 0.0f) + log1pf(__expf(-fabsf(x))); }
__device__ __forceinline__ float gelu_tanh_f(float x) { const float u = 0.7978845608028654f * (x + 0.044715f * x * x * x); return 0.5f * x * (1.0f + tanhf(u)); }

constexpr size_t MiB = 1u << 20;
constexpr size_t al(size_t x) { return (x + MiB - 1) / MiB * MiB; }
constexpr size_t WS_CTL = 0, CTL_ZERO_BYTES = 1 * MiB;
constexpr int CW_BAR = 4096;
constexpr size_t WS_WIN = 1 * MiB;
constexpr size_t WS_WBA = WS_WIN + al((size_t)2 * NPROJ * D * 2);
constexpr size_t WS_WOUT = WS_WBA + al((size_t)2 * 16 * D * 4);
constexpr size_t WS_WGU = WS_WOUT + al((size_t)2 * D * D * 2);
constexpr size_t WS_WD = WS_WGU + al((size_t)2 * DFF * D * 2);
constexpr size_t WS_MGU = WS_WD + al((size_t)D * DFF * 2);
constexpr size_t WS_MD = WS_MGU + al((size_t)2 * DFFE * D * 2);
constexpr size_t WS_XB = WS_MD + al((size_t)D * DFFE * 2);
constexpr size_t WS_RSTD = WS_XB + al((size_t)T * D * 2);
constexpr size_t WS_BA = WS_RSTD + al((size_t)T * 4);
constexpr size_t WS_BETA = WS_BA + al((size_t)T * 16 * 4);
constexpr size_t WS_G = WS_BETA + al((size_t)T * 8 * 4);
constexpr size_t WS_ROWW = WS_G + al((size_t)T * 8 * 4);
constexpr size_t WS_PROJ = WS_ROWW + al((size_t)8 * T * 4);
constexpr size_t WS_YMIX = WS_PROJ + al((size_t)T * NPROJ * 2);
constexpr size_t WS_C = WS_YMIX + al((size_t)T * D * 2);
constexpr size_t WS_WRT = WS_C + (size_t)388 * MiB;
constexpr size_t WS_END = WS_WRT + 1 * MiB;
constexpr int RING_BYTES = 131072, LDSCTL_OFF = RING_BYTES, MISC_OFF = LDSCTL_OFF + 320, LDS_BYTES = 147456;

__device__ __forceinline__ void transpose_item(const float* W, int ldw, int col_off, int K, int nblk, const float* gain, bf16* WT, int blk, int blk_stride, int row_off, LAS float* scr, int item, int lane) {
    const int kb = item / nblk, nb = item % nblk, k0 = 64 * kb, n0 = 32 * nb;
#pragma unroll 8
    for (int i = 0; i < 32; ++i) { const int kk = 2 * i + (lane >> 5); const float g = gain ? gain[k0 + kk] : 1.0f; scr[kk * 33 + (lane & 31)] = W[(size_t)(k0 + kk) * ldw + col_off + n0 + (lane & 31)] * g; }
    LDS_WAIT(); asm volatile("" ::: "memory");
    const int c = lane & 7;
#pragma unroll
    for (int j = 0; j < 4; ++j) { const int nl = (lane >> 3) + 8 * j, n = n0 + nl; const LAS float* s = scr + (8 * c) * 33 + nl;
        u32x4 o; o.x = pk2(s[0 * 33], s[1 * 33]); o.y = pk2(s[2 * 33], s[3 * 33]); o.z = pk2(s[4 * 33], s[5 * 33]); o.w = pk2(s[6 * 33], s[7 * 33]);
        const int drow = (n / blk) * blk_stride + (n % blk) + row_off;
        *(u32x4*)(WT + (size_t)drow * K + k0 + 8 * c) = o; }
    LDS_WAIT(); asm volatile("" ::: "memory");
}
__device__ __forceinline__ void convert_matrix(const float* W, int ldw, int col_off, int K, int N, const float* gain, bf16* WT, int blk, int blk_stride, int row_off, LAS float* scr, int gw, int NGW, int lane) {
    const int nblk = N / 32, nitems = (K / 64) * nblk;
    for (int it = gw; it < nitems; it += NGW) transpose_item(W, ldw, col_off, K, nblk, gain, WT, blk, blk_stride, row_off, scr, it, lane);
}
__device__ __forceinline__ void rowprep_row(const float* x, bf16* xb, float* rstd, const float* Wba, float* ba, int row, int lane) {
    const f32x4* xr = (const f32x4*)(x + (size_t)row * D) + lane;
    f32x4 v[8]; float ss = 0.f;
#pragma unroll
    for (int j = 0; j < 8; ++j) { v[j] = xr[64 * j]; ss += (v[j][0] * v[j][0] + v[j][1] * v[j][1]) + (v[j][2] * v[j][2] + v[j][3] * v[j][3]); }
    ss = wave_sum(ss, lane);
    const float rs = 1.0f / sqrtf(ss * (1.0f / D) + EPS);
    u32x2* o = (u32x2*)(xb + (size_t)row * D) + lane;
#pragma unroll
    for (int j = 0; j < 8; ++j) { u32x2 w; w.x = pk2(v[j][0], v[j][1]); w.y = pk2(v[j][2], v[j][3]); o[64 * j] = w; }
    if (lane == 0) rstd[row] = rs;
    if (Wba) {
        for (int c = 0; c < 16; ++c) { const f32x4* wr = (const f32x4*)(Wba + (size_t)c * D) + lane; float a = 0.f;
#pragma unroll
            for (int j = 0; j < 8; ++j) { const f32x4 w = wr[64 * j]; a += (v[j][0] * w[0] + v[j][1] * w[1]) + (v[j][2] * w[2] + v[j][3] * w[3]); }
            a = wave_sum(a, lane); if (lane == 0) ba[(size_t)row * 16 + c] = a * rs; }
    }
}
__device__ __forceinline__ void lru_conv_elem(const bf16* proj, const float* cw, const float* cb, float* xc, size_t idx) {
    const int t = (int)(idx / DLRU), ch = (int)(idx % DLRU), s = t % SEQ;
    float a = cb[ch];
#pragma unroll
    for (int k = 0; k < 4; ++k) { const int sp = s - 3 + k; if (sp >= 0) a += cw[k * DLRU + ch] * bf2f(proj[(size_t)(t - 3 + k) * NPROJ + ch]); }
    xc[idx] = a;
}
__device__ __forceinline__ void lru_gate_elem(const float* xc, const float* w_r, const float* b_r, const float* w_i, const float* b_i, const float* lam, float* av, float* bv, size_t idx) {
    const int t = (int)(idx / DLRU), ch = (int)(idx % DLRU), n = ch >> 7, d = ch & 127;
    float ar = b_r[ch], ai = b_i[ch];
    const float* xr = xc + (size_t)t * DLRU + n * 128; const float* wr = w_r + (size_t)n * 128 * 128 + d; const float* wi = w_i + (size_t)n * 128 * 128 + d;
    for (int c = 0; c < 128; ++c) { const float xv = xr[c]; ar += xv * wr[c * 128]; ai += xv * wi[c * 128]; }
    const float r = sigmoid_f(ar), ig = sigmoid_f(ai);
    const float log_a = -8.0f * r * softplus_f(-lam[ch]);
    const float a = expf(log_a), mult = sqrtf(-expm1f(2.0f * log_a));
    av[idx] = a; bv[idx] = mult * (ig * xc[idx]);
}
__device__ __forceinline__ void lru_scan_chan(float* av, const float* bv, const bf16* proj, int idx) {
    const int b = idx / DLRU, ch = idx % DLRU;
    float h = 0.f;
    for (int s0 = 0; s0 < SEQ; s0 += 8) {
        float a8[8], b8[8], g8[8];
#pragma unroll
        for (int j = 0; j < 8; ++j) { const size_t t = (size_t)b * SEQ + s0 + j; a8[j] = av[t * DLRU + ch]; b8[j] = bv[t * DLRU + ch]; g8[j] = bf2f(proj[t * NPROJ + DLRU + ch]); }
#pragma unroll
        for (int j = 0; j < 8; ++j) { const size_t t = (size_t)b * SEQ + s0 + j; h = a8[j] * h + b8[j]; av[t * DLRU + ch] = h * gelu_tanh_f(g8[j]); }
    }
}
__device__ __forceinline__ void lru_norm_row(const float* y, const float* gain, bf16* ymix, int row, int lane) {
    const f32x4* yr = (const f32x4*)(y + (size_t)row * DLRU) + lane; const f32x4* gr = (const f32x4*)gain + lane;
    f32x4 v[4]; float ss = 0.f;
#pragma unroll
    for (int j = 0; j < 4; ++j) { v[j] = yr[64 * j]; ss += (v[j][0] * v[j][0] + v[j][1] * v[j][1]) + (v[j][2] * v[j][2] + v[j][3] * v[j][3]); }
    ss = wave_sum(ss, lane); const float rs = 1.0f / sqrtf(ss * (1.0f / DLRU) + EPS);
    u32x2* o = (u32x2*)(ymix + (size_t)row * D) + lane;
#pragma unroll
    for (int j = 0; j < 4; ++j) { const f32x4 g = gr[64 * j]; u32x2 w; w.x = pk2(v[j][0] * rs * g[0], v[j][1] * rs * g[1]); w.y = pk2(v[j][2] * rs * g[2], v[j][3] * rs * g[3]); o[64 * j] = w; }
}
__device__ __forceinline__ void dn_prep_item(const bf16* proj, const float* cw, const float* ba, const float* a_log, const float* dt_bias, float* qn, float* kn, float* vn, float* beta, float* gg, int w, int lane) {
    const int t = w >> 3, h = w & 7, s = t % SEQ;
    float val[3][2];
#pragma unroll
    for (int p = 0; p < 3; ++p)
#pragma unroll
        for (int e = 0; e < 2; ++e) { const int d = lane * 2 + e, c = p * DDN + h * HD + d; float a = 0.f;
#pragma unroll
            for (int k = 0; k < 4; ++k) { const int sp = s - 3 + k; if (sp >= 0) a += cw[k * 3 * DDN + c] * bf2f(proj[(size_t)(t - 3 + k) * NPROJ + 2048 + c]); }
            val[p][e] = silu_f(a); }
    const float sq = wave_sum(val[0][0] * val[0][0] + val[0][1] * val[0][1], lane), sk = wave_sum(val[1][0] * val[1][0] + val[1][1] * val[1][1], lane);
    const float rq = (1.0f / sqrtf(sq + EPS)) * 0.08838834764831845f, rk = 1.0f / sqrtf(sk + EPS);
    const size_t o = ((size_t)t * NH + h) * HD + lane * 2;
    qn[o] = val[0][0] * rq; qn[o + 1] = val[0][1] * rq; kn[o] = val[1][0] * rk; kn[o + 1] = val[1][1] * rk; vn[o] = val[2][0]; vn[o + 1] = val[2][1];
    if (lane == 0) { beta[t * NH + h] = sigmoid_f(ba[(size_t)t * 16 + h]); gg[t * NH + h] = -__expf(a_log[h]) * softplus_f(ba[(size_t)t * 16 + 8 + h] + dt_bias[h]); }
}
__device__ __forceinline__ void dn_rec_seq(const float* qn, const float* kn, const float* vn, const float* beta, const float* gg, float* o, int bh, LAS float* sk, LAS float* sq, LAS float* st, int tid) {
    const int b = bh >> 3, h = bh & 7, j = tid & 127; const bool act = tid < 128;
    if (act) for (int k = 0; k < 128; ++k) st[k * 128 + j] = 0.f;
    const size_t base = ((size_t)(b * SEQ) * NH + h) * HD;
    float nk = kn[base + j], nq = qn[base + j], nv = vn[base + j], nb = beta[(b * SEQ) * NH + h], ng = gg[(b * SEQ) * NH + h];
    for (int s = 0; s < SEQ; ++s) {
        const int buf = (s & 1) * 128;
        if (act) { sk[buf + j] = nk; sq[buf + j] = nq; }
        const float vj = nv, be = nb, ge = __expf(ng);
        __syncthreads();
        if (act) {
            if (s + 1 < SEQ) { const size_t nb_ = ((size_t)(b * SEQ + s + 1) * NH + h) * HD; nk = kn[nb_ + j]; nq = qn[nb_ + j]; nv = vn[nb_ + j]; nb = beta[(b * SEQ + s + 1) * NH + h]; ng = gg[(b * SEQ + s + 1) * NH + h]; }
            float ks = 0.f;
#pragma unroll 8
            for (int k = 0; k < 128; ++k) ks += sk[buf + k] * st[k * 128 + j];
            const float vnew = be * (vj - ge * ks);
            float oo = 0.f;
#pragma unroll 8
            for (int k = 0; k < 128; ++k) { const float sv = ge * st[k * 128 + j] + sk[buf + k] * vnew; st[k * 128 + j] = sv; oo += sq[buf + k] * sv; }
            o[((size_t)(b * SEQ + s) * NH + h) * HD + j] = oo;
        }
    }
    __syncthreads();
}
typedef short bf16x8 __attribute__((ext_vector_type(8)));
__device__ __forceinline__ f32x4 mfma16(bf16x8 a, bf16x8 b, f32x4 c) { return __builtin_amdgcn_mfma_f32_16x16x32_bf16(a, b, c, 0, 0, 0); }
__device__ __forceinline__ float bflo(unsigned x) { return __uint_as_float(x << 16); }
__device__ __forceinline__ float bfhi(unsigned x) { return __uint_as_float(x & 0xffff0000u); }
constexpr int DA_G = 0, DA_KN = 1024, DA_QN = DA_KN + 17408, DA_VBT = DA_QN + 17408, DA_KBET = DA_VBT + 18432, DA_KDT = DA_KBET + 18432, DA_L = DA_KDT + 18432, DA_TB = DA_L + 16384, DA_QK = DA_TB + 9216, DA_END = DA_QK + 9216;
static_assert(DA_END <= RING_BYTES, "DN-A LDS map");
__device__ __forceinline__ void dna_unit(const bf16* proj, const float* cw, const float* ba, const float* a_log, const float* dt_bias,
                                         bf16* Wf, bf16* Qf, bf16* KdTf, bf16* QKf, bf16* Uf, float* glb, int uid, LAS unsigned char* lds, int tid, int lane, int wave) {
    const int h = uid & 7, n = (uid >> 3) & 127, b = uid >> 10, t0 = b * SEQ + n * 64;
    asm volatile("" : "+v"(lds));
    LAS float* Gs = (LAS float*)(lds + DA_G);
    const int fr = lane & 15, fq = lane >> 4;
    if (wave == 0) {
        const size_t t = (size_t)(t0 + lane);
        const float be = sigmoid_f(ba[t * 16 + h]); float Gc = -__expf(a_log[h]) * softplus_f(ba[t * 16 + 8 + h] + dt_bias[h]);
#pragma unroll
        for (int off = 1; off < 64; off <<= 1) { const float tmp = shfl_up_l(Gc, off, lane); if (lane >= off) Gc += tmp; }
        const float GL = shfl_idx_l(Gc, 63);
        Gs[lane] = Gc; Gs[64 + lane] = be; Gs[128 + lane] = __expf(Gc); Gs[192 + lane] = __expf(GL - Gc);
        if (lane == 63) glb[uid] = __expf(Gc);
    }
    __syncthreads();
    {
        const int r = tid >> 3, cg = tid & 7;
        const float be = Gs[64 + r], eg = Gs[128 + r], egl = Gs[192 + r];
        float val[3][16];
#pragma unroll
        for (int p = 0; p < 3; ++p) {
            const int ccol = p * DDN + h * HD + cg * 16;
            float acc[16];
#pragma unroll
            for (int i = 0; i < 16; ++i) acc[i] = 0.f;
#pragma unroll
            for (int k = 0; k < 4; ++k) { const int row = r - 3 + k;
                if (n * 64 + row >= 0) {
                    const bf16* src = proj + (size_t)(t0 + row) * NPROJ + 2048 + ccol;
                    const u32x4 x0 = *(const u32x4*)src, x1 = *(const u32x4*)(src + 8);
                    const float* wp = cw + k * 3 * DDN + ccol;
                    const f32x4 w0 = *(const f32x4*)wp, w1 = *(const f32x4*)(wp + 4), w2 = *(const f32x4*)(wp + 8), w3 = *(const f32x4*)(wp + 12);
                    acc[0] += w0[0] * bflo(x0.x); acc[1] += w0[1] * bfhi(x0.x); acc[2] += w0[2] * bflo(x0.y); acc[3] += w0[3] * bfhi(x0.y);
                    acc[4] += w1[0] * bflo(x0.z); acc[5] += w1[1] * bfhi(x0.z); acc[6] += w1[2] * bflo(x0.w); acc[7] += w1[3] * bfhi(x0.w);
                    acc[8] += w2[0] * bflo(x1.x); acc[9] += w2[1] * bfhi(x1.x); acc[10] += w2[2] * bflo(x1.y); acc[11] += w2[3] * bfhi(x1.y);
                    acc[12] += w3[0] * bflo(x1.z); acc[13] += w3[1] * bfhi(x1.z); acc[14] += w3[2] * bflo(x1.w); acc[15] += w3[3] * bfhi(x1.w);
                } }
#pragma unroll
            for (int i = 0; i < 16; ++i) val[p][i] = silu_f(acc[i]);
        }
        float sq = 0.f, sk = 0.f;
#pragma unroll
        for (int i = 0; i < 16; ++i) { sq += val[0][i] * val[0][i]; sk += val[1][i] * val[1][i]; }
        sq += shfl_xor_l(sq, 1, lane); sq += shfl_xor_l(sq, 2, lane); sq += shfl_xor_l(sq, 4, lane);
        sk += shfl_xor_l(sk, 1, lane); sk += shfl_xor_l(sk, 2, lane); sk += shfl_xor_l(sk, 4, lane);
        const float rq = (1.0f / sqrtf(sq + EPS)) * 0.08838834764831845f, rk = 1.0f / sqrtf(sk + EPS);
#pragma unroll
        for (int i = 0; i < 16; ++i) { val[0][i] *= rq; val[1][i] *= rk; }
        u32x4 o0, o1;
        o0.x = pk2(val[1][0], val[1][1]); o0.y = pk2(val[1][2], val[1][3]); o0.z = pk2(val[1][4], val[1][5]); o0.w = pk2(val[1][6], val[1][7]);
        o1.x = pk2(val[1][8], val[1][9]); o1.y = pk2(val[1][10], val[1][11]); o1.z = pk2(val[1][12], val[1][13]); o1.w = pk2(val[1][14], val[1][15]);
        *(LAS u32x4*)(lds + DA_KN + r * 272 + cg * 32) = o0; *(LAS u32x4*)(lds + DA_KN + r * 272 + cg * 32 + 16) = o1;
        o0.x = pk2(val[0][0], val[0][1]); o0.y = pk2(val[0][2], val[0][3]); o0.z = pk2(val[0][4], val[0][5]); o0.w = pk2(val[0][6], val[0][7]);
        o1.x = pk2(val[0][8], val[0][9]); o1.y = pk2(val[0][10], val[0][11]); o1.z = pk2(val[0][12], val[0][13]); o1.w = pk2(val[0][14], val[0][15]);
        *(LAS u32x4*)(lds + DA_QN + r * 272 + cg * 32) = o0; *(LAS u32x4*)(lds + DA_QN + r * 272 + cg * 32 + 16) = o1;
#pragma unroll
        for (int i = 0; i < 16; ++i) { const int f = cg * 16 + i;
            *(LAS unsigned short*)(lds + DA_VBT + f * 144 + r * 2) = (unsigned short)f2bf(val[2][i] * be);
            *(LAS unsigned short*)(lds + DA_KBET + f * 144 + r * 2) = (unsigned short)f2bf(val[1][i] * (be * eg));
            *(LAS unsigned short*)(lds + DA_KDT + f * 144 + r * 2) = (unsigned short)f2bf(val[1][i] * egl); }
    }
    __syncthreads();
    {
        const int p = wave >> 2, ti = wave & 3;
        const int abase = p == 0 ? DA_KN : DA_QN;
        bf16x8 af[4];
#pragma unroll
        for (int ks = 0; ks < 4; ++ks) af[ks] = *(const LAS bf16x8*)(lds + abase + (ti * 16 + fr) * 272 + (ks * 32 + fq * 8) * 2);
        for (int tj = 0; tj < 4; ++tj) {
            f32x4 acc = {0.f, 0.f, 0.f, 0.f};
            if (tj <= ti) {
#pragma unroll
                for (int ks = 0; ks < 4; ++ks) { const bf16x8 bb = *(const LAS bf16x8*)(lds + DA_KN + (tj * 16 + fr) * 272 + (ks * 32 + fq * 8) * 2); acc = mfma16(af[ks], bb, acc); }
            }
            const int j = tj * 16 + fr; const float Gj = Gs[j];
#pragma unroll
            for (int r = 0; r < 4; ++r) { const int i = ti * 16 + fq * 4 + r; float v = 0.f;
                if (p == 0) { if (i > j) v = Gs[64 + i] * acc[r] * __expf(Gs[i] - Gj); *(LAS float*)(lds + DA_L + (i * 64 + j) * 4) = v; }
                else { if (i >= j) v = acc[r] * __expf(Gs[i] - Gj); *(LAS unsigned short*)(lds + DA_QK + i * 144 + j * 2) = (unsigned short)f2bf(v); } }
        }
    }
    __syncthreads();
    if (wave == 0) {
        float Tc[64]; int lc = lane; asm volatile("" : "+v"(lc)); const float fl = (float)lc;
#pragma unroll
        for (int i = 0; i < 64; ++i) {
            float a = fmaxf(0.f, 1.f - fabsf(fl - (float)i));
            const LAS float* Lr = (const LAS float*)(lds + DA_L) + i * 64;
#pragma unroll
            for (int j = 0; j < i; ++j) a -= Lr[j] * Tc[j];
            Tc[i] = a;
        }
#pragma unroll
        for (int i = 0; i < 64; ++i) *(LAS unsigned short*)(lds + DA_TB + i * 144 + lc * 2) = (unsigned short)f2bf(Tc[i]);
    } else {
        for (int fi = wave - 1; fi < 40; fi += 7) {
            if (fi < 8) { const int mt = fi >> 1, ks = fi & 1;
                const u32x4 v = *(const LAS u32x4*)(lds + DA_QK + (mt * 16 + fr) * 144 + (ks * 32 + fq * 8) * 2);
                *(u32x4*)(QKf + (((size_t)uid * 4 + mt) * 2 + ks) * 512 + lane * 8) = v; }
            else if (fi < 24) { const int f2 = fi - 8, mt = f2 >> 2, ks = f2 & 3; const float eg = Gs[128 + mt * 16 + fr];
                const u32x4 v = *(const LAS u32x4*)(lds + DA_QN + (mt * 16 + fr) * 272 + (ks * 32 + fq * 8) * 2); u32x4 o;
                o.x = pk2(bflo(v.x) * eg, bfhi(v.x) * eg); o.y = pk2(bflo(v.y) * eg, bfhi(v.y) * eg); o.z = pk2(bflo(v.z) * eg, bfhi(v.z) * eg); o.w = pk2(bflo(v.w) * eg, bfhi(v.w) * eg);
                *(u32x4*)(Qf + (((size_t)uid * 4 + mt) * 4 + ks) * 512 + lane * 8) = o; }
            else { const int f2 = fi - 24, ft = f2 >> 1, ks = f2 & 1;
                const u32x4 v = *(const LAS u32x4*)(lds + DA_KDT + (ft * 16 + fr) * 144 + (ks * 32 + fq * 8) * 2);
                *(u32x4*)(KdTf + (((size_t)uid * 8 + ft) * 2 + ks) * 512 + lane * 8) = v; }
        }
    }
    __syncthreads();
    {
        bf16x8 ta[4][2];
#pragma unroll
        for (int mt = 0; mt < 4; ++mt)
#pragma unroll
            for (int ks = 0; ks < 2; ++ks) ta[mt][ks] = *(const LAS bf16x8*)(lds + DA_TB + (mt * 16 + fr) * 144 + (ks * 32 + fq * 8) * 2);
#pragma unroll
        for (int c2 = 0; c2 < 2; ++c2) { const int ct = wave * 2 + c2, img = ct < 8 ? DA_VBT : DA_KBET, cr = (ct & 7) * 16 + fr;
            bf16x8 bb[2];
#pragma unroll
            for (int ks = 0; ks < 2; ++ks) bb[ks] = *(const LAS bf16x8*)(lds + img + cr * 144 + (ks * 32 + fq * 8) * 2);
#pragma unroll
            for (int mt = 0; mt < 4; ++mt) { f32x4 acc = {0.f, 0.f, 0.f, 0.f};
#pragma unroll
                for (int ks = 0; ks < 2; ++ks) acc = mfma16(ta[mt][ks], bb[ks], acc);
                if (ct < 8) { u32x2 o; o.x = pk2(acc[0], acc[1]); o.y = pk2(acc[2], acc[3]); *(u32x2*)(Uf + ((((size_t)uid * 8 + ct) * 4 + mt) * 64 + lane) * 4) = o; }
                else { const int f = (ct - 8) * 16 + fr;
#pragma unroll
                    for (int r = 0; r < 4; ++r) *(LAS unsigned short*)(lds + DA_KN + (mt * 16 + fq * 4 + r) * 272 + f * 2) = (unsigned short)f2bf(acc[r]); } }
        }
    }
    __syncthreads();
#pragma unroll
    for (int q2 = 0; q2 < 2; ++q2) { const int fi = wave * 2 + q2, mt = fi >> 2, ks = fi & 3;
        const u32x4 v = *(const LAS u32x4*)(lds + DA_KN + (mt * 16 + fr) * 272 + (ks * 32 + fq * 8) * 2);
        *(u32x4*)(Wf + (((size_t)uid * 4 + mt) * 4 + ks) * 512 + lane * 8) = v; }
    __syncthreads();
}
struct DnbFrag { bf16x8 a1[4]; bf16x8 a2[2]; bf16x8 kd[2]; u32x2 u; float gl; };
__device__ __forceinline__ DnbFrag dnb_load(const bf16* A1, const bf16* QKf, const bf16* KdTf, const bf16* Uf, const float* glb, int uid, int ds, int wave, int lane) {
    DnbFrag f; const int mt = wave & 3;
#pragma unroll
    for (int ks = 0; ks < 4; ++ks) f.a1[ks] = *(const bf16x8*)(A1 + (((size_t)uid * 4 + mt) * 4 + ks) * 512 + lane * 8);
#pragma unroll
    for (int ks = 0; ks < 2; ++ks) f.kd[ks] = *(const bf16x8*)(KdTf + (((size_t)uid * 8 + wave) * 2 + ks) * 512 + lane * 8);
    if (wave >= 4) {
#pragma unroll
        for (int ks = 0; ks < 2; ++ks) f.a2[ks] = *(const bf16x8*)(QKf + (((size_t)uid * 4 + mt) * 2 + ks) * 512 + lane * 8);
        f.u = (u32x2){0u, 0u};
    } else {
        f.a2[0] = f.a1[0]; f.a2[1] = f.a1[1];
        f.u = *(const u32x2*)(Uf + ((((size_t)uid * 8 + ds) * 4 + mt) * 64 + lane) * 4);
    }
    f.gl = glb[uid];
    return f;
}
__device__ __forceinline__ void dnb_run(const bf16* Wf, const bf16* Qf, const bf16* KdTf, const bf16* QKf, const bf16* Uf, const float* glb, float* o, int bh, int ds, LAS unsigned char* lds, int tid, int lane, int wave) {
    const int b = bh >> 3, h = bh & 7, fr = lane & 15, fq = lane >> 4, mt = wave & 3;
    asm volatile("" : "+v"(lds));
    LAS unsigned char* ST = lds; LAS unsigned char* VNT = lds + 4608;
    for (int i = tid; i < 4608 / 4; i += 512) ((LAS unsigned*)ST)[i] = 0u;
    f32x4 accS = {0.f, 0.f, 0.f, 0.f};
    const bf16* A1 = wave < 4 ? Wf : Qf;
    DnbFrag nx = dnb_load(A1, QKf, KdTf, Uf, glb, (b * 128 + 0) * 8 + h, ds, wave, lane);
    __syncthreads();
    for (int n = 0; n < 128; ++n) {
        const DnbFrag cu = nx;
        if (n + 1 < 128) nx = dnb_load(A1, QKf, KdTf, Uf, glb, (b * 128 + n + 1) * 8 + h, ds, wave, lane);
        f32x4 acc = {0.f, 0.f, 0.f, 0.f};
#pragma unroll
        for (int ks = 0; ks < 4; ++ks) { const bf16x8 sb = *(const LAS bf16x8*)(ST + fr * 272 + (ks * 32 + fq * 8) * 2); acc = mfma16(cu.a1[ks], sb, acc); }
        if (wave < 4) {
            const float v0 = bflo(cu.u.x) - acc[0], v1 = bfhi(cu.u.x) - acc[1], v2 = bflo(cu.u.y) - acc[2], v3 = bfhi(cu.u.y) - acc[3];
            u32x2 w; w.x = pk2(v0, v1); w.y = pk2(v2, v3);
            *(LAS u32x2*)(VNT + fr * 144 + (mt * 16 + fq * 4) * 2) = w;
        }
        __syncthreads();
        bf16x8 vb[2];
#pragma unroll
        for (int ks = 0; ks < 2; ++ks) vb[ks] = *(const LAS bf16x8*)(VNT + fr * 144 + (ks * 32 + fq * 8) * 2);
        if (wave >= 4) {
#pragma unroll
            for (int ks = 0; ks < 2; ++ks) acc = mfma16(cu.a2[ks], vb[ks], acc);
            const size_t ob = ((size_t)(b * SEQ + n * 64 + mt * 16 + fq * 4) * NH + h) * HD + ds * 16 + fr;
#pragma unroll
            for (int r = 0; r < 4; ++r) o[ob + (size_t)r * NH * HD] = acc[r];
        }
        accS = accS * cu.gl;
#pragma unroll
        for (int ks = 0; ks < 2; ++ks) accS = mfma16(cu.kd[ks], vb[ks], accS);
        { u32x2 w; w.x = pk2(accS[0], accS[1]); w.y = pk2(accS[2], accS[3]); *(LAS u32x2*)(ST + fr * 272 + (wave * 16 + fq * 4) * 2) = w; }
        __syncthreads();
    }
}
constexpr int LA_XB = 0, LA_XF = 17408, LA_END = LA_XF + 64 * 132 * 4;
static_assert(LA_END <= RING_BYTES, "LRU-A LDS map");
__device__ __forceinline__ void lrua_unit(const bf16* proj, const float* cw, const float* cb, const bf16* WrT, const bf16* WiT, const float* b_r, const float* b_i, const float* lam,
                                          float* Hloc, float* Acum, float* summ, int unit, LAS unsigned char* lds, int tid, int lane, int wave) {
    const int nb = unit & 7, ct = unit >> 3, n = ct & 127, t0 = ct * 64;
    asm volatile("" : "+v"(lds));
    {
        const int r = tid >> 3, cg = tid & 7, ch0 = nb * 128 + cg * 16;
        float acc[16];
        { const f32x4 c0v = *(const f32x4*)(cb + ch0), c1v = *(const f32x4*)(cb + ch0 + 4), c2v = *(const f32x4*)(cb + ch0 + 8), c3v = *(const f32x4*)(cb + ch0 + 12);
#pragma unroll
          for (int i = 0; i < 4; ++i) { acc[i] = c0v[i]; acc[4 + i] = c1v[i]; acc[8 + i] = c2v[i]; acc[12 + i] = c3v[i]; } }
#pragma unroll
        for (int k = 0; k < 4; ++k) { const int row = r - 3 + k;
            if (n * 64 + row >= 0) {
                const bf16* src = proj + (size_t)(t0 + row) * NPROJ + ch0;
                const u32x4 x0 = *(const u32x4*)src, x1 = *(const u32x4*)(src + 8);
                const float* wp = cw + k * DLRU + ch0;
                const f32x4 w0 = *(const f32x4*)wp, w1 = *(const f32x4*)(wp + 4), w2 = *(const f32x4*)(wp + 8), w3 = *(const f32x4*)(wp + 12);
                acc[0] += w0[0] * bflo(x0.x); acc[1] += w0[1] * bfhi(x0.x); acc[2] += w0[2] * bflo(x0.y); acc[3] += w0[3] * bfhi(x0.y);
                acc[4] += w1[0] * bflo(x0.z); acc[5] += w1[1] * bfhi(x0.z); acc[6] += w1[2] * bflo(x0.w); acc[7] += w1[3] * bfhi(x0.w);
                acc[8] += w2[0] * bflo(x1.x); acc[9] += w2[1] * bfhi(x1.x); acc[10] += w2[2] * bflo(x1.y); acc[11] += w2[3] * bfhi(x1.y);
                acc[12] += w3[0] * bflo(x1.z); acc[13] += w3[1] * bfhi(x1.z); acc[14] += w3[2] * bflo(x1.w); acc[15] += w3[3] * bfhi(x1.w);
            } }
        u32x4 o0, o1;
        o0.x = pk2(acc[0], acc[1]); o0.y = pk2(acc[2], acc[3]); o0.z = pk2(acc[4], acc[5]); o0.w = pk2(acc[6], acc[7]);
        o1.x = pk2(acc[8], acc[9]); o1.y = pk2(acc[10], acc[11]); o1.z = pk2(acc[12], acc[13]); o1.w = pk2(acc[14], acc[15]);
        *(LAS u32x4*)(lds + LA_XB + r * 272 + cg * 32) = o0; *(LAS u32x4*)(lds + LA_XB + r * 272 + cg * 32 + 16) = o1;
        LAS f32x4* xf = (LAS f32x4*)(lds + LA_XF + (r * 132 + cg * 16) * 4);
        xf[0] = (f32x4){acc[0], acc[1], acc[2], acc[3]}; xf[1] = (f32x4){acc[4], acc[5], acc[6], acc[7]}; xf[2] = (f32x4){acc[8], acc[9], acc[10], acc[11]}; xf[3] = (f32x4){acc[12], acc[13], acc[14], acc[15]};
    }
    __syncthreads();
    const int fr = lane & 15, fq = lane >> 4, cl = wave * 16 + fr, ch = nb * 128 + cl;
    bf16x8 br[4], bi[4];
#pragma unroll
    for (int ks = 0; ks < 4; ++ks) { br[ks] = *(const bf16x8*)(WrT + ((size_t)nb * 128 + cl) * 128 + ks * 32 + fq * 8); bi[ks] = *(const bf16x8*)(WiT + ((size_t)nb * 128 + cl) * 128 + ks * 32 + fq * 8); }
    f32x4 ar[4], ai[4];
#pragma unroll
    for (int mt = 0; mt < 4; ++mt) { ar[mt] = (f32x4){0.f, 0.f, 0.f, 0.f}; ai[mt] = (f32x4){0.f, 0.f, 0.f, 0.f};
#pragma unroll
        for (int ks = 0; ks < 4; ++ks) { const bf16x8 af = *(const LAS bf16x8*)(lds + LA_XB + (mt * 16 + fr) * 272 + (ks * 32 + fq * 8) * 2); ar[mt] = mfma16(af, br[ks], ar[mt]); ai[mt] = mfma16(af, bi[ks], ai[mt]); } }
    const float brr = b_r[ch], bii = b_i[ch], sp8 = -8.0f * softplus_f(-lam[ch]);
    float Ac = 1.f, Bc = 0.f;
#pragma unroll
    for (int mt = 0; mt < 4; ++mt) {
        float P[4], H[4];
#pragma unroll
        for (int r = 0; r < 4; ++r) { const int t = mt * 16 + fq * 4 + r; const float xcv = *(const LAS float*)(lds + LA_XF + (t * 132 + cl) * 4);
            const float rr = sigmoid_f(ar[mt][r] + brr), ii = sigmoid_f(ai[mt][r] + bii), la = sp8 * rr, a = __expf(la), bb = sqrtf(-expm1f(2.0f * la)) * (ii * xcv);
            if (r == 0) { P[0] = a; H[0] = bb; } else { P[r] = P[r - 1] * a; H[r] = a * H[r - 1] + bb; } }
        float Ai = P[3], Bi = H[3];
        { const float Au = shfl_up_l(Ai, 16, lane), Bu = shfl_up_l(Bi, 16, lane); if (fq >= 1) { Bi = Ai * Bu + Bi; Ai = Au * Ai; } }
        { const float Au = shfl_up_l(Ai, 32, lane), Bu = shfl_up_l(Bi, 32, lane); if (fq >= 2) { Bi = Ai * Bu + Bi; Ai = Au * Ai; } }
        float Ae = shfl_up_l(Ai, 16, lane), Be = shfl_up_l(Bi, 16, lane); if (fq == 0) { Ae = 1.f; Be = 0.f; }
        const float At = shfl_idx_l(Ai, 48 + fr), Bt = shfl_idx_l(Bi, 48 + fr);
        const float PA = Ac * Ae, PB = Ae * Bc + Be;
#pragma unroll
        for (int r = 0; r < 4; ++r) { const size_t o = (size_t)(t0 + mt * 16 + fq * 4 + r) * DLRU + ch; Acum[o] = PA * P[r]; Hloc[o] = P[r] * PB + H[r]; }
        Bc = At * Bc + Bt; Ac = Ac * At;
    }
    if (fq == 0) { float* sp = summ + ((size_t)ct * DLRU + ch) * 2; sp[0] = Ac; sp[1] = Bc; }
    __syncthreads();
}
__device__ __forceinline__ void lru_carry(const float* summ, float* carry, int idx) {
    const int b = idx >> 10, ch = idx & 1023; float c = 0.f;
    for (int n0 = 0; n0 < 128; n0 += 8) { float A[8], B[8];
#pragma unroll
        for (int j = 0; j < 8; ++j) { const float* sp = summ + ((size_t)(b * 128 + n0 + j) * DLRU + ch) * 2; A[j] = sp[0]; B[j] = sp[1]; }
#pragma unroll
        for (int j = 0; j < 8; ++j) { carry[(size_t)(b * 128 + n0 + j) * DLRU + ch] = c; c = A[j] * c + B[j]; } }
}
__device__ __forceinline__ void lrub_row(const float* Hloc, const float* Acum, const float* carry, const bf16* proj, const float* gain, bf16* ymix, int row, int lane) {
    const int ct = row >> 6; f32x4 y[4]; float ss = 0.f;
#pragma unroll
    for (int j = 0; j < 4; ++j) { const int c4 = lane * 4 + 256 * j;
        const f32x4 hl = *(const f32x4*)(Hloc + (size_t)row * DLRU + c4), ac = *(const f32x4*)(Acum + (size_t)row * DLRU + c4), cr = *(const f32x4*)(carry + (size_t)ct * DLRU + c4);
        const u32x2 g = *(const u32x2*)(proj + (size_t)row * NPROJ + DLRU + c4);
        const f32x4 hh = hl + ac * cr;
        y[j][0] = hh[0] * gelu_tanh_f(bflo(g.x)); y[j][1] = hh[1] * gelu_tanh_f(bfhi(g.x)); y[j][2] = hh[2] * gelu_tanh_f(bflo(g.y)); y[j][3] = hh[3] * gelu_tanh_f(bfhi(g.y));
        ss += (y[j][0] * y[j][0] + y[j][1] * y[j][1]) + (y[j][2] * y[j][2] + y[j][3] * y[j][3]); }
    ss = wave_sum(ss, lane); const float rs = 1.0f / sqrtf(ss * (1.0f / DLRU) + EPS);
#pragma unroll
    for (int j = 0; j < 4; ++j) { const int c4 = lane * 4 + 256 * j; const f32x4 g = *(const f32x4*)(gain + c4); u32x2 w; w.x = pk2(y[j][0] * rs * g[0], y[j][1] * rs * g[1]); w.y = pk2(y[j][2] * rs * g[2], y[j][3] * rs * g[3]);
        *(u32x2*)(ymix + (size_t)row * D + c4) = w; }
}
__device__ __forceinline__ void dn_out_item(const float* o, const float* gain, const bf16* proj, bf16* ymix, int w, int lane) {
    const int t = w >> 3, h = w & 7;
    const size_t ob = ((size_t)t * NH + h) * HD + lane * 2;
    const float o0 = o[ob], o1 = o[ob + 1];
    const float ss = wave_sum(o0 * o0 + o1 * o1, lane), rs = 1.0f / sqrtf(ss * (1.0f / HD) + EPS);
    const int c = h * HD + lane * 2;
    const float g0 = bf2f(proj[(size_t)t * NPROJ + 5120 + c]), g1 = bf2f(proj[(size_t)t * NPROJ + 5120 + c + 1]);
    *(unsigned*)(ymix + (size_t)t * D + DLRU + c) = pk2(o0 * rs * gain[lane * 2] * silu_f(g0), o1 * rs * gain[lane * 2 + 1] * silu_f(g1));
}
__device__ __forceinline__ void route_row(const float* x, const float* rstd, const float* gain, const float* router, float* roww, int row, int lane) {
    float acc[8];
#pragma unroll
    for (int e = 0; e < 8; ++e) acc[e] = 0.f;
    for (int j = 0; j < 32; ++j) { const int k = lane + 64 * j; const float xv = x[(size_t)row * D + k] * gain[k]; const f32x4 r0 = *(const f32x4*)(router + (size_t)k * 8), r1 = *(const f32x4*)(router + (size_t)k * 8 + 4);
        acc[0] += xv * r0[0]; acc[1] += xv * r0[1]; acc[2] += xv * r0[2]; acc[3] += xv * r0[3]; acc[4] += xv * r1[0]; acc[5] += xv * r1[1]; acc[6] += xv * r1[2]; acc[7] += xv * r1[3]; }
    const float rs = rstd[row];
#pragma unroll
    for (int e = 0; e < 8; ++e) acc[e] = wave_sum(acc[e], lane) * rs;
    int e1 = 0; float l1 = acc[0];
#pragma unroll
    for (int e = 1; e < 8; ++e) if (acc[e] > l1) { l1 = acc[e]; e1 = e; }
    int e2 = -1; float l2 = -3.4e38f;
#pragma unroll
    for (int e = 0; e < 8; ++e) if (e != e1 && acc[e] > l2) { l2 = acc[e]; e2 = e; }
    const float w1 = 1.0f / (1.0f + __expf(l2 - l1)), w2 = 1.0f - w1;
    if (lane < 8) roww[(size_t)lane * T + row] = lane == e1 ? w1 : (lane == e2 ? w2 : 0.0f);
}
__device__ __forceinline__ void final_row(const float* x, const float* gain, float* out, int row, int lane) {
    const f32x4* xr = (const f32x4*)(x + (size_t)row * D) + lane; const f32x4* gr = (const f32x4*)gain + lane;
    f32x4 v[8]; float ss = 0.f;
#pragma unroll
    for (int j = 0; j < 8; ++j) { v[j] = xr[64 * j]; ss += (v[j][0] * v[j][0] + v[j][1] * v[j][1]) + (v[j][2] * v[j][2] + v[j][3] * v[j][3]); }
    ss = wave_sum(ss, lane); const float rs = 1.0f / sqrtf(ss * (1.0f / D) + EPS);
    f32x4* o = (f32x4*)(out + (size_t)row * D) + lane;
#pragma unroll
    for (int j = 0; j < 8; ++j) o[64 * j] = v[j] * rs * gr[64 * j];
}

struct Args { const float* in[25]; float* out; unsigned char* ws; int ph_lo, ph_hi; };
typedef const __attribute__((address_space(4))) unsigned long long* kaptr_t;
__device__ __forceinline__ unsigned long long ldka(int i) { kaptr_t ka = (kaptr_t)__builtin_amdgcn_kernarg_segment_ptr(); asm volatile("" : "+s"(i)); return ka[i]; }
__device__ __forceinline__ const float* ldin(const Args&, int i) { return (const float*)ldka(i); }
__device__ __forceinline__ unsigned char* ldws(const Args&) { return (unsigned char*)ldka(26); }
__device__ __forceinline__ float* ldout(const Args&) { return (float*)ldka(25); }
__global__ void __launch_bounds__(512, 2) mega(Args args) {
    extern __shared__ __attribute__((aligned(16))) unsigned char lds_raw[];
    LAS unsigned char* lds = (LAS unsigned char*)lds_raw;
    volatile LAS unsigned* MISC = (volatile LAS unsigned*)(lds + MISC_OFF);
    const int tid = threadIdx.x;
    const int G = gridDim.x, bid = blockIdx.x, NGW = G * 8;
    const size_t NGT = (size_t)G * 512;
    unsigned char* ws = ldws(args);
    for (int u = tid; u < (LDS_BYTES - LDSCTL_OFF) / 4; u += 512) ((LAS unsigned*)(lds + LDSCTL_OFF))[u] = 0u;
    __syncthreads();
    XcdBarrier bar = xcd_barrier_post((unsigned*)(ws + WS_CTL) + CW_BAR, MISC + 8);
    const int lo = args.ph_lo, hi = args.ph_hi;
#define RUN(id) (lo <= (id) && (id) < hi)
#define SEAM(id) do { if (RUN(id) && (id) + 1 < hi) xcd_barrier(bar); } while (0)
#define INP(i) ldin(args, (i))
#define WSP(off) (ldws(args) + (off))
#define x_in INP(0)
#define norm_mix INP(1)
#define w_in INP(2)
#define conv_lru_w INP(3)
#define conv_lru_b INP(4)
#define lru_w_r INP(5)
#define lru_b_r INP(6)
#define lru_w_i INP(7)
#define lru_b_i INP(8)
#define lru_lambda INP(9)
#define lru_out_norm INP(10)
#define conv_qkv_w INP(11)
#define dn_a_log INP(12)
#define dn_dt_bias INP(13)
#define dn_out_norm INP(14)
#define w_out INP(15)
#define norm_ffn INP(16)
#define ffn_w_gate INP(17)
#define ffn_w_up INP(18)
#define ffn_w_down INP(19)
#define moe_router INP(20)
#define moe_w_gate INP(21)
#define moe_w_up INP(22)
#define moe_w_down INP(23)
#define norm_final INP(24)
#define xres (ldout(args))
#define Win ((bf16*)WSP(WS_WIN))
#define Wba ((float*)WSP(WS_WBA))
#define Wout ((bf16*)WSP(WS_WOUT))
#define Wgu ((bf16*)WSP(WS_WGU))
#define Wd ((bf16*)WSP(WS_WD))
#define Mgu ((bf16*)WSP(WS_MGU))
#define Md ((bf16*)WSP(WS_MD))
#define xb ((bf16*)WSP(WS_XB))
#define rstd ((float*)WSP(WS_RSTD))
#define ba ((float*)WSP(WS_BA))
#define beta ((float*)WSP(WS_BETA))
#define gg ((float*)WSP(WS_G))
#define roww ((float*)WSP(WS_ROWW))
#define proj ((bf16*)WSP(WS_PROJ))
#define hid ((bf16*)WSP(WS_PROJ))
#define ymix ((bf16*)WSP(WS_YMIX))
#define c0 ((float*)WSP(WS_C))
#define c1 ((float*)WSP(WS_C + (size_t)T * 1024 * 4))
#define c2 ((float*)WSP(WS_C + (size_t)2 * T * 1024 * 4))
#define c3 ((float*)WSP(WS_C + (size_t)3 * T * 1024 * 4))
#define LRU_WRT ((bf16*)WSP(WS_WRT))
#define LRU_WIT ((bf16*)WSP(WS_WRT + (size_t)2 * 8 * 128 * 128 * 2))
#define LRU_H ((float*)WSP(WS_C + (size_t)256 * MiB))
#define LRU_A ((float*)WSP(WS_C + (size_t)320 * MiB))
#define LRU_SUMM ((float*)WSP(WS_C + (size_t)384 * MiB))
#define LRU_CARRY ((float*)WSP(WS_C + (size_t)386 * MiB))
#define DN_WF ((bf16*)WSP(WS_C))
#define DN_QF ((bf16*)WSP(WS_C + (size_t)32 * MiB))
#define DN_KDTF ((bf16*)WSP(WS_C + (size_t)64 * MiB))
#define DN_UF ((bf16*)WSP(WS_C + (size_t)96 * MiB))
#define DN_QKF ((bf16*)WSP(WS_C + (size_t)128 * MiB))
#define DN_GL ((float*)WSP(WS_C + (size_t)144 * MiB))
    const int BIG = 1 << 30;
    int ph = 0;
#define PHL int tid_ = threadIdx.x; asm volatile("" : "+v"(tid_)); const int lane_ = tid_ & 63; int bid_ = blockIdx.x; asm volatile("" : "+s"(bid_)); const int gw_ = bid_ * 8 + __builtin_amdgcn_readfirstlane(tid_ >> 6); const size_t gt_ = (size_t)bid_ * 512 + tid_; LAS float* scr = (LAS float*)(lds + (gw_ & 7) * 16384);
    if (RUN(ph)) { PHL
        for (int l = 0; l < 2; ++l) {
            convert_matrix(w_in + (size_t)l * D * DIN, DIN, 0, D, NPROJ, norm_mix + l * D, Win + (size_t)l * NPROJ * D, BIG, 0, 0, scr, gw_, NGW, lane_);
            convert_matrix(w_out + (size_t)l * D * D, D, 0, D, D, nullptr, Wout + (size_t)l * D * D, BIG, 0, 0, scr, gw_, NGW, lane_);
            for (size_t i = gt_; i < (size_t)16 * D; i += NGT) { const int j = (int)(i / D), k = (int)(i % D); Wba[(size_t)l * 16 * D + i] = w_in[(size_t)l * D * DIN + (size_t)k * DIN + NPROJ + j] * norm_mix[l * D + k]; }
        }
        for (int m = 0; m < 16; ++m) {
            convert_matrix(lru_w_r + (size_t)m * 128 * 128, 128, 0, 128, 128, nullptr, LRU_WRT + (size_t)m * 128 * 128, BIG, 0, 0, scr, gw_, NGW, lane_);
            convert_matrix(lru_w_i + (size_t)m * 128 * 128, 128, 0, 128, 128, nullptr, LRU_WIT + (size_t)m * 128 * 128, BIG, 0, 0, scr, gw_, NGW, lane_); }
        convert_matrix(ffn_w_gate, DFF, 0, D, DFF, norm_ffn, Wgu, 128, 256, 0, scr, gw_, NGW, lane_);
        convert_matrix(ffn_w_up, DFF, 0, D, DFF, norm_ffn, Wgu, 128, 256, 128, scr, gw_, NGW, lane_);
        convert_matrix(ffn_w_down, D, 0, DFF, D, nullptr, Wd, BIG, 0, 0, scr, gw_, NGW, lane_);
    }
    SEAM(ph); ++ph;
    int xsel = 0;
#define xcur (xsel ? (const float*)xres : x_in)
    for (int l = 0; l < 2; ++l) {
        if (RUN(ph)) { PHL for (int r = gw_; r < T; r += NGW) rowprep_row(xcur, xb, rstd, Wba + (size_t)l * 16 * D, ba, r, lane_); }
        SEAM(ph); ++ph;
        if (RUN(ph)) { pg8::Gemm g{xb, Win + (size_t)l * NPROJ * D, T, NPROJ, D, 0}; pg8::StaticOrder S; S.init(T, NPROJ, G, bid); pg8::EpiScaleBf16 E{proj, rstd, NPROJ, 0};
            pg8::gemm_phase<pg8::EpiScaleBf16, pg8::StaticOrder, true, true>(lds, g, S, E); }
        SEAM(ph); ++ph;
        if (RUN(ph)) { PHL
            for (int u = bid_; u < 2048; u += G) lrua_unit(proj, conv_lru_w + (size_t)l * 4 * DLRU, conv_lru_b + l * DLRU, LRU_WRT + (size_t)l * 8 * 128 * 128, LRU_WIT + (size_t)l * 8 * 128 * 128, lru_b_r + l * DLRU, lru_b_i + l * DLRU, lru_lambda + l * DLRU, LRU_H, LRU_A, LRU_SUMM, u, lds, tid_, lane_, gw_ & 7);
            for (int uid = bid_; uid < 2048; uid += G) dna_unit(proj, conv_qkv_w + (size_t)l * 4 * 3 * DDN, ba, dn_a_log + l * NH, dn_dt_bias + l * NH, DN_WF, DN_QF, DN_KDTF, DN_QKF, DN_UF, DN_GL, uid, lds, tid_, lane_, gw_ & 7); }
        SEAM(ph); ++ph;
        if (RUN(ph)) { PHL
            if (bid_ < 128) dnb_run(DN_WF, DN_QF, DN_KDTF, DN_QKF, DN_UF, DN_GL, c3, (bid_ & 7) + 8 * (bid_ >> 6), (bid_ >> 3) & 7, lds, tid_, lane_, gw_ & 7);
            else if (bid_ < 136 && tid_ < 256) lru_carry(LRU_SUMM, LRU_CARRY, (bid_ - 128) * 256 + tid_); }
        SEAM(ph); ++ph;
        if (RUN(ph)) { PHL
            for (int r = gw_; r < T; r += NGW) lrub_row(LRU_H, LRU_A, LRU_CARRY, proj, lru_out_norm + l * DLRU, ymix, r, lane_);
            for (int w = gw_; w < T * NH; w += NGW) dn_out_item(c3, dn_out_norm + l * HD, proj, ymix, w, lane_); }
        SEAM(ph); ++ph;
        if (RUN(ph)) { pg8::Gemm g{ymix, Wout + (size_t)l * D * D, T, D, D, 0}; pg8::StaticOrder S; S.init(T, D, G, bid); pg8::EpiResidual E{xcur, xres, nullptr, D, 0};
            pg8::gemm_phase<pg8::EpiResidual, pg8::StaticOrder, true, true>(lds, g, S, E); }
        SEAM(ph); ++ph;
        xsel = 1;
        if (RUN(ph)) { PHL for (int r = gw_; r < T; r += NGW) rowprep_row(xcur, xb, rstd, nullptr, nullptr, r, lane_); }
        SEAM(ph); ++ph;
        if (l == 1) { if (RUN(ph)) { PHL for (int r = gw_; r < T; r += NGW) route_row(xcur, rstd, norm_ffn + D, moe_router, roww, r, lane_); } }
        SEAM(ph); ++ph;
        const int ne = l == 0 ? 1 : NEXP, dff = l == 0 ? DFF : DFFE;
        for (int e = 0; e < ne; ++e) {
            if (l == 1) { if (RUN(ph)) { PHL
                convert_matrix(moe_w_gate + (size_t)e * D * DFFE, DFFE, 0, D, DFFE, norm_ffn + D, Mgu, 128, 256, 0, scr, gw_, NGW, lane_);
                convert_matrix(moe_w_up + (size_t)e * D * DFFE, DFFE, 0, D, DFFE, norm_ffn + D, Mgu, 128, 256, 128, scr, gw_, NGW, lane_);
                convert_matrix(moe_w_down + (size_t)e * DFFE * D, D, 0, DFFE, D, nullptr, Md, BIG, 0, 0, scr, gw_, NGW, lane_); } }
            SEAM(ph); ++ph;
            if (RUN(ph)) { pg8::Gemm g{xb, l == 0 ? Wgu : Mgu, T, 2 * dff, D, 0}; pg8::StaticOrder S; S.init(T, 2 * dff, G, bid); pg8::EpiSwiGLU E{hid, rstd, dff, 0};
                pg8::gemm_phase<pg8::EpiSwiGLU, pg8::StaticOrder, true, true>(lds, g, S, E); }
            SEAM(ph); ++ph;
            if (RUN(ph)) { pg8::Gemm g{hid, l == 0 ? Wd : Md, T, D, dff, 0}; pg8::StaticOrder S; S.init(T, D, G, bid); pg8::EpiResidual E{xcur, xres, l == 0 ? nullptr : roww + (size_t)e * T, D, 0};
                pg8::gemm_phase<pg8::EpiResidual, pg8::StaticOrder, true, true>(lds, g, S, E); }
            SEAM(ph); ++ph;
        }
    }
    if (RUN(ph)) { PHL for (int r = gw_; r < T; r += NGW) final_row(xcur, norm_final, xres, r, lane_); }
#undef RUN
#undef SEAM
}

extern "C" void kernel_launch(void* const* d_in, const int* in_sizes, int n_in, void* d_out, int out_size, void* d_ws, size_t ws_size, hipStream_t stream) {
    static int grid = 0;
    if (grid == 0) {
        if (n_in != 25 || ws_size < WS_END) { fprintf(stderr, "kernel_launch: unexpected n_in %d / ws_size %zu (need %zu)\n", n_in, ws_size, (size_t)WS_END); grid = -1; return; }
        int dev = 0, cus = 0, per_cu = 0;
        if (hipGetDevice(&dev) != hipSuccess || hipDeviceGetAttribute(&cus, hipDeviceAttributeMultiprocessorCount, dev) != hipSuccess) { grid = -1; return; }
        if (hipFuncSetAttribute((const void*)mega, hipFuncAttributeMaxDynamicSharedMemorySize, LDS_BYTES) != hipSuccess) { fprintf(stderr, "kernel_launch: hipFuncSetAttribute failed\n"); grid = -1; return; }
        if (hipOccupancyMaxActiveBlocksPerMultiprocessor(&per_cu, (const void*)mega, 512, LDS_BYTES) != hipSuccess || per_cu < 1) { fprintf(stderr, "kernel_launch: occupancy query says %d\n", per_cu); }
        (void)hipGetLastError();
        grid = cus;
    }
    if (grid < 0) return;
    if (hipMemsetAsync((char*)d_ws + WS_CTL, 0, CTL_ZERO_BYTES, stream) != hipSuccess) return;
    Args a{};
    for (int i = 0; i < 25; ++i) a.in[i] = (const float*)d_in[i];
    a.out = (float*)d_out; a.ws = (unsigned char*)d_ws; a.ph_lo = 0; a.ph_hi = 1 << 30;
    hipLaunchKernelGGL(mega, dim3(grid), dim3(512), LDS_BYTES, stream, a);
}
```

```cpp
#include <hip/hip_runtime.h>
#include <cstdio>
#include <cstdint>
namespace pg8 {
#define PG8_LAS __attribute__((address_space(3)))
typedef unsigned short bf16_t;
typedef short bf16x8 __attribute__((ext_vector_type(8)));
typedef float f32x4 __attribute__((ext_vector_type(4)));
typedef unsigned u32x4 __attribute__((ext_vector_type(4)));
constexpr int BM = 256, BK = 64, HALF = 128, HTB = HALF * BK * 2  , STAGE_BYTES = 8 * HTB, NXCD = 8, WGM = 8;

__host__ __device__ __forceinline__ int lds_byte(int r, int c) { const int st = (r >> 4) * 2 + (c >> 5), rr = r & 15, cc = c & 31, ob = rr * 64 + cc * 2; return st * 1024 + (ob ^ (((ob >> 9) & 1) << 5)); }
__host__ __device__ __forceinline__ void stage_rc(int b, int& R, int& C) { const int st = b / 1024, sb = b % 1024, swz = sb ^ (((sb >> 9) & 1) << 5); R = (st >> 1) * 16 + swz / 64; C = (st & 1) * 32 + (swz % 64) / 2; }
__host__ __device__ __forceinline__ int perm32(int rho) { const int n = rho >> 4, i = rho & 15; return 8 * (i >> 2) + 4 * n + (i & 3); }

struct Unit { int pm, pn, pb, lbase, nvalid; };
struct Gemm { const bf16_t* A; const bf16_t* Bt; int M, N, K, pad; };

struct StaticOrder {
    int nM, nN, nwg, G, c;
    __host__ __device__ void init(int M, int N, int G_, int c_) { nM = M / BM; nN = N / BM; nwg = nM * nN; G = G_; c = c_; }
    __host__ __device__ bool next(int i, Unit& u) const {
        const long L = (long)i * G + c; if (L >= nwg) return false;
        int wgid = (int)L; { const int q = nwg / NXCD, r = nwg % NXCD, xcd = wgid % NXCD, off = wgid / NXCD; wgid = (xcd < r ? xcd * (q + 1) : r * (q + 1) + (xcd - r) * q) + off; }
        const int nig = WGM * nN, gid = wgid / nig, fm = gid * WGM, gsz = (nM - fm) < WGM ? (nM - fm) : WGM;
        u.pm = fm + ((wgid % nig) % gsz); u.pn = (wgid % nig) / gsz; u.pb = u.pn; u.lbase = 0; u.nvalid = BM; return true;
    }
    __device__ __forceinline__ int arow(const Unit&, int) const { return 0; }
    __device__ __forceinline__ void a_ready(const Unit&) const {}
    __device__ __forceinline__ void done(const Unit&) const {}
};


__device__ __forceinline__ unsigned cvt_pk_bf16(float lo, float hi) { unsigned r; asm volatile("v_cvt_pk_bf16_f32 %0, %1, %2" : "=v"(r) : "v"(lo), "v"(hi)); return r; }
__device__ __forceinline__ float silu_f(float x) { return x / (1.0f + __expf(-x)); }

struct EpiScaleBf16 {
    static constexpr bool PERM = true, AFTER_DRAIN = false;
    bf16_t* O; const float* rs; int ldc; int pad;
    __device__ __forceinline__ void operator()(const f32x4 (&acc)[2][2][4][2], const Unit& u, int wr, int wc, int fr, int fq) const {
        const int row0 = u.pm * BM + wr * 64 + fr, col0 = u.pn * BM + wc * 32 + 8 * fq;
#pragma unroll
        for (int ai = 0; ai < 2; ++ai)
#pragma unroll
            for (int m = 0; m < 4; ++m) { const int r = row0 + ai * HALF + m * 16; const float s = rs[r]; bf16_t* rowp = O + (size_t)r * ldc + col0;
#pragma unroll
                for (int bj = 0; bj < 2; ++bj) { const f32x4 v0 = acc[ai][bj][m][0] * s, v1 = acc[ai][bj][m][1] * s;
                    u32x4 w; w.x = cvt_pk_bf16(v0[0], v0[1]); w.y = cvt_pk_bf16(v0[2], v0[3]); w.z = cvt_pk_bf16(v1[0], v1[1]); w.w = cvt_pk_bf16(v1[2], v1[3]);
                    *(u32x4*)(rowp + bj * HALF) = w; } }
    }
};
struct EpiSwiGLU {
    static constexpr bool PERM = true, AFTER_DRAIN = false;
    bf16_t* O; const float* rs; int ldc; int pad;
    __device__ __forceinline__ void operator()(const f32x4 (&acc)[2][2][4][2], const Unit& u, int wr, int wc, int fr, int fq) const {
        const int row0 = u.pm * BM + wr * 64 + fr, col0 = u.pn * HALF + wc * 32 + 8 * fq;
#pragma unroll
        for (int ai = 0; ai < 2; ++ai)
#pragma unroll
            for (int m = 0; m < 4; ++m) { const int r = row0 + ai * HALF + m * 16; const float s = rs ? rs[r] : 1.0f; bf16_t* rowp = O + (size_t)r * ldc + col0;
                f32x4 h0, h1;
#pragma unroll
                for (int j = 0; j < 4; ++j) { h0[j] = silu_f(acc[ai][0][m][0][j] * s) * (acc[ai][1][m][0][j] * s); h1[j] = silu_f(acc[ai][0][m][1][j] * s) * (acc[ai][1][m][1][j] * s); }
                u32x4 w; w.x = cvt_pk_bf16(h0[0], h0[1]); w.y = cvt_pk_bf16(h0[2], h0[3]); w.z = cvt_pk_bf16(h1[0], h1[1]); w.w = cvt_pk_bf16(h1[2], h1[3]);
                *(u32x4*)rowp = w; }
    }
};
struct EpiResidual {
    static constexpr bool PERM = false, AFTER_DRAIN = false;
    const float* base; float* out; const float* roww; int ldc; int pad;
    __device__ __forceinline__ void operator()(const f32x4 (&acc)[2][2][4][2], const Unit& u, int wr, int wc, int fr, int fq) const {
        const int row0 = u.pm * BM + wr * 64 + fr, col0 = u.pn * BM + wc * 32 + 4 * fq;
#pragma unroll
        for (int ai = 0; ai < 2; ++ai)
#pragma unroll
            for (int m = 0; m < 4; ++m) { const int r = row0 + ai * HALF + m * 16; const float w = roww ? roww[r] : 1.0f; const size_t off = (size_t)r * ldc + col0;
#pragma unroll
                for (int bj = 0; bj < 2; ++bj)
#pragma unroll
                    for (int n = 0; n < 2; ++n) { const f32x4 bs = *(const f32x4*)(base + off + bj * HALF + n * 16); *(f32x4*)(out + off + bj * HALF + n * 16) = bs + acc[ai][bj][m][n] * w; } }
    }
};

struct EpiSwiGLUMoe {
    static constexpr bool PERM = true, AFTER_DRAIN = false;
    bf16_t* O; const float* rs; const int* list; int ldc; int pad;
    __device__ __forceinline__ void operator()(const f32x4 (&acc)[2][2][4][2], const Unit& u, int wr, int wc, int fr, int fq) const {
        const int rl0 = wr * 64 + fr, col0 = u.pn * HALF + wc * 32 + 8 * fq;
#pragma unroll
        for (int ai = 0; ai < 2; ++ai)
#pragma unroll
            for (int m = 0; m < 4; ++m) { const int rl = rl0 + ai * HALF + m * 16; const int tok = rl < u.nvalid ? (list[u.lbase + rl] & 0xffff) : 0; const float s = rs[tok];
                bf16_t* rowp = O + (size_t)(u.pm * BM + rl) * ldc + col0;
                f32x4 h0, h1;
#pragma unroll
                for (int j = 0; j < 4; ++j) { h0[j] = silu_f(acc[ai][0][m][0][j] * s) * (acc[ai][1][m][0][j] * s); h1[j] = silu_f(acc[ai][0][m][1][j] * s) * (acc[ai][1][m][1][j] * s); }
                u32x4 w; w.x = cvt_pk_bf16(h0[0], h0[1]); w.y = cvt_pk_bf16(h0[2], h0[3]); w.z = cvt_pk_bf16(h1[0], h1[1]); w.w = cvt_pk_bf16(h1[2], h1[3]);
                *(u32x4*)rowp = w; }
    }
};
struct EpiMoeDown {
    static constexpr bool PERM = true, AFTER_DRAIN = false;
    bf16_t* Y0; bf16_t* Y1; const int* list; const float* lw; int ldc; int pad;
    __device__ __forceinline__ void operator()(const f32x4 (&acc)[2][2][4][2], const Unit& u, int wr, int wc, int fr, int fq) const {
        const int rl0 = wr * 64 + fr, col0 = u.pn * BM + wc * 32 + 8 * fq;
#pragma unroll
        for (int ai = 0; ai < 2; ++ai)
#pragma unroll
            for (int m = 0; m < 4; ++m) { const int rl = rl0 + ai * HALF + m * 16;
                if (rl < u.nvalid) { const int en = list[u.lbase + rl]; const float w = lw[u.lbase + rl]; bf16_t* rowp = ((en >> 16) ? Y1 : Y0) + (size_t)(en & 0xffff) * ldc + col0;
#pragma unroll
                    for (int bj = 0; bj < 2; ++bj) { const f32x4 v0 = acc[ai][bj][m][0] * w, v1 = acc[ai][bj][m][1] * w;
                        u32x4 o; o.x = cvt_pk_bf16(v0[0], v0[1]); o.y = cvt_pk_bf16(v0[2], v0[3]); o.z = cvt_pk_bf16(v1[0], v1[1]); o.w = cvt_pk_bf16(v1[2], v1[3]);
                        *(u32x4*)(rowp + bj * HALF) = o; } } }
    }
};
template <class Epi, class Sched, bool ALIGN_EPI = false, bool GATHER = false>
__device__ __forceinline__ void gemm_phase(PG8_LAS unsigned char* lds, const Gemm g, const Sched& S, const Epi& E) {
    int tid_o = threadIdx.x; asm volatile("" : "+v"(tid_o));
    const int tid = tid_o, wid = __builtin_amdgcn_readfirstlane(tid >> 6), lane = tid & 63, wr = wid >> 2, wc = wid & 3, fr = lane & 15, fq = lane >> 4;
    const int K = g.K, nt = K / BK;
    const size_t kstep = (size_t)(BK * 2);
    const size_t hstep = (size_t)HALF * K * 2;
    const size_t tstep = 2 * hstep;
    unsigned voffA[2], voffB[2], oA[2][2], oN[2][2];
#pragma unroll
    for (int i = 0; i < 2; ++i) { int R, C; stage_rc(tid * 16 + i * 8192, R, C); const int Rb = Epi::PERM ? ((R & ~31) + perm32(R & 31)) : R; voffA[i] = (unsigned)(R * K + C) * 2u; voffB[i] = (unsigned)(Rb * K + C) * 2u; }
    const unsigned ldsw = (unsigned)wid * 1024u;
    const int aoff = lds_byte(wr * 64 + fr, fq * 8), boff = lds_byte(wc * 32 + fr, fq * 8);
#define PG8_SA(b, h) (((b) * 2 + (h)) * HTB)
#define PG8_SB(b, h) ((4 + (b) * 2 + (h)) * HTB)
#define PG8_STAGE(bufoff, gbase, voff) do { _Pragma("unroll") for (int _i = 0; _i < 2; ++_i) \
        __builtin_amdgcn_global_load_lds((const unsigned*)((const char*)(gbase) + (voff)[_i]), (PG8_LAS unsigned*)(lds + (bufoff) + ldsw + _i * 8192), 16, 0, 0); } while (0)
#define PG8_LDA(dst, b, h) do { _Pragma("unroll") for (int m = 0; m < 4; ++m) _Pragma("unroll") for (int k = 0; k < 2; ++k) dst[m][k] = *(const PG8_LAS bf16x8*)(lds + PG8_SA(b, h) + aoff + m * 2048 + k * 1024); } while (0)
#define PG8_LDB(dst, b, h) do { _Pragma("unroll") for (int n = 0; n < 2; ++n) _Pragma("unroll") for (int k = 0; k < 2; ++k) dst[n][k] = *(const PG8_LAS bf16x8*)(lds + PG8_SB(b, h) + boff + n * 2048 + k * 1024); } while (0)
#define PG8_MMA(ai, bj, At, Bt) do { __builtin_amdgcn_s_setprio(1); _Pragma("unroll") for (int m = 0; m < 4; ++m) _Pragma("unroll") for (int n = 0; n < 2; ++n) _Pragma("unroll") for (int k = 0; k < 2; ++k) \
        acc[ai][bj][m][n] = __builtin_amdgcn_mfma_f32_16x16x32_bf16(Bt[n][k], At[m][k], acc[ai][bj][m][n], 0, 0, 0); __builtin_amdgcn_s_setprio(0); } while (0)
#define PG8_WAIT_V(n) asm volatile("s_waitcnt vmcnt(" #n ")" ::: "memory")
#define PG8_WAIT_L(n) asm volatile("s_waitcnt lgkmcnt(" #n ")" ::: "memory")
#define PG8_BAR __builtin_amdgcn_s_barrier()
#define PG8_SCHED __builtin_amdgcn_sched_barrier(0)
#define PG8_AOFF(dst, u) do { _Pragma("unroll") for (int _i = 0; _i < 2; ++_i) { int _R, _C; stage_rc(tid * 16 + _i * 8192, _R, _C); _Pragma("unroll") for (int _h = 0; _h < 2; ++_h) \
        dst[_h][_i] = (unsigned)(S.arow(u, _h * HALF + _R) * K + _C) * 2u; } } while (0)
#define PG8_STAGE_A(bufoff, gbase, h, usenext) do { _Pragma("unroll") for (int _i = 0; _i < 2; ++_i) { const unsigned _o = GATHER ? ((usenext) ? oN[h][_i] : oA[h][_i]) : voffA[_i]; \
        __builtin_amdgcn_global_load_lds((const unsigned*)((const char*)(gbase) + (GATHER ? (size_t)0 : (size_t)(h) * hstep) + _o), (PG8_LAS unsigned*)(lds + (bufoff) + ldsw + _i * 8192), 16, 0, 0); } } while (0)
    Unit cur, nxt; int ui = 0;
    if (!S.next(0, cur)) return;
    f32x4 acc[2][2][4][2];
#pragma unroll
    for (int a = 0; a < 2; ++a)
#pragma unroll
        for (int b = 0; b < 2; ++b)
#pragma unroll
            for (int m = 0; m < 4; ++m)
#pragma unroll
                for (int n = 0; n < 2; ++n) acc[a][b][m][n] = (f32x4){0.f, 0.f, 0.f, 0.f};
    bf16x8 At[4][2], B0[2][2], B1[2][2];
    const char* cA = (const char*)g.A + (GATHER ? (size_t)0 : (size_t)cur.pm * tstep); const char* cB = (const char*)g.Bt + (size_t)cur.pb * tstep;
    S.a_ready(cur);
    if constexpr (GATHER) { PG8_AOFF(oA, cur); PG8_WAIT_V(0); }
    PG8_STAGE(PG8_SB(0, 0), cB, voffB); PG8_STAGE(PG8_SB(0, 1), cB + hstep, voffB); PG8_STAGE_A(PG8_SA(0, 0), cA, 0, false); PG8_STAGE_A(PG8_SA(0, 1), cA, 1, false);
    if (wr == 1) PG8_BAR;
    PG8_WAIT_V(2); PG8_BAR;
    PG8_STAGE(PG8_SB(1, 0), cB + kstep, voffB); PG8_STAGE_A(PG8_SA(1, 0), cA + kstep, 0, false); PG8_STAGE(PG8_SB(1, 1), cB + hstep + kstep, voffB);
    PG8_WAIT_V(6); PG8_BAR;
    for (;;) {
        const bool has_next = S.next(ui + 1, nxt);
        const char* nA = has_next ? (const char*)g.A + (GATHER ? (size_t)0 : (size_t)nxt.pm * tstep) : cA; const char* nB = has_next ? (const char*)g.Bt + (size_t)nxt.pb * tstep : cB;
        if constexpr (GATHER) { if (has_next) { PG8_AOFF(oN, nxt); } else {
#pragma unroll
            for (int _h = 0; _h < 2; ++_h) { oN[_h][0] = oA[_h][0]; oN[_h][1] = oA[_h][1]; } } }
        for (int t = 0; t < nt; t += 2) {
            const bool last = (t == nt - 2);
            const char* a1 = cA + (size_t)(t + 1) * kstep;
            const char* a2 = last ? nA : cA + (size_t)(t + 2) * kstep; const char* b2 = last ? nB : cB + (size_t)(t + 2) * kstep;
            const char* a3 = a2 + kstep; const char* b3 = b2 + kstep;
            if (last && has_next) S.a_ready(nxt);
            PG8_LDB(B0, 0, 0); PG8_LDB(B1, 0, 1); PG8_SCHED; PG8_LDA(At, 0, 0); PG8_STAGE_A(PG8_SA(1, 1), a1, 1, false);
            PG8_WAIT_V(8); PG8_WAIT_L(0); PG8_BAR; PG8_MMA(0, 0, At, B0); PG8_MMA(0, 1, At, B1); PG8_BAR; PG8_SCHED;
            PG8_LDA(At, 0, 1); PG8_STAGE(PG8_SB(0, 0), b2, voffB); PG8_STAGE(PG8_SB(0, 1), b2 + hstep, voffB); PG8_STAGE_A(PG8_SA(0, 0), a2, 0, last);
            PG8_WAIT_V(8); PG8_WAIT_L(0); PG8_BAR; PG8_MMA(1, 0, At, B0); PG8_MMA(1, 1, At, B1); PG8_BAR; PG8_SCHED;
            PG8_LDB(B0, 1, 0); PG8_LDB(B1, 1, 1); PG8_SCHED; PG8_LDA(At, 1, 0); PG8_STAGE_A(PG8_SA(0, 1), a2, 1, last);
            PG8_WAIT_V(8); PG8_WAIT_L(0); PG8_BAR; PG8_MMA(0, 0, At, B0); PG8_MMA(0, 1, At, B1); PG8_BAR; PG8_SCHED;
            PG8_LDA(At, 1, 1); PG8_STAGE(PG8_SB(1, 0), b3, voffB); PG8_STAGE(PG8_SB(1, 1), b3 + hstep, voffB); PG8_STAGE_A(PG8_SA(1, 0), a3, 0, last);
            PG8_WAIT_V(8); PG8_WAIT_L(0); PG8_BAR; PG8_MMA(1, 0, At, B0); PG8_MMA(1, 1, At, B1); PG8_BAR; PG8_SCHED;
        }
        if constexpr (ALIGN_EPI) { if (wr == 0) PG8_BAR; }
        E(acc, cur, wr, wc, fr, fq); S.done(cur);
        if (!has_next) break;
#pragma unroll
        for (int a = 0; a < 2; ++a)
#pragma unroll
            for (int b = 0; b < 2; ++b)
#pragma unroll
                for (int m = 0; m < 4; ++m)
#pragma unroll
                    for (int n = 0; n < 2; ++n) acc[a][b][m][n] = (f32x4){0.f, 0.f, 0.f, 0.f};
        cur = nxt; cA = nA; cB = nB; ++ui;
        if constexpr (GATHER) {
#pragma unroll
            for (int _h = 0; _h < 2; ++_h) { oA[_h][0] = oN[_h][0]; oA[_h][1] = oN[_h][1]; } }
        if constexpr (ALIGN_EPI) { if (wr == 1) PG8_BAR; }
    }
    PG8_WAIT_V(0);
    if constexpr (!ALIGN_EPI) { if (wr == 0) PG8_BAR; }
    PG8_BAR;
#undef PG8_SA
#undef PG8_SB
#undef PG8_STAGE
#undef PG8_LDA
#undef PG8_LDB
#undef PG8_MMA
#undef PG8_WAIT_V
#undef PG8_WAIT_L
#undef PG8_BAR
#undef PG8_SCHED
#undef PG8_AOFF
#undef PG8_STAGE_A
}
}

#define GAS __attribute__((address_space(1)))
#define LAS __attribute__((address_space(3)))
#define XB_TMO      128
#define XB_XCNT(j)  (256  + 64 * (j))
#define XB_XSUB(j)  (1280 + 64 * (j))
#define XB_XGEN(j)  (2304 + 64 * (j))
#define XB_TOP      3328
#define XB_TOPGEN   3392
#define XCD_BAR_WORDS 3456
#define XB_SPIN_CAP (1u << 23)

__device__ __forceinline__ unsigned xb_ld(unsigned* p)              { return __hip_atomic_load(p, __ATOMIC_RELAXED, __HIP_MEMORY_SCOPE_AGENT); }
__device__ __forceinline__ unsigned xb_add(unsigned* p, unsigned v) { return __hip_atomic_fetch_add(p, v, __ATOMIC_RELAXED, __HIP_MEMORY_SCOPE_AGENT); }
__device__ __forceinline__ unsigned xb_xcc_id() { return (unsigned)__builtin_amdgcn_s_getreg((3 << 11) | 20) & 0xFu; }
#define XB_SPIN(cond, bar) do { unsigned _sp = 0; while (cond) { __builtin_amdgcn_s_sleep(1); \
    if ((++_sp & 255u) == 0u) { if (xb_ld(&(bar)[XB_TMO])) break; if (_sp > XB_SPIN_CAP) { atomicAdd(&(bar)[XB_TMO], 1u); break; } } } } while (0)

struct XcdBarrier {
    unsigned* bar; unsigned x;
    volatile LAS unsigned* st;
};

__device__ __forceinline__ XcdBarrier xcd_barrier_post(unsigned* bar, volatile LAS unsigned* st) {
    XcdBarrier b; b.bar = bar; b.x = xb_xcc_id(); b.st = st;
    if (threadIdx.x == 0) (void)xb_add(&bar[XB_XCNT(b.x)], 1u);
    return b;
}
__device__ __forceinline__ void xcd_barrier_complete(unsigned* bar, unsigned x, unsigned& nloc, unsigned& nx) {
    const unsigned G = gridDim.x * gridDim.y * gridDim.z;
    unsigned sum, cnt, mine, sp = 0u;
    for (;;) {
        sum = 0u; cnt = 0u; mine = 0u;
#pragma unroll
        for (unsigned j = 0; j < 16; ++j) { const unsigned c = xb_ld(&bar[XB_XCNT(j)]); sum += c; cnt += (c > 0u) ? 1u : 0u; mine = (j == x) ? c : mine; }
        if (sum == G) break;
        __builtin_amdgcn_s_sleep(1);
        if ((++sp & 255u) == 0u) { if (xb_ld(&bar[XB_TMO])) break; if (sp > XB_SPIN_CAP) { atomicAdd(&bar[XB_TMO], 1u); break; } }
    }
    nloc = mine > 0u ? mine : 1u; nx = cnt > 0u ? cnt : 1u;
}

__device__ __forceinline__ void xcd_barrier(const XcdBarrier& b) {
    asm volatile("s_waitcnt vmcnt(0)" ::: "memory");
    __syncthreads();
    if (threadIdx.x == 0) {
        unsigned* bar = b.bar; asm volatile("" : "+s"(bar));
        __builtin_amdgcn_s_waitcnt(0);
        unsigned nloc = b.st[0], nx = b.st[1];
        if (nloc == 0u) { xcd_barrier_complete(bar, b.x, nloc, nx); b.st[0] = nloc; b.st[1] = nx; }
        const unsigned old = xb_add(&bar[XB_XSUB(b.x)], 1u);
        const unsigned gen = old / nloc;
        if (old + 1u == (gen + 1u) * nloc) {
            __builtin_amdgcn_fence(__ATOMIC_RELEASE, "agent");
            asm volatile("s_waitcnt vmcnt(0)" ::: "memory");
            const unsigned og = xb_add(&bar[XB_TOP], 1u);
            const unsigned tg = og / nx;
            if (og + 1u == (tg + 1u) * nx) xb_add(&bar[XB_TOPGEN], 1u);
            else XB_SPIN(xb_ld(&bar[XB_TOPGEN]) == tg, bar);
            __builtin_amdgcn_fence(__ATOMIC_ACQUIRE, "agent");
            xb_add(&bar[XB_XGEN(b.x)], 1u);
            asm volatile("s_waitcnt vmcnt(0)" ::: "memory");
        } else {
            XB_SPIN(xb_ld(&bar[XB_XGEN(b.x)]) == gen, bar);
            __builtin_amdgcn_fence(__ATOMIC_ACQUIRE, "agent");
            asm volatile("s_waitcnt vmcnt(0)" ::: "memory");
        }
    }
    __syncthreads();
}

constexpr int T = 16384, SEQ = 8192, D = 2048, DLRU = 1024, DDN = 1024, NH = 8, HD = 128, NPROJ = 6144, DIN = 6160;
constexpr int DFF = 6144, NEXP = 8, DFFE = 3072;
constexpr float EPS = 1e-6f;
typedef unsigned short bf16;
typedef float f32x4 __attribute__((ext_vector_type(4)));
typedef unsigned u32x4 __attribute__((ext_vector_type(4)));
typedef unsigned u32x2 __attribute__((ext_vector_type(2)));
#define LDS_WAIT() asm volatile("s_waitcnt lgkmcnt(0)" ::: "memory")

__device__ __forceinline__ float bf2f(bf16 b) { return __uint_as_float(((unsigned)b) << 16); }
__device__ __forceinline__ unsigned f2bf(float f) { unsigned u = __float_as_uint(f); return (u + 0x7fffu + ((u >> 16) & 1u)) >> 16; }
__device__ __forceinline__ unsigned pk2(float lo, float hi) { return f2bf(lo) | (f2bf(hi) << 16); }
__device__ __forceinline__ float shfl_xor_l(float v, int o, int lane) { return __int_as_float(__builtin_amdgcn_ds_bpermute((lane ^ o) << 2, __float_as_int(v))); }
__device__ __forceinline__ float shfl_up_l(float v, int d, int lane) { return __int_as_float(__builtin_amdgcn_ds_bpermute((lane - d) << 2, __float_as_int(v))); }
__device__ __forceinline__ float shfl_idx_l(float v, int src) { return __int_as_float(__builtin_amdgcn_ds_bpermute(src << 2, __float_as_int(v))); }
__device__ __forceinline__ float wave_sum(float v, int lane) {
#pragma unroll
    for (int o = 1; o < 64; o <<= 1) v += shfl_xor_l(v, o, lane);
    return v;
}
using pg8::silu_f;
__device__ __forceinline__ float sigmoid_f(float x) { return 1.0f / (1.0f + __expf(-x)); }
__device__ __forceinline__ float softplus_f(float x) { return fmaxf(x, 0.0f) + log1pf(__expf(-fabsf(x))); }
__device__ __forceinline__ float gelu_tanh_f(float x) { const float u = 0.7978845608028654f * (x + 0.044715f * x * x * x); return 0.5f * x * (1.0f + tanhf(u)); }

constexpr size_t MiB = 1u << 20;
constexpr size_t al(size_t x) { return (x + MiB - 1) / MiB * MiB; }
constexpr size_t WS_CTL = 0, CTL_ZERO_BYTES = 1 * MiB;
constexpr int CW_BAR = 4096, CW_CNT = 8192;
constexpr size_t WS_WIN = 1 * MiB;
constexpr size_t WS_WBA = WS_WIN + al((size_t)2 * NPROJ * D * 2);
constexpr size_t WS_WOUT = WS_WBA + al((size_t)2 * 16 * D * 4);
constexpr size_t WS_WGU = WS_WOUT + al((size_t)2 * D * D * 2);
constexpr size_t WS_WD = WS_WGU + al((size_t)2 * DFF * D * 2);
constexpr size_t WS_XB = WS_WD + al((size_t)D * DFF * 2);
constexpr size_t WS_RSTD = WS_XB + al((size_t)T * D * 2);
constexpr size_t WS_BA = WS_RSTD + al((size_t)T * 4);
constexpr size_t WS_BETA = WS_BA + al((size_t)T * 16 * 4);
constexpr size_t WS_G = WS_BETA + al((size_t)T * 8 * 4);
constexpr size_t WS_ROWW = WS_G + al((size_t)T * 8 * 4);
constexpr int NSLOT = 2 * T + NEXP * 256;
constexpr size_t WS_PROJ = WS_ROWW + al((size_t)2 * 8 * T * 4);
constexpr size_t WS_YMIX = WS_PROJ + al((size_t)NSLOT * DFFE * 2);
constexpr size_t WS_C = WS_YMIX + al((size_t)T * D * 2);
constexpr size_t WS_WRT = WS_C + (size_t)388 * MiB;
constexpr size_t WS_END = WS_WRT + 1 * MiB;
static_assert(WS_END <= (size_t)975 * MiB, "d_ws map exceeds the guaranteed workspace");
static_assert((size_t)NEXP * (2 * DFFE * D + D * DFFE) * 2 <= (size_t)388 * MiB, "MoE bf16 weights overlay the mixer scratch");
constexpr int RING_BYTES = 131072, LDSCTL_OFF = RING_BYTES, MISC_OFF = LDSCTL_OFF + 320, LDS_BYTES = 147456;

__device__ __forceinline__ void transpose_item(const float* W, int ldw, int col_off, int K, int nblk, const float* gain, bf16* WT, int blk, int blk_stride, int row_off, LAS float* scr, int item, int lane) {
    const int kb = item / nblk, nb = item % nblk, k0 = 64 * kb, n0 = 32 * nb;
#pragma unroll 8
    for (int i = 0; i < 32; ++i) { const int kk = 2 * i + (lane >> 5); const float g = gain ? gain[k0 + kk] : 1.0f; scr[kk * 33 + (lane & 31)] = W[(size_t)(k0 + kk) * ldw + col_off + n0 + (lane & 31)] * g; }
    LDS_WAIT(); asm volatile("" ::: "memory");
    const int c = lane & 7;
#pragma unroll
    for (int j = 0; j < 4; ++j) { const int nl = (lane >> 3) + 8 * j, n = n0 + nl; const LAS float* s = scr + (8 * c) * 33 + nl;
        u32x4 o; o.x = pk2(s[0 * 33], s[1 * 33]); o.y = pk2(s[2 * 33], s[3 * 33]); o.z = pk2(s[4 * 33], s[5 * 33]); o.w = pk2(s[6 * 33], s[7 * 33]);
        const int drow = (n / blk) * blk_stride + (n % blk) + row_off;
        *(u32x4*)(WT + (size_t)drow * K + k0 + 8 * c) = o; }
    LDS_WAIT(); asm volatile("" ::: "memory");
}
__device__ __forceinline__ void convert_matrix(const float* W, int ldw, int col_off, int K, int N, const float* gain, bf16* WT, int blk, int blk_stride, int row_off, LAS float* scr, int gw, int NGW, int lane) {
    const int nblk = N / 32, nitems = (K / 64) * nblk;
    for (int it = gw; it < nitems; it += NGW) transpose_item(W, ldw, col_off, K, nblk, gain, WT, blk, blk_stride, row_off, scr, it, lane);
}
__device__ __forceinline__ void rowprep_row(const float* x, bf16* xb, float* rstd, const float* Wba, float* ba, int row, int lane) {
    const f32x4* xr = (const f32x4*)(x + (size_t)row * D) + lane;
    f32x4 v[8]; float ss = 0.f;
#pragma unroll
    for (int j = 0; j < 8; ++j) { v[j] = xr[64 * j]; ss += (v[j][0] * v[j][0] + v[j][1] * v[j][1]) + (v[j][2] * v[j][2] + v[j][3] * v[j][3]); }
    ss = wave_sum(ss, lane);
    const float rs = 1.0f / sqrtf(ss * (1.0f / D) + EPS);
    u32x2* o = (u32x2*)(xb + (size_t)row * D) + lane;
#pragma unroll
    for (int j = 0; j < 8; ++j) { u32x2 w; w.x = pk2(v[j][0], v[j][1]); w.y = pk2(v[j][2], v[j][3]); o[64 * j] = w; }
    if (lane == 0) rstd[row] = rs;
    if (Wba) {
        for (int c = 0; c < 16; ++c) { const f32x4* wr = (const f32x4*)(Wba + (size_t)c * D) + lane; float a = 0.f;
#pragma unroll
            for (int j = 0; j < 8; ++j) { const f32x4 w = wr[64 * j]; a += (v[j][0] * w[0] + v[j][1] * w[1]) + (v[j][2] * w[2] + v[j][3] * w[3]); }
            a = wave_sum(a, lane); if (lane == 0) ba[(size_t)row * 16 + c] = a * rs; }
    }
}
__device__ __forceinline__ void lru_conv_elem(const bf16* proj, const float* cw, const float* cb, float* xc, size_t idx) {
    const int t = (int)(idx / DLRU), ch = (int)(idx % DLRU), s = t % SEQ;
    float a = cb[ch];
#pragma unroll
    for (int k = 0; k < 4; ++k) { const int sp = s - 3 + k; if (sp >= 0) a += cw[k * DLRU + ch] * bf2f(proj[(size_t)(t - 3 + k) * NPROJ + ch]); }
    xc[idx] = a;
}
__device__ __forceinline__ void lru_gate_elem(const float* xc, const float* w_r, const float* b_r, const float* w_i, const float* b_i, const float* lam, float* av, float* bv, size_t idx) {
    const int t = (int)(idx / DLRU), ch = (int)(idx % DLRU), n = ch >> 7, d = ch & 127;
    float ar = b_r[ch], ai = b_i[ch];
    const float* xr = xc + (size_t)t * DLRU + n * 128; const float* wr = w_r + (size_t)n * 128 * 128 + d; const float* wi = w_i + (size_t)n * 128 * 128 + d;
    for (int c = 0; c < 128; ++c) { const float xv = xr[c]; ar += xv * wr[c * 128]; ai += xv * wi[c * 128]; }
    const float r = sigmoid_f(ar), ig = sigmoid_f(ai);
    const float log_a = -8.0f * r * softplus_f(-lam[ch]);
    const float a = expf(log_a), mult = sqrtf(-expm1f(2.0f * log_a));
    av[idx] = a; bv[idx] = mult * (ig * xc[idx]);
}
__device__ __forceinline__ void lru_scan_chan(float* av, const float* bv, const bf16* proj, int idx) {
    const int b = idx / DLRU, ch = idx % DLRU;
    float h = 0.f;
    for (int s0 = 0; s0 < SEQ; s0 += 8) {
        float a8[8], b8[8], g8[8];
#pragma unroll
        for (int j = 0; j < 8; ++j) { const size_t t = (size_t)b * SEQ + s0 + j; a8[j] = av[t * DLRU + ch]; b8[j] = bv[t * DLRU + ch]; g8[j] = bf2f(proj[t * NPROJ + DLRU + ch]); }
#pragma unroll
        for (int j = 0; j < 8; ++j) { const size_t t = (size_t)b * SEQ + s0 + j; h = a8[j] * h + b8[j]; av[t * DLRU + ch] = h * gelu_tanh_f(g8[j]); }
    }
}
__device__ __forceinline__ void lru_norm_row(const float* y, const float* gain, bf16* ymix, int row, int lane) {
    const f32x4* yr = (const f32x4*)(y + (size_t)row * DLRU) + lane; const f32x4* gr = (const f32x4*)gain + lane;
    f32x4 v[4]; float ss = 0.f;
#pragma unroll
    for (int j = 0; j < 4; ++j) { v[j] = yr[64 * j]; ss += (v[j][0] * v[j][0] + v[j][1] * v[j][1]) + (v[j][2] * v[j][2] + v[j][3] * v[j][3]); }
    ss = wave_sum(ss, lane); const float rs = 1.0f / sqrtf(ss * (1.0f / DLRU) + EPS);
    u32x2* o = (u32x2*)(ymix + (size_t)row * D) + lane;
#pragma unroll
    for (int j = 0; j < 4; ++j) { const f32x4 g = gr[64 * j]; u32x2 w; w.x = pk2(v[j][0] * rs * g[0], v[j][1] * rs * g[1]); w.y = pk2(v[j][2] * rs * g[2], v[j][3] * rs * g[3]); o[64 * j] = w; }
}
__device__ __forceinline__ void dn_prep_item(const bf16* proj, const float* cw, const float* ba, const float* a_log, const float* dt_bias, float* qn, float* kn, float* vn, float* beta, float* gg, int w, int lane) {
    const int t = w >> 3, h = w & 7, s = t % SEQ;
    float val[3][2];
#pragma unroll
    for (int p = 0; p < 3; ++p)
#pragma unroll
        for (int e = 0; e < 2; ++e) { const int d = lane * 2 + e, c = p * DDN + h * HD + d; float a = 0.f;
#pragma unroll
            for (int k = 0; k < 4; ++k) { const int sp = s - 3 + k; if (sp >= 0) a += cw[k * 3 * DDN + c] * bf2f(proj[(size_t)(t - 3 + k) * NPROJ + 2048 + c]); }
            val[p][e] = silu_f(a); }
    const float sq = wave_sum(val[0][0] * val[0][0] + val[0][1] * val[0][1], lane), sk = wave_sum(val[1][0] * val[1][0] + val[1][1] * val[1][1], lane);
    const float rq = (1.0f / sqrtf(sq + EPS)) * 0.08838834764831845f, rk = 1.0f / sqrtf(sk + EPS);
    const size_t o = ((size_t)t * NH + h) * HD + lane * 2;
    qn[o] = val[0][0] * rq; qn[o + 1] = val[0][1] * rq; kn[o] = val[1][0] * rk; kn[o + 1] = val[1][1] * rk; vn[o] = val[2][0]; vn[o + 1] = val[2][1];
    if (lane == 0) { beta[t * NH + h] = sigmoid_f(ba[(size_t)t * 16 + h]); gg[t * NH + h] = -__expf(a_log[h]) * softplus_f(ba[(size_t)t * 16 + 8 + h] + dt_bias[h]); }
}
__device__ __forceinline__ void dn_rec_seq(const float* qn, const float* kn, const float* vn, const float* beta, const float* gg, float* o, int bh, LAS float* sk, LAS float* sq, LAS float* st, int tid) {
    const int b = bh >> 3, h = bh & 7, j = tid & 127; const bool act = tid < 128;
    if (act) for (int k = 0; k < 128; ++k) st[k * 128 + j] = 0.f;
    const size_t base = ((size_t)(b * SEQ) * NH + h) * HD;
    float nk = kn[base + j], nq = qn[base + j], nv = vn[base + j], nb = beta[(b * SEQ) * NH + h], ng = gg[(b * SEQ) * NH + h];
    for (int s = 0; s < SEQ; ++s) {
        const int buf = (s & 1) * 128;
        if (act) { sk[buf + j] = nk; sq[buf + j] = nq; }
        const float vj = nv, be = nb, ge = __expf(ng);
        __syncthreads();
        if (act) {
            if (s + 1 < SEQ) { const size_t nb_ = ((size_t)(b * SEQ + s + 1) * NH + h) * HD; nk = kn[nb_ + j]; nq = qn[nb_ + j]; nv = vn[nb_ + j]; nb = beta[(b * SEQ + s + 1) * NH + h]; ng = gg[(b * SEQ + s + 1) * NH + h]; }
            float ks = 0.f;
#pragma unroll 8
            for (int k = 0; k < 128; ++k) ks += sk[buf + k] * st[k * 128 + j];
            const float vnew = be * (vj - ge * ks);
            float oo = 0.f;
#pragma unroll 8
            for (int k = 0; k < 128; ++k) { const float sv = ge * st[k * 128 + j] + sk[buf + k] * vnew; st[k * 128 + j] = sv; oo += sq[buf + k] * sv; }
            o[((size_t)(b * SEQ + s) * NH + h) * HD + j] = oo;
        }
    }
    __syncthreads();
}
typedef short bf16x8 __attribute__((ext_vector_type(8)));
__device__ __forceinline__ f32x4 mfma16(bf16x8 a, bf16x8 b, f32x4 c) { return __builtin_amdgcn_mfma_f32_16x16x32_bf16(a, b, c, 0, 0, 0); }
__device__ __forceinline__ float bflo(unsigned x) { return __uint_as_float(x << 16); }
__device__ __forceinline__ float bfhi(unsigned x) { return __uint_as_float(x & 0xffff0000u); }
constexpr int DA_G = 0, DA_KN = 1024, DA_QN = DA_KN + 17408, DA_VBT = DA_QN + 17408, DA_KBET = DA_VBT + 18432, DA_KDT = DA_KBET + 18432, DA_L = DA_KDT + 18432, DA_TB = DA_L + 16384, DA_QK = DA_TB + 9216, DA_END = DA_QK + 9216;
static_assert(DA_END <= RING_BYTES, "DN-A LDS map");
__device__ __forceinline__ void dna_unit(const bf16* proj, const float* cw, const float* ba, const float* a_log, const float* dt_bias,
                                         bf16* Wf, bf16* Qf, bf16* KdTf, bf16* QKf, bf16* Uf, float* glb, int uid, LAS unsigned char* lds, int tid, int lane, int wave) {
    const int h = uid & 7, n = (uid >> 3) & 127, b = uid >> 10, t0 = b * SEQ + n * 64;
    asm volatile("" : "+v"(lds));
    LAS float* Gs = (LAS float*)(lds + DA_G);
    const int fr = lane & 15, fq = lane >> 4;
    if (wave == 0) {
        const size_t t = (size_t)(t0 + lane);
        const float be = sigmoid_f(ba[t * 16 + h]); float Gc = -__expf(a_log[h]) * softplus_f(ba[t * 16 + 8 + h] + dt_bias[h]);
#pragma unroll
        for (int off = 1; off < 64; off <<= 1) { const float tmp = shfl_up_l(Gc, off, lane); if (lane >= off) Gc += tmp; }
        const float GL = shfl_idx_l(Gc, 63);
        Gs[lane] = Gc; Gs[64 + lane] = be; Gs[128 + lane] = __expf(Gc); Gs[192 + lane] = __expf(GL - Gc);
        if (lane == 63) glb[uid] = __expf(Gc);
    }
    __syncthreads();
    {
        const int r = tid >> 3, cg = tid & 7;
        const float be = Gs[64 + r], eg = Gs[128 + r], egl = Gs[192 + r];
        float val[3][16];
#pragma unroll
        for (int p = 0; p < 3; ++p) {
            const int ccol = p * DDN + h * HD + cg * 16;
            float acc[16];
#pragma unroll
            for (int i = 0; i < 16; ++i) acc[i] = 0.f;
#pragma unroll
            for (int k = 0; k < 4; ++k) { const int row = r - 3 + k;
                if (n * 64 + row >= 0) {
                    const bf16* src = proj + (size_t)(t0 + row) * NPROJ + 2048 + ccol;
                    const u32x4 x0 = *(const u32x4*)src, x1 = *(const u32x4*)(src + 8);
                    const float* wp = cw + k * 3 * DDN + ccol;
                    const f32x4 w0 = *(const f32x4*)wp, w1 = *(const f32x4*)(wp + 4), w2 = *(const f32x4*)(wp + 8), w3 = *(const f32x4*)(wp + 12);
                    acc[0] += w0[0] * bflo(x0.x); acc[1] += w0[1] * bfhi(x0.x); acc[2] += w0[2] * bflo(x0.y); acc[3] += w0[3] * bfhi(x0.y);
                    acc[4] += w1[0] * bflo(x0.z); acc[5] += w1[1] * bfhi(x0.z); acc[6] += w1[2] * bflo(x0.w); acc[7] += w1[3] * bfhi(x0.w);
                    acc[8] += w2[0] * bflo(x1.x); acc[9] += w2[1] * bfhi(x1.x); acc[10] += w2[2] * bflo(x1.y); acc[11] += w2[3] * bfhi(x1.y);
                    acc[12] += w3[0] * bflo(x1.z); acc[13] += w3[1] * bfhi(x1.z); acc[14] += w3[2] * bflo(x1.w); acc[15] += w3[3] * bfhi(x1.w);
                } }
#pragma unroll
            for (int i = 0; i < 16; ++i) val[p][i] = silu_f(acc[i]);
        }
        float sq = 0.f, sk = 0.f;
#pragma unroll
        for (int i = 0; i < 16; ++i) { sq += val[0][i] * val[0][i]; sk += val[1][i] * val[1][i]; }
        sq += shfl_xor_l(sq, 1, lane); sq += shfl_xor_l(sq, 2, lane); sq += shfl_xor_l(sq, 4, lane);
        sk += shfl_xor_l(sk, 1, lane); sk += shfl_xor_l(sk, 2, lane); sk += shfl_xor_l(sk, 4, lane);
        const float rq = (1.0f / sqrtf(sq + EPS)) * 0.08838834764831845f, rk = 1.0f / sqrtf(sk + EPS);
#pragma unroll
        for (int i = 0; i < 16; ++i) { val[0][i] *= rq; val[1][i] *= rk; }
        u32x4 o0, o1;
        o0.x = pk2(val[1][0], val[1][1]); o0.y = pk2(val[1][2], val[1][3]); o0.z = pk2(val[1][4], val[1][5]); o0.w = pk2(val[1][6], val[1][7]);
        o1.x = pk2(val[1][8], val[1][9]); o1.y = pk2(val[1][10], val[1][11]); o1.z = pk2(val[1][12], val[1][13]); o1.w = pk2(val[1][14], val[1][15]);
        *(LAS u32x4*)(lds + DA_KN + r * 272 + cg * 32) = o0; *(LAS u32x4*)(lds + DA_KN + r * 272 + cg * 32 + 16) = o1;
        o0.x = pk2(val[0][0], val[0][1]); o0.y = pk2(val[0][2], val[0][3]); o0.z = pk2(val[0][4], val[0][5]); o0.w = pk2(val[0][6], val[0][7]);
        o1.x = pk2(val[0][8], val[0][9]); o1.y = pk2(val[0][10], val[0][11]); o1.z = pk2(val[0][12], val[0][13]); o1.w = pk2(val[0][14], val[0][15]);
        *(LAS u32x4*)(lds + DA_QN + r * 272 + cg * 32) = o0; *(LAS u32x4*)(lds + DA_QN + r * 272 + cg * 32 + 16) = o1;
#pragma unroll
        for (int i = 0; i < 16; ++i) { const int f = cg * 16 + i;
            *(LAS unsigned short*)(lds + DA_VBT + f * 144 + r * 2) = (unsigned short)f2bf(val[2][i] * be);
            *(LAS unsigned short*)(lds + DA_KBET + f * 144 + r * 2) = (unsigned short)f2bf(val[1][i] * (be * eg));
            *(LAS unsigned short*)(lds + DA_KDT + f * 144 + r * 2) = (unsigned short)f2bf(val[1][i] * egl); }
    }
    __syncthreads();
    {
        const int p = wave >> 2, ti = wave & 3;
        const int abase = p == 0 ? DA_KN : DA_QN;
        bf16x8 af[4];
#pragma unroll
        for (int ks = 0; ks < 4; ++ks) af[ks] = *(const LAS bf16x8*)(lds + abase + (ti * 16 + fr) * 272 + (ks * 32 + fq * 8) * 2);
        for (int tj = 0; tj < 4; ++tj) {
            f32x4 acc = {0.f, 0.f, 0.f, 0.f};
            if (tj <= ti) {
#pragma unroll
                for (int ks = 0; ks < 4; ++ks) { const bf16x8 bb = *(const LAS bf16x8*)(lds + DA_KN + (tj * 16 + fr) * 272 + (ks * 32 + fq * 8) * 2); acc = mfma16(af[ks], bb, acc); }
            }
            const int j = tj * 16 + fr; const float Gj = Gs[j];
#pragma unroll
            for (int r = 0; r < 4; ++r) { const int i = ti * 16 + fq * 4 + r; float v = 0.f;
                if (p == 0) { if (i > j) v = Gs[64 + i] * acc[r] * __expf(Gs[i] - Gj); *(LAS float*)(lds + DA_L + (i * 64 + j) * 4) = v; }
                else { if (i >= j) v = acc[r] * __expf(Gs[i] - Gj); *(LAS unsigned short*)(lds + DA_QK + i * 144 + j * 2) = (unsigned short)f2bf(v); } }
        }
    }
    __syncthreads();
    if (wave == 0) {
        float Tc[64]; int lc = lane; asm volatile("" : "+v"(lc)); const float fl = (float)lc;
#pragma unroll
        for (int i = 0; i < 64; ++i) {
            float a = fmaxf(0.f, 1.f - fabsf(fl - (float)i));
            const LAS float* Lr = (const LAS float*)(lds + DA_L) + i * 64;
#pragma unroll
            for (int j = 0; j < i; ++j) a -= Lr[j] * Tc[j];
            Tc[i] = a;
        }
#pragma unroll
        for (int i = 0; i < 64; ++i) *(LAS unsigned short*)(lds + DA_TB + i * 144 + lc * 2) = (unsigned short)f2bf(Tc[i]);
    } else {
        for (int fi = wave - 1; fi < 40; fi += 7) {
            if (fi < 8) { const int mt = fi >> 1, ks = fi & 1;
                const u32x4 v = *(const LAS u32x4*)(lds + DA_QK + (mt * 16 + fr) * 144 + (ks * 32 + fq * 8) * 2);
                *(u32x4*)(QKf + (((size_t)uid * 4 + mt) * 2 + ks) * 512 + lane * 8) = v; }
            else if (fi < 24) { const int f2 = fi - 8, mt = f2 >> 2, ks = f2 & 3; const float eg = Gs[128 + mt * 16 + fr];
                const u32x4 v = *(const LAS u32x4*)(lds + DA_QN + (mt * 16 + fr) * 272 + (ks * 32 + fq * 8) * 2); u32x4 o;
                o.x = pk2(bflo(v.x) * eg, bfhi(v.x) * eg); o.y = pk2(bflo(v.y) * eg, bfhi(v.y) * eg); o.z = pk2(bflo(v.z) * eg, bfhi(v.z) * eg); o.w = pk2(bflo(v.w) * eg, bfhi(v.w) * eg);
                *(u32x4*)(Qf + (((size_t)uid * 4 + mt) * 4 + ks) * 512 + lane * 8) = o; }
            else { const int f2 = fi - 24, ft = f2 >> 1, ks = f2 & 1;
                const u32x4 v = *(const LAS u32x4*)(lds + DA_KDT + (ft * 16 + fr) * 144 + (ks * 32 + fq * 8) * 2);
                *(u32x4*)(KdTf + (((size_t)uid * 8 + ft) * 2 + ks) * 512 + lane * 8) = v; }
        }
    }
    __syncthreads();
    {
        bf16x8 ta[4][2];
#pragma unroll
        for (int mt = 0; mt < 4; ++mt)
#pragma unroll
            for (int ks = 0; ks < 2; ++ks) ta[mt][ks] = *(const LAS bf16x8*)(lds + DA_TB + (mt * 16 + fr) * 144 + (ks * 32 + fq * 8) * 2);
#pragma unroll
        for (int c2 = 0; c2 < 2; ++c2) { const int ct = wave * 2 + c2, img = ct < 8 ? DA_VBT : DA_KBET, cr = (ct & 7) * 16 + fr;
            bf16x8 bb[2];
#pragma unroll
            for (int ks = 0; ks < 2; ++ks) bb[ks] = *(const LAS bf16x8*)(lds + img + cr * 144 + (ks * 32 + fq * 8) * 2);
#pragma unroll
            for (int mt = 0; mt < 4; ++mt) { f32x4 acc = {0.f, 0.f, 0.f, 0.f};
#pragma unroll
                for (int ks = 0; ks < 2; ++ks) acc = mfma16(ta[mt][ks], bb[ks], acc);
                if (ct < 8) { u32x2 o; o.x = pk2(acc[0], acc[1]); o.y = pk2(acc[2], acc[3]); *(u32x2*)(Uf + ((((size_t)uid * 8 + ct) * 4 + mt) * 64 + lane) * 4) = o; }
                else { const int f = (ct - 8) * 16 + fr;
#pragma unroll
                    for (int r = 0; r < 4; ++r) *(LAS unsigned short*)(lds + DA_KN + (mt * 16 + fq * 4 + r) * 272 + f * 2) = (unsigned short)f2bf(acc[r]); } }
        }
    }
    __syncthreads();
#pragma unroll
    for (int q2 = 0; q2 < 2; ++q2) { const int fi = wave * 2 + q2, mt = fi >> 2, ks = fi & 3;
        const u32x4 v = *(const LAS u32x4*)(lds + DA_KN + (mt * 16 + fr) * 272 + (ks * 32 + fq * 8) * 2);
        *(u32x4*)(Wf + (((size_t)uid * 4 + mt) * 4 + ks) * 512 + lane * 8) = v; }
    __syncthreads();
}
struct DnbFrag { bf16x8 a1[4]; bf16x8 a2[2]; bf16x8 kd[2]; u32x2 u; float gl; };
__device__ __forceinline__ DnbFrag dnb_load(const bf16* A1, const bf16* QKf, const bf16* KdTf, const bf16* Uf, const float* glb, int uid, int ds, int wave, int lane) {
    DnbFrag f; const int mt = wave & 3;
#pragma unroll
    for (int ks = 0; ks < 4; ++ks) f.a1[ks] = *(const bf16x8*)(A1 + (((size_t)uid * 4 + mt) * 4 + ks) * 512 + lane * 8);
#pragma unroll
    for (int ks = 0; ks < 2; ++ks) f.kd[ks] = *(const bf16x8*)(KdTf + (((size_t)uid * 8 + wave) * 2 + ks) * 512 + lane * 8);
    if (wave >= 4) {
#pragma unroll
        for (int ks = 0; ks < 2; ++ks) f.a2[ks] = *(const bf16x8*)(QKf + (((size_t)uid * 4 + mt) * 2 + ks) * 512 + lane * 8);
        f.u = (u32x2){0u, 0u};
    } else {
        f.a2[0] = f.a1[0]; f.a2[1] = f.a1[1];
        f.u = *(const u32x2*)(Uf + ((((size_t)uid * 8 + ds) * 4 + mt) * 64 + lane) * 4);
    }
    f.gl = glb[uid];
    return f;
}
__device__ __forceinline__ void dnb_run(const bf16* Wf, const bf16* Qf, const bf16* KdTf, const bf16* QKf, const bf16* Uf, const float* glb, float* o, int bh, int ds, LAS unsigned char* lds, int tid, int lane, int wave) {
    const int b = bh >> 3, h = bh & 7, fr = lane & 15, fq = lane >> 4, mt = wave & 3;
    asm volatile("" : "+v"(lds));
    LAS unsigned char* ST = lds; LAS unsigned char* VNT = lds + 4608;
    for (int i = tid; i < 4608 / 4; i += 512) ((LAS unsigned*)ST)[i] = 0u;
    f32x4 accS = {0.f, 0.f, 0.f, 0.f};
    const bf16* A1 = wave < 4 ? Wf : Qf;
    DnbFrag nx = dnb_load(A1, QKf, KdTf, Uf, glb, (b * 128 + 0) * 8 + h, ds, wave, lane);
    __syncthreads();
    for (int n = 0; n < 128; ++n) {
        const DnbFrag cu = nx;
        if (n + 1 < 128) nx = dnb_load(A1, QKf, KdTf, Uf, glb, (b * 128 + n + 1) * 8 + h, ds, wave, lane);
        f32x4 acc = {0.f, 0.f, 0.f, 0.f};
#pragma unroll
        for (int ks = 0; ks < 4; ++ks) { const bf16x8 sb = *(const LAS bf16x8*)(ST + fr * 272 + (ks * 32 + fq * 8) * 2); acc = mfma16(cu.a1[ks], sb, acc); }
        if (wave < 4) {
            const float v0 = bflo(cu.u.x) - acc[0], v1 = bfhi(cu.u.x) - acc[1], v2 = bflo(cu.u.y) - acc[2], v3 = bfhi(cu.u.y) - acc[3];
            u32x2 w; w.x = pk2(v0, v1); w.y = pk2(v2, v3);
            *(LAS u32x2*)(VNT + fr * 144 + (mt * 16 + fq * 4) * 2) = w;
        }
        __syncthreads();
        bf16x8 vb[2];
#pragma unroll
        for (int ks = 0; ks < 2; ++ks) vb[ks] = *(const LAS bf16x8*)(VNT + fr * 144 + (ks * 32 + fq * 8) * 2);
        if (wave >= 4) {
#pragma unroll
            for (int ks = 0; ks < 2; ++ks) acc = mfma16(cu.a2[ks], vb[ks], acc);
            const size_t ob = ((size_t)(b * SEQ + n * 64 + mt * 16 + fq * 4) * NH + h) * HD + ds * 16 + fr;
#pragma unroll
            for (int r = 0; r < 4; ++r) o[ob + (size_t)r * NH * HD] = acc[r];
        }
        accS = accS * cu.gl;
#pragma unroll
        for (int ks = 0; ks < 2; ++ks) accS = mfma16(cu.kd[ks], vb[ks], accS);
        { u32x2 w; w.x = pk2(accS[0], accS[1]); w.y = pk2(accS[2], accS[3]); *(LAS u32x2*)(ST + fr * 272 + (wave * 16 + fq * 4) * 2) = w; }
        __syncthreads();
    }
}
constexpr int LA_XB = 0, LA_XF = 17408, LA_END = LA_XF + 64 * 132 * 4;
static_assert(LA_END <= RING_BYTES, "LRU-A LDS map");
__device__ __forceinline__ void lrua_unit(const bf16* proj, const float* cw, const float* cb, const bf16* WrT, const bf16* WiT, const float* b_r, const float* b_i, const float* lam,
                                          float* Hloc, float* Acum, float* summ, int unit, LAS unsigned char* lds, int tid, int lane, int wave) {
    const int nb = unit & 7, ct = unit >> 3, n = ct & 127, t0 = ct * 64;
    asm volatile("" : "+v"(lds));
    {
        const int r = tid >> 3, cg = tid & 7, ch0 = nb * 128 + cg * 16;
        float acc[16];
        { const f32x4 c0v = *(const f32x4*)(cb + ch0), c1v = *(const f32x4*)(cb + ch0 + 4), c2v = *(const f32x4*)(cb + ch0 + 8), c3v = *(const f32x4*)(cb + ch0 + 12);
#pragma unroll
          for (int i = 0; i < 4; ++i) { acc[i] = c0v[i]; acc[4 + i] = c1v[i]; acc[8 + i] = c2v[i]; acc[12 + i] = c3v[i]; } }
#pragma unroll
        for (int k = 0; k < 4; ++k) { const int row = r - 3 + k;
            if (n * 64 + row >= 0) {
                const bf16* src = proj + (size_t)(t0 + row) * NPROJ + ch0;
                const u32x4 x0 = *(const u32x4*)src, x1 = *(const u32x4*)(src + 8);
                const float* wp = cw + k * DLRU + ch0;
                const f32x4 w0 = *(const f32x4*)wp, w1 = *(const f32x4*)(wp + 4), w2 = *(const f32x4*)(wp + 8), w3 = *(const f32x4*)(wp + 12);
                acc[0] += w0[0] * bflo(x0.x); acc[1] += w0[1] * bfhi(x0.x); acc[2] += w0[2] * bflo(x0.y); acc[3] += w0[3] * bfhi(x0.y);
                acc[4] += w1[0] * bflo(x0.z); acc[5] += w1[1] * bfhi(x0.z); acc[6] += w1[2] * bflo(x0.w); acc[7] += w1[3] * bfhi(x0.w);
                acc[8] += w2[0] * bflo(x1.x); acc[9] += w2[1] * bfhi(x1.x); acc[10] += w2[2] * bflo(x1.y); acc[11] += w2[3] * bfhi(x1.y);
                acc[12] += w3[0] * bflo(x1.z); acc[13] += w3[1] * bfhi(x1.z); acc[14] += w3[2] * bflo(x1.w); acc[15] += w3[3] * bfhi(x1.w);
            } }
        u32x4 o0, o1;
        o0.x = pk2(acc[0], acc[1]); o0.y = pk2(acc[2], acc[3]); o0.z = pk2(acc[4], acc[5]); o0.w = pk2(acc[6], acc[7]);
        o1.x = pk2(acc[8], acc[9]); o1.y = pk2(acc[10], acc[11]); o1.z = pk2(acc[12], acc[13]); o1.w = pk2(acc[14], acc[15]);
        *(LAS u32x4*)(lds + LA_XB + r * 272 + cg * 32) = o0; *(LAS u32x4*)(lds + LA_XB + r * 272 + cg * 32 + 16) = o1;
        LAS f32x4* xf = (LAS f32x4*)(lds + LA_XF + (r * 132 + cg * 16) * 4);
        xf[0] = (f32x4){acc[0], acc[1], acc[2], acc[3]}; xf[1] = (f32x4){acc[4], acc[5], acc[6], acc[7]}; xf[2] = (f32x4){acc[8], acc[9], acc[10], acc[11]}; xf[3] = (f32x4){acc[12], acc[13], acc[14], acc[15]};
    }
    __syncthreads();
    const int fr = lane & 15, fq = lane >> 4, cl = wave * 16 + fr, ch = nb * 128 + cl;
    bf16x8 br[4], bi[4];
#pragma unroll
    for (int ks = 0; ks < 4; ++ks) { br[ks] = *(const bf16x8*)(WrT + ((size_t)nb * 128 + cl) * 128 + ks * 32 + fq * 8); bi[ks] = *(const bf16x8*)(WiT + ((size_t)nb * 128 + cl) * 128 + ks * 32 + fq * 8); }
    f32x4 ar[4], ai[4];
#pragma unroll
    for (int mt = 0; mt < 4; ++mt) { ar[mt] = (f32x4){0.f, 0.f, 0.f, 0.f}; ai[mt] = (f32x4){0.f, 0.f, 0.f, 0.f};
#pragma unroll
        for (int ks = 0; ks < 4; ++ks) { const bf16x8 af = *(const LAS bf16x8*)(lds + LA_XB + (mt * 16 + fr) * 272 + (ks * 32 + fq * 8) * 2); ar[mt] = mfma16(af, br[ks], ar[mt]); ai[mt] = mfma16(af, bi[ks], ai[mt]); } }
    const float brr = b_r[ch], bii = b_i[ch], sp8 = -8.0f * softplus_f(-lam[ch]);
    float Ac = 1.f, Bc = 0.f;
#pragma unroll
    for (int mt = 0; mt < 4; ++mt) {
        float P[4], H[4];
#pragma unroll
        for (int r = 0; r < 4; ++r) { const int t = mt * 16 + fq * 4 + r; const float xcv = *(const LAS float*)(lds + LA_XF + (t * 132 + cl) * 4);
            const float rr = sigmoid_f(ar[mt][r] + brr), ii = sigmoid_f(ai[mt][r] + bii), la = sp8 * rr, a = __expf(la), bb = sqrtf(-expm1f(2.0f * la)) * (ii * xcv);
            if (r == 0) { P[0] = a; H[0] = bb; } else { P[r] = P[r - 1] * a; H[r] = a * H[r - 1] + bb; } }
        float Ai = P[3], Bi = H[3];
        { const float Au = shfl_up_l(Ai, 16, lane), Bu = shfl_up_l(Bi, 16, lane); if (fq >= 1) { Bi = Ai * Bu + Bi; Ai = Au * Ai; } }
        { const float Au = shfl_up_l(Ai, 32, lane), Bu = shfl_up_l(Bi, 32, lane); if (fq >= 2) { Bi = Ai * Bu + Bi; Ai = Au * Ai; } }
        float Ae = shfl_up_l(Ai, 16, lane), Be = shfl_up_l(Bi, 16, lane); if (fq == 0) { Ae = 1.f; Be = 0.f; }
        const float At = shfl_idx_l(Ai, 48 + fr), Bt = shfl_idx_l(Bi, 48 + fr);
        const float PA = Ac * Ae, PB = Ae * Bc + Be;
#pragma unroll
        for (int r = 0; r < 4; ++r) { const size_t o = (size_t)(t0 + mt * 16 + fq * 4 + r) * DLRU + ch; Acum[o] = PA * P[r]; Hloc[o] = P[r] * PB + H[r]; }
        Bc = At * Bc + Bt; Ac = Ac * At;
    }
    if (fq == 0) { float* sp = summ + ((size_t)ct * DLRU + ch) * 2; sp[0] = Ac; sp[1] = Bc; }
    __syncthreads();
}
__device__ __forceinline__ void lru_carry(const float* summ, float* carry, int idx) {
    const int b = idx >> 10, ch = idx & 1023; float c = 0.f;
    for (int n0 = 0; n0 < 128; n0 += 8) { float A[8], B[8];
#pragma unroll
        for (int j = 0; j < 8; ++j) { const float* sp = summ + ((size_t)(b * 128 + n0 + j) * DLRU + ch) * 2; A[j] = sp[0]; B[j] = sp[1]; }
#pragma unroll
        for (int j = 0; j < 8; ++j) { carry[(size_t)(b * 128 + n0 + j) * DLRU + ch] = c; c = A[j] * c + B[j]; } }
}
__device__ __forceinline__ void lrub_row(const float* Hloc, const float* Acum, const float* carry, const bf16* proj, const float* gain, bf16* ymix, int row, int lane) {
    const int ct = row >> 6; f32x4 y[4]; float ss = 0.f;
#pragma unroll
    for (int j = 0; j < 4; ++j) { const int c4 = lane * 4 + 256 * j;
        const f32x4 hl = *(const f32x4*)(Hloc + (size_t)row * DLRU + c4), ac = *(const f32x4*)(Acum + (size_t)row * DLRU + c4), cr = *(const f32x4*)(carry + (size_t)ct * DLRU + c4);
        const u32x2 g = *(const u32x2*)(proj + (size_t)row * NPROJ + DLRU + c4);
        const f32x4 hh = hl + ac * cr;
        y[j][0] = hh[0] * gelu_tanh_f(bflo(g.x)); y[j][1] = hh[1] * gelu_tanh_f(bfhi(g.x)); y[j][2] = hh[2] * gelu_tanh_f(bflo(g.y)); y[j][3] = hh[3] * gelu_tanh_f(bfhi(g.y));
        ss += (y[j][0] * y[j][0] + y[j][1] * y[j][1]) + (y[j][2] * y[j][2] + y[j][3] * y[j][3]); }
    ss = wave_sum(ss, lane); const float rs = 1.0f / sqrtf(ss * (1.0f / DLRU) + EPS);
#pragma unroll
    for (int j = 0; j < 4; ++j) { const int c4 = lane * 4 + 256 * j; const f32x4 g = *(const f32x4*)(gain + c4); u32x2 w; w.x = pk2(y[j][0] * rs * g[0], y[j][1] * rs * g[1]); w.y = pk2(y[j][2] * rs * g[2], y[j][3] * rs * g[3]);
        *(u32x2*)(ymix + (size_t)row * D + c4) = w; }
}
__device__ __forceinline__ void dn_out_item(const float* o, const float* gain, const bf16* proj, bf16* ymix, int w, int lane) {
    const int t = w >> 3, h = w & 7;
    const size_t ob = ((size_t)t * NH + h) * HD + lane * 2;
    const float o0 = o[ob], o1 = o[ob + 1];
    const float ss = wave_sum(o0 * o0 + o1 * o1, lane), rs = 1.0f / sqrtf(ss * (1.0f / HD) + EPS);
    const int c = h * HD + lane * 2;
    const float g0 = bf2f(proj[(size_t)t * NPROJ + 5120 + c]), g1 = bf2f(proj[(size_t)t * NPROJ + 5120 + c + 1]);
    *(unsigned*)(ymix + (size_t)t * D + DLRU + c) = pk2(o0 * rs * gain[lane * 2] * silu_f(g0), o1 * rs * gain[lane * 2 + 1] * silu_f(g1));
}
__device__ __forceinline__ void route_row(const float* x, const float* rstd, const float* gain, const float* router, float* roww, int row, int lane) {
    float acc[8];
#pragma unroll
    for (int e = 0; e < 8; ++e) acc[e] = 0.f;
    for (int j = 0; j < 32; ++j) { const int k = lane + 64 * j; const float xv = x[(size_t)row * D + k] * gain[k]; const f32x4 r0 = *(const f32x4*)(router + (size_t)k * 8), r1 = *(const f32x4*)(router + (size_t)k * 8 + 4);
        acc[0] += xv * r0[0]; acc[1] += xv * r0[1]; acc[2] += xv * r0[2]; acc[3] += xv * r0[3]; acc[4] += xv * r1[0]; acc[5] += xv * r1[1]; acc[6] += xv * r1[2]; acc[7] += xv * r1[3]; }
    const float rs = rstd[row];
#pragma unroll
    for (int e = 0; e < 8; ++e) acc[e] = wave_sum(acc[e], lane) * rs;
    int e1 = 0; float l1 = acc[0];
#pragma unroll
    for (int e = 1; e < 8; ++e) if (acc[e] > l1) { l1 = acc[e]; e1 = e; }
    int e2 = -1; float l2 = -3.4e38f;
#pragma unroll
    for (int e = 0; e < 8; ++e) if (e != e1 && acc[e] > l2) { l2 = acc[e]; e2 = e; }
    const float w1 = 1.0f / (1.0f + __expf(l2 - l1)), w2 = 1.0f - w1;
    if (lane < 8) roww[(size_t)lane * T + row] = lane == e1 ? w1 : (lane == e2 ? w2 : 0.0f);
}
__device__ __forceinline__ void final_row(const float* x, const float* gain, float* out, int row, int lane) {
    const f32x4* xr = (const f32x4*)(x + (size_t)row * D) + lane; const f32x4* gr = (const f32x4*)gain + lane;
    f32x4 v[8]; float ss = 0.f;
#pragma unroll
    for (int j = 0; j < 8; ++j) { v[j] = xr[64 * j]; ss += (v[j][0] * v[j][0] + v[j][1] * v[j][1]) + (v[j][2] * v[j][2] + v[j][3] * v[j][3]); }
    ss = wave_sum(ss, lane); const float rs = 1.0f / sqrtf(ss * (1.0f / D) + EPS);
    f32x4* o = (f32x4*)(out + (size_t)row * D) + lane;
#pragma unroll
    for (int j = 0; j < 8; ++j) o[64 * j] = v[j] * rs * gr[64 * j];
}

struct MoeOrder {
    const int* list; int nN, G, c; int c0, c1, c2, c3, c4, c5, c6, c7;
    __device__ __forceinline__ void init(const unsigned* cnt, const int* list_, int nN_, int G_, int c_) { list = list_; nN = nN_; G = G_; c = c_;
        c0 = __builtin_amdgcn_readfirstlane((int)cnt[0]); c1 = __builtin_amdgcn_readfirstlane((int)cnt[1]); c2 = __builtin_amdgcn_readfirstlane((int)cnt[2]); c3 = __builtin_amdgcn_readfirstlane((int)cnt[3]);
        c4 = __builtin_amdgcn_readfirstlane((int)cnt[4]); c5 = __builtin_amdgcn_readfirstlane((int)cnt[5]); c6 = __builtin_amdgcn_readfirstlane((int)cnt[6]); c7 = __builtin_amdgcn_readfirstlane((int)cnt[7]); }
    __device__ __forceinline__ bool next(int i, pg8::Unit& u) const {
        const int c8[8] = {c0, c1, c2, c3, c4, c5, c6, c7}; int nM = 0;
#pragma unroll
        for (int k = 0; k < 8; ++k) nM += (c8[k] + 255) >> 8;
        const int nwg = nM * nN; const long L = (long)i * G + c; if (L >= nwg) return false;
        int wgid = (int)L; { const int q = nwg / pg8::NXCD, r = nwg % pg8::NXCD, xcd = wgid % pg8::NXCD, off = wgid / pg8::NXCD; wgid = (xcd < r ? xcd * (q + 1) : r * (q + 1) + (xcd - r) * q) + off; }
        const int nig = pg8::WGM * nN, gid = wgid / nig, fm = gid * pg8::WGM, gsz = (nM - fm) < pg8::WGM ? (nM - fm) : pg8::WGM;
        u.pm = fm + ((wgid % nig) % gsz); u.pn = (wgid % nig) / gsz;
        int e = 0, ps = 0, ce = c8[0], run = 0;
#pragma unroll
        for (int k = 0; k < 8; ++k) { const int mk = (c8[k] + 255) >> 8; if (u.pm >= run && u.pm < run + mk) { e = k; ps = run; ce = c8[k]; } run += mk; }
        const int mtl = u.pm - ps; u.pb = e * nN + u.pn; u.lbase = e * T + mtl * 256; u.nvalid = (ce - mtl * 256) < 256 ? (ce - mtl * 256) : 256;
        return true;
    }
    __device__ __forceinline__ int arow(const pg8::Unit& u, int r) const { return r < u.nvalid ? (list[u.lbase + r] & 0xffff) : 0; }
    __device__ __forceinline__ void a_ready(const pg8::Unit&) const {}
    __device__ __forceinline__ void done(const pg8::Unit&) const {}
};
__device__ __forceinline__ void route_block(const float* x, const float* gain, const float* router, bf16* xb, float* rstd, unsigned* cnt, int* list, float* listw, int blk, LAS unsigned char* lds, int tid, int lane, int wave) {
    asm volatile("" : "+v"(lds));
    LAS float* grt = (LAS float*)lds; LAS int* se1 = (LAS int*)(lds + 65536); LAS int* se2 = se1 + 64; LAS float* sw1 = (LAS float*)(se2 + 64); LAS float* sw2 = sw1 + 64; LAS int* lcnt = (LAS int*)(sw2 + 64); LAS int* gbase = lcnt + 8;
    for (int i = tid; i < D * 8; i += 512) grt[i] = router[i] * gain[i >> 3];
    if (tid < 8) lcnt[tid] = 0;
    __syncthreads();
    for (int q = 0; q < 8; ++q) { const int rloc = wave * 8 + q, row = blk * 64 + rloc;
        const f32x4* xr = (const f32x4*)(x + (size_t)row * D) + lane;
        f32x4 v[8]; float ss = 0.f;
#pragma unroll
        for (int j = 0; j < 8; ++j) { v[j] = xr[64 * j]; ss += (v[j][0] * v[j][0] + v[j][1] * v[j][1]) + (v[j][2] * v[j][2] + v[j][3] * v[j][3]); }
        ss = wave_sum(ss, lane); const float rs = 1.0f / sqrtf(ss * (1.0f / D) + EPS);
        u32x2* o = (u32x2*)(xb + (size_t)row * D) + lane;
#pragma unroll
        for (int j = 0; j < 8; ++j) { u32x2 w; w.x = pk2(v[j][0], v[j][1]); w.y = pk2(v[j][2], v[j][3]); o[64 * j] = w; }
        if (lane == 0) rstd[row] = rs;
        float acc[8];
#pragma unroll
        for (int e = 0; e < 8; ++e) acc[e] = 0.f;
#pragma unroll
        for (int j = 0; j < 8; ++j)
#pragma unroll
            for (int c = 0; c < 4; ++c) { const int k = (lane + 64 * j) * 4 + c; const f32x4 r0 = *(const LAS f32x4*)(grt + k * 8), r1 = *(const LAS f32x4*)(grt + k * 8 + 4); const float xv = v[j][c];
                acc[0] += xv * r0[0]; acc[1] += xv * r0[1]; acc[2] += xv * r0[2]; acc[3] += xv * r0[3]; acc[4] += xv * r1[0]; acc[5] += xv * r1[1]; acc[6] += xv * r1[2]; acc[7] += xv * r1[3]; }
#pragma unroll
        for (int e = 0; e < 8; ++e) acc[e] = wave_sum(acc[e], lane) * rs;
        int e1 = 0; float l1 = acc[0];
#pragma unroll
        for (int e = 1; e < 8; ++e) if (acc[e] > l1) { l1 = acc[e]; e1 = e; }
        int e2 = -1; float l2 = -3.4e38f;
#pragma unroll
        for (int e = 0; e < 8; ++e) if (e != e1 && acc[e] > l2) { l2 = acc[e]; e2 = e; }
        const float w1 = 1.0f / (1.0f + __expf(l2 - l1));
        if (lane == 0) { se1[rloc] = e1; se2[rloc] = e2; sw1[rloc] = w1; sw2[rloc] = 1.0f - w1; }
    }
    __syncthreads();
    int e = 0, lr = 0; float w = 0.f;
    if (tid < 128) { const int rloc = tid >> 1, j = tid & 1; e = j ? se2[rloc] : se1[rloc]; w = j ? sw2[rloc] : sw1[rloc]; lr = __hip_atomic_fetch_add(lcnt + e, 1, __ATOMIC_RELAXED, __HIP_MEMORY_SCOPE_WORKGROUP); }
    __syncthreads();
    if (tid < 8) gbase[tid] = (int)__hip_atomic_fetch_add(cnt + tid, (unsigned)lcnt[tid], __ATOMIC_RELAXED, __HIP_MEMORY_SCOPE_AGENT);
    __syncthreads();
    if (tid < 128) { const int pos = gbase[e] + lr, tok = blk * 64 + (tid >> 1); list[e * T + pos] = tok | ((tid & 1) << 16); listw[e * T + pos] = w; }
    __syncthreads();
}
__device__ __forceinline__ void final_row_moe(const float* x, const bf16* y0, const bf16* y1, const float* gain, float* out, int row, int lane) {
    const f32x4* xr = (const f32x4*)(x + (size_t)row * D) + lane; const f32x4* gr = (const f32x4*)gain + lane;
    const u32x2* p0 = (const u32x2*)(y0 + (size_t)row * D) + lane; const u32x2* p1 = (const u32x2*)(y1 + (size_t)row * D) + lane;
    f32x4 v[8]; float ss = 0.f;
#pragma unroll
    for (int j = 0; j < 8; ++j) { v[j] = xr[64 * j]; const u32x2 a = p0[64 * j], b = p1[64 * j];
        v[j][0] += bflo(a.x) + bflo(b.x); v[j][1] += bfhi(a.x) + bfhi(b.x); v[j][2] += bflo(a.y) + bflo(b.y); v[j][3] += bfhi(a.y) + bfhi(b.y);
        ss += (v[j][0] * v[j][0] + v[j][1] * v[j][1]) + (v[j][2] * v[j][2] + v[j][3] * v[j][3]); }
    ss = wave_sum(ss, lane); const float rs = 1.0f / sqrtf(ss * (1.0f / D) + EPS);
    f32x4* o = (f32x4*)(out + (size_t)row * D) + lane;
#pragma unroll
    for (int j = 0; j < 8; ++j) o[64 * j] = v[j] * rs * gr[64 * j];
}
struct Args { const float* in[25]; float* out; unsigned char* ws; int ph_lo, ph_hi; };
typedef const __attribute__((address_space(4))) unsigned long long* kaptr_t;
__device__ __forceinline__ unsigned long long ldka(int i) { kaptr_t ka = (kaptr_t)__builtin_amdgcn_kernarg_segment_ptr(); asm volatile("" : "+s"(i)); return ka[i]; }
__device__ __forceinline__ const float* ldin(const Args&, int i) { return (const float*)ldka(i); }
__device__ __forceinline__ unsigned char* ldws(const Args&) { return (unsigned char*)ldka(26); }
__device__ __forceinline__ float* ldout(const Args&) { return (float*)ldka(25); }
__global__ void __launch_bounds__(512, 2) mega(Args args) {
    extern __shared__ __attribute__((aligned(16))) unsigned char lds_raw[];
    LAS unsigned char* lds = (LAS unsigned char*)lds_raw;
    volatile LAS unsigned* MISC = (volatile LAS unsigned*)(lds + MISC_OFF);
    const int tid = threadIdx.x;
    const int G = gridDim.x, bid = blockIdx.x, NGW = G * 8;
    unsigned char* ws = ldws(args);
    for (int u = tid; u < (LDS_BYTES - LDSCTL_OFF) / 4; u += 512) ((LAS unsigned*)(lds + LDSCTL_OFF))[u] = 0u;
    __syncthreads();
    (void)xcd_barrier_post((unsigned*)(ws + WS_CTL) + CW_BAR, MISC + 8);
#define RUN(id) true
#define SEAM(id) do { XcdBarrier bar_; bar_.bar = (unsigned*)WSP(WS_CTL) + CW_BAR; bar_.x = xb_xcc_id(); bar_.st = (volatile LAS unsigned*)(lds + MISC_OFF) + 8; xcd_barrier(bar_); } while (0)
#define INP(i) ldin(args, (i))
#define WSP(off) (ldws(args) + (off))
#define x_in INP(0)
#define norm_mix INP(1)
#define w_in INP(2)
#define conv_lru_w INP(3)
#define conv_lru_b INP(4)
#define lru_w_r INP(5)
#define lru_b_r INP(6)
#define lru_w_i INP(7)
#define lru_b_i INP(8)
#define lru_lambda INP(9)
#define lru_out_norm INP(10)
#define conv_qkv_w INP(11)
#define dn_a_log INP(12)
#define dn_dt_bias INP(13)
#define dn_out_norm INP(14)
#define w_out INP(15)
#define norm_ffn INP(16)
#define ffn_w_gate INP(17)
#define ffn_w_up INP(18)
#define ffn_w_down INP(19)
#define moe_router INP(20)
#define moe_w_gate INP(21)
#define moe_w_up INP(22)
#define moe_w_down INP(23)
#define norm_final INP(24)
#define xres (ldout(args))
#define Win ((bf16*)WSP(WS_WIN))
#define Wba ((float*)WSP(WS_WBA))
#define Wout ((bf16*)WSP(WS_WOUT))
#define Wgu ((bf16*)WSP(WS_WGU))
#define Wd ((bf16*)WSP(WS_WD))
#define Mgu ((bf16*)WSP(WS_C))
#define Md ((bf16*)WSP(WS_C + (size_t)NEXP * 2 * DFFE * D * 2))
#define MCNT ((unsigned*)WSP(WS_CTL) + CW_CNT)
#define MLIST ((int*)WSP(WS_ROWW))
#define MLISTW ((float*)WSP(WS_ROWW + (size_t)8 * T * 4))
#define YP0 ((bf16*)WSP(WS_XB))
#define YP1 ((bf16*)WSP(WS_YMIX))
#define xb ((bf16*)WSP(WS_XB))
#define rstd ((float*)WSP(WS_RSTD))
#define ba ((float*)WSP(WS_BA))
#define beta ((float*)WSP(WS_BETA))
#define gg ((float*)WSP(WS_G))
#define roww ((float*)WSP(WS_ROWW))
#define proj ((bf16*)WSP(WS_PROJ))
#define hid ((bf16*)WSP(WS_PROJ))
#define ymix ((bf16*)WSP(WS_YMIX))
#define c0 ((float*)WSP(WS_C))
#define c1 ((float*)WSP(WS_C + (size_t)T * 1024 * 4))
#define c2 ((float*)WSP(WS_C + (size_t)2 * T * 1024 * 4))
#define c3 ((float*)WSP(WS_C + (size_t)3 * T * 1024 * 4))
#define LRU_WRT ((bf16*)WSP(WS_WRT))
#define LRU_WIT ((bf16*)WSP(WS_WRT + (size_t)2 * 8 * 128 * 128 * 2))
#define LRU_H ((float*)WSP(WS_C + (size_t)256 * MiB))
#define LRU_A ((float*)WSP(WS_C + (size_t)320 * MiB))
#define LRU_SUMM ((float*)WSP(WS_C + (size_t)384 * MiB))
#define LRU_CARRY ((float*)WSP(WS_C + (size_t)386 * MiB))
#define DN_WF ((bf16*)WSP(WS_C))
#define DN_QF ((bf16*)WSP(WS_C + (size_t)32 * MiB))
#define DN_KDTF ((bf16*)WSP(WS_C + (size_t)64 * MiB))
#define DN_UF ((bf16*)WSP(WS_C + (size_t)96 * MiB))
#define DN_QKF ((bf16*)WSP(WS_C + (size_t)128 * MiB))
#define DN_GL ((float*)WSP(WS_C + (size_t)144 * MiB))
    const int BIG = 1 << 30;
#define PHL int tid_ = threadIdx.x; asm volatile("" : "+v"(tid_)); const int lane_ = tid_ & 63; int bid_ = blockIdx.x; asm volatile("" : "+s"(bid_)); const int gw_ = bid_ * 8 + __builtin_amdgcn_readfirstlane(tid_ >> 6); const size_t gt_ = (size_t)bid_ * 512 + tid_, NGT = (size_t)G * 512; LAS float* scr = (LAS float*)(lds + (gw_ & 7) * 16384);
    if (RUN(ph)) { PHL
        for (int l = 0; l < 2; ++l) {
            convert_matrix(w_in + (size_t)l * D * DIN, DIN, 0, D, NPROJ, norm_mix + l * D, Win + (size_t)l * NPROJ * D, BIG, 0, 0, scr, gw_, NGW, lane_);
            convert_matrix(w_out + (size_t)l * D * D, D, 0, D, D, nullptr, Wout + (size_t)l * D * D, BIG, 0, 0, scr, gw_, NGW, lane_);
            for (size_t i = gt_; i < (size_t)16 * D; i += NGT) { const int j = (int)(i / D), k = (int)(i % D); Wba[(size_t)l * 16 * D + i] = w_in[(size_t)l * D * DIN + (size_t)k * DIN + NPROJ + j] * norm_mix[l * D + k]; }
        }
        for (int m = 0; m < 16; ++m) {
            convert_matrix(lru_w_r + (size_t)m * 128 * 128, 128, 0, 128, 128, nullptr, LRU_WRT + (size_t)m * 128 * 128, BIG, 0, 0, scr, gw_, NGW, lane_);
            convert_matrix(lru_w_i + (size_t)m * 128 * 128, 128, 0, 128, 128, nullptr, LRU_WIT + (size_t)m * 128 * 128, BIG, 0, 0, scr, gw_, NGW, lane_); }
        convert_matrix(ffn_w_gate, DFF, 0, D, DFF, norm_ffn, Wgu, 128, 256, 0, scr, gw_, NGW, lane_);
        convert_matrix(ffn_w_up, DFF, 0, D, DFF, norm_ffn, Wgu, 128, 256, 128, scr, gw_, NGW, lane_);
        convert_matrix(ffn_w_down, D, 0, DFF, D, nullptr, Wd, BIG, 0, 0, scr, gw_, NGW, lane_);
    }
    SEAM(ph);
    int xsel = 0;
#define xcur (xsel ? (const float*)xres : x_in)
    { constexpr int l = 0;
        if (RUN(ph)) { PHL for (int r = gw_; r < T; r += NGW) rowprep_row(xcur, xb, rstd, Wba + (size_t)l * 16 * D, ba, r, lane_); }
        SEAM(ph);
        if (RUN(ph)) { pg8::Gemm g{xb, Win + (size_t)l * NPROJ * D, T, NPROJ, D, 0}; pg8::StaticOrder S; S.init(T, NPROJ, G, bid); pg8::EpiScaleBf16 E{proj, rstd, NPROJ, 0};
            pg8::gemm_phase<pg8::EpiScaleBf16, pg8::StaticOrder, true, false>(lds, g, S, E); }
        SEAM(ph);
        if (RUN(ph)) { PHL
            for (int u = bid_; u < 2048; u += G) lrua_unit(proj, conv_lru_w + (size_t)l * 4 * DLRU, conv_lru_b + l * DLRU, LRU_WRT + (size_t)l * 8 * 128 * 128, LRU_WIT + (size_t)l * 8 * 128 * 128, lru_b_r + l * DLRU, lru_b_i + l * DLRU, lru_lambda + l * DLRU, LRU_H, LRU_A, LRU_SUMM, u, lds, tid_, lane_, gw_ & 7);
            for (int uid = bid_; uid < 2048; uid += G) dna_unit(proj, conv_qkv_w + (size_t)l * 4 * 3 * DDN, ba, dn_a_log + l * NH, dn_dt_bias + l * NH, DN_WF, DN_QF, DN_KDTF, DN_QKF, DN_UF, DN_GL, uid, lds, tid_, lane_, gw_ & 7); }
        SEAM(ph);
        if (RUN(ph)) { PHL
            if (bid_ < 128) dnb_run(DN_WF, DN_QF, DN_KDTF, DN_QKF, DN_UF, DN_GL, c3, (bid_ & 7) + 8 * (bid_ >> 6), (bid_ >> 3) & 7, lds, tid_, lane_, gw_ & 7);
            else if (bid_ < 136 && tid_ < 256) lru_carry(LRU_SUMM, LRU_CARRY, (bid_ - 128) * 256 + tid_); }
        SEAM(ph);
        if (RUN(ph)) { PHL
            for (int r = gw_; r < T; r += NGW) lrub_row(LRU_H, LRU_A, LRU_CARRY, proj, lru_out_norm + l * DLRU, ymix, r, lane_);
            for (int w = gw_; w < T * NH; w += NGW) dn_out_item(c3, dn_out_norm + l * HD, proj, ymix, w, lane_); }
        SEAM(ph);
        if (RUN(ph)) { { pg8::Gemm g{ymix, Wout + (size_t)l * D * D, T, D, D, 0}; pg8::StaticOrder S; S.init(T, D, G, bid); pg8::EpiResidual E{xcur, xres, nullptr, D, 0};
            pg8::gemm_phase<pg8::EpiResidual, pg8::StaticOrder, true, false>(lds, g, S, E); }
            if (l == 1) { PHL
                for (int e = 0; e < NEXP; ++e) {
                    convert_matrix(moe_w_gate + (size_t)e * D * DFFE, DFFE, 0, D, DFFE, norm_ffn + D, Mgu + (size_t)e * 2 * DFFE * D, 128, 256, 0, scr, gw_, NGW, lane_);
                    convert_matrix(moe_w_up + (size_t)e * D * DFFE, DFFE, 0, D, DFFE, norm_ffn + D, Mgu + (size_t)e * 2 * DFFE * D, 128, 256, 128, scr, gw_, NGW, lane_);
                    convert_matrix(moe_w_down + (size_t)e * DFFE * D, D, 0, DFFE, D, nullptr, Md + (size_t)e * D * DFFE, BIG, 0, 0, scr, gw_, NGW, lane_); } } }
        SEAM(ph);
        xsel = 1;
        if (l == 0) {
            if (RUN(ph)) { PHL for (int r = gw_; r < T; r += NGW) rowprep_row(xcur, xb, rstd, nullptr, nullptr, r, lane_); }
            SEAM(ph);
            if (RUN(ph)) { pg8::Gemm g{xb, Wgu, T, 2 * DFF, D, 0}; pg8::StaticOrder S; S.init(T, 2 * DFF, G, bid); pg8::EpiSwiGLU E{hid, rstd, DFF, 0};
                pg8::gemm_phase<pg8::EpiSwiGLU, pg8::StaticOrder, true, false>(lds, g, S, E); }
            SEAM(ph);
            if (RUN(ph)) { pg8::Gemm g{hid, Wd, T, D, DFF, 0}; pg8::StaticOrder S; S.init(T, D, G, bid); pg8::EpiResidual E{xcur, xres, nullptr, D, 0};
                pg8::gemm_phase<pg8::EpiResidual, pg8::StaticOrder, true, false>(lds, g, S, E); }
            SEAM(ph);
        } else {
            if (RUN(ph)) { PHL for (int blk = bid_; blk < T / 64; blk += G) route_block(xcur, norm_ffn + D, moe_router, xb, rstd, MCNT, MLIST, MLISTW, blk, lds, tid_, lane_, gw_ & 7); }
            SEAM(ph);
            if (RUN(ph)) { pg8::Gemm g{xb, Mgu, NSLOT, 2 * DFFE, D, 0}; MoeOrder S; S.init(MCNT, MLIST, 2 * DFFE / 256, G, bid); pg8::EpiSwiGLUMoe E{hid, rstd, MLIST, DFFE, 0};
                pg8::gemm_phase<pg8::EpiSwiGLUMoe, MoeOrder, true, true>(lds, g, S, E); }
            SEAM(ph);
            if (RUN(ph)) { pg8::Gemm g{hid, Md, NSLOT, D, DFFE, 0}; MoeOrder S; S.init(MCNT, MLIST, D / 256, G, bid); pg8::EpiMoeDown E{YP0, YP1, MLIST, MLISTW, D, 0};
                pg8::gemm_phase<pg8::EpiMoeDown, MoeOrder, true, false>(lds, g, S, E); }
            SEAM(ph);
        }
    }
    { constexpr int l = 1;
        if (RUN(ph)) { PHL for (int r = gw_; r < T; r += NGW) rowprep_row(xcur, xb, rstd, Wba + (size_t)l * 16 * D, ba, r, lane_); }
        SEAM(ph);
        if (RUN(ph)) { pg8::Gemm g{xb, Win + (size_t)l * NPROJ * D, T, NPROJ, D, 0}; pg8::StaticOrder S; S.init(T, NPROJ, G, bid); pg8::EpiScaleBf16 E{proj, rstd, NPROJ, 0};
            pg8::gemm_phase<pg8::EpiScaleBf16, pg8::StaticOrder, true, false>(lds, g, S, E); }
        SEAM(ph);
        if (RUN(ph)) { PHL
            for (int u = bid_; u < 2048; u += G) lrua_unit(proj, conv_lru_w + (size_t)l * 4 * DLRU, conv_lru_b + l * DLRU, LRU_WRT + (size_t)l * 8 * 128 * 128, LRU_WIT + (size_t)l * 8 * 128 * 128, lru_b_r + l * DLRU, lru_b_i + l * DLRU, lru_lambda + l * DLRU, LRU_H, LRU_A, LRU_SUMM, u, lds, tid_, lane_, gw_ & 7);
            for (int uid = bid_; uid < 2048; uid += G) dna_unit(proj, conv_qkv_w + (size_t)l * 4 * 3 * DDN, ba, dn_a_log + l * NH, dn_dt_bias + l * NH, DN_WF, DN_QF, DN_KDTF, DN_QKF, DN_UF, DN_GL, uid, lds, tid_, lane_, gw_ & 7); }
        SEAM(ph);
        if (RUN(ph)) { PHL
            if (bid_ < 128) dnb_run(DN_WF, DN_QF, DN_KDTF, DN_QKF, DN_UF, DN_GL, c3, (bid_ & 7) + 8 * (bid_ >> 6), (bid_ >> 3) & 7, lds, tid_, lane_, gw_ & 7);
            else if (bid_ < 136 && tid_ < 256) lru_carry(LRU_SUMM, LRU_CARRY, (bid_ - 128) * 256 + tid_); }
        SEAM(ph);
        if (RUN(ph)) { PHL
            for (int r = gw_; r < T; r += NGW) lrub_row(LRU_H, LRU_A, LRU_CARRY, proj, lru_out_norm + l * DLRU, ymix, r, lane_);
            for (int w = gw_; w < T * NH; w += NGW) dn_out_item(c3, dn_out_norm + l * HD, proj, ymix, w, lane_); }
        SEAM(ph);
        if (RUN(ph)) { { pg8::Gemm g{ymix, Wout + (size_t)l * D * D, T, D, D, 0}; pg8::StaticOrder S; S.init(T, D, G, bid); pg8::EpiResidual E{xcur, xres, nullptr, D, 0};
            pg8::gemm_phase<pg8::EpiResidual, pg8::StaticOrder, true, false>(lds, g, S, E); }
            if (l == 1) { PHL
                for (int e = 0; e < NEXP; ++e) {
                    convert_matrix(moe_w_gate + (size_t)e * D * DFFE, DFFE, 0, D, DFFE, norm_ffn + D, Mgu + (size_t)e * 2 * DFFE * D, 128, 256, 0, scr, gw_, NGW, lane_);
                    convert_matrix(moe_w_up + (size_t)e * D * DFFE, DFFE, 0, D, DFFE, norm_ffn + D, Mgu + (size_t)e * 2 * DFFE * D, 128, 256, 128, scr, gw_, NGW, lane_);
                    convert_matrix(moe_w_down + (size_t)e * DFFE * D, D, 0, DFFE, D, nullptr, Md + (size_t)e * D * DFFE, BIG, 0, 0, scr, gw_, NGW, lane_); } } }
        SEAM(ph);
        xsel = 1;
        if (l == 0) {
            if (RUN(ph)) { PHL for (int r = gw_; r < T; r += NGW) rowprep_row(xcur, xb, rstd, nullptr, nullptr, r, lane_); }
            SEAM(ph);
            if (RUN(ph)) { pg8::Gemm g{xb, Wgu, T, 2 * DFF, D, 0}; pg8::StaticOrder S; S.init(T, 2 * DFF, G, bid); pg8::EpiSwiGLU E{hid, rstd, DFF, 0};
                pg8::gemm_phase<pg8::EpiSwiGLU, pg8::StaticOrder, true, false>(lds, g, S, E); }
            SEAM(ph);
            if (RUN(ph)) { pg8::Gemm g{hid, Wd, T, D, DFF, 0}; pg8::StaticOrder S; S.init(T, D, G, bid); pg8::EpiResidual E{xcur, xres, nullptr, D, 0};
                pg8::gemm_phase<pg8::EpiResidual, pg8::StaticOrder, true, false>(lds, g, S, E); }
            SEAM(ph);
        } else {
            if (RUN(ph)) { PHL for (int blk = bid_; blk < T / 64; blk += G) route_block(xcur, norm_ffn + D, moe_router, xb, rstd, MCNT, MLIST, MLISTW, blk, lds, tid_, lane_, gw_ & 7); }
            SEAM(ph);
            if (RUN(ph)) { pg8::Gemm g{xb, Mgu, NSLOT, 2 * DFFE, D, 0}; MoeOrder S; S.init(MCNT, MLIST, 2 * DFFE / 256, G, bid); pg8::EpiSwiGLUMoe E{hid, rstd, MLIST, DFFE, 0};
                pg8::gemm_phase<pg8::EpiSwiGLUMoe, MoeOrder, true, true>(lds, g, S, E); }
            SEAM(ph);
            if (RUN(ph)) { pg8::Gemm g{hid, Md, NSLOT, D, DFFE, 0}; MoeOrder S; S.init(MCNT, MLIST, D / 256, G, bid); pg8::EpiMoeDown E{YP0, YP1, MLIST, MLISTW, D, 0};
                pg8::gemm_phase<pg8::EpiMoeDown, MoeOrder, true, false>(lds, g, S, E); }
            SEAM(ph);
        }
    }
    if (RUN(ph)) { PHL for (int r = gw_; r < T; r += NGW) final_row_moe(xcur, YP0, YP1, norm_final, xres, r, lane_); }
#undef RUN
#undef SEAM
}

extern "C" void kernel_launch(void* const* d_in, const int* in_sizes, int n_in, void* d_out, int out_size, void* d_ws, size_t ws_size, hipStream_t stream) {
    static int grid = 0;
    if (grid == 0) {
        if (n_in != 25 || ws_size < WS_END) { fprintf(stderr, "kernel_launch: unexpected n_in %d / ws_size %zu (need %zu)\n", n_in, ws_size, (size_t)WS_END); grid = -1; return; }
        int dev = 0, cus = 0, per_cu = 0;
        if (hipGetDevice(&dev) != hipSuccess || hipDeviceGetAttribute(&cus, hipDeviceAttributeMultiprocessorCount, dev) != hipSuccess) { grid = -1; return; }
        if (hipFuncSetAttribute((const void*)mega, hipFuncAttributeMaxDynamicSharedMemorySize, LDS_BYTES) != hipSuccess) { fprintf(stderr, "kernel_launch: hipFuncSetAttribute failed\n"); grid = -1; return; }
        if (hipOccupancyMaxActiveBlocksPerMultiprocessor(&per_cu, (const void*)mega, 512, LDS_BYTES) != hipSuccess || per_cu < 1) { fprintf(stderr, "kernel_launch: occupancy query says %d\n", per_cu); }
        (void)hipGetLastError();
        grid = cus;
    }
    if (grid < 0) return;
    if (hipMemsetAsync((char*)d_ws + WS_CTL, 0, CTL_ZERO_BYTES, stream) != hipSuccess) return;
    Args a{};
    for (int i = 0; i < 25; ++i) a.in[i] = (const float*)d_in[i];
    a.out = (float*)d_out; a.ws = (unsigned char*)d_ws; a.ph_lo = 0; a.ph_hi = 1 << 30;
    hipLaunchKernelGGL(mega, dim3(grid), dim3(512), LDS_BYTES, stream, a);
}
```

```cpp
#include <hip/hip_runtime.h>
#include <cstdio>
#include <cstdint>
namespace pg8 {
#define PG8_LAS __attribute__((address_space(3)))
typedef unsigned short bf16_t;
typedef short bf16x8 __attribute__((ext_vector_type(8)));
typedef float f32x4 __attribute__((ext_vector_type(4)));
typedef unsigned u32x4 __attribute__((ext_vector_type(4)));
constexpr int BM = 256, BK = 64, HALF = 128, HTB = HALF * BK * 2  , STAGE_BYTES = 8 * HTB, NXCD = 8, WGM = 8;

__host__ __device__ __forceinline__ int lds_byte(int r, int c) { const int st = (r >> 4) * 2 + (c >> 5), rr = r & 15, cc = c & 31, ob = rr * 64 + cc * 2; return st * 1024 + (ob ^ (((ob >> 9) & 1) << 5)); }
__host__ __device__ __forceinline__ void stage_rc(int b, int& R, int& C) { const int st = b / 1024, sb = b % 1024, swz = sb ^ (((sb >> 9) & 1) << 5); R = (st >> 1) * 16 + swz / 64; C = (st & 1) * 32 + (swz % 64) / 2; }
__host__ __device__ __forceinline__ int perm32(int rho) { const int n = rho >> 4, i = rho & 15; return 8 * (i >> 2) + 4 * n + (i & 3); }

struct Unit { int pm, pn, pb, lbase, nvalid; };
struct Gemm { const bf16_t* A; const bf16_t* Bt; int M, N, K, pad; };

struct StaticOrder {
    int nM, nN, nwg, G, c;
    __host__ __device__ void init(int M, int N, int G_, int c_) { nM = M / BM; nN = N / BM; nwg = nM * nN; G = G_; c = c_; }
    __host__ __device__ bool next(int i, Unit& u) const {
        const long L = (long)i * G + c; if (L >= nwg) return false;
        int wgid = (int)L; { const int q = nwg / NXCD, r = nwg % NXCD, xcd = wgid % NXCD, off = wgid / NXCD; wgid = (xcd < r ? xcd * (q + 1) : r * (q + 1) + (xcd - r) * q) + off; }
        const int nig = WGM * nN, gid = wgid / nig, fm = gid * WGM, gsz = (nM - fm) < WGM ? (nM - fm) : WGM;
        u.pm = fm + ((wgid % nig) % gsz); u.pn = (wgid % nig) / gsz; u.pb = u.pn; u.lbase = 0; u.nvalid = BM; return true;
    }
    __device__ __forceinline__ int arow(const Unit&, int) const { return 0; }
    __device__ __forceinline__ void a_ready(const Unit&) const {}
    __device__ __forceinline__ void done(const Unit&) const {}
};


__device__ __forceinline__ unsigned cvt_pk_bf16(float lo, float hi) { unsigned r; asm volatile("v_cvt_pk_bf16_f32 %0, %1, %2" : "=v"(r) : "v"(lo), "v"(hi)); return r; }
__device__ __forceinline__ float silu_f(float x) { return x / (1.0f + __expf(-x)); }

struct EpiScaleBf16 {
    static constexpr bool PERM = true, AFTER_DRAIN = false;
    bf16_t* O; const float* rs; int ldc; int pad;
    __device__ __forceinline__ void operator()(const f32x4 (&acc)[2][2][4][2], const Unit& u, int wr, int wc, int fr, int fq) const {
        const int row0 = u.pm * BM + wr * 64 + fr, col0 = u.pn * BM + wc * 32 + 8 * fq;
#pragma unroll
        for (int ai = 0; ai < 2; ++ai)
#pragma unroll
            for (int m = 0; m < 4; ++m) { const int r = row0 + ai * HALF + m * 16; const float s = rs[r]; bf16_t* rowp = O + (size_t)r * ldc + col0;
#pragma unroll
                for (int bj = 0; bj < 2; ++bj) { const f32x4 v0 = acc[ai][bj][m][0] * s, v1 = acc[ai][bj][m][1] * s;
                    u32x4 w; w.x = cvt_pk_bf16(v0[0], v0[1]); w.y = cvt_pk_bf16(v0[2], v0[3]); w.z = cvt_pk_bf16(v1[0], v1[1]); w.w = cvt_pk_bf16(v1[2], v1[3]);
                    *(u32x4*)(rowp + bj * HALF) = w; } }
    }
};
struct EpiSwiGLU {
    static constexpr bool PERM = true, AFTER_DRAIN = false;
    bf16_t* O; const float* rs; int ldc; int pad;
    __device__ __forceinline__ void operator()(const f32x4 (&acc)[2][2][4][2], const Unit& u, int wr, int wc, int fr, int fq) const {
        const int row0 = u.pm * BM + wr * 64 + fr, col0 = u.pn * HALF + wc * 32 + 8 * fq;
#pragma unroll
        for (int ai = 0; ai < 2; ++ai)
#pragma unroll
            for (int m = 0; m < 4; ++m) { const int r = row0 + ai * HALF + m * 16; const float s = rs ? rs[r] : 1.0f; bf16_t* rowp = O + (size_t)r * ldc + col0;
                f32x4 h0, h1;
#pragma unroll
                for (int j = 0; j < 4; ++j) { h0[j] = silu_f(acc[ai][0][m][0][j] * s) * (acc[ai][1][m][0][j] * s); h1[j] = silu_f(acc[ai][0][m][1][j] * s) * (acc[ai][1][m][1][j] * s); }
                u32x4 w; w.x = cvt_pk_bf16(h0[0], h0[1]); w.y = cvt_pk_bf16(h0[2], h0[3]); w.z = cvt_pk_bf16(h1[0], h1[1]); w.w = cvt_pk_bf16(h1[2], h1[3]);
                *(u32x4*)rowp = w; }
    }
};
struct EpiResidual {
    static constexpr bool PERM = false, AFTER_DRAIN = false;
    const float* base; float* out; const float* roww; int ldc; int pad;
    __device__ __forceinline__ void operator()(const f32x4 (&acc)[2][2][4][2], const Unit& u, int wr, int wc, int fr, int fq) const {
        const int row0 = u.pm * BM + wr * 64 + fr, col0 = u.pn * BM + wc * 32 + 4 * fq;
#pragma unroll
        for (int ai = 0; ai < 2; ++ai)
#pragma unroll
            for (int m = 0; m < 4; ++m) { const int r = row0 + ai * HALF + m * 16; const float w = roww ? roww[r] : 1.0f; const size_t off = (size_t)r * ldc + col0;
#pragma unroll
                for (int bj = 0; bj < 2; ++bj)
#pragma unroll
                    for (int n = 0; n < 2; ++n) { const f32x4 bs = *(const f32x4*)(base + off + bj * HALF + n * 16); *(f32x4*)(out + off + bj * HALF + n * 16) = bs + acc[ai][bj][m][n] * w; } }
    }
};

struct EpiSwiGLUMoe {
    static constexpr bool PERM = true, AFTER_DRAIN = false;
    bf16_t* O; const float* rs; const int* list; int ldc; int pad;
    __device__ __forceinline__ void operator()(const f32x4 (&acc)[2][2][4][2], const Unit& u, int wr, int wc, int fr, int fq) const {
        const int rl0 = wr * 64 + fr, col0 = u.pn * HALF + wc * 32 + 8 * fq;
#pragma unroll
        for (int ai = 0; ai < 2; ++ai)
#pragma unroll
            for (int m = 0; m < 4; ++m) { const int rl = rl0 + ai * HALF + m * 16; const int tok = rl < u.nvalid ? (list[u.lbase + rl] & 0xffff) : 0; const float s = rs[tok];
                bf16_t* rowp = O + (size_t)(u.pm * BM + rl) * ldc + col0;
                f32x4 h0, h1;
#pragma unroll
                for (int j = 0; j < 4; ++j) { h0[j] = silu_f(acc[ai][0][m][0][j] * s) * (acc[ai][1][m][0][j] * s); h1[j] = silu_f(acc[ai][0][m][1][j] * s) * (acc[ai][1][m][1][j] * s); }
                u32x4 w; w.x = cvt_pk_bf16(h0[0], h0[1]); w.y = cvt_pk_bf16(h0[2], h0[3]); w.z = cvt_pk_bf16(h1[0], h1[1]); w.w = cvt_pk_bf16(h1[2], h1[3]);
                *(u32x4*)rowp = w; }
    }
};
struct EpiMoeDown {
    static constexpr bool PERM = true, AFTER_DRAIN = false;
    bf16_t* Y0; bf16_t* Y1; const int* list; const float* lw; int ldc; int pad;
    __device__ __forceinline__ void operator()(const f32x4 (&acc)[2][2][4][2], const Unit& u, int wr, int wc, int fr, int fq) const {
        const int rl0 = wr * 64 + fr, col0 = u.pn * BM + wc * 32 + 8 * fq;
#pragma unroll
        for (int ai = 0; ai < 2; ++ai)
#pragma unroll
            for (int m = 0; m < 4; ++m) { const int rl = rl0 + ai * HALF + m * 16;
                if (rl < u.nvalid) { const int en = list[u.lbase + rl]; const float w = lw[u.lbase + rl]; bf16_t* rowp = ((en >> 16) ? Y1 : Y0) + (size_t)(en & 0xffff) * ldc + col0;
#pragma unroll
                    for (int bj = 0; bj < 2; ++bj) { const f32x4 v0 = acc[ai][bj][m][0] * w, v1 = acc[ai][bj][m][1] * w;
                        u32x4 o; o.x = cvt_pk_bf16(v0[0], v0[1]); o.y = cvt_pk_bf16(v0[2], v0[3]); o.z = cvt_pk_bf16(v1[0], v1[1]); o.w = cvt_pk_bf16(v1[2], v1[3]);
                        *(u32x4*)(rowp + bj * HALF) = o; } } }
    }
};
template <class Epi, class Sched, bool ALIGN_EPI = false, bool GATHER = false>
__device__ __forceinline__ void gemm_phase(PG8_LAS unsigned char* lds, const Gemm g, const Sched& S, const Epi& E) {
    int tid_o = threadIdx.x; asm volatile("" : "+v"(tid_o));
    const int tid = tid_o, wid = __builtin_amdgcn_readfirstlane(tid >> 6), lane = tid & 63, wr = wid >> 2, wc = wid & 3, fr = lane & 15, fq = lane >> 4;
    const int K = g.K, nt = K / BK;
    const size_t kstep = (size_t)(BK * 2);
    const size_t hstep = (size_t)HALF * K * 2;
    const size_t tstep = 2 * hstep;
    unsigned voffA[2], voffB[2], oA[2][2], oN[2][2];
#pragma unroll
    for (int i = 0; i < 2; ++i) { int R, C; stage_rc(tid * 16 + i * 8192, R, C); const int Rb = Epi::PERM ? ((R & ~31) + perm32(R & 31)) : R; voffA[i] = (unsigned)(R * K + C) * 2u; voffB[i] = (unsigned)(Rb * K + C) * 2u; }
    const unsigned ldsw = (unsigned)wid * 1024u;
    const int aoff = lds_byte(wr * 64 + fr, fq * 8), boff = lds_byte(wc * 32 + fr, fq * 8);
#define PG8_SA(b, h) (((b) * 2 + (h)) * HTB)
#define PG8_SB(b, h) ((4 + (b) * 2 + (h)) * HTB)
#define PG8_STAGE(bufoff, gbase, voff) do { _Pragma("unroll") for (int _i = 0; _i < 2; ++_i) \
        __builtin_amdgcn_global_load_lds((const unsigned*)((const char*)(gbase) + (voff)[_i]), (PG8_LAS unsigned*)(lds + (bufoff) + ldsw + _i * 8192), 16, 0, 0); } while (0)
#define PG8_LDA(dst, b, h) do { _Pragma("unroll") for (int m = 0; m < 4; ++m) _Pragma("unroll") for (int k = 0; k < 2; ++k) dst[m][k] = *(const PG8_LAS bf16x8*)(lds + PG8_SA(b, h) + aoff + m * 2048 + k * 1024); } while (0)
#define PG8_LDB(dst, b, h) do { _Pragma("unroll") for (int n = 0; n < 2; ++n) _Pragma("unroll") for (int k = 0; k < 2; ++k) dst[n][k] = *(const PG8_LAS bf16x8*)(lds + PG8_SB(b, h) + boff + n * 2048 + k * 1024); } while (0)
#define PG8_MMA(ai, bj, At, Bt) do { __builtin_amdgcn_s_setprio(1); _Pragma("unroll") for (int m = 0; m < 4; ++m) _Pragma("unroll") for (int n = 0; n < 2; ++n) _Pragma("unroll") for (int k = 0; k < 2; ++k) \
        acc[ai][bj][m][n] = __builtin_amdgcn_mfma_f32_16x16x32_bf16(Bt[n][k], At[m][k], acc[ai][bj][m][n], 0, 0, 0); __builtin_amdgcn_s_setprio(0); } while (0)
#define PG8_WAIT_V(n) asm volatile("s_waitcnt vmcnt(" #n ")" ::: "memory")
#define PG8_WAIT_L(n) asm volatile("s_waitcnt lgkmcnt(" #n ")" ::: "memory")
#define PG8_BAR __builtin_amdgcn_s_barrier()
#define PG8_SCHED __builtin_amdgcn_sched_barrier(0)
#define PG8_AOFF(dst, u) do { _Pragma("unroll") for (int _i = 0; _i < 2; ++_i) { int _R, _C; stage_rc(tid * 16 + _i * 8192, _R, _C); _Pragma("unroll") for (int _h = 0; _h < 2; ++_h) \
        dst[_h][_i] = (unsigned)(S.arow(u, _h * HALF + _R) * K + _C) * 2u; } } while (0)
#define PG8_STAGE_A(bufoff, gbase, h, usenext) do { _Pragma("unroll") for (int _i = 0; _i < 2; ++_i) { const unsigned _o = GATHER ? ((usenext) ? oN[h][_i] : oA[h][_i]) : voffA[_i]; \
        __builtin_amdgcn_global_load_lds((const unsigned*)((const char*)(gbase) + (GATHER ? (size_t)0 : (size_t)(h) * hstep) + _o), (PG8_LAS unsigned*)(lds + (bufoff) + ldsw + _i * 8192), 16, 0, 0); } } while (0)
    Unit cur, nxt; int ui = 0;
    if (!S.next(0, cur)) return;
    f32x4 acc[2][2][4][2];
#pragma unroll
    for (int a = 0; a < 2; ++a)
#pragma unroll
        for (int b = 0; b < 2; ++b)
#pragma unroll
            for (int m = 0; m < 4; ++m)
#pragma unroll
                for (int n = 0; n < 2; ++n) acc[a][b][m][n] = (f32x4){0.f, 0.f, 0.f, 0.f};
    bf16x8 At[4][2], B0[2][2], B1[2][2];
    const char* cA = (const char*)g.A + (GATHER ? (size_t)0 : (size_t)cur.pm * tstep); const char* cB = (const char*)g.Bt + (size_t)cur.pb * tstep;
    S.a_ready(cur);
    if constexpr (GATHER) { PG8_AOFF(oA, cur); PG8_WAIT_V(0); }
    PG8_STAGE(PG8_SB(0, 0), cB, voffB); PG8_STAGE(PG8_SB(0, 1), cB + hstep, voffB); PG8_STAGE_A(PG8_SA(0, 0), cA, 0, false); PG8_STAGE_A(PG8_SA(0, 1), cA, 1, false);
    if (wr == 1) PG8_BAR;
    PG8_WAIT_V(2); PG8_BAR;
    PG8_STAGE(PG8_SB(1, 0), cB + kstep, voffB); PG8_STAGE_A(PG8_SA(1, 0), cA + kstep, 0, false); PG8_STAGE(PG8_SB(1, 1), cB + hstep + kstep, voffB);
    PG8_WAIT_V(6); PG8_BAR;
    for (;;) {
        const bool has_next = S.next(ui + 1, nxt);
        const char* nA = has_next ? (const char*)g.A + (GATHER ? (size_t)0 : (size_t)nxt.pm * tstep) : cA; const char* nB = has_next ? (const char*)g.Bt + (size_t)nxt.pb * tstep : cB;
        if constexpr (GATHER) { if (has_next) { PG8_AOFF(oN, nxt); } else {
#pragma unroll
            for (int _h = 0; _h < 2; ++_h) { oN[_h][0] = oA[_h][0]; oN[_h][1] = oA[_h][1]; } } }
        for (int t = 0; t < nt; t += 2) {
            const bool last = (t == nt - 2);
            const char* a1 = cA + (size_t)(t + 1) * kstep;
            const char* a2 = last ? nA : cA + (size_t)(t + 2) * kstep; const char* b2 = last ? nB : cB + (size_t)(t + 2) * kstep;
            const char* a3 = a2 + kstep; const char* b3 = b2 + kstep;
            if (last && has_next) S.a_ready(nxt);
            PG8_LDB(B0, 0, 0); PG8_LDB(B1, 0, 1); PG8_SCHED; PG8_LDA(At, 0, 0); PG8_STAGE_A(PG8_SA(1, 1), a1, 1, false);
            PG8_WAIT_V(8); PG8_WAIT_L(0); PG8_BAR; PG8_MMA(0, 0, At, B0); PG8_MMA(0, 1, At, B1); PG8_BAR; PG8_SCHED;
            PG8_LDA(At, 0, 1); PG8_STAGE(PG8_SB(0, 0), b2, voffB); PG8_STAGE(PG8_SB(0, 1), b2 + hstep, voffB); PG8_STAGE_A(PG8_SA(0, 0), a2, 0, last);
            PG8_WAIT_V(8); PG8_WAIT_L(0); PG8_BAR; PG8_MMA(1, 0, At, B0); PG8_MMA(1, 1, At, B1); PG8_BAR; PG8_SCHED;
            PG8_LDB(B0, 1, 0); PG8_LDB(B1, 1, 1); PG8_SCHED; PG8_LDA(At, 1, 0); PG8_STAGE_A(PG8_SA(0, 1), a2, 1, last);
            PG8_WAIT_V(8); PG8_WAIT_L(0); PG8_BAR; PG8_MMA(0, 0, At, B0); PG8_MMA(0, 1, At, B1); PG8_BAR; PG8_SCHED;
            PG8_LDA(At, 1, 1); PG8_STAGE(PG8_SB(1, 0), b3, voffB); PG8_STAGE(PG8_SB(1, 1), b3 + hstep, voffB); PG8_STAGE_A(PG8_SA(1, 0), a3, 0, last);
            PG8_WAIT_V(8); PG8_WAIT_L(0); PG8_BAR; PG8_MMA(1, 0, At, B0); PG8_MMA(1, 1, At, B1); PG8_BAR; PG8_SCHED;
        }
        if constexpr (ALIGN_EPI) { if (wr == 0) PG8_BAR; }
        E(acc, cur, wr, wc, fr, fq); S.done(cur);
        if (!has_next) break;
#pragma unroll
        for (int a = 0; a < 2; ++a)
#pragma unroll
            for (int b = 0; b < 2; ++b)
#pragma unroll
                for (int m = 0; m < 4; ++m)
#pragma unroll
                    for (int n = 0; n < 2; ++n) acc[a][b][m][n] = (f32x4){0.f, 0.f, 0.f, 0.f};
        cur = nxt; cA = nA; cB = nB; ++ui;
        if constexpr (GATHER) {
#pragma unroll
            for (int _h = 0; _h < 2; ++_h) { oA[_h][0] = oN[_h][0]; oA[_h][1] = oN[_h][1]; } }
        if constexpr (ALIGN_EPI) { if (wr == 1) PG8_BAR; }
    }
    PG8_WAIT_V(0);
    if constexpr (!ALIGN_EPI) { if (wr == 0) PG8_BAR; }
    PG8_BAR;
#undef PG8_SA
#undef PG8_SB
#undef PG8_STAGE
#undef PG8_LDA
#undef PG8_LDB
#undef PG8_MMA
#undef PG8_WAIT_V
#undef PG8_WAIT_L
#undef PG8_BAR
#undef PG8_SCHED
#undef PG8_AOFF
#undef PG8_STAGE_A
}
}

#define GAS __attribute__((address_space(1)))
#define LAS __attribute__((address_space(3)))
#define XB_TMO      128
#define XB_XCNT(j)  (256  + 64 * (j))
#define XB_XSUB(j)  (1280 + 64 * (j))
#define XB_XGEN(j)  (2304 + 64 * (j))
#define XB_TOP      3328
#define XB_TOPGEN   3392
#define XCD_BAR_WORDS 3456
#define XB_SPIN_CAP (1u << 23)

__device__ __forceinline__ unsigned xb_ld(unsigned* p)              { return __hip_atomic_load(p, __ATOMIC_RELAXED, __HIP_MEMORY_SCOPE_AGENT); }
__device__ __forceinline__ unsigned xb_add(unsigned* p, unsigned v) { return __hip_atomic_fetch_add(p, v, __ATOMIC_RELAXED, __HIP_MEMORY_SCOPE_AGENT); }
__device__ __forceinline__ unsigned xb_xcc_id() { return (unsigned)__builtin_amdgcn_s_getreg((3 << 11) | 20) & 0xFu; }
#define XB_SPIN(cond, bar) do { unsigned _sp = 0; while (cond) { __builtin_amdgcn_s_sleep(1); \
    if ((++_sp & 255u) == 0u) { if (xb_ld(&(bar)[XB_TMO])) break; if (_sp > XB_SPIN_CAP) { atomicAdd(&(bar)[XB_TMO], 1u); break; } } } } while (0)

struct XcdBarrier {
    unsigned* bar; unsigned x;
    volatile LAS unsigned* st;
};

__device__ __forceinline__ XcdBarrier xcd_barrier_post(unsigned* bar, volatile LAS unsigned* st) {
    XcdBarrier b; b.bar = bar; b.x = xb_xcc_id(); b.st = st;
    if (threadIdx.x == 0) (void)xb_add(&bar[XB_XCNT(b.x)], 1u);
    return b;
}
__device__ __forceinline__ void xcd_barrier_complete(unsigned* bar, unsigned x, unsigned& nloc, unsigned& nx) {
    const unsigned G = gridDim.x * gridDim.y * gridDim.z;
    unsigned sum, cnt, mine, sp = 0u;
    for (;;) {
        sum = 0u; cnt = 0u; mine = 0u;
#pragma unroll
        for (unsigned j = 0; j < 16; ++j) { const unsigned c = xb_ld(&bar[XB_XCNT(j)]); sum += c; cnt += (c > 0u) ? 1u : 0u; mine = (j == x) ? c : mine; }
        if (sum == G) break;
        __builtin_amdgcn_s_sleep(1);
        if ((++sp & 255u) == 0u) { if (xb_ld(&bar[XB_TMO])) break; if (sp > XB_SPIN_CAP) { atomicAdd(&bar[XB_TMO], 1u); break; } }
    }
    nloc = mine > 0u ? mine : 1u; nx = cnt > 0u ? cnt : 1u;
}

__device__ __forceinline__ void xcd_barrier(const XcdBarrier& b) {
    asm volatile("s_waitcnt vmcnt(0)" ::: "memory");
    __syncthreads();
    if (threadIdx.x == 0) {
        unsigned* bar = b.bar; asm volatile("" : "+s"(bar));
        __builtin_amdgcn_s_waitcnt(0);
        unsigned nloc = b.st[0], nx = b.st[1];
        if (nloc == 0u) { xcd_barrier_complete(bar, b.x, nloc, nx); b.st[0] = nloc; b.st[1] = nx; }
        const unsigned old = xb_add(&bar[XB_XSUB(b.x)], 1u);
        const unsigned gen = old / nloc;
        if (old + 1u == (gen + 1u) * nloc) {
            __builtin_amdgcn_fence(__ATOMIC_RELEASE, "agent");
            asm volatile("s_waitcnt vmcnt(0)" ::: "memory");
            const unsigned og = xb_add(&bar[XB_TOP], 1u);
            const unsigned tg = og / nx;
            if (og + 1u == (tg + 1u) * nx) xb_add(&bar[XB_TOPGEN], 1u);
            else XB_SPIN(xb_ld(&bar[XB_TOPGEN]) == tg, bar);
            __builtin_amdgcn_fence(__ATOMIC_ACQUIRE, "agent");
            xb_add(&bar[XB_XGEN(b.x)], 1u);
            asm volatile("s_waitcnt vmcnt(0)" ::: "memory");
        } else {
            XB_SPIN(xb_ld(&bar[XB_XGEN(b.x)]) == gen, bar);
            __builtin_amdgcn_fence(__ATOMIC_ACQUIRE, "agent");
            asm volatile("s_waitcnt vmcnt(0)" ::: "memory");
        }
    }
    __syncthreads();
}

constexpr int T = 16384, SEQ = 8192, D = 2048, DLRU = 1024, DDN = 1024, NH = 8, HD = 128, NPROJ = 6144, DIN = 6160;
constexpr int DFF = 6144, NEXP = 8, DFFE = 3072;
constexpr float EPS = 1e-6f;
typedef unsigned short bf16;
typedef float f32x4 __attribute__((ext_vector_type(4)));
typedef unsigned u32x4 __attribute__((ext_vector_type(4)));
typedef unsigned u32x2 __attribute__((ext_vector_type(2)));
#define LDS_WAIT() asm volatile("s_waitcnt lgkmcnt(0)" ::: "memory")
#define LDS_BARRIER() do { asm volatile("s_waitcnt lgkmcnt(0)" ::: "memory"); __builtin_amdgcn_s_barrier(); asm volatile("" ::: "memory"); } while (0)

__device__ __forceinline__ float bf2f(bf16 b) { return __uint_as_float(((unsigned)b) << 16); }
__device__ __forceinline__ unsigned f2bf(float f) { unsigned u = __float_as_uint(f); return (u + 0x7fffu + ((u >> 16) & 1u)) >> 16; }
__device__ __forceinline__ unsigned pk2(float lo, float hi) { return f2bf(lo) | (f2bf(hi) << 16); }
__device__ __forceinline__ float shfl_xor_l(float v, int o, int lane) { return __int_as_float(__builtin_amdgcn_ds_bpermute((lane ^ o) << 2, __float_as_int(v))); }
__device__ __forceinline__ float shfl_up_l(float v, int d, int lane) { return __int_as_float(__builtin_amdgcn_ds_bpermute((lane - d) << 2, __float_as_int(v))); }
__device__ __forceinline__ float shfl_idx_l(float v, int src) { return __int_as_float(__builtin_amdgcn_ds_bpermute(src << 2, __float_as_int(v))); }
__device__ __forceinline__ float wave_sum(float v, int lane) {
#pragma unroll
    for (int o = 1; o < 64; o <<= 1) v += shfl_xor_l(v, o, lane);
    return v;
}
using pg8::silu_f;
__device__ __forceinline__ float sigmoid_f(float x) { return 1.0f / (1.0f + __expf(-x)); }
__device__ __forceinline__ float softplus_f(float x) { return fmaxf(x, 0.0f) + log1pf(__expf(-fabsf(x))); }
__device__ __forceinline__ float gelu_tanh_f(float x) { const float u = 0.7978845608028654f * (x + 0.044715f * x * x * x); return 0.5f * x * (1.0f + tanhf(u)); }

constexpr size_t MiB = 1u << 20;
constexpr size_t al(size_t x) { return (x + MiB - 1) / MiB * MiB; }
constexpr size_t WS_CTL = 0, CTL_ZERO_BYTES = 1 * MiB;
constexpr int CW_BAR = 4096, CW_CNT = 8192;
constexpr size_t WS_WIN = 1 * MiB;
constexpr size_t WS_WBA = WS_WIN + al((size_t)2 * NPROJ * D * 2);
constexpr size_t WS_WOUT = WS_WBA + al((size_t)2 * 16 * D * 4);
constexpr size_t WS_WGU = WS_WOUT + al((size_t)2 * D * D * 2);
constexpr size_t WS_WD = WS_WGU + al((size_t)2 * DFF * D * 2);
constexpr size_t WS_XB = WS_WD + al((size_t)D * DFF * 2);
constexpr size_t WS_RSTD = WS_XB + al((size_t)T * D * 2);
constexpr size_t WS_BA = WS_RSTD + al((size_t)T * 4);
constexpr size_t WS_BETA = WS_BA + al((size_t)T * 16 * 4);
constexpr size_t WS_G = WS_BETA + al((size_t)T * 8 * 4);
constexpr size_t WS_ROWW = WS_G + al((size_t)T * 8 * 4);
constexpr int NSLOT = 2 * T + NEXP * 256;
constexpr size_t WS_PROJ = WS_ROWW + al((size_t)2 * 8 * T * 4);
constexpr size_t WS_YMIX = WS_PROJ + al((size_t)NSLOT * DFFE * 2);
constexpr size_t WS_C = WS_YMIX + al((size_t)T * D * 2);
constexpr size_t WS_WRT = WS_C + (size_t)388 * MiB;
constexpr size_t WS_END = WS_WRT + 1 * MiB;
static_assert(WS_END <= (size_t)975 * MiB, "d_ws map exceeds the guaranteed workspace");
static_assert((size_t)NEXP * (2 * DFFE * D + D * DFFE) * 2 <= (size_t)388 * MiB, "MoE bf16 weights overlay the mixer scratch");
constexpr int RING_BYTES = 131072, LDSCTL_OFF = RING_BYTES, MISC_OFF = LDSCTL_OFF + 320, LDS_BYTES = 147456;

__device__ __forceinline__ void transpose_item(const float* W, int ldw, int col_off, int K, int nblk, const float* gain, bf16* WT, int blk, int blk_stride, int row_off, int item, int lane) {
    const int kb = item / nblk, nb = item % nblk, k0 = 64 * kb + (lane >> 4) * 16, n0 = 64 * nb + (lane & 15) * 4;
    const float* src = W + (size_t)k0 * ldw + col_off + n0;
    f32x4 v[16];
#pragma unroll
    for (int j = 0; j < 16; ++j) v[j] = *(const f32x4*)(src + (size_t)j * ldw);
    if (gain) {
#pragma unroll
        for (int q = 0; q < 4; ++q) { const f32x4 g = *(const f32x4*)(gain + k0 + 4 * q);
#pragma unroll
            for (int c = 0; c < 4; ++c) v[4 * q + c] = v[4 * q + c] * g[c]; }
    }
#pragma unroll
    for (int i = 0; i < 4; ++i) { const int n = n0 + i, drow = (n / blk) * blk_stride + (n % blk) + row_off;
        u32x4 o0, o1;
        o0.x = pk2(v[0][i], v[1][i]); o0.y = pk2(v[2][i], v[3][i]); o0.z = pk2(v[4][i], v[5][i]); o0.w = pk2(v[6][i], v[7][i]);
        o1.x = pk2(v[8][i], v[9][i]); o1.y = pk2(v[10][i], v[11][i]); o1.z = pk2(v[12][i], v[13][i]); o1.w = pk2(v[14][i], v[15][i]);
        u32x4* dst = (u32x4*)(WT + (size_t)drow * K + k0); dst[0] = o0; dst[1] = o1; }
}
__device__ __forceinline__ void convert_matrix(const float* W, int ldw, int col_off, int K, int N, const float* gain, bf16* WT, int blk, int blk_stride, int row_off, LAS float* scr, int gw, int NGW, int lane) {
    const int nblk = N / 64, nitems = (K / 64) * nblk; (void)scr;
    for (int it = gw; it < nitems; it += NGW) transpose_item(W, ldw, col_off, K, nblk, gain, WT, blk, blk_stride, row_off, it, lane);
}
__device__ __forceinline__ void rowprep_row(const float* x, bf16* xb, float* rstd, const float* Wba, float* ba, int row, int lane) {
    const f32x4* xr = (const f32x4*)(x + (size_t)row * D) + lane;
    f32x4 v[8]; float ss = 0.f;
#pragma unroll
    for (int j = 0; j < 8; ++j) { v[j] = xr[64 * j]; ss += (v[j][0] * v[j][0] + v[j][1] * v[j][1]) + (v[j][2] * v[j][2] + v[j][3] * v[j][3]); }
    ss = wave_sum(ss, lane);
    const float rs = 1.0f / sqrtf(ss * (1.0f / D) + EPS);
    u32x2* o = (u32x2*)(xb + (size_t)row * D) + lane;
#pragma unroll
    for (int j = 0; j < 8; ++j) { u32x2 w; w.x = pk2(v[j][0], v[j][1]); w.y = pk2(v[j][2], v[j][3]); o[64 * j] = w; }
    if (lane == 0) rstd[row] = rs;
    if (Wba) {
        for (int c = 0; c < 16; ++c) { const f32x4* wr = (const f32x4*)(Wba + (size_t)c * D) + lane; float a = 0.f;
#pragma unroll
            for (int j = 0; j < 8; ++j) { const f32x4 w = wr[64 * j]; a += (v[j][0] * w[0] + v[j][1] * w[1]) + (v[j][2] * w[2] + v[j][3] * w[3]); }
            a = wave_sum(a, lane); if (lane == 0) ba[(size_t)row * 16 + c] = a * rs; }
    }
}
__device__ __forceinline__ void lru_conv_elem(const bf16* proj, const float* cw, const float* cb, float* xc, size_t idx) {
    const int t = (int)(idx / DLRU), ch = (int)(idx % DLRU), s = t % SEQ;
    float a = cb[ch];
#pragma unroll
    for (int k = 0; k < 4; ++k) { const int sp = s - 3 + k; if (sp >= 0) a += cw[k * DLRU + ch] * bf2f(proj[(size_t)(t - 3 + k) * NPROJ + ch]); }
    xc[idx] = a;
}
__device__ __forceinline__ void lru_gate_elem(const float* xc, const float* w_r, const float* b_r, const float* w_i, const float* b_i, const float* lam, float* av, float* bv, size_t idx) {
    const int t = (int)(idx / DLRU), ch = (int)(idx % DLRU), n = ch >> 7, d = ch & 127;
    float ar = b_r[ch], ai = b_i[ch];
    const float* xr = xc + (size_t)t * DLRU + n * 128; const float* wr = w_r + (size_t)n * 128 * 128 + d; const float* wi = w_i + (size_t)n * 128 * 128 + d;
    for (int c = 0; c < 128; ++c) { const float xv = xr[c]; ar += xv * wr[c * 128]; ai += xv * wi[c * 128]; }
    const float r = sigmoid_f(ar), ig = sigmoid_f(ai);
    const float log_a = -8.0f * r * softplus_f(-lam[ch]);
    const float a = expf(log_a), mult = sqrtf(-expm1f(2.0f * log_a));
    av[idx] = a; bv[idx] = mult * (ig * xc[idx]);
}
__device__ __forceinline__ void lru_scan_chan(float* av, const float* bv, const bf16* proj, int idx) {
    const int b = idx / DLRU, ch = idx % DLRU;
    float h = 0.f;
    for (int s0 = 0; s0 < SEQ; s0 += 8) {
        float a8[8], b8[8], g8[8];
#pragma unroll
        for (int j = 0; j < 8; ++j) { const size_t t = (size_t)b * SEQ + s0 + j; a8[j] = av[t * DLRU + ch]; b8[j] = bv[t * DLRU + ch]; g8[j] = bf2f(proj[t * NPROJ + DLRU + ch]); }
#pragma unroll
        for (int j = 0; j < 8; ++j) { const size_t t = (size_t)b * SEQ + s0 + j; h = a8[j] * h + b8[j]; av[t * DLRU + ch] = h * gelu_tanh_f(g8[j]); }
    }
}
__device__ __forceinline__ void lru_norm_row(const float* y, const float* gain, bf16* ymix, int row, int lane) {
    const f32x4* yr = (const f32x4*)(y + (size_t)row * DLRU) + lane; const f32x4* gr = (const f32x4*)gain + lane;
    f32x4 v[4]; float ss = 0.f;
#pragma unroll
    for (int j = 0; j < 4; ++j) { v[j] = yr[64 * j]; ss += (v[j][0] * v[j][0] + v[j][1] * v[j][1]) + (v[j][2] * v[j][2] + v[j][3] * v[j][3]); }
    ss = wave_sum(ss, lane); const float rs = 1.0f / sqrtf(ss * (1.0f / DLRU) + EPS);
    u32x2* o = (u32x2*)(ymix + (size_t)row * D) + lane;
#pragma unroll
    for (int j = 0; j < 4; ++j) { const f32x4 g = gr[64 * j]; u32x2 w; w.x = pk2(v[j][0] * rs * g[0], v[j][1] * rs * g[1]); w.y = pk2(v[j][2] * rs * g[2], v[j][3] * rs * g[3]); o[64 * j] = w; }
}
__device__ __forceinline__ void dn_prep_item(const bf16* proj, const float* cw, const float* ba, const float* a_log, const float* dt_bias, float* qn, float* kn, float* vn, float* beta, float* gg, int w, int lane) {
    const int t = w >> 3, h = w & 7, s = t % SEQ;
    float val[3][2];
#pragma unroll
    for (int p = 0; p < 3; ++p)
#pragma unroll
        for (int e = 0; e < 2; ++e) { const int d = lane * 2 + e, c = p * DDN + h * HD + d; float a = 0.f;
#pragma unroll
            for (int k = 0; k < 4; ++k) { const int sp = s - 3 + k; if (sp >= 0) a += cw[k * 3 * DDN + c] * bf2f(proj[(size_t)(t - 3 + k) * NPROJ + 2048 + c]); }
            val[p][e] = silu_f(a); }
    const float sq = wave_sum(val[0][0] * val[0][0] + val[0][1] * val[0][1], lane), sk = wave_sum(val[1][0] * val[1][0] + val[1][1] * val[1][1], lane);
    const float rq = (1.0f / sqrtf(sq + EPS)) * 0.08838834764831845f, rk = 1.0f / sqrtf(sk + EPS);
    const size_t o = ((size_t)t * NH + h) * HD + lane * 2;
    qn[o] = val[0][0] * rq; qn[o + 1] = val[0][1] * rq; kn[o] = val[1][0] * rk; kn[o + 1] = val[1][1] * rk; vn[o] = val[2][0]; vn[o + 1] = val[2][1];
    if (lane == 0) { beta[t * NH + h] = sigmoid_f(ba[(size_t)t * 16 + h]); gg[t * NH + h] = -__expf(a_log[h]) * softplus_f(ba[(size_t)t * 16 + 8 + h] + dt_bias[h]); }
}
__device__ __forceinline__ void dn_rec_seq(const float* qn, const float* kn, const float* vn, const float* beta, const float* gg, float* o, int bh, LAS float* sk, LAS float* sq, LAS float* st, int tid) {
    const int b = bh >> 3, h = bh & 7, j = tid & 127; const bool act = tid < 128;
    if (act) for (int k = 0; k < 128; ++k) st[k * 128 + j] = 0.f;
    const size_t base = ((size_t)(b * SEQ) * NH + h) * HD;
    float nk = kn[base + j], nq = qn[base + j], nv = vn[base + j], nb = beta[(b * SEQ) * NH + h], ng = gg[(b * SEQ) * NH + h];
    for (int s = 0; s < SEQ; ++s) {
        const int buf = (s & 1) * 128;
        if (act) { sk[buf + j] = nk; sq[buf + j] = nq; }
        const float vj = nv, be = nb, ge = __expf(ng);
        __syncthreads();
        if (act) {
            if (s + 1 < SEQ) { const size_t nb_ = ((size_t)(b * SEQ + s + 1) * NH + h) * HD; nk = kn[nb_ + j]; nq = qn[nb_ + j]; nv = vn[nb_ + j]; nb = beta[(b * SEQ + s + 1) * NH + h]; ng = gg[(b * SEQ + s + 1) * NH + h]; }
            float ks = 0.f;
#pragma unroll 8
            for (int k = 0; k < 128; ++k) ks += sk[buf + k] * st[k * 128 + j];
            const float vnew = be * (vj - ge * ks);
            float oo = 0.f;
#pragma unroll 8
            for (int k = 0; k < 128; ++k) { const float sv = ge * st[k * 128 + j] + sk[buf + k] * vnew; st[k * 128 + j] = sv; oo += sq[buf + k] * sv; }
            o[((size_t)(b * SEQ + s) * NH + h) * HD + j] = oo;
        }
    }
    __syncthreads();
}
typedef short bf16x8 __attribute__((ext_vector_type(8)));
__device__ __forceinline__ f32x4 mfma16(bf16x8 a, bf16x8 b, f32x4 c) { return __builtin_amdgcn_mfma_f32_16x16x32_bf16(a, b, c, 0, 0, 0); }
__device__ __forceinline__ float bflo(unsigned x) { return __uint_as_float(x << 16); }
__device__ __forceinline__ float bfhi(unsigned x) { return __uint_as_float(x & 0xffff0000u); }
constexpr int DA_G = 0, DA_KN = 1024, DA_QN = DA_KN + 17408, DA_VBT = DA_QN + 17408, DA_KBET = DA_VBT + 18432, DA_KDT = DA_KBET + 18432, DA_L = DA_KDT + 18432, DA_TB = DA_L + 16384, DA_QK = DA_TB + 9216, DA_END = DA_QK + 9216;
static_assert(DA_END <= RING_BYTES, "DN-A LDS map");
__device__ __forceinline__ void dna_unit(const bf16* proj, const float* cw, const float* ba, const float* a_log, const float* dt_bias,
                                         bf16* Wf, bf16* Qf, bf16* KdTf, bf16* QKf, bf16* Uf, float* glb, int uid, LAS unsigned char* lds, int tid, int lane, int wave) {
    const int h = uid & 7, n = (uid >> 3) & 127, b = uid >> 10, t0 = b * SEQ + n * 64;
    asm volatile("" : "+v"(lds));
    LAS float* Gs = (LAS float*)(lds + DA_G);
    const int fr = lane & 15, fq = lane >> 4;
    if (wave == 0) {
        const size_t t = (size_t)(t0 + lane);
        const float be = sigmoid_f(ba[t * 16 + h]); float Gc = -__expf(a_log[h]) * softplus_f(ba[t * 16 + 8 + h] + dt_bias[h]);
#pragma unroll
        for (int off = 1; off < 64; off <<= 1) { const float tmp = shfl_up_l(Gc, off, lane); if (lane >= off) Gc += tmp; }
        const float GL = shfl_idx_l(Gc, 63);
        Gs[lane] = Gc; Gs[64 + lane] = be; Gs[128 + lane] = __expf(Gc); Gs[192 + lane] = __expf(GL - Gc);
        if (lane == 63) glb[uid] = __expf(Gc);
    }
    __syncthreads();
    {
        const int r = tid >> 3, cg = tid & 7;
        const float be = Gs[64 + r], eg = Gs[128 + r], egl = Gs[192 + r];
        float val[3][16];
#pragma unroll
        for (int p = 0; p < 3; ++p) {
            const int ccol = p * DDN + h * HD + cg * 16;
            float acc[16];
#pragma unroll
            for (int i = 0; i < 16; ++i) acc[i] = 0.f;
#pragma unroll
            for (int k = 0; k < 4; ++k) { const int row = r - 3 + k;
                if (n * 64 + row >= 0) {
                    const bf16* src = proj + (size_t)(t0 + row) * NPROJ + 2048 + ccol;
                    const u32x4 x0 = *(const u32x4*)src, x1 = *(const u32x4*)(src + 8);
                    const float* wp = cw + k * 3 * DDN + ccol;
                    const f32x4 w0 = *(const f32x4*)wp, w1 = *(const f32x4*)(wp + 4), w2 = *(const f32x4*)(wp + 8), w3 = *(const f32x4*)(wp + 12);
                    acc[0] += w0[0] * bflo(x0.x); acc[1] += w0[1] * bfhi(x0.x); acc[2] += w0[2] * bflo(x0.y); acc[3] += w0[3] * bfhi(x0.y);
                    acc[4] += w1[0] * bflo(x0.z); acc[5] += w1[1] * bfhi(x0.z); acc[6] += w1[2] * bflo(x0.w); acc[7] += w1[3] * bfhi(x0.w);
                    acc[8] += w2[0] * bflo(x1.x); acc[9] += w2[1] * bfhi(x1.x); acc[10] += w2[2] * bflo(x1.y); acc[11] += w2[3] * bfhi(x1.y);
                    acc[12] += w3[0] * bflo(x1.z); acc[13] += w3[1] * bfhi(x1.z); acc[14] += w3[2] * bflo(x1.w); acc[15] += w3[3] * bfhi(x1.w);
                } }
#pragma unroll
            for (int i = 0; i < 16; ++i) val[p][i] = silu_f(acc[i]);
        }
        float sq = 0.f, sk = 0.f;
#pragma unroll
        for (int i = 0; i < 16; ++i) { sq += val[0][i] * val[0][i]; sk += val[1][i] * val[1][i]; }
        sq += shfl_xor_l(sq, 1, lane); sq += shfl_xor_l(sq, 2, lane); sq += shfl_xor_l(sq, 4, lane);
        sk += shfl_xor_l(sk, 1, lane); sk += shfl_xor_l(sk, 2, lane); sk += shfl_xor_l(sk, 4, lane);
        const float rq = (1.0f / sqrtf(sq + EPS)) * 0.08838834764831845f, rk = 1.0f / sqrtf(sk + EPS);
#pragma unroll
        for (int i = 0; i < 16; ++i) { val[0][i] *= rq; val[1][i] *= rk; }
        u32x4 o0, o1;
        o0.x = pk2(val[1][0], val[1][1]); o0.y = pk2(val[1][2], val[1][3]); o0.z = pk2(val[1][4], val[1][5]); o0.w = pk2(val[1][6], val[1][7]);
        o1.x = pk2(val[1][8], val[1][9]); o1.y = pk2(val[1][10], val[1][11]); o1.z = pk2(val[1][12], val[1][13]); o1.w = pk2(val[1][14], val[1][15]);
        *(LAS u32x4*)(lds + DA_KN + r * 272 + cg * 32) = o0; *(LAS u32x4*)(lds + DA_KN + r * 272 + cg * 32 + 16) = o1;
        o0.x = pk2(val[0][0], val[0][1]); o0.y = pk2(val[0][2], val[0][3]); o0.z = pk2(val[0][4], val[0][5]); o0.w = pk2(val[0][6], val[0][7]);
        o1.x = pk2(val[0][8], val[0][9]); o1.y = pk2(val[0][10], val[0][11]); o1.z = pk2(val[0][12], val[0][13]); o1.w = pk2(val[0][14], val[0][15]);
        *(LAS u32x4*)(lds + DA_QN + r * 272 + cg * 32) = o0; *(LAS u32x4*)(lds + DA_QN + r * 272 + cg * 32 + 16) = o1;
#pragma unroll
        for (int i = 0; i < 16; ++i) { const int f = cg * 16 + i;
            *(LAS unsigned short*)(lds + DA_VBT + f * 144 + r * 2) = (unsigned short)f2bf(val[2][i] * be);
            *(LAS unsigned short*)(lds + DA_KBET + f * 144 + r * 2) = (unsigned short)f2bf(val[1][i] * (be * eg));
            *(LAS unsigned short*)(lds + DA_KDT + f * 144 + r * 2) = (unsigned short)f2bf(val[1][i] * egl); }
    }
    __syncthreads();
    {
        const int p = wave >> 2, ti = wave & 3;
        const int abase = p == 0 ? DA_KN : DA_QN;
        bf16x8 af[4];
#pragma unroll
        for (int ks = 0; ks < 4; ++ks) af[ks] = *(const LAS bf16x8*)(lds + abase + (ti * 16 + fr) * 272 + (ks * 32 + fq * 8) * 2);
        for (int tj = 0; tj < 4; ++tj) {
            f32x4 acc = {0.f, 0.f, 0.f, 0.f};
            if (tj <= ti) {
#pragma unroll
                for (int ks = 0; ks < 4; ++ks) { const bf16x8 bb = *(const LAS bf16x8*)(lds + DA_KN + (tj * 16 + fr) * 272 + (ks * 32 + fq * 8) * 2); acc = mfma16(af[ks], bb, acc); }
            }
            const int j = tj * 16 + fr; const float Gj = Gs[j];
#pragma unroll
            for (int r = 0; r < 4; ++r) { const int i = ti * 16 + fq * 4 + r; float v = 0.f;
                if (p == 0) { if (i > j) v = Gs[64 + i] * acc[r] * __expf(Gs[i] - Gj); *(LAS float*)(lds + DA_L + (i * 64 + j) * 4) = v; }
                else { if (i >= j) v = acc[r] * __expf(Gs[i] - Gj); *(LAS unsigned short*)(lds + DA_QK + i * 144 + j * 2) = (unsigned short)f2bf(v); } }
        }
    }
    __syncthreads();
    if (wave == 0) {
        float Tc[64]; int lc = lane; asm volatile("" : "+v"(lc)); const float fl = (float)lc;
#pragma unroll
        for (int i = 0; i < 64; ++i) {
            float a = fmaxf(0.f, 1.f - fabsf(fl - (float)i));
            const LAS float* Lr = (const LAS float*)(lds + DA_L) + i * 64;
#pragma unroll
            for (int j = 0; j < i; ++j) a -= Lr[j] * Tc[j];
            Tc[i] = a;
        }
#pragma unroll
        for (int i = 0; i < 64; ++i) *(LAS unsigned short*)(lds + DA_TB + i * 144 + lc * 2) = (unsigned short)f2bf(Tc[i]);
    } else {
        for (int fi = wave - 1; fi < 40; fi += 7) {
            if (fi < 8) { const int mt = fi >> 1, ks = fi & 1;
                const u32x4 v = *(const LAS u32x4*)(lds + DA_QK + (mt * 16 + fr) * 144 + (ks * 32 + fq * 8) * 2);
                *(u32x4*)(QKf + (((size_t)uid * 4 + mt) * 2 + ks) * 512 + lane * 8) = v; }
            else if (fi < 24) { const int f2 = fi - 8, mt = f2 >> 2, ks = f2 & 3; const float eg = Gs[128 + mt * 16 + fr];
                const u32x4 v = *(const LAS u32x4*)(lds + DA_QN + (mt * 16 + fr) * 272 + (ks * 32 + fq * 8) * 2); u32x4 o;
                o.x = pk2(bflo(v.x) * eg, bfhi(v.x) * eg); o.y = pk2(bflo(v.y) * eg, bfhi(v.y) * eg); o.z = pk2(bflo(v.z) * eg, bfhi(v.z) * eg); o.w = pk2(bflo(v.w) * eg, bfhi(v.w) * eg);
                *(u32x4*)(Qf + (((size_t)uid * 4 + mt) * 4 + ks) * 512 + lane * 8) = o; }
            else { const int f2 = fi - 24, ft = f2 >> 1, ks = f2 & 1;
                const u32x4 v = *(const LAS u32x4*)(lds + DA_KDT + (ft * 16 + fr) * 144 + (ks * 32 + fq * 8) * 2);
                *(u32x4*)(KdTf + (((size_t)uid * 8 + ft) * 2 + ks) * 512 + lane * 8) = v; }
        }
    }
    __syncthreads();
    {
        bf16x8 ta[4][2];
#pragma unroll
        for (int mt = 0; mt < 4; ++mt)
#pragma unroll
            for (int ks = 0; ks < 2; ++ks) ta[mt][ks] = *(const LAS bf16x8*)(lds + DA_TB + (mt * 16 + fr) * 144 + (ks * 32 + fq * 8) * 2);
#pragma unroll
        for (int c2 = 0; c2 < 2; ++c2) { const int ct = wave * 2 + c2, img = ct < 8 ? DA_VBT : DA_KBET, cr = (ct & 7) * 16 + fr;
            bf16x8 bb[2];
#pragma unroll
            for (int ks = 0; ks < 2; ++ks) bb[ks] = *(const LAS bf16x8*)(lds + img + cr * 144 + (ks * 32 + fq * 8) * 2);
#pragma unroll
            for (int mt = 0; mt < 4; ++mt) { f32x4 acc = {0.f, 0.f, 0.f, 0.f};
#pragma unroll
                for (int ks = 0; ks < 2; ++ks) acc = mfma16(ta[mt][ks], bb[ks], acc);
                if (ct < 8) { u32x2 o; o.x = pk2(acc[0], acc[1]); o.y = pk2(acc[2], acc[3]); *(u32x2*)(Uf + ((((size_t)uid * 8 + ct) * 4 + mt) * 64 + lane) * 4) = o; }
                else { const int f = (ct - 8) * 16 + fr;
#pragma unroll
                    for (int r = 0; r < 4; ++r) *(LAS unsigned short*)(lds + DA_KN + (mt * 16 + fq * 4 + r) * 272 + f * 2) = (unsigned short)f2bf(acc[r]); } }
        }
    }
    __syncthreads();
#pragma unroll
    for (int q2 = 0; q2 < 2; ++q2) { const int fi = wave * 2 + q2, mt = fi >> 2, ks = fi & 3;
        const u32x4 v = *(const LAS u32x4*)(lds + DA_KN + (mt * 16 + fr) * 272 + (ks * 32 + fq * 8) * 2);
        *(u32x4*)(Wf + (((size_t)uid * 4 + mt) * 4 + ks) * 512 + lane * 8) = v; }
    __syncthreads();
}
struct DnbFrag { bf16x8 a1[4]; bf16x8 a2[2]; bf16x8 kd[2]; u32x2 u; float gl; };
__device__ __forceinline__ DnbFrag dnb_load(const bf16* A1, const bf16* QKf, const bf16* KdTf, const bf16* Uf, const float* glb, int uid, int ds, int wave, int lane) {
    DnbFrag f; const int mt = wave & 3;
#pragma unroll
    for (int ks = 0; ks < 4; ++ks) f.a1[ks] = *(const bf16x8*)(A1 + (((size_t)uid * 4 + mt) * 4 + ks) * 512 + lane * 8);
#pragma unroll
    for (int ks = 0; ks < 2; ++ks) f.kd[ks] = *(const bf16x8*)(KdTf + (((size_t)uid * 8 + wave) * 2 + ks) * 512 + lane * 8);
    if (wave >= 4) {
#pragma unroll
        for (int ks = 0; ks < 2; ++ks) f.a2[ks] = *(const bf16x8*)(QKf + (((size_t)uid * 4 + mt) * 2 + ks) * 512 + lane * 8);
        f.u = (u32x2){0u, 0u};
    } else {
        f.a2[0] = f.a1[0]; f.a2[1] = f.a1[1];
        f.u = *(const u32x2*)(Uf + ((((size_t)uid * 8 + ds) * 4 + mt) * 64 + lane) * 4);
    }
    f.gl = glb[uid];
    return f;
}
__device__ __forceinline__ void dnb_run(const bf16* Wf, const bf16* Qf, const bf16* KdTf, const bf16* QKf, const bf16* Uf, const float* glb, float* o, int bh, int ds, LAS unsigned char* lds, int tid, int lane, int wave) {
    const int b = bh >> 3, h = bh & 7, fr = lane & 15, fq = lane >> 4, mt = wave & 3;
    asm volatile("" : "+v"(lds));
    LAS unsigned char* ST = lds; LAS unsigned char* VNT = lds + 4608;
    for (int i = tid; i < 4608 / 4; i += 512) ((LAS unsigned*)ST)[i] = 0u;
    f32x4 accS = {0.f, 0.f, 0.f, 0.f};
    const bf16* A1 = wave < 4 ? Wf : Qf;
    DnbFrag f0 = dnb_load(A1, QKf, KdTf, Uf, glb, (b * 128 + 0) * 8 + h, ds, wave, lane), f1 = dnb_load(A1, QKf, KdTf, Uf, glb, (b * 128 + 1) * 8 + h, ds, wave, lane);
    DnbFrag f2 = dnb_load(A1, QKf, KdTf, Uf, glb, (b * 128 + 2) * 8 + h, ds, wave, lane), f3 = dnb_load(A1, QKf, KdTf, Uf, glb, (b * 128 + 3) * 8 + h, ds, wave, lane);
    __syncthreads();
#define DNB_STEP(F, nn) do { const int n = (nn); \
        f32x4 acc = {0.f, 0.f, 0.f, 0.f}; \
        _Pragma("unroll") for (int ks = 0; ks < 4; ++ks) { const bf16x8 sb = *(const LAS bf16x8*)(ST + fr * 272 + (ks * 32 + fq * 8) * 2); acc = mfma16(F.a1[ks], sb, acc); } \
        if (wave < 4) { const float v0 = bflo(F.u.x) - acc[0], v1 = bfhi(F.u.x) - acc[1], v2 = bflo(F.u.y) - acc[2], v3 = bfhi(F.u.y) - acc[3]; \
            u32x2 w; w.x = pk2(v0, v1); w.y = pk2(v2, v3); *(LAS u32x2*)(VNT + fr * 144 + (mt * 16 + fq * 4) * 2) = w; } \
        LDS_BARRIER(); \
        bf16x8 vb[2]; \
        _Pragma("unroll") for (int ks = 0; ks < 2; ++ks) vb[ks] = *(const LAS bf16x8*)(VNT + fr * 144 + (ks * 32 + fq * 8) * 2); \
        if (wave >= 4) { _Pragma("unroll") for (int ks = 0; ks < 2; ++ks) acc = mfma16(F.a2[ks], vb[ks], acc); \
            const size_t ob = ((size_t)(b * SEQ + n * 64 + mt * 16 + fq * 4) * NH + h) * HD + ds * 16 + fr; \
            _Pragma("unroll") for (int r = 0; r < 4; ++r) o[ob + (size_t)r * NH * HD] = acc[r]; } \
        accS = accS * F.gl; \
        _Pragma("unroll") for (int ks = 0; ks < 2; ++ks) accS = mfma16(F.kd[ks], vb[ks], accS); \
        { u32x2 w; w.x = pk2(accS[0], accS[1]); w.y = pk2(accS[2], accS[3]); *(LAS u32x2*)(ST + fr * 272 + (wave * 16 + fq * 4) * 2) = w; } \
        if (n + 4 < 128) F = dnb_load(A1, QKf, KdTf, Uf, glb, (b * 128 + n + 4) * 8 + h, ds, wave, lane); \
        LDS_BARRIER(); } while (0)
    for (int n4 = 0; n4 < 128; n4 += 4) { DNB_STEP(f0, n4); DNB_STEP(f1, n4 + 1); DNB_STEP(f2, n4 + 2); DNB_STEP(f3, n4 + 3); }
#undef DNB_STEP
}
constexpr int LA_XB = 0, LA_XF = 17408, LA_END = LA_XF + 64 * 132 * 4;
static_assert(LA_END <= RING_BYTES, "LRU-A LDS map");
__device__ __forceinline__ void lrua_unit(const bf16* proj, const float* cw, const float* cb, const bf16* WrT, const bf16* WiT, const float* b_r, const float* b_i, const float* lam,
                                          float* Hloc, float* Acum, float* summ, int unit, LAS unsigned char* lds, int tid, int lane, int wave) {
    const int nb = unit & 7, ct = unit >> 3, n = ct & 127, t0 = ct * 64;
    asm volatile("" : "+v"(lds));
    {
        const int r = tid >> 3, cg = tid & 7, ch0 = nb * 128 + cg * 16;
        float acc[16];
        { const f32x4 c0v = *(const f32x4*)(cb + ch0), c1v = *(const f32x4*)(cb + ch0 + 4), c2v = *(const f32x4*)(cb + ch0 + 8), c3v = *(const f32x4*)(cb + ch0 + 12);
#pragma unroll
          for (int i = 0; i < 4; ++i) { acc[i] = c0v[i]; acc[4 + i] = c1v[i]; acc[8 + i] = c2v[i]; acc[12 + i] = c3v[i]; } }
#pragma unroll
        for (int k = 0; k < 4; ++k) { const int row = r - 3 + k;
            if (n * 64 + row >= 0) {
                const bf16* src = proj + (size_t)(t0 + row) * NPROJ + ch0;
                const u32x4 x0 = *(const u32x4*)src, x1 = *(const u32x4*)(src + 8);
                const float* wp = cw + k * DLRU + ch0;
                const f32x4 w0 = *(const f32x4*)wp, w1 = *(const f32x4*)(wp + 4), w2 = *(const f32x4*)(wp + 8), w3 = *(const f32x4*)(wp + 12);
                acc[0] += w0[0] * bflo(x0.x); acc[1] += w0[1] * bfhi(x0.x); acc[2] += w0[2] * bflo(x0.y); acc[3] += w0[3] * bfhi(x0.y);
                acc[4] += w1[0] * bflo(x0.z); acc[5] += w1[1] * bfhi(x0.z); acc[6] += w1[2] * bflo(x0.w); acc[7] += w1[3] * bfhi(x0.w);
                acc[8] += w2[0] * bflo(x1.x); acc[9] += w2[1] * bfhi(x1.x); acc[10] += w2[2] * bflo(x1.y); acc[11] += w2[3] * bfhi(x1.y);
                acc[12] += w3[0] * bflo(x1.z); acc[13] += w3[1] * bfhi(x1.z); acc[14] += w3[2] * bflo(x1.w); acc[15] += w3[3] * bfhi(x1.w);
            } }
        u32x4 o0, o1;
        o0.x = pk2(acc[0], acc[1]); o0.y = pk2(acc[2], acc[3]); o0.z = pk2(acc[4], acc[5]); o0.w = pk2(acc[6], acc[7]);
        o1.x = pk2(acc[8], acc[9]); o1.y = pk2(acc[10], acc[11]); o1.z = pk2(acc[12], acc[13]); o1.w = pk2(acc[14], acc[15]);
        *(LAS u32x4*)(lds + LA_XB + r * 272 + cg * 32) = o0; *(LAS u32x4*)(lds + LA_XB + r * 272 + cg * 32 + 16) = o1;
        LAS f32x4* xf = (LAS f32x4*)(lds + LA_XF + (r * 132 + cg * 16) * 4);
        xf[0] = (f32x4){acc[0], acc[1], acc[2], acc[3]}; xf[1] = (f32x4){acc[4], acc[5], acc[6], acc[7]}; xf[2] = (f32x4){acc[8], acc[9], acc[10], acc[11]}; xf[3] = (f32x4){acc[12], acc[13], acc[14], acc[15]};
    }
    __syncthreads();
    const int fr = lane & 15, fq = lane >> 4, cl = wave * 16 + fr, ch = nb * 128 + cl;
    bf16x8 br[4], bi[4];
#pragma unroll
    for (int ks = 0; ks < 4; ++ks) { br[ks] = *(const bf16x8*)(WrT + ((size_t)nb * 128 + cl) * 128 + ks * 32 + fq * 8); bi[ks] = *(const bf16x8*)(WiT + ((size_t)nb * 128 + cl) * 128 + ks * 32 + fq * 8); }
    f32x4 ar[4], ai[4];
#pragma unroll
    for (int mt = 0; mt < 4; ++mt) { ar[mt] = (f32x4){0.f, 0.f, 0.f, 0.f}; ai[mt] = (f32x4){0.f, 0.f, 0.f, 0.f};
#pragma unroll
        for (int ks = 0; ks < 4; ++ks) { const bf16x8 af = *(const LAS bf16x8*)(lds + LA_XB + (mt * 16 + fr) * 272 + (ks * 32 + fq * 8) * 2); ar[mt] = mfma16(af, br[ks], ar[mt]); ai[mt] = mfma16(af, bi[ks], ai[mt]); } }
    const float brr = b_r[ch], bii = b_i[ch], sp8 = -8.0f * softplus_f(-lam[ch]);
    float Ac = 1.f, Bc = 0.f;
#pragma unroll
    for (int mt = 0; mt < 4; ++mt) {
        float P[4], H[4];
#pragma unroll
        for (int r = 0; r < 4; ++r) { const int t = mt * 16 + fq * 4 + r; const float xcv = *(const LAS float*)(lds + LA_XF + (t * 132 + cl) * 4);
            const float rr = sigmoid_f(ar[mt][r] + brr), ii = sigmoid_f(ai[mt][r] + bii), la = sp8 * rr, a = __expf(la), bb = sqrtf(-expm1f(2.0f * la)) * (ii * xcv);
            if (r == 0) { P[0] = a; H[0] = bb; } else { P[r] = P[r - 1] * a; H[r] = a * H[r - 1] + bb; } }
        float Ai = P[3], Bi = H[3];
        { const float Au = shfl_up_l(Ai, 16, lane), Bu = shfl_up_l(Bi, 16, lane); if (fq >= 1) { Bi = Ai * Bu + Bi; Ai = Au * Ai; } }
        { const float Au = shfl_up_l(Ai, 32, lane), Bu = shfl_up_l(Bi, 32, lane); if (fq >= 2) { Bi = Ai * Bu + Bi; Ai = Au * Ai; } }
        float Ae = shfl_up_l(Ai, 16, lane), Be = shfl_up_l(Bi, 16, lane); if (fq == 0) { Ae = 1.f; Be = 0.f; }
        const float At = shfl_idx_l(Ai, 48 + fr), Bt = shfl_idx_l(Bi, 48 + fr);
        const float PA = Ac * Ae, PB = Ae * Bc + Be;
#pragma unroll
        for (int r = 0; r < 4; ++r) { const size_t o = (size_t)(t0 + mt * 16 + fq * 4 + r) * DLRU + ch; Acum[o] = PA * P[r]; Hloc[o] = P[r] * PB + H[r]; }
        Bc = At * Bc + Bt; Ac = Ac * At;
    }
    if (fq == 0) { float* sp = summ + ((size_t)ct * DLRU + ch) * 2; sp[0] = Ac; sp[1] = Bc; }
    __syncthreads();
}
__device__ __forceinline__ void lru_carry(const float* summ, float* carry, int idx) {
    const int b = idx >> 10, ch = idx & 1023; float c = 0.f;
    for (int n0 = 0; n0 < 128; n0 += 8) { float A[8], B[8];
#pragma unroll
        for (int j = 0; j < 8; ++j) { const float* sp = summ + ((size_t)(b * 128 + n0 + j) * DLRU + ch) * 2; A[j] = sp[0]; B[j] = sp[1]; }
#pragma unroll
        for (int j = 0; j < 8; ++j) { carry[(size_t)(b * 128 + n0 + j) * DLRU + ch] = c; c = A[j] * c + B[j]; } }
}
__device__ __forceinline__ void lrub_row(const float* Hloc, const float* Acum, const float* carry, const bf16* proj, const float* gain, bf16* ymix, int row, int lane) {
    const int ct = row >> 6; f32x4 y[4]; float ss = 0.f;
#pragma unroll
    for (int j = 0; j < 4; ++j) { const int c4 = lane * 4 + 256 * j;
        const f32x4 hl = *(const f32x4*)(Hloc + (size_t)row * DLRU + c4), ac = *(const f32x4*)(Acum + (size_t)row * DLRU + c4), cr = *(const f32x4*)(carry + (size_t)ct * DLRU + c4);
        const u32x2 g = *(const u32x2*)(proj + (size_t)row * NPROJ + DLRU + c4);
        const f32x4 hh = hl + ac * cr;
        y[j][0] = hh[0] * gelu_tanh_f(bflo(g.x)); y[j][1] = hh[1] * gelu_tanh_f(bfhi(g.x)); y[j][2] = hh[2] * gelu_tanh_f(bflo(g.y)); y[j][3] = hh[3] * gelu_tanh_f(bfhi(g.y));
        ss += (y[j][0] * y[j][0] + y[j][1] * y[j][1]) + (y[j][2] * y[j][2] + y[j][3] * y[j][3]); }
    ss = wave_sum(ss, lane); const float rs = 1.0f / sqrtf(ss * (1.0f / DLRU) + EPS);
#pragma unroll
    for (int j = 0; j < 4; ++j) { const int c4 = lane * 4 + 256 * j; const f32x4 g = *(const f32x4*)(gain + c4); u32x2 w; w.x = pk2(y[j][0] * rs * g[0], y[j][1] * rs * g[1]); w.y = pk2(y[j][2] * rs * g[2], y[j][3] * rs * g[3]);
        *(u32x2*)(ymix + (size_t)row * D + c4) = w; }
}
__device__ __forceinline__ void dn_out_row(const float* o, const float* gain, const bf16* proj, bf16* ymix, int t, int lane) {
    const int c = lane * 16;
    const f32x4* op = (const f32x4*)(o + (size_t)t * DDN + c); const f32x4 o0 = op[0], o1 = op[1], o2 = op[2], o3 = op[3];
    const u32x4* gp = (const u32x4*)(proj + (size_t)t * NPROJ + 5120 + c); const u32x4 g0 = gp[0], g1 = gp[1];
    const f32x4* wp = (const f32x4*)(gain + (c & 127)); const f32x4 w0 = wp[0], w1 = wp[1], w2 = wp[2], w3 = wp[3];
    float ss = (o0[0] * o0[0] + o0[1] * o0[1]) + (o0[2] * o0[2] + o0[3] * o0[3]) + (o1[0] * o1[0] + o1[1] * o1[1]) + (o1[2] * o1[2] + o1[3] * o1[3])
             + (o2[0] * o2[0] + o2[1] * o2[1]) + (o2[2] * o2[2] + o2[3] * o2[3]) + (o3[0] * o3[0] + o3[1] * o3[1]) + (o3[2] * o3[2] + o3[3] * o3[3]);
    ss += shfl_xor_l(ss, 1, lane); ss += shfl_xor_l(ss, 2, lane); ss += shfl_xor_l(ss, 4, lane);
    const float rs = 1.0f / sqrtf(ss * (1.0f / HD) + EPS);
    u32x4 r0, r1;
    r0.x = pk2(o0[0] * rs * w0[0] * silu_f(bflo(g0.x)), o0[1] * rs * w0[1] * silu_f(bfhi(g0.x))); r0.y = pk2(o0[2] * rs * w0[2] * silu_f(bflo(g0.y)), o0[3] * rs * w0[3] * silu_f(bfhi(g0.y)));
    r0.z = pk2(o1[0] * rs * w1[0] * silu_f(bflo(g0.z)), o1[1] * rs * w1[1] * silu_f(bfhi(g0.z))); r0.w = pk2(o1[2] * rs * w1[2] * silu_f(bflo(g0.w)), o1[3] * rs * w1[3] * silu_f(bfhi(g0.w)));
    r1.x = pk2(o2[0] * rs * w2[0] * silu_f(bflo(g1.x)), o2[1] * rs * w2[1] * silu_f(bfhi(g1.x))); r1.y = pk2(o2[2] * rs * w2[2] * silu_f(bflo(g1.y)), o2[3] * rs * w2[3] * silu_f(bfhi(g1.y)));
    r1.z = pk2(o3[0] * rs * w3[0] * silu_f(bflo(g1.z)), o3[1] * rs * w3[1] * silu_f(bfhi(g1.z))); r1.w = pk2(o3[2] * rs * w3[2] * silu_f(bflo(g1.w)), o3[3] * rs * w3[3] * silu_f(bfhi(g1.w)));
    u32x4* dst = (u32x4*)(ymix + (size_t)t * D + DLRU + c); dst[0] = r0; dst[1] = r1;
}
__device__ __forceinline__ void route_row(const float* x, const float* rstd, const float* gain, const float* router, float* roww, int row, int lane) {
    float acc[8];
#pragma unroll
    for (int e = 0; e < 8; ++e) acc[e] = 0.f;
    for (int j = 0; j < 32; ++j) { const int k = lane + 64 * j; const float xv = x[(size_t)row * D + k] * gain[k]; const f32x4 r0 = *(const f32x4*)(router + (size_t)k * 8), r1 = *(const f32x4*)(router + (size_t)k * 8 + 4);
        acc[0] += xv * r0[0]; acc[1] += xv * r0[1]; acc[2] += xv * r0[2]; acc[3] += xv * r0[3]; acc[4] += xv * r1[0]; acc[5] += xv * r1[1]; acc[6] += xv * r1[2]; acc[7] += xv * r1[3]; }
    const float rs = rstd[row];
#pragma unroll
    for (int e = 0; e < 8; ++e) acc[e] = wave_sum(acc[e], lane) * rs;
    int e1 = 0; float l1 = acc[0];
#pragma unroll
    for (int e = 1; e < 8; ++e) if (acc[e] > l1) { l1 = acc[e]; e1 = e; }
    int e2 = -1; float l2 = -3.4e38f;
#pragma unroll
    for (int e = 0; e < 8; ++e) if (e != e1 && acc[e] > l2) { l2 = acc[e]; e2 = e; }
    const float w1 = 1.0f / (1.0f + __expf(l2 - l1)), w2 = 1.0f - w1;
    if (lane < 8) roww[(size_t)lane * T + row] = lane == e1 ? w1 : (lane == e2 ? w2 : 0.0f);
}
__device__ __forceinline__ void final_row(const float* x, const float* gain, float* out, int row, int lane) {
    const f32x4* xr = (const f32x4*)(x + (size_t)row * D) + lane; const f32x4* gr = (const f32x4*)gain + lane;
    f32x4 v[8]; float ss = 0.f;
#pragma unroll
    for (int j = 0; j < 8; ++j) { v[j] = xr[64 * j]; ss += (v[j][0] * v[j][0] + v[j][1] * v[j][1]) + (v[j][2] * v[j][2] + v[j][3] * v[j][3]); }
    ss = wave_sum(ss, lane); const float rs = 1.0f / sqrtf(ss * (1.0f / D) + EPS);
    f32x4* o = (f32x4*)(out + (size_t)row * D) + lane;
#pragma unroll
    for (int j = 0; j < 8; ++j) o[64 * j] = v[j] * rs * gr[64 * j];
}

struct MoeOrder {
    const int* list; int nN, G, c; int c0, c1, c2, c3, c4, c5, c6, c7;
    __device__ __forceinline__ void init(const unsigned* cnt, const int* list_, int nN_, int G_, int c_) { list = list_; nN = nN_; G = G_; c = c_;
        c0 = __builtin_amdgcn_readfirstlane((int)cnt[0]); c1 = __builtin_amdgcn_readfirstlane((int)cnt[1]); c2 = __builtin_amdgcn_readfirstlane((int)cnt[2]); c3 = __builtin_amdgcn_readfirstlane((int)cnt[3]);
        c4 = __builtin_amdgcn_readfirstlane((int)cnt[4]); c5 = __builtin_amdgcn_readfirstlane((int)cnt[5]); c6 = __builtin_amdgcn_readfirstlane((int)cnt[6]); c7 = __builtin_amdgcn_readfirstlane((int)cnt[7]); }
    __device__ __forceinline__ bool next(int i, pg8::Unit& u) const {
        const int c8[8] = {c0, c1, c2, c3, c4, c5, c6, c7}; int nM = 0;
#pragma unroll
        for (int k = 0; k < 8; ++k) nM += (c8[k] + 255) >> 8;
        const int nwg = nM * nN; const long L = (long)i * G + c; if (L >= nwg) return false;
        int wgid = (int)L; { const int q = nwg / pg8::NXCD, r = nwg % pg8::NXCD, xcd = wgid % pg8::NXCD, off = wgid / pg8::NXCD; wgid = (xcd < r ? xcd * (q + 1) : r * (q + 1) + (xcd - r) * q) + off; }
        const int nig = pg8::WGM * nN, gid = wgid / nig, fm = gid * pg8::WGM, gsz = (nM - fm) < pg8::WGM ? (nM - fm) : pg8::WGM;
        u.pm = fm + ((wgid % nig) % gsz); u.pn = (wgid % nig) / gsz;
        int e = 0, ps = 0, ce = c8[0], run = 0;
#pragma unroll
        for (int k = 0; k < 8; ++k) { const int mk = (c8[k] + 255) >> 8; if (u.pm >= run && u.pm < run + mk) { e = k; ps = run; ce = c8[k]; } run += mk; }
        const int mtl = u.pm - ps; u.pb = e * nN + u.pn; u.lbase = e * T + mtl * 256; u.nvalid = (ce - mtl * 256) < 256 ? (ce - mtl * 256) : 256;
        return true;
    }
    __device__ __forceinline__ int arow(const pg8::Unit& u, int r) const { return r < u.nvalid ? (list[u.lbase + r] & 0xffff) : 0; }
    __device__ __forceinline__ void a_ready(const pg8::Unit&) const {}
    __device__ __forceinline__ void done(const pg8::Unit&) const {}
};
__device__ __forceinline__ void route_block(const float* x, const float* gain, const float* router, bf16* xb, float* rstd, unsigned* cnt, int* list, float* listw, int blk, LAS unsigned char* lds, int tid, int lane, int wave) {
    asm volatile("" : "+v"(lds));
    LAS float* grt = (LAS float*)lds; LAS int* se1 = (LAS int*)(lds + 65536); LAS int* se2 = se1 + 64; LAS float* sw1 = (LAS float*)(se2 + 64); LAS float* sw2 = sw1 + 64; LAS int* lcnt = (LAS int*)(sw2 + 64); LAS int* gbase = lcnt + 8;
    for (int i = tid; i < D * 8; i += 512) grt[i] = router[i] * gain[i >> 3];
    if (tid < 8) lcnt[tid] = 0;
    __syncthreads();
    for (int q = 0; q < 8; ++q) { const int rloc = wave * 8 + q, row = blk * 64 + rloc;
        const f32x4* xr = (const f32x4*)(x + (size_t)row * D) + lane;
        f32x4 v[8]; float ss = 0.f;
#pragma unroll
        for (int j = 0; j < 8; ++j) { v[j] = xr[64 * j]; ss += (v[j][0] * v[j][0] + v[j][1] * v[j][1]) + (v[j][2] * v[j][2] + v[j][3] * v[j][3]); }
        ss = wave_sum(ss, lane); const float rs = 1.0f / sqrtf(ss * (1.0f / D) + EPS);
        u32x2* o = (u32x2*)(xb + (size_t)row * D) + lane;
#pragma unroll
        for (int j = 0; j < 8; ++j) { u32x2 w; w.x = pk2(v[j][0], v[j][1]); w.y = pk2(v[j][2], v[j][3]); o[64 * j] = w; }
        if (lane == 0) rstd[row] = rs;
        float acc[8];
#pragma unroll
        for (int e = 0; e < 8; ++e) acc[e] = 0.f;
#pragma unroll
        for (int j = 0; j < 8; ++j)
#pragma unroll
            for (int c = 0; c < 4; ++c) { const int k = (lane + 64 * j) * 4 + c; const f32x4 r0 = *(const LAS f32x4*)(grt + k * 8), r1 = *(const LAS f32x4*)(grt + k * 8 + 4); const float xv = v[j][c];
                acc[0] += xv * r0[0]; acc[1] += xv * r0[1]; acc[2] += xv * r0[2]; acc[3] += xv * r0[3]; acc[4] += xv * r1[0]; acc[5] += xv * r1[1]; acc[6] += xv * r1[2]; acc[7] += xv * r1[3]; }
#pragma unroll
        for (int e = 0; e < 8; ++e) acc[e] = wave_sum(acc[e], lane) * rs;
        int e1 = 0; float l1 = acc[0];
#pragma unroll
        for (int e = 1; e < 8; ++e) if (acc[e] > l1) { l1 = acc[e]; e1 = e; }
        int e2 = -1; float l2 = -3.4e38f;
#pragma unroll
        for (int e = 0; e < 8; ++e) if (e != e1 && acc[e] > l2) { l2 = acc[e]; e2 = e; }
        const float w1 = 1.0f / (1.0f + __expf(l2 - l1));
        if (lane == 0) { se1[rloc] = e1; se2[rloc] = e2; sw1[rloc] = w1; sw2[rloc] = 1.0f - w1; }
    }
    __syncthreads();
    int e = 0, lr = 0; float w = 0.f;
    if (tid < 128) { const int rloc = tid >> 1, j = tid & 1; e = j ? se2[rloc] : se1[rloc]; w = j ? sw2[rloc] : sw1[rloc]; lr = __hip_atomic_fetch_add(lcnt + e, 1, __ATOMIC_RELAXED, __HIP_MEMORY_SCOPE_WORKGROUP); }
    __syncthreads();
    if (tid < 8) gbase[tid] = (int)__hip_atomic_fetch_add(cnt + tid, (unsigned)lcnt[tid], __ATOMIC_RELAXED, __HIP_MEMORY_SCOPE_AGENT);
    __syncthreads();
    if (tid < 128) { const int pos = gbase[e] + lr, tok = blk * 64 + (tid >> 1); list[e * T + pos] = tok | ((tid & 1) << 16); listw[e * T + pos] = w; }
    __syncthreads();
}
__device__ __forceinline__ void final_row_moe(const float* x, const bf16* y0, const bf16* y1, const float* gain, float* out, int row, int lane) {
    const f32x4* xr = (const f32x4*)(x + (size_t)row * D) + lane; const f32x4* gr = (const f32x4*)gain + lane;
    const u32x2* p0 = (const u32x2*)(y0 + (size_t)row * D) + lane; const u32x2* p1 = (const u32x2*)(y1 + (size_t)row * D) + lane;
    f32x4 v[8]; float ss = 0.f;
#pragma unroll
    for (int j = 0; j < 8; ++j) { v[j] = xr[64 * j]; const u32x2 a = p0[64 * j], b = p1[64 * j];
        v[j][0] += bflo(a.x) + bflo(b.x); v[j][1] += bfhi(a.x) + bfhi(b.x); v[j][2] += bflo(a.y) + bflo(b.y); v[j][3] += bfhi(a.y) + bfhi(b.y);
        ss += (v[j][0] * v[j][0] + v[j][1] * v[j][1]) + (v[j][2] * v[j][2] + v[j][3] * v[j][3]); }
    ss = wave_sum(ss, lane); const float rs = 1.0f / sqrtf(ss * (1.0f / D) + EPS);
    f32x4* o = (f32x4*)(out + (size_t)row * D) + lane;
#pragma unroll
    for (int j = 0; j < 8; ++j) o[64 * j] = v[j] * rs * gr[64 * j];
}
struct Args { const float* in[25]; float* out; unsigned char* ws; int ph_lo, ph_hi; };
typedef const __attribute__((address_space(4))) unsigned long long* kaptr_t;
__device__ __forceinline__ unsigned long long ldka(int i) { kaptr_t ka = (kaptr_t)__builtin_amdgcn_kernarg_segment_ptr(); asm volatile("" : "+s"(i)); return ka[i]; }
__device__ __forceinline__ const float* ldin(const Args&, int i) { return (const float*)ldka(i); }
__device__ __forceinline__ unsigned char* ldws(const Args&) { return (unsigned char*)ldka(26); }
__device__ __forceinline__ float* ldout(const Args&) { return (float*)ldka(25); }
__global__ void __launch_bounds__(512, 2) mega(Args args) {
    extern __shared__ __attribute__((aligned(16))) unsigned char lds_raw[];
    LAS unsigned char* lds = (LAS unsigned char*)lds_raw;
    volatile LAS unsigned* MISC = (volatile LAS unsigned*)(lds + MISC_OFF);
    const int tid = threadIdx.x;
    const int G = gridDim.x, bid = blockIdx.x, NGW = G * 8;
    unsigned char* ws = ldws(args);
    for (int u = tid; u < (LDS_BYTES - LDSCTL_OFF) / 4; u += 512) ((LAS unsigned*)(lds + LDSCTL_OFF))[u] = 0u;
    __syncthreads();
    (void)xcd_barrier_post((unsigned*)(ws + WS_CTL) + CW_BAR, MISC + 8);
#define RUN(id) true
#if defined(PROBE_MASK)
#define STAMP() do { if (threadIdx.x == 0) { ((volatile LAS unsigned long long*)(lds + LDSCTL_OFF + 1024))[nst] = __builtin_amdgcn_s_memrealtime(); } ++nst; } while (0)
#else
#define STAMP() do { } while (0)
#endif
#define SEAM(id) do { XcdBarrier bar_; bar_.bar = (unsigned*)WSP(WS_CTL) + CW_BAR; bar_.x = xb_xcc_id(); bar_.st = (volatile LAS unsigned*)(lds + MISC_OFF) + 8; xcd_barrier(bar_); STAMP(); } while (0)
#if defined(PROBE_MASK)
    int nst = 0; STAMP();
#endif
#define INP(i) ldin(args, (i))
#define WSP(off) (ldws(args) + (off))
#define x_in INP(0)
#define norm_mix INP(1)
#define w_in INP(2)
#define conv_lru_w INP(3)
#define conv_lru_b INP(4)
#define lru_w_r INP(5)
#define lru_b_r INP(6)
#define lru_w_i INP(7)
#define lru_b_i INP(8)
#define lru_lambda INP(9)
#define lru_out_norm INP(10)
#define conv_qkv_w INP(11)
#define dn_a_log INP(12)
#define dn_dt_bias INP(13)
#define dn_out_norm INP(14)
#define w_out INP(15)
#define norm_ffn INP(16)
#define ffn_w_gate INP(17)
#define ffn_w_up INP(18)
#define ffn_w_down INP(19)
#define moe_router INP(20)
#define moe_w_gate INP(21)
#define moe_w_up INP(22)
#define moe_w_down INP(23)
#define norm_final INP(24)
#define xres (ldout(args))
#define Win ((bf16*)WSP(WS_WIN))
#define Wba ((float*)WSP(WS_WBA))
#define Wout ((bf16*)WSP(WS_WOUT))
#define Wgu ((bf16*)WSP(WS_WGU))
#define Wd ((bf16*)WSP(WS_WD))
#define Mgu ((bf16*)WSP(WS_C))
#define Md ((bf16*)WSP(WS_C + (size_t)NEXP * 2 * DFFE * D * 2))
#define MCNT ((unsigned*)WSP(WS_CTL) + CW_CNT)
#define MLIST ((int*)WSP(WS_ROWW))
#define MLISTW ((float*)WSP(WS_ROWW + (size_t)8 * T * 4))
#define YP0 ((bf16*)WSP(WS_XB))
#define YP1 ((bf16*)WSP(WS_YMIX))
#define xb ((bf16*)WSP(WS_XB))
#define rstd ((float*)WSP(WS_RSTD))
#define ba ((float*)WSP(WS_BA))
#define beta ((float*)WSP(WS_BETA))
#define gg ((float*)WSP(WS_G))
#define roww ((float*)WSP(WS_ROWW))
#define proj ((bf16*)WSP(WS_PROJ))
#define hid ((bf16*)WSP(WS_PROJ))
#define ymix ((bf16*)WSP(WS_YMIX))
#define c0 ((float*)WSP(WS_C))
#define c1 ((float*)WSP(WS_C + (size_t)T * 1024 * 4))
#define c2 ((float*)WSP(WS_C + (size_t)2 * T * 1024 * 4))
#define c3 ((float*)WSP(WS_C + (size_t)3 * T * 1024 * 4))
#define LRU_WRT ((bf16*)WSP(WS_WRT))
#define LRU_WIT ((bf16*)WSP(WS_WRT + (size_t)2 * 8 * 128 * 128 * 2))
#define LRU_H ((float*)WSP(WS_C + (size_t)256 * MiB))
#define LRU_A ((float*)WSP(WS_C + (size_t)320 * MiB))
#define LRU_SUMM ((float*)WSP(WS_C + (size_t)384 * MiB))
#define LRU_CARRY ((float*)WSP(WS_C + (size_t)386 * MiB))
#define DN_WF ((bf16*)WSP(WS_C))
#define DN_QF ((bf16*)WSP(WS_C + (size_t)32 * MiB))
#define DN_KDTF ((bf16*)WSP(WS_C + (size_t)64 * MiB))
#define DN_UF ((bf16*)WSP(WS_C + (size_t)96 * MiB))
#define DN_QKF ((bf16*)WSP(WS_C + (size_t)128 * MiB))
#define DN_GL ((float*)WSP(WS_C + (size_t)144 * MiB))
    const int BIG = 1 << 30;
#define PHL int tid_ = threadIdx.x; asm volatile("" : "+v"(tid_)); const int lane_ = tid_ & 63; int bid_ = blockIdx.x; asm volatile("" : "+s"(bid_)); const int gw_ = bid_ * 8 + __builtin_amdgcn_readfirstlane(tid_ >> 6); const size_t gt_ = (size_t)bid_ * 512 + tid_, NGT = (size_t)G * 512; LAS float* scr = (LAS float*)(lds + (gw_ & 7) * 16384);
    if (RUN(ph)) { PHL
        for (int l = 0; l < 2; ++l) {
            convert_matrix(w_in + (size_t)l * D * DIN, DIN, 0, D, NPROJ, norm_mix + l * D, Win + (size_t)l * NPROJ * D, BIG, 0, 0, scr, gw_, NGW, lane_);
            convert_matrix(w_out + (size_t)l * D * D, D, 0, D, D, nullptr, Wout + (size_t)l * D * D, BIG, 0, 0, scr, gw_, NGW, lane_);
            for (size_t i = gt_; i < (size_t)16 * D; i += NGT) { const int j = (int)(i / D), k = (int)(i % D); Wba[(size_t)l * 16 * D + i] = w_in[(size_t)l * D * DIN + (size_t)k * DIN + NPROJ + j] * norm_mix[l * D + k]; }
        }
        for (int m = 0; m < 16; ++m) {
            convert_matrix(lru_w_r + (size_t)m * 128 * 128, 128, 0, 128, 128, nullptr, LRU_WRT + (size_t)m * 128 * 128, BIG, 0, 0, scr, gw_, NGW, lane_);
            convert_matrix(lru_w_i + (size_t)m * 128 * 128, 128, 0, 128, 128, nullptr, LRU_WIT + (size_t)m * 128 * 128, BIG, 0, 0, scr, gw_, NGW, lane_); }
        convert_matrix(ffn_w_gate, DFF, 0, D, DFF, norm_ffn, Wgu, 128, 256, 0, scr, gw_, NGW, lane_);
        convert_matrix(ffn_w_up, DFF, 0, D, DFF, norm_ffn, Wgu, 128, 256, 128, scr, gw_, NGW, lane_);
        convert_matrix(ffn_w_down, D, 0, DFF, D, nullptr, Wd, BIG, 0, 0, scr, gw_, NGW, lane_);
    }
    SEAM(ph);
    int xsel = 0;
#define xcur (xsel ? (const float*)xres : x_in)
    { constexpr int l = 0;
        if (RUN(ph)) { PHL for (int r = gw_; r < T; r += NGW) rowprep_row(xcur, xb, rstd, Wba + (size_t)l * 16 * D, ba, r, lane_); }
        SEAM(ph);
        if (RUN(ph)) { pg8::Gemm g{xb, Win + (size_t)l * NPROJ * D, T, NPROJ, D, 0}; pg8::StaticOrder S; S.init(T, NPROJ, G, bid); pg8::EpiScaleBf16 E{proj, rstd, NPROJ, 0};
            pg8::gemm_phase<pg8::EpiScaleBf16, pg8::StaticOrder, true, false>(lds, g, S, E); }
        SEAM(ph);
        if (RUN(ph)) { PHL
            for (int u = bid_; u < 2048; u += G) lrua_unit(proj, conv_lru_w + (size_t)l * 4 * DLRU, conv_lru_b + l * DLRU, LRU_WRT + (size_t)l * 8 * 128 * 128, LRU_WIT + (size_t)l * 8 * 128 * 128, lru_b_r + l * DLRU, lru_b_i + l * DLRU, lru_lambda + l * DLRU, LRU_H, LRU_A, LRU_SUMM, u, lds, tid_, lane_, gw_ & 7);
            STAMP();
            for (int uid = bid_; uid < 2048; uid += G) dna_unit(proj, conv_qkv_w + (size_t)l * 4 * 3 * DDN, ba, dn_a_log + l * NH, dn_dt_bias + l * NH, DN_WF, DN_QF, DN_KDTF, DN_QKF, DN_UF, DN_GL, uid, lds, tid_, lane_, gw_ & 7); }
        SEAM(ph);
        if (RUN(ph)) { PHL
            if (bid_ < 128) dnb_run(DN_WF, DN_QF, DN_KDTF, DN_QKF, DN_UF, DN_GL, c3, (bid_ & 7) + 8 * (bid_ >> 6), (bid_ >> 3) & 7, lds, tid_, lane_, gw_ & 7);
            else if (bid_ < 136 && tid_ < 256) lru_carry(LRU_SUMM, LRU_CARRY, (bid_ - 128) * 256 + tid_); }
        SEAM(ph);
        if (RUN(ph)) { PHL
            for (int r = gw_; r < T; r += NGW) lrub_row(LRU_H, LRU_A, LRU_CARRY, proj, lru_out_norm + l * DLRU, ymix, r, lane_);
            for (int r = gw_; r < T; r += NGW) dn_out_row(c3, dn_out_norm + l * HD, proj, ymix, r, lane_); }
        SEAM(ph);
        if (RUN(ph)) { { pg8::Gemm g{ymix, Wout + (size_t)l * D * D, T, D, D, 0}; pg8::StaticOrder S; S.init(T, D, G, bid); pg8::EpiResidual E{xcur, xres, nullptr, D, 0};
            pg8::gemm_phase<pg8::EpiResidual, pg8::StaticOrder, true, false>(lds, g, S, E); }
            if (l == 1) { PHL
                for (int e = 0; e < NEXP; ++e) {
                    convert_matrix(moe_w_gate + (size_t)e * D * DFFE, DFFE, 0, D, DFFE, norm_ffn + D, Mgu + (size_t)e * 2 * DFFE * D, 128, 256, 0, scr, gw_, NGW, lane_);
                    convert_matrix(moe_w_up + (size_t)e * D * DFFE, DFFE, 0, D, DFFE, norm_ffn + D, Mgu + (size_t)e * 2 * DFFE * D, 128, 256, 128, scr, gw_, NGW, lane_);
                    convert_matrix(moe_w_down + (size_t)e * DFFE * D, D, 0, DFFE, D, nullptr, Md + (size_t)e * D * DFFE, BIG, 0, 0, scr, gw_, NGW, lane_); } } }
        SEAM(ph);
        xsel = 1;
        if (l == 0) {
            if (RUN(ph)) { PHL for (int r = gw_; r < T; r += NGW) rowprep_row(xcur, xb, rstd, nullptr, nullptr, r, lane_); }
            SEAM(ph);
            if (RUN(ph)) { pg8::Gemm g{xb, Wgu, T, 2 * DFF, D, 0}; pg8::StaticOrder S; S.init(T, 2 * DFF, G, bid); pg8::EpiSwiGLU E{hid, rstd, DFF, 0};
                pg8::gemm_phase<pg8::EpiSwiGLU, pg8::StaticOrder, true, false>(lds, g, S, E); }
            SEAM(ph);
            if (RUN(ph)) { pg8::Gemm g{hid, Wd, T, D, DFF, 0}; pg8::StaticOrder S; S.init(T, D, G, bid); pg8::EpiResidual E{xcur, xres, nullptr, D, 0};
                pg8::gemm_phase<pg8::EpiResidual, pg8::StaticOrder, true, false>(lds, g, S, E); }
            SEAM(ph);
        } else {
            if (RUN(ph)) { PHL for (int blk = bid_; blk < T / 64; blk += G) route_block(xcur, norm_ffn + D, moe_router, xb, rstd, MCNT, MLIST, MLISTW, blk, lds, tid_, lane_, gw_ & 7); }
            SEAM(ph);
            if (RUN(ph)) { pg8::Gemm g{xb, Mgu, NSLOT, 2 * DFFE, D, 0}; MoeOrder S; S.init(MCNT, MLIST, 2 * DFFE / 256, G, bid); pg8::EpiSwiGLUMoe E{hid, rstd, MLIST, DFFE, 0};
                pg8::gemm_phase<pg8::EpiSwiGLUMoe, MoeOrder, true, true>(lds, g, S, E); }
            SEAM(ph);
            if (RUN(ph)) { pg8::Gemm g{hid, Md, NSLOT, D, DFFE, 0}; MoeOrder S; S.init(MCNT, MLIST, D / 256, G, bid); pg8::EpiMoeDown E{YP0, YP1, MLIST, MLISTW, D, 0};
                pg8::gemm_phase<pg8::EpiMoeDown, MoeOrder, true, false>(lds, g, S, E); }
            SEAM(ph);
        }
    }
    { constexpr int l = 1;
        if (RUN(ph)) { PHL for (int r = gw_; r < T; r += NGW) rowprep_row(xcur, xb, rstd, Wba + (size_t)l * 16 * D, ba, r, lane_); }
        SEAM(ph);
        if (RUN(ph)) { pg8::Gemm g{xb, Win + (size_t)l * NPROJ * D, T, NPROJ, D, 0}; pg8::StaticOrder S; S.init(T, NPROJ, G, bid); pg8::EpiScaleBf16 E{proj, rstd, NPROJ, 0};
            pg8::gemm_phase<pg8::EpiScaleBf16, pg8::StaticOrder, true, false>(lds, g, S, E); }
        SEAM(ph);
        if (RUN(ph)) { PHL
            for (int u = bid_; u < 2048; u += G) lrua_unit(proj, conv_lru_w + (size_t)l * 4 * DLRU, conv_lru_b + l * DLRU, LRU_WRT + (size_t)l * 8 * 128 * 128, LRU_WIT + (size_t)l * 8 * 128 * 128, lru_b_r + l * DLRU, lru_b_i + l * DLRU, lru_lambda + l * DLRU, LRU_H, LRU_A, LRU_SUMM, u, lds, tid_, lane_, gw_ & 7);
            STAMP();
            for (int uid = bid_; uid < 2048; uid += G) dna_unit(proj, conv_qkv_w + (size_t)l * 4 * 3 * DDN, ba, dn_a_log + l * NH, dn_dt_bias + l * NH, DN_WF, DN_QF, DN_KDTF, DN_QKF, DN_UF, DN_GL, uid, lds, tid_, lane_, gw_ & 7); }
        SEAM(ph);
        if (RUN(ph)) { PHL
            if (bid_ < 128) dnb_run(DN_WF, DN_QF, DN_KDTF, DN_QKF, DN_UF, DN_GL, c3, (bid_ & 7) + 8 * (bid_ >> 6), (bid_ >> 3) & 7, lds, tid_, lane_, gw_ & 7);
            else if (bid_ < 136 && tid_ < 256) lru_carry(LRU_SUMM, LRU_CARRY, (bid_ - 128) * 256 + tid_); }
        SEAM(ph);
        if (RUN(ph)) { PHL
            for (int r = gw_; r < T; r += NGW) lrub_row(LRU_H, LRU_A, LRU_CARRY, proj, lru_out_norm + l * DLRU, ymix, r, lane_);
            for (int r = gw_; r < T; r += NGW) dn_out_row(c3, dn_out_norm + l * HD, proj, ymix, r, lane_); }
        SEAM(ph);
        if (RUN(ph)) { { pg8::Gemm g{ymix, Wout + (size_t)l * D * D, T, D, D, 0}; pg8::StaticOrder S; S.init(T, D, G, bid); pg8::EpiResidual E{xcur, xres, nullptr, D, 0};
            pg8::gemm_phase<pg8::EpiResidual, pg8::StaticOrder, true, false>(lds, g, S, E); }
            if (l == 1) { PHL
                for (int e = 0; e < NEXP; ++e) {
                    convert_matrix(moe_w_gate + (size_t)e * D * DFFE, DFFE, 0, D, DFFE, norm_ffn + D, Mgu + (size_t)e * 2 * DFFE * D, 128, 256, 0, scr, gw_, NGW, lane_);
                    convert_matrix(moe_w_up + (size_t)e * D * DFFE, DFFE, 0, D, DFFE, norm_ffn + D, Mgu + (size_t)e * 2 * DFFE * D, 128, 256, 128, scr, gw_, NGW, lane_);
                    convert_matrix(moe_w_down + (size_t)e * DFFE * D, D, 0, DFFE, D, nullptr, Md + (size_t)e * D * DFFE, BIG, 0, 0, scr, gw_, NGW, lane_); } } }
        SEAM(ph);
        xsel = 1;
        if (l == 0) {
            if (RUN(ph)) { PHL for (int r = gw_; r < T; r += NGW) rowprep_row(xcur, xb, rstd, nullptr, nullptr, r, lane_); }
            SEAM(ph);
            if (RUN(ph)) { pg8::Gemm g{xb, Wgu, T, 2 * DFF, D, 0}; pg8::StaticOrder S; S.init(T, 2 * DFF, G, bid); pg8::EpiSwiGLU E{hid, rstd, DFF, 0};
                pg8::gemm_phase<pg8::EpiSwiGLU, pg8::StaticOrder, true, false>(lds, g, S, E); }
            SEAM(ph);
            if (RUN(ph)) { pg8::Gemm g{hid, Wd, T, D, DFF, 0}; pg8::StaticOrder S; S.init(T, D, G, bid); pg8::EpiResidual E{xcur, xres, nullptr, D, 0};
                pg8::gemm_phase<pg8::EpiResidual, pg8::StaticOrder, true, false>(lds, g, S, E); }
            SEAM(ph);
        } else {
            if (RUN(ph)) { PHL for (int blk = bid_; blk < T / 64; blk += G) route_block(xcur, norm_ffn + D, moe_router, xb, rstd, MCNT, MLIST, MLISTW, blk, lds, tid_, lane_, gw_ & 7); }
            SEAM(ph);
            if (RUN(ph)) { pg8::Gemm g{xb, Mgu, NSLOT, 2 * DFFE, D, 0}; MoeOrder S; S.init(MCNT, MLIST, 2 * DFFE / 256, G, bid); pg8::EpiSwiGLUMoe E{hid, rstd, MLIST, DFFE, 0};
                pg8::gemm_phase<pg8::EpiSwiGLUMoe, MoeOrder, true, true>(lds, g, S, E); }
            SEAM(ph);
            if (RUN(ph)) { pg8::Gemm g{hid, Md, NSLOT, D, DFFE, 0}; MoeOrder S; S.init(MCNT, MLIST, D / 256, G, bid); pg8::EpiMoeDown E{YP0, YP1, MLIST, MLISTW, D, 0};
                pg8::gemm_phase<pg8::EpiMoeDown, MoeOrder, true, false>(lds, g, S, E); }
            SEAM(ph);
        }
    }
    if (RUN(ph)) { PHL for (int r = gw_; r < T; r += NGW) final_row_moe(xcur, YP0, YP1, norm_final, xres, r, lane_); }
#if defined(PROBE_MASK)
    __syncthreads(); STAMP();
    if (blockIdx.x == 0 && threadIdx.x == 0) { asm volatile("s_waitcnt vmcnt(0)" ::: "memory"); volatile LAS unsigned long long* st = (volatile LAS unsigned long long*)(lds + LDSCTL_OFF + 1024); unsigned long long tot = 0;
        for (int k = 1; k < nst; ++k) if ((PROBE_MASK >> (k - 1)) & 1ull) tot += st[k] - st[k - 1];
        xres[0] = (float)tot * 0.01f * PROBE_SCALE; }
#endif
#undef RUN
#undef SEAM
}

extern "C" void kernel_launch(void* const* d_in, const int* in_sizes, int n_in, void* d_out, int out_size, void* d_ws, size_t ws_size, hipStream_t stream) {
    static int grid = 0;
    if (grid == 0) {
        if (n_in != 25 || ws_size < WS_END) { fprintf(stderr, "kernel_launch: unexpected n_in %d / ws_size %zu (need %zu)\n", n_in, ws_size, (size_t)WS_END); grid = -1; return; }
        int dev = 0, cus = 0, per_cu = 0;
        if (hipGetDevice(&dev) != hipSuccess || hipDeviceGetAttribute(&cus, hipDeviceAttributeMultiprocessorCount, dev) != hipSuccess) { grid = -1; return; }
        if (hipFuncSetAttribute((const void*)mega, hipFuncAttributeMaxDynamicSharedMemorySize, LDS_BYTES) != hipSuccess) { fprintf(stderr, "kernel_launch: hipFuncSetAttribute failed\n"); grid = -1; return; }
        if (hipOccupancyMaxActiveBlocksPerMultiprocessor(&per_cu, (const void*)mega, 512, LDS_BYTES) != hipSuccess || per_cu < 1) { fprintf(stderr, "kernel_launch: occupancy query says %d\n", per_cu); }
        (void)hipGetLastError();
        grid = cus;
    }
    if (grid < 0) return;
    if (hipMemsetAsync((char*)d_ws + WS_CTL, 0, CTL_ZERO_BYTES, stream) != hipSuccess) return;
    Args a{};
    for (int i = 0; i < 25; ++i) a.in[i] = (const float*)d_in[i];
    a.out = (float*)d_out; a.ws = (unsigned char*)d_ws; a.ph_lo = 0; a.ph_hi = 1 << 30;
    hipLaunchKernelGGL(mega, dim3(grid), dim3(512), LDS_BYTES, stream, a);
}
```

```cpp
#include <hip/hip_runtime.h>
#include <cstdio>
#include <cstdint>
namespace pg8 {
#define PG8_LAS __attribute__((address_space(3)))
typedef unsigned short bf16_t;
typedef short bf16x8 __attribute__((ext_vector_type(8)));
typedef float f32x4 __attribute__((ext_vector_type(4)));
typedef unsigned u32x4 __attribute__((ext_vector_type(4)));
constexpr int BM = 256, BK = 64, HALF = 128, HTB = HALF * BK * 2  , STAGE_BYTES = 8 * HTB, NXCD = 8, WGM = 8;

__host__ __device__ __forceinline__ int lds_byte(int r, int c) { const int st = (r >> 4) * 2 + (c >> 5), rr = r & 15, cc = c & 31, ob = rr * 64 + cc * 2; return st * 1024 + (ob ^ (((ob >> 9) & 1) << 5)); }
__host__ __device__ __forceinline__ void stage_rc(int b, int& R, int& C) { const int st = b / 1024, sb = b % 1024, swz = sb ^ (((sb >> 9) & 1) << 5); R = (st >> 1) * 16 + swz / 64; C = (st & 1) * 32 + (swz % 64) / 2; }
__host__ __device__ __forceinline__ int perm32(int rho) { const int n = rho >> 4, i = rho & 15; return 8 * (i >> 2) + 4 * n + (i & 3); }

struct Unit { int pm, pn, pb, lbase, nvalid; };
struct Gemm { const bf16_t* A; const bf16_t* Bt; int M, N, K, pad; };

struct StaticOrder {
    int nM, nN, nwg, G, c;
    __host__ __device__ void init(int M, int N, int G_, int c_) { nM = M / BM; nN = N / BM; nwg = nM * nN; G = G_; c = c_; }
    __host__ __device__ bool next(int i, Unit& u) const {
        const long L = (long)i * G + c; if (L >= nwg) return false;
        int wgid = (int)L; { const int q = nwg / NXCD, r = nwg % NXCD, xcd = wgid % NXCD, off = wgid / NXCD; wgid = (xcd < r ? xcd * (q + 1) : r * (q + 1) + (xcd - r) * q) + off; }
        const int nig = WGM * nN, gid = wgid / nig, fm = gid * WGM, gsz = (nM - fm) < WGM ? (nM - fm) : WGM;
        u.pm = fm + ((wgid % nig) % gsz); u.pn = (wgid % nig) / gsz; u.pb = u.pn; u.lbase = 0; u.nvalid = BM; return true;
    }
    __device__ __forceinline__ int arow(const Unit&, int) const { return 0; }
    __device__ __forceinline__ void a_ready(const Unit&) const {}
    __device__ __forceinline__ void done(const Unit&) const {}
};


__device__ __forceinline__ unsigned cvt_pk_bf16(float lo, float hi) { unsigned r; asm volatile("v_cvt_pk_bf16_f32 %0, %1, %2" : "=v"(r) : "v"(lo), "v"(hi)); return r; }
__device__ __forceinline__ float silu_f(float x) { return x / (1.0f + __expf(-x)); }

struct EpiScaleBf16 {
    static constexpr bool PERM = true, AFTER_DRAIN = false;
    bf16_t* O; const float* rs; int ldc; int pad;
    __device__ __forceinline__ void operator()(const f32x4 (&acc)[2][2][4][2], const Unit& u, int wr, int wc, int fr, int fq) const {
        const int row0 = u.pm * BM + wr * 64 + fr, col0 = u.pn * BM + wc * 32 + 8 * fq;
#pragma unroll
        for (int ai = 0; ai < 2; ++ai)
#pragma unroll
            for (int m = 0; m < 4; ++m) { const int r = row0 + ai * HALF + m * 16; const float s = rs[r]; bf16_t* rowp = O + (size_t)r * ldc + col0;
#pragma unroll
                for (int bj = 0; bj < 2; ++bj) { const f32x4 v0 = acc[ai][bj][m][0] * s, v1 = acc[ai][bj][m][1] * s;
                    u32x4 w; w.x = cvt_pk_bf16(v0[0], v0[1]); w.y = cvt_pk_bf16(v0[2], v0[3]); w.z = cvt_pk_bf16(v1[0], v1[1]); w.w = cvt_pk_bf16(v1[2], v1[3]);
                    *(u32x4*)(rowp + bj * HALF) = w; } }
    }
};
struct EpiSwiGLU {
    static constexpr bool PERM = true, AFTER_DRAIN = false;
    bf16_t* O; const float* rs; int ldc; int pad;
    __device__ __forceinline__ void operator()(const f32x4 (&acc)[2][2][4][2], const Unit& u, int wr, int wc, int fr, int fq) const {
        const int row0 = u.pm * BM + wr * 64 + fr, col0 = u.pn * HALF + wc * 32 + 8 * fq;
#pragma unroll
        for (int ai = 0; ai < 2; ++ai)
#pragma unroll
            for (int m = 0; m < 4; ++m) { const int r = row0 + ai * HALF + m * 16; const float s = rs ? rs[r] : 1.0f; bf16_t* rowp = O + (size_t)r * ldc + col0;
                f32x4 h0, h1;
#pragma unroll
                for (int j = 0; j < 4; ++j) { h0[j] = silu_f(acc[ai][0][m][0][j] * s) * (acc[ai][1][m][0][j] * s); h1[j] = silu_f(acc[ai][0][m][1][j] * s) * (acc[ai][1][m][1][j] * s); }
                u32x4 w; w.x = cvt_pk_bf16(h0[0], h0[1]); w.y = cvt_pk_bf16(h0[2], h0[3]); w.z = cvt_pk_bf16(h1[0], h1[1]); w.w = cvt_pk_bf16(h1[2], h1[3]);
                *(u32x4*)rowp = w; }
    }
};
struct EpiResidual {
    static constexpr bool PERM = false, AFTER_DRAIN = false;
    const float* base; float* out; const float* roww; int ldc; int pad;
    __device__ __forceinline__ void operator()(const f32x4 (&acc)[2][2][4][2], const Unit& u, int wr, int wc, int fr, int fq) const {
        const int row0 = u.pm * BM + wr * 64 + fr, col0 = u.pn * BM + wc * 32 + 4 * fq;
#pragma unroll
        for (int ai = 0; ai < 2; ++ai)
#pragma unroll
            for (int m = 0; m < 4; ++m) { const int r = row0 + ai * HALF + m * 16; const float w = roww ? roww[r] : 1.0f; const size_t off = (size_t)r * ldc + col0;
#pragma unroll
                for (int bj = 0; bj < 2; ++bj)
#pragma unroll
                    for (int n = 0; n < 2; ++n) { const f32x4 bs = *(const f32x4*)(base + off + bj * HALF + n * 16); *(f32x4*)(out + off + bj * HALF + n * 16) = bs + acc[ai][bj][m][n] * w; } }
    }
};

struct EpiSwiGLUMoe {
    static constexpr bool PERM = true, AFTER_DRAIN = false;
    bf16_t* O; const float* rs; const int* list; int ldc; int pad;
    __device__ __forceinline__ void operator()(const f32x4 (&acc)[2][2][4][2], const Unit& u, int wr, int wc, int fr, int fq) const {
        const int rl0 = wr * 64 + fr, col0 = u.pn * HALF + wc * 32 + 8 * fq;
#pragma unroll
        for (int ai = 0; ai < 2; ++ai)
#pragma unroll
            for (int m = 0; m < 4; ++m) { const int rl = rl0 + ai * HALF + m * 16; const int tok = rl < u.nvalid ? (list[u.lbase + rl] & 0xffff) : 0; const float s = rs[tok];
                bf16_t* rowp = O + (size_t)(u.pm * BM + rl) * ldc + col0;
                f32x4 h0, h1;
#pragma unroll
                for (int j = 0; j < 4; ++j) { h0[j] = silu_f(acc[ai][0][m][0][j] * s) * (acc[ai][1][m][0][j] * s); h1[j] = silu_f(acc[ai][0][m][1][j] * s) * (acc[ai][1][m][1][j] * s); }
                u32x4 w; w.x = cvt_pk_bf16(h0[0], h0[1]); w.y = cvt_pk_bf16(h0[2], h0[3]); w.z = cvt_pk_bf16(h1[0], h1[1]); w.w = cvt_pk_bf16(h1[2], h1[3]);
                *(u32x4*)rowp = w; }
    }
};
struct EpiMoeDown {
    static constexpr bool PERM = true, AFTER_DRAIN = false;
    bf16_t* Y0; bf16_t* Y1; const int* list; const float* lw; int ldc; int pad;
    __device__ __forceinline__ void operator()(const f32x4 (&acc)[2][2][4][2], const Unit& u, int wr, int wc, int fr, int fq) const {
        const int rl0 = wr * 64 + fr, col0 = u.pn * BM + wc * 32 + 8 * fq;
#pragma unroll
        for (int ai = 0; ai < 2; ++ai)
#pragma unroll
            for (int m = 0; m < 4; ++m) { const int rl = rl0 + ai * HALF + m * 16;
                if (rl < u.nvalid) { const int en = list[u.lbase + rl]; const float w = lw[u.lbase + rl]; bf16_t* rowp = ((en >> 16) ? Y1 : Y0) + (size_t)(en & 0xffff) * ldc + col0;
#pragma unroll
                    for (int bj = 0; bj < 2; ++bj) { const f32x4 v0 = acc[ai][bj][m][0] * w, v1 = acc[ai][bj][m][1] * w;
                        u32x4 o; o.x = cvt_pk_bf16(v0[0], v0[1]); o.y = cvt_pk_bf16(v0[2], v0[3]); o.z = cvt_pk_bf16(v1[0], v1[1]); o.w = cvt_pk_bf16(v1[2], v1[3]);
                        *(u32x4*)(rowp + bj * HALF) = o; } } }
    }
};
template <class Epi, class Sched, bool ALIGN_EPI = false, bool GATHER = false>
__device__ __forceinline__ void gemm_phase(PG8_LAS unsigned char* lds, const Gemm g, const Sched& S, const Epi& E) {
    int tid_o = threadIdx.x; asm volatile("" : "+v"(tid_o));
    const int tid = tid_o, wid = __builtin_amdgcn_readfirstlane(tid >> 6), lane = tid & 63, wr = wid >> 2, wc = wid & 3, fr = lane & 15, fq = lane >> 4;
    const int K = g.K, nt = K / BK;
    const size_t kstep = (size_t)(BK * 2);
    const size_t hstep = (size_t)HALF * K * 2;
    const size_t tstep = 2 * hstep;
    unsigned voffA[2], voffB[2], oA[2][2], oN[2][2];
#pragma unroll
    for (int i = 0; i < 2; ++i) { int R, C; stage_rc(tid * 16 + i * 8192, R, C); const int Rb = Epi::PERM ? ((R & ~31) + perm32(R & 31)) : R; voffA[i] = (unsigned)(R * K + C) * 2u; voffB[i] = (unsigned)(Rb * K + C) * 2u; }
    const unsigned ldsw = (unsigned)wid * 1024u;
    const int aoff = lds_byte(wr * 64 + fr, fq * 8), boff = lds_byte(wc * 32 + fr, fq * 8);
#define PG8_SA(b, h) (((b) * 2 + (h)) * HTB)
#define PG8_SB(b, h) ((4 + (b) * 2 + (h)) * HTB)
#define PG8_STAGE(bufoff, gbase, voff) do { _Pragma("unroll") for (int _i = 0; _i < 2; ++_i) \
        __builtin_amdgcn_global_load_lds((const unsigned*)((const char*)(gbase) + (voff)[_i]), (PG8_LAS unsigned*)(lds + (bufoff) + ldsw + _i * 8192), 16, 0, 0); } while (0)
#define PG8_LDA(dst, b, h) do { _Pragma("unroll") for (int m = 0; m < 4; ++m) _Pragma("unroll") for (int k = 0; k < 2; ++k) dst[m][k] = *(const PG8_LAS bf16x8*)(lds + PG8_SA(b, h) + aoff + m * 2048 + k * 1024); } while (0)
#define PG8_LDB(dst, b, h) do { _Pragma("unroll") for (int n = 0; n < 2; ++n) _Pragma("unroll") for (int k = 0; k < 2; ++k) dst[n][k] = *(const PG8_LAS bf16x8*)(lds + PG8_SB(b, h) + boff + n * 2048 + k * 1024); } while (0)
#define PG8_MMA(ai, bj, At, Bt) do { __builtin_amdgcn_s_setprio(1); _Pragma("unroll") for (int m = 0; m < 4; ++m) _Pragma("unroll") for (int n = 0; n < 2; ++n) _Pragma("unroll") for (int k = 0; k < 2; ++k) \
        acc[ai][bj][m][n] = __builtin_amdgcn_mfma_f32_16x16x32_bf16(Bt[n][k], At[m][k], acc[ai][bj][m][n], 0, 0, 0); __builtin_amdgcn_s_setprio(0); } while (0)
#define PG8_WAIT_V(n) asm volatile("s_waitcnt vmcnt(" #n ")" ::: "memory")
#define PG8_WAIT_L(n) asm volatile("s_waitcnt lgkmcnt(" #n ")" ::: "memory")
#define PG8_BAR __builtin_amdgcn_s_barrier()
#define PG8_SCHED __builtin_amdgcn_sched_barrier(0)
#define PG8_AOFF(dst, u) do { _Pragma("unroll") for (int _i = 0; _i < 2; ++_i) { int _R, _C; stage_rc(tid * 16 + _i * 8192, _R, _C); _Pragma("unroll") for (int _h = 0; _h < 2; ++_h) \
        dst[_h][_i] = (unsigned)(S.arow(u, _h * HALF + _R) * K + _C) * 2u; } } while (0)
#define PG8_STAGE_A(bufoff, gbase, h, usenext) do { _Pragma("unroll") for (int _i = 0; _i < 2; ++_i) { const unsigned _o = GATHER ? ((usenext) ? oN[h][_i] : oA[h][_i]) : voffA[_i]; \
        __builtin_amdgcn_global_load_lds((const unsigned*)((const char*)(gbase) + (GATHER ? (size_t)0 : (size_t)(h) * hstep) + _o), (PG8_LAS unsigned*)(lds + (bufoff) + ldsw + _i * 8192), 16, 0, 0); } } while (0)
    Unit cur, nxt; int ui = 0;
    if (!S.next(0, cur)) return;
    f32x4 acc[2][2][4][2];
#pragma unroll
    for (int a = 0; a < 2; ++a)
#pragma unroll
        for (int b = 0; b < 2; ++b)
#pragma unroll
            for (int m = 0; m < 4; ++m)
#pragma unroll
                for (int n = 0; n < 2; ++n) acc[a][b][m][n] = (f32x4){0.f, 0.f, 0.f, 0.f};
    bf16x8 At[4][2], B0[2][2], B1[2][2];
    const char* cA = (const char*)g.A + (GATHER ? (size_t)0 : (size_t)cur.pm * tstep); const char* cB = (const char*)g.Bt + (size_t)cur.pb * tstep;
    S.a_ready(cur);
    if constexpr (GATHER) { PG8_AOFF(oA, cur); PG8_WAIT_V(0); }
    PG8_STAGE(PG8_SB(0, 0), cB, voffB); PG8_STAGE(PG8_SB(0, 1), cB + hstep, voffB); PG8_STAGE_A(PG8_SA(0, 0), cA, 0, false); PG8_STAGE_A(PG8_SA(0, 1), cA, 1, false);
    if (wr == 1) PG8_BAR;
    PG8_WAIT_V(2); PG8_BAR;
    PG8_STAGE(PG8_SB(1, 0), cB + kstep, voffB); PG8_STAGE_A(PG8_SA(1, 0), cA + kstep, 0, false); PG8_STAGE(PG8_SB(1, 1), cB + hstep + kstep, voffB);
    PG8_WAIT_V(6); PG8_BAR;
    for (;;) {
        const bool has_next = S.next(ui + 1, nxt);
        const char* nA = has_next ? (const char*)g.A + (GATHER ? (size_t)0 : (size_t)nxt.pm * tstep) : cA; const char* nB = has_next ? (const char*)g.Bt + (size_t)nxt.pb * tstep : cB;
        if constexpr (GATHER) { if (has_next) { PG8_AOFF(oN, nxt); } else {
#pragma unroll
            for (int _h = 0; _h < 2; ++_h) { oN[_h][0] = oA[_h][0]; oN[_h][1] = oA[_h][1]; } } }
        for (int t = 0; t < nt; t += 2) {
            const bool last = (t == nt - 2);
            const char* a1 = cA + (size_t)(t + 1) * kstep;
            const char* a2 = last ? nA : cA + (size_t)(t + 2) * kstep; const char* b2 = last ? nB : cB + (size_t)(t + 2) * kstep;
            const char* a3 = a2 + kstep; const char* b3 = b2 + kstep;
            if (last && has_next) S.a_ready(nxt);
            PG8_LDB(B0, 0, 0); PG8_LDB(B1, 0, 1); PG8_SCHED; PG8_LDA(At, 0, 0); PG8_STAGE_A(PG8_SA(1, 1), a1, 1, false);
            PG8_WAIT_V(8); PG8_WAIT_L(0); PG8_BAR; PG8_MMA(0, 0, At, B0); PG8_MMA(0, 1, At, B1); PG8_BAR; PG8_SCHED;
            PG8_LDA(At, 0, 1); PG8_STAGE(PG8_SB(0, 0), b2, voffB); PG8_STAGE(PG8_SB(0, 1), b2 + hstep, voffB); PG8_STAGE_A(PG8_SA(0, 0), a2, 0, last);
            PG8_WAIT_V(8); PG8_WAIT_L(0); PG8_BAR; PG8_MMA(1, 0, At, B0); PG8_MMA(1, 1, At, B1); PG8_BAR; PG8_SCHED;
            PG8_LDB(B0, 1, 0); PG8_LDB(B1, 1, 1); PG8_SCHED; PG8_LDA(At, 1, 0); PG8_STAGE_A(PG8_SA(0, 1), a2, 1, last);
            PG8_WAIT_V(8); PG8_WAIT_L(0); PG8_BAR; PG8_MMA(0, 0, At, B0); PG8_MMA(0, 1, At, B1); PG8_BAR; PG8_SCHED;
            PG8_LDA(At, 1, 1); PG8_STAGE(PG8_SB(1, 0), b3, voffB); PG8_STAGE(PG8_SB(1, 1), b3 + hstep, voffB); PG8_STAGE_A(PG8_SA(1, 0), a3, 0, last);
            PG8_WAIT_V(8); PG8_WAIT_L(0); PG8_BAR; PG8_MMA(1, 0, At, B0); PG8_MMA(1, 1, At, B1); PG8_BAR; PG8_SCHED;
        }
        if constexpr (ALIGN_EPI) { if (wr == 0) PG8_BAR; }
        E(acc, cur, wr, wc, fr, fq); S.done(cur);
        if (!has_next) break;
#pragma unroll
        for (int a = 0; a < 2; ++a)
#pragma unroll
            for (int b = 0; b < 2; ++b)
#pragma unroll
                for (int m = 0; m < 4; ++m)
#pragma unroll
                    for (int n = 0; n < 2; ++n) acc[a][b][m][n] = (f32x4){0.f, 0.f, 0.f, 0.f};
        cur = nxt; cA = nA; cB = nB; ++ui;
        if constexpr (GATHER) {
#pragma unroll
            for (int _h = 0; _h < 2; ++_h) { oA[_h][0] = oN[_h][0]; oA[_h][1] = oN[_h][1]; } }
        if constexpr (ALIGN_EPI) { if (wr == 1) PG8_BAR; }
    }
    PG8_WAIT_V(0);
    if constexpr (!ALIGN_EPI) { if (wr == 0) PG8_BAR; }
    PG8_BAR;
#undef PG8_SA
#undef PG8_SB
#undef PG8_STAGE
#undef PG8_LDA
#undef PG8_LDB
#undef PG8_MMA
#undef PG8_WAIT_V
#undef PG8_WAIT_L
#undef PG8_BAR
#undef PG8_SCHED
#undef PG8_AOFF
#undef PG8_STAGE_A
}
}

#define GAS __attribute__((address_space(1)))
#define LAS __attribute__((address_space(3)))
#define XB_TMO      128
#define XB_XCNT(j)  (256  + 64 * (j))
#define XB_XSUB(j)  (1280 + 64 * (j))
#define XB_XGEN(j)  (2304 + 64 * (j))
#define XB_TOP      3328
#define XB_TOPGEN   3392
#define XCD_BAR_WORDS 3456
#define XB_SPIN_CAP (1u << 23)

__device__ __forceinline__ unsigned xb_ld(unsigned* p)              { return __hip_atomic_load(p, __ATOMIC_RELAXED, __HIP_MEMORY_SCOPE_AGENT); }
__device__ __forceinline__ unsigned xb_add(unsigned* p, unsigned v) { return __hip_atomic_fetch_add(p, v, __ATOMIC_RELAXED, __HIP_MEMORY_SCOPE_AGENT); }
__device__ __forceinline__ unsigned xb_xcc_id() { return (unsigned)__builtin_amdgcn_s_getreg((3 << 11) | 20) & 0xFu; }
#define XB_SPIN(cond, bar) do { unsigned _sp = 0; while (cond) { __builtin_amdgcn_s_sleep(1); \
    if ((++_sp & 255u) == 0u) { if (xb_ld(&(bar)[XB_TMO])) break; if (_sp > XB_SPIN_CAP) { atomicAdd(&(bar)[XB_TMO], 1u); break; } } } } while (0)

struct XcdBarrier {
    unsigned* bar; unsigned x;
    volatile LAS unsigned* st;
};

__device__ __forceinline__ XcdBarrier xcd_barrier_post(unsigned* bar, volatile LAS unsigned* st) {
    XcdBarrier b; b.bar = bar; b.x = xb_xcc_id(); b.st = st;
    if (threadIdx.x == 0) (void)xb_add(&bar[XB_XCNT(b.x)], 1u);
    return b;
}
__device__ __forceinline__ void xcd_barrier_complete(unsigned* bar, unsigned x, unsigned& nloc, unsigned& nx) {
    const unsigned G = gridDim.x * gridDim.y * gridDim.z;
    unsigned sum, cnt, mine, sp = 0u;
    for (;;) {
        sum = 0u; cnt = 0u; mine = 0u;
#pragma unroll
        for (unsigned j = 0; j < 16; ++j) { const unsigned c = xb_ld(&bar[XB_XCNT(j)]); sum += c; cnt += (c > 0u) ? 1u : 0u; mine = (j == x) ? c : mine; }
        if (sum == G) break;
        __builtin_amdgcn_s_sleep(1);
        if ((++sp & 255u) == 0u) { if (xb_ld(&bar[XB_TMO])) break; if (sp > XB_SPIN_CAP) { atomicAdd(&bar[XB_TMO], 1u); break; } }
    }
    nloc = mine > 0u ? mine : 1u; nx = cnt > 0u ? cnt : 1u;
}

__device__ __forceinline__ void xcd_barrier(const XcdBarrier& b) {
    asm volatile("s_waitcnt vmcnt(0)" ::: "memory");
    __syncthreads();
    if (threadIdx.x == 0) {
        unsigned* bar = b.bar; asm volatile("" : "+s"(bar));
        __builtin_amdgcn_s_waitcnt(0);
        unsigned nloc = b.st[0], nx = b.st[1];
        if (nloc == 0u) { xcd_barrier_complete(bar, b.x, nloc, nx); b.st[0] = nloc; b.st[1] = nx; }
        const unsigned old = xb_add(&bar[XB_XSUB(b.x)], 1u);
        const unsigned gen = old / nloc;
        if (old + 1u == (gen + 1u) * nloc) {
            __builtin_amdgcn_fence(__ATOMIC_RELEASE, "agent");
            asm volatile("s_waitcnt vmcnt(0)" ::: "memory");
            const unsigned og = xb_add(&bar[XB_TOP], 1u);
            const unsigned tg = og / nx;
            if (og + 1u == (tg + 1u) * nx) xb_add(&bar[XB_TOPGEN], 1u);
            else XB_SPIN(xb_ld(&bar[XB_TOPGEN]) == tg, bar);
            __builtin_amdgcn_fence(__ATOMIC_ACQUIRE, "agent");
            xb_add(&bar[XB_XGEN(b.x)], 1u);
            asm volatile("s_waitcnt vmcnt(0)" ::: "memory");
        } else {
            XB_SPIN(xb_ld(&bar[XB_XGEN(b.x)]) == gen, bar);
            __builtin_amdgcn_fence(__ATOMIC_ACQUIRE, "agent");
            asm volatile("s_waitcnt vmcnt(0)" ::: "memory");
        }
    }
    __syncthreads();
}

constexpr int T = 16384, SEQ = 8192, D = 2048, DLRU = 1024, DDN = 1024, NH = 8, HD = 128, NPROJ = 6144, DIN = 6160;
constexpr int DFF = 6144, NEXP = 8, DFFE = 3072;
constexpr float EPS = 1e-6f;
typedef unsigned short bf16;
typedef float f32x4 __attribute__((ext_vector_type(4)));
typedef unsigned u32x4 __attribute__((ext_vector_type(4)));
typedef unsigned u32x2 __attribute__((ext_vector_type(2)));
#define LDS_WAIT() asm volatile("s_waitcnt lgkmcnt(0)" ::: "memory")
#define LDS_BARRIER() do { asm volatile("s_waitcnt lgkmcnt(0)" ::: "memory"); __builtin_amdgcn_s_barrier(); asm volatile("" ::: "memory"); } while (0)

__device__ __forceinline__ float bf2f(bf16 b) { return __uint_as_float(((unsigned)b) << 16); }
__device__ __forceinline__ unsigned f2bf(float f) { unsigned u = __float_as_uint(f); return (u + 0x7fffu + ((u >> 16) & 1u)) >> 16; }
__device__ __forceinline__ unsigned pk2(float lo, float hi) { return f2bf(lo) | (f2bf(hi) << 16); }
__device__ __forceinline__ float shfl_xor_l(float v, int o, int lane) { return __int_as_float(__builtin_amdgcn_ds_bpermute((lane ^ o) << 2, __float_as_int(v))); }
__device__ __forceinline__ float shfl_up_l(float v, int d, int lane) { return __int_as_float(__builtin_amdgcn_ds_bpermute((lane - d) << 2, __float_as_int(v))); }
__device__ __forceinline__ float shfl_idx_l(float v, int src) { return __int_as_float(__builtin_amdgcn_ds_bpermute(src << 2, __float_as_int(v))); }
__device__ __forceinline__ float wave_sum(float v, int lane) {
#pragma unroll
    for (int o = 1; o < 64; o <<= 1) v += shfl_xor_l(v, o, lane);
    return v;
}
using pg8::silu_f;
__device__ __forceinline__ float sigmoid_f(float x) { return 1.0f / (1.0f + __expf(-x)); }
__device__ __forceinline__ float softplus_f(float x) { return fmaxf(x, 0.0f) + log1pf(__expf(-fabsf(x))); }
__device__ __forceinline__ float gelu_tanh_f(float x) { const float u = 0.7978845608028654f * (x + 0.044715f * x * x * x); return 0.5f * x * (1.0f + tanhf(u)); }

constexpr size_t MiB = 1u << 20;
constexpr size_t al(size_t x) { return (x + MiB - 1) / MiB * MiB; }
constexpr size_t WS_CTL = 0, CTL_ZERO_BYTES = 1 * MiB;
constexpr int CW_BAR = 4096, CW_CNT = 8192;
constexpr size_t WS_WGU = 1 * MiB;
constexpr size_t WS_WD = WS_WGU + al((size_t)2 * DFF * D * 2);
constexpr size_t WS_WIN = WS_WD + al((size_t)D * DFF * 2);
constexpr size_t WS_WBA = WS_WIN + al((size_t)2 * NPROJ * D * 2);
constexpr size_t WS_WOUT = WS_WBA + al((size_t)2 * 16 * D * 4);
static_assert(WS_WIN + (size_t)NPROJ * D * 2 - WS_WGU >= (size_t)NEXP * D * DFFE * 2, "MoE down weights overlay");
constexpr size_t WS_XB = WS_WOUT + al((size_t)2 * D * D * 2);
constexpr size_t WS_RSTD = WS_XB + al((size_t)T * D * 2);
constexpr size_t WS_BA = WS_RSTD + al((size_t)T * 4);
constexpr size_t WS_BETA = WS_BA + al((size_t)T * 16 * 4);
constexpr size_t WS_G = WS_BETA + al((size_t)T * 8 * 4);
constexpr size_t WS_ROWW = WS_G + al((size_t)T * 8 * 4);
constexpr int NSLOT = 2 * T + NEXP * 256;
constexpr size_t WS_PROJ = WS_ROWW + al((size_t)2 * 8 * T * 4);
constexpr size_t WS_YMIX = WS_PROJ + al((size_t)NSLOT * DFFE * 2);
constexpr size_t WS_C = WS_YMIX + al((size_t)T * D * 2);
constexpr size_t WS_WRT = WS_C + (size_t)388 * MiB;
constexpr size_t WS_END = WS_WRT + 1 * MiB;
static_assert(WS_END <= (size_t)975 * MiB, "d_ws map exceeds the guaranteed workspace");
static_assert((size_t)NEXP * 2 * DFFE * D * 2 <= (size_t)388 * MiB, "MoE gate/up bf16 weights overlay the mixer scratch");
constexpr int RING_BYTES = 131072, LDSCTL_OFF = RING_BYTES, MISC_OFF = LDSCTL_OFF + 320, LDS_BYTES = 147456;

__device__ __forceinline__ void transpose_item(const float* W, int ldw, int col_off, int K, int nblk, const float* gain, bf16* WT, int blk, int blk_stride, int row_off, int item, int lane) {
    const int kb = item / nblk, nb = item % nblk, k0 = 64 * kb + (lane >> 4) * 16, n0 = 64 * nb + (lane & 15) * 4;
    const float* src = W + (size_t)k0 * ldw + col_off + n0;
    f32x4 v[16];
#pragma unroll
    for (int j = 0; j < 16; ++j) v[j] = *(const f32x4*)(src + (size_t)j * ldw);
    if (gain) {
#pragma unroll
        for (int q = 0; q < 4; ++q) { const f32x4 g = *(const f32x4*)(gain + k0 + 4 * q);
#pragma unroll
            for (int c = 0; c < 4; ++c) v[4 * q + c] = v[4 * q + c] * g[c]; }
    }
#pragma unroll
    for (int i = 0; i < 4; ++i) { const int n = n0 + i, drow = (n / blk) * blk_stride + (n % blk) + row_off;
        u32x4 o0, o1;
        o0.x = pk2(v[0][i], v[1][i]); o0.y = pk2(v[2][i], v[3][i]); o0.z = pk2(v[4][i], v[5][i]); o0.w = pk2(v[6][i], v[7][i]);
        o1.x = pk2(v[8][i], v[9][i]); o1.y = pk2(v[10][i], v[11][i]); o1.z = pk2(v[12][i], v[13][i]); o1.w = pk2(v[14][i], v[15][i]);
        u32x4* dst = (u32x4*)(WT + (size_t)drow * K + k0); dst[0] = o0; dst[1] = o1; }
}
__device__ __forceinline__ void convert_matrix(const float* W, int ldw, int col_off, int K, int N, const float* gain, bf16* WT, int blk, int blk_stride, int row_off, LAS float* scr, int gw, int NGW, int lane) {
    const int nblk = N / 64, nitems = (K / 64) * nblk; (void)scr;
    for (int it = gw; it < nitems; it += NGW) transpose_item(W, ldw, col_off, K, nblk, gain, WT, blk, blk_stride, row_off, it, lane);
}
__device__ __forceinline__ void rowprep_row(const float* x, bf16* xb, float* rstd, const float* Wba, float* ba, int row, int lane) {
    const f32x4* xr = (const f32x4*)(x + (size_t)row * D) + lane;
    f32x4 v[8]; float ss = 0.f;
#pragma unroll
    for (int j = 0; j < 8; ++j) { v[j] = xr[64 * j]; ss += (v[j][0] * v[j][0] + v[j][1] * v[j][1]) + (v[j][2] * v[j][2] + v[j][3] * v[j][3]); }
    ss = wave_sum(ss, lane);
    const float rs = 1.0f / sqrtf(ss * (1.0f / D) + EPS);
    u32x2* o = (u32x2*)(xb + (size_t)row * D) + lane;
#pragma unroll
    for (int j = 0; j < 8; ++j) { u32x2 w; w.x = pk2(v[j][0], v[j][1]); w.y = pk2(v[j][2], v[j][3]); o[64 * j] = w; }
    if (lane == 0) rstd[row] = rs;
    if (Wba) {
        for (int c = 0; c < 16; ++c) { const f32x4* wr = (const f32x4*)(Wba + (size_t)c * D) + lane; float a = 0.f;
#pragma unroll
            for (int j = 0; j < 8; ++j) { const f32x4 w = wr[64 * j]; a += (v[j][0] * w[0] + v[j][1] * w[1]) + (v[j][2] * w[2] + v[j][3] * w[3]); }
            a = wave_sum(a, lane); if (lane == 0) ba[(size_t)row * 16 + c] = a * rs; }
    }
}
__device__ __forceinline__ void lru_conv_elem(const bf16* proj, const float* cw, const float* cb, float* xc, size_t idx) {
    const int t = (int)(idx / DLRU), ch = (int)(idx % DLRU), s = t % SEQ;
    float a = cb[ch];
#pragma unroll
    for (int k = 0; k < 4; ++k) { const int sp = s - 3 + k; if (sp >= 0) a += cw[k * DLRU + ch] * bf2f(proj[(size_t)(t - 3 + k) * NPROJ + ch]); }
    xc[idx] = a;
}
__device__ __forceinline__ void lru_gate_elem(const float* xc, const float* w_r, const float* b_r, const float* w_i, const float* b_i, const float* lam, float* av, float* bv, size_t idx) {
    const int t = (int)(idx / DLRU), ch = (int)(idx % DLRU), n = ch >> 7, d = ch & 127;
    float ar = b_r[ch], ai = b_i[ch];
    const float* xr = xc + (size_t)t * DLRU + n * 128; const float* wr = w_r + (size_t)n * 128 * 128 + d; const float* wi = w_i + (size_t)n * 128 * 128 + d;
    for (int c = 0; c < 128; ++c) { const float xv = xr[c]; ar += xv * wr[c * 128]; ai += xv * wi[c * 128]; }
    const float r = sigmoid_f(ar), ig = sigmoid_f(ai);
    const float log_a = -8.0f * r * softplus_f(-lam[ch]);
    const float a = expf(log_a), mult = sqrtf(-expm1f(2.0f * log_a));
    av[idx] = a; bv[idx] = mult * (ig * xc[idx]);
}
__device__ __forceinline__ void lru_scan_chan(float* av, const float* bv, const bf16* proj, int idx) {
    const int b = idx / DLRU, ch = idx % DLRU;
    float h = 0.f;
    for (int s0 = 0; s0 < SEQ; s0 += 8) {
        float a8[8], b8[8], g8[8];
#pragma unroll
        for (int j = 0; j < 8; ++j) { const size_t t = (size_t)b * SEQ + s0 + j; a8[j] = av[t * DLRU + ch]; b8[j] = bv[t * DLRU + ch]; g8[j] = bf2f(proj[t * NPROJ + DLRU + ch]); }
#pragma unroll
        for (int j = 0; j < 8; ++j) { const size_t t = (size_t)b * SEQ + s0 + j; h = a8[j] * h + b8[j]; av[t * DLRU + ch] = h * gelu_tanh_f(g8[j]); }
    }
}
__device__ __forceinline__ void lru_norm_row(const float* y, const float* gain, bf16* ymix, int row, int lane) {
    const f32x4* yr = (const f32x4*)(y + (size_t)row * DLRU) + lane; const f32x4* gr = (const f32x4*)gain + lane;
    f32x4 v[4]; float ss = 0.f;
#pragma unroll
    for (int j = 0; j < 4; ++j) { v[j] = yr[64 * j]; ss += (v[j][0] * v[j][0] + v[j][1] * v[j][1]) + (v[j][2] * v[j][2] + v[j][3] * v[j][3]); }
    ss = wave_sum(ss, lane); const float rs = 1.0f / sqrtf(ss * (1.0f / DLRU) + EPS);
    u32x2* o = (u32x2*)(ymix + (size_t)row * D) + lane;
#pragma unroll
    for (int j = 0; j < 4; ++j) { const f32x4 g = gr[64 * j]; u32x2 w; w.x = pk2(v[j][0] * rs * g[0], v[j][1] * rs * g[1]); w.y = pk2(v[j][2] * rs * g[2], v[j][3] * rs * g[3]); o[64 * j] = w; }
}
__device__ __forceinline__ void dn_prep_item(const bf16* proj, const float* cw, const float* ba, const float* a_log, const float* dt_bias, float* qn, float* kn, float* vn, float* beta, float* gg, int w, int lane) {
    const int t = w >> 3, h = w & 7, s = t % SEQ;
    float val[3][2];
#pragma unroll
    for (int p = 0; p < 3; ++p)
#pragma unroll
        for (int e = 0; e < 2; ++e) { const int d = lane * 2 + e, c = p * DDN + h * HD + d; float a = 0.f;
#pragma unroll
            for (int k = 0; k < 4; ++k) { const int sp = s - 3 + k; if (sp >= 0) a += cw[k * 3 * DDN + c] * bf2f(proj[(size_t)(t - 3 + k) * NPROJ + 2048 + c]); }
            val[p][e] = silu_f(a); }
    const float sq = wave_sum(val[0][0] * val[0][0] + val[0][1] * val[0][1], lane), sk = wave_sum(val[1][0] * val[1][0] + val[1][1] * val[1][1], lane);
    const float rq = (1.0f / sqrtf(sq + EPS)) * 0.08838834764831845f, rk = 1.0f / sqrtf(sk + EPS);
    const size_t o = ((size_t)t * NH + h) * HD + lane * 2;
    qn[o] = val[0][0] * rq; qn[o + 1] = val[0][1] * rq; kn[o] = val[1][0] * rk; kn[o + 1] = val[1][1] * rk; vn[o] = val[2][0]; vn[o + 1] = val[2][1];
    if (lane == 0) { beta[t * NH + h] = sigmoid_f(ba[(size_t)t * 16 + h]); gg[t * NH + h] = -__expf(a_log[h]) * softplus_f(ba[(size_t)t * 16 + 8 + h] + dt_bias[h]); }
}
__device__ __forceinline__ void dn_rec_seq(const float* qn, const float* kn, const float* vn, const float* beta, const float* gg, float* o, int bh, LAS float* sk, LAS float* sq, LAS float* st, int tid) {
    const int b = bh >> 3, h = bh & 7, j = tid & 127; const bool act = tid < 128;
    if (act) for (int k = 0; k < 128; ++k) st[k * 128 + j] = 0.f;
    const size_t base = ((size_t)(b * SEQ) * NH + h) * HD;
    float nk = kn[base + j], nq = qn[base + j], nv = vn[base + j], nb = beta[(b * SEQ) * NH + h], ng = gg[(b * SEQ) * NH + h];
    for (int s = 0; s < SEQ; ++s) {
        const int buf = (s & 1) * 128;
        if (act) { sk[buf + j] = nk; sq[buf + j] = nq; }
        const float vj = nv, be = nb, ge = __expf(ng);
        __syncthreads();
        if (act) {
            if (s + 1 < SEQ) { const size_t nb_ = ((size_t)(b * SEQ + s + 1) * NH + h) * HD; nk = kn[nb_ + j]; nq = qn[nb_ + j]; nv = vn[nb_ + j]; nb = beta[(b * SEQ + s + 1) * NH + h]; ng = gg[(b * SEQ + s + 1) * NH + h]; }
            float ks = 0.f;
#pragma unroll 8
            for (int k = 0; k < 128; ++k) ks += sk[buf + k] * st[k * 128 + j];
            const float vnew = be * (vj - ge * ks);
            float oo = 0.f;
#pragma unroll 8
            for (int k = 0; k < 128; ++k) { const float sv = ge * st[k * 128 + j] + sk[buf + k] * vnew; st[k * 128 + j] = sv; oo += sq[buf + k] * sv; }
            o[((size_t)(b * SEQ + s) * NH + h) * HD + j] = oo;
        }
    }
    __syncthreads();
}
typedef short bf16x8 __attribute__((ext_vector_type(8)));
__device__ __forceinline__ f32x4 mfma16(bf16x8 a, bf16x8 b, f32x4 c) { return __builtin_amdgcn_mfma_f32_16x16x32_bf16(a, b, c, 0, 0, 0); }
__device__ __forceinline__ float bflo(unsigned x) { return __uint_as_float(x << 16); }
__device__ __forceinline__ float bfhi(unsigned x) { return __uint_as_float(x & 0xffff0000u); }
constexpr int DA_G = 0, DA_L = 1024, DA_KN = DA_L + 16384, DA_QN = DA_KN + 17408, DA_VBT = DA_QN + 17408, DA_KBET = DA_VBT + 18432, DA_KDT = DA_KBET + 18432, DA_TB = DA_KDT + 18432, DA_QK = DA_TB + 9216, DA_END = DA_QK + 9216;
static_assert(DA_END <= RING_BYTES, "DN-A LDS map");
#if defined(PROBE_DNA_A)
#define DNA_ST(k) do { if (threadIdx.x == 0) ((volatile LAS unsigned long long*)(lds + (RING_BYTES + 2048)))[k] = __builtin_amdgcn_s_memrealtime(); } while (0)
#else
#define DNA_ST(k) do { } while (0)
#endif
__device__ __forceinline__ void dna_unit(const bf16* proj, const float* cw, const float* ba, const float* a_log, const float* dt_bias,
                                         bf16* Wf, bf16* Qf, bf16* KdTf, bf16* QKf, bf16* Uf, float* glb, int uid, LAS unsigned char* lds, int tid, int lane, int wave) {
    const int h = uid & 7, n = (uid >> 3) & 127, b = uid >> 10, t0 = b * SEQ + n * 64;
    asm volatile("" : "+v"(lds));
    DNA_ST(0);
    LAS float* Gs = (LAS float*)(lds + DA_G);
    const int fr = lane & 15, fq = lane >> 4;
    if (wave == 0) {
        const size_t t = (size_t)(t0 + lane);
        const float be = sigmoid_f(ba[t * 16 + h]); float Gc = -__expf(a_log[h]) * softplus_f(ba[t * 16 + 8 + h] + dt_bias[h]);
#pragma unroll
        for (int off = 1; off < 64; off <<= 1) { const float tmp = shfl_up_l(Gc, off, lane); if (lane >= off) Gc += tmp; }
        const float GL = shfl_idx_l(Gc, 63);
        Gs[lane] = Gc; Gs[64 + lane] = be; Gs[128 + lane] = __expf(Gc); Gs[192 + lane] = __expf(GL - Gc);
        if (lane == 63) glb[uid] = __expf(Gc);
    }
    __syncthreads();
    DNA_ST(1);
    {
        const int r = tid >> 3, cg = tid & 7;
        const float be = Gs[64 + r], eg = Gs[128 + r], egl = Gs[192 + r];
        float val[3][16];
#pragma unroll
        for (int p = 0; p < 3; ++p) {
            const int ccol = p * DDN + h * HD + cg * 16;
            float acc[16];
#pragma unroll
            for (int i = 0; i < 16; ++i) acc[i] = 0.f;
#pragma unroll
            for (int k = 0; k < 4; ++k) { const int row = r - 3 + k;
                if (n * 64 + row >= 0) {
                    const bf16* src = proj + (size_t)(t0 + row) * NPROJ + 2048 + ccol;
                    const u32x4 x0 = *(const u32x4*)src, x1 = *(const u32x4*)(src + 8);
                    const float* wp = cw + k * 3 * DDN + ccol;
                    const f32x4 w0 = *(const f32x4*)wp, w1 = *(const f32x4*)(wp + 4), w2 = *(const f32x4*)(wp + 8), w3 = *(const f32x4*)(wp + 12);
                    acc[0] += w0[0] * bflo(x0.x); acc[1] += w0[1] * bfhi(x0.x); acc[2] += w0[2] * bflo(x0.y); acc[3] += w0[3] * bfhi(x0.y);
                    acc[4] += w1[0] * bflo(x0.z); acc[5] += w1[1] * bfhi(x0.z); acc[6] += w1[2] * bflo(x0.w); acc[7] += w1[3] * bfhi(x0.w);
                    acc[8] += w2[0] * bflo(x1.x); acc[9] += w2[1] * bfhi(x1.x); acc[10] += w2[2] * bflo(x1.y); acc[11] += w2[3] * bfhi(x1.y);
                    acc[12] += w3[0] * bflo(x1.z); acc[13] += w3[1] * bfhi(x1.z); acc[14] += w3[2] * bflo(x1.w); acc[15] += w3[3] * bfhi(x1.w);
                } }
#pragma unroll
            for (int i = 0; i < 16; ++i) val[p][i] = silu_f(acc[i]);
        }
        float sq = 0.f, sk = 0.f;
#pragma unroll
        for (int i = 0; i < 16; ++i) { sq += val[0][i] * val[0][i]; sk += val[1][i] * val[1][i]; }
        sq += shfl_xor_l(sq, 1, lane); sq += shfl_xor_l(sq, 2, lane); sq += shfl_xor_l(sq, 4, lane);
        sk += shfl_xor_l(sk, 1, lane); sk += shfl_xor_l(sk, 2, lane); sk += shfl_xor_l(sk, 4, lane);
        const float rq = (1.0f / sqrtf(sq + EPS)) * 0.08838834764831845f, rk = 1.0f / sqrtf(sk + EPS);
#pragma unroll
        for (int i = 0; i < 16; ++i) { val[0][i] *= rq; val[1][i] *= rk; }
        u32x4 o0, o1;
        o0.x = pk2(val[1][0], val[1][1]); o0.y = pk2(val[1][2], val[1][3]); o0.z = pk2(val[1][4], val[1][5]); o0.w = pk2(val[1][6], val[1][7]);
        o1.x = pk2(val[1][8], val[1][9]); o1.y = pk2(val[1][10], val[1][11]); o1.z = pk2(val[1][12], val[1][13]); o1.w = pk2(val[1][14], val[1][15]);
        *(LAS u32x4*)(lds + DA_KN + r * 272 + cg * 32) = o0; *(LAS u32x4*)(lds + DA_KN + r * 272 + cg * 32 + 16) = o1;
        o0.x = pk2(val[0][0], val[0][1]); o0.y = pk2(val[0][2], val[0][3]); o0.z = pk2(val[0][4], val[0][5]); o0.w = pk2(val[0][6], val[0][7]);
        o1.x = pk2(val[0][8], val[0][9]); o1.y = pk2(val[0][10], val[0][11]); o1.z = pk2(val[0][12], val[0][13]); o1.w = pk2(val[0][14], val[0][15]);
        *(LAS u32x4*)(lds + DA_QN + r * 272 + cg * 32) = o0; *(LAS u32x4*)(lds + DA_QN + r * 272 + cg * 32 + 16) = o1;
#pragma unroll
        for (int i = 0; i < 16; ++i) { const int f = cg * 16 + i;
            *(LAS unsigned short*)(lds + DA_VBT + f * 144 + r * 2) = (unsigned short)f2bf(val[2][i] * be);
            *(LAS unsigned short*)(lds + DA_KBET + f * 144 + r * 2) = (unsigned short)f2bf(val[1][i] * (be * eg));
            *(LAS unsigned short*)(lds + DA_KDT + f * 144 + r * 2) = (unsigned short)f2bf(val[1][i] * egl); }
    }
    __syncthreads();
    DNA_ST(2);
    {
        const int p = wave >> 2, ti = wave & 3;
        const int abase = p == 0 ? DA_KN : DA_QN;
        bf16x8 af[4];
#pragma unroll
        for (int ks = 0; ks < 4; ++ks) af[ks] = *(const LAS bf16x8*)(lds + abase + (ti * 16 + fr) * 272 + (ks * 32 + fq * 8) * 2);
        for (int tj = 0; tj < 4; ++tj) {
            f32x4 acc = {0.f, 0.f, 0.f, 0.f};
            if (tj <= ti) {
#pragma unroll
                for (int ks = 0; ks < 4; ++ks) { const bf16x8 bb = *(const LAS bf16x8*)(lds + DA_KN + (tj * 16 + fr) * 272 + (ks * 32 + fq * 8) * 2); acc = mfma16(af[ks], bb, acc); }
            }
            const int j = tj * 16 + fr; const float Gj = Gs[j];
#pragma unroll
            for (int r = 0; r < 4; ++r) { const int i = ti * 16 + fq * 4 + r; float v = 0.f;
                if (p == 0) { if (i > j) v = Gs[64 + i] * acc[r] * __expf(Gs[i] - Gj); *(LAS float*)(lds + DA_L + (j * 64 + i) * 4) = v; }
                else { if (i >= j) v = acc[r] * __expf(Gs[i] - Gj); *(LAS unsigned short*)(lds + DA_QK + i * 144 + j * 2) = (unsigned short)f2bf(v); } }
        }
    }
    __syncthreads();
    DNA_ST(3);
    if (wave == 0) {
        float Tc[64]; int lc = lane; asm volatile("" : "+v"(lc)); const float fl = (float)lc;
#pragma unroll
        for (int i = 0; i < 64; ++i) Tc[i] = fmaxf(0.f, 1.f - fabsf(fl - (float)i));
        f32x4 lcur[16], lnxt[16];
#pragma unroll
        for (int g = 0; g < 16; ++g) lcur[g] = *(const LAS f32x4*)(lds + DA_L + (0 * 64 + g * 4) * 4);
#pragma unroll
        for (int j = 0; j < 63; ++j) {
            if (j + 1 < 63) {
#pragma unroll
                for (int g = (j + 2) / 4; g < 16; ++g) lnxt[g] = *(const LAS f32x4*)(lds + DA_L + ((j + 1) * 64 + g * 4) * 4);
            }
            __builtin_amdgcn_sched_barrier(0);
            const float tj = Tc[j];
#pragma unroll
            for (int i = j + 1; i < 64; ++i) Tc[i] -= lcur[i >> 2][i & 3] * tj;
            __builtin_amdgcn_sched_barrier(0);
#pragma unroll
            for (int g = 0; g < 16; ++g) lcur[g] = lnxt[g];
        }
#pragma unroll
        for (int i = 0; i < 64; ++i) *(LAS unsigned short*)(lds + DA_TB + i * 144 + lc * 2) = (unsigned short)f2bf(Tc[i]);
    } else {
        for (int fi = wave - 1; fi < 40; fi += 7) {
            if (fi < 8) { const int mt = fi >> 1, ks = fi & 1;
                const u32x4 v = *(const LAS u32x4*)(lds + DA_QK + (mt * 16 + fr) * 144 + (ks * 32 + fq * 8) * 2);
                *(u32x4*)(QKf + (((size_t)uid * 4 + mt) * 2 + ks) * 512 + lane * 8) = v; }
            else if (fi < 24) { const int f2 = fi - 8, mt = f2 >> 2, ks = f2 & 3; const float eg = Gs[128 + mt * 16 + fr];
                const u32x4 v = *(const LAS u32x4*)(lds + DA_QN + (mt * 16 + fr) * 272 + (ks * 32 + fq * 8) * 2); u32x4 o;
                o.x = pk2(bflo(v.x) * eg, bfhi(v.x) * eg); o.y = pk2(bflo(v.y) * eg, bfhi(v.y) * eg); o.z = pk2(bflo(v.z) * eg, bfhi(v.z) * eg); o.w = pk2(bflo(v.w) * eg, bfhi(v.w) * eg);
                *(u32x4*)(Qf + (((size_t)uid * 4 + mt) * 4 + ks) * 512 + lane * 8) = o; }
            else { const int f2 = fi - 24, ft = f2 >> 1, ks = f2 & 1;
                const u32x4 v = *(const LAS u32x4*)(lds + DA_KDT + (ft * 16 + fr) * 144 + (ks * 32 + fq * 8) * 2);
                *(u32x4*)(KdTf + (((size_t)uid * 8 + ft) * 2 + ks) * 512 + lane * 8) = v; }
        }
    }
    __syncthreads();
    DNA_ST(4);
    {
        bf16x8 ta[4][2];
#pragma unroll
        for (int mt = 0; mt < 4; ++mt)
#pragma unroll
            for (int ks = 0; ks < 2; ++ks) ta[mt][ks] = *(const LAS bf16x8*)(lds + DA_TB + (mt * 16 + fr) * 144 + (ks * 32 + fq * 8) * 2);
#pragma unroll
        for (int c2 = 0; c2 < 2; ++c2) { const int ct = wave * 2 + c2, img = ct < 8 ? DA_VBT : DA_KBET, cr = (ct & 7) * 16 + fr;
            bf16x8 bb[2];
#pragma unroll
            for (int ks = 0; ks < 2; ++ks) bb[ks] = *(const LAS bf16x8*)(lds + img + cr * 144 + (ks * 32 + fq * 8) * 2);
#pragma unroll
            for (int mt = 0; mt < 4; ++mt) { f32x4 acc = {0.f, 0.f, 0.f, 0.f};
#pragma unroll
                for (int ks = 0; ks < 2; ++ks) acc = mfma16(ta[mt][ks], bb[ks], acc);
                if (ct < 8) { u32x2 o; o.x = pk2(acc[0], acc[1]); o.y = pk2(acc[2], acc[3]); *(u32x2*)(Uf + ((((size_t)uid * 8 + ct) * 4 + mt) * 64 + lane) * 4) = o; }
                else { const int f = (ct - 8) * 16 + fr;
#pragma unroll
                    for (int r = 0; r < 4; ++r) *(LAS unsigned short*)(lds + DA_KN + (mt * 16 + fq * 4 + r) * 272 + f * 2) = (unsigned short)f2bf(acc[r]); } }
        }
    }
    __syncthreads();
    DNA_ST(5);
#pragma unroll
    for (int q2 = 0; q2 < 2; ++q2) { const int fi = wave * 2 + q2, mt = fi >> 2, ks = fi & 3;
        const u32x4 v = *(const LAS u32x4*)(lds + DA_KN + (mt * 16 + fr) * 272 + (ks * 32 + fq * 8) * 2);
        *(u32x4*)(Wf + (((size_t)uid * 4 + mt) * 4 + ks) * 512 + lane * 8) = v; }
    __syncthreads();
    DNA_ST(6);
}
struct DnbFrag { bf16x8 a1[4]; bf16x8 a2[2]; bf16x8 kd[2]; u32x2 u; float gl; };
__device__ __forceinline__ DnbFrag dnb_load(const bf16* A1, const bf16* QKf, const bf16* KdTf, const bf16* Uf, const float* glb, int uid, int ds, int wave, int lane) {
    DnbFrag f; const int mt = wave & 3;
#pragma unroll
    for (int ks = 0; ks < 4; ++ks) f.a1[ks] = *(const bf16x8*)(A1 + (((size_t)uid * 4 + mt) * 4 + ks) * 512 + lane * 8);
#pragma unroll
    for (int ks = 0; ks < 2; ++ks) f.kd[ks] = *(const bf16x8*)(KdTf + (((size_t)uid * 8 + wave) * 2 + ks) * 512 + lane * 8);
#pragma unroll
    for (int ks = 0; ks < 2; ++ks) f.a2[ks] = *(const bf16x8*)(QKf + (((size_t)uid * 4 + mt) * 2 + ks) * 512 + lane * 8);
    f.u = *(const u32x2*)(Uf + ((((size_t)uid * 8 + ds) * 4 + mt) * 64 + lane) * 4);
    f.gl = glb[uid];
    return f;
}
__device__ __forceinline__ void dnb_run(const bf16* Wf, const bf16* Qf, const bf16* KdTf, const bf16* QKf, const bf16* Uf, const float* glb, float* o, int bh, int ds, LAS unsigned char* lds, int tid, int lane, int wave) {
    const int b = bh >> 3, h = bh & 7, fr = lane & 15, fq = lane >> 4, mt = wave & 3;
    asm volatile("" : "+v"(lds));
    LAS unsigned char* ST = lds; LAS unsigned char* VNT = lds + 4608;
    for (int i = tid; i < 4608 / 4; i += 512) ((LAS unsigned*)ST)[i] = 0u;
    f32x4 accS = {0.f, 0.f, 0.f, 0.f};
    const bf16* A1 = wave < 4 ? Wf : Qf;
    DnbFrag f0 = dnb_load(A1, QKf, KdTf, Uf, glb, (b * 128 + 0) * 8 + h, ds, wave, lane), f1 = dnb_load(A1, QKf, KdTf, Uf, glb, (b * 128 + 1) * 8 + h, ds, wave, lane);
    DnbFrag f2 = dnb_load(A1, QKf, KdTf, Uf, glb, (b * 128 + 2) * 8 + h, ds, wave, lane), f3 = dnb_load(A1, QKf, KdTf, Uf, glb, (b * 128 + 3) * 8 + h, ds, wave, lane);
    __syncthreads();
#define DNB_STEP(F, nn) do { const int n = (nn); \
        f32x4 acc = {0.f, 0.f, 0.f, 0.f}; \
        _Pragma("unroll") for (int ks = 0; ks < 4; ++ks) { const bf16x8 sb = *(const LAS bf16x8*)(ST + fr * 272 + (ks * 32 + fq * 8) * 2); acc = mfma16(F.a1[ks], sb, acc); } \
        if (wave < 4) { const float v0 = bflo(F.u.x) - acc[0], v1 = bfhi(F.u.x) - acc[1], v2 = bflo(F.u.y) - acc[2], v3 = bfhi(F.u.y) - acc[3]; \
            u32x2 w; w.x = pk2(v0, v1); w.y = pk2(v2, v3); *(LAS u32x2*)(VNT + fr * 144 + (mt * 16 + fq * 4) * 2) = w; } \
        LDS_BARRIER(); \
        bf16x8 vb[2]; \
        _Pragma("unroll") for (int ks = 0; ks < 2; ++ks) vb[ks] = *(const LAS bf16x8*)(VNT + fr * 144 + (ks * 32 + fq * 8) * 2); \
        if (wave >= 4) { _Pragma("unroll") for (int ks = 0; ks < 2; ++ks) acc = mfma16(F.a2[ks], vb[ks], acc); \
            const size_t ob = ((size_t)(b * SEQ + n * 64 + mt * 16 + fq * 4) * NH + h) * HD + ds * 16 + fr; \
            _Pragma("unroll") for (int r = 0; r < 4; ++r) o[ob + (size_t)r * NH * HD] = acc[r]; } \
        accS = accS * F.gl; \
        _Pragma("unroll") for (int ks = 0; ks < 2; ++ks) accS = mfma16(F.kd[ks], vb[ks], accS); \
        { u32x2 w; w.x = pk2(accS[0], accS[1]); w.y = pk2(accS[2], accS[3]); *(LAS u32x2*)(ST + fr * 272 + (wave * 16 + fq * 4) * 2) = w; } \
        F = dnb_load(A1, QKf, KdTf, Uf, glb, (b * 128 + (n + 4 < 128 ? n + 4 : 127)) * 8 + h, ds, wave, lane);     \
        LDS_BARRIER(); } while (0)
    for (int n4 = 0; n4 < 128; n4 += 16) {
        DNB_STEP(f0, n4); DNB_STEP(f1, n4 + 1); DNB_STEP(f2, n4 + 2); DNB_STEP(f3, n4 + 3); DNB_STEP(f0, n4 + 4); DNB_STEP(f1, n4 + 5); DNB_STEP(f2, n4 + 6); DNB_STEP(f3, n4 + 7);
        DNB_STEP(f0, n4 + 8); DNB_STEP(f1, n4 + 9); DNB_STEP(f2, n4 + 10); DNB_STEP(f3, n4 + 11); DNB_STEP(f0, n4 + 12); DNB_STEP(f1, n4 + 13); DNB_STEP(f2, n4 + 14); DNB_STEP(f3, n4 + 15); }
#undef DNB_STEP
}
constexpr int LA_XB = 0, LA_XF = 17408, LA_END = LA_XF + 64 * 132 * 4;
static_assert(LA_END <= RING_BYTES, "LRU-A LDS map");
__device__ __forceinline__ void lrua_unit(const bf16* proj, const float* cw, const float* cb, const bf16* WrT, const bf16* WiT, const float* b_r, const float* b_i, const float* lam,
                                          float* Hloc, float* Acum, float* summ, int unit, LAS unsigned char* lds, int tid, int lane, int wave) {
    const int nb = unit & 7, ct = unit >> 3, n = ct & 127, t0 = ct * 64;
    asm volatile("" : "+v"(lds));
    {
        const int r = tid >> 3, cg = tid & 7, ch0 = nb * 128 + cg * 16;
        float acc[16];
        { const f32x4 c0v = *(const f32x4*)(cb + ch0), c1v = *(const f32x4*)(cb + ch0 + 4), c2v = *(const f32x4*)(cb + ch0 + 8), c3v = *(const f32x4*)(cb + ch0 + 12);
#pragma unroll
          for (int i = 0; i < 4; ++i) { acc[i] = c0v[i]; acc[4 + i] = c1v[i]; acc[8 + i] = c2v[i]; acc[12 + i] = c3v[i]; } }
#pragma unroll
        for (int k = 0; k < 4; ++k) { const int row = r - 3 + k;
            if (n * 64 + row >= 0) {
                const bf16* src = proj + (size_t)(t0 + row) * NPROJ + ch0;
                const u32x4 x0 = *(const u32x4*)src, x1 = *(const u32x4*)(src + 8);
                const float* wp = cw + k * DLRU + ch0;
                const f32x4 w0 = *(const f32x4*)wp, w1 = *(const f32x4*)(wp + 4), w2 = *(const f32x4*)(wp + 8), w3 = *(const f32x4*)(wp + 12);
                acc[0] += w0[0] * bflo(x0.x); acc[1] += w0[1] * bfhi(x0.x); acc[2] += w0[2] * bflo(x0.y); acc[3] += w0[3] * bfhi(x0.y);
                acc[4] += w1[0] * bflo(x0.z); acc[5] += w1[1] * bfhi(x0.z); acc[6] += w1[2] * bflo(x0.w); acc[7] += w1[3] * bfhi(x0.w);
                acc[8] += w2[0] * bflo(x1.x); acc[9] += w2[1] * bfhi(x1.x); acc[10] += w2[2] * bflo(x1.y); acc[11] += w2[3] * bfhi(x1.y);
                acc[12] += w3[0] * bflo(x1.z); acc[13] += w3[1] * bfhi(x1.z); acc[14] += w3[2] * bflo(x1.w); acc[15] += w3[3] * bfhi(x1.w);
            } }
        u32x4 o0, o1;
        o0.x = pk2(acc[0], acc[1]); o0.y = pk2(acc[2], acc[3]); o0.z = pk2(acc[4], acc[5]); o0.w = pk2(acc[6], acc[7]);
        o1.x = pk2(acc[8], acc[9]); o1.y = pk2(acc[10], acc[11]); o1.z = pk2(acc[12], acc[13]); o1.w = pk2(acc[14], acc[15]);
        *(LAS u32x4*)(lds + LA_XB + r * 272 + cg * 32) = o0; *(LAS u32x4*)(lds + LA_XB + r * 272 + cg * 32 + 16) = o1;
        LAS f32x4* xf = (LAS f32x4*)(lds + LA_XF + (r * 132 + cg * 16) * 4);
        xf[0] = (f32x4){acc[0], acc[1], acc[2], acc[3]}; xf[1] = (f32x4){acc[4], acc[5], acc[6], acc[7]}; xf[2] = (f32x4){acc[8], acc[9], acc[10], acc[11]}; xf[3] = (f32x4){acc[12], acc[13], acc[14], acc[15]};
    }
    __syncthreads();
    const int fr = lane & 15, fq = lane >> 4, cl = wave * 16 + fr, ch = nb * 128 + cl;
    bf16x8 br[4], bi[4];
#pragma unroll
    for (int ks = 0; ks < 4; ++ks) { br[ks] = *(const bf16x8*)(WrT + ((size_t)nb * 128 + cl) * 128 + ks * 32 + fq * 8); bi[ks] = *(const bf16x8*)(WiT + ((size_t)nb * 128 + cl) * 128 + ks * 32 + fq * 8); }
    f32x4 ar[4], ai[4];
#pragma unroll
    for (int mt = 0; mt < 4; ++mt) { ar[mt] = (f32x4){0.f, 0.f, 0.f, 0.f}; ai[mt] = (f32x4){0.f, 0.f, 0.f, 0.f};
#pragma unroll
        for (int ks = 0; ks < 4; ++ks) { const bf16x8 af = *(const LAS bf16x8*)(lds + LA_XB + (mt * 16 + fr) * 272 + (ks * 32 + fq * 8) * 2); ar[mt] = mfma16(af, br[ks], ar[mt]); ai[mt] = mfma16(af, bi[ks], ai[mt]); } }
    const float brr = b_r[ch], bii = b_i[ch], sp8 = -8.0f * softplus_f(-lam[ch]);
    float Ac = 1.f, Bc = 0.f;
#pragma unroll
    for (int mt = 0; mt < 4; ++mt) {
        float P[4], H[4];
#pragma unroll
        for (int r = 0; r < 4; ++r) { const int t = mt * 16 + fq * 4 + r; const float xcv = *(const LAS float*)(lds + LA_XF + (t * 132 + cl) * 4);
            const float rr = sigmoid_f(ar[mt][r] + brr), ii = sigmoid_f(ai[mt][r] + bii), la = sp8 * rr, a = __expf(la), bb = sqrtf(-expm1f(2.0f * la)) * (ii * xcv);
            if (r == 0) { P[0] = a; H[0] = bb; } else { P[r] = P[r - 1] * a; H[r] = a * H[r - 1] + bb; } }
        float Ai = P[3], Bi = H[3];
        { const float Au = shfl_up_l(Ai, 16, lane), Bu = shfl_up_l(Bi, 16, lane); if (fq >= 1) { Bi = Ai * Bu + Bi; Ai = Au * Ai; } }
        { const float Au = shfl_up_l(Ai, 32, lane), Bu = shfl_up_l(Bi, 32, lane); if (fq >= 2) { Bi = Ai * Bu + Bi; Ai = Au * Ai; } }
        float Ae = shfl_up_l(Ai, 16, lane), Be = shfl_up_l(Bi, 16, lane); if (fq == 0) { Ae = 1.f; Be = 0.f; }
        const float At = shfl_idx_l(Ai, 48 + fr), Bt = shfl_idx_l(Bi, 48 + fr);
        const float PA = Ac * Ae, PB = Ae * Bc + Be;
#pragma unroll
        for (int r = 0; r < 4; ++r) { const size_t o = (size_t)(t0 + mt * 16 + fq * 4 + r) * DLRU + ch; Acum[o] = PA * P[r]; Hloc[o] = P[r] * PB + H[r]; }
        Bc = At * Bc + Bt; Ac = Ac * At;
    }
    if (fq == 0) { float* sp = summ + ((size_t)ct * DLRU + ch) * 2; sp[0] = Ac; sp[1] = Bc; }
    __syncthreads();
}
__device__ __forceinline__ void lru_carry(const float* summ, float* carry, int idx) {
    const int b = idx >> 10, ch = idx & 1023; float c = 0.f;
    for (int n0 = 0; n0 < 128; n0 += 8) { float A[8], B[8];
#pragma unroll
        for (int j = 0; j < 8; ++j) { const float* sp = summ + ((size_t)(b * 128 + n0 + j) * DLRU + ch) * 2; A[j] = sp[0]; B[j] = sp[1]; }
#pragma unroll
        for (int j = 0; j < 8; ++j) { carry[(size_t)(b * 128 + n0 + j) * DLRU + ch] = c; c = A[j] * c + B[j]; } }
}
__device__ __forceinline__ void lrub_row(const float* Hloc, const float* Acum, const float* carry, const bf16* proj, const float* gain, bf16* ymix, int row, int lane) {
    const int ct = row >> 6; f32x4 y[4]; float ss = 0.f;
#pragma unroll
    for (int j = 0; j < 4; ++j) { const int c4 = lane * 4 + 256 * j;
        const f32x4 hl = *(const f32x4*)(Hloc + (size_t)row * DLRU + c4), ac = *(const f32x4*)(Acum + (size_t)row * DLRU + c4), cr = *(const f32x4*)(carry + (size_t)ct * DLRU + c4);
        const u32x2 g = *(const u32x2*)(proj + (size_t)row * NPROJ + DLRU + c4);
        const f32x4 hh = hl + ac * cr;
        y[j][0] = hh[0] * gelu_tanh_f(bflo(g.x)); y[j][1] = hh[1] * gelu_tanh_f(bfhi(g.x)); y[j][2] = hh[2] * gelu_tanh_f(bflo(g.y)); y[j][3] = hh[3] * gelu_tanh_f(bfhi(g.y));
        ss += (y[j][0] * y[j][0] + y[j][1] * y[j][1]) + (y[j][2] * y[j][2] + y[j][3] * y[j][3]); }
    ss = wave_sum(ss, lane); const float rs = 1.0f / sqrtf(ss * (1.0f / DLRU) + EPS);
#pragma unroll
    for (int j = 0; j < 4; ++j) { const int c4 = lane * 4 + 256 * j; const f32x4 g = *(const f32x4*)(gain + c4); u32x2 w; w.x = pk2(y[j][0] * rs * g[0], y[j][1] * rs * g[1]); w.y = pk2(y[j][2] * rs * g[2], y[j][3] * rs * g[3]);
        *(u32x2*)(ymix + (size_t)row * D + c4) = w; }
}
__device__ __forceinline__ void dn_out_row(const float* o, const float* gain, const bf16* proj, bf16* ymix, int t, int lane) {
    const int c = lane * 16;
    const f32x4* op = (const f32x4*)(o + (size_t)t * DDN + c); const f32x4 o0 = op[0], o1 = op[1], o2 = op[2], o3 = op[3];
    const u32x4* gp = (const u32x4*)(proj + (size_t)t * NPROJ + 5120 + c); const u32x4 g0 = gp[0], g1 = gp[1];
    const f32x4* wp = (const f32x4*)(gain + (c & 127)); const f32x4 w0 = wp[0], w1 = wp[1], w2 = wp[2], w3 = wp[3];
    float ss = (o0[0] * o0[0] + o0[1] * o0[1]) + (o0[2] * o0[2] + o0[3] * o0[3]) + (o1[0] * o1[0] + o1[1] * o1[1]) + (o1[2] * o1[2] + o1[3] * o1[3])
             + (o2[0] * o2[0] + o2[1] * o2[1]) + (o2[2] * o2[2] + o2[3] * o2[3]) + (o3[0] * o3[0] + o3[1] * o3[1]) + (o3[2] * o3[2] + o3[3] * o3[3]);
    ss += shfl_xor_l(ss, 1, lane); ss += shfl_xor_l(ss, 2, lane); ss += shfl_xor_l(ss, 4, lane);
    const float rs = 1.0f / sqrtf(ss * (1.0f / HD) + EPS);
    u32x4 r0, r1;
    r0.x = pk2(o0[0] * rs * w0[0] * silu_f(bflo(g0.x)), o0[1] * rs * w0[1] * silu_f(bfhi(g0.x))); r0.y = pk2(o0[2] * rs * w0[2] * silu_f(bflo(g0.y)), o0[3] * rs * w0[3] * silu_f(bfhi(g0.y)));
    r0.z = pk2(o1[0] * rs * w1[0] * silu_f(bflo(g0.z)), o1[1] * rs * w1[1] * silu_f(bfhi(g0.z))); r0.w = pk2(o1[2] * rs * w1[2] * silu_f(bflo(g0.w)), o1[3] * rs * w1[3] * silu_f(bfhi(g0.w)));
    r1.x = pk2(o2[0] * rs * w2[0] * silu_f(bflo(g1.x)), o2[1] * rs * w2[1] * silu_f(bfhi(g1.x))); r1.y = pk2(o2[2] * rs * w2[2] * silu_f(bflo(g1.y)), o2[3] * rs * w2[3] * silu_f(bfhi(g1.y)));
    r1.z = pk2(o3[0] * rs * w3[0] * silu_f(bflo(g1.z)), o3[1] * rs * w3[1] * silu_f(bfhi(g1.z))); r1.w = pk2(o3[2] * rs * w3[2] * silu_f(bflo(g1.w)), o3[3] * rs * w3[3] * silu_f(bfhi(g1.w)));
    u32x4* dst = (u32x4*)(ymix + (size_t)t * D + DLRU + c); dst[0] = r0; dst[1] = r1;
}
__device__ __forceinline__ void route_row(const float* x, const float* rstd, const float* gain, const float* router, float* roww, int row, int lane) {
    float acc[8];
#pragma unroll
    for (int e = 0; e < 8; ++e) acc[e] = 0.f;
    for (int j = 0; j < 32; ++j) { const int k = lane + 64 * j; const float xv = x[(size_t)row * D + k] * gain[k]; const f32x4 r0 = *(const f32x4*)(router + (size_t)k * 8), r1 = *(const f32x4*)(router + (size_t)k * 8 + 4);
        acc[0] += xv * r0[0]; acc[1] += xv * r0[1]; acc[2] += xv * r0[2]; acc[3] += xv * r0[3]; acc[4] += xv * r1[0]; acc[5] += xv * r1[1]; acc[6] += xv * r1[2]; acc[7] += xv * r1[3]; }
    const float rs = rstd[row];
#pragma unroll
    for (int e = 0; e < 8; ++e) acc[e] = wave_sum(acc[e], lane) * rs;
    int e1 = 0; float l1 = acc[0];
#pragma unroll
    for (int e = 1; e < 8; ++e) if (acc[e] > l1) { l1 = acc[e]; e1 = e; }
    int e2 = -1; float l2 = -3.4e38f;
#pragma unroll
    for (int e = 0; e < 8; ++e) if (e != e1 && acc[e] > l2) { l2 = acc[e]; e2 = e; }
    const float w1 = 1.0f / (1.0f + __expf(l2 - l1)), w2 = 1.0f - w1;
    if (lane < 8) roww[(size_t)lane * T + row] = lane == e1 ? w1 : (lane == e2 ? w2 : 0.0f);
}
__device__ __forceinline__ void final_row(const float* x, const float* gain, float* out, int row, int lane) {
    const f32x4* xr = (const f32x4*)(x + (size_t)row * D) + lane; const f32x4* gr = (const f32x4*)gain + lane;
    f32x4 v[8]; float ss = 0.f;
#pragma unroll
    for (int j = 0; j < 8; ++j) { v[j] = xr[64 * j]; ss += (v[j][0] * v[j][0] + v[j][1] * v[j][1]) + (v[j][2] * v[j][2] + v[j][3] * v[j][3]); }
    ss = wave_sum(ss, lane); const float rs = 1.0f / sqrtf(ss * (1.0f / D) + EPS);
    f32x4* o = (f32x4*)(out + (size_t)row * D) + lane;
#pragma unroll
    for (int j = 0; j < 8; ++j) o[64 * j] = v[j] * rs * gr[64 * j];
}

struct MoeOrder {
    const int* list; int nN, G, c; int c0, c1, c2, c3, c4, c5, c6, c7;
    __device__ __forceinline__ void init(const unsigned* cnt, const int* list_, int nN_, int G_, int c_) { list = list_; nN = nN_; G = G_; c = c_;
        c0 = __builtin_amdgcn_readfirstlane((int)cnt[0]); c1 = __builtin_amdgcn_readfirstlane((int)cnt[1]); c2 = __builtin_amdgcn_readfirstlane((int)cnt[2]); c3 = __builtin_amdgcn_readfirstlane((int)cnt[3]);
        c4 = __builtin_amdgcn_readfirstlane((int)cnt[4]); c5 = __builtin_amdgcn_readfirstlane((int)cnt[5]); c6 = __builtin_amdgcn_readfirstlane((int)cnt[6]); c7 = __builtin_amdgcn_readfirstlane((int)cnt[7]); }
    __device__ __forceinline__ bool next(int i, pg8::Unit& u) const {
        const int c8[8] = {c0, c1, c2, c3, c4, c5, c6, c7}; int nM = 0;
#pragma unroll
        for (int k = 0; k < 8; ++k) nM += (c8[k] + 255) >> 8;
        const int nwg = nM * nN; const long L = (long)i * G + c; if (L >= nwg) return false;
        int wgid = (int)L; { const int q = nwg / pg8::NXCD, r = nwg % pg8::NXCD, xcd = wgid % pg8::NXCD, off = wgid / pg8::NXCD; wgid = (xcd < r ? xcd * (q + 1) : r * (q + 1) + (xcd - r) * q) + off; }
        const int nig = pg8::WGM * nN, gid = wgid / nig, fm = gid * pg8::WGM, gsz = (nM - fm) < pg8::WGM ? (nM - fm) : pg8::WGM;
        u.pm = fm + ((wgid % nig) % gsz); u.pn = (wgid % nig) / gsz;
        int e = 0, ps = 0, ce = c8[0], run = 0;
#pragma unroll
        for (int k = 0; k < 8; ++k) { const int mk = (c8[k] + 255) >> 8; if (u.pm >= run && u.pm < run + mk) { e = k; ps = run; ce = c8[k]; } run += mk; }
        const int mtl = u.pm - ps; u.pb = e * nN + u.pn; u.lbase = e * T + mtl * 256; u.nvalid = (ce - mtl * 256) < 256 ? (ce - mtl * 256) : 256;
        return true;
    }
    __device__ __forceinline__ int arow(const pg8::Unit& u, int r) const { return r < u.nvalid ? (list[u.lbase + r] & 0xffff) : 0; }
    __device__ __forceinline__ void a_ready(const pg8::Unit&) const {}
    __device__ __forceinline__ void done(const pg8::Unit&) const {}
};
__device__ __forceinline__ void route_block(const float* x, const float* gain, const float* router, bf16* xb, float* rstd, unsigned* cnt, int* list, float* listw, int blk, LAS unsigned char* lds, int tid, int lane, int wave) {
    asm volatile("" : "+v"(lds));
    LAS float* grt = (LAS float*)lds; LAS int* se1 = (LAS int*)(lds + 65536); LAS int* se2 = se1 + 64; LAS float* sw1 = (LAS float*)(se2 + 64); LAS float* sw2 = sw1 + 64; LAS int* lcnt = (LAS int*)(sw2 + 64); LAS int* gbase = lcnt + 8;
    for (int i = tid; i < D * 8; i += 512) grt[i] = router[i] * gain[i >> 3];
    if (tid < 8) lcnt[tid] = 0;
    __syncthreads();
    for (int q = 0; q < 8; ++q) { const int rloc = wave * 8 + q, row = blk * 64 + rloc;
        const f32x4* xr = (const f32x4*)(x + (size_t)row * D) + lane;
        f32x4 v[8]; float ss = 0.f;
#pragma unroll
        for (int j = 0; j < 8; ++j) { v[j] = xr[64 * j]; ss += (v[j][0] * v[j][0] + v[j][1] * v[j][1]) + (v[j][2] * v[j][2] + v[j][3] * v[j][3]); }
        ss = wave_sum(ss, lane); const float rs = 1.0f / sqrtf(ss * (1.0f / D) + EPS);
        u32x2* o = (u32x2*)(xb + (size_t)row * D) + lane;
#pragma unroll
        for (int j = 0; j < 8; ++j) { u32x2 w; w.x = pk2(v[j][0], v[j][1]); w.y = pk2(v[j][2], v[j][3]); o[64 * j] = w; }
        if (lane == 0) rstd[row] = rs;
        float acc[8];
#pragma unroll
        for (int e = 0; e < 8; ++e) acc[e] = 0.f;
#pragma unroll
        for (int j = 0; j < 8; ++j)
#pragma unroll
            for (int c = 0; c < 4; ++c) { const int k = (lane + 64 * j) * 4 + c; const f32x4 r0 = *(const LAS f32x4*)(grt + k * 8), r1 = *(const LAS f32x4*)(grt + k * 8 + 4); const float xv = v[j][c];
                acc[0] += xv * r0[0]; acc[1] += xv * r0[1]; acc[2] += xv * r0[2]; acc[3] += xv * r0[3]; acc[4] += xv * r1[0]; acc[5] += xv * r1[1]; acc[6] += xv * r1[2]; acc[7] += xv * r1[3]; }
#pragma unroll
        for (int e = 0; e < 8; ++e) acc[e] = wave_sum(acc[e], lane) * rs;
        int e1 = 0; float l1 = acc[0];
#pragma unroll
        for (int e = 1; e < 8; ++e) if (acc[e] > l1) { l1 = acc[e]; e1 = e; }
        int e2 = -1; float l2 = -3.4e38f;
#pragma unroll
        for (int e = 0; e < 8; ++e) if (e != e1 && acc[e] > l2) { l2 = acc[e]; e2 = e; }
        const float w1 = 1.0f / (1.0f + __expf(l2 - l1));
        if (lane == 0) { se1[rloc] = e1; se2[rloc] = e2; sw1[rloc] = w1; sw2[rloc] = 1.0f - w1; }
    }
    __syncthreads();
    int e = 0, lr = 0; float w = 0.f;
    if (tid < 128) { const int rloc = tid >> 1, j = tid & 1; e = j ? se2[rloc] : se1[rloc]; w = j ? sw2[rloc] : sw1[rloc]; lr = __hip_atomic_fetch_add(lcnt + e, 1, __ATOMIC_RELAXED, __HIP_MEMORY_SCOPE_WORKGROUP); }
    __syncthreads();
    if (tid < 8) gbase[tid] = (int)__hip_atomic_fetch_add(cnt + tid, (unsigned)lcnt[tid], __ATOMIC_RELAXED, __HIP_MEMORY_SCOPE_AGENT);
    __syncthreads();
    if (tid < 128) { const int pos = gbase[e] + lr, tok = blk * 64 + (tid >> 1); list[e * T + pos] = tok | ((tid & 1) << 16); listw[e * T + pos] = w; }
    __syncthreads();
}
__device__ __forceinline__ void final_row_moe(const float* x, const bf16* y0, const bf16* y1, const float* gain, float* out, int row, int lane) {
    const f32x4* xr = (const f32x4*)(x + (size_t)row * D) + lane; const f32x4* gr = (const f32x4*)gain + lane;
    const u32x2* p0 = (const u32x2*)(y0 + (size_t)row * D) + lane; const u32x2* p1 = (const u32x2*)(y1 + (size_t)row * D) + lane;
    f32x4 v[8]; float ss = 0.f;
#pragma unroll
    for (int j = 0; j < 8; ++j) { v[j] = xr[64 * j]; const u32x2 a = p0[64 * j], b = p1[64 * j];
        v[j][0] += bflo(a.x) + bflo(b.x); v[j][1] += bfhi(a.x) + bfhi(b.x); v[j][2] += bflo(a.y) + bflo(b.y); v[j][3] += bfhi(a.y) + bfhi(b.y);
        ss += (v[j][0] * v[j][0] + v[j][1] * v[j][1]) + (v[j][2] * v[j][2] + v[j][3] * v[j][3]); }
    ss = wave_sum(ss, lane); const float rs = 1.0f / sqrtf(ss * (1.0f / D) + EPS);
    f32x4* o = (f32x4*)(out + (size_t)row * D) + lane;
#pragma unroll
    for (int j = 0; j < 8; ++j) o[64 * j] = v[j] * rs * gr[64 * j];
}
struct Args { const float* in[25]; float* out; unsigned char* ws; int ph_lo, ph_hi; };
typedef const __attribute__((address_space(4))) unsigned long long* kaptr_t;
__device__ __forceinline__ unsigned long long ldka(int i) { kaptr_t ka = (kaptr_t)__builtin_amdgcn_kernarg_segment_ptr(); asm volatile("" : "+s"(i)); return ka[i]; }
__device__ __forceinline__ const float* ldin(const Args&, int i) { return (const float*)(const GAS float*)ldka(i); }
__device__ __forceinline__ unsigned char* ldws(const Args&) { return (unsigned char*)(GAS unsigned char*)ldka(26); }
__device__ __forceinline__ float* ldout(const Args&) { return (float*)(GAS float*)ldka(25); }
__global__ void __launch_bounds__(512, 2) mega(Args args) {
    extern __shared__ __attribute__((aligned(16))) unsigned char lds_raw[];
    LAS unsigned char* lds = (LAS unsigned char*)lds_raw;
    volatile LAS unsigned* MISC = (volatile LAS unsigned*)(lds + MISC_OFF);
    const int tid = threadIdx.x;
    const int G = gridDim.x, bid = blockIdx.x, NGW = G * 8;
    unsigned char* ws = ldws(args);
    for (int u = tid; u < (LDS_BYTES - LDSCTL_OFF) / 4; u += 512) ((LAS unsigned*)(lds + LDSCTL_OFF))[u] = 0u;
    __syncthreads();
    (void)xcd_barrier_post((unsigned*)(ws + WS_CTL) + CW_BAR, MISC + 8);
#define RUN(id) true
#if defined(PROBE_MASK)
#define STAMP() do { if (threadIdx.x == 0) { ((volatile LAS unsigned long long*)(lds + LDSCTL_OFF + 1024))[nst] = __builtin_amdgcn_s_memrealtime(); } ++nst; } while (0)
#else
#define STAMP() do { } while (0)
#endif
#define SEAM(id) do { XcdBarrier bar_; bar_.bar = (unsigned*)WSP(WS_CTL) + CW_BAR; bar_.x = xb_xcc_id(); bar_.st = (volatile LAS unsigned*)(lds + MISC_OFF) + 8; xcd_barrier(bar_); STAMP(); } while (0)
#if defined(PROBE_MASK)
    int nst = 0; STAMP();
#endif
#define INP(i) ldin(args, (i))
#define WSP(off) (ldws(args) + (off))
#define x_in INP(0)
#define norm_mix INP(1)
#define w_in INP(2)
#define conv_lru_w INP(3)
#define conv_lru_b INP(4)
#define lru_w_r INP(5)
#define lru_b_r INP(6)
#define lru_w_i INP(7)
#define lru_b_i INP(8)
#define lru_lambda INP(9)
#define lru_out_norm INP(10)
#define conv_qkv_w INP(11)
#define dn_a_log INP(12)
#define dn_dt_bias INP(13)
#define dn_out_norm INP(14)
#define w_out INP(15)
#define norm_ffn INP(16)
#define ffn_w_gate INP(17)
#define ffn_w_up INP(18)
#define ffn_w_down INP(19)
#define moe_router INP(20)
#define moe_w_gate INP(21)
#define moe_w_up INP(22)
#define moe_w_down INP(23)
#define norm_final INP(24)
#define xres (ldout(args))
#define Win ((bf16*)WSP(WS_WIN))
#define Wba ((float*)WSP(WS_WBA))
#define Wout ((bf16*)WSP(WS_WOUT))
#define Wgu ((bf16*)WSP(WS_WGU))
#define Wd ((bf16*)WSP(WS_WD))
#define Mgu ((bf16*)WSP(WS_C))
#define Md ((bf16*)WSP(WS_WGU))
#define MCNT ((unsigned*)WSP(WS_CTL) + CW_CNT)
#define MLIST ((int*)WSP(WS_ROWW))
#define MLISTW ((float*)WSP(WS_ROWW + (size_t)8 * T * 4))
#define YP0 ((bf16*)WSP(WS_XB))
#define YP1 ((bf16*)WSP(WS_YMIX))
#define xb ((bf16*)WSP(WS_XB))
#define rstd ((float*)WSP(WS_RSTD))
#define ba ((float*)WSP(WS_BA))
#define beta ((float*)WSP(WS_BETA))
#define gg ((float*)WSP(WS_G))
#define roww ((float*)WSP(WS_ROWW))
#define proj ((bf16*)WSP(WS_PROJ))
#define hid ((bf16*)WSP(WS_PROJ))
#define ymix ((bf16*)WSP(WS_YMIX))
#define c0 ((float*)WSP(WS_C))
#define c1 ((float*)WSP(WS_C + (size_t)T * 1024 * 4))
#define c2 ((float*)WSP(WS_C + (size_t)2 * T * 1024 * 4))
#define c3 ((float*)WSP(WS_C + (size_t)3 * T * 1024 * 4))
#define LRU_WRT ((bf16*)WSP(WS_WRT))
#define LRU_WIT ((bf16*)WSP(WS_WRT + (size_t)2 * 8 * 128 * 128 * 2))
#define LRU_H ((float*)WSP(WS_C + (size_t)256 * MiB))
#define LRU_A ((float*)WSP(WS_C + (size_t)320 * MiB))
#define LRU_SUMM ((float*)WSP(WS_C + (size_t)384 * MiB))
#define LRU_CARRY ((float*)WSP(WS_C + (size_t)386 * MiB))
#define DN_WF ((bf16*)WSP(WS_C))
#define DN_QF ((bf16*)WSP(WS_C + (size_t)32 * MiB))
#define DN_KDTF ((bf16*)WSP(WS_C + (size_t)64 * MiB))
#define DN_UF ((bf16*)WSP(WS_C + (size_t)96 * MiB))
#define DN_QKF ((bf16*)WSP(WS_C + (size_t)128 * MiB))
#define DN_GL ((float*)WSP(WS_C + (size_t)144 * MiB))
    const int BIG = 1 << 30;
#define PHL int tid_ = threadIdx.x; asm volatile("" : "+v"(tid_)); const int lane_ = tid_ & 63; int bid_ = blockIdx.x; asm volatile("" : "+s"(bid_)); const int gw_ = bid_ * 8 + __builtin_amdgcn_readfirstlane(tid_ >> 6); const size_t gt_ = (size_t)bid_ * 512 + tid_, NGT = (size_t)G * 512; LAS float* scr = (LAS float*)(lds + (gw_ & 7) * 16384);
    if (RUN(ph)) { PHL
        convert_matrix(w_in, DIN, 0, D, NPROJ, norm_mix, Win, BIG, 0, 0, scr, gw_, NGW, lane_);
        convert_matrix(w_out, D, 0, D, D, nullptr, Wout, BIG, 0, 0, scr, gw_, NGW, lane_);
        for (int l = 0; l < 2; ++l)
            for (size_t i = gt_; i < (size_t)16 * D; i += NGT) { const int j = (int)(i / D), k = (int)(i % D); Wba[(size_t)l * 16 * D + i] = w_in[(size_t)l * D * DIN + (size_t)k * DIN + NPROJ + j] * norm_mix[l * D + k]; }
        for (int m = 0; m < 16; ++m) {
            convert_matrix(lru_w_r + (size_t)m * 128 * 128, 128, 0, 128, 128, nullptr, LRU_WRT + (size_t)m * 128 * 128, BIG, 0, 0, scr, gw_, NGW, lane_);
            convert_matrix(lru_w_i + (size_t)m * 128 * 128, 128, 0, 128, 128, nullptr, LRU_WIT + (size_t)m * 128 * 128, BIG, 0, 0, scr, gw_, NGW, lane_); }
    }
    SEAM(ph);
    int xsel = 0;
#define xcur (xsel ? (const float*)xres : x_in)
    { constexpr int l = 0;
        if (RUN(ph)) { PHL for (int r = gw_; r < T; r += NGW) rowprep_row(xcur, xb, rstd, Wba + (size_t)l * 16 * D, ba, r, lane_); }
        SEAM(ph);
        if (RUN(ph)) { pg8::Gemm g{xb, Win + (size_t)l * NPROJ * D, T, NPROJ, D, 0}; pg8::StaticOrder S; S.init(T, NPROJ, G, bid); pg8::EpiScaleBf16 E{proj, rstd, NPROJ, 0};
            pg8::gemm_phase<pg8::EpiScaleBf16, pg8::StaticOrder, true, false>(lds, g, S, E); }
        SEAM(ph);
        if (RUN(ph)) { PHL
            for (int u = bid_; u < 2048; u += G) lrua_unit(proj, conv_lru_w + (size_t)l * 4 * DLRU, conv_lru_b + l * DLRU, LRU_WRT + (size_t)l * 8 * 128 * 128, LRU_WIT + (size_t)l * 8 * 128 * 128, lru_b_r + l * DLRU, lru_b_i + l * DLRU, lru_lambda + l * DLRU, LRU_H, LRU_A, LRU_SUMM, u, lds, tid_, lane_, gw_ & 7);
            STAMP();
            for (int uid = bid_; uid < 2048; uid += G) dna_unit(proj, conv_qkv_w + (size_t)l * 4 * 3 * DDN, ba, dn_a_log + l * NH, dn_dt_bias + l * NH, DN_WF, DN_QF, DN_KDTF, DN_QKF, DN_UF, DN_GL, uid, lds, tid_, lane_, gw_ & 7); }
        SEAM(ph);
        if (RUN(ph)) { PHL
            if (bid_ < 128) dnb_run(DN_WF, DN_QF, DN_KDTF, DN_QKF, DN_UF, DN_GL, c3, (bid_ & 7) + 8 * (bid_ >> 6), (bid_ >> 3) & 7, lds, tid_, lane_, gw_ & 7);
            else if (bid_ < 136) { if (tid_ < 256) lru_carry(LRU_SUMM, LRU_CARRY, (bid_ - 128) * 256 + tid_); }
            else { const int cw = gw_ - 136 * 8, CNW = NGW - 136 * 8;
                if (l == 0) {
                    convert_matrix(w_in + (size_t)D * DIN, DIN, 0, D, NPROJ, norm_mix + D, Win + (size_t)NPROJ * D, BIG, 0, 0, scr, cw, CNW, lane_);
                    convert_matrix(w_out + (size_t)D * D, D, 0, D, D, nullptr, Wout + (size_t)D * D, BIG, 0, 0, scr, cw, CNW, lane_);
                    convert_matrix(ffn_w_gate, DFF, 0, D, DFF, norm_ffn, Wgu, 128, 256, 0, scr, cw, CNW, lane_);
                    convert_matrix(ffn_w_up, DFF, 0, D, DFF, norm_ffn, Wgu, 128, 256, 128, scr, cw, CNW, lane_);
                    convert_matrix(ffn_w_down, D, 0, DFF, D, nullptr, Wd, BIG, 0, 0, scr, cw, CNW, lane_);
                } else {
                    for (int e = 0; e < NEXP; ++e) convert_matrix(moe_w_down + (size_t)e * DFFE * D, D, 0, DFFE, D, nullptr, Md + (size_t)e * D * DFFE, BIG, 0, 0, scr, cw, CNW, lane_);
                } } }
        SEAM(ph);
        if (RUN(ph)) { PHL
            for (int r = gw_; r < T; r += NGW) lrub_row(LRU_H, LRU_A, LRU_CARRY, proj, lru_out_norm + l * DLRU, ymix, r, lane_);
            for (int r = gw_; r < T; r += NGW) dn_out_row(c3, dn_out_norm + l * HD, proj, ymix, r, lane_); }
        SEAM(ph);
        if (RUN(ph)) { { pg8::Gemm g{ymix, Wout + (size_t)l * D * D, T, D, D, 0}; pg8::StaticOrder S; S.init(T, D, G, bid); pg8::EpiResidual E{xcur, xres, nullptr, D, 0};
            pg8::gemm_phase<pg8::EpiResidual, pg8::StaticOrder, true, false>(lds, g, S, E); }
            if (l == 1) { PHL
                for (int e = 0; e < NEXP; ++e) {
                    convert_matrix(moe_w_gate + (size_t)e * D * DFFE, DFFE, 0, D, DFFE, norm_ffn + D, Mgu + (size_t)e * 2 * DFFE * D, 128, 256, 0, scr, gw_, NGW, lane_);
                    convert_matrix(moe_w_up + (size_t)e * D * DFFE, DFFE, 0, D, DFFE, norm_ffn + D, Mgu + (size_t)e * 2 * DFFE * D, 128, 256, 128, scr, gw_, NGW, lane_);
 } } }
        SEAM(ph);
        xsel = 1;
        if (l == 0) {
            if (RUN(ph)) { PHL for (int r = gw_; r < T; r += NGW) rowprep_row(xcur, xb, rstd, nullptr, nullptr, r, lane_); }
            SEAM(ph);
            if (RUN(ph)) { pg8::Gemm g{xb, Wgu, T, 2 * DFF, D, 0}; pg8::StaticOrder S; S.init(T, 2 * DFF, G, bid); pg8::EpiSwiGLU E{hid, rstd, DFF, 0};
                pg8::gemm_phase<pg8::EpiSwiGLU, pg8::StaticOrder, true, false>(lds, g, S, E); }
            SEAM(ph);
            if (RUN(ph)) { pg8::Gemm g{hid, Wd, T, D, DFF, 0}; pg8::StaticOrder S; S.init(T, D, G, bid); pg8::EpiResidual E{xcur, xres, nullptr, D, 0};
                pg8::gemm_phase<pg8::EpiResidual, pg8::StaticOrder, true, false>(lds, g, S, E); }
            SEAM(ph);
        } else {
            if (RUN(ph)) { PHL for (int blk = bid_; blk < T / 64; blk += G) route_block(xcur, norm_ffn + D, moe_router, xb, rstd, MCNT, MLIST, MLISTW, blk, lds, tid_, lane_, gw_ & 7); }
            SEAM(ph);
            if (RUN(ph)) { pg8::Gemm g{xb, Mgu, NSLOT, 2 * DFFE, D, 0}; MoeOrder S; S.init(MCNT, MLIST, 2 * DFFE / 256, G, bid); pg8::EpiSwiGLUMoe E{hid, rstd, MLIST, DFFE, 0};
                pg8::gemm_phase<pg8::EpiSwiGLUMoe, MoeOrder, true, true>(lds, g, S, E); }
            SEAM(ph);
            if (RUN(ph)) { pg8::Gemm g{hid, Md, NSLOT, D, DFFE, 0}; MoeOrder S; S.init(MCNT, MLIST, D / 256, G, bid); pg8::EpiMoeDown E{YP0, YP1, MLIST, MLISTW, D, 0};
                pg8::gemm_phase<pg8::EpiMoeDown, MoeOrder, true, false>(lds, g, S, E); }
            SEAM(ph);
        }
    }
    { constexpr int l = 1;
        if (RUN(ph)) { PHL for (int r = gw_; r < T; r += NGW) rowprep_row(xcur, xb, rstd, Wba + (size_t)l * 16 * D, ba, r, lane_); }
        SEAM(ph);
        if (RUN(ph)) { pg8::Gemm g{xb, Win + (size_t)l * NPROJ * D, T, NPROJ, D, 0}; pg8::StaticOrder S; S.init(T, NPROJ, G, bid); pg8::EpiScaleBf16 E{proj, rstd, NPROJ, 0};
            pg8::gemm_phase<pg8::EpiScaleBf16, pg8::StaticOrder, true, false>(lds, g, S, E); }
        SEAM(ph);
        if (RUN(ph)) { PHL
            for (int u = bid_; u < 2048; u += G) lrua_unit(proj, conv_lru_w + (size_t)l * 4 * DLRU, conv_lru_b + l * DLRU, LRU_WRT + (size_t)l * 8 * 128 * 128, LRU_WIT + (size_t)l * 8 * 128 * 128, lru_b_r + l * DLRU, lru_b_i + l * DLRU, lru_lambda + l * DLRU, LRU_H, LRU_A, LRU_SUMM, u, lds, tid_, lane_, gw_ & 7);
            STAMP();
            for (int uid = bid_; uid < 2048; uid += G) dna_unit(proj, conv_qkv_w + (size_t)l * 4 * 3 * DDN, ba, dn_a_log + l * NH, dn_dt_bias + l * NH, DN_WF, DN_QF, DN_KDTF, DN_QKF, DN_UF, DN_GL, uid, lds, tid_, lane_, gw_ & 7); }
        SEAM(ph);
        if (RUN(ph)) { PHL
            if (bid_ < 128) dnb_run(DN_WF, DN_QF, DN_KDTF, DN_QKF, DN_UF, DN_GL, c3, (bid_ & 7) + 8 * (bid_ >> 6), (bid_ >> 3) & 7, lds, tid_, lane_, gw_ & 7);
            else if (bid_ < 136) { if (tid_ < 256) lru_carry(LRU_SUMM, LRU_CARRY, (bid_ - 128) * 256 + tid_); }
            else { const int cw = gw_ - 136 * 8, CNW = NGW - 136 * 8;
                if (l == 0) {
                    convert_matrix(w_in + (size_t)D * DIN, DIN, 0, D, NPROJ, norm_mix + D, Win + (size_t)NPROJ * D, BIG, 0, 0, scr, cw, CNW, lane_);
                    convert_matrix(w_out + (size_t)D * D, D, 0, D, D, nullptr, Wout + (size_t)D * D, BIG, 0, 0, scr, cw, CNW, lane_);
                    convert_matrix(ffn_w_gate, DFF, 0, D, DFF, norm_ffn, Wgu, 128, 256, 0, scr, cw, CNW, lane_);
                    convert_matrix(ffn_w_up, DFF, 0, D, DFF, norm_ffn, Wgu, 128, 256, 128, scr, cw, CNW, lane_);
                    convert_matrix(ffn_w_down, D, 0, DFF, D, nullptr, Wd, BIG, 0, 0, scr, cw, CNW, lane_);
                } else {
                    for (int e = 0; e < NEXP; ++e) convert_matrix(moe_w_down + (size_t)e * DFFE * D, D, 0, DFFE, D, nullptr, Md + (size_t)e * D * DFFE, BIG, 0, 0, scr, cw, CNW, lane_);
                } } }
        SEAM(ph);
        if (RUN(ph)) { PHL
            for (int r = gw_; r < T; r += NGW) lrub_row(LRU_H, LRU_A, LRU_CARRY, proj, lru_out_norm + l * DLRU, ymix, r, lane_);
            for (int r = gw_; r < T; r += NGW) dn_out_row(c3, dn_out_norm + l * HD, proj, ymix, r, lane_); }
        SEAM(ph);
        if (RUN(ph)) { { pg8::Gemm g{ymix, Wout + (size_t)l * D * D, T, D, D, 0}; pg8::StaticOrder S; S.init(T, D, G, bid); pg8::EpiResidual E{xcur, xres, nullptr, D, 0};
            pg8::gemm_phase<pg8::EpiResidual, pg8::StaticOrder, true, false>(lds, g, S, E); }
            if (l == 1) { PHL
                for (int e = 0; e < NEXP; ++e) {
                    convert_matrix(moe_w_gate + (size_t)e * D * DFFE, DFFE, 0, D, DFFE, norm_ffn + D, Mgu + (size_t)e * 2 * DFFE * D, 128, 256, 0, scr, gw_, NGW, lane_);
                    convert_matrix(moe_w_up + (size_t)e * D * DFFE, DFFE, 0, D, DFFE, norm_ffn + D, Mgu + (size_t)e * 2 * DFFE * D, 128, 256, 128, scr, gw_, NGW, lane_);
 } } }
        SEAM(ph);
        xsel = 1;
        if (l == 0) {
            if (RUN(ph)) { PHL for (int r = gw_; r < T; r += NGW) rowprep_row(xcur, xb, rstd, nullptr, nullptr, r, lane_); }
            SEAM(ph);
            if (RUN(ph)) { pg8::Gemm g{xb, Wgu, T, 2 * DFF, D, 0}; pg8::StaticOrder S; S.init(T, 2 * DFF, G, bid); pg8::EpiSwiGLU E{hid, rstd, DFF, 0};
                pg8::gemm_phase<pg8::EpiSwiGLU, pg8::StaticOrder, true, false>(lds, g, S, E); }
            SEAM(ph);
            if (RUN(ph)) { pg8::Gemm g{hid, Wd, T, D, DFF, 0}; pg8::StaticOrder S; S.init(T, D, G, bid); pg8::EpiResidual E{xcur, xres, nullptr, D, 0};
                pg8::gemm_phase<pg8::EpiResidual, pg8::StaticOrder, true, false>(lds, g, S, E); }
            SEAM(ph);
        } else {
            if (RUN(ph)) { PHL for (int blk = bid_; blk < T / 64; blk += G) route_block(xcur, norm_ffn + D, moe_router, xb, rstd, MCNT, MLIST, MLISTW, blk, lds, tid_, lane_, gw_ & 7); }
            SEAM(ph);
            if (RUN(ph)) { pg8::Gemm g{xb, Mgu, NSLOT, 2 * DFFE, D, 0}; MoeOrder S; S.init(MCNT, MLIST, 2 * DFFE / 256, G, bid); pg8::EpiSwiGLUMoe E{hid, rstd, MLIST, DFFE, 0};
                pg8::gemm_phase<pg8::EpiSwiGLUMoe, MoeOrder, true, true>(lds, g, S, E); }
            SEAM(ph);
            if (RUN(ph)) { pg8::Gemm g{hid, Md, NSLOT, D, DFFE, 0}; MoeOrder S; S.init(MCNT, MLIST, D / 256, G, bid); pg8::EpiMoeDown E{YP0, YP1, MLIST, MLISTW, D, 0};
                pg8::gemm_phase<pg8::EpiMoeDown, MoeOrder, true, false>(lds, g, S, E); }
            SEAM(ph);
        }
    }
    if (RUN(ph)) { PHL for (int r = gw_; r < T; r += NGW) final_row_moe(xcur, YP0, YP1, norm_final, xres, r, lane_); }
#if defined(PROBE_MASK)
    __syncthreads(); STAMP();
    if (blockIdx.x == 0 && threadIdx.x == 0) { asm volatile("s_waitcnt vmcnt(0)" ::: "memory"); volatile LAS unsigned long long* st = (volatile LAS unsigned long long*)(lds + LDSCTL_OFF + 1024); unsigned long long tot = 0;
        for (int k = 1; k < nst; ++k) if ((PROBE_MASK >> (k - 1)) & 1ull) tot += st[k] - st[k - 1];
        xres[0] = rintf((float)tot * 0.01f * PROBE_SCALE); }
#endif
#if defined(PROBE_DNA_A)
    __syncthreads();
    if (blockIdx.x == 0 && threadIdx.x == 0) { asm volatile("s_waitcnt vmcnt(0)" ::: "memory"); volatile LAS unsigned long long* st = (volatile LAS unsigned long long*)(lds + (RING_BYTES + 2048));
        xres[0] = rintf((float)(st[PROBE_DNA_B] - st[PROBE_DNA_A]) * 0.01f * PROBE_SCALE); }
#endif
#undef RUN
#undef SEAM
}

extern "C" void kernel_launch(void* const* d_in, const int* in_sizes, int n_in, void* d_out, int out_size, void* d_ws, size_t ws_size, hipStream_t stream) {
    static int grid = 0;
    if (grid == 0) {
        if (n_in != 25 || ws_size < WS_END) { fprintf(stderr, "kernel_launch: unexpected n_in %d / ws_size %zu (need %zu)\n", n_in, ws_size, (size_t)WS_END); grid = -1; return; }
        int dev = 0, cus = 0, per_cu = 0;
        if (hipGetDevice(&dev) != hipSuccess || hipDeviceGetAttribute(&cus, hipDeviceAttributeMultiprocessorCount, dev) != hipSuccess) { grid = -1; return; }
        if (hipFuncSetAttribute((const void*)mega, hipFuncAttributeMaxDynamicSharedMemorySize, LDS_BYTES) != hipSuccess) { fprintf(stderr, "kernel_launch: hipFuncSetAttribute failed\n"); grid = -1; return; }
        if (hipOccupancyMaxActiveBlocksPerMultiprocessor(&per_cu, (const void*)mega, 512, LDS_BYTES) != hipSuccess || per_cu < 1) { fprintf(stderr, "kernel_launch: occupancy query says %d\n", per_cu); }
        (void)hipGetLastError();
        grid = cus;
    }
    if (grid < 0) return;
    if (hipMemsetAsync((char*)d_ws + WS_CTL, 0, CTL_ZERO_BYTES, stream) != hipSuccess) return;
    Args a{};
    for (int i = 0; i < 25; ++i) a.in[i] = (const float*)d_in[i];
    a.out = (float*)d_out; a.ws = (unsigned char*)d_ws; a.ph_lo = 0; a.ph_hi = 1 << 30;
    hipLaunchKernelGGL(mega, dim3(grid), dim3(512), LDS_BYTES, stream, a);
}
```

```cpp
#include <hip/hip_runtime.h>
#include <cstdio>
#include <cstdint>
namespace pg8 {
#define PG8_LAS __attribute__((address_space(3)))
typedef unsigned short bf16_t;
typedef short bf16x8 __attribute__((ext_vector_type(8)));
typedef float f32x4 __attribute__((ext_vector_type(4)));
typedef unsigned u32x4 __attribute__((ext_vector_type(4)));
constexpr int BM = 256, BK = 64, HALF = 128, HTB = HALF * BK * 2  , STAGE_BYTES = 8 * HTB, NXCD = 8, WGM = 8;

__host__ __device__ __forceinline__ int lds_byte(int r, int c) { const int st = (r >> 4) * 2 + (c >> 5), rr = r & 15, cc = c & 31, ob = rr * 64 + cc * 2; return st * 1024 + (ob ^ (((ob >> 9) & 1) << 5)); }
__host__ __device__ __forceinline__ void stage_rc(int b, int& R, int& C) { const int st = b / 1024, sb = b % 1024, swz = sb ^ (((sb >> 9) & 1) << 5); R = (st >> 1) * 16 + swz / 64; C = (st & 1) * 32 + (swz % 64) / 2; }
__host__ __device__ __forceinline__ int perm32(int rho) { const int n = rho >> 4, i = rho & 15; return 8 * (i >> 2) + 4 * n + (i & 3); }

struct Unit { int pm, pn, pb, lbase, nvalid; };
struct Gemm { const bf16_t* A; const bf16_t* Bt; int M, N, K, pad; };

struct StaticOrder {
    int nM, nN, nwg, G, c;
    __host__ __device__ void init(int M, int N, int G_, int c_) { nM = M / BM; nN = N / BM; nwg = nM * nN; G = G_; c = c_; }
    __host__ __device__ bool next(int i, Unit& u) const {
        const long L = (long)i * G + c; if (L >= nwg) return false;
        int wgid = (int)L; { const int q = nwg / NXCD, r = nwg % NXCD, xcd = wgid % NXCD, off = wgid / NXCD; wgid = (xcd < r ? xcd * (q + 1) : r * (q + 1) + (xcd - r) * q) + off; }
        const int nig = WGM * nN, gid = wgid / nig, fm = gid * WGM, gsz = (nM - fm) < WGM ? (nM - fm) : WGM;
        u.pm = fm + ((wgid % nig) % gsz); u.pn = (wgid % nig) / gsz; u.pb = u.pn; u.lbase = 0; u.nvalid = BM; return true;
    }
    __device__ __forceinline__ int arow(const Unit&, int) const { return 0; }
    __device__ __forceinline__ void a_ready(const Unit&) const {}
    __device__ __forceinline__ void done(const Unit&) const {}
};


typedef float f32x2_t __attribute__((ext_vector_type(2)));
typedef __bf16 bf16x2_t __attribute__((ext_vector_type(2)));
__device__ __forceinline__ unsigned cvt_pk_bf16(float lo, float hi) { const f32x2_t v = {lo, hi}; const bf16x2_t b = __builtin_convertvector(v, bf16x2_t); return __builtin_bit_cast(unsigned, b); }
__device__ __forceinline__ float silu_f(float x) { return x / (1.0f + __expf(-x)); }

struct EpiScaleBf16 {
    static constexpr bool PERM = true, AFTER_DRAIN = false;
    bf16_t* O; const float* rs; int ldc; int pad;
    __device__ __forceinline__ void operator()(const f32x4 (&acc)[2][2][4][2], const Unit& u, int wr, int wc, int fr, int fq) const {
        const int row0 = u.pm * BM + wr * 64 + fr, col0 = u.pn * BM + wc * 32 + 8 * fq;
#pragma unroll
        for (int ai = 0; ai < 2; ++ai)
#pragma unroll
            for (int m = 0; m < 4; ++m) { const int r = row0 + ai * HALF + m * 16; const float s = rs[r]; bf16_t* rowp = O + (size_t)r * ldc + col0;
#pragma unroll
                for (int bj = 0; bj < 2; ++bj) { const f32x4 v0 = acc[ai][bj][m][0] * s, v1 = acc[ai][bj][m][1] * s;
                    u32x4 w; w.x = cvt_pk_bf16(v0[0], v0[1]); w.y = cvt_pk_bf16(v0[2], v0[3]); w.z = cvt_pk_bf16(v1[0], v1[1]); w.w = cvt_pk_bf16(v1[2], v1[3]);
                    *(u32x4*)(rowp + bj * HALF) = w; } }
    }
};
struct EpiSwiGLU {
    static constexpr bool PERM = true, AFTER_DRAIN = false;
    bf16_t* O; const float* rs; int ldc; int pad;
    __device__ __forceinline__ void operator()(const f32x4 (&acc)[2][2][4][2], const Unit& u, int wr, int wc, int fr, int fq) const {
        const int row0 = u.pm * BM + wr * 64 + fr, col0 = u.pn * HALF + wc * 32 + 8 * fq;
#pragma unroll
        for (int ai = 0; ai < 2; ++ai)
#pragma unroll
            for (int m = 0; m < 4; ++m) { const int r = row0 + ai * HALF + m * 16; const float s = rs ? rs[r] : 1.0f; bf16_t* rowp = O + (size_t)r * ldc + col0;
                f32x4 h0, h1;
#pragma unroll
                for (int j = 0; j < 4; ++j) { h0[j] = silu_f(acc[ai][0][m][0][j] * s) * (acc[ai][1][m][0][j] * s); h1[j] = silu_f(acc[ai][0][m][1][j] * s) * (acc[ai][1][m][1][j] * s); }
                u32x4 w; w.x = cvt_pk_bf16(h0[0], h0[1]); w.y = cvt_pk_bf16(h0[2], h0[3]); w.z = cvt_pk_bf16(h1[0], h1[1]); w.w = cvt_pk_bf16(h1[2], h1[3]);
                *(u32x4*)rowp = w; }
    }
};
struct EpiResidual {
    static constexpr bool PERM = false, AFTER_DRAIN = false;
    const float* base; float* out; const float* roww; int ldc; int pad;
    __device__ __forceinline__ void operator()(const f32x4 (&acc)[2][2][4][2], const Unit& u, int wr, int wc, int fr, int fq) const {
        const int row0 = u.pm * BM + wr * 64 + fr, col0 = u.pn * BM + wc * 32 + 4 * fq;
#pragma unroll
        for (int ai = 0; ai < 2; ++ai)
#pragma unroll
            for (int m = 0; m < 4; ++m) { const int r = row0 + ai * HALF + m * 16; const float w = roww ? roww[r] : 1.0f; const size_t off = (size_t)r * ldc + col0;
#pragma unroll
                for (int bj = 0; bj < 2; ++bj)
#pragma unroll
                    for (int n = 0; n < 2; ++n) { const f32x4 bs = *(const f32x4*)(base + off + bj * HALF + n * 16); *(f32x4*)(out + off + bj * HALF + n * 16) = bs + acc[ai][bj][m][n] * w; } }
    }
};

struct EpiSwiGLUMoe {
    static constexpr bool PERM = true, AFTER_DRAIN = false;
    bf16_t* O; const float* rs; const int* list; int ldc; int pad;
    __device__ __forceinline__ void operator()(const f32x4 (&acc)[2][2][4][2], const Unit& u, int wr, int wc, int fr, int fq) const {
        const int rl0 = wr * 64 + fr, col0 = u.pn * HALF + wc * 32 + 8 * fq;
#pragma unroll
        for (int ai = 0; ai < 2; ++ai)
#pragma unroll
            for (int m = 0; m < 4; ++m) { const int rl = rl0 + ai * HALF + m * 16; const int tok = rl < u.nvalid ? (list[u.lbase + rl] & 0xffff) : 0; const float s = rs[tok];
                bf16_t* rowp = O + (size_t)(u.pm * BM + rl) * ldc + col0;
                f32x4 h0, h1;
#pragma unroll
                for (int j = 0; j < 4; ++j) { h0[j] = silu_f(acc[ai][0][m][0][j] * s) * (acc[ai][1][m][0][j] * s); h1[j] = silu_f(acc[ai][0][m][1][j] * s) * (acc[ai][1][m][1][j] * s); }
                u32x4 w; w.x = cvt_pk_bf16(h0[0], h0[1]); w.y = cvt_pk_bf16(h0[2], h0[3]); w.z = cvt_pk_bf16(h1[0], h1[1]); w.w = cvt_pk_bf16(h1[2], h1[3]);
                *(u32x4*)rowp = w; }
    }
};
struct EpiMoeDown {
    static constexpr bool PERM = true, AFTER_DRAIN = false;
    bf16_t* Y0; bf16_t* Y1; const int* list; const float* lw; int ldc; int pad;
    __device__ __forceinline__ void operator()(const f32x4 (&acc)[2][2][4][2], const Unit& u, int wr, int wc, int fr, int fq) const {
        const int rl0 = wr * 64 + fr, col0 = u.pn * BM + wc * 32 + 8 * fq;
#pragma unroll
        for (int ai = 0; ai < 2; ++ai)
#pragma unroll
            for (int m = 0; m < 4; ++m) { const int rl = rl0 + ai * HALF + m * 16;
                if (rl < u.nvalid) { const int en = list[u.lbase + rl]; const float w = lw[u.lbase + rl]; bf16_t* rowp = ((en >> 16) ? Y1 : Y0) + (size_t)(en & 0xffff) * ldc + col0;
#pragma unroll
                    for (int bj = 0; bj < 2; ++bj) { const f32x4 v0 = acc[ai][bj][m][0] * w, v1 = acc[ai][bj][m][1] * w;
                        u32x4 o; o.x = cvt_pk_bf16(v0[0], v0[1]); o.y = cvt_pk_bf16(v0[2], v0[3]); o.z = cvt_pk_bf16(v1[0], v1[1]); o.w = cvt_pk_bf16(v1[2], v1[3]);
                        *(u32x4*)(rowp + bj * HALF) = o; } } }
    }
};
template <class Epi, class Sched, bool ALIGN_EPI = false, bool GATHER = false>
__device__ __forceinline__ void gemm_phase(PG8_LAS unsigned char* lds, const Gemm g, const Sched& S, const Epi& E) {
    int tid_o = threadIdx.x; asm volatile("" : "+v"(tid_o));
    const int tid = tid_o, wid = __builtin_amdgcn_readfirstlane(tid >> 6), lane = tid & 63, wr = wid >> 2, wc = wid & 3, fr = lane & 15, fq = lane >> 4;
    const int K = g.K, nt = K / BK;
    const size_t kstep = (size_t)(BK * 2);
    const size_t hstep = (size_t)HALF * K * 2;
    const size_t tstep = 2 * hstep;
    unsigned voffA[2], voffB[2], oA[2][2], oN[2][2];
#pragma unroll
    for (int i = 0; i < 2; ++i) { int R, C; stage_rc(tid * 16 + i * 8192, R, C); const int Rb = Epi::PERM ? ((R & ~31) + perm32(R & 31)) : R; voffA[i] = (unsigned)(R * K + C) * 2u; voffB[i] = (unsigned)(Rb * K + C) * 2u; }
    const unsigned ldsw = (unsigned)wid * 1024u;
    const int aoff = lds_byte(wr * 64 + fr, fq * 8), boff = lds_byte(wc * 32 + fr, fq * 8);
#define PG8_SA(b, h) (((b) * 2 + (h)) * HTB)
#define PG8_SB(b, h) ((4 + (b) * 2 + (h)) * HTB)
#define PG8_STAGE(bufoff, gbase, voff) do { _Pragma("unroll") for (int _i = 0; _i < 2; ++_i) \
        __builtin_amdgcn_global_load_lds((const unsigned*)((const char*)(gbase) + (voff)[_i]), (PG8_LAS unsigned*)(lds + (bufoff) + ldsw + _i * 8192), 16, 0, 0); } while (0)
#define PG8_LDA(dst, b, h) do { _Pragma("unroll") for (int m = 0; m < 4; ++m) _Pragma("unroll") for (int k = 0; k < 2; ++k) dst[m][k] = *(const PG8_LAS bf16x8*)(lds + PG8_SA(b, h) + aoff + m * 2048 + k * 1024); } while (0)
#define PG8_LDB(dst, b, h) do { _Pragma("unroll") for (int n = 0; n < 2; ++n) _Pragma("unroll") for (int k = 0; k < 2; ++k) dst[n][k] = *(const PG8_LAS bf16x8*)(lds + PG8_SB(b, h) + boff + n * 2048 + k * 1024); } while (0)
#define PG8_MMA(ai, bj, At, Bt) do { __builtin_amdgcn_s_setprio(1); _Pragma("unroll") for (int m = 0; m < 4; ++m) _Pragma("unroll") for (int n = 0; n < 2; ++n) _Pragma("unroll") for (int k = 0; k < 2; ++k) \
        acc[ai][bj][m][n] = __builtin_amdgcn_mfma_f32_16x16x32_bf16(Bt[n][k], At[m][k], acc[ai][bj][m][n], 0, 0, 0); __builtin_amdgcn_s_setprio(0); } while (0)
#define PG8_WAIT_V(n) asm volatile("s_waitcnt vmcnt(" #n ")" ::: "memory")
#define PG8_WAIT_L(n) asm volatile("s_waitcnt lgkmcnt(" #n ")" ::: "memory")
#define PG8_BAR __builtin_amdgcn_s_barrier()
#define PG8_SCHED __builtin_amdgcn_sched_barrier(0)
#define PG8_AOFF(dst, u) do { _Pragma("unroll") for (int _i = 0; _i < 2; ++_i) { int _R, _C; stage_rc(tid * 16 + _i * 8192, _R, _C); _Pragma("unroll") for (int _h = 0; _h < 2; ++_h) \
        dst[_h][_i] = (unsigned)(S.arow(u, _h * HALF + _R) * K + _C) * 2u; } } while (0)
#define PG8_STAGE_A(bufoff, gbase, h, usenext) do { _Pragma("unroll") for (int _i = 0; _i < 2; ++_i) { const unsigned _o = GATHER ? ((usenext) ? oN[h][_i] : oA[h][_i]) : voffA[_i]; \
        __builtin_amdgcn_global_load_lds((const unsigned*)((const char*)(gbase) + (GATHER ? (size_t)0 : (size_t)(h) * hstep) + _o), (PG8_LAS unsigned*)(lds + (bufoff) + ldsw + _i * 8192), 16, 0, 0); } } while (0)
    Unit cur, nxt; int ui = 0;
    if (!S.next(0, cur)) return;
    f32x4 acc[2][2][4][2];
#pragma unroll
    for (int a = 0; a < 2; ++a)
#pragma unroll
        for (int b = 0; b < 2; ++b)
#pragma unroll
            for (int m = 0; m < 4; ++m)
#pragma unroll
                for (int n = 0; n < 2; ++n) acc[a][b][m][n] = (f32x4){0.f, 0.f, 0.f, 0.f};
    bf16x8 At[4][2], B0[2][2], B1[2][2];
    const char* cA = (const char*)g.A + (GATHER ? (size_t)0 : (size_t)cur.pm * tstep); const char* cB = (const char*)g.Bt + (size_t)cur.pb * tstep;
    S.a_ready(cur);
    if constexpr (GATHER) { PG8_AOFF(oA, cur); PG8_WAIT_V(0); }
    PG8_STAGE(PG8_SB(0, 0), cB, voffB); PG8_STAGE(PG8_SB(0, 1), cB + hstep, voffB); PG8_STAGE_A(PG8_SA(0, 0), cA, 0, false); PG8_STAGE_A(PG8_SA(0, 1), cA, 1, false);
    if (wr == 1) PG8_BAR;
    PG8_WAIT_V(2); PG8_BAR;
    PG8_STAGE(PG8_SB(1, 0), cB + kstep, voffB); PG8_STAGE_A(PG8_SA(1, 0), cA + kstep, 0, false); PG8_STAGE(PG8_SB(1, 1), cB + hstep + kstep, voffB);
    PG8_WAIT_V(6); PG8_BAR;
    for (;;) {
        const bool has_next = S.next(ui + 1, nxt);
        const char* nA = has_next ? (const char*)g.A + (GATHER ? (size_t)0 : (size_t)nxt.pm * tstep) : cA; const char* nB = has_next ? (const char*)g.Bt + (size_t)nxt.pb * tstep : cB;
        if constexpr (GATHER) { if (has_next) { PG8_AOFF(oN, nxt); } else {
#pragma unroll
            for (int _h = 0; _h < 2; ++_h) { oN[_h][0] = oA[_h][0]; oN[_h][1] = oA[_h][1]; } } }
        for (int t = 0; t < nt; t += 2) {
            const bool last = (t == nt - 2);
            const char* a1 = cA + (size_t)(t + 1) * kstep;
            const char* a2 = last ? nA : cA + (size_t)(t + 2) * kstep; const char* b2 = last ? nB : cB + (size_t)(t + 2) * kstep;
            const char* a3 = a2 + kstep; const char* b3 = b2 + kstep;
            if (last && has_next) S.a_ready(nxt);
            PG8_LDB(B0, 0, 0); PG8_LDB(B1, 0, 1); PG8_SCHED; PG8_LDA(At, 0, 0); PG8_STAGE_A(PG8_SA(1, 1), a1, 1, false);
            PG8_WAIT_V(8); PG8_WAIT_L(0); PG8_BAR; PG8_MMA(0, 0, At, B0); PG8_MMA(0, 1, At, B1); PG8_BAR; PG8_SCHED;
            PG8_LDA(At, 0, 1); PG8_STAGE(PG8_SB(0, 0), b2, voffB); PG8_STAGE(PG8_SB(0, 1), b2 + hstep, voffB); PG8_STAGE_A(PG8_SA(0, 0), a2, 0, last);
            PG8_WAIT_V(8); PG8_WAIT_L(0); PG8_BAR; PG8_MMA(1, 0, At, B0); PG8_MMA(1, 1, At, B1); PG8_BAR; PG8_SCHED;
            PG8_LDB(B0, 1, 0); PG8_LDB(B1, 1, 1); PG8_SCHED; PG8_LDA(At, 1, 0); PG8_STAGE_A(PG8_SA(0, 1), a2, 1, last);
            PG8_WAIT_V(8); PG8_WAIT_L(0); PG8_BAR; PG8_MMA(0, 0, At, B0); PG8_MMA(0, 1, At, B1); PG8_BAR; PG8_SCHED;
            PG8_LDA(At, 1, 1); PG8_STAGE(PG8_SB(1, 0), b3, voffB); PG8_STAGE(PG8_SB(1, 1), b3 + hstep, voffB); PG8_STAGE_A(PG8_SA(1, 0), a3, 0, last);
            PG8_WAIT_V(8); PG8_WAIT_L(0); PG8_BAR; PG8_MMA(1, 0, At, B0); PG8_MMA(1, 1, At, B1); PG8_BAR; PG8_SCHED;
        }
        if constexpr (ALIGN_EPI) { if (wr == 0) PG8_BAR; }
        E(acc, cur, wr, wc, fr, fq); S.done(cur);
        if (!has_next) break;
#pragma unroll
        for (int a = 0; a < 2; ++a)
#pragma unroll
            for (int b = 0; b < 2; ++b)
#pragma unroll
                for (int m = 0; m < 4; ++m)
#pragma unroll
                    for (int n = 0; n < 2; ++n) acc[a][b][m][n] = (f32x4){0.f, 0.f, 0.f, 0.f};
        cur = nxt; cA = nA; cB = nB; ++ui;
        if constexpr (GATHER) {
#pragma unroll
            for (int _h = 0; _h < 2; ++_h) { oA[_h][0] = oN[_h][0]; oA[_h][1] = oN[_h][1]; } }
        if constexpr (ALIGN_EPI) { if (wr == 1) PG8_BAR; }
    }
    PG8_WAIT_V(0);
    if constexpr (!ALIGN_EPI) { if (wr == 0) PG8_BAR; }
    PG8_BAR;
#undef PG8_SA
#undef PG8_SB
#undef PG8_STAGE
#undef PG8_LDA
#undef PG8_LDB
#undef PG8_MMA
#undef PG8_WAIT_V
#undef PG8_WAIT_L
#undef PG8_BAR
#undef PG8_SCHED
#undef PG8_AOFF
#undef PG8_STAGE_A
}
}

#define GAS __attribute__((address_space(1)))
#define LAS __attribute__((address_space(3)))
#define XB_TMO      128
#define XB_XCNT(j)  (256  + 64 * (j))
#define XB_XSUB(j)  (1280 + 64 * (j))
#define XB_XGEN(j)  (2304 + 64 * (j))
#define XB_TOP      3328
#define XB_TOPGEN   3392
#define XCD_BAR_WORDS 3456
#define XB_SPIN_CAP (1u << 23)

__device__ __forceinline__ unsigned xb_ld(unsigned* p)              { return __hip_atomic_load(p, __ATOMIC_RELAXED, __HIP_MEMORY_SCOPE_AGENT); }
__device__ __forceinline__ unsigned xb_add(unsigned* p, unsigned v) { return __hip_atomic_fetch_add(p, v, __ATOMIC_RELAXED, __HIP_MEMORY_SCOPE_AGENT); }
__device__ __forceinline__ unsigned xb_xcc_id() { return (unsigned)__builtin_amdgcn_s_getreg((3 << 11) | 20) & 0xFu; }
#define XB_SPIN(cond, bar) do { unsigned _sp = 0; while (cond) { __builtin_amdgcn_s_sleep(1); \
    if ((++_sp & 255u) == 0u) { if (xb_ld(&(bar)[XB_TMO])) break; if (_sp > XB_SPIN_CAP) { atomicAdd(&(bar)[XB_TMO], 1u); break; } } } } while (0)

struct XcdBarrier {
    unsigned* bar; unsigned x;
    volatile LAS unsigned* st;
};

__device__ __forceinline__ XcdBarrier xcd_barrier_post(unsigned* bar, volatile LAS unsigned* st) {
    XcdBarrier b; b.bar = bar; b.x = xb_xcc_id(); b.st = st;
    if (threadIdx.x == 0) (void)xb_add(&bar[XB_XCNT(b.x)], 1u);
    return b;
}
__device__ __forceinline__ void xcd_barrier_complete(unsigned* bar, unsigned x, unsigned& nloc, unsigned& nx) {
    const unsigned G = gridDim.x * gridDim.y * gridDim.z;
    unsigned sum, cnt, mine, sp = 0u;
    for (;;) {
        sum = 0u; cnt = 0u; mine = 0u;
#pragma unroll
        for (unsigned j = 0; j < 16; ++j) { const unsigned c = xb_ld(&bar[XB_XCNT(j)]); sum += c; cnt += (c > 0u) ? 1u : 0u; mine = (j == x) ? c : mine; }
        if (sum == G) break;
        __builtin_amdgcn_s_sleep(1);
        if ((++sp & 255u) == 0u) { if (xb_ld(&bar[XB_TMO])) break; if (sp > XB_SPIN_CAP) { atomicAdd(&bar[XB_TMO], 1u); break; } }
    }
    nloc = mine > 0u ? mine : 1u; nx = cnt > 0u ? cnt : 1u;
}

__device__ __forceinline__ void xcd_barrier(const XcdBarrier& b) {
    asm volatile("s_waitcnt vmcnt(0)" ::: "memory");
    __syncthreads();
    if (threadIdx.x == 0) {
        unsigned* bar = b.bar; asm volatile("" : "+s"(bar));
        __builtin_amdgcn_s_waitcnt(0);
        unsigned nloc = b.st[0], nx = b.st[1];
        if (nloc == 0u) { xcd_barrier_complete(bar, b.x, nloc, nx); b.st[0] = nloc; b.st[1] = nx; }
        const unsigned old = xb_add(&bar[XB_XSUB(b.x)], 1u);
        const unsigned gen = old / nloc;
        if (old + 1u == (gen + 1u) * nloc) {
            __builtin_amdgcn_fence(__ATOMIC_RELEASE, "agent");
            asm volatile("s_waitcnt vmcnt(0)" ::: "memory");
            const unsigned og = xb_add(&bar[XB_TOP], 1u);
            const unsigned tg = og / nx;
            if (og + 1u == (tg + 1u) * nx) xb_add(&bar[XB_TOPGEN], 1u);
            else XB_SPIN(xb_ld(&bar[XB_TOPGEN]) == tg, bar);
            __builtin_amdgcn_fence(__ATOMIC_ACQUIRE, "agent");
            xb_add(&bar[XB_XGEN(b.x)], 1u);
            asm volatile("s_waitcnt vmcnt(0)" ::: "memory");
        } else {
            XB_SPIN(xb_ld(&bar[XB_XGEN(b.x)]) == gen, bar);
            __builtin_amdgcn_fence(__ATOMIC_ACQUIRE, "agent");
            asm volatile("s_waitcnt vmcnt(0)" ::: "memory");
        }
    }
    __syncthreads();
}

constexpr int T = 16384, SEQ = 8192, D = 2048, DLRU = 1024, DDN = 1024, NH = 8, HD = 128, NPROJ = 6144, DIN = 6160;
constexpr int DFF = 6144, NEXP = 8, DFFE = 3072;
constexpr float EPS = 1e-6f;
typedef unsigned short bf16;
typedef float f32x4 __attribute__((ext_vector_type(4)));
typedef unsigned u32x4 __attribute__((ext_vector_type(4)));
typedef unsigned u32x2 __attribute__((ext_vector_type(2)));
#define LDS_WAIT() asm volatile("s_waitcnt lgkmcnt(0)" ::: "memory")
#define LDS_BARRIER() do { asm volatile("s_waitcnt lgkmcnt(0)" ::: "memory"); __builtin_amdgcn_s_barrier(); asm volatile("" ::: "memory"); } while (0)

__device__ __forceinline__ float bf2f(bf16 b) { return __uint_as_float(((unsigned)b) << 16); }
__device__ __forceinline__ unsigned f2bf(float f) { unsigned u = __float_as_uint(f); return (u + 0x7fffu + ((u >> 16) & 1u)) >> 16; }
__device__ __forceinline__ unsigned pk2(float lo, float hi) { return pg8::cvt_pk_bf16(lo, hi); }
__device__ __forceinline__ float shfl_xor_l(float v, int o, int lane) { return __int_as_float(__builtin_amdgcn_ds_bpermute((lane ^ o) << 2, __float_as_int(v))); }
__device__ __forceinline__ float shfl_up_l(float v, int d, int lane) { return __int_as_float(__builtin_amdgcn_ds_bpermute((lane - d) << 2, __float_as_int(v))); }
__device__ __forceinline__ float shfl_idx_l(float v, int src) { return __int_as_float(__builtin_amdgcn_ds_bpermute(src << 2, __float_as_int(v))); }
__device__ __forceinline__ float wave_sum(float v, int lane) {
#pragma unroll
    for (int o = 1; o < 64; o <<= 1) v += shfl_xor_l(v, o, lane);
    return v;
}
using pg8::silu_f;
__device__ __forceinline__ float sigmoid_f(float x) { return 1.0f / (1.0f + __expf(-x)); }
__device__ __forceinline__ float softplus_f(float x) { return fmaxf(x, 0.0f) + log1pf(__expf(-fabsf(x))); }
__device__ __forceinline__ float gelu_tanh_f(float x) { const float u = 0.7978845608028654f * (x + 0.044715f * x * x * x); return 0.5f * x * (1.0f + tanhf(u)); }

constexpr size_t MiB = 1u << 20;
constexpr size_t al(size_t x) { return (x + MiB - 1) / MiB * MiB; }
constexpr size_t WS_CTL = 0, CTL_ZERO_BYTES = 1 * MiB;
constexpr int CW_BAR = 4096, CW_CNT = 8192;
constexpr size_t WS_WGU = 1 * MiB;
constexpr size_t WS_WD = WS_WGU + al((size_t)2 * DFF * D * 2);
constexpr size_t WS_WIN = WS_WD + al((size_t)D * DFF * 2);
constexpr size_t WS_WBA = WS_WIN + al((size_t)2 * NPROJ * D * 2);
constexpr size_t WS_WOUT = WS_WBA + al((size_t)2 * 16 * D * 4);
static_assert(WS_WIN + (size_t)NPROJ * D * 2 - WS_WGU >= (size_t)NEXP * D * DFFE * 2, "MoE down weights overlay");
constexpr size_t WS_XB = WS_WOUT + al((size_t)2 * D * D * 2);
constexpr size_t WS_RSTD = WS_XB + al((size_t)T * D * 2);
constexpr size_t WS_BA = WS_RSTD + al((size_t)T * 4);
constexpr size_t WS_BETA = WS_BA + al((size_t)T * 16 * 4);
constexpr size_t WS_G = WS_BETA + al((size_t)T * 8 * 4);
constexpr size_t WS_ROWW = WS_G + al((size_t)T * 8 * 4);
constexpr int NSLOT = 2 * T + NEXP * 256;
constexpr size_t WS_PROJ = WS_ROWW + al((size_t)2 * 8 * T * 4);
constexpr size_t WS_YMIX = WS_PROJ + al((size_t)NSLOT * DFFE * 2);
constexpr size_t WS_C = WS_YMIX + al((size_t)T * D * 2);
constexpr size_t WS_WRT = WS_C + (size_t)388 * MiB;
constexpr size_t WS_END = WS_WRT + 1 * MiB;
static_assert(WS_END <= (size_t)975 * MiB, "d_ws map exceeds the guaranteed workspace");
static_assert((size_t)NEXP * 2 * DFFE * D * 2 <= (size_t)388 * MiB, "MoE gate/up bf16 weights overlay the mixer scratch");
constexpr int RING_BYTES = 131072, LDSCTL_OFF = RING_BYTES, MISC_OFF = LDSCTL_OFF + 320, LDS_BYTES = 147456;

__device__ __forceinline__ void transpose_item(const float* W, int ldw, int col_off, int K, int nblk, const float* gain, bf16* WT, int blk, int blk_stride, int row_off, int item, int lane) {
    const int kb = item / nblk, nb = item % nblk, k0 = 64 * kb + (lane >> 4) * 16, n0 = 64 * nb + (lane & 15) * 4;
    const float* src = W + (size_t)k0 * ldw + col_off + n0;
    f32x4 v[16];
#pragma unroll
    for (int j = 0; j < 16; ++j) v[j] = *(const f32x4*)(src + (size_t)j * ldw);
    if (gain) {
#pragma unroll
        for (int q = 0; q < 4; ++q) { const f32x4 g = *(const f32x4*)(gain + k0 + 4 * q);
#pragma unroll
            for (int c = 0; c < 4; ++c) v[4 * q + c] = v[4 * q + c] * g[c]; }
    }
#pragma unroll
    for (int i = 0; i < 4; ++i) { const int n = n0 + i, drow = (n / blk) * blk_stride + (n % blk) + row_off;
        u32x4 o0, o1;
        o0.x = pk2(v[0][i], v[1][i]); o0.y = pk2(v[2][i], v[3][i]); o0.z = pk2(v[4][i], v[5][i]); o0.w = pk2(v[6][i], v[7][i]);
        o1.x = pk2(v[8][i], v[9][i]); o1.y = pk2(v[10][i], v[11][i]); o1.z = pk2(v[12][i], v[13][i]); o1.w = pk2(v[14][i], v[15][i]);
        u32x4* dst = (u32x4*)(WT + (size_t)drow * K + k0); dst[0] = o0; dst[1] = o1; }
}
__device__ __forceinline__ void convert_matrix(const float* W, int ldw, int col_off, int K, int N, const float* gain, bf16* WT, int blk, int blk_stride, int row_off, LAS float* scr, int gw, int NGW, int lane) {
    const int nblk = N / 64, nitems = (K / 64) * nblk; (void)scr;
    for (int it = gw; it < nitems; it += NGW) transpose_item(W, ldw, col_off, K, nblk, gain, WT, blk, blk_stride, row_off, it, lane);
}
__device__ __forceinline__ void rowprep_row(const float* x, bf16* xb, float* rstd, const float* Wba, float* ba, int row, int lane) {
    const f32x4* xr = (const f32x4*)(x + (size_t)row * D) + lane;
    f32x4 v[8]; float ss = 0.f;
#pragma unroll
    for (int j = 0; j < 8; ++j) { v[j] = xr[64 * j]; ss += (v[j][0] * v[j][0] + v[j][1] * v[j][1]) + (v[j][2] * v[j][2] + v[j][3] * v[j][3]); }
    ss = wave_sum(ss, lane);
    const float rs = 1.0f / sqrtf(ss * (1.0f / D) + EPS);
    u32x2* o = (u32x2*)(xb + (size_t)row * D) + lane;
#pragma unroll
    for (int j = 0; j < 8; ++j) { u32x2 w; w.x = pk2(v[j][0], v[j][1]); w.y = pk2(v[j][2], v[j][3]); o[64 * j] = w; }
    if (lane == 0) rstd[row] = rs;
    if (Wba) {
        for (int c = 0; c < 16; ++c) { const f32x4* wr = (const f32x4*)(Wba + (size_t)c * D) + lane; float a = 0.f;
#pragma unroll
            for (int j = 0; j < 8; ++j) { const f32x4 w = wr[64 * j]; a += (v[j][0] * w[0] + v[j][1] * w[1]) + (v[j][2] * w[2] + v[j][3] * w[3]); }
            a = wave_sum(a, lane); if (lane == 0) ba[(size_t)row * 16 + c] = a * rs; }
    }
}
__device__ __forceinline__ void lru_conv_elem(const bf16* proj, const float* cw, const float* cb, float* xc, size_t idx) {
    const int t = (int)(idx / DLRU), ch = (int)(idx % DLRU), s = t % SEQ;
    float a = cb[ch];
#pragma unroll
    for (int k = 0; k < 4; ++k) { const int sp = s - 3 + k; if (sp >= 0) a += cw[k * DLRU + ch] * bf2f(proj[(size_t)(t - 3 + k) * NPROJ + ch]); }
    xc[idx] = a;
}
__device__ __forceinline__ void lru_gate_elem(const float* xc, const float* w_r, const float* b_r, const float* w_i, const float* b_i, const float* lam, float* av, float* bv, size_t idx) {
    const int t = (int)(idx / DLRU), ch = (int)(idx % DLRU), n = ch >> 7, d = ch & 127;
    float ar = b_r[ch], ai = b_i[ch];
    const float* xr = xc + (size_t)t * DLRU + n * 128; const float* wr = w_r + (size_t)n * 128 * 128 + d; const float* wi = w_i + (size_t)n * 128 * 128 + d;
    for (int c = 0; c < 128; ++c) { const float xv = xr[c]; ar += xv * wr[c * 128]; ai += xv * wi[c * 128]; }
    const float r = sigmoid_f(ar), ig = sigmoid_f(ai);
    const float log_a = -8.0f * r * softplus_f(-lam[ch]);
    const float a = expf(log_a), mult = sqrtf(-expm1f(2.0f * log_a));
    av[idx] = a; bv[idx] = mult * (ig * xc[idx]);
}
__device__ __forceinline__ void lru_scan_chan(float* av, const float* bv, const bf16* proj, int idx) {
    const int b = idx / DLRU, ch = idx % DLRU;
    float h = 0.f;
    for (int s0 = 0; s0 < SEQ; s0 += 8) {
        float a8[8], b8[8], g8[8];
#pragma unroll
        for (int j = 0; j < 8; ++j) { const size_t t = (size_t)b * SEQ + s0 + j; a8[j] = av[t * DLRU + ch]; b8[j] = bv[t * DLRU + ch]; g8[j] = bf2f(proj[t * NPROJ + DLRU + ch]); }
#pragma unroll
        for (int j = 0; j < 8; ++j) { const size_t t = (size_t)b * SEQ + s0 + j; h = a8[j] * h + b8[j]; av[t * DLRU + ch] = h * gelu_tanh_f(g8[j]); }
    }
}
__device__ __forceinline__ void lru_norm_row(const float* y, const float* gain, bf16* ymix, int row, int lane) {
    const f32x4* yr = (const f32x4*)(y + (size_t)row * DLRU) + lane; const f32x4* gr = (const f32x4*)gain + lane;
    f32x4 v[4]; float ss = 0.f;
#pragma unroll
    for (int j = 0; j < 4; ++j) { v[j] = yr[64 * j]; ss += (v[j][0] * v[j][0] + v[j][1] * v[j][1]) + (v[j][2] * v[j][2] + v[j][3] * v[j][3]); }
    ss = wave_sum(ss, lane); const float rs = 1.0f / sqrtf(ss * (1.0f / DLRU) + EPS);
    u32x2* o = (u32x2*)(ymix + (size_t)row * D) + lane;
#pragma unroll
    for (int j = 0; j < 4; ++j) { const f32x4 g = gr[64 * j]; u32x2 w; w.x = pk2(v[j][0] * rs * g[0], v[j][1] * rs * g[1]); w.y = pk2(v[j][2] * rs * g[2], v[j][3] * rs * g[3]); o[64 * j] = w; }
}
__device__ __forceinline__ void dn_prep_item(const bf16* proj, const float* cw, const float* ba, const float* a_log, const float* dt_bias, float* qn, float* kn, float* vn, float* beta, float* gg, int w, int lane) {
    const int t = w >> 3, h = w & 7, s = t % SEQ;
    float val[3][2];
#pragma unroll
    for (int p = 0; p < 3; ++p)
#pragma unroll
        for (int e = 0; e < 2; ++e) { const int d = lane * 2 + e, c = p * DDN + h * HD + d; float a = 0.f;
#pragma unroll
            for (int k = 0; k < 4; ++k) { const int sp = s - 3 + k; if (sp >= 0) a += cw[k * 3 * DDN + c] * bf2f(proj[(size_t)(t - 3 + k) * NPROJ + 2048 + c]); }
            val[p][e] = silu_f(a); }
    const float sq = wave_sum(val[0][0] * val[0][0] + val[0][1] * val[0][1], lane), sk = wave_sum(val[1][0] * val[1][0] + val[1][1] * val[1][1], lane);
    const float rq = (1.0f / sqrtf(sq + EPS)) * 0.08838834764831845f, rk = 1.0f / sqrtf(sk + EPS);
    const size_t o = ((size_t)t * NH + h) * HD + lane * 2;
    qn[o] = val[0][0] * rq; qn[o + 1] = val[0][1] * rq; kn[o] = val[1][0] * rk; kn[o + 1] = val[1][1] * rk; vn[o] = val[2][0]; vn[o + 1] = val[2][1];
    if (lane == 0) { beta[t * NH + h] = sigmoid_f(ba[(size_t)t * 16 + h]); gg[t * NH + h] = -__expf(a_log[h]) * softplus_f(ba[(size_t)t * 16 + 8 + h] + dt_bias[h]); }
}
__device__ __forceinline__ void dn_rec_seq(const float* qn, const float* kn, const float* vn, const float* beta, const float* gg, float* o, int bh, LAS float* sk, LAS float* sq, LAS float* st, int tid) {
    const int b = bh >> 3, h = bh & 7, j = tid & 127; const bool act = tid < 128;
    if (act) for (int k = 0; k < 128; ++k) st[k * 128 + j] = 0.f;
    const size_t base = ((size_t)(b * SEQ) * NH + h) * HD;
    float nk = kn[base + j], nq = qn[base + j], nv = vn[base + j], nb = beta[(b * SEQ) * NH + h], ng = gg[(b * SEQ) * NH + h];
    for (int s = 0; s < SEQ; ++s) {
        const int buf = (s & 1) * 128;
        if (act) { sk[buf + j] = nk; sq[buf + j] = nq; }
        const float vj = nv, be = nb, ge = __expf(ng);
        __syncthreads();
        if (act) {
            if (s + 1 < SEQ) { const size_t nb_ = ((size_t)(b * SEQ + s + 1) * NH + h) * HD; nk = kn[nb_ + j]; nq = qn[nb_ + j]; nv = vn[nb_ + j]; nb = beta[(b * SEQ + s + 1) * NH + h]; ng = gg[(b * SEQ + s + 1) * NH + h]; }
            float ks = 0.f;
#pragma unroll 8
            for (int k = 0; k < 128; ++k) ks += sk[buf + k] * st[k * 128 + j];
            const float vnew = be * (vj - ge * ks);
            float oo = 0.f;
#pragma unroll 8
            for (int k = 0; k < 128; ++k) { const float sv = ge * st[k * 128 + j] + sk[buf + k] * vnew; st[k * 128 + j] = sv; oo += sq[buf + k] * sv; }
            o[((size_t)(b * SEQ + s) * NH + h) * HD + j] = oo;
        }
    }
    __syncthreads();
}
typedef short bf16x8 __attribute__((ext_vector_type(8)));
__device__ __forceinline__ f32x4 mfma16(bf16x8 a, bf16x8 b, f32x4 c) { return __builtin_amdgcn_mfma_f32_16x16x32_bf16(a, b, c, 0, 0, 0); }
__device__ __forceinline__ float bflo(unsigned x) { return __uint_as_float(x << 16); }
__device__ __forceinline__ float bfhi(unsigned x) { return __uint_as_float(x & 0xffff0000u); }
constexpr int DA_G = 0, DA_L = 1024, DA_KN = DA_L + 16384, DA_QN = DA_KN + 17408, DA_VBT = DA_QN + 17408, DA_KBET = DA_VBT + 18432, DA_KDT = DA_KBET + 18432, DA_TB = DA_KDT + 18432, DA_QK = DA_TB + 9216, DA_END = DA_QK + 9216;
static_assert(DA_END <= RING_BYTES, "DN-A LDS map");
#if defined(PROBE_DNA_A)
#define DNA_ST(k) do { if (threadIdx.x == 0) ((volatile LAS unsigned long long*)(lds + (RING_BYTES + 2048)))[k] = __builtin_amdgcn_s_memrealtime(); } while (0)
#else
#define DNA_ST(k) do { } while (0)
#endif
__device__ __forceinline__ void dna_unit(const bf16* proj, const float* cw, const float* ba, const float* a_log, const float* dt_bias,
                                         bf16* Wf, bf16* Qf, bf16* KdTf, bf16* QKf, bf16* Uf, float* glb, int uid, LAS unsigned char* lds, int tid, int lane, int wave) {
    const int h = uid & 7, n = (uid >> 3) & 127, b = uid >> 10, t0 = b * SEQ + n * 64;
    asm volatile("" : "+v"(lds));
    DNA_ST(0);
    LAS float* Gs = (LAS float*)(lds + DA_G);
    const int fr = lane & 15, fq = lane >> 4;
    if (wave == 0) {
        const size_t t = (size_t)(t0 + lane);
        const float be = sigmoid_f(ba[t * 16 + h]); float Gc = -__expf(a_log[h]) * softplus_f(ba[t * 16 + 8 + h] + dt_bias[h]);
#pragma unroll
        for (int off = 1; off < 64; off <<= 1) { const float tmp = shfl_up_l(Gc, off, lane); if (lane >= off) Gc += tmp; }
        const float GL = shfl_idx_l(Gc, 63);
        Gs[lane] = Gc; Gs[64 + lane] = be; Gs[128 + lane] = __expf(Gc); Gs[192 + lane] = __expf(GL - Gc);
        if (lane == 63) glb[uid] = __expf(Gc);
    }
    LDS_BARRIER();
    DNA_ST(1);
    {
        const int r = tid >> 3, cg = tid & 7;
        const float be = Gs[64 + r], eg = Gs[128 + r], egl = Gs[192 + r];
        float val[3][16];
#pragma unroll
        for (int p = 0; p < 3; ++p) {
            const int ccol = p * DDN + h * HD + cg * 16;
            float acc[16];
#pragma unroll
            for (int i = 0; i < 16; ++i) acc[i] = 0.f;
#pragma unroll
            for (int k = 0; k < 4; ++k) { const int row = r - 3 + k;
                if (n * 64 + row >= 0) {
                    const bf16* src = proj + (size_t)(t0 + row) * NPROJ + 2048 + ccol;
                    const u32x4 x0 = *(const u32x4*)src, x1 = *(const u32x4*)(src + 8);
                    const float* wp = cw + k * 3 * DDN + ccol;
                    const f32x4 w0 = *(const f32x4*)wp, w1 = *(const f32x4*)(wp + 4), w2 = *(const f32x4*)(wp + 8), w3 = *(const f32x4*)(wp + 12);
                    acc[0] += w0[0] * bflo(x0.x); acc[1] += w0[1] * bfhi(x0.x); acc[2] += w0[2] * bflo(x0.y); acc[3] += w0[3] * bfhi(x0.y);
                    acc[4] += w1[0] * bflo(x0.z); acc[5] += w1[1] * bfhi(x0.z); acc[6] += w1[2] * bflo(x0.w); acc[7] += w1[3] * bfhi(x0.w);
                    acc[8] += w2[0] * bflo(x1.x); acc[9] += w2[1] * bfhi(x1.x); acc[10] += w2[2] * bflo(x1.y); acc[11] += w2[3] * bfhi(x1.y);
                    acc[12] += w3[0] * bflo(x1.z); acc[13] += w3[1] * bfhi(x1.z); acc[14] += w3[2] * bflo(x1.w); acc[15] += w3[3] * bfhi(x1.w);
                } }
#pragma unroll
            for (int i = 0; i < 16; ++i) val[p][i] = silu_f(acc[i]);
        }
        float sq = 0.f, sk = 0.f;
#pragma unroll
        for (int i = 0; i < 16; ++i) { sq += val[0][i] * val[0][i]; sk += val[1][i] * val[1][i]; }
        sq += shfl_xor_l(sq, 1, lane); sq += shfl_xor_l(sq, 2, lane); sq += shfl_xor_l(sq, 4, lane);
        sk += shfl_xor_l(sk, 1, lane); sk += shfl_xor_l(sk, 2, lane); sk += shfl_xor_l(sk, 4, lane);
        const float rq = (1.0f / sqrtf(sq + EPS)) * 0.08838834764831845f, rk = 1.0f / sqrtf(sk + EPS);
#pragma unroll
        for (int i = 0; i < 16; ++i) { val[0][i] *= rq; val[1][i] *= rk; }
        u32x4 o0, o1;
        o0.x = pk2(val[1][0], val[1][1]); o0.y = pk2(val[1][2], val[1][3]); o0.z = pk2(val[1][4], val[1][5]); o0.w = pk2(val[1][6], val[1][7]);
        o1.x = pk2(val[1][8], val[1][9]); o1.y = pk2(val[1][10], val[1][11]); o1.z = pk2(val[1][12], val[1][13]); o1.w = pk2(val[1][14], val[1][15]);
        *(LAS u32x4*)(lds + DA_KN + r * 272 + cg * 32) = o0; *(LAS u32x4*)(lds + DA_KN + r * 272 + cg * 32 + 16) = o1;
        o0.x = pk2(val[0][0], val[0][1]); o0.y = pk2(val[0][2], val[0][3]); o0.z = pk2(val[0][4], val[0][5]); o0.w = pk2(val[0][6], val[0][7]);
        o1.x = pk2(val[0][8], val[0][9]); o1.y = pk2(val[0][10], val[0][11]); o1.z = pk2(val[0][12], val[0][13]); o1.w = pk2(val[0][14], val[0][15]);
        *(LAS u32x4*)(lds + DA_QN + r * 272 + cg * 32) = o0; *(LAS u32x4*)(lds + DA_QN + r * 272 + cg * 32 + 16) = o1;
#pragma unroll
        for (int i = 0; i < 16; ++i) { const int f = cg * 16 + i;
            *(LAS unsigned short*)(lds + DA_VBT + f * 144 + r * 2) = (unsigned short)f2bf(val[2][i] * be);
            *(LAS unsigned short*)(lds + DA_KBET + f * 144 + r * 2) = (unsigned short)f2bf(val[1][i] * (be * eg));
            *(LAS unsigned short*)(lds + DA_KDT + f * 144 + r * 2) = (unsigned short)f2bf(val[1][i] * egl); }
    }
    LDS_BARRIER();
    DNA_ST(2);
    {
        const int p = wave >> 2, ti = wave & 3;
        const int abase = p == 0 ? DA_KN : DA_QN;
        bf16x8 af[4];
#pragma unroll
        for (int ks = 0; ks < 4; ++ks) af[ks] = *(const LAS bf16x8*)(lds + abase + (ti * 16 + fr) * 272 + (ks * 32 + fq * 8) * 2);
        for (int tj = 0; tj < 4; ++tj) {
            f32x4 acc = {0.f, 0.f, 0.f, 0.f};
            if (tj <= ti) {
#pragma unroll
                for (int ks = 0; ks < 4; ++ks) { const bf16x8 bb = *(const LAS bf16x8*)(lds + DA_KN + (tj * 16 + fr) * 272 + (ks * 32 + fq * 8) * 2); acc = mfma16(af[ks], bb, acc); }
            }
            const int j = tj * 16 + fr; const float Gj = Gs[j];
#pragma unroll
            for (int r = 0; r < 4; ++r) { const int i = ti * 16 + fq * 4 + r; float v = 0.f;
                if (p == 0) { if (i > j) v = Gs[64 + i] * acc[r] * __expf(Gs[i] - Gj); *(LAS float*)(lds + DA_L + (j * 64 + i) * 4) = v; }
                else { if (i >= j) v = acc[r] * __expf(Gs[i] - Gj); *(LAS unsigned short*)(lds + DA_QK + i * 144 + j * 2) = (unsigned short)f2bf(v); } }
        }
    }
    LDS_BARRIER();
    DNA_ST(3);
    {
        int lc = lane; asm volatile("" : "+v"(lc)); const float fl = (float)lc;
        const int blk = wave < 4 ? wave : 11 - wave;
        float Tr[8];
#pragma unroll
        for (int c = 0; c < 8; ++c) Tr[c] = fmaxf(0.f, 1.f - fabsf(fl - (float)(blk * 8 + c)));
        float lj[63];
#pragma unroll
        for (int j = 0; j < 63; ++j) lj[j] = *(const LAS float*)(lds + DA_L + (j * 64) * 4 + lc * 4);
#pragma unroll
        for (int j = 0; j < 63; ++j) {
            if (j >= blk * 8) {
#pragma unroll
                for (int c = 0; c < 8; ++c) { const float tj = __int_as_float(__builtin_amdgcn_readlane(__float_as_int(Tr[c]), j)); Tr[c] -= lj[j] * tj; }
            }
        }
        u32x4 o; o.x = pk2(Tr[0], Tr[1]); o.y = pk2(Tr[2], Tr[3]); o.z = pk2(Tr[4], Tr[5]); o.w = pk2(Tr[6], Tr[7]);
        *(LAS u32x4*)(lds + DA_TB + lc * 144 + blk * 16) = o;
    }
    {
        for (int fi = wave; fi < 40; fi += 8) {
            if (fi < 8) { const int mt = fi >> 1, ks = fi & 1;
                const u32x4 v = *(const LAS u32x4*)(lds + DA_QK + (mt * 16 + fr) * 144 + (ks * 32 + fq * 8) * 2);
                *(u32x4*)(QKf + (((size_t)uid * 4 + mt) * 2 + ks) * 512 + lane * 8) = v; }
            else if (fi < 24) { const int f2 = fi - 8, mt = f2 >> 2, ks = f2 & 3; const float eg = Gs[128 + mt * 16 + fr];
                const u32x4 v = *(const LAS u32x4*)(lds + DA_QN + (mt * 16 + fr) * 272 + (ks * 32 + fq * 8) * 2); u32x4 o;
                o.x = pk2(bflo(v.x) * eg, bfhi(v.x) * eg); o.y = pk2(bflo(v.y) * eg, bfhi(v.y) * eg); o.z = pk2(bflo(v.z) * eg, bfhi(v.z) * eg); o.w = pk2(bflo(v.w) * eg, bfhi(v.w) * eg);
                *(u32x4*)(Qf + (((size_t)uid * 4 + mt) * 4 + ks) * 512 + lane * 8) = o; }
            else { const int f2 = fi - 24, ft = f2 >> 1, ks = f2 & 1;
                const u32x4 v = *(const LAS u32x4*)(lds + DA_KDT + (ft * 16 + fr) * 144 + (ks * 32 + fq * 8) * 2);
                *(u32x4*)(KdTf + (((size_t)uid * 8 + ft) * 2 + ks) * 512 + lane * 8) = v; }
        }
    }
    LDS_BARRIER();
    DNA_ST(4);
    {
        bf16x8 ta[4][2];
#pragma unroll
        for (int mt = 0; mt < 4; ++mt)
#pragma unroll
            for (int ks = 0; ks < 2; ++ks) ta[mt][ks] = *(const LAS bf16x8*)(lds + DA_TB + (mt * 16 + fr) * 144 + (ks * 32 + fq * 8) * 2);
#pragma unroll
        for (int c2 = 0; c2 < 2; ++c2) { const int ct = wave * 2 + c2, img = ct < 8 ? DA_VBT : DA_KBET, cr = (ct & 7) * 16 + fr;
            bf16x8 bb[2];
#pragma unroll
            for (int ks = 0; ks < 2; ++ks) bb[ks] = *(const LAS bf16x8*)(lds + img + cr * 144 + (ks * 32 + fq * 8) * 2);
#pragma unroll
            for (int mt = 0; mt < 4; ++mt) { f32x4 acc = {0.f, 0.f, 0.f, 0.f};
#pragma unroll
                for (int ks = 0; ks < 2; ++ks) acc = mfma16(ta[mt][ks], bb[ks], acc);
                if (ct < 8) { u32x2 o; o.x = pk2(acc[0], acc[1]); o.y = pk2(acc[2], acc[3]); *(u32x2*)(Uf + ((((size_t)uid * 8 + ct) * 4 + mt) * 64 + lane) * 4) = o; }
                else { const int f = (ct - 8) * 16 + fr;
#pragma unroll
                    for (int r = 0; r < 4; ++r) *(LAS unsigned short*)(lds + DA_KN + (mt * 16 + fq * 4 + r) * 272 + f * 2) = (unsigned short)f2bf(acc[r]); } }
        }
    }
    LDS_BARRIER();
    DNA_ST(5);
#pragma unroll
    for (int q2 = 0; q2 < 2; ++q2) { const int fi = wave * 2 + q2, mt = fi >> 2, ks = fi & 3;
        const u32x4 v = *(const LAS u32x4*)(lds + DA_KN + (mt * 16 + fr) * 272 + (ks * 32 + fq * 8) * 2);
        *(u32x4*)(Wf + (((size_t)uid * 4 + mt) * 4 + ks) * 512 + lane * 8) = v; }
    LDS_BARRIER();
    DNA_ST(6);
}
struct DnbFrag { bf16x8 a1[4]; bf16x8 a2[2]; bf16x8 kd[2]; u32x2 u; float gl; };
__device__ __forceinline__ DnbFrag dnb_load(const bf16* A1, const bf16* QKf, const bf16* KdTf, const bf16* Uf, const float* glb, int uid, int ds, int wave, int lane) {
    DnbFrag f; const int mt = wave & 3;
#pragma unroll
    for (int ks = 0; ks < 4; ++ks) f.a1[ks] = *(const bf16x8*)(A1 + (((size_t)uid * 4 + mt) * 4 + ks) * 512 + lane * 8);
#pragma unroll
    for (int ks = 0; ks < 2; ++ks) f.kd[ks] = *(const bf16x8*)(KdTf + (((size_t)uid * 8 + wave) * 2 + ks) * 512 + lane * 8);
#pragma unroll
    for (int ks = 0; ks < 2; ++ks) f.a2[ks] = *(const bf16x8*)(QKf + (((size_t)uid * 4 + mt) * 2 + ks) * 512 + lane * 8);
    f.u = *(const u32x2*)(Uf + ((((size_t)uid * 8 + ds) * 4 + mt) * 64 + lane) * 4);
    f.gl = glb[uid];
    return f;
}
__device__ __forceinline__ void dnb_run(const bf16* Wf, const bf16* Qf, const bf16* KdTf, const bf16* QKf, const bf16* Uf, const float* glb, float* o, int bh, int ds, LAS unsigned char* lds, int tid, int lane, int wave) {
    const int b = bh >> 3, h = bh & 7, fr = lane & 15, fq = lane >> 4, mt = wave & 3;
    asm volatile("" : "+v"(lds));
    LAS unsigned char* ST = lds; LAS unsigned char* VNT = lds + 4608;
    for (int i = tid; i < 4608 / 4; i += 512) ((LAS unsigned*)ST)[i] = 0u;
    f32x4 accS = {0.f, 0.f, 0.f, 0.f};
    const bf16* A1 = wave < 4 ? Wf : Qf;
    DnbFrag f0 = dnb_load(A1, QKf, KdTf, Uf, glb, (b * 128 + 0) * 8 + h, ds, wave, lane), f1 = dnb_load(A1, QKf, KdTf, Uf, glb, (b * 128 + 1) * 8 + h, ds, wave, lane);
    DnbFrag f2 = dnb_load(A1, QKf, KdTf, Uf, glb, (b * 128 + 2) * 8 + h, ds, wave, lane), f3 = dnb_load(A1, QKf, KdTf, Uf, glb, (b * 128 + 3) * 8 + h, ds, wave, lane);
    __syncthreads();
#define DNB_STEP(F, nn) do { const int n = (nn); \
        f32x4 acc = {0.f, 0.f, 0.f, 0.f}; \
        _Pragma("unroll") for (int ks = 0; ks < 4; ++ks) { const bf16x8 sb = *(const LAS bf16x8*)(ST + fr * 272 + (ks * 32 + fq * 8) * 2); acc = mfma16(F.a1[ks], sb, acc); } \
        if (wave < 4) { const float v0 = bflo(F.u.x) - acc[0], v1 = bfhi(F.u.x) - acc[1], v2 = bflo(F.u.y) - acc[2], v3 = bfhi(F.u.y) - acc[3]; \
            u32x2 w; w.x = pk2(v0, v1); w.y = pk2(v2, v3); *(LAS u32x2*)(VNT + fr * 144 + (mt * 16 + fq * 4) * 2) = w; } \
        LDS_BARRIER(); \
        bf16x8 vb[2]; \
        _Pragma("unroll") for (int ks = 0; ks < 2; ++ks) vb[ks] = *(const LAS bf16x8*)(VNT + fr * 144 + (ks * 32 + fq * 8) * 2); \
        if (wave >= 4) { _Pragma("unroll") for (int ks = 0; ks < 2; ++ks) acc = mfma16(F.a2[ks], vb[ks], acc); \
            const size_t ob = ((size_t)(b * SEQ + n * 64 + mt * 16 + fq * 4) * NH + h) * HD + ds * 16 + fr; \
            _Pragma("unroll") for (int r = 0; r < 4; ++r) o[ob + (size_t)r * NH * HD] = acc[r]; } \
        accS = accS * F.gl; \
        _Pragma("unroll") for (int ks = 0; ks < 2; ++ks) accS = mfma16(F.kd[ks], vb[ks], accS); \
        { u32x2 w; w.x = pk2(accS[0], accS[1]); w.y = pk2(accS[2], accS[3]); *(LAS u32x2*)(ST + fr * 272 + (wave * 16 + fq * 4) * 2) = w; } \
        F = dnb_load(A1, QKf, KdTf, Uf, glb, (b * 128 + (n + 4 < 128 ? n + 4 : 127)) * 8 + h, ds, wave, lane);     \
        LDS_BARRIER(); } while (0)
    for (int n4 = 0; n4 < 128; n4 += 16) {
        DNB_STEP(f0, n4); DNB_STEP(f1, n4 + 1); DNB_STEP(f2, n4 + 2); DNB_STEP(f3, n4 + 3); DNB_STEP(f0, n4 + 4); DNB_STEP(f1, n4 + 5); DNB_STEP(f2, n4 + 6); DNB_STEP(f3, n4 + 7);
        DNB_STEP(f0, n4 + 8); DNB_STEP(f1, n4 + 9); DNB_STEP(f2, n4 + 10); DNB_STEP(f3, n4 + 11); DNB_STEP(f0, n4 + 12); DNB_STEP(f1, n4 + 13); DNB_STEP(f2, n4 + 14); DNB_STEP(f3, n4 + 15); }
#undef DNB_STEP
}
constexpr int LA_XB = 0, LA_XF = 17408, LA_END = LA_XF + 64 * 132 * 4;
static_assert(LA_END <= RING_BYTES, "LRU-A LDS map");
__device__ __forceinline__ void lrua_unit(const bf16* proj, const float* cw, const float* cb, const bf16* WrT, const bf16* WiT, const float* b_r, const float* b_i, const float* lam,
                                          float* Hloc, float* Acum, float* summ, int unit, LAS unsigned char* lds, int tid, int lane, int wave) {
    const int nb = unit & 7, ct = unit >> 3, n = ct & 127, t0 = ct * 64;
    asm volatile("" : "+v"(lds));
    {
        const int r = tid >> 3, cg = tid & 7, ch0 = nb * 128 + cg * 16;
        float acc[16];
        { const f32x4 c0v = *(const f32x4*)(cb + ch0), c1v = *(const f32x4*)(cb + ch0 + 4), c2v = *(const f32x4*)(cb + ch0 + 8), c3v = *(const f32x4*)(cb + ch0 + 12);
#pragma unroll
          for (int i = 0; i < 4; ++i) { acc[i] = c0v[i]; acc[4 + i] = c1v[i]; acc[8 + i] = c2v[i]; acc[12 + i] = c3v[i]; } }
#pragma unroll
        for (int k = 0; k < 4; ++k) { const int row = r - 3 + k;
            if (n * 64 + row >= 0) {
                const bf16* src = proj + (size_t)(t0 + row) * NPROJ + ch0;
                const u32x4 x0 = *(const u32x4*)src, x1 = *(const u32x4*)(src + 8);
                const float* wp = cw + k * DLRU + ch0;
                const f32x4 w0 = *(const f32x4*)wp, w1 = *(const f32x4*)(wp + 4), w2 = *(const f32x4*)(wp + 8), w3 = *(const f32x4*)(wp + 12);
                acc[0] += w0[0] * bflo(x0.x); acc[1] += w0[1] * bfhi(x0.x); acc[2] += w0[2] * bflo(x0.y); acc[3] += w0[3] * bfhi(x0.y);
                acc[4] += w1[0] * bflo(x0.z); acc[5] += w1[1] * bfhi(x0.z); acc[6] += w1[2] * bflo(x0.w); acc[7] += w1[3] * bfhi(x0.w);
                acc[8] += w2[0] * bflo(x1.x); acc[9] += w2[1] * bfhi(x1.x); acc[10] += w2[2] * bflo(x1.y); acc[11] += w2[3] * bfhi(x1.y);
                acc[12] += w3[0] * bflo(x1.z); acc[13] += w3[1] * bfhi(x1.z); acc[14] += w3[2] * bflo(x1.w); acc[15] += w3[3] * bfhi(x1.w);
            } }
        u32x4 o0, o1;
        o0.x = pk2(acc[0], acc[1]); o0.y = pk2(acc[2], acc[3]); o0.z = pk2(acc[4], acc[5]); o0.w = pk2(acc[6], acc[7]);
        o1.x = pk2(acc[8], acc[9]); o1.y = pk2(acc[10], acc[11]); o1.z = pk2(acc[12], acc[13]); o1.w = pk2(acc[14], acc[15]);
        *(LAS u32x4*)(lds + LA_XB + r * 272 + cg * 32) = o0; *(LAS u32x4*)(lds + LA_XB + r * 272 + cg * 32 + 16) = o1;
        LAS f32x4* xf = (LAS f32x4*)(lds + LA_XF + (r * 132 + cg * 16) * 4);
        xf[0] = (f32x4){acc[0], acc[1], acc[2], acc[3]}; xf[1] = (f32x4){acc[4], acc[5], acc[6], acc[7]}; xf[2] = (f32x4){acc[8], acc[9], acc[10], acc[11]}; xf[3] = (f32x4){acc[12], acc[13], acc[14], acc[15]};
    }
    LDS_BARRIER();
    const int fr = lane & 15, fq = lane >> 4, cl = wave * 16 + fr, ch = nb * 128 + cl;
    bf16x8 br[4], bi[4];
#pragma unroll
    for (int ks = 0; ks < 4; ++ks) { br[ks] = *(const bf16x8*)(WrT + ((size_t)nb * 128 + cl) * 128 + ks * 32 + fq * 8); bi[ks] = *(const bf16x8*)(WiT + ((size_t)nb * 128 + cl) * 128 + ks * 32 + fq * 8); }
    f32x4 ar[4], ai[4];
#pragma unroll
    for (int mt = 0; mt < 4; ++mt) { ar[mt] = (f32x4){0.f, 0.f, 0.f, 0.f}; ai[mt] = (f32x4){0.f, 0.f, 0.f, 0.f};
#pragma unroll
        for (int ks = 0; ks < 4; ++ks) { const bf16x8 af = *(const LAS bf16x8*)(lds + LA_XB + (mt * 16 + fr) * 272 + (ks * 32 + fq * 8) * 2); ar[mt] = mfma16(af, br[ks], ar[mt]); ai[mt] = mfma16(af, bi[ks], ai[mt]); } }
    const float brr = b_r[ch], bii = b_i[ch], sp8 = -8.0f * softplus_f(-lam[ch]);
    float Ac = 1.f, Bc = 0.f;
#pragma unroll
    for (int mt = 0; mt < 4; ++mt) {
        float P[4], H[4];
#pragma unroll
        for (int r = 0; r < 4; ++r) { const int t = mt * 16 + fq * 4 + r; const float xcv = *(const LAS float*)(lds + LA_XF + (t * 132 + cl) * 4);
            const float rr = sigmoid_f(ar[mt][r] + brr), ii = sigmoid_f(ai[mt][r] + bii), la = sp8 * rr, a = __expf(la), bb = sqrtf(fmaxf(1.0f - a * a, 0.0f)) * (ii * xcv);
            if (r == 0) { P[0] = a; H[0] = bb; } else { P[r] = P[r - 1] * a; H[r] = a * H[r - 1] + bb; } }
        float Ai = P[3], Bi = H[3];
        { const float Au = shfl_up_l(Ai, 16, lane), Bu = shfl_up_l(Bi, 16, lane); if (fq >= 1) { Bi = Ai * Bu + Bi; Ai = Au * Ai; } }
        { const float Au = shfl_up_l(Ai, 32, lane), Bu = shfl_up_l(Bi, 32, lane); if (fq >= 2) { Bi = Ai * Bu + Bi; Ai = Au * Ai; } }
        float Ae = shfl_up_l(Ai, 16, lane), Be = shfl_up_l(Bi, 16, lane); if (fq == 0) { Ae = 1.f; Be = 0.f; }
        const float At = shfl_idx_l(Ai, 48 + fr), Bt = shfl_idx_l(Bi, 48 + fr);
        const float PA = Ac * Ae, PB = Ae * Bc + Be;
#pragma unroll
        for (int r = 0; r < 4; ++r) { const size_t o = (size_t)(t0 + mt * 16 + fq * 4 + r) * DLRU + ch; Acum[o] = PA * P[r]; Hloc[o] = P[r] * PB + H[r]; }
        Bc = At * Bc + Bt; Ac = Ac * At;
    }
    if (fq == 0) { float* sp = summ + ((size_t)ct * DLRU + ch) * 2; sp[0] = Ac; sp[1] = Bc; }
    LDS_BARRIER();
}
__device__ __forceinline__ void lru_carry(const float* summ, float* carry, int idx) {
    const int b = idx >> 10, ch = idx & 1023; float c = 0.f;
    for (int n0 = 0; n0 < 128; n0 += 8) { float A[8], B[8];
#pragma unroll
        for (int j = 0; j < 8; ++j) { const float* sp = summ + ((size_t)(b * 128 + n0 + j) * DLRU + ch) * 2; A[j] = sp[0]; B[j] = sp[1]; }
#pragma unroll
        for (int j = 0; j < 8; ++j) { carry[(size_t)(b * 128 + n0 + j) * DLRU + ch] = c; c = A[j] * c + B[j]; } }
}
__device__ __forceinline__ void lrub_row(const float* Hloc, const float* Acum, const float* carry, const bf16* proj, const float* gain, bf16* ymix, int row, int lane) {
    const int ct = row >> 6; f32x4 y[4]; float ss = 0.f;
#pragma unroll
    for (int j = 0; j < 4; ++j) { const int c4 = lane * 4 + 256 * j;
        const f32x4 hl = *(const f32x4*)(Hloc + (size_t)row * DLRU + c4), ac = *(const f32x4*)(Acum + (size_t)row * DLRU + c4), cr = *(const f32x4*)(carry + (size_t)ct * DLRU + c4);
        const u32x2 g = *(const u32x2*)(proj + (size_t)row * NPROJ + DLRU + c4);
        const f32x4 hh = hl + ac * cr;
        y[j][0] = hh[0] * gelu_tanh_f(bflo(g.x)); y[j][1] = hh[1] * gelu_tanh_f(bfhi(g.x)); y[j][2] = hh[2] * gelu_tanh_f(bflo(g.y)); y[j][3] = hh[3] * gelu_tanh_f(bfhi(g.y));
        ss += (y[j][0] * y[j][0] + y[j][1] * y[j][1]) + (y[j][2] * y[j][2] + y[j][3] * y[j][3]); }
    ss = wave_sum(ss, lane); const float rs = 1.0f / sqrtf(ss * (1.0f / DLRU) + EPS);
#pragma unroll
    for (int j = 0; j < 4; ++j) { const int c4 = lane * 4 + 256 * j; const f32x4 g = *(const f32x4*)(gain + c4); u32x2 w; w.x = pk2(y[j][0] * rs * g[0], y[j][1] * rs * g[1]); w.y = pk2(y[j][2] * rs * g[2], y[j][3] * rs * g[3]);
        *(u32x2*)(ymix + (size_t)row * D + c4) = w; }
}
__device__ __forceinline__ void dn_out_row(const float* o, const float* gain, const bf16* proj, bf16* ymix, int t, int lane) {
    const int c = lane * 16;
    const f32x4* op = (const f32x4*)(o + (size_t)t * DDN + c); const f32x4 o0 = op[0], o1 = op[1], o2 = op[2], o3 = op[3];
    const u32x4* gp = (const u32x4*)(proj + (size_t)t * NPROJ + 5120 + c); const u32x4 g0 = gp[0], g1 = gp[1];
    const f32x4* wp = (const f32x4*)(gain + (c & 127)); const f32x4 w0 = wp[0], w1 = wp[1], w2 = wp[2], w3 = wp[3];
    float ss = (o0[0] * o0[0] + o0[1] * o0[1]) + (o0[2] * o0[2] + o0[3] * o0[3]) + (o1[0] * o1[0] + o1[1] * o1[1]) + (o1[2] * o1[2] + o1[3] * o1[3])
             + (o2[0] * o2[0] + o2[1] * o2[1]) + (o2[2] * o2[2] + o2[3] * o2[3]) + (o3[0] * o3[0] + o3[1] * o3[1]) + (o3[2] * o3[2] + o3[3] * o3[3]);
    ss += shfl_xor_l(ss, 1, lane); ss += shfl_xor_l(ss, 2, lane); ss += shfl_xor_l(ss, 4, lane);
    const float rs = 1.0f / sqrtf(ss * (1.0f / HD) + EPS);
    u32x4 r0, r1;
    r0.x = pk2(o0[0] * rs * w0[0] * silu_f(bflo(g0.x)), o0[1] * rs * w0[1] * silu_f(bfhi(g0.x))); r0.y = pk2(o0[2] * rs * w0[2] * silu_f(bflo(g0.y)), o0[3] * rs * w0[3] * silu_f(bfhi(g0.y)));
    r0.z = pk2(o1[0] * rs * w1[0] * silu_f(bflo(g0.z)), o1[1] * rs * w1[1] * silu_f(bfhi(g0.z))); r0.w = pk2(o1[2] * rs * w1[2] * silu_f(bflo(g0.w)), o1[3] * rs * w1[3] * silu_f(bfhi(g0.w)));
    r1.x = pk2(o2[0] * rs * w2[0] * silu_f(bflo(g1.x)), o2[1] * rs * w2[1] * silu_f(bfhi(g1.x))); r1.y = pk2(o2[2] * rs * w2[2] * silu_f(bflo(g1.y)), o2[3] * rs * w2[3] * silu_f(bfhi(g1.y)));
    r1.z = pk2(o3[0] * rs * w3[0] * silu_f(bflo(g1.z)), o3[1] * rs * w3[1] * silu_f(bfhi(g1.z))); r1.w = pk2(o3[2] * rs * w3[2] * silu_f(bflo(g1.w)), o3[3] * rs * w3[3] * silu_f(bfhi(g1.w)));
    u32x4* dst = (u32x4*)(ymix + (size_t)t * D + DLRU + c); dst[0] = r0; dst[1] = r1;
}
__device__ __forceinline__ void route_row(const float* x, const float* rstd, const float* gain, const float* router, float* roww, int row, int lane) {
    float acc[8];
#pragma unroll
    for (int e = 0; e < 8; ++e) acc[e] = 0.f;
    for (int j = 0; j < 32; ++j) { const int k = lane + 64 * j; const float xv = x[(size_t)row * D + k] * gain[k]; const f32x4 r0 = *(const f32x4*)(router + (size_t)k * 8), r1 = *(const f32x4*)(router + (size_t)k * 8 + 4);
        acc[0] += xv * r0[0]; acc[1] += xv * r0[1]; acc[2] += xv * r0[2]; acc[3] += xv * r0[3]; acc[4] += xv * r1[0]; acc[5] += xv * r1[1]; acc[6] += xv * r1[2]; acc[7] += xv * r1[3]; }
    const float rs = rstd[row];
#pragma unroll
    for (int e = 0; e < 8; ++e) acc[e] = wave_sum(acc[e], lane) * rs;
    int e1 = 0; float l1 = acc[0];
#pragma unroll
    for (int e = 1; e < 8; ++e) if (acc[e] > l1) { l1 = acc[e]; e1 = e; }
    int e2 = -1; float l2 = -3.4e38f;
#pragma unroll
    for (int e = 0; e < 8; ++e) if (e != e1 && acc[e] > l2) { l2 = acc[e]; e2 = e; }
    const float w1 = 1.0f / (1.0f + __expf(l2 - l1)), w2 = 1.0f - w1;
    if (lane < 8) roww[(size_t)lane * T + row] = lane == e1 ? w1 : (lane == e2 ? w2 : 0.0f);
}
__device__ __forceinline__ void final_row(const float* x, const float* gain, float* out, int row, int lane) {
    const f32x4* xr = (const f32x4*)(x + (size_t)row * D) + lane; const f32x4* gr = (const f32x4*)gain + lane;
    f32x4 v[8]; float ss = 0.f;
#pragma unroll
    for (int j = 0; j < 8; ++j) { v[j] = xr[64 * j]; ss += (v[j][0] * v[j][0] + v[j][1] * v[j][1]) + (v[j][2] * v[j][2] + v[j][3] * v[j][3]); }
    ss = wave_sum(ss, lane); const float rs = 1.0f / sqrtf(ss * (1.0f / D) + EPS);
    f32x4* o = (f32x4*)(out + (size_t)row * D) + lane;
#pragma unroll
    for (int j = 0; j < 8; ++j) o[64 * j] = v[j] * rs * gr[64 * j];
}

struct MoeOrder {
    const int* list; int nN, G, c; int c0, c1, c2, c3, c4, c5, c6, c7;
    __device__ __forceinline__ void init(const unsigned* cnt, const int* list_, int nN_, int G_, int c_) { list = list_; nN = nN_; G = G_; c = c_;
        c0 = __builtin_amdgcn_readfirstlane((int)cnt[0]); c1 = __builtin_amdgcn_readfirstlane((int)cnt[1]); c2 = __builtin_amdgcn_readfirstlane((int)cnt[2]); c3 = __builtin_amdgcn_readfirstlane((int)cnt[3]);
        c4 = __builtin_amdgcn_readfirstlane((int)cnt[4]); c5 = __builtin_amdgcn_readfirstlane((int)cnt[5]); c6 = __builtin_amdgcn_readfirstlane((int)cnt[6]); c7 = __builtin_amdgcn_readfirstlane((int)cnt[7]); }
    __device__ __forceinline__ bool next(int i, pg8::Unit& u) const {
        const int c8[8] = {c0, c1, c2, c3, c4, c5, c6, c7}; int nM = 0;
#pragma unroll
        for (int k = 0; k < 8; ++k) nM += (c8[k] + 255) >> 8;
        const int nwg = nM * nN; const long L = (long)i * G + c; if (L >= nwg) return false;
        int wgid = (int)L; { const int q = nwg / pg8::NXCD, r = nwg % pg8::NXCD, xcd = wgid % pg8::NXCD, off = wgid / pg8::NXCD; wgid = (xcd < r ? xcd * (q + 1) : r * (q + 1) + (xcd - r) * q) + off; }
        const int nig = pg8::WGM * nN, gid = wgid / nig, fm = gid * pg8::WGM, gsz = (nM - fm) < pg8::WGM ? (nM - fm) : pg8::WGM;
        u.pm = fm + ((wgid % nig) % gsz); u.pn = (wgid % nig) / gsz;
        int e = 0, ps = 0, ce = c8[0], run = 0;
#pragma unroll
        for (int k = 0; k < 8; ++k) { const int mk = (c8[k] + 255) >> 8; if (u.pm >= run && u.pm < run + mk) { e = k; ps = run; ce = c8[k]; } run += mk; }
        const int mtl = u.pm - ps; u.pb = e * nN + u.pn; u.lbase = e * T + mtl * 256; u.nvalid = (ce - mtl * 256) < 256 ? (ce - mtl * 256) : 256;
        return true;
    }
    __device__ __forceinline__ int arow(const pg8::Unit& u, int r) const { return r < u.nvalid ? (list[u.lbase + r] & 0xffff) : 0; }
    __device__ __forceinline__ void a_ready(const pg8::Unit&) const {}
    __device__ __forceinline__ void done(const pg8::Unit&) const {}
};
__device__ __forceinline__ void route_block(const float* x, const float* gain, const float* router, bf16* xb, float* rstd, unsigned* cnt, int* list, float* listw, int blk, LAS unsigned char* lds, int tid, int lane, int wave) {
    asm volatile("" : "+v"(lds));
    LAS float* grt = (LAS float*)lds; LAS int* se1 = (LAS int*)(lds + 65536); LAS int* se2 = se1 + 64; LAS float* sw1 = (LAS float*)(se2 + 64); LAS float* sw2 = sw1 + 64; LAS int* lcnt = (LAS int*)(sw2 + 64); LAS int* gbase = lcnt + 8;
    for (int i = tid; i < D * 8; i += 512) grt[i] = router[i] * gain[i >> 3];
    if (tid < 8) lcnt[tid] = 0;
    __syncthreads();
    for (int q = 0; q < 8; ++q) { const int rloc = wave * 8 + q, row = blk * 64 + rloc;
        const f32x4* xr = (const f32x4*)(x + (size_t)row * D) + lane;
        f32x4 v[8]; float ss = 0.f;
#pragma unroll
        for (int j = 0; j < 8; ++j) { v[j] = xr[64 * j]; ss += (v[j][0] * v[j][0] + v[j][1] * v[j][1]) + (v[j][2] * v[j][2] + v[j][3] * v[j][3]); }
        ss = wave_sum(ss, lane); const float rs = 1.0f / sqrtf(ss * (1.0f / D) + EPS);
        u32x2* o = (u32x2*)(xb + (size_t)row * D) + lane;
#pragma unroll
        for (int j = 0; j < 8; ++j) { u32x2 w; w.x = pk2(v[j][0], v[j][1]); w.y = pk2(v[j][2], v[j][3]); o[64 * j] = w; }
        if (lane == 0) rstd[row] = rs;
        float acc[8];
#pragma unroll
        for (int e = 0; e < 8; ++e) acc[e] = 0.f;
#pragma unroll
        for (int j = 0; j < 8; ++j)
#pragma unroll
            for (int c = 0; c < 4; ++c) { const int k = (lane + 64 * j) * 4 + c; const f32x4 r0 = *(const LAS f32x4*)(grt + k * 8), r1 = *(const LAS f32x4*)(grt + k * 8 + 4); const float xv = v[j][c];
                acc[0] += xv * r0[0]; acc[1] += xv * r0[1]; acc[2] += xv * r0[2]; acc[3] += xv * r0[3]; acc[4] += xv * r1[0]; acc[5] += xv * r1[1]; acc[6] += xv * r1[2]; acc[7] += xv * r1[3]; }
#pragma unroll
        for (int e = 0; e < 8; ++e) acc[e] = wave_sum(acc[e], lane) * rs;
        int e1 = 0; float l1 = acc[0];
#pragma unroll
        for (int e = 1; e < 8; ++e) if (acc[e] > l1) { l1 = acc[e]; e1 = e; }
        int e2 = -1; float l2 = -3.4e38f;
#pragma unroll
        for (int e = 0; e < 8; ++e) if (e != e1 && acc[e] > l2) { l2 = acc[e]; e2 = e; }
        const float w1 = 1.0f / (1.0f + __expf(l2 - l1));
        if (lane == 0) { se1[rloc] = e1; se2[rloc] = e2; sw1[rloc] = w1; sw2[rloc] = 1.0f - w1; }
    }
    __syncthreads();
    int e = 0, lr = 0; float w = 0.f;
    if (tid < 128) { const int rloc = tid >> 1, j = tid & 1; e = j ? se2[rloc] : se1[rloc]; w = j ? sw2[rloc] : sw1[rloc]; lr = __hip_atomic_fetch_add(lcnt + e, 1, __ATOMIC_RELAXED, __HIP_MEMORY_SCOPE_WORKGROUP); }
    __syncthreads();
    if (tid < 8) gbase[tid] = (int)__hip_atomic_fetch_add(cnt + tid, (unsigned)lcnt[tid], __ATOMIC_RELAXED, __HIP_MEMORY_SCOPE_AGENT);
    __syncthreads();
    if (tid < 128) { const int pos = gbase[e] + lr, tok = blk * 64 + (tid >> 1); list[e * T + pos] = tok | ((tid & 1) << 16); listw[e * T + pos] = w; }
    __syncthreads();
}
__device__ __forceinline__ void final_row_moe(const float* x, const bf16* y0, const bf16* y1, const float* gain, float* out, int row, int lane) {
    const f32x4* xr = (const f32x4*)(x + (size_t)row * D) + lane; const f32x4* gr = (const f32x4*)gain + lane;
    const u32x2* p0 = (const u32x2*)(y0 + (size_t)row * D) + lane; const u32x2* p1 = (const u32x2*)(y1 + (size_t)row * D) + lane;
    f32x4 v[8]; float ss = 0.f;
#pragma unroll
    for (int j = 0; j < 8; ++j) { v[j] = xr[64 * j]; const u32x2 a = p0[64 * j], b = p1[64 * j];
        v[j][0] += bflo(a.x) + bflo(b.x); v[j][1] += bfhi(a.x) + bfhi(b.x); v[j][2] += bflo(a.y) + bflo(b.y); v[j][3] += bfhi(a.y) + bfhi(b.y);
        ss += (v[j][0] * v[j][0] + v[j][1] * v[j][1]) + (v[j][2] * v[j][2] + v[j][3] * v[j][3]); }
    ss = wave_sum(ss, lane); const float rs = 1.0f / sqrtf(ss * (1.0f / D) + EPS);
    f32x4* o = (f32x4*)(out + (size_t)row * D) + lane;
#pragma unroll
    for (int j = 0; j < 8; ++j) o[64 * j] = v[j] * rs * gr[64 * j];
}
struct Args { const float* in[25]; float* out; unsigned char* ws; int ph_lo, ph_hi; };
typedef const __attribute__((address_space(4))) unsigned long long* kaptr_t;
__device__ __forceinline__ unsigned long long ldka(int i) { kaptr_t ka = (kaptr_t)__builtin_amdgcn_kernarg_segment_ptr(); asm volatile("" : "+s"(i)); return ka[i]; }
__device__ __forceinline__ const float* ldin(const Args&, int i) { return (const float*)(const GAS float*)ldka(i); }
__device__ __forceinline__ unsigned char* ldws(const Args&) { return (unsigned char*)(GAS unsigned char*)ldka(26); }
__device__ __forceinline__ float* ldout(const Args&) { return (float*)(GAS float*)ldka(25); }
__global__ void __launch_bounds__(512, 2) mega(Args args) {
    extern __shared__ __attribute__((aligned(16))) unsigned char lds_raw[];
    LAS unsigned char* lds = (LAS unsigned char*)lds_raw;
    volatile LAS unsigned* MISC = (volatile LAS unsigned*)(lds + MISC_OFF);
    const int tid = threadIdx.x;
    const int G = gridDim.x, bid = blockIdx.x, NGW = G * 8;
    unsigned char* ws = ldws(args);
    for (int u = tid; u < (LDS_BYTES - LDSCTL_OFF) / 4; u += 512) ((LAS unsigned*)(lds + LDSCTL_OFF))[u] = 0u;
    __syncthreads();
    (void)xcd_barrier_post((unsigned*)(ws + WS_CTL) + CW_BAR, MISC + 8);
#define RUN(id) true
#if defined(PROBE_MASK)
#define STAMP() do { if (threadIdx.x == 0) { ((volatile LAS unsigned long long*)(lds + LDSCTL_OFF + 1024))[nst] = __builtin_amdgcn_s_memrealtime(); } ++nst; } while (0)
#else
#define STAMP() do { } while (0)
#endif
#define SEAM(id) do { XcdBarrier bar_; bar_.bar = (unsigned*)WSP(WS_CTL) + CW_BAR; bar_.x = xb_xcc_id(); bar_.st = (volatile LAS unsigned*)(lds + MISC_OFF) + 8; xcd_barrier(bar_); STAMP(); } while (0)
#if defined(PROBE_MASK)
    int nst = 0; STAMP();
#endif
#define INP(i) ldin(args, (i))
#define WSP(off) (ldws(args) + (off))
#define x_in INP(0)
#define norm_mix INP(1)
#define w_in INP(2)
#define conv_lru_w INP(3)
#define conv_lru_b INP(4)
#define lru_w_r INP(5)
#define lru_b_r INP(6)
#define lru_w_i INP(7)
#define lru_b_i INP(8)
#define lru_lambda INP(9)
#define lru_out_norm INP(10)
#define conv_qkv_w INP(11)
#define dn_a_log INP(12)
#define dn_dt_bias INP(13)
#define dn_out_norm INP(14)
#define w_out INP(15)
#define norm_ffn INP(16)
#define ffn_w_gate INP(17)
#define ffn_w_up INP(18)
#define ffn_w_down INP(19)
#define moe_router INP(20)
#define moe_w_gate INP(21)
#define moe_w_up INP(22)
#define moe_w_down INP(23)
#define norm_final INP(24)
#define xres (ldout(args))
#define Win ((bf16*)WSP(WS_WIN))
#define Wba ((float*)WSP(WS_WBA))
#define Wout ((bf16*)WSP(WS_WOUT))
#define Wgu ((bf16*)WSP(WS_WGU))
#define Wd ((bf16*)WSP(WS_WD))
#define Mgu ((bf16*)WSP(WS_C))
#define Md ((bf16*)WSP(WS_WGU))
#define MCNT ((unsigned*)WSP(WS_CTL) + CW_CNT)
#define MLIST ((int*)WSP(WS_ROWW))
#define MLISTW ((float*)WSP(WS_ROWW + (size_t)8 * T * 4))
#define YP0 ((bf16*)WSP(WS_XB))
#define YP1 ((bf16*)WSP(WS_YMIX))
#define xb ((bf16*)WSP(WS_XB))
#define rstd ((float*)WSP(WS_RSTD))
#define ba ((float*)WSP(WS_BA))
#define beta ((float*)WSP(WS_BETA))
#define gg ((float*)WSP(WS_G))
#define roww ((float*)WSP(WS_ROWW))
#define proj ((bf16*)WSP(WS_PROJ))
#define hid ((bf16*)WSP(WS_PROJ))
#define ymix ((bf16*)WSP(WS_YMIX))
#define c0 ((float*)WSP(WS_C))
#define c1 ((float*)WSP(WS_C + (size_t)T * 1024 * 4))
#define c2 ((float*)WSP(WS_C + (size_t)2 * T * 1024 * 4))
#define c3 ((float*)WSP(WS_C + (size_t)3 * T * 1024 * 4))
#define LRU_WRT ((bf16*)WSP(WS_WRT))
#define LRU_WIT ((bf16*)WSP(WS_WRT + (size_t)2 * 8 * 128 * 128 * 2))
#define LRU_H ((float*)WSP(WS_C + (size_t)256 * MiB))
#define LRU_A ((float*)WSP(WS_C + (size_t)320 * MiB))
#define LRU_SUMM ((float*)WSP(WS_C + (size_t)384 * MiB))
#define LRU_CARRY ((float*)WSP(WS_C + (size_t)386 * MiB))
#define DN_WF ((bf16*)WSP(WS_C))
#define DN_QF ((bf16*)WSP(WS_C + (size_t)32 * MiB))
#define DN_KDTF ((bf16*)WSP(WS_C + (size_t)64 * MiB))
#define DN_UF ((bf16*)WSP(WS_C + (size_t)96 * MiB))
#define DN_QKF ((bf16*)WSP(WS_C + (size_t)128 * MiB))
#define DN_GL ((float*)WSP(WS_C + (size_t)144 * MiB))
    const int BIG = 1 << 30;
#define PHL int tid_ = threadIdx.x; asm volatile("" : "+v"(tid_)); const int lane_ = tid_ & 63; int bid_ = blockIdx.x; asm volatile("" : "+s"(bid_)); const int gw_ = bid_ * 8 + __builtin_amdgcn_readfirstlane(tid_ >> 6); const size_t gt_ = (size_t)bid_ * 512 + tid_, NGT = (size_t)G * 512; LAS float* scr = (LAS float*)(lds + (gw_ & 7) * 16384);
    if (RUN(ph)) { PHL
        convert_matrix(w_in, DIN, 0, D, NPROJ, norm_mix, Win, BIG, 0, 0, scr, gw_, NGW, lane_);
        convert_matrix(w_out, D, 0, D, D, nullptr, Wout, BIG, 0, 0, scr, gw_, NGW, lane_);
        for (int l = 0; l < 2; ++l)
            for (size_t i = gt_; i < (size_t)16 * D; i += NGT) { const int j = (int)(i / D), k = (int)(i % D); Wba[(size_t)l * 16 * D + i] = w_in[(size_t)l * D * DIN + (size_t)k * DIN + NPROJ + j] * norm_mix[l * D + k]; }
        for (int m = 0; m < 16; ++m) {
            convert_matrix(lru_w_r + (size_t)m * 128 * 128, 128, 0, 128, 128, nullptr, LRU_WRT + (size_t)m * 128 * 128, BIG, 0, 0, scr, gw_, NGW, lane_);
            convert_matrix(lru_w_i + (size_t)m * 128 * 128, 128, 0, 128, 128, nullptr, LRU_WIT + (size_t)m * 128 * 128, BIG, 0, 0, scr, gw_, NGW, lane_); }
    }
    SEAM(ph);
    int xsel = 0;
#define xcur (xsel ? (const float*)xres : x_in)
    { constexpr int l = 0;
        if (RUN(ph)) { PHL for (int r = gw_; r < T; r += NGW) rowprep_row(xcur, xb, rstd, Wba + (size_t)l * 16 * D, ba, r, lane_); }
        SEAM(ph);
        if (RUN(ph)) { pg8::Gemm g{xb, Win + (size_t)l * NPROJ * D, T, NPROJ, D, 0}; pg8::StaticOrder S; S.init(T, NPROJ, G, bid); pg8::EpiScaleBf16 E{proj, rstd, NPROJ, 0};
            pg8::gemm_phase<pg8::EpiScaleBf16, pg8::StaticOrder, true, false>(lds, g, S, E); }
        SEAM(ph);
        if (RUN(ph)) { PHL
            for (int u = bid_; u < 2048; u += G) lrua_unit(proj, conv_lru_w + (size_t)l * 4 * DLRU, conv_lru_b + l * DLRU, LRU_WRT + (size_t)l * 8 * 128 * 128, LRU_WIT + (size_t)l * 8 * 128 * 128, lru_b_r + l * DLRU, lru_b_i + l * DLRU, lru_lambda + l * DLRU, LRU_H, LRU_A, LRU_SUMM, u, lds, tid_, lane_, gw_ & 7);
            STAMP();
            for (int uid = bid_; uid < 2048; uid += G) dna_unit(proj, conv_qkv_w + (size_t)l * 4 * 3 * DDN, ba, dn_a_log + l * NH, dn_dt_bias + l * NH, DN_WF, DN_QF, DN_KDTF, DN_QKF, DN_UF, DN_GL, uid, lds, tid_, lane_, gw_ & 7); }
        SEAM(ph);
        if (RUN(ph)) { PHL
            if (bid_ < 128) dnb_run(DN_WF, DN_QF, DN_KDTF, DN_QKF, DN_UF, DN_GL, c3, (bid_ & 7) + 8 * (bid_ >> 6), (bid_ >> 3) & 7, lds, tid_, lane_, gw_ & 7);
            else if (bid_ < 136) { if (tid_ < 256) lru_carry(LRU_SUMM, LRU_CARRY, (bid_ - 128) * 256 + tid_); }
            else { const int cw = gw_ - 136 * 8, CNW = NGW - 136 * 8;
                if (l == 0) {
                    convert_matrix(w_in + (size_t)D * DIN, DIN, 0, D, NPROJ, norm_mix + D, Win + (size_t)NPROJ * D, BIG, 0, 0, scr, cw, CNW, lane_);
                    convert_matrix(w_out + (size_t)D * D, D, 0, D, D, nullptr, Wout + (size_t)D * D, BIG, 0, 0, scr, cw, CNW, lane_);
                    convert_matrix(ffn_w_gate, DFF, 0, D, DFF, norm_ffn, Wgu, 128, 256, 0, scr, cw, CNW, lane_);
                    convert_matrix(ffn_w_up, DFF, 0, D, DFF, norm_ffn, Wgu, 128, 256, 128, scr, cw, CNW, lane_);
                    convert_matrix(ffn_w_down, D, 0, DFF, D, nullptr, Wd, BIG, 0, 0, scr, cw, CNW, lane_);
                } else {
                    for (int e = 0; e < NEXP; ++e) convert_matrix(moe_w_down + (size_t)e * DFFE * D, D, 0, DFFE, D, nullptr, Md + (size_t)e * D * DFFE, BIG, 0, 0, scr, cw, CNW, lane_);
                } } }
        SEAM(ph);
        if (RUN(ph)) { PHL
            for (int r = gw_; r < T; r += NGW) lrub_row(LRU_H, LRU_A, LRU_CARRY, proj, lru_out_norm + l * DLRU, ymix, r, lane_);
            for (int r = gw_; r < T; r += NGW) dn_out_row(c3, dn_out_norm + l * HD, proj, ymix, r, lane_); }
        SEAM(ph);
        if (RUN(ph)) { { pg8::Gemm g{ymix, Wout + (size_t)l * D * D, T, D, D, 0}; pg8::StaticOrder S; S.init(T, D, G, bid); pg8::EpiResidual E{xcur, xres, nullptr, D, 0};
            pg8::gemm_phase<pg8::EpiResidual, pg8::StaticOrder, true, false>(lds, g, S, E); }
            if (l == 1) { PHL
                for (int e = 0; e < NEXP; ++e) {
                    convert_matrix(moe_w_gate + (size_t)e * D * DFFE, DFFE, 0, D, DFFE, norm_ffn + D, Mgu + (size_t)e * 2 * DFFE * D, 128, 256, 0, scr, gw_, NGW, lane_);
                    convert_matrix(moe_w_up + (size_t)e * D * DFFE, DFFE, 0, D, DFFE, norm_ffn + D, Mgu + (size_t)e * 2 * DFFE * D, 128, 256, 128, scr, gw_, NGW, lane_);
 } } }
        SEAM(ph);
        xsel = 1;
        if (l == 0) {
            if (RUN(ph)) { PHL for (int r = gw_; r < T; r += NGW) rowprep_row(xcur, xb, rstd, nullptr, nullptr, r, lane_); }
            SEAM(ph);
            if (RUN(ph)) { pg8::Gemm g{xb, Wgu, T, 2 * DFF, D, 0}; pg8::StaticOrder S; S.init(T, 2 * DFF, G, bid); pg8::EpiSwiGLU E{hid, rstd, DFF, 0};
                pg8::gemm_phase<pg8::EpiSwiGLU, pg8::StaticOrder, true, false>(lds, g, S, E); }
            SEAM(ph);
            if (RUN(ph)) { pg8::Gemm g{hid, Wd, T, D, DFF, 0}; pg8::StaticOrder S; S.init(T, D, G, bid); pg8::EpiResidual E{xcur, xres, nullptr, D, 0};
                pg8::gemm_phase<pg8::EpiResidual, pg8::StaticOrder, true, false>(lds, g, S, E); }
            SEAM(ph);
        } else {
            if (RUN(ph)) { PHL for (int blk = bid_; blk < T / 64; blk += G) route_block(xcur, norm_ffn + D, moe_router, xb, rstd, MCNT, MLIST, MLISTW, blk, lds, tid_, lane_, gw_ & 7); }
            SEAM(ph);
            if (RUN(ph)) { pg8::Gemm g{xb, Mgu, NSLOT, 2 * DFFE, D, 0}; MoeOrder S; S.init(MCNT, MLIST, 2 * DFFE / 256, G, bid); pg8::EpiSwiGLUMoe E{hid, rstd, MLIST, DFFE, 0};
                pg8::gemm_phase<pg8::EpiSwiGLUMoe, MoeOrder, true, true>(lds, g, S, E); }
            SEAM(ph);
            if (RUN(ph)) { pg8::Gemm g{hid, Md, NSLOT, D, DFFE, 0}; MoeOrder S; S.init(MCNT, MLIST, D / 256, G, bid); pg8::EpiMoeDown E{YP0, YP1, MLIST, MLISTW, D, 0};
                pg8::gemm_phase<pg8::EpiMoeDown, MoeOrder, true, false>(lds, g, S, E); }
            SEAM(ph);
        }
    }
    { constexpr int l = 1;
        if (RUN(ph)) { PHL for (int r = gw_; r < T; r += NGW) rowprep_row(xcur, xb, rstd, Wba + (size_t)l * 16 * D, ba, r, lane_); }
        SEAM(ph);
        if (RUN(ph)) { pg8::Gemm g{xb, Win + (size_t)l * NPROJ * D, T, NPROJ, D, 0}; pg8::StaticOrder S; S.init(T, NPROJ, G, bid); pg8::EpiScaleBf16 E{proj, rstd, NPROJ, 0};
            pg8::gemm_phase<pg8::EpiScaleBf16, pg8::StaticOrder, true, false>(lds, g, S, E); }
        SEAM(ph);
        if (RUN(ph)) { PHL
            for (int u = bid_; u < 2048; u += G) lrua_unit(proj, conv_lru_w + (size_t)l * 4 * DLRU, conv_lru_b + l * DLRU, LRU_WRT + (size_t)l * 8 * 128 * 128, LRU_WIT + (size_t)l * 8 * 128 * 128, lru_b_r + l * DLRU, lru_b_i + l * DLRU, lru_lambda + l * DLRU, LRU_H, LRU_A, LRU_SUMM, u, lds, tid_, lane_, gw_ & 7);
            STAMP();
            for (int uid = bid_; uid < 2048; uid += G) dna_unit(proj, conv_qkv_w + (size_t)l * 4 * 3 * DDN, ba, dn_a_log + l * NH, dn_dt_bias + l * NH, DN_WF, DN_QF, DN_KDTF, DN_QKF, DN_UF, DN_GL, uid, lds, tid_, lane_, gw_ & 7); }
        SEAM(ph);
        if (RUN(ph)) { PHL
            if (bid_ < 128) dnb_run(DN_WF, DN_QF, DN_KDTF, DN_QKF, DN_UF, DN_GL, c3, (bid_ & 7) + 8 * (bid_ >> 6), (bid_ >> 3) & 7, lds, tid_, lane_, gw_ & 7);
            else if (bid_ < 136) { if (tid_ < 256) lru_carry(LRU_SUMM, LRU_CARRY, (bid_ - 128) * 256 + tid_); }
            else { const int cw = gw_ - 136 * 8, CNW = NGW - 136 * 8;
                if (l == 0) {
                    convert_matrix(w_in + (size_t)D * DIN, DIN, 0, D, NPROJ, norm_mix + D, Win + (size_t)NPROJ * D, BIG, 0, 0, scr, cw, CNW, lane_);
                    convert_matrix(w_out + (size_t)D * D, D, 0, D, D, nullptr, Wout + (size_t)D * D, BIG, 0, 0, scr, cw, CNW, lane_);
                    convert_matrix(ffn_w_gate, DFF, 0, D, DFF, norm_ffn, Wgu, 128, 256, 0, scr, cw, CNW, lane_);
                    convert_matrix(ffn_w_up, DFF, 0, D, DFF, norm_ffn, Wgu, 128, 256, 128, scr, cw, CNW, lane_);
                    convert_matrix(ffn_w_down, D, 0, DFF, D, nullptr, Wd, BIG, 0, 0, scr, cw, CNW, lane_);
                } else {
                    for (int e = 0; e < NEXP; ++e) convert_matrix(moe_w_down + (size_t)e * DFFE * D, D, 0, DFFE, D, nullptr, Md + (size_t)e * D * DFFE, BIG, 0, 0, scr, cw, CNW, lane_);
                } } }
        SEAM(ph);
        if (RUN(ph)) { PHL
            for (int r = gw_; r < T; r += NGW) lrub_row(LRU_H, LRU_A, LRU_CARRY, proj, lru_out_norm + l * DLRU, ymix, r, lane_);
            for (int r = gw_; r < T; r += NGW) dn_out_row(c3, dn_out_norm + l * HD, proj, ymix, r, lane_); }
        SEAM(ph);
        if (RUN(ph)) { { pg8::Gemm g{ymix, Wout + (size_t)l * D * D, T, D, D, 0}; pg8::StaticOrder S; S.init(T, D, G, bid); pg8::EpiResidual E{xcur, xres, nullptr, D, 0};
            pg8::gemm_phase<pg8::EpiResidual, pg8::StaticOrder, true, false>(lds, g, S, E); }
            if (l == 1) { PHL
                for (int e = 0; e < NEXP; ++e) {
                    convert_matrix(moe_w_gate + (size_t)e * D * DFFE, DFFE, 0, D, DFFE, norm_ffn + D, Mgu + (size_t)e * 2 * DFFE * D, 128, 256, 0, scr, gw_, NGW, lane_);
                    convert_matrix(moe_w_up + (size_t)e * D * DFFE, DFFE, 0, D, DFFE, norm_ffn + D, Mgu + (size_t)e * 2 * DFFE * D, 128, 256, 128, scr, gw_, NGW, lane_);
 } } }
        SEAM(ph);
        xsel = 1;
        if (l == 0) {
            if (RUN(ph)) { PHL for (int r = gw_; r < T; r += NGW) rowprep_row(xcur, xb, rstd, nullptr, nullptr, r, lane_); }
            SEAM(ph);
            if (RUN(ph)) { pg8::Gemm g{xb, Wgu, T, 2 * DFF, D, 0}; pg8::StaticOrder S; S.init(T, 2 * DFF, G, bid); pg8::EpiSwiGLU E{hid, rstd, DFF, 0};
                pg8::gemm_phase<pg8::EpiSwiGLU, pg8::StaticOrder, true, false>(lds, g, S, E); }
            SEAM(ph);
            if (RUN(ph)) { pg8::Gemm g{hid, Wd, T, D, DFF, 0}; pg8::StaticOrder S; S.init(T, D, G, bid); pg8::EpiResidual E{xcur, xres, nullptr, D, 0};
                pg8::gemm_phase<pg8::EpiResidual, pg8::StaticOrder, true, false>(lds, g, S, E); }
            SEAM(ph);
        } else {
            if (RUN(ph)) { PHL for (int blk = bid_; blk < T / 64; blk += G) route_block(xcur, norm_ffn + D, moe_router, xb, rstd, MCNT, MLIST, MLISTW, blk, lds, tid_, lane_, gw_ & 7); }
            SEAM(ph);
            if (RUN(ph)) { pg8::Gemm g{xb, Mgu, NSLOT, 2 * DFFE, D, 0}; MoeOrder S; S.init(MCNT, MLIST, 2 * DFFE / 256, G, bid); pg8::EpiSwiGLUMoe E{hid, rstd, MLIST, DFFE, 0};
                pg8::gemm_phase<pg8::EpiSwiGLUMoe, MoeOrder, true, true>(lds, g, S, E); }
            SEAM(ph);
            if (RUN(ph)) { pg8::Gemm g{hid, Md, NSLOT, D, DFFE, 0}; MoeOrder S; S.init(MCNT, MLIST, D / 256, G, bid); pg8::EpiMoeDown E{YP0, YP1, MLIST, MLISTW, D, 0};
                pg8::gemm_phase<pg8::EpiMoeDown, MoeOrder, true, false>(lds, g, S, E); }
            SEAM(ph);
        }
    }
    if (RUN(ph)) { PHL for (int r = gw_; r < T; r += NGW) final_row_moe(xcur, YP0, YP1, norm_final, xres, r, lane_); }
#if defined(PROBE_MASK)
    __syncthreads(); STAMP();
    if (blockIdx.x == 0 && threadIdx.x == 0) { asm volatile("s_waitcnt vmcnt(0)" ::: "memory"); volatile LAS unsigned long long* st = (volatile LAS unsigned long long*)(lds + LDSCTL_OFF + 1024); unsigned long long tot = 0;
        for (int k = 1; k < nst; ++k) if ((PROBE_MASK >> (k - 1)) & 1ull) tot += st[k] - st[k - 1];
        xres[0] = rintf((float)tot * 0.01f * PROBE_SCALE); }
#endif
#if defined(PROBE_DNA_A)
    __syncthreads();
    if (blockIdx.x == 0 && threadIdx.x == 0) { asm volatile("s_waitcnt vmcnt(0)" ::: "memory"); volatile LAS unsigned long long* st = (volatile LAS unsigned long long*)(lds + (RING_BYTES + 2048));
        xres[0] = rintf((float)(st[PROBE_DNA_B] - st[PROBE_DNA_A]) * 0.01f * PROBE_SCALE); }
#endif
#undef RUN
#undef SEAM
}

extern "C" void kernel_launch(void* const* d_in, const int* in_sizes, int n_in, void* d_out, int out_size, void* d_ws, size_t ws_size, hipStream_t stream) {
    static int grid = 0;
    if (grid == 0) {
        if (n_in != 25 || ws_size < WS_END) { fprintf(stderr, "kernel_launch: unexpected n_in %d / ws_size %zu (need %zu)\n", n_in, ws_size, (size_t)WS_END); grid = -1; return; }
        int dev = 0, cus = 0, per_cu = 0;
        if (hipGetDevice(&dev) != hipSuccess || hipDeviceGetAttribute(&cus, hipDeviceAttributeMultiprocessorCount, dev) != hipSuccess) { grid = -1; return; }
        if (hipFuncSetAttribute((const void*)mega, hipFuncAttributeMaxDynamicSharedMemorySize, LDS_BYTES) != hipSuccess) { fprintf(stderr, "kernel_launch: hipFuncSetAttribute failed\n"); grid = -1; return; }
        if (hipOccupancyMaxActiveBlocksPerMultiprocessor(&per_cu, (const void*)mega, 512, LDS_BYTES) != hipSuccess || per_cu < 1) { fprintf(stderr, "kernel_launch: occupancy query says %d\n", per_cu); }
        (void)hipGetLastError();
        grid = cus;
    }
    if (grid < 0) return;
    if (hipMemsetAsync((char*)d_ws + WS_CTL, 0, CTL_ZERO_BYTES, stream) != hipSuccess) return;
    Args a{};
    for (int i = 0; i < 25; ++i) a.in[i] = (const float*)d_in[i];
    a.out = (float*)d_out; a.ws = (unsigned char*)d_ws; a.ph_lo = 0; a.ph_hi = 1 << 30;
    hipLaunchKernelGGL(mega, dim3(grid), dim3(512), LDS_BYTES, stream, a);
}
```

```cpp
#include <hip/hip_runtime.h>
#include <cstdio>
#include <cstdint>
namespace pg8 {
#define PG8_LAS __attribute__((address_space(3)))
typedef unsigned short bf16_t;
typedef short bf16x8 __attribute__((ext_vector_type(8)));
typedef float f32x4 __attribute__((ext_vector_type(4)));
typedef unsigned u32x4 __attribute__((ext_vector_type(4)));
constexpr int BM = 256, BK = 64, HALF = 128, HTB = HALF * BK * 2  , STAGE_BYTES = 8 * HTB, NXCD = 8, WGM = 8;

__host__ __device__ __forceinline__ int lds_byte(int r, int c) { const int st = (r >> 4) * 2 + (c >> 5), rr = r & 15, cc = c & 31, ob = rr * 64 + cc * 2; return st * 1024 + (ob ^ (((ob >> 9) & 1) << 5)); }
__host__ __device__ __forceinline__ void stage_rc(int b, int& R, int& C) { const int st = b / 1024, sb = b % 1024, swz = sb ^ (((sb >> 9) & 1) << 5); R = (st >> 1) * 16 + swz / 64; C = (st & 1) * 32 + (swz % 64) / 2; }
__host__ __device__ __forceinline__ int perm32(int rho) { const int n = rho >> 4, i = rho & 15; return 8 * (i >> 2) + 4 * n + (i & 3); }

struct Unit { int pm, pn, pb, lbase, nvalid; };
struct Gemm { const bf16_t* A; const bf16_t* Bt; int M, N, K, pad; };

struct StaticOrder {
    int nM, nN, nwg, G, c;
    __host__ __device__ void init(int M, int N, int G_, int c_) { nM = M / BM; nN = N / BM; nwg = nM * nN; G = G_; c = c_; }
    __host__ __device__ bool next(int i, Unit& u) const {
        const long L = (long)i * G + c; if (L >= nwg) return false;
        int wgid = (int)L; { const int q = nwg / NXCD, r = nwg % NXCD, xcd = wgid % NXCD, off = wgid / NXCD; wgid = (xcd < r ? xcd * (q + 1) : r * (q + 1) + (xcd - r) * q) + off; }
        const int nig = WGM * nN, gid = wgid / nig, fm = gid * WGM, gsz = (nM - fm) < WGM ? (nM - fm) : WGM;
        u.pm = fm + ((wgid % nig) % gsz); u.pn = (wgid % nig) / gsz; u.pb = u.pn; u.lbase = 0; u.nvalid = BM; return true;
    }
    __device__ __forceinline__ int arow(const Unit&, int) const { return 0; }
    __device__ __forceinline__ void a_ready(const Unit&) const {}
    __device__ __forceinline__ void done(const Unit&) const {}
};


typedef float f32x2_t __attribute__((ext_vector_type(2)));
typedef __bf16 bf16x2_t __attribute__((ext_vector_type(2)));
__device__ __forceinline__ unsigned cvt_pk_bf16(float lo, float hi) { const f32x2_t v = {lo, hi}; const bf16x2_t b = __builtin_convertvector(v, bf16x2_t); return __builtin_bit_cast(unsigned, b); }
__device__ __forceinline__ float silu_f(float x) { return x / (1.0f + __expf(-x)); }
__device__ __forceinline__ float row_scale(const float* rs, int r, int mode) {
    if (!mode) return rs[r];
    const f32x4* p = (const f32x4*)(rs + (size_t)r * 32); float s = 0.f;
#pragma unroll
    for (int i = 0; i < 8; ++i) { const f32x4 v = p[i]; s += (v[0] + v[1]) + (v[2] + v[3]); }
    return 1.0f / sqrtf(s * (1.0f / 2048.0f) + 1e-6f);
}
__device__ __forceinline__ void row_scales8(const float* rs, int row0, int fr, int fq, int mode, float (&sc)[2][4]) {
    if (!mode) {
#pragma unroll
        for (int ai = 0; ai < 2; ++ai)
#pragma unroll
            for (int m = 0; m < 4; ++m) sc[ai][m] = rs[row0 + ai * HALF + m * 16];
    } else {
        const int lane = fr + 16 * fq; f32x4 pa[2][4][2];
#pragma unroll
        for (int ai = 0; ai < 2; ++ai)
#pragma unroll
            for (int m = 0; m < 4; ++m) { const f32x4* p = (const f32x4*)(rs + (size_t)(row0 + ai * HALF + m * 16) * 32 + fq * 8); pa[ai][m][0] = p[0]; pa[ai][m][1] = p[1]; }
#pragma unroll
        for (int ai = 0; ai < 2; ++ai)
#pragma unroll
            for (int m = 0; m < 4; ++m) { const f32x4 a = pa[ai][m][0], b = pa[ai][m][1]; float t = ((a[0] + a[1]) + (a[2] + a[3])) + ((b[0] + b[1]) + (b[2] + b[3]));
                t += __int_as_float(__builtin_amdgcn_ds_bpermute((lane ^ 16) << 2, __float_as_int(t)));
                t += __int_as_float(__builtin_amdgcn_ds_bpermute((lane ^ 32) << 2, __float_as_int(t)));
                sc[ai][m] = 1.0f / sqrtf(t * (1.0f / 2048.0f) + 1e-6f); }
    }
}
struct EpiScaleBf16 {
    static constexpr bool PERM = true, AFTER_DRAIN = false;
    bf16_t* O; const float* rs; int ldc; int pad;
    __device__ __forceinline__ void operator()(const f32x4 (&acc)[2][2][4][2], const Unit& u, int wr, int wc, int fr, int fq) const {
        const int row0 = u.pm * BM + wr * 64 + fr, col0 = u.pn * BM + wc * 32 + 8 * fq;
        float sc[2][4]; row_scales8(rs, row0, fr, fq, pad, sc);
#pragma unroll
        for (int ai = 0; ai < 2; ++ai)
#pragma unroll
            for (int m = 0; m < 4; ++m) { const int r = row0 + ai * HALF + m * 16; const float s = sc[ai][m]; bf16_t* rowp = O + (size_t)r * ldc + col0;
#pragma unroll
                for (int bj = 0; bj < 2; ++bj) { const f32x4 v0 = acc[ai][bj][m][0] * s, v1 = acc[ai][bj][m][1] * s;
                    u32x4 w; w.x = cvt_pk_bf16(v0[0], v0[1]); w.y = cvt_pk_bf16(v0[2], v0[3]); w.z = cvt_pk_bf16(v1[0], v1[1]); w.w = cvt_pk_bf16(v1[2], v1[3]);
                    *(u32x4*)(rowp + bj * HALF) = w; } }
    }
};
struct EpiSwiGLU {
    static constexpr bool PERM = true, AFTER_DRAIN = false;
    bf16_t* O; const float* rs; int ldc; int pad;
    __device__ __forceinline__ void operator()(const f32x4 (&acc)[2][2][4][2], const Unit& u, int wr, int wc, int fr, int fq) const {
        const int row0 = u.pm * BM + wr * 64 + fr, col0 = u.pn * HALF + wc * 32 + 8 * fq;
        float sc[2][4]; row_scales8(rs, row0, fr, fq, pad, sc);
#pragma unroll
        for (int ai = 0; ai < 2; ++ai)
#pragma unroll
            for (int m = 0; m < 4; ++m) { const int r = row0 + ai * HALF + m * 16; const float s = sc[ai][m]; bf16_t* rowp = O + (size_t)r * ldc + col0;
                f32x4 h0, h1;
#pragma unroll
                for (int j = 0; j < 4; ++j) { h0[j] = silu_f(acc[ai][0][m][0][j] * s) * (acc[ai][1][m][0][j] * s); h1[j] = silu_f(acc[ai][0][m][1][j] * s) * (acc[ai][1][m][1][j] * s); }
                u32x4 w; w.x = cvt_pk_bf16(h0[0], h0[1]); w.y = cvt_pk_bf16(h0[2], h0[3]); w.z = cvt_pk_bf16(h1[0], h1[1]); w.w = cvt_pk_bf16(h1[2], h1[3]);
                *(u32x4*)rowp = w; }
    }
};
struct EpiResidual {
    static constexpr bool PERM = false, AFTER_DRAIN = false;
    const float* base; float* out; const float* roww; int ldc; int pad;
    __device__ __forceinline__ void operator()(const f32x4 (&acc)[2][2][4][2], const Unit& u, int wr, int wc, int fr, int fq) const {
        const int row0 = u.pm * BM + wr * 64 + fr, col0 = u.pn * BM + wc * 32 + 4 * fq;
#pragma unroll
        for (int ai = 0; ai < 2; ++ai)
#pragma unroll
            for (int m = 0; m < 4; ++m) { const int r = row0 + ai * HALF + m * 16; const float w = roww ? roww[r] : 1.0f; const size_t off = (size_t)r * ldc + col0;
#pragma unroll
                for (int bj = 0; bj < 2; ++bj)
#pragma unroll
                    for (int n = 0; n < 2; ++n) { const f32x4 bs = *(const f32x4*)(base + off + bj * HALF + n * 16); *(f32x4*)(out + off + bj * HALF + n * 16) = bs + acc[ai][bj][m][n] * w; } }
    }
};

struct EpiSwiGLUMoe {
    static constexpr bool PERM = true, AFTER_DRAIN = false;
    bf16_t* O; const float* rs; const int* list; int ldc; int pad;
    __device__ __forceinline__ void operator()(const f32x4 (&acc)[2][2][4][2], const Unit& u, int wr, int wc, int fr, int fq) const {
        const int rl0 = wr * 64 + fr, col0 = u.pn * HALF + wc * 32 + 8 * fq;
#pragma unroll
        for (int ai = 0; ai < 2; ++ai)
#pragma unroll
            for (int m = 0; m < 4; ++m) { const int rl = rl0 + ai * HALF + m * 16; const int tok = rl < u.nvalid ? (list[u.lbase + rl] & 0xffff) : 0; const float s = rs[tok];
                bf16_t* rowp = O + (size_t)(u.pm * BM + rl) * ldc + col0;
                f32x4 h0, h1;
#pragma unroll
                for (int j = 0; j < 4; ++j) { h0[j] = silu_f(acc[ai][0][m][0][j] * s) * (acc[ai][1][m][0][j] * s); h1[j] = silu_f(acc[ai][0][m][1][j] * s) * (acc[ai][1][m][1][j] * s); }
                u32x4 w; w.x = cvt_pk_bf16(h0[0], h0[1]); w.y = cvt_pk_bf16(h0[2], h0[3]); w.z = cvt_pk_bf16(h1[0], h1[1]); w.w = cvt_pk_bf16(h1[2], h1[3]);
                *(u32x4*)rowp = w; }
    }
};
struct EpiMoeDown {
    static constexpr bool PERM = true, AFTER_DRAIN = false;
    bf16_t* Y0; bf16_t* Y1; const int* list; const float* lw; int ldc; int pad;
    __device__ __forceinline__ void operator()(const f32x4 (&acc)[2][2][4][2], const Unit& u, int wr, int wc, int fr, int fq) const {
        const int rl0 = wr * 64 + fr, col0 = u.pn * BM + wc * 32 + 8 * fq;
#pragma unroll
        for (int ai = 0; ai < 2; ++ai)
#pragma unroll
            for (int m = 0; m < 4; ++m) { const int rl = rl0 + ai * HALF + m * 16;
                if (rl < u.nvalid) { const int en = list[u.lbase + rl]; const float w = lw[u.lbase + rl]; bf16_t* rowp = ((en >> 16) ? Y1 : Y0) + (size_t)(en & 0xffff) * ldc + col0;
#pragma unroll
                    for (int bj = 0; bj < 2; ++bj) { const f32x4 v0 = acc[ai][bj][m][0] * w, v1 = acc[ai][bj][m][1] * w;
                        u32x4 o; o.x = cvt_pk_bf16(v0[0], v0[1]); o.y = cvt_pk_bf16(v0[2], v0[3]); o.z = cvt_pk_bf16(v1[0], v1[1]); o.w = cvt_pk_bf16(v1[2], v1[3]);
                        *(u32x4*)(rowp + bj * HALF) = o; } } }
    }
};

struct EpiResidualNorm {
    static constexpr bool PERM = true, AFTER_DRAIN = false;
    const float* base; float* out; bf16_t* xb; float* ssq; int ldc; int pad;
    __device__ __forceinline__ void operator()(const f32x4 (&acc)[2][2][4][2], const Unit& u, int wr, int wc, int fr, int fq) const {
        const int row0 = u.pm * BM + wr * 64 + fr, col0 = u.pn * BM + wc * 32 + 8 * fq, lane = fr + 16 * fq;
#pragma unroll
        for (int ai = 0; ai < 2; ++ai)
#pragma unroll
            for (int m = 0; m < 4; ++m) { const int r = row0 + ai * HALF + m * 16; const size_t off = (size_t)r * ldc + col0; float part = 0.f;
#pragma unroll
                for (int bj = 0; bj < 2; ++bj) { const f32x4 b0 = *(const f32x4*)(base + off + bj * HALF), b1 = *(const f32x4*)(base + off + bj * HALF + 4);
                    const f32x4 v0 = b0 + acc[ai][bj][m][0], v1 = b1 + acc[ai][bj][m][1];
                    *(f32x4*)(out + off + bj * HALF) = v0; *(f32x4*)(out + off + bj * HALF + 4) = v1;
                    u32x4 w; w.x = cvt_pk_bf16(v0[0], v0[1]); w.y = cvt_pk_bf16(v0[2], v0[3]); w.z = cvt_pk_bf16(v1[0], v1[1]); w.w = cvt_pk_bf16(v1[2], v1[3]);
                    *(u32x4*)(xb + off + bj * HALF) = w;
                    part += (v0[0] * v0[0] + v0[1] * v0[1]) + (v0[2] * v0[2] + v0[3] * v0[3]) + (v1[0] * v1[0] + v1[1] * v1[1]) + (v1[2] * v1[2] + v1[3] * v1[3]); }
                part += __int_as_float(__builtin_amdgcn_ds_bpermute((lane ^ 16) << 2, __float_as_int(part)));
                part += __int_as_float(__builtin_amdgcn_ds_bpermute((lane ^ 32) << 2, __float_as_int(part)));
                if (fq == 0) ssq[(size_t)r * 32 + u.pn * 4 + wc] = part; }
    }
};
template <class Epi, class Sched, bool ALIGN_EPI = false, bool GATHER = false>
__device__ __forceinline__ void gemm_phase(PG8_LAS unsigned char* lds, const Gemm g, const Sched& S, const Epi& E) {
    int tid_o = threadIdx.x; asm volatile("" : "+v"(tid_o));
    const int tid = tid_o, wid = __builtin_amdgcn_readfirstlane(tid >> 6), lane = tid & 63, wr = wid >> 2, wc = wid & 3, fr = lane & 15, fq = lane >> 4;
    const int K = g.K, nt = K / BK;
    const size_t kstep = (size_t)(BK * 2);
    const size_t hstep = (size_t)HALF * K * 2;
    const size_t tstep = 2 * hstep;
    unsigned voffA[2], voffB[2], oA[2][2], oN[2][2];
#pragma unroll
    for (int i = 0; i < 2; ++i) { int R, C; stage_rc(tid * 16 + i * 8192, R, C); const int Rb = Epi::PERM ? ((R & ~31) + perm32(R & 31)) : R; voffA[i] = (unsigned)(R * K + C) * 2u; voffB[i] = (unsigned)(Rb * K + C) * 2u; }
    const unsigned ldsw = (unsigned)wid * 1024u;
    const int aoff = lds_byte(wr * 64 + fr, fq * 8), boff = lds_byte(wc * 32 + fr, fq * 8);
#define PG8_SA(b, h) (((b) * 2 + (h)) * HTB)
#define PG8_SB(b, h) ((4 + (b) * 2 + (h)) * HTB)
#define PG8_STAGE(bufoff, gbase, voff) do { _Pragma("unroll") for (int _i = 0; _i < 2; ++_i) \
        __builtin_amdgcn_global_load_lds((const unsigned*)((const char*)(gbase) + (voff)[_i]), (PG8_LAS unsigned*)(lds + (bufoff) + ldsw + _i * 8192), 16, 0, 0); } while (0)
#define PG8_LDA(dst, b, h) do { _Pragma("unroll") for (int m = 0; m < 4; ++m) _Pragma("unroll") for (int k = 0; k < 2; ++k) dst[m][k] = *(const PG8_LAS bf16x8*)(lds + PG8_SA(b, h) + aoff + m * 2048 + k * 1024); } while (0)
#define PG8_LDB(dst, b, h) do { _Pragma("unroll") for (int n = 0; n < 2; ++n) _Pragma("unroll") for (int k = 0; k < 2; ++k) dst[n][k] = *(const PG8_LAS bf16x8*)(lds + PG8_SB(b, h) + boff + n * 2048 + k * 1024); } while (0)
#define PG8_MMA(ai, bj, At, Bt) do { __builtin_amdgcn_s_setprio(1); _Pragma("unroll") for (int m = 0; m < 4; ++m) _Pragma("unroll") for (int n = 0; n < 2; ++n) _Pragma("unroll") for (int k = 0; k < 2; ++k) \
        acc[ai][bj][m][n] = __builtin_amdgcn_mfma_f32_16x16x32_bf16(Bt[n][k], At[m][k], acc[ai][bj][m][n], 0, 0, 0); __builtin_amdgcn_s_setprio(0); } while (0)
#define PG8_WAIT_V(n) asm volatile("s_waitcnt vmcnt(" #n ")" ::: "memory")
#define PG8_WAIT_L(n) asm volatile("s_waitcnt lgkmcnt(" #n ")" ::: "memory")
#define PG8_BAR __builtin_amdgcn_s_barrier()
#define PG8_SCHED __builtin_amdgcn_sched_barrier(0)
#define PG8_AOFF(dst, u) do { _Pragma("unroll") for (int _i = 0; _i < 2; ++_i) { int _R, _C; stage_rc(tid * 16 + _i * 8192, _R, _C); _Pragma("unroll") for (int _h = 0; _h < 2; ++_h) \
        dst[_h][_i] = (unsigned)(S.arow(u, _h * HALF + _R) * K + _C) * 2u; } } while (0)
#define PG8_STAGE_A(bufoff, gbase, h, usenext) do { _Pragma("unroll") for (int _i = 0; _i < 2; ++_i) { const unsigned _o = GATHER ? ((usenext) ? oN[h][_i] : oA[h][_i]) : voffA[_i]; \
        __builtin_amdgcn_global_load_lds((const unsigned*)((const char*)(gbase) + (GATHER ? (size_t)0 : (size_t)(h) * hstep) + _o), (PG8_LAS unsigned*)(lds + (bufoff) + ldsw + _i * 8192), 16, 0, 0); } } while (0)
    Unit cur, nxt; int ui = 0;
    if (!S.next(0, cur)) return;
    f32x4 acc[2][2][4][2];
#pragma unroll
    for (int a = 0; a < 2; ++a)
#pragma unroll
        for (int b = 0; b < 2; ++b)
#pragma unroll
            for (int m = 0; m < 4; ++m)
#pragma unroll
                for (int n = 0; n < 2; ++n) acc[a][b][m][n] = (f32x4){0.f, 0.f, 0.f, 0.f};
    bf16x8 At[4][2], B0[2][2], B1[2][2];
    const char* cA = (const char*)g.A + (GATHER ? (size_t)0 : (size_t)cur.pm * tstep); const char* cB = (const char*)g.Bt + (size_t)cur.pb * tstep;
    S.a_ready(cur);
    if constexpr (GATHER) { PG8_AOFF(oA, cur); PG8_WAIT_V(0); }
    PG8_STAGE(PG8_SB(0, 0), cB, voffB); PG8_STAGE(PG8_SB(0, 1), cB + hstep, voffB); PG8_STAGE_A(PG8_SA(0, 0), cA, 0, false); PG8_STAGE_A(PG8_SA(0, 1), cA, 1, false);
    if (wr == 1) PG8_BAR;
    PG8_WAIT_V(2); PG8_BAR;
    PG8_STAGE(PG8_SB(1, 0), cB + kstep, voffB); PG8_STAGE_A(PG8_SA(1, 0), cA + kstep, 0, false); PG8_STAGE(PG8_SB(1, 1), cB + hstep + kstep, voffB);
    PG8_WAIT_V(6); PG8_BAR;
    for (;;) {
        const bool has_next = S.next(ui + 1, nxt);
        const char* nA = has_next ? (const char*)g.A + (GATHER ? (size_t)0 : (size_t)nxt.pm * tstep) : cA; const char* nB = has_next ? (const char*)g.Bt + (size_t)nxt.pb * tstep : cB;
        if constexpr (GATHER) { if (has_next) { PG8_AOFF(oN, nxt); } else {
#pragma unroll
            for (int _h = 0; _h < 2; ++_h) { oN[_h][0] = oA[_h][0]; oN[_h][1] = oA[_h][1]; } } }
        for (int t = 0; t < nt; t += 2) {
            const bool last = (t == nt - 2);
            const char* a1 = cA + (size_t)(t + 1) * kstep;
            const char* a2 = last ? nA : cA + (size_t)(t + 2) * kstep; const char* b2 = last ? nB : cB + (size_t)(t + 2) * kstep;
            const char* a3 = a2 + kstep; const char* b3 = b2 + kstep;
            if (last && has_next) S.a_ready(nxt);
            PG8_LDB(B0, 0, 0); PG8_LDB(B1, 0, 1); PG8_SCHED; PG8_LDA(At, 0, 0); PG8_STAGE_A(PG8_SA(1, 1), a1, 1, false);
            PG8_WAIT_V(8); PG8_WAIT_L(0); PG8_BAR; PG8_MMA(0, 0, At, B0); PG8_MMA(0, 1, At, B1); PG8_BAR; PG8_SCHED;
            PG8_LDA(At, 0, 1); PG8_STAGE(PG8_SB(0, 0), b2, voffB); PG8_STAGE(PG8_SB(0, 1), b2 + hstep, voffB); PG8_STAGE_A(PG8_SA(0, 0), a2, 0, last);
            PG8_WAIT_V(8); PG8_WAIT_L(0); PG8_BAR; PG8_MMA(1, 0, At, B0); PG8_MMA(1, 1, At, B1); PG8_BAR; PG8_SCHED;
            PG8_LDB(B0, 1, 0); PG8_LDB(B1, 1, 1); PG8_SCHED; PG8_LDA(At, 1, 0); PG8_STAGE_A(PG8_SA(0, 1), a2, 1, last);
            PG8_WAIT_V(8); PG8_WAIT_L(0); PG8_BAR; PG8_MMA(0, 0, At, B0); PG8_MMA(0, 1, At, B1); PG8_BAR; PG8_SCHED;
            PG8_LDA(At, 1, 1); PG8_STAGE(PG8_SB(1, 0), b3, voffB); PG8_STAGE(PG8_SB(1, 1), b3 + hstep, voffB); PG8_STAGE_A(PG8_SA(1, 0), a3, 0, last);
            PG8_WAIT_V(8); PG8_WAIT_L(0); PG8_BAR; PG8_MMA(1, 0, At, B0); PG8_MMA(1, 1, At, B1); PG8_BAR; PG8_SCHED;
        }
        if constexpr (ALIGN_EPI) { if (wr == 0) PG8_BAR; }
        E(acc, cur, wr, wc, fr, fq); S.done(cur);
        if (!has_next) break;
#pragma unroll
        for (int a = 0; a < 2; ++a)
#pragma unroll
            for (int b = 0; b < 2; ++b)
#pragma unroll
                for (int m = 0; m < 4; ++m)
#pragma unroll
                    for (int n = 0; n < 2; ++n) acc[a][b][m][n] = (f32x4){0.f, 0.f, 0.f, 0.f};
        cur = nxt; cA = nA; cB = nB; ++ui;
        if constexpr (GATHER) {
#pragma unroll
            for (int _h = 0; _h < 2; ++_h) { oA[_h][0] = oN[_h][0]; oA[_h][1] = oN[_h][1]; } }
        if constexpr (ALIGN_EPI) { if (wr == 1) PG8_BAR; }
    }
    PG8_WAIT_V(0);
    if constexpr (!ALIGN_EPI) { if (wr == 0) PG8_BAR; }
    PG8_BAR;
#undef PG8_SA
#undef PG8_SB
#undef PG8_STAGE
#undef PG8_LDA
#undef PG8_LDB
#undef PG8_MMA
#undef PG8_WAIT_V
#undef PG8_WAIT_L
#undef PG8_BAR
#undef PG8_SCHED
#undef PG8_AOFF
#undef PG8_STAGE_A
}
}

#define GAS __attribute__((address_space(1)))
#define LAS __attribute__((address_space(3)))
#define XB_TMO      128
#define XB_XCNT(j)  (256  + 64 * (j))
#define XB_XSUB(j)  (1280 + 64 * (j))
#define XB_XGEN(j)  (2304 + 64 * (j))
#define XB_TOP      3328
#define XB_TOPGEN   3392
#define XCD_BAR_WORDS 3456
#define XB_SPIN_CAP (1u << 23)

__device__ __forceinline__ unsigned xb_ld(unsigned* p)              { return __hip_atomic_load(p, __ATOMIC_RELAXED, __HIP_MEMORY_SCOPE_AGENT); }
__device__ __forceinline__ unsigned xb_add(unsigned* p, unsigned v) { return __hip_atomic_fetch_add(p, v, __ATOMIC_RELAXED, __HIP_MEMORY_SCOPE_AGENT); }
__device__ __forceinline__ unsigned xb_xcc_id() { return (unsigned)__builtin_amdgcn_s_getreg((3 << 11) | 20) & 0xFu; }
#define XB_SPIN(cond, bar) do { unsigned _sp = 0; while (cond) { __builtin_amdgcn_s_sleep(1); \
    if ((++_sp & 255u) == 0u) { if (xb_ld(&(bar)[XB_TMO])) break; if (_sp > XB_SPIN_CAP) { atomicAdd(&(bar)[XB_TMO], 1u); break; } } } } while (0)

struct XcdBarrier {
    unsigned* bar; unsigned x;
    volatile LAS unsigned* st;
};

__device__ __forceinline__ XcdBarrier xcd_barrier_post(unsigned* bar, volatile LAS unsigned* st) {
    XcdBarrier b; b.bar = bar; b.x = xb_xcc_id(); b.st = st;
    if (threadIdx.x == 0) (void)xb_add(&bar[XB_XCNT(b.x)], 1u);
    return b;
}
__device__ __forceinline__ void xcd_barrier_complete(unsigned* bar, unsigned x, unsigned& nloc, unsigned& nx) {
    const unsigned G = gridDim.x * gridDim.y * gridDim.z;
    unsigned sum, cnt, mine, sp = 0u;
    for (;;) {
        sum = 0u; cnt = 0u; mine = 0u;
#pragma unroll
        for (unsigned j = 0; j < 16; ++j) { const unsigned c = xb_ld(&bar[XB_XCNT(j)]); sum += c; cnt += (c > 0u) ? 1u : 0u; mine = (j == x) ? c : mine; }
        if (sum == G) break;
        __builtin_amdgcn_s_sleep(1);
        if ((++sp & 255u) == 0u) { if (xb_ld(&bar[XB_TMO])) break; if (sp > XB_SPIN_CAP) { atomicAdd(&bar[XB_TMO], 1u); break; } }
    }
    nloc = mine > 0u ? mine : 1u; nx = cnt > 0u ? cnt : 1u;
}

__device__ __forceinline__ void xcd_barrier(const XcdBarrier& b) {
    asm volatile("s_waitcnt vmcnt(0)" ::: "memory");
    __syncthreads();
    if (threadIdx.x == 0) {
        unsigned* bar = b.bar; asm volatile("" : "+s"(bar));
        __builtin_amdgcn_s_waitcnt(0);
        unsigned nloc = b.st[0], nx = b.st[1];
        if (nloc == 0u) { xcd_barrier_complete(bar, b.x, nloc, nx); b.st[0] = nloc; b.st[1] = nx; }
        const unsigned old = xb_add(&bar[XB_XSUB(b.x)], 1u);
        const unsigned gen = old / nloc;
        if (old + 1u == (gen + 1u) * nloc) {
            __builtin_amdgcn_fence(__ATOMIC_RELEASE, "agent");
            asm volatile("s_waitcnt vmcnt(0)" ::: "memory");
            const unsigned og = xb_add(&bar[XB_TOP], 1u);
            const unsigned tg = og / nx;
            if (og + 1u == (tg + 1u) * nx) xb_add(&bar[XB_TOPGEN], 1u);
            else XB_SPIN(xb_ld(&bar[XB_TOPGEN]) == tg, bar);
            __builtin_amdgcn_fence(__ATOMIC_ACQUIRE, "agent");
            xb_add(&bar[XB_XGEN(b.x)], 1u);
            asm volatile("s_waitcnt vmcnt(0)" ::: "memory");
        } else {
            XB_SPIN(xb_ld(&bar[XB_XGEN(b.x)]) == gen, bar);
            __builtin_amdgcn_fence(__ATOMIC_ACQUIRE, "agent");
            asm volatile("s_waitcnt vmcnt(0)" ::: "memory");
        }
    }
    __syncthreads();
}

constexpr int T = 16384, SEQ = 8192, D = 2048, DLRU = 1024, DDN = 1024, NH = 8, HD = 128, NPROJ = 6144, DIN = 6160;
constexpr int DFF = 6144, NEXP = 8, DFFE = 3072;
constexpr float EPS = 1e-6f;
typedef unsigned short bf16;
typedef float f32x4 __attribute__((ext_vector_type(4)));
typedef unsigned u32x4 __attribute__((ext_vector_type(4)));
typedef unsigned u32x2 __attribute__((ext_vector_type(2)));
#define LDS_WAIT() asm volatile("s_waitcnt lgkmcnt(0)" ::: "memory")
#define LDS_BARRIER() do { asm volatile("s_waitcnt lgkmcnt(0)" ::: "memory"); __builtin_amdgcn_s_barrier(); asm volatile("" ::: "memory"); } while (0)

__device__ __forceinline__ float bf2f(bf16 b) { return __uint_as_float(((unsigned)b) << 16); }
__device__ __forceinline__ unsigned f2bf(float f) { unsigned u = __float_as_uint(f); return (u + 0x7fffu + ((u >> 16) & 1u)) >> 16; }
__device__ __forceinline__ unsigned pk2(float lo, float hi) { return pg8::cvt_pk_bf16(lo, hi); }
__device__ __forceinline__ float shfl_xor_l(float v, int o, int lane) { return __int_as_float(__builtin_amdgcn_ds_bpermute((lane ^ o) << 2, __float_as_int(v))); }
__device__ __forceinline__ float shfl_up_l(float v, int d, int lane) { return __int_as_float(__builtin_amdgcn_ds_bpermute((lane - d) << 2, __float_as_int(v))); }
__device__ __forceinline__ float shfl_idx_l(float v, int src) { return __int_as_float(__builtin_amdgcn_ds_bpermute(src << 2, __float_as_int(v))); }
__device__ __forceinline__ float wave_sum(float v, int lane) {
#pragma unroll
    for (int o = 1; o < 64; o <<= 1) v += shfl_xor_l(v, o, lane);
    return v;
}
using pg8::silu_f;
__device__ __forceinline__ float sigmoid_f(float x) { return 1.0f / (1.0f + __expf(-x)); }
__device__ __forceinline__ float softplus_f(float x) { return fmaxf(x, 0.0f) + log1pf(__expf(-fabsf(x))); }
__device__ __forceinline__ float gelu_tanh_f(float x) { const float u = 0.7978845608028654f * (x + 0.044715f * x * x * x); return 0.5f * x * (1.0f + tanhf(u)); }

constexpr size_t MiB = 1u << 20;
constexpr size_t al(size_t x) { return (x + MiB - 1) / MiB * MiB; }
constexpr size_t WS_CTL = 0, CTL_ZERO_BYTES = 1 * MiB;
constexpr int CW_BAR = 4096, CW_CNT = 8192;
constexpr size_t WS_WGU = 1 * MiB;
constexpr size_t WS_WD = WS_WGU + al((size_t)2 * DFF * D * 2);
constexpr size_t WS_WIN = WS_WD + al((size_t)D * DFF * 2);
constexpr size_t WS_WBA = WS_WIN + al((size_t)2 * NPROJ * D * 2);
constexpr size_t WS_WOUT = WS_WBA + al((size_t)2 * 16 * D * 4 + 16 * D * 2);
static_assert(WS_WIN + (size_t)NPROJ * D * 2 - WS_WGU >= (size_t)NEXP * D * DFFE * 2, "MoE down weights overlay");
constexpr size_t WS_XB = WS_WOUT + al((size_t)2 * D * D * 2);
constexpr size_t WS_RSTD = WS_XB + al((size_t)T * D * 2);
constexpr size_t WS_BA = WS_RSTD + 5 * MiB;
constexpr size_t WS_BETA = WS_BA + al((size_t)T * 16 * 4);
constexpr size_t WS_G = WS_BETA + al((size_t)T * 8 * 4);
constexpr size_t WS_ROWW = WS_G + al((size_t)T * 8 * 4);
constexpr int NSLOT = 2 * T + NEXP * 256;
constexpr size_t WS_PROJ = WS_ROWW + al((size_t)2 * 8 * T * 4);
constexpr size_t WS_YMIX = WS_PROJ + al((size_t)NSLOT * DFFE * 2);
constexpr size_t WS_C = WS_YMIX + al((size_t)T * D * 2);
constexpr size_t WS_WRT = WS_C + (size_t)388 * MiB;
constexpr size_t WS_END = WS_WRT + 1 * MiB;
static_assert(WS_END <= (size_t)975 * MiB, "d_ws map exceeds the guaranteed workspace");
static_assert((size_t)NEXP * 2 * DFFE * D * 2 <= (size_t)388 * MiB, "MoE gate/up bf16 weights overlay the mixer scratch");
constexpr int RING_BYTES = 131072, LDSCTL_OFF = RING_BYTES, MISC_OFF = LDSCTL_OFF + 320, LDS_BYTES = 147456;

__device__ __forceinline__ void transpose_item(const float* W, int ldw, int col_off, int K, int nblk, const float* gain, bf16* WT, int blk, int blk_stride, int row_off, int item, int lane) {
    const int kb = item / nblk, nb = item % nblk, k0 = 64 * kb + (lane >> 4) * 16, n0 = 64 * nb + (lane & 15) * 4;
    const float* src = W + (size_t)k0 * ldw + col_off + n0;
    f32x4 v[16];
#pragma unroll
    for (int j = 0; j < 16; ++j) v[j] = *(const f32x4*)(src + (size_t)j * ldw);
    if (gain) {
#pragma unroll
        for (int q = 0; q < 4; ++q) { const f32x4 g = *(const f32x4*)(gain + k0 + 4 * q);
#pragma unroll
            for (int c = 0; c < 4; ++c) v[4 * q + c] = v[4 * q + c] * g[c]; }
    }
#pragma unroll
    for (int i = 0; i < 4; ++i) { const int n = n0 + i, drow = (n / blk) * blk_stride + (n % blk) + row_off;
        u32x4 o0, o1;
        o0.x = pk2(v[0][i], v[1][i]); o0.y = pk2(v[2][i], v[3][i]); o0.z = pk2(v[4][i], v[5][i]); o0.w = pk2(v[6][i], v[7][i]);
        o1.x = pk2(v[8][i], v[9][i]); o1.y = pk2(v[10][i], v[11][i]); o1.z = pk2(v[12][i], v[13][i]); o1.w = pk2(v[14][i], v[15][i]);
        u32x4* dst = (u32x4*)(WT + (size_t)drow * K + k0); dst[0] = o0; dst[1] = o1; }
}
__device__ __forceinline__ void convert_matrix(const float* W, int ldw, int col_off, int K, int N, const float* gain, bf16* WT, int blk, int blk_stride, int row_off, LAS float* scr, int gw, int NGW, int lane) {
    const int nblk = N / 64, nitems = (K / 64) * nblk; (void)scr;
    for (int it = gw; it < nitems; it += NGW) transpose_item(W, ldw, col_off, K, nblk, gain, WT, blk, blk_stride, row_off, it, lane);
}
__device__ __forceinline__ void rowprep_row(const float* x, bf16* xb, float* rstd, const float* Wba, float* ba, int row, int lane) {
    const f32x4* xr = (const f32x4*)(x + (size_t)row * D) + lane;
    f32x4 v[8]; float ss = 0.f;
#pragma unroll
    for (int j = 0; j < 8; ++j) { v[j] = xr[64 * j]; ss += (v[j][0] * v[j][0] + v[j][1] * v[j][1]) + (v[j][2] * v[j][2] + v[j][3] * v[j][3]); }
    ss = wave_sum(ss, lane);
    const float rs = 1.0f / sqrtf(ss * (1.0f / D) + EPS);
    u32x2* o = (u32x2*)(xb + (size_t)row * D) + lane;
#pragma unroll
    for (int j = 0; j < 8; ++j) { u32x2 w; w.x = pk2(v[j][0], v[j][1]); w.y = pk2(v[j][2], v[j][3]); o[64 * j] = w; }
    if (lane == 0) rstd[row] = rs;
    if (Wba) {
        for (int c = 0; c < 16; ++c) { const f32x4* wr = (const f32x4*)(Wba + (size_t)c * D) + lane; float a = 0.f;
#pragma unroll
            for (int j = 0; j < 8; ++j) { const f32x4 w = wr[64 * j]; a += (v[j][0] * w[0] + v[j][1] * w[1]) + (v[j][2] * w[2] + v[j][3] * w[3]); }
            a = wave_sum(a, lane); if (lane == 0) ba[(size_t)row * 16 + c] = a * rs; }
    }
}
__device__ __forceinline__ void lru_conv_elem(const bf16* proj, const float* cw, const float* cb, float* xc, size_t idx) {
    const int t = (int)(idx / DLRU), ch = (int)(idx % DLRU), s = t % SEQ;
    float a = cb[ch];
#pragma unroll
    for (int k = 0; k < 4; ++k) { const int sp = s - 3 + k; if (sp >= 0) a += cw[k * DLRU + ch] * bf2f(proj[(size_t)(t - 3 + k) * NPROJ + ch]); }
    xc[idx] = a;
}
__device__ __forceinline__ void lru_gate_elem(const float* xc, const float* w_r, const float* b_r, const float* w_i, const float* b_i, const float* lam, float* av, float* bv, size_t idx) {
    const int t = (int)(idx / DLRU), ch = (int)(idx % DLRU), n = ch >> 7, d = ch & 127;
    float ar = b_r[ch], ai = b_i[ch];
    const float* xr = xc + (size_t)t * DLRU + n * 128; const float* wr = w_r + (size_t)n * 128 * 128 + d; const float* wi = w_i + (size_t)n * 128 * 128 + d;
    for (int c = 0; c < 128; ++c) { const float xv = xr[c]; ar += xv * wr[c * 128]; ai += xv * wi[c * 128]; }
    const float r = sigmoid_f(ar), ig = sigmoid_f(ai);
    const float log_a = -8.0f * r * softplus_f(-lam[ch]);
    const float a = expf(log_a), mult = sqrtf(-expm1f(2.0f * log_a));
    av[idx] = a; bv[idx] = mult * (ig * xc[idx]);
}
__device__ __forceinline__ void lru_scan_chan(float* av, const float* bv, const bf16* proj, int idx) {
    const int b = idx / DLRU, ch = idx % DLRU;
    float h = 0.f;
    for (int s0 = 0; s0 < SEQ; s0 += 8) {
        float a8[8], b8[8], g8[8];
#pragma unroll
        for (int j = 0; j < 8; ++j) { const size_t t = (size_t)b * SEQ + s0 + j; a8[j] = av[t * DLRU + ch]; b8[j] = bv[t * DLRU + ch]; g8[j] = bf2f(proj[t * NPROJ + DLRU + ch]); }
#pragma unroll
        for (int j = 0; j < 8; ++j) { const size_t t = (size_t)b * SEQ + s0 + j; h = a8[j] * h + b8[j]; av[t * DLRU + ch] = h * gelu_tanh_f(g8[j]); }
    }
}
__device__ __forceinline__ void lru_norm_row(const float* y, const float* gain, bf16* ymix, int row, int lane) {
    const f32x4* yr = (const f32x4*)(y + (size_t)row * DLRU) + lane; const f32x4* gr = (const f32x4*)gain + lane;
    f32x4 v[4]; float ss = 0.f;
#pragma unroll
    for (int j = 0; j < 4; ++j) { v[j] = yr[64 * j]; ss += (v[j][0] * v[j][0] + v[j][1] * v[j][1]) + (v[j][2] * v[j][2] + v[j][3] * v[j][3]); }
    ss = wave_sum(ss, lane); const float rs = 1.0f / sqrtf(ss * (1.0f / DLRU) + EPS);
    u32x2* o = (u32x2*)(ymix + (size_t)row * D) + lane;
#pragma unroll
    for (int j = 0; j < 4; ++j) { const f32x4 g = gr[64 * j]; u32x2 w; w.x = pk2(v[j][0] * rs * g[0], v[j][1] * rs * g[1]); w.y = pk2(v[j][2] * rs * g[2], v[j][3] * rs * g[3]); o[64 * j] = w; }
}
__device__ __forceinline__ void dn_prep_item(const bf16* proj, const float* cw, const float* ba, const float* a_log, const float* dt_bias, float* qn, float* kn, float* vn, float* beta, float* gg, int w, int lane) {
    const int t = w >> 3, h = w & 7, s = t % SEQ;
    float val[3][2];
#pragma unroll
    for (int p = 0; p < 3; ++p)
#pragma unroll
        for (int e = 0; e < 2; ++e) { const int d = lane * 2 + e, c = p * DDN + h * HD + d; float a = 0.f;
#pragma unroll
            for (int k = 0; k < 4; ++k) { const int sp = s - 3 + k; if (sp >= 0) a += cw[k * 3 * DDN + c] * bf2f(proj[(size_t)(t - 3 + k) * NPROJ + 2048 + c]); }
            val[p][e] = silu_f(a); }
    const float sq = wave_sum(val[0][0] * val[0][0] + val[0][1] * val[0][1], lane), sk = wave_sum(val[1][0] * val[1][0] + val[1][1] * val[1][1], lane);
    const float rq = (1.0f / sqrtf(sq + EPS)) * 0.08838834764831845f, rk = 1.0f / sqrtf(sk + EPS);
    const size_t o = ((size_t)t * NH + h) * HD + lane * 2;
    qn[o] = val[0][0] * rq; qn[o + 1] = val[0][1] * rq; kn[o] = val[1][0] * rk; kn[o + 1] = val[1][1] * rk; vn[o] = val[2][0]; vn[o + 1] = val[2][1];
    if (lane == 0) { beta[t * NH + h] = sigmoid_f(ba[(size_t)t * 16 + h]); gg[t * NH + h] = -__expf(a_log[h]) * softplus_f(ba[(size_t)t * 16 + 8 + h] + dt_bias[h]); }
}
__device__ __forceinline__ void dn_rec_seq(const float* qn, const float* kn, const float* vn, const float* beta, const float* gg, float* o, int bh, LAS float* sk, LAS float* sq, LAS float* st, int tid) {
    const int b = bh >> 3, h = bh & 7, j = tid & 127; const bool act = tid < 128;
    if (act) for (int k = 0; k < 128; ++k) st[k * 128 + j] = 0.f;
    const size_t base = ((size_t)(b * SEQ) * NH + h) * HD;
    float nk = kn[base + j], nq = qn[base + j], nv = vn[base + j], nb = beta[(b * SEQ) * NH + h], ng = gg[(b * SEQ) * NH + h];
    for (int s = 0; s < SEQ; ++s) {
        const int buf = (s & 1) * 128;
        if (act) { sk[buf + j] = nk; sq[buf + j] = nq; }
        const float vj = nv, be = nb, ge = __expf(ng);
        __syncthreads();
        if (act) {
            if (s + 1 < SEQ) { const size_t nb_ = ((size_t)(b * SEQ + s + 1) * NH + h) * HD; nk = kn[nb_ + j]; nq = qn[nb_ + j]; nv = vn[nb_ + j]; nb = beta[(b * SEQ + s + 1) * NH + h]; ng = gg[(b * SEQ + s + 1) * NH + h]; }
            float ks = 0.f;
#pragma unroll 8
            for (int k = 0; k < 128; ++k) ks += sk[buf + k] * st[k * 128 + j];
            const float vnew = be * (vj - ge * ks);
            float oo = 0.f;
#pragma unroll 8
            for (int k = 0; k < 128; ++k) { const float sv = ge * st[k * 128 + j] + sk[buf + k] * vnew; st[k * 128 + j] = sv; oo += sq[buf + k] * sv; }
            o[((size_t)(b * SEQ + s) * NH + h) * HD + j] = oo;
        }
    }
    __syncthreads();
}
typedef short bf16x8 __attribute__((ext_vector_type(8)));
__device__ __forceinline__ f32x4 mfma16(bf16x8 a, bf16x8 b, f32x4 c) { return __builtin_amdgcn_mfma_f32_16x16x32_bf16(a, b, c, 0, 0, 0); }
__device__ __forceinline__ float bflo(unsigned x) { return __uint_as_float(x << 16); }
__device__ __forceinline__ float bfhi(unsigned x) { return __uint_as_float(x & 0xffff0000u); }
constexpr int DA_G = 0, DA_L = 1024, DA_KN = DA_L + 16384, DA_QN = DA_KN + 17408, DA_VBT = DA_QN + 17408, DA_KBET = DA_VBT + 18432, DA_KDT = DA_KBET + 18432, DA_TB = DA_KDT + 18432, DA_QK = DA_TB + 9216, DA_END = DA_QK + 9216;
static_assert(DA_END <= RING_BYTES, "DN-A LDS map");
#if defined(PROBE_DNA_A)
#define DNA_ST(k) do { if (threadIdx.x == 0) ((volatile LAS unsigned long long*)(lds + (RING_BYTES + 2048)))[k] = __builtin_amdgcn_s_memrealtime(); } while (0)
#else
#define DNA_ST(k) do { } while (0)
#endif
__device__ __forceinline__ void dna_unit(const bf16* proj, const float* cw, const float* ba, const float* a_log, const float* dt_bias,
                                         bf16* Wf, bf16* Qf, bf16* KdTf, bf16* QKf, bf16* Uf, float* glb, int uid, LAS unsigned char* lds, int tid, int lane, int wave) {
    const int h = uid & 7, n = (uid >> 3) & 127, b = uid >> 10, t0 = b * SEQ + n * 64;
    asm volatile("" : "+v"(lds));
    DNA_ST(0);
    LAS float* Gs = (LAS float*)(lds + DA_G);
    const int fr = lane & 15, fq = lane >> 4;
    if (wave == 0) {
        const size_t t = (size_t)(t0 + lane);
        const float be = sigmoid_f(ba[t * 16 + h]); float Gc = -__expf(a_log[h]) * softplus_f(ba[t * 16 + 8 + h] + dt_bias[h]);
#pragma unroll
        for (int off = 1; off < 64; off <<= 1) { const float tmp = shfl_up_l(Gc, off, lane); if (lane >= off) Gc += tmp; }
        const float GL = shfl_idx_l(Gc, 63);
        Gs[lane] = Gc; Gs[64 + lane] = be; Gs[128 + lane] = __expf(Gc); Gs[192 + lane] = __expf(GL - Gc);
        if (lane == 63) glb[uid] = __expf(Gc);
    }
    LDS_BARRIER();
    DNA_ST(1);
    {
        const int r = tid >> 3, cg = tid & 7;
        const float be = Gs[64 + r], eg = Gs[128 + r], egl = Gs[192 + r];
        float val[3][16];
#pragma unroll
        for (int p = 0; p < 3; ++p) {
            const int ccol = p * DDN + h * HD + cg * 16;
            float acc[16];
#pragma unroll
            for (int i = 0; i < 16; ++i) acc[i] = 0.f;
#pragma unroll
            for (int k = 0; k < 4; ++k) { const int row = r - 3 + k;
                if (n * 64 + row >= 0) {
                    const bf16* src = proj + (size_t)(t0 + row) * NPROJ + 2048 + ccol;
                    const u32x4 x0 = *(const u32x4*)src, x1 = *(const u32x4*)(src + 8);
                    const float* wp = cw + k * 3 * DDN + ccol;
                    const f32x4 w0 = *(const f32x4*)wp, w1 = *(const f32x4*)(wp + 4), w2 = *(const f32x4*)(wp + 8), w3 = *(const f32x4*)(wp + 12);
                    acc[0] += w0[0] * bflo(x0.x); acc[1] += w0[1] * bfhi(x0.x); acc[2] += w0[2] * bflo(x0.y); acc[3] += w0[3] * bfhi(x0.y);
                    acc[4] += w1[0] * bflo(x0.z); acc[5] += w1[1] * bfhi(x0.z); acc[6] += w1[2] * bflo(x0.w); acc[7] += w1[3] * bfhi(x0.w);
                    acc[8] += w2[0] * bflo(x1.x); acc[9] += w2[1] * bfhi(x1.x); acc[10] += w2[2] * bflo(x1.y); acc[11] += w2[3] * bfhi(x1.y);
                    acc[12] += w3[0] * bflo(x1.z); acc[13] += w3[1] * bfhi(x1.z); acc[14] += w3[2] * bflo(x1.w); acc[15] += w3[3] * bfhi(x1.w);
                } }
#pragma unroll
            for (int i = 0; i < 16; ++i) val[p][i] = silu_f(acc[i]);
        }
        float sq = 0.f, sk = 0.f;
#pragma unroll
        for (int i = 0; i < 16; ++i) { sq += val[0][i] * val[0][i]; sk += val[1][i] * val[1][i]; }
        sq += shfl_xor_l(sq, 1, lane); sq += shfl_xor_l(sq, 2, lane); sq += shfl_xor_l(sq, 4, lane);
        sk += shfl_xor_l(sk, 1, lane); sk += shfl_xor_l(sk, 2, lane); sk += shfl_xor_l(sk, 4, lane);
        const float rq = (1.0f / sqrtf(sq + EPS)) * 0.08838834764831845f, rk = 1.0f / sqrtf(sk + EPS);
#pragma unroll
        for (int i = 0; i < 16; ++i) { val[0][i] *= rq; val[1][i] *= rk; }
        u32x4 o0, o1;
        o0.x = pk2(val[1][0], val[1][1]); o0.y = pk2(val[1][2], val[1][3]); o0.z = pk2(val[1][4], val[1][5]); o0.w = pk2(val[1][6], val[1][7]);
        o1.x = pk2(val[1][8], val[1][9]); o1.y = pk2(val[1][10], val[1][11]); o1.z = pk2(val[1][12], val[1][13]); o1.w = pk2(val[1][14], val[1][15]);
        *(LAS u32x4*)(lds + DA_KN + r * 272 + cg * 32) = o0; *(LAS u32x4*)(lds + DA_KN + r * 272 + cg * 32 + 16) = o1;
        o0.x = pk2(val[0][0], val[0][1]); o0.y = pk2(val[0][2], val[0][3]); o0.z = pk2(val[0][4], val[0][5]); o0.w = pk2(val[0][6], val[0][7]);
        o1.x = pk2(val[0][8], val[0][9]); o1.y = pk2(val[0][10], val[0][11]); o1.z = pk2(val[0][12], val[0][13]); o1.w = pk2(val[0][14], val[0][15]);
        *(LAS u32x4*)(lds + DA_QN + r * 272 + cg * 32) = o0; *(LAS u32x4*)(lds + DA_QN + r * 272 + cg * 32 + 16) = o1;
#pragma unroll
        for (int i = 0; i < 16; ++i) { const int f = cg * 16 + i;
            *(LAS unsigned short*)(lds + DA_VBT + f * 144 + r * 2) = (unsigned short)f2bf(val[2][i] * be);
            *(LAS unsigned short*)(lds + DA_KBET + f * 144 + r * 2) = (unsigned short)f2bf(val[1][i] * (be * eg));
            *(LAS unsigned short*)(lds + DA_KDT + f * 144 + r * 2) = (unsigned short)f2bf(val[1][i] * egl); }
    }
    LDS_BARRIER();
    DNA_ST(2);
    {
        const int p = wave >> 2, ti = wave & 3;
        const int abase = p == 0 ? DA_KN : DA_QN;
        bf16x8 af[4];
#pragma unroll
        for (int ks = 0; ks < 4; ++ks) af[ks] = *(const LAS bf16x8*)(lds + abase + (ti * 16 + fr) * 272 + (ks * 32 + fq * 8) * 2);
        for (int tj = 0; tj < 4; ++tj) {
            f32x4 acc = {0.f, 0.f, 0.f, 0.f};
            if (tj <= ti) {
#pragma unroll
                for (int ks = 0; ks < 4; ++ks) { const bf16x8 bb = *(const LAS bf16x8*)(lds + DA_KN + (tj * 16 + fr) * 272 + (ks * 32 + fq * 8) * 2); acc = mfma16(af[ks], bb, acc); }
            }
            const int j = tj * 16 + fr; const float Gj = Gs[j];
#pragma unroll
            for (int r = 0; r < 4; ++r) { const int i = ti * 16 + fq * 4 + r; float v = 0.f;
                if (p == 0) { if (i > j) v = Gs[64 + i] * acc[r] * __expf(Gs[i] - Gj); *(LAS float*)(lds + DA_L + (j * 64 + i) * 4) = v; }
                else { if (i >= j) v = acc[r] * __expf(Gs[i] - Gj); *(LAS unsigned short*)(lds + DA_QK + i * 144 + j * 2) = (unsigned short)f2bf(v); } }
        }
    }
    LDS_BARRIER();
    DNA_ST(3);
    {
        int lc = lane; asm volatile("" : "+v"(lc)); const float fl = (float)lc;
        const int blk = wave < 4 ? wave : 11 - wave;
        float Tr[8];
#pragma unroll
        for (int c = 0; c < 8; ++c) Tr[c] = fmaxf(0.f, 1.f - fabsf(fl - (float)(blk * 8 + c)));
        float lj[63];
#pragma unroll
        for (int j = 0; j < 63; ++j) lj[j] = *(const LAS float*)(lds + DA_L + (j * 64) * 4 + lc * 4);
#pragma unroll
        for (int j = 0; j < 63; ++j) {
            if (j >= blk * 8) {
#pragma unroll
                for (int c = 0; c < 8; ++c) { const float tj = __int_as_float(__builtin_amdgcn_readlane(__float_as_int(Tr[c]), j)); Tr[c] -= lj[j] * tj; }
            }
        }
        u32x4 o; o.x = pk2(Tr[0], Tr[1]); o.y = pk2(Tr[2], Tr[3]); o.z = pk2(Tr[4], Tr[5]); o.w = pk2(Tr[6], Tr[7]);
        *(LAS u32x4*)(lds + DA_TB + lc * 144 + blk * 16) = o;
    }
    {
        for (int fi = wave; fi < 40; fi += 8) {
            if (fi < 8) { const int mt = fi >> 1, ks = fi & 1;
                const u32x4 v = *(const LAS u32x4*)(lds + DA_QK + (mt * 16 + fr) * 144 + (ks * 32 + fq * 8) * 2);
                *(u32x4*)(QKf + (((size_t)uid * 4 + mt) * 2 + ks) * 512 + lane * 8) = v; }
            else if (fi < 24) { const int f2 = fi - 8, mt = f2 >> 2, ks = f2 & 3; const float eg = Gs[128 + mt * 16 + fr];
                const u32x4 v = *(const LAS u32x4*)(lds + DA_QN + (mt * 16 + fr) * 272 + (ks * 32 + fq * 8) * 2); u32x4 o;
                o.x = pk2(bflo(v.x) * eg, bfhi(v.x) * eg); o.y = pk2(bflo(v.y) * eg, bfhi(v.y) * eg); o.z = pk2(bflo(v.z) * eg, bfhi(v.z) * eg); o.w = pk2(bflo(v.w) * eg, bfhi(v.w) * eg);
                *(u32x4*)(Qf + (((size_t)uid * 4 + mt) * 4 + ks) * 512 + lane * 8) = o; }
            else { const int f2 = fi - 24, ft = f2 >> 1, ks = f2 & 1;
                const u32x4 v = *(const LAS u32x4*)(lds + DA_KDT + (ft * 16 + fr) * 144 + (ks * 32 + fq * 8) * 2);
                *(u32x4*)(KdTf + (((size_t)uid * 8 + ft) * 2 + ks) * 512 + lane * 8) = v; }
        }
    }
    LDS_BARRIER();
    DNA_ST(4);
    {
        bf16x8 ta[4][2];
#pragma unroll
        for (int mt = 0; mt < 4; ++mt)
#pragma unroll
            for (int ks = 0; ks < 2; ++ks) ta[mt][ks] = *(const LAS bf16x8*)(lds + DA_TB + (mt * 16 + fr) * 144 + (ks * 32 + fq * 8) * 2);
#pragma unroll
        for (int c2 = 0; c2 < 2; ++c2) { const int ct = wave * 2 + c2, img = ct < 8 ? DA_VBT : DA_KBET, cr = (ct & 7) * 16 + fr;
            bf16x8 bb[2];
#pragma unroll
            for (int ks = 0; ks < 2; ++ks) bb[ks] = *(const LAS bf16x8*)(lds + img + cr * 144 + (ks * 32 + fq * 8) * 2);
#pragma unroll
            for (int mt = 0; mt < 4; ++mt) { f32x4 acc = {0.f, 0.f, 0.f, 0.f};
#pragma unroll
                for (int ks = 0; ks < 2; ++ks) acc = mfma16(ta[mt][ks], bb[ks], acc);
                if (ct < 8) { u32x2 o; o.x = pk2(acc[0], acc[1]); o.y = pk2(acc[2], acc[3]); *(u32x2*)(Uf + ((((size_t)uid * 8 + ct) * 4 + mt) * 64 + lane) * 4) = o; }
                else { const int f = (ct - 8) * 16 + fr;
#pragma unroll
                    for (int r = 0; r < 4; ++r) *(LAS unsigned short*)(lds + DA_KN + (mt * 16 + fq * 4 + r) * 272 + f * 2) = (unsigned short)f2bf(acc[r]); } }
        }
    }
    LDS_BARRIER();
    DNA_ST(5);
#pragma unroll
    for (int q2 = 0; q2 < 2; ++q2) { const int fi = wave * 2 + q2, mt = fi >> 2, ks = fi & 3;
        const u32x4 v = *(const LAS u32x4*)(lds + DA_KN + (mt * 16 + fr) * 272 + (ks * 32 + fq * 8) * 2);
        *(u32x4*)(Wf + (((size_t)uid * 4 + mt) * 4 + ks) * 512 + lane * 8) = v; }
    LDS_BARRIER();
    DNA_ST(6);
}
struct DnbFrag { bf16x8 a1[4]; bf16x8 a2[2]; bf16x8 kd[2]; u32x2 u; float gl; };
__device__ __forceinline__ DnbFrag dnb_load(const bf16* A1, const bf16* QKf, const bf16* KdTf, const bf16* Uf, const float* glb, int uid, int ds, int wave, int lane) {
    DnbFrag f; const int mt = wave & 3;
#pragma unroll
    for (int ks = 0; ks < 4; ++ks) f.a1[ks] = *(const bf16x8*)(A1 + (((size_t)uid * 4 + mt) * 4 + ks) * 512 + lane * 8);
#pragma unroll
    for (int ks = 0; ks < 2; ++ks) f.kd[ks] = *(const bf16x8*)(KdTf + (((size_t)uid * 8 + wave) * 2 + ks) * 512 + lane * 8);
#pragma unroll
    for (int ks = 0; ks < 2; ++ks) f.a2[ks] = *(const bf16x8*)(QKf + (((size_t)uid * 4 + mt) * 2 + ks) * 512 + lane * 8);
    f.u = *(const u32x2*)(Uf + ((((size_t)uid * 8 + ds) * 4 + mt) * 64 + lane) * 4);
    f.gl = glb[uid];
    return f;
}
__device__ __forceinline__ void dnb_run(const bf16* Wf, const bf16* Qf, const bf16* KdTf, const bf16* QKf, const bf16* Uf, const float* glb, float* o, int bh, int ds, LAS unsigned char* lds, int tid, int lane, int wave) {
    const int b = bh >> 3, h = bh & 7, fr = lane & 15, fq = lane >> 4, mt = wave & 3;
    asm volatile("" : "+v"(lds));
    LAS unsigned char* ST = lds; LAS unsigned char* VNT = lds + 4608;
    for (int i = tid; i < 4608 / 4; i += 512) ((LAS unsigned*)ST)[i] = 0u;
    f32x4 accS = {0.f, 0.f, 0.f, 0.f};
    const bf16* A1 = wave < 4 ? Wf : Qf;
    DnbFrag f0 = dnb_load(A1, QKf, KdTf, Uf, glb, (b * 128 + 0) * 8 + h, ds, wave, lane), f1 = dnb_load(A1, QKf, KdTf, Uf, glb, (b * 128 + 1) * 8 + h, ds, wave, lane);
    DnbFrag f2 = dnb_load(A1, QKf, KdTf, Uf, glb, (b * 128 + 2) * 8 + h, ds, wave, lane), f3 = dnb_load(A1, QKf, KdTf, Uf, glb, (b * 128 + 3) * 8 + h, ds, wave, lane);
    __syncthreads();
#define DNB_STEP(F, nn) do { const int n = (nn); \
        f32x4 acc = {0.f, 0.f, 0.f, 0.f}; \
        _Pragma("unroll") for (int ks = 0; ks < 4; ++ks) { const bf16x8 sb = *(const LAS bf16x8*)(ST + fr * 272 + (ks * 32 + fq * 8) * 2); acc = mfma16(F.a1[ks], sb, acc); } \
        if (wave < 4) { const float v0 = bflo(F.u.x) - acc[0], v1 = bfhi(F.u.x) - acc[1], v2 = bflo(F.u.y) - acc[2], v3 = bfhi(F.u.y) - acc[3]; \
            u32x2 w; w.x = pk2(v0, v1); w.y = pk2(v2, v3); *(LAS u32x2*)(VNT + fr * 144 + (mt * 16 + fq * 4) * 2) = w; } \
        LDS_BARRIER(); \
        bf16x8 vb[2]; \
        _Pragma("unroll") for (int ks = 0; ks < 2; ++ks) vb[ks] = *(const LAS bf16x8*)(VNT + fr * 144 + (ks * 32 + fq * 8) * 2); \
        if (wave >= 4) { _Pragma("unroll") for (int ks = 0; ks < 2; ++ks) acc = mfma16(F.a2[ks], vb[ks], acc); \
            const size_t ob = ((size_t)(b * SEQ + n * 64 + mt * 16 + fq * 4) * NH + h) * HD + ds * 16 + fr; \
            _Pragma("unroll") for (int r = 0; r < 4; ++r) o[ob + (size_t)r * NH * HD] = acc[r]; } \
        accS = accS * F.gl; \
        _Pragma("unroll") for (int ks = 0; ks < 2; ++ks) accS = mfma16(F.kd[ks], vb[ks], accS); \
        { u32x2 w; w.x = pk2(accS[0], accS[1]); w.y = pk2(accS[2], accS[3]); *(LAS u32x2*)(ST + fr * 272 + (wave * 16 + fq * 4) * 2) = w; } \
        F = dnb_load(A1, QKf, KdTf, Uf, glb, (b * 128 + (n + 4 < 128 ? n + 4 : 127)) * 8 + h, ds, wave, lane);     \
        LDS_BARRIER(); } while (0)
    for (int n4 = 0; n4 < 128; n4 += 16) {
        DNB_STEP(f0, n4); DNB_STEP(f1, n4 + 1); DNB_STEP(f2, n4 + 2); DNB_STEP(f3, n4 + 3); DNB_STEP(f0, n4 + 4); DNB_STEP(f1, n4 + 5); DNB_STEP(f2, n4 + 6); DNB_STEP(f3, n4 + 7);
        DNB_STEP(f0, n4 + 8); DNB_STEP(f1, n4 + 9); DNB_STEP(f2, n4 + 10); DNB_STEP(f3, n4 + 11); DNB_STEP(f0, n4 + 12); DNB_STEP(f1, n4 + 13); DNB_STEP(f2, n4 + 14); DNB_STEP(f3, n4 + 15); }
#undef DNB_STEP
}
constexpr int LA_XB = 0, LA_XF = 17408, LA_END = LA_XF + 64 * 132 * 4;
static_assert(LA_END <= RING_BYTES, "LRU-A LDS map");
__device__ __forceinline__ void lrua_unit(const bf16* proj, const float* cw, const float* cb, const bf16* WrT, const bf16* WiT, const float* b_r, const float* b_i, const float* lam,
                                          float* Hloc, float* Acum, float* summ, int unit, LAS unsigned char* lds, int tid, int lane, int wave) {
    const int nb = unit & 7, ct = unit >> 3, n = ct & 127, t0 = ct * 64;
    asm volatile("" : "+v"(lds));
    {
        const int r = tid >> 3, cg = tid & 7, ch0 = nb * 128 + cg * 16;
        float acc[16];
        { const f32x4 c0v = *(const f32x4*)(cb + ch0), c1v = *(const f32x4*)(cb + ch0 + 4), c2v = *(const f32x4*)(cb + ch0 + 8), c3v = *(const f32x4*)(cb + ch0 + 12);
#pragma unroll
          for (int i = 0; i < 4; ++i) { acc[i] = c0v[i]; acc[4 + i] = c1v[i]; acc[8 + i] = c2v[i]; acc[12 + i] = c3v[i]; } }
#pragma unroll
        for (int k = 0; k < 4; ++k) { const int row = r - 3 + k;
            if (n * 64 + row >= 0) {
                const bf16* src = proj + (size_t)(t0 + row) * NPROJ + ch0;
                const u32x4 x0 = *(const u32x4*)src, x1 = *(const u32x4*)(src + 8);
                const float* wp = cw + k * DLRU + ch0;
                const f32x4 w0 = *(const f32x4*)wp, w1 = *(const f32x4*)(wp + 4), w2 = *(const f32x4*)(wp + 8), w3 = *(const f32x4*)(wp + 12);
                acc[0] += w0[0] * bflo(x0.x); acc[1] += w0[1] * bfhi(x0.x); acc[2] += w0[2] * bflo(x0.y); acc[3] += w0[3] * bfhi(x0.y);
                acc[4] += w1[0] * bflo(x0.z); acc[5] += w1[1] * bfhi(x0.z); acc[6] += w1[2] * bflo(x0.w); acc[7] += w1[3] * bfhi(x0.w);
                acc[8] += w2[0] * bflo(x1.x); acc[9] += w2[1] * bfhi(x1.x); acc[10] += w2[2] * bflo(x1.y); acc[11] += w2[3] * bfhi(x1.y);
                acc[12] += w3[0] * bflo(x1.z); acc[13] += w3[1] * bfhi(x1.z); acc[14] += w3[2] * bflo(x1.w); acc[15] += w3[3] * bfhi(x1.w);
            } }
        u32x4 o0, o1;
        o0.x = pk2(acc[0], acc[1]); o0.y = pk2(acc[2], acc[3]); o0.z = pk2(acc[4], acc[5]); o0.w = pk2(acc[6], acc[7]);
        o1.x = pk2(acc[8], acc[9]); o1.y = pk2(acc[10], acc[11]); o1.z = pk2(acc[12], acc[13]); o1.w = pk2(acc[14], acc[15]);
        *(LAS u32x4*)(lds + LA_XB + r * 272 + cg * 32) = o0; *(LAS u32x4*)(lds + LA_XB + r * 272 + cg * 32 + 16) = o1;
        LAS f32x4* xf = (LAS f32x4*)(lds + LA_XF + (r * 132 + cg * 16) * 4);
        xf[0] = (f32x4){acc[0], acc[1], acc[2], acc[3]}; xf[1] = (f32x4){acc[4], acc[5], acc[6], acc[7]}; xf[2] = (f32x4){acc[8], acc[9], acc[10], acc[11]}; xf[3] = (f32x4){acc[12], acc[13], acc[14], acc[15]};
    }
    LDS_BARRIER();
    const int fr = lane & 15, fq = lane >> 4, cl = wave * 16 + fr, ch = nb * 128 + cl;
    bf16x8 br[4], bi[4];
#pragma unroll
    for (int ks = 0; ks < 4; ++ks) { br[ks] = *(const bf16x8*)(WrT + ((size_t)nb * 128 + cl) * 128 + ks * 32 + fq * 8); bi[ks] = *(const bf16x8*)(WiT + ((size_t)nb * 128 + cl) * 128 + ks * 32 + fq * 8); }
    f32x4 ar[4], ai[4];
#pragma unroll
    for (int mt = 0; mt < 4; ++mt) { ar[mt] = (f32x4){0.f, 0.f, 0.f, 0.f}; ai[mt] = (f32x4){0.f, 0.f, 0.f, 0.f};
#pragma unroll
        for (int ks = 0; ks < 4; ++ks) { const bf16x8 af = *(const LAS bf16x8*)(lds + LA_XB + (mt * 16 + fr) * 272 + (ks * 32 + fq * 8) * 2); ar[mt] = mfma16(af, br[ks], ar[mt]); ai[mt] = mfma16(af, bi[ks], ai[mt]); } }
    const float brr = b_r[ch], bii = b_i[ch], sp8 = -8.0f * softplus_f(-lam[ch]);
    float Ac = 1.f, Bc = 0.f;
#pragma unroll
    for (int mt = 0; mt < 4; ++mt) {
        float P[4], H[4];
#pragma unroll
        for (int r = 0; r < 4; ++r) { const int t = mt * 16 + fq * 4 + r; const float xcv = *(const LAS float*)(lds + LA_XF + (t * 132 + cl) * 4);
            const float rr = sigmoid_f(ar[mt][r] + brr), ii = sigmoid_f(ai[mt][r] + bii), la = sp8 * rr, a = __expf(la), bb = sqrtf(fmaxf(1.0f - a * a, 0.0f)) * (ii * xcv);
            if (r == 0) { P[0] = a; H[0] = bb; } else { P[r] = P[r - 1] * a; H[r] = a * H[r - 1] + bb; } }
        float Ai = P[3], Bi = H[3];
        { const float Au = shfl_up_l(Ai, 16, lane), Bu = shfl_up_l(Bi, 16, lane); if (fq >= 1) { Bi = Ai * Bu + Bi; Ai = Au * Ai; } }
        { const float Au = shfl_up_l(Ai, 32, lane), Bu = shfl_up_l(Bi, 32, lane); if (fq >= 2) { Bi = Ai * Bu + Bi; Ai = Au * Ai; } }
        float Ae = shfl_up_l(Ai, 16, lane), Be = shfl_up_l(Bi, 16, lane); if (fq == 0) { Ae = 1.f; Be = 0.f; }
        const float At = shfl_idx_l(Ai, 48 + fr), Bt = shfl_idx_l(Bi, 48 + fr);
        const float PA = Ac * Ae, PB = Ae * Bc + Be;
#pragma unroll
        for (int r = 0; r < 4; ++r) { const size_t o = (size_t)(t0 + mt * 16 + fq * 4 + r) * DLRU + ch; Acum[o] = PA * P[r]; Hloc[o] = P[r] * PB + H[r]; }
        Bc = At * Bc + Bt; Ac = Ac * At;
    }
    if (fq == 0) { float* sp = summ + ((size_t)ct * DLRU + ch) * 2; sp[0] = Ac; sp[1] = Bc; }
    LDS_BARRIER();
}
__device__ __forceinline__ void lru_carry(const float* summ, float* carry, int idx) {
    const int b = idx >> 10, ch = idx & 1023; float c = 0.f;
    for (int n0 = 0; n0 < 128; n0 += 8) { float A[8], B[8];
#pragma unroll
        for (int j = 0; j < 8; ++j) { const float* sp = summ + ((size_t)(b * 128 + n0 + j) * DLRU + ch) * 2; A[j] = sp[0]; B[j] = sp[1]; }
#pragma unroll
        for (int j = 0; j < 8; ++j) { carry[(size_t)(b * 128 + n0 + j) * DLRU + ch] = c; c = A[j] * c + B[j]; } }
}
__device__ __forceinline__ void lrub_row(const float* Hloc, const float* Acum, const float* carry, const bf16* proj, const float* gain, bf16* ymix, int row, int lane) {
    const int ct = row >> 6; f32x4 y[4]; float ss = 0.f;
#pragma unroll
    for (int j = 0; j < 4; ++j) { const int c4 = lane * 4 + 256 * j;
        const f32x4 hl = *(const f32x4*)(Hloc + (size_t)row * DLRU + c4), ac = *(const f32x4*)(Acum + (size_t)row * DLRU + c4), cr = *(const f32x4*)(carry + (size_t)ct * DLRU + c4);
        const u32x2 g = *(const u32x2*)(proj + (size_t)row * NPROJ + DLRU + c4);
        const f32x4 hh = hl + ac * cr;
        y[j][0] = hh[0] * gelu_tanh_f(bflo(g.x)); y[j][1] = hh[1] * gelu_tanh_f(bfhi(g.x)); y[j][2] = hh[2] * gelu_tanh_f(bflo(g.y)); y[j][3] = hh[3] * gelu_tanh_f(bfhi(g.y));
        ss += (y[j][0] * y[j][0] + y[j][1] * y[j][1]) + (y[j][2] * y[j][2] + y[j][3] * y[j][3]); }
    ss = wave_sum(ss, lane); const float rs = 1.0f / sqrtf(ss * (1.0f / DLRU) + EPS);
#pragma unroll
    for (int j = 0; j < 4; ++j) { const int c4 = lane * 4 + 256 * j; const f32x4 g = *(const f32x4*)(gain + c4); u32x2 w; w.x = pk2(y[j][0] * rs * g[0], y[j][1] * rs * g[1]); w.y = pk2(y[j][2] * rs * g[2], y[j][3] * rs * g[3]);
        *(u32x2*)(ymix + (size_t)row * D + c4) = w; }
}
__device__ __forceinline__ void dn_out_row(const float* o, const float* gain, const bf16* proj, bf16* ymix, int t, int lane) {
    const int c = lane * 16;
    const f32x4* op = (const f32x4*)(o + (size_t)t * DDN + c); const f32x4 o0 = op[0], o1 = op[1], o2 = op[2], o3 = op[3];
    const u32x4* gp = (const u32x4*)(proj + (size_t)t * NPROJ + 5120 + c); const u32x4 g0 = gp[0], g1 = gp[1];
    const f32x4* wp = (const f32x4*)(gain + (c & 127)); const f32x4 w0 = wp[0], w1 = wp[1], w2 = wp[2], w3 = wp[3];
    float ss = (o0[0] * o0[0] + o0[1] * o0[1]) + (o0[2] * o0[2] + o0[3] * o0[3]) + (o1[0] * o1[0] + o1[1] * o1[1]) + (o1[2] * o1[2] + o1[3] * o1[3])
             + (o2[0] * o2[0] + o2[1] * o2[1]) + (o2[2] * o2[2] + o2[3] * o2[3]) + (o3[0] * o3[0] + o3[1] * o3[1]) + (o3[2] * o3[2] + o3[3] * o3[3]);
    ss += shfl_xor_l(ss, 1, lane); ss += shfl_xor_l(ss, 2, lane); ss += shfl_xor_l(ss, 4, lane);
    const float rs = 1.0f / sqrtf(ss * (1.0f / HD) + EPS);
    u32x4 r0, r1;
    r0.x = pk2(o0[0] * rs * w0[0] * silu_f(bflo(g0.x)), o0[1] * rs * w0[1] * silu_f(bfhi(g0.x))); r0.y = pk2(o0[2] * rs * w0[2] * silu_f(bflo(g0.y)), o0[3] * rs * w0[3] * silu_f(bfhi(g0.y)));
    r0.z = pk2(o1[0] * rs * w1[0] * silu_f(bflo(g0.z)), o1[1] * rs * w1[1] * silu_f(bfhi(g0.z))); r0.w = pk2(o1[2] * rs * w1[2] * silu_f(bflo(g0.w)), o1[3] * rs * w1[3] * silu_f(bfhi(g0.w)));
    r1.x = pk2(o2[0] * rs * w2[0] * silu_f(bflo(g1.x)), o2[1] * rs * w2[1] * silu_f(bfhi(g1.x))); r1.y = pk2(o2[2] * rs * w2[2] * silu_f(bflo(g1.y)), o2[3] * rs * w2[3] * silu_f(bfhi(g1.y)));
    r1.z = pk2(o3[0] * rs * w3[0] * silu_f(bflo(g1.z)), o3[1] * rs * w3[1] * silu_f(bfhi(g1.z))); r1.w = pk2(o3[2] * rs * w3[2] * silu_f(bflo(g1.w)), o3[3] * rs * w3[3] * silu_f(bfhi(g1.w)));
    u32x4* dst = (u32x4*)(ymix + (size_t)t * D + DLRU + c); dst[0] = r0; dst[1] = r1;
}
__device__ __forceinline__ void route_row(const float* x, const float* rstd, const float* gain, const float* router, float* roww, int row, int lane) {
    float acc[8];
#pragma unroll
    for (int e = 0; e < 8; ++e) acc[e] = 0.f;
    for (int j = 0; j < 32; ++j) { const int k = lane + 64 * j; const float xv = x[(size_t)row * D + k] * gain[k]; const f32x4 r0 = *(const f32x4*)(router + (size_t)k * 8), r1 = *(const f32x4*)(router + (size_t)k * 8 + 4);
        acc[0] += xv * r0[0]; acc[1] += xv * r0[1]; acc[2] += xv * r0[2]; acc[3] += xv * r0[3]; acc[4] += xv * r1[0]; acc[5] += xv * r1[1]; acc[6] += xv * r1[2]; acc[7] += xv * r1[3]; }
    const float rs = rstd[row];
#pragma unroll
    for (int e = 0; e < 8; ++e) acc[e] = wave_sum(acc[e], lane) * rs;
    int e1 = 0; float l1 = acc[0];
#pragma unroll
    for (int e = 1; e < 8; ++e) if (acc[e] > l1) { l1 = acc[e]; e1 = e; }
    int e2 = -1; float l2 = -3.4e38f;
#pragma unroll
    for (int e = 0; e < 8; ++e) if (e != e1 && acc[e] > l2) { l2 = acc[e]; e2 = e; }
    const float w1 = 1.0f / (1.0f + __expf(l2 - l1)), w2 = 1.0f - w1;
    if (lane < 8) roww[(size_t)lane * T + row] = lane == e1 ? w1 : (lane == e2 ? w2 : 0.0f);
}
__device__ __forceinline__ void final_row(const float* x, const float* gain, float* out, int row, int lane) {
    const f32x4* xr = (const f32x4*)(x + (size_t)row * D) + lane; const f32x4* gr = (const f32x4*)gain + lane;
    f32x4 v[8]; float ss = 0.f;
#pragma unroll
    for (int j = 0; j < 8; ++j) { v[j] = xr[64 * j]; ss += (v[j][0] * v[j][0] + v[j][1] * v[j][1]) + (v[j][2] * v[j][2] + v[j][3] * v[j][3]); }
    ss = wave_sum(ss, lane); const float rs = 1.0f / sqrtf(ss * (1.0f / D) + EPS);
    f32x4* o = (f32x4*)(out + (size_t)row * D) + lane;
#pragma unroll
    for (int j = 0; j < 8; ++j) o[64 * j] = v[j] * rs * gr[64 * j];
}

struct MoeOrder {
    const int* list; int nN, G, c; int c0, c1, c2, c3, c4, c5, c6, c7;
    __device__ __forceinline__ void init(const unsigned* cnt, const int* list_, int nN_, int G_, int c_) { list = list_; nN = nN_; G = G_; c = c_;
        c0 = __builtin_amdgcn_readfirstlane((int)cnt[0]); c1 = __builtin_amdgcn_readfirstlane((int)cnt[1]); c2 = __builtin_amdgcn_readfirstlane((int)cnt[2]); c3 = __builtin_amdgcn_readfirstlane((int)cnt[3]);
        c4 = __builtin_amdgcn_readfirstlane((int)cnt[4]); c5 = __builtin_amdgcn_readfirstlane((int)cnt[5]); c6 = __builtin_amdgcn_readfirstlane((int)cnt[6]); c7 = __builtin_amdgcn_readfirstlane((int)cnt[7]); }
    __device__ __forceinline__ bool next(int i, pg8::Unit& u) const {
        const int c8[8] = {c0, c1, c2, c3, c4, c5, c6, c7}; int nM = 0;
#pragma unroll
        for (int k = 0; k < 8; ++k) nM += (c8[k] + 255) >> 8;
        const int nwg = nM * nN; const long L = (long)i * G + c; if (L >= nwg) return false;
        int wgid = (int)L; { const int q = nwg / pg8::NXCD, r = nwg % pg8::NXCD, xcd = wgid % pg8::NXCD, off = wgid / pg8::NXCD; wgid = (xcd < r ? xcd * (q + 1) : r * (q + 1) + (xcd - r) * q) + off; }
        const int nig = pg8::WGM * nN, gid = wgid / nig, fm = gid * pg8::WGM, gsz = (nM - fm) < pg8::WGM ? (nM - fm) : pg8::WGM;
        u.pm = fm + ((wgid % nig) % gsz); u.pn = (wgid % nig) / gsz;
        int e = 0, ps = 0, ce = c8[0], run = 0;
#pragma unroll
        for (int k = 0; k < 8; ++k) { const int mk = (c8[k] + 255) >> 8; if (u.pm >= run && u.pm < run + mk) { e = k; ps = run; ce = c8[k]; } run += mk; }
        const int mtl = u.pm - ps; u.pb = e * nN + u.pn; u.lbase = e * T + mtl * 256; u.nvalid = (ce - mtl * 256) < 256 ? (ce - mtl * 256) : 256;
        return true;
    }
    __device__ __forceinline__ int arow(const pg8::Unit& u, int r) const { return r < u.nvalid ? (list[u.lbase + r] & 0xffff) : 0; }
    __device__ __forceinline__ void a_ready(const pg8::Unit&) const {}
    __device__ __forceinline__ void done(const pg8::Unit&) const {}
};
__device__ __forceinline__ void route_block(const float* x, const float* gain, const float* router, bf16* xb, float* rstd, unsigned* cnt, int* list, float* listw, int blk, LAS unsigned char* lds, int tid, int lane, int wave) {
    asm volatile("" : "+v"(lds));
    LAS float* grt = (LAS float*)lds; LAS int* se1 = (LAS int*)(lds + 65536); LAS int* se2 = se1 + 64; LAS float* sw1 = (LAS float*)(se2 + 64); LAS float* sw2 = sw1 + 64; LAS int* lcnt = (LAS int*)(sw2 + 64); LAS int* gbase = lcnt + 8;
    for (int i = tid; i < D * 8; i += 512) grt[i] = router[i] * gain[i >> 3];
    if (tid < 8) lcnt[tid] = 0;
    __syncthreads();
    for (int q = 0; q < 8; ++q) { const int rloc = wave * 8 + q, row = blk * 64 + rloc;
        const f32x4* xr = (const f32x4*)(x + (size_t)row * D) + lane;
        f32x4 v[8]; float ss = 0.f;
#pragma unroll
        for (int j = 0; j < 8; ++j) { v[j] = xr[64 * j]; ss += (v[j][0] * v[j][0] + v[j][1] * v[j][1]) + (v[j][2] * v[j][2] + v[j][3] * v[j][3]); }
        ss = wave_sum(ss, lane); const float rs = 1.0f / sqrtf(ss * (1.0f / D) + EPS);
        u32x2* o = (u32x2*)(xb + (size_t)row * D) + lane;
#pragma unroll
        for (int j = 0; j < 8; ++j) { u32x2 w; w.x = pk2(v[j][0], v[j][1]); w.y = pk2(v[j][2], v[j][3]); o[64 * j] = w; }
        if (lane == 0) rstd[row] = rs;
        float acc[8];
#pragma unroll
        for (int e = 0; e < 8; ++e) acc[e] = 0.f;
#pragma unroll
        for (int j = 0; j < 8; ++j)
#pragma unroll
            for (int c = 0; c < 4; ++c) { const int k = (lane + 64 * j) * 4 + c; const f32x4 r0 = *(const LAS f32x4*)(grt + k * 8), r1 = *(const LAS f32x4*)(grt + k * 8 + 4); const float xv = v[j][c];
                acc[0] += xv * r0[0]; acc[1] += xv * r0[1]; acc[2] += xv * r0[2]; acc[3] += xv * r0[3]; acc[4] += xv * r1[0]; acc[5] += xv * r1[1]; acc[6] += xv * r1[2]; acc[7] += xv * r1[3]; }
#pragma unroll
        for (int e = 0; e < 8; ++e) acc[e] = wave_sum(acc[e], lane) * rs;
        int e1 = 0; float l1 = acc[0];
#pragma unroll
        for (int e = 1; e < 8; ++e) if (acc[e] > l1) { l1 = acc[e]; e1 = e; }
        int e2 = -1; float l2 = -3.4e38f;
#pragma unroll
        for (int e = 0; e < 8; ++e) if (e != e1 && acc[e] > l2) { l2 = acc[e]; e2 = e; }
        const float w1 = 1.0f / (1.0f + __expf(l2 - l1));
        if (lane == 0) { se1[rloc] = e1; se2[rloc] = e2; sw1[rloc] = w1; sw2[rloc] = 1.0f - w1; }
    }
    __syncthreads();
    int e = 0, lr = 0; float w = 0.f;
    if (tid < 128) { const int rloc = tid >> 1, j = tid & 1; e = j ? se2[rloc] : se1[rloc]; w = j ? sw2[rloc] : sw1[rloc]; lr = __hip_atomic_fetch_add(lcnt + e, 1, __ATOMIC_RELAXED, __HIP_MEMORY_SCOPE_WORKGROUP); }
    __syncthreads();
    if (tid < 8) gbase[tid] = (int)__hip_atomic_fetch_add(cnt + tid, (unsigned)lcnt[tid], __ATOMIC_RELAXED, __HIP_MEMORY_SCOPE_AGENT);
    __syncthreads();
    if (tid < 128) { const int pos = gbase[e] + lr, tok = blk * 64 + (tid >> 1); list[e * T + pos] = tok | ((tid & 1) << 16); listw[e * T + pos] = w; }
    __syncthreads();
}
__device__ __forceinline__ void final_row_moe(const float* x, const bf16* y0, const bf16* y1, const float* gain, float* out, int row, int lane) {
    const f32x4* xr = (const f32x4*)(x + (size_t)row * D) + lane; const f32x4* gr = (const f32x4*)gain + lane;
    const u32x2* p0 = (const u32x2*)(y0 + (size_t)row * D) + lane; const u32x2* p1 = (const u32x2*)(y1 + (size_t)row * D) + lane;
    f32x4 v[8]; float ss = 0.f;
#pragma unroll
    for (int j = 0; j < 8; ++j) { v[j] = xr[64 * j]; const u32x2 a = p0[64 * j], b = p1[64 * j];
        v[j][0] += bflo(a.x) + bflo(b.x); v[j][1] += bfhi(a.x) + bfhi(b.x); v[j][2] += bflo(a.y) + bflo(b.y); v[j][3] += bfhi(a.y) + bfhi(b.y);
        ss += (v[j][0] * v[j][0] + v[j][1] * v[j][1]) + (v[j][2] * v[j][2] + v[j][3] * v[j][3]); }
    ss = wave_sum(ss, lane); const float rs = 1.0f / sqrtf(ss * (1.0f / D) + EPS);
    f32x4* o = (f32x4*)(out + (size_t)row * D) + lane;
#pragma unroll
    for (int j = 0; j < 8; ++j) o[64 * j] = v[j] * rs * gr[64 * j];
}
__device__ __forceinline__ void ba_tail(const bf16* xbp, const bf16* wbab, const float* ssq, float* bap, int rb, int wave, int lane) {
    if (wave < 4) { const int fr = lane & 15, fq = lane >> 4, r0 = rb * 64 + wave * 16;
        const bf16* ap = xbp + (size_t)(r0 + fr) * D + fq * 8; const bf16* bp = wbab + (size_t)fr * D + fq * 8;
        f32x4 acc = {0.f, 0.f, 0.f, 0.f};
#pragma unroll 16
        for (int ks = 0; ks < 64; ++ks) { const bf16x8 a = *(const bf16x8*)(ap + ks * 32), b = *(const bf16x8*)(bp + ks * 32); acc = mfma16(a, b, acc); }
#pragma unroll
        for (int rr = 0; rr < 4; ++rr) { const int r = r0 + fq * 4 + rr; bap[(size_t)r * 16 + fr] = acc[rr] * pg8::row_scale(ssq, r, 1); } }
}
struct Args { const float* in[25]; float* out; unsigned char* ws; int ph_lo, ph_hi; };
typedef const __attribute__((address_space(4))) unsigned long long* kaptr_t;
__device__ __forceinline__ unsigned long long ldka(int i) { kaptr_t ka = (kaptr_t)__builtin_amdgcn_kernarg_segment_ptr(); asm volatile("" : "+s"(i)); return ka[i]; }
__device__ __forceinline__ const float* ldin(const Args&, int i) { return (const float*)(const GAS float*)ldka(i); }
__device__ __forceinline__ unsigned char* ldws(const Args&) { return (unsigned char*)(GAS unsigned char*)ldka(26); }
__device__ __forceinline__ float* ldout(const Args&) { return (float*)(GAS float*)ldka(25); }
__global__ void __launch_bounds__(512, 2) mega(Args args) {
    extern __shared__ __attribute__((aligned(16))) unsigned char lds_raw[];
    LAS unsigned char* lds = (LAS unsigned char*)lds_raw;
    volatile LAS unsigned* MISC = (volatile LAS unsigned*)(lds + MISC_OFF);
    const int tid = threadIdx.x;
    const int G = gridDim.x, bid = blockIdx.x, NGW = G * 8;
    unsigned char* ws = ldws(args);
    for (int u = tid; u < (LDS_BYTES - LDSCTL_OFF) / 4; u += 512) ((LAS unsigned*)(lds + LDSCTL_OFF))[u] = 0u;
    __syncthreads();
    (void)xcd_barrier_post((unsigned*)(ws + WS_CTL) + CW_BAR, MISC + 8);
#define RUN(id) true
#if defined(PROBE_MASK)
#define STAMP() do { if (threadIdx.x == 0) { ((volatile LAS unsigned long long*)(lds + LDSCTL_OFF + 1024))[nst] = __builtin_amdgcn_s_memrealtime(); } ++nst; } while (0)
#else
#define STAMP() do { } while (0)
#endif
#define SEAM(id) do { XcdBarrier bar_; bar_.bar = (unsigned*)WSP(WS_CTL) + CW_BAR; bar_.x = xb_xcc_id(); bar_.st = (volatile LAS unsigned*)(lds + MISC_OFF) + 8; xcd_barrier(bar_); STAMP(); } while (0)
#if defined(PROBE_MASK)
    int nst = 0; STAMP();
#endif
#define INP(i) ldin(args, (i))
#define WSP(off) (ldws(args) + (off))
#define x_in INP(0)
#define norm_mix INP(1)
#define w_in INP(2)
#define conv_lru_w INP(3)
#define conv_lru_b INP(4)
#define lru_w_r INP(5)
#define lru_b_r INP(6)
#define lru_w_i INP(7)
#define lru_b_i INP(8)
#define lru_lambda INP(9)
#define lru_out_norm INP(10)
#define conv_qkv_w INP(11)
#define dn_a_log INP(12)
#define dn_dt_bias INP(13)
#define dn_out_norm INP(14)
#define w_out INP(15)
#define norm_ffn INP(16)
#define ffn_w_gate INP(17)
#define ffn_w_up INP(18)
#define ffn_w_down INP(19)
#define moe_router INP(20)
#define moe_w_gate INP(21)
#define moe_w_up INP(22)
#define moe_w_down INP(23)
#define norm_final INP(24)
#define xres (ldout(args))
#define Win ((bf16*)WSP(WS_WIN))
#define Wba ((float*)WSP(WS_WBA))
#define Wout ((bf16*)WSP(WS_WOUT))
#define Wgu ((bf16*)WSP(WS_WGU))
#define Wd ((bf16*)WSP(WS_WD))
#define Mgu ((bf16*)WSP(WS_C))
#define Md ((bf16*)WSP(WS_WGU))
#define MCNT ((unsigned*)WSP(WS_CTL) + CW_CNT)
#define MLIST ((int*)WSP(WS_ROWW))
#define MLISTW ((float*)WSP(WS_ROWW + (size_t)8 * T * 4))
#define YP0 ((bf16*)WSP(WS_XB))
#define YP1 ((bf16*)WSP(WS_YMIX))
#define xb ((bf16*)WSP(WS_XB))
#define rstd ((float*)WSP(WS_RSTD))
#define SSQA ((float*)WSP(WS_RSTD + (size_t)1 * MiB))
#define SSQB ((float*)WSP(WS_RSTD + (size_t)3 * MiB))
#define WBAB ((bf16*)WSP(WS_WBA + (size_t)2 * 16 * D * 4))
#define ba ((float*)WSP(WS_BA))
#define beta ((float*)WSP(WS_BETA))
#define gg ((float*)WSP(WS_G))
#define roww ((float*)WSP(WS_ROWW))
#define proj ((bf16*)WSP(WS_PROJ))
#define hid ((bf16*)WSP(WS_PROJ))
#define ymix ((bf16*)WSP(WS_YMIX))
#define c0 ((float*)WSP(WS_C))
#define c1 ((float*)WSP(WS_C + (size_t)T * 1024 * 4))
#define c2 ((float*)WSP(WS_C + (size_t)2 * T * 1024 * 4))
#define c3 ((float*)WSP(WS_C + (size_t)3 * T * 1024 * 4))
#define LRU_WRT ((bf16*)WSP(WS_WRT))
#define LRU_WIT ((bf16*)WSP(WS_WRT + (size_t)2 * 8 * 128 * 128 * 2))
#define LRU_H ((float*)WSP(WS_C + (size_t)256 * MiB))
#define LRU_A ((float*)WSP(WS_C + (size_t)320 * MiB))
#define LRU_SUMM ((float*)WSP(WS_C + (size_t)384 * MiB))
#define LRU_CARRY ((float*)WSP(WS_C + (size_t)386 * MiB))
#define DN_WF ((bf16*)WSP(WS_C))
#define DN_QF ((bf16*)WSP(WS_C + (size_t)32 * MiB))
#define DN_KDTF ((bf16*)WSP(WS_C + (size_t)64 * MiB))
#define DN_UF ((bf16*)WSP(WS_C + (size_t)96 * MiB))
#define DN_QKF ((bf16*)WSP(WS_C + (size_t)128 * MiB))
#define DN_GL ((float*)WSP(WS_C + (size_t)144 * MiB))
    const int BIG = 1 << 30;
#define PHL int tid_ = threadIdx.x; asm volatile("" : "+v"(tid_)); const int lane_ = tid_ & 63; int bid_ = blockIdx.x; asm volatile("" : "+s"(bid_)); const int gw_ = bid_ * 8 + __builtin_amdgcn_readfirstlane(tid_ >> 6); const size_t gt_ = (size_t)bid_ * 512 + tid_, NGT = (size_t)G * 512; LAS float* scr = (LAS float*)(lds + (gw_ & 7) * 16384);
    if (RUN(ph)) { PHL
        convert_matrix(w_in, DIN, 0, D, NPROJ, norm_mix, Win, BIG, 0, 0, scr, gw_, NGW, lane_);
        convert_matrix(w_out, D, 0, D, D, nullptr, Wout, BIG, 0, 0, scr, gw_, NGW, lane_);
        for (size_t i = gt_; i < (size_t)16 * D; i += NGT) { const int j = (int)(i / D), k = (int)(i % D); WBAB[i] = (bf16)f2bf(w_in[(size_t)D * DIN + (size_t)k * DIN + NPROJ + j] * norm_mix[D + k]); }
        for (int l = 0; l < 2; ++l)
            for (size_t i = gt_; i < (size_t)16 * D; i += NGT) { const int j = (int)(i / D), k = (int)(i % D); Wba[(size_t)l * 16 * D + i] = w_in[(size_t)l * D * DIN + (size_t)k * DIN + NPROJ + j] * norm_mix[l * D + k]; }
        for (int m = 0; m < 16; ++m) {
            convert_matrix(lru_w_r + (size_t)m * 128 * 128, 128, 0, 128, 128, nullptr, LRU_WRT + (size_t)m * 128 * 128, BIG, 0, 0, scr, gw_, NGW, lane_);
            convert_matrix(lru_w_i + (size_t)m * 128 * 128, 128, 0, 128, 128, nullptr, LRU_WIT + (size_t)m * 128 * 128, BIG, 0, 0, scr, gw_, NGW, lane_); }
    }
    SEAM(ph);
    int xsel = 0;
#define xcur (xsel ? (const float*)xres : x_in)
    { constexpr int l = 0;
        if (l == 0) { { PHL for (int r = gw_; r < T; r += NGW) rowprep_row(xcur, xb, rstd, Wba, ba, r, lane_); }
        SEAM(ph); }
        if (RUN(ph)) { pg8::Gemm g{xb, Win + (size_t)l * NPROJ * D, T, NPROJ, D, 0}; pg8::StaticOrder S; S.init(T, NPROJ, G, bid); pg8::EpiScaleBf16 E{proj, l == 0 ? rstd : SSQB, NPROJ, l};
            pg8::gemm_phase<pg8::EpiScaleBf16, pg8::StaticOrder, true, false>(lds, g, S, E);
            if (l == 1) { PHL for (int rb = bid_; rb < T / 64; rb += G) ba_tail(xb, WBAB, SSQB, ba, rb, gw_ & 7, lane_); } }
        SEAM(ph);
        if (RUN(ph)) { PHL
            for (int u = bid_; u < 2048; u += G) lrua_unit(proj, conv_lru_w + (size_t)l * 4 * DLRU, conv_lru_b + l * DLRU, LRU_WRT + (size_t)l * 8 * 128 * 128, LRU_WIT + (size_t)l * 8 * 128 * 128, lru_b_r + l * DLRU, lru_b_i + l * DLRU, lru_lambda + l * DLRU, LRU_H, LRU_A, LRU_SUMM, u, lds, tid_, lane_, gw_ & 7);
            STAMP();
            for (int uid = bid_; uid < 2048; uid += G) dna_unit(proj, conv_qkv_w + (size_t)l * 4 * 3 * DDN, ba, dn_a_log + l * NH, dn_dt_bias + l * NH, DN_WF, DN_QF, DN_KDTF, DN_QKF, DN_UF, DN_GL, uid, lds, tid_, lane_, gw_ & 7); }
        SEAM(ph);
        if (RUN(ph)) { PHL
            if (bid_ < 128) dnb_run(DN_WF, DN_QF, DN_KDTF, DN_QKF, DN_UF, DN_GL, c3, (bid_ & 7) + 8 * (bid_ >> 6), (bid_ >> 3) & 7, lds, tid_, lane_, gw_ & 7);
            else if (bid_ < 136) { if (tid_ < 256) lru_carry(LRU_SUMM, LRU_CARRY, (bid_ - 128) * 256 + tid_); }
            else { const int cw = gw_ - 136 * 8, CNW = NGW - 136 * 8;
                if (l == 0) {
                    convert_matrix(w_in + (size_t)D * DIN, DIN, 0, D, NPROJ, norm_mix + D, Win + (size_t)NPROJ * D, BIG, 0, 0, scr, cw, CNW, lane_);
                    convert_matrix(w_out + (size_t)D * D, D, 0, D, D, nullptr, Wout + (size_t)D * D, BIG, 0, 0, scr, cw, CNW, lane_);
                    convert_matrix(ffn_w_gate, DFF, 0, D, DFF, norm_ffn, Wgu, 128, 256, 0, scr, cw, CNW, lane_);
                    convert_matrix(ffn_w_up, DFF, 0, D, DFF, norm_ffn, Wgu, 128, 256, 128, scr, cw, CNW, lane_);
                    convert_matrix(ffn_w_down, D, 0, DFF, D, nullptr, Wd, BIG, 0, 0, scr, cw, CNW, lane_);
                } else {
                    for (int e = 0; e < NEXP; ++e) convert_matrix(moe_w_down + (size_t)e * DFFE * D, D, 0, DFFE, D, nullptr, Md + (size_t)e * D * DFFE, BIG, 0, 0, scr, cw, CNW, lane_);
                } } }
        SEAM(ph);
        if (RUN(ph)) { PHL
            for (int r = gw_; r < T; r += NGW) lrub_row(LRU_H, LRU_A, LRU_CARRY, proj, lru_out_norm + l * DLRU, ymix, r, lane_);
            for (int r = gw_; r < T; r += NGW) dn_out_row(c3, dn_out_norm + l * HD, proj, ymix, r, lane_); }
        SEAM(ph);
        if (RUN(ph)) { if (l == 0) { pg8::Gemm g{ymix, Wout, T, D, D, 0}; pg8::StaticOrder S; S.init(T, D, G, bid); pg8::EpiResidualNorm E{xcur, xres, xb, SSQA, D, 0};
            pg8::gemm_phase<pg8::EpiResidualNorm, pg8::StaticOrder, true, false>(lds, g, S, E); }
          else { pg8::Gemm g{ymix, Wout + (size_t)D * D, T, D, D, 0}; pg8::StaticOrder S; S.init(T, D, G, bid); pg8::EpiResidual E{xcur, xres, nullptr, D, 0};
            pg8::gemm_phase<pg8::EpiResidual, pg8::StaticOrder, true, false>(lds, g, S, E); }
            if (l == 1) { PHL
                for (int e = 0; e < NEXP; ++e) {
                    convert_matrix(moe_w_gate + (size_t)e * D * DFFE, DFFE, 0, D, DFFE, norm_ffn + D, Mgu + (size_t)e * 2 * DFFE * D, 128, 256, 0, scr, gw_, NGW, lane_);
                    convert_matrix(moe_w_up + (size_t)e * D * DFFE, DFFE, 0, D, DFFE, norm_ffn + D, Mgu + (size_t)e * 2 * DFFE * D, 128, 256, 128, scr, gw_, NGW, lane_);
 } } }
        SEAM(ph);
        xsel = 1;
        if (l == 0) {
            if (RUN(ph)) { pg8::Gemm g{xb, Wgu, T, 2 * DFF, D, 0}; pg8::StaticOrder S; S.init(T, 2 * DFF, G, bid); pg8::EpiSwiGLU E{hid, SSQA, DFF, 1};
                pg8::gemm_phase<pg8::EpiSwiGLU, pg8::StaticOrder, true, false>(lds, g, S, E); }
            SEAM(ph);
            if (RUN(ph)) { pg8::Gemm g{hid, Wd, T, D, DFF, 0}; pg8::StaticOrder S; S.init(T, D, G, bid); pg8::EpiResidualNorm E{xcur, xres, xb, SSQB, D, 0};
                pg8::gemm_phase<pg8::EpiResidualNorm, pg8::StaticOrder, true, false>(lds, g, S, E); }
            SEAM(ph);
        } else {
            if (RUN(ph)) { PHL for (int blk = bid_; blk < T / 64; blk += G) route_block(xcur, norm_ffn + D, moe_router, xb, rstd, MCNT, MLIST, MLISTW, blk, lds, tid_, lane_, gw_ & 7); }
            SEAM(ph);
            if (RUN(ph)) { pg8::Gemm g{xb, Mgu, NSLOT, 2 * DFFE, D, 0}; MoeOrder S; S.init(MCNT, MLIST, 2 * DFFE / 256, G, bid); pg8::EpiSwiGLUMoe E{hid, rstd, MLIST, DFFE, 0};
                pg8::gemm_phase<pg8::EpiSwiGLUMoe, MoeOrder, true, true>(lds, g, S, E); }
            SEAM(ph);
            if (RUN(ph)) { pg8::Gemm g{hid, Md, NSLOT, D, DFFE, 0}; MoeOrder S; S.init(MCNT, MLIST, D / 256, G, bid); pg8::EpiMoeDown E{YP0, YP1, MLIST, MLISTW, D, 0};
                pg8::gemm_phase<pg8::EpiMoeDown, MoeOrder, true, false>(lds, g, S, E); }
            SEAM(ph);
        }
    }
    { constexpr int l = 1;
        if (l == 0) { { PHL for (int r = gw_; r < T; r += NGW) rowprep_row(xcur, xb, rstd, Wba, ba, r, lane_); }
        SEAM(ph); }
        if (RUN(ph)) { pg8::Gemm g{xb, Win + (size_t)l * NPROJ * D, T, NPROJ, D, 0}; pg8::StaticOrder S; S.init(T, NPROJ, G, bid); pg8::EpiScaleBf16 E{proj, l == 0 ? rstd : SSQB, NPROJ, l};
            pg8::gemm_phase<pg8::EpiScaleBf16, pg8::StaticOrder, true, false>(lds, g, S, E);
            if (l == 1) { PHL for (int rb = bid_; rb < T / 64; rb += G) ba_tail(xb, WBAB, SSQB, ba, rb, gw_ & 7, lane_); } }
        SEAM(ph);
        if (RUN(ph)) { PHL
            for (int u = bid_; u < 2048; u += G) lrua_unit(proj, conv_lru_w + (size_t)l * 4 * DLRU, conv_lru_b + l * DLRU, LRU_WRT + (size_t)l * 8 * 128 * 128, LRU_WIT + (size_t)l * 8 * 128 * 128, lru_b_r + l * DLRU, lru_b_i + l * DLRU, lru_lambda + l * DLRU, LRU_H, LRU_A, LRU_SUMM, u, lds, tid_, lane_, gw_ & 7);
            STAMP();
            for (int uid = bid_; uid < 2048; uid += G) dna_unit(proj, conv_qkv_w + (size_t)l * 4 * 3 * DDN, ba, dn_a_log + l * NH, dn_dt_bias + l * NH, DN_WF, DN_QF, DN_KDTF, DN_QKF, DN_UF, DN_GL, uid, lds, tid_, lane_, gw_ & 7); }
        SEAM(ph);
        if (RUN(ph)) { PHL
            if (bid_ < 128) dnb_run(DN_WF, DN_QF, DN_KDTF, DN_QKF, DN_UF, DN_GL, c3, (bid_ & 7) + 8 * (bid_ >> 6), (bid_ >> 3) & 7, lds, tid_, lane_, gw_ & 7);
            else if (bid_ < 136) { if (tid_ < 256) lru_carry(LRU_SUMM, LRU_CARRY, (bid_ - 128) * 256 + tid_); }
            else { const int cw = gw_ - 136 * 8, CNW = NGW - 136 * 8;
                if (l == 0) {
                    convert_matrix(w_in + (size_t)D * DIN, DIN, 0, D, NPROJ, norm_mix + D, Win + (size_t)NPROJ * D, BIG, 0, 0, scr, cw, CNW, lane_);
                    convert_matrix(w_out + (size_t)D * D, D, 0, D, D, nullptr, Wout + (size_t)D * D, BIG, 0, 0, scr, cw, CNW, lane_);
                    convert_matrix(ffn_w_gate, DFF, 0, D, DFF, norm_ffn, Wgu, 128, 256, 0, scr, cw, CNW, lane_);
                    convert_matrix(ffn_w_up, DFF, 0, D, DFF, norm_ffn, Wgu, 128, 256, 128, scr, cw, CNW, lane_);
                    convert_matrix(ffn_w_down, D, 0, DFF, D, nullptr, Wd, BIG, 0, 0, scr, cw, CNW, lane_);
                } else {
                    for (int e = 0; e < NEXP; ++e) convert_matrix(moe_w_down + (size_t)e * DFFE * D, D, 0, DFFE, D, nullptr, Md + (size_t)e * D * DFFE, BIG, 0, 0, scr, cw, CNW, lane_);
                } } }
        SEAM(ph);
        if (RUN(ph)) { PHL
            for (int r = gw_; r < T; r += NGW) lrub_row(LRU_H, LRU_A, LRU_CARRY, proj, lru_out_norm + l * DLRU, ymix, r, lane_);
            for (int r = gw_; r < T; r += NGW) dn_out_row(c3, dn_out_norm + l * HD, proj, ymix, r, lane_); }
        SEAM(ph);
        if (RUN(ph)) { if (l == 0) { pg8::Gemm g{ymix, Wout, T, D, D, 0}; pg8::StaticOrder S; S.init(T, D, G, bid); pg8::EpiResidualNorm E{xcur, xres, xb, SSQA, D, 0};
            pg8::gemm_phase<pg8::EpiResidualNorm, pg8::StaticOrder, true, false>(lds, g, S, E); }
          else { pg8::Gemm g{ymix, Wout + (size_t)D * D, T, D, D, 0}; pg8::StaticOrder S; S.init(T, D, G, bid); pg8::EpiResidual E{xcur, xres, nullptr, D, 0};
            pg8::gemm_phase<pg8::EpiResidual, pg8::StaticOrder, true, false>(lds, g, S, E); }
            if (l == 1) { PHL
                for (int e = 0; e < NEXP; ++e) {
                    convert_matrix(moe_w_gate + (size_t)e * D * DFFE, DFFE, 0, D, DFFE, norm_ffn + D, Mgu + (size_t)e * 2 * DFFE * D, 128, 256, 0, scr, gw_, NGW, lane_);
                    convert_matrix(moe_w_up + (size_t)e * D * DFFE, DFFE, 0, D, DFFE, norm_ffn + D, Mgu + (size_t)e * 2 * DFFE * D, 128, 256, 128, scr, gw_, NGW, lane_);
 } } }
        SEAM(ph);
        xsel = 1;
        if (l == 0) {
            if (RUN(ph)) { pg8::Gemm g{xb, Wgu, T, 2 * DFF, D, 0}; pg8::StaticOrder S; S.init(T, 2 * DFF, G, bid); pg8::EpiSwiGLU E{hid, SSQA, DFF, 1};
                pg8::gemm_phase<pg8::EpiSwiGLU, pg8::StaticOrder, true, false>(lds, g, S, E); }
            SEAM(ph);
            if (RUN(ph)) { pg8::Gemm g{hid, Wd, T, D, DFF, 0}; pg8::StaticOrder S; S.init(T, D, G, bid); pg8::EpiResidualNorm E{xcur, xres, xb, SSQB, D, 0};
                pg8::gemm_phase<pg8::EpiResidualNorm, pg8::StaticOrder, true, false>(lds, g, S, E); }
            SEAM(ph);
        } else {
            if (RUN(ph)) { PHL for (int blk = bid_; blk < T / 64; blk += G) route_block(xcur, norm_ffn + D, moe_router, xb, rstd, MCNT, MLIST, MLISTW, blk, lds, tid_, lane_, gw_ & 7); }
            SEAM(ph);
            if (RUN(ph)) { pg8::Gemm g{xb, Mgu, NSLOT, 2 * DFFE, D, 0}; MoeOrder S; S.init(MCNT, MLIST, 2 * DFFE / 256, G, bid); pg8::EpiSwiGLUMoe E{hid, rstd, MLIST, DFFE, 0};
                pg8::gemm_phase<pg8::EpiSwiGLUMoe, MoeOrder, true, true>(lds, g, S, E); }
            SEAM(ph);
            if (RUN(ph)) { pg8::Gemm g{hid, Md, NSLOT, D, DFFE, 0}; MoeOrder S; S.init(MCNT, MLIST, D / 256, G, bid); pg8::EpiMoeDown E{YP0, YP1, MLIST, MLISTW, D, 0};
                pg8::gemm_phase<pg8::EpiMoeDown, MoeOrder, true, false>(lds, g, S, E); }
            SEAM(ph);
        }
    }
    if (RUN(ph)) { PHL for (int r = gw_; r < T; r += NGW) final_row_moe(xcur, YP0, YP1, norm_final, xres, r, lane_); }
#if defined(PROBE_MASK)
    __syncthreads(); STAMP();
    if (blockIdx.x == 0 && threadIdx.x == 0) { asm volatile("s_waitcnt vmcnt(0)" ::: "memory"); volatile LAS unsigned long long* st = (volatile LAS unsigned long long*)(lds + LDSCTL_OFF + 1024); unsigned long long tot = 0;
        for (int k = 1; k < nst; ++k) if ((PROBE_MASK >> (k - 1)) & 1ull) tot += st[k] - st[k - 1];
        xres[0] = rintf((float)tot * 0.01f * PROBE_SCALE); }
#endif
#if defined(PROBE_DNA_A)
    __syncthreads();
    if (blockIdx.x == 0 && threadIdx.x == 0) { asm volatile("s_waitcnt vmcnt(0)" ::: "memory"); volatile LAS unsigned long long* st = (volatile LAS unsigned long long*)(lds + (RING_BYTES + 2048));
        xres[0] = rintf((float)(st[PROBE_DNA_B] - st[PROBE_DNA_A]) * 0.01f * PROBE_SCALE); }
#endif
#undef RUN
#undef SEAM
}

extern "C" void kernel_launch(void* const* d_in, const int* in_sizes, int n_in, void* d_out, int out_size, void* d_ws, size_t ws_size, hipStream_t stream) {
    static int grid = 0;
    if (grid == 0) {
        if (n_in != 25 || ws_size < WS_END) { fprintf(stderr, "kernel_launch: unexpected n_in %d / ws_size %zu (need %zu)\n", n_in, ws_size, (size_t)WS_END); grid = -1; return; }
        int dev = 0, cus = 0, per_cu = 0;
        if (hipGetDevice(&dev) != hipSuccess || hipDeviceGetAttribute(&cus, hipDeviceAttributeMultiprocessorCount, dev) != hipSuccess) { grid = -1; return; }
        if (hipFuncSetAttribute((const void*)mega, hipFuncAttributeMaxDynamicSharedMemorySize, LDS_BYTES) != hipSuccess) { fprintf(stderr, "kernel_launch: hipFuncSetAttribute failed\n"); grid = -1; return; }
        if (hipOccupancyMaxActiveBlocksPerMultiprocessor(&per_cu, (const void*)mega, 512, LDS_BYTES) != hipSuccess || per_cu < 1) { fprintf(stderr, "kernel_launch: occupancy query says %d\n", per_cu); }
        (void)hipGetLastError();
        grid = cus;
    }
    if (grid < 0) return;
    if (hipMemsetAsync((char*)d_ws + WS_CTL, 0, CTL_ZERO_BYTES, stream) != hipSuccess) return;
    Args a{};
    for (int i = 0; i < 25; ++i) a.in[i] = (const float*)d_in[i];
    a.out = (float*)d_out; a.ws = (unsigned char*)d_ws; a.ph_lo = 0; a.ph_hi = 1 << 30;
    hipLaunchKernelGGL(mega, dim3(grid), dim3(512), LDS_BYTES, stream, a);
}
```

```cpp
#include <hip/hip_runtime.h>
#include <cstdio>
#include <cstdint>
namespace pg8 {
#define PG8_LAS __attribute__((address_space(3)))
typedef unsigned short bf16_t;
typedef short bf16x8 __attribute__((ext_vector_type(8)));
typedef float f32x4 __attribute__((ext_vector_type(4)));
typedef unsigned u32x4 __attribute__((ext_vector_type(4)));
constexpr int BM = 256, BK = 64, HALF = 128, HTB = HALF * BK * 2  , STAGE_BYTES = 8 * HTB, NXCD = 8, WGM = 8;

__host__ __device__ __forceinline__ int lds_byte(int r, int c) { const int st = (r >> 4) * 2 + (c >> 5), rr = r & 15, cc = c & 31, ob = rr * 64 + cc * 2; return st * 1024 + (ob ^ (((ob >> 9) & 1) << 5)); }
__host__ __device__ __forceinline__ void stage_rc(int b, int& R, int& C) { const int st = b / 1024, sb = b % 1024, swz = sb ^ (((sb >> 9) & 1) << 5); R = (st >> 1) * 16 + swz / 64; C = (st & 1) * 32 + (swz % 64) / 2; }
__host__ __device__ __forceinline__ int perm32(int rho) { const int n = rho >> 4, i = rho & 15; return 8 * (i >> 2) + 4 * n + (i & 3); }

struct Unit { int pm, pn, pb, lbase, nvalid; };
struct Gemm { const bf16_t* A; const bf16_t* Bt; int M, N, K, pad; };

struct StaticOrder {
    int nM, nN, nwg, G, c;
    __host__ __device__ void init(int M, int N, int G_, int c_) { nM = M / BM; nN = N / BM; nwg = nM * nN; G = G_; c = c_; }
    __host__ __device__ bool next(int i, Unit& u) const {
        const long L = (long)i * G + c; if (L >= nwg) return false;
        int wgid = (int)L; { const int q = nwg / NXCD, r = nwg % NXCD, xcd = wgid % NXCD, off = wgid / NXCD; wgid = (xcd < r ? xcd * (q + 1) : r * (q + 1) + (xcd - r) * q) + off; }
        const int nig = WGM * nN, gid = wgid / nig, fm = gid * WGM, gsz = (nM - fm) < WGM ? (nM - fm) : WGM;
        u.pm = fm + ((wgid % nig) % gsz); u.pn = (wgid % nig) / gsz; u.pb = u.pn; u.lbase = 0; u.nvalid = BM; return true;
    }
    __device__ __forceinline__ int arow(const Unit&, int) const { return 0; }
    __device__ __forceinline__ void a_ready(const Unit&) const {}
    __device__ __forceinline__ void done(const Unit&) const {}
};


typedef float f32x2_t __attribute__((ext_vector_type(2)));
typedef __bf16 bf16x2_t __attribute__((ext_vector_type(2)));
__device__ __forceinline__ unsigned cvt_pk_bf16(float lo, float hi) { const f32x2_t v = {lo, hi}; const bf16x2_t b = __builtin_convertvector(v, bf16x2_t); return __builtin_bit_cast(unsigned, b); }
__device__ __forceinline__ float silu_f(float x) { return x / (1.0f + __expf(-x)); }
__device__ __forceinline__ float row_scale(const float* rs, int r, int mode) {
    if (!mode) return rs[r];
    const f32x4* p = (const f32x4*)(rs + (size_t)r * 32); float s = 0.f;
#pragma unroll
    for (int i = 0; i < 8; ++i) { const f32x4 v = p[i]; s += (v[0] + v[1]) + (v[2] + v[3]); }
    return 1.0f / sqrtf(s * (1.0f / 2048.0f) + 1e-6f);
}
__device__ __forceinline__ void row_scales8(const float* rs, int row0, int fr, int fq, int mode, float (&sc)[2][4]) {
    if (!mode) {
#pragma unroll
        for (int ai = 0; ai < 2; ++ai)
#pragma unroll
            for (int m = 0; m < 4; ++m) sc[ai][m] = rs[row0 + ai * HALF + m * 16];
    } else {
        const int lane = fr + 16 * fq; f32x4 pa[2][4][2];
#pragma unroll
        for (int ai = 0; ai < 2; ++ai)
#pragma unroll
            for (int m = 0; m < 4; ++m) { const f32x4* p = (const f32x4*)(rs + (size_t)(row0 + ai * HALF + m * 16) * 32 + fq * 8); pa[ai][m][0] = p[0]; pa[ai][m][1] = p[1]; }
#pragma unroll
        for (int ai = 0; ai < 2; ++ai)
#pragma unroll
            for (int m = 0; m < 4; ++m) { const f32x4 a = pa[ai][m][0], b = pa[ai][m][1]; float t = ((a[0] + a[1]) + (a[2] + a[3])) + ((b[0] + b[1]) + (b[2] + b[3]));
                t += __int_as_float(__builtin_amdgcn_ds_bpermute((lane ^ 16) << 2, __float_as_int(t)));
                t += __int_as_float(__builtin_amdgcn_ds_bpermute((lane ^ 32) << 2, __float_as_int(t)));
                sc[ai][m] = 1.0f / sqrtf(t * (1.0f / 2048.0f) + 1e-6f); }
    }
}
struct EpiScaleBf16 {
    static constexpr bool PERM = true, AFTER_DRAIN = false;
    bf16_t* O; const float* rs; int ldc; int pad;
    __device__ __forceinline__ void operator()(const f32x4 (&acc)[2][2][4][2], const Unit& u, int wr, int wc, int fr, int fq) const {
        const int row0 = u.pm * BM + wr * 64 + fr, col0 = u.pn * BM + wc * 32 + 8 * fq;
        float sc[2][4]; row_scales8(rs, row0, fr, fq, pad, sc);
#pragma unroll
        for (int ai = 0; ai < 2; ++ai)
#pragma unroll
            for (int m = 0; m < 4; ++m) { const int r = row0 + ai * HALF + m * 16; const float s = sc[ai][m]; bf16_t* rowp = O + (size_t)r * ldc + col0;
#pragma unroll
                for (int bj = 0; bj < 2; ++bj) { const f32x4 v0 = acc[ai][bj][m][0] * s, v1 = acc[ai][bj][m][1] * s;
                    u32x4 w; w.x = cvt_pk_bf16(v0[0], v0[1]); w.y = cvt_pk_bf16(v0[2], v0[3]); w.z = cvt_pk_bf16(v1[0], v1[1]); w.w = cvt_pk_bf16(v1[2], v1[3]);
                    *(u32x4*)(rowp + bj * HALF) = w; } }
    }
};
struct EpiSwiGLU {
    static constexpr bool PERM = true, AFTER_DRAIN = false;
    bf16_t* O; const float* rs; int ldc; int pad;
    __device__ __forceinline__ void operator()(const f32x4 (&acc)[2][2][4][2], const Unit& u, int wr, int wc, int fr, int fq) const {
        const int row0 = u.pm * BM + wr * 64 + fr, col0 = u.pn * HALF + wc * 32 + 8 * fq;
        float sc[2][4]; row_scales8(rs, row0, fr, fq, pad, sc);
#pragma unroll
        for (int ai = 0; ai < 2; ++ai)
#pragma unroll
            for (int m = 0; m < 4; ++m) { const int r = row0 + ai * HALF + m * 16; const float s = sc[ai][m]; bf16_t* rowp = O + (size_t)r * ldc + col0;
                f32x4 h0, h1;
#pragma unroll
                for (int j = 0; j < 4; ++j) { h0[j] = silu_f(acc[ai][0][m][0][j] * s) * (acc[ai][1][m][0][j] * s); h1[j] = silu_f(acc[ai][0][m][1][j] * s) * (acc[ai][1][m][1][j] * s); }
                u32x4 w; w.x = cvt_pk_bf16(h0[0], h0[1]); w.y = cvt_pk_bf16(h0[2], h0[3]); w.z = cvt_pk_bf16(h1[0], h1[1]); w.w = cvt_pk_bf16(h1[2], h1[3]);
                *(u32x4*)rowp = w; }
    }
};
struct EpiResidual {
    static constexpr bool PERM = false, AFTER_DRAIN = false;
    const float* base; float* out; const float* roww; int ldc; int pad;
    __device__ __forceinline__ void operator()(const f32x4 (&acc)[2][2][4][2], const Unit& u, int wr, int wc, int fr, int fq) const {
        const int row0 = u.pm * BM + wr * 64 + fr, col0 = u.pn * BM + wc * 32 + 4 * fq;
#pragma unroll
        for (int ai = 0; ai < 2; ++ai)
#pragma unroll
            for (int m = 0; m < 4; ++m) { const int r = row0 + ai * HALF + m * 16; const float w = roww ? roww[r] : 1.0f; const size_t off = (size_t)r * ldc + col0;
#pragma unroll
                for (int bj = 0; bj < 2; ++bj)
#pragma unroll
                    for (int n = 0; n < 2; ++n) { const f32x4 bs = *(const f32x4*)(base + off + bj * HALF + n * 16); *(f32x4*)(out + off + bj * HALF + n * 16) = bs + acc[ai][bj][m][n] * w; } }
    }
};

struct EpiSwiGLUMoe {
    static constexpr bool PERM = true, AFTER_DRAIN = false;
    bf16_t* O; const float* rs; const int* list; int ldc; int pad;
    __device__ __forceinline__ void operator()(const f32x4 (&acc)[2][2][4][2], const Unit& u, int wr, int wc, int fr, int fq) const {
        const int rl0 = wr * 64 + fr, col0 = u.pn * HALF + wc * 32 + 8 * fq;
#pragma unroll
        for (int ai = 0; ai < 2; ++ai)
#pragma unroll
            for (int m = 0; m < 4; ++m) { const int rl = rl0 + ai * HALF + m * 16; const int tok = rl < u.nvalid ? (list[u.lbase + rl] & 0xffff) : 0; const float s = rs[tok];
                bf16_t* rowp = O + (size_t)(u.pm * BM + rl) * ldc + col0;
                f32x4 h0, h1;
#pragma unroll
                for (int j = 0; j < 4; ++j) { h0[j] = silu_f(acc[ai][0][m][0][j] * s) * (acc[ai][1][m][0][j] * s); h1[j] = silu_f(acc[ai][0][m][1][j] * s) * (acc[ai][1][m][1][j] * s); }
                u32x4 w; w.x = cvt_pk_bf16(h0[0], h0[1]); w.y = cvt_pk_bf16(h0[2], h0[3]); w.z = cvt_pk_bf16(h1[0], h1[1]); w.w = cvt_pk_bf16(h1[2], h1[3]);
                *(u32x4*)rowp = w; }
    }
};
struct EpiMoeDown {
    static constexpr bool PERM = true, AFTER_DRAIN = false;
    bf16_t* Y0; bf16_t* Y1; const int* list; const float* lw; int ldc; int pad;
    __device__ __forceinline__ void operator()(const f32x4 (&acc)[2][2][4][2], const Unit& u, int wr, int wc, int fr, int fq) const {
        const int rl0 = wr * 64 + fr, col0 = u.pn * BM + wc * 32 + 8 * fq;
#pragma unroll
        for (int ai = 0; ai < 2; ++ai)
#pragma unroll
            for (int m = 0; m < 4; ++m) { const int rl = rl0 + ai * HALF + m * 16;
                if (rl < u.nvalid) { const int en = list[u.lbase + rl]; const float w = lw[u.lbase + rl]; bf16_t* rowp = ((en >> 16) ? Y1 : Y0) + (size_t)(en & 0xffff) * ldc + col0;
#pragma unroll
                    for (int bj = 0; bj < 2; ++bj) { const f32x4 v0 = acc[ai][bj][m][0] * w, v1 = acc[ai][bj][m][1] * w;
                        u32x4 o; o.x = cvt_pk_bf16(v0[0], v0[1]); o.y = cvt_pk_bf16(v0[2], v0[3]); o.z = cvt_pk_bf16(v1[0], v1[1]); o.w = cvt_pk_bf16(v1[2], v1[3]);
                        *(u32x4*)(rowp + bj * HALF) = o; } } }
    }
};

struct EpiResidualNorm {
    static constexpr bool PERM = true, AFTER_DRAIN = false;
    const float* base; float* out; bf16_t* xb; float* ssq; int ldc; int pad;
    __device__ __forceinline__ void operator()(const f32x4 (&acc)[2][2][4][2], const Unit& u, int wr, int wc, int fr, int fq) const {
        const int row0 = u.pm * BM + wr * 64 + fr, col0 = u.pn * BM + wc * 32 + 8 * fq, lane = fr + 16 * fq;
#pragma unroll
        for (int ai = 0; ai < 2; ++ai)
#pragma unroll
            for (int m = 0; m < 4; ++m) { const int r = row0 + ai * HALF + m * 16; const size_t off = (size_t)r * ldc + col0; float part = 0.f;
#pragma unroll
                for (int bj = 0; bj < 2; ++bj) { const f32x4 b0 = *(const f32x4*)(base + off + bj * HALF), b1 = *(const f32x4*)(base + off + bj * HALF + 4);
                    const f32x4 v0 = b0 + acc[ai][bj][m][0], v1 = b1 + acc[ai][bj][m][1];
                    *(f32x4*)(out + off + bj * HALF) = v0; *(f32x4*)(out + off + bj * HALF + 4) = v1;
                    u32x4 w; w.x = cvt_pk_bf16(v0[0], v0[1]); w.y = cvt_pk_bf16(v0[2], v0[3]); w.z = cvt_pk_bf16(v1[0], v1[1]); w.w = cvt_pk_bf16(v1[2], v1[3]);
                    *(u32x4*)(xb + off + bj * HALF) = w;
                    part += (v0[0] * v0[0] + v0[1] * v0[1]) + (v0[2] * v0[2] + v0[3] * v0[3]) + (v1[0] * v1[0] + v1[1] * v1[1]) + (v1[2] * v1[2] + v1[3] * v1[3]); }
                part += __int_as_float(__builtin_amdgcn_ds_bpermute((lane ^ 16) << 2, __float_as_int(part)));
                part += __int_as_float(__builtin_amdgcn_ds_bpermute((lane ^ 32) << 2, __float_as_int(part)));
                if (fq == 0) ssq[(size_t)r * 32 + u.pn * 4 + wc] = part; }
    }
};
template <class Epi, class Sched, bool ALIGN_EPI = false, bool GATHER = false>
__device__ __forceinline__ void gemm_phase(PG8_LAS unsigned char* lds, const Gemm g, const Sched& S, const Epi& E) {
    int tid_o = threadIdx.x; asm volatile("" : "+v"(tid_o));
    const int tid = tid_o, wid = __builtin_amdgcn_readfirstlane(tid >> 6), lane = tid & 63, wr = wid >> 2, wc = wid & 3, fr = lane & 15, fq = lane >> 4;
    const int K = g.K, nt = K / BK;
    const size_t kstep = (size_t)(BK * 2);
    const size_t hstep = (size_t)HALF * K * 2;
    const size_t tstep = 2 * hstep;
    unsigned voffA[2], voffB[2], oA[2][2], oN[2][2];
#pragma unroll
    for (int i = 0; i < 2; ++i) { int R, C; stage_rc(tid * 16 + i * 8192, R, C); const int Rb = Epi::PERM ? ((R & ~31) + perm32(R & 31)) : R; voffA[i] = (unsigned)(R * K + C) * 2u; voffB[i] = (unsigned)(Rb * K + C) * 2u; }
    const unsigned ldsw = (unsigned)wid * 1024u;
    const int aoff = lds_byte(wr * 64 + fr, fq * 8), boff = lds_byte(wc * 32 + fr, fq * 8);
#define PG8_SA(b, h) (((b) * 2 + (h)) * HTB)
#define PG8_SB(b, h) ((4 + (b) * 2 + (h)) * HTB)
#define PG8_STAGE(bufoff, gbase, voff) do { _Pragma("unroll") for (int _i = 0; _i < 2; ++_i) \
        __builtin_amdgcn_global_load_lds((const unsigned*)((const char*)(gbase) + (voff)[_i]), (PG8_LAS unsigned*)(lds + (bufoff) + ldsw + _i * 8192), 16, 0, 0); } while (0)
#define PG8_LDA(dst, b, h) do { _Pragma("unroll") for (int m = 0; m < 4; ++m) _Pragma("unroll") for (int k = 0; k < 2; ++k) dst[m][k] = *(const PG8_LAS bf16x8*)(lds + PG8_SA(b, h) + aoff + m * 2048 + k * 1024); } while (0)
#define PG8_LDB(dst, b, h) do { _Pragma("unroll") for (int n = 0; n < 2; ++n) _Pragma("unroll") for (int k = 0; k < 2; ++k) dst[n][k] = *(const PG8_LAS bf16x8*)(lds + PG8_SB(b, h) + boff + n * 2048 + k * 1024); } while (0)
#define PG8_MMA(ai, bj, At, Bt) do { __builtin_amdgcn_s_setprio(1); _Pragma("unroll") for (int m = 0; m < 4; ++m) _Pragma("unroll") for (int n = 0; n < 2; ++n) _Pragma("unroll") for (int k = 0; k < 2; ++k) \
        acc[ai][bj][m][n] = __builtin_amdgcn_mfma_f32_16x16x32_bf16(Bt[n][k], At[m][k], acc[ai][bj][m][n], 0, 0, 0); __builtin_amdgcn_s_setprio(0); } while (0)
#define PG8_WAIT_V(n) asm volatile("s_waitcnt vmcnt(" #n ")" ::: "memory")
#define PG8_WAIT_L(n) asm volatile("s_waitcnt lgkmcnt(" #n ")" ::: "memory")
#define PG8_BAR __builtin_amdgcn_s_barrier()
#define PG8_SCHED __builtin_amdgcn_sched_barrier(0)
#define PG8_AOFF(dst, u) do { _Pragma("unroll") for (int _i = 0; _i < 2; ++_i) { int _R, _C; stage_rc(tid * 16 + _i * 8192, _R, _C); _Pragma("unroll") for (int _h = 0; _h < 2; ++_h) \
        dst[_h][_i] = (unsigned)(S.arow(u, _h * HALF + _R) * K + _C) * 2u; } } while (0)
#define PG8_STAGE_A(bufoff, gbase, h, usenext) do { _Pragma("unroll") for (int _i = 0; _i < 2; ++_i) { const unsigned _o = GATHER ? ((usenext) ? oN[h][_i] : oA[h][_i]) : voffA[_i]; \
        __builtin_amdgcn_global_load_lds((const unsigned*)((const char*)(gbase) + (GATHER ? (size_t)0 : (size_t)(h) * hstep) + _o), (PG8_LAS unsigned*)(lds + (bufoff) + ldsw + _i * 8192), 16, 0, 0); } } while (0)
    Unit cur, nxt; int ui = 0;
    if (!S.next(0, cur)) return;
    f32x4 acc[2][2][4][2];
#pragma unroll
    for (int a = 0; a < 2; ++a)
#pragma unroll
        for (int b = 0; b < 2; ++b)
#pragma unroll
            for (int m = 0; m < 4; ++m)
#pragma unroll
                for (int n = 0; n < 2; ++n) acc[a][b][m][n] = (f32x4){0.f, 0.f, 0.f, 0.f};
    bf16x8 At[4][2], B0[2][2], B1[2][2];
    const char* cA = (const char*)g.A + (GATHER ? (size_t)0 : (size_t)cur.pm * tstep); const char* cB = (const char*)g.Bt + (size_t)cur.pb * tstep;
    S.a_ready(cur);
    if constexpr (GATHER) { PG8_AOFF(oA, cur); PG8_WAIT_V(0); }
    PG8_STAGE(PG8_SB(0, 0), cB, voffB); PG8_STAGE(PG8_SB(0, 1), cB + hstep, voffB); PG8_STAGE_A(PG8_SA(0, 0), cA, 0, false); PG8_STAGE_A(PG8_SA(0, 1), cA, 1, false);
    if (wr == 1) PG8_BAR;
    PG8_WAIT_V(2); PG8_BAR;
    PG8_STAGE(PG8_SB(1, 0), cB + kstep, voffB); PG8_STAGE_A(PG8_SA(1, 0), cA + kstep, 0, false); PG8_STAGE(PG8_SB(1, 1), cB + hstep + kstep, voffB);
    PG8_WAIT_V(6); PG8_BAR;
    for (;;) {
        const bool has_next = S.next(ui + 1, nxt);
        const char* nA = has_next ? (const char*)g.A + (GATHER ? (size_t)0 : (size_t)nxt.pm * tstep) : cA; const char* nB = has_next ? (const char*)g.Bt + (size_t)nxt.pb * tstep : cB;
        if constexpr (GATHER) { if (has_next) { PG8_AOFF(oN, nxt); } else {
#pragma unroll
            for (int _h = 0; _h < 2; ++_h) { oN[_h][0] = oA[_h][0]; oN[_h][1] = oA[_h][1]; } } }
        for (int t = 0; t < nt; t += 2) {
            const bool last = (t == nt - 2);
            const char* a1 = cA + (size_t)(t + 1) * kstep;
            const char* a2 = last ? nA : cA + (size_t)(t + 2) * kstep; const char* b2 = last ? nB : cB + (size_t)(t + 2) * kstep;
            const char* a3 = a2 + kstep; const char* b3 = b2 + kstep;
            if (last && has_next) S.a_ready(nxt);
            PG8_LDB(B0, 0, 0); PG8_LDB(B1, 0, 1); PG8_SCHED; PG8_LDA(At, 0, 0); PG8_STAGE_A(PG8_SA(1, 1), a1, 1, false);
            PG8_WAIT_V(8); PG8_WAIT_L(0); PG8_BAR; PG8_MMA(0, 0, At, B0); PG8_MMA(0, 1, At, B1); PG8_BAR; PG8_SCHED;
            PG8_LDA(At, 0, 1); PG8_STAGE(PG8_SB(0, 0), b2, voffB); PG8_STAGE(PG8_SB(0, 1), b2 + hstep, voffB); PG8_STAGE_A(PG8_SA(0, 0), a2, 0, last);
            PG8_WAIT_V(8); PG8_WAIT_L(0); PG8_BAR; PG8_MMA(1, 0, At, B0); PG8_MMA(1, 1, At, B1); PG8_BAR; PG8_SCHED;
            PG8_LDB(B0, 1, 0); PG8_LDB(B1, 1, 1); PG8_SCHED; PG8_LDA(At, 1, 0); PG8_STAGE_A(PG8_SA(0, 1), a2, 1, last);
            PG8_WAIT_V(8); PG8_WAIT_L(0); PG8_BAR; PG8_MMA(0, 0, At, B0); PG8_MMA(0, 1, At, B1); PG8_BAR; PG8_SCHED;
            PG8_LDA(At, 1, 1); PG8_STAGE(PG8_SB(1, 0), b3, voffB); PG8_STAGE(PG8_SB(1, 1), b3 + hstep, voffB); PG8_STAGE_A(PG8_SA(1, 0), a3, 0, last);
            PG8_WAIT_V(8); PG8_WAIT_L(0); PG8_BAR; PG8_MMA(1, 0, At, B0); PG8_MMA(1, 1, At, B1); PG8_BAR; PG8_SCHED;
        }
        if constexpr (ALIGN_EPI) { if (wr == 0) PG8_BAR; }
        E(acc, cur, wr, wc, fr, fq); S.done(cur);
        if (!has_next) break;
#pragma unroll
        for (int a = 0; a < 2; ++a)
#pragma unroll
            for (int b = 0; b < 2; ++b)
#pragma unroll
                for (int m = 0; m < 4; ++m)
#pragma unroll
                    for (int n = 0; n < 2; ++n) acc[a][b][m][n] = (f32x4){0.f, 0.f, 0.f, 0.f};
        cur = nxt; cA = nA; cB = nB; ++ui;
        if constexpr (GATHER) {
#pragma unroll
            for (int _h = 0; _h < 2; ++_h) { oA[_h][0] = oN[_h][0]; oA[_h][1] = oN[_h][1]; } }
        if constexpr (ALIGN_EPI) { if (wr == 1) PG8_BAR; }
    }
    PG8_WAIT_V(0);
    if constexpr (!ALIGN_EPI) { if (wr == 0) PG8_BAR; }
    PG8_BAR;
#undef PG8_SA
#undef PG8_SB
#undef PG8_STAGE
#undef PG8_LDA
#undef PG8_LDB
#undef PG8_MMA
#undef PG8_WAIT_V
#undef PG8_WAIT_L
#undef PG8_BAR
#undef PG8_SCHED
#undef PG8_AOFF
#undef PG8_STAGE_A
}
}

#define GAS __attribute__((address_space(1)))
#define LAS __attribute__((address_space(3)))
#define XB_TMO      128
#define XB_XCNT(j)  (256  + 64 * (j))
#define XB_XSUB(j)  (1280 + 64 * (j))
#define XB_XGEN(j)  (2304 + 64 * (j))
#define XB_TOP      3328
#define XB_TOPGEN   3392
#define XCD_BAR_WORDS 3456
#define XB_SPIN_CAP (1u << 23)

__device__ __forceinline__ unsigned xb_ld(unsigned* p)              { return __hip_atomic_load(p, __ATOMIC_RELAXED, __HIP_MEMORY_SCOPE_AGENT); }
__device__ __forceinline__ unsigned xb_add(unsigned* p, unsigned v) { return __hip_atomic_fetch_add(p, v, __ATOMIC_RELAXED, __HIP_MEMORY_SCOPE_AGENT); }
__device__ __forceinline__ unsigned xb_xcc_id() { return (unsigned)__builtin_amdgcn_s_getreg((3 << 11) | 20) & 0xFu; }
#define XB_SPIN(cond, bar) do { unsigned _sp = 0; while (cond) { __builtin_amdgcn_s_sleep(1); \
    if ((++_sp & 255u) == 0u) { if (xb_ld(&(bar)[XB_TMO])) break; if (_sp > XB_SPIN_CAP) { atomicAdd(&(bar)[XB_TMO], 1u); break; } } } } while (0)

struct XcdBarrier {
    unsigned* bar; unsigned x;
    volatile LAS unsigned* st;
};

__device__ __forceinline__ XcdBarrier xcd_barrier_post(unsigned* bar, volatile LAS unsigned* st) {
    XcdBarrier b; b.bar = bar; b.x = xb_xcc_id(); b.st = st;
    if (threadIdx.x == 0) (void)xb_add(&bar[XB_XCNT(b.x)], 1u);
    return b;
}
__device__ __forceinline__ void xcd_barrier_complete(unsigned* bar, unsigned x, unsigned& nloc, unsigned& nx) {
    const unsigned G = gridDim.x * gridDim.y * gridDim.z;
    unsigned sum, cnt, mine, sp = 0u;
    for (;;) {
        sum = 0u; cnt = 0u; mine = 0u;
#pragma unroll
        for (unsigned j = 0; j < 16; ++j) { const unsigned c = xb_ld(&bar[XB_XCNT(j)]); sum += c; cnt += (c > 0u) ? 1u : 0u; mine = (j == x) ? c : mine; }
        if (sum == G) break;
        __builtin_amdgcn_s_sleep(1);
        if ((++sp & 255u) == 0u) { if (xb_ld(&bar[XB_TMO])) break; if (sp > XB_SPIN_CAP) { atomicAdd(&bar[XB_TMO], 1u); break; } }
    }
    nloc = mine > 0u ? mine : 1u; nx = cnt > 0u ? cnt : 1u;
}

__device__ __forceinline__ void xcd_barrier(const XcdBarrier& b) {
    asm volatile("s_waitcnt vmcnt(0)" ::: "memory");
    __syncthreads();
    if (threadIdx.x == 0) {
        unsigned* bar = b.bar; asm volatile("" : "+s"(bar));
        __builtin_amdgcn_s_waitcnt(0);
        unsigned nloc = b.st[0], nx = b.st[1];
        if (nloc == 0u) { xcd_barrier_complete(bar, b.x, nloc, nx); b.st[0] = nloc; b.st[1] = nx; }
        const unsigned old = xb_add(&bar[XB_XSUB(b.x)], 1u);
        const unsigned gen = old / nloc;
        if (old + 1u == (gen + 1u) * nloc) {
            __builtin_amdgcn_fence(__ATOMIC_RELEASE, "agent");
            asm volatile("s_waitcnt vmcnt(0)" ::: "memory");
            const unsigned og = xb_add(&bar[XB_TOP], 1u);
            const unsigned tg = og / nx;
            if (og + 1u == (tg + 1u) * nx) xb_add(&bar[XB_TOPGEN], 1u);
            else XB_SPIN(xb_ld(&bar[XB_TOPGEN]) == tg, bar);
            __builtin_amdgcn_fence(__ATOMIC_ACQUIRE, "agent");
            xb_add(&bar[XB_XGEN(b.x)], 1u);
            asm volatile("s_waitcnt vmcnt(0)" ::: "memory");
        } else {
            XB_SPIN(xb_ld(&bar[XB_XGEN(b.x)]) == gen, bar);
            __builtin_amdgcn_fence(__ATOMIC_ACQUIRE, "agent");
            asm volatile("s_waitcnt vmcnt(0)" ::: "memory");
        }
    }
    __syncthreads();
}

constexpr int T = 16384, SEQ = 8192, D = 2048, DLRU = 1024, DDN = 1024, NH = 8, HD = 128, NPROJ = 6144, DIN = 6160;
constexpr int DFF = 6144, NEXP = 8, DFFE = 3072;
constexpr float EPS = 1e-6f;
typedef unsigned short bf16;
typedef float f32x4 __attribute__((ext_vector_type(4)));
typedef unsigned u32x4 __attribute__((ext_vector_type(4)));
typedef unsigned u32x2 __attribute__((ext_vector_type(2)));
#define LDS_WAIT() asm volatile("s_waitcnt lgkmcnt(0)" ::: "memory")
#define LDS_BARRIER() do { asm volatile("s_waitcnt lgkmcnt(0)" ::: "memory"); __builtin_amdgcn_s_barrier(); asm volatile("" ::: "memory"); } while (0)

__device__ __forceinline__ float bf2f(bf16 b) { return __uint_as_float(((unsigned)b) << 16); }
__device__ __forceinline__ unsigned f2bf(float f) { unsigned u = __float_as_uint(f); return (u + 0x7fffu + ((u >> 16) & 1u)) >> 16; }
__device__ __forceinline__ unsigned pk2(float lo, float hi) { return pg8::cvt_pk_bf16(lo, hi); }
__device__ __forceinline__ float shfl_xor_l(float v, int o, int lane) { return __int_as_float(__builtin_amdgcn_ds_bpermute((lane ^ o) << 2, __float_as_int(v))); }
__device__ __forceinline__ float shfl_up_l(float v, int d, int lane) { return __int_as_float(__builtin_amdgcn_ds_bpermute((lane - d) << 2, __float_as_int(v))); }
__device__ __forceinline__ float shfl_idx_l(float v, int src) { return __int_as_float(__builtin_amdgcn_ds_bpermute(src << 2, __float_as_int(v))); }
__device__ __forceinline__ float wave_sum(float v, int lane) {
#pragma unroll
    for (int o = 1; o < 64; o <<= 1) v += shfl_xor_l(v, o, lane);
    return v;
}
using pg8::silu_f;
__device__ __forceinline__ float sigmoid_f(float x) { return 1.0f / (1.0f + __expf(-x)); }
__device__ __forceinline__ float softplus_f(float x) { return fmaxf(x, 0.0f) + log1pf(__expf(-fabsf(x))); }
__device__ __forceinline__ float gelu_tanh_f(float x) { const float u = 0.7978845608028654f * (x + 0.044715f * x * x * x); return 0.5f * x * (1.0f + tanhf(u)); }

constexpr size_t MiB = 1u << 20;
constexpr size_t al(size_t x) { return (x + MiB - 1) / MiB * MiB; }
constexpr size_t WS_CTL = 0, CTL_ZERO_BYTES = 1 * MiB;
constexpr int CW_BAR = 4096, CW_CNT = 8192;
constexpr size_t WS_WGU = 1 * MiB;
constexpr size_t WS_WD = WS_WGU + al((size_t)2 * DFF * D * 2);
constexpr size_t WS_WIN = WS_WD + al((size_t)D * DFF * 2);
constexpr size_t WS_WBA = WS_WIN + al((size_t)2 * NPROJ * D * 2);
constexpr size_t WS_WOUT = WS_WBA + al((size_t)2 * 16 * D * 4 + 16 * D * 2);
static_assert(WS_WIN + (size_t)NPROJ * D * 2 - WS_WGU >= (size_t)NEXP * D * DFFE * 2, "MoE down weights overlay");
constexpr size_t WS_XB = WS_WOUT + al((size_t)2 * D * D * 2);
constexpr size_t WS_RSTD = WS_XB + al((size_t)T * D * 2);
constexpr size_t WS_BA = WS_RSTD + 5 * MiB;
constexpr size_t WS_BETA = WS_BA + al((size_t)T * 16 * 4);
constexpr size_t WS_G = WS_BETA + al((size_t)T * 8 * 4);
constexpr size_t WS_ROWW = WS_G + al((size_t)T * 8 * 4);
constexpr int NSLOT = 2 * T + NEXP * 256;
constexpr size_t WS_PROJ = WS_ROWW + al((size_t)2 * 8 * T * 4);
constexpr size_t WS_YMIX = WS_PROJ + al((size_t)NSLOT * DFFE * 2);
constexpr size_t WS_C = WS_YMIX + al((size_t)T * D * 2);
constexpr size_t WS_WRT = WS_C + (size_t)388 * MiB;
constexpr size_t WS_END = WS_WRT + 1 * MiB;
static_assert(WS_END <= (size_t)975 * MiB, "d_ws map exceeds the guaranteed workspace");
static_assert((size_t)NEXP * 2 * DFFE * D * 2 <= (size_t)388 * MiB, "MoE gate/up bf16 weights overlay the mixer scratch");
constexpr int RING_BYTES = 131072, LDSCTL_OFF = RING_BYTES, MISC_OFF = LDSCTL_OFF + 320, LDS_BYTES = 147456;

__device__ __forceinline__ void transpose_item(const float* W, int ldw, int col_off, int K, int nblk, const float* gain, bf16* WT, int blk, int blk_stride, int row_off, int item, int lane) {
    const int kb = item / nblk, nb = item % nblk, k0 = 64 * kb + (lane >> 4) * 16, n0 = 64 * nb + (lane & 15) * 4;
    const float* src = W + (size_t)k0 * ldw + col_off + n0;
    f32x4 v[16];
#pragma unroll
    for (int j = 0; j < 16; ++j) v[j] = __builtin_nontemporal_load((const f32x4*)(src + (size_t)j * ldw));
    if (gain) {
#pragma unroll
        for (int q = 0; q < 4; ++q) { const f32x4 g = *(const f32x4*)(gain + k0 + 4 * q);
#pragma unroll
            for (int c = 0; c < 4; ++c) v[4 * q + c] = v[4 * q + c] * g[c]; }
    }
#pragma unroll
    for (int i = 0; i < 4; ++i) { const int n = n0 + i, drow = (n / blk) * blk_stride + (n % blk) + row_off;
        u32x4 o0, o1;
        o0.x = pk2(v[0][i], v[1][i]); o0.y = pk2(v[2][i], v[3][i]); o0.z = pk2(v[4][i], v[5][i]); o0.w = pk2(v[6][i], v[7][i]);
        o1.x = pk2(v[8][i], v[9][i]); o1.y = pk2(v[10][i], v[11][i]); o1.z = pk2(v[12][i], v[13][i]); o1.w = pk2(v[14][i], v[15][i]);
        u32x4* dst = (u32x4*)(WT + (size_t)drow * K + k0); dst[0] = o0; dst[1] = o1; }
}
__device__ __forceinline__ void convert_matrix(const float* W, int ldw, int col_off, int K, int N, const float* gain, bf16* WT, int blk, int blk_stride, int row_off, LAS float* scr, int gw, int NGW, int lane) {
    const int nblk = N / 64, nitems = (K / 64) * nblk; (void)scr;
    for (int it = gw; it < nitems; it += NGW) transpose_item(W, ldw, col_off, K, nblk, gain, WT, blk, blk_stride, row_off, it, lane);
}
__device__ __forceinline__ void rowprep_row(const float* x, bf16* xb, float* rstd, const float* Wba, float* ba, int row, int lane) {
    const f32x4* xr = (const f32x4*)(x + (size_t)row * D) + lane;
    f32x4 v[8]; float ss = 0.f;
#pragma unroll
    for (int j = 0; j < 8; ++j) { v[j] = xr[64 * j]; ss += (v[j][0] * v[j][0] + v[j][1] * v[j][1]) + (v[j][2] * v[j][2] + v[j][3] * v[j][3]); }
    ss = wave_sum(ss, lane);
    const float rs = 1.0f / sqrtf(ss * (1.0f / D) + EPS);
    u32x2* o = (u32x2*)(xb + (size_t)row * D) + lane;
#pragma unroll
    for (int j = 0; j < 8; ++j) { u32x2 w; w.x = pk2(v[j][0], v[j][1]); w.y = pk2(v[j][2], v[j][3]); o[64 * j] = w; }
    if (lane == 0) rstd[row] = rs;
    if (Wba) {
        for (int c = 0; c < 16; ++c) { const f32x4* wr = (const f32x4*)(Wba + (size_t)c * D) + lane; float a = 0.f;
#pragma unroll
            for (int j = 0; j < 8; ++j) { const f32x4 w = wr[64 * j]; a += (v[j][0] * w[0] + v[j][1] * w[1]) + (v[j][2] * w[2] + v[j][3] * w[3]); }
            a = wave_sum(a, lane); if (lane == 0) ba[(size_t)row * 16 + c] = a * rs; }
    }
}
__device__ __forceinline__ void lru_conv_elem(const bf16* proj, const float* cw, const float* cb, float* xc, size_t idx) {
    const int t = (int)(idx / DLRU), ch = (int)(idx % DLRU), s = t % SEQ;
    float a = cb[ch];
#pragma unroll
    for (int k = 0; k < 4; ++k) { const int sp = s - 3 + k; if (sp >= 0) a += cw[k * DLRU + ch] * bf2f(proj[(size_t)(t - 3 + k) * NPROJ + ch]); }
    xc[idx] = a;
}
__device__ __forceinline__ void lru_gate_elem(const float* xc, const float* w_r, const float* b_r, const float* w_i, const float* b_i, const float* lam, float* av, float* bv, size_t idx) {
    const int t = (int)(idx / DLRU), ch = (int)(idx % DLRU), n = ch >> 7, d = ch & 127;
    float ar = b_r[ch], ai = b_i[ch];
    const float* xr = xc + (size_t)t * DLRU + n * 128; const float* wr = w_r + (size_t)n * 128 * 128 + d; const float* wi = w_i + (size_t)n * 128 * 128 + d;
    for (int c = 0; c < 128; ++c) { const float xv = xr[c]; ar += xv * wr[c * 128]; ai += xv * wi[c * 128]; }
    const float r = sigmoid_f(ar), ig = sigmoid_f(ai);
    const float log_a = -8.0f * r * softplus_f(-lam[ch]);
    const float a = expf(log_a), mult = sqrtf(-expm1f(2.0f * log_a));
    av[idx] = a; bv[idx] = mult * (ig * xc[idx]);
}
__device__ __forceinline__ void lru_scan_chan(float* av, const float* bv, const bf16* proj, int idx) {
    const int b = idx / DLRU, ch = idx % DLRU;
    float h = 0.f;
    for (int s0 = 0; s0 < SEQ; s0 += 8) {
        float a8[8], b8[8], g8[8];
#pragma unroll
        for (int j = 0; j < 8; ++j) { const size_t t = (size_t)b * SEQ + s0 + j; a8[j] = av[t * DLRU + ch]; b8[j] = bv[t * DLRU + ch]; g8[j] = bf2f(proj[t * NPROJ + DLRU + ch]); }
#pragma unroll
        for (int j = 0; j < 8; ++j) { const size_t t = (size_t)b * SEQ + s0 + j; h = a8[j] * h + b8[j]; av[t * DLRU + ch] = h * gelu_tanh_f(g8[j]); }
    }
}
__device__ __forceinline__ void lru_norm_row(const float* y, const float* gain, bf16* ymix, int row, int lane) {
    const f32x4* yr = (const f32x4*)(y + (size_t)row * DLRU) + lane; const f32x4* gr = (const f32x4*)gain + lane;
    f32x4 v[4]; float ss = 0.f;
#pragma unroll
    for (int j = 0; j < 4; ++j) { v[j] = yr[64 * j]; ss += (v[j][0] * v[j][0] + v[j][1] * v[j][1]) + (v[j][2] * v[j][2] + v[j][3] * v[j][3]); }
    ss = wave_sum(ss, lane); const float rs = 1.0f / sqrtf(ss * (1.0f / DLRU) + EPS);
    u32x2* o = (u32x2*)(ymix + (size_t)row * D) + lane;
#pragma unroll
    for (int j = 0; j < 4; ++j) { const f32x4 g = gr[64 * j]; u32x2 w; w.x = pk2(v[j][0] * rs * g[0], v[j][1] * rs * g[1]); w.y = pk2(v[j][2] * rs * g[2], v[j][3] * rs * g[3]); o[64 * j] = w; }
}
__device__ __forceinline__ void dn_prep_item(const bf16* proj, const float* cw, const float* ba, const float* a_log, const float* dt_bias, float* qn, float* kn, float* vn, float* beta, float* gg, int w, int lane) {
    const int t = w >> 3, h = w & 7, s = t % SEQ;
    float val[3][2];
#pragma unroll
    for (int p = 0; p < 3; ++p)
#pragma unroll
        for (int e = 0; e < 2; ++e) { const int d = lane * 2 + e, c = p * DDN + h * HD + d; float a = 0.f;
#pragma unroll
            for (int k = 0; k < 4; ++k) { const int sp = s - 3 + k; if (sp >= 0) a += cw[k * 3 * DDN + c] * bf2f(proj[(size_t)(t - 3 + k) * NPROJ + 2048 + c]); }
            val[p][e] = silu_f(a); }
    const float sq = wave_sum(val[0][0] * val[0][0] + val[0][1] * val[0][1], lane), sk = wave_sum(val[1][0] * val[1][0] + val[1][1] * val[1][1], lane);
    const float rq = (1.0f / sqrtf(sq + EPS)) * 0.08838834764831845f, rk = 1.0f / sqrtf(sk + EPS);
    const size_t o = ((size_t)t * NH + h) * HD + lane * 2;
    qn[o] = val[0][0] * rq; qn[o + 1] = val[0][1] * rq; kn[o] = val[1][0] * rk; kn[o + 1] = val[1][1] * rk; vn[o] = val[2][0]; vn[o + 1] = val[2][1];
    if (lane == 0) { beta[t * NH + h] = sigmoid_f(ba[(size_t)t * 16 + h]); gg[t * NH + h] = -__expf(a_log[h]) * softplus_f(ba[(size_t)t * 16 + 8 + h] + dt_bias[h]); }
}
__device__ __forceinline__ void dn_rec_seq(const float* qn, const float* kn, const float* vn, const float* beta, const float* gg, float* o, int bh, LAS float* sk, LAS float* sq, LAS float* st, int tid) {
    const int b = bh >> 3, h = bh & 7, j = tid & 127; const bool act = tid < 128;
    if (act) for (int k = 0; k < 128; ++k) st[k * 128 + j] = 0.f;
    const size_t base = ((size_t)(b * SEQ) * NH + h) * HD;
    float nk = kn[base + j], nq = qn[base + j], nv = vn[base + j], nb = beta[(b * SEQ) * NH + h], ng = gg[(b * SEQ) * NH + h];
    for (int s = 0; s < SEQ; ++s) {
        const int buf = (s & 1) * 128;
        if (act) { sk[buf + j] = nk; sq[buf + j] = nq; }
        const float vj = nv, be = nb, ge = __expf(ng);
        __syncthreads();
        if (act) {
            if (s + 1 < SEQ) { const size_t nb_ = ((size_t)(b * SEQ + s + 1) * NH + h) * HD; nk = kn[nb_ + j]; nq = qn[nb_ + j]; nv = vn[nb_ + j]; nb = beta[(b * SEQ + s + 1) * NH + h]; ng = gg[(b * SEQ + s + 1) * NH + h]; }
            float ks = 0.f;
#pragma unroll 8
            for (int k = 0; k < 128; ++k) ks += sk[buf + k] * st[k * 128 + j];
            const float vnew = be * (vj - ge * ks);
            float oo = 0.f;
#pragma unroll 8
            for (int k = 0; k < 128; ++k) { const float sv = ge * st[k * 128 + j] + sk[buf + k] * vnew; st[k * 128 + j] = sv; oo += sq[buf + k] * sv; }
            o[((size_t)(b * SEQ + s) * NH + h) * HD + j] = oo;
        }
    }
    __syncthreads();
}
typedef short bf16x8 __attribute__((ext_vector_type(8)));
__device__ __forceinline__ f32x4 mfma16(bf16x8 a, bf16x8 b, f32x4 c) { return __builtin_amdgcn_mfma_f32_16x16x32_bf16(a, b, c, 0, 0, 0); }
__device__ __forceinline__ float bflo(unsigned x) { return __uint_as_float(x << 16); }
__device__ __forceinline__ float bfhi(unsigned x) { return __uint_as_float(x & 0xffff0000u); }
constexpr int DA_G = 0, DA_L = 1024, DA_KN = DA_L + 16384, DA_QN = DA_KN + 17408, DA_VBT = DA_QN + 17408, DA_KBET = DA_VBT + 18432, DA_KDT = DA_KBET + 18432, DA_TB = DA_KDT + 18432, DA_QK = DA_TB + 9216, DA_END = DA_QK + 9216;
static_assert(DA_END <= RING_BYTES, "DN-A LDS map");
#if defined(PROBE_DNA_A)
#define DNA_ST(k) do { if (threadIdx.x == 0) ((volatile LAS unsigned long long*)(lds + (RING_BYTES + 2048)))[k] = __builtin_amdgcn_s_memrealtime(); } while (0)
#else
#define DNA_ST(k) do { } while (0)
#endif
__device__ __forceinline__ void dna_unit(const bf16* proj, const float* cw, const float* ba, const float* a_log, const float* dt_bias,
                                         bf16* Wf, bf16* Qf, bf16* KdTf, bf16* QKf, bf16* Uf, float* glb, int uid, LAS unsigned char* lds, int tid, int lane, int wave) {
    const int h = uid & 7, n = (uid >> 3) & 127, b = uid >> 10, t0 = b * SEQ + n * 64;
    asm volatile("" : "+v"(lds));
    DNA_ST(0);
    LAS float* Gs = (LAS float*)(lds + DA_G);
    const int fr = lane & 15, fq = lane >> 4;
    if (wave == 0) {
        const size_t t = (size_t)(t0 + lane);
        const float be = sigmoid_f(ba[t * 16 + h]); float Gc = -__expf(a_log[h]) * softplus_f(ba[t * 16 + 8 + h] + dt_bias[h]);
#pragma unroll
        for (int off = 1; off < 64; off <<= 1) { const float tmp = shfl_up_l(Gc, off, lane); if (lane >= off) Gc += tmp; }
        const float GL = shfl_idx_l(Gc, 63);
        Gs[lane] = Gc; Gs[64 + lane] = be; Gs[128 + lane] = __expf(Gc); Gs[192 + lane] = __expf(GL - Gc);
        if (lane == 63) glb[uid] = __expf(Gc);
    }
    LDS_BARRIER();
    DNA_ST(1);
    {
        const int r = tid >> 3, cg = tid & 7;
        const float be = Gs[64 + r], eg = Gs[128 + r], egl = Gs[192 + r];
        float val[3][16];
#pragma unroll
        for (int p = 0; p < 3; ++p) {
            const int ccol = p * DDN + h * HD + cg * 16;
            float acc[16];
#pragma unroll
            for (int i = 0; i < 16; ++i) acc[i] = 0.f;
#pragma unroll
            for (int k = 0; k < 4; ++k) { const int row = r - 3 + k;
                if (n * 64 + row >= 0) {
                    const bf16* src = proj + (size_t)(t0 + row) * NPROJ + 2048 + ccol;
                    const u32x4 x0 = *(const u32x4*)src, x1 = *(const u32x4*)(src + 8);
                    const float* wp = cw + k * 3 * DDN + ccol;
                    const f32x4 w0 = *(const f32x4*)wp, w1 = *(const f32x4*)(wp + 4), w2 = *(const f32x4*)(wp + 8), w3 = *(const f32x4*)(wp + 12);
                    acc[0] += w0[0] * bflo(x0.x); acc[1] += w0[1] * bfhi(x0.x); acc[2] += w0[2] * bflo(x0.y); acc[3] += w0[3] * bfhi(x0.y);
                    acc[4] += w1[0] * bflo(x0.z); acc[5] += w1[1] * bfhi(x0.z); acc[6] += w1[2] * bflo(x0.w); acc[7] += w1[3] * bfhi(x0.w);
                    acc[8] += w2[0] * bflo(x1.x); acc[9] += w2[1] * bfhi(x1.x); acc[10] += w2[2] * bflo(x1.y); acc[11] += w2[3] * bfhi(x1.y);
                    acc[12] += w3[0] * bflo(x1.z); acc[13] += w3[1] * bfhi(x1.z); acc[14] += w3[2] * bflo(x1.w); acc[15] += w3[3] * bfhi(x1.w);
                } }
#pragma unroll
            for (int i = 0; i < 16; ++i) val[p][i] = silu_f(acc[i]);
        }
        float sq = 0.f, sk = 0.f;
#pragma unroll
        for (int i = 0; i < 16; ++i) { sq += val[0][i] * val[0][i]; sk += val[1][i] * val[1][i]; }
        sq += shfl_xor_l(sq, 1, lane); sq += shfl_xor_l(sq, 2, lane); sq += shfl_xor_l(sq, 4, lane);
        sk += shfl_xor_l(sk, 1, lane); sk += shfl_xor_l(sk, 2, lane); sk += shfl_xor_l(sk, 4, lane);
        const float rq = (1.0f / sqrtf(sq + EPS)) * 0.08838834764831845f, rk = 1.0f / sqrtf(sk + EPS);
#pragma unroll
        for (int i = 0; i < 16; ++i) { val[0][i] *= rq; val[1][i] *= rk; }
        u32x4 o0, o1;
        o0.x = pk2(val[1][0], val[1][1]); o0.y = pk2(val[1][2], val[1][3]); o0.z = pk2(val[1][4], val[1][5]); o0.w = pk2(val[1][6], val[1][7]);
        o1.x = pk2(val[1][8], val[1][9]); o1.y = pk2(val[1][10], val[1][11]); o1.z = pk2(val[1][12], val[1][13]); o1.w = pk2(val[1][14], val[1][15]);
        *(LAS u32x4*)(lds + DA_KN + r * 272 + cg * 32) = o0; *(LAS u32x4*)(lds + DA_KN + r * 272 + cg * 32 + 16) = o1;
        o0.x = pk2(val[0][0], val[0][1]); o0.y = pk2(val[0][2], val[0][3]); o0.z = pk2(val[0][4], val[0][5]); o0.w = pk2(val[0][6], val[0][7]);
        o1.x = pk2(val[0][8], val[0][9]); o1.y = pk2(val[0][10], val[0][11]); o1.z = pk2(val[0][12], val[0][13]); o1.w = pk2(val[0][14], val[0][15]);
        *(LAS u32x4*)(lds + DA_QN + r * 272 + cg * 32) = o0; *(LAS u32x4*)(lds + DA_QN + r * 272 + cg * 32 + 16) = o1;
#pragma unroll
        for (int i = 0; i < 16; ++i) { const int f = cg * 16 + i;
            *(LAS unsigned short*)(lds + DA_VBT + f * 144 + r * 2) = (unsigned short)f2bf(val[2][i] * be);
            *(LAS unsigned short*)(lds + DA_KBET + f * 144 + r * 2) = (unsigned short)f2bf(val[1][i] * (be * eg));
            *(LAS unsigned short*)(lds + DA_KDT + f * 144 + r * 2) = (unsigned short)f2bf(val[1][i] * egl); }
    }
    LDS_BARRIER();
    DNA_ST(2);
    {
        const int p = wave >> 2, ti = wave & 3;
        const int abase = p == 0 ? DA_KN : DA_QN;
        bf16x8 af[4];
#pragma unroll
        for (int ks = 0; ks < 4; ++ks) af[ks] = *(const LAS bf16x8*)(lds + abase + (ti * 16 + fr) * 272 + (ks * 32 + fq * 8) * 2);
        for (int tj = 0; tj < 4; ++tj) {
            f32x4 acc = {0.f, 0.f, 0.f, 0.f};
            if (tj <= ti) {
#pragma unroll
                for (int ks = 0; ks < 4; ++ks) { const bf16x8 bb = *(const LAS bf16x8*)(lds + DA_KN + (tj * 16 + fr) * 272 + (ks * 32 + fq * 8) * 2); acc = mfma16(af[ks], bb, acc); }
            }
            const int j = tj * 16 + fr; const float Gj = Gs[j];
#pragma unroll
            for (int r = 0; r < 4; ++r) { const int i = ti * 16 + fq * 4 + r; float v = 0.f;
                if (p == 0) { if (i > j) v = Gs[64 + i] * acc[r] * __expf(Gs[i] - Gj); *(LAS float*)(lds + DA_L + (j * 64 + i) * 4) = v; }
                else { if (i >= j) v = acc[r] * __expf(Gs[i] - Gj); *(LAS unsigned short*)(lds + DA_QK + i * 144 + j * 2) = (unsigned short)f2bf(v); } }
        }
    }
    LDS_BARRIER();
    DNA_ST(3);
    {
        int lc = lane; asm volatile("" : "+v"(lc)); const float fl = (float)lc;
        const int blk = wave < 4 ? wave : 11 - wave;
        float Tr[8];
#pragma unroll
        for (int c = 0; c < 8; ++c) Tr[c] = fmaxf(0.f, 1.f - fabsf(fl - (float)(blk * 8 + c)));
        float lj[63];
#pragma unroll
        for (int j = 0; j < 63; ++j) lj[j] = *(const LAS float*)(lds + DA_L + (j * 64) * 4 + lc * 4);
#pragma unroll
        for (int j = 0; j < 63; ++j) {
            if (j >= blk * 8) {
#pragma unroll
                for (int c = 0; c < 8; ++c) { const float tj = __int_as_float(__builtin_amdgcn_readlane(__float_as_int(Tr[c]), j)); Tr[c] -= lj[j] * tj; }
            }
        }
        u32x4 o; o.x = pk2(Tr[0], Tr[1]); o.y = pk2(Tr[2], Tr[3]); o.z = pk2(Tr[4], Tr[5]); o.w = pk2(Tr[6], Tr[7]);
        *(LAS u32x4*)(lds + DA_TB + lc * 144 + blk * 16) = o;
    }
    {
        for (int fi = wave; fi < 40; fi += 8) {
            if (fi < 8) { const int mt = fi >> 1, ks = fi & 1;
                const u32x4 v = *(const LAS u32x4*)(lds + DA_QK + (mt * 16 + fr) * 144 + (ks * 32 + fq * 8) * 2);
                *(u32x4*)(QKf + (((size_t)uid * 4 + mt) * 2 + ks) * 512 + lane * 8) = v; }
            else if (fi < 24) { const int f2 = fi - 8, mt = f2 >> 2, ks = f2 & 3; const float eg = Gs[128 + mt * 16 + fr];
                const u32x4 v = *(const LAS u32x4*)(lds + DA_QN + (mt * 16 + fr) * 272 + (ks * 32 + fq * 8) * 2); u32x4 o;
                o.x = pk2(bflo(v.x) * eg, bfhi(v.x) * eg); o.y = pk2(bflo(v.y) * eg, bfhi(v.y) * eg); o.z = pk2(bflo(v.z) * eg, bfhi(v.z) * eg); o.w = pk2(bflo(v.w) * eg, bfhi(v.w) * eg);
                *(u32x4*)(Qf + (((size_t)uid * 4 + mt) * 4 + ks) * 512 + lane * 8) = o; }
            else { const int f2 = fi - 24, ft = f2 >> 1, ks = f2 & 1;
                const u32x4 v = *(const LAS u32x4*)(lds + DA_KDT + (ft * 16 + fr) * 144 + (ks * 32 + fq * 8) * 2);
                *(u32x4*)(KdTf + (((size_t)uid * 8 + ft) * 2 + ks) * 512 + lane * 8) = v; }
        }
    }
    LDS_BARRIER();
    DNA_ST(4);
    {
        bf16x8 ta[4][2];
#pragma unroll
        for (int mt = 0; mt < 4; ++mt)
#pragma unroll
            for (int ks = 0; ks < 2; ++ks) ta[mt][ks] = *(const LAS bf16x8*)(lds + DA_TB + (mt * 16 + fr) * 144 + (ks * 32 + fq * 8) * 2);
#pragma unroll
        for (int c2 = 0; c2 < 2; ++c2) { const int ct = wave * 2 + c2, img = ct < 8 ? DA_VBT : DA_KBET, cr = (ct & 7) * 16 + fr;
            bf16x8 bb[2];
#pragma unroll
            for (int ks = 0; ks < 2; ++ks) bb[ks] = *(const LAS bf16x8*)(lds + img + cr * 144 + (ks * 32 + fq * 8) * 2);
#pragma unroll
            for (int mt = 0; mt < 4; ++mt) { f32x4 acc = {0.f, 0.f, 0.f, 0.f};
#pragma unroll
                for (int ks = 0; ks < 2; ++ks) acc = mfma16(ta[mt][ks], bb[ks], acc);
                if (ct < 8) { u32x2 o; o.x = pk2(acc[0], acc[1]); o.y = pk2(acc[2], acc[3]); *(u32x2*)(Uf + ((((size_t)uid * 8 + ct) * 4 + mt) * 64 + lane) * 4) = o; }
                else { const int f = (ct - 8) * 16 + fr;
#pragma unroll
                    for (int r = 0; r < 4; ++r) *(LAS unsigned short*)(lds + DA_KN + (mt * 16 + fq * 4 + r) * 272 + f * 2) = (unsigned short)f2bf(acc[r]); } }
        }
    }
    LDS_BARRIER();
    DNA_ST(5);
#pragma unroll
    for (int q2 = 0; q2 < 2; ++q2) { const int fi = wave * 2 + q2, mt = fi >> 2, ks = fi & 3;
        const u32x4 v = *(const LAS u32x4*)(lds + DA_KN + (mt * 16 + fr) * 272 + (ks * 32 + fq * 8) * 2);
        *(u32x4*)(Wf + (((size_t)uid * 4 + mt) * 4 + ks) * 512 + lane * 8) = v; }
    LDS_BARRIER();
    DNA_ST(6);
}
struct DnbFrag { bf16x8 a1[4]; bf16x8 a2[2]; bf16x8 kd[2]; u32x2 u; float gl; };
__device__ __forceinline__ DnbFrag dnb_load(const bf16* A1, const bf16* QKf, const bf16* KdTf, const bf16* Uf, const float* glb, int uid, int ds, int wave, int lane) {
    DnbFrag f; const int mt = wave & 3;
#pragma unroll
    for (int ks = 0; ks < 4; ++ks) f.a1[ks] = *(const bf16x8*)(A1 + (((size_t)uid * 4 + mt) * 4 + ks) * 512 + lane * 8);
#pragma unroll
    for (int ks = 0; ks < 2; ++ks) f.kd[ks] = *(const bf16x8*)(KdTf + (((size_t)uid * 8 + wave) * 2 + ks) * 512 + lane * 8);
#pragma unroll
    for (int ks = 0; ks < 2; ++ks) f.a2[ks] = *(const bf16x8*)(QKf + (((size_t)uid * 4 + mt) * 2 + ks) * 512 + lane * 8);
    f.u = *(const u32x2*)(Uf + ((((size_t)uid * 8 + ds) * 4 + mt) * 64 + lane) * 4);
    f.gl = glb[uid];
    return f;
}
__device__ __forceinline__ void dnb_run(const bf16* Wf, const bf16* Qf, const bf16* KdTf, const bf16* QKf, const bf16* Uf, const float* glb, float* o, int bh, int ds, LAS unsigned char* lds, int tid, int lane, int wave) {
    const int b = bh >> 3, h = bh & 7, fr = lane & 15, fq = lane >> 4, mt = wave & 3;
    asm volatile("" : "+v"(lds));
    LAS unsigned char* ST = lds; LAS unsigned char* VNT = lds + 4608;
    for (int i = tid; i < 4608 / 4; i += 512) ((LAS unsigned*)ST)[i] = 0u;
    f32x4 accS = {0.f, 0.f, 0.f, 0.f};
    const bf16* A1 = wave < 4 ? Wf : Qf;
    DnbFrag f0 = dnb_load(A1, QKf, KdTf, Uf, glb, (b * 128 + 0) * 8 + h, ds, wave, lane), f1 = dnb_load(A1, QKf, KdTf, Uf, glb, (b * 128 + 1) * 8 + h, ds, wave, lane);
    DnbFrag f2 = dnb_load(A1, QKf, KdTf, Uf, glb, (b * 128 + 2) * 8 + h, ds, wave, lane), f3 = dnb_load(A1, QKf, KdTf, Uf, glb, (b * 128 + 3) * 8 + h, ds, wave, lane);
    __syncthreads();
#define DNB_STEP(F, nn) do { const int n = (nn); \
        f32x4 acc = {0.f, 0.f, 0.f, 0.f}; \
        _Pragma("unroll") for (int ks = 0; ks < 4; ++ks) { const bf16x8 sb = *(const LAS bf16x8*)(ST + fr * 272 + (ks * 32 + fq * 8) * 2); acc = mfma16(F.a1[ks], sb, acc); } \
        if (wave < 4) { const float v0 = bflo(F.u.x) - acc[0], v1 = bfhi(F.u.x) - acc[1], v2 = bflo(F.u.y) - acc[2], v3 = bfhi(F.u.y) - acc[3]; \
            u32x2 w; w.x = pk2(v0, v1); w.y = pk2(v2, v3); *(LAS u32x2*)(VNT + fr * 144 + (mt * 16 + fq * 4) * 2) = w; } \
        LDS_BARRIER(); \
        bf16x8 vb[2]; \
        _Pragma("unroll") for (int ks = 0; ks < 2; ++ks) vb[ks] = *(const LAS bf16x8*)(VNT + fr * 144 + (ks * 32 + fq * 8) * 2); \
        if (wave >= 4) { _Pragma("unroll") for (int ks = 0; ks < 2; ++ks) acc = mfma16(F.a2[ks], vb[ks], acc); \
            const size_t ob = ((size_t)(b * SEQ + n * 64 + mt * 16 + fq * 4) * NH + h) * HD + ds * 16 + fr; \
            _Pragma("unroll") for (int r = 0; r < 4; ++r) o[ob + (size_t)r * NH * HD] = acc[r]; } \
        accS = accS * F.gl; \
        _Pragma("unroll") for (int ks = 0; ks < 2; ++ks) accS = mfma16(F.kd[ks], vb[ks], accS); \
        { u32x2 w; w.x = pk2(accS[0], accS[1]); w.y = pk2(accS[2], accS[3]); *(LAS u32x2*)(ST + fr * 272 + (wave * 16 + fq * 4) * 2) = w; } \
        F = dnb_load(A1, QKf, KdTf, Uf, glb, (b * 128 + (n + 4 < 128 ? n + 4 : 127)) * 8 + h, ds, wave, lane);     \
        LDS_BARRIER(); } while (0)
    for (int n4 = 0; n4 < 128; n4 += 16) {
        DNB_STEP(f0, n4); DNB_STEP(f1, n4 + 1); DNB_STEP(f2, n4 + 2); DNB_STEP(f3, n4 + 3); DNB_STEP(f0, n4 + 4); DNB_STEP(f1, n4 + 5); DNB_STEP(f2, n4 + 6); DNB_STEP(f3, n4 + 7);
        DNB_STEP(f0, n4 + 8); DNB_STEP(f1, n4 + 9); DNB_STEP(f2, n4 + 10); DNB_STEP(f3, n4 + 11); DNB_STEP(f0, n4 + 12); DNB_STEP(f1, n4 + 13); DNB_STEP(f2, n4 + 14); DNB_STEP(f3, n4 + 15); }
#undef DNB_STEP
}
constexpr int LA_XB = 0, LA_XF = 17408, LA_END = LA_XF + 64 * 132 * 4;
static_assert(LA_END <= RING_BYTES, "LRU-A LDS map");
__device__ __forceinline__ void lrua_unit(const bf16* proj, const float* cw, const float* cb, const bf16* WrT, const bf16* WiT, const float* b_r, const float* b_i, const float* lam,
                                          float* Hloc, float* Acum, float* summ, int unit, LAS unsigned char* lds, int tid, int lane, int wave) {
    const int nb = unit & 7, ct = unit >> 3, n = ct & 127, t0 = ct * 64;
    asm volatile("" : "+v"(lds));
    {
        const int r = tid >> 3, cg = tid & 7, ch0 = nb * 128 + cg * 16;
        float acc[16];
        { const f32x4 c0v = *(const f32x4*)(cb + ch0), c1v = *(const f32x4*)(cb + ch0 + 4), c2v = *(const f32x4*)(cb + ch0 + 8), c3v = *(const f32x4*)(cb + ch0 + 12);
#pragma unroll
          for (int i = 0; i < 4; ++i) { acc[i] = c0v[i]; acc[4 + i] = c1v[i]; acc[8 + i] = c2v[i]; acc[12 + i] = c3v[i]; } }
#pragma unroll
        for (int k = 0; k < 4; ++k) { const int row = r - 3 + k;
            if (n * 64 + row >= 0) {
                const bf16* src = proj + (size_t)(t0 + row) * NPROJ + ch0;
                const u32x4 x0 = *(const u32x4*)src, x1 = *(const u32x4*)(src + 8);
                const float* wp = cw + k * DLRU + ch0;
                const f32x4 w0 = *(const f32x4*)wp, w1 = *(const f32x4*)(wp + 4), w2 = *(const f32x4*)(wp + 8), w3 = *(const f32x4*)(wp + 12);
                acc[0] += w0[0] * bflo(x0.x); acc[1] += w0[1] * bfhi(x0.x); acc[2] += w0[2] * bflo(x0.y); acc[3] += w0[3] * bfhi(x0.y);
                acc[4] += w1[0] * bflo(x0.z); acc[5] += w1[1] * bfhi(x0.z); acc[6] += w1[2] * bflo(x0.w); acc[7] += w1[3] * bfhi(x0.w);
                acc[8] += w2[0] * bflo(x1.x); acc[9] += w2[1] * bfhi(x1.x); acc[10] += w2[2] * bflo(x1.y); acc[11] += w2[3] * bfhi(x1.y);
                acc[12] += w3[0] * bflo(x1.z); acc[13] += w3[1] * bfhi(x1.z); acc[14] += w3[2] * bflo(x1.w); acc[15] += w3[3] * bfhi(x1.w);
            } }
        u32x4 o0, o1;
        o0.x = pk2(acc[0], acc[1]); o0.y = pk2(acc[2], acc[3]); o0.z = pk2(acc[4], acc[5]); o0.w = pk2(acc[6], acc[7]);
        o1.x = pk2(acc[8], acc[9]); o1.y = pk2(acc[10], acc[11]); o1.z = pk2(acc[12], acc[13]); o1.w = pk2(acc[14], acc[15]);
        *(LAS u32x4*)(lds + LA_XB + r * 272 + cg * 32) = o0; *(LAS u32x4*)(lds + LA_XB + r * 272 + cg * 32 + 16) = o1;
        LAS f32x4* xf = (LAS f32x4*)(lds + LA_XF + (r * 132 + cg * 16) * 4);
        xf[0] = (f32x4){acc[0], acc[1], acc[2], acc[3]}; xf[1] = (f32x4){acc[4], acc[5], acc[6], acc[7]}; xf[2] = (f32x4){acc[8], acc[9], acc[10], acc[11]}; xf[3] = (f32x4){acc[12], acc[13], acc[14], acc[15]};
    }
    LDS_BARRIER();
    const int fr = lane & 15, fq = lane >> 4, cl = wave * 16 + fr, ch = nb * 128 + cl;
    bf16x8 br[4], bi[4];
#pragma unroll
    for (int ks = 0; ks < 4; ++ks) { br[ks] = *(const bf16x8*)(WrT + ((size_t)nb * 128 + cl) * 128 + ks * 32 + fq * 8); bi[ks] = *(const bf16x8*)(WiT + ((size_t)nb * 128 + cl) * 128 + ks * 32 + fq * 8); }
    f32x4 ar[4], ai[4];
#pragma unroll
    for (int mt = 0; mt < 4; ++mt) { ar[mt] = (f32x4){0.f, 0.f, 0.f, 0.f}; ai[mt] = (f32x4){0.f, 0.f, 0.f, 0.f};
#pragma unroll
        for (int ks = 0; ks < 4; ++ks) { const bf16x8 af = *(const LAS bf16x8*)(lds + LA_XB + (mt * 16 + fr) * 272 + (ks * 32 + fq * 8) * 2); ar[mt] = mfma16(af, br[ks], ar[mt]); ai[mt] = mfma16(af, bi[ks], ai[mt]); } }
    const float brr = b_r[ch], bii = b_i[ch], sp8 = -8.0f * softplus_f(-lam[ch]);
    float Ac = 1.f, Bc = 0.f;
#pragma unroll
    for (int mt = 0; mt < 4; ++mt) {
        float P[4], H[4];
#pragma unroll
        for (int r = 0; r < 4; ++r) { const int t = mt * 16 + fq * 4 + r; const float xcv = *(const LAS float*)(lds + LA_XF + (t * 132 + cl) * 4);
            const float rr = sigmoid_f(ar[mt][r] + brr), ii = sigmoid_f(ai[mt][r] + bii), la = sp8 * rr, a = __expf(la), bb = sqrtf(fmaxf(1.0f - a * a, 0.0f)) * (ii * xcv);
            if (r == 0) { P[0] = a; H[0] = bb; } else { P[r] = P[r - 1] * a; H[r] = a * H[r - 1] + bb; } }
        float Ai = P[3], Bi = H[3];
        { const float Au = shfl_up_l(Ai, 16, lane), Bu = shfl_up_l(Bi, 16, lane); if (fq >= 1) { Bi = Ai * Bu + Bi; Ai = Au * Ai; } }
        { const float Au = shfl_up_l(Ai, 32, lane), Bu = shfl_up_l(Bi, 32, lane); if (fq >= 2) { Bi = Ai * Bu + Bi; Ai = Au * Ai; } }
        float Ae = shfl_up_l(Ai, 16, lane), Be = shfl_up_l(Bi, 16, lane); if (fq == 0) { Ae = 1.f; Be = 0.f; }
        const float At = shfl_idx_l(Ai, 48 + fr), Bt = shfl_idx_l(Bi, 48 + fr);
        const float PA = Ac * Ae, PB = Ae * Bc + Be;
#pragma unroll
        for (int r = 0; r < 4; ++r) { const size_t o = (size_t)(t0 + mt * 16 + fq * 4 + r) * DLRU + ch; ((unsigned*)Hloc)[o] = pk2(P[r] * PB + H[r], PA * P[r]); }
        Bc = At * Bc + Bt; Ac = Ac * At;
    }
    if (fq == 0) { float* sp = summ + ((size_t)ct * DLRU + ch) * 2; sp[0] = Ac; sp[1] = Bc; }
    LDS_BARRIER();
}
__device__ __forceinline__ void lru_carry(const float* summ, float* carry, int idx) {
    const int b = idx >> 10, ch = idx & 1023; float c = 0.f;
    for (int n0 = 0; n0 < 128; n0 += 8) { float A[8], B[8];
#pragma unroll
        for (int j = 0; j < 8; ++j) { const float* sp = summ + ((size_t)(b * 128 + n0 + j) * DLRU + ch) * 2; A[j] = sp[0]; B[j] = sp[1]; }
#pragma unroll
        for (int j = 0; j < 8; ++j) { carry[(size_t)(b * 128 + n0 + j) * DLRU + ch] = c; c = A[j] * c + B[j]; } }
}
__device__ __forceinline__ void lrub_row(const float* Hloc, const float* Acum, const float* carry, const bf16* proj, const float* gain, bf16* ymix, int row, int lane) {
    const int ct = row >> 6; f32x4 y[4]; float ss = 0.f;
#pragma unroll
    for (int j = 0; j < 4; ++j) { const int c4 = lane * 4 + 256 * j;
        const u32x4 ha = *(const u32x4*)((const unsigned*)Hloc + (size_t)row * DLRU + c4); const f32x4 cr = *(const f32x4*)(carry + (size_t)ct * DLRU + c4);
        const u32x2 g = *(const u32x2*)(proj + (size_t)row * NPROJ + DLRU + c4);
        const f32x4 hl = {bflo(ha.x), bflo(ha.y), bflo(ha.z), bflo(ha.w)}, ac = {bfhi(ha.x), bfhi(ha.y), bfhi(ha.z), bfhi(ha.w)};
        const f32x4 hh = hl + ac * cr;
        y[j][0] = hh[0] * gelu_tanh_f(bflo(g.x)); y[j][1] = hh[1] * gelu_tanh_f(bfhi(g.x)); y[j][2] = hh[2] * gelu_tanh_f(bflo(g.y)); y[j][3] = hh[3] * gelu_tanh_f(bfhi(g.y));
        ss += (y[j][0] * y[j][0] + y[j][1] * y[j][1]) + (y[j][2] * y[j][2] + y[j][3] * y[j][3]); }
    ss = wave_sum(ss, lane); const float rs = 1.0f / sqrtf(ss * (1.0f / DLRU) + EPS);
#pragma unroll
    for (int j = 0; j < 4; ++j) { const int c4 = lane * 4 + 256 * j; const f32x4 g = *(const f32x4*)(gain + c4); u32x2 w; w.x = pk2(y[j][0] * rs * g[0], y[j][1] * rs * g[1]); w.y = pk2(y[j][2] * rs * g[2], y[j][3] * rs * g[3]);
        *(u32x2*)(ymix + (size_t)row * D + c4) = w; }
}
__device__ __forceinline__ void dn_out_row(const float* o, const float* gain, const bf16* proj, bf16* ymix, int t, int lane) {
    const int c = lane * 16;
    const f32x4* op = (const f32x4*)(o + (size_t)t * DDN + c); const f32x4 o0 = op[0], o1 = op[1], o2 = op[2], o3 = op[3];
    const u32x4* gp = (const u32x4*)(proj + (size_t)t * NPROJ + 5120 + c); const u32x4 g0 = gp[0], g1 = gp[1];
    const f32x4* wp = (const f32x4*)(gain + (c & 127)); const f32x4 w0 = wp[0], w1 = wp[1], w2 = wp[2], w3 = wp[3];
    float ss = (o0[0] * o0[0] + o0[1] * o0[1]) + (o0[2] * o0[2] + o0[3] * o0[3]) + (o1[0] * o1[0] + o1[1] * o1[1]) + (o1[2] * o1[2] + o1[3] * o1[3])
             + (o2[0] * o2[0] + o2[1] * o2[1]) + (o2[2] * o2[2] + o2[3] * o2[3]) + (o3[0] * o3[0] + o3[1] * o3[1]) + (o3[2] * o3[2] + o3[3] * o3[3]);
    ss += shfl_xor_l(ss, 1, lane); ss += shfl_xor_l(ss, 2, lane); ss += shfl_xor_l(ss, 4, lane);
    const float rs = 1.0f / sqrtf(ss * (1.0f / HD) + EPS);
    u32x4 r0, r1;
    r0.x = pk2(o0[0] * rs * w0[0] * silu_f(bflo(g0.x)), o0[1] * rs * w0[1] * silu_f(bfhi(g0.x))); r0.y = pk2(o0[2] * rs * w0[2] * silu_f(bflo(g0.y)), o0[3] * rs * w0[3] * silu_f(bfhi(g0.y)));
    r0.z = pk2(o1[0] * rs * w1[0] * silu_f(bflo(g0.z)), o1[1] * rs * w1[1] * silu_f(bfhi(g0.z))); r0.w = pk2(o1[2] * rs * w1[2] * silu_f(bflo(g0.w)), o1[3] * rs * w1[3] * silu_f(bfhi(g0.w)));
    r1.x = pk2(o2[0] * rs * w2[0] * silu_f(bflo(g1.x)), o2[1] * rs * w2[1] * silu_f(bfhi(g1.x))); r1.y = pk2(o2[2] * rs * w2[2] * silu_f(bflo(g1.y)), o2[3] * rs * w2[3] * silu_f(bfhi(g1.y)));
    r1.z = pk2(o3[0] * rs * w3[0] * silu_f(bflo(g1.z)), o3[1] * rs * w3[1] * silu_f(bfhi(g1.z))); r1.w = pk2(o3[2] * rs * w3[2] * silu_f(bflo(g1.w)), o3[3] * rs * w3[3] * silu_f(bfhi(g1.w)));
    u32x4* dst = (u32x4*)(ymix + (size_t)t * D + DLRU + c); dst[0] = r0; dst[1] = r1;
}
__device__ __forceinline__ void route_row(const float* x, const float* rstd, const float* gain, const float* router, float* roww, int row, int lane) {
    float acc[8];
#pragma unroll
    for (int e = 0; e < 8; ++e) acc[e] = 0.f;
    for (int j = 0; j < 32; ++j) { const int k = lane + 64 * j; const float xv = x[(size_t)row * D + k] * gain[k]; const f32x4 r0 = *(const f32x4*)(router + (size_t)k * 8), r1 = *(const f32x4*)(router + (size_t)k * 8 + 4);
        acc[0] += xv * r0[0]; acc[1] += xv * r0[1]; acc[2] += xv * r0[2]; acc[3] += xv * r0[3]; acc[4] += xv * r1[0]; acc[5] += xv * r1[1]; acc[6] += xv * r1[2]; acc[7] += xv * r1[3]; }
    const float rs = rstd[row];
#pragma unroll
    for (int e = 0; e < 8; ++e) acc[e] = wave_sum(acc[e], lane) * rs;
    int e1 = 0; float l1 = acc[0];
#pragma unroll
    for (int e = 1; e < 8; ++e) if (acc[e] > l1) { l1 = acc[e]; e1 = e; }
    int e2 = -1; float l2 = -3.4e38f;
#pragma unroll
    for (int e = 0; e < 8; ++e) if (e != e1 && acc[e] > l2) { l2 = acc[e]; e2 = e; }
    const float w1 = 1.0f / (1.0f + __expf(l2 - l1)), w2 = 1.0f - w1;
    if (lane < 8) roww[(size_t)lane * T + row] = lane == e1 ? w1 : (lane == e2 ? w2 : 0.0f);
}
__device__ __forceinline__ void final_row(const float* x, const float* gain, float* out, int row, int lane) {
    const f32x4* xr = (const f32x4*)(x + (size_t)row * D) + lane; const f32x4* gr = (const f32x4*)gain + lane;
    f32x4 v[8]; float ss = 0.f;
#pragma unroll
    for (int j = 0; j < 8; ++j) { v[j] = xr[64 * j]; ss += (v[j][0] * v[j][0] + v[j][1] * v[j][1]) + (v[j][2] * v[j][2] + v[j][3] * v[j][3]); }
    ss = wave_sum(ss, lane); const float rs = 1.0f / sqrtf(ss * (1.0f / D) + EPS);
    f32x4* o = (f32x4*)(out + (size_t)row * D) + lane;
#pragma unroll
    for (int j = 0; j < 8; ++j) o[64 * j] = v[j] * rs * gr[64 * j];
}

struct MoeOrder {
    const int* list; int nN, G, c; int c0, c1, c2, c3, c4, c5, c6, c7;
    __device__ __forceinline__ void init(const unsigned* cnt, const int* list_, int nN_, int G_, int c_) { list = list_; nN = nN_; G = G_; c = c_;
        c0 = __builtin_amdgcn_readfirstlane((int)cnt[0]); c1 = __builtin_amdgcn_readfirstlane((int)cnt[1]); c2 = __builtin_amdgcn_readfirstlane((int)cnt[2]); c3 = __builtin_amdgcn_readfirstlane((int)cnt[3]);
        c4 = __builtin_amdgcn_readfirstlane((int)cnt[4]); c5 = __builtin_amdgcn_readfirstlane((int)cnt[5]); c6 = __builtin_amdgcn_readfirstlane((int)cnt[6]); c7 = __builtin_amdgcn_readfirstlane((int)cnt[7]); }
    __device__ __forceinline__ bool next(int i, pg8::Unit& u) const {
        const int c8[8] = {c0, c1, c2, c3, c4, c5, c6, c7}; int nM = 0;
#pragma unroll
        for (int k = 0; k < 8; ++k) nM += (c8[k] + 255) >> 8;
        const int nwg = nM * nN; const long L = (long)i * G + c; if (L >= nwg) return false;
        int wgid = (int)L; { const int q = nwg / pg8::NXCD, r = nwg % pg8::NXCD, xcd = wgid % pg8::NXCD, off = wgid / pg8::NXCD; wgid = (xcd < r ? xcd * (q + 1) : r * (q + 1) + (xcd - r) * q) + off; }
        const int nig = pg8::WGM * nN, gid = wgid / nig, fm = gid * pg8::WGM, gsz = (nM - fm) < pg8::WGM ? (nM - fm) : pg8::WGM;
        u.pm = fm + ((wgid % nig) % gsz); u.pn = (wgid % nig) / gsz;
        int e = 0, ps = 0, ce = c8[0], run = 0;
#pragma unroll
        for (int k = 0; k < 8; ++k) { const int mk = (c8[k] + 255) >> 8; if (u.pm >= run && u.pm < run + mk) { e = k; ps = run; ce = c8[k]; } run += mk; }
        const int mtl = u.pm - ps; u.pb = e * nN + u.pn; u.lbase = e * T + mtl * 256; u.nvalid = (ce - mtl * 256) < 256 ? (ce - mtl * 256) : 256;
        return true;
    }
    __device__ __forceinline__ int arow(const pg8::Unit& u, int r) const { return r < u.nvalid ? (list[u.lbase + r] & 0xffff) : 0; }
    __device__ __forceinline__ void a_ready(const pg8::Unit&) const {}
    __device__ __forceinline__ void done(const pg8::Unit&) const {}
};
__device__ __forceinline__ void route_block(const float* x, const float* gain, const float* router, bf16* xb, float* rstd, unsigned* cnt, int* list, float* listw, int blk, LAS unsigned char* lds, int tid, int lane, int wave) {
    asm volatile("" : "+v"(lds));
    LAS float* grt = (LAS float*)lds; LAS int* se1 = (LAS int*)(lds + 65536); LAS int* se2 = se1 + 64; LAS float* sw1 = (LAS float*)(se2 + 64); LAS float* sw2 = sw1 + 64; LAS int* lcnt = (LAS int*)(sw2 + 64); LAS int* gbase = lcnt + 8;
    for (int i = tid; i < D * 8; i += 512) grt[i] = router[i] * gain[i >> 3];
    if (tid < 8) lcnt[tid] = 0;
    __syncthreads();
    for (int q = 0; q < 8; ++q) { const int rloc = wave * 8 + q, row = blk * 64 + rloc;
        const f32x4* xr = (const f32x4*)(x + (size_t)row * D) + lane;
        f32x4 v[8]; float ss = 0.f;
#pragma unroll
        for (int j = 0; j < 8; ++j) { v[j] = xr[64 * j]; ss += (v[j][0] * v[j][0] + v[j][1] * v[j][1]) + (v[j][2] * v[j][2] + v[j][3] * v[j][3]); }
        ss = wave_sum(ss, lane); const float rs = 1.0f / sqrtf(ss * (1.0f / D) + EPS);
        u32x2* o = (u32x2*)(xb + (size_t)row * D) + lane;
#pragma unroll
        for (int j = 0; j < 8; ++j) { u32x2 w; w.x = pk2(v[j][0], v[j][1]); w.y = pk2(v[j][2], v[j][3]); o[64 * j] = w; }
        if (lane == 0) rstd[row] = rs;
        float acc[8];
#pragma unroll
        for (int e = 0; e < 8; ++e) acc[e] = 0.f;
#pragma unroll
        for (int j = 0; j < 8; ++j)
#pragma unroll
            for (int c = 0; c < 4; ++c) { const int k = (lane + 64 * j) * 4 + c; const f32x4 r0 = *(const LAS f32x4*)(grt + k * 8), r1 = *(const LAS f32x4*)(grt + k * 8 + 4); const float xv = v[j][c];
                acc[0] += xv * r0[0]; acc[1] += xv * r0[1]; acc[2] += xv * r0[2]; acc[3] += xv * r0[3]; acc[4] += xv * r1[0]; acc[5] += xv * r1[1]; acc[6] += xv * r1[2]; acc[7] += xv * r1[3]; }
#pragma unroll
        for (int e = 0; e < 8; ++e) acc[e] = wave_sum(acc[e], lane) * rs;
        int e1 = 0; float l1 = acc[0];
#pragma unroll
        for (int e = 1; e < 8; ++e) if (acc[e] > l1) { l1 = acc[e]; e1 = e; }
        int e2 = -1; float l2 = -3.4e38f;
#pragma unroll
        for (int e = 0; e < 8; ++e) if (e != e1 && acc[e] > l2) { l2 = acc[e]; e2 = e; }
        const float w1 = 1.0f / (1.0f + __expf(l2 - l1));
        if (lane == 0) { se1[rloc] = e1; se2[rloc] = e2; sw1[rloc] = w1; sw2[rloc] = 1.0f - w1; }
    }
    __syncthreads();
    int e = 0, lr = 0; float w = 0.f;
    if (tid < 128) { const int rloc = tid >> 1, j = tid & 1; e = j ? se2[rloc] : se1[rloc]; w = j ? sw2[rloc] : sw1[rloc]; lr = __hip_atomic_fetch_add(lcnt + e, 1, __ATOMIC_RELAXED, __HIP_MEMORY_SCOPE_WORKGROUP); }
    __syncthreads();
    if (tid < 8) gbase[tid] = (int)__hip_atomic_fetch_add(cnt + tid, (unsigned)lcnt[tid], __ATOMIC_RELAXED, __HIP_MEMORY_SCOPE_AGENT);
    __syncthreads();
    if (tid < 128) { const int pos = gbase[e] + lr, tok = blk * 64 + (tid >> 1); list[e * T + pos] = tok | ((tid & 1) << 16); listw[e * T + pos] = w; }
    __syncthreads();
}
__device__ __forceinline__ void final_row_moe(const float* x, const bf16* y0, const bf16* y1, const float* gain, float* out, int row, int lane) {
    const f32x4* xr = (const f32x4*)(x + (size_t)row * D) + lane; const f32x4* gr = (const f32x4*)gain + lane;
    const u32x2* p0 = (const u32x2*)(y0 + (size_t)row * D) + lane; const u32x2* p1 = (const u32x2*)(y1 + (size_t)row * D) + lane;
    f32x4 v[8]; float ss = 0.f;
#pragma unroll
    for (int j = 0; j < 8; ++j) { v[j] = xr[64 * j]; const u32x2 a = p0[64 * j], b = p1[64 * j];
        v[j][0] += bflo(a.x) + bflo(b.x); v[j][1] += bfhi(a.x) + bfhi(b.x); v[j][2] += bflo(a.y) + bflo(b.y); v[j][3] += bfhi(a.y) + bfhi(b.y);
        ss += (v[j][0] * v[j][0] + v[j][1] * v[j][1]) + (v[j][2] * v[j][2] + v[j][3] * v[j][3]); }
    ss = wave_sum(ss, lane); const float rs = 1.0f / sqrtf(ss * (1.0f / D) + EPS);
    f32x4* o = (f32x4*)(out + (size_t)row * D) + lane;
#pragma unroll
    for (int j = 0; j < 8; ++j) o[64 * j] = v[j] * rs * gr[64 * j];
}
__device__ __forceinline__ void ba_tail(const bf16* xbp, const bf16* wbab, const float* ssq, float* bap, int rb, int wave, int lane) {
    if (wave < 4) { const int fr = lane & 15, fq = lane >> 4, r0 = rb * 64 + wave * 16;
        const bf16* ap = xbp + (size_t)(r0 + fr) * D + fq * 8; const bf16* bp = wbab + (size_t)fr * D + fq * 8;
        f32x4 acc = {0.f, 0.f, 0.f, 0.f};
#pragma unroll 16
        for (int ks = 0; ks < 64; ++ks) { const bf16x8 a = *(const bf16x8*)(ap + ks * 32), b = *(const bf16x8*)(bp + ks * 32); acc = mfma16(a, b, acc); }
#pragma unroll
        for (int rr = 0; rr < 4; ++rr) { const int r = r0 + fq * 4 + rr; bap[(size_t)r * 16 + fr] = acc[rr] * pg8::row_scale(ssq, r, 1); } }
}
struct Args { const float* in[25]; float* out; unsigned char* ws; int ph_lo, ph_hi; };
typedef const __attribute__((address_space(4))) unsigned long long* kaptr_t;
__device__ __forceinline__ unsigned long long ldka(int i) { kaptr_t ka = (kaptr_t)__builtin_amdgcn_kernarg_segment_ptr(); asm volatile("" : "+s"(i)); return ka[i]; }
__device__ __forceinline__ const float* ldin(const Args&, int i) { return (const float*)(const GAS float*)ldka(i); }
__device__ __forceinline__ unsigned char* ldws(const Args&) { return (unsigned char*)(GAS unsigned char*)ldka(26); }
__device__ __forceinline__ float* ldout(const Args&) { return (float*)(GAS float*)ldka(25); }
__global__ void __launch_bounds__(512, 2) mega(Args args) {
    extern __shared__ __attribute__((aligned(16))) unsigned char lds_raw[];
    LAS unsigned char* lds = (LAS unsigned char*)lds_raw;
    volatile LAS unsigned* MISC = (volatile LAS unsigned*)(lds + MISC_OFF);
    const int tid = threadIdx.x;
    const int G = gridDim.x, bid = blockIdx.x, NGW = G * 8;
    unsigned char* ws = ldws(args);
    for (int u = tid; u < (LDS_BYTES - LDSCTL_OFF) / 4; u += 512) ((LAS unsigned*)(lds + LDSCTL_OFF))[u] = 0u;
    __syncthreads();
    (void)xcd_barrier_post((unsigned*)(ws + WS_CTL) + CW_BAR, MISC + 8);
#define RUN(id) true
#if defined(PROBE_MASK)
#define STAMP() do { if (threadIdx.x == 0) { ((volatile LAS unsigned long long*)(lds + LDSCTL_OFF + 1024))[nst] = __builtin_amdgcn_s_memrealtime(); } ++nst; } while (0)
#else
#define STAMP() do { } while (0)
#endif
#define SEAM(id) do { XcdBarrier bar_; bar_.bar = (unsigned*)WSP(WS_CTL) + CW_BAR; bar_.x = xb_xcc_id(); bar_.st = (volatile LAS unsigned*)(lds + MISC_OFF) + 8; xcd_barrier(bar_); STAMP(); } while (0)
#if defined(PROBE_MASK)
    int nst = 0; STAMP();
#endif
#define INP(i) ldin(args, (i))
#define WSP(off) (ldws(args) + (off))
#define x_in INP(0)
#define norm_mix INP(1)
#define w_in INP(2)
#define conv_lru_w INP(3)
#define conv_lru_b INP(4)
#define lru_w_r INP(5)
#define lru_b_r INP(6)
#define lru_w_i INP(7)
#define lru_b_i INP(8)
#define lru_lambda INP(9)
#define lru_out_norm INP(10)
#define conv_qkv_w INP(11)
#define dn_a_log INP(12)
#define dn_dt_bias INP(13)
#define dn_out_norm INP(14)
#define w_out INP(15)
#define norm_ffn INP(16)
#define ffn_w_gate INP(17)
#define ffn_w_up INP(18)
#define ffn_w_down INP(19)
#define moe_router INP(20)
#define moe_w_gate INP(21)
#define moe_w_up INP(22)
#define moe_w_down INP(23)
#define norm_final INP(24)
#define xres (ldout(args))
#define Win ((bf16*)WSP(WS_WIN))
#define Wba ((float*)WSP(WS_WBA))
#define Wout ((bf16*)WSP(WS_WOUT))
#define Wgu ((bf16*)WSP(WS_WGU))
#define Wd ((bf16*)WSP(WS_WD))
#define Mgu ((bf16*)WSP(WS_C))
#define Md ((bf16*)WSP(WS_WGU))
#define MCNT ((unsigned*)WSP(WS_CTL) + CW_CNT)
#define MLIST ((int*)WSP(WS_ROWW))
#define MLISTW ((float*)WSP(WS_ROWW + (size_t)8 * T * 4))
#define YP0 ((bf16*)WSP(WS_XB))
#define YP1 ((bf16*)WSP(WS_YMIX))
#define xb ((bf16*)WSP(WS_XB))
#define rstd ((float*)WSP(WS_RSTD))
#define SSQA ((float*)WSP(WS_RSTD + (size_t)1 * MiB))
#define SSQB ((float*)WSP(WS_RSTD + (size_t)3 * MiB))
#define WBAB ((bf16*)WSP(WS_WBA + (size_t)2 * 16 * D * 4))
#define ba ((float*)WSP(WS_BA))
#define beta ((float*)WSP(WS_BETA))
#define gg ((float*)WSP(WS_G))
#define roww ((float*)WSP(WS_ROWW))
#define proj ((bf16*)WSP(WS_PROJ))
#define hid ((bf16*)WSP(WS_PROJ))
#define ymix ((bf16*)WSP(WS_YMIX))
#define c0 ((float*)WSP(WS_C))
#define c1 ((float*)WSP(WS_C + (size_t)T * 1024 * 4))
#define c2 ((float*)WSP(WS_C + (size_t)2 * T * 1024 * 4))
#define c3 ((float*)WSP(WS_C + (size_t)3 * T * 1024 * 4))
#define LRU_WRT ((bf16*)WSP(WS_WRT))
#define LRU_WIT ((bf16*)WSP(WS_WRT + (size_t)2 * 8 * 128 * 128 * 2))
#define LRU_H ((float*)WSP(WS_C + (size_t)256 * MiB))
#define LRU_A ((float*)WSP(WS_C + (size_t)320 * MiB))
#define LRU_SUMM ((float*)WSP(WS_C + (size_t)384 * MiB))
#define LRU_CARRY ((float*)WSP(WS_C + (size_t)386 * MiB))
#define DN_WF ((bf16*)WSP(WS_C))
#define DN_QF ((bf16*)WSP(WS_C + (size_t)32 * MiB))
#define DN_KDTF ((bf16*)WSP(WS_C + (size_t)64 * MiB))
#define DN_UF ((bf16*)WSP(WS_C + (size_t)96 * MiB))
#define DN_QKF ((bf16*)WSP(WS_C + (size_t)128 * MiB))
#define DN_GL ((float*)WSP(WS_C + (size_t)144 * MiB))
    const int BIG = 1 << 30;
#define PHL int tid_ = threadIdx.x; asm volatile("" : "+v"(tid_)); const int lane_ = tid_ & 63; int bid_ = blockIdx.x; asm volatile("" : "+s"(bid_)); const int gw_ = bid_ * 8 + __builtin_amdgcn_readfirstlane(tid_ >> 6); const size_t gt_ = (size_t)bid_ * 512 + tid_, NGT = (size_t)G * 512; LAS float* scr = (LAS float*)(lds + (gw_ & 7) * 16384);
    if (RUN(ph)) { PHL
        convert_matrix(w_in, DIN, 0, D, NPROJ, norm_mix, Win, BIG, 0, 0, scr, gw_, NGW, lane_);
        convert_matrix(w_out, D, 0, D, D, nullptr, Wout, BIG, 0, 0, scr, gw_, NGW, lane_);
        for (size_t i = gt_; i < (size_t)16 * D; i += NGT) { const int j = (int)(i / D), k = (int)(i % D); WBAB[i] = (bf16)f2bf(w_in[(size_t)D * DIN + (size_t)k * DIN + NPROJ + j] * norm_mix[D + k]); }
        for (int l = 0; l < 2; ++l)
            for (size_t i = gt_; i < (size_t)16 * D; i += NGT) { const int j = (int)(i / D), k = (int)(i % D); Wba[(size_t)l * 16 * D + i] = w_in[(size_t)l * D * DIN + (size_t)k * DIN + NPROJ + j] * norm_mix[l * D + k]; }
        for (int m = 0; m < 16; ++m) {
            convert_matrix(lru_w_r + (size_t)m * 128 * 128, 128, 0, 128, 128, nullptr, LRU_WRT + (size_t)m * 128 * 128, BIG, 0, 0, scr, gw_, NGW, lane_);
            convert_matrix(lru_w_i + (size_t)m * 128 * 128, 128, 0, 128, 128, nullptr, LRU_WIT + (size_t)m * 128 * 128, BIG, 0, 0, scr, gw_, NGW, lane_); }
    }
    SEAM(ph);
    int xsel = 0;
#define xcur (xsel ? (const float*)xres : x_in)
    { constexpr int l = 0;
        if (l == 0) { { PHL for (int r = gw_; r < T; r += NGW) rowprep_row(xcur, xb, rstd, Wba, ba, r, lane_); }
        SEAM(ph); }
        if (RUN(ph)) { pg8::Gemm g{xb, Win + (size_t)l * NPROJ * D, T, NPROJ, D, 0}; pg8::StaticOrder S; S.init(T, NPROJ, G, bid); pg8::EpiScaleBf16 E{proj, l == 0 ? rstd : SSQB, NPROJ, l};
            pg8::gemm_phase<pg8::EpiScaleBf16, pg8::StaticOrder, true, false>(lds, g, S, E);
            if (l == 1) { PHL for (int rb = bid_; rb < T / 64; rb += G) ba_tail(xb, WBAB, SSQB, ba, rb, gw_ & 7, lane_); } }
        SEAM(ph);
        if (RUN(ph)) { PHL
            for (int u = bid_; u < 2048; u += G) lrua_unit(proj, conv_lru_w + (size_t)l * 4 * DLRU, conv_lru_b + l * DLRU, LRU_WRT + (size_t)l * 8 * 128 * 128, LRU_WIT + (size_t)l * 8 * 128 * 128, lru_b_r + l * DLRU, lru_b_i + l * DLRU, lru_lambda + l * DLRU, LRU_H, LRU_A, LRU_SUMM, u, lds, tid_, lane_, gw_ & 7);
            STAMP();
            for (int uid = bid_; uid < 2048; uid += G) dna_unit(proj, conv_qkv_w + (size_t)l * 4 * 3 * DDN, ba, dn_a_log + l * NH, dn_dt_bias + l * NH, DN_WF, DN_QF, DN_KDTF, DN_QKF, DN_UF, DN_GL, uid, lds, tid_, lane_, gw_ & 7); }
        SEAM(ph);
        if (RUN(ph)) { PHL
            if (bid_ < 128) dnb_run(DN_WF, DN_QF, DN_KDTF, DN_QKF, DN_UF, DN_GL, c3, (bid_ & 7) + 8 * (bid_ >> 6), (bid_ >> 3) & 7, lds, tid_, lane_, gw_ & 7);
            else if (bid_ < 136) { if (tid_ < 256) lru_carry(LRU_SUMM, LRU_CARRY, (bid_ - 128) * 256 + tid_); }
            else { const int cw = gw_ - 136 * 8, CNW = NGW - 136 * 8;
                if (l == 0) {
                    convert_matrix(w_in + (size_t)D * DIN, DIN, 0, D, NPROJ, norm_mix + D, Win + (size_t)NPROJ * D, BIG, 0, 0, scr, cw, CNW, lane_);
                    convert_matrix(w_out + (size_t)D * D, D, 0, D, D, nullptr, Wout + (size_t)D * D, BIG, 0, 0, scr, cw, CNW, lane_);
                    convert_matrix(ffn_w_gate, DFF, 0, D, DFF, norm_ffn, Wgu, 128, 256, 0, scr, cw, CNW, lane_);
                    convert_matrix(ffn_w_up, DFF, 0, D, DFF, norm_ffn, Wgu, 128, 256, 128, scr, cw, CNW, lane_);
                    convert_matrix(ffn_w_down, D, 0, DFF, D, nullptr, Wd, BIG, 0, 0, scr, cw, CNW, lane_);
                } else {
                    for (int e = 0; e < NEXP; ++e) convert_matrix(moe_w_down + (size_t)e * DFFE * D, D, 0, DFFE, D, nullptr, Md + (size_t)e * D * DFFE, BIG, 0, 0, scr, cw, CNW, lane_);
                } } }
        SEAM(ph);
        if (RUN(ph)) { PHL
            for (int r = gw_; r < T; r += NGW) lrub_row(LRU_H, LRU_A, LRU_CARRY, proj, lru_out_norm + l * DLRU, ymix, r, lane_);
            for (int r = gw_; r < T; r += NGW) dn_out_row(c3, dn_out_norm + l * HD, proj, ymix, r, lane_); }
        SEAM(ph);
        if (RUN(ph)) { if (l == 0) { pg8::Gemm g{ymix, Wout, T, D, D, 0}; pg8::StaticOrder S; S.init(T, D, G, bid); pg8::EpiResidualNorm E{xcur, xres, xb, SSQA, D, 0};
            pg8::gemm_phase<pg8::EpiResidualNorm, pg8::StaticOrder, true, false>(lds, g, S, E); }
          else { pg8::Gemm g{ymix, Wout + (size_t)D * D, T, D, D, 0}; pg8::StaticOrder S; S.init(T, D, G, bid); pg8::EpiResidual E{xcur, xres, nullptr, D, 0};
            pg8::gemm_phase<pg8::EpiResidual, pg8::StaticOrder, true, false>(lds, g, S, E); }
            if (l == 1) { PHL
                for (int e = 0; e < NEXP; ++e) {
                    convert_matrix(moe_w_gate + (size_t)e * D * DFFE, DFFE, 0, D, DFFE, norm_ffn + D, Mgu + (size_t)e * 2 * DFFE * D, 128, 256, 0, scr, gw_, NGW, lane_);
                    convert_matrix(moe_w_up + (size_t)e * D * DFFE, DFFE, 0, D, DFFE, norm_ffn + D, Mgu + (size_t)e * 2 * DFFE * D, 128, 256, 128, scr, gw_, NGW, lane_);
 } } }
        SEAM(ph);
        xsel = 1;
        if (l == 0) {
            if (RUN(ph)) { pg8::Gemm g{xb, Wgu, T, 2 * DFF, D, 0}; pg8::StaticOrder S; S.init(T, 2 * DFF, G, bid); pg8::EpiSwiGLU E{hid, SSQA, DFF, 1};
                pg8::gemm_phase<pg8::EpiSwiGLU, pg8::StaticOrder, true, false>(lds, g, S, E); }
            SEAM(ph);
            if (RUN(ph)) { pg8::Gemm g{hid, Wd, T, D, DFF, 0}; pg8::StaticOrder S; S.init(T, D, G, bid); pg8::EpiResidualNorm E{xcur, xres, xb, SSQB, D, 0};
                pg8::gemm_phase<pg8::EpiResidualNorm, pg8::StaticOrder, true, false>(lds, g, S, E); }
            SEAM(ph);
        } else {
            if (RUN(ph)) { PHL for (int blk = bid_; blk < T / 64; blk += G) route_block(xcur, norm_ffn + D, moe_router, xb, rstd, MCNT, MLIST, MLISTW, blk, lds, tid_, lane_, gw_ & 7); }
            SEAM(ph);
            if (RUN(ph)) { pg8::Gemm g{xb, Mgu, NSLOT, 2 * DFFE, D, 0}; MoeOrder S; S.init(MCNT, MLIST, 2 * DFFE / 256, G, bid); pg8::EpiSwiGLUMoe E{hid, rstd, MLIST, DFFE, 0};
                pg8::gemm_phase<pg8::EpiSwiGLUMoe, MoeOrder, true, true>(lds, g, S, E); }
            SEAM(ph);
            if (RUN(ph)) { pg8::Gemm g{hid, Md, NSLOT, D, DFFE, 0}; MoeOrder S; S.init(MCNT, MLIST, D / 256, G, bid); pg8::EpiMoeDown E{YP0, YP1, MLIST, MLISTW, D, 0};
                pg8::gemm_phase<pg8::EpiMoeDown, MoeOrder, true, false>(lds, g, S, E); }
            SEAM(ph);
        }
    }
    { constexpr int l = 1;
        if (l == 0) { { PHL for (int r = gw_; r < T; r += NGW) rowprep_row(xcur, xb, rstd, Wba, ba, r, lane_); }
        SEAM(ph); }
        if (RUN(ph)) { pg8::Gemm g{xb, Win + (size_t)l * NPROJ * D, T, NPROJ, D, 0}; pg8::StaticOrder S; S.init(T, NPROJ, G, bid); pg8::EpiScaleBf16 E{proj, l == 0 ? rstd : SSQB, NPROJ, l};
            pg8::gemm_phase<pg8::EpiScaleBf16, pg8::StaticOrder, true, false>(lds, g, S, E);
            if (l == 1) { PHL for (int rb = bid_; rb < T / 64; rb += G) ba_tail(xb, WBAB, SSQB, ba, rb, gw_ & 7, lane_); } }
        SEAM(ph);
        if (RUN(ph)) { PHL
            for (int u = bid_; u < 2048; u += G) lrua_unit(proj, conv_lru_w + (size_t)l * 4 * DLRU, conv_lru_b + l * DLRU, LRU_WRT + (size_t)l * 8 * 128 * 128, LRU_WIT + (size_t)l * 8 * 128 * 128, lru_b_r + l * DLRU, lru_b_i + l * DLRU, lru_lambda + l * DLRU, LRU_H, LRU_A, LRU_SUMM, u, lds, tid_, lane_, gw_ & 7);
            STAMP();
            for (int uid = bid_; uid < 2048; uid += G) dna_unit(proj, conv_qkv_w + (size_t)l * 4 * 3 * DDN, ba, dn_a_log + l * NH, dn_dt_bias + l * NH, DN_WF, DN_QF, DN_KDTF, DN_QKF, DN_UF, DN_GL, uid, lds, tid_, lane_, gw_ & 7); }
        SEAM(ph);
        if (RUN(ph)) { PHL
            if (bid_ < 128) dnb_run(DN_WF, DN_QF, DN_KDTF, DN_QKF, DN_UF, DN_GL, c3, (bid_ & 7) + 8 * (bid_ >> 6), (bid_ >> 3) & 7, lds, tid_, lane_, gw_ & 7);
            else if (bid_ < 136) { if (tid_ < 256) lru_carry(LRU_SUMM, LRU_CARRY, (bid_ - 128) * 256 + tid_); }
            else { const int cw = gw_ - 136 * 8, CNW = NGW - 136 * 8;
                if (l == 0) {
                    convert_matrix(w_in + (size_t)D * DIN, DIN, 0, D, NPROJ, norm_mix + D, Win + (size_t)NPROJ * D, BIG, 0, 0, scr, cw, CNW, lane_);
                    convert_matrix(w_out + (size_t)D * D, D, 0, D, D, nullptr, Wout + (size_t)D * D, BIG, 0, 0, scr, cw, CNW, lane_);
                    convert_matrix(ffn_w_gate, DFF, 0, D, DFF, norm_ffn, Wgu, 128, 256, 0, scr, cw, CNW, lane_);
                    convert_matrix(ffn_w_up, DFF, 0, D, DFF, norm_ffn, Wgu, 128, 256, 128, scr, cw, CNW, lane_);
                    convert_matrix(ffn_w_down, D, 0, DFF, D, nullptr, Wd, BIG, 0, 0, scr, cw, CNW, lane_);
                } else {
                    for (int e = 0; e < NEXP; ++e) convert_matrix(moe_w_down + (size_t)e * DFFE * D, D, 0, DFFE, D, nullptr, Md + (size_t)e * D * DFFE, BIG, 0, 0, scr, cw, CNW, lane_);
                } } }
        SEAM(ph);
        if (RUN(ph)) { PHL
            for (int r = gw_; r < T; r += NGW) lrub_row(LRU_H, LRU_A, LRU_CARRY, proj, lru_out_norm + l * DLRU, ymix, r, lane_);
            for (int r = gw_; r < T; r += NGW) dn_out_row(c3, dn_out_norm + l * HD, proj, ymix, r, lane_); }
        SEAM(ph);
        if (RUN(ph)) { if (l == 0) { pg8::Gemm g{ymix, Wout, T, D, D, 0}; pg8::StaticOrder S; S.init(T, D, G, bid); pg8::EpiResidualNorm E{xcur, xres, xb, SSQA, D, 0};
            pg8::gemm_phase<pg8::EpiResidualNorm, pg8::StaticOrder, true, false>(lds, g, S, E); }
          else { pg8::Gemm g{ymix, Wout + (size_t)D * D, T, D, D, 0}; pg8::StaticOrder S; S.init(T, D, G, bid); pg8::EpiResidual E{xcur, xres, nullptr, D, 0};
            pg8::gemm_phase<pg8::EpiResidual, pg8::StaticOrder, true, false>(lds, g, S, E); }
            if (l == 1) { PHL
                for (int e = 0; e < NEXP; ++e) {
                    convert_matrix(moe_w_gate + (size_t)e * D * DFFE, DFFE, 0, D, DFFE, norm_ffn + D, Mgu + (size_t)e * 2 * DFFE * D, 128, 256, 0, scr, gw_, NGW, lane_);
                    convert_matrix(moe_w_up + (size_t)e * D * DFFE, DFFE, 0, D, DFFE, norm_ffn + D, Mgu + (size_t)e * 2 * DFFE * D, 128, 256, 128, scr, gw_, NGW, lane_);
 } } }
        SEAM(ph);
        xsel = 1;
        if (l == 0) {
            if (RUN(ph)) { pg8::Gemm g{xb, Wgu, T, 2 * DFF, D, 0}; pg8::StaticOrder S; S.init(T, 2 * DFF, G, bid); pg8::EpiSwiGLU E{hid, SSQA, DFF, 1};
                pg8::gemm_phase<pg8::EpiSwiGLU, pg8::StaticOrder, true, false>(lds, g, S, E); }
            SEAM(ph);
            if (RUN(ph)) { pg8::Gemm g{hid, Wd, T, D, DFF, 0}; pg8::StaticOrder S; S.init(T, D, G, bid); pg8::EpiResidualNorm E{xcur, xres, xb, SSQB, D, 0};
                pg8::gemm_phase<pg8::EpiResidualNorm, pg8::StaticOrder, true, false>(lds, g, S, E); }
            SEAM(ph);
        } else {
            if (RUN(ph)) { PHL for (int blk = bid_; blk < T / 64; blk += G) route_block(xcur, norm_ffn + D, moe_router, xb, rstd, MCNT, MLIST, MLISTW, blk, lds, tid_, lane_, gw_ & 7); }
            SEAM(ph);
            if (RUN(ph)) { pg8::Gemm g{xb, Mgu, NSLOT, 2 * DFFE, D, 0}; MoeOrder S; S.init(MCNT, MLIST, 2 * DFFE / 256, G, bid); pg8::EpiSwiGLUMoe E{hid, rstd, MLIST, DFFE, 0};
                pg8::gemm_phase<pg8::EpiSwiGLUMoe, MoeOrder, true, true>(lds, g, S, E); }
            SEAM(ph);
            if (RUN(ph)) { pg8::Gemm g{hid, Md, NSLOT, D, DFFE, 0}; MoeOrder S; S.init(MCNT, MLIST, D / 256, G, bid); pg8::EpiMoeDown E{YP0, YP1, MLIST, MLISTW, D, 0};
                pg8::gemm_phase<pg8::EpiMoeDown, MoeOrder, true, false>(lds, g, S, E); }
            SEAM(ph);
        }
    }
    if (RUN(ph)) { PHL for (int r = gw_; r < T; r += NGW) final_row_moe(xcur, YP0, YP1, norm_final, xres, r, lane_); }
#if defined(PROBE_MASK)
    __syncthreads(); STAMP();
    if (blockIdx.x == 0 && threadIdx.x == 0) { asm volatile("s_waitcnt vmcnt(0)" ::: "memory"); volatile LAS unsigned long long* st = (volatile LAS unsigned long long*)(lds + LDSCTL_OFF + 1024); unsigned long long tot = 0;
        for (int k = 1; k < nst; ++k) if ((PROBE_MASK >> (k - 1)) & 1ull) tot += st[k] - st[k - 1];
        xres[0] = rintf((float)tot * 0.01f * PROBE_SCALE); }
#endif
#if defined(PROBE_DNA_A)
    __syncthreads();
    if (blockIdx.x == 0 && threadIdx.x == 0) { asm volatile("s_waitcnt vmcnt(0)" ::: "memory"); volatile LAS unsigned long long* st = (volatile LAS unsigned long long*)(lds + (RING_BYTES + 2048));
        xres[0] = rintf((float)(st[PROBE_DNA_B] - st[PROBE_DNA_A]) * 0.01f * PROBE_SCALE); }
#endif
#undef RUN
#undef SEAM
}

extern "C" void kernel_launch(void* const* d_in, const int* in_sizes, int n_in, void* d_out, int out_size, void* d_ws, size_t ws_size, hipStream_t stream) {
    static int grid = 0;
    if (grid == 0) {
        if (n_in != 25 || ws_size < WS_END) { fprintf(stderr, "kernel_launch: unexpected n_in %d / ws_size %zu (need %zu)\n", n_in, ws_size, (size_t)WS_END); grid = -1; return; }
        int dev = 0, cus = 0, per_cu = 0;
        if (hipGetDevice(&dev) != hipSuccess || hipDeviceGetAttribute(&cus, hipDeviceAttributeMultiprocessorCount, dev) != hipSuccess) { grid = -1; return; }
        if (hipFuncSetAttribute((const void*)mega, hipFuncAttributeMaxDynamicSharedMemorySize, LDS_BYTES) != hipSuccess) { fprintf(stderr, "kernel_launch: hipFuncSetAttribute failed\n"); grid = -1; return; }
        if (hipOccupancyMaxActiveBlocksPerMultiprocessor(&per_cu, (const void*)mega, 512, LDS_BYTES) != hipSuccess || per_cu < 1) { fprintf(stderr, "kernel_launch: occupancy query says %d\n", per_cu); }
        (void)hipGetLastError();
        grid = cus;
    }
    if (grid < 0) return;
    if (hipMemsetAsync((char*)d_ws + WS_CTL, 0, CTL_ZERO_BYTES, stream) != hipSuccess) return;
    Args a{};
    for (int i = 0; i < 25; ++i) a.in[i] = (const float*)d_in[i];
    a.out = (float*)d_out; a.ws = (unsigned char*)d_ws; a.ph_lo = 0; a.ph_hi = 1 << 30;
    hipLaunchKernelGGL(mega, dim3(grid), dim3(512), LDS_BYTES, stream, a);
}
```

```cpp
#include <hip/hip_runtime.h>
#include <cstdio>
#include <cstdint>
namespace pg8 {
#define PG8_LAS __attribute__((address_space(3)))
typedef unsigned short bf16_t;
typedef short bf16x8 __attribute__((ext_vector_type(8)));
typedef float f32x4 __attribute__((ext_vector_type(4)));
typedef unsigned u32x4 __attribute__((ext_vector_type(4)));
constexpr int BM = 256, BK = 64, HALF = 128, HTB = HALF * BK * 2  , STAGE_BYTES = 8 * HTB, NXCD = 8, WGM = 8;

__host__ __device__ __forceinline__ int lds_byte(int r, int c) { const int st = (r >> 4) * 2 + (c >> 5), rr = r & 15, cc = c & 31, ob = rr * 64 + cc * 2; return st * 1024 + (ob ^ (((ob >> 9) & 1) << 5)); }
__host__ __device__ __forceinline__ void stage_rc(int b, int& R, int& C) { const int st = b / 1024, sb = b % 1024, swz = sb ^ (((sb >> 9) & 1) << 5); R = (st >> 1) * 16 + swz / 64; C = (st & 1) * 32 + (swz % 64) / 2; }
__host__ __device__ __forceinline__ int perm32(int rho) { const int n = rho >> 4, i = rho & 15; return 8 * (i >> 2) + 4 * n + (i & 3); }

struct Unit { int pm, pn, pb, lbase, nvalid; };
struct Gemm { const bf16_t* A; const bf16_t* Bt; int M, N, K, pad; };

struct StaticOrder {
    int nM, nN, nwg, G, c;
    __host__ __device__ void init(int M, int N, int G_, int c_) { nM = M / BM; nN = N / BM; nwg = nM * nN; G = G_; c = c_; }
    __host__ __device__ bool next(int i, Unit& u) const {
        const long L = (long)i * G + c; if (L >= nwg) return false;
        int wgid = (int)L; { const int q = nwg / NXCD, r = nwg % NXCD, xcd = wgid % NXCD, off = wgid / NXCD; wgid = (xcd < r ? xcd * (q + 1) : r * (q + 1) + (xcd - r) * q) + off; }
        const int nig = WGM * nN, gid = wgid / nig, fm = gid * WGM, gsz = (nM - fm) < WGM ? (nM - fm) : WGM;
        u.pm = fm + ((wgid % nig) % gsz); u.pn = (wgid % nig) / gsz; u.pb = u.pn; u.lbase = 0; u.nvalid = BM; return true;
    }
    __device__ __forceinline__ int arow(const Unit&, int) const { return 0; }
    __device__ __forceinline__ void a_ready(const Unit&) const {}
    __device__ __forceinline__ void done(const Unit&) const {}
};


typedef float f32x2_t __attribute__((ext_vector_type(2)));
typedef __bf16 bf16x2_t __attribute__((ext_vector_type(2)));
__device__ __forceinline__ unsigned cvt_pk_bf16(float lo, float hi) { const f32x2_t v = {lo, hi}; const bf16x2_t b = __builtin_convertvector(v, bf16x2_t); return __builtin_bit_cast(unsigned, b); }
__device__ __forceinline__ float frcp(float x) { return __builtin_amdgcn_rcpf(x); }
__device__ __forceinline__ float rsqrt_f(float x) { return __builtin_amdgcn_rsqf(x); }
__device__ __forceinline__ float silu_f(float x) { return x * frcp(1.0f + __expf(-x)); }
__device__ __forceinline__ float row_scale(const float* rs, int r, int mode) {
    if (!mode) return rs[r];
    const f32x4* p = (const f32x4*)(rs + (size_t)r * 32); float s = 0.f;
#pragma unroll
    for (int i = 0; i < 8; ++i) { const f32x4 v = p[i]; s += (v[0] + v[1]) + (v[2] + v[3]); }
    return rsqrt_f(s * (1.0f / 2048.0f) + 1e-6f);
}
__device__ __forceinline__ void row_scales8(const float* rs, int row0, int fr, int fq, int mode, float (&sc)[2][4]) {
    if (!mode) {
#pragma unroll
        for (int ai = 0; ai < 2; ++ai)
#pragma unroll
            for (int m = 0; m < 4; ++m) sc[ai][m] = rs[row0 + ai * HALF + m * 16];
    } else {
        const int lane = fr + 16 * fq; f32x4 pa[2][4][2];
#pragma unroll
        for (int ai = 0; ai < 2; ++ai)
#pragma unroll
            for (int m = 0; m < 4; ++m) { const f32x4* p = (const f32x4*)(rs + (size_t)(row0 + ai * HALF + m * 16) * 32 + fq * 8); pa[ai][m][0] = p[0]; pa[ai][m][1] = p[1]; }
#pragma unroll
        for (int ai = 0; ai < 2; ++ai)
#pragma unroll
            for (int m = 0; m < 4; ++m) { const f32x4 a = pa[ai][m][0], b = pa[ai][m][1]; float t = ((a[0] + a[1]) + (a[2] + a[3])) + ((b[0] + b[1]) + (b[2] + b[3]));
                t += __int_as_float(__builtin_amdgcn_ds_bpermute((lane ^ 16) << 2, __float_as_int(t)));
                t += __int_as_float(__builtin_amdgcn_ds_bpermute((lane ^ 32) << 2, __float_as_int(t)));
                sc[ai][m] = rsqrt_f(t * (1.0f / 2048.0f) + 1e-6f); }
    }
}
struct EpiScaleBf16 {
    static constexpr bool PERM = true, AFTER_DRAIN = false;
    bf16_t* O; const float* rs; int ldc; int pad;
    __device__ __forceinline__ void operator()(const f32x4 (&acc)[2][2][4][2], const Unit& u, int wr, int wc, int fr, int fq) const {
        const int row0 = u.pm * BM + wr * 64 + fr, col0 = u.pn * BM + wc * 32 + 8 * fq;
        float sc[2][4]; row_scales8(rs, row0, fr, fq, pad, sc);
#pragma unroll
        for (int ai = 0; ai < 2; ++ai)
#pragma unroll
            for (int m = 0; m < 4; ++m) { const int r = row0 + ai * HALF + m * 16; const float s = sc[ai][m]; bf16_t* rowp = O + (size_t)r * ldc + col0;
#pragma unroll
                for (int bj = 0; bj < 2; ++bj) { const f32x4 v0 = acc[ai][bj][m][0] * s, v1 = acc[ai][bj][m][1] * s;
                    u32x4 w; w.x = cvt_pk_bf16(v0[0], v0[1]); w.y = cvt_pk_bf16(v0[2], v0[3]); w.z = cvt_pk_bf16(v1[0], v1[1]); w.w = cvt_pk_bf16(v1[2], v1[3]);
                    *(u32x4*)(rowp + bj * HALF) = w; } }
    }
};
struct EpiSwiGLU {
    static constexpr bool PERM = true, AFTER_DRAIN = false;
    bf16_t* O; const float* rs; int ldc; int pad;
    __device__ __forceinline__ void operator()(const f32x4 (&acc)[2][2][4][2], const Unit& u, int wr, int wc, int fr, int fq) const {
        const int row0 = u.pm * BM + wr * 64 + fr, col0 = u.pn * HALF + wc * 32 + 8 * fq;
        float sc[2][4]; row_scales8(rs, row0, fr, fq, pad, sc);
#pragma unroll
        for (int ai = 0; ai < 2; ++ai)
#pragma unroll
            for (int m = 0; m < 4; ++m) { const int r = row0 + ai * HALF + m * 16; const float s = sc[ai][m]; bf16_t* rowp = O + (size_t)r * ldc + col0;
                f32x4 h0, h1;
#pragma unroll
                for (int j = 0; j < 4; ++j) { h0[j] = silu_f(acc[ai][0][m][0][j] * s) * (acc[ai][1][m][0][j] * s); h1[j] = silu_f(acc[ai][0][m][1][j] * s) * (acc[ai][1][m][1][j] * s); }
                u32x4 w; w.x = cvt_pk_bf16(h0[0], h0[1]); w.y = cvt_pk_bf16(h0[2], h0[3]); w.z = cvt_pk_bf16(h1[0], h1[1]); w.w = cvt_pk_bf16(h1[2], h1[3]);
                *(u32x4*)rowp = w; }
    }
};
struct EpiResidual {
    static constexpr bool PERM = false, AFTER_DRAIN = false;
    const float* base; float* out; const float* roww; int ldc; int pad;
    __device__ __forceinline__ void operator()(const f32x4 (&acc)[2][2][4][2], const Unit& u, int wr, int wc, int fr, int fq) const {
        const int row0 = u.pm * BM + wr * 64 + fr, col0 = u.pn * BM + wc * 32 + 4 * fq;
#pragma unroll
        for (int ai = 0; ai < 2; ++ai)
#pragma unroll
            for (int m = 0; m < 4; ++m) { const int r = row0 + ai * HALF + m * 16; const float w = roww ? roww[r] : 1.0f; const size_t off = (size_t)r * ldc + col0;
#pragma unroll
                for (int bj = 0; bj < 2; ++bj)
#pragma unroll
                    for (int n = 0; n < 2; ++n) { const f32x4 bs = *(const f32x4*)(base + off + bj * HALF + n * 16); *(f32x4*)(out + off + bj * HALF + n * 16) = bs + acc[ai][bj][m][n] * w; } }
    }
};

struct EpiSwiGLUMoe {
    static constexpr bool PERM = true, AFTER_DRAIN = false;
    bf16_t* O; const float* rs; const int* list; int ldc; int pad;
    __device__ __forceinline__ void operator()(const f32x4 (&acc)[2][2][4][2], const Unit& u, int wr, int wc, int fr, int fq) const {
        const int rl0 = wr * 64 + fr, col0 = u.pn * HALF + wc * 32 + 8 * fq;
#pragma unroll
        for (int ai = 0; ai < 2; ++ai)
#pragma unroll
            for (int m = 0; m < 4; ++m) { const int rl = rl0 + ai * HALF + m * 16; const int tok = rl < u.nvalid ? (list[u.lbase + rl] & 0xffff) : 0; const float s = rs[tok];
                bf16_t* rowp = O + (size_t)(u.pm * BM + rl) * ldc + col0;
                f32x4 h0, h1;
#pragma unroll
                for (int j = 0; j < 4; ++j) { h0[j] = silu_f(acc[ai][0][m][0][j] * s) * (acc[ai][1][m][0][j] * s); h1[j] = silu_f(acc[ai][0][m][1][j] * s) * (acc[ai][1][m][1][j] * s); }
                u32x4 w; w.x = cvt_pk_bf16(h0[0], h0[1]); w.y = cvt_pk_bf16(h0[2], h0[3]); w.z = cvt_pk_bf16(h1[0], h1[1]); w.w = cvt_pk_bf16(h1[2], h1[3]);
                *(u32x4*)rowp = w; }
    }
};
struct EpiMoeDown {
    static constexpr bool PERM = true, AFTER_DRAIN = false;
    bf16_t* Y0; bf16_t* Y1; const int* list; const float* lw; int ldc; int pad;
    __device__ __forceinline__ void operator()(const f32x4 (&acc)[2][2][4][2], const Unit& u, int wr, int wc, int fr, int fq) const {
        const int rl0 = wr * 64 + fr, col0 = u.pn * BM + wc * 32 + 8 * fq;
#pragma unroll
        for (int ai = 0; ai < 2; ++ai)
#pragma unroll
            for (int m = 0; m < 4; ++m) { const int rl = rl0 + ai * HALF + m * 16;
                if (rl < u.nvalid) { const int en = list[u.lbase + rl]; const float w = lw[u.lbase + rl]; bf16_t* rowp = ((en >> 16) ? Y1 : Y0) + (size_t)(en & 0xffff) * ldc + col0;
#pragma unroll
                    for (int bj = 0; bj < 2; ++bj) { const f32x4 v0 = acc[ai][bj][m][0] * w, v1 = acc[ai][bj][m][1] * w;
                        u32x4 o; o.x = cvt_pk_bf16(v0[0], v0[1]); o.y = cvt_pk_bf16(v0[2], v0[3]); o.z = cvt_pk_bf16(v1[0], v1[1]); o.w = cvt_pk_bf16(v1[2], v1[3]);
                        *(u32x4*)(rowp + bj * HALF) = o; } } }
    }
};

struct EpiResidualNorm {
    static constexpr bool PERM = true, AFTER_DRAIN = false;
    const float* base; float* out; bf16_t* xb; float* ssq; int ldc; int pad;
    __device__ __forceinline__ void operator()(const f32x4 (&acc)[2][2][4][2], const Unit& u, int wr, int wc, int fr, int fq) const {
        const int row0 = u.pm * BM + wr * 64 + fr, col0 = u.pn * BM + wc * 32 + 8 * fq, lane = fr + 16 * fq;
#pragma unroll
        for (int ai = 0; ai < 2; ++ai)
#pragma unroll
            for (int m = 0; m < 4; ++m) { const int r = row0 + ai * HALF + m * 16; const size_t off = (size_t)r * ldc + col0; float part = 0.f;
#pragma unroll
                for (int bj = 0; bj < 2; ++bj) { const f32x4 b0 = *(const f32x4*)(base + off + bj * HALF), b1 = *(const f32x4*)(base + off + bj * HALF + 4);
                    const f32x4 v0 = b0 + acc[ai][bj][m][0], v1 = b1 + acc[ai][bj][m][1];
                    *(f32x4*)(out + off + bj * HALF) = v0; *(f32x4*)(out + off + bj * HALF + 4) = v1;
                    u32x4 w; w.x = cvt_pk_bf16(v0[0], v0[1]); w.y = cvt_pk_bf16(v0[2], v0[3]); w.z = cvt_pk_bf16(v1[0], v1[1]); w.w = cvt_pk_bf16(v1[2], v1[3]);
                    *(u32x4*)(xb + off + bj * HALF) = w;
                    part += (v0[0] * v0[0] + v0[1] * v0[1]) + (v0[2] * v0[2] + v0[3] * v0[3]) + (v1[0] * v1[0] + v1[1] * v1[1]) + (v1[2] * v1[2] + v1[3] * v1[3]); }
                part += __int_as_float(__builtin_amdgcn_ds_bpermute((lane ^ 16) << 2, __float_as_int(part)));
                part += __int_as_float(__builtin_amdgcn_ds_bpermute((lane ^ 32) << 2, __float_as_int(part)));
                if (fq == 0) ssq[(size_t)r * 32 + u.pn * 4 + wc] = part; }
    }
};
template <class Epi, class Sched, bool ALIGN_EPI = false, bool GATHER = false>
__device__ __forceinline__ void gemm_phase(PG8_LAS unsigned char* lds, const Gemm g, const Sched& S, const Epi& E) {
    int tid_o = threadIdx.x; asm volatile("" : "+v"(tid_o));
    const int tid = tid_o, wid = __builtin_amdgcn_readfirstlane(tid >> 6), lane = tid & 63, wr = wid >> 2, wc = wid & 3, fr = lane & 15, fq = lane >> 4;
    const int K = g.K, nt = K / BK;
    const size_t kstep = (size_t)(BK * 2);
    const size_t hstep = (size_t)HALF * K * 2;
    const size_t tstep = 2 * hstep;
    unsigned voffA[2], voffB[2], oA[2][2], oN[2][2];
#pragma unroll
    for (int i = 0; i < 2; ++i) { int R, C; stage_rc(tid * 16 + i * 8192, R, C); const int Rb = Epi::PERM ? ((R & ~31) + perm32(R & 31)) : R; voffA[i] = (unsigned)(R * K + C) * 2u; voffB[i] = (unsigned)(Rb * K + C) * 2u; }
    const unsigned ldsw = (unsigned)wid * 1024u;
    const int aoff = lds_byte(wr * 64 + fr, fq * 8), boff = lds_byte(wc * 32 + fr, fq * 8);
#define PG8_SA(b, h) (((b) * 2 + (h)) * HTB)
#define PG8_SB(b, h) ((4 + (b) * 2 + (h)) * HTB)
#define PG8_STAGE(bufoff, gbase, voff) do { _Pragma("unroll") for (int _i = 0; _i < 2; ++_i) \
        __builtin_amdgcn_global_load_lds((const unsigned*)((const char*)(gbase) + (voff)[_i]), (PG8_LAS unsigned*)(lds + (bufoff) + ldsw + _i * 8192), 16, 0, 0); } while (0)
#define PG8_LDA(dst, b, h) do { _Pragma("unroll") for (int m = 0; m < 4; ++m) _Pragma("unroll") for (int k = 0; k < 2; ++k) dst[m][k] = *(const PG8_LAS bf16x8*)(lds + PG8_SA(b, h) + aoff + m * 2048 + k * 1024); } while (0)
#define PG8_LDB(dst, b, h) do { _Pragma("unroll") for (int n = 0; n < 2; ++n) _Pragma("unroll") for (int k = 0; k < 2; ++k) dst[n][k] = *(const PG8_LAS bf16x8*)(lds + PG8_SB(b, h) + boff + n * 2048 + k * 1024); } while (0)
#define PG8_MMA(ai, bj, At, Bt) do { __builtin_amdgcn_s_setprio(1); _Pragma("unroll") for (int m = 0; m < 4; ++m) _Pragma("unroll") for (int n = 0; n < 2; ++n) _Pragma("unroll") for (int k = 0; k < 2; ++k) \
        acc[ai][bj][m][n] = __builtin_amdgcn_mfma_f32_16x16x32_bf16(Bt[n][k], At[m][k], acc[ai][bj][m][n], 0, 0, 0); __builtin_amdgcn_s_setprio(0); } while (0)
#define PG8_WAIT_V(n) asm volatile("s_waitcnt vmcnt(" #n ")" ::: "memory")
#define PG8_WAIT_L(n) asm volatile("s_waitcnt lgkmcnt(" #n ")" ::: "memory")
#define PG8_BAR __builtin_amdgcn_s_barrier()
#define PG8_SCHED __builtin_amdgcn_sched_barrier(0)
#define PG8_AOFF(dst, u) do { _Pragma("unroll") for (int _i = 0; _i < 2; ++_i) { int _R, _C; stage_rc(tid * 16 + _i * 8192, _R, _C); _Pragma("unroll") for (int _h = 0; _h < 2; ++_h) \
        dst[_h][_i] = (unsigned)(S.arow(u, _h * HALF + _R) * K + _C) * 2u; } } while (0)
#define PG8_STAGE_A(bufoff, gbase, h, usenext) do { _Pragma("unroll") for (int _i = 0; _i < 2; ++_i) { const unsigned _o = GATHER ? ((usenext) ? oN[h][_i] : oA[h][_i]) : voffA[_i]; \
        __builtin_amdgcn_global_load_lds((const unsigned*)((const char*)(gbase) + (GATHER ? (size_t)0 : (size_t)(h) * hstep) + _o), (PG8_LAS unsigned*)(lds + (bufoff) + ldsw + _i * 8192), 16, 0, 0); } } while (0)
    Unit cur, nxt; int ui = 0;
    if (!S.next(0, cur)) return;
    f32x4 acc[2][2][4][2];
#pragma unroll
    for (int a = 0; a < 2; ++a)
#pragma unroll
        for (int b = 0; b < 2; ++b)
#pragma unroll
            for (int m = 0; m < 4; ++m)
#pragma unroll
                for (int n = 0; n < 2; ++n) acc[a][b][m][n] = (f32x4){0.f, 0.f, 0.f, 0.f};
    bf16x8 At[4][2], B0[2][2], B1[2][2];
    const char* cA = (const char*)g.A + (GATHER ? (size_t)0 : (size_t)cur.pm * tstep); const char* cB = (const char*)g.Bt + (size_t)cur.pb * tstep;
    S.a_ready(cur);
    if constexpr (GATHER) { PG8_AOFF(oA, cur); PG8_WAIT_V(0); }
    PG8_STAGE(PG8_SB(0, 0), cB, voffB); PG8_STAGE(PG8_SB(0, 1), cB + hstep, voffB); PG8_STAGE_A(PG8_SA(0, 0), cA, 0, false); PG8_STAGE_A(PG8_SA(0, 1), cA, 1, false);
    if (wr == 1) PG8_BAR;
    PG8_WAIT_V(2); PG8_BAR;
    PG8_STAGE(PG8_SB(1, 0), cB + kstep, voffB); PG8_STAGE_A(PG8_SA(1, 0), cA + kstep, 0, false); PG8_STAGE(PG8_SB(1, 1), cB + hstep + kstep, voffB);
    PG8_WAIT_V(6); PG8_BAR;
    for (;;) {
        const bool has_next = S.next(ui + 1, nxt);
        const char* nA = has_next ? (const char*)g.A + (GATHER ? (size_t)0 : (size_t)nxt.pm * tstep) : cA; const char* nB = has_next ? (const char*)g.Bt + (size_t)nxt.pb * tstep : cB;
        if constexpr (GATHER) { if (has_next) { PG8_AOFF(oN, nxt); } else {
#pragma unroll
            for (int _h = 0; _h < 2; ++_h) { oN[_h][0] = oA[_h][0]; oN[_h][1] = oA[_h][1]; } } }
        for (int t = 0; t < nt; t += 2) {
            const bool last = (t == nt - 2);
            const char* a1 = cA + (size_t)(t + 1) * kstep;
            const char* a2 = last ? nA : cA + (size_t)(t + 2) * kstep; const char* b2 = last ? nB : cB + (size_t)(t + 2) * kstep;
            const char* a3 = a2 + kstep; const char* b3 = b2 + kstep;
            if (last && has_next) S.a_ready(nxt);
            PG8_LDB(B0, 0, 0); PG8_LDB(B1, 0, 1); PG8_SCHED; PG8_LDA(At, 0, 0); PG8_STAGE_A(PG8_SA(1, 1), a1, 1, false);
            PG8_WAIT_V(8); PG8_WAIT_L(0); PG8_BAR; PG8_MMA(0, 0, At, B0); PG8_MMA(0, 1, At, B1); PG8_BAR; PG8_SCHED;
            PG8_LDA(At, 0, 1); PG8_STAGE(PG8_SB(0, 0), b2, voffB); PG8_STAGE(PG8_SB(0, 1), b2 + hstep, voffB); PG8_STAGE_A(PG8_SA(0, 0), a2, 0, last);
            PG8_WAIT_V(8); PG8_WAIT_L(0); PG8_BAR; PG8_MMA(1, 0, At, B0); PG8_MMA(1, 1, At, B1); PG8_BAR; PG8_SCHED;
            PG8_LDB(B0, 1, 0); PG8_LDB(B1, 1, 1); PG8_SCHED; PG8_LDA(At, 1, 0); PG8_STAGE_A(PG8_SA(0, 1), a2, 1, last);
            PG8_WAIT_V(8); PG8_WAIT_L(0); PG8_BAR; PG8_MMA(0, 0, At, B0); PG8_MMA(0, 1, At, B1); PG8_BAR; PG8_SCHED;
            PG8_LDA(At, 1, 1); PG8_STAGE(PG8_SB(1, 0), b3, voffB); PG8_STAGE(PG8_SB(1, 1), b3 + hstep, voffB); PG8_STAGE_A(PG8_SA(1, 0), a3, 0, last);
            PG8_WAIT_V(8); PG8_WAIT_L(0); PG8_BAR; PG8_MMA(1, 0, At, B0); PG8_MMA(1, 1, At, B1); PG8_BAR; PG8_SCHED;
        }
        if constexpr (ALIGN_EPI) { if (wr == 0) PG8_BAR; }
        E(acc, cur, wr, wc, fr, fq); S.done(cur);
        if (!has_next) break;
#pragma unroll
        for (int a = 0; a < 2; ++a)
#pragma unroll
            for (int b = 0; b < 2; ++b)
#pragma unroll
                for (int m = 0; m < 4; ++m)
#pragma unroll
                    for (int n = 0; n < 2; ++n) acc[a][b][m][n] = (f32x4){0.f, 0.f, 0.f, 0.f};
        cur = nxt; cA = nA; cB = nB; ++ui;
        if constexpr (GATHER) {
#pragma unroll
            for (int _h = 0; _h < 2; ++_h) { oA[_h][0] = oN[_h][0]; oA[_h][1] = oN[_h][1]; } }
        if constexpr (ALIGN_EPI) { if (wr == 1) PG8_BAR; }
    }
    PG8_WAIT_V(0);
    if constexpr (!ALIGN_EPI) { if (wr == 0) PG8_BAR; }
    PG8_BAR;
#undef PG8_SA
#undef PG8_SB
#undef PG8_STAGE
#undef PG8_LDA
#undef PG8_LDB
#undef PG8_MMA
#undef PG8_WAIT_V
#undef PG8_WAIT_L
#undef PG8_BAR
#undef PG8_SCHED
#undef PG8_AOFF
#undef PG8_STAGE_A
}
}

#define GAS __attribute__((address_space(1)))
#define LAS __attribute__((address_space(3)))
#define XB_TMO      128
#define XB_XCNT(j)  (256  + 64 * (j))
#define XB_XSUB(j)  (1280 + 64 * (j))
#define XB_XGEN(j)  (2304 + 64 * (j))
#define XB_TOP      3328
#define XB_TOPGEN   3392
#define XCD_BAR_WORDS 3456
#define XB_SPIN_CAP (1u << 23)

__device__ __forceinline__ unsigned xb_ld(unsigned* p)              { return __hip_atomic_load(p, __ATOMIC_RELAXED, __HIP_MEMORY_SCOPE_AGENT); }
__device__ __forceinline__ unsigned xb_add(unsigned* p, unsigned v) { return __hip_atomic_fetch_add(p, v, __ATOMIC_RELAXED, __HIP_MEMORY_SCOPE_AGENT); }
__device__ __forceinline__ unsigned xb_xcc_id() { return (unsigned)__builtin_amdgcn_s_getreg((3 << 11) | 20) & 0xFu; }
#define XB_SPIN(cond, bar) do { unsigned _sp = 0; while (cond) { __builtin_amdgcn_s_sleep(1); \
    if ((++_sp & 255u) == 0u) { if (xb_ld(&(bar)[XB_TMO])) break; if (_sp > XB_SPIN_CAP) { atomicAdd(&(bar)[XB_TMO], 1u); break; } } } } while (0)

struct XcdBarrier {
    unsigned* bar; unsigned x;
    volatile LAS unsigned* st;
};

__device__ __forceinline__ XcdBarrier xcd_barrier_post(unsigned* bar, volatile LAS unsigned* st) {
    XcdBarrier b; b.bar = bar; b.x = xb_xcc_id(); b.st = st;
    if (threadIdx.x == 0) (void)xb_add(&bar[XB_XCNT(b.x)], 1u);
    return b;
}
__device__ __forceinline__ void xcd_barrier_complete(unsigned* bar, unsigned x, unsigned& nloc, unsigned& nx) {
    const unsigned G = gridDim.x * gridDim.y * gridDim.z;
    unsigned sum, cnt, mine, sp = 0u;
    for (;;) {
        sum = 0u; cnt = 0u; mine = 0u;
#pragma unroll
        for (unsigned j = 0; j < 16; ++j) { const unsigned c = xb_ld(&bar[XB_XCNT(j)]); sum += c; cnt += (c > 0u) ? 1u : 0u; mine = (j == x) ? c : mine; }
        if (sum == G) break;
        __builtin_amdgcn_s_sleep(1);
        if ((++sp & 255u) == 0u) { if (xb_ld(&bar[XB_TMO])) break; if (sp > XB_SPIN_CAP) { atomicAdd(&bar[XB_TMO], 1u); break; } }
    }
    nloc = mine > 0u ? mine : 1u; nx = cnt > 0u ? cnt : 1u;
}

__device__ __forceinline__ void xcd_barrier(const XcdBarrier& b) {
    asm volatile("s_waitcnt vmcnt(0)" ::: "memory");
    __syncthreads();
    if (threadIdx.x == 0) {
        unsigned* bar = b.bar; asm volatile("" : "+s"(bar));
        __builtin_amdgcn_s_waitcnt(0);
        unsigned nloc = b.st[0], nx = b.st[1];
        if (nloc == 0u) { xcd_barrier_complete(bar, b.x, nloc, nx); b.st[0] = nloc; b.st[1] = nx; }
        const unsigned old = xb_add(&bar[XB_XSUB(b.x)], 1u);
        const unsigned gen = old / nloc;
        if (old + 1u == (gen + 1u) * nloc) {
            __builtin_amdgcn_fence(__ATOMIC_RELEASE, "agent");
            asm volatile("s_waitcnt vmcnt(0)" ::: "memory");
            const unsigned og = xb_add(&bar[XB_TOP], 1u);
            const unsigned tg = og / nx;
            if (og + 1u == (tg + 1u) * nx) xb_add(&bar[XB_TOPGEN], 1u);
            else XB_SPIN(xb_ld(&bar[XB_TOPGEN]) == tg, bar);
            __builtin_amdgcn_fence(__ATOMIC_ACQUIRE, "agent");
            xb_add(&bar[XB_XGEN(b.x)], 1u);
            asm volatile("s_waitcnt vmcnt(0)" ::: "memory");
        } else {
            XB_SPIN(xb_ld(&bar[XB_XGEN(b.x)]) == gen, bar);
            __builtin_amdgcn_fence(__ATOMIC_ACQUIRE, "agent");
            asm volatile("s_waitcnt vmcnt(0)" ::: "memory");
        }
    }
    __syncthreads();
}

constexpr int T = 16384, SEQ = 8192, D = 2048, DLRU = 1024, DDN = 1024, NH = 8, HD = 128, NPROJ = 6144, DIN = 6160;
constexpr int DFF = 6144, NEXP = 8, DFFE = 3072;
constexpr float EPS = 1e-6f;
typedef unsigned short bf16;
typedef float f32x4 __attribute__((ext_vector_type(4)));
typedef unsigned u32x4 __attribute__((ext_vector_type(4)));
typedef unsigned u32x2 __attribute__((ext_vector_type(2)));
#define LDS_WAIT() asm volatile("s_waitcnt lgkmcnt(0)" ::: "memory")
#define LDS_BARRIER() do { asm volatile("s_waitcnt lgkmcnt(0)" ::: "memory"); __builtin_amdgcn_s_barrier(); asm volatile("" ::: "memory"); } while (0)

__device__ __forceinline__ float bf2f(bf16 b) { return __uint_as_float(((unsigned)b) << 16); }
__device__ __forceinline__ unsigned f2bf(float f) { return pg8::cvt_pk_bf16(f, f) & 0xffffu; }
__device__ __forceinline__ unsigned pk2(float lo, float hi) { return pg8::cvt_pk_bf16(lo, hi); }
__device__ __forceinline__ float shfl_xor_l(float v, int o, int lane) { return __int_as_float(__builtin_amdgcn_ds_bpermute((lane ^ o) << 2, __float_as_int(v))); }
__device__ __forceinline__ float shfl_up_l(float v, int d, int lane) { return __int_as_float(__builtin_amdgcn_ds_bpermute((lane - d) << 2, __float_as_int(v))); }
__device__ __forceinline__ float shfl_idx_l(float v, int src) { return __int_as_float(__builtin_amdgcn_ds_bpermute(src << 2, __float_as_int(v))); }
__device__ __forceinline__ float wave_sum(float v, int lane) {
#pragma unroll
    for (int o = 1; o < 64; o <<= 1) v += shfl_xor_l(v, o, lane);
    return v;
}
using pg8::silu_f;
using pg8::frcp; using pg8::rsqrt_f;
__device__ __forceinline__ float sigmoid_f(float x) { return frcp(1.0f + __expf(-x)); }
__device__ __forceinline__ float softplus_f(float x) { return fmaxf(x, 0.0f) + log1pf(__expf(-fabsf(x))); }
__device__ __forceinline__ float gelu_tanh_f(float x) { const float u = 0.7978845608028654f * (x + 0.044715f * x * x * x); return x * frcp(1.0f + __expf(-2.0f * u)); }

constexpr size_t MiB = 1u << 20;
constexpr size_t al(size_t x) { return (x + MiB - 1) / MiB * MiB; }
constexpr size_t WS_CTL = 0, CTL_ZERO_BYTES = 1 * MiB;
constexpr int CW_BAR = 4096, CW_CNT = 8192;
constexpr size_t WS_WGU = 1 * MiB;
constexpr size_t WS_WD = WS_WGU + al((size_t)2 * DFF * D * 2);
constexpr size_t WS_WIN = WS_WD + al((size_t)D * DFF * 2);
constexpr size_t WS_WBA = WS_WIN + al((size_t)2 * NPROJ * D * 2);
constexpr size_t WS_WOUT = WS_WBA + al((size_t)2 * 16 * D * 4 + 16 * D * 2);
static_assert(WS_WIN + (size_t)NPROJ * D * 2 - WS_WGU >= (size_t)NEXP * D * DFFE * 2, "MoE down weights overlay");
constexpr size_t WS_XB = WS_WOUT + al((size_t)2 * D * D * 2);
constexpr size_t WS_RSTD = WS_XB + al((size_t)T * D * 2);
constexpr size_t WS_BA = WS_RSTD + 5 * MiB;
constexpr size_t WS_BETA = WS_BA + al((size_t)T * 16 * 4);
constexpr size_t WS_G = WS_BETA + al((size_t)T * 8 * 4);
constexpr size_t WS_ROWW = WS_G + al((size_t)T * 8 * 4);
constexpr int NSLOT = 2 * T + NEXP * 256;
constexpr size_t WS_PROJ = WS_ROWW + al((size_t)2 * 8 * T * 4);
constexpr size_t WS_YMIX = WS_PROJ + al((size_t)NSLOT * DFFE * 2);
constexpr size_t WS_C = WS_YMIX + al((size_t)T * D * 2);
constexpr size_t WS_WRT = WS_C + (size_t)388 * MiB;
constexpr size_t WS_END = WS_WRT + 1 * MiB;
static_assert(WS_END <= (size_t)975 * MiB, "d_ws map exceeds the guaranteed workspace");
static_assert((size_t)NEXP * 2 * DFFE * D * 2 <= (size_t)388 * MiB, "MoE gate/up bf16 weights overlay the mixer scratch");
constexpr int RING_BYTES = 131072, LDSCTL_OFF = RING_BYTES, MISC_OFF = LDSCTL_OFF + 320, LDS_BYTES = 147456;

__device__ __forceinline__ void transpose_item(const float* W, int ldw, int col_off, int K, int nblk, const float* gain, bf16* WT, int blk, int blk_stride, int row_off, int item, int lane) {
    const int kb = item / nblk, nb = item % nblk, k0 = 64 * kb + (lane >> 4) * 16, n0 = 64 * nb + (lane & 15) * 4;
    const float* src = W + (size_t)k0 * ldw + col_off + n0;
    f32x4 v[16];
#pragma unroll
    for (int j = 0; j < 16; ++j) v[j] = __builtin_nontemporal_load((const f32x4*)(src + (size_t)j * ldw));
    if (gain) {
#pragma unroll
        for (int q = 0; q < 4; ++q) { const f32x4 g = *(const f32x4*)(gain + k0 + 4 * q);
#pragma unroll
            for (int c = 0; c < 4; ++c) v[4 * q + c] = v[4 * q + c] * g[c]; }
    }
#pragma unroll
    for (int i = 0; i < 4; ++i) { const int n = n0 + i, drow = (n / blk) * blk_stride + (n % blk) + row_off;
        u32x4 o0, o1;
        o0.x = pk2(v[0][i], v[1][i]); o0.y = pk2(v[2][i], v[3][i]); o0.z = pk2(v[4][i], v[5][i]); o0.w = pk2(v[6][i], v[7][i]);
        o1.x = pk2(v[8][i], v[9][i]); o1.y = pk2(v[10][i], v[11][i]); o1.z = pk2(v[12][i], v[13][i]); o1.w = pk2(v[14][i], v[15][i]);
        u32x4* dst = (u32x4*)(WT + (size_t)drow * K + k0); dst[0] = o0; dst[1] = o1; }
}
__device__ __forceinline__ void convert_matrix(const float* W, int ldw, int col_off, int K, int N, const float* gain, bf16* WT, int blk, int blk_stride, int row_off, LAS float* scr, int gw, int NGW, int lane) {
    const int nblk = N / 64, nitems = (K / 64) * nblk; (void)scr;
    for (int it = gw; it < nitems; it += NGW) transpose_item(W, ldw, col_off, K, nblk, gain, WT, blk, blk_stride, row_off, it, lane);
}
__device__ __forceinline__ void rowprep_row(const float* x, bf16* xb, float* rstd, const float* Wba, float* ba, int row, int lane) {
    const f32x4* xr = (const f32x4*)(x + (size_t)row * D) + lane;
    f32x4 v[8]; float ss = 0.f;
#pragma unroll
    for (int j = 0; j < 8; ++j) { v[j] = xr[64 * j]; ss += (v[j][0] * v[j][0] + v[j][1] * v[j][1]) + (v[j][2] * v[j][2] + v[j][3] * v[j][3]); }
    ss = wave_sum(ss, lane);
    const float rs = rsqrt_f(ss * (1.0f / D) + EPS);
    u32x2* o = (u32x2*)(xb + (size_t)row * D) + lane;
#pragma unroll
    for (int j = 0; j < 8; ++j) { u32x2 w; w.x = pk2(v[j][0], v[j][1]); w.y = pk2(v[j][2], v[j][3]); o[64 * j] = w; }
    if (lane == 0) rstd[row] = rs;
    if (Wba) {
        for (int c = 0; c < 16; ++c) { const f32x4* wr = (const f32x4*)(Wba + (size_t)c * D) + lane; float a = 0.f;
#pragma unroll
            for (int j = 0; j < 8; ++j) { const f32x4 w = wr[64 * j]; a += (v[j][0] * w[0] + v[j][1] * w[1]) + (v[j][2] * w[2] + v[j][3] * w[3]); }
            a = wave_sum(a, lane); if (lane == 0) ba[(size_t)row * 16 + c] = a * rs; }
    }
}
__device__ __forceinline__ void lru_conv_elem(const bf16* proj, const float* cw, const float* cb, float* xc, size_t idx) {
    const int t = (int)(idx / DLRU), ch = (int)(idx % DLRU), s = t % SEQ;
    float a = cb[ch];
#pragma unroll
    for (int k = 0; k < 4; ++k) { const int sp = s - 3 + k; if (sp >= 0) a += cw[k * DLRU + ch] * bf2f(proj[(size_t)(t - 3 + k) * NPROJ + ch]); }
    xc[idx] = a;
}
__device__ __forceinline__ void lru_gate_elem(const float* xc, const float* w_r, const float* b_r, const float* w_i, const float* b_i, const float* lam, float* av, float* bv, size_t idx) {
    const int t = (int)(idx / DLRU), ch = (int)(idx % DLRU), n = ch >> 7, d = ch & 127;
    float ar = b_r[ch], ai = b_i[ch];
    const float* xr = xc + (size_t)t * DLRU + n * 128; const float* wr = w_r + (size_t)n * 128 * 128 + d; const float* wi = w_i + (size_t)n * 128 * 128 + d;
    for (int c = 0; c < 128; ++c) { const float xv = xr[c]; ar += xv * wr[c * 128]; ai += xv * wi[c * 128]; }
    const float r = sigmoid_f(ar), ig = sigmoid_f(ai);
    const float log_a = -8.0f * r * softplus_f(-lam[ch]);
    const float a = expf(log_a), mult = sqrtf(-expm1f(2.0f * log_a));
    av[idx] = a; bv[idx] = mult * (ig * xc[idx]);
}
__device__ __forceinline__ void lru_scan_chan(float* av, const float* bv, const bf16* proj, int idx) {
    const int b = idx / DLRU, ch = idx % DLRU;
    float h = 0.f;
    for (int s0 = 0; s0 < SEQ; s0 += 8) {
        float a8[8], b8[8], g8[8];
#pragma unroll
        for (int j = 0; j < 8; ++j) { const size_t t = (size_t)b * SEQ + s0 + j; a8[j] = av[t * DLRU + ch]; b8[j] = bv[t * DLRU + ch]; g8[j] = bf2f(proj[t * NPROJ + DLRU + ch]); }
#pragma unroll
        for (int j = 0; j < 8; ++j) { const size_t t = (size_t)b * SEQ + s0 + j; h = a8[j] * h + b8[j]; av[t * DLRU + ch] = h * gelu_tanh_f(g8[j]); }
    }
}
__device__ __forceinline__ void lru_norm_row(const float* y, const float* gain, bf16* ymix, int row, int lane) {
    const f32x4* yr = (const f32x4*)(y + (size_t)row * DLRU) + lane; const f32x4* gr = (const f32x4*)gain + lane;
    f32x4 v[4]; float ss = 0.f;
#pragma unroll
    for (int j = 0; j < 4; ++j) { v[j] = yr[64 * j]; ss += (v[j][0] * v[j][0] + v[j][1] * v[j][1]) + (v[j][2] * v[j][2] + v[j][3] * v[j][3]); }
    ss = wave_sum(ss, lane); const float rs = rsqrt_f(ss * (1.0f / DLRU) + EPS);
    u32x2* o = (u32x2*)(ymix + (size_t)row * D) + lane;
#pragma unroll
    for (int j = 0; j < 4; ++j) { const f32x4 g = gr[64 * j]; u32x2 w; w.x = pk2(v[j][0] * rs * g[0], v[j][1] * rs * g[1]); w.y = pk2(v[j][2] * rs * g[2], v[j][3] * rs * g[3]); o[64 * j] = w; }
}
__device__ __forceinline__ void dn_prep_item(const bf16* proj, const float* cw, const float* ba, const float* a_log, const float* dt_bias, float* qn, float* kn, float* vn, float* beta, float* gg, int w, int lane) {
    const int t = w >> 3, h = w & 7, s = t % SEQ;
    float val[3][2];
#pragma unroll
    for (int p = 0; p < 3; ++p)
#pragma unroll
        for (int e = 0; e < 2; ++e) { const int d = lane * 2 + e, c = p * DDN + h * HD + d; float a = 0.f;
#pragma unroll
            for (int k = 0; k < 4; ++k) { const int sp = s - 3 + k; if (sp >= 0) a += cw[k * 3 * DDN + c] * bf2f(proj[(size_t)(t - 3 + k) * NPROJ + 2048 + c]); }
            val[p][e] = silu_f(a); }
    const float sq = wave_sum(val[0][0] * val[0][0] + val[0][1] * val[0][1], lane), sk = wave_sum(val[1][0] * val[1][0] + val[1][1] * val[1][1], lane);
    const float rq = rsqrt_f(sq + EPS) * 0.08838834764831845f, rk = rsqrt_f(sk + EPS);
    const size_t o = ((size_t)t * NH + h) * HD + lane * 2;
    qn[o] = val[0][0] * rq; qn[o + 1] = val[0][1] * rq; kn[o] = val[1][0] * rk; kn[o + 1] = val[1][1] * rk; vn[o] = val[2][0]; vn[o + 1] = val[2][1];
    if (lane == 0) { beta[t * NH + h] = sigmoid_f(ba[(size_t)t * 16 + h]); gg[t * NH + h] = -__expf(a_log[h]) * softplus_f(ba[(size_t)t * 16 + 8 + h] + dt_bias[h]); }
}
__device__ __forceinline__ void dn_rec_seq(const float* qn, const float* kn, const float* vn, const float* beta, const float* gg, float* o, int bh, LAS float* sk, LAS float* sq, LAS float* st, int tid) {
    const int b = bh >> 3, h = bh & 7, j = tid & 127; const bool act = tid < 128;
    if (act) for (int k = 0; k < 128; ++k) st[k * 128 + j] = 0.f;
    const size_t base = ((size_t)(b * SEQ) * NH + h) * HD;
    float nk = kn[base + j], nq = qn[base + j], nv = vn[base + j], nb = beta[(b * SEQ) * NH + h], ng = gg[(b * SEQ) * NH + h];
    for (int s = 0; s < SEQ; ++s) {
        const int buf = (s & 1) * 128;
        if (act) { sk[buf + j] = nk; sq[buf + j] = nq; }
        const float vj = nv, be = nb, ge = __expf(ng);
        __syncthreads();
        if (act) {
            if (s + 1 < SEQ) { const size_t nb_ = ((size_t)(b * SEQ + s + 1) * NH + h) * HD; nk = kn[nb_ + j]; nq = qn[nb_ + j]; nv = vn[nb_ + j]; nb = beta[(b * SEQ + s + 1) * NH + h]; ng = gg[(b * SEQ + s + 1) * NH + h]; }
            float ks = 0.f;
#pragma unroll 8
            for (int k = 0; k < 128; ++k) ks += sk[buf + k] * st[k * 128 + j];
            const float vnew = be * (vj - ge * ks);
            float oo = 0.f;
#pragma unroll 8
            for (int k = 0; k < 128; ++k) { const float sv = ge * st[k * 128 + j] + sk[buf + k] * vnew; st[k * 128 + j] = sv; oo += sq[buf + k] * sv; }
            o[((size_t)(b * SEQ + s) * NH + h) * HD + j] = oo;
        }
    }
    __syncthreads();
}
typedef short bf16x8 __attribute__((ext_vector_type(8)));
__device__ __forceinline__ f32x4 mfma16(bf16x8 a, bf16x8 b, f32x4 c) { return __builtin_amdgcn_mfma_f32_16x16x32_bf16(a, b, c, 0, 0, 0); }
__device__ __forceinline__ float bflo(unsigned x) { return __uint_as_float(x << 16); }
__device__ __forceinline__ float bfhi(unsigned x) { return __uint_as_float(x & 0xffff0000u); }
constexpr int DA_G = 0, DA_L = 1024, DA_KN = DA_L + 16384, DA_QN = DA_KN + 17408, DA_VBT = DA_QN + 17408, DA_KBET = DA_VBT + 18432, DA_KDT = DA_KBET + 18432, DA_TB = DA_KDT + 18432, DA_QK = DA_TB + 9216, DA_END = DA_QK + 9216;
static_assert(DA_END <= RING_BYTES, "DN-A LDS map");
#if defined(PROBE_DNA_A)
#define DNA_ST(k) do { if (threadIdx.x == 0) ((volatile LAS unsigned long long*)(lds + (RING_BYTES + 2048)))[k] = __builtin_amdgcn_s_memrealtime(); } while (0)
#else
#define DNA_ST(k) do { } while (0)
#endif
__device__ __forceinline__ void dna_unit(const bf16* proj, const float* cw, const float* ba, const float* a_log, const float* dt_bias,
                                         bf16* Wf, bf16* Qf, bf16* KdTf, bf16* QKf, bf16* Uf, float* glb, int uid, LAS unsigned char* lds, int tid, int lane, int wave) {
    const int h = uid & 7, n = (uid >> 3) & 127, b = uid >> 10, t0 = b * SEQ + n * 64;
    asm volatile("" : "+v"(lds));
    DNA_ST(0);
    LAS float* Gs = (LAS float*)(lds + DA_G);
    const int fr = lane & 15, fq = lane >> 4;
    if (wave == 0) {
        const size_t t = (size_t)(t0 + lane);
        const float be = sigmoid_f(ba[t * 16 + h]); float Gc = -__expf(a_log[h]) * softplus_f(ba[t * 16 + 8 + h] + dt_bias[h]);
#pragma unroll
        for (int off = 1; off < 64; off <<= 1) { const float tmp = shfl_up_l(Gc, off, lane); if (lane >= off) Gc += tmp; }
        const float GL = shfl_idx_l(Gc, 63);
        Gs[lane] = Gc; Gs[64 + lane] = be; Gs[128 + lane] = __expf(Gc); Gs[192 + lane] = __expf(GL - Gc);
        if (lane == 63) glb[uid] = __expf(Gc);
    }
    LDS_BARRIER();
    DNA_ST(1);
    {
        const int r = tid >> 3, cg = tid & 7;
        const float be = Gs[64 + r], eg = Gs[128 + r], egl = Gs[192 + r];
        float val[3][16];
#pragma unroll
        for (int p = 0; p < 3; ++p) {
            const int ccol = p * DDN + h * HD + cg * 16;
            float acc[16];
#pragma unroll
            for (int i = 0; i < 16; ++i) acc[i] = 0.f;
#pragma unroll
            for (int k = 0; k < 4; ++k) { const int row = r - 3 + k;
                if (n * 64 + row >= 0) {
                    const bf16* src = proj + (size_t)(t0 + row) * NPROJ + 2048 + ccol;
                    const u32x4 x0 = *(const u32x4*)src, x1 = *(const u32x4*)(src + 8);
                    const float* wp = cw + k * 3 * DDN + ccol;
                    const f32x4 w0 = *(const f32x4*)wp, w1 = *(const f32x4*)(wp + 4), w2 = *(const f32x4*)(wp + 8), w3 = *(const f32x4*)(wp + 12);
                    acc[0] += w0[0] * bflo(x0.x); acc[1] += w0[1] * bfhi(x0.x); acc[2] += w0[2] * bflo(x0.y); acc[3] += w0[3] * bfhi(x0.y);
                    acc[4] += w1[0] * bflo(x0.z); acc[5] += w1[1] * bfhi(x0.z); acc[6] += w1[2] * bflo(x0.w); acc[7] += w1[3] * bfhi(x0.w);
                    acc[8] += w2[0] * bflo(x1.x); acc[9] += w2[1] * bfhi(x1.x); acc[10] += w2[2] * bflo(x1.y); acc[11] += w2[3] * bfhi(x1.y);
                    acc[12] += w3[0] * bflo(x1.z); acc[13] += w3[1] * bfhi(x1.z); acc[14] += w3[2] * bflo(x1.w); acc[15] += w3[3] * bfhi(x1.w);
                } }
#pragma unroll
            for (int i = 0; i < 16; ++i) val[p][i] = silu_f(acc[i]);
        }
        float sq = 0.f, sk = 0.f;
#pragma unroll
        for (int i = 0; i < 16; ++i) { sq += val[0][i] * val[0][i]; sk += val[1][i] * val[1][i]; }
        sq += shfl_xor_l(sq, 1, lane); sq += shfl_xor_l(sq, 2, lane); sq += shfl_xor_l(sq, 4, lane);
        sk += shfl_xor_l(sk, 1, lane); sk += shfl_xor_l(sk, 2, lane); sk += shfl_xor_l(sk, 4, lane);
        const float rq = rsqrt_f(sq + EPS) * 0.08838834764831845f, rk = rsqrt_f(sk + EPS);
#pragma unroll
        for (int i = 0; i < 16; ++i) { val[0][i] *= rq; val[1][i] *= rk; }
        u32x4 o0, o1;
        o0.x = pk2(val[1][0], val[1][1]); o0.y = pk2(val[1][2], val[1][3]); o0.z = pk2(val[1][4], val[1][5]); o0.w = pk2(val[1][6], val[1][7]);
        o1.x = pk2(val[1][8], val[1][9]); o1.y = pk2(val[1][10], val[1][11]); o1.z = pk2(val[1][12], val[1][13]); o1.w = pk2(val[1][14], val[1][15]);
        *(LAS u32x4*)(lds + DA_KN + r * 272 + cg * 32) = o0; *(LAS u32x4*)(lds + DA_KN + r * 272 + cg * 32 + 16) = o1;
        o0.x = pk2(val[0][0], val[0][1]); o0.y = pk2(val[0][2], val[0][3]); o0.z = pk2(val[0][4], val[0][5]); o0.w = pk2(val[0][6], val[0][7]);
        o1.x = pk2(val[0][8], val[0][9]); o1.y = pk2(val[0][10], val[0][11]); o1.z = pk2(val[0][12], val[0][13]); o1.w = pk2(val[0][14], val[0][15]);
        *(LAS u32x4*)(lds + DA_QN + r * 272 + cg * 32) = o0; *(LAS u32x4*)(lds + DA_QN + r * 272 + cg * 32 + 16) = o1;
#pragma unroll
        for (int i = 0; i < 16; ++i) { const int f = cg * 16 + i;
            *(LAS unsigned short*)(lds + DA_VBT + f * 144 + r * 2) = (unsigned short)f2bf(val[2][i] * be);
            *(LAS unsigned short*)(lds + DA_KBET + f * 144 + r * 2) = (unsigned short)f2bf(val[1][i] * (be * eg));
            *(LAS unsigned short*)(lds + DA_KDT + f * 144 + r * 2) = (unsigned short)f2bf(val[1][i] * egl); }
    }
    LDS_BARRIER();
    DNA_ST(2);
    {
        const int p = wave >> 2, ti = wave & 3;
        const int abase = p == 0 ? DA_KN : DA_QN;
        bf16x8 af[4];
#pragma unroll
        for (int ks = 0; ks < 4; ++ks) af[ks] = *(const LAS bf16x8*)(lds + abase + (ti * 16 + fr) * 272 + (ks * 32 + fq * 8) * 2);
        for (int tj = 0; tj < 4; ++tj) {
            f32x4 acc = {0.f, 0.f, 0.f, 0.f};
            if (tj <= ti) {
#pragma unroll
                for (int ks = 0; ks < 4; ++ks) { const bf16x8 bb = *(const LAS bf16x8*)(lds + DA_KN + (tj * 16 + fr) * 272 + (ks * 32 + fq * 8) * 2); acc = mfma16(af[ks], bb, acc); }
            }
            const int j = tj * 16 + fr; const float Gj = Gs[j];
#pragma unroll
            for (int r = 0; r < 4; ++r) { const int i = ti * 16 + fq * 4 + r; float v = 0.f;
                if (p == 0) { if (i > j) v = Gs[64 + i] * acc[r] * __expf(Gs[i] - Gj); *(LAS float*)(lds + DA_L + (j * 64 + i) * 4) = v; }
                else { if (i >= j) v = acc[r] * __expf(Gs[i] - Gj); *(LAS unsigned short*)(lds + DA_QK + i * 144 + j * 2) = (unsigned short)f2bf(v); } }
        }
    }
    LDS_BARRIER();
    DNA_ST(3);
    {
        int lc = lane; asm volatile("" : "+v"(lc)); const float fl = (float)lc;
        const int blk = wave < 4 ? wave : 11 - wave;
        float Tr[8];
#pragma unroll
        for (int c = 0; c < 8; ++c) Tr[c] = fmaxf(0.f, 1.f - fabsf(fl - (float)(blk * 8 + c)));
        float lj[63];
#pragma unroll
        for (int j = 0; j < 63; ++j) lj[j] = *(const LAS float*)(lds + DA_L + (j * 64) * 4 + lc * 4);
#pragma unroll
        for (int j = 0; j < 63; ++j) {
            if (j >= blk * 8) {
#pragma unroll
                for (int c = 0; c < 8; ++c) { const float tj = __int_as_float(__builtin_amdgcn_readlane(__float_as_int(Tr[c]), j)); Tr[c] -= lj[j] * tj; }
            }
        }
        u32x4 o; o.x = pk2(Tr[0], Tr[1]); o.y = pk2(Tr[2], Tr[3]); o.z = pk2(Tr[4], Tr[5]); o.w = pk2(Tr[6], Tr[7]);
        *(LAS u32x4*)(lds + DA_TB + lc * 144 + blk * 16) = o;
    }
    {
        for (int fi = wave; fi < 40; fi += 8) {
            if (fi < 8) { const int mt = fi >> 1, ks = fi & 1;
                const u32x4 v = *(const LAS u32x4*)(lds + DA_QK + (mt * 16 + fr) * 144 + (ks * 32 + fq * 8) * 2);
                *(u32x4*)(QKf + (((size_t)uid * 4 + mt) * 2 + ks) * 512 + lane * 8) = v; }
            else if (fi < 24) { const int f2 = fi - 8, mt = f2 >> 2, ks = f2 & 3; const float eg = Gs[128 + mt * 16 + fr];
                const u32x4 v = *(const LAS u32x4*)(lds + DA_QN + (mt * 16 + fr) * 272 + (ks * 32 + fq * 8) * 2); u32x4 o;
                o.x = pk2(bflo(v.x) * eg, bfhi(v.x) * eg); o.y = pk2(bflo(v.y) * eg, bfhi(v.y) * eg); o.z = pk2(bflo(v.z) * eg, bfhi(v.z) * eg); o.w = pk2(bflo(v.w) * eg, bfhi(v.w) * eg);
                *(u32x4*)(Qf + (((size_t)uid * 4 + mt) * 4 + ks) * 512 + lane * 8) = o; }
            else { const int f2 = fi - 24, ft = f2 >> 1, ks = f2 & 1;
                const u32x4 v = *(const LAS u32x4*)(lds + DA_KDT + (ft * 16 + fr) * 144 + (ks * 32 + fq * 8) * 2);
                *(u32x4*)(KdTf + (((size_t)uid * 8 + ft) * 2 + ks) * 512 + lane * 8) = v; }
        }
    }
    LDS_BARRIER();
    DNA_ST(4);
    {
        bf16x8 ta[4][2];
#pragma unroll
        for (int mt = 0; mt < 4; ++mt)
#pragma unroll
            for (int ks = 0; ks < 2; ++ks) ta[mt][ks] = *(const LAS bf16x8*)(lds + DA_TB + (mt * 16 + fr) * 144 + (ks * 32 + fq * 8) * 2);
#pragma unroll
        for (int c2 = 0; c2 < 2; ++c2) { const int ct = wave * 2 + c2, img = ct < 8 ? DA_VBT : DA_KBET, cr = (ct & 7) * 16 + fr;
            bf16x8 bb[2];
#pragma unroll
            for (int ks = 0; ks < 2; ++ks) bb[ks] = *(const LAS bf16x8*)(lds + img + cr * 144 + (ks * 32 + fq * 8) * 2);
#pragma unroll
            for (int mt = 0; mt < 4; ++mt) { f32x4 acc = {0.f, 0.f, 0.f, 0.f};
#pragma unroll
                for (int ks = 0; ks < 2; ++ks) acc = mfma16(ta[mt][ks], bb[ks], acc);
                if (ct < 8) { u32x2 o; o.x = pk2(acc[0], acc[1]); o.y = pk2(acc[2], acc[3]); *(u32x2*)(Uf + ((((size_t)uid * 8 + ct) * 4 + mt) * 64 + lane) * 4) = o; }
                else { const int f = (ct - 8) * 16 + fr;
#pragma unroll
                    for (int r = 0; r < 4; ++r) *(LAS unsigned short*)(lds + DA_KN + (mt * 16 + fq * 4 + r) * 272 + f * 2) = (unsigned short)f2bf(acc[r]); } }
        }
    }
    LDS_BARRIER();
    DNA_ST(5);
#pragma unroll
    for (int q2 = 0; q2 < 2; ++q2) { const int fi = wave * 2 + q2, mt = fi >> 2, ks = fi & 3;
        const u32x4 v = *(const LAS u32x4*)(lds + DA_KN + (mt * 16 + fr) * 272 + (ks * 32 + fq * 8) * 2);
        *(u32x4*)(Wf + (((size_t)uid * 4 + mt) * 4 + ks) * 512 + lane * 8) = v; }
    LDS_BARRIER();
    DNA_ST(6);
}
struct DnbFrag { bf16x8 a1[4]; bf16x8 a2[2]; bf16x8 kd[2]; u32x2 u; float gl; };
__device__ __forceinline__ DnbFrag dnb_load(const bf16* A1, const bf16* QKf, const bf16* KdTf, const bf16* Uf, const float* glb, int uid, int ds, int wave, int lane) {
    DnbFrag f; const int mt = wave & 3;
#pragma unroll
    for (int ks = 0; ks < 4; ++ks) f.a1[ks] = *(const bf16x8*)(A1 + (((size_t)uid * 4 + mt) * 4 + ks) * 512 + lane * 8);
#pragma unroll
    for (int ks = 0; ks < 2; ++ks) f.kd[ks] = *(const bf16x8*)(KdTf + (((size_t)uid * 8 + wave) * 2 + ks) * 512 + lane * 8);
#pragma unroll
    for (int ks = 0; ks < 2; ++ks) f.a2[ks] = *(const bf16x8*)(QKf + (((size_t)uid * 4 + mt) * 2 + ks) * 512 + lane * 8);
    f.u = *(const u32x2*)(Uf + ((((size_t)uid * 8 + ds) * 4 + mt) * 64 + lane) * 4);
    f.gl = glb[uid];
    return f;
}
__device__ __forceinline__ void dnb_run(const bf16* Wf, const bf16* Qf, const bf16* KdTf, const bf16* QKf, const bf16* Uf, const float* glb, float* o, int bh, int ds, LAS unsigned char* lds, int tid, int lane, int wave) {
    const int b = bh >> 3, h = bh & 7, fr = lane & 15, fq = lane >> 4, mt = wave & 3;
    asm volatile("" : "+v"(lds));
    LAS unsigned char* ST = lds; LAS unsigned char* VNT = lds + 4608;
    for (int i = tid; i < 4608 / 4; i += 512) ((LAS unsigned*)ST)[i] = 0u;
    f32x4 accS = {0.f, 0.f, 0.f, 0.f};
    const bf16* A1 = wave < 4 ? Wf : Qf;
    DnbFrag f0 = dnb_load(A1, QKf, KdTf, Uf, glb, (b * 128 + 0) * 8 + h, ds, wave, lane), f1 = dnb_load(A1, QKf, KdTf, Uf, glb, (b * 128 + 1) * 8 + h, ds, wave, lane);
    DnbFrag f2 = dnb_load(A1, QKf, KdTf, Uf, glb, (b * 128 + 2) * 8 + h, ds, wave, lane), f3 = dnb_load(A1, QKf, KdTf, Uf, glb, (b * 128 + 3) * 8 + h, ds, wave, lane);
    __syncthreads();
#define DNB_STEP(F, nn) do { const int n = (nn); \
        f32x4 acc = {0.f, 0.f, 0.f, 0.f}; \
        _Pragma("unroll") for (int ks = 0; ks < 4; ++ks) { const bf16x8 sb = *(const LAS bf16x8*)(ST + fr * 272 + (ks * 32 + fq * 8) * 2); acc = mfma16(F.a1[ks], sb, acc); } \
        if (wave < 4) { const float v0 = bflo(F.u.x) - acc[0], v1 = bfhi(F.u.x) - acc[1], v2 = bflo(F.u.y) - acc[2], v3 = bfhi(F.u.y) - acc[3]; \
            u32x2 w; w.x = pk2(v0, v1); w.y = pk2(v2, v3); *(LAS u32x2*)(VNT + fr * 144 + (mt * 16 + fq * 4) * 2) = w; } \
        LDS_BARRIER(); \
        bf16x8 vb[2]; \
        _Pragma("unroll") for (int ks = 0; ks < 2; ++ks) vb[ks] = *(const LAS bf16x8*)(VNT + fr * 144 + (ks * 32 + fq * 8) * 2); \
        if (wave >= 4) { _Pragma("unroll") for (int ks = 0; ks < 2; ++ks) acc = mfma16(F.a2[ks], vb[ks], acc); \
            const size_t ob = ((size_t)(b * SEQ + n * 64 + mt * 16 + fq * 4) * NH + h) * HD + ds * 16 + fr; \
            _Pragma("unroll") for (int r = 0; r < 4; ++r) o[ob + (size_t)r * NH * HD] = acc[r]; } \
        accS = accS * F.gl; \
        _Pragma("unroll") for (int ks = 0; ks < 2; ++ks) accS = mfma16(F.kd[ks], vb[ks], accS); \
        { u32x2 w; w.x = pk2(accS[0], accS[1]); w.y = pk2(accS[2], accS[3]); *(LAS u32x2*)(ST + fr * 272 + (wave * 16 + fq * 4) * 2) = w; } \
        F = dnb_load(A1, QKf, KdTf, Uf, glb, (b * 128 + (n + 4 < 128 ? n + 4 : 127)) * 8 + h, ds, wave, lane);     \
        LDS_BARRIER(); } while (0)
    for (int n4 = 0; n4 < 128; n4 += 16) {
        DNB_STEP(f0, n4); DNB_STEP(f1, n4 + 1); DNB_STEP(f2, n4 + 2); DNB_STEP(f3, n4 + 3); DNB_STEP(f0, n4 + 4); DNB_STEP(f1, n4 + 5); DNB_STEP(f2, n4 + 6); DNB_STEP(f3, n4 + 7);
        DNB_STEP(f0, n4 + 8); DNB_STEP(f1, n4 + 9); DNB_STEP(f2, n4 + 10); DNB_STEP(f3, n4 + 11); DNB_STEP(f0, n4 + 12); DNB_STEP(f1, n4 + 13); DNB_STEP(f2, n4 + 14); DNB_STEP(f3, n4 + 15); }
#undef DNB_STEP
}
constexpr int LA_XB = 0, LA_XF = 17408, LA_END = LA_XF + 64 * 132 * 4;
static_assert(LA_END <= RING_BYTES, "LRU-A LDS map");
__device__ __forceinline__ void lrua_unit(const bf16* proj, const float* cw, const float* cb, const bf16* WrT, const bf16* WiT, const float* b_r, const float* b_i, const float* lam,
                                          float* Hloc, float* Acum, float* summ, int unit, LAS unsigned char* lds, int tid, int lane, int wave) {
    const int nb = unit & 7, ct = unit >> 3, n = ct & 127, t0 = ct * 64;
    asm volatile("" : "+v"(lds));
    {
        const int r = tid >> 3, cg = tid & 7, ch0 = nb * 128 + cg * 16;
        float acc[16];
        { const f32x4 c0v = *(const f32x4*)(cb + ch0), c1v = *(const f32x4*)(cb + ch0 + 4), c2v = *(const f32x4*)(cb + ch0 + 8), c3v = *(const f32x4*)(cb + ch0 + 12);
#pragma unroll
          for (int i = 0; i < 4; ++i) { acc[i] = c0v[i]; acc[4 + i] = c1v[i]; acc[8 + i] = c2v[i]; acc[12 + i] = c3v[i]; } }
#pragma unroll
        for (int k = 0; k < 4; ++k) { const int row = r - 3 + k;
            if (n * 64 + row >= 0) {
                const bf16* src = proj + (size_t)(t0 + row) * NPROJ + ch0;
                const u32x4 x0 = *(const u32x4*)src, x1 = *(const u32x4*)(src + 8);
                const float* wp = cw + k * DLRU + ch0;
                const f32x4 w0 = *(const f32x4*)wp, w1 = *(const f32x4*)(wp + 4), w2 = *(const f32x4*)(wp + 8), w3 = *(const f32x4*)(wp + 12);
                acc[0] += w0[0] * bflo(x0.x); acc[1] += w0[1] * bfhi(x0.x); acc[2] += w0[2] * bflo(x0.y); acc[3] += w0[3] * bfhi(x0.y);
                acc[4] += w1[0] * bflo(x0.z); acc[5] += w1[1] * bfhi(x0.z); acc[6] += w1[2] * bflo(x0.w); acc[7] += w1[3] * bfhi(x0.w);
                acc[8] += w2[0] * bflo(x1.x); acc[9] += w2[1] * bfhi(x1.x); acc[10] += w2[2] * bflo(x1.y); acc[11] += w2[3] * bfhi(x1.y);
                acc[12] += w3[0] * bflo(x1.z); acc[13] += w3[1] * bfhi(x1.z); acc[14] += w3[2] * bflo(x1.w); acc[15] += w3[3] * bfhi(x1.w);
            } }
        u32x4 o0, o1;
        o0.x = pk2(acc[0], acc[1]); o0.y = pk2(acc[2], acc[3]); o0.z = pk2(acc[4], acc[5]); o0.w = pk2(acc[6], acc[7]);
        o1.x = pk2(acc[8], acc[9]); o1.y = pk2(acc[10], acc[11]); o1.z = pk2(acc[12], acc[13]); o1.w = pk2(acc[14], acc[15]);
        *(LAS u32x4*)(lds + LA_XB + r * 272 + cg * 32) = o0; *(LAS u32x4*)(lds + LA_XB + r * 272 + cg * 32 + 16) = o1;
        LAS f32x4* xf = (LAS f32x4*)(lds + LA_XF + (r * 132 + cg * 16) * 4);
        xf[0] = (f32x4){acc[0], acc[1], acc[2], acc[3]}; xf[1] = (f32x4){acc[4], acc[5], acc[6], acc[7]}; xf[2] = (f32x4){acc[8], acc[9], acc[10], acc[11]}; xf[3] = (f32x4){acc[12], acc[13], acc[14], acc[15]};
    }
    LDS_BARRIER();
    const int fr = lane & 15, fq = lane >> 4, cl = wave * 16 + fr, ch = nb * 128 + cl;
    bf16x8 br[4], bi[4];
#pragma unroll
    for (int ks = 0; ks < 4; ++ks) { br[ks] = *(const bf16x8*)(WrT + ((size_t)nb * 128 + cl) * 128 + ks * 32 + fq * 8); bi[ks] = *(const bf16x8*)(WiT + ((size_t)nb * 128 + cl) * 128 + ks * 32 + fq * 8); }
    f32x4 ar[4], ai[4];
#pragma unroll
    for (int mt = 0; mt < 4; ++mt) { ar[mt] = (f32x4){0.f, 0.f, 0.f, 0.f}; ai[mt] = (f32x4){0.f, 0.f, 0.f, 0.f};
#pragma unroll
        for (int ks = 0; ks < 4; ++ks) { const bf16x8 af = *(const LAS bf16x8*)(lds + LA_XB + (mt * 16 + fr) * 272 + (ks * 32 + fq * 8) * 2); ar[mt] = mfma16(af, br[ks], ar[mt]); ai[mt] = mfma16(af, bi[ks], ai[mt]); } }
    const float brr = b_r[ch], bii = b_i[ch], sp8 = -8.0f * softplus_f(-lam[ch]);
    float Ac = 1.f, Bc = 0.f;
#pragma unroll
    for (int mt = 0; mt < 4; ++mt) {
        float P[4], H[4];
#pragma unroll
        for (int r = 0; r < 4; ++r) { const int t = mt * 16 + fq * 4 + r; const float xcv = *(const LAS float*)(lds + LA_XF + (t * 132 + cl) * 4);
            const float rr = sigmoid_f(ar[mt][r] + brr), ii = sigmoid_f(ai[mt][r] + bii), la = sp8 * rr, a = __expf(la), bb = __builtin_amdgcn_sqrtf(fmaxf(1.0f - a * a, 0.0f)) * (ii * xcv);
            if (r == 0) { P[0] = a; H[0] = bb; } else { P[r] = P[r - 1] * a; H[r] = a * H[r - 1] + bb; } }
        float Ai = P[3], Bi = H[3];
        { const float Au = shfl_up_l(Ai, 16, lane), Bu = shfl_up_l(Bi, 16, lane); if (fq >= 1) { Bi = Ai * Bu + Bi; Ai = Au * Ai; } }
        { const float Au = shfl_up_l(Ai, 32, lane), Bu = shfl_up_l(Bi, 32, lane); if (fq >= 2) { Bi = Ai * Bu + Bi; Ai = Au * Ai; } }
        float Ae = shfl_up_l(Ai, 16, lane), Be = shfl_up_l(Bi, 16, lane); if (fq == 0) { Ae = 1.f; Be = 0.f; }
        const float At = shfl_idx_l(Ai, 48 + fr), Bt = shfl_idx_l(Bi, 48 + fr);
        const float PA = Ac * Ae, PB = Ae * Bc + Be;
#pragma unroll
        for (int r = 0; r < 4; ++r) { const size_t o = (size_t)(t0 + mt * 16 + fq * 4 + r) * DLRU + ch; ((unsigned*)Hloc)[o] = pk2(P[r] * PB + H[r], PA * P[r]); }
        Bc = At * Bc + Bt; Ac = Ac * At;
    }
    if (fq == 0) { float* sp = summ + ((size_t)ct * DLRU + ch) * 2; sp[0] = Ac; sp[1] = Bc; }
    LDS_BARRIER();
}
__device__ __forceinline__ void lru_carry(const float* summ, float* carry, int idx) {
    const int b = idx >> 10, ch = idx & 1023; float c = 0.f;
    for (int n0 = 0; n0 < 128; n0 += 8) { float A[8], B[8];
#pragma unroll
        for (int j = 0; j < 8; ++j) { const float* sp = summ + ((size_t)(b * 128 + n0 + j) * DLRU + ch) * 2; A[j] = sp[0]; B[j] = sp[1]; }
#pragma unroll
        for (int j = 0; j < 8; ++j) { carry[(size_t)(b * 128 + n0 + j) * DLRU + ch] = c; c = A[j] * c + B[j]; } }
}
__device__ __forceinline__ void lrub_row(const float* Hloc, const float* Acum, const float* carry, const bf16* proj, const float* gain, bf16* ymix, int row, int lane) {
    const int ct = row >> 6; f32x4 y[4]; float ss = 0.f;
#pragma unroll
    for (int j = 0; j < 4; ++j) { const int c4 = lane * 4 + 256 * j;
        const u32x4 ha = *(const u32x4*)((const unsigned*)Hloc + (size_t)row * DLRU + c4); const f32x4 cr = *(const f32x4*)(carry + (size_t)ct * DLRU + c4);
        const u32x2 g = *(const u32x2*)(proj + (size_t)row * NPROJ + DLRU + c4);
        const f32x4 hl = {bflo(ha.x), bflo(ha.y), bflo(ha.z), bflo(ha.w)}, ac = {bfhi(ha.x), bfhi(ha.y), bfhi(ha.z), bfhi(ha.w)};
        const f32x4 hh = hl + ac * cr;
        y[j][0] = hh[0] * gelu_tanh_f(bflo(g.x)); y[j][1] = hh[1] * gelu_tanh_f(bfhi(g.x)); y[j][2] = hh[2] * gelu_tanh_f(bflo(g.y)); y[j][3] = hh[3] * gelu_tanh_f(bfhi(g.y));
        ss += (y[j][0] * y[j][0] + y[j][1] * y[j][1]) + (y[j][2] * y[j][2] + y[j][3] * y[j][3]); }
    ss = wave_sum(ss, lane); const float rs = rsqrt_f(ss * (1.0f / DLRU) + EPS);
#pragma unroll
    for (int j = 0; j < 4; ++j) { const int c4 = lane * 4 + 256 * j; const f32x4 g = *(const f32x4*)(gain + c4); u32x2 w; w.x = pk2(y[j][0] * rs * g[0], y[j][1] * rs * g[1]); w.y = pk2(y[j][2] * rs * g[2], y[j][3] * rs * g[3]);
        *(u32x2*)(ymix + (size_t)row * D + c4) = w; }
}
__device__ __forceinline__ void dn_out_row(const float* o, const float* gain, const bf16* proj, bf16* ymix, int t, int lane) {
    const int c = lane * 16;
    const f32x4* op = (const f32x4*)(o + (size_t)t * DDN + c); const f32x4 o0 = op[0], o1 = op[1], o2 = op[2], o3 = op[3];
    const u32x4* gp = (const u32x4*)(proj + (size_t)t * NPROJ + 5120 + c); const u32x4 g0 = gp[0], g1 = gp[1];
    const f32x4* wp = (const f32x4*)(gain + (c & 127)); const f32x4 w0 = wp[0], w1 = wp[1], w2 = wp[2], w3 = wp[3];
    float ss = (o0[0] * o0[0] + o0[1] * o0[1]) + (o0[2] * o0[2] + o0[3] * o0[3]) + (o1[0] * o1[0] + o1[1] * o1[1]) + (o1[2] * o1[2] + o1[3] * o1[3])
             + (o2[0] * o2[0] + o2[1] * o2[1]) + (o2[2] * o2[2] + o2[3] * o2[3]) + (o3[0] * o3[0] + o3[1] * o3[1]) + (o3[2] * o3[2] + o3[3] * o3[3]);
    ss += shfl_xor_l(ss, 1, lane); ss += shfl_xor_l(ss, 2, lane); ss += shfl_xor_l(ss, 4, lane);
    const float rs = rsqrt_f(ss * (1.0f / HD) + EPS);
    u32x4 r0, r1;
    r0.x = pk2(o0[0] * rs * w0[0] * silu_f(bflo(g0.x)), o0[1] * rs * w0[1] * silu_f(bfhi(g0.x))); r0.y = pk2(o0[2] * rs * w0[2] * silu_f(bflo(g0.y)), o0[3] * rs * w0[3] * silu_f(bfhi(g0.y)));
    r0.z = pk2(o1[0] * rs * w1[0] * silu_f(bflo(g0.z)), o1[1] * rs * w1[1] * silu_f(bfhi(g0.z))); r0.w = pk2(o1[2] * rs * w1[2] * silu_f(bflo(g0.w)), o1[3] * rs * w1[3] * silu_f(bfhi(g0.w)));
    r1.x = pk2(o2[0] * rs * w2[0] * silu_f(bflo(g1.x)), o2[1] * rs * w2[1] * silu_f(bfhi(g1.x))); r1.y = pk2(o2[2] * rs * w2[2] * silu_f(bflo(g1.y)), o2[3] * rs * w2[3] * silu_f(bfhi(g1.y)));
    r1.z = pk2(o3[0] * rs * w3[0] * silu_f(bflo(g1.z)), o3[1] * rs * w3[1] * silu_f(bfhi(g1.z))); r1.w = pk2(o3[2] * rs * w3[2] * silu_f(bflo(g1.w)), o3[3] * rs * w3[3] * silu_f(bfhi(g1.w)));
    u32x4* dst = (u32x4*)(ymix + (size_t)t * D + DLRU + c); dst[0] = r0; dst[1] = r1;
}
__device__ __forceinline__ void route_row(const float* x, const float* rstd, const float* gain, const float* router, float* roww, int row, int lane) {
    float acc[8];
#pragma unroll
    for (int e = 0; e < 8; ++e) acc[e] = 0.f;
    for (int j = 0; j < 32; ++j) { const int k = lane + 64 * j; const float xv = x[(size_t)row * D + k] * gain[k]; const f32x4 r0 = *(const f32x4*)(router + (size_t)k * 8), r1 = *(const f32x4*)(router + (size_t)k * 8 + 4);
        acc[0] += xv * r0[0]; acc[1] += xv * r0[1]; acc[2] += xv * r0[2]; acc[3] += xv * r0[3]; acc[4] += xv * r1[0]; acc[5] += xv * r1[1]; acc[6] += xv * r1[2]; acc[7] += xv * r1[3]; }
    const float rs = rstd[row];
#pragma unroll
    for (int e = 0; e < 8; ++e) acc[e] = wave_sum(acc[e], lane) * rs;
    int e1 = 0; float l1 = acc[0];
#pragma unroll
    for (int e = 1; e < 8; ++e) if (acc[e] > l1) { l1 = acc[e]; e1 = e; }
    int e2 = -1; float l2 = -3.4e38f;
#pragma unroll
    for (int e = 0; e < 8; ++e) if (e != e1 && acc[e] > l2) { l2 = acc[e]; e2 = e; }
    const float w1 = 1.0f / (1.0f + __expf(l2 - l1)), w2 = 1.0f - w1;
    if (lane < 8) roww[(size_t)lane * T + row] = lane == e1 ? w1 : (lane == e2 ? w2 : 0.0f);
}
__device__ __forceinline__ void final_row(const float* x, const float* gain, float* out, int row, int lane) {
    const f32x4* xr = (const f32x4*)(x + (size_t)row * D) + lane; const f32x4* gr = (const f32x4*)gain + lane;
    f32x4 v[8]; float ss = 0.f;
#pragma unroll
    for (int j = 0; j < 8; ++j) { v[j] = xr[64 * j]; ss += (v[j][0] * v[j][0] + v[j][1] * v[j][1]) + (v[j][2] * v[j][2] + v[j][3] * v[j][3]); }
    ss = wave_sum(ss, lane); const float rs = rsqrt_f(ss * (1.0f / D) + EPS);
    f32x4* o = (f32x4*)(out + (size_t)row * D) + lane;
#pragma unroll
    for (int j = 0; j < 8; ++j) o[64 * j] = v[j] * rs * gr[64 * j];
}

struct MoeOrder {
    const int* list; int nN, G, c; int c0, c1, c2, c3, c4, c5, c6, c7;
    __device__ __forceinline__ void init(const unsigned* cnt, const int* list_, int nN_, int G_, int c_) { list = list_; nN = nN_; G = G_; c = c_;
        c0 = __builtin_amdgcn_readfirstlane((int)cnt[0]); c1 = __builtin_amdgcn_readfirstlane((int)cnt[1]); c2 = __builtin_amdgcn_readfirstlane((int)cnt[2]); c3 = __builtin_amdgcn_readfirstlane((int)cnt[3]);
        c4 = __builtin_amdgcn_readfirstlane((int)cnt[4]); c5 = __builtin_amdgcn_readfirstlane((int)cnt[5]); c6 = __builtin_amdgcn_readfirstlane((int)cnt[6]); c7 = __builtin_amdgcn_readfirstlane((int)cnt[7]); }
    __device__ __forceinline__ bool next(int i, pg8::Unit& u) const {
        const int c8[8] = {c0, c1, c2, c3, c4, c5, c6, c7}; int nM = 0;
#pragma unroll
        for (int k = 0; k < 8; ++k) nM += (c8[k] + 255) >> 8;
        const int nwg = nM * nN; const long L = (long)i * G + c; if (L >= nwg) return false;
        int wgid = (int)L; { const int q = nwg / pg8::NXCD, r = nwg % pg8::NXCD, xcd = wgid % pg8::NXCD, off = wgid / pg8::NXCD; wgid = (xcd < r ? xcd * (q + 1) : r * (q + 1) + (xcd - r) * q) + off; }
        const int nig = pg8::WGM * nN, gid = wgid / nig, fm = gid * pg8::WGM, gsz = (nM - fm) < pg8::WGM ? (nM - fm) : pg8::WGM;
        u.pm = fm + ((wgid % nig) % gsz); u.pn = (wgid % nig) / gsz;
        int e = 0, ps = 0, ce = c8[0], run = 0;
#pragma unroll
        for (int k = 0; k < 8; ++k) { const int mk = (c8[k] + 255) >> 8; if (u.pm >= run && u.pm < run + mk) { e = k; ps = run; ce = c8[k]; } run += mk; }
        const int mtl = u.pm - ps; u.pb = e * nN + u.pn; u.lbase = e * T + mtl * 256; u.nvalid = (ce - mtl * 256) < 256 ? (ce - mtl * 256) : 256;
        return true;
    }
    __device__ __forceinline__ int arow(const pg8::Unit& u, int r) const { return r < u.nvalid ? (list[u.lbase + r] & 0xffff) : 0; }
    __device__ __forceinline__ void a_ready(const pg8::Unit&) const {}
    __device__ __forceinline__ void done(const pg8::Unit&) const {}
};
__device__ __forceinline__ void route_block(const float* x, const float* gain, const float* router, bf16* xb, float* rstd, unsigned* cnt, int* list, float* listw, int blk, LAS unsigned char* lds, int tid, int lane, int wave) {
    asm volatile("" : "+v"(lds));
    LAS float* grt = (LAS float*)lds; LAS int* se1 = (LAS int*)(lds + 65536); LAS int* se2 = se1 + 64; LAS float* sw1 = (LAS float*)(se2 + 64); LAS float* sw2 = sw1 + 64; LAS int* lcnt = (LAS int*)(sw2 + 64); LAS int* gbase = lcnt + 8;
    for (int i = tid; i < D * 8; i += 512) grt[i] = router[i] * gain[i >> 3];
    if (tid < 8) lcnt[tid] = 0;
    __syncthreads();
    for (int q = 0; q < 8; ++q) { const int rloc = wave * 8 + q, row = blk * 64 + rloc;
        const f32x4* xr = (const f32x4*)(x + (size_t)row * D) + lane;
        f32x4 v[8]; float ss = 0.f;
#pragma unroll
        for (int j = 0; j < 8; ++j) { v[j] = xr[64 * j]; ss += (v[j][0] * v[j][0] + v[j][1] * v[j][1]) + (v[j][2] * v[j][2] + v[j][3] * v[j][3]); }
        ss = wave_sum(ss, lane); const float rs = rsqrt_f(ss * (1.0f / D) + EPS);
        u32x2* o = (u32x2*)(xb + (size_t)row * D) + lane;
#pragma unroll
        for (int j = 0; j < 8; ++j) { u32x2 w; w.x = pk2(v[j][0], v[j][1]); w.y = pk2(v[j][2], v[j][3]); o[64 * j] = w; }
        if (lane == 0) rstd[row] = rs;
        float acc[8];
#pragma unroll
        for (int e = 0; e < 8; ++e) acc[e] = 0.f;
#pragma unroll
        for (int j = 0; j < 8; ++j)
#pragma unroll
            for (int c = 0; c < 4; ++c) { const int k = (lane + 64 * j) * 4 + c; const f32x4 r0 = *(const LAS f32x4*)(grt + k * 8), r1 = *(const LAS f32x4*)(grt + k * 8 + 4); const float xv = v[j][c];
                acc[0] += xv * r0[0]; acc[1] += xv * r0[1]; acc[2] += xv * r0[2]; acc[3] += xv * r0[3]; acc[4] += xv * r1[0]; acc[5] += xv * r1[1]; acc[6] += xv * r1[2]; acc[7] += xv * r1[3]; }
#pragma unroll
        for (int e = 0; e < 8; ++e) acc[e] = wave_sum(acc[e], lane) * rs;
        int e1 = 0; float l1 = acc[0];
#pragma unroll
        for (int e = 1; e < 8; ++e) if (acc[e] > l1) { l1 = acc[e]; e1 = e; }
        int e2 = -1; float l2 = -3.4e38f;
#pragma unroll
        for (int e = 0; e < 8; ++e) if (e != e1 && acc[e] > l2) { l2 = acc[e]; e2 = e; }
        const float w1 = 1.0f / (1.0f + __expf(l2 - l1));
        if (lane == 0) { se1[rloc] = e1; se2[rloc] = e2; sw1[rloc] = w1; sw2[rloc] = 1.0f - w1; }
    }
    __syncthreads();
    int e = 0, lr = 0; float w = 0.f;
    if (tid < 128) { const int rloc = tid >> 1, j = tid & 1; e = j ? se2[rloc] : se1[rloc]; w = j ? sw2[rloc] : sw1[rloc]; lr = __hip_atomic_fetch_add(lcnt + e, 1, __ATOMIC_RELAXED, __HIP_MEMORY_SCOPE_WORKGROUP); }
    __syncthreads();
    if (tid < 8) gbase[tid] = (int)__hip_atomic_fetch_add(cnt + tid, (unsigned)lcnt[tid], __ATOMIC_RELAXED, __HIP_MEMORY_SCOPE_AGENT);
    __syncthreads();
    if (tid < 128) { const int pos = gbase[e] + lr, tok = blk * 64 + (tid >> 1); list[e * T + pos] = tok | ((tid & 1) << 16); listw[e * T + pos] = w; }
    __syncthreads();
}
__device__ __forceinline__ void final_row_moe(const float* x, const bf16* y0, const bf16* y1, const float* gain, float* out, int row, int lane) {
    const f32x4* xr = (const f32x4*)(x + (size_t)row * D) + lane; const f32x4* gr = (const f32x4*)gain + lane;
    const u32x2* p0 = (const u32x2*)(y0 + (size_t)row * D) + lane; const u32x2* p1 = (const u32x2*)(y1 + (size_t)row * D) + lane;
    f32x4 v[8]; float ss = 0.f;
#pragma unroll
    for (int j = 0; j < 8; ++j) { v[j] = xr[64 * j]; const u32x2 a = p0[64 * j], b = p1[64 * j];
        v[j][0] += bflo(a.x) + bflo(b.x); v[j][1] += bfhi(a.x) + bfhi(b.x); v[j][2] += bflo(a.y) + bflo(b.y); v[j][3] += bfhi(a.y) + bfhi(b.y);
        ss += (v[j][0] * v[j][0] + v[j][1] * v[j][1]) + (v[j][2] * v[j][2] + v[j][3] * v[j][3]); }
    ss = wave_sum(ss, lane); const float rs = rsqrt_f(ss * (1.0f / D) + EPS);
    f32x4* o = (f32x4*)(out + (size_t)row * D) + lane;
#pragma unroll
    for (int j = 0; j < 8; ++j) o[64 * j] = v[j] * rs * gr[64 * j];
}
__device__ __forceinline__ void ba_tail(const bf16* xbp, const bf16* wbab, const float* ssq, float* bap, int rb, int wave, int lane) {
    if (wave < 4) { const int fr = lane & 15, fq = lane >> 4, r0 = rb * 64 + wave * 16;
        const bf16* ap = xbp + (size_t)(r0 + fr) * D + fq * 8; const bf16* bp = wbab + (size_t)fr * D + fq * 8;
        f32x4 acc = {0.f, 0.f, 0.f, 0.f};
#pragma unroll 16
        for (int ks = 0; ks < 64; ++ks) { const bf16x8 a = *(const bf16x8*)(ap + ks * 32), b = *(const bf16x8*)(bp + ks * 32); acc = mfma16(a, b, acc); }
#pragma unroll
        for (int rr = 0; rr < 4; ++rr) { const int r = r0 + fq * 4 + rr; bap[(size_t)r * 16 + fr] = acc[rr] * pg8::row_scale(ssq, r, 1); } }
}
struct Args { const float* in[25]; float* out; unsigned char* ws; int ph_lo, ph_hi; };
typedef const __attribute__((address_space(4))) unsigned long long* kaptr_t;
__device__ __forceinline__ unsigned long long ldka(int i) { kaptr_t ka = (kaptr_t)__builtin_amdgcn_kernarg_segment_ptr(); asm volatile("" : "+s"(i)); return ka[i]; }
__device__ __forceinline__ const float* ldin(const Args&, int i) { return (const float*)(const GAS float*)ldka(i); }
__device__ __forceinline__ unsigned char* ldws(const Args&) { return (unsigned char*)(GAS unsigned char*)ldka(26); }
__device__ __forceinline__ float* ldout(const Args&) { return (float*)(GAS float*)ldka(25); }
__global__ void __launch_bounds__(512, 2) mega(Args args) {
    extern __shared__ __attribute__((aligned(16))) unsigned char lds_raw[];
    LAS unsigned char* lds = (LAS unsigned char*)lds_raw;
    volatile LAS unsigned* MISC = (volatile LAS unsigned*)(lds + MISC_OFF);
    const int tid = threadIdx.x;
    const int G = gridDim.x, bid = blockIdx.x, NGW = G * 8;
    unsigned char* ws = ldws(args);
    for (int u = tid; u < (LDS_BYTES - LDSCTL_OFF) / 4; u += 512) ((LAS unsigned*)(lds + LDSCTL_OFF))[u] = 0u;
    __syncthreads();
    (void)xcd_barrier_post((unsigned*)(ws + WS_CTL) + CW_BAR, MISC + 8);
#define RUN(id) true
#if defined(PROBE_MASK)
#define STAMP() do { if (threadIdx.x == 0) { ((volatile LAS unsigned long long*)(lds + LDSCTL_OFF + 1024))[nst] = __builtin_amdgcn_s_memrealtime(); } ++nst; } while (0)
#else
#define STAMP() do { } while (0)
#endif
#define SEAM(id) do { XcdBarrier bar_; bar_.bar = (unsigned*)WSP(WS_CTL) + CW_BAR; bar_.x = xb_xcc_id(); bar_.st = (volatile LAS unsigned*)(lds + MISC_OFF) + 8; xcd_barrier(bar_); STAMP(); } while (0)
#if defined(PROBE_MASK)
    int nst = 0; STAMP();
#endif
#define INP(i) ldin(args, (i))
#define WSP(off) (ldws(args) + (off))
#define x_in INP(0)
#define norm_mix INP(1)
#define w_in INP(2)
#define conv_lru_w INP(3)
#define conv_lru_b INP(4)
#define lru_w_r INP(5)
#define lru_b_r INP(6)
#define lru_w_i INP(7)
#define lru_b_i INP(8)
#define lru_lambda INP(9)
#define lru_out_norm INP(10)
#define conv_qkv_w INP(11)
#define dn_a_log INP(12)
#define dn_dt_bias INP(13)
#define dn_out_norm INP(14)
#define w_out INP(15)
#define norm_ffn INP(16)
#define ffn_w_gate INP(17)
#define ffn_w_up INP(18)
#define ffn_w_down INP(19)
#define moe_router INP(20)
#define moe_w_gate INP(21)
#define moe_w_up INP(22)
#define moe_w_down INP(23)
#define norm_final INP(24)
#define xres (ldout(args))
#define Win ((bf16*)WSP(WS_WIN))
#define Wba ((float*)WSP(WS_WBA))
#define Wout ((bf16*)WSP(WS_WOUT))
#define Wgu ((bf16*)WSP(WS_WGU))
#define Wd ((bf16*)WSP(WS_WD))
#define Mgu ((bf16*)WSP(WS_C))
#define Md ((bf16*)WSP(WS_WGU))
#define MCNT ((unsigned*)WSP(WS_CTL) + CW_CNT)
#define MLIST ((int*)WSP(WS_ROWW))
#define MLISTW ((float*)WSP(WS_ROWW + (size_t)8 * T * 4))
#define YP0 ((bf16*)WSP(WS_XB))
#define YP1 ((bf16*)WSP(WS_YMIX))
#define xb ((bf16*)WSP(WS_XB))
#define rstd ((float*)WSP(WS_RSTD))
#define SSQA ((float*)WSP(WS_RSTD + (size_t)1 * MiB))
#define SSQB ((float*)WSP(WS_RSTD + (size_t)3 * MiB))
#define WBAB ((bf16*)WSP(WS_WBA + (size_t)2 * 16 * D * 4))
#define ba ((float*)WSP(WS_BA))
#define beta ((float*)WSP(WS_BETA))
#define gg ((float*)WSP(WS_G))
#define roww ((float*)WSP(WS_ROWW))
#define proj ((bf16*)WSP(WS_PROJ))
#define hid ((bf16*)WSP(WS_PROJ))
#define ymix ((bf16*)WSP(WS_YMIX))
#define c0 ((float*)WSP(WS_C))
#define c1 ((float*)WSP(WS_C + (size_t)T * 1024 * 4))
#define c2 ((float*)WSP(WS_C + (size_t)2 * T * 1024 * 4))
#define c3 ((float*)WSP(WS_C + (size_t)3 * T * 1024 * 4))
#define LRU_WRT ((bf16*)WSP(WS_WRT))
#define LRU_WIT ((bf16*)WSP(WS_WRT + (size_t)2 * 8 * 128 * 128 * 2))
#define LRU_H ((float*)WSP(WS_C + (size_t)256 * MiB))
#define LRU_A ((float*)WSP(WS_C + (size_t)320 * MiB))
#define LRU_SUMM ((float*)WSP(WS_C + (size_t)384 * MiB))
#define LRU_CARRY ((float*)WSP(WS_C + (size_t)386 * MiB))
#define DN_WF ((bf16*)WSP(WS_C))
#define DN_QF ((bf16*)WSP(WS_C + (size_t)32 * MiB))
#define DN_KDTF ((bf16*)WSP(WS_C + (size_t)64 * MiB))
#define DN_UF ((bf16*)WSP(WS_C + (size_t)96 * MiB))
#define DN_QKF ((bf16*)WSP(WS_C + (size_t)128 * MiB))
#define DN_GL ((float*)WSP(WS_C + (size_t)144 * MiB))
    const int BIG = 1 << 30;
#define PHL int tid_ = threadIdx.x; asm volatile("" : "+v"(tid_)); const int lane_ = tid_ & 63; int bid_ = blockIdx.x; asm volatile("" : "+s"(bid_)); const int gw_ = bid_ * 8 + __builtin_amdgcn_readfirstlane(tid_ >> 6); const size_t gt_ = (size_t)bid_ * 512 + tid_, NGT = (size_t)G * 512; LAS float* scr = (LAS float*)(lds + (gw_ & 7) * 16384);
    if (RUN(ph)) { PHL
        convert_matrix(w_in, DIN, 0, D, NPROJ, norm_mix, Win, BIG, 0, 0, scr, gw_, NGW, lane_);
        convert_matrix(w_out, D, 0, D, D, nullptr, Wout, BIG, 0, 0, scr, gw_, NGW, lane_);
        for (size_t i = gt_; i < (size_t)16 * D; i += NGT) { const int j = (int)(i / D), k = (int)(i % D); WBAB[i] = (bf16)f2bf(w_in[(size_t)D * DIN + (size_t)k * DIN + NPROJ + j] * norm_mix[D + k]); }
        for (int l = 0; l < 2; ++l)
            for (size_t i = gt_; i < (size_t)16 * D; i += NGT) { const int j = (int)(i / D), k = (int)(i % D); Wba[(size_t)l * 16 * D + i] = w_in[(size_t)l * D * DIN + (size_t)k * DIN + NPROJ + j] * norm_mix[l * D + k]; }
        for (int m = 0; m < 16; ++m) {
            convert_matrix(lru_w_r + (size_t)m * 128 * 128, 128, 0, 128, 128, nullptr, LRU_WRT + (size_t)m * 128 * 128, BIG, 0, 0, scr, gw_, NGW, lane_);
            convert_matrix(lru_w_i + (size_t)m * 128 * 128, 128, 0, 128, 128, nullptr, LRU_WIT + (size_t)m * 128 * 128, BIG, 0, 0, scr, gw_, NGW, lane_); }
    }
    SEAM(ph);
    int xsel = 0;
#define xcur (xsel ? (const float*)xres : x_in)
    { constexpr int l = 0;
        if (l == 0) { { PHL for (int r = gw_; r < T; r += NGW) rowprep_row(xcur, xb, rstd, Wba, ba, r, lane_); }
        SEAM(ph); }
        if (RUN(ph)) { pg8::Gemm g{xb, Win + (size_t)l * NPROJ * D, T, NPROJ, D, 0}; pg8::StaticOrder S; S.init(T, NPROJ, G, bid); pg8::EpiScaleBf16 E{proj, l == 0 ? rstd : SSQB, NPROJ, l};
            pg8::gemm_phase<pg8::EpiScaleBf16, pg8::StaticOrder, true, false>(lds, g, S, E);
            if (l == 1) { PHL for (int rb = bid_; rb < T / 64; rb += G) ba_tail(xb, WBAB, SSQB, ba, rb, gw_ & 7, lane_); } }
        SEAM(ph);
        if (RUN(ph)) { PHL
            for (int u = bid_; u < 2048; u += G) lrua_unit(proj, conv_lru_w + (size_t)l * 4 * DLRU, conv_lru_b + l * DLRU, LRU_WRT + (size_t)l * 8 * 128 * 128, LRU_WIT + (size_t)l * 8 * 128 * 128, lru_b_r + l * DLRU, lru_b_i + l * DLRU, lru_lambda + l * DLRU, LRU_H, LRU_A, LRU_SUMM, u, lds, tid_, lane_, gw_ & 7);
            STAMP();
            for (int uid = bid_; uid < 2048; uid += G) dna_unit(proj, conv_qkv_w + (size_t)l * 4 * 3 * DDN, ba, dn_a_log + l * NH, dn_dt_bias + l * NH, DN_WF, DN_QF, DN_KDTF, DN_QKF, DN_UF, DN_GL, uid, lds, tid_, lane_, gw_ & 7); }
        SEAM(ph);
        if (RUN(ph)) { PHL
            if (bid_ < 128) dnb_run(DN_WF, DN_QF, DN_KDTF, DN_QKF, DN_UF, DN_GL, c3, (bid_ & 7) + 8 * (bid_ >> 6), (bid_ >> 3) & 7, lds, tid_, lane_, gw_ & 7);
            else if (bid_ < 136) { if (tid_ < 256) lru_carry(LRU_SUMM, LRU_CARRY, (bid_ - 128) * 256 + tid_); }
            else { const int cw = gw_ - 136 * 8, CNW = NGW - 136 * 8;
                if (l == 0) {
                    convert_matrix(w_in + (size_t)D * DIN, DIN, 0, D, NPROJ, norm_mix + D, Win + (size_t)NPROJ * D, BIG, 0, 0, scr, cw, CNW, lane_);
                    convert_matrix(w_out + (size_t)D * D, D, 0, D, D, nullptr, Wout + (size_t)D * D, BIG, 0, 0, scr, cw, CNW, lane_);
                    convert_matrix(ffn_w_gate, DFF, 0, D, DFF, norm_ffn, Wgu, 128, 256, 0, scr, cw, CNW, lane_);
                    convert_matrix(ffn_w_up, DFF, 0, D, DFF, norm_ffn, Wgu, 128, 256, 128, scr, cw, CNW, lane_);
                    convert_matrix(ffn_w_down, D, 0, DFF, D, nullptr, Wd, BIG, 0, 0, scr, cw, CNW, lane_);
                } else {
                    for (int e = 0; e < NEXP; ++e) convert_matrix(moe_w_down + (size_t)e * DFFE * D, D, 0, DFFE, D, nullptr, Md + (size_t)e * D * DFFE, BIG, 0, 0, scr, cw, CNW, lane_);
                } } }
        SEAM(ph);
        if (RUN(ph)) { PHL
            for (int r = gw_; r < T; r += NGW) lrub_row(LRU_H, LRU_A, LRU_CARRY, proj, lru_out_norm + l * DLRU, ymix, r, lane_);
            for (int r = gw_; r < T; r += NGW) dn_out_row(c3, dn_out_norm + l * HD, proj, ymix, r, lane_); }
        SEAM(ph);
        if (RUN(ph)) { if (l == 0) { pg8::Gemm g{ymix, Wout, T, D, D, 0}; pg8::StaticOrder S; S.init(T, D, G, bid); pg8::EpiResidualNorm E{xcur, xres, xb, SSQA, D, 0};
            pg8::gemm_phase<pg8::EpiResidualNorm, pg8::StaticOrder, true, false>(lds, g, S, E); }
          else { pg8::Gemm g{ymix, Wout + (size_t)D * D, T, D, D, 0}; pg8::StaticOrder S; S.init(T, D, G, bid); pg8::EpiResidual E{xcur, xres, nullptr, D, 0};
            pg8::gemm_phase<pg8::EpiResidual, pg8::StaticOrder, true, false>(lds, g, S, E); }
            if (l == 1) { PHL
                for (int e = 0; e < NEXP; ++e) {
                    convert_matrix(moe_w_gate + (size_t)e * D * DFFE, DFFE, 0, D, DFFE, norm_ffn + D, Mgu + (size_t)e * 2 * DFFE * D, 128, 256, 0, scr, gw_, NGW, lane_);
                    convert_matrix(moe_w_up + (size_t)e * D * DFFE, DFFE, 0, D, DFFE, norm_ffn + D, Mgu + (size_t)e * 2 * DFFE * D, 128, 256, 128, scr, gw_, NGW, lane_);
 } } }
        SEAM(ph);
        xsel = 1;
        if (l == 0) {
            if (RUN(ph)) { pg8::Gemm g{xb, Wgu, T, 2 * DFF, D, 0}; pg8::StaticOrder S; S.init(T, 2 * DFF, G, bid); pg8::EpiSwiGLU E{hid, SSQA, DFF, 1};
                pg8::gemm_phase<pg8::EpiSwiGLU, pg8::StaticOrder, true, false>(lds, g, S, E); }
            SEAM(ph);
            if (RUN(ph)) { pg8::Gemm g{hid, Wd, T, D, DFF, 0}; pg8::StaticOrder S; S.init(T, D, G, bid); pg8::EpiResidualNorm E{xcur, xres, xb, SSQB, D, 0};
                pg8::gemm_phase<pg8::EpiResidualNorm, pg8::StaticOrder, true, false>(lds, g, S, E); }
            SEAM(ph);
        } else {
            if (RUN(ph)) { PHL for (int blk = bid_; blk < T / 64; blk += G) route_block(xcur, norm_ffn + D, moe_router, xb, rstd, MCNT, MLIST, MLISTW, blk, lds, tid_, lane_, gw_ & 7); }
            SEAM(ph);
            if (RUN(ph)) { pg8::Gemm g{xb, Mgu, NSLOT, 2 * DFFE, D, 0}; MoeOrder S; S.init(MCNT, MLIST, 2 * DFFE / 256, G, bid); pg8::EpiSwiGLUMoe E{hid, rstd, MLIST, DFFE, 0};
                pg8::gemm_phase<pg8::EpiSwiGLUMoe, MoeOrder, true, true>(lds, g, S, E); }
            SEAM(ph);
            if (RUN(ph)) { pg8::Gemm g{hid, Md, NSLOT, D, DFFE, 0}; MoeOrder S; S.init(MCNT, MLIST, D / 256, G, bid); pg8::EpiMoeDown E{YP0, YP1, MLIST, MLISTW, D, 0};
                pg8::gemm_phase<pg8::EpiMoeDown, MoeOrder, true, false>(lds, g, S, E); }
            SEAM(ph);
        }
    }
    { constexpr int l = 1;
        if (l == 0) { { PHL for (int r = gw_; r < T; r += NGW) rowprep_row(xcur, xb, rstd, Wba, ba, r, lane_); }
        SEAM(ph); }
        if (RUN(ph)) { pg8::Gemm g{xb, Win + (size_t)l * NPROJ * D, T, NPROJ, D, 0}; pg8::StaticOrder S; S.init(T, NPROJ, G, bid); pg8::EpiScaleBf16 E{proj, l == 0 ? rstd : SSQB, NPROJ, l};
            pg8::gemm_phase<pg8::EpiScaleBf16, pg8::StaticOrder, true, false>(lds, g, S, E);
            if (l == 1) { PHL for (int rb = bid_; rb < T / 64; rb += G) ba_tail(xb, WBAB, SSQB, ba, rb, gw_ & 7, lane_); } }
        SEAM(ph);
        if (RUN(ph)) { PHL
            for (int u = bid_; u < 2048; u += G) lrua_unit(proj, conv_lru_w + (size_t)l * 4 * DLRU, conv_lru_b + l * DLRU, LRU_WRT + (size_t)l * 8 * 128 * 128, LRU_WIT + (size_t)l * 8 * 128 * 128, lru_b_r + l * DLRU, lru_b_i + l * DLRU, lru_lambda + l * DLRU, LRU_H, LRU_A, LRU_SUMM, u, lds, tid_, lane_, gw_ & 7);
            STAMP();
            for (int uid = bid_; uid < 2048; uid += G) dna_unit(proj, conv_qkv_w + (size_t)l * 4 * 3 * DDN, ba, dn_a_log + l * NH, dn_dt_bias + l * NH, DN_WF, DN_QF, DN_KDTF, DN_QKF, DN_UF, DN_GL, uid, lds, tid_, lane_, gw_ & 7); }
        SEAM(ph);
        if (RUN(ph)) { PHL
            if (bid_ < 128) dnb_run(DN_WF, DN_QF, DN_KDTF, DN_QKF, DN_UF, DN_GL, c3, (bid_ & 7) + 8 * (bid_ >> 6), (bid_ >> 3) & 7, lds, tid_, lane_, gw_ & 7);
            else if (bid_ < 136) { if (tid_ < 256) lru_carry(LRU_SUMM, LRU_CARRY, (bid_ - 128) * 256 + tid_); }
            else { const int cw = gw_ - 136 * 8, CNW = NGW - 136 * 8;
                if (l == 0) {
                    convert_matrix(w_in + (size_t)D * DIN, DIN, 0, D, NPROJ, norm_mix + D, Win + (size_t)NPROJ * D, BIG, 0, 0, scr, cw, CNW, lane_);
                    convert_matrix(w_out + (size_t)D * D, D, 0, D, D, nullptr, Wout + (size_t)D * D, BIG, 0, 0, scr, cw, CNW, lane_);
                    convert_matrix(ffn_w_gate, DFF, 0, D, DFF, norm_ffn, Wgu, 128, 256, 0, scr, cw, CNW, lane_);
                    convert_matrix(ffn_w_up, DFF, 0, D, DFF, norm_ffn, Wgu, 128, 256, 128, scr, cw, CNW, lane_);
                    convert_matrix(ffn_w_down, D, 0, DFF, D, nullptr, Wd, BIG, 0, 0, scr, cw, CNW, lane_);
                } else {
                    for (int e = 0; e < NEXP; ++e) convert_matrix(moe_w_down + (size_t)e * DFFE * D, D, 0, DFFE, D, nullptr, Md + (size_t)e * D * DFFE, BIG, 0, 0, scr, cw, CNW, lane_);
                } } }
        SEAM(ph);
        if (RUN(ph)) { PHL
            for (int r = gw_; r < T; r += NGW) lrub_row(LRU_H, LRU_A, LRU_CARRY, proj, lru_out_norm + l * DLRU, ymix, r, lane_);
            for (int r = gw_; r < T; r += NGW) dn_out_row(c3, dn_out_norm + l * HD, proj, ymix, r, lane_); }
        SEAM(ph);
        if (RUN(ph)) { if (l == 0) { pg8::Gemm g{ymix, Wout, T, D, D, 0}; pg8::StaticOrder S; S.init(T, D, G, bid); pg8::EpiResidualNorm E{xcur, xres, xb, SSQA, D, 0};
            pg8::gemm_phase<pg8::EpiResidualNorm, pg8::StaticOrder, true, false>(lds, g, S, E); }
          else { pg8::Gemm g{ymix, Wout + (size_t)D * D, T, D, D, 0}; pg8::StaticOrder S; S.init(T, D, G, bid); pg8::EpiResidual E{xcur, xres, nullptr, D, 0};
            pg8::gemm_phase<pg8::EpiResidual, pg8::StaticOrder, true, false>(lds, g, S, E); }
            if (l == 1) { PHL
                for (int e = 0; e < NEXP; ++e) {
                    convert_matrix(moe_w_gate + (size_t)e * D * DFFE, DFFE, 0, D, DFFE, norm_ffn + D, Mgu + (size_t)e * 2 * DFFE * D, 128, 256, 0, scr, gw_, NGW, lane_);
                    convert_matrix(moe_w_up + (size_t)e * D * DFFE, DFFE, 0, D, DFFE, norm_ffn + D, Mgu + (size_t)e * 2 * DFFE * D, 128, 256, 128, scr, gw_, NGW, lane_);
 } } }
        SEAM(ph);
        xsel = 1;
        if (l == 0) {
            if (RUN(ph)) { pg8::Gemm g{xb, Wgu, T, 2 * DFF, D, 0}; pg8::StaticOrder S; S.init(T, 2 * DFF, G, bid); pg8::EpiSwiGLU E{hid, SSQA, DFF, 1};
                pg8::gemm_phase<pg8::EpiSwiGLU, pg8::StaticOrder, true, false>(lds, g, S, E); }
            SEAM(ph);
            if (RUN(ph)) { pg8::Gemm g{hid, Wd, T, D, DFF, 0}; pg8::StaticOrder S; S.init(T, D, G, bid); pg8::EpiResidualNorm E{xcur, xres, xb, SSQB, D, 0};
                pg8::gemm_phase<pg8::EpiResidualNorm, pg8::StaticOrder, true, false>(lds, g, S, E); }
            SEAM(ph);
        } else {
            if (RUN(ph)) { PHL for (int blk = bid_; blk < T / 64; blk += G) route_block(xcur, norm_ffn + D, moe_router, xb, rstd, MCNT, MLIST, MLISTW, blk, lds, tid_, lane_, gw_ & 7); }
            SEAM(ph);
            if (RUN(ph)) { pg8::Gemm g{xb, Mgu, NSLOT, 2 * DFFE, D, 0}; MoeOrder S; S.init(MCNT, MLIST, 2 * DFFE / 256, G, bid); pg8::EpiSwiGLUMoe E{hid, rstd, MLIST, DFFE, 0};
                pg8::gemm_phase<pg8::EpiSwiGLUMoe, MoeOrder, true, true>(lds, g, S, E); }
            SEAM(ph);
            if (RUN(ph)) { pg8::Gemm g{hid, Md, NSLOT, D, DFFE, 0}; MoeOrder S; S.init(MCNT, MLIST, D / 256, G, bid); pg8::EpiMoeDown E{YP0, YP1, MLIST, MLISTW, D, 0};
                pg8::gemm_phase<pg8::EpiMoeDown, MoeOrder, true, false>(lds, g, S, E); }
            SEAM(ph);
        }
    }
    if (RUN(ph)) { PHL for (int r = gw_; r < T; r += NGW) final_row_moe(xcur, YP0, YP1, norm_final, xres, r, lane_); }
#if defined(PROBE_MASK)
    __syncthreads(); STAMP();
    if (blockIdx.x == 0 && threadIdx.x == 0) { asm volatile("s_waitcnt vmcnt(0)" ::: "memory"); volatile LAS unsigned long long* st = (volatile LAS unsigned long long*)(lds + LDSCTL_OFF + 1024); unsigned long long tot = 0;
        for (int k = 1; k < nst; ++k) if ((PROBE_MASK >> (k - 1)) & 1ull) tot += st[k] - st[k - 1];
        xres[0] = rintf((float)tot * 0.01f * PROBE_SCALE); }
#endif
#if defined(PROBE_DNA_A)
    __syncthreads();
    if (blockIdx.x == 0 && threadIdx.x == 0) { asm volatile("s_waitcnt vmcnt(0)" ::: "memory"); volatile LAS unsigned long long* st = (volatile LAS unsigned long long*)(lds + (RING_BYTES + 2048));
        xres[0] = rintf((float)(st[PROBE_DNA_B] - st[PROBE_DNA_A]) * 0.01f * PROBE_SCALE); }
#endif
#undef RUN
#undef SEAM
}

extern "C" void kernel_launch(void* const* d_in, const int* in_sizes, int n_in, void* d_out, int out_size, void* d_ws, size_t ws_size, hipStream_t stream) {
    static int grid = 0;
    if (grid == 0) {
        if (n_in != 25 || ws_size < WS_END) { fprintf(stderr, "kernel_launch: unexpected n_in %d / ws_size %zu (need %zu)\n", n_in, ws_size, (size_t)WS_END); grid = -1; return; }
        int dev = 0, cus = 0, per_cu = 0;
        if (hipGetDevice(&dev) != hipSuccess || hipDeviceGetAttribute(&cus, hipDeviceAttributeMultiprocessorCount, dev) != hipSuccess) { grid = -1; return; }
        if (hipFuncSetAttribute((const void*)mega, hipFuncAttributeMaxDynamicSharedMemorySize, LDS_BYTES) != hipSuccess) { fprintf(stderr, "kernel_launch: hipFuncSetAttribute failed\n"); grid = -1; return; }
        if (hipOccupancyMaxActiveBlocksPerMultiprocessor(&per_cu, (const void*)mega, 512, LDS_BYTES) != hipSuccess || per_cu < 1) { fprintf(stderr, "kernel_launch: occupancy query says %d\n", per_cu); }
        (void)hipGetLastError();
        grid = cus;
    }
    if (grid < 0) return;
    if (hipMemsetAsync((char*)d_ws + WS_CTL, 0, CTL_ZERO_BYTES, stream) != hipSuccess) return;
    Args a{};
    for (int i = 0; i < 25; ++i) a.in[i] = (const float*)d_in[i];
    a.out = (float*)d_out; a.ws = (unsigned char*)d_ws; a.ph_lo = 0; a.ph_hi = 1 << 30;
    hipLaunchKernelGGL(mega, dim3(grid), dim3(512), LDS_BYTES, stream, a);
}
```

```cpp
#include <hip/hip_runtime.h>
#include <cstdio>
#include <cstdint>
namespace pg8 {
#define PG8_LAS __attribute__((address_space(3)))
typedef unsigned short bf16_t;
typedef short bf16x8 __attribute__((ext_vector_type(8)));
typedef float f32x4 __attribute__((ext_vector_type(4)));
typedef unsigned u32x4 __attribute__((ext_vector_type(4)));
constexpr int BM = 256, BK = 64, HALF = 128, HTB = HALF * BK * 2  , STAGE_BYTES = 8 * HTB, NXCD = 8, WGM = 8;

__host__ __device__ __forceinline__ int lds_byte(int r, int c) { const int st = (r >> 4) * 2 + (c >> 5), rr = r & 15, cc = c & 31, ob = rr * 64 + cc * 2; return st * 1024 + (ob ^ (((ob >> 9) & 1) << 5)); }
__host__ __device__ __forceinline__ void stage_rc(int b, int& R, int& C) { const int st = b / 1024, sb = b % 1024, swz = sb ^ (((sb >> 9) & 1) << 5); R = (st >> 1) * 16 + swz / 64; C = (st & 1) * 32 + (swz % 64) / 2; }
__host__ __device__ __forceinline__ int perm32(int rho) { const int n = rho >> 4, i = rho & 15; return 8 * (i >> 2) + 4 * n + (i & 3); }

struct Unit { int pm, pn, pb, lbase, nvalid; };
struct Gemm { const bf16_t* A; const bf16_t* Bt; int M, N, K, pad; };

struct StaticOrder {
    int nM, nN, nwg, G, c;
    __host__ __device__ void init(int M, int N, int G_, int c_) { nM = M / BM; nN = N / BM; nwg = nM * nN; G = G_; c = c_; }
    __host__ __device__ bool next(int i, Unit& u) const {
        const long L = (long)i * G + c; if (L >= nwg) return false;
        int wgid = (int)L; { const int q = nwg / NXCD, r = nwg % NXCD, xcd = wgid % NXCD, off = wgid / NXCD; wgid = (xcd < r ? xcd * (q + 1) : r * (q + 1) + (xcd - r) * q) + off; }
        const int nig = WGM * nN, gid = wgid / nig, fm = gid * WGM, gsz = (nM - fm) < WGM ? (nM - fm) : WGM;
        u.pm = fm + ((wgid % nig) % gsz); u.pn = (wgid % nig) / gsz; u.pb = u.pn; u.lbase = 0; u.nvalid = BM; return true;
    }
    __device__ __forceinline__ int arow(const Unit&, int) const { return 0; }
    __device__ __forceinline__ void a_ready(const Unit&) const {}
    __device__ __forceinline__ void done(const Unit&) const {}
};


typedef float f32x2_t __attribute__((ext_vector_type(2)));
typedef __bf16 bf16x2_t __attribute__((ext_vector_type(2)));
__device__ __forceinline__ unsigned cvt_pk_bf16(float lo, float hi) { const f32x2_t v = {lo, hi}; const bf16x2_t b = __builtin_convertvector(v, bf16x2_t); return __builtin_bit_cast(unsigned, b); }
__device__ __forceinline__ float frcp(float x) { return __builtin_amdgcn_rcpf(x); }
__device__ __forceinline__ float rsqrt_f(float x) { return __builtin_amdgcn_rsqf(x); }
__device__ __forceinline__ float silu_f(float x) { return x * frcp(1.0f + __expf(-x)); }
__device__ __forceinline__ float row_scale(const float* rs, int r, int mode) {
    if (!mode) return rs[r];
    const f32x4* p = (const f32x4*)(rs + (size_t)r * 32); float s = 0.f;
#pragma unroll
    for (int i = 0; i < 8; ++i) { const f32x4 v = p[i]; s += (v[0] + v[1]) + (v[2] + v[3]); }
    return rsqrt_f(s * (1.0f / 2048.0f) + 1e-6f);
}
__device__ __forceinline__ void row_scales8(const float* rs, int row0, int fr, int fq, int mode, float (&sc)[2][4]) {
    if (!mode) {
#pragma unroll
        for (int ai = 0; ai < 2; ++ai)
#pragma unroll
            for (int m = 0; m < 4; ++m) sc[ai][m] = rs[row0 + ai * HALF + m * 16];
    } else {
        const int lane = fr + 16 * fq; f32x4 pa[2][4][2];
#pragma unroll
        for (int ai = 0; ai < 2; ++ai)
#pragma unroll
            for (int m = 0; m < 4; ++m) { const f32x4* p = (const f32x4*)(rs + (size_t)(row0 + ai * HALF + m * 16) * 32 + fq * 8); pa[ai][m][0] = p[0]; pa[ai][m][1] = p[1]; }
#pragma unroll
        for (int ai = 0; ai < 2; ++ai)
#pragma unroll
            for (int m = 0; m < 4; ++m) { const f32x4 a = pa[ai][m][0], b = pa[ai][m][1]; float t = ((a[0] + a[1]) + (a[2] + a[3])) + ((b[0] + b[1]) + (b[2] + b[3]));
                t += __int_as_float(__builtin_amdgcn_ds_bpermute((lane ^ 16) << 2, __float_as_int(t)));
                t += __int_as_float(__builtin_amdgcn_ds_bpermute((lane ^ 32) << 2, __float_as_int(t)));
                sc[ai][m] = rsqrt_f(t * (1.0f / 2048.0f) + 1e-6f); }
    }
}
struct EpiScaleBf16 {
    static constexpr bool PERM = true, AFTER_DRAIN = false;
    bf16_t* O; const float* rs; int ldc; int pad;
    __device__ __forceinline__ void operator()(const f32x4 (&acc)[2][2][4][2], const Unit& u, int wr, int wc, int fr, int fq) const {
        const int row0 = u.pm * BM + wr * 64 + fr, col0 = u.pn * BM + wc * 32 + 8 * fq;
        float sc[2][4]; row_scales8(rs, row0, fr, fq, pad, sc);
#pragma unroll
        for (int ai = 0; ai < 2; ++ai)
#pragma unroll
            for (int m = 0; m < 4; ++m) { const int r = row0 + ai * HALF + m * 16; const float s = sc[ai][m]; bf16_t* rowp = O + (size_t)r * ldc + col0;
#pragma unroll
                for (int bj = 0; bj < 2; ++bj) { const f32x4 v0 = acc[ai][bj][m][0] * s, v1 = acc[ai][bj][m][1] * s;
                    u32x4 w; w.x = cvt_pk_bf16(v0[0], v0[1]); w.y = cvt_pk_bf16(v0[2], v0[3]); w.z = cvt_pk_bf16(v1[0], v1[1]); w.w = cvt_pk_bf16(v1[2], v1[3]);
                    *(u32x4*)(rowp + bj * HALF) = w; } }
    }
};
struct EpiSwiGLU {
    static constexpr bool PERM = true, AFTER_DRAIN = false;
    bf16_t* O; const float* rs; int ldc; int pad;
    __device__ __forceinline__ void operator()(const f32x4 (&acc)[2][2][4][2], const Unit& u, int wr, int wc, int fr, int fq) const {
        const int row0 = u.pm * BM + wr * 64 + fr, col0 = u.pn * HALF + wc * 32 + 8 * fq;
        float sc[2][4]; row_scales8(rs, row0, fr, fq, pad, sc);
#pragma unroll
        for (int ai = 0; ai < 2; ++ai)
#pragma unroll
            for (int m = 0; m < 4; ++m) { const int r = row0 + ai * HALF + m * 16; const float s = sc[ai][m]; bf16_t* rowp = O + (size_t)r * ldc + col0;
                f32x4 h0, h1;
#pragma unroll
                for (int j = 0; j < 4; ++j) { h0[j] = silu_f(acc[ai][0][m][0][j] * s) * (acc[ai][1][m][0][j] * s); h1[j] = silu_f(acc[ai][0][m][1][j] * s) * (acc[ai][1][m][1][j] * s); }
                u32x4 w; w.x = cvt_pk_bf16(h0[0], h0[1]); w.y = cvt_pk_bf16(h0[2], h0[3]); w.z = cvt_pk_bf16(h1[0], h1[1]); w.w = cvt_pk_bf16(h1[2], h1[3]);
                *(u32x4*)rowp = w; }
    }
};
struct EpiResidual {
    static constexpr bool PERM = false, AFTER_DRAIN = false;
    const float* base; float* out; const float* roww; int ldc; int pad;
    __device__ __forceinline__ void operator()(const f32x4 (&acc)[2][2][4][2], const Unit& u, int wr, int wc, int fr, int fq) const {
        const int row0 = u.pm * BM + wr * 64 + fr, col0 = u.pn * BM + wc * 32 + 4 * fq;
#pragma unroll
        for (int ai = 0; ai < 2; ++ai)
#pragma unroll
            for (int m = 0; m < 4; ++m) { const int r = row0 + ai * HALF + m * 16; const float w = roww ? roww[r] : 1.0f; const size_t off = (size_t)r * ldc + col0;
#pragma unroll
                for (int bj = 0; bj < 2; ++bj)
#pragma unroll
                    for (int n = 0; n < 2; ++n) { const f32x4 bs = *(const f32x4*)(base + off + bj * HALF + n * 16); *(f32x4*)(out + off + bj * HALF + n * 16) = bs + acc[ai][bj][m][n] * w; } }
    }
};

struct EpiSwiGLUMoe {
    static constexpr bool PERM = true, AFTER_DRAIN = false;
    bf16_t* O; const float* rs; const int* list; int ldc; int pad;
    __device__ __forceinline__ void operator()(const f32x4 (&acc)[2][2][4][2], const Unit& u, int wr, int wc, int fr, int fq) const {
        const int rl0 = wr * 64 + fr, col0 = u.pn * HALF + wc * 32 + 8 * fq;
#pragma unroll
        for (int ai = 0; ai < 2; ++ai)
#pragma unroll
            for (int m = 0; m < 4; ++m) { const int rl = rl0 + ai * HALF + m * 16; const int tok = rl < u.nvalid ? (list[u.lbase + rl] & 0xffff) : 0; const float s = rs[tok];
                bf16_t* rowp = O + (size_t)(u.pm * BM + rl) * ldc + col0;
                f32x4 h0, h1;
#pragma unroll
                for (int j = 0; j < 4; ++j) { h0[j] = silu_f(acc[ai][0][m][0][j] * s) * (acc[ai][1][m][0][j] * s); h1[j] = silu_f(acc[ai][0][m][1][j] * s) * (acc[ai][1][m][1][j] * s); }
                u32x4 w; w.x = cvt_pk_bf16(h0[0], h0[1]); w.y = cvt_pk_bf16(h0[2], h0[3]); w.z = cvt_pk_bf16(h1[0], h1[1]); w.w = cvt_pk_bf16(h1[2], h1[3]);
                *(u32x4*)rowp = w; }
    }
};
struct EpiMoeDown {
    static constexpr bool PERM = true, AFTER_DRAIN = false;
    bf16_t* Y0; bf16_t* Y1; const int* list; const float* lw; int ldc; int pad;
    __device__ __forceinline__ void operator()(const f32x4 (&acc)[2][2][4][2], const Unit& u, int wr, int wc, int fr, int fq) const {
        const int rl0 = wr * 64 + fr, col0 = u.pn * BM + wc * 32 + 8 * fq;
#pragma unroll
        for (int ai = 0; ai < 2; ++ai)
#pragma unroll
            for (int m = 0; m < 4; ++m) { const int rl = rl0 + ai * HALF + m * 16;
                if (rl < u.nvalid) { const int en = list[u.lbase + rl]; const float w = lw[u.lbase + rl]; bf16_t* rowp = ((en >> 16) ? Y1 : Y0) + (size_t)(en & 0xffff) * ldc + col0;
#pragma unroll
                    for (int bj = 0; bj < 2; ++bj) { const f32x4 v0 = acc[ai][bj][m][0] * w, v1 = acc[ai][bj][m][1] * w;
                        u32x4 o; o.x = cvt_pk_bf16(v0[0], v0[1]); o.y = cvt_pk_bf16(v0[2], v0[3]); o.z = cvt_pk_bf16(v1[0], v1[1]); o.w = cvt_pk_bf16(v1[2], v1[3]);
                        *(u32x4*)(rowp + bj * HALF) = o; } } }
    }
};

struct EpiResidualNorm {
    static constexpr bool PERM = true, AFTER_DRAIN = false;
    const float* base; float* out; bf16_t* xb; float* ssq; int ldc; int pad;
    __device__ __forceinline__ void operator()(const f32x4 (&acc)[2][2][4][2], const Unit& u, int wr, int wc, int fr, int fq) const {
        const int row0 = u.pm * BM + wr * 64 + fr, col0 = u.pn * BM + wc * 32 + 8 * fq, lane = fr + 16 * fq;
#pragma unroll
        for (int ai = 0; ai < 2; ++ai)
#pragma unroll
            for (int m = 0; m < 4; ++m) { const int r = row0 + ai * HALF + m * 16; const size_t off = (size_t)r * ldc + col0; float part = 0.f;
#pragma unroll
                for (int bj = 0; bj < 2; ++bj) { const f32x4 b0 = *(const f32x4*)(base + off + bj * HALF), b1 = *(const f32x4*)(base + off + bj * HALF + 4);
                    const f32x4 v0 = b0 + acc[ai][bj][m][0], v1 = b1 + acc[ai][bj][m][1];
                    *(f32x4*)(out + off + bj * HALF) = v0; *(f32x4*)(out + off + bj * HALF + 4) = v1;
                    u32x4 w; w.x = cvt_pk_bf16(v0[0], v0[1]); w.y = cvt_pk_bf16(v0[2], v0[3]); w.z = cvt_pk_bf16(v1[0], v1[1]); w.w = cvt_pk_bf16(v1[2], v1[3]);
                    *(u32x4*)(xb + off + bj * HALF) = w;
                    part += (v0[0] * v0[0] + v0[1] * v0[1]) + (v0[2] * v0[2] + v0[3] * v0[3]) + (v1[0] * v1[0] + v1[1] * v1[1]) + (v1[2] * v1[2] + v1[3] * v1[3]); }
                part += __int_as_float(__builtin_amdgcn_ds_bpermute((lane ^ 16) << 2, __float_as_int(part)));
                part += __int_as_float(__builtin_amdgcn_ds_bpermute((lane ^ 32) << 2, __float_as_int(part)));
                if (fq == 0) ssq[(size_t)r * 32 + u.pn * 4 + wc] = part; }
    }
};
template <class Epi, class Sched, bool ALIGN_EPI = false, bool GATHER = false>
__device__ __forceinline__ void gemm_phase(PG8_LAS unsigned char* lds, const Gemm g, const Sched& S, const Epi& E) {
    int tid_o = threadIdx.x; asm volatile("" : "+v"(tid_o));
    const int tid = tid_o, wid = __builtin_amdgcn_readfirstlane(tid >> 6), lane = tid & 63, wr = wid >> 2, wc = wid & 3, fr = lane & 15, fq = lane >> 4;
    const int K = g.K, nt = K / BK;
    const size_t kstep = (size_t)(BK * 2);
    const size_t hstep = (size_t)HALF * K * 2;
    const size_t tstep = 2 * hstep;
    unsigned voffA[2], voffB[2], oA[2][2], oN[2][2];
#pragma unroll
    for (int i = 0; i < 2; ++i) { int R, C; stage_rc(tid * 16 + i * 8192, R, C); const int Rb = Epi::PERM ? ((R & ~31) + perm32(R & 31)) : R; voffA[i] = (unsigned)(R * K + C) * 2u; voffB[i] = (unsigned)(Rb * K + C) * 2u; }
    const unsigned ldsw = (unsigned)wid * 1024u;
    const int aoff = lds_byte(wr * 64 + fr, fq * 8), boff = lds_byte(wc * 32 + fr, fq * 8);
#define PG8_SA(b, h) (((b) * 2 + (h)) * HTB)
#define PG8_SB(b, h) ((4 + (b) * 2 + (h)) * HTB)
#define PG8_STAGE(bufoff, gbase, voff) do { _Pragma("unroll") for (int _i = 0; _i < 2; ++_i) \
        __builtin_amdgcn_global_load_lds((const unsigned*)((const char*)(gbase) + (voff)[_i]), (PG8_LAS unsigned*)(lds + (bufoff) + ldsw + _i * 8192), 16, 0, 0); } while (0)
#define PG8_LDA(dst, b, h) do { _Pragma("unroll") for (int m = 0; m < 4; ++m) _Pragma("unroll") for (int k = 0; k < 2; ++k) dst[m][k] = *(const PG8_LAS bf16x8*)(lds + PG8_SA(b, h) + aoff + m * 2048 + k * 1024); } while (0)
#define PG8_LDB(dst, b, h) do { _Pragma("unroll") for (int n = 0; n < 2; ++n) _Pragma("unroll") for (int k = 0; k < 2; ++k) dst[n][k] = *(const PG8_LAS bf16x8*)(lds + PG8_SB(b, h) + boff + n * 2048 + k * 1024); } while (0)
#define PG8_MMA(ai, bj, At, Bt) do { __builtin_amdgcn_s_setprio(1); _Pragma("unroll") for (int m = 0; m < 4; ++m) _Pragma("unroll") for (int n = 0; n < 2; ++n) _Pragma("unroll") for (int k = 0; k < 2; ++k) \
        acc[ai][bj][m][n] = __builtin_amdgcn_mfma_f32_16x16x32_bf16(Bt[n][k], At[m][k], acc[ai][bj][m][n], 0, 0, 0); __builtin_amdgcn_s_setprio(0); } while (0)
#define PG8_WAIT_V(n) asm volatile("s_waitcnt vmcnt(" #n ")" ::: "memory")
#define PG8_WAIT_L(n) asm volatile("s_waitcnt lgkmcnt(" #n ")" ::: "memory")
#define PG8_BAR __builtin_amdgcn_s_barrier()
#define PG8_SCHED __builtin_amdgcn_sched_barrier(0)
#define PG8_AOFF(dst, u) do { _Pragma("unroll") for (int _i = 0; _i < 2; ++_i) { int _R, _C; stage_rc(tid * 16 + _i * 8192, _R, _C); _Pragma("unroll") for (int _h = 0; _h < 2; ++_h) \
        dst[_h][_i] = (unsigned)(S.arow(u, _h * HALF + _R) * K + _C) * 2u; } } while (0)
#define PG8_STAGE_A(bufoff, gbase, h, usenext) do { _Pragma("unroll") for (int _i = 0; _i < 2; ++_i) { const unsigned _o = GATHER ? ((usenext) ? oN[h][_i] : oA[h][_i]) : voffA[_i]; \
        __builtin_amdgcn_global_load_lds((const unsigned*)((const char*)(gbase) + (GATHER ? (size_t)0 : (size_t)(h) * hstep) + _o), (PG8_LAS unsigned*)(lds + (bufoff) + ldsw + _i * 8192), 16, 0, 0); } } while (0)
    Unit cur, nxt; int ui = 0;
    if (!S.next(0, cur)) return;
    f32x4 acc[2][2][4][2];
#pragma unroll
    for (int a = 0; a < 2; ++a)
#pragma unroll
        for (int b = 0; b < 2; ++b)
#pragma unroll
            for (int m = 0; m < 4; ++m)
#pragma unroll
                for (int n = 0; n < 2; ++n) acc[a][b][m][n] = (f32x4){0.f, 0.f, 0.f, 0.f};
    bf16x8 At[4][2], B0[2][2], B1[2][2];
    const char* cA = (const char*)g.A + (GATHER ? (size_t)0 : (size_t)cur.pm * tstep); const char* cB = (const char*)g.Bt + (size_t)cur.pb * tstep;
    S.a_ready(cur);
    if constexpr (GATHER) { PG8_AOFF(oA, cur); PG8_WAIT_V(0); }
    PG8_STAGE(PG8_SB(0, 0), cB, voffB); PG8_STAGE(PG8_SB(0, 1), cB + hstep, voffB); PG8_STAGE_A(PG8_SA(0, 0), cA, 0, false); PG8_STAGE_A(PG8_SA(0, 1), cA, 1, false);
    if (wr == 1) PG8_BAR;
    PG8_WAIT_V(2); PG8_BAR;
    PG8_STAGE(PG8_SB(1, 0), cB + kstep, voffB); PG8_STAGE_A(PG8_SA(1, 0), cA + kstep, 0, false); PG8_STAGE(PG8_SB(1, 1), cB + hstep + kstep, voffB);
    PG8_WAIT_V(6); PG8_BAR;
    for (;;) {
        const bool has_next = S.next(ui + 1, nxt);
        const char* nA = has_next ? (const char*)g.A + (GATHER ? (size_t)0 : (size_t)nxt.pm * tstep) : cA; const char* nB = has_next ? (const char*)g.Bt + (size_t)nxt.pb * tstep : cB;
        if constexpr (GATHER) { if (has_next) { PG8_AOFF(oN, nxt); } else {
#pragma unroll
            for (int _h = 0; _h < 2; ++_h) { oN[_h][0] = oA[_h][0]; oN[_h][1] = oA[_h][1]; } } }
        for (int t = 0; t < nt; t += 2) {
            const bool last = (t == nt - 2);
            const char* a1 = cA + (size_t)(t + 1) * kstep;
            const char* a2 = last ? nA : cA + (size_t)(t + 2) * kstep; const char* b2 = last ? nB : cB + (size_t)(t + 2) * kstep;
            const char* a3 = a2 + kstep; const char* b3 = b2 + kstep;
            if (last && has_next) S.a_ready(nxt);
            PG8_LDB(B0, 0, 0); PG8_LDB(B1, 0, 1); PG8_SCHED; PG8_LDA(At, 0, 0); PG8_STAGE_A(PG8_SA(1, 1), a1, 1, false);
            PG8_WAIT_V(8); PG8_WAIT_L(0); PG8_BAR; PG8_MMA(0, 0, At, B0); PG8_MMA(0, 1, At, B1); PG8_BAR; PG8_SCHED;
            PG8_LDA(At, 0, 1); PG8_STAGE(PG8_SB(0, 0), b2, voffB); PG8_STAGE(PG8_SB(0, 1), b2 + hstep, voffB); PG8_STAGE_A(PG8_SA(0, 0), a2, 0, last);
            PG8_WAIT_V(8); PG8_WAIT_L(0); PG8_BAR; PG8_MMA(1, 0, At, B0); PG8_MMA(1, 1, At, B1); PG8_BAR; PG8_SCHED;
            PG8_LDB(B0, 1, 0); PG8_LDB(B1, 1, 1); PG8_SCHED; PG8_LDA(At, 1, 0); PG8_STAGE_A(PG8_SA(0, 1), a2, 1, last);
            PG8_WAIT_V(8); PG8_WAIT_L(0); PG8_BAR; PG8_MMA(0, 0, At, B0); PG8_MMA(0, 1, At, B1); PG8_BAR; PG8_SCHED;
            PG8_LDA(At, 1, 1); PG8_STAGE(PG8_SB(1, 0), b3, voffB); PG8_STAGE(PG8_SB(1, 1), b3 + hstep, voffB); PG8_STAGE_A(PG8_SA(1, 0), a3, 0, last);
            PG8_WAIT_V(8); PG8_WAIT_L(0); PG8_BAR; PG8_MMA(1, 0, At, B0); PG8_MMA(1, 1, At, B1); PG8_BAR; PG8_SCHED;
        }
        if constexpr (ALIGN_EPI) { if (wr == 0) PG8_BAR; }
        E(acc, cur, wr, wc, fr, fq); S.done(cur);
        if (!has_next) break;
#pragma unroll
        for (int a = 0; a < 2; ++a)
#pragma unroll
            for (int b = 0; b < 2; ++b)
#pragma unroll
                for (int m = 0; m < 4; ++m)
#pragma unroll
                    for (int n = 0; n < 2; ++n) acc[a][b][m][n] = (f32x4){0.f, 0.f, 0.f, 0.f};
        cur = nxt; cA = nA; cB = nB; ++ui;
        if constexpr (GATHER) {
#pragma unroll
            for (int _h = 0; _h < 2; ++_h) { oA[_h][0] = oN[_h][0]; oA[_h][1] = oN[_h][1]; } }
        if constexpr (ALIGN_EPI) { if (wr == 1) PG8_BAR; }
    }
    PG8_WAIT_V(0);
    if constexpr (!ALIGN_EPI) { if (wr == 0) PG8_BAR; }
    PG8_BAR;
#undef PG8_SA
#undef PG8_SB
#undef PG8_STAGE
#undef PG8_LDA
#undef PG8_LDB
#undef PG8_MMA
#undef PG8_WAIT_V
#undef PG8_WAIT_L
#undef PG8_BAR
#undef PG8_SCHED
#undef PG8_AOFF
#undef PG8_STAGE_A
}
}

#define GAS __attribute__((address_space(1)))
#define LAS __attribute__((address_space(3)))
#define XB_TMO      128
#define XB_XCNT(j)  (256  + 64 * (j))
#define XB_XSUB(j)  (1280 + 64 * (j))
#define XB_XGEN(j)  (2304 + 64 * (j))
#define XB_TOP      3328
#define XB_TOPGEN   3392
#define XCD_BAR_WORDS 3456
#define XB_SPIN_CAP (1u << 23)

__device__ __forceinline__ unsigned xb_ld(unsigned* p)              { return __hip_atomic_load(p, __ATOMIC_RELAXED, __HIP_MEMORY_SCOPE_AGENT); }
__device__ __forceinline__ unsigned xb_add(unsigned* p, unsigned v) { return __hip_atomic_fetch_add(p, v, __ATOMIC_RELAXED, __HIP_MEMORY_SCOPE_AGENT); }
__device__ __forceinline__ unsigned xb_xcc_id() { return (unsigned)__builtin_amdgcn_s_getreg((3 << 11) | 20) & 0xFu; }
#define XB_SPIN(cond, bar) do { unsigned _sp = 0; while (cond) { __builtin_amdgcn_s_sleep(1); \
    if ((++_sp & 255u) == 0u) { if (xb_ld(&(bar)[XB_TMO])) break; if (_sp > XB_SPIN_CAP) { atomicAdd(&(bar)[XB_TMO], 1u); break; } } } } while (0)

struct XcdBarrier {
    unsigned* bar; unsigned x;
    volatile LAS unsigned* st;
};

__device__ __forceinline__ XcdBarrier xcd_barrier_post(unsigned* bar, volatile LAS unsigned* st) {
    XcdBarrier b; b.bar = bar; b.x = xb_xcc_id(); b.st = st;
    if (threadIdx.x == 0) (void)xb_add(&bar[XB_XCNT(b.x)], 1u);
    return b;
}
__device__ __forceinline__ void xcd_barrier_complete(unsigned* bar, unsigned x, unsigned& nloc, unsigned& nx) {
    const unsigned G = gridDim.x * gridDim.y * gridDim.z;
    unsigned sum, cnt, mine, sp = 0u;
    for (;;) {
        sum = 0u; cnt = 0u; mine = 0u;
#pragma unroll
        for (unsigned j = 0; j < 16; ++j) { const unsigned c = xb_ld(&bar[XB_XCNT(j)]); sum += c; cnt += (c > 0u) ? 1u : 0u; mine = (j == x) ? c : mine; }
        if (sum == G) break;
        __builtin_amdgcn_s_sleep(1);
        if ((++sp & 255u) == 0u) { if (xb_ld(&bar[XB_TMO])) break; if (sp > XB_SPIN_CAP) { atomicAdd(&bar[XB_TMO], 1u); break; } }
    }
    nloc = mine > 0u ? mine : 1u; nx = cnt > 0u ? cnt : 1u;
}

__device__ __forceinline__ void xcd_barrier(const XcdBarrier& b) {
    asm volatile("s_waitcnt vmcnt(0)" ::: "memory");
    __syncthreads();
    if (threadIdx.x == 0) {
        unsigned* bar = b.bar; asm volatile("" : "+s"(bar));
        __builtin_amdgcn_s_waitcnt(0);
        unsigned nloc = b.st[0], nx = b.st[1];
        if (nloc == 0u) { xcd_barrier_complete(bar, b.x, nloc, nx); b.st[0] = nloc; b.st[1] = nx; }
        const unsigned old = xb_add(&bar[XB_XSUB(b.x)], 1u);
        const unsigned gen = old / nloc;
        if (old + 1u == (gen + 1u) * nloc) {
            __builtin_amdgcn_fence(__ATOMIC_RELEASE, "agent");
            asm volatile("s_waitcnt vmcnt(0)" ::: "memory");
            const unsigned og = xb_add(&bar[XB_TOP], 1u);
            const unsigned tg = og / nx;
            if (og + 1u == (tg + 1u) * nx) xb_add(&bar[XB_TOPGEN], 1u);
            else XB_SPIN(xb_ld(&bar[XB_TOPGEN]) == tg, bar);
            __builtin_amdgcn_fence(__ATOMIC_ACQUIRE, "agent");
            xb_add(&bar[XB_XGEN(b.x)], 1u);
            asm volatile("s_waitcnt vmcnt(0)" ::: "memory");
        } else {
            XB_SPIN(xb_ld(&bar[XB_XGEN(b.x)]) == gen, bar);
            __builtin_amdgcn_fence(__ATOMIC_ACQUIRE, "agent");
            asm volatile("s_waitcnt vmcnt(0)" ::: "memory");
        }
    }
    __syncthreads();
}

constexpr int T = 16384, SEQ = 8192, D = 2048, DLRU = 1024, DDN = 1024, NH = 8, HD = 128, NPROJ = 6144, DIN = 6160;
constexpr int DFF = 6144, NEXP = 8, DFFE = 3072;
constexpr float EPS = 1e-6f;
typedef unsigned short bf16;
typedef float f32x4 __attribute__((ext_vector_type(4)));
typedef unsigned u32x4 __attribute__((ext_vector_type(4)));
typedef unsigned u32x2 __attribute__((ext_vector_type(2)));
#define LDS_WAIT() asm volatile("s_waitcnt lgkmcnt(0)" ::: "memory")
#define LDS_BARRIER() do { asm volatile("s_waitcnt lgkmcnt(0)" ::: "memory"); __builtin_amdgcn_s_barrier(); asm volatile("" ::: "memory"); } while (0)

__device__ __forceinline__ float bf2f(bf16 b) { return __uint_as_float(((unsigned)b) << 16); }
__device__ __forceinline__ unsigned f2bf(float f) { return pg8::cvt_pk_bf16(f, f) & 0xffffu; }
__device__ __forceinline__ unsigned pk2(float lo, float hi) { return pg8::cvt_pk_bf16(lo, hi); }
__device__ __forceinline__ float shfl_xor_l(float v, int o, int lane) { return __int_as_float(__builtin_amdgcn_ds_bpermute((lane ^ o) << 2, __float_as_int(v))); }
__device__ __forceinline__ float shfl_up_l(float v, int d, int lane) { return __int_as_float(__builtin_amdgcn_ds_bpermute((lane - d) << 2, __float_as_int(v))); }
__device__ __forceinline__ float shfl_idx_l(float v, int src) { return __int_as_float(__builtin_amdgcn_ds_bpermute(src << 2, __float_as_int(v))); }
__device__ __forceinline__ float wave_sum(float v, int lane) {
#pragma unroll
    for (int o = 1; o < 64; o <<= 1) v += shfl_xor_l(v, o, lane);
    return v;
}
using pg8::silu_f;
using pg8::frcp; using pg8::rsqrt_f;
__device__ __forceinline__ float sigmoid_f(float x) { return frcp(1.0f + __expf(-x)); }
__device__ __forceinline__ float softplus_f(float x) { return fmaxf(x, 0.0f) + log1pf(__expf(-fabsf(x))); }
__device__ __forceinline__ float gelu_tanh_f(float x) { const float u = 0.7978845608028654f * (x + 0.044715f * x * x * x); return x * frcp(1.0f + __expf(-2.0f * u)); }

constexpr size_t MiB = 1u << 20;
constexpr size_t al(size_t x) { return (x + MiB - 1) / MiB * MiB; }
constexpr size_t WS_CTL = 0, CTL_ZERO_BYTES = 1 * MiB;
constexpr int CW_BAR = 4096, CW_CNT = 8192;
constexpr size_t WS_WGU = 1 * MiB;
constexpr size_t WS_WD = WS_WGU + al((size_t)2 * DFF * D * 2);
constexpr size_t WS_WIN = WS_WD + al((size_t)D * DFF * 2);
constexpr size_t WS_WBA = WS_WIN + al((size_t)2 * NPROJ * D * 2);
constexpr size_t WS_WOUT = WS_WBA + al((size_t)2 * 16 * D * 4 + 2 * 16 * D * 2);
static_assert(WS_WIN + (size_t)NPROJ * D * 2 - WS_WGU >= (size_t)NEXP * D * DFFE * 2, "MoE down weights overlay");
constexpr size_t WS_XB = WS_WOUT + al((size_t)2 * D * D * 2);
constexpr size_t WS_RSTD = WS_XB + al((size_t)T * D * 2);
constexpr size_t WS_BA = WS_RSTD + 5 * MiB;
constexpr size_t WS_BETA = WS_BA + al((size_t)T * 16 * 4);
constexpr size_t WS_G = WS_BETA + al((size_t)T * 8 * 4);
constexpr size_t WS_ROWW = WS_G + al((size_t)T * 8 * 4);
constexpr int NSLOT = 2 * T + NEXP * 256;
constexpr size_t WS_PROJ = WS_ROWW + al((size_t)2 * 8 * T * 4);
constexpr size_t WS_YMIX = WS_PROJ + al((size_t)NSLOT * DFFE * 2);
constexpr size_t WS_C = WS_YMIX + al((size_t)T * D * 2);
constexpr size_t WS_WRT = WS_C + (size_t)388 * MiB;
constexpr size_t WS_END = WS_WRT + 1 * MiB;
static_assert(WS_END <= (size_t)975 * MiB, "d_ws map exceeds the guaranteed workspace");
static_assert((size_t)NEXP * 2 * DFFE * D * 2 <= (size_t)388 * MiB, "MoE gate/up bf16 weights overlay the mixer scratch");
constexpr int RING_BYTES = 131072, LDSCTL_OFF = RING_BYTES, MISC_OFF = LDSCTL_OFF + 320, LDS_BYTES = 147456;

__device__ __forceinline__ void transpose_item(const float* W, int ldw, int col_off, int K, int nblk, const float* gain, bf16* WT, int blk, int blk_stride, int row_off, int item, int lane) {
    const int kb = item / nblk, nb = item % nblk, k0 = 64 * kb + (lane >> 4) * 16, n0 = 64 * nb + (lane & 15) * 4;
    const float* src = W + (size_t)k0 * ldw + col_off + n0;
    f32x4 v[16];
#pragma unroll
    for (int j = 0; j < 16; ++j) v[j] = __builtin_nontemporal_load((const f32x4*)(src + (size_t)j * ldw));
    if (gain) {
#pragma unroll
        for (int q = 0; q < 4; ++q) { const f32x4 g = *(const f32x4*)(gain + k0 + 4 * q);
#pragma unroll
            for (int c = 0; c < 4; ++c) v[4 * q + c] = v[4 * q + c] * g[c]; }
    }
#pragma unroll
    for (int i = 0; i < 4; ++i) { const int n = n0 + i, drow = (n / blk) * blk_stride + (n % blk) + row_off;
        u32x4 o0, o1;
        o0.x = pk2(v[0][i], v[1][i]); o0.y = pk2(v[2][i], v[3][i]); o0.z = pk2(v[4][i], v[5][i]); o0.w = pk2(v[6][i], v[7][i]);
        o1.x = pk2(v[8][i], v[9][i]); o1.y = pk2(v[10][i], v[11][i]); o1.z = pk2(v[12][i], v[13][i]); o1.w = pk2(v[14][i], v[15][i]);
        u32x4* dst = (u32x4*)(WT + (size_t)drow * K + k0); dst[0] = o0; dst[1] = o1; }
}
__device__ __forceinline__ void convert_matrix(const float* W, int ldw, int col_off, int K, int N, const float* gain, bf16* WT, int blk, int blk_stride, int row_off, LAS float* scr, int gw, int NGW, int lane) {
    const int nblk = N / 64, nitems = (K / 64) * nblk; (void)scr;
    for (int it = gw; it < nitems; it += NGW) transpose_item(W, ldw, col_off, K, nblk, gain, WT, blk, blk_stride, row_off, it, lane);
}
__device__ __forceinline__ void rowprep_row(const float* x, bf16* xb, float* rstd, const float* Wba, float* ba, int row, int lane) {
    const f32x4* xr = (const f32x4*)(x + (size_t)row * D) + lane;
    f32x4 v[8]; float ss = 0.f;
#pragma unroll
    for (int j = 0; j < 8; ++j) { v[j] = xr[64 * j]; ss += (v[j][0] * v[j][0] + v[j][1] * v[j][1]) + (v[j][2] * v[j][2] + v[j][3] * v[j][3]); }
    ss = wave_sum(ss, lane);
    const float rs = rsqrt_f(ss * (1.0f / D) + EPS);
    u32x2* o = (u32x2*)(xb + (size_t)row * D) + lane;
#pragma unroll
    for (int j = 0; j < 8; ++j) { u32x2 w; w.x = pk2(v[j][0], v[j][1]); w.y = pk2(v[j][2], v[j][3]); o[64 * j] = w; }
    if (lane == 0) rstd[row] = rs;
    if (Wba) {
        for (int c = 0; c < 16; ++c) { const f32x4* wr = (const f32x4*)(Wba + (size_t)c * D) + lane; float a = 0.f;
#pragma unroll
            for (int j = 0; j < 8; ++j) { const f32x4 w = wr[64 * j]; a += (v[j][0] * w[0] + v[j][1] * w[1]) + (v[j][2] * w[2] + v[j][3] * w[3]); }
            a = wave_sum(a, lane); if (lane == 0) ba[(size_t)row * 16 + c] = a * rs; }
    }
}
__device__ __forceinline__ void lru_conv_elem(const bf16* proj, const float* cw, const float* cb, float* xc, size_t idx) {
    const int t = (int)(idx / DLRU), ch = (int)(idx % DLRU), s = t % SEQ;
    float a = cb[ch];
#pragma unroll
    for (int k = 0; k < 4; ++k) { const int sp = s - 3 + k; if (sp >= 0) a += cw[k * DLRU + ch] * bf2f(proj[(size_t)(t - 3 + k) * NPROJ + ch]); }
    xc[idx] = a;
}
__device__ __forceinline__ void lru_gate_elem(const float* xc, const float* w_r, const float* b_r, const float* w_i, const float* b_i, const float* lam, float* av, float* bv, size_t idx) {
    const int t = (int)(idx / DLRU), ch = (int)(idx % DLRU), n = ch >> 7, d = ch & 127;
    float ar = b_r[ch], ai = b_i[ch];
    const float* xr = xc + (size_t)t * DLRU + n * 128; const float* wr = w_r + (size_t)n * 128 * 128 + d; const float* wi = w_i + (size_t)n * 128 * 128 + d;
    for (int c = 0; c < 128; ++c) { const float xv = xr[c]; ar += xv * wr[c * 128]; ai += xv * wi[c * 128]; }
    const float r = sigmoid_f(ar), ig = sigmoid_f(ai);
    const float log_a = -8.0f * r * softplus_f(-lam[ch]);
    const float a = expf(log_a), mult = sqrtf(-expm1f(2.0f * log_a));
    av[idx] = a; bv[idx] = mult * (ig * xc[idx]);
}
__device__ __forceinline__ void lru_scan_chan(float* av, const float* bv, const bf16* proj, int idx) {
    const int b = idx / DLRU, ch = idx % DLRU;
    float h = 0.f;
    for (int s0 = 0; s0 < SEQ; s0 += 8) {
        float a8[8], b8[8], g8[8];
#pragma unroll
        for (int j = 0; j < 8; ++j) { const size_t t = (size_t)b * SEQ + s0 + j; a8[j] = av[t * DLRU + ch]; b8[j] = bv[t * DLRU + ch]; g8[j] = bf2f(proj[t * NPROJ + DLRU + ch]); }
#pragma unroll
        for (int j = 0; j < 8; ++j) { const size_t t = (size_t)b * SEQ + s0 + j; h = a8[j] * h + b8[j]; av[t * DLRU + ch] = h * gelu_tanh_f(g8[j]); }
    }
}
__device__ __forceinline__ void lru_norm_row(const float* y, const float* gain, bf16* ymix, int row, int lane) {
    const f32x4* yr = (const f32x4*)(y + (size_t)row * DLRU) + lane; const f32x4* gr = (const f32x4*)gain + lane;
    f32x4 v[4]; float ss = 0.f;
#pragma unroll
    for (int j = 0; j < 4; ++j) { v[j] = yr[64 * j]; ss += (v[j][0] * v[j][0] + v[j][1] * v[j][1]) + (v[j][2] * v[j][2] + v[j][3] * v[j][3]); }
    ss = wave_sum(ss, lane); const float rs = rsqrt_f(ss * (1.0f / DLRU) + EPS);
    u32x2* o = (u32x2*)(ymix + (size_t)row * D) + lane;
#pragma unroll
    for (int j = 0; j < 4; ++j) { const f32x4 g = gr[64 * j]; u32x2 w; w.x = pk2(v[j][0] * rs * g[0], v[j][1] * rs * g[1]); w.y = pk2(v[j][2] * rs * g[2], v[j][3] * rs * g[3]); o[64 * j] = w; }
}
__device__ __forceinline__ void dn_prep_item(const bf16* proj, const float* cw, const float* ba, const float* a_log, const float* dt_bias, float* qn, float* kn, float* vn, float* beta, float* gg, int w, int lane) {
    const int t = w >> 3, h = w & 7, s = t % SEQ;
    float val[3][2];
#pragma unroll
    for (int p = 0; p < 3; ++p)
#pragma unroll
        for (int e = 0; e < 2; ++e) { const int d = lane * 2 + e, c = p * DDN + h * HD + d; float a = 0.f;
#pragma unroll
            for (int k = 0; k < 4; ++k) { const int sp = s - 3 + k; if (sp >= 0) a += cw[k * 3 * DDN + c] * bf2f(proj[(size_t)(t - 3 + k) * NPROJ + 2048 + c]); }
            val[p][e] = silu_f(a); }
    const float sq = wave_sum(val[0][0] * val[0][0] + val[0][1] * val[0][1], lane), sk = wave_sum(val[1][0] * val[1][0] + val[1][1] * val[1][1], lane);
    const float rq = rsqrt_f(sq + EPS) * 0.08838834764831845f, rk = rsqrt_f(sk + EPS);
    const size_t o = ((size_t)t * NH + h) * HD + lane * 2;
    qn[o] = val[0][0] * rq; qn[o + 1] = val[0][1] * rq; kn[o] = val[1][0] * rk; kn[o + 1] = val[1][1] * rk; vn[o] = val[2][0]; vn[o + 1] = val[2][1];
    if (lane == 0) { beta[t * NH + h] = sigmoid_f(ba[(size_t)t * 16 + h]); gg[t * NH + h] = -__expf(a_log[h]) * softplus_f(ba[(size_t)t * 16 + 8 + h] + dt_bias[h]); }
}
__device__ __forceinline__ void dn_rec_seq(const float* qn, const float* kn, const float* vn, const float* beta, const float* gg, float* o, int bh, LAS float* sk, LAS float* sq, LAS float* st, int tid) {
    const int b = bh >> 3, h = bh & 7, j = tid & 127; const bool act = tid < 128;
    if (act) for (int k = 0; k < 128; ++k) st[k * 128 + j] = 0.f;
    const size_t base = ((size_t)(b * SEQ) * NH + h) * HD;
    float nk = kn[base + j], nq = qn[base + j], nv = vn[base + j], nb = beta[(b * SEQ) * NH + h], ng = gg[(b * SEQ) * NH + h];
    for (int s = 0; s < SEQ; ++s) {
        const int buf = (s & 1) * 128;
        if (act) { sk[buf + j] = nk; sq[buf + j] = nq; }
        const float vj = nv, be = nb, ge = __expf(ng);
        __syncthreads();
        if (act) {
            if (s + 1 < SEQ) { const size_t nb_ = ((size_t)(b * SEQ + s + 1) * NH + h) * HD; nk = kn[nb_ + j]; nq = qn[nb_ + j]; nv = vn[nb_ + j]; nb = beta[(b * SEQ + s + 1) * NH + h]; ng = gg[(b * SEQ + s + 1) * NH + h]; }
            float ks = 0.f;
#pragma unroll 8
            for (int k = 0; k < 128; ++k) ks += sk[buf + k] * st[k * 128 + j];
            const float vnew = be * (vj - ge * ks);
            float oo = 0.f;
#pragma unroll 8
            for (int k = 0; k < 128; ++k) { const float sv = ge * st[k * 128 + j] + sk[buf + k] * vnew; st[k * 128 + j] = sv; oo += sq[buf + k] * sv; }
            o[((size_t)(b * SEQ + s) * NH + h) * HD + j] = oo;
        }
    }
    __syncthreads();
}
typedef short bf16x8 __attribute__((ext_vector_type(8)));
__device__ __forceinline__ f32x4 mfma16(bf16x8 a, bf16x8 b, f32x4 c) { return __builtin_amdgcn_mfma_f32_16x16x32_bf16(a, b, c, 0, 0, 0); }
__device__ __forceinline__ float bflo(unsigned x) { return __uint_as_float(x << 16); }
__device__ __forceinline__ float bfhi(unsigned x) { return __uint_as_float(x & 0xffff0000u); }
constexpr int DA_G = 0, DA_L = 1024, DA_KN = DA_L + 16384, DA_QN = DA_KN + 17408, DA_VBT = DA_QN + 17408, DA_KBET = DA_VBT + 18432, DA_KDT = DA_KBET + 18432, DA_TB = DA_KDT + 18432, DA_QK = DA_TB + 9216, DA_END = DA_QK + 9216;
static_assert(DA_END <= RING_BYTES, "DN-A LDS map");
#if defined(PROBE_DNA_A)
#define DNA_ST(k) do { if (threadIdx.x == 0) ((volatile LAS unsigned long long*)(lds + (RING_BYTES + 2048)))[k] = __builtin_amdgcn_s_memrealtime(); } while (0)
#else
#define DNA_ST(k) do { } while (0)
#endif
__device__ __forceinline__ void dna_unit(const bf16* proj, const float* cw, const float* ba, const float* a_log, const float* dt_bias,
                                         bf16* Wf, bf16* Qf, bf16* KdTf, bf16* QKf, bf16* Uf, float* glb, int uid, LAS unsigned char* lds, int tid, int lane, int wave) {
    const int h = uid & 7, n = (uid >> 3) & 127, b = uid >> 10, t0 = b * SEQ + n * 64;
    asm volatile("" : "+v"(lds));
    DNA_ST(0);
    LAS float* Gs = (LAS float*)(lds + DA_G);
    const int fr = lane & 15, fq = lane >> 4;
    if (wave == 0) {
        const size_t t = (size_t)(t0 + lane);
        const float be = sigmoid_f(ba[t * 16 + h]); float Gc = -__expf(a_log[h]) * softplus_f(ba[t * 16 + 8 + h] + dt_bias[h]);
#pragma unroll
        for (int off = 1; off < 64; off <<= 1) { const float tmp = shfl_up_l(Gc, off, lane); if (lane >= off) Gc += tmp; }
        const float GL = shfl_idx_l(Gc, 63);
        Gs[lane] = Gc; Gs[64 + lane] = be; Gs[128 + lane] = __expf(Gc); Gs[192 + lane] = __expf(GL - Gc);
        if (lane == 63) glb[uid] = __expf(Gc);
    }
    LDS_BARRIER();
    DNA_ST(1);
    {
        const int r = tid >> 3, cg = tid & 7;
        const float be = Gs[64 + r], eg = Gs[128 + r], egl = Gs[192 + r];
        float val[3][16];
#pragma unroll
        for (int p = 0; p < 3; ++p) {
            const int ccol = p * DDN + h * HD + cg * 16;
            float acc[16];
#pragma unroll
            for (int i = 0; i < 16; ++i) acc[i] = 0.f;
#pragma unroll
            for (int k = 0; k < 4; ++k) { const int row = r - 3 + k;
                if (n * 64 + row >= 0) {
                    const bf16* src = proj + (size_t)(t0 + row) * NPROJ + 2048 + ccol;
                    const u32x4 x0 = *(const u32x4*)src, x1 = *(const u32x4*)(src + 8);
                    const float* wp = cw + k * 3 * DDN + ccol;
                    const f32x4 w0 = *(const f32x4*)wp, w1 = *(const f32x4*)(wp + 4), w2 = *(const f32x4*)(wp + 8), w3 = *(const f32x4*)(wp + 12);
                    acc[0] += w0[0] * bflo(x0.x); acc[1] += w0[1] * bfhi(x0.x); acc[2] += w0[2] * bflo(x0.y); acc[3] += w0[3] * bfhi(x0.y);
                    acc[4] += w1[0] * bflo(x0.z); acc[5] += w1[1] * bfhi(x0.z); acc[6] += w1[2] * bflo(x0.w); acc[7] += w1[3] * bfhi(x0.w);
                    acc[8] += w2[0] * bflo(x1.x); acc[9] += w2[1] * bfhi(x1.x); acc[10] += w2[2] * bflo(x1.y); acc[11] += w2[3] * bfhi(x1.y);
                    acc[12] += w3[0] * bflo(x1.z); acc[13] += w3[1] * bfhi(x1.z); acc[14] += w3[2] * bflo(x1.w); acc[15] += w3[3] * bfhi(x1.w);
                } }
#pragma unroll
            for (int i = 0; i < 16; ++i) val[p][i] = silu_f(acc[i]);
        }
        float sq = 0.f, sk = 0.f;
#pragma unroll
        for (int i = 0; i < 16; ++i) { sq += val[0][i] * val[0][i]; sk += val[1][i] * val[1][i]; }
        sq += shfl_xor_l(sq, 1, lane); sq += shfl_xor_l(sq, 2, lane); sq += shfl_xor_l(sq, 4, lane);
        sk += shfl_xor_l(sk, 1, lane); sk += shfl_xor_l(sk, 2, lane); sk += shfl_xor_l(sk, 4, lane);
        const float rq = rsqrt_f(sq + EPS) * 0.08838834764831845f, rk = rsqrt_f(sk + EPS);
#pragma unroll
        for (int i = 0; i < 16; ++i) { val[0][i] *= rq; val[1][i] *= rk; }
        u32x4 o0, o1;
        o0.x = pk2(val[1][0], val[1][1]); o0.y = pk2(val[1][2], val[1][3]); o0.z = pk2(val[1][4], val[1][5]); o0.w = pk2(val[1][6], val[1][7]);
        o1.x = pk2(val[1][8], val[1][9]); o1.y = pk2(val[1][10], val[1][11]); o1.z = pk2(val[1][12], val[1][13]); o1.w = pk2(val[1][14], val[1][15]);
        *(LAS u32x4*)(lds + DA_KN + r * 272 + cg * 32) = o0; *(LAS u32x4*)(lds + DA_KN + r * 272 + cg * 32 + 16) = o1;
        o0.x = pk2(val[0][0], val[0][1]); o0.y = pk2(val[0][2], val[0][3]); o0.z = pk2(val[0][4], val[0][5]); o0.w = pk2(val[0][6], val[0][7]);
        o1.x = pk2(val[0][8], val[0][9]); o1.y = pk2(val[0][10], val[0][11]); o1.z = pk2(val[0][12], val[0][13]); o1.w = pk2(val[0][14], val[0][15]);
        *(LAS u32x4*)(lds + DA_QN + r * 272 + cg * 32) = o0; *(LAS u32x4*)(lds + DA_QN + r * 272 + cg * 32 + 16) = o1;
#pragma unroll
        for (int i = 0; i < 16; ++i) { const int f = cg * 16 + i;
            *(LAS unsigned short*)(lds + DA_VBT + f * 144 + r * 2) = (unsigned short)f2bf(val[2][i] * be);
            *(LAS unsigned short*)(lds + DA_KBET + f * 144 + r * 2) = (unsigned short)f2bf(val[1][i] * (be * eg));
            *(LAS unsigned short*)(lds + DA_KDT + f * 144 + r * 2) = (unsigned short)f2bf(val[1][i] * egl); }
    }
    LDS_BARRIER();
    DNA_ST(2);
    {
        const int p = wave >> 2, ti = wave & 3;
        const int abase = p == 0 ? DA_KN : DA_QN;
        bf16x8 af[4];
#pragma unroll
        for (int ks = 0; ks < 4; ++ks) af[ks] = *(const LAS bf16x8*)(lds + abase + (ti * 16 + fr) * 272 + (ks * 32 + fq * 8) * 2);
        for (int tj = 0; tj < 4; ++tj) {
            f32x4 acc = {0.f, 0.f, 0.f, 0.f};
            if (tj <= ti) {
#pragma unroll
                for (int ks = 0; ks < 4; ++ks) { const bf16x8 bb = *(const LAS bf16x8*)(lds + DA_KN + (tj * 16 + fr) * 272 + (ks * 32 + fq * 8) * 2); acc = mfma16(af[ks], bb, acc); }
            }
            const int j = tj * 16 + fr; const float Gj = Gs[j];
#pragma unroll
            for (int r = 0; r < 4; ++r) { const int i = ti * 16 + fq * 4 + r; float v = 0.f;
                if (p == 0) { if (i > j) v = Gs[64 + i] * acc[r] * __expf(Gs[i] - Gj); *(LAS float*)(lds + DA_L + (j * 64 + i) * 4) = v; }
                else { if (i >= j) v = acc[r] * __expf(Gs[i] - Gj); *(LAS unsigned short*)(lds + DA_QK + i * 144 + j * 2) = (unsigned short)f2bf(v); } }
        }
    }
    LDS_BARRIER();
    DNA_ST(3);
    {
        int lc = lane; asm volatile("" : "+v"(lc)); const float fl = (float)lc;
        const int blk = wave < 4 ? wave : 11 - wave;
        float Tr[8];
#pragma unroll
        for (int c = 0; c < 8; ++c) Tr[c] = fmaxf(0.f, 1.f - fabsf(fl - (float)(blk * 8 + c)));
        float lj[63];
#pragma unroll
        for (int j = 0; j < 63; ++j) lj[j] = *(const LAS float*)(lds + DA_L + (j * 64) * 4 + lc * 4);
#pragma unroll
        for (int j = 0; j < 63; ++j) {
            if (j >= blk * 8) {
#pragma unroll
                for (int c = 0; c < 8; ++c) { const float tj = __int_as_float(__builtin_amdgcn_readlane(__float_as_int(Tr[c]), j)); Tr[c] -= lj[j] * tj; }
            }
        }
        u32x4 o; o.x = pk2(Tr[0], Tr[1]); o.y = pk2(Tr[2], Tr[3]); o.z = pk2(Tr[4], Tr[5]); o.w = pk2(Tr[6], Tr[7]);
        *(LAS u32x4*)(lds + DA_TB + lc * 144 + blk * 16) = o;
    }
    {
        for (int fi = wave; fi < 40; fi += 8) {
            if (fi < 8) { const int mt = fi >> 1, ks = fi & 1;
                const u32x4 v = *(const LAS u32x4*)(lds + DA_QK + (mt * 16 + fr) * 144 + (ks * 32 + fq * 8) * 2);
                *(u32x4*)(QKf + (((size_t)uid * 4 + mt) * 2 + ks) * 512 + lane * 8) = v; }
            else if (fi < 24) { const int f2 = fi - 8, mt = f2 >> 2, ks = f2 & 3; const float eg = Gs[128 + mt * 16 + fr];
                const u32x4 v = *(const LAS u32x4*)(lds + DA_QN + (mt * 16 + fr) * 272 + (ks * 32 + fq * 8) * 2); u32x4 o;
                o.x = pk2(bflo(v.x) * eg, bfhi(v.x) * eg); o.y = pk2(bflo(v.y) * eg, bfhi(v.y) * eg); o.z = pk2(bflo(v.z) * eg, bfhi(v.z) * eg); o.w = pk2(bflo(v.w) * eg, bfhi(v.w) * eg);
                *(u32x4*)(Qf + (((size_t)uid * 4 + mt) * 4 + ks) * 512 + lane * 8) = o; }
            else { const int f2 = fi - 24, ft = f2 >> 1, ks = f2 & 1;
                const u32x4 v = *(const LAS u32x4*)(lds + DA_KDT + (ft * 16 + fr) * 144 + (ks * 32 + fq * 8) * 2);
                *(u32x4*)(KdTf + (((size_t)uid * 8 + ft) * 2 + ks) * 512 + lane * 8) = v; }
        }
    }
    LDS_BARRIER();
    DNA_ST(4);
    {
        bf16x8 ta[4][2];
#pragma unroll
        for (int mt = 0; mt < 4; ++mt)
#pragma unroll
            for (int ks = 0; ks < 2; ++ks) ta[mt][ks] = *(const LAS bf16x8*)(lds + DA_TB + (mt * 16 + fr) * 144 + (ks * 32 + fq * 8) * 2);
#pragma unroll
        for (int c2 = 0; c2 < 2; ++c2) { const int ct = wave * 2 + c2, img = ct < 8 ? DA_VBT : DA_KBET, cr = (ct & 7) * 16 + fr;
            bf16x8 bb[2];
#pragma unroll
            for (int ks = 0; ks < 2; ++ks) bb[ks] = *(const LAS bf16x8*)(lds + img + cr * 144 + (ks * 32 + fq * 8) * 2);
#pragma unroll
            for (int mt = 0; mt < 4; ++mt) { f32x4 acc = {0.f, 0.f, 0.f, 0.f};
#pragma unroll
                for (int ks = 0; ks < 2; ++ks) acc = mfma16(ta[mt][ks], bb[ks], acc);
                if (ct < 8) { u32x2 o; o.x = pk2(acc[0], acc[1]); o.y = pk2(acc[2], acc[3]); *(u32x2*)(Uf + ((((size_t)uid * 8 + ct) * 4 + mt) * 64 + lane) * 4) = o; }
                else { const int f = (ct - 8) * 16 + fr;
#pragma unroll
                    for (int r = 0; r < 4; ++r) *(LAS unsigned short*)(lds + DA_KN + (mt * 16 + fq * 4 + r) * 272 + f * 2) = (unsigned short)f2bf(acc[r]); } }
        }
    }
    LDS_BARRIER();
    DNA_ST(5);
#pragma unroll
    for (int q2 = 0; q2 < 2; ++q2) { const int fi = wave * 2 + q2, mt = fi >> 2, ks = fi & 3;
        const u32x4 v = *(const LAS u32x4*)(lds + DA_KN + (mt * 16 + fr) * 272 + (ks * 32 + fq * 8) * 2);
        *(u32x4*)(Wf + (((size_t)uid * 4 + mt) * 4 + ks) * 512 + lane * 8) = v; }
    LDS_BARRIER();
    DNA_ST(6);
}
struct DnbFrag { bf16x8 a1[4]; bf16x8 a2[2]; bf16x8 kd[2]; u32x2 u; float gl; };
__device__ __forceinline__ DnbFrag dnb_load(const bf16* A1, const bf16* QKf, const bf16* KdTf, const bf16* Uf, const float* glb, int uid, int ds, int wave, int lane) {
    DnbFrag f; const int mt = wave & 3;
#pragma unroll
    for (int ks = 0; ks < 4; ++ks) f.a1[ks] = *(const bf16x8*)(A1 + (((size_t)uid * 4 + mt) * 4 + ks) * 512 + lane * 8);
#pragma unroll
    for (int ks = 0; ks < 2; ++ks) f.kd[ks] = *(const bf16x8*)(KdTf + (((size_t)uid * 8 + wave) * 2 + ks) * 512 + lane * 8);
#pragma unroll
    for (int ks = 0; ks < 2; ++ks) f.a2[ks] = *(const bf16x8*)(QKf + (((size_t)uid * 4 + mt) * 2 + ks) * 512 + lane * 8);
    f.u = *(const u32x2*)(Uf + ((((size_t)uid * 8 + ds) * 4 + mt) * 64 + lane) * 4);
    f.gl = glb[uid];
    return f;
}
__device__ __forceinline__ void dnb_run(const bf16* Wf, const bf16* Qf, const bf16* KdTf, const bf16* QKf, const bf16* Uf, const float* glb, float* o, int bh, int ds, LAS unsigned char* lds, int tid, int lane, int wave) {
    const int b = bh >> 3, h = bh & 7, fr = lane & 15, fq = lane >> 4, mt = wave & 3;
    asm volatile("" : "+v"(lds));
    LAS unsigned char* ST = lds; LAS unsigned char* VNT = lds + 4608;
    for (int i = tid; i < 4608 / 4; i += 512) ((LAS unsigned*)ST)[i] = 0u;
    f32x4 accS = {0.f, 0.f, 0.f, 0.f};
    const bf16* A1 = wave < 4 ? Wf : Qf;
    DnbFrag f0 = dnb_load(A1, QKf, KdTf, Uf, glb, (b * 128 + 0) * 8 + h, ds, wave, lane), f1 = dnb_load(A1, QKf, KdTf, Uf, glb, (b * 128 + 1) * 8 + h, ds, wave, lane);
    DnbFrag f2 = dnb_load(A1, QKf, KdTf, Uf, glb, (b * 128 + 2) * 8 + h, ds, wave, lane), f3 = dnb_load(A1, QKf, KdTf, Uf, glb, (b * 128 + 3) * 8 + h, ds, wave, lane);
    __syncthreads();
#define DNB_STEP(F, nn) do { const int n = (nn); \
        f32x4 acc = {0.f, 0.f, 0.f, 0.f}; \
        _Pragma("unroll") for (int ks = 0; ks < 4; ++ks) { const bf16x8 sb = *(const LAS bf16x8*)(ST + fr * 272 + (ks * 32 + fq * 8) * 2); acc = mfma16(F.a1[ks], sb, acc); } \
        if (wave < 4) { const float v0 = bflo(F.u.x) - acc[0], v1 = bfhi(F.u.x) - acc[1], v2 = bflo(F.u.y) - acc[2], v3 = bfhi(F.u.y) - acc[3]; \
            u32x2 w; w.x = pk2(v0, v1); w.y = pk2(v2, v3); *(LAS u32x2*)(VNT + fr * 144 + (mt * 16 + fq * 4) * 2) = w; } \
        LDS_BARRIER(); \
        bf16x8 vb[2]; \
        _Pragma("unroll") for (int ks = 0; ks < 2; ++ks) vb[ks] = *(const LAS bf16x8*)(VNT + fr * 144 + (ks * 32 + fq * 8) * 2); \
        if (wave >= 4) { _Pragma("unroll") for (int ks = 0; ks < 2; ++ks) acc = mfma16(F.a2[ks], vb[ks], acc); \
            const size_t ob = ((size_t)(b * SEQ + n * 64 + mt * 16 + fq * 4) * NH + h) * HD + ds * 16 + fr; \
            _Pragma("unroll") for (int r = 0; r < 4; ++r) o[ob + (size_t)r * NH * HD] = acc[r]; } \
        accS = accS * F.gl; \
        _Pragma("unroll") for (int ks = 0; ks < 2; ++ks) accS = mfma16(F.kd[ks], vb[ks], accS); \
        { u32x2 w; w.x = pk2(accS[0], accS[1]); w.y = pk2(accS[2], accS[3]); *(LAS u32x2*)(ST + fr * 272 + (wave * 16 + fq * 4) * 2) = w; } \
        F = dnb_load(A1, QKf, KdTf, Uf, glb, (b * 128 + (n + 4 < 128 ? n + 4 : 127)) * 8 + h, ds, wave, lane);     \
        LDS_BARRIER(); } while (0)
    for (int n4 = 0; n4 < 128; n4 += 16) {
        DNB_STEP(f0, n4); DNB_STEP(f1, n4 + 1); DNB_STEP(f2, n4 + 2); DNB_STEP(f3, n4 + 3); DNB_STEP(f0, n4 + 4); DNB_STEP(f1, n4 + 5); DNB_STEP(f2, n4 + 6); DNB_STEP(f3, n4 + 7);
        DNB_STEP(f0, n4 + 8); DNB_STEP(f1, n4 + 9); DNB_STEP(f2, n4 + 10); DNB_STEP(f3, n4 + 11); DNB_STEP(f0, n4 + 12); DNB_STEP(f1, n4 + 13); DNB_STEP(f2, n4 + 14); DNB_STEP(f3, n4 + 15); }
#undef DNB_STEP
}
constexpr int LA_XB = 0, LA_XF = 17408, LA_END = LA_XF + 64 * 132 * 4;
static_assert(LA_END <= RING_BYTES, "LRU-A LDS map");
__device__ __forceinline__ void lrua_unit(const bf16* proj, const float* cw, const float* cb, const bf16* WrT, const bf16* WiT, const float* b_r, const float* b_i, const float* lam,
                                          float* Hloc, float* Acum, float* summ, int unit, LAS unsigned char* lds, int tid, int lane, int wave) {
    const int nb = unit & 7, ct = unit >> 3, n = ct & 127, t0 = ct * 64;
    asm volatile("" : "+v"(lds));
    {
        const int r = tid >> 3, cg = tid & 7, ch0 = nb * 128 + cg * 16;
        float acc[16];
        { const f32x4 c0v = *(const f32x4*)(cb + ch0), c1v = *(const f32x4*)(cb + ch0 + 4), c2v = *(const f32x4*)(cb + ch0 + 8), c3v = *(const f32x4*)(cb + ch0 + 12);
#pragma unroll
          for (int i = 0; i < 4; ++i) { acc[i] = c0v[i]; acc[4 + i] = c1v[i]; acc[8 + i] = c2v[i]; acc[12 + i] = c3v[i]; } }
#pragma unroll
        for (int k = 0; k < 4; ++k) { const int row = r - 3 + k;
            if (n * 64 + row >= 0) {
                const bf16* src = proj + (size_t)(t0 + row) * NPROJ + ch0;
                const u32x4 x0 = *(const u32x4*)src, x1 = *(const u32x4*)(src + 8);
                const float* wp = cw + k * DLRU + ch0;
                const f32x4 w0 = *(const f32x4*)wp, w1 = *(const f32x4*)(wp + 4), w2 = *(const f32x4*)(wp + 8), w3 = *(const f32x4*)(wp + 12);
                acc[0] += w0[0] * bflo(x0.x); acc[1] += w0[1] * bfhi(x0.x); acc[2] += w0[2] * bflo(x0.y); acc[3] += w0[3] * bfhi(x0.y);
                acc[4] += w1[0] * bflo(x0.z); acc[5] += w1[1] * bfhi(x0.z); acc[6] += w1[2] * bflo(x0.w); acc[7] += w1[3] * bfhi(x0.w);
                acc[8] += w2[0] * bflo(x1.x); acc[9] += w2[1] * bfhi(x1.x); acc[10] += w2[2] * bflo(x1.y); acc[11] += w2[3] * bfhi(x1.y);
                acc[12] += w3[0] * bflo(x1.z); acc[13] += w3[1] * bfhi(x1.z); acc[14] += w3[2] * bflo(x1.w); acc[15] += w3[3] * bfhi(x1.w);
            } }
        u32x4 o0, o1;
        o0.x = pk2(acc[0], acc[1]); o0.y = pk2(acc[2], acc[3]); o0.z = pk2(acc[4], acc[5]); o0.w = pk2(acc[6], acc[7]);
        o1.x = pk2(acc[8], acc[9]); o1.y = pk2(acc[10], acc[11]); o1.z = pk2(acc[12], acc[13]); o1.w = pk2(acc[14], acc[15]);
        *(LAS u32x4*)(lds + LA_XB + r * 272 + cg * 32) = o0; *(LAS u32x4*)(lds + LA_XB + r * 272 + cg * 32 + 16) = o1;
        LAS f32x4* xf = (LAS f32x4*)(lds + LA_XF + (r * 132 + cg * 16) * 4);
        xf[0] = (f32x4){acc[0], acc[1], acc[2], acc[3]}; xf[1] = (f32x4){acc[4], acc[5], acc[6], acc[7]}; xf[2] = (f32x4){acc[8], acc[9], acc[10], acc[11]}; xf[3] = (f32x4){acc[12], acc[13], acc[14], acc[15]};
    }
    LDS_BARRIER();
    const int fr = lane & 15, fq = lane >> 4, cl = wave * 16 + fr, ch = nb * 128 + cl;
    bf16x8 br[4], bi[4];
#pragma unroll
    for (int ks = 0; ks < 4; ++ks) { br[ks] = *(const bf16x8*)(WrT + ((size_t)nb * 128 + cl) * 128 + ks * 32 + fq * 8); bi[ks] = *(const bf16x8*)(WiT + ((size_t)nb * 128 + cl) * 128 + ks * 32 + fq * 8); }
    f32x4 ar[4], ai[4];
#pragma unroll
    for (int mt = 0; mt < 4; ++mt) { ar[mt] = (f32x4){0.f, 0.f, 0.f, 0.f}; ai[mt] = (f32x4){0.f, 0.f, 0.f, 0.f};
#pragma unroll
        for (int ks = 0; ks < 4; ++ks) { const bf16x8 af = *(const LAS bf16x8*)(lds + LA_XB + (mt * 16 + fr) * 272 + (ks * 32 + fq * 8) * 2); ar[mt] = mfma16(af, br[ks], ar[mt]); ai[mt] = mfma16(af, bi[ks], ai[mt]); } }
    const float brr = b_r[ch], bii = b_i[ch], sp8 = -8.0f * softplus_f(-lam[ch]);
    float Ac = 1.f, Bc = 0.f;
#pragma unroll
    for (int mt = 0; mt < 4; ++mt) {
        float P[4], H[4];
#pragma unroll
        for (int r = 0; r < 4; ++r) { const int t = mt * 16 + fq * 4 + r; const float xcv = *(const LAS float*)(lds + LA_XF + (t * 132 + cl) * 4);
            const float rr = sigmoid_f(ar[mt][r] + brr), ii = sigmoid_f(ai[mt][r] + bii), la = sp8 * rr, a = __expf(la), bb = __builtin_amdgcn_sqrtf(fmaxf(1.0f - a * a, 0.0f)) * (ii * xcv);
            if (r == 0) { P[0] = a; H[0] = bb; } else { P[r] = P[r - 1] * a; H[r] = a * H[r - 1] + bb; } }
        float Ai = P[3], Bi = H[3];
        { const float Au = shfl_up_l(Ai, 16, lane), Bu = shfl_up_l(Bi, 16, lane); if (fq >= 1) { Bi = Ai * Bu + Bi; Ai = Au * Ai; } }
        { const float Au = shfl_up_l(Ai, 32, lane), Bu = shfl_up_l(Bi, 32, lane); if (fq >= 2) { Bi = Ai * Bu + Bi; Ai = Au * Ai; } }
        float Ae = shfl_up_l(Ai, 16, lane), Be = shfl_up_l(Bi, 16, lane); if (fq == 0) { Ae = 1.f; Be = 0.f; }
        const float At = shfl_idx_l(Ai, 48 + fr), Bt = shfl_idx_l(Bi, 48 + fr);
        const float PA = Ac * Ae, PB = Ae * Bc + Be;
#pragma unroll
        for (int r = 0; r < 4; ++r) { const size_t o = (size_t)(t0 + mt * 16 + fq * 4 + r) * DLRU + ch; ((unsigned*)Hloc)[o] = pk2(P[r] * PB + H[r], PA * P[r]); }
        Bc = At * Bc + Bt; Ac = Ac * At;
    }
    if (fq == 0) { float* sp = summ + ((size_t)ct * DLRU + ch) * 2; sp[0] = Ac; sp[1] = Bc; }
    LDS_BARRIER();
}
__device__ __forceinline__ void lru_carry(const float* summ, float* carry, int idx) {
    const int b = idx >> 10, ch = idx & 1023; float c = 0.f;
    for (int n0 = 0; n0 < 128; n0 += 8) { float A[8], B[8];
#pragma unroll
        for (int j = 0; j < 8; ++j) { const float* sp = summ + ((size_t)(b * 128 + n0 + j) * DLRU + ch) * 2; A[j] = sp[0]; B[j] = sp[1]; }
#pragma unroll
        for (int j = 0; j < 8; ++j) { carry[(size_t)(b * 128 + n0 + j) * DLRU + ch] = c; c = A[j] * c + B[j]; } }
}
__device__ __forceinline__ void lrub_row(const float* Hloc, const float* Acum, const float* carry, const bf16* proj, const float* gain, bf16* ymix, int row, int lane) {
    const int ct = row >> 6; f32x4 y[4]; float ss = 0.f;
#pragma unroll
    for (int j = 0; j < 4; ++j) { const int c4 = lane * 4 + 256 * j;
        const u32x4 ha = *(const u32x4*)((const unsigned*)Hloc + (size_t)row * DLRU + c4); const f32x4 cr = *(const f32x4*)(carry + (size_t)ct * DLRU + c4);
        const u32x2 g = *(const u32x2*)(proj + (size_t)row * NPROJ + DLRU + c4);
        const f32x4 hl = {bflo(ha.x), bflo(ha.y), bflo(ha.z), bflo(ha.w)}, ac = {bfhi(ha.x), bfhi(ha.y), bfhi(ha.z), bfhi(ha.w)};
        const f32x4 hh = hl + ac * cr;
        y[j][0] = hh[0] * gelu_tanh_f(bflo(g.x)); y[j][1] = hh[1] * gelu_tanh_f(bfhi(g.x)); y[j][2] = hh[2] * gelu_tanh_f(bflo(g.y)); y[j][3] = hh[3] * gelu_tanh_f(bfhi(g.y));
        ss += (y[j][0] * y[j][0] + y[j][1] * y[j][1]) + (y[j][2] * y[j][2] + y[j][3] * y[j][3]); }
    ss = wave_sum(ss, lane); const float rs = rsqrt_f(ss * (1.0f / DLRU) + EPS);
#pragma unroll
    for (int j = 0; j < 4; ++j) { const int c4 = lane * 4 + 256 * j; const f32x4 g = *(const f32x4*)(gain + c4); u32x2 w; w.x = pk2(y[j][0] * rs * g[0], y[j][1] * rs * g[1]); w.y = pk2(y[j][2] * rs * g[2], y[j][3] * rs * g[3]);
        *(u32x2*)(ymix + (size_t)row * D + c4) = w; }
}
__device__ __forceinline__ void dn_out_row(const float* o, const float* gain, const bf16* proj, bf16* ymix, int t, int lane) {
    const int c = lane * 16;
    const f32x4* op = (const f32x4*)(o + (size_t)t * DDN + c); const f32x4 o0 = op[0], o1 = op[1], o2 = op[2], o3 = op[3];
    const u32x4* gp = (const u32x4*)(proj + (size_t)t * NPROJ + 5120 + c); const u32x4 g0 = gp[0], g1 = gp[1];
    const f32x4* wp = (const f32x4*)(gain + (c & 127)); const f32x4 w0 = wp[0], w1 = wp[1], w2 = wp[2], w3 = wp[3];
    float ss = (o0[0] * o0[0] + o0[1] * o0[1]) + (o0[2] * o0[2] + o0[3] * o0[3]) + (o1[0] * o1[0] + o1[1] * o1[1]) + (o1[2] * o1[2] + o1[3] * o1[3])
             + (o2[0] * o2[0] + o2[1] * o2[1]) + (o2[2] * o2[2] + o2[3] * o2[3]) + (o3[0] * o3[0] + o3[1] * o3[1]) + (o3[2] * o3[2] + o3[3] * o3[3]);
    ss += shfl_xor_l(ss, 1, lane); ss += shfl_xor_l(ss, 2, lane); ss += shfl_xor_l(ss, 4, lane);
    const float rs = rsqrt_f(ss * (1.0f / HD) + EPS);
    u32x4 r0, r1;
    r0.x = pk2(o0[0] * rs * w0[0] * silu_f(bflo(g0.x)), o0[1] * rs * w0[1] * silu_f(bfhi(g0.x))); r0.y = pk2(o0[2] * rs * w0[2] * silu_f(bflo(g0.y)), o0[3] * rs * w0[3] * silu_f(bfhi(g0.y)));
    r0.z = pk2(o1[0] * rs * w1[0] * silu_f(bflo(g0.z)), o1[1] * rs * w1[1] * silu_f(bfhi(g0.z))); r0.w = pk2(o1[2] * rs * w1[2] * silu_f(bflo(g0.w)), o1[3] * rs * w1[3] * silu_f(bfhi(g0.w)));
    r1.x = pk2(o2[0] * rs * w2[0] * silu_f(bflo(g1.x)), o2[1] * rs * w2[1] * silu_f(bfhi(g1.x))); r1.y = pk2(o2[2] * rs * w2[2] * silu_f(bflo(g1.y)), o2[3] * rs * w2[3] * silu_f(bfhi(g1.y)));
    r1.z = pk2(o3[0] * rs * w3[0] * silu_f(bflo(g1.z)), o3[1] * rs * w3[1] * silu_f(bfhi(g1.z))); r1.w = pk2(o3[2] * rs * w3[2] * silu_f(bflo(g1.w)), o3[3] * rs * w3[3] * silu_f(bfhi(g1.w)));
    u32x4* dst = (u32x4*)(ymix + (size_t)t * D + DLRU + c); dst[0] = r0; dst[1] = r1;
}
__device__ __forceinline__ void route_row(const float* x, const float* rstd, const float* gain, const float* router, float* roww, int row, int lane) {
    float acc[8];
#pragma unroll
    for (int e = 0; e < 8; ++e) acc[e] = 0.f;
    for (int j = 0; j < 32; ++j) { const int k = lane + 64 * j; const float xv = x[(size_t)row * D + k] * gain[k]; const f32x4 r0 = *(const f32x4*)(router + (size_t)k * 8), r1 = *(const f32x4*)(router + (size_t)k * 8 + 4);
        acc[0] += xv * r0[0]; acc[1] += xv * r0[1]; acc[2] += xv * r0[2]; acc[3] += xv * r0[3]; acc[4] += xv * r1[0]; acc[5] += xv * r1[1]; acc[6] += xv * r1[2]; acc[7] += xv * r1[3]; }
    const float rs = rstd[row];
#pragma unroll
    for (int e = 0; e < 8; ++e) acc[e] = wave_sum(acc[e], lane) * rs;
    int e1 = 0; float l1 = acc[0];
#pragma unroll
    for (int e = 1; e < 8; ++e) if (acc[e] > l1) { l1 = acc[e]; e1 = e; }
    int e2 = -1; float l2 = -3.4e38f;
#pragma unroll
    for (int e = 0; e < 8; ++e) if (e != e1 && acc[e] > l2) { l2 = acc[e]; e2 = e; }
    const float w1 = 1.0f / (1.0f + __expf(l2 - l1)), w2 = 1.0f - w1;
    if (lane < 8) roww[(size_t)lane * T + row] = lane == e1 ? w1 : (lane == e2 ? w2 : 0.0f);
}
__device__ __forceinline__ void final_row(const float* x, const float* gain, float* out, int row, int lane) {
    const f32x4* xr = (const f32x4*)(x + (size_t)row * D) + lane; const f32x4* gr = (const f32x4*)gain + lane;
    f32x4 v[8]; float ss = 0.f;
#pragma unroll
    for (int j = 0; j < 8; ++j) { v[j] = xr[64 * j]; ss += (v[j][0] * v[j][0] + v[j][1] * v[j][1]) + (v[j][2] * v[j][2] + v[j][3] * v[j][3]); }
    ss = wave_sum(ss, lane); const float rs = rsqrt_f(ss * (1.0f / D) + EPS);
    f32x4* o = (f32x4*)(out + (size_t)row * D) + lane;
#pragma unroll
    for (int j = 0; j < 8; ++j) o[64 * j] = v[j] * rs * gr[64 * j];
}

struct MoeOrder {
    const int* list; int nN, G, c; int c0, c1, c2, c3, c4, c5, c6, c7;
    __device__ __forceinline__ void init(const unsigned* cnt, const int* list_, int nN_, int G_, int c_) { list = list_; nN = nN_; G = G_; c = c_;
        c0 = __builtin_amdgcn_readfirstlane((int)cnt[0]); c1 = __builtin_amdgcn_readfirstlane((int)cnt[1]); c2 = __builtin_amdgcn_readfirstlane((int)cnt[2]); c3 = __builtin_amdgcn_readfirstlane((int)cnt[3]);
        c4 = __builtin_amdgcn_readfirstlane((int)cnt[4]); c5 = __builtin_amdgcn_readfirstlane((int)cnt[5]); c6 = __builtin_amdgcn_readfirstlane((int)cnt[6]); c7 = __builtin_amdgcn_readfirstlane((int)cnt[7]); }
    __device__ __forceinline__ bool next(int i, pg8::Unit& u) const {
        const int c8[8] = {c0, c1, c2, c3, c4, c5, c6, c7}; int nM = 0;
#pragma unroll
        for (int k = 0; k < 8; ++k) nM += (c8[k] + 255) >> 8;
        const int nwg = nM * nN; const long L = (long)i * G + c; if (L >= nwg) return false;
        int wgid = (int)L; { const int q = nwg / pg8::NXCD, r = nwg % pg8::NXCD, xcd = wgid % pg8::NXCD, off = wgid / pg8::NXCD; wgid = (xcd < r ? xcd * (q + 1) : r * (q + 1) + (xcd - r) * q) + off; }
        const int nig = pg8::WGM * nN, gid = wgid / nig, fm = gid * pg8::WGM, gsz = (nM - fm) < pg8::WGM ? (nM - fm) : pg8::WGM;
        u.pm = fm + ((wgid % nig) % gsz); u.pn = (wgid % nig) / gsz;
        int e = 0, ps = 0, ce = c8[0], run = 0;
#pragma unroll
        for (int k = 0; k < 8; ++k) { const int mk = (c8[k] + 255) >> 8; if (u.pm >= run && u.pm < run + mk) { e = k; ps = run; ce = c8[k]; } run += mk; }
        const int mtl = u.pm - ps; u.pb = e * nN + u.pn; u.lbase = e * T + mtl * 256; u.nvalid = (ce - mtl * 256) < 256 ? (ce - mtl * 256) : 256;
        return true;
    }
    __device__ __forceinline__ int arow(const pg8::Unit& u, int r) const { return r < u.nvalid ? (list[u.lbase + r] & 0xffff) : 0; }
    __device__ __forceinline__ void a_ready(const pg8::Unit&) const {}
    __device__ __forceinline__ void done(const pg8::Unit&) const {}
};
__device__ __forceinline__ void route_block(const float* x, const float* gain, const float* router, bf16* xb, float* rstd, unsigned* cnt, int* list, float* listw, int blk, LAS unsigned char* lds, int tid, int lane, int wave) {
    asm volatile("" : "+v"(lds));
    LAS float* grt = (LAS float*)lds; LAS int* se1 = (LAS int*)(lds + 65536); LAS int* se2 = se1 + 64; LAS float* sw1 = (LAS float*)(se2 + 64); LAS float* sw2 = sw1 + 64; LAS int* lcnt = (LAS int*)(sw2 + 64); LAS int* gbase = lcnt + 8;
    for (int i = tid; i < D * 8; i += 512) grt[i] = router[i] * gain[i >> 3];
    if (tid < 8) lcnt[tid] = 0;
    __syncthreads();
    for (int q = 0; q < 8; ++q) { const int rloc = wave * 8 + q, row = blk * 64 + rloc;
        const f32x4* xr = (const f32x4*)(x + (size_t)row * D) + lane;
        f32x4 v[8]; float ss = 0.f;
#pragma unroll
        for (int j = 0; j < 8; ++j) { v[j] = xr[64 * j]; ss += (v[j][0] * v[j][0] + v[j][1] * v[j][1]) + (v[j][2] * v[j][2] + v[j][3] * v[j][3]); }
        ss = wave_sum(ss, lane); const float rs = rsqrt_f(ss * (1.0f / D) + EPS);
        u32x2* o = (u32x2*)(xb + (size_t)row * D) + lane;
#pragma unroll
        for (int j = 0; j < 8; ++j) { u32x2 w; w.x = pk2(v[j][0], v[j][1]); w.y = pk2(v[j][2], v[j][3]); o[64 * j] = w; }
        if (lane == 0) rstd[row] = rs;
        float acc[8];
#pragma unroll
        for (int e = 0; e < 8; ++e) acc[e] = 0.f;
#pragma unroll
        for (int j = 0; j < 8; ++j)
#pragma unroll
            for (int c = 0; c < 4; ++c) { const int k = (lane + 64 * j) * 4 + c; const f32x4 r0 = *(const LAS f32x4*)(grt + k * 8), r1 = *(const LAS f32x4*)(grt + k * 8 + 4); const float xv = v[j][c];
                acc[0] += xv * r0[0]; acc[1] += xv * r0[1]; acc[2] += xv * r0[2]; acc[3] += xv * r0[3]; acc[4] += xv * r1[0]; acc[5] += xv * r1[1]; acc[6] += xv * r1[2]; acc[7] += xv * r1[3]; }
#pragma unroll
        for (int e = 0; e < 8; ++e) acc[e] = wave_sum(acc[e], lane) * rs;
        int e1 = 0; float l1 = acc[0];
#pragma unroll
        for (int e = 1; e < 8; ++e) if (acc[e] > l1) { l1 = acc[e]; e1 = e; }
        int e2 = -1; float l2 = -3.4e38f;
#pragma unroll
        for (int e = 0; e < 8; ++e) if (e != e1 && acc[e] > l2) { l2 = acc[e]; e2 = e; }
        const float w1 = 1.0f / (1.0f + __expf(l2 - l1));
        if (lane == 0) { se1[rloc] = e1; se2[rloc] = e2; sw1[rloc] = w1; sw2[rloc] = 1.0f - w1; }
    }
    __syncthreads();
    int e = 0, lr = 0; float w = 0.f;
    if (tid < 128) { const int rloc = tid >> 1, j = tid & 1; e = j ? se2[rloc] : se1[rloc]; w = j ? sw2[rloc] : sw1[rloc]; lr = __hip_atomic_fetch_add(lcnt + e, 1, __ATOMIC_RELAXED, __HIP_MEMORY_SCOPE_WORKGROUP); }
    __syncthreads();
    if (tid < 8) gbase[tid] = (int)__hip_atomic_fetch_add(cnt + tid, (unsigned)lcnt[tid], __ATOMIC_RELAXED, __HIP_MEMORY_SCOPE_AGENT);
    __syncthreads();
    if (tid < 128) { const int pos = gbase[e] + lr, tok = blk * 64 + (tid >> 1); list[e * T + pos] = tok | ((tid & 1) << 16); listw[e * T + pos] = w; }
    __syncthreads();
}
__device__ __forceinline__ void final_row_moe(const float* x, const bf16* y0, const bf16* y1, const float* gain, float* out, int row, int lane) {
    const f32x4* xr = (const f32x4*)(x + (size_t)row * D) + lane; const f32x4* gr = (const f32x4*)gain + lane;
    const u32x2* p0 = (const u32x2*)(y0 + (size_t)row * D) + lane; const u32x2* p1 = (const u32x2*)(y1 + (size_t)row * D) + lane;
    f32x4 v[8]; float ss = 0.f;
#pragma unroll
    for (int j = 0; j < 8; ++j) { v[j] = xr[64 * j]; const u32x2 a = p0[64 * j], b = p1[64 * j];
        v[j][0] += bflo(a.x) + bflo(b.x); v[j][1] += bfhi(a.x) + bfhi(b.x); v[j][2] += bflo(a.y) + bflo(b.y); v[j][3] += bfhi(a.y) + bfhi(b.y);
        ss += (v[j][0] * v[j][0] + v[j][1] * v[j][1]) + (v[j][2] * v[j][2] + v[j][3] * v[j][3]); }
    ss = wave_sum(ss, lane); const float rs = rsqrt_f(ss * (1.0f / D) + EPS);
    f32x4* o = (f32x4*)(out + (size_t)row * D) + lane;
#pragma unroll
    for (int j = 0; j < 8; ++j) o[64 * j] = v[j] * rs * gr[64 * j];
}
__device__ __forceinline__ void ba_tail(const bf16* xbp, const bf16* wbab, const float* ssq, int mode, float* bap, int rb, int wave, int lane) {
    if (wave < 4) { const int fr = lane & 15, fq = lane >> 4, r0 = rb * 64 + wave * 16;
        const bf16* ap = xbp + (size_t)(r0 + fr) * D + fq * 8; const bf16* bp = wbab + (size_t)fr * D + fq * 8;
        f32x4 acc = {0.f, 0.f, 0.f, 0.f};
#pragma unroll 16
        for (int ks = 0; ks < 64; ++ks) { const bf16x8 a = *(const bf16x8*)(ap + ks * 32), b = *(const bf16x8*)(bp + ks * 32); acc = mfma16(a, b, acc); }
#pragma unroll
        for (int rr = 0; rr < 4; ++rr) { const int r = r0 + fq * 4 + rr; bap[(size_t)r * 16 + fr] = acc[rr] * pg8::row_scale(ssq, r, mode); } }
}
struct Args { const float* in[25]; float* out; unsigned char* ws; int ph_lo, ph_hi; };
typedef const __attribute__((address_space(4))) unsigned long long* kaptr_t;
__device__ __forceinline__ unsigned long long ldka(int i) { kaptr_t ka = (kaptr_t)__builtin_amdgcn_kernarg_segment_ptr(); asm volatile("" : "+s"(i)); return ka[i]; }
__device__ __forceinline__ const float* ldin(const Args&, int i) { return (const float*)(const GAS float*)ldka(i); }
__device__ __forceinline__ unsigned char* ldws(const Args&) { return (unsigned char*)(GAS unsigned char*)ldka(26); }
__device__ __forceinline__ float* ldout(const Args&) { return (float*)(GAS float*)ldka(25); }
__global__ void __launch_bounds__(512, 2) mega(Args args) {
    extern __shared__ __attribute__((aligned(16))) unsigned char lds_raw[];
    LAS unsigned char* lds = (LAS unsigned char*)lds_raw;
    volatile LAS unsigned* MISC = (volatile LAS unsigned*)(lds + MISC_OFF);
    const int tid = threadIdx.x;
    const int G = gridDim.x, bid = blockIdx.x, NGW = G * 8;
    unsigned char* ws = ldws(args);
    for (int u = tid; u < (LDS_BYTES - LDSCTL_OFF) / 4; u += 512) ((LAS unsigned*)(lds + LDSCTL_OFF))[u] = 0u;
    __syncthreads();
    (void)xcd_barrier_post((unsigned*)(ws + WS_CTL) + CW_BAR, MISC + 8);
#define RUN(id) true
#if defined(PROBE_MASK)
#define STAMP() do { if (threadIdx.x == 0) { ((volatile LAS unsigned long long*)(lds + LDSCTL_OFF + 1024))[nst] = __builtin_amdgcn_s_memrealtime(); } ++nst; } while (0)
#else
#define STAMP() do { } while (0)
#endif
#define SEAM(id) do { XcdBarrier bar_; bar_.bar = (unsigned*)WSP(WS_CTL) + CW_BAR; bar_.x = xb_xcc_id(); bar_.st = (volatile LAS unsigned*)(lds + MISC_OFF) + 8; xcd_barrier(bar_); STAMP(); } while (0)
#if defined(PROBE_MASK)
    int nst = 0; STAMP();
#endif
#define INP(i) ldin(args, (i))
#define WSP(off) (ldws(args) + (off))
#define x_in INP(0)
#define norm_mix INP(1)
#define w_in INP(2)
#define conv_lru_w INP(3)
#define conv_lru_b INP(4)
#define lru_w_r INP(5)
#define lru_b_r INP(6)
#define lru_w_i INP(7)
#define lru_b_i INP(8)
#define lru_lambda INP(9)
#define lru_out_norm INP(10)
#define conv_qkv_w INP(11)
#define dn_a_log INP(12)
#define dn_dt_bias INP(13)
#define dn_out_norm INP(14)
#define w_out INP(15)
#define norm_ffn INP(16)
#define ffn_w_gate INP(17)
#define ffn_w_up INP(18)
#define ffn_w_down INP(19)
#define moe_router INP(20)
#define moe_w_gate INP(21)
#define moe_w_up INP(22)
#define moe_w_down INP(23)
#define norm_final INP(24)
#define xres (ldout(args))
#define Win ((bf16*)WSP(WS_WIN))
#define Wba ((float*)WSP(WS_WBA))
#define Wout ((bf16*)WSP(WS_WOUT))
#define Wgu ((bf16*)WSP(WS_WGU))
#define Wd ((bf16*)WSP(WS_WD))
#define Mgu ((bf16*)WSP(WS_C))
#define Md ((bf16*)WSP(WS_WGU))
#define MCNT ((unsigned*)WSP(WS_CTL) + CW_CNT)
#define MLIST ((int*)WSP(WS_ROWW))
#define MLISTW ((float*)WSP(WS_ROWW + (size_t)8 * T * 4))
#define YP0 ((bf16*)WSP(WS_XB))
#define YP1 ((bf16*)WSP(WS_YMIX))
#define xb ((bf16*)WSP(WS_XB))
#define rstd ((float*)WSP(WS_RSTD))
#define SSQA ((float*)WSP(WS_RSTD + (size_t)1 * MiB))
#define SSQB ((float*)WSP(WS_RSTD + (size_t)3 * MiB))
#define WBAB ((bf16*)WSP(WS_WBA + (size_t)2 * 16 * D * 4))
#define ba ((float*)WSP(WS_BA))
#define beta ((float*)WSP(WS_BETA))
#define gg ((float*)WSP(WS_G))
#define roww ((float*)WSP(WS_ROWW))
#define proj ((bf16*)WSP(WS_PROJ))
#define hid ((bf16*)WSP(WS_PROJ))
#define ymix ((bf16*)WSP(WS_YMIX))
#define c0 ((float*)WSP(WS_C))
#define c1 ((float*)WSP(WS_C + (size_t)T * 1024 * 4))
#define c2 ((float*)WSP(WS_C + (size_t)2 * T * 1024 * 4))
#define c3 ((float*)WSP(WS_C + (size_t)3 * T * 1024 * 4))
#define LRU_WRT ((bf16*)WSP(WS_WRT))
#define LRU_WIT ((bf16*)WSP(WS_WRT + (size_t)2 * 8 * 128 * 128 * 2))
#define LRU_H ((float*)WSP(WS_C + (size_t)256 * MiB))
#define LRU_A ((float*)WSP(WS_C + (size_t)320 * MiB))
#define LRU_SUMM ((float*)WSP(WS_C + (size_t)384 * MiB))
#define LRU_CARRY ((float*)WSP(WS_C + (size_t)386 * MiB))
#define DN_WF ((bf16*)WSP(WS_C))
#define DN_QF ((bf16*)WSP(WS_C + (size_t)32 * MiB))
#define DN_KDTF ((bf16*)WSP(WS_C + (size_t)64 * MiB))
#define DN_UF ((bf16*)WSP(WS_C + (size_t)96 * MiB))
#define DN_QKF ((bf16*)WSP(WS_C + (size_t)128 * MiB))
#define DN_GL ((float*)WSP(WS_C + (size_t)144 * MiB))
    const int BIG = 1 << 30;
#define PHL int tid_ = threadIdx.x; asm volatile("" : "+v"(tid_)); const int lane_ = tid_ & 63; int bid_ = blockIdx.x; asm volatile("" : "+s"(bid_)); const int gw_ = bid_ * 8 + __builtin_amdgcn_readfirstlane(tid_ >> 6); const size_t gt_ = (size_t)bid_ * 512 + tid_, NGT = (size_t)G * 512; LAS float* scr = (LAS float*)(lds + (gw_ & 7) * 16384);
    if (RUN(ph)) { PHL
        convert_matrix(w_in, DIN, 0, D, NPROJ, norm_mix, Win, BIG, 0, 0, scr, gw_, NGW, lane_);
        convert_matrix(w_out, D, 0, D, D, nullptr, Wout, BIG, 0, 0, scr, gw_, NGW, lane_);
        for (size_t i = gt_; i < (size_t)2 * 16 * D; i += NGT) { const int l = (int)(i / (16 * D)), j = (int)((i / D) & 15), k = (int)(i % D); WBAB[i] = (bf16)f2bf(w_in[(size_t)l * D * DIN + (size_t)k * DIN + NPROJ + j] * norm_mix[l * D + k]); }
        for (int r = gw_; r < T; r += NGW) rowprep_row(x_in, xb, rstd, nullptr, nullptr, r, lane_);
        for (int m = 0; m < 16; ++m) {
            convert_matrix(lru_w_r + (size_t)m * 128 * 128, 128, 0, 128, 128, nullptr, LRU_WRT + (size_t)m * 128 * 128, BIG, 0, 0, scr, gw_, NGW, lane_);
            convert_matrix(lru_w_i + (size_t)m * 128 * 128, 128, 0, 128, 128, nullptr, LRU_WIT + (size_t)m * 128 * 128, BIG, 0, 0, scr, gw_, NGW, lane_); }
    }
    SEAM(ph);
    int xsel = 0;
#define xcur (xsel ? (const float*)xres : x_in)
    { constexpr int l = 0;
        if (RUN(ph)) { pg8::Gemm g{xb, Win + (size_t)l * NPROJ * D, T, NPROJ, D, 0}; pg8::StaticOrder S; S.init(T, NPROJ, G, bid); pg8::EpiScaleBf16 E{proj, l == 0 ? rstd : SSQB, NPROJ, l};
            pg8::gemm_phase<pg8::EpiScaleBf16, pg8::StaticOrder, true, false>(lds, g, S, E);
            { PHL for (int rb = bid_; rb < T / 64; rb += G) ba_tail(xb, WBAB + (size_t)l * 16 * D, l == 0 ? rstd : SSQB, l, ba, rb, gw_ & 7, lane_); } }
        SEAM(ph);
        if (RUN(ph)) { PHL
            for (int u = bid_; u < 2048; u += G) lrua_unit(proj, conv_lru_w + (size_t)l * 4 * DLRU, conv_lru_b + l * DLRU, LRU_WRT + (size_t)l * 8 * 128 * 128, LRU_WIT + (size_t)l * 8 * 128 * 128, lru_b_r + l * DLRU, lru_b_i + l * DLRU, lru_lambda + l * DLRU, LRU_H, LRU_A, LRU_SUMM, u, lds, tid_, lane_, gw_ & 7);
            STAMP();
            for (int uid = bid_; uid < 2048; uid += G) dna_unit(proj, conv_qkv_w + (size_t)l * 4 * 3 * DDN, ba, dn_a_log + l * NH, dn_dt_bias + l * NH, DN_WF, DN_QF, DN_KDTF, DN_QKF, DN_UF, DN_GL, uid, lds, tid_, lane_, gw_ & 7); }
        SEAM(ph);
        if (RUN(ph)) { PHL
            if (bid_ < 128) dnb_run(DN_WF, DN_QF, DN_KDTF, DN_QKF, DN_UF, DN_GL, c3, (bid_ & 7) + 8 * (bid_ >> 6), (bid_ >> 3) & 7, lds, tid_, lane_, gw_ & 7);
            else if (bid_ < 136) { if (tid_ < 256) lru_carry(LRU_SUMM, LRU_CARRY, (bid_ - 128) * 256 + tid_); }
            else { const int cw = gw_ - 136 * 8, CNW = NGW - 136 * 8;
                if (l == 0) {
                    convert_matrix(w_in + (size_t)D * DIN, DIN, 0, D, NPROJ, norm_mix + D, Win + (size_t)NPROJ * D, BIG, 0, 0, scr, cw, CNW, lane_);
                    convert_matrix(w_out + (size_t)D * D, D, 0, D, D, nullptr, Wout + (size_t)D * D, BIG, 0, 0, scr, cw, CNW, lane_);
                    convert_matrix(ffn_w_gate, DFF, 0, D, DFF, norm_ffn, Wgu, 128, 256, 0, scr, cw, CNW, lane_);
                    convert_matrix(ffn_w_up, DFF, 0, D, DFF, norm_ffn, Wgu, 128, 256, 128, scr, cw, CNW, lane_);
                    convert_matrix(ffn_w_down, D, 0, DFF, D, nullptr, Wd, BIG, 0, 0, scr, cw, CNW, lane_);
                } else {
                    for (int e = 0; e < NEXP; ++e) convert_matrix(moe_w_down + (size_t)e * DFFE * D, D, 0, DFFE, D, nullptr, Md + (size_t)e * D * DFFE, BIG, 0, 0, scr, cw, CNW, lane_);
                } } }
        SEAM(ph);
        if (RUN(ph)) { PHL
            for (int r = gw_; r < T; r += NGW) lrub_row(LRU_H, LRU_A, LRU_CARRY, proj, lru_out_norm + l * DLRU, ymix, r, lane_);
            for (int r = gw_; r < T; r += NGW) dn_out_row(c3, dn_out_norm + l * HD, proj, ymix, r, lane_); }
        SEAM(ph);
        if (RUN(ph)) { if (l == 0) { pg8::Gemm g{ymix, Wout, T, D, D, 0}; pg8::StaticOrder S; S.init(T, D, G, bid); pg8::EpiResidualNorm E{xcur, xres, xb, SSQA, D, 0};
            pg8::gemm_phase<pg8::EpiResidualNorm, pg8::StaticOrder, true, false>(lds, g, S, E); }
          else { pg8::Gemm g{ymix, Wout + (size_t)D * D, T, D, D, 0}; pg8::StaticOrder S; S.init(T, D, G, bid); pg8::EpiResidual E{xcur, xres, nullptr, D, 0};
            pg8::gemm_phase<pg8::EpiResidual, pg8::StaticOrder, true, false>(lds, g, S, E); }
            if (l == 1) { PHL
                for (int e = 0; e < NEXP; ++e) {
                    convert_matrix(moe_w_gate + (size_t)e * D * DFFE, DFFE, 0, D, DFFE, norm_ffn + D, Mgu + (size_t)e * 2 * DFFE * D, 128, 256, 0, scr, gw_, NGW, lane_);
                    convert_matrix(moe_w_up + (size_t)e * D * DFFE, DFFE, 0, D, DFFE, norm_ffn + D, Mgu + (size_t)e * 2 * DFFE * D, 128, 256, 128, scr, gw_, NGW, lane_);
 } } }
        SEAM(ph);
        xsel = 1;
        if (l == 0) {
            if (RUN(ph)) { pg8::Gemm g{xb, Wgu, T, 2 * DFF, D, 0}; pg8::StaticOrder S; S.init(T, 2 * DFF, G, bid); pg8::EpiSwiGLU E{hid, SSQA, DFF, 1};
                pg8::gemm_phase<pg8::EpiSwiGLU, pg8::StaticOrder, true, false>(lds, g, S, E); }
            SEAM(ph);
            if (RUN(ph)) { pg8::Gemm g{hid, Wd, T, D, DFF, 0}; pg8::StaticOrder S; S.init(T, D, G, bid); pg8::EpiResidualNorm E{xcur, xres, xb, SSQB, D, 0};
                pg8::gemm_phase<pg8::EpiResidualNorm, pg8::StaticOrder, true, false>(lds, g, S, E); }
            SEAM(ph);
        } else {
            if (RUN(ph)) { PHL for (int blk = bid_; blk < T / 64; blk += G) route_block(xcur, norm_ffn + D, moe_router, xb, rstd, MCNT, MLIST, MLISTW, blk, lds, tid_, lane_, gw_ & 7); }
            SEAM(ph);
            if (RUN(ph)) { pg8::Gemm g{xb, Mgu, NSLOT, 2 * DFFE, D, 0}; MoeOrder S; S.init(MCNT, MLIST, 2 * DFFE / 256, G, bid); pg8::EpiSwiGLUMoe E{hid, rstd, MLIST, DFFE, 0};
                pg8::gemm_phase<pg8::EpiSwiGLUMoe, MoeOrder, true, true>(lds, g, S, E); }
            SEAM(ph);
            if (RUN(ph)) { pg8::Gemm g{hid, Md, NSLOT, D, DFFE, 0}; MoeOrder S; S.init(MCNT, MLIST, D / 256, G, bid); pg8::EpiMoeDown E{YP0, YP1, MLIST, MLISTW, D, 0};
                pg8::gemm_phase<pg8::EpiMoeDown, MoeOrder, true, false>(lds, g, S, E); }
            SEAM(ph);
        }
    }
    { constexpr int l = 1;
        if (RUN(ph)) { pg8::Gemm g{xb, Win + (size_t)l * NPROJ * D, T, NPROJ, D, 0}; pg8::StaticOrder S; S.init(T, NPROJ, G, bid); pg8::EpiScaleBf16 E{proj, l == 0 ? rstd : SSQB, NPROJ, l};
            pg8::gemm_phase<pg8::EpiScaleBf16, pg8::StaticOrder, true, false>(lds, g, S, E);
            { PHL for (int rb = bid_; rb < T / 64; rb += G) ba_tail(xb, WBAB + (size_t)l * 16 * D, l == 0 ? rstd : SSQB, l, ba, rb, gw_ & 7, lane_); } }
        SEAM(ph);
        if (RUN(ph)) { PHL
            for (int u = bid_; u < 2048; u += G) lrua_unit(proj, conv_lru_w + (size_t)l * 4 * DLRU, conv_lru_b + l * DLRU, LRU_WRT + (size_t)l * 8 * 128 * 128, LRU_WIT + (size_t)l * 8 * 128 * 128, lru_b_r + l * DLRU, lru_b_i + l * DLRU, lru_lambda + l * DLRU, LRU_H, LRU_A, LRU_SUMM, u, lds, tid_, lane_, gw_ & 7);
            STAMP();
            for (int uid = bid_; uid < 2048; uid += G) dna_unit(proj, conv_qkv_w + (size_t)l * 4 * 3 * DDN, ba, dn_a_log + l * NH, dn_dt_bias + l * NH, DN_WF, DN_QF, DN_KDTF, DN_QKF, DN_UF, DN_GL, uid, lds, tid_, lane_, gw_ & 7); }
        SEAM(ph);
        if (RUN(ph)) { PHL
            if (bid_ < 128) dnb_run(DN_WF, DN_QF, DN_KDTF, DN_QKF, DN_UF, DN_GL, c3, (bid_ & 7) + 8 * (bid_ >> 6), (bid_ >> 3) & 7, lds, tid_, lane_, gw_ & 7);
            else if (bid_ < 136) { if (tid_ < 256) lru_carry(LRU_SUMM, LRU_CARRY, (bid_ - 128) * 256 + tid_); }
            else { const int cw = gw_ - 136 * 8, CNW = NGW - 136 * 8;
                if (l == 0) {
                    convert_matrix(w_in + (size_t)D * DIN, DIN, 0, D, NPROJ, norm_mix + D, Win + (size_t)NPROJ * D, BIG, 0, 0, scr, cw, CNW, lane_);
                    convert_matrix(w_out + (size_t)D * D, D, 0, D, D, nullptr, Wout + (size_t)D * D, BIG, 0, 0, scr, cw, CNW, lane_);
                    convert_matrix(ffn_w_gate, DFF, 0, D, DFF, norm_ffn, Wgu, 128, 256, 0, scr, cw, CNW, lane_);
                    convert_matrix(ffn_w_up, DFF, 0, D, DFF, norm_ffn, Wgu, 128, 256, 128, scr, cw, CNW, lane_);
                    convert_matrix(ffn_w_down, D, 0, DFF, D, nullptr, Wd, BIG, 0, 0, scr, cw, CNW, lane_);
                } else {
                    for (int e = 0; e < NEXP; ++e) convert_matrix(moe_w_down + (size_t)e * DFFE * D, D, 0, DFFE, D, nullptr, Md + (size_t)e * D * DFFE, BIG, 0, 0, scr, cw, CNW, lane_);
                } } }
        SEAM(ph);
        if (RUN(ph)) { PHL
            for (int r = gw_; r < T; r += NGW) lrub_row(LRU_H, LRU_A, LRU_CARRY, proj, lru_out_norm + l * DLRU, ymix, r, lane_);
            for (int r = gw_; r < T; r += NGW) dn_out_row(c3, dn_out_norm + l * HD, proj, ymix, r, lane_); }
        SEAM(ph);
        if (RUN(ph)) { if (l == 0) { pg8::Gemm g{ymix, Wout, T, D, D, 0}; pg8::StaticOrder S; S.init(T, D, G, bid); pg8::EpiResidualNorm E{xcur, xres, xb, SSQA, D, 0};
            pg8::gemm_phase<pg8::EpiResidualNorm, pg8::StaticOrder, true, false>(lds, g, S, E); }
          else { pg8::Gemm g{ymix, Wout + (size_t)D * D, T, D, D, 0}; pg8::StaticOrder S; S.init(T, D, G, bid); pg8::EpiResidual E{xcur, xres, nullptr, D, 0};
            pg8::gemm_phase<pg8::EpiResidual, pg8::StaticOrder, true, false>(lds, g, S, E); }
            if (l == 1) { PHL
                for (int e = 0; e < NEXP; ++e) {
                    convert_matrix(moe_w_gate + (size_t)e * D * DFFE, DFFE, 0, D, DFFE, norm_ffn + D, Mgu + (size_t)e * 2 * DFFE * D, 128, 256, 0, scr, gw_, NGW, lane_);
                    convert_matrix(moe_w_up + (size_t)e * D * DFFE, DFFE, 0, D, DFFE, norm_ffn + D, Mgu + (size_t)e * 2 * DFFE * D, 128, 256, 128, scr, gw_, NGW, lane_);
 } } }
        SEAM(ph);
        xsel = 1;
        if (l == 0) {
            if (RUN(ph)) { pg8::Gemm g{xb, Wgu, T, 2 * DFF, D, 0}; pg8::StaticOrder S; S.init(T, 2 * DFF, G, bid); pg8::EpiSwiGLU E{hid, SSQA, DFF, 1};
                pg8::gemm_phase<pg8::EpiSwiGLU, pg8::StaticOrder, true, false>(lds, g, S, E); }
            SEAM(ph);
            if (RUN(ph)) { pg8::Gemm g{hid, Wd, T, D, DFF, 0}; pg8::StaticOrder S; S.init(T, D, G, bid); pg8::EpiResidualNorm E{xcur, xres, xb, SSQB, D, 0};
                pg8::gemm_phase<pg8::EpiResidualNorm, pg8::StaticOrder, true, false>(lds, g, S, E); }
            SEAM(ph);
        } else {
            if (RUN(ph)) { PHL for (int blk = bid_; blk < T / 64; blk += G) route_block(xcur, norm_ffn + D, moe_router, xb, rstd, MCNT, MLIST, MLISTW, blk, lds, tid_, lane_, gw_ & 7); }
            SEAM(ph);
            if (RUN(ph)) { pg8::Gemm g{xb, Mgu, NSLOT, 2 * DFFE, D, 0}; MoeOrder S; S.init(MCNT, MLIST, 2 * DFFE / 256, G, bid); pg8::EpiSwiGLUMoe E{hid, rstd, MLIST, DFFE, 0};
                pg8::gemm_phase<pg8::EpiSwiGLUMoe, MoeOrder, true, true>(lds, g, S, E); }
            SEAM(ph);
            if (RUN(ph)) { pg8::Gemm g{hid, Md, NSLOT, D, DFFE, 0}; MoeOrder S; S.init(MCNT, MLIST, D / 256, G, bid); pg8::EpiMoeDown E{YP0, YP1, MLIST, MLISTW, D, 0};
                pg8::gemm_phase<pg8::EpiMoeDown, MoeOrder, true, false>(lds, g, S, E); }
            SEAM(ph);
        }
    }
    if (RUN(ph)) { PHL for (int r = gw_; r < T; r += NGW) final_row_moe(xcur, YP0, YP1, norm_final, xres, r, lane_); }
#if defined(PROBE_MASK)
    __syncthreads(); STAMP();
    if (blockIdx.x == 0 && threadIdx.x == 0) { asm volatile("s_waitcnt vmcnt(0)" ::: "memory"); volatile LAS unsigned long long* st = (volatile LAS unsigned long long*)(lds + LDSCTL_OFF + 1024); unsigned long long tot = 0;
        for (int k = 1; k < nst; ++k) if ((PROBE_MASK >> (k - 1)) & 1ull) tot += st[k] - st[k - 1];
        xres[0] = rintf((float)tot * 0.01f * PROBE_SCALE); }
#endif
#if defined(PROBE_DNA_A)
    __syncthreads();
    if (blockIdx.x == 0 && threadIdx.x == 0) { asm volatile("s_waitcnt vmcnt(0)" ::: "memory"); volatile LAS unsigned long long* st = (volatile LAS unsigned long long*)(lds + (RING_BYTES + 2048));
        xres[0] = rintf((float)(st[PROBE_DNA_B] - st[PROBE_DNA_A]) * 0.01f * PROBE_SCALE); }
#endif
#undef RUN
#undef SEAM
}

extern "C" void kernel_launch(void* const* d_in, const int* in_sizes, int n_in, void* d_out, int out_size, void* d_ws, size_t ws_size, hipStream_t stream) {
    static int grid = 0;
    if (grid == 0) {
        if (n_in != 25 || ws_size < WS_END) { fprintf(stderr, "kernel_launch: unexpected n_in %d / ws_size %zu (need %zu)\n", n_in, ws_size, (size_t)WS_END); grid = -1; return; }
        int dev = 0, cus = 0, per_cu = 0;
        if (hipGetDevice(&dev) != hipSuccess || hipDeviceGetAttribute(&cus, hipDeviceAttributeMultiprocessorCount, dev) != hipSuccess) { grid = -1; return; }
        if (hipFuncSetAttribute((const void*)mega, hipFuncAttributeMaxDynamicSharedMemorySize, LDS_BYTES) != hipSuccess) { fprintf(stderr, "kernel_launch: hipFuncSetAttribute failed\n"); grid = -1; return; }
        if (hipOccupancyMaxActiveBlocksPerMultiprocessor(&per_cu, (const void*)mega, 512, LDS_BYTES) != hipSuccess || per_cu < 1) { fprintf(stderr, "kernel_launch: occupancy query says %d\n", per_cu); }
        (void)hipGetLastError();
        grid = cus;
    }
    if (grid < 0) return;
    if (hipMemsetAsync((char*)d_ws + WS_CTL, 0, CTL_ZERO_BYTES, stream) != hipSuccess) return;
    Args a{};
    for (int i = 0; i < 25; ++i) a.in[i] = (const float*)d_in[i];
    a.out = (float*)d_out; a.ws = (unsigned char*)d_ws; a.ph_lo = 0; a.ph_hi = 1 << 30;
    hipLaunchKernelGGL(mega, dim3(grid), dim3(512), LDS_BYTES, stream, a);
}
```

```cpp
#include <hip/hip_runtime.h>
#include <cstdio>
#include <cstdint>
namespace pg8 {
#define PG8_LAS __attribute__((address_space(3)))
typedef unsigned short bf16_t;
typedef short bf16x8 __attribute__((ext_vector_type(8)));
typedef float f32x4 __attribute__((ext_vector_type(4)));
typedef unsigned u32x4 __attribute__((ext_vector_type(4)));
constexpr int BM = 256, BK = 64, HALF = 128, HTB = HALF * BK * 2  , STAGE_BYTES = 8 * HTB, NXCD = 8, WGM = 8;

__host__ __device__ __forceinline__ int lds_byte(int r, int c) { const int st = (r >> 4) * 2 + (c >> 5), rr = r & 15, cc = c & 31, ob = rr * 64 + cc * 2; return st * 1024 + (ob ^ (((ob >> 9) & 1) << 5)); }
__host__ __device__ __forceinline__ void stage_rc(int b, int& R, int& C) { const int st = b / 1024, sb = b % 1024, swz = sb ^ (((sb >> 9) & 1) << 5); R = (st >> 1) * 16 + swz / 64; C = (st & 1) * 32 + (swz % 64) / 2; }
__host__ __device__ __forceinline__ int perm32(int rho) { const int n = rho >> 4, i = rho & 15; return 8 * (i >> 2) + 4 * n + (i & 3); }

struct Unit { int pm, pn, pb, lbase, nvalid; };
struct Gemm { const bf16_t* A; const bf16_t* Bt; int M, N, K, pad; };

struct StaticOrder {
    int nM, nN, nwg, G, c;
    __host__ __device__ void init(int M, int N, int G_, int c_) { nM = M / BM; nN = N / BM; nwg = nM * nN; G = G_; c = c_; }
    __host__ __device__ bool next(int i, Unit& u) const {
        const long L = (long)i * G + c; if (L >= nwg) return false;
        int wgid = (int)L; { const int q = nwg / NXCD, r = nwg % NXCD, xcd = wgid % NXCD, off = wgid / NXCD; wgid = (xcd < r ? xcd * (q + 1) : r * (q + 1) + (xcd - r) * q) + off; }
        const int nig = WGM * nN, gid = wgid / nig, fm = gid * WGM, gsz = (nM - fm) < WGM ? (nM - fm) : WGM;
        u.pm = fm + ((wgid % nig) % gsz); u.pn = (wgid % nig) / gsz; u.pb = u.pn; u.lbase = 0; u.nvalid = BM; return true;
    }
    __device__ __forceinline__ int arow(const Unit&, int) const { return 0; }
    __device__ __forceinline__ void a_ready(const Unit&) const {}
    __device__ __forceinline__ void done(const Unit&) const {}
};


typedef float f32x2_t __attribute__((ext_vector_type(2)));
typedef __bf16 bf16x2_t __attribute__((ext_vector_type(2)));
__device__ __forceinline__ unsigned cvt_pk_bf16(float lo, float hi) { const f32x2_t v = {lo, hi}; const bf16x2_t b = __builtin_convertvector(v, bf16x2_t); return __builtin_bit_cast(unsigned, b); }
__device__ __forceinline__ float frcp(float x) { return __builtin_amdgcn_rcpf(x); }
__device__ __forceinline__ float rsqrt_f(float x) { return __builtin_amdgcn_rsqf(x); }
__device__ __forceinline__ float silu_f(float x) { return x * frcp(1.0f + __expf(-x)); }
__device__ __forceinline__ float swiglu_f(float g, float u, float k1, float s2) { return (g * u) * (s2 * frcp(1.0f + __builtin_amdgcn_exp2f(g * k1))); }
__device__ __forceinline__ float row_scale(const float* rs, int r, int mode) {
    if (!mode) return rs[r];
    const f32x4* p = (const f32x4*)(rs + (size_t)r * 32); float s = 0.f;
#pragma unroll
    for (int i = 0; i < 8; ++i) { const f32x4 v = p[i]; s += (v[0] + v[1]) + (v[2] + v[3]); }
    return rsqrt_f(s * (1.0f / 2048.0f) + 1e-6f);
}
__device__ __forceinline__ void row_scales8(const float* rs, int row0, int fr, int fq, int mode, float (&sc)[2][4]) {
    if (!mode) {
#pragma unroll
        for (int ai = 0; ai < 2; ++ai)
#pragma unroll
            for (int m = 0; m < 4; ++m) sc[ai][m] = rs[row0 + ai * HALF + m * 16];
    } else {
        const int lane = fr + 16 * fq; f32x4 pa[2][4][2];
#pragma unroll
        for (int ai = 0; ai < 2; ++ai)
#pragma unroll
            for (int m = 0; m < 4; ++m) { const f32x4* p = (const f32x4*)(rs + (size_t)(row0 + ai * HALF + m * 16) * 32 + fq * 8); pa[ai][m][0] = p[0]; pa[ai][m][1] = p[1]; }
#pragma unroll
        for (int ai = 0; ai < 2; ++ai)
#pragma unroll
            for (int m = 0; m < 4; ++m) { const f32x4 a = pa[ai][m][0], b = pa[ai][m][1]; float t = ((a[0] + a[1]) + (a[2] + a[3])) + ((b[0] + b[1]) + (b[2] + b[3]));
                t += __int_as_float(__builtin_amdgcn_ds_bpermute((lane ^ 16) << 2, __float_as_int(t)));
                t += __int_as_float(__builtin_amdgcn_ds_bpermute((lane ^ 32) << 2, __float_as_int(t)));
                sc[ai][m] = rsqrt_f(t * (1.0f / 2048.0f) + 1e-6f); }
    }
}
struct EpiScaleBf16 {
    static constexpr bool PERM = true, AFTER_DRAIN = false;
    bf16_t* O; const float* rs; int ldc; int pad;
    __device__ __forceinline__ void operator()(const f32x4 (&acc)[2][2][4][2], const Unit& u, int wr, int wc, int fr, int fq) const {
        const int row0 = u.pm * BM + wr * 64 + fr, col0 = u.pn * BM + wc * 32 + 8 * fq;
        float sc[2][4]; row_scales8(rs, row0, fr, fq, pad, sc);
#pragma unroll
        for (int ai = 0; ai < 2; ++ai)
#pragma unroll
            for (int m = 0; m < 4; ++m) { const int r = row0 + ai * HALF + m * 16; const float s = sc[ai][m]; bf16_t* rowp = O + (size_t)r * ldc + col0;
#pragma unroll
                for (int bj = 0; bj < 2; ++bj) { const f32x4 v0 = acc[ai][bj][m][0] * s, v1 = acc[ai][bj][m][1] * s;
                    u32x4 w; w.x = cvt_pk_bf16(v0[0], v0[1]); w.y = cvt_pk_bf16(v0[2], v0[3]); w.z = cvt_pk_bf16(v1[0], v1[1]); w.w = cvt_pk_bf16(v1[2], v1[3]);
                    *(u32x4*)(rowp + bj * HALF) = w; } }
    }
};
struct EpiSwiGLU {
    static constexpr bool PERM = true, AFTER_DRAIN = false;
    bf16_t* O; const float* rs; int ldc; int pad;
    __device__ __forceinline__ void operator()(const f32x4 (&acc)[2][2][4][2], const Unit& u, int wr, int wc, int fr, int fq) const {
        const int row0 = u.pm * BM + wr * 64 + fr, col0 = u.pn * HALF + wc * 32 + 8 * fq;
        float sc[2][4]; row_scales8(rs, row0, fr, fq, pad, sc);
#pragma unroll
        for (int ai = 0; ai < 2; ++ai)
#pragma unroll
            for (int m = 0; m < 4; ++m) { const int r = row0 + ai * HALF + m * 16; const float s = sc[ai][m], k1 = s * -1.4426950408889634f, s2 = s * s; bf16_t* rowp = O + (size_t)r * ldc + col0;
                f32x4 h0, h1;
#pragma unroll
                for (int j = 0; j < 4; ++j) { h0[j] = swiglu_f(acc[ai][0][m][0][j], acc[ai][1][m][0][j], k1, s2); h1[j] = swiglu_f(acc[ai][0][m][1][j], acc[ai][1][m][1][j], k1, s2); }
                u32x4 w; w.x = cvt_pk_bf16(h0[0], h0[1]); w.y = cvt_pk_bf16(h0[2], h0[3]); w.z = cvt_pk_bf16(h1[0], h1[1]); w.w = cvt_pk_bf16(h1[2], h1[3]);
                *(u32x4*)rowp = w; }
    }
};
struct EpiResidual {
    static constexpr bool PERM = false, AFTER_DRAIN = false;
    const float* base; float* out; const float* roww; int ldc; int pad;
    __device__ __forceinline__ void operator()(const f32x4 (&acc)[2][2][4][2], const Unit& u, int wr, int wc, int fr, int fq) const {
        const int row0 = u.pm * BM + wr * 64 + fr, col0 = u.pn * BM + wc * 32 + 4 * fq;
#pragma unroll
        for (int ai = 0; ai < 2; ++ai)
#pragma unroll
            for (int m = 0; m < 4; ++m) { const int r = row0 + ai * HALF + m * 16; const float w = roww ? roww[r] : 1.0f; const size_t off = (size_t)r * ldc + col0;
#pragma unroll
                for (int bj = 0; bj < 2; ++bj)
#pragma unroll
                    for (int n = 0; n < 2; ++n) { const f32x4 bs = *(const f32x4*)(base + off + bj * HALF + n * 16); *(f32x4*)(out + off + bj * HALF + n * 16) = bs + acc[ai][bj][m][n] * w; } }
    }
};

struct EpiSwiGLUMoe {
    static constexpr bool PERM = true, AFTER_DRAIN = false;
    bf16_t* O; const float* rs; const int* list; int ldc; int pad;
    __device__ __forceinline__ void operator()(const f32x4 (&acc)[2][2][4][2], const Unit& u, int wr, int wc, int fr, int fq) const {
        const int rl0 = wr * 64 + fr, col0 = u.pn * HALF + wc * 32 + 8 * fq;
#pragma unroll
        for (int ai = 0; ai < 2; ++ai)
#pragma unroll
            for (int m = 0; m < 4; ++m) { const int rl = rl0 + ai * HALF + m * 16; const int tok = rl < u.nvalid ? (list[u.lbase + rl] & 0xffff) : 0; const float s = rs[tok], k1 = s * -1.4426950408889634f, s2 = s * s;
                bf16_t* rowp = O + (size_t)(u.pm * BM + rl) * ldc + col0;
                f32x4 h0, h1;
#pragma unroll
                for (int j = 0; j < 4; ++j) { h0[j] = swiglu_f(acc[ai][0][m][0][j], acc[ai][1][m][0][j], k1, s2); h1[j] = swiglu_f(acc[ai][0][m][1][j], acc[ai][1][m][1][j], k1, s2); }
                u32x4 w; w.x = cvt_pk_bf16(h0[0], h0[1]); w.y = cvt_pk_bf16(h0[2], h0[3]); w.z = cvt_pk_bf16(h1[0], h1[1]); w.w = cvt_pk_bf16(h1[2], h1[3]);
                *(u32x4*)rowp = w; }
    }
};
struct EpiMoeDown {
    static constexpr bool PERM = true, AFTER_DRAIN = false;
    bf16_t* Y0; bf16_t* Y1; const int* list; const float* lw; int ldc; int pad;
    __device__ __forceinline__ void operator()(const f32x4 (&acc)[2][2][4][2], const Unit& u, int wr, int wc, int fr, int fq) const {
        const int rl0 = wr * 64 + fr, col0 = u.pn * BM + wc * 32 + 8 * fq;
#pragma unroll
        for (int ai = 0; ai < 2; ++ai)
#pragma unroll
            for (int m = 0; m < 4; ++m) { const int rl = rl0 + ai * HALF + m * 16;
                if (rl < u.nvalid) { const int en = list[u.lbase + rl]; const float w = lw[u.lbase + rl]; bf16_t* rowp = ((en >> 16) ? Y1 : Y0) + (size_t)(en & 0xffff) * ldc + col0;
#pragma unroll
                    for (int bj = 0; bj < 2; ++bj) { const f32x4 v0 = acc[ai][bj][m][0] * w, v1 = acc[ai][bj][m][1] * w;
                        u32x4 o; o.x = cvt_pk_bf16(v0[0], v0[1]); o.y = cvt_pk_bf16(v0[2], v0[3]); o.z = cvt_pk_bf16(v1[0], v1[1]); o.w = cvt_pk_bf16(v1[2], v1[3]);
                        *(u32x4*)(rowp + bj * HALF) = o; } } }
    }
};

struct EpiResidualNorm {
    static constexpr bool PERM = true, AFTER_DRAIN = false;
    const float* base; float* out; bf16_t* xb; float* ssq; int ldc; int pad;
    __device__ __forceinline__ void operator()(const f32x4 (&acc)[2][2][4][2], const Unit& u, int wr, int wc, int fr, int fq) const {
        const int row0 = u.pm * BM + wr * 64 + fr, col0 = u.pn * BM + wc * 32 + 8 * fq, lane = fr + 16 * fq;
#pragma unroll
        for (int ai = 0; ai < 2; ++ai)
#pragma unroll
            for (int m = 0; m < 4; ++m) { const int r = row0 + ai * HALF + m * 16; const size_t off = (size_t)r * ldc + col0; float part = 0.f;
#pragma unroll
                for (int bj = 0; bj < 2; ++bj) { const f32x4 b0 = *(const f32x4*)(base + off + bj * HALF), b1 = *(const f32x4*)(base + off + bj * HALF + 4);
                    const f32x4 v0 = b0 + acc[ai][bj][m][0], v1 = b1 + acc[ai][bj][m][1];
                    *(f32x4*)(out + off + bj * HALF) = v0; *(f32x4*)(out + off + bj * HALF + 4) = v1;
                    u32x4 w; w.x = cvt_pk_bf16(v0[0], v0[1]); w.y = cvt_pk_bf16(v0[2], v0[3]); w.z = cvt_pk_bf16(v1[0], v1[1]); w.w = cvt_pk_bf16(v1[2], v1[3]);
                    *(u32x4*)(xb + off + bj * HALF) = w;
                    part += (v0[0] * v0[0] + v0[1] * v0[1]) + (v0[2] * v0[2] + v0[3] * v0[3]) + (v1[0] * v1[0] + v1[1] * v1[1]) + (v1[2] * v1[2] + v1[3] * v1[3]); }
                part += __int_as_float(__builtin_amdgcn_ds_bpermute((lane ^ 16) << 2, __float_as_int(part)));
                part += __int_as_float(__builtin_amdgcn_ds_bpermute((lane ^ 32) << 2, __float_as_int(part)));
                if (fq == 0) ssq[(size_t)r * 32 + u.pn * 4 + wc] = part; }
    }
};
template <class Epi, class Sched, bool ALIGN_EPI = false, bool GATHER = false>
__device__ __forceinline__ void gemm_phase(PG8_LAS unsigned char* lds, const Gemm g, const Sched& S, const Epi& E) {
    int tid_o = threadIdx.x; asm volatile("" : "+v"(tid_o));
    const int tid = tid_o, wid = __builtin_amdgcn_readfirstlane(tid >> 6), lane = tid & 63, wr = wid >> 2, wc = wid & 3, fr = lane & 15, fq = lane >> 4;
    const int K = g.K, nt = K / BK;
    const size_t kstep = (size_t)(BK * 2);
    const size_t hstep = (size_t)HALF * K * 2;
    const size_t tstep = 2 * hstep;
    unsigned voffA[2], voffB[2], oA[2][2], oN[2][2];
#pragma unroll
    for (int i = 0; i < 2; ++i) { int R, C; stage_rc(tid * 16 + i * 8192, R, C); const int Rb = Epi::PERM ? ((R & ~31) + perm32(R & 31)) : R; voffA[i] = (unsigned)(R * K + C) * 2u; voffB[i] = (unsigned)(Rb * K + C) * 2u; }
    const unsigned ldsw = (unsigned)wid * 1024u;
    const int aoff = lds_byte(wr * 64 + fr, fq * 8), boff = lds_byte(wc * 32 + fr, fq * 8);
#define PG8_SA(b, h) (((b) * 2 + (h)) * HTB)
#define PG8_SB(b, h) ((4 + (b) * 2 + (h)) * HTB)
#define PG8_STAGE(bufoff, gbase, voff) do { _Pragma("unroll") for (int _i = 0; _i < 2; ++_i) \
        __builtin_amdgcn_global_load_lds((const unsigned*)((const char*)(gbase) + (voff)[_i]), (PG8_LAS unsigned*)(lds + (bufoff) + ldsw + _i * 8192), 16, 0, 0); } while (0)
#define PG8_LDA(dst, b, h) do { _Pragma("unroll") for (int m = 0; m < 4; ++m) _Pragma("unroll") for (int k = 0; k < 2; ++k) dst[m][k] = *(const PG8_LAS bf16x8*)(lds + PG8_SA(b, h) + aoff + m * 2048 + k * 1024); } while (0)
#define PG8_LDB(dst, b, h) do { _Pragma("unroll") for (int n = 0; n < 2; ++n) _Pragma("unroll") for (int k = 0; k < 2; ++k) dst[n][k] = *(const PG8_LAS bf16x8*)(lds + PG8_SB(b, h) + boff + n * 2048 + k * 1024); } while (0)
#define PG8_MMA(ai, bj, At, Bt) do { __builtin_amdgcn_s_setprio(1); _Pragma("unroll") for (int m = 0; m < 4; ++m) _Pragma("unroll") for (int n = 0; n < 2; ++n) _Pragma("unroll") for (int k = 0; k < 2; ++k) \
        acc[ai][bj][m][n] = __builtin_amdgcn_mfma_f32_16x16x32_bf16(Bt[n][k], At[m][k], acc[ai][bj][m][n], 0, 0, 0); __builtin_amdgcn_s_setprio(0); } while (0)
#define PG8_WAIT_V(n) asm volatile("s_waitcnt vmcnt(" #n ")" ::: "memory")
#define PG8_WAIT_L(n) asm volatile("s_waitcnt lgkmcnt(" #n ")" ::: "memory")
#define PG8_BAR __builtin_amdgcn_s_barrier()
#define PG8_SCHED __builtin_amdgcn_sched_barrier(0)
#define PG8_AOFF(dst, u) do { _Pragma("unroll") for (int _i = 0; _i < 2; ++_i) { int _R, _C; stage_rc(tid * 16 + _i * 8192, _R, _C); _Pragma("unroll") for (int _h = 0; _h < 2; ++_h) \
        dst[_h][_i] = (unsigned)(S.arow(u, _h * HALF + _R) * K + _C) * 2u; } } while (0)
#define PG8_STAGE_A(bufoff, gbase, h, usenext) do { _Pragma("unroll") for (int _i = 0; _i < 2; ++_i) { const unsigned _o = GATHER ? ((usenext) ? oN[h][_i] : oA[h][_i]) : voffA[_i]; \
        __builtin_amdgcn_global_load_lds((const unsigned*)((const char*)(gbase) + (GATHER ? (size_t)0 : (size_t)(h) * hstep) + _o), (PG8_LAS unsigned*)(lds + (bufoff) + ldsw + _i * 8192), 16, 0, 0); } } while (0)
    Unit cur, nxt; int ui = 0;
    if (!S.next(0, cur)) return;
    f32x4 acc[2][2][4][2];
#pragma unroll
    for (int a = 0; a < 2; ++a)
#pragma unroll
        for (int b = 0; b < 2; ++b)
#pragma unroll
            for (int m = 0; m < 4; ++m)
#pragma unroll
                for (int n = 0; n < 2; ++n) acc[a][b][m][n] = (f32x4){0.f, 0.f, 0.f, 0.f};
    bf16x8 At[4][2], B0[2][2], B1[2][2];
    const char* cA = (const char*)g.A + (GATHER ? (size_t)0 : (size_t)cur.pm * tstep); const char* cB = (const char*)g.Bt + (size_t)cur.pb * tstep;
    S.a_ready(cur);
    if constexpr (GATHER) { PG8_AOFF(oA, cur); PG8_WAIT_V(0); }
    PG8_STAGE(PG8_SB(0, 0), cB, voffB); PG8_STAGE(PG8_SB(0, 1), cB + hstep, voffB); PG8_STAGE_A(PG8_SA(0, 0), cA, 0, false); PG8_STAGE_A(PG8_SA(0, 1), cA, 1, false);
    if (wr == 1) PG8_BAR;
    PG8_WAIT_V(2); PG8_BAR;
    PG8_STAGE(PG8_SB(1, 0), cB + kstep, voffB); PG8_STAGE_A(PG8_SA(1, 0), cA + kstep, 0, false); PG8_STAGE(PG8_SB(1, 1), cB + hstep + kstep, voffB);
    PG8_WAIT_V(6); PG8_BAR;
    for (;;) {
        const bool has_next = S.next(ui + 1, nxt);
        const char* nA = has_next ? (const char*)g.A + (GATHER ? (size_t)0 : (size_t)nxt.pm * tstep) : cA; const char* nB = has_next ? (const char*)g.Bt + (size_t)nxt.pb * tstep : cB;
        if constexpr (GATHER) { if (has_next) { PG8_AOFF(oN, nxt); } else {
#pragma unroll
            for (int _h = 0; _h < 2; ++_h) { oN[_h][0] = oA[_h][0]; oN[_h][1] = oA[_h][1]; } } }
        for (int t = 0; t < nt; t += 2) {
            const bool last = (t == nt - 2);
            const char* a1 = cA + (size_t)(t + 1) * kstep;
            const char* a2 = last ? nA : cA + (size_t)(t + 2) * kstep; const char* b2 = last ? nB : cB + (size_t)(t + 2) * kstep;
            const char* a3 = a2 + kstep; const char* b3 = b2 + kstep;
            if (last && has_next) S.a_ready(nxt);
            PG8_LDB(B0, 0, 0); PG8_LDB(B1, 0, 1); PG8_SCHED; PG8_LDA(At, 0, 0); PG8_STAGE_A(PG8_SA(1, 1), a1, 1, false);
            PG8_WAIT_V(8); PG8_WAIT_L(0); PG8_BAR; PG8_MMA(0, 0, At, B0); PG8_MMA(0, 1, At, B1); PG8_BAR; PG8_SCHED;
            PG8_LDA(At, 0, 1); PG8_STAGE(PG8_SB(0, 0), b2, voffB); PG8_STAGE(PG8_SB(0, 1), b2 + hstep, voffB); PG8_STAGE_A(PG8_SA(0, 0), a2, 0, last);
            PG8_WAIT_V(8); PG8_WAIT_L(0); PG8_BAR; PG8_MMA(1, 0, At, B0); PG8_MMA(1, 1, At, B1); PG8_BAR; PG8_SCHED;
            PG8_LDB(B0, 1, 0); PG8_LDB(B1, 1, 1); PG8_SCHED; PG8_LDA(At, 1, 0); PG8_STAGE_A(PG8_SA(0, 1), a2, 1, last);
            PG8_WAIT_V(8); PG8_WAIT_L(0); PG8_BAR; PG8_MMA(0, 0, At, B0); PG8_MMA(0, 1, At, B1); PG8_BAR; PG8_SCHED;
            PG8_LDA(At, 1, 1); PG8_STAGE(PG8_SB(1, 0), b3, voffB); PG8_STAGE(PG8_SB(1, 1), b3 + hstep, voffB); PG8_STAGE_A(PG8_SA(1, 0), a3, 0, last);
            PG8_WAIT_V(8); PG8_WAIT_L(0); PG8_BAR; PG8_MMA(1, 0, At, B0); PG8_MMA(1, 1, At, B1); PG8_BAR; PG8_SCHED;
        }
        if constexpr (ALIGN_EPI) { if (wr == 0) PG8_BAR; }
        E(acc, cur, wr, wc, fr, fq); S.done(cur);
        if (!has_next) break;
#pragma unroll
        for (int a = 0; a < 2; ++a)
#pragma unroll
            for (int b = 0; b < 2; ++b)
#pragma unroll
                for (int m = 0; m < 4; ++m)
#pragma unroll
                    for (int n = 0; n < 2; ++n) acc[a][b][m][n] = (f32x4){0.f, 0.f, 0.f, 0.f};
        cur = nxt; cA = nA; cB = nB; ++ui;
        if constexpr (GATHER) {
#pragma unroll
            for (int _h = 0; _h < 2; ++_h) { oA[_h][0] = oN[_h][0]; oA[_h][1] = oN[_h][1]; } }
        if constexpr (ALIGN_EPI) { if (wr == 1) PG8_BAR; }
    }
    PG8_WAIT_V(0);
    if constexpr (!ALIGN_EPI) { if (wr == 0) PG8_BAR; }
    PG8_BAR;
#undef PG8_SA
#undef PG8_SB
#undef PG8_STAGE
#undef PG8_LDA
#undef PG8_LDB
#undef PG8_MMA
#undef PG8_WAIT_V
#undef PG8_WAIT_L
#undef PG8_BAR
#undef PG8_SCHED
#undef PG8_AOFF
#undef PG8_STAGE_A
}
}

#define GAS __attribute__((address_space(1)))
#define LAS __attribute__((address_space(3)))
#define XB_TMO      128
#define XB_XCNT(j)  (256  + 64 * (j))
#define XB_XSUB(j)  (1280 + 64 * (j))
#define XB_XGEN(j)  (2304 + 64 * (j))
#define XB_TOP      3328
#define XB_TOPGEN   3392
#define XCD_BAR_WORDS 3456
#define XB_SPIN_CAP (1u << 23)

__device__ __forceinline__ unsigned xb_ld(unsigned* p)              { return __hip_atomic_load(p, __ATOMIC_RELAXED, __HIP_MEMORY_SCOPE_AGENT); }
__device__ __forceinline__ unsigned xb_add(unsigned* p, unsigned v) { return __hip_atomic_fetch_add(p, v, __ATOMIC_RELAXED, __HIP_MEMORY_SCOPE_AGENT); }
__device__ __forceinline__ unsigned xb_xcc_id() { return (unsigned)__builtin_amdgcn_s_getreg((3 << 11) | 20) & 0xFu; }
#define XB_SPIN(cond, bar) do { unsigned _sp = 0; while (cond) { __builtin_amdgcn_s_sleep(1); \
    if ((++_sp & 255u) == 0u) { if (xb_ld(&(bar)[XB_TMO])) break; if (_sp > XB_SPIN_CAP) { atomicAdd(&(bar)[XB_TMO], 1u); break; } } } } while (0)

struct XcdBarrier {
    unsigned* bar; unsigned x;
    volatile LAS unsigned* st;
};

__device__ __forceinline__ XcdBarrier xcd_barrier_post(unsigned* bar, volatile LAS unsigned* st) {
    XcdBarrier b; b.bar = bar; b.x = xb_xcc_id(); b.st = st;
    if (threadIdx.x == 0) (void)xb_add(&bar[XB_XCNT(b.x)], 1u);
    return b;
}
__device__ __forceinline__ void xcd_barrier_complete(unsigned* bar, unsigned x, unsigned& nloc, unsigned& nx) {
    const unsigned G = gridDim.x * gridDim.y * gridDim.z;
    unsigned sum, cnt, mine, sp = 0u;
    for (;;) {
        sum = 0u; cnt = 0u; mine = 0u;
#pragma unroll
        for (unsigned j = 0; j < 16; ++j) { const unsigned c = xb_ld(&bar[XB_XCNT(j)]); sum += c; cnt += (c > 0u) ? 1u : 0u; mine = (j == x) ? c : mine; }
        if (sum == G) break;
        __builtin_amdgcn_s_sleep(1);
        if ((++sp & 255u) == 0u) { if (xb_ld(&bar[XB_TMO])) break; if (sp > XB_SPIN_CAP) { atomicAdd(&bar[XB_TMO], 1u); break; } }
    }
    nloc = mine > 0u ? mine : 1u; nx = cnt > 0u ? cnt : 1u;
}

__device__ __forceinline__ void xcd_barrier(const XcdBarrier& b) {
    asm volatile("s_waitcnt vmcnt(0)" ::: "memory");
    __syncthreads();
    if (threadIdx.x == 0) {
        unsigned* bar = b.bar; asm volatile("" : "+s"(bar));
        __builtin_amdgcn_s_waitcnt(0);
        unsigned nloc = b.st[0], nx = b.st[1];
        if (nloc == 0u) { xcd_barrier_complete(bar, b.x, nloc, nx); b.st[0] = nloc; b.st[1] = nx; }
        const unsigned old = xb_add(&bar[XB_XSUB(b.x)], 1u);
        const unsigned gen = old / nloc;
        if (old + 1u == (gen + 1u) * nloc) {
            __builtin_amdgcn_fence(__ATOMIC_RELEASE, "agent");
            asm volatile("s_waitcnt vmcnt(0)" ::: "memory");
            const unsigned og = xb_add(&bar[XB_TOP], 1u);
            const unsigned tg = og / nx;
            if (og + 1u == (tg + 1u) * nx) xb_add(&bar[XB_TOPGEN], 1u);
            else XB_SPIN(xb_ld(&bar[XB_TOPGEN]) == tg, bar);
            __builtin_amdgcn_fence(__ATOMIC_ACQUIRE, "agent");
            xb_add(&bar[XB_XGEN(b.x)], 1u);
            asm volatile("s_waitcnt vmcnt(0)" ::: "memory");
        } else {
            XB_SPIN(xb_ld(&bar[XB_XGEN(b.x)]) == gen, bar);
            __builtin_amdgcn_fence(__ATOMIC_ACQUIRE, "agent");
            asm volatile("s_waitcnt vmcnt(0)" ::: "memory");
        }
    }
    __syncthreads();
}

constexpr int T = 16384, SEQ = 8192, D = 2048, DLRU = 1024, DDN = 1024, NH = 8, HD = 128, NPROJ = 6144, DIN = 6160;
constexpr int DFF = 6144, NEXP = 8, DFFE = 3072;
constexpr float EPS = 1e-6f;
typedef unsigned short bf16;
typedef float f32x4 __attribute__((ext_vector_type(4)));
typedef unsigned u32x4 __attribute__((ext_vector_type(4)));
typedef unsigned u32x2 __attribute__((ext_vector_type(2)));
#define LDS_WAIT() asm volatile("s_waitcnt lgkmcnt(0)" ::: "memory")
#define LDS_BARRIER() do { asm volatile("s_waitcnt lgkmcnt(0)" ::: "memory"); __builtin_amdgcn_s_barrier(); asm volatile("" ::: "memory"); } while (0)

__device__ __forceinline__ float bf2f(bf16 b) { return __uint_as_float(((unsigned)b) << 16); }
__device__ __forceinline__ unsigned f2bf(float f) { return pg8::cvt_pk_bf16(f, f) & 0xffffu; }
__device__ __forceinline__ unsigned pk2(float lo, float hi) { return pg8::cvt_pk_bf16(lo, hi); }
__device__ __forceinline__ float shfl_xor_l(float v, int o, int lane) { return __int_as_float(__builtin_amdgcn_ds_bpermute((lane ^ o) << 2, __float_as_int(v))); }
__device__ __forceinline__ float shfl_up_l(float v, int d, int lane) { return __int_as_float(__builtin_amdgcn_ds_bpermute((lane - d) << 2, __float_as_int(v))); }
__device__ __forceinline__ float shfl_idx_l(float v, int src) { return __int_as_float(__builtin_amdgcn_ds_bpermute(src << 2, __float_as_int(v))); }
__device__ __forceinline__ float wave_sum(float v, int lane) {
#pragma unroll
    for (int o = 1; o < 64; o <<= 1) v += shfl_xor_l(v, o, lane);
    return v;
}
using pg8::silu_f;
using pg8::frcp; using pg8::rsqrt_f;
__device__ __forceinline__ float sigmoid_f(float x) { return frcp(1.0f + __expf(-x)); }
__device__ __forceinline__ float softplus_f(float x) { return fmaxf(x, 0.0f) + log1pf(__expf(-fabsf(x))); }
__device__ __forceinline__ float gelu_tanh_f(float x) { const float u = 0.7978845608028654f * (x + 0.044715f * x * x * x); return x * frcp(1.0f + __expf(-2.0f * u)); }

constexpr size_t MiB = 1u << 20;
constexpr size_t al(size_t x) { return (x + MiB - 1) / MiB * MiB; }
constexpr size_t WS_CTL = 0, CTL_ZERO_BYTES = 1 * MiB;
constexpr int CW_BAR = 4096, CW_CNT = 8192;
constexpr size_t WS_WGU = 1 * MiB;
constexpr size_t WS_WD = WS_WGU + al((size_t)2 * DFF * D * 2);
constexpr size_t WS_WIN = WS_WD + al((size_t)D * DFF * 2);
constexpr size_t WS_WBA = WS_WIN + al((size_t)2 * NPROJ * D * 2);
constexpr size_t WS_WOUT = WS_WBA + al((size_t)2 * 16 * D * 4 + 2 * 16 * D * 2);
static_assert(WS_WIN + (size_t)NPROJ * D * 2 - WS_WGU >= (size_t)NEXP * D * DFFE * 2, "MoE down weights overlay");
constexpr size_t WS_XB = WS_WOUT + al((size_t)2 * D * D * 2);
constexpr size_t WS_RSTD = WS_XB + al((size_t)T * D * 2);
constexpr size_t WS_BA = WS_RSTD + 5 * MiB;
constexpr size_t WS_BETA = WS_BA + al((size_t)T * 16 * 4);
constexpr size_t WS_G = WS_BETA + al((size_t)T * 8 * 4);
constexpr size_t WS_ROWW = WS_G + al((size_t)T * 8 * 4);
constexpr int NSLOT = 2 * T + NEXP * 256;
constexpr size_t WS_PROJ = WS_ROWW + al((size_t)2 * 8 * T * 4);
constexpr size_t WS_YMIX = WS_PROJ + al((size_t)NSLOT * DFFE * 2);
constexpr size_t WS_C = WS_YMIX + al((size_t)T * D * 2);
constexpr size_t WS_WRT = WS_C + (size_t)388 * MiB;
constexpr size_t WS_END = WS_WRT + 1 * MiB;
static_assert(WS_END <= (size_t)975 * MiB, "d_ws map exceeds the guaranteed workspace");
static_assert((size_t)NEXP * 2 * DFFE * D * 2 <= (size_t)388 * MiB, "MoE gate/up bf16 weights overlay the mixer scratch");
constexpr int RING_BYTES = 131072, LDSCTL_OFF = RING_BYTES, MISC_OFF = LDSCTL_OFF + 320, LDS_BYTES = 147456;

__device__ __forceinline__ void transpose_item(const float* W, int ldw, int col_off, int K, int nblk, const float* gain, bf16* WT, int blk, int blk_stride, int row_off, int item, int lane) {
    const int kb = item / nblk, nb = item % nblk, k0 = 64 * kb + (lane >> 4) * 16, n0 = 64 * nb + (lane & 15) * 4;
    const float* src = W + (size_t)k0 * ldw + col_off + n0;
    f32x4 v[16];
#pragma unroll
    for (int j = 0; j < 16; ++j) v[j] = __builtin_nontemporal_load((const f32x4*)(src + (size_t)j * ldw));
    if (gain) {
#pragma unroll
        for (int q = 0; q < 4; ++q) { const f32x4 g = *(const f32x4*)(gain + k0 + 4 * q);
#pragma unroll
            for (int c = 0; c < 4; ++c) v[4 * q + c] = v[4 * q + c] * g[c]; }
    }
#pragma unroll
    for (int i = 0; i < 4; ++i) { const int n = n0 + i, drow = (n / blk) * blk_stride + (n % blk) + row_off;
        u32x4 o0, o1;
        o0.x = pk2(v[0][i], v[1][i]); o0.y = pk2(v[2][i], v[3][i]); o0.z = pk2(v[4][i], v[5][i]); o0.w = pk2(v[6][i], v[7][i]);
        o1.x = pk2(v[8][i], v[9][i]); o1.y = pk2(v[10][i], v[11][i]); o1.z = pk2(v[12][i], v[13][i]); o1.w = pk2(v[14][i], v[15][i]);
        u32x4* dst = (u32x4*)(WT + (size_t)drow * K + k0); dst[0] = o0; dst[1] = o1; }
}
__device__ __forceinline__ void convert_matrix(const float* W, int ldw, int col_off, int K, int N, const float* gain, bf16* WT, int blk, int blk_stride, int row_off, LAS float* scr, int gw, int NGW, int lane) {
    const int nblk = N / 64, nitems = (K / 64) * nblk; (void)scr;
    for (int it = gw; it < nitems; it += NGW) transpose_item(W, ldw, col_off, K, nblk, gain, WT, blk, blk_stride, row_off, it, lane);
}
__device__ __forceinline__ void rowprep_row(const float* x, bf16* xb, float* rstd, const float* Wba, float* ba, int row, int lane) {
    const f32x4* xr = (const f32x4*)(x + (size_t)row * D) + lane;
    f32x4 v[8]; float ss = 0.f;
#pragma unroll
    for (int j = 0; j < 8; ++j) { v[j] = xr[64 * j]; ss += (v[j][0] * v[j][0] + v[j][1] * v[j][1]) + (v[j][2] * v[j][2] + v[j][3] * v[j][3]); }
    ss = wave_sum(ss, lane);
    const float rs = rsqrt_f(ss * (1.0f / D) + EPS);
    u32x2* o = (u32x2*)(xb + (size_t)row * D) + lane;
#pragma unroll
    for (int j = 0; j < 8; ++j) { u32x2 w; w.x = pk2(v[j][0], v[j][1]); w.y = pk2(v[j][2], v[j][3]); o[64 * j] = w; }
    if (lane == 0) rstd[row] = rs;
    if (Wba) {
        for (int c = 0; c < 16; ++c) { const f32x4* wr = (const f32x4*)(Wba + (size_t)c * D) + lane; float a = 0.f;
#pragma unroll
            for (int j = 0; j < 8; ++j) { const f32x4 w = wr[64 * j]; a += (v[j][0] * w[0] + v[j][1] * w[1]) + (v[j][2] * w[2] + v[j][3] * w[3]); }
            a = wave_sum(a, lane); if (lane == 0) ba[(size_t)row * 16 + c] = a * rs; }
    }
}
__device__ __forceinline__ void lru_conv_elem(const bf16* proj, const float* cw, const float* cb, float* xc, size_t idx) {
    const int t = (int)(idx / DLRU), ch = (int)(idx % DLRU), s = t % SEQ;
    float a = cb[ch];
#pragma unroll
    for (int k = 0; k < 4; ++k) { const int sp = s - 3 + k; if (sp >= 0) a += cw[k * DLRU + ch] * bf2f(proj[(size_t)(t - 3 + k) * NPROJ + ch]); }
    xc[idx] = a;
}
__device__ __forceinline__ void lru_gate_elem(const float* xc, const float* w_r, const float* b_r, const float* w_i, const float* b_i, const float* lam, float* av, float* bv, size_t idx) {
    const int t = (int)(idx / DLRU), ch = (int)(idx % DLRU), n = ch >> 7, d = ch & 127;
    float ar = b_r[ch], ai = b_i[ch];
    const float* xr = xc + (size_t)t * DLRU + n * 128; const float* wr = w_r + (size_t)n * 128 * 128 + d; const float* wi = w_i + (size_t)n * 128 * 128 + d;
    for (int c = 0; c < 128; ++c) { const float xv = xr[c]; ar += xv * wr[c * 128]; ai += xv * wi[c * 128]; }
    const float r = sigmoid_f(ar), ig = sigmoid_f(ai);
    const float log_a = -8.0f * r * softplus_f(-lam[ch]);
    const float a = expf(log_a), mult = sqrtf(-expm1f(2.0f * log_a));
    av[idx] = a; bv[idx] = mult * (ig * xc[idx]);
}
__device__ __forceinline__ void lru_scan_chan(float* av, const float* bv, const bf16* proj, int idx) {
    const int b = idx / DLRU, ch = idx % DLRU;
    float h = 0.f;
    for (int s0 = 0; s0 < SEQ; s0 += 8) {
        float a8[8], b8[8], g8[8];
#pragma unroll
        for (int j = 0; j < 8; ++j) { const size_t t = (size_t)b * SEQ + s0 + j; a8[j] = av[t * DLRU + ch]; b8[j] = bv[t * DLRU + ch]; g8[j] = bf2f(proj[t * NPROJ + DLRU + ch]); }
#pragma unroll
        for (int j = 0; j < 8; ++j) { const size_t t = (size_t)b * SEQ + s0 + j; h = a8[j] * h + b8[j]; av[t * DLRU + ch] = h * gelu_tanh_f(g8[j]); }
    }
}
__device__ __forceinline__ void lru_norm_row(const float* y, const float* gain, bf16* ymix, int row, int lane) {
    const f32x4* yr = (const f32x4*)(y + (size_t)row * DLRU) + lane; const f32x4* gr = (const f32x4*)gain + lane;
    f32x4 v[4]; float ss = 0.f;
#pragma unroll
    for (int j = 0; j < 4; ++j) { v[j] = yr[64 * j]; ss += (v[j][0] * v[j][0] + v[j][1] * v[j][1]) + (v[j][2] * v[j][2] + v[j][3] * v[j][3]); }
    ss = wave_sum(ss, lane); const float rs = rsqrt_f(ss * (1.0f / DLRU) + EPS);
    u32x2* o = (u32x2*)(ymix + (size_t)row * D) + lane;
#pragma unroll
    for (int j = 0; j < 4; ++j) { const f32x4 g = gr[64 * j]; u32x2 w; w.x = pk2(v[j][0] * rs * g[0], v[j][1] * rs * g[1]); w.y = pk2(v[j][2] * rs * g[2], v[j][3] * rs * g[3]); o[64 * j] = w; }
}
__device__ __forceinline__ void dn_prep_item(const bf16* proj, const float* cw, const float* ba, const float* a_log, const float* dt_bias, float* qn, float* kn, float* vn, float* beta, float* gg, int w, int lane) {
    const int t = w >> 3, h = w & 7, s = t % SEQ;
    float val[3][2];
#pragma unroll
    for (int p = 0; p < 3; ++p)
#pragma unroll
        for (int e = 0; e < 2; ++e) { const int d = lane * 2 + e, c = p * DDN + h * HD + d; float a = 0.f;
#pragma unroll
            for (int k = 0; k < 4; ++k) { const int sp = s - 3 + k; if (sp >= 0) a += cw[k * 3 * DDN + c] * bf2f(proj[(size_t)(t - 3 + k) * NPROJ + 2048 + c]); }
            val[p][e] = silu_f(a); }
    const float sq = wave_sum(val[0][0] * val[0][0] + val[0][1] * val[0][1], lane), sk = wave_sum(val[1][0] * val[1][0] + val[1][1] * val[1][1], lane);
    const float rq = rsqrt_f(sq + EPS) * 0.08838834764831845f, rk = rsqrt_f(sk + EPS);
    const size_t o = ((size_t)t * NH + h) * HD + lane * 2;
    qn[o] = val[0][0] * rq; qn[o + 1] = val[0][1] * rq; kn[o] = val[1][0] * rk; kn[o + 1] = val[1][1] * rk; vn[o] = val[2][0]; vn[o + 1] = val[2][1];
    if (lane == 0) { beta[t * NH + h] = sigmoid_f(ba[(size_t)t * 16 + h]); gg[t * NH + h] = -__expf(a_log[h]) * softplus_f(ba[(size_t)t * 16 + 8 + h] + dt_bias[h]); }
}
__device__ __forceinline__ void dn_rec_seq(const float* qn, const float* kn, const float* vn, const float* beta, const float* gg, float* o, int bh, LAS float* sk, LAS float* sq, LAS float* st, int tid) {
    const int b = bh >> 3, h = bh & 7, j = tid & 127; const bool act = tid < 128;
    if (act) for (int k = 0; k < 128; ++k) st[k * 128 + j] = 0.f;
    const size_t base = ((size_t)(b * SEQ) * NH + h) * HD;
    float nk = kn[base + j], nq = qn[base + j], nv = vn[base + j], nb = beta[(b * SEQ) * NH + h], ng = gg[(b * SEQ) * NH + h];
    for (int s = 0; s < SEQ; ++s) {
        const int buf = (s & 1) * 128;
        if (act) { sk[buf + j] = nk; sq[buf + j] = nq; }
        const float vj = nv, be = nb, ge = __expf(ng);
        __syncthreads();
        if (act) {
            if (s + 1 < SEQ) { const size_t nb_ = ((size_t)(b * SEQ + s + 1) * NH + h) * HD; nk = kn[nb_ + j]; nq = qn[nb_ + j]; nv = vn[nb_ + j]; nb = beta[(b * SEQ + s + 1) * NH + h]; ng = gg[(b * SEQ + s + 1) * NH + h]; }
            float ks = 0.f;
#pragma unroll 8
            for (int k = 0; k < 128; ++k) ks += sk[buf + k] * st[k * 128 + j];
            const float vnew = be * (vj - ge * ks);
            float oo = 0.f;
#pragma unroll 8
            for (int k = 0; k < 128; ++k) { const float sv = ge * st[k * 128 + j] + sk[buf + k] * vnew; st[k * 128 + j] = sv; oo += sq[buf + k] * sv; }
            o[((size_t)(b * SEQ + s) * NH + h) * HD + j] = oo;
        }
    }
    __syncthreads();
}
typedef short bf16x8 __attribute__((ext_vector_type(8)));
__device__ __forceinline__ f32x4 mfma16(bf16x8 a, bf16x8 b, f32x4 c) { return __builtin_amdgcn_mfma_f32_16x16x32_bf16(a, b, c, 0, 0, 0); }
__device__ __forceinline__ float bflo(unsigned x) { return __uint_as_float(x << 16); }
__device__ __forceinline__ float bfhi(unsigned x) { return __uint_as_float(x & 0xffff0000u); }
constexpr int DA_G = 0, DA_L = 1024, DA_KN = DA_L + 16384, DA_QN = DA_KN + 17408, DA_VBT = DA_QN + 17408, DA_KBET = DA_VBT + 18432, DA_KDT = DA_KBET + 18432, DA_TB = DA_KDT + 18432, DA_QK = DA_TB + 9216, DA_END = DA_QK + 9216;
static_assert(DA_END <= RING_BYTES, "DN-A LDS map");
#if defined(PROBE_DNA_A)
#define DNA_ST(k) do { if (threadIdx.x == 0) ((volatile LAS unsigned long long*)(lds + (RING_BYTES + 2048)))[k] = __builtin_amdgcn_s_memrealtime(); } while (0)
#else
#define DNA_ST(k) do { } while (0)
#endif
__device__ __forceinline__ void dna_unit(const bf16* proj, const float* cw, const float* ba, const float* a_log, const float* dt_bias,
                                         bf16* Wf, bf16* Qf, bf16* KdTf, bf16* QKf, bf16* Uf, float* glb, int uid, LAS unsigned char* lds, int tid, int lane, int wave) {
    const int h = uid & 7, n = (uid >> 3) & 127, b = uid >> 10, t0 = b * SEQ + n * 64;
    asm volatile("" : "+v"(lds));
    DNA_ST(0);
    LAS float* Gs = (LAS float*)(lds + DA_G);
    const int fr = lane & 15, fq = lane >> 4;
    if (wave == 0) {
        const size_t t = (size_t)(t0 + lane);
        const float be = sigmoid_f(ba[t * 16 + h]); float Gc = -__expf(a_log[h]) * softplus_f(ba[t * 16 + 8 + h] + dt_bias[h]);
#pragma unroll
        for (int off = 1; off < 64; off <<= 1) { const float tmp = shfl_up_l(Gc, off, lane); if (lane >= off) Gc += tmp; }
        const float GL = shfl_idx_l(Gc, 63);
        Gs[lane] = Gc; Gs[64 + lane] = be; Gs[128 + lane] = __expf(Gc); Gs[192 + lane] = __expf(GL - Gc);
        if (lane == 63) glb[uid] = __expf(Gc);
    }
    LDS_BARRIER();
    DNA_ST(1);
    {
        const int r = tid >> 3, cg = tid & 7;
        const float be = Gs[64 + r], eg = Gs[128 + r], egl = Gs[192 + r];
        float val[3][16];
#pragma unroll
        for (int p = 0; p < 3; ++p) {
            const int ccol = p * DDN + h * HD + cg * 16;
            float acc[16];
#pragma unroll
            for (int i = 0; i < 16; ++i) acc[i] = 0.f;
#pragma unroll
            for (int k = 0; k < 4; ++k) { const int row = r - 3 + k;
                if (n * 64 + row >= 0) {
                    const bf16* src = proj + (size_t)(t0 + row) * NPROJ + 2048 + ccol;
                    const u32x4 x0 = *(const u32x4*)src, x1 = *(const u32x4*)(src + 8);
                    const float* wp = cw + k * 3 * DDN + ccol;
                    const f32x4 w0 = *(const f32x4*)wp, w1 = *(const f32x4*)(wp + 4), w2 = *(const f32x4*)(wp + 8), w3 = *(const f32x4*)(wp + 12);
                    acc[0] += w0[0] * bflo(x0.x); acc[1] += w0[1] * bfhi(x0.x); acc[2] += w0[2] * bflo(x0.y); acc[3] += w0[3] * bfhi(x0.y);
                    acc[4] += w1[0] * bflo(x0.z); acc[5] += w1[1] * bfhi(x0.z); acc[6] += w1[2] * bflo(x0.w); acc[7] += w1[3] * bfhi(x0.w);
                    acc[8] += w2[0] * bflo(x1.x); acc[9] += w2[1] * bfhi(x1.x); acc[10] += w2[2] * bflo(x1.y); acc[11] += w2[3] * bfhi(x1.y);
                    acc[12] += w3[0] * bflo(x1.z); acc[13] += w3[1] * bfhi(x1.z); acc[14] += w3[2] * bflo(x1.w); acc[15] += w3[3] * bfhi(x1.w);
                } }
#pragma unroll
            for (int i = 0; i < 16; ++i) val[p][i] = silu_f(acc[i]);
        }
        float sq = 0.f, sk = 0.f;
#pragma unroll
        for (int i = 0; i < 16; ++i) { sq += val[0][i] * val[0][i]; sk += val[1][i] * val[1][i]; }
        sq += shfl_xor_l(sq, 1, lane); sq += shfl_xor_l(sq, 2, lane); sq += shfl_xor_l(sq, 4, lane);
        sk += shfl_xor_l(sk, 1, lane); sk += shfl_xor_l(sk, 2, lane); sk += shfl_xor_l(sk, 4, lane);
        const float rq = rsqrt_f(sq + EPS) * 0.08838834764831845f, rk = rsqrt_f(sk + EPS);
#pragma unroll
        for (int i = 0; i < 16; ++i) { val[0][i] *= rq; val[1][i] *= rk; }
        u32x4 o0, o1;
        o0.x = pk2(val[1][0], val[1][1]); o0.y = pk2(val[1][2], val[1][3]); o0.z = pk2(val[1][4], val[1][5]); o0.w = pk2(val[1][6], val[1][7]);
        o1.x = pk2(val[1][8], val[1][9]); o1.y = pk2(val[1][10], val[1][11]); o1.z = pk2(val[1][12], val[1][13]); o1.w = pk2(val[1][14], val[1][15]);
        *(LAS u32x4*)(lds + DA_KN + r * 272 + cg * 32) = o0; *(LAS u32x4*)(lds + DA_KN + r * 272 + cg * 32 + 16) = o1;
        o0.x = pk2(val[0][0], val[0][1]); o0.y = pk2(val[0][2], val[0][3]); o0.z = pk2(val[0][4], val[0][5]); o0.w = pk2(val[0][6], val[0][7]);
        o1.x = pk2(val[0][8], val[0][9]); o1.y = pk2(val[0][10], val[0][11]); o1.z = pk2(val[0][12], val[0][13]); o1.w = pk2(val[0][14], val[0][15]);
        *(LAS u32x4*)(lds + DA_QN + r * 272 + cg * 32) = o0; *(LAS u32x4*)(lds + DA_QN + r * 272 + cg * 32 + 16) = o1;
#pragma unroll
        for (int i = 0; i < 16; ++i) { const int f = cg * 16 + i;
            *(LAS unsigned short*)(lds + DA_VBT + f * 144 + r * 2) = (unsigned short)f2bf(val[2][i] * be);
            *(LAS unsigned short*)(lds + DA_KBET + f * 144 + r * 2) = (unsigned short)f2bf(val[1][i] * (be * eg));
            *(LAS unsigned short*)(lds + DA_KDT + f * 144 + r * 2) = (unsigned short)f2bf(val[1][i] * egl); }
    }
    LDS_BARRIER();
    DNA_ST(2);
    {
        const int p = wave >> 2, ti = wave & 3;
        const int abase = p == 0 ? DA_KN : DA_QN;
        bf16x8 af[4];
#pragma unroll
        for (int ks = 0; ks < 4; ++ks) af[ks] = *(const LAS bf16x8*)(lds + abase + (ti * 16 + fr) * 272 + (ks * 32 + fq * 8) * 2);
        for (int tj = 0; tj < 4; ++tj) {
            f32x4 acc = {0.f, 0.f, 0.f, 0.f};
            if (tj <= ti) {
#pragma unroll
                for (int ks = 0; ks < 4; ++ks) { const bf16x8 bb = *(const LAS bf16x8*)(lds + DA_KN + (tj * 16 + fr) * 272 + (ks * 32 + fq * 8) * 2); acc = mfma16(af[ks], bb, acc); }
            }
            const int j = tj * 16 + fr; const float Gj = Gs[j];
#pragma unroll
            for (int r = 0; r < 4; ++r) { const int i = ti * 16 + fq * 4 + r; float v = 0.f;
                if (p == 0) { if (i > j) v = Gs[64 + i] * acc[r] * __expf(Gs[i] - Gj); *(LAS float*)(lds + DA_L + (j * 64 + i) * 4) = v; }
                else { if (i >= j) v = acc[r] * __expf(Gs[i] - Gj); *(LAS unsigned short*)(lds + DA_QK + i * 144 + j * 2) = (unsigned short)f2bf(v); } }
        }
    }
    LDS_BARRIER();
    DNA_ST(3);
    {
        int lc = lane; asm volatile("" : "+v"(lc)); const float fl = (float)lc;
        const int blk = wave < 4 ? wave : 11 - wave;
        float Tr[8];
#pragma unroll
        for (int c = 0; c < 8; ++c) Tr[c] = fmaxf(0.f, 1.f - fabsf(fl - (float)(blk * 8 + c)));
        float lj[63];
#pragma unroll
        for (int j = 0; j < 63; ++j) lj[j] = *(const LAS float*)(lds + DA_L + (j * 64) * 4 + lc * 4);
#pragma unroll
        for (int j = 0; j < 63; ++j) {
            if (j >= blk * 8) {
#pragma unroll
                for (int c = 0; c < 8; ++c) { const float tj = __int_as_float(__builtin_amdgcn_readlane(__float_as_int(Tr[c]), j)); Tr[c] -= lj[j] * tj; }
            }
        }
        u32x4 o; o.x = pk2(Tr[0], Tr[1]); o.y = pk2(Tr[2], Tr[3]); o.z = pk2(Tr[4], Tr[5]); o.w = pk2(Tr[6], Tr[7]);
        *(LAS u32x4*)(lds + DA_TB + lc * 144 + blk * 16) = o;
    }
    {
        for (int fi = wave; fi < 40; fi += 8) {
            if (fi < 8) { const int mt = fi >> 1, ks = fi & 1;
                const u32x4 v = *(const LAS u32x4*)(lds + DA_QK + (mt * 16 + fr) * 144 + (ks * 32 + fq * 8) * 2);
                *(u32x4*)(QKf + (((size_t)uid * 4 + mt) * 2 + ks) * 512 + lane * 8) = v; }
            else if (fi < 24) { const int f2 = fi - 8, mt = f2 >> 2, ks = f2 & 3; const float eg = Gs[128 + mt * 16 + fr];
                const u32x4 v = *(const LAS u32x4*)(lds + DA_QN + (mt * 16 + fr) * 272 + (ks * 32 + fq * 8) * 2); u32x4 o;
                o.x = pk2(bflo(v.x) * eg, bfhi(v.x) * eg); o.y = pk2(bflo(v.y) * eg, bfhi(v.y) * eg); o.z = pk2(bflo(v.z) * eg, bfhi(v.z) * eg); o.w = pk2(bflo(v.w) * eg, bfhi(v.w) * eg);
                *(u32x4*)(Qf + (((size_t)uid * 4 + mt) * 4 + ks) * 512 + lane * 8) = o; }
            else { const int f2 = fi - 24, ft = f2 >> 1, ks = f2 & 1;
                const u32x4 v = *(const LAS u32x4*)(lds + DA_KDT + (ft * 16 + fr) * 144 + (ks * 32 + fq * 8) * 2);
                *(u32x4*)(KdTf + (((size_t)uid * 8 + ft) * 2 + ks) * 512 + lane * 8) = v; }
        }
    }
    LDS_BARRIER();
    DNA_ST(4);
    {
        bf16x8 ta[4][2];
#pragma unroll
        for (int mt = 0; mt < 4; ++mt)
#pragma unroll
            for (int ks = 0; ks < 2; ++ks) ta[mt][ks] = *(const LAS bf16x8*)(lds + DA_TB + (mt * 16 + fr) * 144 + (ks * 32 + fq * 8) * 2);
#pragma unroll
        for (int c2 = 0; c2 < 2; ++c2) { const int ct = wave * 2 + c2, img = ct < 8 ? DA_VBT : DA_KBET, cr = (ct & 7) * 16 + fr;
            bf16x8 bb[2];
#pragma unroll
            for (int ks = 0; ks < 2; ++ks) bb[ks] = *(const LAS bf16x8*)(lds + img + cr * 144 + (ks * 32 + fq * 8) * 2);
#pragma unroll
            for (int mt = 0; mt < 4; ++mt) { f32x4 acc = {0.f, 0.f, 0.f, 0.f};
#pragma unroll
                for (int ks = 0; ks < 2; ++ks) acc = mfma16(ta[mt][ks], bb[ks], acc);
                if (ct < 8) { u32x2 o; o.x = pk2(acc[0], acc[1]); o.y = pk2(acc[2], acc[3]); *(u32x2*)(Uf + ((((size_t)uid * 8 + ct) * 4 + mt) * 64 + lane) * 4) = o; }
                else { const int f = (ct - 8) * 16 + fr;
#pragma unroll
                    for (int r = 0; r < 4; ++r) *(LAS unsigned short*)(lds + DA_KN + (mt * 16 + fq * 4 + r) * 272 + f * 2) = (unsigned short)f2bf(acc[r]); } }
        }
    }
    LDS_BARRIER();
    DNA_ST(5);
#pragma unroll
    for (int q2 = 0; q2 < 2; ++q2) { const int fi = wave * 2 + q2, mt = fi >> 2, ks = fi & 3;
        const u32x4 v = *(const LAS u32x4*)(lds + DA_KN + (mt * 16 + fr) * 272 + (ks * 32 + fq * 8) * 2);
        *(u32x4*)(Wf + (((size_t)uid * 4 + mt) * 4 + ks) * 512 + lane * 8) = v; }
    LDS_BARRIER();
    DNA_ST(6);
}
struct DnbFrag { bf16x8 a1[4]; bf16x8 a2[2]; bf16x8 kd[2]; u32x2 u; float gl; };
__device__ __forceinline__ DnbFrag dnb_load(const bf16* A1, const bf16* QKf, const bf16* KdTf, const bf16* Uf, const float* glb, int uid, int ds, int wave, int lane) {
    DnbFrag f; const int mt = wave & 3;
#pragma unroll
    for (int ks = 0; ks < 4; ++ks) f.a1[ks] = *(const bf16x8*)(A1 + (((size_t)uid * 4 + mt) * 4 + ks) * 512 + lane * 8);
#pragma unroll
    for (int ks = 0; ks < 2; ++ks) f.kd[ks] = *(const bf16x8*)(KdTf + (((size_t)uid * 8 + wave) * 2 + ks) * 512 + lane * 8);
#pragma unroll
    for (int ks = 0; ks < 2; ++ks) f.a2[ks] = *(const bf16x8*)(QKf + (((size_t)uid * 4 + mt) * 2 + ks) * 512 + lane * 8);
    f.u = *(const u32x2*)(Uf + ((((size_t)uid * 8 + ds) * 4 + mt) * 64 + lane) * 4);
    f.gl = glb[uid];
    return f;
}
__device__ __forceinline__ void dnb_run(const bf16* Wf, const bf16* Qf, const bf16* KdTf, const bf16* QKf, const bf16* Uf, const float* glb, float* o, int bh, int ds, LAS unsigned char* lds, int tid, int lane, int wave) {
    const int b = bh >> 3, h = bh & 7, fr = lane & 15, fq = lane >> 4, mt = wave & 3;
    asm volatile("" : "+v"(lds));
    LAS unsigned char* ST = lds; LAS unsigned char* VNT = lds + 4608;
    for (int i = tid; i < 4608 / 4; i += 512) ((LAS unsigned*)ST)[i] = 0u;
    f32x4 accS = {0.f, 0.f, 0.f, 0.f};
    const bf16* A1 = wave < 4 ? Wf : Qf;
    DnbFrag f0 = dnb_load(A1, QKf, KdTf, Uf, glb, (b * 128 + 0) * 8 + h, ds, wave, lane), f1 = dnb_load(A1, QKf, KdTf, Uf, glb, (b * 128 + 1) * 8 + h, ds, wave, lane);
    DnbFrag f2 = dnb_load(A1, QKf, KdTf, Uf, glb, (b * 128 + 2) * 8 + h, ds, wave, lane), f3 = dnb_load(A1, QKf, KdTf, Uf, glb, (b * 128 + 3) * 8 + h, ds, wave, lane);
    __syncthreads();
#define DNB_STEP(F, nn) do { const int n = (nn); \
        f32x4 acc = {0.f, 0.f, 0.f, 0.f}; \
        _Pragma("unroll") for (int ks = 0; ks < 4; ++ks) { const bf16x8 sb = *(const LAS bf16x8*)(ST + fr * 272 + (ks * 32 + fq * 8) * 2); acc = mfma16(F.a1[ks], sb, acc); } \
        if (wave < 4) { const float v0 = bflo(F.u.x) - acc[0], v1 = bfhi(F.u.x) - acc[1], v2 = bflo(F.u.y) - acc[2], v3 = bfhi(F.u.y) - acc[3]; \
            u32x2 w; w.x = pk2(v0, v1); w.y = pk2(v2, v3); *(LAS u32x2*)(VNT + fr * 144 + (mt * 16 + fq * 4) * 2) = w; } \
        LDS_BARRIER(); \
        bf16x8 vb[2]; \
        _Pragma("unroll") for (int ks = 0; ks < 2; ++ks) vb[ks] = *(const LAS bf16x8*)(VNT + fr * 144 + (ks * 32 + fq * 8) * 2); \
        accS = accS * F.gl; \
        _Pragma("unroll") for (int ks = 0; ks < 2; ++ks) accS = mfma16(F.kd[ks], vb[ks], accS); \
        { u32x2 w; w.x = pk2(accS[0], accS[1]); w.y = pk2(accS[2], accS[3]); *(LAS u32x2*)(ST + fr * 272 + (wave * 16 + fq * 4) * 2) = w; } \
        if (wave >= 4) { _Pragma("unroll") for (int ks = 0; ks < 2; ++ks) acc = mfma16(F.a2[ks], vb[ks], acc);     \
            const size_t ob = ((size_t)(b * SEQ + n * 64 + mt * 16 + fq * 4) * NH + h) * HD + ds * 16 + fr; \
            _Pragma("unroll") for (int r = 0; r < 4; ++r) o[ob + (size_t)r * NH * HD] = acc[r]; } \
        F = dnb_load(A1, QKf, KdTf, Uf, glb, (b * 128 + (n + 4 < 128 ? n + 4 : 127)) * 8 + h, ds, wave, lane);     \
        LDS_BARRIER(); } while (0)
    for (int n4 = 0; n4 < 128; n4 += 16) {
        DNB_STEP(f0, n4); DNB_STEP(f1, n4 + 1); DNB_STEP(f2, n4 + 2); DNB_STEP(f3, n4 + 3); DNB_STEP(f0, n4 + 4); DNB_STEP(f1, n4 + 5); DNB_STEP(f2, n4 + 6); DNB_STEP(f3, n4 + 7);
        DNB_STEP(f0, n4 + 8); DNB_STEP(f1, n4 + 9); DNB_STEP(f2, n4 + 10); DNB_STEP(f3, n4 + 11); DNB_STEP(f0, n4 + 12); DNB_STEP(f1, n4 + 13); DNB_STEP(f2, n4 + 14); DNB_STEP(f3, n4 + 15); }
#undef DNB_STEP
}
constexpr int LA_XB = 0, LA_XF = 17408, LA_END = LA_XF + 64 * 132 * 4;
static_assert(LA_END <= RING_BYTES, "LRU-A LDS map");
__device__ __forceinline__ void lrua_unit(const bf16* proj, const float* cw, const float* cb, const bf16* WrT, const bf16* WiT, const float* b_r, const float* b_i, const float* lam,
                                          float* Hloc, float* Acum, float* summ, int unit, LAS unsigned char* lds, int tid, int lane, int wave) {
    const int nb = unit & 7, ct = unit >> 3, n = ct & 127, t0 = ct * 64;
    asm volatile("" : "+v"(lds));
    {
        const int r = tid >> 3, cg = tid & 7, ch0 = nb * 128 + cg * 16;
        float acc[16];
        { const f32x4 c0v = *(const f32x4*)(cb + ch0), c1v = *(const f32x4*)(cb + ch0 + 4), c2v = *(const f32x4*)(cb + ch0 + 8), c3v = *(const f32x4*)(cb + ch0 + 12);
#pragma unroll
          for (int i = 0; i < 4; ++i) { acc[i] = c0v[i]; acc[4 + i] = c1v[i]; acc[8 + i] = c2v[i]; acc[12 + i] = c3v[i]; } }
#pragma unroll
        for (int k = 0; k < 4; ++k) { const int row = r - 3 + k;
            if (n * 64 + row >= 0) {
                const bf16* src = proj + (size_t)(t0 + row) * NPROJ + ch0;
                const u32x4 x0 = *(const u32x4*)src, x1 = *(const u32x4*)(src + 8);
                const float* wp = cw + k * DLRU + ch0;
                const f32x4 w0 = *(const f32x4*)wp, w1 = *(const f32x4*)(wp + 4), w2 = *(const f32x4*)(wp + 8), w3 = *(const f32x4*)(wp + 12);
                acc[0] += w0[0] * bflo(x0.x); acc[1] += w0[1] * bfhi(x0.x); acc[2] += w0[2] * bflo(x0.y); acc[3] += w0[3] * bfhi(x0.y);
                acc[4] += w1[0] * bflo(x0.z); acc[5] += w1[1] * bfhi(x0.z); acc[6] += w1[2] * bflo(x0.w); acc[7] += w1[3] * bfhi(x0.w);
                acc[8] += w2[0] * bflo(x1.x); acc[9] += w2[1] * bfhi(x1.x); acc[10] += w2[2] * bflo(x1.y); acc[11] += w2[3] * bfhi(x1.y);
                acc[12] += w3[0] * bflo(x1.z); acc[13] += w3[1] * bfhi(x1.z); acc[14] += w3[2] * bflo(x1.w); acc[15] += w3[3] * bfhi(x1.w);
            } }
        u32x4 o0, o1;
        o0.x = pk2(acc[0], acc[1]); o0.y = pk2(acc[2], acc[3]); o0.z = pk2(acc[4], acc[5]); o0.w = pk2(acc[6], acc[7]);
        o1.x = pk2(acc[8], acc[9]); o1.y = pk2(acc[10], acc[11]); o1.z = pk2(acc[12], acc[13]); o1.w = pk2(acc[14], acc[15]);
        *(LAS u32x4*)(lds + LA_XB + r * 272 + cg * 32) = o0; *(LAS u32x4*)(lds + LA_XB + r * 272 + cg * 32 + 16) = o1;
        LAS f32x4* xf = (LAS f32x4*)(lds + LA_XF + (r * 132 + cg * 16) * 4);
        xf[0] = (f32x4){acc[0], acc[1], acc[2], acc[3]}; xf[1] = (f32x4){acc[4], acc[5], acc[6], acc[7]}; xf[2] = (f32x4){acc[8], acc[9], acc[10], acc[11]}; xf[3] = (f32x4){acc[12], acc[13], acc[14], acc[15]};
    }
    LDS_BARRIER();
    const int fr = lane & 15, fq = lane >> 4, cl = wave * 16 + fr, ch = nb * 128 + cl;
    bf16x8 br[4], bi[4];
#pragma unroll
    for (int ks = 0; ks < 4; ++ks) { br[ks] = *(const bf16x8*)(WrT + ((size_t)nb * 128 + cl) * 128 + ks * 32 + fq * 8); bi[ks] = *(const bf16x8*)(WiT + ((size_t)nb * 128 + cl) * 128 + ks * 32 + fq * 8); }
    f32x4 ar[4], ai[4];
#pragma unroll
    for (int mt = 0; mt < 4; ++mt) { ar[mt] = (f32x4){0.f, 0.f, 0.f, 0.f}; ai[mt] = (f32x4){0.f, 0.f, 0.f, 0.f};
#pragma unroll
        for (int ks = 0; ks < 4; ++ks) { const bf16x8 af = *(const LAS bf16x8*)(lds + LA_XB + (mt * 16 + fr) * 272 + (ks * 32 + fq * 8) * 2); ar[mt] = mfma16(af, br[ks], ar[mt]); ai[mt] = mfma16(af, bi[ks], ai[mt]); } }
    const float brr = b_r[ch], bii = b_i[ch], sp8 = -8.0f * softplus_f(-lam[ch]);
    float Ac = 1.f, Bc = 0.f;
#pragma unroll
    for (int mt = 0; mt < 4; ++mt) {
        float P[4], H[4];
#pragma unroll
        for (int r = 0; r < 4; ++r) { const int t = mt * 16 + fq * 4 + r; const float xcv = *(const LAS float*)(lds + LA_XF + (t * 132 + cl) * 4);
            const float rr = sigmoid_f(ar[mt][r] + brr), ii = sigmoid_f(ai[mt][r] + bii), la = sp8 * rr, a = __expf(la), bb = __builtin_amdgcn_sqrtf(fmaxf(1.0f - a * a, 0.0f)) * (ii * xcv);
            if (r == 0) { P[0] = a; H[0] = bb; } else { P[r] = P[r - 1] * a; H[r] = a * H[r - 1] + bb; } }
        float Ai = P[3], Bi = H[3];
        { const float Au = shfl_up_l(Ai, 16, lane), Bu = shfl_up_l(Bi, 16, lane); if (fq >= 1) { Bi = Ai * Bu + Bi; Ai = Au * Ai; } }
        { const float Au = shfl_up_l(Ai, 32, lane), Bu = shfl_up_l(Bi, 32, lane); if (fq >= 2) { Bi = Ai * Bu + Bi; Ai = Au * Ai; } }
        float Ae = shfl_up_l(Ai, 16, lane), Be = shfl_up_l(Bi, 16, lane); if (fq == 0) { Ae = 1.f; Be = 0.f; }
        const float At = shfl_idx_l(Ai, 48 + fr), Bt = shfl_idx_l(Bi, 48 + fr);
        const float PA = Ac * Ae, PB = Ae * Bc + Be;
#pragma unroll
        for (int r = 0; r < 4; ++r) { const size_t o = (size_t)(t0 + mt * 16 + fq * 4 + r) * DLRU + ch; ((unsigned*)Hloc)[o] = pk2(P[r] * PB + H[r], PA * P[r]); }
        Bc = At * Bc + Bt; Ac = Ac * At;
    }
    if (fq == 0) { float* sp = summ + ((size_t)ct * DLRU + ch) * 2; sp[0] = Ac; sp[1] = Bc; }
    LDS_BARRIER();
}
__device__ __forceinline__ void lru_carry(const float* summ, float* carry, int idx) {
    const int b = idx >> 10, ch = idx & 1023; float c = 0.f;
    for (int n0 = 0; n0 < 128; n0 += 8) { float A[8], B[8];
#pragma unroll
        for (int j = 0; j < 8; ++j) { const float* sp = summ + ((size_t)(b * 128 + n0 + j) * DLRU + ch) * 2; A[j] = sp[0]; B[j] = sp[1]; }
#pragma unroll
        for (int j = 0; j < 8; ++j) { carry[(size_t)(b * 128 + n0 + j) * DLRU + ch] = c; c = A[j] * c + B[j]; } }
}
__device__ __forceinline__ void lrub_row(const float* Hloc, const float* Acum, const float* carry, const bf16* proj, const float* gain, bf16* ymix, int row, int lane) {
    const int ct = row >> 6; f32x4 y[4]; float ss = 0.f;
#pragma unroll
    for (int j = 0; j < 4; ++j) { const int c4 = lane * 4 + 256 * j;
        const u32x4 ha = *(const u32x4*)((const unsigned*)Hloc + (size_t)row * DLRU + c4); const f32x4 cr = *(const f32x4*)(carry + (size_t)ct * DLRU + c4);
        const u32x2 g = *(const u32x2*)(proj + (size_t)row * NPROJ + DLRU + c4);
        const f32x4 hl = {bflo(ha.x), bflo(ha.y), bflo(ha.z), bflo(ha.w)}, ac = {bfhi(ha.x), bfhi(ha.y), bfhi(ha.z), bfhi(ha.w)};
        const f32x4 hh = hl + ac * cr;
        y[j][0] = hh[0] * gelu_tanh_f(bflo(g.x)); y[j][1] = hh[1] * gelu_tanh_f(bfhi(g.x)); y[j][2] = hh[2] * gelu_tanh_f(bflo(g.y)); y[j][3] = hh[3] * gelu_tanh_f(bfhi(g.y));
        ss += (y[j][0] * y[j][0] + y[j][1] * y[j][1]) + (y[j][2] * y[j][2] + y[j][3] * y[j][3]); }
    ss = wave_sum(ss, lane); const float rs = rsqrt_f(ss * (1.0f / DLRU) + EPS);
#pragma unroll
    for (int j = 0; j < 4; ++j) { const int c4 = lane * 4 + 256 * j; const f32x4 g = *(const f32x4*)(gain + c4); u32x2 w; w.x = pk2(y[j][0] * rs * g[0], y[j][1] * rs * g[1]); w.y = pk2(y[j][2] * rs * g[2], y[j][3] * rs * g[3]);
        *(u32x2*)(ymix + (size_t)row * D + c4) = w; }
}
__device__ __forceinline__ void dn_out_row(const float* o, const float* gain, const bf16* proj, bf16* ymix, int t, int lane) {
    const int c = lane * 16;
    const f32x4* op = (const f32x4*)(o + (size_t)t * DDN + c); const f32x4 o0 = op[0], o1 = op[1], o2 = op[2], o3 = op[3];
    const u32x4* gp = (const u32x4*)(proj + (size_t)t * NPROJ + 5120 + c); const u32x4 g0 = gp[0], g1 = gp[1];
    const f32x4* wp = (const f32x4*)(gain + (c & 127)); const f32x4 w0 = wp[0], w1 = wp[1], w2 = wp[2], w3 = wp[3];
    float ss = (o0[0] * o0[0] + o0[1] * o0[1]) + (o0[2] * o0[2] + o0[3] * o0[3]) + (o1[0] * o1[0] + o1[1] * o1[1]) + (o1[2] * o1[2] + o1[3] * o1[3])
             + (o2[0] * o2[0] + o2[1] * o2[1]) + (o2[2] * o2[2] + o2[3] * o2[3]) + (o3[0] * o3[0] + o3[1] * o3[1]) + (o3[2] * o3[2] + o3[3] * o3[3]);
    ss += shfl_xor_l(ss, 1, lane); ss += shfl_xor_l(ss, 2, lane); ss += shfl_xor_l(ss, 4, lane);
    const float rs = rsqrt_f(ss * (1.0f / HD) + EPS);
    u32x4 r0, r1;
    r0.x = pk2(o0[0] * rs * w0[0] * silu_f(bflo(g0.x)), o0[1] * rs * w0[1] * silu_f(bfhi(g0.x))); r0.y = pk2(o0[2] * rs * w0[2] * silu_f(bflo(g0.y)), o0[3] * rs * w0[3] * silu_f(bfhi(g0.y)));
    r0.z = pk2(o1[0] * rs * w1[0] * silu_f(bflo(g0.z)), o1[1] * rs * w1[1] * silu_f(bfhi(g0.z))); r0.w = pk2(o1[2] * rs * w1[2] * silu_f(bflo(g0.w)), o1[3] * rs * w1[3] * silu_f(bfhi(g0.w)));
    r1.x = pk2(o2[0] * rs * w2[0] * silu_f(bflo(g1.x)), o2[1] * rs * w2[1] * silu_f(bfhi(g1.x))); r1.y = pk2(o2[2] * rs * w2[2] * silu_f(bflo(g1.y)), o2[3] * rs * w2[3] * silu_f(bfhi(g1.y)));
    r1.z = pk2(o3[0] * rs * w3[0] * silu_f(bflo(g1.z)), o3[1] * rs * w3[1] * silu_f(bfhi(g1.z))); r1.w = pk2(o3[2] * rs * w3[2] * silu_f(bflo(g1.w)), o3[3] * rs * w3[3] * silu_f(bfhi(g1.w)));
    u32x4* dst = (u32x4*)(ymix + (size_t)t * D + DLRU + c); dst[0] = r0; dst[1] = r1;
}
__device__ __forceinline__ void route_row(const float* x, const float* rstd, const float* gain, const float* router, float* roww, int row, int lane) {
    float acc[8];
#pragma unroll
    for (int e = 0; e < 8; ++e) acc[e] = 0.f;
    for (int j = 0; j < 32; ++j) { const int k = lane + 64 * j; const float xv = x[(size_t)row * D + k] * gain[k]; const f32x4 r0 = *(const f32x4*)(router + (size_t)k * 8), r1 = *(const f32x4*)(router + (size_t)k * 8 + 4);
        acc[0] += xv * r0[0]; acc[1] += xv * r0[1]; acc[2] += xv * r0[2]; acc[3] += xv * r0[3]; acc[4] += xv * r1[0]; acc[5] += xv * r1[1]; acc[6] += xv * r1[2]; acc[7] += xv * r1[3]; }
    const float rs = rstd[row];
#pragma unroll
    for (int e = 0; e < 8; ++e) acc[e] = wave_sum(acc[e], lane) * rs;
    int e1 = 0; float l1 = acc[0];
#pragma unroll
    for (int e = 1; e < 8; ++e) if (acc[e] > l1) { l1 = acc[e]; e1 = e; }
    int e2 = -1; float l2 = -3.4e38f;
#pragma unroll
    for (int e = 0; e < 8; ++e) if (e != e1 && acc[e] > l2) { l2 = acc[e]; e2 = e; }
    const float w1 = 1.0f / (1.0f + __expf(l2 - l1)), w2 = 1.0f - w1;
    if (lane < 8) roww[(size_t)lane * T + row] = lane == e1 ? w1 : (lane == e2 ? w2 : 0.0f);
}
__device__ __forceinline__ void final_row(const float* x, const float* gain, float* out, int row, int lane) {
    const f32x4* xr = (const f32x4*)(x + (size_t)row * D) + lane; const f32x4* gr = (const f32x4*)gain + lane;
    f32x4 v[8]; float ss = 0.f;
#pragma unroll
    for (int j = 0; j < 8; ++j) { v[j] = xr[64 * j]; ss += (v[j][0] * v[j][0] + v[j][1] * v[j][1]) + (v[j][2] * v[j][2] + v[j][3] * v[j][3]); }
    ss = wave_sum(ss, lane); const float rs = rsqrt_f(ss * (1.0f / D) + EPS);
    f32x4* o = (f32x4*)(out + (size_t)row * D) + lane;
#pragma unroll
    for (int j = 0; j < 8; ++j) o[64 * j] = v[j] * rs * gr[64 * j];
}

struct MoeOrder {
    const int* list; int nN, G, c; int c0, c1, c2, c3, c4, c5, c6, c7;
    __device__ __forceinline__ void init(const unsigned* cnt, const int* list_, int nN_, int G_, int c_) { list = list_; nN = nN_; G = G_; c = c_;
        c0 = __builtin_amdgcn_readfirstlane((int)cnt[0]); c1 = __builtin_amdgcn_readfirstlane((int)cnt[1]); c2 = __builtin_amdgcn_readfirstlane((int)cnt[2]); c3 = __builtin_amdgcn_readfirstlane((int)cnt[3]);
        c4 = __builtin_amdgcn_readfirstlane((int)cnt[4]); c5 = __builtin_amdgcn_readfirstlane((int)cnt[5]); c6 = __builtin_amdgcn_readfirstlane((int)cnt[6]); c7 = __builtin_amdgcn_readfirstlane((int)cnt[7]); }
    __device__ __forceinline__ bool next(int i, pg8::Unit& u) const {
        const int c8[8] = {c0, c1, c2, c3, c4, c5, c6, c7}; int nM = 0;
#pragma unroll
        for (int k = 0; k < 8; ++k) nM += (c8[k] + 255) >> 8;
        const int nwg = nM * nN; const long L = (long)i * G + c; if (L >= nwg) return false;
        int wgid = (int)L; { const int q = nwg / pg8::NXCD, r = nwg % pg8::NXCD, xcd = wgid % pg8::NXCD, off = wgid / pg8::NXCD; wgid = (xcd < r ? xcd * (q + 1) : r * (q + 1) + (xcd - r) * q) + off; }
        const int nig = pg8::WGM * nN, gid = wgid / nig, fm = gid * pg8::WGM, gsz = (nM - fm) < pg8::WGM ? (nM - fm) : pg8::WGM;
        u.pm = fm + ((wgid % nig) % gsz); u.pn = (wgid % nig) / gsz;
        int e = 0, ps = 0, ce = c8[0], run = 0;
#pragma unroll
        for (int k = 0; k < 8; ++k) { const int mk = (c8[k] + 255) >> 8; if (u.pm >= run && u.pm < run + mk) { e = k; ps = run; ce = c8[k]; } run += mk; }
        const int mtl = u.pm - ps; u.pb = e * nN + u.pn; u.lbase = e * T + mtl * 256; u.nvalid = (ce - mtl * 256) < 256 ? (ce - mtl * 256) : 256;
        return true;
    }
    __device__ __forceinline__ int arow(const pg8::Unit& u, int r) const { return r < u.nvalid ? (list[u.lbase + r] & 0xffff) : 0; }
    __device__ __forceinline__ void a_ready(const pg8::Unit&) const {}
    __device__ __forceinline__ void done(const pg8::Unit&) const {}
};
__device__ __forceinline__ void route_block(const float* x, const float* gain, const float* router, bf16* xb, float* rstd, unsigned* cnt, int* list, float* listw, int blk, LAS unsigned char* lds, int tid, int lane, int wave) {
    asm volatile("" : "+v"(lds));
    LAS float* grt = (LAS float*)lds; LAS int* se1 = (LAS int*)(lds + 65536); LAS int* se2 = se1 + 64; LAS float* sw1 = (LAS float*)(se2 + 64); LAS float* sw2 = sw1 + 64; LAS int* lcnt = (LAS int*)(sw2 + 64); LAS int* gbase = lcnt + 8;
    for (int i = tid; i < D * 8; i += 512) grt[i] = router[i] * gain[i >> 3];
    if (tid < 8) lcnt[tid] = 0;
    __syncthreads();
    for (int q = 0; q < 8; ++q) { const int rloc = wave * 8 + q, row = blk * 64 + rloc;
        const f32x4* xr = (const f32x4*)(x + (size_t)row * D) + lane;
        f32x4 v[8]; float ss = 0.f;
#pragma unroll
        for (int j = 0; j < 8; ++j) { v[j] = xr[64 * j]; ss += (v[j][0] * v[j][0] + v[j][1] * v[j][1]) + (v[j][2] * v[j][2] + v[j][3] * v[j][3]); }
        ss = wave_sum(ss, lane); const float rs = rsqrt_f(ss * (1.0f / D) + EPS);
        u32x2* o = (u32x2*)(xb + (size_t)row * D) + lane;
#pragma unroll
        for (int j = 0; j < 8; ++j) { u32x2 w; w.x = pk2(v[j][0], v[j][1]); w.y = pk2(v[j][2], v[j][3]); o[64 * j] = w; }
        if (lane == 0) rstd[row] = rs;
        float acc[8];
#pragma unroll
        for (int e = 0; e < 8; ++e) acc[e] = 0.f;
#pragma unroll
        for (int j = 0; j < 8; ++j)
#pragma unroll
            for (int c = 0; c < 4; ++c) { const int k = (lane + 64 * j) * 4 + c; const f32x4 r0 = *(const LAS f32x4*)(grt + k * 8), r1 = *(const LAS f32x4*)(grt + k * 8 + 4); const float xv = v[j][c];
                acc[0] += xv * r0[0]; acc[1] += xv * r0[1]; acc[2] += xv * r0[2]; acc[3] += xv * r0[3]; acc[4] += xv * r1[0]; acc[5] += xv * r1[1]; acc[6] += xv * r1[2]; acc[7] += xv * r1[3]; }
#pragma unroll
        for (int e = 0; e < 8; ++e) acc[e] = wave_sum(acc[e], lane) * rs;
        int e1 = 0; float l1 = acc[0];
#pragma unroll
        for (int e = 1; e < 8; ++e) if (acc[e] > l1) { l1 = acc[e]; e1 = e; }
        int e2 = -1; float l2 = -3.4e38f;
#pragma unroll
        for (int e = 0; e < 8; ++e) if (e != e1 && acc[e] > l2) { l2 = acc[e]; e2 = e; }
        const float w1 = 1.0f / (1.0f + __expf(l2 - l1));
        if (lane == 0) { se1[rloc] = e1; se2[rloc] = e2; sw1[rloc] = w1; sw2[rloc] = 1.0f - w1; }
    }
    __syncthreads();
    int e = 0, lr = 0; float w = 0.f;
    if (tid < 128) { const int rloc = tid >> 1, j = tid & 1; e = j ? se2[rloc] : se1[rloc]; w = j ? sw2[rloc] : sw1[rloc]; lr = __hip_atomic_fetch_add(lcnt + e, 1, __ATOMIC_RELAXED, __HIP_MEMORY_SCOPE_WORKGROUP); }
    __syncthreads();
    if (tid < 8) gbase[tid] = (int)__hip_atomic_fetch_add(cnt + tid, (unsigned)lcnt[tid], __ATOMIC_RELAXED, __HIP_MEMORY_SCOPE_AGENT);
    __syncthreads();
    if (tid < 128) { const int pos = gbase[e] + lr, tok = blk * 64 + (tid >> 1); list[e * T + pos] = tok | ((tid & 1) << 16); listw[e * T + pos] = w; }
    __syncthreads();
}
__device__ __forceinline__ void final_row_moe(const float* x, const bf16* y0, const bf16* y1, const float* gain, float* out, int row, int lane) {
    const f32x4* xr = (const f32x4*)(x + (size_t)row * D) + lane; const f32x4* gr = (const f32x4*)gain + lane;
    const u32x2* p0 = (const u32x2*)(y0 + (size_t)row * D) + lane; const u32x2* p1 = (const u32x2*)(y1 + (size_t)row * D) + lane;
    f32x4 v[8]; float ss = 0.f;
#pragma unroll
    for (int j = 0; j < 8; ++j) { v[j] = xr[64 * j]; const u32x2 a = p0[64 * j], b = p1[64 * j];
        v[j][0] += bflo(a.x) + bflo(b.x); v[j][1] += bfhi(a.x) + bfhi(b.x); v[j][2] += bflo(a.y) + bflo(b.y); v[j][3] += bfhi(a.y) + bfhi(b.y);
        ss += (v[j][0] * v[j][0] + v[j][1] * v[j][1]) + (v[j][2] * v[j][2] + v[j][3] * v[j][3]); }
    ss = wave_sum(ss, lane); const float rs = rsqrt_f(ss * (1.0f / D) + EPS);
    f32x4* o = (f32x4*)(out + (size_t)row * D) + lane;
#pragma unroll
    for (int j = 0; j < 8; ++j) o[64 * j] = v[j] * rs * gr[64 * j];
}
__device__ __forceinline__ void ba_tail(const bf16* xbp, const bf16* wbab, const float* ssq, int mode, float* bap, int rb, int wave, int lane) {
    if (wave < 4) { const int fr = lane & 15, fq = lane >> 4, r0 = rb * 64 + wave * 16;
        const bf16* ap = xbp + (size_t)(r0 + fr) * D + fq * 8; const bf16* bp = wbab + (size_t)fr * D + fq * 8;
        f32x4 acc = {0.f, 0.f, 0.f, 0.f};
#pragma unroll 16
        for (int ks = 0; ks < 64; ++ks) { const bf16x8 a = *(const bf16x8*)(ap + ks * 32), b = *(const bf16x8*)(bp + ks * 32); acc = mfma16(a, b, acc); }
#pragma unroll
        for (int rr = 0; rr < 4; ++rr) { const int r = r0 + fq * 4 + rr; bap[(size_t)r * 16 + fr] = acc[rr] * pg8::row_scale(ssq, r, mode); } }
}
struct Args { const float* in[25]; float* out; unsigned char* ws; int ph_lo, ph_hi; };
typedef const __attribute__((address_space(4))) unsigned long long* kaptr_t;
__device__ __forceinline__ unsigned long long ldka(int i) { kaptr_t ka = (kaptr_t)__builtin_amdgcn_kernarg_segment_ptr(); asm volatile("" : "+s"(i)); return ka[i]; }
__device__ __forceinline__ const float* ldin(const Args&, int i) { return (const float*)(const GAS float*)ldka(i); }
__device__ __forceinline__ unsigned char* ldws(const Args&) { return (unsigned char*)(GAS unsigned char*)ldka(26); }
__device__ __forceinline__ float* ldout(const Args&) { return (float*)(GAS float*)ldka(25); }
__global__ void __launch_bounds__(512, 2) mega(Args args) {
    extern __shared__ __attribute__((aligned(16))) unsigned char lds_raw[];
    LAS unsigned char* lds = (LAS unsigned char*)lds_raw;
    volatile LAS unsigned* MISC = (volatile LAS unsigned*)(lds + MISC_OFF);
    const int tid = threadIdx.x;
    const int G = gridDim.x, bid = blockIdx.x, NGW = G * 8;
    unsigned char* ws = ldws(args);
    for (int u = tid; u < (LDS_BYTES - LDSCTL_OFF) / 4; u += 512) ((LAS unsigned*)(lds + LDSCTL_OFF))[u] = 0u;
    __syncthreads();
    (void)xcd_barrier_post((unsigned*)(ws + WS_CTL) + CW_BAR, MISC + 8);
#define RUN(id) true
#if defined(PROBE_MASK)
#define STAMP() do { if (threadIdx.x == 0) { ((volatile LAS unsigned long long*)(lds + LDSCTL_OFF + 1024))[nst] = __builtin_amdgcn_s_memrealtime(); } ++nst; } while (0)
#else
#define STAMP() do { } while (0)
#endif
#define SEAM(id) do { XcdBarrier bar_; bar_.bar = (unsigned*)WSP(WS_CTL) + CW_BAR; bar_.x = xb_xcc_id(); bar_.st = (volatile LAS unsigned*)(lds + MISC_OFF) + 8; xcd_barrier(bar_); STAMP(); } while (0)
#if defined(PROBE_MASK)
    int nst = 0; STAMP();
#endif
#define INP(i) ldin(args, (i))
#define WSP(off) (ldws(args) + (off))
#define x_in INP(0)
#define norm_mix INP(1)
#define w_in INP(2)
#define conv_lru_w INP(3)
#define conv_lru_b INP(4)
#define lru_w_r INP(5)
#define lru_b_r INP(6)
#define lru_w_i INP(7)
#define lru_b_i INP(8)
#define lru_lambda INP(9)
#define lru_out_norm INP(10)
#define conv_qkv_w INP(11)
#define dn_a_log INP(12)
#define dn_dt_bias INP(13)
#define dn_out_norm INP(14)
#define w_out INP(15)
#define norm_ffn INP(16)
#define ffn_w_gate INP(17)
#define ffn_w_up INP(18)
#define ffn_w_down INP(19)
#define moe_router INP(20)
#define moe_w_gate INP(21)
#define moe_w_up INP(22)
#define moe_w_down INP(23)
#define norm_final INP(24)
#define xres (ldout(args))
#define Win ((bf16*)WSP(WS_WIN))
#define Wba ((float*)WSP(WS_WBA))
#define Wout ((bf16*)WSP(WS_WOUT))
#define Wgu ((bf16*)WSP(WS_WGU))
#define Wd ((bf16*)WSP(WS_WD))
#define Mgu ((bf16*)WSP(WS_C))
#define Md ((bf16*)WSP(WS_WGU))
#define MCNT ((unsigned*)WSP(WS_CTL) + CW_CNT)
#define MLIST ((int*)WSP(WS_ROWW))
#define MLISTW ((float*)WSP(WS_ROWW + (size_t)8 * T * 4))
#define YP0 ((bf16*)WSP(WS_XB))
#define YP1 ((bf16*)WSP(WS_YMIX))
#define xb ((bf16*)WSP(WS_XB))
#define rstd ((float*)WSP(WS_RSTD))
#define SSQA ((float*)WSP(WS_RSTD + (size_t)1 * MiB))
#define SSQB ((float*)WSP(WS_RSTD + (size_t)3 * MiB))
#define WBAB ((bf16*)WSP(WS_WBA + (size_t)2 * 16 * D * 4))
#define ba ((float*)WSP(WS_BA))
#define beta ((float*)WSP(WS_BETA))
#define gg ((float*)WSP(WS_G))
#define roww ((float*)WSP(WS_ROWW))
#define proj ((bf16*)WSP(WS_PROJ))
#define hid ((bf16*)WSP(WS_PROJ))
#define ymix ((bf16*)WSP(WS_YMIX))
#define c0 ((float*)WSP(WS_C))
#define c1 ((float*)WSP(WS_C + (size_t)T * 1024 * 4))
#define c2 ((float*)WSP(WS_C + (size_t)2 * T * 1024 * 4))
#define c3 ((float*)WSP(WS_C + (size_t)3 * T * 1024 * 4))
#define LRU_WRT ((bf16*)WSP(WS_WRT))
#define LRU_WIT ((bf16*)WSP(WS_WRT + (size_t)2 * 8 * 128 * 128 * 2))
#define LRU_H ((float*)WSP(WS_C + (size_t)256 * MiB))
#define LRU_A ((float*)WSP(WS_C + (size_t)320 * MiB))
#define LRU_SUMM ((float*)WSP(WS_C + (size_t)384 * MiB))
#define LRU_CARRY ((float*)WSP(WS_C + (size_t)386 * MiB))
#define DN_WF ((bf16*)WSP(WS_C))
#define DN_QF ((bf16*)WSP(WS_C + (size_t)32 * MiB))
#define DN_KDTF ((bf16*)WSP(WS_C + (size_t)64 * MiB))
#define DN_UF ((bf16*)WSP(WS_C + (size_t)96 * MiB))
#define DN_QKF ((bf16*)WSP(WS_C + (size_t)128 * MiB))
#define DN_GL ((float*)WSP(WS_C + (size_t)144 * MiB))
    const int BIG = 1 << 30;
#define PHL int tid_ = threadIdx.x; asm volatile("" : "+v"(tid_)); const int lane_ = tid_ & 63; int bid_ = blockIdx.x; asm volatile("" : "+s"(bid_)); const int gw_ = bid_ * 8 + __builtin_amdgcn_readfirstlane(tid_ >> 6); const size_t gt_ = (size_t)bid_ * 512 + tid_, NGT = (size_t)G * 512; LAS float* scr = (LAS float*)(lds + (gw_ & 7) * 16384);
    if (RUN(ph)) { PHL
        convert_matrix(w_in, DIN, 0, D, NPROJ, norm_mix, Win, BIG, 0, 0, scr, gw_, NGW, lane_);
        convert_matrix(w_out, D, 0, D, D, nullptr, Wout, BIG, 0, 0, scr, gw_, NGW, lane_);
        for (size_t i = gt_; i < (size_t)2 * 16 * D; i += NGT) { const int l = (int)(i / (16 * D)), j = (int)((i / D) & 15), k = (int)(i % D); WBAB[i] = (bf16)f2bf(w_in[(size_t)l * D * DIN + (size_t)k * DIN + NPROJ + j] * norm_mix[l * D + k]); }
        for (int r = gw_; r < T; r += NGW) rowprep_row(x_in, xb, rstd, nullptr, nullptr, r, lane_);
        for (int m = 0; m < 16; ++m) {
            convert_matrix(lru_w_r + (size_t)m * 128 * 128, 128, 0, 128, 128, nullptr, LRU_WRT + (size_t)m * 128 * 128, BIG, 0, 0, scr, gw_, NGW, lane_);
            convert_matrix(lru_w_i + (size_t)m * 128 * 128, 128, 0, 128, 128, nullptr, LRU_WIT + (size_t)m * 128 * 128, BIG, 0, 0, scr, gw_, NGW, lane_); }
    }
    SEAM(ph);
    int xsel = 0;
#define xcur (xsel ? (const float*)xres : x_in)
    { constexpr int l = 0;
        if (RUN(ph)) { pg8::Gemm g{xb, Win + (size_t)l * NPROJ * D, T, NPROJ, D, 0}; pg8::StaticOrder S; S.init(T, NPROJ, G, bid); pg8::EpiScaleBf16 E{proj, l == 0 ? rstd : SSQB, NPROJ, l};
            pg8::gemm_phase<pg8::EpiScaleBf16, pg8::StaticOrder, true, false>(lds, g, S, E);
            { PHL for (int rb = bid_; rb < T / 64; rb += G) ba_tail(xb, WBAB + (size_t)l * 16 * D, l == 0 ? rstd : SSQB, l, ba, rb, gw_ & 7, lane_); } }
        SEAM(ph);
        if (RUN(ph)) { PHL
            for (int u = bid_; u < 2048; u += G) lrua_unit(proj, conv_lru_w + (size_t)l * 4 * DLRU, conv_lru_b + l * DLRU, LRU_WRT + (size_t)l * 8 * 128 * 128, LRU_WIT + (size_t)l * 8 * 128 * 128, lru_b_r + l * DLRU, lru_b_i + l * DLRU, lru_lambda + l * DLRU, LRU_H, LRU_A, LRU_SUMM, u, lds, tid_, lane_, gw_ & 7);
            STAMP();
            for (int uid = bid_; uid < 2048; uid += G) dna_unit(proj, conv_qkv_w + (size_t)l * 4 * 3 * DDN, ba, dn_a_log + l * NH, dn_dt_bias + l * NH, DN_WF, DN_QF, DN_KDTF, DN_QKF, DN_UF, DN_GL, uid, lds, tid_, lane_, gw_ & 7); }
        SEAM(ph);
        if (RUN(ph)) { PHL
            if (bid_ < 128) dnb_run(DN_WF, DN_QF, DN_KDTF, DN_QKF, DN_UF, DN_GL, c3, (bid_ & 7) + 8 * (bid_ >> 6), (bid_ >> 3) & 7, lds, tid_, lane_, gw_ & 7);
            else if (bid_ < 136) { if (tid_ < 256) lru_carry(LRU_SUMM, LRU_CARRY, (bid_ - 128) * 256 + tid_); }
            else { const int cw = gw_ - 136 * 8, CNW = NGW - 136 * 8;
                if (l == 0) {
                    convert_matrix(w_in + (size_t)D * DIN, DIN, 0, D, NPROJ, norm_mix + D, Win + (size_t)NPROJ * D, BIG, 0, 0, scr, cw, CNW, lane_);
                    convert_matrix(w_out + (size_t)D * D, D, 0, D, D, nullptr, Wout + (size_t)D * D, BIG, 0, 0, scr, cw, CNW, lane_);
                    convert_matrix(ffn_w_gate, DFF, 0, D, DFF, norm_ffn, Wgu, 128, 256, 0, scr, cw, CNW, lane_);
                    convert_matrix(ffn_w_up, DFF, 0, D, DFF, norm_ffn, Wgu, 128, 256, 128, scr, cw, CNW, lane_);
                    convert_matrix(ffn_w_down, D, 0, DFF, D, nullptr, Wd, BIG, 0, 0, scr, cw, CNW, lane_);
                } else {
                    for (int e = 0; e < NEXP; ++e) convert_matrix(moe_w_down + (size_t)e * DFFE * D, D, 0, DFFE, D, nullptr, Md + (size_t)e * D * DFFE, BIG, 0, 0, scr, cw, CNW, lane_);
                } } }
        SEAM(ph);
        if (RUN(ph)) { PHL
            for (int r = gw_; r < T; r += NGW) lrub_row(LRU_H, LRU_A, LRU_CARRY, proj, lru_out_norm + l * DLRU, ymix, r, lane_);
            for (int r = gw_; r < T; r += NGW) dn_out_row(c3, dn_out_norm + l * HD, proj, ymix, r, lane_); }
        SEAM(ph);
        if (RUN(ph)) { if (l == 0) { pg8::Gemm g{ymix, Wout, T, D, D, 0}; pg8::StaticOrder S; S.init(T, D, G, bid); pg8::EpiResidualNorm E{xcur, xres, xb, SSQA, D, 0};
            pg8::gemm_phase<pg8::EpiResidualNorm, pg8::StaticOrder, true, false>(lds, g, S, E); }
          else { pg8::Gemm g{ymix, Wout + (size_t)D * D, T, D, D, 0}; pg8::StaticOrder S; S.init(T, D, G, bid); pg8::EpiResidual E{xcur, xres, nullptr, D, 0};
            pg8::gemm_phase<pg8::EpiResidual, pg8::StaticOrder, true, false>(lds, g, S, E); }
            if (l == 1) { PHL
                for (int e = 0; e < NEXP; ++e) {
                    convert_matrix(moe_w_gate + (size_t)e * D * DFFE, DFFE, 0, D, DFFE, norm_ffn + D, Mgu + (size_t)e * 2 * DFFE * D, 128, 256, 0, scr, gw_, NGW, lane_);
                    convert_matrix(moe_w_up + (size_t)e * D * DFFE, DFFE, 0, D, DFFE, norm_ffn + D, Mgu + (size_t)e * 2 * DFFE * D, 128, 256, 128, scr, gw_, NGW, lane_);
 } } }
        SEAM(ph);
        xsel = 1;
        if (l == 0) {
            if (RUN(ph)) { pg8::Gemm g{xb, Wgu, T, 2 * DFF, D, 0}; pg8::StaticOrder S; S.init(T, 2 * DFF, G, bid); pg8::EpiSwiGLU E{hid, SSQA, DFF, 1};
                pg8::gemm_phase<pg8::EpiSwiGLU, pg8::StaticOrder, true, false>(lds, g, S, E); }
            SEAM(ph);
            if (RUN(ph)) { pg8::Gemm g{hid, Wd, T, D, DFF, 0}; pg8::StaticOrder S; S.init(T, D, G, bid); pg8::EpiResidualNorm E{xcur, xres, xb, SSQB, D, 0};
                pg8::gemm_phase<pg8::EpiResidualNorm, pg8::StaticOrder, true, false>(lds, g, S, E); }
            SEAM(ph);
        } else {
            if (RUN(ph)) { PHL for (int blk = bid_; blk < T / 64; blk += G) route_block(xcur, norm_ffn + D, moe_router, xb, rstd, MCNT, MLIST, MLISTW, blk, lds, tid_, lane_, gw_ & 7); }
            SEAM(ph);
            if (RUN(ph)) { pg8::Gemm g{xb, Mgu, NSLOT, 2 * DFFE, D, 0}; MoeOrder S; S.init(MCNT, MLIST, 2 * DFFE / 256, G, bid); pg8::EpiSwiGLUMoe E{hid, rstd, MLIST, DFFE, 0};
                pg8::gemm_phase<pg8::EpiSwiGLUMoe, MoeOrder, true, true>(lds, g, S, E); }
            SEAM(ph);
            if (RUN(ph)) { pg8::Gemm g{hid, Md, NSLOT, D, DFFE, 0}; MoeOrder S; S.init(MCNT, MLIST, D / 256, G, bid); pg8::EpiMoeDown E{YP0, YP1, MLIST, MLISTW, D, 0};
                pg8::gemm_phase<pg8::EpiMoeDown, MoeOrder, true, false>(lds, g, S, E); }
            SEAM(ph);
        }
    }
    { constexpr int l = 1;
        if (RUN(ph)) { pg8::Gemm g{xb, Win + (size_t)l * NPROJ * D, T, NPROJ, D, 0}; pg8::StaticOrder S; S.init(T, NPROJ, G, bid); pg8::EpiScaleBf16 E{proj, l == 0 ? rstd : SSQB, NPROJ, l};
            pg8::gemm_phase<pg8::EpiScaleBf16, pg8::StaticOrder, true, false>(lds, g, S, E);
            { PHL for (int rb = bid_; rb < T / 64; rb += G) ba_tail(xb, WBAB + (size_t)l * 16 * D, l == 0 ? rstd : SSQB, l, ba, rb, gw_ & 7, lane_); } }
        SEAM(ph);
        if (RUN(ph)) { PHL
            for (int u = bid_; u < 2048; u += G) lrua_unit(proj, conv_lru_w + (size_t)l * 4 * DLRU, conv_lru_b + l * DLRU, LRU_WRT + (size_t)l * 8 * 128 * 128, LRU_WIT + (size_t)l * 8 * 128 * 128, lru_b_r + l * DLRU, lru_b_i + l * DLRU, lru_lambda + l * DLRU, LRU_H, LRU_A, LRU_SUMM, u, lds, tid_, lane_, gw_ & 7);
            STAMP();
            for (int uid = bid_; uid < 2048; uid += G) dna_unit(proj, conv_qkv_w + (size_t)l * 4 * 3 * DDN, ba, dn_a_log + l * NH, dn_dt_bias + l * NH, DN_WF, DN_QF, DN_KDTF, DN_QKF, DN_UF, DN_GL, uid, lds, tid_, lane_, gw_ & 7); }
        SEAM(ph);
        if (RUN(ph)) { PHL
            if (bid_ < 128) dnb_run(DN_WF, DN_QF, DN_KDTF, DN_QKF, DN_UF, DN_GL, c3, (bid_ & 7) + 8 * (bid_ >> 6), (bid_ >> 3) & 7, lds, tid_, lane_, gw_ & 7);
            else if (bid_ < 136) { if (tid_ < 256) lru_carry(LRU_SUMM, LRU_CARRY, (bid_ - 128) * 256 + tid_); }
            else { const int cw = gw_ - 136 * 8, CNW = NGW - 136 * 8;
                if (l == 0) {
                    convert_matrix(w_in + (size_t)D * DIN, DIN, 0, D, NPROJ, norm_mix + D, Win + (size_t)NPROJ * D, BIG, 0, 0, scr, cw, CNW, lane_);
                    convert_matrix(w_out + (size_t)D * D, D, 0, D, D, nullptr, Wout + (size_t)D * D, BIG, 0, 0, scr, cw, CNW, lane_);
                    convert_matrix(ffn_w_gate, DFF, 0, D, DFF, norm_ffn, Wgu, 128, 256, 0, scr, cw, CNW, lane_);
                    convert_matrix(ffn_w_up, DFF, 0, D, DFF, norm_ffn, Wgu, 128, 256, 128, scr, cw, CNW, lane_);
                    convert_matrix(ffn_w_down, D, 0, DFF, D, nullptr, Wd, BIG, 0, 0, scr, cw, CNW, lane_);
                } else {
                    for (int e = 0; e < NEXP; ++e) convert_matrix(moe_w_down + (size_t)e * DFFE * D, D, 0, DFFE, D, nullptr, Md + (size_t)e * D * DFFE, BIG, 0, 0, scr, cw, CNW, lane_);
                } } }
        SEAM(ph);
        if (RUN(ph)) { PHL
            for (int r = gw_; r < T; r += NGW) lrub_row(LRU_H, LRU_A, LRU_CARRY, proj, lru_out_norm + l * DLRU, ymix, r, lane_);
            for (int r = gw_; r < T; r += NGW) dn_out_row(c3, dn_out_norm + l * HD, proj, ymix, r, lane_); }
        SEAM(ph);
        if (RUN(ph)) { if (l == 0) { pg8::Gemm g{ymix, Wout, T, D, D, 0}; pg8::StaticOrder S; S.init(T, D, G, bid); pg8::EpiResidualNorm E{xcur, xres, xb, SSQA, D, 0};
            pg8::gemm_phase<pg8::EpiResidualNorm, pg8::StaticOrder, true, false>(lds, g, S, E); }
          else { pg8::Gemm g{ymix, Wout + (size_t)D * D, T, D, D, 0}; pg8::StaticOrder S; S.init(T, D, G, bid); pg8::EpiResidual E{xcur, xres, nullptr, D, 0};
            pg8::gemm_phase<pg8::EpiResidual, pg8::StaticOrder, true, false>(lds, g, S, E); }
            if (l == 1) { PHL
                for (int e = 0; e < NEXP; ++e) {
                    convert_matrix(moe_w_gate + (size_t)e * D * DFFE, DFFE, 0, D, DFFE, norm_ffn + D, Mgu + (size_t)e * 2 * DFFE * D, 128, 256, 0, scr, gw_, NGW, lane_);
                    convert_matrix(moe_w_up + (size_t)e * D * DFFE, DFFE, 0, D, DFFE, norm_ffn + D, Mgu + (size_t)e * 2 * DFFE * D, 128, 256, 128, scr, gw_, NGW, lane_);
 } } }
        SEAM(ph);
        xsel = 1;
        if (l == 0) {
            if (RUN(ph)) { pg8::Gemm g{xb, Wgu, T, 2 * DFF, D, 0}; pg8::StaticOrder S; S.init(T, 2 * DFF, G, bid); pg8::EpiSwiGLU E{hid, SSQA, DFF, 1};
                pg8::gemm_phase<pg8::EpiSwiGLU, pg8::StaticOrder, true, false>(lds, g, S, E); }
            SEAM(ph);
            if (RUN(ph)) { pg8::Gemm g{hid, Wd, T, D, DFF, 0}; pg8::StaticOrder S; S.init(T, D, G, bid); pg8::EpiResidualNorm E{xcur, xres, xb, SSQB, D, 0};
                pg8::gemm_phase<pg8::EpiResidualNorm, pg8::StaticOrder, true, false>(lds, g, S, E); }
            SEAM(ph);
        } else {
            if (RUN(ph)) { PHL for (int blk = bid_; blk < T / 64; blk += G) route_block(xcur, norm_ffn + D, moe_router, xb, rstd, MCNT, MLIST, MLISTW, blk, lds, tid_, lane_, gw_ & 7); }
            SEAM(ph);
            if (RUN(ph)) { pg8::Gemm g{xb, Mgu, NSLOT, 2 * DFFE, D, 0}; MoeOrder S; S.init(MCNT, MLIST, 2 * DFFE / 256, G, bid); pg8::EpiSwiGLUMoe E{hid, rstd, MLIST, DFFE, 0};
                pg8::gemm_phase<pg8::EpiSwiGLUMoe, MoeOrder, true, true>(lds, g, S, E); }
            SEAM(ph);
            if (RUN(ph)) { pg8::Gemm g{hid, Md, NSLOT, D, DFFE, 0}; MoeOrder S; S.init(MCNT, MLIST, D / 256, G, bid); pg8::EpiMoeDown E{YP0, YP1, MLIST, MLISTW, D, 0};
                pg8::gemm_phase<pg8::EpiMoeDown, MoeOrder, true, false>(lds, g, S, E); }
            SEAM(ph);
        }
    }
    if (RUN(ph)) { PHL for (int r = gw_; r < T; r += NGW) final_row_moe(xcur, YP0, YP1, norm_final, xres, r, lane_); }
#if defined(PROBE_MASK)
    __syncthreads(); STAMP();
    if (blockIdx.x == 0 && threadIdx.x == 0) { asm volatile("s_waitcnt vmcnt(0)" ::: "memory"); volatile LAS unsigned long long* st = (volatile LAS unsigned long long*)(lds + LDSCTL_OFF + 1024); unsigned long long tot = 0;
        for (int k = 1; k < nst; ++k) if ((PROBE_MASK >> (k - 1)) & 1ull) tot += st[k] - st[k - 1];
        xres[0] = rintf((float)tot * 0.01f * PROBE_SCALE); }
#endif
#if defined(PROBE_DNA_A)
    __syncthreads();
    if (blockIdx.x == 0 && threadIdx.x == 0) { asm volatile("s_waitcnt vmcnt(0)" ::: "memory"); volatile LAS unsigned long long* st = (volatile LAS unsigned long long*)(lds + (RING_BYTES + 2048));
        xres[0] = rintf((float)(st[PROBE_DNA_B] - st[PROBE_DNA_A]) * 0.01f * PROBE_SCALE); }
#endif
#undef RUN
#undef SEAM
}

extern "C" void kernel_launch(void* const* d_in, const int* in_sizes, int n_in, void* d_out, int out_size, void* d_ws, size_t ws_size, hipStream_t stream) {
    static int grid = 0;
    if (grid == 0) {
        if (n_in != 25 || ws_size < WS_END) { fprintf(stderr, "kernel_launch: unexpected n_in %d / ws_size %zu (need %zu)\n", n_in, ws_size, (size_t)WS_END); grid = -1; return; }
        int dev = 0, cus = 0, per_cu = 0;
        if (hipGetDevice(&dev) != hipSuccess || hipDeviceGetAttribute(&cus, hipDeviceAttributeMultiprocessorCount, dev) != hipSuccess) { grid = -1; return; }
        if (hipFuncSetAttribute((const void*)mega, hipFuncAttributeMaxDynamicSharedMemorySize, LDS_BYTES) != hipSuccess) { fprintf(stderr, "kernel_launch: hipFuncSetAttribute failed\n"); grid = -1; return; }
        if (hipOccupancyMaxActiveBlocksPerMultiprocessor(&per_cu, (const void*)mega, 512, LDS_BYTES) != hipSuccess || per_cu < 1) { fprintf(stderr, "kernel_launch: occupancy query says %d\n", per_cu); }
        (void)hipGetLastError();
        grid = cus;
    }
    if (grid < 0) return;
    if (hipMemsetAsync((char*)d_ws + WS_CTL, 0, CTL_ZERO_BYTES, stream) != hipSuccess) return;
    Args a{};
    for (int i = 0; i < 25; ++i) a.in[i] = (const float*)d_in[i];
    a.out = (float*)d_out; a.ws = (unsigned char*)d_ws; a.ph_lo = 0; a.ph_hi = 1 << 30;
    hipLaunchKernelGGL(mega, dim3(grid), dim3(512), LDS_BYTES, stream, a);
}
```

```cpp
#include <hip/hip_runtime.h>
#include <cstdio>
#include <cstdint>
namespace pg8 {
#define PG8_LAS __attribute__((address_space(3)))
typedef unsigned short bf16_t;
typedef short bf16x8 __attribute__((ext_vector_type(8)));
typedef float f32x4 __attribute__((ext_vector_type(4)));
typedef unsigned u32x4 __attribute__((ext_vector_type(4)));
constexpr int BM = 256, BK = 64, HALF = 128, HTB = HALF * BK * 2  , STAGE_BYTES = 8 * HTB, NXCD = 8, WGM = 8;

__host__ __device__ __forceinline__ int lds_byte(int r, int c) { const int st = (r >> 4) * 2 + (c >> 5), rr = r & 15, cc = c & 31, ob = rr * 64 + cc * 2; return st * 1024 + (ob ^ (((ob >> 9) & 1) << 5)); }
__host__ __device__ __forceinline__ void stage_rc(int b, int& R, int& C) { const int st = b / 1024, sb = b % 1024, swz = sb ^ (((sb >> 9) & 1) << 5); R = (st >> 1) * 16 + swz / 64; C = (st & 1) * 32 + (swz % 64) / 2; }
__host__ __device__ __forceinline__ int perm32(int rho) { const int n = rho >> 4, i = rho & 15; return 8 * (i >> 2) + 4 * n + (i & 3); }

struct Unit { int pm, pn, pb, lbase, nvalid; };
struct Gemm { const bf16_t* A; const bf16_t* Bt; int M, N, K, pad; };

struct StaticOrder {
    int nM, nN, nwg, G, c;
    __host__ __device__ void init(int M, int N, int G_, int c_) { nM = M / BM; nN = N / BM; nwg = nM * nN; G = G_; c = c_; }
    __host__ __device__ bool next(int i, Unit& u) const {
        const long L = (long)i * G + c; if (L >= nwg) return false;
        int wgid = (int)L; { const int q = nwg / NXCD, r = nwg % NXCD, xcd = wgid % NXCD, off = wgid / NXCD; wgid = (xcd < r ? xcd * (q + 1) : r * (q + 1) + (xcd - r) * q) + off; }
        const int nig = WGM * nN, gid = wgid / nig, fm = gid * WGM, gsz = (nM - fm) < WGM ? (nM - fm) : WGM;
        u.pm = fm + ((wgid % nig) % gsz); u.pn = (wgid % nig) / gsz; u.pb = u.pn; u.lbase = 0; u.nvalid = BM; return true;
    }
    __device__ __forceinline__ int arow(const Unit&, int) const { return 0; }
    __device__ __forceinline__ void a_ready(const Unit&) const {}
    __device__ __forceinline__ void done(const Unit&) const {}
};


typedef float f32x2_t __attribute__((ext_vector_type(2)));
typedef __bf16 bf16x2_t __attribute__((ext_vector_type(2)));
__device__ __forceinline__ unsigned cvt_pk_bf16(float lo, float hi) { const f32x2_t v = {lo, hi}; const bf16x2_t b = __builtin_convertvector(v, bf16x2_t); return __builtin_bit_cast(unsigned, b); }
__device__ __forceinline__ float frcp(float x) { return __builtin_amdgcn_rcpf(x); }
__device__ __forceinline__ float rsqrt_f(float x) { return __builtin_amdgcn_rsqf(x); }
__device__ __forceinline__ float silu_f(float x) { return x * frcp(1.0f + __expf(-x)); }
__device__ __forceinline__ float swiglu_f(float g, float u, float k1, float s2) { return (g * u) * (s2 * frcp(1.0f + __builtin_amdgcn_exp2f(g * k1))); }
__device__ __forceinline__ float row_scale(const float* rs, int r, int mode) {
    if (!mode) return rs[r];
    const f32x4* p = (const f32x4*)(rs + (size_t)r * 32); float s = 0.f;
#pragma unroll
    for (int i = 0; i < 8; ++i) { const f32x4 v = p[i]; s += (v[0] + v[1]) + (v[2] + v[3]); }
    return rsqrt_f(s * (1.0f / 2048.0f) + 1e-6f);
}
__device__ __forceinline__ void row_scales8(const float* rs, int row0, int fr, int fq, int mode, float (&sc)[2][4]) {
    if (!mode) {
#pragma unroll
        for (int ai = 0; ai < 2; ++ai)
#pragma unroll
            for (int m = 0; m < 4; ++m) sc[ai][m] = rs[row0 + ai * HALF + m * 16];
    } else {
        const int lane = fr + 16 * fq; f32x4 pa[2][4][2];
#pragma unroll
        for (int ai = 0; ai < 2; ++ai)
#pragma unroll
            for (int m = 0; m < 4; ++m) { const f32x4* p = (const f32x4*)(rs + (size_t)(row0 + ai * HALF + m * 16) * 32 + fq * 8); pa[ai][m][0] = p[0]; pa[ai][m][1] = p[1]; }
#pragma unroll
        for (int ai = 0; ai < 2; ++ai)
#pragma unroll
            for (int m = 0; m < 4; ++m) { const f32x4 a = pa[ai][m][0], b = pa[ai][m][1]; float t = ((a[0] + a[1]) + (a[2] + a[3])) + ((b[0] + b[1]) + (b[2] + b[3]));
                t += __int_as_float(__builtin_amdgcn_ds_bpermute((lane ^ 16) << 2, __float_as_int(t)));
                t += __int_as_float(__builtin_amdgcn_ds_bpermute((lane ^ 32) << 2, __float_as_int(t)));
                sc[ai][m] = rsqrt_f(t * (1.0f / 2048.0f) + 1e-6f); }
    }
}
struct EpiScaleBf16 {
    static constexpr bool PERM = true, AFTER_DRAIN = false;
    bf16_t* O; const float* rs; int ldc; int pad;
    __device__ __forceinline__ void operator()(const f32x4 (&acc)[2][2][4][2], const Unit& u, int wr, int wc, int fr, int fq) const {
        const int row0 = u.pm * BM + wr * 64 + fr, col0 = u.pn * BM + wc * 32 + 8 * fq;
        float sc[2][4]; row_scales8(rs, row0, fr, fq, pad, sc);
#pragma unroll
        for (int ai = 0; ai < 2; ++ai)
#pragma unroll
            for (int m = 0; m < 4; ++m) { const int r = row0 + ai * HALF + m * 16; const float s = sc[ai][m]; bf16_t* rowp = O + (size_t)r * ldc + col0;
#pragma unroll
                for (int bj = 0; bj < 2; ++bj) { const f32x4 v0 = acc[ai][bj][m][0] * s, v1 = acc[ai][bj][m][1] * s;
                    u32x4 w; w.x = cvt_pk_bf16(v0[0], v0[1]); w.y = cvt_pk_bf16(v0[2], v0[3]); w.z = cvt_pk_bf16(v1[0], v1[1]); w.w = cvt_pk_bf16(v1[2], v1[3]);
                    *(u32x4*)(rowp + bj * HALF) = w; } }
    }
};
struct EpiSwiGLU {
    static constexpr bool PERM = true, AFTER_DRAIN = false;
    bf16_t* O; const float* rs; int ldc; int pad;
    __device__ __forceinline__ void operator()(const f32x4 (&acc)[2][2][4][2], const Unit& u, int wr, int wc, int fr, int fq) const {
        const int row0 = u.pm * BM + wr * 64 + fr, col0 = u.pn * HALF + wc * 32 + 8 * fq;
        float sc[2][4]; row_scales8(rs, row0, fr, fq, pad, sc);
#pragma unroll
        for (int ai = 0; ai < 2; ++ai)
#pragma unroll
            for (int m = 0; m < 4; ++m) { const int r = row0 + ai * HALF + m * 16; const float s = sc[ai][m], k1 = s * -1.4426950408889634f, s2 = s * s; bf16_t* rowp = O + (size_t)r * ldc + col0;
                f32x4 h0, h1;
#pragma unroll
                for (int j = 0; j < 4; ++j) { h0[j] = swiglu_f(acc[ai][0][m][0][j], acc[ai][1][m][0][j], k1, s2); h1[j] = swiglu_f(acc[ai][0][m][1][j], acc[ai][1][m][1][j], k1, s2); }
                u32x4 w; w.x = cvt_pk_bf16(h0[0], h0[1]); w.y = cvt_pk_bf16(h0[2], h0[3]); w.z = cvt_pk_bf16(h1[0], h1[1]); w.w = cvt_pk_bf16(h1[2], h1[3]);
                *(u32x4*)rowp = w; }
    }
};
struct EpiResidual {
    static constexpr bool PERM = false, AFTER_DRAIN = false;
    const float* base; float* out; const float* roww; int ldc; int pad;
    __device__ __forceinline__ void operator()(const f32x4 (&acc)[2][2][4][2], const Unit& u, int wr, int wc, int fr, int fq) const {
        const int row0 = u.pm * BM + wr * 64 + fr, col0 = u.pn * BM + wc * 32 + 4 * fq;
#pragma unroll
        for (int ai = 0; ai < 2; ++ai)
#pragma unroll
            for (int m = 0; m < 4; ++m) { const int r = row0 + ai * HALF + m * 16; const float w = roww ? roww[r] : 1.0f; const size_t off = (size_t)r * ldc + col0;
#pragma unroll
                for (int bj = 0; bj < 2; ++bj)
#pragma unroll
                    for (int n = 0; n < 2; ++n) { const f32x4 bs = *(const f32x4*)(base + off + bj * HALF + n * 16); *(f32x4*)(out + off + bj * HALF + n * 16) = bs + acc[ai][bj][m][n] * w; } }
    }
};

struct EpiSwiGLUMoe {
    static constexpr bool PERM = true, AFTER_DRAIN = false;
    bf16_t* O; const float* rs; const int* list; int ldc; int pad;
    __device__ __forceinline__ void operator()(const f32x4 (&acc)[2][2][4][2], const Unit& u, int wr, int wc, int fr, int fq) const {
        const int rl0 = wr * 64 + fr, col0 = u.pn * HALF + wc * 32 + 8 * fq;
#pragma unroll
        for (int ai = 0; ai < 2; ++ai)
#pragma unroll
            for (int m = 0; m < 4; ++m) { const int rl = rl0 + ai * HALF + m * 16; const int tok = rl < u.nvalid ? (list[u.lbase + rl] & 0xffff) : 0; const float s = rs[tok], k1 = s * -1.4426950408889634f, s2 = s * s;
                bf16_t* rowp = O + (size_t)(u.pm * BM + rl) * ldc + col0;
                f32x4 h0, h1;
#pragma unroll
                for (int j = 0; j < 4; ++j) { h0[j] = swiglu_f(acc[ai][0][m][0][j], acc[ai][1][m][0][j], k1, s2); h1[j] = swiglu_f(acc[ai][0][m][1][j], acc[ai][1][m][1][j], k1, s2); }
                u32x4 w; w.x = cvt_pk_bf16(h0[0], h0[1]); w.y = cvt_pk_bf16(h0[2], h0[3]); w.z = cvt_pk_bf16(h1[0], h1[1]); w.w = cvt_pk_bf16(h1[2], h1[3]);
                *(u32x4*)rowp = w; }
    }
};
struct EpiMoeDown {
    static constexpr bool PERM = true, AFTER_DRAIN = false;
    bf16_t* Y0; bf16_t* Y1; const int* list; const float* lw; int ldc; int pad;
    __device__ __forceinline__ void operator()(const f32x4 (&acc)[2][2][4][2], const Unit& u, int wr, int wc, int fr, int fq) const {
        const int rl0 = wr * 64 + fr, col0 = u.pn * BM + wc * 32 + 8 * fq;
#pragma unroll
        for (int ai = 0; ai < 2; ++ai)
#pragma unroll
            for (int m = 0; m < 4; ++m) { const int rl = rl0 + ai * HALF + m * 16;
                if (rl < u.nvalid) { const int en = list[u.lbase + rl]; const float w = lw[u.lbase + rl]; bf16_t* rowp = ((en >> 16) ? Y1 : Y0) + (size_t)(en & 0xffff) * ldc + col0;
#pragma unroll
                    for (int bj = 0; bj < 2; ++bj) { const f32x4 v0 = acc[ai][bj][m][0] * w, v1 = acc[ai][bj][m][1] * w;
                        u32x4 o; o.x = cvt_pk_bf16(v0[0], v0[1]); o.y = cvt_pk_bf16(v0[2], v0[3]); o.z = cvt_pk_bf16(v1[0], v1[1]); o.w = cvt_pk_bf16(v1[2], v1[3]);
                        *(u32x4*)(rowp + bj * HALF) = o; } } }
    }
};

struct EpiResidualNorm {
    static constexpr bool PERM = true, AFTER_DRAIN = false;
    const float* base; float* out; bf16_t* xb; float* ssq; int ldc; int pad;
    __device__ __forceinline__ void operator()(const f32x4 (&acc)[2][2][4][2], const Unit& u, int wr, int wc, int fr, int fq) const {
        const int row0 = u.pm * BM + wr * 64 + fr, col0 = u.pn * BM + wc * 32 + 8 * fq, lane = fr + 16 * fq;
#pragma unroll
        for (int ai = 0; ai < 2; ++ai)
#pragma unroll
            for (int m = 0; m < 4; ++m) { const int r = row0 + ai * HALF + m * 16; const size_t off = (size_t)r * ldc + col0; float part = 0.f;
#pragma unroll
                for (int bj = 0; bj < 2; ++bj) { const f32x4 b0 = *(const f32x4*)(base + off + bj * HALF), b1 = *(const f32x4*)(base + off + bj * HALF + 4);
                    const f32x4 v0 = b0 + acc[ai][bj][m][0], v1 = b1 + acc[ai][bj][m][1];
                    *(f32x4*)(out + off + bj * HALF) = v0; *(f32x4*)(out + off + bj * HALF + 4) = v1;
                    u32x4 w; w.x = cvt_pk_bf16(v0[0], v0[1]); w.y = cvt_pk_bf16(v0[2], v0[3]); w.z = cvt_pk_bf16(v1[0], v1[1]); w.w = cvt_pk_bf16(v1[2], v1[3]);
                    *(u32x4*)(xb + off + bj * HALF) = w;
                    part += (v0[0] * v0[0] + v0[1] * v0[1]) + (v0[2] * v0[2] + v0[3] * v0[3]) + (v1[0] * v1[0] + v1[1] * v1[1]) + (v1[2] * v1[2] + v1[3] * v1[3]); }
                part += __int_as_float(__builtin_amdgcn_ds_bpermute((lane ^ 16) << 2, __float_as_int(part)));
                part += __int_as_float(__builtin_amdgcn_ds_bpermute((lane ^ 32) << 2, __float_as_int(part)));
                if (fq == 0) ssq[(size_t)r * 32 + u.pn * 4 + wc] = part; }
    }
};
template <class Epi, class Sched, bool ALIGN_EPI = false, bool GATHER = false>
__device__ __forceinline__ void gemm_phase(PG8_LAS unsigned char* lds, const Gemm g, const Sched& S, const Epi& E) {
    int tid_o = threadIdx.x; asm volatile("" : "+v"(tid_o));
    const int tid = tid_o, wid = __builtin_amdgcn_readfirstlane(tid >> 6), lane = tid & 63, wr = wid >> 2, wc = wid & 3, fr = lane & 15, fq = lane >> 4;
    const int K = g.K, nt = K / BK;
    const size_t kstep = (size_t)(BK * 2);
    const size_t hstep = (size_t)HALF * K * 2;
    const size_t tstep = 2 * hstep;
    unsigned voffA[2], voffB[2], oA[2][2], oN[2][2];
#pragma unroll
    for (int i = 0; i < 2; ++i) { int R, C; stage_rc(tid * 16 + i * 8192, R, C); const int Rb = Epi::PERM ? ((R & ~31) + perm32(R & 31)) : R; voffA[i] = (unsigned)(R * K + C) * 2u; voffB[i] = (unsigned)(Rb * K + C) * 2u; }
    const unsigned ldsw = (unsigned)wid * 1024u;
    const int aoff = lds_byte(wr * 64 + fr, fq * 8), boff = lds_byte(wc * 32 + fr, fq * 8);
#define PG8_SA(b, h) (((b) * 2 + (h)) * HTB)
#define PG8_SB(b, h) ((4 + (b) * 2 + (h)) * HTB)
#define PG8_STAGE(bufoff, gbase, voff) do { _Pragma("unroll") for (int _i = 0; _i < 2; ++_i) \
        __builtin_amdgcn_global_load_lds((const unsigned*)((const char*)(gbase) + (voff)[_i]), (PG8_LAS unsigned*)(lds + (bufoff) + ldsw + _i * 8192), 16, 0, 0); } while (0)
#define PG8_LDA(dst, b, h) do { _Pragma("unroll") for (int m = 0; m < 4; ++m) _Pragma("unroll") for (int k = 0; k < 2; ++k) dst[m][k] = *(const PG8_LAS bf16x8*)(lds + PG8_SA(b, h) + aoff + m * 2048 + k * 1024); } while (0)
#define PG8_LDB(dst, b, h) do { _Pragma("unroll") for (int n = 0; n < 2; ++n) _Pragma("unroll") for (int k = 0; k < 2; ++k) dst[n][k] = *(const PG8_LAS bf16x8*)(lds + PG8_SB(b, h) + boff + n * 2048 + k * 1024); } while (0)
#define PG8_MMA(ai, bj, At, Bt) do { __builtin_amdgcn_s_setprio(1); _Pragma("unroll") for (int m = 0; m < 4; ++m) _Pragma("unroll") for (int n = 0; n < 2; ++n) _Pragma("unroll") for (int k = 0; k < 2; ++k) \
        acc[ai][bj][m][n] = __builtin_amdgcn_mfma_f32_16x16x32_bf16(Bt[n][k], At[m][k], acc[ai][bj][m][n], 0, 0, 0); __builtin_amdgcn_s_setprio(0); } while (0)
#define PG8_WAIT_V(n) asm volatile("s_waitcnt vmcnt(" #n ")" ::: "memory")
#define PG8_WAIT_L(n) asm volatile("s_waitcnt lgkmcnt(" #n ")" ::: "memory")
#define PG8_BAR __builtin_amdgcn_s_barrier()
#define PG8_SCHED __builtin_amdgcn_sched_barrier(0)
#define PG8_AOFF(dst, u) do { _Pragma("unroll") for (int _i = 0; _i < 2; ++_i) { int _R, _C; stage_rc(tid * 16 + _i * 8192, _R, _C); _Pragma("unroll") for (int _h = 0; _h < 2; ++_h) \
        dst[_h][_i] = (unsigned)(S.arow(u, _h * HALF + _R) * K + _C) * 2u; } } while (0)
#define PG8_STAGE_A(bufoff, gbase, h, usenext) do { _Pragma("unroll") for (int _i = 0; _i < 2; ++_i) { const unsigned _o = GATHER ? ((usenext) ? oN[h][_i] : oA[h][_i]) : voffA[_i]; \
        __builtin_amdgcn_global_load_lds((const unsigned*)((const char*)(gbase) + (GATHER ? (size_t)0 : (size_t)(h) * hstep) + _o), (PG8_LAS unsigned*)(lds + (bufoff) + ldsw + _i * 8192), 16, 0, 0); } } while (0)
    Unit cur, nxt; int ui = 0;
    if (!S.next(0, cur)) return;
    f32x4 acc[2][2][4][2];
#pragma unroll
    for (int a = 0; a < 2; ++a)
#pragma unroll
        for (int b = 0; b < 2; ++b)
#pragma unroll
            for (int m = 0; m < 4; ++m)
#pragma unroll
                for (int n = 0; n < 2; ++n) acc[a][b][m][n] = (f32x4){0.f, 0.f, 0.f, 0.f};
    bf16x8 At[4][2], B0[2][2], B1[2][2];
    const char* cA = (const char*)g.A + (GATHER ? (size_t)0 : (size_t)cur.pm * tstep); const char* cB = (const char*)g.Bt + (size_t)cur.pb * tstep;
    S.a_ready(cur);
    if constexpr (GATHER) { PG8_AOFF(oA, cur); PG8_WAIT_V(0); }
    PG8_STAGE(PG8_SB(0, 0), cB, voffB); PG8_STAGE(PG8_SB(0, 1), cB + hstep, voffB); PG8_STAGE_A(PG8_SA(0, 0), cA, 0, false); PG8_STAGE_A(PG8_SA(0, 1), cA, 1, false);
    if (wr == 1) PG8_BAR;
    PG8_WAIT_V(2); PG8_BAR;
    PG8_STAGE(PG8_SB(1, 0), cB + kstep, voffB); PG8_STAGE_A(PG8_SA(1, 0), cA + kstep, 0, false); PG8_STAGE(PG8_SB(1, 1), cB + hstep + kstep, voffB);
    PG8_WAIT_V(6); PG8_BAR;
    for (;;) {
        const bool has_next = S.next(ui + 1, nxt);
        const char* nA = has_next ? (const char*)g.A + (GATHER ? (size_t)0 : (size_t)nxt.pm * tstep) : cA; const char* nB = has_next ? (const char*)g.Bt + (size_t)nxt.pb * tstep : cB;
        if constexpr (GATHER) { if (has_next) { PG8_AOFF(oN, nxt); } else {
#pragma unroll
            for (int _h = 0; _h < 2; ++_h) { oN[_h][0] = oA[_h][0]; oN[_h][1] = oA[_h][1]; } } }
        for (int t = 0; t < nt; t += 2) {
            const bool last = (t == nt - 2);
            const char* a1 = cA + (size_t)(t + 1) * kstep;
            const char* a2 = last ? nA : cA + (size_t)(t + 2) * kstep; const char* b2 = last ? nB : cB + (size_t)(t + 2) * kstep;
            const char* a3 = a2 + kstep; const char* b3 = b2 + kstep;
            if (last && has_next) S.a_ready(nxt);
            PG8_LDB(B0, 0, 0); PG8_LDB(B1, 0, 1); PG8_SCHED; PG8_LDA(At, 0, 0); PG8_STAGE_A(PG8_SA(1, 1), a1, 1, false);
            PG8_WAIT_V(8); PG8_WAIT_L(0); PG8_BAR; PG8_MMA(0, 0, At, B0); PG8_MMA(0, 1, At, B1); PG8_BAR; PG8_SCHED;
            PG8_LDA(At, 0, 1); PG8_STAGE(PG8_SB(0, 0), b2, voffB); PG8_STAGE(PG8_SB(0, 1), b2 + hstep, voffB); PG8_STAGE_A(PG8_SA(0, 0), a2, 0, last);
            PG8_WAIT_V(8); PG8_WAIT_L(0); PG8_BAR; PG8_MMA(1, 0, At, B0); PG8_MMA(1, 1, At, B1); PG8_BAR; PG8_SCHED;
            PG8_LDB(B0, 1, 0); PG8_LDB(B1, 1, 1); PG8_SCHED; PG8_LDA(At, 1, 0); PG8_STAGE_A(PG8_SA(0, 1), a2, 1, last);
            PG8_WAIT_V(8); PG8_WAIT_L(0); PG8_BAR; PG8_MMA(0, 0, At, B0); PG8_MMA(0, 1, At, B1); PG8_BAR; PG8_SCHED;
            PG8_LDA(At, 1, 1); PG8_STAGE(PG8_SB(1, 0), b3, voffB); PG8_STAGE(PG8_SB(1, 1), b3 + hstep, voffB); PG8_STAGE_A(PG8_SA(1, 0), a3, 0, last);
            PG8_WAIT_V(8); PG8_WAIT_L(0); PG8_BAR; PG8_MMA(1, 0, At, B0); PG8_MMA(1, 1, At, B1); PG8_BAR; PG8_SCHED;
        }
        if constexpr (ALIGN_EPI) { if (wr == 0) PG8_BAR; }
        E(acc, cur, wr, wc, fr, fq); S.done(cur);
        if (!has_next) break;
#pragma unroll
        for (int a = 0; a < 2; ++a)
#pragma unroll
            for (int b = 0; b < 2; ++b)
#pragma unroll
                for (int m = 0; m < 4; ++m)
#pragma unroll
                    for (int n = 0; n < 2; ++n) acc[a][b][m][n] = (f32x4){0.f, 0.f, 0.f, 0.f};
        cur = nxt; cA = nA; cB = nB; ++ui;
        if constexpr (GATHER) {
#pragma unroll
            for (int _h = 0; _h < 2; ++_h) { oA[_h][0] = oN[_h][0]; oA[_h][1] = oN[_h][1]; } }
        if constexpr (ALIGN_EPI) { if (wr == 1) PG8_BAR; }
    }
    PG8_WAIT_V(0);
    if constexpr (!ALIGN_EPI) { if (wr == 0) PG8_BAR; }
    PG8_BAR;
#undef PG8_SA
#undef PG8_SB
#undef PG8_STAGE
#undef PG8_LDA
#undef PG8_LDB
#undef PG8_MMA
#undef PG8_WAIT_V
#undef PG8_WAIT_L
#undef PG8_BAR
#undef PG8_SCHED
#undef PG8_AOFF
#undef PG8_STAGE_A
}
}

#define GAS __attribute__((address_space(1)))
#define LAS __attribute__((address_space(3)))
#define XB_TMO      128
#define XB_XCNT(j)  (256  + 64 * (j))
#define XB_XSUB(j)  (1280 + 64 * (j))
#define XB_XGEN(j)  (2304 + 64 * (j))
#define XB_TOP      3328
#define XB_TOPGEN   3392
#define XCD_BAR_WORDS 3456
#define XB_SPIN_CAP (1u << 23)

__device__ __forceinline__ unsigned xb_ld(unsigned* p)              { return __hip_atomic_load(p, __ATOMIC_RELAXED, __HIP_MEMORY_SCOPE_AGENT); }
__device__ __forceinline__ unsigned xb_add(unsigned* p, unsigned v) { return __hip_atomic_fetch_add(p, v, __ATOMIC_RELAXED, __HIP_MEMORY_SCOPE_AGENT); }
__device__ __forceinline__ unsigned xb_xcc_id() { return (unsigned)__builtin_amdgcn_s_getreg((3 << 11) | 20) & 0xFu; }
#define XB_SPIN(cond, bar) do { unsigned _sp = 0; while (cond) { __builtin_amdgcn_s_sleep(1); \
    if ((++_sp & 255u) == 0u) { if (xb_ld(&(bar)[XB_TMO])) break; if (_sp > XB_SPIN_CAP) { atomicAdd(&(bar)[XB_TMO], 1u); break; } } } } while (0)

struct XcdBarrier {
    unsigned* bar; unsigned x;
    volatile LAS unsigned* st;
};

__device__ __forceinline__ XcdBarrier xcd_barrier_post(unsigned* bar, volatile LAS unsigned* st) {
    XcdBarrier b; b.bar = bar; b.x = xb_xcc_id(); b.st = st;
    if (threadIdx.x == 0) (void)xb_add(&bar[XB_XCNT(b.x)], 1u);
    return b;
}
__device__ __forceinline__ void xcd_barrier_complete(unsigned* bar, unsigned x, unsigned& nloc, unsigned& nx) {
    const unsigned G = gridDim.x * gridDim.y * gridDim.z;
    unsigned sum, cnt, mine, sp = 0u;
    for (;;) {
        sum = 0u; cnt = 0u; mine = 0u;
#pragma unroll
        for (unsigned j = 0; j < 16; ++j) { const unsigned c = xb_ld(&bar[XB_XCNT(j)]); sum += c; cnt += (c > 0u) ? 1u : 0u; mine = (j == x) ? c : mine; }
        if (sum == G) break;
        __builtin_amdgcn_s_sleep(1);
        if ((++sp & 255u) == 0u) { if (xb_ld(&bar[XB_TMO])) break; if (sp > XB_SPIN_CAP) { atomicAdd(&bar[XB_TMO], 1u); break; } }
    }
    nloc = mine > 0u ? mine : 1u; nx = cnt > 0u ? cnt : 1u;
}

__device__ __forceinline__ void xcd_barrier(const XcdBarrier& b) {
    asm volatile("s_waitcnt vmcnt(0)" ::: "memory");
    __syncthreads();
    if (threadIdx.x == 0) {
        unsigned* bar = b.bar; asm volatile("" : "+s"(bar));
        __builtin_amdgcn_s_waitcnt(0);
        unsigned nloc = b.st[0], nx = b.st[1];
        if (nloc == 0u) { xcd_barrier_complete(bar, b.x, nloc, nx); b.st[0] = nloc; b.st[1] = nx; }
        const unsigned old = xb_add(&bar[XB_XSUB(b.x)], 1u);
        const unsigned gen = old / nloc;
        if (old + 1u == (gen + 1u) * nloc) {
            __builtin_amdgcn_fence(__ATOMIC_RELEASE, "agent");
            asm volatile("s_waitcnt vmcnt(0)" ::: "memory");
            const unsigned og = xb_add(&bar[XB_TOP], 1u);
            const unsigned tg = og / nx;
            if (og + 1u == (tg + 1u) * nx) xb_add(&bar[XB_TOPGEN], 1u);
            else XB_SPIN(xb_ld(&bar[XB_TOPGEN]) == tg, bar);
            __builtin_amdgcn_fence(__ATOMIC_ACQUIRE, "agent");
            xb_add(&bar[XB_XGEN(b.x)], 1u);
            asm volatile("s_waitcnt vmcnt(0)" ::: "memory");
        } else {
            XB_SPIN(xb_ld(&bar[XB_XGEN(b.x)]) == gen, bar);
            __builtin_amdgcn_fence(__ATOMIC_ACQUIRE, "agent");
            asm volatile("s_waitcnt vmcnt(0)" ::: "memory");
        }
    }
    __syncthreads();
}

constexpr int T = 16384, SEQ = 8192, D = 2048, DLRU = 1024, DDN = 1024, NH = 8, HD = 128, NPROJ = 6144, DIN = 6160;
constexpr int DFF = 6144, NEXP = 8, DFFE = 3072;
constexpr float EPS = 1e-6f;
typedef unsigned short bf16;
typedef float f32x4 __attribute__((ext_vector_type(4)));
typedef unsigned u32x4 __attribute__((ext_vector_type(4)));
typedef unsigned u32x2 __attribute__((ext_vector_type(2)));
#define LDS_WAIT() asm volatile("s_waitcnt lgkmcnt(0)" ::: "memory")
#define LDS_BARRIER() do { asm volatile("s_waitcnt lgkmcnt(0)" ::: "memory"); __builtin_amdgcn_s_barrier(); asm volatile("" ::: "memory"); } while (0)

__device__ __forceinline__ float bf2f(bf16 b) { return __uint_as_float(((unsigned)b) << 16); }
__device__ __forceinline__ unsigned f2bf(float f) { return pg8::cvt_pk_bf16(f, f) & 0xffffu; }
__device__ __forceinline__ unsigned pk2(float lo, float hi) { return pg8::cvt_pk_bf16(lo, hi); }
__device__ __forceinline__ float shfl_xor_l(float v, int o, int lane) { return __int_as_float(__builtin_amdgcn_ds_bpermute((lane ^ o) << 2, __float_as_int(v))); }
__device__ __forceinline__ float shfl_up_l(float v, int d, int lane) { return __int_as_float(__builtin_amdgcn_ds_bpermute((lane - d) << 2, __float_as_int(v))); }
__device__ __forceinline__ float shfl_idx_l(float v, int src) { return __int_as_float(__builtin_amdgcn_ds_bpermute(src << 2, __float_as_int(v))); }
__device__ __forceinline__ float wave_sum(float v, int lane) {
#pragma unroll
    for (int o = 1; o < 64; o <<= 1) v += shfl_xor_l(v, o, lane);
    return v;
}
using pg8::silu_f;
using pg8::frcp; using pg8::rsqrt_f;
__device__ __forceinline__ float sigmoid_f(float x) { return frcp(1.0f + __expf(-x)); }
__device__ __forceinline__ float softplus_f(float x) { return fmaxf(x, 0.0f) + log1pf(__expf(-fabsf(x))); }
__device__ __forceinline__ float gelu_tanh_f(float x) { const float u = 0.7978845608028654f * (x + 0.044715f * x * x * x); return x * frcp(1.0f + __expf(-2.0f * u)); }

constexpr size_t MiB = 1u << 20;
constexpr size_t al(size_t x) { return (x + MiB - 1) / MiB * MiB; }
constexpr size_t WS_CTL = 0, CTL_ZERO_BYTES = 1 * MiB;
constexpr int CW_BAR = 4096, CW_CNT = 8192;
constexpr size_t WS_WGU = 1 * MiB;
constexpr size_t WS_WD = WS_WGU + al((size_t)2 * DFF * D * 2);
constexpr size_t WS_WIN = WS_WD + al((size_t)D * DFF * 2);
constexpr size_t WS_WBA = WS_WIN + al((size_t)2 * NPROJ * D * 2);
constexpr size_t WS_WOUT = WS_WBA + al((size_t)2 * 16 * D * 4 + 2 * 16 * D * 2);
static_assert(WS_WIN + (size_t)NPROJ * D * 2 - WS_WGU >= (size_t)NEXP * D * DFFE * 2, "MoE down weights overlay");
constexpr size_t WS_XB = WS_WOUT + al((size_t)2 * D * D * 2);
constexpr size_t WS_RSTD = WS_XB + al((size_t)T * D * 2);
constexpr size_t WS_BA = WS_RSTD + 5 * MiB;
constexpr size_t WS_BETA = WS_BA + al((size_t)T * 16 * 4);
constexpr size_t WS_G = WS_BETA + al((size_t)T * 8 * 4);
constexpr size_t WS_ROWW = WS_G + al((size_t)T * 8 * 4);
constexpr int NSLOT = 2 * T + NEXP * 256;
constexpr size_t WS_PROJ = WS_ROWW + al((size_t)2 * 8 * T * 4);
constexpr size_t WS_YMIX = WS_PROJ + al((size_t)NSLOT * DFFE * 2);
constexpr size_t WS_C = WS_YMIX + al((size_t)T * D * 2);
constexpr size_t WS_WRT = WS_C + (size_t)388 * MiB;
constexpr size_t WS_END = WS_WRT + 1 * MiB;
static_assert(WS_END <= (size_t)975 * MiB, "d_ws map exceeds the guaranteed workspace");
static_assert((size_t)NEXP * 2 * DFFE * D * 2 <= (size_t)388 * MiB, "MoE gate/up bf16 weights overlay the mixer scratch");
constexpr int RING_BYTES = 131072, LDSCTL_OFF = RING_BYTES, MISC_OFF = LDSCTL_OFF + 320, LDS_BYTES = 147456;

__device__ __forceinline__ void transpose_item(const float* W, int ldw, int col_off, int K, int nblk, const float* gain, bf16* WT, int blk, int blk_stride, int row_off, int item, int lane) {
    const int kb = item / nblk, nb = item % nblk, k0 = 64 * kb + (lane >> 4) * 16, n0 = 64 * nb + (lane & 15) * 4;
    const float* src = W + (size_t)k0 * ldw + col_off + n0;
    f32x4 v[16];
#pragma unroll
    for (int j = 0; j < 16; ++j) v[j] = __builtin_nontemporal_load((const f32x4*)(src + (size_t)j * ldw));
    if (gain) {
#pragma unroll
        for (int q = 0; q < 4; ++q) { const f32x4 g = *(const f32x4*)(gain + k0 + 4 * q);
#pragma unroll
            for (int c = 0; c < 4; ++c) v[4 * q + c] = v[4 * q + c] * g[c]; }
    }
#pragma unroll
    for (int i = 0; i < 4; ++i) { const int n = n0 + i, drow = (n / blk) * blk_stride + (n % blk) + row_off;
        u32x4 o0, o1;
        o0.x = pk2(v[0][i], v[1][i]); o0.y = pk2(v[2][i], v[3][i]); o0.z = pk2(v[4][i], v[5][i]); o0.w = pk2(v[6][i], v[7][i]);
        o1.x = pk2(v[8][i], v[9][i]); o1.y = pk2(v[10][i], v[11][i]); o1.z = pk2(v[12][i], v[13][i]); o1.w = pk2(v[14][i], v[15][i]);
        u32x4* dst = (u32x4*)(WT + (size_t)drow * K + k0); dst[0] = o0; dst[1] = o1; }
}
__device__ __forceinline__ void convert_matrix(const float* W, int ldw, int col_off, int K, int N, const float* gain, bf16* WT, int blk, int blk_stride, int row_off, LAS float* scr, int gw, int NGW, int lane) {
    const int nblk = N / 64, nitems = (K / 64) * nblk; (void)scr;
    for (int it = gw; it < nitems; it += NGW) transpose_item(W, ldw, col_off, K, nblk, gain, WT, blk, blk_stride, row_off, it, lane);
}
__device__ __forceinline__ void rowprep_row(const float* x, bf16* xb, float* rstd, const float* Wba, float* ba, int row, int lane) {
    const f32x4* xr = (const f32x4*)(x + (size_t)row * D) + lane;
    f32x4 v[8]; float ss = 0.f;
#pragma unroll
    for (int j = 0; j < 8; ++j) { v[j] = xr[64 * j]; ss += (v[j][0] * v[j][0] + v[j][1] * v[j][1]) + (v[j][2] * v[j][2] + v[j][3] * v[j][3]); }
    ss = wave_sum(ss, lane);
    const float rs = rsqrt_f(ss * (1.0f / D) + EPS);
    u32x2* o = (u32x2*)(xb + (size_t)row * D) + lane;
#pragma unroll
    for (int j = 0; j < 8; ++j) { u32x2 w; w.x = pk2(v[j][0], v[j][1]); w.y = pk2(v[j][2], v[j][3]); o[64 * j] = w; }
    if (lane == 0) rstd[row] = rs;
    if (Wba) {
        for (int c = 0; c < 16; ++c) { const f32x4* wr = (const f32x4*)(Wba + (size_t)c * D) + lane; float a = 0.f;
#pragma unroll
            for (int j = 0; j < 8; ++j) { const f32x4 w = wr[64 * j]; a += (v[j][0] * w[0] + v[j][1] * w[1]) + (v[j][2] * w[2] + v[j][3] * w[3]); }
            a = wave_sum(a, lane); if (lane == 0) ba[(size_t)row * 16 + c] = a * rs; }
    }
}
__device__ __forceinline__ void lru_conv_elem(const bf16* proj, const float* cw, const float* cb, float* xc, size_t idx) {
    const int t = (int)(idx / DLRU), ch = (int)(idx % DLRU), s = t % SEQ;
    float a = cb[ch];
#pragma unroll
    for (int k = 0; k < 4; ++k) { const int sp = s - 3 + k; if (sp >= 0) a += cw[k * DLRU + ch] * bf2f(proj[(size_t)(t - 3 + k) * NPROJ + ch]); }
    xc[idx] = a;
}
__device__ __forceinline__ void lru_gate_elem(const float* xc, const float* w_r, const float* b_r, const float* w_i, const float* b_i, const float* lam, float* av, float* bv, size_t idx) {
    const int t = (int)(idx / DLRU), ch = (int)(idx % DLRU), n = ch >> 7, d = ch & 127;
    float ar = b_r[ch], ai = b_i[ch];
    const float* xr = xc + (size_t)t * DLRU + n * 128; const float* wr = w_r + (size_t)n * 128 * 128 + d; const float* wi = w_i + (size_t)n * 128 * 128 + d;
    for (int c = 0; c < 128; ++c) { const float xv = xr[c]; ar += xv * wr[c * 128]; ai += xv * wi[c * 128]; }
    const float r = sigmoid_f(ar), ig = sigmoid_f(ai);
    const float log_a = -8.0f * r * softplus_f(-lam[ch]);
    const float a = expf(log_a), mult = sqrtf(-expm1f(2.0f * log_a));
    av[idx] = a; bv[idx] = mult * (ig * xc[idx]);
}
__device__ __forceinline__ void lru_scan_chan(float* av, const float* bv, const bf16* proj, int idx) {
    const int b = idx / DLRU, ch = idx % DLRU;
    float h = 0.f;
    for (int s0 = 0; s0 < SEQ; s0 += 8) {
        float a8[8], b8[8], g8[8];
#pragma unroll
        for (int j = 0; j < 8; ++j) { const size_t t = (size_t)b * SEQ + s0 + j; a8[j] = av[t * DLRU + ch]; b8[j] = bv[t * DLRU + ch]; g8[j] = bf2f(proj[t * NPROJ + DLRU + ch]); }
#pragma unroll
        for (int j = 0; j < 8; ++j) { const size_t t = (size_t)b * SEQ + s0 + j; h = a8[j] * h + b8[j]; av[t * DLRU + ch] = h * gelu_tanh_f(g8[j]); }
    }
}
__device__ __forceinline__ void lru_norm_row(const float* y, const float* gain, bf16* ymix, int row, int lane) {
    const f32x4* yr = (const f32x4*)(y + (size_t)row * DLRU) + lane; const f32x4* gr = (const f32x4*)gain + lane;
    f32x4 v[4]; float ss = 0.f;
#pragma unroll
    for (int j = 0; j < 4; ++j) { v[j] = yr[64 * j]; ss += (v[j][0] * v[j][0] + v[j][1] * v[j][1]) + (v[j][2] * v[j][2] + v[j][3] * v[j][3]); }
    ss = wave_sum(ss, lane); const float rs = rsqrt_f(ss * (1.0f / DLRU) + EPS);
    u32x2* o = (u32x2*)(ymix + (size_t)row * D) + lane;
#pragma unroll
    for (int j = 0; j < 4; ++j) { const f32x4 g = gr[64 * j]; u32x2 w; w.x = pk2(v[j][0] * rs * g[0], v[j][1] * rs * g[1]); w.y = pk2(v[j][2] * rs * g[2], v[j][3] * rs * g[3]); o[64 * j] = w; }
}
__device__ __forceinline__ void dn_prep_item(const bf16* proj, const float* cw, const float* ba, const float* a_log, const float* dt_bias, float* qn, float* kn, float* vn, float* beta, float* gg, int w, int lane) {
    const int t = w >> 3, h = w & 7, s = t % SEQ;
    float val[3][2];
#pragma unroll
    for (int p = 0; p < 3; ++p)
#pragma unroll
        for (int e = 0; e < 2; ++e) { const int d = lane * 2 + e, c = p * DDN + h * HD + d; float a = 0.f;
#pragma unroll
            for (int k = 0; k < 4; ++k) { const int sp = s - 3 + k; if (sp >= 0) a += cw[k * 3 * DDN + c] * bf2f(proj[(size_t)(t - 3 + k) * NPROJ + 2048 + c]); }
            val[p][e] = silu_f(a); }
    const float sq = wave_sum(val[0][0] * val[0][0] + val[0][1] * val[0][1], lane), sk = wave_sum(val[1][0] * val[1][0] + val[1][1] * val[1][1], lane);
    const float rq = rsqrt_f(sq + EPS) * 0.08838834764831845f, rk = rsqrt_f(sk + EPS);
    const size_t o = ((size_t)t * NH + h) * HD + lane * 2;
    qn[o] = val[0][0] * rq; qn[o + 1] = val[0][1] * rq; kn[o] = val[1][0] * rk; kn[o + 1] = val[1][1] * rk; vn[o] = val[2][0]; vn[o + 1] = val[2][1];
    if (lane == 0) { beta[t * NH + h] = sigmoid_f(ba[(size_t)t * 16 + h]); gg[t * NH + h] = -__expf(a_log[h]) * softplus_f(ba[(size_t)t * 16 + 8 + h] + dt_bias[h]); }
}
__device__ __forceinline__ void dn_rec_seq(const float* qn, const float* kn, const float* vn, const float* beta, const float* gg, float* o, int bh, LAS float* sk, LAS float* sq, LAS float* st, int tid) {
    const int b = bh >> 3, h = bh & 7, j = tid & 127; const bool act = tid < 128;
    if (act) for (int k = 0; k < 128; ++k) st[k * 128 + j] = 0.f;
    const size_t base = ((size_t)(b * SEQ) * NH + h) * HD;
    float nk = kn[base + j], nq = qn[base + j], nv = vn[base + j], nb = beta[(b * SEQ) * NH + h], ng = gg[(b * SEQ) * NH + h];
    for (int s = 0; s < SEQ; ++s) {
        const int buf = (s & 1) * 128;
        if (act) { sk[buf + j] = nk; sq[buf + j] = nq; }
        const float vj = nv, be = nb, ge = __expf(ng);
        __syncthreads();
        if (act) {
            if (s + 1 < SEQ) { const size_t nb_ = ((size_t)(b * SEQ + s + 1) * NH + h) * HD; nk = kn[nb_ + j]; nq = qn[nb_ + j]; nv = vn[nb_ + j]; nb = beta[(b * SEQ + s + 1) * NH + h]; ng = gg[(b * SEQ + s + 1) * NH + h]; }
            float ks = 0.f;
#pragma unroll 8
            for (int k = 0; k < 128; ++k) ks += sk[buf + k] * st[k * 128 + j];
            const float vnew = be * (vj - ge * ks);
            float oo = 0.f;
#pragma unroll 8
            for (int k = 0; k < 128; ++k) { const float sv = ge * st[k * 128 + j] + sk[buf + k] * vnew; st[k * 128 + j] = sv; oo += sq[buf + k] * sv; }
            o[((size_t)(b * SEQ + s) * NH + h) * HD + j] = oo;
        }
    }
    __syncthreads();
}
typedef short bf16x8 __attribute__((ext_vector_type(8)));
__device__ __forceinline__ f32x4 mfma16(bf16x8 a, bf16x8 b, f32x4 c) { return __builtin_amdgcn_mfma_f32_16x16x32_bf16(a, b, c, 0, 0, 0); }
__device__ __forceinline__ float bflo(unsigned x) { return __uint_as_float(x << 16); }
__device__ __forceinline__ float bfhi(unsigned x) { return __uint_as_float(x & 0xffff0000u); }
constexpr int DA_G = 0, DA_L = 1024, DA_KN = DA_L + 16384, DA_QN = DA_KN + 17408, DA_VBT = DA_QN + 17408, DA_KBET = DA_VBT + 18432, DA_KDT = DA_KBET + 18432, DA_TB = DA_KDT + 18432, DA_QK = DA_TB + 9216, DA_END = DA_QK + 9216;
static_assert(DA_END <= RING_BYTES, "DN-A LDS map");
#if defined(PROBE_DNA_A)
#define DNA_ST(k) do { if (threadIdx.x == 0) ((volatile LAS unsigned long long*)(lds + (RING_BYTES + 2048)))[k] = __builtin_amdgcn_s_memrealtime(); } while (0)
#else
#define DNA_ST(k) do { } while (0)
#endif
__device__ __forceinline__ void dna_unit(const bf16* proj, const float* cw, const float* ba, const float* a_log, const float* dt_bias,
                                         bf16* Wf, bf16* Qf, bf16* KdTf, bf16* QKf, bf16* Uf, float* glb, int uid, LAS unsigned char* lds, const LAS float* cwl, int tid, int lane, int wave) {
    const int h = uid & 7, n = (uid >> 3) & 127, b = uid >> 10, t0 = b * SEQ + n * 64;
    asm volatile("" : "+v"(lds));
    DNA_ST(0);
    LAS float* Gs = (LAS float*)(lds + DA_G);
    const int fr = lane & 15, fq = lane >> 4;
    float ba_b = 0.f, ba_a = 0.f;
    if (wave == 0) { const size_t t = (size_t)(t0 + lane); ba_b = ba[t * 16 + h]; ba_a = ba[t * 16 + 8 + h]; }
    DNA_ST(1);
    {
        const int r = tid >> 3, cg = tid & 7;
        float val[3][16];
#pragma unroll
        for (int p = 0; p < 3; ++p) {
            const int ccol = p * DDN + h * HD + cg * 16;
            float acc[16];
#pragma unroll
            for (int i = 0; i < 16; ++i) acc[i] = 0.f;
#pragma unroll
            for (int k = 0; k < 4; ++k) { const int row = r - 3 + k;
                if (n * 64 + row >= 0) {
                    const bf16* src = proj + (size_t)(t0 + row) * NPROJ + 2048 + ccol;
                    const u32x4 x0 = *(const u32x4*)src, x1 = *(const u32x4*)(src + 8);
                    const LAS float* wp = cwl + k * 384 + p * 128 + cg * 16;
                    const f32x4 w0 = *(const LAS f32x4*)wp, w1 = *(const LAS f32x4*)(wp + 4), w2 = *(const LAS f32x4*)(wp + 8), w3 = *(const LAS f32x4*)(wp + 12);
                    acc[0] += w0[0] * bflo(x0.x); acc[1] += w0[1] * bfhi(x0.x); acc[2] += w0[2] * bflo(x0.y); acc[3] += w0[3] * bfhi(x0.y);
                    acc[4] += w1[0] * bflo(x0.z); acc[5] += w1[1] * bfhi(x0.z); acc[6] += w1[2] * bflo(x0.w); acc[7] += w1[3] * bfhi(x0.w);
                    acc[8] += w2[0] * bflo(x1.x); acc[9] += w2[1] * bfhi(x1.x); acc[10] += w2[2] * bflo(x1.y); acc[11] += w2[3] * bfhi(x1.y);
                    acc[12] += w3[0] * bflo(x1.z); acc[13] += w3[1] * bfhi(x1.z); acc[14] += w3[2] * bflo(x1.w); acc[15] += w3[3] * bfhi(x1.w);
                } }
#pragma unroll
            for (int i = 0; i < 16; ++i) val[p][i] = silu_f(acc[i]);
        }
        float sq = 0.f, sk = 0.f;
#pragma unroll
        for (int i = 0; i < 16; ++i) { sq += val[0][i] * val[0][i]; sk += val[1][i] * val[1][i]; }
        sq += shfl_xor_l(sq, 1, lane); sq += shfl_xor_l(sq, 2, lane); sq += shfl_xor_l(sq, 4, lane);
        sk += shfl_xor_l(sk, 1, lane); sk += shfl_xor_l(sk, 2, lane); sk += shfl_xor_l(sk, 4, lane);
        const float rq = rsqrt_f(sq + EPS) * 0.08838834764831845f, rk = rsqrt_f(sk + EPS);
        if (wave == 0) {
            const float be0 = sigmoid_f(ba_b); float Gc = -__expf(a_log[h]) * softplus_f(ba_a + dt_bias[h]);
#pragma unroll
            for (int off = 1; off < 64; off <<= 1) { const float tmp = shfl_up_l(Gc, off, lane); if (lane >= off) Gc += tmp; }
            const float GL = shfl_idx_l(Gc, 63);
            Gs[lane] = Gc; Gs[64 + lane] = be0; Gs[128 + lane] = __expf(Gc); Gs[192 + lane] = __expf(GL - Gc);
            if (lane == 63) glb[uid] = __expf(Gc);
        }
        LDS_BARRIER();
        const float be = Gs[64 + r], eg = Gs[128 + r], egl = Gs[192 + r];
#pragma unroll
        for (int i = 0; i < 16; ++i) { val[0][i] *= rq; val[1][i] *= rk; }
        u32x4 o0, o1;
        o0.x = pk2(val[1][0], val[1][1]); o0.y = pk2(val[1][2], val[1][3]); o0.z = pk2(val[1][4], val[1][5]); o0.w = pk2(val[1][6], val[1][7]);
        o1.x = pk2(val[1][8], val[1][9]); o1.y = pk2(val[1][10], val[1][11]); o1.z = pk2(val[1][12], val[1][13]); o1.w = pk2(val[1][14], val[1][15]);
        *(LAS u32x4*)(lds + DA_KN + r * 272 + cg * 32) = o0; *(LAS u32x4*)(lds + DA_KN + r * 272 + cg * 32 + 16) = o1;
        o0.x = pk2(val[0][0], val[0][1]); o0.y = pk2(val[0][2], val[0][3]); o0.z = pk2(val[0][4], val[0][5]); o0.w = pk2(val[0][6], val[0][7]);
        o1.x = pk2(val[0][8], val[0][9]); o1.y = pk2(val[0][10], val[0][11]); o1.z = pk2(val[0][12], val[0][13]); o1.w = pk2(val[0][14], val[0][15]);
        *(LAS u32x4*)(lds + DA_QN + r * 272 + cg * 32) = o0; *(LAS u32x4*)(lds + DA_QN + r * 272 + cg * 32 + 16) = o1;
#pragma unroll
        for (int i = 0; i < 16; ++i) { const int f = cg * 16 + i;
            *(LAS unsigned short*)(lds + DA_VBT + f * 144 + r * 2) = (unsigned short)f2bf(val[2][i] * be);
            *(LAS unsigned short*)(lds + DA_KBET + f * 144 + r * 2) = (unsigned short)f2bf(val[1][i] * (be * eg));
            *(LAS unsigned short*)(lds + DA_KDT + f * 144 + r * 2) = (unsigned short)f2bf(val[1][i] * egl); }
    }
    LDS_BARRIER();
    DNA_ST(2);
    {
        const int p = wave >> 2, ti = wave & 3;
        const int abase = p == 0 ? DA_KN : DA_QN;
        bf16x8 af[4];
#pragma unroll
        for (int ks = 0; ks < 4; ++ks) af[ks] = *(const LAS bf16x8*)(lds + abase + (ti * 16 + fr) * 272 + (ks * 32 + fq * 8) * 2);
        for (int tj = 0; tj < 4; ++tj) {
            f32x4 acc = {0.f, 0.f, 0.f, 0.f};
            if (tj <= ti) {
#pragma unroll
                for (int ks = 0; ks < 4; ++ks) { const bf16x8 bb = *(const LAS bf16x8*)(lds + DA_KN + (tj * 16 + fr) * 272 + (ks * 32 + fq * 8) * 2); acc = mfma16(af[ks], bb, acc); }
            }
            const int j = tj * 16 + fr; const float Gj = Gs[j];
#pragma unroll
            for (int r = 0; r < 4; ++r) { const int i = ti * 16 + fq * 4 + r; float v = 0.f;
                if (p == 0) { if (i > j) v = Gs[64 + i] * acc[r] * __expf(Gs[i] - Gj); *(LAS float*)(lds + DA_L + (j * 64 + i) * 4) = v; }
                else { if (i >= j) v = acc[r] * __expf(Gs[i] - Gj); *(LAS unsigned short*)(lds + DA_QK + i * 144 + j * 2) = (unsigned short)f2bf(v); } }
        }
    }
    LDS_BARRIER();
    DNA_ST(3);
    {
        int lc = lane; asm volatile("" : "+v"(lc)); const float fl = (float)lc;
        const int blk = wave < 4 ? wave : 11 - wave;
        float Tr[8];
#pragma unroll
        for (int c = 0; c < 8; ++c) Tr[c] = fmaxf(0.f, 1.f - fabsf(fl - (float)(blk * 8 + c)));
        float lj[63];
#pragma unroll
        for (int j = 0; j < 63; ++j) lj[j] = *(const LAS float*)(lds + DA_L + (j * 64) * 4 + lc * 4);
#pragma unroll
        for (int j = 0; j < 63; ++j) {
            if (j >= blk * 8) {
#pragma unroll
                for (int c = 0; c < 8; ++c) { const float tj = __int_as_float(__builtin_amdgcn_readlane(__float_as_int(Tr[c]), j)); Tr[c] -= lj[j] * tj; }
            }
        }
        u32x4 o; o.x = pk2(Tr[0], Tr[1]); o.y = pk2(Tr[2], Tr[3]); o.z = pk2(Tr[4], Tr[5]); o.w = pk2(Tr[6], Tr[7]);
        *(LAS u32x4*)(lds + DA_TB + lc * 144 + blk * 16) = o;
    }
    {
        for (int fi = wave; fi < 40; fi += 8) {
            if (fi < 8) { const int mt = fi >> 1, ks = fi & 1;
                const u32x4 v = *(const LAS u32x4*)(lds + DA_QK + (mt * 16 + fr) * 144 + (ks * 32 + fq * 8) * 2);
                *(u32x4*)(QKf + (((size_t)uid * 4 + mt) * 2 + ks) * 512 + lane * 8) = v; }
            else if (fi < 24) { const int f2 = fi - 8, mt = f2 >> 2, ks = f2 & 3; const float eg = Gs[128 + mt * 16 + fr];
                const u32x4 v = *(const LAS u32x4*)(lds + DA_QN + (mt * 16 + fr) * 272 + (ks * 32 + fq * 8) * 2); u32x4 o;
                o.x = pk2(bflo(v.x) * eg, bfhi(v.x) * eg); o.y = pk2(bflo(v.y) * eg, bfhi(v.y) * eg); o.z = pk2(bflo(v.z) * eg, bfhi(v.z) * eg); o.w = pk2(bflo(v.w) * eg, bfhi(v.w) * eg);
                *(u32x4*)(Qf + (((size_t)uid * 4 + mt) * 4 + ks) * 512 + lane * 8) = o; }
            else { const int f2 = fi - 24, ft = f2 >> 1, ks = f2 & 1;
                const u32x4 v = *(const LAS u32x4*)(lds + DA_KDT + (ft * 16 + fr) * 144 + (ks * 32 + fq * 8) * 2);
                *(u32x4*)(KdTf + (((size_t)uid * 8 + ft) * 2 + ks) * 512 + lane * 8) = v; }
        }
    }
    LDS_BARRIER();
    DNA_ST(4);
    {
        bf16x8 ta[4][2];
#pragma unroll
        for (int mt = 0; mt < 4; ++mt)
#pragma unroll
            for (int ks = 0; ks < 2; ++ks) ta[mt][ks] = *(const LAS bf16x8*)(lds + DA_TB + (mt * 16 + fr) * 144 + (ks * 32 + fq * 8) * 2);
#pragma unroll
        for (int c2 = 0; c2 < 2; ++c2) { const int ct = wave * 2 + c2, img = ct < 8 ? DA_VBT : DA_KBET, cr = (ct & 7) * 16 + fr;
            bf16x8 bb[2];
#pragma unroll
            for (int ks = 0; ks < 2; ++ks) bb[ks] = *(const LAS bf16x8*)(lds + img + cr * 144 + (ks * 32 + fq * 8) * 2);
#pragma unroll
            for (int mt = 0; mt < 4; ++mt) { f32x4 acc = {0.f, 0.f, 0.f, 0.f};
#pragma unroll
                for (int ks = 0; ks < 2; ++ks) acc = mfma16(ta[mt][ks], bb[ks], acc);
                if (ct < 8) { u32x2 o; o.x = pk2(acc[0], acc[1]); o.y = pk2(acc[2], acc[3]); *(u32x2*)(Uf + ((((size_t)uid * 8 + ct) * 4 + mt) * 64 + lane) * 4) = o; }
                else { const int f = (ct - 8) * 16 + fr;
#pragma unroll
                    for (int r = 0; r < 4; ++r) *(LAS unsigned short*)(lds + DA_KN + (mt * 16 + fq * 4 + r) * 272 + f * 2) = (unsigned short)f2bf(acc[r]); } }
        }
    }
    LDS_BARRIER();
    DNA_ST(5);
#pragma unroll
    for (int q2 = 0; q2 < 2; ++q2) { const int fi = wave * 2 + q2, mt = fi >> 2, ks = fi & 3;
        const u32x4 v = *(const LAS u32x4*)(lds + DA_KN + (mt * 16 + fr) * 272 + (ks * 32 + fq * 8) * 2);
        *(u32x4*)(Wf + (((size_t)uid * 4 + mt) * 4 + ks) * 512 + lane * 8) = v; }
    LDS_BARRIER();
    DNA_ST(6);
}
struct DnbFrag { bf16x8 a1[4]; bf16x8 a2[2]; bf16x8 kd[2]; u32x2 u; float gl; };
__device__ __forceinline__ DnbFrag dnb_load(const bf16* A1, const bf16* QKf, const bf16* KdTf, const bf16* Uf, const float* glb, int uid, int ds, int wave, int lane) {
    DnbFrag f; const int mt = wave & 3;
#pragma unroll
    for (int ks = 0; ks < 4; ++ks) f.a1[ks] = *(const bf16x8*)(A1 + (((size_t)uid * 4 + mt) * 4 + ks) * 512 + lane * 8);
#pragma unroll
    for (int ks = 0; ks < 2; ++ks) f.kd[ks] = *(const bf16x8*)(KdTf + (((size_t)uid * 8 + wave) * 2 + ks) * 512 + lane * 8);
#pragma unroll
    for (int ks = 0; ks < 2; ++ks) f.a2[ks] = *(const bf16x8*)(QKf + (((size_t)uid * 4 + mt) * 2 + ks) * 512 + lane * 8);
    f.u = *(const u32x2*)(Uf + ((((size_t)uid * 8 + ds) * 4 + mt) * 64 + lane) * 4);
    f.gl = glb[uid];
    return f;
}
__device__ __forceinline__ void dnb_run(const bf16* Wf, const bf16* Qf, const bf16* KdTf, const bf16* QKf, const bf16* Uf, const float* glb, float* o, int bh, int ds, LAS unsigned char* lds, int tid, int lane, int wave) {
    const int b = bh >> 3, h = bh & 7, fr = lane & 15, fq = lane >> 4, mt = wave & 3;
    asm volatile("" : "+v"(lds));
    LAS unsigned char* ST = lds; LAS unsigned char* VNT = lds + 4608;
    for (int i = tid; i < 4608 / 4; i += 512) ((LAS unsigned*)ST)[i] = 0u;
    f32x4 accS = {0.f, 0.f, 0.f, 0.f};
    const bf16* A1 = wave < 4 ? Wf : Qf;
    DnbFrag f0 = dnb_load(A1, QKf, KdTf, Uf, glb, (b * 128 + 0) * 8 + h, ds, wave, lane), f1 = dnb_load(A1, QKf, KdTf, Uf, glb, (b * 128 + 1) * 8 + h, ds, wave, lane);
    DnbFrag f2 = dnb_load(A1, QKf, KdTf, Uf, glb, (b * 128 + 2) * 8 + h, ds, wave, lane), f3 = dnb_load(A1, QKf, KdTf, Uf, glb, (b * 128 + 3) * 8 + h, ds, wave, lane);
    __syncthreads();
#define DNB_STEP(F, nn) do { const int n = (nn); \
        f32x4 acc = {0.f, 0.f, 0.f, 0.f}; \
        _Pragma("unroll") for (int ks = 0; ks < 4; ++ks) { const bf16x8 sb = *(const LAS bf16x8*)(ST + fr * 272 + (ks * 32 + fq * 8) * 2); acc = mfma16(F.a1[ks], sb, acc); } \
        if (wave < 4) { const float v0 = bflo(F.u.x) - acc[0], v1 = bfhi(F.u.x) - acc[1], v2 = bflo(F.u.y) - acc[2], v3 = bfhi(F.u.y) - acc[3]; \
            u32x2 w; w.x = pk2(v0, v1); w.y = pk2(v2, v3); *(LAS u32x2*)(VNT + fr * 144 + (mt * 16 + fq * 4) * 2) = w; } \
        LDS_BARRIER(); \
        bf16x8 vb[2]; \
        _Pragma("unroll") for (int ks = 0; ks < 2; ++ks) vb[ks] = *(const LAS bf16x8*)(VNT + fr * 144 + (ks * 32 + fq * 8) * 2); \
        accS = accS * F.gl; \
        _Pragma("unroll") for (int ks = 0; ks < 2; ++ks) accS = mfma16(F.kd[ks], vb[ks], accS); \
        { u32x2 w; w.x = pk2(accS[0], accS[1]); w.y = pk2(accS[2], accS[3]); *(LAS u32x2*)(ST + fr * 272 + (wave * 16 + fq * 4) * 2) = w; } \
        if (wave >= 4) { _Pragma("unroll") for (int ks = 0; ks < 2; ++ks) acc = mfma16(F.a2[ks], vb[ks], acc);     \
            const size_t ob = ((size_t)(b * SEQ + n * 64 + mt * 16 + fq * 4) * NH + h) * HD + ds * 16 + fr; \
            _Pragma("unroll") for (int r = 0; r < 4; ++r) o[ob + (size_t)r * NH * HD] = acc[r]; } \
        F = dnb_load(A1, QKf, KdTf, Uf, glb, (b * 128 + (n + 4 < 128 ? n + 4 : 127)) * 8 + h, ds, wave, lane);     \
        LDS_BARRIER(); } while (0)
    for (int n4 = 0; n4 < 128; n4 += 16) {
        DNB_STEP(f0, n4); DNB_STEP(f1, n4 + 1); DNB_STEP(f2, n4 + 2); DNB_STEP(f3, n4 + 3); DNB_STEP(f0, n4 + 4); DNB_STEP(f1, n4 + 5); DNB_STEP(f2, n4 + 6); DNB_STEP(f3, n4 + 7);
        DNB_STEP(f0, n4 + 8); DNB_STEP(f1, n4 + 9); DNB_STEP(f2, n4 + 10); DNB_STEP(f3, n4 + 11); DNB_STEP(f0, n4 + 12); DNB_STEP(f1, n4 + 13); DNB_STEP(f2, n4 + 14); DNB_STEP(f3, n4 + 15); }
#undef DNB_STEP
}
constexpr int LA_XB = 0, LA_XF = 17408, LA_END = LA_XF + 64 * 132 * 4;
static_assert(LA_END <= RING_BYTES, "LRU-A LDS map");
struct LruConst { bf16x8 br[4], bi[4]; float brr, bii, sp8; };
__device__ __forceinline__ LruConst lrua_const(const bf16* WrT, const bf16* WiT, const float* b_r, const float* b_i, const float* lam, int nb, int lane, int wave) {
    LruConst c; const int fr = lane & 15, fq = lane >> 4, cl = wave * 16 + fr, ch = nb * 128 + cl;
#pragma unroll
    for (int ks = 0; ks < 4; ++ks) { c.br[ks] = *(const bf16x8*)(WrT + ((size_t)nb * 128 + cl) * 128 + ks * 32 + fq * 8); c.bi[ks] = *(const bf16x8*)(WiT + ((size_t)nb * 128 + cl) * 128 + ks * 32 + fq * 8); }
    c.brr = b_r[ch]; c.bii = b_i[ch]; c.sp8 = -8.0f * softplus_f(-lam[ch]);
    return c;
}
__device__ __forceinline__ void lrua_unit(const bf16* proj, const LruConst& LC,
                                          float* Hloc, float* Acum, float* summ, int unit, LAS unsigned char* lds, const LAS float* lwl, int tid, int lane, int wave) {
    const int nb = unit & 7, ct = unit >> 3, n = ct & 127, t0 = ct * 64;
    asm volatile("" : "+v"(lds));
    {
        const int r = tid >> 3, cg = tid & 7, ch0 = nb * 128 + cg * 16;
        float acc[16];
        { const LAS float* bp = lwl + 512 + cg * 16; const f32x4 c0v = *(const LAS f32x4*)bp, c1v = *(const LAS f32x4*)(bp + 4), c2v = *(const LAS f32x4*)(bp + 8), c3v = *(const LAS f32x4*)(bp + 12);
#pragma unroll
          for (int i = 0; i < 4; ++i) { acc[i] = c0v[i]; acc[4 + i] = c1v[i]; acc[8 + i] = c2v[i]; acc[12 + i] = c3v[i]; } }
#pragma unroll
        for (int k = 0; k < 4; ++k) { const int row = r - 3 + k;
            if (n * 64 + row >= 0) {
                const bf16* src = proj + (size_t)(t0 + row) * NPROJ + ch0;
                const u32x4 x0 = *(const u32x4*)src, x1 = *(const u32x4*)(src + 8);
                const LAS float* wp = lwl + k * 128 + cg * 16;
                const f32x4 w0 = *(const LAS f32x4*)wp, w1 = *(const LAS f32x4*)(wp + 4), w2 = *(const LAS f32x4*)(wp + 8), w3 = *(const LAS f32x4*)(wp + 12);
                acc[0] += w0[0] * bflo(x0.x); acc[1] += w0[1] * bfhi(x0.x); acc[2] += w0[2] * bflo(x0.y); acc[3] += w0[3] * bfhi(x0.y);
                acc[4] += w1[0] * bflo(x0.z); acc[5] += w1[1] * bfhi(x0.z); acc[6] += w1[2] * bflo(x0.w); acc[7] += w1[3] * bfhi(x0.w);
                acc[8] += w2[0] * bflo(x1.x); acc[9] += w2[1] * bfhi(x1.x); acc[10] += w2[2] * bflo(x1.y); acc[11] += w2[3] * bfhi(x1.y);
                acc[12] += w3[0] * bflo(x1.z); acc[13] += w3[1] * bfhi(x1.z); acc[14] += w3[2] * bflo(x1.w); acc[15] += w3[3] * bfhi(x1.w);
            } }
        u32x4 o0, o1;
        o0.x = pk2(acc[0], acc[1]); o0.y = pk2(acc[2], acc[3]); o0.z = pk2(acc[4], acc[5]); o0.w = pk2(acc[6], acc[7]);
        o1.x = pk2(acc[8], acc[9]); o1.y = pk2(acc[10], acc[11]); o1.z = pk2(acc[12], acc[13]); o1.w = pk2(acc[14], acc[15]);
        *(LAS u32x4*)(lds + LA_XB + r * 272 + cg * 32) = o0; *(LAS u32x4*)(lds + LA_XB + r * 272 + cg * 32 + 16) = o1;
        LAS f32x4* xf = (LAS f32x4*)(lds + LA_XF + (r * 132 + cg * 16) * 4);
        xf[0] = (f32x4){acc[0], acc[1], acc[2], acc[3]}; xf[1] = (f32x4){acc[4], acc[5], acc[6], acc[7]}; xf[2] = (f32x4){acc[8], acc[9], acc[10], acc[11]}; xf[3] = (f32x4){acc[12], acc[13], acc[14], acc[15]};
    }
    LDS_BARRIER();
    const int fr = lane & 15, fq = lane >> 4, cl = wave * 16 + fr, ch = nb * 128 + cl;
    f32x4 ar[4], ai[4];
#pragma unroll
    for (int mt = 0; mt < 4; ++mt) { ar[mt] = (f32x4){0.f, 0.f, 0.f, 0.f}; ai[mt] = (f32x4){0.f, 0.f, 0.f, 0.f};
#pragma unroll
        for (int ks = 0; ks < 4; ++ks) { const bf16x8 af = *(const LAS bf16x8*)(lds + LA_XB + (mt * 16 + fr) * 272 + (ks * 32 + fq * 8) * 2); ar[mt] = mfma16(af, LC.br[ks], ar[mt]); ai[mt] = mfma16(af, LC.bi[ks], ai[mt]); } }
    const float brr = LC.brr, bii = LC.bii, sp8 = LC.sp8;
    float Ac = 1.f, Bc = 0.f;
#pragma unroll
    for (int mt = 0; mt < 4; ++mt) {
        float P[4], H[4];
#pragma unroll
        for (int r = 0; r < 4; ++r) { const int t = mt * 16 + fq * 4 + r; const float xcv = *(const LAS float*)(lds + LA_XF + (t * 132 + cl) * 4);
            const float rr = sigmoid_f(ar[mt][r] + brr), ii = sigmoid_f(ai[mt][r] + bii), la = sp8 * rr, a = __expf(la), bb = __builtin_amdgcn_sqrtf(fmaxf(1.0f - a * a, 0.0f)) * (ii * xcv);
            if (r == 0) { P[0] = a; H[0] = bb; } else { P[r] = P[r - 1] * a; H[r] = a * H[r - 1] + bb; } }
        float Ai = P[3], Bi = H[3];
        { const float Au = shfl_up_l(Ai, 16, lane), Bu = shfl_up_l(Bi, 16, lane); if (fq >= 1) { Bi = Ai * Bu + Bi; Ai = Au * Ai; } }
        { const float Au = shfl_up_l(Ai, 32, lane), Bu = shfl_up_l(Bi, 32, lane); if (fq >= 2) { Bi = Ai * Bu + Bi; Ai = Au * Ai; } }
        float Ae = shfl_up_l(Ai, 16, lane), Be = shfl_up_l(Bi, 16, lane); if (fq == 0) { Ae = 1.f; Be = 0.f; }
        const float At = shfl_idx_l(Ai, 48 + fr), Bt = shfl_idx_l(Bi, 48 + fr);
        const float PA = Ac * Ae, PB = Ae * Bc + Be;
#pragma unroll
        for (int r = 0; r < 4; ++r) { const size_t o = (size_t)(t0 + mt * 16 + fq * 4 + r) * DLRU + ch; ((unsigned*)Hloc)[o] = pk2(P[r] * PB + H[r], PA * P[r]); }
        Bc = At * Bc + Bt; Ac = Ac * At;
    }
    if (fq == 0) { float* sp = summ + ((size_t)ct * DLRU + ch) * 2; sp[0] = Ac; sp[1] = Bc; }
    LDS_BARRIER();
}
__device__ __forceinline__ void lru_carry(const float* summ, float* carry, int idx) {
    const int b = idx >> 10, ch = idx & 1023; float c = 0.f;
    for (int n0 = 0; n0 < 128; n0 += 8) { float A[8], B[8];
#pragma unroll
        for (int j = 0; j < 8; ++j) { const float* sp = summ + ((size_t)(b * 128 + n0 + j) * DLRU + ch) * 2; A[j] = sp[0]; B[j] = sp[1]; }
#pragma unroll
        for (int j = 0; j < 8; ++j) { carry[(size_t)(b * 128 + n0 + j) * DLRU + ch] = c; c = A[j] * c + B[j]; } }
}
__device__ __forceinline__ void lrub_row(const float* Hloc, const float* Acum, const float* carry, const bf16* proj, const float* gain, bf16* ymix, int row, int lane) {
    const int ct = row >> 6; f32x4 y[4]; float ss = 0.f;
#pragma unroll
    for (int j = 0; j < 4; ++j) { const int c4 = lane * 4 + 256 * j;
        const u32x4 ha = *(const u32x4*)((const unsigned*)Hloc + (size_t)row * DLRU + c4); const f32x4 cr = *(const f32x4*)(carry + (size_t)ct * DLRU + c4);
        const u32x2 g = *(const u32x2*)(proj + (size_t)row * NPROJ + DLRU + c4);
        const f32x4 hl = {bflo(ha.x), bflo(ha.y), bflo(ha.z), bflo(ha.w)}, ac = {bfhi(ha.x), bfhi(ha.y), bfhi(ha.z), bfhi(ha.w)};
        const f32x4 hh = hl + ac * cr;
        y[j][0] = hh[0] * gelu_tanh_f(bflo(g.x)); y[j][1] = hh[1] * gelu_tanh_f(bfhi(g.x)); y[j][2] = hh[2] * gelu_tanh_f(bflo(g.y)); y[j][3] = hh[3] * gelu_tanh_f(bfhi(g.y));
        ss += (y[j][0] * y[j][0] + y[j][1] * y[j][1]) + (y[j][2] * y[j][2] + y[j][3] * y[j][3]); }
    ss = wave_sum(ss, lane); const float rs = rsqrt_f(ss * (1.0f / DLRU) + EPS);
#pragma unroll
    for (int j = 0; j < 4; ++j) { const int c4 = lane * 4 + 256 * j; const f32x4 g = *(const f32x4*)(gain + c4); u32x2 w; w.x = pk2(y[j][0] * rs * g[0], y[j][1] * rs * g[1]); w.y = pk2(y[j][2] * rs * g[2], y[j][3] * rs * g[3]);
        *(u32x2*)(ymix + (size_t)row * D + c4) = w; }
}
__device__ __forceinline__ void dn_out_row(const float* o, const float* gain, const bf16* proj, bf16* ymix, int t, int lane) {
    const int c = lane * 16;
    const f32x4* op = (const f32x4*)(o + (size_t)t * DDN + c); const f32x4 o0 = op[0], o1 = op[1], o2 = op[2], o3 = op[3];
    const u32x4* gp = (const u32x4*)(proj + (size_t)t * NPROJ + 5120 + c); const u32x4 g0 = gp[0], g1 = gp[1];
    const f32x4* wp = (const f32x4*)(gain + (c & 127)); const f32x4 w0 = wp[0], w1 = wp[1], w2 = wp[2], w3 = wp[3];
    float ss = (o0[0] * o0[0] + o0[1] * o0[1]) + (o0[2] * o0[2] + o0[3] * o0[3]) + (o1[0] * o1[0] + o1[1] * o1[1]) + (o1[2] * o1[2] + o1[3] * o1[3])
             + (o2[0] * o2[0] + o2[1] * o2[1]) + (o2[2] * o2[2] + o2[3] * o2[3]) + (o3[0] * o3[0] + o3[1] * o3[1]) + (o3[2] * o3[2] + o3[3] * o3[3]);
    ss += shfl_xor_l(ss, 1, lane); ss += shfl_xor_l(ss, 2, lane); ss += shfl_xor_l(ss, 4, lane);
    const float rs = rsqrt_f(ss * (1.0f / HD) + EPS);
    u32x4 r0, r1;
    r0.x = pk2(o0[0] * rs * w0[0] * silu_f(bflo(g0.x)), o0[1] * rs * w0[1] * silu_f(bfhi(g0.x))); r0.y = pk2(o0[2] * rs * w0[2] * silu_f(bflo(g0.y)), o0[3] * rs * w0[3] * silu_f(bfhi(g0.y)));
    r0.z = pk2(o1[0] * rs * w1[0] * silu_f(bflo(g0.z)), o1[1] * rs * w1[1] * silu_f(bfhi(g0.z))); r0.w = pk2(o1[2] * rs * w1[2] * silu_f(bflo(g0.w)), o1[3] * rs * w1[3] * silu_f(bfhi(g0.w)));
    r1.x = pk2(o2[0] * rs * w2[0] * silu_f(bflo(g1.x)), o2[1] * rs * w2[1] * silu_f(bfhi(g1.x))); r1.y = pk2(o2[2] * rs * w2[2] * silu_f(bflo(g1.y)), o2[3] * rs * w2[3] * silu_f(bfhi(g1.y)));
    r1.z = pk2(o3[0] * rs * w3[0] * silu_f(bflo(g1.z)), o3[1] * rs * w3[1] * silu_f(bfhi(g1.z))); r1.w = pk2(o3[2] * rs * w3[2] * silu_f(bflo(g1.w)), o3[3] * rs * w3[3] * silu_f(bfhi(g1.w)));
    u32x4* dst = (u32x4*)(ymix + (size_t)t * D + DLRU + c); dst[0] = r0; dst[1] = r1;
}
__device__ __forceinline__ void route_row(const float* x, const float* rstd, const float* gain, const float* router, float* roww, int row, int lane) {
    float acc[8];
#pragma unroll
    for (int e = 0; e < 8; ++e) acc[e] = 0.f;
    for (int j = 0; j < 32; ++j) { const int k = lane + 64 * j; const float xv = x[(size_t)row * D + k] * gain[k]; const f32x4 r0 = *(const f32x4*)(router + (size_t)k * 8), r1 = *(const f32x4*)(router + (size_t)k * 8 + 4);
        acc[0] += xv * r0[0]; acc[1] += xv * r0[1]; acc[2] += xv * r0[2]; acc[3] += xv * r0[3]; acc[4] += xv * r1[0]; acc[5] += xv * r1[1]; acc[6] += xv * r1[2]; acc[7] += xv * r1[3]; }
    const float rs = rstd[row];
#pragma unroll
    for (int e = 0; e < 8; ++e) acc[e] = wave_sum(acc[e], lane) * rs;
    int e1 = 0; float l1 = acc[0];
#pragma unroll
    for (int e = 1; e < 8; ++e) if (acc[e] > l1) { l1 = acc[e]; e1 = e; }
    int e2 = -1; float l2 = -3.4e38f;
#pragma unroll
    for (int e = 0; e < 8; ++e) if (e != e1 && acc[e] > l2) { l2 = acc[e]; e2 = e; }
    const float w1 = 1.0f / (1.0f + __expf(l2 - l1)), w2 = 1.0f - w1;
    if (lane < 8) roww[(size_t)lane * T + row] = lane == e1 ? w1 : (lane == e2 ? w2 : 0.0f);
}
__device__ __forceinline__ void final_row(const float* x, const float* gain, float* out, int row, int lane) {
    const f32x4* xr = (const f32x4*)(x + (size_t)row * D) + lane; const f32x4* gr = (const f32x4*)gain + lane;
    f32x4 v[8]; float ss = 0.f;
#pragma unroll
    for (int j = 0; j < 8; ++j) { v[j] = xr[64 * j]; ss += (v[j][0] * v[j][0] + v[j][1] * v[j][1]) + (v[j][2] * v[j][2] + v[j][3] * v[j][3]); }
    ss = wave_sum(ss, lane); const float rs = rsqrt_f(ss * (1.0f / D) + EPS);
    f32x4* o = (f32x4*)(out + (size_t)row * D) + lane;
#pragma unroll
    for (int j = 0; j < 8; ++j) o[64 * j] = v[j] * rs * gr[64 * j];
}

struct MoeOrder {
    const int* list; int nN, G, c; int c0, c1, c2, c3, c4, c5, c6, c7;
    __device__ __forceinline__ void init(const unsigned* cnt, const int* list_, int nN_, int G_, int c_) { list = list_; nN = nN_; G = G_; c = c_;
        c0 = __builtin_amdgcn_readfirstlane((int)cnt[0]); c1 = __builtin_amdgcn_readfirstlane((int)cnt[1]); c2 = __builtin_amdgcn_readfirstlane((int)cnt[2]); c3 = __builtin_amdgcn_readfirstlane((int)cnt[3]);
        c4 = __builtin_amdgcn_readfirstlane((int)cnt[4]); c5 = __builtin_amdgcn_readfirstlane((int)cnt[5]); c6 = __builtin_amdgcn_readfirstlane((int)cnt[6]); c7 = __builtin_amdgcn_readfirstlane((int)cnt[7]); }
    __device__ __forceinline__ bool next(int i, pg8::Unit& u) const {
        const int c8[8] = {c0, c1, c2, c3, c4, c5, c6, c7}; int nM = 0;
#pragma unroll
        for (int k = 0; k < 8; ++k) nM += (c8[k] + 255) >> 8;
        const int nwg = nM * nN; const long L = (long)i * G + c; if (L >= nwg) return false;
        int wgid = (int)L; { const int q = nwg / pg8::NXCD, r = nwg % pg8::NXCD, xcd = wgid % pg8::NXCD, off = wgid / pg8::NXCD; wgid = (xcd < r ? xcd * (q + 1) : r * (q + 1) + (xcd - r) * q) + off; }
        const int nig = pg8::WGM * nN, gid = wgid / nig, fm = gid * pg8::WGM, gsz = (nM - fm) < pg8::WGM ? (nM - fm) : pg8::WGM;
        u.pm = fm + ((wgid % nig) % gsz); u.pn = (wgid % nig) / gsz;
        int e = 0, ps = 0, ce = c8[0], run = 0;
#pragma unroll
        for (int k = 0; k < 8; ++k) { const int mk = (c8[k] + 255) >> 8; if (u.pm >= run && u.pm < run + mk) { e = k; ps = run; ce = c8[k]; } run += mk; }
        const int mtl = u.pm - ps; u.pb = e * nN + u.pn; u.lbase = e * T + mtl * 256; u.nvalid = (ce - mtl * 256) < 256 ? (ce - mtl * 256) : 256;
        return true;
    }
    __device__ __forceinline__ int arow(const pg8::Unit& u, int r) const { return r < u.nvalid ? (list[u.lbase + r] & 0xffff) : 0; }
    __device__ __forceinline__ void a_ready(const pg8::Unit&) const {}
    __device__ __forceinline__ void done(const pg8::Unit&) const {}
};
__device__ __forceinline__ void route_block(const float* x, const float* gain, const float* router, bf16* xb, float* rstd, unsigned* cnt, int* list, float* listw, int blk, LAS unsigned char* lds, int tid, int lane, int wave) {
    asm volatile("" : "+v"(lds));
    LAS float* grt = (LAS float*)lds; LAS int* se1 = (LAS int*)(lds + 65536); LAS int* se2 = se1 + 64; LAS float* sw1 = (LAS float*)(se2 + 64); LAS float* sw2 = sw1 + 64; LAS int* lcnt = (LAS int*)(sw2 + 64); LAS int* gbase = lcnt + 8;
    for (int i = tid; i < D * 8; i += 512) grt[i] = router[i] * gain[i >> 3];
    if (tid < 8) lcnt[tid] = 0;
    __syncthreads();
    for (int q = 0; q < 8; ++q) { const int rloc = wave * 8 + q, row = blk * 64 + rloc;
        const f32x4* xr = (const f32x4*)(x + (size_t)row * D) + lane;
        f32x4 v[8]; float ss = 0.f;
#pragma unroll
        for (int j = 0; j < 8; ++j) { v[j] = xr[64 * j]; ss += (v[j][0] * v[j][0] + v[j][1] * v[j][1]) + (v[j][2] * v[j][2] + v[j][3] * v[j][3]); }
        ss = wave_sum(ss, lane); const float rs = rsqrt_f(ss * (1.0f / D) + EPS);
        u32x2* o = (u32x2*)(xb + (size_t)row * D) + lane;
#pragma unroll
        for (int j = 0; j < 8; ++j) { u32x2 w; w.x = pk2(v[j][0], v[j][1]); w.y = pk2(v[j][2], v[j][3]); o[64 * j] = w; }
        if (lane == 0) rstd[row] = rs;
        float acc[8];
#pragma unroll
        for (int e = 0; e < 8; ++e) acc[e] = 0.f;
#pragma unroll
        for (int j = 0; j < 8; ++j)
#pragma unroll
            for (int c = 0; c < 4; ++c) { const int k = (lane + 64 * j) * 4 + c; const f32x4 r0 = *(const LAS f32x4*)(grt + k * 8), r1 = *(const LAS f32x4*)(grt + k * 8 + 4); const float xv = v[j][c];
                acc[0] += xv * r0[0]; acc[1] += xv * r0[1]; acc[2] += xv * r0[2]; acc[3] += xv * r0[3]; acc[4] += xv * r1[0]; acc[5] += xv * r1[1]; acc[6] += xv * r1[2]; acc[7] += xv * r1[3]; }
#pragma unroll
        for (int e = 0; e < 8; ++e) acc[e] = wave_sum(acc[e], lane) * rs;
        int e1 = 0; float l1 = acc[0];
#pragma unroll
        for (int e = 1; e < 8; ++e) if (acc[e] > l1) { l1 = acc[e]; e1 = e; }
        int e2 = -1; float l2 = -3.4e38f;
#pragma unroll
        for (int e = 0; e < 8; ++e) if (e != e1 && acc[e] > l2) { l2 = acc[e]; e2 = e; }
        const float w1 = 1.0f / (1.0f + __expf(l2 - l1));
        if (lane == 0) { se1[rloc] = e1; se2[rloc] = e2; sw1[rloc] = w1; sw2[rloc] = 1.0f - w1; }
    }
    __syncthreads();
    int e = 0, lr = 0; float w = 0.f;
    if (tid < 128) { const int rloc = tid >> 1, j = tid & 1; e = j ? se2[rloc] : se1[rloc]; w = j ? sw2[rloc] : sw1[rloc]; lr = __hip_atomic_fetch_add(lcnt + e, 1, __ATOMIC_RELAXED, __HIP_MEMORY_SCOPE_WORKGROUP); }
    __syncthreads();
    if (tid < 8) gbase[tid] = (int)__hip_atomic_fetch_add(cnt + tid, (unsigned)lcnt[tid], __ATOMIC_RELAXED, __HIP_MEMORY_SCOPE_AGENT);
    __syncthreads();
    if (tid < 128) { const int pos = gbase[e] + lr, tok = blk * 64 + (tid >> 1); list[e * T + pos] = tok | ((tid & 1) << 16); listw[e * T + pos] = w; }
    __syncthreads();
}
__device__ __forceinline__ void final_row_moe(const float* x, const bf16* y0, const bf16* y1, const float* gain, float* out, int row, int lane) {
    const f32x4* xr = (const f32x4*)(x + (size_t)row * D) + lane; const f32x4* gr = (const f32x4*)gain + lane;
    const u32x2* p0 = (const u32x2*)(y0 + (size_t)row * D) + lane; const u32x2* p1 = (const u32x2*)(y1 + (size_t)row * D) + lane;
    f32x4 v[8]; float ss = 0.f;
#pragma unroll
    for (int j = 0; j < 8; ++j) { v[j] = xr[64 * j]; const u32x2 a = p0[64 * j], b = p1[64 * j];
        v[j][0] += bflo(a.x) + bflo(b.x); v[j][1] += bfhi(a.x) + bfhi(b.x); v[j][2] += bflo(a.y) + bflo(b.y); v[j][3] += bfhi(a.y) + bfhi(b.y);
        ss += (v[j][0] * v[j][0] + v[j][1] * v[j][1]) + (v[j][2] * v[j][2] + v[j][3] * v[j][3]); }
    ss = wave_sum(ss, lane); const float rs = rsqrt_f(ss * (1.0f / D) + EPS);
    f32x4* o = (f32x4*)(out + (size_t)row * D) + lane;
#pragma unroll
    for (int j = 0; j < 8; ++j) o[64 * j] = v[j] * rs * gr[64 * j];
}
__device__ __forceinline__ void ba_tail(const bf16* xbp, const bf16* wbab, const float* ssq, int mode, float* bap, int rb, int wave, int lane) {
    if (wave < 4) { const int fr = lane & 15, fq = lane >> 4, r0 = rb * 64 + wave * 16;
        const bf16* ap = xbp + (size_t)(r0 + fr) * D + fq * 8; const bf16* bp = wbab + (size_t)fr * D + fq * 8;
        f32x4 acc = {0.f, 0.f, 0.f, 0.f};
#pragma unroll 16
        for (int ks = 0; ks < 64; ++ks) { const bf16x8 a = *(const bf16x8*)(ap + ks * 32), b = *(const bf16x8*)(bp + ks * 32); acc = mfma16(a, b, acc); }
#pragma unroll
        for (int rr = 0; rr < 4; ++rr) { const int r = r0 + fq * 4 + rr; bap[(size_t)r * 16 + fr] = acc[rr] * pg8::row_scale(ssq, r, mode); } }
}
struct Args { const float* in[25]; float* out; unsigned char* ws; int ph_lo, ph_hi; };
typedef const __attribute__((address_space(4))) unsigned long long* kaptr_t;
__device__ __forceinline__ unsigned long long ldka(int i) { kaptr_t ka = (kaptr_t)__builtin_amdgcn_kernarg_segment_ptr(); asm volatile("" : "+s"(i)); return ka[i]; }
__device__ __forceinline__ const float* ldin(const Args&, int i) { return (const float*)(const GAS float*)ldka(i); }
__device__ __forceinline__ unsigned char* ldws(const Args&) { return (unsigned char*)(GAS unsigned char*)ldka(26); }
__device__ __forceinline__ float* ldout(const Args&) { return (float*)(GAS float*)ldka(25); }
__global__ void __launch_bounds__(512, 2) mega(Args args) {
    extern __shared__ __attribute__((aligned(16))) unsigned char lds_raw[];
    LAS unsigned char* lds = (LAS unsigned char*)lds_raw;
    volatile LAS unsigned* MISC = (volatile LAS unsigned*)(lds + MISC_OFF);
    const int tid = threadIdx.x;
    const int G = gridDim.x, bid = blockIdx.x, NGW = G * 8;
    unsigned char* ws = ldws(args);
    for (int u = tid; u < (LDS_BYTES - LDSCTL_OFF) / 4; u += 512) ((LAS unsigned*)(lds + LDSCTL_OFF))[u] = 0u;
    __syncthreads();
    (void)xcd_barrier_post((unsigned*)(ws + WS_CTL) + CW_BAR, MISC + 8);
#define RUN(id) true
#if defined(PROBE_MASK)
#define STAMP() do { if (threadIdx.x == 0) { ((volatile LAS unsigned long long*)(lds + LDSCTL_OFF + 1024))[nst] = __builtin_amdgcn_s_memrealtime(); } ++nst; } while (0)
#else
#define STAMP() do { } while (0)
#endif
#define SEAM(id) do { XcdBarrier bar_; bar_.bar = (unsigned*)WSP(WS_CTL) + CW_BAR; bar_.x = xb_xcc_id(); bar_.st = (volatile LAS unsigned*)(lds + MISC_OFF) + 8; xcd_barrier(bar_); STAMP(); } while (0)
#if defined(PROBE_MASK)
    int nst = 0; STAMP();
#endif
#define INP(i) ldin(args, (i))
#define WSP(off) (ldws(args) + (off))
#define x_in INP(0)
#define norm_mix INP(1)
#define w_in INP(2)
#define conv_lru_w INP(3)
#define conv_lru_b INP(4)
#define lru_w_r INP(5)
#define lru_b_r INP(6)
#define lru_w_i INP(7)
#define lru_b_i INP(8)
#define lru_lambda INP(9)
#define lru_out_norm INP(10)
#define conv_qkv_w INP(11)
#define dn_a_log INP(12)
#define dn_dt_bias INP(13)
#define dn_out_norm INP(14)
#define w_out INP(15)
#define norm_ffn INP(16)
#define ffn_w_gate INP(17)
#define ffn_w_up INP(18)
#define ffn_w_down INP(19)
#define moe_router INP(20)
#define moe_w_gate INP(21)
#define moe_w_up INP(22)
#define moe_w_down INP(23)
#define norm_final INP(24)
#define xres (ldout(args))
#define Win ((bf16*)WSP(WS_WIN))
#define Wba ((float*)WSP(WS_WBA))
#define Wout ((bf16*)WSP(WS_WOUT))
#define Wgu ((bf16*)WSP(WS_WGU))
#define Wd ((bf16*)WSP(WS_WD))
#define Mgu ((bf16*)WSP(WS_C))
#define Md ((bf16*)WSP(WS_WGU))
#define MCNT ((unsigned*)WSP(WS_CTL) + CW_CNT)
#define MLIST ((int*)WSP(WS_ROWW))
#define MLISTW ((float*)WSP(WS_ROWW + (size_t)8 * T * 4))
#define YP0 ((bf16*)WSP(WS_XB))
#define YP1 ((bf16*)WSP(WS_YMIX))
#define xb ((bf16*)WSP(WS_XB))
#define rstd ((float*)WSP(WS_RSTD))
#define SSQA ((float*)WSP(WS_RSTD + (size_t)1 * MiB))
#define SSQB ((float*)WSP(WS_RSTD + (size_t)3 * MiB))
#define WBAB ((bf16*)WSP(WS_WBA + (size_t)2 * 16 * D * 4))
#define ba ((float*)WSP(WS_BA))
#define beta ((float*)WSP(WS_BETA))
#define gg ((float*)WSP(WS_G))
#define roww ((float*)WSP(WS_ROWW))
#define proj ((bf16*)WSP(WS_PROJ))
#define hid ((bf16*)WSP(WS_PROJ))
#define ymix ((bf16*)WSP(WS_YMIX))
#define c0 ((float*)WSP(WS_C))
#define c1 ((float*)WSP(WS_C + (size_t)T * 1024 * 4))
#define c2 ((float*)WSP(WS_C + (size_t)2 * T * 1024 * 4))
#define c3 ((float*)WSP(WS_C + (size_t)3 * T * 1024 * 4))
#define LRU_WRT ((bf16*)WSP(WS_WRT))
#define LRU_WIT ((bf16*)WSP(WS_WRT + (size_t)2 * 8 * 128 * 128 * 2))
#define LRU_H ((float*)WSP(WS_C + (size_t)256 * MiB))
#define LRU_A ((float*)WSP(WS_C + (size_t)320 * MiB))
#define LRU_SUMM ((float*)WSP(WS_C + (size_t)384 * MiB))
#define LRU_CARRY ((float*)WSP(WS_C + (size_t)386 * MiB))
#define DN_WF ((bf16*)WSP(WS_C))
#define DN_QF ((bf16*)WSP(WS_C + (size_t)32 * MiB))
#define DN_KDTF ((bf16*)WSP(WS_C + (size_t)64 * MiB))
#define DN_UF ((bf16*)WSP(WS_C + (size_t)96 * MiB))
#define DN_QKF ((bf16*)WSP(WS_C + (size_t)128 * MiB))
#define DN_GL ((float*)WSP(WS_C + (size_t)144 * MiB))
    const int BIG = 1 << 30;
#define PHL int tid_ = threadIdx.x; asm volatile("" : "+v"(tid_)); const int lane_ = tid_ & 63; int bid_ = blockIdx.x; asm volatile("" : "+s"(bid_)); const int gw_ = bid_ * 8 + __builtin_amdgcn_readfirstlane(tid_ >> 6); const size_t gt_ = (size_t)bid_ * 512 + tid_, NGT = (size_t)G * 512; LAS float* scr = (LAS float*)(lds + (gw_ & 7) * 16384);
    if (RUN(ph)) { PHL
        convert_matrix(w_in, DIN, 0, D, NPROJ, norm_mix, Win, BIG, 0, 0, scr, gw_, NGW, lane_);
        convert_matrix(w_out, D, 0, D, D, nullptr, Wout, BIG, 0, 0, scr, gw_, NGW, lane_);
        for (size_t i = gt_; i < (size_t)2 * 16 * D; i += NGT) { const int l = (int)(i / (16 * D)), j = (int)((i / D) & 15), k = (int)(i % D); WBAB[i] = (bf16)f2bf(w_in[(size_t)l * D * DIN + (size_t)k * DIN + NPROJ + j] * norm_mix[l * D + k]); }
        for (int r = gw_; r < T; r += NGW) rowprep_row(x_in, xb, rstd, nullptr, nullptr, r, lane_);
        for (int m = 0; m < 16; ++m) {
            convert_matrix(lru_w_r + (size_t)m * 128 * 128, 128, 0, 128, 128, nullptr, LRU_WRT + (size_t)m * 128 * 128, BIG, 0, 0, scr, gw_, NGW, lane_);
            convert_matrix(lru_w_i + (size_t)m * 128 * 128, 128, 0, 128, 128, nullptr, LRU_WIT + (size_t)m * 128 * 128, BIG, 0, 0, scr, gw_, NGW, lane_); }
    }
    SEAM(ph);
    int xsel = 0;
#define xcur (xsel ? (const float*)xres : x_in)
    { constexpr int l = 0;
        if (RUN(ph)) { pg8::Gemm g{xb, Win + (size_t)l * NPROJ * D, T, NPROJ, D, 0}; pg8::StaticOrder S; S.init(T, NPROJ, G, bid); pg8::EpiScaleBf16 E{proj, l == 0 ? rstd : SSQB, NPROJ, l};
            pg8::gemm_phase<pg8::EpiScaleBf16, pg8::StaticOrder, true, false>(lds, g, S, E);
            { PHL for (int rb = bid_; rb < T / 64; rb += G) ba_tail(xb, WBAB + (size_t)l * 16 * D, l == 0 ? rstd : SSQB, l, ba, rb, gw_ & 7, lane_); } }
        SEAM(ph);
        if (RUN(ph)) { PHL
            LAS float* cwl = (LAS float*)(lds + LDSCTL_OFF + 4096); LAS float* lwl = cwl + 4 * 384;
            { const int hb = bid_ & 7; const float* cq = conv_qkv_w + (size_t)l * 4 * 3 * DDN; const float* cl = conv_lru_w + (size_t)l * 4 * DLRU; const float* cbp = conv_lru_b + l * DLRU;
              for (int i = tid_; i < 4 * 384; i += 512) { const int k = i / 384, pp = (i % 384) >> 7, d = i & 127; cwl[i] = cq[k * 3 * DDN + pp * DDN + hb * HD + d]; }
              for (int i = tid_; i < 640; i += 512) { const int k = i >> 7, d = i & 127; lwl[i] = k < 4 ? cl[k * DLRU + hb * 128 + d] : cbp[hb * 128 + d]; }
              __syncthreads(); }
            { const LruConst LC = lrua_const(LRU_WRT + (size_t)l * 8 * 128 * 128, LRU_WIT + (size_t)l * 8 * 128 * 128, lru_b_r + l * DLRU, lru_b_i + l * DLRU, lru_lambda + l * DLRU, bid_ & 7, lane_, gw_ & 7);
              for (int u = bid_; u < 2048; u += G) lrua_unit(proj, LC, LRU_H, LRU_A, LRU_SUMM, u, lds, lwl, tid_, lane_, gw_ & 7); }
            STAMP();
            for (int uid = bid_; uid < 2048; uid += G) dna_unit(proj, conv_qkv_w + (size_t)l * 4 * 3 * DDN, ba, dn_a_log + l * NH, dn_dt_bias + l * NH, DN_WF, DN_QF, DN_KDTF, DN_QKF, DN_UF, DN_GL, uid, lds, cwl, tid_, lane_, gw_ & 7); }
        SEAM(ph);
        if (RUN(ph)) { PHL
            if (bid_ < 128) dnb_run(DN_WF, DN_QF, DN_KDTF, DN_QKF, DN_UF, DN_GL, c3, (bid_ & 7) + 8 * (bid_ >> 6), (bid_ >> 3) & 7, lds, tid_, lane_, gw_ & 7);
            else { if (bid_ < 136 && tid_ < 256) lru_carry(LRU_SUMM, LRU_CARRY, (bid_ - 128) * 256 + tid_);
                const int cw = gw_ - 128 * 8, CNW = NGW - 128 * 8;
                if (l == 0) {
                    convert_matrix(w_in + (size_t)D * DIN, DIN, 0, D, NPROJ, norm_mix + D, Win + (size_t)NPROJ * D, BIG, 0, 0, scr, cw, CNW, lane_);
                    convert_matrix(w_out + (size_t)D * D, D, 0, D, D, nullptr, Wout + (size_t)D * D, BIG, 0, 0, scr, cw, CNW, lane_);
                    convert_matrix(ffn_w_gate, DFF, 0, D, DFF, norm_ffn, Wgu, 128, 256, 0, scr, cw, CNW, lane_);
                    convert_matrix(ffn_w_up, DFF, 0, D, DFF, norm_ffn, Wgu, 128, 256, 128, scr, cw, CNW, lane_);
                    convert_matrix(ffn_w_down, D, 0, DFF, D, nullptr, Wd, BIG, 0, 0, scr, cw, CNW, lane_);
                } else {
                    for (int e = 0; e < NEXP; ++e) convert_matrix(moe_w_down + (size_t)e * DFFE * D, D, 0, DFFE, D, nullptr, Md + (size_t)e * D * DFFE, BIG, 0, 0, scr, cw, CNW, lane_);
                } } }
        SEAM(ph);
        if (RUN(ph)) { PHL
            for (int r = gw_; r < T; r += NGW) lrub_row(LRU_H, LRU_A, LRU_CARRY, proj, lru_out_norm + l * DLRU, ymix, r, lane_);
            for (int r = gw_; r < T; r += NGW) dn_out_row(c3, dn_out_norm + l * HD, proj, ymix, r, lane_); }
        SEAM(ph);
        if (RUN(ph)) { if (l == 0) { pg8::Gemm g{ymix, Wout, T, D, D, 0}; pg8::StaticOrder S; S.init(T, D, G, bid); pg8::EpiResidualNorm E{xcur, xres, xb, SSQA, D, 0};
            pg8::gemm_phase<pg8::EpiResidualNorm, pg8::StaticOrder, true, false>(lds, g, S, E); }
          else { pg8::Gemm g{ymix, Wout + (size_t)D * D, T, D, D, 0}; pg8::StaticOrder S; S.init(T, D, G, bid); pg8::EpiResidual E{xcur, xres, nullptr, D, 0};
            pg8::gemm_phase<pg8::EpiResidual, pg8::StaticOrder, true, false>(lds, g, S, E); }
            if (l == 1) { PHL
                for (int e = 0; e < NEXP; ++e) {
                    convert_matrix(moe_w_gate + (size_t)e * D * DFFE, DFFE, 0, D, DFFE, norm_ffn + D, Mgu + (size_t)e * 2 * DFFE * D, 128, 256, 0, scr, gw_, NGW, lane_);
                    convert_matrix(moe_w_up + (size_t)e * D * DFFE, DFFE, 0, D, DFFE, norm_ffn + D, Mgu + (size_t)e * 2 * DFFE * D, 128, 256, 128, scr, gw_, NGW, lane_);
 } } }
        SEAM(ph);
        xsel = 1;
        if (l == 0) {
            if (RUN(ph)) { pg8::Gemm g{xb, Wgu, T, 2 * DFF, D, 0}; pg8::StaticOrder S; S.init(T, 2 * DFF, G, bid); pg8::EpiSwiGLU E{hid, SSQA, DFF, 1};
                pg8::gemm_phase<pg8::EpiSwiGLU, pg8::StaticOrder, true, false>(lds, g, S, E); }
            SEAM(ph);
            if (RUN(ph)) { pg8::Gemm g{hid, Wd, T, D, DFF, 0}; pg8::StaticOrder S; S.init(T, D, G, bid); pg8::EpiResidualNorm E{xcur, xres, xb, SSQB, D, 0};
                pg8::gemm_phase<pg8::EpiResidualNorm, pg8::StaticOrder, true, false>(lds, g, S, E); }
            SEAM(ph);
        } else {
            if (RUN(ph)) { PHL for (int blk = bid_; blk < T / 64; blk += G) route_block(xcur, norm_ffn + D, moe_router, xb, rstd, MCNT, MLIST, MLISTW, blk, lds, tid_, lane_, gw_ & 7); }
            SEAM(ph);
            if (RUN(ph)) { pg8::Gemm g{xb, Mgu, NSLOT, 2 * DFFE, D, 0}; MoeOrder S; S.init(MCNT, MLIST, 2 * DFFE / 256, G, bid); pg8::EpiSwiGLUMoe E{hid, rstd, MLIST, DFFE, 0};
                pg8::gemm_phase<pg8::EpiSwiGLUMoe, MoeOrder, true, true>(lds, g, S, E); }
            SEAM(ph);
            if (RUN(ph)) { pg8::Gemm g{hid, Md, NSLOT, D, DFFE, 0}; MoeOrder S; S.init(MCNT, MLIST, D / 256, G, bid); pg8::EpiMoeDown E{YP0, YP1, MLIST, MLISTW, D, 0};
                pg8::gemm_phase<pg8::EpiMoeDown, MoeOrder, true, false>(lds, g, S, E); }
            SEAM(ph);
        }
    }
    { constexpr int l = 1;
        if (RUN(ph)) { pg8::Gemm g{xb, Win + (size_t)l * NPROJ * D, T, NPROJ, D, 0}; pg8::StaticOrder S; S.init(T, NPROJ, G, bid); pg8::EpiScaleBf16 E{proj, l == 0 ? rstd : SSQB, NPROJ, l};
            pg8::gemm_phase<pg8::EpiScaleBf16, pg8::StaticOrder, true, false>(lds, g, S, E);
            { PHL for (int rb = bid_; rb < T / 64; rb += G) ba_tail(xb, WBAB + (size_t)l * 16 * D, l == 0 ? rstd : SSQB, l, ba, rb, gw_ & 7, lane_); } }
        SEAM(ph);
        if (RUN(ph)) { PHL
            LAS float* cwl = (LAS float*)(lds + LDSCTL_OFF + 4096); LAS float* lwl = cwl + 4 * 384;
            { const int hb = bid_ & 7; const float* cq = conv_qkv_w + (size_t)l * 4 * 3 * DDN; const float* cl = conv_lru_w + (size_t)l * 4 * DLRU; const float* cbp = conv_lru_b + l * DLRU;
              for (int i = tid_; i < 4 * 384; i += 512) { const int k = i / 384, pp = (i % 384) >> 7, d = i & 127; cwl[i] = cq[k * 3 * DDN + pp * DDN + hb * HD + d]; }
              for (int i = tid_; i < 640; i += 512) { const int k = i >> 7, d = i & 127; lwl[i] = k < 4 ? cl[k * DLRU + hb * 128 + d] : cbp[hb * 128 + d]; }
              __syncthreads(); }
            { const LruConst LC = lrua_const(LRU_WRT + (size_t)l * 8 * 128 * 128, LRU_WIT + (size_t)l * 8 * 128 * 128, lru_b_r + l * DLRU, lru_b_i + l * DLRU, lru_lambda + l * DLRU, bid_ & 7, lane_, gw_ & 7);
              for (int u = bid_; u < 2048; u += G) lrua_unit(proj, LC, LRU_H, LRU_A, LRU_SUMM, u, lds, lwl, tid_, lane_, gw_ & 7); }
            STAMP();
            for (int uid = bid_; uid < 2048; uid += G) dna_unit(proj, conv_qkv_w + (size_t)l * 4 * 3 * DDN, ba, dn_a_log + l * NH, dn_dt_bias + l * NH, DN_WF, DN_QF, DN_KDTF, DN_QKF, DN_UF, DN_GL, uid, lds, cwl, tid_, lane_, gw_ & 7); }
        SEAM(ph);
        if (RUN(ph)) { PHL
            if (bid_ < 128) dnb_run(DN_WF, DN_QF, DN_KDTF, DN_QKF, DN_UF, DN_GL, c3, (bid_ & 7) + 8 * (bid_ >> 6), (bid_ >> 3) & 7, lds, tid_, lane_, gw_ & 7);
            else { if (bid_ < 136 && tid_ < 256) lru_carry(LRU_SUMM, LRU_CARRY, (bid_ - 128) * 256 + tid_);
                const int cw = gw_ - 128 * 8, CNW = NGW - 128 * 8;
                if (l == 0) {
                    convert_matrix(w_in + (size_t)D * DIN, DIN, 0, D, NPROJ, norm_mix + D, Win + (size_t)NPROJ * D, BIG, 0, 0, scr, cw, CNW, lane_);
                    convert_matrix(w_out + (size_t)D * D, D, 0, D, D, nullptr, Wout + (size_t)D * D, BIG, 0, 0, scr, cw, CNW, lane_);
                    convert_matrix(ffn_w_gate, DFF, 0, D, DFF, norm_ffn, Wgu, 128, 256, 0, scr, cw, CNW, lane_);
                    convert_matrix(ffn_w_up, DFF, 0, D, DFF, norm_ffn, Wgu, 128, 256, 128, scr, cw, CNW, lane_);
                    convert_matrix(ffn_w_down, D, 0, DFF, D, nullptr, Wd, BIG, 0, 0, scr, cw, CNW, lane_);
                } else {
                    for (int e = 0; e < NEXP; ++e) convert_matrix(moe_w_down + (size_t)e * DFFE * D, D, 0, DFFE, D, nullptr, Md + (size_t)e * D * DFFE, BIG, 0, 0, scr, cw, CNW, lane_);
                } } }
        SEAM(ph);
        if (RUN(ph)) { PHL
            for (int r = gw_; r < T; r += NGW) lrub_row(LRU_H, LRU_A, LRU_CARRY, proj, lru_out_norm + l * DLRU, ymix, r, lane_);
            for (int r = gw_; r < T; r += NGW) dn_out_row(c3, dn_out_norm + l * HD, proj, ymix, r, lane_); }
        SEAM(ph);
        if (RUN(ph)) { if (l == 0) { pg8::Gemm g{ymix, Wout, T, D, D, 0}; pg8::StaticOrder S; S.init(T, D, G, bid); pg8::EpiResidualNorm E{xcur, xres, xb, SSQA, D, 0};
            pg8::gemm_phase<pg8::EpiResidualNorm, pg8::StaticOrder, true, false>(lds, g, S, E); }
          else { pg8::Gemm g{ymix, Wout + (size_t)D * D, T, D, D, 0}; pg8::StaticOrder S; S.init(T, D, G, bid); pg8::EpiResidual E{xcur, xres, nullptr, D, 0};
            pg8::gemm_phase<pg8::EpiResidual, pg8::StaticOrder, true, false>(lds, g, S, E); }
            if (l == 1) { PHL
                for (int e = 0; e < NEXP; ++e) {
                    convert_matrix(moe_w_gate + (size_t)e * D * DFFE, DFFE, 0, D, DFFE, norm_ffn + D, Mgu + (size_t)e * 2 * DFFE * D, 128, 256, 0, scr, gw_, NGW, lane_);
                    convert_matrix(moe_w_up + (size_t)e * D * DFFE, DFFE, 0, D, DFFE, norm_ffn + D, Mgu + (size_t)e * 2 * DFFE * D, 128, 256, 128, scr, gw_, NGW, lane_);
 } } }
        SEAM(ph);
        xsel = 1;
        if (l == 0) {
            if (RUN(ph)) { pg8::Gemm g{xb, Wgu, T, 2 * DFF, D, 0}; pg8::StaticOrder S; S.init(T, 2 * DFF, G, bid); pg8::EpiSwiGLU E{hid, SSQA, DFF, 1};
                pg8::gemm_phase<pg8::EpiSwiGLU, pg8::StaticOrder, true, false>(lds, g, S, E); }
            SEAM(ph);
            if (RUN(ph)) { pg8::Gemm g{hid, Wd, T, D, DFF, 0}; pg8::StaticOrder S; S.init(T, D, G, bid); pg8::EpiResidualNorm E{xcur, xres, xb, SSQB, D, 0};
                pg8::gemm_phase<pg8::EpiResidualNorm, pg8::StaticOrder, true, false>(lds, g, S, E); }
            SEAM(ph);
        } else {
            if (RUN(ph)) { PHL for (int blk = bid_; blk < T / 64; blk += G) route_block(xcur, norm_ffn + D, moe_router, xb, rstd, MCNT, MLIST, MLISTW, blk, lds, tid_, lane_, gw_ & 7); }
            SEAM(ph);
            if (RUN(ph)) { pg8::Gemm g{xb, Mgu, NSLOT, 2 * DFFE, D, 0}; MoeOrder S; S.init(MCNT, MLIST, 2 * DFFE / 256, G, bid); pg8::EpiSwiGLUMoe E{hid, rstd, MLIST, DFFE, 0};
                pg8::gemm_phase<pg8::EpiSwiGLUMoe, MoeOrder, true, true>(lds, g, S, E); }
            SEAM(ph);
            if (RUN(ph)) { pg8::Gemm g{hid, Md, NSLOT, D, DFFE, 0}; MoeOrder S; S.init(MCNT, MLIST, D / 256, G, bid); pg8::EpiMoeDown E{YP0, YP1, MLIST, MLISTW, D, 0};
                pg8::gemm_phase<pg8::EpiMoeDown, MoeOrder, true, false>(lds, g, S, E); }
            SEAM(ph);
        }
    }
    if (RUN(ph)) { PHL for (int r = gw_; r < T; r += NGW) final_row_moe(xcur, YP0, YP1, norm_final, xres, r, lane_); }
#if defined(PROBE_MASK)
    __syncthreads(); STAMP();
    if (blockIdx.x == 0 && threadIdx.x == 0) { asm volatile("s_waitcnt vmcnt(0)" ::: "memory"); volatile LAS unsigned long long* st = (volatile LAS unsigned long long*)(lds + LDSCTL_OFF + 1024); unsigned long long tot = 0;
        for (int k = 1; k < nst; ++k) if ((PROBE_MASK >> (k - 1)) & 1ull) tot += st[k] - st[k - 1];
        xres[0] = rintf((float)tot * 0.01f * PROBE_SCALE); }
#endif
#if defined(PROBE_DNA_A)
    __syncthreads();
    if (blockIdx.x == 0 && threadIdx.x == 0) { asm volatile("s_waitcnt vmcnt(0)" ::: "memory"); volatile LAS unsigned long long* st = (volatile LAS unsigned long long*)(lds + (RING_BYTES + 2048));
        xres[0] = rintf((float)(st[PROBE_DNA_B] - st[PROBE_DNA_A]) * 0.01f * PROBE_SCALE); }
#endif
#undef RUN
#undef SEAM
}

extern "C" void kernel_launch(void* const* d_in, const int* in_sizes, int n_in, void* d_out, int out_size, void* d_ws, size_t ws_size, hipStream_t stream) {
    static int grid = 0;
    if (grid == 0) {
        if (n_in != 25 || ws_size < WS_END) { fprintf(stderr, "kernel_launch: unexpected n_in %d / ws_size %zu (need %zu)\n", n_in, ws_size, (size_t)WS_END); grid = -1; return; }
        int dev = 0, cus = 0, per_cu = 0;
        if (hipGetDevice(&dev) != hipSuccess || hipDeviceGetAttribute(&cus, hipDeviceAttributeMultiprocessorCount, dev) != hipSuccess) { grid = -1; return; }
        if (hipFuncSetAttribute((const void*)mega, hipFuncAttributeMaxDynamicSharedMemorySize, LDS_BYTES) != hipSuccess) { fprintf(stderr, "kernel_launch: hipFuncSetAttribute failed\n"); grid = -1; return; }
        if (hipOccupancyMaxActiveBlocksPerMultiprocessor(&per_cu, (const void*)mega, 512, LDS_BYTES) != hipSuccess || per_cu < 1) { fprintf(stderr, "kernel_launch: occupancy query says %d\n", per_cu); }
        (void)hipGetLastError();
        grid = cus;
    }
    if (grid < 0) return;
    if (hipMemsetAsync((char*)d_ws + WS_CTL, 0, CTL_ZERO_BYTES, stream) != hipSuccess) return;
    Args a{};
    for (int i = 0; i < 25; ++i) a.in[i] = (const float*)d_in[i];
    a.out = (float*)d_out; a.ws = (unsigned char*)d_ws; a.ph_lo = 0; a.ph_hi = 1 << 30;
    hipLaunchKernelGGL(mega, dim3(grid), dim3(512), LDS_BYTES, stream, a);
}
```

```cpp
#include <hip/hip_runtime.h>
#include <cstdio>
#include <cstdint>
namespace pg8 {
#define PG8_LAS __attribute__((address_space(3)))
typedef unsigned short bf16_t;
typedef short bf16x8 __attribute__((ext_vector_type(8)));
typedef float f32x4 __attribute__((ext_vector_type(4)));
typedef unsigned u32x4 __attribute__((ext_vector_type(4)));
constexpr int BM = 256, BK = 64, HALF = 128, HTB = HALF * BK * 2  , STAGE_BYTES = 8 * HTB, NXCD = 8, WGM = 8;

__host__ __device__ __forceinline__ int lds_byte(int r, int c) { const int st = (r >> 4) * 2 + (c >> 5), rr = r & 15, cc = c & 31, ob = rr * 64 + cc * 2; return st * 1024 + (ob ^ (((ob >> 9) & 1) << 5)); }
__host__ __device__ __forceinline__ void stage_rc(int b, int& R, int& C) { const int st = b / 1024, sb = b % 1024, swz = sb ^ (((sb >> 9) & 1) << 5); R = (st >> 1) * 16 + swz / 64; C = (st & 1) * 32 + (swz % 64) / 2; }
__host__ __device__ __forceinline__ int perm32(int rho) { const int n = rho >> 4, i = rho & 15; return 8 * (i >> 2) + 4 * n + (i & 3); }

struct Unit { int pm, pn, pb, lbase, nvalid; };
struct Gemm { const bf16_t* A; const bf16_t* Bt; int M, N, K, pad; };

struct StaticOrder {
    int nM, nN, nwg, G, c;
    __host__ __device__ void init(int M, int N, int G_, int c_) { nM = M / BM; nN = N / BM; nwg = nM * nN; G = G_; c = c_; }
    __host__ __device__ bool next(int i, Unit& u) const {
        const long L = (long)i * G + c; if (L >= nwg) return false;
        int wgid = (int)L; { const int q = nwg / NXCD, r = nwg % NXCD, xcd = wgid % NXCD, off = wgid / NXCD; wgid = (xcd < r ? xcd * (q + 1) : r * (q + 1) + (xcd - r) * q) + off; }
        const int nig = WGM * nN, gid = wgid / nig, fm = gid * WGM, gsz = (nM - fm) < WGM ? (nM - fm) : WGM;
        u.pm = fm + ((wgid % nig) % gsz); u.pn = (wgid % nig) / gsz; u.pb = u.pn; u.lbase = 0; u.nvalid = BM; return true;
    }
    __device__ __forceinline__ int arow(const Unit&, int) const { return 0; }
    __device__ __forceinline__ void a_ready(const Unit&) const {}
    __device__ __forceinline__ void done(const Unit&) const {}
};


typedef float f32x2_t __attribute__((ext_vector_type(2)));
typedef __bf16 bf16x2_t __attribute__((ext_vector_type(2)));
__device__ __forceinline__ unsigned cvt_pk_bf16(float lo, float hi) { const f32x2_t v = {lo, hi}; const bf16x2_t b = __builtin_convertvector(v, bf16x2_t); return __builtin_bit_cast(unsigned, b); }
__device__ __forceinline__ float frcp(float x) { return __builtin_amdgcn_rcpf(x); }
__device__ __forceinline__ float rsqrt_f(float x) { return __builtin_amdgcn_rsqf(x); }
__device__ __forceinline__ float silu_f(float x) { return x * frcp(1.0f + __expf(-x)); }
__device__ __forceinline__ float swiglu_f(float g, float u, float k1, float s2) { return (g * u) * (s2 * frcp(1.0f + __builtin_amdgcn_exp2f(g * k1))); }
__device__ __forceinline__ float row_scale(const float* rs, int r, int mode) {
    if (!mode) return rs[r];
    const f32x4* p = (const f32x4*)(rs + (size_t)r * 32); float s = 0.f;
#pragma unroll
    for (int i = 0; i < 8; ++i) { const f32x4 v = p[i]; s += (v[0] + v[1]) + (v[2] + v[3]); }
    return rsqrt_f(s * (1.0f / 2048.0f) + 1e-6f);
}
__device__ __forceinline__ void row_scales8(const float* rs, int row0, int fr, int fq, int mode, float (&sc)[2][4]) {
    if (!mode) {
#pragma unroll
        for (int ai = 0; ai < 2; ++ai)
#pragma unroll
            for (int m = 0; m < 4; ++m) sc[ai][m] = rs[row0 + ai * HALF + m * 16];
    } else {
        const int lane = fr + 16 * fq; f32x4 pa[2][4][2];
#pragma unroll
        for (int ai = 0; ai < 2; ++ai)
#pragma unroll
            for (int m = 0; m < 4; ++m) { const f32x4* p = (const f32x4*)(rs + (size_t)(row0 + ai * HALF + m * 16) * 32 + fq * 8); pa[ai][m][0] = p[0]; pa[ai][m][1] = p[1]; }
#pragma unroll
        for (int ai = 0; ai < 2; ++ai)
#pragma unroll
            for (int m = 0; m < 4; ++m) { const f32x4 a = pa[ai][m][0], b = pa[ai][m][1]; float t = ((a[0] + a[1]) + (a[2] + a[3])) + ((b[0] + b[1]) + (b[2] + b[3]));
                t += __int_as_float(__builtin_amdgcn_ds_bpermute((lane ^ 16) << 2, __float_as_int(t)));
                t += __int_as_float(__builtin_amdgcn_ds_bpermute((lane ^ 32) << 2, __float_as_int(t)));
                sc[ai][m] = rsqrt_f(t * (1.0f / 2048.0f) + 1e-6f); }
    }
}
struct EpiScaleBf16 {
    static constexpr bool PERM = true, AFTER_DRAIN = false;
    bf16_t* O; const float* rs; int ldc; int pad;
    __device__ __forceinline__ void operator()(const f32x4 (&acc)[2][2][4][2], const Unit& u, int wr, int wc, int fr, int fq) const {
        const int row0 = u.pm * BM + wr * 64 + fr, col0 = u.pn * BM + wc * 32 + 8 * fq;
        float sc[2][4]; row_scales8(rs, row0, fr, fq, pad, sc);
#pragma unroll
        for (int ai = 0; ai < 2; ++ai)
#pragma unroll
            for (int m = 0; m < 4; ++m) { const int r = row0 + ai * HALF + m * 16; const float s = sc[ai][m]; bf16_t* rowp = O + (size_t)r * ldc + col0;
#pragma unroll
                for (int bj = 0; bj < 2; ++bj) { const f32x4 v0 = acc[ai][bj][m][0] * s, v1 = acc[ai][bj][m][1] * s;
                    u32x4 w; w.x = cvt_pk_bf16(v0[0], v0[1]); w.y = cvt_pk_bf16(v0[2], v0[3]); w.z = cvt_pk_bf16(v1[0], v1[1]); w.w = cvt_pk_bf16(v1[2], v1[3]);
                    *(u32x4*)(rowp + bj * HALF) = w; } }
    }
};
struct EpiSwiGLU {
    static constexpr bool PERM = true, AFTER_DRAIN = false;
    bf16_t* O; const float* rs; int ldc; int pad;
    __device__ __forceinline__ void operator()(const f32x4 (&acc)[2][2][4][2], const Unit& u, int wr, int wc, int fr, int fq) const {
        const int row0 = u.pm * BM + wr * 64 + fr, col0 = u.pn * HALF + wc * 32 + 8 * fq;
        float sc[2][4]; row_scales8(rs, row0, fr, fq, pad, sc);
#pragma unroll
        for (int ai = 0; ai < 2; ++ai)
#pragma unroll
            for (int m = 0; m < 4; ++m) { const int r = row0 + ai * HALF + m * 16; const float s = sc[ai][m], k1 = s * -1.4426950408889634f, s2 = s * s; bf16_t* rowp = O + (size_t)r * ldc + col0;
                f32x4 h0, h1;
#pragma unroll
                for (int j = 0; j < 4; ++j) { h0[j] = swiglu_f(acc[ai][0][m][0][j], acc[ai][1][m][0][j], k1, s2); h1[j] = swiglu_f(acc[ai][0][m][1][j], acc[ai][1][m][1][j], k1, s2); }
                u32x4 w; w.x = cvt_pk_bf16(h0[0], h0[1]); w.y = cvt_pk_bf16(h0[2], h0[3]); w.z = cvt_pk_bf16(h1[0], h1[1]); w.w = cvt_pk_bf16(h1[2], h1[3]);
                *(u32x4*)rowp = w; }
    }
};
struct EpiResidual {
    static constexpr bool PERM = false, AFTER_DRAIN = false;
    const float* base; float* out; const float* roww; int ldc; int pad;
    __device__ __forceinline__ void operator()(const f32x4 (&acc)[2][2][4][2], const Unit& u, int wr, int wc, int fr, int fq) const {
        const int row0 = u.pm * BM + wr * 64 + fr, col0 = u.pn * BM + wc * 32 + 4 * fq;
#pragma unroll
        for (int ai = 0; ai < 2; ++ai)
#pragma unroll
            for (int m = 0; m < 4; ++m) { const int r = row0 + ai * HALF + m * 16; const float w = roww ? roww[r] : 1.0f; const size_t off = (size_t)r * ldc + col0;
#pragma unroll
                for (int bj = 0; bj < 2; ++bj)
#pragma unroll
                    for (int n = 0; n < 2; ++n) { const f32x4 bs = *(const f32x4*)(base + off + bj * HALF + n * 16); *(f32x4*)(out + off + bj * HALF + n * 16) = bs + acc[ai][bj][m][n] * w; } }
    }
};

struct EpiSwiGLUMoe {
    static constexpr bool PERM = true, AFTER_DRAIN = false;
    bf16_t* O; const float* rs; const int* list; int ldc; int pad;
    __device__ __forceinline__ void operator()(const f32x4 (&acc)[2][2][4][2], const Unit& u, int wr, int wc, int fr, int fq) const {
        const int rl0 = wr * 64 + fr, col0 = u.pn * HALF + wc * 32 + 8 * fq;
#pragma unroll
        for (int ai = 0; ai < 2; ++ai)
#pragma unroll
            for (int m = 0; m < 4; ++m) { const int rl = rl0 + ai * HALF + m * 16; const int tok = rl < u.nvalid ? (list[u.lbase + rl] & 0xffff) : 0; const float s = rs[tok], k1 = s * -1.4426950408889634f, s2 = s * s;
                bf16_t* rowp = O + (size_t)(u.pm * BM + rl) * ldc + col0;
                f32x4 h0, h1;
#pragma unroll
                for (int j = 0; j < 4; ++j) { h0[j] = swiglu_f(acc[ai][0][m][0][j], acc[ai][1][m][0][j], k1, s2); h1[j] = swiglu_f(acc[ai][0][m][1][j], acc[ai][1][m][1][j], k1, s2); }
                u32x4 w; w.x = cvt_pk_bf16(h0[0], h0[1]); w.y = cvt_pk_bf16(h0[2], h0[3]); w.z = cvt_pk_bf16(h1[0], h1[1]); w.w = cvt_pk_bf16(h1[2], h1[3]);
                *(u32x4*)rowp = w; }
    }
};
struct EpiMoeDown {
    static constexpr bool PERM = true, AFTER_DRAIN = false;
    bf16_t* Y0; bf16_t* Y1; const int* list; const float* lw; int ldc; int pad;
    __device__ __forceinline__ void operator()(const f32x4 (&acc)[2][2][4][2], const Unit& u, int wr, int wc, int fr, int fq) const {
        const int rl0 = wr * 64 + fr, col0 = u.pn * BM + wc * 32 + 8 * fq;
#pragma unroll
        for (int ai = 0; ai < 2; ++ai)
#pragma unroll
            for (int m = 0; m < 4; ++m) { const int rl = rl0 + ai * HALF + m * 16;
                if (rl < u.nvalid) { const int en = list[u.lbase + rl]; const float w = lw[u.lbase + rl]; bf16_t* rowp = ((en >> 16) ? Y1 : Y0) + (size_t)(en & 0xffff) * ldc + col0;
#pragma unroll
                    for (int bj = 0; bj < 2; ++bj) { const f32x4 v0 = acc[ai][bj][m][0] * w, v1 = acc[ai][bj][m][1] * w;
                        u32x4 o; o.x = cvt_pk_bf16(v0[0], v0[1]); o.y = cvt_pk_bf16(v0[2], v0[3]); o.z = cvt_pk_bf16(v1[0], v1[1]); o.w = cvt_pk_bf16(v1[2], v1[3]);
                        *(u32x4*)(rowp + bj * HALF) = o; } } }
    }
};

struct EpiResidualNorm {
    static constexpr bool PERM = true, AFTER_DRAIN = false;
    const float* base; float* out; bf16_t* xb; float* ssq; int ldc; int pad;
    __device__ __forceinline__ void operator()(const f32x4 (&acc)[2][2][4][2], const Unit& u, int wr, int wc, int fr, int fq) const {
        const int row0 = u.pm * BM + wr * 64 + fr, col0 = u.pn * BM + wc * 32 + 8 * fq, lane = fr + 16 * fq;
#pragma unroll
        for (int ai = 0; ai < 2; ++ai)
#pragma unroll
            for (int m = 0; m < 4; ++m) { const int r = row0 + ai * HALF + m * 16; const size_t off = (size_t)r * ldc + col0; float part = 0.f;
#pragma unroll
                for (int bj = 0; bj < 2; ++bj) { const f32x4 b0 = *(const f32x4*)(base + off + bj * HALF), b1 = *(const f32x4*)(base + off + bj * HALF + 4);
                    const f32x4 v0 = b0 + acc[ai][bj][m][0], v1 = b1 + acc[ai][bj][m][1];
                    *(f32x4*)(out + off + bj * HALF) = v0; *(f32x4*)(out + off + bj * HALF + 4) = v1;
                    u32x4 w; w.x = cvt_pk_bf16(v0[0], v0[1]); w.y = cvt_pk_bf16(v0[2], v0[3]); w.z = cvt_pk_bf16(v1[0], v1[1]); w.w = cvt_pk_bf16(v1[2], v1[3]);
                    *(u32x4*)(xb + off + bj * HALF) = w;
                    part += (v0[0] * v0[0] + v0[1] * v0[1]) + (v0[2] * v0[2] + v0[3] * v0[3]) + (v1[0] * v1[0] + v1[1] * v1[1]) + (v1[2] * v1[2] + v1[3] * v1[3]); }
                part += __int_as_float(__builtin_amdgcn_ds_bpermute((lane ^ 16) << 2, __float_as_int(part)));
                part += __int_as_float(__builtin_amdgcn_ds_bpermute((lane ^ 32) << 2, __float_as_int(part)));
                if (fq == 0) ssq[(size_t)r * 32 + u.pn * 4 + wc] = part; }
    }
};
template <class Epi, class Sched, bool ALIGN_EPI = false, bool GATHER = false>
__device__ __forceinline__ void gemm_phase(PG8_LAS unsigned char* lds, const Gemm g, const Sched& S, const Epi& E) {
    int tid_o = threadIdx.x; asm volatile("" : "+v"(tid_o));
    const int tid = tid_o, wid = __builtin_amdgcn_readfirstlane(tid >> 6), lane = tid & 63, wr = wid >> 2, wc = wid & 3, fr = lane & 15, fq = lane >> 4;
    const int K = g.K, nt = K / BK;
    const size_t kstep = (size_t)(BK * 2);
    const size_t hstep = (size_t)HALF * K * 2;
    const size_t tstep = 2 * hstep;
    unsigned voffA[2], voffB[2], oA[2][2], oN[2][2];
#pragma unroll
    for (int i = 0; i < 2; ++i) { int R, C; stage_rc(tid * 16 + i * 8192, R, C); const int Rb = Epi::PERM ? ((R & ~31) + perm32(R & 31)) : R; voffA[i] = (unsigned)(R * K + C) * 2u; voffB[i] = (unsigned)(Rb * K + C) * 2u; }
    const unsigned ldsw = (unsigned)wid * 1024u;
    const int aoff = lds_byte(wr * 64 + fr, fq * 8), boff = lds_byte(wc * 32 + fr, fq * 8);
#define PG8_SA(b, h) (((b) * 2 + (h)) * HTB)
#define PG8_SB(b, h) ((4 + (b) * 2 + (h)) * HTB)
#define PG8_STAGE(bufoff, gbase, voff) do { _Pragma("unroll") for (int _i = 0; _i < 2; ++_i) \
        __builtin_amdgcn_global_load_lds((const unsigned*)((const char*)(gbase) + (voff)[_i]), (PG8_LAS unsigned*)(lds + (bufoff) + ldsw + _i * 8192), 16, 0, 0); } while (0)
#define PG8_LDA(dst, b, h) do { _Pragma("unroll") for (int m = 0; m < 4; ++m) _Pragma("unroll") for (int k = 0; k < 2; ++k) dst[m][k] = *(const PG8_LAS bf16x8*)(lds + PG8_SA(b, h) + aoff + m * 2048 + k * 1024); } while (0)
#define PG8_LDB(dst, b, h) do { _Pragma("unroll") for (int n = 0; n < 2; ++n) _Pragma("unroll") for (int k = 0; k < 2; ++k) dst[n][k] = *(const PG8_LAS bf16x8*)(lds + PG8_SB(b, h) + boff + n * 2048 + k * 1024); } while (0)
#define PG8_MMA(ai, bj, At, Bt) do { __builtin_amdgcn_s_setprio(1); _Pragma("unroll") for (int m = 0; m < 4; ++m) _Pragma("unroll") for (int n = 0; n < 2; ++n) _Pragma("unroll") for (int k = 0; k < 2; ++k) \
        acc[ai][bj][m][n] = __builtin_amdgcn_mfma_f32_16x16x32_bf16(Bt[n][k], At[m][k], acc[ai][bj][m][n], 0, 0, 0); __builtin_amdgcn_s_setprio(0); } while (0)
#define PG8_WAIT_V(n) asm volatile("s_waitcnt vmcnt(" #n ")" ::: "memory")
#define PG8_WAIT_L(n) asm volatile("s_waitcnt lgkmcnt(" #n ")" ::: "memory")
#define PG8_BAR __builtin_amdgcn_s_barrier()
#define PG8_SCHED __builtin_amdgcn_sched_barrier(0)
#define PG8_AOFF(dst, u) do { _Pragma("unroll") for (int _i = 0; _i < 2; ++_i) { int _R, _C; stage_rc(tid * 16 + _i * 8192, _R, _C); _Pragma("unroll") for (int _h = 0; _h < 2; ++_h) \
        dst[_h][_i] = (unsigned)(S.arow(u, _h * HALF + _R) * K + _C) * 2u; } } while (0)
#define PG8_STAGE_A(bufoff, gbase, h, usenext) do { _Pragma("unroll") for (int _i = 0; _i < 2; ++_i) { const unsigned _o = GATHER ? ((usenext) ? oN[h][_i] : oA[h][_i]) : voffA[_i]; \
        __builtin_amdgcn_global_load_lds((const unsigned*)((const char*)(gbase) + (GATHER ? (size_t)0 : (size_t)(h) * hstep) + _o), (PG8_LAS unsigned*)(lds + (bufoff) + ldsw + _i * 8192), 16, 0, 0); } } while (0)
    Unit cur, nxt; int ui = 0;
    if (!S.next(0, cur)) return;
    f32x4 acc[2][2][4][2];
#pragma unroll
    for (int a = 0; a < 2; ++a)
#pragma unroll
        for (int b = 0; b < 2; ++b)
#pragma unroll
            for (int m = 0; m < 4; ++m)
#pragma unroll
                for (int n = 0; n < 2; ++n) acc[a][b][m][n] = (f32x4){0.f, 0.f, 0.f, 0.f};
    bf16x8 At[4][2], B0[2][2], B1[2][2];
    const char* cA = (const char*)g.A + (GATHER ? (size_t)0 : (size_t)cur.pm * tstep); const char* cB = (const char*)g.Bt + (size_t)cur.pb * tstep;
    S.a_ready(cur);
    if constexpr (GATHER) { PG8_AOFF(oA, cur); PG8_WAIT_V(0); }
    PG8_STAGE(PG8_SB(0, 0), cB, voffB); PG8_STAGE(PG8_SB(0, 1), cB + hstep, voffB); PG8_STAGE_A(PG8_SA(0, 0), cA, 0, false); PG8_STAGE_A(PG8_SA(0, 1), cA, 1, false);
    if (wr == 1) PG8_BAR;
    PG8_WAIT_V(2); PG8_BAR;
    PG8_STAGE(PG8_SB(1, 0), cB + kstep, voffB); PG8_STAGE_A(PG8_SA(1, 0), cA + kstep, 0, false); PG8_STAGE(PG8_SB(1, 1), cB + hstep + kstep, voffB);
    PG8_WAIT_V(6); PG8_BAR;
    for (;;) {
        const bool has_next = S.next(ui + 1, nxt);
        const char* nA = has_next ? (const char*)g.A + (GATHER ? (size_t)0 : (size_t)nxt.pm * tstep) : cA; const char* nB = has_next ? (const char*)g.Bt + (size_t)nxt.pb * tstep : cB;
        if constexpr (GATHER) { if (has_next) { PG8_AOFF(oN, nxt); } else {
#pragma unroll
            for (int _h = 0; _h < 2; ++_h) { oN[_h][0] = oA[_h][0]; oN[_h][1] = oA[_h][1]; } } }
        for (int t = 0; t < nt; t += 2) {
            const bool last = (t == nt - 2);
            const char* a1 = cA + (size_t)(t + 1) * kstep;
            const char* a2 = last ? nA : cA + (size_t)(t + 2) * kstep; const char* b2 = last ? nB : cB + (size_t)(t + 2) * kstep;
            const char* a3 = a2 + kstep; const char* b3 = b2 + kstep;
            if (last && has_next) S.a_ready(nxt);
            PG8_LDB(B0, 0, 0); PG8_LDB(B1, 0, 1); PG8_SCHED; PG8_LDA(At, 0, 0); PG8_STAGE_A(PG8_SA(1, 1), a1, 1, false);
            PG8_WAIT_V(8); PG8_WAIT_L(0); PG8_BAR; PG8_MMA(0, 0, At, B0); PG8_MMA(0, 1, At, B1); PG8_BAR; PG8_SCHED;
            PG8_LDA(At, 0, 1); PG8_STAGE(PG8_SB(0, 0), b2, voffB); PG8_STAGE(PG8_SB(0, 1), b2 + hstep, voffB); PG8_STAGE_A(PG8_SA(0, 0), a2, 0, last);
            PG8_WAIT_V(8); PG8_WAIT_L(0); PG8_BAR; PG8_MMA(1, 0, At, B0); PG8_MMA(1, 1, At, B1); PG8_BAR; PG8_SCHED;
            PG8_LDB(B0, 1, 0); PG8_LDB(B1, 1, 1); PG8_SCHED; PG8_LDA(At, 1, 0); PG8_STAGE_A(PG8_SA(0, 1), a2, 1, last);
            PG8_WAIT_V(8); PG8_WAIT_L(0); PG8_BAR; PG8_MMA(0, 0, At, B0); PG8_MMA(0, 1, At, B1); PG8_BAR; PG8_SCHED;
            PG8_LDA(At, 1, 1); PG8_STAGE(PG8_SB(1, 0), b3, voffB); PG8_STAGE(PG8_SB(1, 1), b3 + hstep, voffB); PG8_STAGE_A(PG8_SA(1, 0), a3, 0, last);
            PG8_WAIT_V(8); PG8_WAIT_L(0); PG8_BAR; PG8_MMA(1, 0, At, B0); PG8_MMA(1, 1, At, B1); PG8_BAR; PG8_SCHED;
        }
        if constexpr (ALIGN_EPI) { if (wr == 0) PG8_BAR; }
        E(acc, cur, wr, wc, fr, fq); S.done(cur);
        if (!has_next) break;
#pragma unroll
        for (int a = 0; a < 2; ++a)
#pragma unroll
            for (int b = 0; b < 2; ++b)
#pragma unroll
                for (int m = 0; m < 4; ++m)
#pragma unroll
                    for (int n = 0; n < 2; ++n) acc[a][b][m][n] = (f32x4){0.f, 0.f, 0.f, 0.f};
        cur = nxt; cA = nA; cB = nB; ++ui;
        if constexpr (GATHER) {
#pragma unroll
            for (int _h = 0; _h < 2; ++_h) { oA[_h][0] = oN[_h][0]; oA[_h][1] = oN[_h][1]; } }
        if constexpr (ALIGN_EPI) { if (wr == 1) PG8_BAR; }
    }
    PG8_WAIT_V(0);
    if constexpr (!ALIGN_EPI) { if (wr == 0) PG8_BAR; }
    PG8_BAR;
#undef PG8_SA
#undef PG8_SB
#undef PG8_STAGE
#undef PG8_LDA
#undef PG8_LDB
#undef PG8_MMA
#undef PG8_WAIT_V
#undef PG8_WAIT_L
#undef PG8_BAR
#undef PG8_SCHED
#undef PG8_AOFF
#undef PG8_STAGE_A
}
}

#define GAS __attribute__((address_space(1)))
#define LAS __attribute__((address_space(3)))
#define XB_TMO      128
#define XB_XCNT(j)  (256  + 64 * (j))
#define XB_XSUB(j)  (1280 + 64 * (j))
#define XB_XGEN(j)  (2304 + 64 * (j))
#define XB_TOP      3328
#define XB_TOPGEN   3392
#define XCD_BAR_WORDS 3456
#define XB_SPIN_CAP (1u << 23)

__device__ __forceinline__ unsigned xb_ld(unsigned* p)              { return __hip_atomic_load(p, __ATOMIC_RELAXED, __HIP_MEMORY_SCOPE_AGENT); }
__device__ __forceinline__ unsigned xb_add(unsigned* p, unsigned v) { return __hip_atomic_fetch_add(p, v, __ATOMIC_RELAXED, __HIP_MEMORY_SCOPE_AGENT); }
__device__ __forceinline__ unsigned xb_xcc_id() { return (unsigned)__builtin_amdgcn_s_getreg((3 << 11) | 20) & 0xFu; }
#define XB_SPIN(cond, bar) do { unsigned _sp = 0; while (cond) { __builtin_amdgcn_s_sleep(1); \
    if ((++_sp & 255u) == 0u) { if (xb_ld(&(bar)[XB_TMO])) break; if (_sp > XB_SPIN_CAP) { atomicAdd(&(bar)[XB_TMO], 1u); break; } } } } while (0)

struct XcdBarrier {
    unsigned* bar; unsigned x;
    volatile LAS unsigned* st;
};

__device__ __forceinline__ XcdBarrier xcd_barrier_post(unsigned* bar, volatile LAS unsigned* st) {
    XcdBarrier b; b.bar = bar; b.x = xb_xcc_id(); b.st = st;
    if (threadIdx.x == 0) (void)xb_add(&bar[XB_XCNT(b.x)], 1u);
    return b;
}
__device__ __forceinline__ void xcd_barrier_complete(unsigned* bar, unsigned x, unsigned& nloc, unsigned& nx) {
    const unsigned G = gridDim.x * gridDim.y * gridDim.z;
    unsigned sum, cnt, mine, sp = 0u;
    for (;;) {
        sum = 0u; cnt = 0u; mine = 0u;
#pragma unroll
        for (unsigned j = 0; j < 16; ++j) { const unsigned c = xb_ld(&bar[XB_XCNT(j)]); sum += c; cnt += (c > 0u) ? 1u : 0u; mine = (j == x) ? c : mine; }
        if (sum == G) break;
        __builtin_amdgcn_s_sleep(1);
        if ((++sp & 255u) == 0u) { if (xb_ld(&bar[XB_TMO])) break; if (sp > XB_SPIN_CAP) { atomicAdd(&bar[XB_TMO], 1u); break; } }
    }
    nloc = mine > 0u ? mine : 1u; nx = cnt > 0u ? cnt : 1u;
}

__device__ __forceinline__ void xcd_barrier(const XcdBarrier& b) {
    asm volatile("s_waitcnt vmcnt(0)" ::: "memory");
    __syncthreads();
    if (threadIdx.x == 0) {
        unsigned* bar = b.bar; asm volatile("" : "+s"(bar));
        __builtin_amdgcn_s_waitcnt(0);
        unsigned nloc = b.st[0], nx = b.st[1];
        if (nloc == 0u) { xcd_barrier_complete(bar, b.x, nloc, nx); b.st[0] = nloc; b.st[1] = nx; }
        const unsigned old = xb_add(&bar[XB_XSUB(b.x)], 1u);
        const unsigned gen = old / nloc;
        if (old + 1u == (gen + 1u) * nloc) {
            __builtin_amdgcn_fence(__ATOMIC_RELEASE, "agent");
            asm volatile("s_waitcnt vmcnt(0)" ::: "memory");
            const unsigned og = xb_add(&bar[XB_TOP], 1u);
            const unsigned tg = og / nx;
            if (og + 1u == (tg + 1u) * nx) xb_add(&bar[XB_TOPGEN], 1u);
            else XB_SPIN(xb_ld(&bar[XB_TOPGEN]) == tg, bar);
            __builtin_amdgcn_fence(__ATOMIC_ACQUIRE, "agent");
            xb_add(&bar[XB_XGEN(b.x)], 1u);
            asm volatile("s_waitcnt vmcnt(0)" ::: "memory");
        } else {
            XB_SPIN(xb_ld(&bar[XB_XGEN(b.x)]) == gen, bar);
            __builtin_amdgcn_fence(__ATOMIC_ACQUIRE, "agent");
            asm volatile("s_waitcnt vmcnt(0)" ::: "memory");
        }
    }
    __syncthreads();
}

constexpr int T = 16384, SEQ = 8192, D = 2048, DLRU = 1024, DDN = 1024, NH = 8, HD = 128, NPROJ = 6144, DIN = 6160;
constexpr int DFF = 6144, NEXP = 8, DFFE = 3072;
constexpr float EPS = 1e-6f;
typedef unsigned short bf16;
typedef float f32x4 __attribute__((ext_vector_type(4)));
typedef unsigned u32x4 __attribute__((ext_vector_type(4)));
typedef unsigned u32x2 __attribute__((ext_vector_type(2)));
#define LDS_WAIT() asm volatile("s_waitcnt lgkmcnt(0)" ::: "memory")
#define LDS_BARRIER() do { asm volatile("s_waitcnt lgkmcnt(0)" ::: "memory"); __builtin_amdgcn_s_barrier(); asm volatile("" ::: "memory"); } while (0)

__device__ __forceinline__ float bf2f(bf16 b) { return __uint_as_float(((unsigned)b) << 16); }
__device__ __forceinline__ unsigned f2bf(float f) { return pg8::cvt_pk_bf16(f, f) & 0xffffu; }
__device__ __forceinline__ unsigned pk2(float lo, float hi) { return pg8::cvt_pk_bf16(lo, hi); }
__device__ __forceinline__ float shfl_xor_l(float v, int o, int lane) { return __int_as_float(__builtin_amdgcn_ds_bpermute((lane ^ o) << 2, __float_as_int(v))); }
__device__ __forceinline__ float shfl_up_l(float v, int d, int lane) { return __int_as_float(__builtin_amdgcn_ds_bpermute((lane - d) << 2, __float_as_int(v))); }
__device__ __forceinline__ float shfl_idx_l(float v, int src) { return __int_as_float(__builtin_amdgcn_ds_bpermute(src << 2, __float_as_int(v))); }
__device__ __forceinline__ float wave_sum(float v, int lane) {
#pragma unroll
    for (int o = 1; o < 64; o <<= 1) v += shfl_xor_l(v, o, lane);
    return v;
}
using pg8::silu_f;
using pg8::frcp; using pg8::rsqrt_f;
__device__ __forceinline__ float sigmoid_f(float x) { return frcp(1.0f + __expf(-x)); }
__device__ __forceinline__ float softplus_f(float x) { return fmaxf(x, 0.0f) + log1pf(__expf(-fabsf(x))); }
__device__ __forceinline__ float gelu_tanh_f(float x) { const float u = 0.7978845608028654f * (x + 0.044715f * x * x * x); return x * frcp(1.0f + __expf(-2.0f * u)); }

constexpr size_t MiB = 1u << 20;
constexpr size_t al(size_t x) { return (x + MiB - 1) / MiB * MiB; }
constexpr size_t WS_CTL = 0, CTL_ZERO_BYTES = 1 * MiB;
constexpr int CW_BAR = 4096, CW_CNT = 8192;
constexpr size_t WS_WGU = 1 * MiB;
constexpr size_t WS_WD = WS_WGU + al((size_t)2 * DFF * D * 2);
constexpr size_t WS_WIN = WS_WD + al((size_t)D * DFF * 2);
constexpr size_t WS_WBA = WS_WIN + al((size_t)2 * NPROJ * D * 2);
constexpr size_t WS_WOUT = WS_WBA + al((size_t)2 * 16 * D * 4 + 2 * 16 * D * 2);
static_assert(WS_WIN + (size_t)NPROJ * D * 2 - WS_WGU >= (size_t)NEXP * D * DFFE * 2, "MoE down weights overlay");
constexpr size_t WS_XB = WS_WOUT + al((size_t)2 * D * D * 2);
constexpr size_t WS_RSTD = WS_XB + al((size_t)T * D * 2);
constexpr size_t WS_BA = WS_RSTD + 5 * MiB;
constexpr size_t WS_BETA = WS_BA + al((size_t)T * 16 * 4);
constexpr size_t WS_G = WS_BETA + al((size_t)T * 8 * 4);
constexpr size_t WS_ROWW = WS_G + al((size_t)T * 8 * 4);
constexpr int NSLOT = 2 * T + NEXP * 256;
constexpr size_t WS_PROJ = WS_ROWW + al((size_t)2 * 8 * T * 4);
constexpr size_t WS_YMIX = WS_PROJ + al((size_t)NSLOT * DFFE * 2);
constexpr size_t WS_C = WS_YMIX + al((size_t)T * D * 2);
constexpr size_t WS_WRT = WS_C + (size_t)388 * MiB;
constexpr size_t WS_END = WS_WRT + 1 * MiB;
static_assert(WS_END <= (size_t)975 * MiB, "d_ws map exceeds the guaranteed workspace");
static_assert((size_t)NEXP * 2 * DFFE * D * 2 <= (size_t)388 * MiB, "MoE gate/up bf16 weights overlay the mixer scratch");
constexpr int RING_BYTES = 131072, LDSCTL_OFF = RING_BYTES, MISC_OFF = LDSCTL_OFF + 320, LDS_BYTES = 147456;

__device__ __forceinline__ void transpose_item(const float* W, int ldw, int col_off, int K, int nblk, const float* gain, bf16* WT, int blk, int blk_stride, int row_off, int item, int lane) {
    const int kb = item / nblk, nb = item % nblk, k0 = 64 * kb + (lane >> 4) * 16, n0 = 64 * nb + (lane & 15) * 4;
    const float* src = W + (size_t)k0 * ldw + col_off + n0;
    f32x4 v[16];
#pragma unroll
    for (int j = 0; j < 16; ++j) v[j] = __builtin_nontemporal_load((const f32x4*)(src + (size_t)j * ldw));
    if (gain) {
#pragma unroll
        for (int q = 0; q < 4; ++q) { const f32x4 g = *(const f32x4*)(gain + k0 + 4 * q);
#pragma unroll
            for (int c = 0; c < 4; ++c) v[4 * q + c] = v[4 * q + c] * g[c]; }
    }
#pragma unroll
    for (int i = 0; i < 4; ++i) { const int n = n0 + i, drow = (n / blk) * blk_stride + (n % blk) + row_off;
        u32x4 o0, o1;
        o0.x = pk2(v[0][i], v[1][i]); o0.y = pk2(v[2][i], v[3][i]); o0.z = pk2(v[4][i], v[5][i]); o0.w = pk2(v[6][i], v[7][i]);
        o1.x = pk2(v[8][i], v[9][i]); o1.y = pk2(v[10][i], v[11][i]); o1.z = pk2(v[12][i], v[13][i]); o1.w = pk2(v[14][i], v[15][i]);
        u32x4* dst = (u32x4*)(WT + (size_t)drow * K + k0); dst[0] = o0; dst[1] = o1; }
}
__device__ __forceinline__ void convert_matrix(const float* W, int ldw, int col_off, int K, int N, const float* gain, bf16* WT, int blk, int blk_stride, int row_off, LAS float* scr, int gw, int NGW, int lane) {
    const int nblk = N / 64, nitems = (K / 64) * nblk; (void)scr;
    for (int it = gw; it < nitems; it += NGW) transpose_item(W, ldw, col_off, K, nblk, gain, WT, blk, blk_stride, row_off, it, lane);
}
__device__ __forceinline__ void rowprep_row(const float* x, bf16* xb, float* rstd, const float* Wba, float* ba, int row, int lane) {
    const f32x4* xr = (const f32x4*)(x + (size_t)row * D) + lane;
    f32x4 v[8]; float ss = 0.f;
#pragma unroll
    for (int j = 0; j < 8; ++j) { v[j] = xr[64 * j]; ss += (v[j][0] * v[j][0] + v[j][1] * v[j][1]) + (v[j][2] * v[j][2] + v[j][3] * v[j][3]); }
    ss = wave_sum(ss, lane);
    const float rs = rsqrt_f(ss * (1.0f / D) + EPS);
    u32x2* o = (u32x2*)(xb + (size_t)row * D) + lane;
#pragma unroll
    for (int j = 0; j < 8; ++j) { u32x2 w; w.x = pk2(v[j][0], v[j][1]); w.y = pk2(v[j][2], v[j][3]); o[64 * j] = w; }
    if (lane == 0) rstd[row] = rs;
    if (Wba) {
        for (int c = 0; c < 16; ++c) { const f32x4* wr = (const f32x4*)(Wba + (size_t)c * D) + lane; float a = 0.f;
#pragma unroll
            for (int j = 0; j < 8; ++j) { const f32x4 w = wr[64 * j]; a += (v[j][0] * w[0] + v[j][1] * w[1]) + (v[j][2] * w[2] + v[j][3] * w[3]); }
            a = wave_sum(a, lane); if (lane == 0) ba[(size_t)row * 16 + c] = a * rs; }
    }
}
__device__ __forceinline__ void lru_conv_elem(const bf16* proj, const float* cw, const float* cb, float* xc, size_t idx) {
    const int t = (int)(idx / DLRU), ch = (int)(idx % DLRU), s = t % SEQ;
    float a = cb[ch];
#pragma unroll
    for (int k = 0; k < 4; ++k) { const int sp = s - 3 + k; if (sp >= 0) a += cw[k * DLRU + ch] * bf2f(proj[(size_t)(t - 3 + k) * NPROJ + ch]); }
    xc[idx] = a;
}
__device__ __forceinline__ void lru_gate_elem(const float* xc, const float* w_r, const float* b_r, const float* w_i, const float* b_i, const float* lam, float* av, float* bv, size_t idx) {
    const int t = (int)(idx / DLRU), ch = (int)(idx % DLRU), n = ch >> 7, d = ch & 127;
    float ar = b_r[ch], ai = b_i[ch];
    const float* xr = xc + (size_t)t * DLRU + n * 128; const float* wr = w_r + (size_t)n * 128 * 128 + d; const float* wi = w_i + (size_t)n * 128 * 128 + d;
    for (int c = 0; c < 128; ++c) { const float xv = xr[c]; ar += xv * wr[c * 128]; ai += xv * wi[c * 128]; }
    const float r = sigmoid_f(ar), ig = sigmoid_f(ai);
    const float log_a = -8.0f * r * softplus_f(-lam[ch]);
    const float a = expf(log_a), mult = sqrtf(-expm1f(2.0f * log_a));
    av[idx] = a; bv[idx] = mult * (ig * xc[idx]);
}
__device__ __forceinline__ void lru_scan_chan(float* av, const float* bv, const bf16* proj, int idx) {
    const int b = idx / DLRU, ch = idx % DLRU;
    float h = 0.f;
    for (int s0 = 0; s0 < SEQ; s0 += 8) {
        float a8[8], b8[8], g8[8];
#pragma unroll
        for (int j = 0; j < 8; ++j) { const size_t t = (size_t)b * SEQ + s0 + j; a8[j] = av[t * DLRU + ch]; b8[j] = bv[t * DLRU + ch]; g8[j] = bf2f(proj[t * NPROJ + DLRU + ch]); }
#pragma unroll
        for (int j = 0; j < 8; ++j) { const size_t t = (size_t)b * SEQ + s0 + j; h = a8[j] * h + b8[j]; av[t * DLRU + ch] = h * gelu_tanh_f(g8[j]); }
    }
}
__device__ __forceinline__ void lru_norm_row(const float* y, const float* gain, bf16* ymix, int row, int lane) {
    const f32x4* yr = (const f32x4*)(y + (size_t)row * DLRU) + lane; const f32x4* gr = (const f32x4*)gain + lane;
    f32x4 v[4]; float ss = 0.f;
#pragma unroll
    for (int j = 0; j < 4; ++j) { v[j] = yr[64 * j]; ss += (v[j][0] * v[j][0] + v[j][1] * v[j][1]) + (v[j][2] * v[j][2] + v[j][3] * v[j][3]); }
    ss = wave_sum(ss, lane); const float rs = rsqrt_f(ss * (1.0f / DLRU) + EPS);
    u32x2* o = (u32x2*)(ymix + (size_t)row * D) + lane;
#pragma unroll
    for (int j = 0; j < 4; ++j) { const f32x4 g = gr[64 * j]; u32x2 w; w.x = pk2(v[j][0] * rs * g[0], v[j][1] * rs * g[1]); w.y = pk2(v[j][2] * rs * g[2], v[j][3] * rs * g[3]); o[64 * j] = w; }
}
__device__ __forceinline__ void dn_prep_item(const bf16* proj, const float* cw, const float* ba, const float* a_log, const float* dt_bias, float* qn, float* kn, float* vn, float* beta, float* gg, int w, int lane) {
    const int t = w >> 3, h = w & 7, s = t % SEQ;
    float val[3][2];
#pragma unroll
    for (int p = 0; p < 3; ++p)
#pragma unroll
        for (int e = 0; e < 2; ++e) { const int d = lane * 2 + e, c = p * DDN + h * HD + d; float a = 0.f;
#pragma unroll
            for (int k = 0; k < 4; ++k) { const int sp = s - 3 + k; if (sp >= 0) a += cw[k * 3 * DDN + c] * bf2f(proj[(size_t)(t - 3 + k) * NPROJ + 2048 + c]); }
            val[p][e] = silu_f(a); }
    const float sq = wave_sum(val[0][0] * val[0][0] + val[0][1] * val[0][1], lane), sk = wave_sum(val[1][0] * val[1][0] + val[1][1] * val[1][1], lane);
    const float rq = rsqrt_f(sq + EPS) * 0.08838834764831845f, rk = rsqrt_f(sk + EPS);
    const size_t o = ((size_t)t * NH + h) * HD + lane * 2;
    qn[o] = val[0][0] * rq; qn[o + 1] = val[0][1] * rq; kn[o] = val[1][0] * rk; kn[o + 1] = val[1][1] * rk; vn[o] = val[2][0]; vn[o + 1] = val[2][1];
    if (lane == 0) { beta[t * NH + h] = sigmoid_f(ba[(size_t)t * 16 + h]); gg[t * NH + h] = -__expf(a_log[h]) * softplus_f(ba[(size_t)t * 16 + 8 + h] + dt_bias[h]); }
}
__device__ __forceinline__ void dn_rec_seq(const float* qn, const float* kn, const float* vn, const float* beta, const float* gg, float* o, int bh, LAS float* sk, LAS float* sq, LAS float* st, int tid) {
    const int b = bh >> 3, h = bh & 7, j = tid & 127; const bool act = tid < 128;
    if (act) for (int k = 0; k < 128; ++k) st[k * 128 + j] = 0.f;
    const size_t base = ((size_t)(b * SEQ) * NH + h) * HD;
    float nk = kn[base + j], nq = qn[base + j], nv = vn[base + j], nb = beta[(b * SEQ) * NH + h], ng = gg[(b * SEQ) * NH + h];
    for (int s = 0; s < SEQ; ++s) {
        const int buf = (s & 1) * 128;
        if (act) { sk[buf + j] = nk; sq[buf + j] = nq; }
        const float vj = nv, be = nb, ge = __expf(ng);
        __syncthreads();
        if (act) {
            if (s + 1 < SEQ) { const size_t nb_ = ((size_t)(b * SEQ + s + 1) * NH + h) * HD; nk = kn[nb_ + j]; nq = qn[nb_ + j]; nv = vn[nb_ + j]; nb = beta[(b * SEQ + s + 1) * NH + h]; ng = gg[(b * SEQ + s + 1) * NH + h]; }
            float ks = 0.f;
#pragma unroll 8
            for (int k = 0; k < 128; ++k) ks += sk[buf + k] * st[k * 128 + j];
            const float vnew = be * (vj - ge * ks);
            float oo = 0.f;
#pragma unroll 8
            for (int k = 0; k < 128; ++k) { const float sv = ge * st[k * 128 + j] + sk[buf + k] * vnew; st[k * 128 + j] = sv; oo += sq[buf + k] * sv; }
            o[((size_t)(b * SEQ + s) * NH + h) * HD + j] = oo;
        }
    }
    __syncthreads();
}
typedef short bf16x8 __attribute__((ext_vector_type(8)));
__device__ __forceinline__ f32x4 mfma16(bf16x8 a, bf16x8 b, f32x4 c) { return __builtin_amdgcn_mfma_f32_16x16x32_bf16(a, b, c, 0, 0, 0); }
__device__ __forceinline__ float bflo(unsigned x) { return __uint_as_float(x << 16); }
__device__ __forceinline__ float bfhi(unsigned x) { return __uint_as_float(x & 0xffff0000u); }
constexpr int DA_G = 0, DA_L = 1024, DA_KN = DA_L + 16384, DA_QN = DA_KN + 17408, DA_VBT = DA_QN + 17408, DA_KBET = DA_VBT + 18432, DA_KDT = DA_KBET + 18432, DA_TB = DA_KDT + 18432, DA_QK = DA_TB + 9216, DA_END = DA_QK + 9216;
static_assert(DA_END <= RING_BYTES, "DN-A LDS map");
#if defined(PROBE_DNA_A)
#define DNA_ST(k) do { if (threadIdx.x == 0) ((volatile LAS unsigned long long*)(lds + (RING_BYTES + 2048)))[k] = __builtin_amdgcn_s_memrealtime(); } while (0)
#else
#define DNA_ST(k) do { } while (0)
#endif
__device__ __forceinline__ void dna_unit(const bf16* proj, const float* cw, const float* ba, const float* a_log, const float* dt_bias,
                                         bf16* Wf, bf16* Qf, bf16* KdTf, bf16* QKf, bf16* Uf, float* glb, int uid, LAS unsigned char* lds, const LAS float* cwl, int tid, int lane, int wave) {
    const int h = uid & 7, n = (uid >> 3) & 127, b = uid >> 10, t0 = b * SEQ + n * 64;
    asm volatile("" : "+v"(lds));
    DNA_ST(0);
    LAS float* Gs = (LAS float*)(lds + DA_G);
    const int fr = lane & 15, fq = lane >> 4;
    float ba_b = 0.f, ba_a = 0.f;
    if (wave == 0) { const size_t t = (size_t)(t0 + lane); ba_b = ba[t * 16 + h]; ba_a = ba[t * 16 + 8 + h]; }
    DNA_ST(1);
    {
        const int r = tid >> 3, cg = tid & 7;
        float val[3][16];
#pragma unroll
        for (int p = 0; p < 3; ++p) {
            const int ccol = p * DDN + h * HD + cg * 16;
            float acc[16];
#pragma unroll
            for (int i = 0; i < 16; ++i) acc[i] = 0.f;
#pragma unroll
            for (int k = 0; k < 4; ++k) { const int row = r - 3 + k;
                if (n * 64 + row >= 0) {
                    const bf16* src = proj + (size_t)(t0 + row) * NPROJ + 2048 + ccol;
                    const u32x4 x0 = *(const u32x4*)src, x1 = *(const u32x4*)(src + 8);
                    const LAS float* wp = cwl + k * 384 + p * 128 + cg * 16;
                    const f32x4 w0 = *(const LAS f32x4*)wp, w1 = *(const LAS f32x4*)(wp + 4), w2 = *(const LAS f32x4*)(wp + 8), w3 = *(const LAS f32x4*)(wp + 12);
                    acc[0] += w0[0] * bflo(x0.x); acc[1] += w0[1] * bfhi(x0.x); acc[2] += w0[2] * bflo(x0.y); acc[3] += w0[3] * bfhi(x0.y);
                    acc[4] += w1[0] * bflo(x0.z); acc[5] += w1[1] * bfhi(x0.z); acc[6] += w1[2] * bflo(x0.w); acc[7] += w1[3] * bfhi(x0.w);
                    acc[8] += w2[0] * bflo(x1.x); acc[9] += w2[1] * bfhi(x1.x); acc[10] += w2[2] * bflo(x1.y); acc[11] += w2[3] * bfhi(x1.y);
                    acc[12] += w3[0] * bflo(x1.z); acc[13] += w3[1] * bfhi(x1.z); acc[14] += w3[2] * bflo(x1.w); acc[15] += w3[3] * bfhi(x1.w);
                } }
#pragma unroll
            for (int i = 0; i < 16; ++i) val[p][i] = silu_f(acc[i]);
        }
        float sq = 0.f, sk = 0.f;
#pragma unroll
        for (int i = 0; i < 16; ++i) { sq += val[0][i] * val[0][i]; sk += val[1][i] * val[1][i]; }
        sq += shfl_xor_l(sq, 1, lane); sq += shfl_xor_l(sq, 2, lane); sq += shfl_xor_l(sq, 4, lane);
        sk += shfl_xor_l(sk, 1, lane); sk += shfl_xor_l(sk, 2, lane); sk += shfl_xor_l(sk, 4, lane);
        const float rq = rsqrt_f(sq + EPS) * 0.08838834764831845f, rk = rsqrt_f(sk + EPS);
        if (wave == 0) {
            const float be0 = sigmoid_f(ba_b); float Gc = -__expf(a_log[h]) * softplus_f(ba_a + dt_bias[h]);
#pragma unroll
            for (int off = 1; off < 64; off <<= 1) { const float tmp = shfl_up_l(Gc, off, lane); if (lane >= off) Gc += tmp; }
            const float GL = shfl_idx_l(Gc, 63);
            Gs[lane] = Gc; Gs[64 + lane] = be0; Gs[128 + lane] = __expf(Gc); Gs[192 + lane] = __expf(GL - Gc);
            if (lane == 63) glb[uid] = __expf(Gc);
        }
        LDS_BARRIER();
        const float be = Gs[64 + r], eg = Gs[128 + r], egl = Gs[192 + r];
#pragma unroll
        for (int i = 0; i < 16; ++i) { val[0][i] *= rq; val[1][i] *= rk; }
        u32x4 o0, o1;
        o0.x = pk2(val[1][0], val[1][1]); o0.y = pk2(val[1][2], val[1][3]); o0.z = pk2(val[1][4], val[1][5]); o0.w = pk2(val[1][6], val[1][7]);
        o1.x = pk2(val[1][8], val[1][9]); o1.y = pk2(val[1][10], val[1][11]); o1.z = pk2(val[1][12], val[1][13]); o1.w = pk2(val[1][14], val[1][15]);
        *(LAS u32x4*)(lds + DA_KN + r * 272 + cg * 32) = o0; *(LAS u32x4*)(lds + DA_KN + r * 272 + cg * 32 + 16) = o1;
        o0.x = pk2(val[0][0], val[0][1]); o0.y = pk2(val[0][2], val[0][3]); o0.z = pk2(val[0][4], val[0][5]); o0.w = pk2(val[0][6], val[0][7]);
        o1.x = pk2(val[0][8], val[0][9]); o1.y = pk2(val[0][10], val[0][11]); o1.z = pk2(val[0][12], val[0][13]); o1.w = pk2(val[0][14], val[0][15]);
        *(LAS u32x4*)(lds + DA_QN + r * 272 + cg * 32) = o0; *(LAS u32x4*)(lds + DA_QN + r * 272 + cg * 32 + 16) = o1;
#pragma unroll
        for (int i = 0; i < 16; ++i) { const int f = cg * 16 + i;
            *(LAS unsigned short*)(lds + DA_VBT + f * 144 + r * 2) = (unsigned short)f2bf(val[2][i] * be);
            *(LAS unsigned short*)(lds + DA_KBET + f * 144 + r * 2) = (unsigned short)f2bf(val[1][i] * (be * eg));
            *(LAS unsigned short*)(lds + DA_KDT + f * 144 + r * 2) = (unsigned short)f2bf(val[1][i] * egl); }
    }
    LDS_BARRIER();
    DNA_ST(2);
    {
        const int p = wave >> 2, ti = wave & 3;
        const int abase = p == 0 ? DA_KN : DA_QN;
        bf16x8 af[4];
#pragma unroll
        for (int ks = 0; ks < 4; ++ks) af[ks] = *(const LAS bf16x8*)(lds + abase + (ti * 16 + fr) * 272 + (ks * 32 + fq * 8) * 2);
        for (int tj = 0; tj < 4; ++tj) {
            f32x4 acc = {0.f, 0.f, 0.f, 0.f};
            if (tj <= ti) {
#pragma unroll
                for (int ks = 0; ks < 4; ++ks) { const bf16x8 bb = *(const LAS bf16x8*)(lds + DA_KN + (tj * 16 + fr) * 272 + (ks * 32 + fq * 8) * 2); acc = mfma16(af[ks], bb, acc); }
            }
            const int j = tj * 16 + fr; const float Gj = Gs[j];
#pragma unroll
            for (int r = 0; r < 4; ++r) { const int i = ti * 16 + fq * 4 + r; float v = 0.f;
                if (p == 0) { if (i > j) v = Gs[64 + i] * acc[r] * __expf(Gs[i] - Gj); *(LAS float*)(lds + DA_L + (j * 64 + i) * 4) = v; }
                else { if (i >= j) v = acc[r] * __expf(Gs[i] - Gj); *(LAS unsigned short*)(lds + DA_QK + i * 144 + j * 2) = (unsigned short)f2bf(v); } }
        }
    }
    LDS_BARRIER();
    DNA_ST(3);
    {
        int lc = lane; asm volatile("" : "+v"(lc)); const float fl = (float)lc;
        const int blk = wave < 4 ? wave : 11 - wave;
        float Tr[8];
#pragma unroll
        for (int c = 0; c < 8; ++c) Tr[c] = fmaxf(0.f, 1.f - fabsf(fl - (float)(blk * 8 + c)));
        float lj[63];
#pragma unroll
        for (int j = 0; j < 63; ++j) lj[j] = *(const LAS float*)(lds + DA_L + (j * 64) * 4 + lc * 4);
#pragma unroll
        for (int j = 0; j < 63; ++j) {
            if (j >= blk * 8) {
#pragma unroll
                for (int c = 0; c < 8; ++c) { const float tj = __int_as_float(__builtin_amdgcn_readlane(__float_as_int(Tr[c]), j)); Tr[c] -= lj[j] * tj; }
            }
        }
        u32x4 o; o.x = pk2(Tr[0], Tr[1]); o.y = pk2(Tr[2], Tr[3]); o.z = pk2(Tr[4], Tr[5]); o.w = pk2(Tr[6], Tr[7]);
        *(LAS u32x4*)(lds + DA_TB + lc * 144 + blk * 16) = o;
    }
    {
        for (int fi = wave; fi < 40; fi += 8) {
            if (fi < 8) { const int mt = fi >> 1, ks = fi & 1;
                const u32x4 v = *(const LAS u32x4*)(lds + DA_QK + (mt * 16 + fr) * 144 + (ks * 32 + fq * 8) * 2);
                *(u32x4*)(QKf + (((size_t)uid * 4 + mt) * 2 + ks) * 512 + lane * 8) = v; }
            else if (fi < 24) { const int f2 = fi - 8, mt = f2 >> 2, ks = f2 & 3; const float eg = Gs[128 + mt * 16 + fr];
                const u32x4 v = *(const LAS u32x4*)(lds + DA_QN + (mt * 16 + fr) * 272 + (ks * 32 + fq * 8) * 2); u32x4 o;
                o.x = pk2(bflo(v.x) * eg, bfhi(v.x) * eg); o.y = pk2(bflo(v.y) * eg, bfhi(v.y) * eg); o.z = pk2(bflo(v.z) * eg, bfhi(v.z) * eg); o.w = pk2(bflo(v.w) * eg, bfhi(v.w) * eg);
                *(u32x4*)(Qf + (((size_t)uid * 4 + mt) * 4 + ks) * 512 + lane * 8) = o; }
            else { const int f2 = fi - 24, ft = f2 >> 1, ks = f2 & 1;
                const u32x4 v = *(const LAS u32x4*)(lds + DA_KDT + (ft * 16 + fr) * 144 + (ks * 32 + fq * 8) * 2);
                *(u32x4*)(KdTf + (((size_t)uid * 8 + ft) * 2 + ks) * 512 + lane * 8) = v; }
        }
    }
    LDS_BARRIER();
    DNA_ST(4);
    {
        bf16x8 ta[4][2];
#pragma unroll
        for (int mt = 0; mt < 4; ++mt)
#pragma unroll
            for (int ks = 0; ks < 2; ++ks) ta[mt][ks] = *(const LAS bf16x8*)(lds + DA_TB + (mt * 16 + fr) * 144 + (ks * 32 + fq * 8) * 2);
#pragma unroll
        for (int c2 = 0; c2 < 2; ++c2) { const int ct = wave * 2 + c2, img = ct < 8 ? DA_VBT : DA_KBET, cr = (ct & 7) * 16 + fr;
            bf16x8 bb[2];
#pragma unroll
            for (int ks = 0; ks < 2; ++ks) bb[ks] = *(const LAS bf16x8*)(lds + img + cr * 144 + (ks * 32 + fq * 8) * 2);
#pragma unroll
            for (int mt = 0; mt < 4; ++mt) { f32x4 acc = {0.f, 0.f, 0.f, 0.f};
#pragma unroll
                for (int ks = 0; ks < 2; ++ks) acc = mfma16(ta[mt][ks], bb[ks], acc);
                if (ct < 8) { u32x2 o; o.x = pk2(acc[0], acc[1]); o.y = pk2(acc[2], acc[3]); *(u32x2*)(Uf + ((((size_t)uid * 8 + ct) * 4 + mt) * 64 + lane) * 4) = o; }
                else { const int f = (ct - 8) * 16 + fr;
#pragma unroll
                    for (int r = 0; r < 4; ++r) *(LAS unsigned short*)(lds + DA_KN + (mt * 16 + fq * 4 + r) * 272 + f * 2) = (unsigned short)f2bf(acc[r]); } }
        }
    }
    LDS_BARRIER();
    DNA_ST(5);
#pragma unroll
    for (int q2 = 0; q2 < 2; ++q2) { const int fi = wave * 2 + q2, mt = fi >> 2, ks = fi & 3;
        const u32x4 v = *(const LAS u32x4*)(lds + DA_KN + (mt * 16 + fr) * 272 + (ks * 32 + fq * 8) * 2);
        *(u32x4*)(Wf + (((size_t)uid * 4 + mt) * 4 + ks) * 512 + lane * 8) = v; }
    LDS_BARRIER();
    DNA_ST(6);
}
struct DnbFrag { bf16x8 a1[4]; bf16x8 a2[2]; bf16x8 kd[2]; u32x2 u; float gl; };
__device__ __forceinline__ DnbFrag dnb_load(const bf16* A1, const bf16* QKf, const bf16* KdTf, const bf16* Uf, const float* glb, int uid, int ds, int wave, int lane) {
    DnbFrag f; const int mt = wave & 3;
#pragma unroll
    for (int ks = 0; ks < 4; ++ks) f.a1[ks] = *(const bf16x8*)(A1 + (((size_t)uid * 4 + mt) * 4 + ks) * 512 + lane * 8);
#pragma unroll
    for (int ks = 0; ks < 2; ++ks) f.kd[ks] = *(const bf16x8*)(KdTf + (((size_t)uid * 8 + wave) * 2 + ks) * 512 + lane * 8);
#pragma unroll
    for (int ks = 0; ks < 2; ++ks) f.a2[ks] = *(const bf16x8*)(QKf + (((size_t)uid * 4 + mt) * 2 + ks) * 512 + lane * 8);
    f.u = *(const u32x2*)(Uf + ((((size_t)uid * 8 + ds) * 4 + mt) * 64 + lane) * 4);
    f.gl = glb[uid];
    return f;
}
__device__ __forceinline__ void dnb_run(const bf16* Wf, const bf16* Qf, const bf16* KdTf, const bf16* QKf, const bf16* Uf, const float* glb, float* o, int bh, int ds, LAS unsigned char* lds, int tid, int lane, int wave) {
    const int b = bh >> 3, h = bh & 7, fr = lane & 15, fq = lane >> 4, mt = wave & 3;
    asm volatile("" : "+v"(lds));
    LAS unsigned char* ST = lds; LAS unsigned char* VNT = lds + 4608;
    for (int i = tid; i < 4608 / 4; i += 512) ((LAS unsigned*)ST)[i] = 0u;
    f32x4 accS = {0.f, 0.f, 0.f, 0.f};
    const bf16* A1 = wave < 4 ? Wf : Qf;
    DnbFrag f0 = dnb_load(A1, QKf, KdTf, Uf, glb, (b * 128 + 0) * 8 + h, ds, wave, lane), f1 = dnb_load(A1, QKf, KdTf, Uf, glb, (b * 128 + 1) * 8 + h, ds, wave, lane);
    DnbFrag f2 = dnb_load(A1, QKf, KdTf, Uf, glb, (b * 128 + 2) * 8 + h, ds, wave, lane), f3 = dnb_load(A1, QKf, KdTf, Uf, glb, (b * 128 + 3) * 8 + h, ds, wave, lane);
    __syncthreads();
#define DNB_STEP(F, nn) do { const int n = (nn); \
        f32x4 acc = {0.f, 0.f, 0.f, 0.f}; \
        _Pragma("unroll") for (int ks = 0; ks < 4; ++ks) { const bf16x8 sb = *(const LAS bf16x8*)(ST + fr * 272 + (ks * 32 + fq * 8) * 2); acc = mfma16(F.a1[ks], sb, acc); } \
        if (wave < 4) { const float v0 = bflo(F.u.x) - acc[0], v1 = bfhi(F.u.x) - acc[1], v2 = bflo(F.u.y) - acc[2], v3 = bfhi(F.u.y) - acc[3]; \
            u32x2 w; w.x = pk2(v0, v1); w.y = pk2(v2, v3); *(LAS u32x2*)(VNT + fr * 144 + (mt * 16 + fq * 4) * 2) = w; } \
        LDS_BARRIER(); \
        bf16x8 vb[2]; \
        _Pragma("unroll") for (int ks = 0; ks < 2; ++ks) vb[ks] = *(const LAS bf16x8*)(VNT + fr * 144 + (ks * 32 + fq * 8) * 2); \
        accS = accS * F.gl; \
        _Pragma("unroll") for (int ks = 0; ks < 2; ++ks) accS = mfma16(F.kd[ks], vb[ks], accS); \
        { u32x2 w; w.x = pk2(accS[0], accS[1]); w.y = pk2(accS[2], accS[3]); *(LAS u32x2*)(ST + fr * 272 + (wave * 16 + fq * 4) * 2) = w; } \
        if (wave >= 4) { _Pragma("unroll") for (int ks = 0; ks < 2; ++ks) acc = mfma16(F.a2[ks], vb[ks], acc);     \
            const size_t ob = ((size_t)(b * SEQ + n * 64 + mt * 16 + fq * 4) * NH + h) * HD + ds * 16 + fr; \
            _Pragma("unroll") for (int r = 0; r < 4; ++r) o[ob + (size_t)r * NH * HD] = acc[r]; } \
        F = dnb_load(A1, QKf, KdTf, Uf, glb, (b * 128 + (n + 4 < 128 ? n + 4 : 127)) * 8 + h, ds, wave, lane);     \
        LDS_BARRIER(); } while (0)
    for (int n4 = 0; n4 < 128; n4 += 16) {
        DNB_STEP(f0, n4); DNB_STEP(f1, n4 + 1); DNB_STEP(f2, n4 + 2); DNB_STEP(f3, n4 + 3); DNB_STEP(f0, n4 + 4); DNB_STEP(f1, n4 + 5); DNB_STEP(f2, n4 + 6); DNB_STEP(f3, n4 + 7);
        DNB_STEP(f0, n4 + 8); DNB_STEP(f1, n4 + 9); DNB_STEP(f2, n4 + 10); DNB_STEP(f3, n4 + 11); DNB_STEP(f0, n4 + 12); DNB_STEP(f1, n4 + 13); DNB_STEP(f2, n4 + 14); DNB_STEP(f3, n4 + 15); }
#undef DNB_STEP
}
constexpr int LA_XB = 0, LA_XF = 17408, LA_END = LA_XF + 64 * 132 * 4;
static_assert(LA_END <= RING_BYTES, "LRU-A LDS map");
struct LruConst { bf16x8 br[4], bi[4]; float brr, bii, sp8; };
__device__ __forceinline__ LruConst lrua_const(const bf16* WrT, const bf16* WiT, const float* b_r, const float* b_i, const float* lam, int nb, int lane, int wave) {
    LruConst c; const int fr = lane & 15, fq = lane >> 4, cl = wave * 16 + fr, ch = nb * 128 + cl;
#pragma unroll
    for (int ks = 0; ks < 4; ++ks) { c.br[ks] = *(const bf16x8*)(WrT + ((size_t)nb * 128 + cl) * 128 + ks * 32 + fq * 8); c.bi[ks] = *(const bf16x8*)(WiT + ((size_t)nb * 128 + cl) * 128 + ks * 32 + fq * 8); }
    c.brr = b_r[ch]; c.bii = b_i[ch]; c.sp8 = -8.0f * softplus_f(-lam[ch]);
    return c;
}
__device__ __forceinline__ void lrua_unit(const bf16* proj, const LruConst& LC,
                                          float* Hloc, float* Acum, float* summ, int unit, LAS unsigned char* lds, const LAS float* lwl, int tid, int lane, int wave) {
    const int nb = unit & 7, ct = unit >> 3, n = ct & 127, t0 = ct * 64;
    asm volatile("" : "+v"(lds));
    {
        const int r = tid >> 3, cg = tid & 7, ch0 = nb * 128 + cg * 16;
        float acc[16];
        { const LAS float* bp = lwl + 512 + cg * 16; const f32x4 c0v = *(const LAS f32x4*)bp, c1v = *(const LAS f32x4*)(bp + 4), c2v = *(const LAS f32x4*)(bp + 8), c3v = *(const LAS f32x4*)(bp + 12);
#pragma unroll
          for (int i = 0; i < 4; ++i) { acc[i] = c0v[i]; acc[4 + i] = c1v[i]; acc[8 + i] = c2v[i]; acc[12 + i] = c3v[i]; } }
#pragma unroll
        for (int k = 0; k < 4; ++k) { const int row = r - 3 + k;
            if (n * 64 + row >= 0) {
                const bf16* src = proj + (size_t)(t0 + row) * NPROJ + ch0;
                const u32x4 x0 = *(const u32x4*)src, x1 = *(const u32x4*)(src + 8);
                const LAS float* wp = lwl + k * 128 + cg * 16;
                const f32x4 w0 = *(const LAS f32x4*)wp, w1 = *(const LAS f32x4*)(wp + 4), w2 = *(const LAS f32x4*)(wp + 8), w3 = *(const LAS f32x4*)(wp + 12);
                acc[0] += w0[0] * bflo(x0.x); acc[1] += w0[1] * bfhi(x0.x); acc[2] += w0[2] * bflo(x0.y); acc[3] += w0[3] * bfhi(x0.y);
                acc[4] += w1[0] * bflo(x0.z); acc[5] += w1[1] * bfhi(x0.z); acc[6] += w1[2] * bflo(x0.w); acc[7] += w1[3] * bfhi(x0.w);
                acc[8] += w2[0] * bflo(x1.x); acc[9] += w2[1] * bfhi(x1.x); acc[10] += w2[2] * bflo(x1.y); acc[11] += w2[3] * bfhi(x1.y);
                acc[12] += w3[0] * bflo(x1.z); acc[13] += w3[1] * bfhi(x1.z); acc[14] += w3[2] * bflo(x1.w); acc[15] += w3[3] * bfhi(x1.w);
            } }
        u32x4 o0, o1;
        o0.x = pk2(acc[0], acc[1]); o0.y = pk2(acc[2], acc[3]); o0.z = pk2(acc[4], acc[5]); o0.w = pk2(acc[6], acc[7]);
        o1.x = pk2(acc[8], acc[9]); o1.y = pk2(acc[10], acc[11]); o1.z = pk2(acc[12], acc[13]); o1.w = pk2(acc[14], acc[15]);
        *(LAS u32x4*)(lds + LA_XB + r * 272 + cg * 32) = o0; *(LAS u32x4*)(lds + LA_XB + r * 272 + cg * 32 + 16) = o1;
        LAS f32x4* xf = (LAS f32x4*)(lds + LA_XF + (r * 132 + cg * 16) * 4);
        xf[0] = (f32x4){acc[0], acc[1], acc[2], acc[3]}; xf[1] = (f32x4){acc[4], acc[5], acc[6], acc[7]}; xf[2] = (f32x4){acc[8], acc[9], acc[10], acc[11]}; xf[3] = (f32x4){acc[12], acc[13], acc[14], acc[15]};
    }
    LDS_BARRIER();
    const int fr = lane & 15, fq = lane >> 4, cl = wave * 16 + fr, ch = nb * 128 + cl;
    f32x4 ar[4], ai[4];
#pragma unroll
    for (int mt = 0; mt < 4; ++mt) { ar[mt] = (f32x4){0.f, 0.f, 0.f, 0.f}; ai[mt] = (f32x4){0.f, 0.f, 0.f, 0.f};
#pragma unroll
        for (int ks = 0; ks < 4; ++ks) { const bf16x8 af = *(const LAS bf16x8*)(lds + LA_XB + (mt * 16 + fr) * 272 + (ks * 32 + fq * 8) * 2); ar[mt] = mfma16(af, LC.br[ks], ar[mt]); ai[mt] = mfma16(af, LC.bi[ks], ai[mt]); } }
    const float brr = LC.brr, bii = LC.bii, sp8 = LC.sp8;
    float Ac = 1.f, Bc = 0.f;
#pragma unroll
    for (int mt = 0; mt < 4; ++mt) {
        float P[4], H[4];
#pragma unroll
        for (int r = 0; r < 4; ++r) { const int t = mt * 16 + fq * 4 + r; const float xcv = *(const LAS float*)(lds + LA_XF + (t * 132 + cl) * 4);
            const float rr = sigmoid_f(ar[mt][r] + brr), ii = sigmoid_f(ai[mt][r] + bii), la = sp8 * rr, a = __expf(la), bb = __builtin_amdgcn_sqrtf(fmaxf(1.0f - a * a, 0.0f)) * (ii * xcv);
            if (r == 0) { P[0] = a; H[0] = bb; } else { P[r] = P[r - 1] * a; H[r] = a * H[r - 1] + bb; } }
        float Ai = P[3], Bi = H[3];
        { const float Au = shfl_up_l(Ai, 16, lane), Bu = shfl_up_l(Bi, 16, lane); if (fq >= 1) { Bi = Ai * Bu + Bi; Ai = Au * Ai; } }
        { const float Au = shfl_up_l(Ai, 32, lane), Bu = shfl_up_l(Bi, 32, lane); if (fq >= 2) { Bi = Ai * Bu + Bi; Ai = Au * Ai; } }
        float Ae = shfl_up_l(Ai, 16, lane), Be = shfl_up_l(Bi, 16, lane); if (fq == 0) { Ae = 1.f; Be = 0.f; }
        const float At = shfl_idx_l(Ai, 48 + fr), Bt = shfl_idx_l(Bi, 48 + fr);
        const float PA = Ac * Ae, PB = Ae * Bc + Be;
#pragma unroll
        for (int r = 0; r < 4; ++r) { const size_t o = (size_t)(t0 + mt * 16 + fq * 4 + r) * DLRU + ch; ((unsigned*)Hloc)[o] = pk2(P[r] * PB + H[r], PA * P[r]); }
        Bc = At * Bc + Bt; Ac = Ac * At;
    }
    if (fq == 0) { float* sp = summ + ((size_t)ct * DLRU + ch) * 2; sp[0] = Ac; sp[1] = Bc; }
    LDS_BARRIER();
}
__device__ __forceinline__ void lru_carry(const float* summ, float* carry, int idx) {
    const int b = idx >> 10, ch = idx & 1023; float c = 0.f;
    for (int n0 = 0; n0 < 128; n0 += 8) { float A[8], B[8];
#pragma unroll
        for (int j = 0; j < 8; ++j) { const float* sp = summ + ((size_t)(b * 128 + n0 + j) * DLRU + ch) * 2; A[j] = sp[0]; B[j] = sp[1]; }
#pragma unroll
        for (int j = 0; j < 8; ++j) { carry[(size_t)(b * 128 + n0 + j) * DLRU + ch] = c; c = A[j] * c + B[j]; } }
}
__device__ __forceinline__ void lrub_row(const float* Hloc, const float* Acum, const float* carry, const bf16* proj, const float* gain, bf16* ymix, int row, int lane) {
    const int ct = row >> 6; f32x4 y[4]; float ss = 0.f;
#pragma unroll
    for (int j = 0; j < 4; ++j) { const int c4 = lane * 4 + 256 * j;
        const u32x4 ha = *(const u32x4*)((const unsigned*)Hloc + (size_t)row * DLRU + c4); const f32x4 cr = *(const f32x4*)(carry + (size_t)ct * DLRU + c4);
        const u32x2 g = *(const u32x2*)(proj + (size_t)row * NPROJ + DLRU + c4);
        const f32x4 hl = {bflo(ha.x), bflo(ha.y), bflo(ha.z), bflo(ha.w)}, ac = {bfhi(ha.x), bfhi(ha.y), bfhi(ha.z), bfhi(ha.w)};
        const f32x4 hh = hl + ac * cr;
        y[j][0] = hh[0] * gelu_tanh_f(bflo(g.x)); y[j][1] = hh[1] * gelu_tanh_f(bfhi(g.x)); y[j][2] = hh[2] * gelu_tanh_f(bflo(g.y)); y[j][3] = hh[3] * gelu_tanh_f(bfhi(g.y));
        ss += (y[j][0] * y[j][0] + y[j][1] * y[j][1]) + (y[j][2] * y[j][2] + y[j][3] * y[j][3]); }
    ss = wave_sum(ss, lane); const float rs = rsqrt_f(ss * (1.0f / DLRU) + EPS);
#pragma unroll
    for (int j = 0; j < 4; ++j) { const int c4 = lane * 4 + 256 * j; const f32x4 g = *(const f32x4*)(gain + c4); u32x2 w; w.x = pk2(y[j][0] * rs * g[0], y[j][1] * rs * g[1]); w.y = pk2(y[j][2] * rs * g[2], y[j][3] * rs * g[3]);
        *(u32x2*)(ymix + (size_t)row * D + c4) = w; }
}
__device__ __forceinline__ void dn_out_row(const float* o, const float* gain, const bf16* proj, bf16* ymix, int t, int lane) {
    const int c = lane * 16;
    const f32x4* op = (const f32x4*)(o + (size_t)t * DDN + c); const f32x4 o0 = op[0], o1 = op[1], o2 = op[2], o3 = op[3];
    const u32x4* gp = (const u32x4*)(proj + (size_t)t * NPROJ + 5120 + c); const u32x4 g0 = gp[0], g1 = gp[1];
    const f32x4* wp = (const f32x4*)(gain + (c & 127)); const f32x4 w0 = wp[0], w1 = wp[1], w2 = wp[2], w3 = wp[3];
    float ss = (o0[0] * o0[0] + o0[1] * o0[1]) + (o0[2] * o0[2] + o0[3] * o0[3]) + (o1[0] * o1[0] + o1[1] * o1[1]) + (o1[2] * o1[2] + o1[3] * o1[3])
             + (o2[0] * o2[0] + o2[1] * o2[1]) + (o2[2] * o2[2] + o2[3] * o2[3]) + (o3[0] * o3[0] + o3[1] * o3[1]) + (o3[2] * o3[2] + o3[3] * o3[3]);
    ss += shfl_xor_l(ss, 1, lane); ss += shfl_xor_l(ss, 2, lane); ss += shfl_xor_l(ss, 4, lane);
    const float rs = rsqrt_f(ss * (1.0f / HD) + EPS);
    u32x4 r0, r1;
    r0.x = pk2(o0[0] * rs * w0[0] * silu_f(bflo(g0.x)), o0[1] * rs * w0[1] * silu_f(bfhi(g0.x))); r0.y = pk2(o0[2] * rs * w0[2] * silu_f(bflo(g0.y)), o0[3] * rs * w0[3] * silu_f(bfhi(g0.y)));
    r0.z = pk2(o1[0] * rs * w1[0] * silu_f(bflo(g0.z)), o1[1] * rs * w1[1] * silu_f(bfhi(g0.z))); r0.w = pk2(o1[2] * rs * w1[2] * silu_f(bflo(g0.w)), o1[3] * rs * w1[3] * silu_f(bfhi(g0.w)));
    r1.x = pk2(o2[0] * rs * w2[0] * silu_f(bflo(g1.x)), o2[1] * rs * w2[1] * silu_f(bfhi(g1.x))); r1.y = pk2(o2[2] * rs * w2[2] * silu_f(bflo(g1.y)), o2[3] * rs * w2[3] * silu_f(bfhi(g1.y)));
    r1.z = pk2(o3[0] * rs * w3[0] * silu_f(bflo(g1.z)), o3[1] * rs * w3[1] * silu_f(bfhi(g1.z))); r1.w = pk2(o3[2] * rs * w3[2] * silu_f(bflo(g1.w)), o3[3] * rs * w3[3] * silu_f(bfhi(g1.w)));
    u32x4* dst = (u32x4*)(ymix + (size_t)t * D + DLRU + c); dst[0] = r0; dst[1] = r1;
}
__device__ __forceinline__ void route_row(const float* x, const float* rstd, const float* gain, const float* router, float* roww, int row, int lane) {
    float acc[8];
#pragma unroll
    for (int e = 0; e < 8; ++e) acc[e] = 0.f;
    for (int j = 0; j < 32; ++j) { const int k = lane + 64 * j; const float xv = x[(size_t)row * D + k] * gain[k]; const f32x4 r0 = *(const f32x4*)(router + (size_t)k * 8), r1 = *(const f32x4*)(router + (size_t)k * 8 + 4);
        acc[0] += xv * r0[0]; acc[1] += xv * r0[1]; acc[2] += xv * r0[2]; acc[3] += xv * r0[3]; acc[4] += xv * r1[0]; acc[5] += xv * r1[1]; acc[6] += xv * r1[2]; acc[7] += xv * r1[3]; }
    const float rs = rstd[row];
#pragma unroll
    for (int e = 0; e < 8; ++e) acc[e] = wave_sum(acc[e], lane) * rs;
    int e1 = 0; float l1 = acc[0];
#pragma unroll
    for (int e = 1; e < 8; ++e) if (acc[e] > l1) { l1 = acc[e]; e1 = e; }
    int e2 = -1; float l2 = -3.4e38f;
#pragma unroll
    for (int e = 0; e < 8; ++e) if (e != e1 && acc[e] > l2) { l2 = acc[e]; e2 = e; }
    const float w1 = 1.0f / (1.0f + __expf(l2 - l1)), w2 = 1.0f - w1;
    if (lane < 8) roww[(size_t)lane * T + row] = lane == e1 ? w1 : (lane == e2 ? w2 : 0.0f);
}
__device__ __forceinline__ void final_row(const float* x, const float* gain, float* out, int row, int lane) {
    const f32x4* xr = (const f32x4*)(x + (size_t)row * D) + lane; const f32x4* gr = (const f32x4*)gain + lane;
    f32x4 v[8]; float ss = 0.f;
#pragma unroll
    for (int j = 0; j < 8; ++j) { v[j] = xr[64 * j]; ss += (v[j][0] * v[j][0] + v[j][1] * v[j][1]) + (v[j][2] * v[j][2] + v[j][3] * v[j][3]); }
    ss = wave_sum(ss, lane); const float rs = rsqrt_f(ss * (1.0f / D) + EPS);
    f32x4* o = (f32x4*)(out + (size_t)row * D) + lane;
#pragma unroll
    for (int j = 0; j < 8; ++j) o[64 * j] = v[j] * rs * gr[64 * j];
}

struct MoeOrder {
    const int* list; int nN, G, c; int c0, c1, c2, c3, c4, c5, c6, c7;
    __device__ __forceinline__ void init(const unsigned* cnt, const int* list_, int nN_, int G_, int c_) { list = list_; nN = nN_; G = G_; c = c_;
        c0 = __builtin_amdgcn_readfirstlane((int)cnt[0]); c1 = __builtin_amdgcn_readfirstlane((int)cnt[1]); c2 = __builtin_amdgcn_readfirstlane((int)cnt[2]); c3 = __builtin_amdgcn_readfirstlane((int)cnt[3]);
        c4 = __builtin_amdgcn_readfirstlane((int)cnt[4]); c5 = __builtin_amdgcn_readfirstlane((int)cnt[5]); c6 = __builtin_amdgcn_readfirstlane((int)cnt[6]); c7 = __builtin_amdgcn_readfirstlane((int)cnt[7]); }
    __device__ __forceinline__ bool next(int i, pg8::Unit& u) const {
        const int c8[8] = {c0, c1, c2, c3, c4, c5, c6, c7}; int nM = 0;
#pragma unroll
        for (int k = 0; k < 8; ++k) nM += (c8[k] + 255) >> 8;
        const int nwg = nM * nN; const long L = (long)i * G + c; if (L >= nwg) return false;
        int wgid = (int)L; { const int q = nwg / pg8::NXCD, r = nwg % pg8::NXCD, xcd = wgid % pg8::NXCD, off = wgid / pg8::NXCD; wgid = (xcd < r ? xcd * (q + 1) : r * (q + 1) + (xcd - r) * q) + off; }
        const int nig = pg8::WGM * nN, gid = wgid / nig, fm = gid * pg8::WGM, gsz = (nM - fm) < pg8::WGM ? (nM - fm) : pg8::WGM;
        u.pm = fm + ((wgid % nig) % gsz); u.pn = (wgid % nig) / gsz;
        int e = 0, ps = 0, ce = c8[0], run = 0;
#pragma unroll
        for (int k = 0; k < 8; ++k) { const int mk = (c8[k] + 255) >> 8; if (u.pm >= run && u.pm < run + mk) { e = k; ps = run; ce = c8[k]; } run += mk; }
        const int mtl = u.pm - ps; u.pb = e * nN + u.pn; u.lbase = e * T + mtl * 256; u.nvalid = (ce - mtl * 256) < 256 ? (ce - mtl * 256) : 256;
        return true;
    }
    __device__ __forceinline__ int arow(const pg8::Unit& u, int r) const { return r < u.nvalid ? (list[u.lbase + r] & 0xffff) : 0; }
    __device__ __forceinline__ void a_ready(const pg8::Unit&) const {}
    __device__ __forceinline__ void done(const pg8::Unit&) const {}
};
__device__ __forceinline__ void route_block(const float* x, const float* gain, const float* router, bf16* xb, float* rstd, unsigned* cnt, int* list, float* listw, int blk, LAS unsigned char* lds, int tid, int lane, int wave) {
    asm volatile("" : "+v"(lds));
    LAS float* grt = (LAS float*)lds; LAS int* se1 = (LAS int*)(lds + 65536); LAS int* se2 = se1 + 64; LAS float* sw1 = (LAS float*)(se2 + 64); LAS float* sw2 = sw1 + 64; LAS int* lcnt = (LAS int*)(sw2 + 64); LAS int* gbase = lcnt + 8;
    for (int i = tid; i < D * 8; i += 512) grt[i] = router[i] * gain[i >> 3];
    if (tid < 8) lcnt[tid] = 0;
    __syncthreads();
    f32x4 vnx[8];
    { const f32x4* xr = (const f32x4*)(x + (size_t)(blk * 64 + wave * 8) * D) + lane;
#pragma unroll
      for (int j = 0; j < 8; ++j) vnx[j] = xr[64 * j]; }
    for (int q = 0; q < 8; ++q) { const int rloc = wave * 8 + q, row = blk * 64 + rloc;
        f32x4 v[8]; float ss = 0.f;
#pragma unroll
        for (int j = 0; j < 8; ++j) { v[j] = vnx[j]; ss += (v[j][0] * v[j][0] + v[j][1] * v[j][1]) + (v[j][2] * v[j][2] + v[j][3] * v[j][3]); }
        { const f32x4* xr = (const f32x4*)(x + (size_t)(row + (q < 7 ? 1 : 0)) * D) + lane;
#pragma unroll
          for (int j = 0; j < 8; ++j) vnx[j] = xr[64 * j]; }
        ss = wave_sum(ss, lane); const float rs = rsqrt_f(ss * (1.0f / D) + EPS);
        u32x2* o = (u32x2*)(xb + (size_t)row * D) + lane;
#pragma unroll
        for (int j = 0; j < 8; ++j) { u32x2 w; w.x = pk2(v[j][0], v[j][1]); w.y = pk2(v[j][2], v[j][3]); o[64 * j] = w; }
        if (lane == 0) rstd[row] = rs;
        float acc[8];
#pragma unroll
        for (int e = 0; e < 8; ++e) acc[e] = 0.f;
#pragma unroll
        for (int j = 0; j < 8; ++j)
#pragma unroll
            for (int c = 0; c < 4; ++c) { const int k = (lane + 64 * j) * 4 + c; const f32x4 r0 = *(const LAS f32x4*)(grt + k * 8), r1 = *(const LAS f32x4*)(grt + k * 8 + 4); const float xv = v[j][c];
                acc[0] += xv * r0[0]; acc[1] += xv * r0[1]; acc[2] += xv * r0[2]; acc[3] += xv * r0[3]; acc[4] += xv * r1[0]; acc[5] += xv * r1[1]; acc[6] += xv * r1[2]; acc[7] += xv * r1[3]; }
#pragma unroll
        for (int e = 0; e < 8; ++e) acc[e] = wave_sum(acc[e], lane) * rs;
        int e1 = 0; float l1 = acc[0];
#pragma unroll
        for (int e = 1; e < 8; ++e) if (acc[e] > l1) { l1 = acc[e]; e1 = e; }
        int e2 = -1; float l2 = -3.4e38f;
#pragma unroll
        for (int e = 0; e < 8; ++e) if (e != e1 && acc[e] > l2) { l2 = acc[e]; e2 = e; }
        const float w1 = 1.0f / (1.0f + __expf(l2 - l1));
        if (lane == 0) { se1[rloc] = e1; se2[rloc] = e2; sw1[rloc] = w1; sw2[rloc] = 1.0f - w1; }
    }
    __syncthreads();
    int e = 0, lr = 0; float w = 0.f;
    if (tid < 128) { const int rloc = tid >> 1, j = tid & 1; e = j ? se2[rloc] : se1[rloc]; w = j ? sw2[rloc] : sw1[rloc]; lr = __hip_atomic_fetch_add(lcnt + e, 1, __ATOMIC_RELAXED, __HIP_MEMORY_SCOPE_WORKGROUP); }
    __syncthreads();
    if (tid < 8) gbase[tid] = (int)__hip_atomic_fetch_add(cnt + tid, (unsigned)lcnt[tid], __ATOMIC_RELAXED, __HIP_MEMORY_SCOPE_AGENT);
    __syncthreads();
    if (tid < 128) { const int pos = gbase[e] + lr, tok = blk * 64 + (tid >> 1); list[e * T + pos] = tok | ((tid & 1) << 16); listw[e * T + pos] = w; }
    __syncthreads();
}
__device__ __forceinline__ void final_row_moe(const float* x, const bf16* y0, const bf16* y1, const float* gain, float* out, int row, int lane) {
    const f32x4* xr = (const f32x4*)(x + (size_t)row * D) + lane; const f32x4* gr = (const f32x4*)gain + lane;
    const u32x2* p0 = (const u32x2*)(y0 + (size_t)row * D) + lane; const u32x2* p1 = (const u32x2*)(y1 + (size_t)row * D) + lane;
    f32x4 v[8]; float ss = 0.f;
#pragma unroll
    for (int j = 0; j < 8; ++j) { v[j] = xr[64 * j]; const u32x2 a = p0[64 * j], b = p1[64 * j];
        v[j][0] += bflo(a.x) + bflo(b.x); v[j][1] += bfhi(a.x) + bfhi(b.x); v[j][2] += bflo(a.y) + bflo(b.y); v[j][3] += bfhi(a.y) + bfhi(b.y);
        ss += (v[j][0] * v[j][0] + v[j][1] * v[j][1]) + (v[j][2] * v[j][2] + v[j][3] * v[j][3]); }
    ss = wave_sum(ss, lane); const float rs = rsqrt_f(ss * (1.0f / D) + EPS);
    f32x4* o = (f32x4*)(out + (size_t)row * D) + lane;
#pragma unroll
    for (int j = 0; j < 8; ++j) o[64 * j] = v[j] * rs * gr[64 * j];
}
__device__ __forceinline__ void ba_tail(const bf16* xbp, const bf16* wbab, const float* ssq, int mode, float* bap, int rb, int wave, int lane) {
    if (wave < 4) { const int fr = lane & 15, fq = lane >> 4, r0 = rb * 64 + wave * 16;
        const bf16* ap = xbp + (size_t)(r0 + fr) * D + fq * 8; const bf16* bp = wbab + (size_t)fr * D + fq * 8;
        f32x4 acc = {0.f, 0.f, 0.f, 0.f};
#pragma unroll 16
        for (int ks = 0; ks < 64; ++ks) { const bf16x8 a = *(const bf16x8*)(ap + ks * 32), b = *(const bf16x8*)(bp + ks * 32); acc = mfma16(a, b, acc); }
#pragma unroll
        for (int rr = 0; rr < 4; ++rr) { const int r = r0 + fq * 4 + rr; bap[(size_t)r * 16 + fr] = acc[rr] * pg8::row_scale(ssq, r, mode); } }
}
struct Args { const float* in[25]; float* out; unsigned char* ws; int ph_lo, ph_hi; };
typedef const __attribute__((address_space(4))) unsigned long long* kaptr_t;
__device__ __forceinline__ unsigned long long ldka(int i) { kaptr_t ka = (kaptr_t)__builtin_amdgcn_kernarg_segment_ptr(); asm volatile("" : "+s"(i)); return ka[i]; }
__device__ __forceinline__ const float* ldin(const Args&, int i) { return (const float*)(const GAS float*)ldka(i); }
__device__ __forceinline__ unsigned char* ldws(const Args&) { return (unsigned char*)(GAS unsigned char*)ldka(26); }
__device__ __forceinline__ float* ldout(const Args&) { return (float*)(GAS float*)ldka(25); }
__global__ void __launch_bounds__(512, 2) mega(Args args) {
    extern __shared__ __attribute__((aligned(16))) unsigned char lds_raw[];
    LAS unsigned char* lds = (LAS unsigned char*)lds_raw;
    volatile LAS unsigned* MISC = (volatile LAS unsigned*)(lds + MISC_OFF);
    const int tid = threadIdx.x;
    const int G = gridDim.x, bid = blockIdx.x, NGW = G * 8;
    unsigned char* ws = ldws(args);
    for (int u = tid; u < (LDS_BYTES - LDSCTL_OFF) / 4; u += 512) ((LAS unsigned*)(lds + LDSCTL_OFF))[u] = 0u;
    __syncthreads();
    (void)xcd_barrier_post((unsigned*)(ws + WS_CTL) + CW_BAR, MISC + 8);
#define RUN(id) true
#if defined(PROBE_MASK)
#define STAMP() do { if (threadIdx.x == 0) { ((volatile LAS unsigned long long*)(lds + LDSCTL_OFF + 1024))[nst] = __builtin_amdgcn_s_memrealtime(); } ++nst; } while (0)
#else
#define STAMP() do { } while (0)
#endif
#define SEAM(id) do { XcdBarrier bar_; bar_.bar = (unsigned*)WSP(WS_CTL) + CW_BAR; bar_.x = xb_xcc_id(); bar_.st = (volatile LAS unsigned*)(lds + MISC_OFF) + 8; xcd_barrier(bar_); STAMP(); } while (0)
#if defined(PROBE_MASK)
    int nst = 0; STAMP();
#endif
#define INP(i) ldin(args, (i))
#define WSP(off) (ldws(args) + (off))
#define x_in INP(0)
#define norm_mix INP(1)
#define w_in INP(2)
#define conv_lru_w INP(3)
#define conv_lru_b INP(4)
#define lru_w_r INP(5)
#define lru_b_r INP(6)
#define lru_w_i INP(7)
#define lru_b_i INP(8)
#define lru_lambda INP(9)
#define lru_out_norm INP(10)
#define conv_qkv_w INP(11)
#define dn_a_log INP(12)
#define dn_dt_bias INP(13)
#define dn_out_norm INP(14)
#define w_out INP(15)
#define norm_ffn INP(16)
#define ffn_w_gate INP(17)
#define ffn_w_up INP(18)
#define ffn_w_down INP(19)
#define moe_router INP(20)
#define moe_w_gate INP(21)
#define moe_w_up INP(22)
#define moe_w_down INP(23)
#define norm_final INP(24)
#define xres (ldout(args))
#define Win ((bf16*)WSP(WS_WIN))
#define Wba ((float*)WSP(WS_WBA))
#define Wout ((bf16*)WSP(WS_WOUT))
#define Wgu ((bf16*)WSP(WS_WGU))
#define Wd ((bf16*)WSP(WS_WD))
#define Mgu ((bf16*)WSP(WS_C))
#define Md ((bf16*)WSP(WS_WGU))
#define MCNT ((unsigned*)WSP(WS_CTL) + CW_CNT)
#define MLIST ((int*)WSP(WS_ROWW))
#define MLISTW ((float*)WSP(WS_ROWW + (size_t)8 * T * 4))
#define YP0 ((bf16*)WSP(WS_XB))
#define YP1 ((bf16*)WSP(WS_YMIX))
#define xb ((bf16*)WSP(WS_XB))
#define rstd ((float*)WSP(WS_RSTD))
#define SSQA ((float*)WSP(WS_RSTD + (size_t)1 * MiB))
#define SSQB ((float*)WSP(WS_RSTD + (size_t)3 * MiB))
#define WBAB ((bf16*)WSP(WS_WBA + (size_t)2 * 16 * D * 4))
#define ba ((float*)WSP(WS_BA))
#define beta ((float*)WSP(WS_BETA))
#define gg ((float*)WSP(WS_G))
#define roww ((float*)WSP(WS_ROWW))
#define proj ((bf16*)WSP(WS_PROJ))
#define hid ((bf16*)WSP(WS_PROJ))
#define ymix ((bf16*)WSP(WS_YMIX))
#define c0 ((float*)WSP(WS_C))
#define c1 ((float*)WSP(WS_C + (size_t)T * 1024 * 4))
#define c2 ((float*)WSP(WS_C + (size_t)2 * T * 1024 * 4))
#define c3 ((float*)WSP(WS_C + (size_t)3 * T * 1024 * 4))
#define LRU_WRT ((bf16*)WSP(WS_WRT))
#define LRU_WIT ((bf16*)WSP(WS_WRT + (size_t)2 * 8 * 128 * 128 * 2))
#define LRU_H ((float*)WSP(WS_C + (size_t)256 * MiB))
#define LRU_A ((float*)WSP(WS_C + (size_t)320 * MiB))
#define LRU_SUMM ((float*)WSP(WS_C + (size_t)384 * MiB))
#define LRU_CARRY ((float*)WSP(WS_C + (size_t)386 * MiB))
#define DN_WF ((bf16*)WSP(WS_C))
#define DN_QF ((bf16*)WSP(WS_C + (size_t)32 * MiB))
#define DN_KDTF ((bf16*)WSP(WS_C + (size_t)64 * MiB))
#define DN_UF ((bf16*)WSP(WS_C + (size_t)96 * MiB))
#define DN_QKF ((bf16*)WSP(WS_C + (size_t)128 * MiB))
#define DN_GL ((float*)WSP(WS_C + (size_t)144 * MiB))
    const int BIG = 1 << 30;
#define PHL int tid_ = threadIdx.x; asm volatile("" : "+v"(tid_)); const int lane_ = tid_ & 63; int bid_ = blockIdx.x; asm volatile("" : "+s"(bid_)); const int gw_ = bid_ * 8 + __builtin_amdgcn_readfirstlane(tid_ >> 6); const size_t gt_ = (size_t)bid_ * 512 + tid_, NGT = (size_t)G * 512; LAS float* scr = (LAS float*)(lds + (gw_ & 7) * 16384);
    if (RUN(ph)) { PHL
        convert_matrix(w_in, DIN, 0, D, NPROJ, norm_mix, Win, BIG, 0, 0, scr, gw_, NGW, lane_);
        convert_matrix(w_out, D, 0, D, D, nullptr, Wout, BIG, 0, 0, scr, gw_, NGW, lane_);
        for (size_t i = gt_; i < (size_t)2 * 16 * D; i += NGT) { const int l = (int)(i / (16 * D)), j = (int)((i / D) & 15), k = (int)(i % D); WBAB[i] = (bf16)f2bf(w_in[(size_t)l * D * DIN + (size_t)k * DIN + NPROJ + j] * norm_mix[l * D + k]); }
        for (int r = gw_; r < T; r += NGW) rowprep_row(x_in, xb, rstd, nullptr, nullptr, r, lane_);
        for (int m = 0; m < 16; ++m) {
            convert_matrix(lru_w_r + (size_t)m * 128 * 128, 128, 0, 128, 128, nullptr, LRU_WRT + (size_t)m * 128 * 128, BIG, 0, 0, scr, gw_, NGW, lane_);
            convert_matrix(lru_w_i + (size_t)m * 128 * 128, 128, 0, 128, 128, nullptr, LRU_WIT + (size_t)m * 128 * 128, BIG, 0, 0, scr, gw_, NGW, lane_); }
    }
    SEAM(ph);
    int xsel = 0;
#define xcur (xsel ? (const float*)xres : x_in)
    { constexpr int l = 0;
        if (RUN(ph)) { pg8::Gemm g{xb, Win + (size_t)l * NPROJ * D, T, NPROJ, D, 0}; pg8::StaticOrder S; S.init(T, NPROJ, G, bid); pg8::EpiScaleBf16 E{proj, l == 0 ? rstd : SSQB, NPROJ, l};
            pg8::gemm_phase<pg8::EpiScaleBf16, pg8::StaticOrder, true, false>(lds, g, S, E);
            { PHL for (int rb = bid_; rb < T / 64; rb += G) ba_tail(xb, WBAB + (size_t)l * 16 * D, l == 0 ? rstd : SSQB, l, ba, rb, gw_ & 7, lane_); } }
        SEAM(ph);
        if (RUN(ph)) { PHL
            LAS float* cwl = (LAS float*)(lds + LDSCTL_OFF + 4096); LAS float* lwl = cwl + 4 * 384;
            { const int hb = bid_ & 7; const float* cq = conv_qkv_w + (size_t)l * 4 * 3 * DDN; const float* cl = conv_lru_w + (size_t)l * 4 * DLRU; const float* cbp = conv_lru_b + l * DLRU;
              for (int i = tid_; i < 4 * 384; i += 512) { const int k = i / 384, pp = (i % 384) >> 7, d = i & 127; cwl[i] = cq[k * 3 * DDN + pp * DDN + hb * HD + d]; }
              for (int i = tid_; i < 640; i += 512) { const int k = i >> 7, d = i & 127; lwl[i] = k < 4 ? cl[k * DLRU + hb * 128 + d] : cbp[hb * 128 + d]; }
              __syncthreads(); }
            { const LruConst LC = lrua_const(LRU_WRT + (size_t)l * 8 * 128 * 128, LRU_WIT + (size_t)l * 8 * 128 * 128, lru_b_r + l * DLRU, lru_b_i + l * DLRU, lru_lambda + l * DLRU, bid_ & 7, lane_, gw_ & 7);
              for (int u = bid_; u < 2048; u += G) lrua_unit(proj, LC, LRU_H, LRU_A, LRU_SUMM, u, lds, lwl, tid_, lane_, gw_ & 7); }
            STAMP();
            for (int uid = bid_; uid < 2048; uid += G) dna_unit(proj, conv_qkv_w + (size_t)l * 4 * 3 * DDN, ba, dn_a_log + l * NH, dn_dt_bias + l * NH, DN_WF, DN_QF, DN_KDTF, DN_QKF, DN_UF, DN_GL, uid, lds, cwl, tid_, lane_, gw_ & 7); }
        SEAM(ph);
        if (RUN(ph)) { PHL
            if (bid_ < 128) dnb_run(DN_WF, DN_QF, DN_KDTF, DN_QKF, DN_UF, DN_GL, c3, (bid_ & 7) + 8 * (bid_ >> 6), (bid_ >> 3) & 7, lds, tid_, lane_, gw_ & 7);
            else { if (bid_ < 136 && tid_ < 256) lru_carry(LRU_SUMM, LRU_CARRY, (bid_ - 128) * 256 + tid_);
                const int cw = gw_ - 128 * 8, CNW = NGW - 128 * 8;
                if (l == 0) {
                    convert_matrix(w_in + (size_t)D * DIN, DIN, 0, D, NPROJ, norm_mix + D, Win + (size_t)NPROJ * D, BIG, 0, 0, scr, cw, CNW, lane_);
                    convert_matrix(w_out + (size_t)D * D, D, 0, D, D, nullptr, Wout + (size_t)D * D, BIG, 0, 0, scr, cw, CNW, lane_);
                    convert_matrix(ffn_w_gate, DFF, 0, D, DFF, norm_ffn, Wgu, 128, 256, 0, scr, cw, CNW, lane_);
                    convert_matrix(ffn_w_up, DFF, 0, D, DFF, norm_ffn, Wgu, 128, 256, 128, scr, cw, CNW, lane_);
                    convert_matrix(ffn_w_down, D, 0, DFF, D, nullptr, Wd, BIG, 0, 0, scr, cw, CNW, lane_);
                } else {
                    for (int e = 0; e < NEXP; ++e) convert_matrix(moe_w_down + (size_t)e * DFFE * D, D, 0, DFFE, D, nullptr, Md + (size_t)e * D * DFFE, BIG, 0, 0, scr, cw, CNW, lane_);
                } } }
        SEAM(ph);
        if (RUN(ph)) { PHL
            for (int r = gw_; r < T; r += NGW) lrub_row(LRU_H, LRU_A, LRU_CARRY, proj, lru_out_norm + l * DLRU, ymix, r, lane_);
            for (int r = gw_; r < T; r += NGW) dn_out_row(c3, dn_out_norm + l * HD, proj, ymix, r, lane_); }
        SEAM(ph);
        if (RUN(ph)) { if (l == 0) { pg8::Gemm g{ymix, Wout, T, D, D, 0}; pg8::StaticOrder S; S.init(T, D, G, bid); pg8::EpiResidualNorm E{xcur, xres, xb, SSQA, D, 0};
            pg8::gemm_phase<pg8::EpiResidualNorm, pg8::StaticOrder, true, false>(lds, g, S, E); }
          else { pg8::Gemm g{ymix, Wout + (size_t)D * D, T, D, D, 0}; pg8::StaticOrder S; S.init(T, D, G, bid); pg8::EpiResidual E{xcur, xres, nullptr, D, 0};
            pg8::gemm_phase<pg8::EpiResidual, pg8::StaticOrder, true, false>(lds, g, S, E); }
            if (l == 1) { PHL
                for (int e = 0; e < NEXP; ++e) {
                    convert_matrix(moe_w_gate + (size_t)e * D * DFFE, DFFE, 0, D, DFFE, norm_ffn + D, Mgu + (size_t)e * 2 * DFFE * D, 128, 256, 0, scr, gw_, NGW, lane_);
                    convert_matrix(moe_w_up + (size_t)e * D * DFFE, DFFE, 0, D, DFFE, norm_ffn + D, Mgu + (size_t)e * 2 * DFFE * D, 128, 256, 128, scr, gw_, NGW, lane_);
 } } }
        SEAM(ph);
        xsel = 1;
        if (l == 0) {
            if (RUN(ph)) { pg8::Gemm g{xb, Wgu, T, 2 * DFF, D, 0}; pg8::StaticOrder S; S.init(T, 2 * DFF, G, bid); pg8::EpiSwiGLU E{hid, SSQA, DFF, 1};
                pg8::gemm_phase<pg8::EpiSwiGLU, pg8::StaticOrder, true, false>(lds, g, S, E); }
            SEAM(ph);
            if (RUN(ph)) { pg8::Gemm g{hid, Wd, T, D, DFF, 0}; pg8::StaticOrder S; S.init(T, D, G, bid); pg8::EpiResidualNorm E{xcur, xres, xb, SSQB, D, 0};
                pg8::gemm_phase<pg8::EpiResidualNorm, pg8::StaticOrder, true, false>(lds, g, S, E); }
            SEAM(ph);
        } else {
            if (RUN(ph)) { PHL for (int blk = bid_; blk < T / 64; blk += G) route_block(xcur, norm_ffn + D, moe_router, xb, rstd, MCNT, MLIST, MLISTW, blk, lds, tid_, lane_, gw_ & 7); }
            SEAM(ph);
            if (RUN(ph)) { pg8::Gemm g{xb, Mgu, NSLOT, 2 * DFFE, D, 0}; MoeOrder S; S.init(MCNT, MLIST, 2 * DFFE / 256, G, bid); pg8::EpiSwiGLUMoe E{hid, rstd, MLIST, DFFE, 0};
                pg8::gemm_phase<pg8::EpiSwiGLUMoe, MoeOrder, true, true>(lds, g, S, E); }
            SEAM(ph);
            if (RUN(ph)) { pg8::Gemm g{hid, Md, NSLOT, D, DFFE, 0}; MoeOrder S; S.init(MCNT, MLIST, D / 256, G, bid); pg8::EpiMoeDown E{YP0, YP1, MLIST, MLISTW, D, 0};
                pg8::gemm_phase<pg8::EpiMoeDown, MoeOrder, true, false>(lds, g, S, E); }
            SEAM(ph);
        }
    }
    { constexpr int l = 1;
        if (RUN(ph)) { pg8::Gemm g{xb, Win + (size_t)l * NPROJ * D, T, NPROJ, D, 0}; pg8::StaticOrder S; S.init(T, NPROJ, G, bid); pg8::EpiScaleBf16 E{proj, l == 0 ? rstd : SSQB, NPROJ, l};
            pg8::gemm_phase<pg8::EpiScaleBf16, pg8::StaticOrder, true, false>(lds, g, S, E);
            { PHL for (int rb = bid_; rb < T / 64; rb += G) ba_tail(xb, WBAB + (size_t)l * 16 * D, l == 0 ? rstd : SSQB, l, ba, rb, gw_ & 7, lane_); } }
        SEAM(ph);
        if (RUN(ph)) { PHL
            LAS float* cwl = (LAS float*)(lds + LDSCTL_OFF + 4096); LAS float* lwl = cwl + 4 * 384;
            { const int hb = bid_ & 7; const float* cq = conv_qkv_w + (size_t)l * 4 * 3 * DDN; const float* cl = conv_lru_w + (size_t)l * 4 * DLRU; const float* cbp = conv_lru_b + l * DLRU;
              for (int i = tid_; i < 4 * 384; i += 512) { const int k = i / 384, pp = (i % 384) >> 7, d = i & 127; cwl[i] = cq[k * 3 * DDN + pp * DDN + hb * HD + d]; }
              for (int i = tid_; i < 640; i += 512) { const int k = i >> 7, d = i & 127; lwl[i] = k < 4 ? cl[k * DLRU + hb * 128 + d] : cbp[hb * 128 + d]; }
              __syncthreads(); }
            { const LruConst LC = lrua_const(LRU_WRT + (size_t)l * 8 * 128 * 128, LRU_WIT + (size_t)l * 8 * 128 * 128, lru_b_r + l * DLRU, lru_b_i + l * DLRU, lru_lambda + l * DLRU, bid_ & 7, lane_, gw_ & 7);
              for (int u = bid_; u < 2048; u += G) lrua_unit(proj, LC, LRU_H, LRU_A, LRU_SUMM, u, lds, lwl, tid_, lane_, gw_ & 7); }
            STAMP();
            for (int uid = bid_; uid < 2048; uid += G) dna_unit(proj, conv_qkv_w + (size_t)l * 4 * 3 * DDN, ba, dn_a_log + l * NH, dn_dt_bias + l * NH, DN_WF, DN_QF, DN_KDTF, DN_QKF, DN_UF, DN_GL, uid, lds, cwl, tid_, lane_, gw_ & 7); }
        SEAM(ph);
        if (RUN(ph)) { PHL
            if (bid_ < 128) dnb_run(DN_WF, DN_QF, DN_KDTF, DN_QKF, DN_UF, DN_GL, c3, (bid_ & 7) + 8 * (bid_ >> 6), (bid_ >> 3) & 7, lds, tid_, lane_, gw_ & 7);
            else { if (bid_ < 136 && tid_ < 256) lru_carry(LRU_SUMM, LRU_CARRY, (bid_ - 128) * 256 + tid_);
                const int cw = gw_ - 128 * 8, CNW = NGW - 128 * 8;
                if (l == 0) {
                    convert_matrix(w_in + (size_t)D * DIN, DIN, 0, D, NPROJ, norm_mix + D, Win + (size_t)NPROJ * D, BIG, 0, 0, scr, cw, CNW, lane_);
                    convert_matrix(w_out + (size_t)D * D, D, 0, D, D, nullptr, Wout + (size_t)D * D, BIG, 0, 0, scr, cw, CNW, lane_);
                    convert_matrix(ffn_w_gate, DFF, 0, D, DFF, norm_ffn, Wgu, 128, 256, 0, scr, cw, CNW, lane_);
                    convert_matrix(ffn_w_up, DFF, 0, D, DFF, norm_ffn, Wgu, 128, 256, 128, scr, cw, CNW, lane_);
                    convert_matrix(ffn_w_down, D, 0, DFF, D, nullptr, Wd, BIG, 0, 0, scr, cw, CNW, lane_);
                } else {
                    for (int e = 0; e < NEXP; ++e) convert_matrix(moe_w_down + (size_t)e * DFFE * D, D, 0, DFFE, D, nullptr, Md + (size_t)e * D * DFFE, BIG, 0, 0, scr, cw, CNW, lane_);
                } } }
        SEAM(ph);
        if (RUN(ph)) { PHL
            for (int r = gw_; r < T; r += NGW) lrub_row(LRU_H, LRU_A, LRU_CARRY, proj, lru_out_norm + l * DLRU, ymix, r, lane_);
            for (int r = gw_; r < T; r += NGW) dn_out_row(c3, dn_out_norm + l * HD, proj, ymix, r, lane_); }
        SEAM(ph);
        if (RUN(ph)) { if (l == 0) { pg8::Gemm g{ymix, Wout, T, D, D, 0}; pg8::StaticOrder S; S.init(T, D, G, bid); pg8::EpiResidualNorm E{xcur, xres, xb, SSQA, D, 0};
            pg8::gemm_phase<pg8::EpiResidualNorm, pg8::StaticOrder, true, false>(lds, g, S, E); }
          else { pg8::Gemm g{ymix, Wout + (size_t)D * D, T, D, D, 0}; pg8::StaticOrder S; S.init(T, D, G, bid); pg8::EpiResidual E{xcur, xres, nullptr, D, 0};
            pg8::gemm_phase<pg8::EpiResidual, pg8::StaticOrder, true, false>(lds, g, S, E); }
            if (l == 1) { PHL
                for (int e = 0; e < NEXP; ++e) {
                    convert_matrix(moe_w_gate + (size_t)e * D * DFFE, DFFE, 0, D, DFFE, norm_ffn + D, Mgu + (size_t)e * 2 * DFFE * D, 128, 256, 0, scr, gw_, NGW, lane_);
                    convert_matrix(moe_w_up + (size_t)e * D * DFFE, DFFE, 0, D, DFFE, norm_ffn + D, Mgu + (size_t)e * 2 * DFFE * D, 128, 256, 128, scr, gw_, NGW, lane_);
 } } }
        SEAM(ph);
        xsel = 1;
        if (l == 0) {
            if (RUN(ph)) { pg8::Gemm g{xb, Wgu, T, 2 * DFF, D, 0}; pg8::StaticOrder S; S.init(T, 2 * DFF, G, bid); pg8::EpiSwiGLU E{hid, SSQA, DFF, 1};
                pg8::gemm_phase<pg8::EpiSwiGLU, pg8::StaticOrder, true, false>(lds, g, S, E); }
            SEAM(ph);
            if (RUN(ph)) { pg8::Gemm g{hid, Wd, T, D, DFF, 0}; pg8::StaticOrder S; S.init(T, D, G, bid); pg8::EpiResidualNorm E{xcur, xres, xb, SSQB, D, 0};
                pg8::gemm_phase<pg8::EpiResidualNorm, pg8::StaticOrder, true, false>(lds, g, S, E); }
            SEAM(ph);
        } else {
            if (RUN(ph)) { PHL for (int blk = bid_; blk < T / 64; blk += G) route_block(xcur, norm_ffn + D, moe_router, xb, rstd, MCNT, MLIST, MLISTW, blk, lds, tid_, lane_, gw_ & 7); }
            SEAM(ph);
            if (RUN(ph)) { pg8::Gemm g{xb, Mgu, NSLOT, 2 * DFFE, D, 0}; MoeOrder S; S.init(MCNT, MLIST, 2 * DFFE / 256, G, bid); pg8::EpiSwiGLUMoe E{hid, rstd, MLIST, DFFE, 0};
                pg8::gemm_phase<pg8::EpiSwiGLUMoe, MoeOrder, true, true>(lds, g, S, E); }
            SEAM(ph);
            if (RUN(ph)) { pg8::Gemm g{hid, Md, NSLOT, D, DFFE, 0}; MoeOrder S; S.init(MCNT, MLIST, D / 256, G, bid); pg8::EpiMoeDown E{YP0, YP1, MLIST, MLISTW, D, 0};
                pg8::gemm_phase<pg8::EpiMoeDown, MoeOrder, true, false>(lds, g, S, E); }
            SEAM(ph);
        }
    }
    if (RUN(ph)) { PHL for (int r = gw_; r < T; r += NGW) final_row_moe(xcur, YP0, YP1, norm_final, xres, r, lane_); }
#if defined(PROBE_MASK)
    __syncthreads(); STAMP();
    if (blockIdx.x == 0 && threadIdx.x == 0) { asm volatile("s_waitcnt vmcnt(0)" ::: "memory"); volatile LAS unsigned long long* st = (volatile LAS unsigned long long*)(lds + LDSCTL_OFF + 1024); unsigned long long tot = 0;
        for (int k = 1; k < nst; ++k) if ((PROBE_MASK >> (k - 1)) & 1ull) tot += st[k] - st[k - 1];
        xres[0] = rintf((float)tot * 0.01f * PROBE_SCALE); }
#endif
#if defined(PROBE_DNA_A)
    __syncthreads();
    if (blockIdx.x == 0 && threadIdx.x == 0) { asm volatile("s_waitcnt vmcnt(0)" ::: "memory"); volatile LAS unsigned long long* st = (volatile LAS unsigned long long*)(lds + (RING_BYTES + 2048));
        xres[0] = rintf((float)(st[PROBE_DNA_B] - st[PROBE_DNA_A]) * 0.01f * PROBE_SCALE); }
#endif
#undef RUN
#undef SEAM
}

extern "C" void kernel_launch(void* const* d_in, const int* in_sizes, int n_in, void* d_out, int out_size, void* d_ws, size_t ws_size, hipStream_t stream) {
    static int grid = 0;
    if (grid == 0) {
        if (n_in != 25 || ws_size < WS_END) { fprintf(stderr, "kernel_launch: unexpected n_in %d / ws_size %zu (need %zu)\n", n_in, ws_size, (size_t)WS_END); grid = -1; return; }
        int dev = 0, cus = 0, per_cu = 0;
        if (hipGetDevice(&dev) != hipSuccess || hipDeviceGetAttribute(&cus, hipDeviceAttributeMultiprocessorCount, dev) != hipSuccess) { grid = -1; return; }
        if (hipFuncSetAttribute((const void*)mega, hipFuncAttributeMaxDynamicSharedMemorySize, LDS_BYTES) != hipSuccess) { fprintf(stderr, "kernel_launch: hipFuncSetAttribute failed\n"); grid = -1; return; }
        if (hipOccupancyMaxActiveBlocksPerMultiprocessor(&per_cu, (const void*)mega, 512, LDS_BYTES) != hipSuccess || per_cu < 1) { fprintf(stderr, "kernel_launch: occupancy query says %d\n", per_cu); }
        (void)hipGetLastError();
        grid = cus;
    }
    if (grid < 0) return;
    if (hipMemsetAsync((char*)d_ws + WS_CTL, 0, CTL_ZERO_BYTES, stream) != hipSuccess) return;
    Args a{};
    for (int i = 0; i < 25; ++i) a.in[i] = (const float*)d_in[i];
    a.out = (float*)d_out; a.ws = (unsigned char*)d_ws; a.ph_lo = 0; a.ph_hi = 1 << 30;
    hipLaunchKernelGGL(mega, dim3(grid), dim3(512), LDS_BYTES, stream, a);
}
```

```cpp
#include <hip/hip_runtime.h>
#include <cstdio>
#include <cstdint>
namespace pg8 {
#define PG8_LAS __attribute__((address_space(3)))
typedef unsigned short bf16_t;
typedef short bf16x8 __attribute__((ext_vector_type(8)));
typedef float f32x4 __attribute__((ext_vector_type(4)));
typedef unsigned u32x4 __attribute__((ext_vector_type(4)));
constexpr int BM = 256, BK = 64, HALF = 128, HTB = HALF * BK * 2  , STAGE_BYTES = 8 * HTB, NXCD = 8, WGM = 8;

__host__ __device__ __forceinline__ int lds_byte(int r, int c) { const int st = (r >> 4) * 2 + (c >> 5), rr = r & 15, cc = c & 31, ob = rr * 64 + cc * 2; return st * 1024 + (ob ^ (((ob >> 9) & 1) << 5)); }
__host__ __device__ __forceinline__ void stage_rc(int b, int& R, int& C) { const int st = b / 1024, sb = b % 1024, swz = sb ^ (((sb >> 9) & 1) << 5); R = (st >> 1) * 16 + swz / 64; C = (st & 1) * 32 + (swz % 64) / 2; }
__host__ __device__ __forceinline__ int perm32(int rho) { const int n = rho >> 4, i = rho & 15; return 8 * (i >> 2) + 4 * n + (i & 3); }

struct Unit { int pm, pn, pb, lbase, nvalid; };
struct Gemm { const bf16_t* A; const bf16_t* Bt; int M, N, K, pad; };

struct StaticOrder {
    int nM, nN, nwg, G, c;
    __host__ __device__ void init(int M, int N, int G_, int c_) { nM = M / BM; nN = N / BM; nwg = nM * nN; G = G_; c = c_; }
    __host__ __device__ bool next(int i, Unit& u) const {
        const long L = (long)i * G + c; if (L >= nwg) return false;
        int wgid = (int)L; { const int q = nwg / NXCD, r = nwg % NXCD, xcd = wgid % NXCD, off = wgid / NXCD; wgid = (xcd < r ? xcd * (q + 1) : r * (q + 1) + (xcd - r) * q) + off; }
        const int nig = WGM * nN, gid = wgid / nig, fm = gid * WGM, gsz = (nM - fm) < WGM ? (nM - fm) : WGM;
        u.pm = fm + ((wgid % nig) % gsz); u.pn = (wgid % nig) / gsz; u.pb = u.pn; u.lbase = 0; u.nvalid = BM; return true;
    }
    __device__ __forceinline__ int arow(const Unit&, int) const { return 0; }
    __device__ __forceinline__ void a_ready(const Unit&) const {}
    __device__ __forceinline__ void done(const Unit&) const {}
};


typedef float f32x2_t __attribute__((ext_vector_type(2)));
typedef __bf16 bf16x2_t __attribute__((ext_vector_type(2)));
__device__ __forceinline__ unsigned cvt_pk_bf16(float lo, float hi) { const f32x2_t v = {lo, hi}; const bf16x2_t b = __builtin_convertvector(v, bf16x2_t); return __builtin_bit_cast(unsigned, b); }
__device__ __forceinline__ float frcp(float x) { return __builtin_amdgcn_rcpf(x); }
__device__ __forceinline__ float rsqrt_f(float x) { return __builtin_amdgcn_rsqf(x); }
__device__ __forceinline__ float silu_f(float x) { return x * frcp(1.0f + __expf(-x)); }
__device__ __forceinline__ float swiglu_f(float g, float u, float k1, float s2) { return (g * u) * (s2 * frcp(1.0f + __builtin_amdgcn_exp2f(g * k1))); }
__device__ __forceinline__ float row_scale(const float* rs, int r, int mode) {
    if (!mode) return rs[r];
    const f32x4* p = (const f32x4*)(rs + (size_t)r * 32); float s = 0.f;
#pragma unroll
    for (int i = 0; i < 8; ++i) { const f32x4 v = p[i]; s += (v[0] + v[1]) + (v[2] + v[3]); }
    return rsqrt_f(s * (1.0f / 2048.0f) + 1e-6f);
}
__device__ __forceinline__ void row_scales8(const float* rs, int row0, int fr, int fq, int mode, float (&sc)[2][4]) {
    if (!mode) {
#pragma unroll
        for (int ai = 0; ai < 2; ++ai)
#pragma unroll
            for (int m = 0; m < 4; ++m) sc[ai][m] = rs[row0 + ai * HALF + m * 16];
    } else {
        const int lane = fr + 16 * fq; f32x4 pa[2][4][2];
#pragma unroll
        for (int ai = 0; ai < 2; ++ai)
#pragma unroll
            for (int m = 0; m < 4; ++m) { const f32x4* p = (const f32x4*)(rs + (size_t)(row0 + ai * HALF + m * 16) * 32 + fq * 8); pa[ai][m][0] = p[0]; pa[ai][m][1] = p[1]; }
#pragma unroll
        for (int ai = 0; ai < 2; ++ai)
#pragma unroll
            for (int m = 0; m < 4; ++m) { const f32x4 a = pa[ai][m][0], b = pa[ai][m][1]; float t = ((a[0] + a[1]) + (a[2] + a[3])) + ((b[0] + b[1]) + (b[2] + b[3]));
                t += __int_as_float(__builtin_amdgcn_ds_bpermute((lane ^ 16) << 2, __float_as_int(t)));
                t += __int_as_float(__builtin_amdgcn_ds_bpermute((lane ^ 32) << 2, __float_as_int(t)));
                sc[ai][m] = rsqrt_f(t * (1.0f / 2048.0f) + 1e-6f); }
    }
}
struct EpiScaleBf16 {
    static constexpr bool PERM = true, AFTER_DRAIN = false;
    bf16_t* O; const float* rs; int ldc; int pad;
    __device__ __forceinline__ void operator()(const f32x4 (&acc)[2][2][4][2], const Unit& u, int wr, int wc, int fr, int fq) const {
        const int row0 = u.pm * BM + wr * 64 + fr, col0 = u.pn * BM + wc * 32 + 8 * fq;
        float sc[2][4]; row_scales8(rs, row0, fr, fq, pad, sc);
#pragma unroll
        for (int ai = 0; ai < 2; ++ai)
#pragma unroll
            for (int m = 0; m < 4; ++m) { const int r = row0 + ai * HALF + m * 16; const float s = sc[ai][m]; bf16_t* rowp = O + (size_t)r * ldc + col0;
#pragma unroll
                for (int bj = 0; bj < 2; ++bj) { const f32x4 v0 = acc[ai][bj][m][0] * s, v1 = acc[ai][bj][m][1] * s;
                    u32x4 w; w.x = cvt_pk_bf16(v0[0], v0[1]); w.y = cvt_pk_bf16(v0[2], v0[3]); w.z = cvt_pk_bf16(v1[0], v1[1]); w.w = cvt_pk_bf16(v1[2], v1[3]);
                    *(u32x4*)(rowp + bj * HALF) = w; } }
    }
};
struct EpiSwiGLU {
    static constexpr bool PERM = true, AFTER_DRAIN = false;
    bf16_t* O; const float* rs; int ldc; int pad;
    __device__ __forceinline__ void operator()(const f32x4 (&acc)[2][2][4][2], const Unit& u, int wr, int wc, int fr, int fq) const {
        const int row0 = u.pm * BM + wr * 64 + fr, col0 = u.pn * HALF + wc * 32 + 8 * fq;
        float sc[2][4]; row_scales8(rs, row0, fr, fq, pad, sc);
#pragma unroll
        for (int ai = 0; ai < 2; ++ai)
#pragma unroll
            for (int m = 0; m < 4; ++m) { const int r = row0 + ai * HALF + m * 16; const float s = sc[ai][m], k1 = s * -1.4426950408889634f, s2 = s * s; bf16_t* rowp = O + (size_t)r * ldc + col0;
                f32x4 h0, h1;
#pragma unroll
                for (int j = 0; j < 4; ++j) { h0[j] = swiglu_f(acc[ai][0][m][0][j], acc[ai][1][m][0][j], k1, s2); h1[j] = swiglu_f(acc[ai][0][m][1][j], acc[ai][1][m][1][j], k1, s2); }
                u32x4 w; w.x = cvt_pk_bf16(h0[0], h0[1]); w.y = cvt_pk_bf16(h0[2], h0[3]); w.z = cvt_pk_bf16(h1[0], h1[1]); w.w = cvt_pk_bf16(h1[2], h1[3]);
                *(u32x4*)rowp = w; }
    }
};
struct EpiResidual {
    static constexpr bool PERM = false, AFTER_DRAIN = false;
    const float* base; float* out; const float* roww; int ldc; int pad;
    __device__ __forceinline__ void operator()(const f32x4 (&acc)[2][2][4][2], const Unit& u, int wr, int wc, int fr, int fq) const {
        const int row0 = u.pm * BM + wr * 64 + fr, col0 = u.pn * BM + wc * 32 + 4 * fq;
#pragma unroll
        for (int ai = 0; ai < 2; ++ai)
#pragma unroll
            for (int m = 0; m < 4; ++m) { const int r = row0 + ai * HALF + m * 16; const float w = roww ? roww[r] : 1.0f; const size_t off = (size_t)r * ldc + col0;
#pragma unroll
                for (int bj = 0; bj < 2; ++bj)
#pragma unroll
                    for (int n = 0; n < 2; ++n) { const f32x4 bs = *(const f32x4*)(base + off + bj * HALF + n * 16); *(f32x4*)(out + off + bj * HALF + n * 16) = bs + acc[ai][bj][m][n] * w; } }
    }
};

struct EpiSwiGLUMoe {
    static constexpr bool PERM = true, AFTER_DRAIN = false;
    bf16_t* O; const float* rs; const int* list; int ldc; int pad;
    __device__ __forceinline__ void operator()(const f32x4 (&acc)[2][2][4][2], const Unit& u, int wr, int wc, int fr, int fq) const {
        const int rl0 = wr * 64 + fr, col0 = u.pn * HALF + wc * 32 + 8 * fq;
#pragma unroll
        for (int ai = 0; ai < 2; ++ai)
#pragma unroll
            for (int m = 0; m < 4; ++m) { const int rl = rl0 + ai * HALF + m * 16; const int tok = rl < u.nvalid ? (list[u.lbase + rl] & 0xffff) : 0; const float s = rs[tok], k1 = s * -1.4426950408889634f, s2 = s * s;
                bf16_t* rowp = O + (size_t)(u.pm * BM + rl) * ldc + col0;
                f32x4 h0, h1;
#pragma unroll
                for (int j = 0; j < 4; ++j) { h0[j] = swiglu_f(acc[ai][0][m][0][j], acc[ai][1][m][0][j], k1, s2); h1[j] = swiglu_f(acc[ai][0][m][1][j], acc[ai][1][m][1][j], k1, s2); }
                u32x4 w; w.x = cvt_pk_bf16(h0[0], h0[1]); w.y = cvt_pk_bf16(h0[2], h0[3]); w.z = cvt_pk_bf16(h1[0], h1[1]); w.w = cvt_pk_bf16(h1[2], h1[3]);
                *(u32x4*)rowp = w; }
    }
};
struct EpiMoeDown {
    static constexpr bool PERM = true, AFTER_DRAIN = false;
    bf16_t* Y0; bf16_t* Y1; const int* list; const float* lw; int ldc; int pad;
    __device__ __forceinline__ void operator()(const f32x4 (&acc)[2][2][4][2], const Unit& u, int wr, int wc, int fr, int fq) const {
        const int rl0 = wr * 64 + fr, col0 = u.pn * BM + wc * 32 + 8 * fq;
#pragma unroll
        for (int ai = 0; ai < 2; ++ai)
#pragma unroll
            for (int m = 0; m < 4; ++m) { const int rl = rl0 + ai * HALF + m * 16;
                if (rl < u.nvalid) { const int en = list[u.lbase + rl]; const float w = lw[u.lbase + rl]; bf16_t* rowp = ((en >> 16) ? Y1 : Y0) + (size_t)(en & 0xffff) * ldc + col0;
#pragma unroll
                    for (int bj = 0; bj < 2; ++bj) { const f32x4 v0 = acc[ai][bj][m][0] * w, v1 = acc[ai][bj][m][1] * w;
                        u32x4 o; o.x = cvt_pk_bf16(v0[0], v0[1]); o.y = cvt_pk_bf16(v0[2], v0[3]); o.z = cvt_pk_bf16(v1[0], v1[1]); o.w = cvt_pk_bf16(v1[2], v1[3]);
                        *(u32x4*)(rowp + bj * HALF) = o; } } }
    }
};

struct EpiResidualNorm {
    static constexpr bool PERM = true, AFTER_DRAIN = false;
    const float* base; float* out; bf16_t* xb; float* ssq; int ldc; int pad;
    __device__ __forceinline__ void operator()(const f32x4 (&acc)[2][2][4][2], const Unit& u, int wr, int wc, int fr, int fq) const {
        const int row0 = u.pm * BM + wr * 64 + fr, col0 = u.pn * BM + wc * 32 + 8 * fq, lane = fr + 16 * fq;
#pragma unroll
        for (int ai = 0; ai < 2; ++ai)
#pragma unroll
            for (int m = 0; m < 4; ++m) { const int r = row0 + ai * HALF + m * 16; const size_t off = (size_t)r * ldc + col0; float part = 0.f;
#pragma unroll
                for (int bj = 0; bj < 2; ++bj) { const f32x4 b0 = *(const f32x4*)(base + off + bj * HALF), b1 = *(const f32x4*)(base + off + bj * HALF + 4);
                    const f32x4 v0 = b0 + acc[ai][bj][m][0], v1 = b1 + acc[ai][bj][m][1];
                    *(f32x4*)(out + off + bj * HALF) = v0; *(f32x4*)(out + off + bj * HALF + 4) = v1;
                    u32x4 w; w.x = cvt_pk_bf16(v0[0], v0[1]); w.y = cvt_pk_bf16(v0[2], v0[3]); w.z = cvt_pk_bf16(v1[0], v1[1]); w.w = cvt_pk_bf16(v1[2], v1[3]);
                    *(u32x4*)(xb + off + bj * HALF) = w;
                    part += (v0[0] * v0[0] + v0[1] * v0[1]) + (v0[2] * v0[2] + v0[3] * v0[3]) + (v1[0] * v1[0] + v1[1] * v1[1]) + (v1[2] * v1[2] + v1[3] * v1[3]); }
                part += __int_as_float(__builtin_amdgcn_ds_bpermute((lane ^ 16) << 2, __float_as_int(part)));
                part += __int_as_float(__builtin_amdgcn_ds_bpermute((lane ^ 32) << 2, __float_as_int(part)));
                if (fq == 0) ssq[(size_t)r * 32 + u.pn * 4 + wc] = part; }
    }
};
template <class Epi, class Sched, bool ALIGN_EPI = false, bool GATHER = false>
__device__ __forceinline__ void gemm_phase(PG8_LAS unsigned char* lds, const Gemm g, const Sched& S, const Epi& E) {
    int tid_o = threadIdx.x; asm volatile("" : "+v"(tid_o));
    const int tid = tid_o, wid = __builtin_amdgcn_readfirstlane(tid >> 6), lane = tid & 63, wr = wid >> 2, wc = wid & 3, fr = lane & 15, fq = lane >> 4;
    const int K = g.K, nt = K / BK;
    const size_t kstep = (size_t)(BK * 2);
    const size_t hstep = (size_t)HALF * K * 2;
    const size_t tstep = 2 * hstep;
    unsigned voffA[2], voffB[2], oA[2][2], oN[2][2];
#pragma unroll
    for (int i = 0; i < 2; ++i) { int R, C; stage_rc(tid * 16 + i * 8192, R, C); const int Rb = Epi::PERM ? ((R & ~31) + perm32(R & 31)) : R; voffA[i] = (unsigned)(R * K + C) * 2u; voffB[i] = (unsigned)(Rb * K + C) * 2u; }
    const unsigned ldsw = (unsigned)wid * 1024u;
    const int aoff = lds_byte(wr * 64 + fr, fq * 8), boff = lds_byte(wc * 32 + fr, fq * 8);
#define PG8_SA(b, h) (((b) * 2 + (h)) * HTB)
#define PG8_SB(b, h) ((4 + (b) * 2 + (h)) * HTB)
#define PG8_STAGE(bufoff, gbase, voff) do { _Pragma("unroll") for (int _i = 0; _i < 2; ++_i) \
        __builtin_amdgcn_global_load_lds((const unsigned*)((const char*)(gbase) + (voff)[_i]), (PG8_LAS unsigned*)(lds + (bufoff) + ldsw + _i * 8192), 16, 0, 0); } while (0)
#define PG8_LDA(dst, b, h) do { _Pragma("unroll") for (int m = 0; m < 4; ++m) _Pragma("unroll") for (int k = 0; k < 2; ++k) dst[m][k] = *(const PG8_LAS bf16x8*)(lds + PG8_SA(b, h) + aoff + m * 2048 + k * 1024); } while (0)
#define PG8_LDB(dst, b, h) do { _Pragma("unroll") for (int n = 0; n < 2; ++n) _Pragma("unroll") for (int k = 0; k < 2; ++k) dst[n][k] = *(const PG8_LAS bf16x8*)(lds + PG8_SB(b, h) + boff + n * 2048 + k * 1024); } while (0)
#define PG8_MMA(ai, bj, At, Bt) do { __builtin_amdgcn_s_setprio(1); _Pragma("unroll") for (int m = 0; m < 4; ++m) _Pragma("unroll") for (int n = 0; n < 2; ++n) _Pragma("unroll") for (int k = 0; k < 2; ++k) \
        acc[ai][bj][m][n] = __builtin_amdgcn_mfma_f32_16x16x32_bf16(Bt[n][k], At[m][k], acc[ai][bj][m][n], 0, 0, 0); __builtin_amdgcn_s_setprio(0); } while (0)
#define PG8_WAIT_V(n) asm volatile("s_waitcnt vmcnt(" #n ")" ::: "memory")
#define PG8_WAIT_L(n) asm volatile("s_waitcnt lgkmcnt(" #n ")" ::: "memory")
#define PG8_BAR __builtin_amdgcn_s_barrier()
#define PG8_SCHED __builtin_amdgcn_sched_barrier(0)
#define PG8_AOFF(dst, u) do { _Pragma("unroll") for (int _i = 0; _i < 2; ++_i) { int _R, _C; stage_rc(tid * 16 + _i * 8192, _R, _C); _Pragma("unroll") for (int _h = 0; _h < 2; ++_h) \
        dst[_h][_i] = (unsigned)(S.arow(u, _h * HALF + _R) * K + _C) * 2u; } } while (0)
#define PG8_STAGE_A(bufoff, gbase, h, usenext) do { _Pragma("unroll") for (int _i = 0; _i < 2; ++_i) { const unsigned _o = GATHER ? ((usenext) ? oN[h][_i] : oA[h][_i]) : voffA[_i]; \
        __builtin_amdgcn_global_load_lds((const unsigned*)((const char*)(gbase) + (GATHER ? (size_t)0 : (size_t)(h) * hstep) + _o), (PG8_LAS unsigned*)(lds + (bufoff) + ldsw + _i * 8192), 16, 0, 0); } } while (0)
    Unit cur, nxt; int ui = 0;
    if (!S.next(0, cur)) return;
    f32x4 acc[2][2][4][2];
#pragma unroll
    for (int a = 0; a < 2; ++a)
#pragma unroll
        for (int b = 0; b < 2; ++b)
#pragma unroll
            for (int m = 0; m < 4; ++m)
#pragma unroll
                for (int n = 0; n < 2; ++n) acc[a][b][m][n] = (f32x4){0.f, 0.f, 0.f, 0.f};
    bf16x8 At[4][2], B0[2][2], B1[2][2];
    const char* cA = (const char*)g.A + (GATHER ? (size_t)0 : (size_t)cur.pm * tstep); const char* cB = (const char*)g.Bt + (size_t)cur.pb * tstep;
    S.a_ready(cur);
    if constexpr (GATHER) { PG8_AOFF(oA, cur); PG8_WAIT_V(0); }
    PG8_STAGE(PG8_SB(0, 0), cB, voffB); PG8_STAGE(PG8_SB(0, 1), cB + hstep, voffB); PG8_STAGE_A(PG8_SA(0, 0), cA, 0, false); PG8_STAGE_A(PG8_SA(0, 1), cA, 1, false);
    if (wr == 1) PG8_BAR;
    PG8_WAIT_V(2); PG8_BAR;
    PG8_STAGE(PG8_SB(1, 0), cB + kstep, voffB); PG8_STAGE_A(PG8_SA(1, 0), cA + kstep, 0, false); PG8_STAGE(PG8_SB(1, 1), cB + hstep + kstep, voffB);
    PG8_WAIT_V(6); PG8_BAR;
    for (;;) {
        const bool has_next = S.next(ui + 1, nxt);
        const char* nA = has_next ? (const char*)g.A + (GATHER ? (size_t)0 : (size_t)nxt.pm * tstep) : cA; const char* nB = has_next ? (const char*)g.Bt + (size_t)nxt.pb * tstep : cB;
        if constexpr (GATHER) { if (has_next) { PG8_AOFF(oN, nxt); } else {
#pragma unroll
            for (int _h = 0; _h < 2; ++_h) { oN[_h][0] = oA[_h][0]; oN[_h][1] = oA[_h][1]; } } }
        for (int t = 0; t < nt; t += 2) {
            const bool last = (t == nt - 2);
            const char* a1 = cA + (size_t)(t + 1) * kstep;
            const char* a2 = last ? nA : cA + (size_t)(t + 2) * kstep; const char* b2 = last ? nB : cB + (size_t)(t + 2) * kstep;
            const char* a3 = a2 + kstep; const char* b3 = b2 + kstep;
            if (last && has_next) S.a_ready(nxt);
            PG8_LDB(B0, 0, 0); PG8_LDB(B1, 0, 1); PG8_SCHED; PG8_LDA(At, 0, 0); PG8_STAGE_A(PG8_SA(1, 1), a1, 1, false);
            PG8_WAIT_V(8); PG8_WAIT_L(0); PG8_BAR; PG8_MMA(0, 0, At, B0); PG8_MMA(0, 1, At, B1); PG8_BAR; PG8_SCHED;
            PG8_LDA(At, 0, 1); PG8_STAGE(PG8_SB(0, 0), b2, voffB); PG8_STAGE(PG8_SB(0, 1), b2 + hstep, voffB); PG8_STAGE_A(PG8_SA(0, 0), a2, 0, last);
            PG8_WAIT_V(8); PG8_WAIT_L(0); PG8_BAR; PG8_MMA(1, 0, At, B0); PG8_MMA(1, 1, At, B1); PG8_BAR; PG8_SCHED;
            PG8_LDB(B0, 1, 0); PG8_LDB(B1, 1, 1); PG8_SCHED; PG8_LDA(At, 1, 0); PG8_STAGE_A(PG8_SA(0, 1), a2, 1, last);
            PG8_WAIT_V(8); PG8_WAIT_L(0); PG8_BAR; PG8_MMA(0, 0, At, B0); PG8_MMA(0, 1, At, B1); PG8_BAR; PG8_SCHED;
            PG8_LDA(At, 1, 1); PG8_STAGE(PG8_SB(1, 0), b3, voffB); PG8_STAGE(PG8_SB(1, 1), b3 + hstep, voffB); PG8_STAGE_A(PG8_SA(1, 0), a3, 0, last);
            PG8_WAIT_V(8); PG8_WAIT_L(0); PG8_BAR; PG8_MMA(1, 0, At, B0); PG8_MMA(1, 1, At, B1); PG8_BAR; PG8_SCHED;
        }
        if constexpr (ALIGN_EPI) { if (wr == 0) PG8_BAR; }
        E(acc, cur, wr, wc, fr, fq); S.done(cur);
        if (!has_next) break;
#pragma unroll
        for (int a = 0; a < 2; ++a)
#pragma unroll
            for (int b = 0; b < 2; ++b)
#pragma unroll
                for (int m = 0; m < 4; ++m)
#pragma unroll
                    for (int n = 0; n < 2; ++n) acc[a][b][m][n] = (f32x4){0.f, 0.f, 0.f, 0.f};
        cur = nxt; cA = nA; cB = nB; ++ui;
        if constexpr (GATHER) {
#pragma unroll
            for (int _h = 0; _h < 2; ++_h) { oA[_h][0] = oN[_h][0]; oA[_h][1] = oN[_h][1]; } }
        if constexpr (ALIGN_EPI) { if (wr == 1) PG8_BAR; }
    }
    PG8_WAIT_V(0);
    if constexpr (!ALIGN_EPI) { if (wr == 0) PG8_BAR; }
    PG8_BAR;
#undef PG8_SA
#undef PG8_SB
#undef PG8_STAGE
#undef PG8_LDA
#undef PG8_LDB
#undef PG8_MMA
#undef PG8_WAIT_V
#undef PG8_WAIT_L
#undef PG8_BAR
#undef PG8_SCHED
#undef PG8_AOFF
#undef PG8_STAGE_A
}
}

#define GAS __attribute__((address_space(1)))
#define LAS __attribute__((address_space(3)))
#define XB_TMO      128
#define XB_XCNT(j)  (256  + 64 * (j))
#define XB_XSUB(j)  (1280 + 64 * (j))
#define XB_XGEN(j)  (2304 + 64 * (j))
#define XB_TOP      3328
#define XB_TOPGEN   3392
#define XCD_BAR_WORDS 3456
#define XB_SPIN_CAP (1u << 23)

__device__ __forceinline__ unsigned xb_ld(unsigned* p)              { return __hip_atomic_load(p, __ATOMIC_RELAXED, __HIP_MEMORY_SCOPE_AGENT); }
__device__ __forceinline__ unsigned xb_add(unsigned* p, unsigned v) { return __hip_atomic_fetch_add(p, v, __ATOMIC_RELAXED, __HIP_MEMORY_SCOPE_AGENT); }
__device__ __forceinline__ unsigned xb_xcc_id() { return (unsigned)__builtin_amdgcn_s_getreg((3 << 11) | 20) & 0xFu; }
#define XB_SPIN(cond, bar) do { unsigned _sp = 0; while (cond) { __builtin_amdgcn_s_sleep(1); \
    if ((++_sp & 255u) == 0u) { if (xb_ld(&(bar)[XB_TMO])) break; if (_sp > XB_SPIN_CAP) { atomicAdd(&(bar)[XB_TMO], 1u); break; } } } } while (0)

struct XcdBarrier {
    unsigned* bar; unsigned x;
    volatile LAS unsigned* st;
};

__device__ __forceinline__ XcdBarrier xcd_barrier_post(unsigned* bar, volatile LAS unsigned* st) {
    XcdBarrier b; b.bar = bar; b.x = xb_xcc_id(); b.st = st;
    if (threadIdx.x == 0) (void)xb_add(&bar[XB_XCNT(b.x)], 1u);
    return b;
}
__device__ __forceinline__ void xcd_barrier_complete(unsigned* bar, unsigned x, unsigned& nloc, unsigned& nx) {
    const unsigned G = gridDim.x * gridDim.y * gridDim.z;
    unsigned sum, cnt, mine, sp = 0u;
    for (;;) {
        sum = 0u; cnt = 0u; mine = 0u;
#pragma unroll
        for (unsigned j = 0; j < 16; ++j) { const unsigned c = xb_ld(&bar[XB_XCNT(j)]); sum += c; cnt += (c > 0u) ? 1u : 0u; mine = (j == x) ? c : mine; }
        if (sum == G) break;
        __builtin_amdgcn_s_sleep(1);
        if ((++sp & 255u) == 0u) { if (xb_ld(&bar[XB_TMO])) break; if (sp > XB_SPIN_CAP) { atomicAdd(&bar[XB_TMO], 1u); break; } }
    }
    nloc = mine > 0u ? mine : 1u; nx = cnt > 0u ? cnt : 1u;
}

__device__ __forceinline__ void xcd_barrier(const XcdBarrier& b) {
    asm volatile("s_waitcnt vmcnt(0)" ::: "memory");
    __syncthreads();
    if (threadIdx.x == 0) {
        unsigned* bar = b.bar; asm volatile("" : "+s"(bar));
        __builtin_amdgcn_s_waitcnt(0);
        unsigned nloc = b.st[0], nx = b.st[1];
        if (nloc == 0u) { xcd_barrier_complete(bar, b.x, nloc, nx); b.st[0] = nloc; b.st[1] = nx; }
        const unsigned old = xb_add(&bar[XB_XSUB(b.x)], 1u);
        const unsigned gen = old / nloc;
        if (old + 1u == (gen + 1u) * nloc) {
            __builtin_amdgcn_fence(__ATOMIC_RELEASE, "agent");
            asm volatile("s_waitcnt vmcnt(0)" ::: "memory");
            const unsigned og = xb_add(&bar[XB_TOP], 1u);
            const unsigned tg = og / nx;
            if (og + 1u == (tg + 1u) * nx) xb_add(&bar[XB_TOPGEN], 1u);
            else XB_SPIN(xb_ld(&bar[XB_TOPGEN]) == tg, bar);
            __builtin_amdgcn_fence(__ATOMIC_ACQUIRE, "agent");
            xb_add(&bar[XB_XGEN(b.x)], 1u);
            asm volatile("s_waitcnt vmcnt(0)" ::: "memory");
        } else {
            XB_SPIN(xb_ld(&bar[XB_XGEN(b.x)]) == gen, bar);
            __builtin_amdgcn_fence(__ATOMIC_ACQUIRE, "agent");
            asm volatile("s_waitcnt vmcnt(0)" ::: "memory");
        }
    }
    __syncthreads();
}

constexpr int T = 16384, SEQ = 8192, D = 2048, DLRU = 1024, DDN = 1024, NH = 8, HD = 128, NPROJ = 6144, DIN = 6160;
constexpr int DFF = 6144, NEXP = 8, DFFE = 3072;
constexpr float EPS = 1e-6f;
typedef unsigned short bf16;
typedef float f32x4 __attribute__((ext_vector_type(4)));
typedef unsigned u32x4 __attribute__((ext_vector_type(4)));
typedef unsigned u32x2 __attribute__((ext_vector_type(2)));
#define LDS_WAIT() asm volatile("s_waitcnt lgkmcnt(0)" ::: "memory")
#define LDS_BARRIER() do { asm volatile("s_waitcnt lgkmcnt(0)" ::: "memory"); __builtin_amdgcn_s_barrier(); asm volatile("" ::: "memory"); } while (0)

__device__ __forceinline__ float bf2f(bf16 b) { return __uint_as_float(((unsigned)b) << 16); }
__device__ __forceinline__ unsigned f2bf(float f) { return pg8::cvt_pk_bf16(f, f) & 0xffffu; }
__device__ __forceinline__ unsigned pk2(float lo, float hi) { return pg8::cvt_pk_bf16(lo, hi); }
__device__ __forceinline__ float shfl_xor_l(float v, int o, int lane) { return __int_as_float(__builtin_amdgcn_ds_bpermute((lane ^ o) << 2, __float_as_int(v))); }
__device__ __forceinline__ float shfl_up_l(float v, int d, int lane) { return __int_as_float(__builtin_amdgcn_ds_bpermute((lane - d) << 2, __float_as_int(v))); }
__device__ __forceinline__ float shfl_idx_l(float v, int src) { return __int_as_float(__builtin_amdgcn_ds_bpermute(src << 2, __float_as_int(v))); }
__device__ __forceinline__ float wave_sum(float v, int lane) {
#pragma unroll
    for (int o = 1; o < 64; o <<= 1) v += shfl_xor_l(v, o, lane);
    return v;
}
using pg8::silu_f;
using pg8::frcp; using pg8::rsqrt_f;
__device__ __forceinline__ float sigmoid_f(float x) { return frcp(1.0f + __expf(-x)); }
__device__ __forceinline__ float softplus_f(float x) { return fmaxf(x, 0.0f) + log1pf(__expf(-fabsf(x))); }
__device__ __forceinline__ float gelu_tanh_f(float x) { const float u = 0.7978845608028654f * (x + 0.044715f * x * x * x); return x * frcp(1.0f + __expf(-2.0f * u)); }

constexpr size_t MiB = 1u << 20;
constexpr size_t al(size_t x) { return (x + MiB - 1) / MiB * MiB; }
constexpr size_t WS_CTL = 0, CTL_ZERO_BYTES = 1 * MiB;
constexpr int CW_BAR = 4096, CW_CNT = 8192;
constexpr size_t WS_WGU = 1 * MiB;
constexpr size_t WS_WD = WS_WGU + al((size_t)2 * DFF * D * 2);
constexpr size_t WS_WIN = WS_WD + al((size_t)D * DFF * 2);
constexpr size_t WS_WBA = WS_WIN + al((size_t)2 * NPROJ * D * 2);
constexpr size_t WS_WOUT = WS_WBA + al((size_t)2 * 16 * D * 4 + 2 * 16 * D * 2);
static_assert(WS_WIN + (size_t)NPROJ * D * 2 - WS_WGU >= (size_t)NEXP * D * DFFE * 2, "MoE down weights overlay");
constexpr size_t WS_XB = WS_WOUT + al((size_t)2 * D * D * 2);
constexpr size_t WS_RSTD = WS_XB + al((size_t)T * D * 2);
constexpr size_t WS_BA = WS_RSTD + 5 * MiB;
constexpr size_t WS_BETA = WS_BA + al((size_t)T * 16 * 4);
constexpr size_t WS_G = WS_BETA + al((size_t)T * 8 * 4);
constexpr size_t WS_ROWW = WS_G + al((size_t)T * 8 * 4);
constexpr int NSLOT = 2 * T + NEXP * 256;
constexpr size_t WS_PROJ = WS_ROWW + al((size_t)2 * 8 * T * 4);
constexpr size_t WS_YMIX = WS_PROJ + al((size_t)NSLOT * DFFE * 2);
constexpr size_t WS_MG0 = WS_YMIX + al((size_t)T * D * 2);
constexpr size_t WS_C = WS_MG0 + (size_t)96 * MiB;
constexpr size_t WS_WRT = WS_C + (size_t)388 * MiB;
constexpr size_t WS_END = WS_WRT + 1 * MiB;
static_assert(WS_END <= (size_t)975 * MiB, "d_ws map exceeds the guaranteed workspace");
static_assert((size_t)4 * 2 * DFFE * D * 2 == (size_t)96 * MiB, "experts 0-3 fill the region in front of the mixer scratch exactly");
constexpr int RING_BYTES = 131072, LDSCTL_OFF = RING_BYTES, MISC_OFF = LDSCTL_OFF + 320, LDS_BYTES = 147456;

__device__ __forceinline__ void transpose_item(const float* W, int ldw, int col_off, int K, int nblk, const float* gain, bf16* WT, int blk, int blk_stride, int row_off, int item, int lane) {
    const int kb = item / nblk, nb = item % nblk, k0 = 64 * kb + (lane >> 4) * 16, n0 = 64 * nb + (lane & 15) * 4;
    const float* src = W + (size_t)k0 * ldw + col_off + n0;
    f32x4 v[16];
#pragma unroll
    for (int j = 0; j < 16; ++j) v[j] = __builtin_nontemporal_load((const f32x4*)(src + (size_t)j * ldw));
    if (gain) {
#pragma unroll
        for (int q = 0; q < 4; ++q) { const f32x4 g = *(const f32x4*)(gain + k0 + 4 * q);
#pragma unroll
            for (int c = 0; c < 4; ++c) v[4 * q + c] = v[4 * q + c] * g[c]; }
    }
#pragma unroll
    for (int i = 0; i < 4; ++i) { const int n = n0 + i, drow = (n / blk) * blk_stride + (n % blk) + row_off;
        u32x4 o0, o1;
        o0.x = pk2(v[0][i], v[1][i]); o0.y = pk2(v[2][i], v[3][i]); o0.z = pk2(v[4][i], v[5][i]); o0.w = pk2(v[6][i], v[7][i]);
        o1.x = pk2(v[8][i], v[9][i]); o1.y = pk2(v[10][i], v[11][i]); o1.z = pk2(v[12][i], v[13][i]); o1.w = pk2(v[14][i], v[15][i]);
        u32x4* dst = (u32x4*)(WT + (size_t)drow * K + k0); dst[0] = o0; dst[1] = o1; }
}
__device__ __forceinline__ void convert_matrix(const float* W, int ldw, int col_off, int K, int N, const float* gain, bf16* WT, int blk, int blk_stride, int row_off, LAS float* scr, int gw, int NGW, int lane) {
    const int nblk = N / 64, nitems = (K / 64) * nblk; (void)scr;
    for (int it = gw; it < nitems; it += NGW) transpose_item(W, ldw, col_off, K, nblk, gain, WT, blk, blk_stride, row_off, it, lane);
}
__device__ __forceinline__ void rowprep_row(const float* x, bf16* xb, float* rstd, const float* Wba, float* ba, int row, int lane) {
    const f32x4* xr = (const f32x4*)(x + (size_t)row * D) + lane;
    f32x4 v[8]; float ss = 0.f;
#pragma unroll
    for (int j = 0; j < 8; ++j) { v[j] = xr[64 * j]; ss += (v[j][0] * v[j][0] + v[j][1] * v[j][1]) + (v[j][2] * v[j][2] + v[j][3] * v[j][3]); }
    ss = wave_sum(ss, lane);
    const float rs = rsqrt_f(ss * (1.0f / D) + EPS);
    u32x2* o = (u32x2*)(xb + (size_t)row * D) + lane;
#pragma unroll
    for (int j = 0; j < 8; ++j) { u32x2 w; w.x = pk2(v[j][0], v[j][1]); w.y = pk2(v[j][2], v[j][3]); o[64 * j] = w; }
    if (lane == 0) rstd[row] = rs;
    if (Wba) {
        for (int c = 0; c < 16; ++c) { const f32x4* wr = (const f32x4*)(Wba + (size_t)c * D) + lane; float a = 0.f;
#pragma unroll
            for (int j = 0; j < 8; ++j) { const f32x4 w = wr[64 * j]; a += (v[j][0] * w[0] + v[j][1] * w[1]) + (v[j][2] * w[2] + v[j][3] * w[3]); }
            a = wave_sum(a, lane); if (lane == 0) ba[(size_t)row * 16 + c] = a * rs; }
    }
}
__device__ __forceinline__ void lru_conv_elem(const bf16* proj, const float* cw, const float* cb, float* xc, size_t idx) {
    const int t = (int)(idx / DLRU), ch = (int)(idx % DLRU), s = t % SEQ;
    float a = cb[ch];
#pragma unroll
    for (int k = 0; k < 4; ++k) { const int sp = s - 3 + k; if (sp >= 0) a += cw[k * DLRU + ch] * bf2f(proj[(size_t)(t - 3 + k) * NPROJ + ch]); }
    xc[idx] = a;
}
__device__ __forceinline__ void lru_gate_elem(const float* xc, const float* w_r, const float* b_r, const float* w_i, const float* b_i, const float* lam, float* av, float* bv, size_t idx) {
    const int t = (int)(idx / DLRU), ch = (int)(idx % DLRU), n = ch >> 7, d = ch & 127;
    float ar = b_r[ch], ai = b_i[ch];
    const float* xr = xc + (size_t)t * DLRU + n * 128; const float* wr = w_r + (size_t)n * 128 * 128 + d; const float* wi = w_i + (size_t)n * 128 * 128 + d;
    for (int c = 0; c < 128; ++c) { const float xv = xr[c]; ar += xv * wr[c * 128]; ai += xv * wi[c * 128]; }
    const float r = sigmoid_f(ar), ig = sigmoid_f(ai);
    const float log_a = -8.0f * r * softplus_f(-lam[ch]);
    const float a = expf(log_a), mult = sqrtf(-expm1f(2.0f * log_a));
    av[idx] = a; bv[idx] = mult * (ig * xc[idx]);
}
__device__ __forceinline__ void lru_scan_chan(float* av, const float* bv, const bf16* proj, int idx) {
    const int b = idx / DLRU, ch = idx % DLRU;
    float h = 0.f;
    for (int s0 = 0; s0 < SEQ; s0 += 8) {
        float a8[8], b8[8], g8[8];
#pragma unroll
        for (int j = 0; j < 8; ++j) { const size_t t = (size_t)b * SEQ + s0 + j; a8[j] = av[t * DLRU + ch]; b8[j] = bv[t * DLRU + ch]; g8[j] = bf2f(proj[t * NPROJ + DLRU + ch]); }
#pragma unroll
        for (int j = 0; j < 8; ++j) { const size_t t = (size_t)b * SEQ + s0 + j; h = a8[j] * h + b8[j]; av[t * DLRU + ch] = h * gelu_tanh_f(g8[j]); }
    }
}
__device__ __forceinline__ void lru_norm_row(const float* y, const float* gain, bf16* ymix, int row, int lane) {
    const f32x4* yr = (const f32x4*)(y + (size_t)row * DLRU) + lane; const f32x4* gr = (const f32x4*)gain + lane;
    f32x4 v[4]; float ss = 0.f;
#pragma unroll
    for (int j = 0; j < 4; ++j) { v[j] = yr[64 * j]; ss += (v[j][0] * v[j][0] + v[j][1] * v[j][1]) + (v[j][2] * v[j][2] + v[j][3] * v[j][3]); }
    ss = wave_sum(ss, lane); const float rs = rsqrt_f(ss * (1.0f / DLRU) + EPS);
    u32x2* o = (u32x2*)(ymix + (size_t)row * D) + lane;
#pragma unroll
    for (int j = 0; j < 4; ++j) { const f32x4 g = gr[64 * j]; u32x2 w; w.x = pk2(v[j][0] * rs * g[0], v[j][1] * rs * g[1]); w.y = pk2(v[j][2] * rs * g[2], v[j][3] * rs * g[3]); o[64 * j] = w; }
}
__device__ __forceinline__ void dn_prep_item(const bf16* proj, const float* cw, const float* ba, const float* a_log, const float* dt_bias, float* qn, float* kn, float* vn, float* beta, float* gg, int w, int lane) {
    const int t = w >> 3, h = w & 7, s = t % SEQ;
    float val[3][2];
#pragma unroll
    for (int p = 0; p < 3; ++p)
#pragma unroll
        for (int e = 0; e < 2; ++e) { const int d = lane * 2 + e, c = p * DDN + h * HD + d; float a = 0.f;
#pragma unroll
            for (int k = 0; k < 4; ++k) { const int sp = s - 3 + k; if (sp >= 0) a += cw[k * 3 * DDN + c] * bf2f(proj[(size_t)(t - 3 + k) * NPROJ + 2048 + c]); }
            val[p][e] = silu_f(a); }
    const float sq = wave_sum(val[0][0] * val[0][0] + val[0][1] * val[0][1], lane), sk = wave_sum(val[1][0] * val[1][0] + val[1][1] * val[1][1], lane);
    const float rq = rsqrt_f(sq + EPS) * 0.08838834764831845f, rk = rsqrt_f(sk + EPS);
    const size_t o = ((size_t)t * NH + h) * HD + lane * 2;
    qn[o] = val[0][0] * rq; qn[o + 1] = val[0][1] * rq; kn[o] = val[1][0] * rk; kn[o + 1] = val[1][1] * rk; vn[o] = val[2][0]; vn[o + 1] = val[2][1];
    if (lane == 0) { beta[t * NH + h] = sigmoid_f(ba[(size_t)t * 16 + h]); gg[t * NH + h] = -__expf(a_log[h]) * softplus_f(ba[(size_t)t * 16 + 8 + h] + dt_bias[h]); }
}
__device__ __forceinline__ void dn_rec_seq(const float* qn, const float* kn, const float* vn, const float* beta, const float* gg, float* o, int bh, LAS float* sk, LAS float* sq, LAS float* st, int tid) {
    const int b = bh >> 3, h = bh & 7, j = tid & 127; const bool act = tid < 128;
    if (act) for (int k = 0; k < 128; ++k) st[k * 128 + j] = 0.f;
    const size_t base = ((size_t)(b * SEQ) * NH + h) * HD;
    float nk = kn[base + j], nq = qn[base + j], nv = vn[base + j], nb = beta[(b * SEQ) * NH + h], ng = gg[(b * SEQ) * NH + h];
    for (int s = 0; s < SEQ; ++s) {
        const int buf = (s & 1) * 128;
        if (act) { sk[buf + j] = nk; sq[buf + j] = nq; }
        const float vj = nv, be = nb, ge = __expf(ng);
        __syncthreads();
        if (act) {
            if (s + 1 < SEQ) { const size_t nb_ = ((size_t)(b * SEQ + s + 1) * NH + h) * HD; nk = kn[nb_ + j]; nq = qn[nb_ + j]; nv = vn[nb_ + j]; nb = beta[(b * SEQ + s + 1) * NH + h]; ng = gg[(b * SEQ + s + 1) * NH + h]; }
            float ks = 0.f;
#pragma unroll 8
            for (int k = 0; k < 128; ++k) ks += sk[buf + k] * st[k * 128 + j];
            const float vnew = be * (vj - ge * ks);
            float oo = 0.f;
#pragma unroll 8
            for (int k = 0; k < 128; ++k) { const float sv = ge * st[k * 128 + j] + sk[buf + k] * vnew; st[k * 128 + j] = sv; oo += sq[buf + k] * sv; }
            o[((size_t)(b * SEQ + s) * NH + h) * HD + j] = oo;
        }
    }
    __syncthreads();
}
typedef short bf16x8 __attribute__((ext_vector_type(8)));
__device__ __forceinline__ f32x4 mfma16(bf16x8 a, bf16x8 b, f32x4 c) { return __builtin_amdgcn_mfma_f32_16x16x32_bf16(a, b, c, 0, 0, 0); }
__device__ __forceinline__ float bflo(unsigned x) { return __uint_as_float(x << 16); }
__device__ __forceinline__ float bfhi(unsigned x) { return __uint_as_float(x & 0xffff0000u); }
constexpr int DA_G = 0, DA_L = 1024, DA_KN = DA_L + 16384, DA_QN = DA_KN + 17408, DA_VBT = DA_QN + 17408, DA_KBET = DA_VBT + 18432, DA_KDT = DA_KBET + 18432, DA_TB = DA_KDT + 18432, DA_QK = DA_TB + 9216, DA_END = DA_QK + 9216;
static_assert(DA_END <= RING_BYTES, "DN-A LDS map");
#if defined(PROBE_DNA_A)
#define DNA_ST(k) do { if (threadIdx.x == 0) ((volatile LAS unsigned long long*)(lds + (RING_BYTES + 2048)))[k] = __builtin_amdgcn_s_memrealtime(); } while (0)
#else
#define DNA_ST(k) do { } while (0)
#endif
__device__ __forceinline__ void dna_unit(const bf16* proj, const float* cw, const float* ba, const float* a_log, const float* dt_bias,
                                         bf16* Wf, bf16* Qf, bf16* KdTf, bf16* QKf, bf16* Uf, float* glb, int uid, LAS unsigned char* lds, const LAS float* cwl, int tid, int lane, int wave) {
    const int h = uid & 7, n = (uid >> 3) & 127, b = uid >> 10, t0 = b * SEQ + n * 64;
    asm volatile("" : "+v"(lds));
    DNA_ST(0);
    LAS float* Gs = (LAS float*)(lds + DA_G);
    const int fr = lane & 15, fq = lane >> 4;
    float ba_b = 0.f, ba_a = 0.f;
    if (wave == 0) { const size_t t = (size_t)(t0 + lane); ba_b = ba[t * 16 + h]; ba_a = ba[t * 16 + 8 + h]; }
    DNA_ST(1);
    {
        const int r = tid >> 3, cg = tid & 7;
        float val[3][16];
#pragma unroll
        for (int p = 0; p < 3; ++p) {
            const int ccol = p * DDN + h * HD + cg * 16;
            float acc[16];
#pragma unroll
            for (int i = 0; i < 16; ++i) acc[i] = 0.f;
#pragma unroll
            for (int k = 0; k < 4; ++k) { const int row = r - 3 + k;
                if (n * 64 + row >= 0) {
                    const bf16* src = proj + (size_t)(t0 + row) * NPROJ + 2048 + ccol;
                    const u32x4 x0 = *(const u32x4*)src, x1 = *(const u32x4*)(src + 8);
                    const LAS float* wp = cwl + k * 384 + p * 128 + cg * 16;
                    const f32x4 w0 = *(const LAS f32x4*)wp, w1 = *(const LAS f32x4*)(wp + 4), w2 = *(const LAS f32x4*)(wp + 8), w3 = *(const LAS f32x4*)(wp + 12);
                    acc[0] += w0[0] * bflo(x0.x); acc[1] += w0[1] * bfhi(x0.x); acc[2] += w0[2] * bflo(x0.y); acc[3] += w0[3] * bfhi(x0.y);
                    acc[4] += w1[0] * bflo(x0.z); acc[5] += w1[1] * bfhi(x0.z); acc[6] += w1[2] * bflo(x0.w); acc[7] += w1[3] * bfhi(x0.w);
                    acc[8] += w2[0] * bflo(x1.x); acc[9] += w2[1] * bfhi(x1.x); acc[10] += w2[2] * bflo(x1.y); acc[11] += w2[3] * bfhi(x1.y);
                    acc[12] += w3[0] * bflo(x1.z); acc[13] += w3[1] * bfhi(x1.z); acc[14] += w3[2] * bflo(x1.w); acc[15] += w3[3] * bfhi(x1.w);
                } }
#pragma unroll
            for (int i = 0; i < 16; ++i) val[p][i] = silu_f(acc[i]);
        }
        float sq = 0.f, sk = 0.f;
#pragma unroll
        for (int i = 0; i < 16; ++i) { sq += val[0][i] * val[0][i]; sk += val[1][i] * val[1][i]; }
        sq += shfl_xor_l(sq, 1, lane); sq += shfl_xor_l(sq, 2, lane); sq += shfl_xor_l(sq, 4, lane);
        sk += shfl_xor_l(sk, 1, lane); sk += shfl_xor_l(sk, 2, lane); sk += shfl_xor_l(sk, 4, lane);
        const float rq = rsqrt_f(sq + EPS) * 0.08838834764831845f, rk = rsqrt_f(sk + EPS);
        if (wave == 0) {
            const float be0 = sigmoid_f(ba_b); float Gc = -__expf(a_log[h]) * softplus_f(ba_a + dt_bias[h]);
#pragma unroll
            for (int off = 1; off < 64; off <<= 1) { const float tmp = shfl_up_l(Gc, off, lane); if (lane >= off) Gc += tmp; }
            const float GL = shfl_idx_l(Gc, 63);
            Gs[lane] = Gc; Gs[64 + lane] = be0; Gs[128 + lane] = __expf(Gc); Gs[192 + lane] = __expf(GL - Gc);
            if (lane == 63) glb[uid] = __expf(Gc);
        }
        LDS_BARRIER();
        const float be = Gs[64 + r], eg = Gs[128 + r], egl = Gs[192 + r];
#pragma unroll
        for (int i = 0; i < 16; ++i) { val[0][i] *= rq; val[1][i] *= rk; }
        u32x4 o0, o1;
        o0.x = pk2(val[1][0], val[1][1]); o0.y = pk2(val[1][2], val[1][3]); o0.z = pk2(val[1][4], val[1][5]); o0.w = pk2(val[1][6], val[1][7]);
        o1.x = pk2(val[1][8], val[1][9]); o1.y = pk2(val[1][10], val[1][11]); o1.z = pk2(val[1][12], val[1][13]); o1.w = pk2(val[1][14], val[1][15]);
        *(LAS u32x4*)(lds + DA_KN + r * 272 + cg * 32) = o0; *(LAS u32x4*)(lds + DA_KN + r * 272 + cg * 32 + 16) = o1;
        o0.x = pk2(val[0][0], val[0][1]); o0.y = pk2(val[0][2], val[0][3]); o0.z = pk2(val[0][4], val[0][5]); o0.w = pk2(val[0][6], val[0][7]);
        o1.x = pk2(val[0][8], val[0][9]); o1.y = pk2(val[0][10], val[0][11]); o1.z = pk2(val[0][12], val[0][13]); o1.w = pk2(val[0][14], val[0][15]);
        *(LAS u32x4*)(lds + DA_QN + r * 272 + cg * 32) = o0; *(LAS u32x4*)(lds + DA_QN + r * 272 + cg * 32 + 16) = o1;
#pragma unroll
        for (int i = 0; i < 16; ++i) { const int f = cg * 16 + i;
            *(LAS unsigned short*)(lds + DA_VBT + f * 144 + r * 2) = (unsigned short)f2bf(val[2][i] * be);
            *(LAS unsigned short*)(lds + DA_KBET + f * 144 + r * 2) = (unsigned short)f2bf(val[1][i] * (be * eg));
            *(LAS unsigned short*)(lds + DA_KDT + f * 144 + r * 2) = (unsigned short)f2bf(val[1][i] * egl); }
    }
    LDS_BARRIER();
    DNA_ST(2);
    {
        const int p = wave >> 2, ti = wave & 3;
        const int abase = p == 0 ? DA_KN : DA_QN;
        bf16x8 af[4];
#pragma unroll
        for (int ks = 0; ks < 4; ++ks) af[ks] = *(const LAS bf16x8*)(lds + abase + (ti * 16 + fr) * 272 + (ks * 32 + fq * 8) * 2);
        for (int tj = 0; tj < 4; ++tj) {
            f32x4 acc = {0.f, 0.f, 0.f, 0.f};
            if (tj <= ti) {
#pragma unroll
                for (int ks = 0; ks < 4; ++ks) { const bf16x8 bb = *(const LAS bf16x8*)(lds + DA_KN + (tj * 16 + fr) * 272 + (ks * 32 + fq * 8) * 2); acc = mfma16(af[ks], bb, acc); }
            }
            const int j = tj * 16 + fr; const float Gj = Gs[j];
#pragma unroll
            for (int r = 0; r < 4; ++r) { const int i = ti * 16 + fq * 4 + r; float v = 0.f;
                if (p == 0) { if (i > j) v = Gs[64 + i] * acc[r] * __expf(Gs[i] - Gj); *(LAS float*)(lds + DA_L + (j * 64 + i) * 4) = v; }
                else { if (i >= j) v = acc[r] * __expf(Gs[i] - Gj); *(LAS unsigned short*)(lds + DA_QK + i * 144 + j * 2) = (unsigned short)f2bf(v); } }
        }
    }
    LDS_BARRIER();
    DNA_ST(3);
    {
        int lc = lane; asm volatile("" : "+v"(lc)); const float fl = (float)lc;
        const int blk = wave < 4 ? wave : 11 - wave;
        float Tr[8];
#pragma unroll
        for (int c = 0; c < 8; ++c) Tr[c] = fmaxf(0.f, 1.f - fabsf(fl - (float)(blk * 8 + c)));
        float lj[63];
#pragma unroll
        for (int j = 0; j < 63; ++j) lj[j] = *(const LAS float*)(lds + DA_L + (j * 64) * 4 + lc * 4);
#pragma unroll
        for (int j = 0; j < 63; ++j) {
            if (j >= blk * 8) {
#pragma unroll
                for (int c = 0; c < 8; ++c) { const float tj = __int_as_float(__builtin_amdgcn_readlane(__float_as_int(Tr[c]), j)); Tr[c] -= lj[j] * tj; }
            }
        }
        u32x4 o; o.x = pk2(Tr[0], Tr[1]); o.y = pk2(Tr[2], Tr[3]); o.z = pk2(Tr[4], Tr[5]); o.w = pk2(Tr[6], Tr[7]);
        *(LAS u32x4*)(lds + DA_TB + lc * 144 + blk * 16) = o;
    }
    {
        for (int fi = wave; fi < 40; fi += 8) {
            if (fi < 8) { const int mt = fi >> 1, ks = fi & 1;
                const u32x4 v = *(const LAS u32x4*)(lds + DA_QK + (mt * 16 + fr) * 144 + (ks * 32 + fq * 8) * 2);
                *(u32x4*)(QKf + (((size_t)uid * 4 + mt) * 2 + ks) * 512 + lane * 8) = v; }
            else if (fi < 24) { const int f2 = fi - 8, mt = f2 >> 2, ks = f2 & 3; const float eg = Gs[128 + mt * 16 + fr];
                const u32x4 v = *(const LAS u32x4*)(lds + DA_QN + (mt * 16 + fr) * 272 + (ks * 32 + fq * 8) * 2); u32x4 o;
                o.x = pk2(bflo(v.x) * eg, bfhi(v.x) * eg); o.y = pk2(bflo(v.y) * eg, bfhi(v.y) * eg); o.z = pk2(bflo(v.z) * eg, bfhi(v.z) * eg); o.w = pk2(bflo(v.w) * eg, bfhi(v.w) * eg);
                *(u32x4*)(Qf + (((size_t)uid * 4 + mt) * 4 + ks) * 512 + lane * 8) = o; }
            else { const int f2 = fi - 24, ft = f2 >> 1, ks = f2 & 1;
                const u32x4 v = *(const LAS u32x4*)(lds + DA_KDT + (ft * 16 + fr) * 144 + (ks * 32 + fq * 8) * 2);
                *(u32x4*)(KdTf + (((size_t)uid * 8 + ft) * 2 + ks) * 512 + lane * 8) = v; }
        }
    }
    LDS_BARRIER();
    DNA_ST(4);
    {
        bf16x8 ta[4][2];
#pragma unroll
        for (int mt = 0; mt < 4; ++mt)
#pragma unroll
            for (int ks = 0; ks < 2; ++ks) ta[mt][ks] = *(const LAS bf16x8*)(lds + DA_TB + (mt * 16 + fr) * 144 + (ks * 32 + fq * 8) * 2);
#pragma unroll
        for (int c2 = 0; c2 < 2; ++c2) { const int ct = wave * 2 + c2, img = ct < 8 ? DA_VBT : DA_KBET, cr = (ct & 7) * 16 + fr;
            bf16x8 bb[2];
#pragma unroll
            for (int ks = 0; ks < 2; ++ks) bb[ks] = *(const LAS bf16x8*)(lds + img + cr * 144 + (ks * 32 + fq * 8) * 2);
#pragma unroll
            for (int mt = 0; mt < 4; ++mt) { f32x4 acc = {0.f, 0.f, 0.f, 0.f};
#pragma unroll
                for (int ks = 0; ks < 2; ++ks) acc = mfma16(ta[mt][ks], bb[ks], acc);
                if (ct < 8) { u32x2 o; o.x = pk2(acc[0], acc[1]); o.y = pk2(acc[2], acc[3]); *(u32x2*)(Uf + ((((size_t)uid * 8 + ct) * 4 + mt) * 64 + lane) * 4) = o; }
                else { const int f = (ct - 8) * 16 + fr;
#pragma unroll
                    for (int r = 0; r < 4; ++r) *(LAS unsigned short*)(lds + DA_KN + (mt * 16 + fq * 4 + r) * 272 + f * 2) = (unsigned short)f2bf(acc[r]); } }
        }
    }
    LDS_BARRIER();
    DNA_ST(5);
#pragma unroll
    for (int q2 = 0; q2 < 2; ++q2) { const int fi = wave * 2 + q2, mt = fi >> 2, ks = fi & 3;
        const u32x4 v = *(const LAS u32x4*)(lds + DA_KN + (mt * 16 + fr) * 272 + (ks * 32 + fq * 8) * 2);
        *(u32x4*)(Wf + (((size_t)uid * 4 + mt) * 4 + ks) * 512 + lane * 8) = v; }
    LDS_BARRIER();
    DNA_ST(6);
}
struct DnbFrag { bf16x8 a1[4]; bf16x8 kd[2]; u32x2 u; float gl; };
__device__ __forceinline__ DnbFrag dnb_load(const bf16* Wf, const bf16* KdTf, const bf16* Uf, const float* glb, int uid, int ds, int wave, int lane) {
    DnbFrag f; const int mt = wave & 3;
#pragma unroll
    for (int ks = 0; ks < 4; ++ks) f.a1[ks] = (wave < 4) ? *(const bf16x8*)(Wf + (((size_t)uid * 4 + mt) * 4 + ks) * 512 + lane * 8) : (bf16x8){0, 0, 0, 0, 0, 0, 0, 0};
#pragma unroll
    for (int ks = 0; ks < 2; ++ks) f.kd[ks] = *(const bf16x8*)(KdTf + (((size_t)uid * 8 + wave) * 2 + ks) * 512 + lane * 8);
    f.u = (wave < 4) ? *(const u32x2*)(Uf + ((((size_t)uid * 8 + ds) * 4 + mt) * 64 + lane) * 4) : (u32x2){0u, 0u};
    f.gl = glb[uid];
    return f;
}
__device__ __forceinline__ void dnb_run(const bf16* Wf, const bf16* KdTf, const bf16* Uf, const float* glb, bf16* Sf, bf16* Vf, int bh, int ds, LAS unsigned char* lds, int tid, int lane, int wave) {
    const int b = bh >> 3, h = bh & 7, fr = lane & 15, fq = lane >> 4, mt = wave & 3;
    asm volatile("" : "+v"(lds));
    LAS unsigned char* ST = lds; LAS unsigned char* VNT = lds + 4608;
    for (int i = tid; i < 4608 / 4; i += 512) ((LAS unsigned*)ST)[i] = 0u;
    f32x4 accS = {0.f, 0.f, 0.f, 0.f};
    DnbFrag f0 = dnb_load(Wf, KdTf, Uf, glb, (b * 128 + 0) * 8 + h, ds, wave, lane), f1 = dnb_load(Wf, KdTf, Uf, glb, (b * 128 + 1) * 8 + h, ds, wave, lane);
    DnbFrag f2 = dnb_load(Wf, KdTf, Uf, glb, (b * 128 + 2) * 8 + h, ds, wave, lane), f3 = dnb_load(Wf, KdTf, Uf, glb, (b * 128 + 3) * 8 + h, ds, wave, lane);
    __syncthreads();
#define DNB_STEP(F, nn) do { const int n = (nn); const size_t uds = (size_t)((b * 128 + n) * 8 + h) * 8 + ds; \
        if (wave < 4) { f32x4 acc = {0.f, 0.f, 0.f, 0.f}; \
            _Pragma("unroll") for (int ks = 0; ks < 4; ++ks) { const bf16x8 sb = *(const LAS bf16x8*)(ST + fr * 272 + (ks * 32 + fq * 8) * 2); acc = mfma16(F.a1[ks], sb, acc); } \
            const float v0 = bflo(F.u.x) - acc[0], v1 = bfhi(F.u.x) - acc[1], v2 = bflo(F.u.y) - acc[2], v3 = bfhi(F.u.y) - acc[3]; \
            u32x2 w; w.x = pk2(v0, v1); w.y = pk2(v2, v3); *(LAS u32x2*)(VNT + fr * 144 + (mt * 16 + fq * 4) * 2) = w; } \
        else { const u32x4 sb = *(const LAS u32x4*)(ST + fr * 272 + (mt * 32 + fq * 8) * 2);     \
            *(u32x4*)(Sf + (uds * 4 + mt) * 512 + lane * 8) = sb; } \
        LDS_BARRIER(); \
        bf16x8 vb[2]; \
        _Pragma("unroll") for (int ks = 0; ks < 2; ++ks) vb[ks] = *(const LAS bf16x8*)(VNT + fr * 144 + (ks * 32 + fq * 8) * 2); \
        accS = accS * F.gl; \
        _Pragma("unroll") for (int ks = 0; ks < 2; ++ks) accS = mfma16(F.kd[ks], vb[ks], accS); \
        { u32x2 w; w.x = pk2(accS[0], accS[1]); w.y = pk2(accS[2], accS[3]); *(LAS u32x2*)(ST + fr * 272 + (wave * 16 + fq * 4) * 2) = w; } \
        if (wave == 4) *(bf16x8*)(Vf + (uds * 2 + 0) * 512 + lane * 8) = vb[0];     \
        if (wave == 5) *(bf16x8*)(Vf + (uds * 2 + 1) * 512 + lane * 8) = vb[1]; \
        F = dnb_load(Wf, KdTf, Uf, glb, (b * 128 + (n + 4 < 128 ? n + 4 : 127)) * 8 + h, ds, wave, lane);     \
        LDS_BARRIER(); } while (0)
    for (int n4 = 0; n4 < 128; n4 += 16) {
        DNB_STEP(f0, n4); DNB_STEP(f1, n4 + 1); DNB_STEP(f2, n4 + 2); DNB_STEP(f3, n4 + 3); DNB_STEP(f0, n4 + 4); DNB_STEP(f1, n4 + 5); DNB_STEP(f2, n4 + 6); DNB_STEP(f3, n4 + 7);
        DNB_STEP(f0, n4 + 8); DNB_STEP(f1, n4 + 9); DNB_STEP(f2, n4 + 10); DNB_STEP(f3, n4 + 11); DNB_STEP(f0, n4 + 12); DNB_STEP(f1, n4 + 13); DNB_STEP(f2, n4 + 14); DNB_STEP(f3, n4 + 15); }
#undef DNB_STEP
}
constexpr int DO_ABUF = 24576, DO_OT = 49152, DO_END = DO_OT + 64 * 132 * 4;
static_assert(DO_END <= RING_BYTES, "DN-O LDS map");
struct DnoOps { bf16x8 sB[4], vB[2]; u32x4 g0, g1; };
__device__ __forceinline__ DnoOps dno_request(const bf16* Qf, const bf16* QKf, const bf16* Sf, const bf16* Vf, const bf16* proj, int uid, LAS unsigned char* abuf, int tid, int lane, int wave) {
    DnoOps f; const int h = uid & 7, n = (uid >> 3) & 127, b = uid >> 10, t = b * SEQ + n * 64 + (tid >> 3), c = h * HD + (tid & 7) * 16;
#pragma unroll
    for (int i = 0; i < 3; ++i) { const int ch = wave * 3 + i;
        __builtin_amdgcn_global_load_lds((const unsigned*)((ch < 16 ? Qf + (size_t)uid * 8192 + ch * 512 : QKf + (size_t)uid * 4096 + (ch - 16) * 512) + lane * 8), (LAS unsigned*)(abuf + ch * 1024), 16, 0, 0); }
#pragma unroll
    for (int ks = 0; ks < 4; ++ks) f.sB[ks] = *(const bf16x8*)(Sf + ((((size_t)uid * 8 + wave) * 4) + ks) * 512 + lane * 8);
#pragma unroll
    for (int ks = 0; ks < 2; ++ks) f.vB[ks] = *(const bf16x8*)(Vf + ((((size_t)uid * 8 + wave) * 2) + ks) * 512 + lane * 8);
    const u32x4* gp = (const u32x4*)(proj + (size_t)t * NPROJ + 5120 + c); f.g0 = gp[0]; f.g1 = gp[1];
    return f;
}
__device__ __forceinline__ void dno_run(const bf16* Qf, const bf16* QKf, const bf16* Sf, const bf16* Vf, const float* gain, const bf16* proj, bf16* ymix, int bid, int G, LAS unsigned char* lds, int tid, int lane, int wave) {
    const int fr = lane & 15, fq = lane >> 4, cg = tid & 7, rr = tid >> 3;
    LAS unsigned char* ldu = lds;
    asm volatile("" : "+v"(lds));
    const f32x4* wp = (const f32x4*)(gain + cg * 16); const f32x4 w0 = wp[0], w1 = wp[1], w2 = wp[2], w3 = wp[3];
    int buf = 0;
    DnoOps cur = dno_request(Qf, QKf, Sf, Vf, proj, bid, ldu, tid, lane, wave);
    for (int uid = bid; uid < 2048; uid += G) {
        const int h = uid & 7, n = (uid >> 3) & 127, b = uid >> 10, t0 = b * SEQ + n * 64;
        asm volatile("s_waitcnt vmcnt(0)" ::: "memory");
        LDS_BARRIER();
        const LAS unsigned char* ab = lds + buf * DO_ABUF;
#pragma unroll
        for (int mt = 0; mt < 4; ++mt) { f32x4 acc = {0.f, 0.f, 0.f, 0.f};
#pragma unroll
            for (int ks = 0; ks < 4; ++ks) { const bf16x8 a = *(const LAS bf16x8*)(ab + (mt * 4 + ks) * 1024 + lane * 16); acc = mfma16(a, cur.sB[ks], acc); }
#pragma unroll
            for (int ks = 0; ks < 2; ++ks) { const bf16x8 a = *(const LAS bf16x8*)(ab + 16384 + (mt * 2 + ks) * 1024 + lane * 16); acc = mfma16(a, cur.vB[ks], acc); }
#pragma unroll
            for (int r = 0; r < 4; ++r) *(LAS float*)(lds + DO_OT + ((mt * 16 + fq * 4 + r) * 132 + wave * 16 + fr) * 4) = acc[r]; }
        const u32x4 g0 = cur.g0, g1 = cur.g1;
        buf ^= 1;
        cur = dno_request(Qf, QKf, Sf, Vf, proj, uid + G < 2048 ? uid + G : uid, ldu + buf * DO_ABUF, tid, lane, wave);
        LDS_BARRIER();
        {
            const int t = t0 + rr, c = h * HD + cg * 16;
            const LAS f32x4* op = (const LAS f32x4*)(lds + DO_OT + (rr * 132 + cg * 16) * 4); const f32x4 o0 = op[0], o1 = op[1], o2 = op[2], o3 = op[3];
            float ss = (o0[0] * o0[0] + o0[1] * o0[1]) + (o0[2] * o0[2] + o0[3] * o0[3]) + (o1[0] * o1[0] + o1[1] * o1[1]) + (o1[2] * o1[2] + o1[3] * o1[3])
                     + (o2[0] * o2[0] + o2[1] * o2[1]) + (o2[2] * o2[2] + o2[3] * o2[3]) + (o3[0] * o3[0] + o3[1] * o3[1]) + (o3[2] * o3[2] + o3[3] * o3[3]);
            ss += shfl_xor_l(ss, 1, lane); ss += shfl_xor_l(ss, 2, lane); ss += shfl_xor_l(ss, 4, lane);
            const float rs = rsqrt_f(ss * (1.0f / HD) + EPS);
            u32x4 r0, r1;
            r0.x = pk2(o0[0] * rs * w0[0] * silu_f(bflo(g0.x)), o0[1] * rs * w0[1] * silu_f(bfhi(g0.x))); r0.y = pk2(o0[2] * rs * w0[2] * silu_f(bflo(g0.y)), o0[3] * rs * w0[3] * silu_f(bfhi(g0.y)));
            r0.z = pk2(o1[0] * rs * w1[0] * silu_f(bflo(g0.z)), o1[1] * rs * w1[1] * silu_f(bfhi(g0.z))); r0.w = pk2(o1[2] * rs * w1[2] * silu_f(bflo(g0.w)), o1[3] * rs * w1[3] * silu_f(bfhi(g0.w)));
            r1.x = pk2(o2[0] * rs * w2[0] * silu_f(bflo(g1.x)), o2[1] * rs * w2[1] * silu_f(bfhi(g1.x))); r1.y = pk2(o2[2] * rs * w2[2] * silu_f(bflo(g1.y)), o2[3] * rs * w2[3] * silu_f(bfhi(g1.y)));
            r1.z = pk2(o3[0] * rs * w3[0] * silu_f(bflo(g1.z)), o3[1] * rs * w3[1] * silu_f(bfhi(g1.z))); r1.w = pk2(o3[2] * rs * w3[2] * silu_f(bflo(g1.w)), o3[3] * rs * w3[3] * silu_f(bfhi(g1.w)));
            u32x4* dst = (u32x4*)(ymix + (size_t)t * D + DLRU + c); dst[0] = r0; dst[1] = r1;
        }
    }
    asm volatile("s_waitcnt vmcnt(0)" ::: "memory");
    LDS_BARRIER();
}
constexpr int LA_XB = 0, LA_XF = 17408, LA_END = LA_XF + 64 * 132 * 4;
static_assert(LA_END <= RING_BYTES, "LRU-A LDS map");
struct LruConst { bf16x8 br[4], bi[4]; float brr, bii, sp8; };
__device__ __forceinline__ LruConst lrua_const(const bf16* WrT, const bf16* WiT, const float* b_r, const float* b_i, const float* lam, int nb, int lane, int wave) {
    LruConst c; const int fr = lane & 15, fq = lane >> 4, cl = wave * 16 + fr, ch = nb * 128 + cl;
#pragma unroll
    for (int ks = 0; ks < 4; ++ks) { c.br[ks] = *(const bf16x8*)(WrT + ((size_t)nb * 128 + cl) * 128 + ks * 32 + fq * 8); c.bi[ks] = *(const bf16x8*)(WiT + ((size_t)nb * 128 + cl) * 128 + ks * 32 + fq * 8); }
    c.brr = b_r[ch]; c.bii = b_i[ch]; c.sp8 = -8.0f * softplus_f(-lam[ch]);
    return c;
}
__device__ __forceinline__ void lrua_unit(const bf16* proj, const LruConst& LC,
                                          float* Hloc, float* Acum, float* summ, int unit, LAS unsigned char* lds, const LAS float* lwl, int tid, int lane, int wave) {
    const int nb = unit & 7, ct = unit >> 3, n = ct & 127, t0 = ct * 64;
    asm volatile("" : "+v"(lds));
    {
        const int r = tid >> 3, cg = tid & 7, ch0 = nb * 128 + cg * 16;
        float acc[16];
        { const LAS float* bp = lwl + 512 + cg * 16; const f32x4 c0v = *(const LAS f32x4*)bp, c1v = *(const LAS f32x4*)(bp + 4), c2v = *(const LAS f32x4*)(bp + 8), c3v = *(const LAS f32x4*)(bp + 12);
#pragma unroll
          for (int i = 0; i < 4; ++i) { acc[i] = c0v[i]; acc[4 + i] = c1v[i]; acc[8 + i] = c2v[i]; acc[12 + i] = c3v[i]; } }
#pragma unroll
        for (int k = 0; k < 4; ++k) { const int row = r - 3 + k;
            if (n * 64 + row >= 0) {
                const bf16* src = proj + (size_t)(t0 + row) * NPROJ + ch0;
                const u32x4 x0 = *(const u32x4*)src, x1 = *(const u32x4*)(src + 8);
                const LAS float* wp = lwl + k * 128 + cg * 16;
                const f32x4 w0 = *(const LAS f32x4*)wp, w1 = *(const LAS f32x4*)(wp + 4), w2 = *(const LAS f32x4*)(wp + 8), w3 = *(const LAS f32x4*)(wp + 12);
                acc[0] += w0[0] * bflo(x0.x); acc[1] += w0[1] * bfhi(x0.x); acc[2] += w0[2] * bflo(x0.y); acc[3] += w0[3] * bfhi(x0.y);
                acc[4] += w1[0] * bflo(x0.z); acc[5] += w1[1] * bfhi(x0.z); acc[6] += w1[2] * bflo(x0.w); acc[7] += w1[3] * bfhi(x0.w);
                acc[8] += w2[0] * bflo(x1.x); acc[9] += w2[1] * bfhi(x1.x); acc[10] += w2[2] * bflo(x1.y); acc[11] += w2[3] * bfhi(x1.y);
                acc[12] += w3[0] * bflo(x1.z); acc[13] += w3[1] * bfhi(x1.z); acc[14] += w3[2] * bflo(x1.w); acc[15] += w3[3] * bfhi(x1.w);
            } }
        u32x4 o0, o1;
        o0.x = pk2(acc[0], acc[1]); o0.y = pk2(acc[2], acc[3]); o0.z = pk2(acc[4], acc[5]); o0.w = pk2(acc[6], acc[7]);
        o1.x = pk2(acc[8], acc[9]); o1.y = pk2(acc[10], acc[11]); o1.z = pk2(acc[12], acc[13]); o1.w = pk2(acc[14], acc[15]);
        *(LAS u32x4*)(lds + LA_XB + r * 272 + cg * 32) = o0; *(LAS u32x4*)(lds + LA_XB + r * 272 + cg * 32 + 16) = o1;
        LAS f32x4* xf = (LAS f32x4*)(lds + LA_XF + (r * 132 + cg * 16) * 4);
        xf[0] = (f32x4){acc[0], acc[1], acc[2], acc[3]}; xf[1] = (f32x4){acc[4], acc[5], acc[6], acc[7]}; xf[2] = (f32x4){acc[8], acc[9], acc[10], acc[11]}; xf[3] = (f32x4){acc[12], acc[13], acc[14], acc[15]};
    }
    LDS_BARRIER();
    const int fr = lane & 15, fq = lane >> 4, cl = wave * 16 + fr, ch = nb * 128 + cl;
    f32x4 ar[4], ai[4];
#pragma unroll
    for (int mt = 0; mt < 4; ++mt) { ar[mt] = (f32x4){0.f, 0.f, 0.f, 0.f}; ai[mt] = (f32x4){0.f, 0.f, 0.f, 0.f};
#pragma unroll
        for (int ks = 0; ks < 4; ++ks) { const bf16x8 af = *(const LAS bf16x8*)(lds + LA_XB + (mt * 16 + fr) * 272 + (ks * 32 + fq * 8) * 2); ar[mt] = mfma16(af, LC.br[ks], ar[mt]); ai[mt] = mfma16(af, LC.bi[ks], ai[mt]); } }
    const float brr = LC.brr, bii = LC.bii, sp8 = LC.sp8;
    float Ac = 1.f, Bc = 0.f;
#pragma unroll
    for (int mt = 0; mt < 4; ++mt) {
        float P[4], H[4];
#pragma unroll
        for (int r = 0; r < 4; ++r) { const int t = mt * 16 + fq * 4 + r; const float xcv = *(const LAS float*)(lds + LA_XF + (t * 132 + cl) * 4);
            const float rr = sigmoid_f(ar[mt][r] + brr), ii = sigmoid_f(ai[mt][r] + bii), la = sp8 * rr, a = __expf(la), bb = __builtin_amdgcn_sqrtf(fmaxf(1.0f - a * a, 0.0f)) * (ii * xcv);
            if (r == 0) { P[0] = a; H[0] = bb; } else { P[r] = P[r - 1] * a; H[r] = a * H[r - 1] + bb; } }
        float Ai = P[3], Bi = H[3];
        { const float Au = shfl_up_l(Ai, 16, lane), Bu = shfl_up_l(Bi, 16, lane); if (fq >= 1) { Bi = Ai * Bu + Bi; Ai = Au * Ai; } }
        { const float Au = shfl_up_l(Ai, 32, lane), Bu = shfl_up_l(Bi, 32, lane); if (fq >= 2) { Bi = Ai * Bu + Bi; Ai = Au * Ai; } }
        float Ae = shfl_up_l(Ai, 16, lane), Be = shfl_up_l(Bi, 16, lane); if (fq == 0) { Ae = 1.f; Be = 0.f; }
        const float At = shfl_idx_l(Ai, 48 + fr), Bt = shfl_idx_l(Bi, 48 + fr);
        const float PA = Ac * Ae, PB = Ae * Bc + Be;
#pragma unroll
        for (int r = 0; r < 4; ++r) { const size_t o = (size_t)(t0 + mt * 16 + fq * 4 + r) * DLRU + ch; ((unsigned*)Hloc)[o] = pk2(P[r] * PB + H[r], PA * P[r]); }
        Bc = At * Bc + Bt; Ac = Ac * At;
    }
    if (fq == 0) { float* sp = summ + ((size_t)ct * DLRU + ch) * 2; sp[0] = Ac; sp[1] = Bc; }
    LDS_BARRIER();
}
__device__ __forceinline__ void lru_carry(const float* summ, float* carry, int idx) {
    const int b = idx >> 10, ch = idx & 1023; float c = 0.f;
    for (int n0 = 0; n0 < 128; n0 += 8) { float A[8], B[8];
#pragma unroll
        for (int j = 0; j < 8; ++j) { const float* sp = summ + ((size_t)(b * 128 + n0 + j) * DLRU + ch) * 2; A[j] = sp[0]; B[j] = sp[1]; }
#pragma unroll
        for (int j = 0; j < 8; ++j) { carry[(size_t)(b * 128 + n0 + j) * DLRU + ch] = c; c = A[j] * c + B[j]; } }
}
__device__ __forceinline__ void lrub_row(const float* Hloc, const float* Acum, const float* carry, const bf16* proj, const float* gain, bf16* ymix, int row, int lane) {
    const int ct = row >> 6; f32x4 y[4]; float ss = 0.f;
#pragma unroll
    for (int j = 0; j < 4; ++j) { const int c4 = lane * 4 + 256 * j;
        const u32x4 ha = *(const u32x4*)((const unsigned*)Hloc + (size_t)row * DLRU + c4); const f32x4 cr = *(const f32x4*)(carry + (size_t)ct * DLRU + c4);
        const u32x2 g = *(const u32x2*)(proj + (size_t)row * NPROJ + DLRU + c4);
        const f32x4 hl = {bflo(ha.x), bflo(ha.y), bflo(ha.z), bflo(ha.w)}, ac = {bfhi(ha.x), bfhi(ha.y), bfhi(ha.z), bfhi(ha.w)};
        const f32x4 hh = hl + ac * cr;
        y[j][0] = hh[0] * gelu_tanh_f(bflo(g.x)); y[j][1] = hh[1] * gelu_tanh_f(bfhi(g.x)); y[j][2] = hh[2] * gelu_tanh_f(bflo(g.y)); y[j][3] = hh[3] * gelu_tanh_f(bfhi(g.y));
        ss += (y[j][0] * y[j][0] + y[j][1] * y[j][1]) + (y[j][2] * y[j][2] + y[j][3] * y[j][3]); }
    ss = wave_sum(ss, lane); const float rs = rsqrt_f(ss * (1.0f / DLRU) + EPS);
#pragma unroll
    for (int j = 0; j < 4; ++j) { const int c4 = lane * 4 + 256 * j; const f32x4 g = *(const f32x4*)(gain + c4); u32x2 w; w.x = pk2(y[j][0] * rs * g[0], y[j][1] * rs * g[1]); w.y = pk2(y[j][2] * rs * g[2], y[j][3] * rs * g[3]);
        *(u32x2*)(ymix + (size_t)row * D + c4) = w; }
}
__device__ __forceinline__ void dn_out_row(const float* o, const float* gain, const bf16* proj, bf16* ymix, int t, int lane) {
    const int c = lane * 16;
    const f32x4* op = (const f32x4*)(o + (size_t)t * DDN + c); const f32x4 o0 = op[0], o1 = op[1], o2 = op[2], o3 = op[3];
    const u32x4* gp = (const u32x4*)(proj + (size_t)t * NPROJ + 5120 + c); const u32x4 g0 = gp[0], g1 = gp[1];
    const f32x4* wp = (const f32x4*)(gain + (c & 127)); const f32x4 w0 = wp[0], w1 = wp[1], w2 = wp[2], w3 = wp[3];
    float ss = (o0[0] * o0[0] + o0[1] * o0[1]) + (o0[2] * o0[2] + o0[3] * o0[3]) + (o1[0] * o1[0] + o1[1] * o1[1]) + (o1[2] * o1[2] + o1[3] * o1[3])
             + (o2[0] * o2[0] + o2[1] * o2[1]) + (o2[2] * o2[2] + o2[3] * o2[3]) + (o3[0] * o3[0] + o3[1] * o3[1]) + (o3[2] * o3[2] + o3[3] * o3[3]);
    ss += shfl_xor_l(ss, 1, lane); ss += shfl_xor_l(ss, 2, lane); ss += shfl_xor_l(ss, 4, lane);
    const float rs = rsqrt_f(ss * (1.0f / HD) + EPS);
    u32x4 r0, r1;
    r0.x = pk2(o0[0] * rs * w0[0] * silu_f(bflo(g0.x)), o0[1] * rs * w0[1] * silu_f(bfhi(g0.x))); r0.y = pk2(o0[2] * rs * w0[2] * silu_f(bflo(g0.y)), o0[3] * rs * w0[3] * silu_f(bfhi(g0.y)));
    r0.z = pk2(o1[0] * rs * w1[0] * silu_f(bflo(g0.z)), o1[1] * rs * w1[1] * silu_f(bfhi(g0.z))); r0.w = pk2(o1[2] * rs * w1[2] * silu_f(bflo(g0.w)), o1[3] * rs * w1[3] * silu_f(bfhi(g0.w)));
    r1.x = pk2(o2[0] * rs * w2[0] * silu_f(bflo(g1.x)), o2[1] * rs * w2[1] * silu_f(bfhi(g1.x))); r1.y = pk2(o2[2] * rs * w2[2] * silu_f(bflo(g1.y)), o2[3] * rs * w2[3] * silu_f(bfhi(g1.y)));
    r1.z = pk2(o3[0] * rs * w3[0] * silu_f(bflo(g1.z)), o3[1] * rs * w3[1] * silu_f(bfhi(g1.z))); r1.w = pk2(o3[2] * rs * w3[2] * silu_f(bflo(g1.w)), o3[3] * rs * w3[3] * silu_f(bfhi(g1.w)));
    u32x4* dst = (u32x4*)(ymix + (size_t)t * D + DLRU + c); dst[0] = r0; dst[1] = r1;
}
__device__ __forceinline__ void route_row(const float* x, const float* rstd, const float* gain, const float* router, float* roww, int row, int lane) {
    float acc[8];
#pragma unroll
    for (int e = 0; e < 8; ++e) acc[e] = 0.f;
    for (int j = 0; j < 32; ++j) { const int k = lane + 64 * j; const float xv = x[(size_t)row * D + k] * gain[k]; const f32x4 r0 = *(const f32x4*)(router + (size_t)k * 8), r1 = *(const f32x4*)(router + (size_t)k * 8 + 4);
        acc[0] += xv * r0[0]; acc[1] += xv * r0[1]; acc[2] += xv * r0[2]; acc[3] += xv * r0[3]; acc[4] += xv * r1[0]; acc[5] += xv * r1[1]; acc[6] += xv * r1[2]; acc[7] += xv * r1[3]; }
    const float rs = rstd[row];
#pragma unroll
    for (int e = 0; e < 8; ++e) acc[e] = wave_sum(acc[e], lane) * rs;
    int e1 = 0; float l1 = acc[0];
#pragma unroll
    for (int e = 1; e < 8; ++e) if (acc[e] > l1) { l1 = acc[e]; e1 = e; }
    int e2 = -1; float l2 = -3.4e38f;
#pragma unroll
    for (int e = 0; e < 8; ++e) if (e != e1 && acc[e] > l2) { l2 = acc[e]; e2 = e; }
    const float w1 = 1.0f / (1.0f + __expf(l2 - l1)), w2 = 1.0f - w1;
    if (lane < 8) roww[(size_t)lane * T + row] = lane == e1 ? w1 : (lane == e2 ? w2 : 0.0f);
}
__device__ __forceinline__ void final_row(const float* x, const float* gain, float* out, int row, int lane) {
    const f32x4* xr = (const f32x4*)(x + (size_t)row * D) + lane; const f32x4* gr = (const f32x4*)gain + lane;
    f32x4 v[8]; float ss = 0.f;
#pragma unroll
    for (int j = 0; j < 8; ++j) { v[j] = xr[64 * j]; ss += (v[j][0] * v[j][0] + v[j][1] * v[j][1]) + (v[j][2] * v[j][2] + v[j][3] * v[j][3]); }
    ss = wave_sum(ss, lane); const float rs = rsqrt_f(ss * (1.0f / D) + EPS);
    f32x4* o = (f32x4*)(out + (size_t)row * D) + lane;
#pragma unroll
    for (int j = 0; j < 8; ++j) o[64 * j] = v[j] * rs * gr[64 * j];
}

struct MoeOrder {
    const int* list; int nN, G, c; int c0, c1, c2, c3, c4, c5, c6, c7;
    __device__ __forceinline__ void init(const unsigned* cnt, const int* list_, int nN_, int G_, int c_) { list = list_; nN = nN_; G = G_; c = c_;
        c0 = __builtin_amdgcn_readfirstlane((int)cnt[0]); c1 = __builtin_amdgcn_readfirstlane((int)cnt[1]); c2 = __builtin_amdgcn_readfirstlane((int)cnt[2]); c3 = __builtin_amdgcn_readfirstlane((int)cnt[3]);
        c4 = __builtin_amdgcn_readfirstlane((int)cnt[4]); c5 = __builtin_amdgcn_readfirstlane((int)cnt[5]); c6 = __builtin_amdgcn_readfirstlane((int)cnt[6]); c7 = __builtin_amdgcn_readfirstlane((int)cnt[7]); }
    __device__ __forceinline__ bool next(int i, pg8::Unit& u) const {
        const int c8[8] = {c0, c1, c2, c3, c4, c5, c6, c7}; int nM = 0;
#pragma unroll
        for (int k = 0; k < 8; ++k) nM += (c8[k] + 255) >> 8;
        const int nwg = nM * nN; const long L = (long)i * G + c; if (L >= nwg) return false;
        int wgid = (int)L; { const int q = nwg / pg8::NXCD, r = nwg % pg8::NXCD, xcd = wgid % pg8::NXCD, off = wgid / pg8::NXCD; wgid = (xcd < r ? xcd * (q + 1) : r * (q + 1) + (xcd - r) * q) + off; }
        const int nig = pg8::WGM * nN, gid = wgid / nig, fm = gid * pg8::WGM, gsz = (nM - fm) < pg8::WGM ? (nM - fm) : pg8::WGM;
        u.pm = fm + ((wgid % nig) % gsz); u.pn = (wgid % nig) / gsz;
        int e = 0, ps = 0, ce = c8[0], run = 0;
#pragma unroll
        for (int k = 0; k < 8; ++k) { const int mk = (c8[k] + 255) >> 8; if (u.pm >= run && u.pm < run + mk) { e = k; ps = run; ce = c8[k]; } run += mk; }
        const int mtl = u.pm - ps; u.pb = e * nN + u.pn; u.lbase = e * T + mtl * 256; u.nvalid = (ce - mtl * 256) < 256 ? (ce - mtl * 256) : 256;
        return true;
    }
    __device__ __forceinline__ int arow(const pg8::Unit& u, int r) const { return r < u.nvalid ? (list[u.lbase + r] & 0xffff) : 0; }
    __device__ __forceinline__ void a_ready(const pg8::Unit&) const {}
    __device__ __forceinline__ void done(const pg8::Unit&) const {}
};
__device__ __forceinline__ void route_block(const float* x, const float* gain, const float* router, bf16* xb, float* rstd, unsigned* cnt, int* list, float* listw, int blk, LAS unsigned char* lds, int tid, int lane, int wave) {
    asm volatile("" : "+v"(lds));
    LAS float* grt = (LAS float*)lds; LAS int* se1 = (LAS int*)(lds + 65536); LAS int* se2 = se1 + 64; LAS float* sw1 = (LAS float*)(se2 + 64); LAS float* sw2 = sw1 + 64; LAS int* lcnt = (LAS int*)(sw2 + 64); LAS int* gbase = lcnt + 8;
    for (int i = tid; i < D * 8; i += 512) grt[i] = router[i] * gain[i >> 3];
    if (tid < 8) lcnt[tid] = 0;
    __syncthreads();
    f32x4 vnx[8];
    { const f32x4* xr = (const f32x4*)(x + (size_t)(blk * 64 + wave * 8) * D) + lane;
#pragma unroll
      for (int j = 0; j < 8; ++j) vnx[j] = xr[64 * j]; }
    for (int q = 0; q < 8; ++q) { const int rloc = wave * 8 + q, row = blk * 64 + rloc;
        f32x4 v[8]; float ss = 0.f;
#pragma unroll
        for (int j = 0; j < 8; ++j) { v[j] = vnx[j]; ss += (v[j][0] * v[j][0] + v[j][1] * v[j][1]) + (v[j][2] * v[j][2] + v[j][3] * v[j][3]); }
        { const f32x4* xr = (const f32x4*)(x + (size_t)(row + (q < 7 ? 1 : 0)) * D) + lane;
#pragma unroll
          for (int j = 0; j < 8; ++j) vnx[j] = xr[64 * j]; }
        ss = wave_sum(ss, lane); const float rs = rsqrt_f(ss * (1.0f / D) + EPS);
        u32x2* o = (u32x2*)(xb + (size_t)row * D) + lane;
#pragma unroll
        for (int j = 0; j < 8; ++j) { u32x2 w; w.x = pk2(v[j][0], v[j][1]); w.y = pk2(v[j][2], v[j][3]); o[64 * j] = w; }
        if (lane == 0) rstd[row] = rs;
        float acc[8];
#pragma unroll
        for (int e = 0; e < 8; ++e) acc[e] = 0.f;
#pragma unroll
        for (int j = 0; j < 8; ++j)
#pragma unroll
            for (int c = 0; c < 4; ++c) { const int k = (lane + 64 * j) * 4 + c; const f32x4 r0 = *(const LAS f32x4*)(grt + k * 8), r1 = *(const LAS f32x4*)(grt + k * 8 + 4); const float xv = v[j][c];
                acc[0] += xv * r0[0]; acc[1] += xv * r0[1]; acc[2] += xv * r0[2]; acc[3] += xv * r0[3]; acc[4] += xv * r1[0]; acc[5] += xv * r1[1]; acc[6] += xv * r1[2]; acc[7] += xv * r1[3]; }
#pragma unroll
        for (int e = 0; e < 8; ++e) acc[e] = wave_sum(acc[e], lane) * rs;
        int e1 = 0; float l1 = acc[0];
#pragma unroll
        for (int e = 1; e < 8; ++e) if (acc[e] > l1) { l1 = acc[e]; e1 = e; }
        int e2 = -1; float l2 = -3.4e38f;
#pragma unroll
        for (int e = 0; e < 8; ++e) if (e != e1 && acc[e] > l2) { l2 = acc[e]; e2 = e; }
        const float w1 = 1.0f / (1.0f + __expf(l2 - l1));
        if (lane == 0) { se1[rloc] = e1; se2[rloc] = e2; sw1[rloc] = w1; sw2[rloc] = 1.0f - w1; }
    }
    __syncthreads();
    int e = 0, lr = 0; float w = 0.f;
    if (tid < 128) { const int rloc = tid >> 1, j = tid & 1; e = j ? se2[rloc] : se1[rloc]; w = j ? sw2[rloc] : sw1[rloc]; lr = __hip_atomic_fetch_add(lcnt + e, 1, __ATOMIC_RELAXED, __HIP_MEMORY_SCOPE_WORKGROUP); }
    __syncthreads();
    if (tid < 8) gbase[tid] = (int)__hip_atomic_fetch_add(cnt + tid, (unsigned)lcnt[tid], __ATOMIC_RELAXED, __HIP_MEMORY_SCOPE_AGENT);
    __syncthreads();
    if (tid < 128) { const int pos = gbase[e] + lr, tok = blk * 64 + (tid >> 1); list[e * T + pos] = tok | ((tid & 1) << 16); listw[e * T + pos] = w; }
    __syncthreads();
}
__device__ __forceinline__ void final_row_moe(const float* x, const bf16* y0, const bf16* y1, const float* gain, float* out, int row, int lane) {
    const f32x4* xr = (const f32x4*)(x + (size_t)row * D) + lane; const f32x4* gr = (const f32x4*)gain + lane;
    const u32x2* p0 = (const u32x2*)(y0 + (size_t)row * D) + lane; const u32x2* p1 = (const u32x2*)(y1 + (size_t)row * D) + lane;
    f32x4 v[8]; float ss = 0.f;
#pragma unroll
    for (int j = 0; j < 8; ++j) { v[j] = xr[64 * j]; const u32x2 a = p0[64 * j], b = p1[64 * j];
        v[j][0] += bflo(a.x) + bflo(b.x); v[j][1] += bfhi(a.x) + bfhi(b.x); v[j][2] += bflo(a.y) + bflo(b.y); v[j][3] += bfhi(a.y) + bfhi(b.y);
        ss += (v[j][0] * v[j][0] + v[j][1] * v[j][1]) + (v[j][2] * v[j][2] + v[j][3] * v[j][3]); }
    ss = wave_sum(ss, lane); const float rs = rsqrt_f(ss * (1.0f / D) + EPS);
    f32x4* o = (f32x4*)(out + (size_t)row * D) + lane;
#pragma unroll
    for (int j = 0; j < 8; ++j) o[64 * j] = v[j] * rs * gr[64 * j];
}
__device__ __forceinline__ void ba_tail(const bf16* xbp, const bf16* wbab, const float* ssq, int mode, float* bap, int rb, int wave, int lane) {
    if (wave < 4) { const int fr = lane & 15, fq = lane >> 4, r0 = rb * 64 + wave * 16;
        const bf16* ap = xbp + (size_t)(r0 + fr) * D + fq * 8; const bf16* bp = wbab + (size_t)fr * D + fq * 8;
        f32x4 acc = {0.f, 0.f, 0.f, 0.f};
#pragma unroll 16
        for (int ks = 0; ks < 64; ++ks) { const bf16x8 a = *(const bf16x8*)(ap + ks * 32), b = *(const bf16x8*)(bp + ks * 32); acc = mfma16(a, b, acc); }
#pragma unroll
        for (int rr = 0; rr < 4; ++rr) { const int r = r0 + fq * 4 + rr; bap[(size_t)r * 16 + fr] = acc[rr] * pg8::row_scale(ssq, r, mode); } }
}
struct Args { const float* in[25]; float* out; unsigned char* ws; int ph_lo, ph_hi; };
typedef const __attribute__((address_space(4))) unsigned long long* kaptr_t;
__device__ __forceinline__ unsigned long long ldka(int i) { kaptr_t ka = (kaptr_t)__builtin_amdgcn_kernarg_segment_ptr(); asm volatile("" : "+s"(i)); return ka[i]; }
__device__ __forceinline__ const float* ldin(const Args&, int i) { return (const float*)(const GAS float*)ldka(i); }
__device__ __forceinline__ unsigned char* ldws(const Args&) { return (unsigned char*)(GAS unsigned char*)ldka(26); }
__device__ __forceinline__ float* ldout(const Args&) { return (float*)(GAS float*)ldka(25); }
__global__ void __launch_bounds__(512, 2) mega(Args args) {
    extern __shared__ __attribute__((aligned(16))) unsigned char lds_raw[];
    LAS unsigned char* lds = (LAS unsigned char*)lds_raw;
    volatile LAS unsigned* MISC = (volatile LAS unsigned*)(lds + MISC_OFF);
    const int tid = threadIdx.x;
    const int G = gridDim.x, bid = blockIdx.x, NGW = G * 8;
    unsigned char* ws = ldws(args);
    for (int u = tid; u < (LDS_BYTES - LDSCTL_OFF) / 4; u += 512) ((LAS unsigned*)(lds + LDSCTL_OFF))[u] = 0u;
    __syncthreads();
    (void)xcd_barrier_post((unsigned*)(ws + WS_CTL) + CW_BAR, MISC + 8);
#define RUN(id) true
#if defined(PROBE_MASK)
#define STAMP() do { if (threadIdx.x == 0) { ((volatile LAS unsigned long long*)(lds + LDSCTL_OFF + 1024))[nst] = __builtin_amdgcn_s_memrealtime(); } ++nst; } while (0)
#else
#define STAMP() do { } while (0)
#endif
#define SEAM(id) do { XcdBarrier bar_; bar_.bar = (unsigned*)WSP(WS_CTL) + CW_BAR; bar_.x = xb_xcc_id(); bar_.st = (volatile LAS unsigned*)(lds + MISC_OFF) + 8; xcd_barrier(bar_); STAMP(); } while (0)
#if defined(PROBE_MASK)
    int nst = 0; STAMP();
#endif
#define INP(i) ldin(args, (i))
#define WSP(off) (ldws(args) + (off))
#define x_in INP(0)
#define norm_mix INP(1)
#define w_in INP(2)
#define conv_lru_w INP(3)
#define conv_lru_b INP(4)
#define lru_w_r INP(5)
#define lru_b_r INP(6)
#define lru_w_i INP(7)
#define lru_b_i INP(8)
#define lru_lambda INP(9)
#define lru_out_norm INP(10)
#define conv_qkv_w INP(11)
#define dn_a_log INP(12)
#define dn_dt_bias INP(13)
#define dn_out_norm INP(14)
#define w_out INP(15)
#define norm_ffn INP(16)
#define ffn_w_gate INP(17)
#define ffn_w_up INP(18)
#define ffn_w_down INP(19)
#define moe_router INP(20)
#define moe_w_gate INP(21)
#define moe_w_up INP(22)
#define moe_w_down INP(23)
#define norm_final INP(24)
#define xres (ldout(args))
#define Win ((bf16*)WSP(WS_WIN))
#define Wba ((float*)WSP(WS_WBA))
#define Wout ((bf16*)WSP(WS_WOUT))
#define Wgu ((bf16*)WSP(WS_WGU))
#define Wd ((bf16*)WSP(WS_WD))
#define Mgu ((bf16*)WSP(WS_MG0))
#define Md ((bf16*)WSP(WS_WGU))
#define MCNT ((unsigned*)WSP(WS_CTL) + CW_CNT)
#define MLIST ((int*)WSP(WS_ROWW))
#define MLISTW ((float*)WSP(WS_ROWW + (size_t)8 * T * 4))
#define YP0 ((bf16*)WSP(WS_XB))
#define YP1 ((bf16*)WSP(WS_YMIX))
#define xb ((bf16*)WSP(WS_XB))
#define rstd ((float*)WSP(WS_RSTD))
#define SSQA ((float*)WSP(WS_RSTD + (size_t)1 * MiB))
#define SSQB ((float*)WSP(WS_RSTD + (size_t)3 * MiB))
#define WBAB ((bf16*)WSP(WS_WBA + (size_t)2 * 16 * D * 4))
#define ba ((float*)WSP(WS_BA))
#define beta ((float*)WSP(WS_BETA))
#define gg ((float*)WSP(WS_G))
#define roww ((float*)WSP(WS_ROWW))
#define proj ((bf16*)WSP(WS_PROJ))
#define hid ((bf16*)WSP(WS_PROJ))
#define ymix ((bf16*)WSP(WS_YMIX))
#define c0 ((float*)WSP(WS_C))
#define c1 ((float*)WSP(WS_C + (size_t)T * 1024 * 4))
#define c2 ((float*)WSP(WS_C + (size_t)2 * T * 1024 * 4))
#define c3 ((float*)WSP(WS_C + (size_t)3 * T * 1024 * 4))
#define LRU_WRT ((bf16*)WSP(WS_WRT))
#define LRU_WIT ((bf16*)WSP(WS_WRT + (size_t)2 * 8 * 128 * 128 * 2))
#define LRU_H ((float*)WSP(WS_C + (size_t)256 * MiB))
#define LRU_A ((float*)WSP(WS_C + (size_t)320 * MiB))
#define LRU_SUMM ((float*)WSP(WS_C + (size_t)384 * MiB))
#define LRU_CARRY ((float*)WSP(WS_C + (size_t)386 * MiB))
#define DN_WF ((bf16*)WSP(WS_C))
#define DN_QF ((bf16*)WSP(WS_C + (size_t)32 * MiB))
#define DN_KDTF ((bf16*)WSP(WS_C + (size_t)64 * MiB))
#define DN_UF ((bf16*)WSP(WS_C + (size_t)96 * MiB))
#define DN_QKF ((bf16*)WSP(WS_C + (size_t)128 * MiB))
#define DN_GL ((float*)WSP(WS_C + (size_t)144 * MiB))
#define DN_VF ((bf16*)WSP(WS_C + (size_t)146 * MiB))
#define DN_SF ((bf16*)WSP(WS_C + (size_t)192 * MiB))
    const int BIG = 1 << 30;
#define PHL int tid_ = threadIdx.x; asm volatile("" : "+v"(tid_)); const int lane_ = tid_ & 63; int bid_ = blockIdx.x; asm volatile("" : "+s"(bid_)); const int gw_ = bid_ * 8 + __builtin_amdgcn_readfirstlane(tid_ >> 6); const size_t gt_ = (size_t)bid_ * 512 + tid_, NGT = (size_t)G * 512; LAS float* scr = (LAS float*)(lds + (gw_ & 7) * 16384);
    if (RUN(ph)) { PHL
        convert_matrix(w_in, DIN, 0, D, NPROJ, norm_mix, Win, BIG, 0, 0, scr, gw_, NGW, lane_);
        convert_matrix(w_out, D, 0, D, D, nullptr, Wout, BIG, 0, 0, scr, gw_, NGW, lane_);
        for (size_t i = gt_; i < (size_t)2 * 16 * D; i += NGT) { const int l = (int)(i / (16 * D)), j = (int)((i / D) & 15), k = (int)(i % D); WBAB[i] = (bf16)f2bf(w_in[(size_t)l * D * DIN + (size_t)k * DIN + NPROJ + j] * norm_mix[l * D + k]); }
        for (int r = gw_; r < T; r += NGW) rowprep_row(x_in, xb, rstd, nullptr, nullptr, r, lane_);
        for (int m = 0; m < 16; ++m) {
            convert_matrix(lru_w_r + (size_t)m * 128 * 128, 128, 0, 128, 128, nullptr, LRU_WRT + (size_t)m * 128 * 128, BIG, 0, 0, scr, gw_, NGW, lane_);
            convert_matrix(lru_w_i + (size_t)m * 128 * 128, 128, 0, 128, 128, nullptr, LRU_WIT + (size_t)m * 128 * 128, BIG, 0, 0, scr, gw_, NGW, lane_); }
    }
    SEAM(ph);
    int xsel = 0;
#define xcur (xsel ? (const float*)xres : x_in)
    { constexpr int l = 0;
        if (RUN(ph)) { pg8::Gemm g{xb, Win + (size_t)l * NPROJ * D, T, NPROJ, D, 0}; pg8::StaticOrder S; S.init(T, NPROJ, G, bid); pg8::EpiScaleBf16 E{proj, l == 0 ? rstd : SSQB, NPROJ, l};
            pg8::gemm_phase<pg8::EpiScaleBf16, pg8::StaticOrder, true, false>(lds, g, S, E);
            { PHL for (int rb = bid_; rb < T / 64; rb += G) ba_tail(xb, WBAB + (size_t)l * 16 * D, l == 0 ? rstd : SSQB, l, ba, rb, gw_ & 7, lane_); } }
        SEAM(ph);
        if (RUN(ph)) { PHL
            LAS float* cwl = (LAS float*)(lds + LDSCTL_OFF + 4096); LAS float* lwl = cwl + 4 * 384;
            { const int hb = bid_ & 7; const float* cq = conv_qkv_w + (size_t)l * 4 * 3 * DDN; const float* cl = conv_lru_w + (size_t)l * 4 * DLRU; const float* cbp = conv_lru_b + l * DLRU;
              for (int i = tid_; i < 4 * 384; i += 512) { const int k = i / 384, pp = (i % 384) >> 7, d = i & 127; cwl[i] = cq[k * 3 * DDN + pp * DDN + hb * HD + d]; }
              for (int i = tid_; i < 640; i += 512) { const int k = i >> 7, d = i & 127; lwl[i] = k < 4 ? cl[k * DLRU + hb * 128 + d] : cbp[hb * 128 + d]; }
              __syncthreads(); }
            { const LruConst LC = lrua_const(LRU_WRT + (size_t)l * 8 * 128 * 128, LRU_WIT + (size_t)l * 8 * 128 * 128, lru_b_r + l * DLRU, lru_b_i + l * DLRU, lru_lambda + l * DLRU, bid_ & 7, lane_, gw_ & 7);
              for (int u = bid_; u < 2048; u += G) lrua_unit(proj, LC, LRU_H, LRU_A, LRU_SUMM, u, lds, lwl, tid_, lane_, gw_ & 7); }
            STAMP();
            for (int uid = bid_; uid < 2048; uid += G) dna_unit(proj, conv_qkv_w + (size_t)l * 4 * 3 * DDN, ba, dn_a_log + l * NH, dn_dt_bias + l * NH, DN_WF, DN_QF, DN_KDTF, DN_QKF, DN_UF, DN_GL, uid, lds, cwl, tid_, lane_, gw_ & 7); }
        SEAM(ph);
        if (RUN(ph)) { PHL
            if (bid_ < 128) dnb_run(DN_WF, DN_KDTF, DN_UF, DN_GL, DN_SF, DN_VF, (bid_ & 7) + 8 * (bid_ >> 6), (bid_ >> 3) & 7, lds, tid_, lane_, gw_ & 7);
            else { if (bid_ < 136 && tid_ < 256) lru_carry(LRU_SUMM, LRU_CARRY, (bid_ - 128) * 256 + tid_);
                const int cw = gw_ - 128 * 8, CNW = NGW - 128 * 8;
                if (l == 0) {
                    convert_matrix(w_in + (size_t)D * DIN, DIN, 0, D, NPROJ, norm_mix + D, Win + (size_t)NPROJ * D, BIG, 0, 0, scr, cw, CNW, lane_);
                    convert_matrix(w_out + (size_t)D * D, D, 0, D, D, nullptr, Wout + (size_t)D * D, BIG, 0, 0, scr, cw, CNW, lane_);
                    convert_matrix(ffn_w_gate, DFF, 0, D, DFF, norm_ffn, Wgu, 128, 256, 0, scr, cw, CNW, lane_);
                    convert_matrix(ffn_w_up, DFF, 0, D, DFF, norm_ffn, Wgu, 128, 256, 128, scr, cw, CNW, lane_);
                    convert_matrix(ffn_w_down, D, 0, DFF, D, nullptr, Wd, BIG, 0, 0, scr, cw, CNW, lane_);
                } else {
                    for (int e = 0; e < NEXP; ++e) convert_matrix(moe_w_down + (size_t)e * DFFE * D, D, 0, DFFE, D, nullptr, Md + (size_t)e * D * DFFE, BIG, 0, 0, scr, cw, CNW, lane_);
                    for (int e = 0; e < 2; ++e) {
                        convert_matrix(moe_w_gate + (size_t)e * D * DFFE, DFFE, 0, D, DFFE, norm_ffn + D, Mgu + (size_t)e * 2 * DFFE * D, 128, 256, 0, scr, cw, CNW, lane_);
                        convert_matrix(moe_w_up + (size_t)e * D * DFFE, DFFE, 0, D, DFFE, norm_ffn + D, Mgu + (size_t)e * 2 * DFFE * D, 128, 256, 128, scr, cw, CNW, lane_); }
                } } }
        SEAM(ph);
        if (RUN(ph)) { PHL
            for (int r = gw_; r < T; r += NGW) lrub_row(LRU_H, LRU_A, LRU_CARRY, proj, lru_out_norm + l * DLRU, ymix, r, lane_);
            dno_run(DN_QF, DN_QKF, DN_SF, DN_VF, dn_out_norm + l * HD, proj, ymix, bid_, G, lds, tid_, lane_, gw_ & 7); }
        SEAM(ph);
        if (RUN(ph)) { if (l == 0) { pg8::Gemm g{ymix, Wout, T, D, D, 0}; pg8::StaticOrder S; S.init(T, D, G, bid); pg8::EpiResidualNorm E{xcur, xres, xb, SSQA, D, 0};
            pg8::gemm_phase<pg8::EpiResidualNorm, pg8::StaticOrder, true, false>(lds, g, S, E); }
          else { pg8::Gemm g{ymix, Wout + (size_t)D * D, T, D, D, 0}; pg8::StaticOrder S; S.init(T, D, G, bid); pg8::EpiResidual E{xcur, xres, nullptr, D, 0};
            pg8::gemm_phase<pg8::EpiResidual, pg8::StaticOrder, true, false>(lds, g, S, E); }
            if (l == 1) { PHL
                for (int e = 2; e < NEXP; ++e) {
                    convert_matrix(moe_w_gate + (size_t)e * D * DFFE, DFFE, 0, D, DFFE, norm_ffn + D, Mgu + (size_t)e * 2 * DFFE * D, 128, 256, 0, scr, gw_, NGW, lane_);
                    convert_matrix(moe_w_up + (size_t)e * D * DFFE, DFFE, 0, D, DFFE, norm_ffn + D, Mgu + (size_t)e * 2 * DFFE * D, 128, 256, 128, scr, gw_, NGW, lane_);
 } } }
        SEAM(ph);
        xsel = 1;
        if (l == 0) {
            if (RUN(ph)) { pg8::Gemm g{xb, Wgu, T, 2 * DFF, D, 0}; pg8::StaticOrder S; S.init(T, 2 * DFF, G, bid); pg8::EpiSwiGLU E{hid, SSQA, DFF, 1};
                pg8::gemm_phase<pg8::EpiSwiGLU, pg8::StaticOrder, true, false>(lds, g, S, E); }
            SEAM(ph);
            if (RUN(ph)) { pg8::Gemm g{hid, Wd, T, D, DFF, 0}; pg8::StaticOrder S; S.init(T, D, G, bid); pg8::EpiResidualNorm E{xcur, xres, xb, SSQB, D, 0};
                pg8::gemm_phase<pg8::EpiResidualNorm, pg8::StaticOrder, true, false>(lds, g, S, E); }
            SEAM(ph);
        } else {
            if (RUN(ph)) { PHL for (int blk = bid_; blk < T / 64; blk += G) route_block(xcur, norm_ffn + D, moe_router, xb, rstd, MCNT, MLIST, MLISTW, blk, lds, tid_, lane_, gw_ & 7); }
            SEAM(ph);
            if (RUN(ph)) { pg8::Gemm g{xb, Mgu, NSLOT, 2 * DFFE, D, 0}; MoeOrder S; S.init(MCNT, MLIST, 2 * DFFE / 256, G, bid); pg8::EpiSwiGLUMoe E{hid, rstd, MLIST, DFFE, 0};
                pg8::gemm_phase<pg8::EpiSwiGLUMoe, MoeOrder, true, true>(lds, g, S, E); }
            SEAM(ph);
            if (RUN(ph)) { pg8::Gemm g{hid, Md, NSLOT, D, DFFE, 0}; MoeOrder S; S.init(MCNT, MLIST, D / 256, G, bid); pg8::EpiMoeDown E{YP0, YP1, MLIST, MLISTW, D, 0};
                pg8::gemm_phase<pg8::EpiMoeDown, MoeOrder, true, false>(lds, g, S, E); }
            SEAM(ph);
        }
    }
    { constexpr int l = 1;
        if (RUN(ph)) { pg8::Gemm g{xb, Win + (size_t)l * NPROJ * D, T, NPROJ, D, 0}; pg8::StaticOrder S; S.init(T, NPROJ, G, bid); pg8::EpiScaleBf16 E{proj, l == 0 ? rstd : SSQB, NPROJ, l};
            pg8::gemm_phase<pg8::EpiScaleBf16, pg8::StaticOrder, true, false>(lds, g, S, E);
            { PHL for (int rb = bid_; rb < T / 64; rb += G) ba_tail(xb, WBAB + (size_t)l * 16 * D, l == 0 ? rstd : SSQB, l, ba, rb, gw_ & 7, lane_); } }
        SEAM(ph);
        if (RUN(ph)) { PHL
            LAS float* cwl = (LAS float*)(lds + LDSCTL_OFF + 4096); LAS float* lwl = cwl + 4 * 384;
            { const int hb = bid_ & 7; const float* cq = conv_qkv_w + (size_t)l * 4 * 3 * DDN; const float* cl = conv_lru_w + (size_t)l * 4 * DLRU; const float* cbp = conv_lru_b + l * DLRU;
              for (int i = tid_; i < 4 * 384; i += 512) { const int k = i / 384, pp = (i % 384) >> 7, d = i & 127; cwl[i] = cq[k * 3 * DDN + pp * DDN + hb * HD + d]; }
              for (int i = tid_; i < 640; i += 512) { const int k = i >> 7, d = i & 127; lwl[i] = k < 4 ? cl[k * DLRU + hb * 128 + d] : cbp[hb * 128 + d]; }
              __syncthreads(); }
            { const LruConst LC = lrua_const(LRU_WRT + (size_t)l * 8 * 128 * 128, LRU_WIT + (size_t)l * 8 * 128 * 128, lru_b_r + l * DLRU, lru_b_i + l * DLRU, lru_lambda + l * DLRU, bid_ & 7, lane_, gw_ & 7);
              for (int u = bid_; u < 2048; u += G) lrua_unit(proj, LC, LRU_H, LRU_A, LRU_SUMM, u, lds, lwl, tid_, lane_, gw_ & 7); }
            STAMP();
            for (int uid = bid_; uid < 2048; uid += G) dna_unit(proj, conv_qkv_w + (size_t)l * 4 * 3 * DDN, ba, dn_a_log + l * NH, dn_dt_bias + l * NH, DN_WF, DN_QF, DN_KDTF, DN_QKF, DN_UF, DN_GL, uid, lds, cwl, tid_, lane_, gw_ & 7); }
        SEAM(ph);
        if (RUN(ph)) { PHL
            if (bid_ < 128) dnb_run(DN_WF, DN_KDTF, DN_UF, DN_GL, DN_SF, DN_VF, (bid_ & 7) + 8 * (bid_ >> 6), (bid_ >> 3) & 7, lds, tid_, lane_, gw_ & 7);
            else { if (bid_ < 136 && tid_ < 256) lru_carry(LRU_SUMM, LRU_CARRY, (bid_ - 128) * 256 + tid_);
                const int cw = gw_ - 128 * 8, CNW = NGW - 128 * 8;
                if (l == 0) {
                    convert_matrix(w_in + (size_t)D * DIN, DIN, 0, D, NPROJ, norm_mix + D, Win + (size_t)NPROJ * D, BIG, 0, 0, scr, cw, CNW, lane_);
                    convert_matrix(w_out + (size_t)D * D, D, 0, D, D, nullptr, Wout + (size_t)D * D, BIG, 0, 0, scr, cw, CNW, lane_);
                    convert_matrix(ffn_w_gate, DFF, 0, D, DFF, norm_ffn, Wgu, 128, 256, 0, scr, cw, CNW, lane_);
                    convert_matrix(ffn_w_up, DFF, 0, D, DFF, norm_ffn, Wgu, 128, 256, 128, scr, cw, CNW, lane_);
                    convert_matrix(ffn_w_down, D, 0, DFF, D, nullptr, Wd, BIG, 0, 0, scr, cw, CNW, lane_);
                } else {
                    for (int e = 0; e < NEXP; ++e) convert_matrix(moe_w_down + (size_t)e * DFFE * D, D, 0, DFFE, D, nullptr, Md + (size_t)e * D * DFFE, BIG, 0, 0, scr, cw, CNW, lane_);
                    for (int e = 0; e < 2; ++e) {
                        convert_matrix(moe_w_gate + (size_t)e * D * DFFE, DFFE, 0, D, DFFE, norm_ffn + D, Mgu + (size_t)e * 2 * DFFE * D, 128, 256, 0, scr, cw, CNW, lane_);
                        convert_matrix(moe_w_up + (size_t)e * D * DFFE, DFFE, 0, D, DFFE, norm_ffn + D, Mgu + (size_t)e * 2 * DFFE * D, 128, 256, 128, scr, cw, CNW, lane_); }
                } } }
        SEAM(ph);
        if (RUN(ph)) { PHL
            for (int r = gw_; r < T; r += NGW) lrub_row(LRU_H, LRU_A, LRU_CARRY, proj, lru_out_norm + l * DLRU, ymix, r, lane_);
            dno_run(DN_QF, DN_QKF, DN_SF, DN_VF, dn_out_norm + l * HD, proj, ymix, bid_, G, lds, tid_, lane_, gw_ & 7); }
        SEAM(ph);
        if (RUN(ph)) { if (l == 0) { pg8::Gemm g{ymix, Wout, T, D, D, 0}; pg8::StaticOrder S; S.init(T, D, G, bid); pg8::EpiResidualNorm E{xcur, xres, xb, SSQA, D, 0};
            pg8::gemm_phase<pg8::EpiResidualNorm, pg8::StaticOrder, true, false>(lds, g, S, E); }
          else { pg8::Gemm g{ymix, Wout + (size_t)D * D, T, D, D, 0}; pg8::StaticOrder S; S.init(T, D, G, bid); pg8::EpiResidual E{xcur, xres, nullptr, D, 0};
            pg8::gemm_phase<pg8::EpiResidual, pg8::StaticOrder, true, false>(lds, g, S, E); }
            if (l == 1) { PHL
                for (int e = 2; e < NEXP; ++e) {
                    convert_matrix(moe_w_gate + (size_t)e * D * DFFE, DFFE, 0, D, DFFE, norm_ffn + D, Mgu + (size_t)e * 2 * DFFE * D, 128, 256, 0, scr, gw_, NGW, lane_);
                    convert_matrix(moe_w_up + (size_t)e * D * DFFE, DFFE, 0, D, DFFE, norm_ffn + D, Mgu + (size_t)e * 2 * DFFE * D, 128, 256, 128, scr, gw_, NGW, lane_);
 } } }
        SEAM(ph);
        xsel = 1;
        if (l == 0) {
            if (RUN(ph)) { pg8::Gemm g{xb, Wgu, T, 2 * DFF, D, 0}; pg8::StaticOrder S; S.init(T, 2 * DFF, G, bid); pg8::EpiSwiGLU E{hid, SSQA, DFF, 1};
                pg8::gemm_phase<pg8::EpiSwiGLU, pg8::StaticOrder, true, false>(lds, g, S, E); }
            SEAM(ph);
            if (RUN(ph)) { pg8::Gemm g{hid, Wd, T, D, DFF, 0}; pg8::StaticOrder S; S.init(T, D, G, bid); pg8::EpiResidualNorm E{xcur, xres, xb, SSQB, D, 0};
                pg8::gemm_phase<pg8::EpiResidualNorm, pg8::StaticOrder, true, false>(lds, g, S, E); }
            SEAM(ph);
        } else {
            if (RUN(ph)) { PHL for (int blk = bid_; blk < T / 64; blk += G) route_block(xcur, norm_ffn + D, moe_router, xb, rstd, MCNT, MLIST, MLISTW, blk, lds, tid_, lane_, gw_ & 7); }
            SEAM(ph);
            if (RUN(ph)) { pg8::Gemm g{xb, Mgu, NSLOT, 2 * DFFE, D, 0}; MoeOrder S; S.init(MCNT, MLIST, 2 * DFFE / 256, G, bid); pg8::EpiSwiGLUMoe E{hid, rstd, MLIST, DFFE, 0};
                pg8::gemm_phase<pg8::EpiSwiGLUMoe, MoeOrder, true, true>(lds, g, S, E); }
            SEAM(ph);
            if (RUN(ph)) { pg8::Gemm g{hid, Md, NSLOT, D, DFFE, 0}; MoeOrder S; S.init(MCNT, MLIST, D / 256, G, bid); pg8::EpiMoeDown E{YP0, YP1, MLIST, MLISTW, D, 0};
                pg8::gemm_phase<pg8::EpiMoeDown, MoeOrder, true, false>(lds, g, S, E); }
            SEAM(ph);
        }
    }
    if (RUN(ph)) { PHL for (int r = gw_; r < T; r += NGW) final_row_moe(xcur, YP0, YP1, norm_final, xres, r, lane_); }
#if defined(PROBE_MASK)
    __syncthreads(); STAMP();
    if (blockIdx.x == 0 && threadIdx.x == 0) { asm volatile("s_waitcnt vmcnt(0)" ::: "memory"); volatile LAS unsigned long long* st = (volatile LAS unsigned long long*)(lds + LDSCTL_OFF + 1024); unsigned long long tot = 0;
        for (int k = 1; k < nst; ++k) if ((PROBE_MASK >> (k - 1)) & 1ull) tot += st[k] - st[k - 1];
        xres[0] = rintf((float)tot * 0.01f * PROBE_SCALE); }
#endif
#if defined(PROBE_DNA_A)
    __syncthreads();
    if (blockIdx.x == 0 && threadIdx.x == 0) { asm volatile("s_waitcnt vmcnt(0)" ::: "memory"); volatile LAS unsigned long long* st = (volatile LAS unsigned long long*)(lds + (RING_BYTES + 2048));
        xres[0] = rintf((float)(st[PROBE_DNA_B] - st[PROBE_DNA_A]) * 0.01f * PROBE_SCALE); }
#endif
#undef RUN
#undef SEAM
}

extern "C" void kernel_launch(void* const* d_in, const int* in_sizes, int n_in, void* d_out, int out_size, void* d_ws, size_t ws_size, hipStream_t stream) {
    static int grid = 0;
    if (grid == 0) {
        if (n_in != 25 || ws_size < WS_END) { fprintf(stderr, "kernel_launch: unexpected n_in %d / ws_size %zu (need %zu)\n", n_in, ws_size, (size_t)WS_END); grid = -1; return; }
        int dev = 0, cus = 0, per_cu = 0;
        if (hipGetDevice(&dev) != hipSuccess || hipDeviceGetAttribute(&cus, hipDeviceAttributeMultiprocessorCount, dev) != hipSuccess) { grid = -1; return; }
        if (hipFuncSetAttribute((const void*)mega, hipFuncAttributeMaxDynamicSharedMemorySize, LDS_BYTES) != hipSuccess) { fprintf(stderr, "kernel_launch: hipFuncSetAttribute failed\n"); grid = -1; return; }
        if (hipOccupancyMaxActiveBlocksPerMultiprocessor(&per_cu, (const void*)mega, 512, LDS_BYTES) != hipSuccess || per_cu < 1) { fprintf(stderr, "kernel_launch: occupancy query says %d\n", per_cu); }
        (void)hipGetLastError();
        grid = cus;
    }
    if (grid < 0) return;
    if (hipMemsetAsync((char*)d_ws + WS_CTL, 0, CTL_ZERO_BYTES, stream) != hipSuccess) return;
    Args a{};
    for (int i = 0; i < 25; ++i) a.in[i] = (const float*)d_in[i];
    a.out = (float*)d_out; a.ws = (unsigned char*)d_ws; a.ph_lo = 0; a.ph_hi = 1 << 30;
    hipLaunchKernelGGL(mega, dim3(grid), dim3(512), LDS_BYTES, stream, a);
}
```

```cpp
#include <hip/hip_runtime.h>
#include <cstdio>
#include <cstdint>
namespace pg8 {
#define PG8_LAS __attribute__((address_space(3)))
typedef unsigned short bf16_t;
typedef short bf16x8 __attribute__((ext_vector_type(8)));
typedef float f32x4 __attribute__((ext_vector_type(4)));
typedef unsigned u32x4 __attribute__((ext_vector_type(4)));
constexpr int BM = 256, BK = 64, HALF = 128, HTB = HALF * BK * 2  , STAGE_BYTES = 8 * HTB, NXCD = 8, WGM = 8;

__host__ __device__ __forceinline__ int lds_byte(int r, int c) { const int st = (r >> 4) * 2 + (c >> 5), rr = r & 15, cc = c & 31, ob = rr * 64 + cc * 2; return st * 1024 + (ob ^ (((ob >> 9) & 1) << 5)); }
__host__ __device__ __forceinline__ void stage_rc(int b, int& R, int& C) { const int st = b / 1024, sb = b % 1024, swz = sb ^ (((sb >> 9) & 1) << 5); R = (st >> 1) * 16 + swz / 64; C = (st & 1) * 32 + (swz % 64) / 2; }
__host__ __device__ __forceinline__ int perm32(int rho) { const int n = rho >> 4, i = rho & 15; return 8 * (i >> 2) + 4 * n + (i & 3); }

struct Unit { int pm, pn, pb, lbase, nvalid; };
struct Gemm { const bf16_t* A; const bf16_t* Bt; int M, N, K, pad; };

struct StaticOrder {
    int nM, nN, nwg, G, c;
    __host__ __device__ void init(int M, int N, int G_, int c_) { nM = M / BM; nN = N / BM; nwg = nM * nN; G = G_; c = c_; }
    __host__ __device__ bool next(int i, Unit& u) const {
        const long L = (long)i * G + c; if (L >= nwg) return false;
        int wgid = (int)L; { const int q = nwg / NXCD, r = nwg % NXCD, xcd = wgid % NXCD, off = wgid / NXCD; wgid = (xcd < r ? xcd * (q + 1) : r * (q + 1) + (xcd - r) * q) + off; }
        const int nig = WGM * nN, gid = wgid / nig, fm = gid * WGM, gsz = (nM - fm) < WGM ? (nM - fm) : WGM;
        u.pm = fm + ((wgid % nig) % gsz); u.pn = (wgid % nig) / gsz; u.pb = u.pn; u.lbase = 0; u.nvalid = BM; return true;
    }
    __device__ __forceinline__ int arow(const Unit&, int) const { return 0; }
    __device__ __forceinline__ void a_ready(const Unit&) const {}
    __device__ __forceinline__ void done(const Unit&) const {}
};


typedef float f32x2_t __attribute__((ext_vector_type(2)));
typedef __bf16 bf16x2_t __attribute__((ext_vector_type(2)));
typedef unsigned u32x2_t __attribute__((ext_vector_type(2)));
__device__ __forceinline__ unsigned cvt_pk_bf16(float lo, float hi) { const f32x2_t v = {lo, hi}; const bf16x2_t b = __builtin_convertvector(v, bf16x2_t); return __builtin_bit_cast(unsigned, b); }
__device__ __forceinline__ float frcp(float x) { return __builtin_amdgcn_rcpf(x); }
__device__ __forceinline__ float rsqrt_f(float x) { return __builtin_amdgcn_rsqf(x); }
__device__ __forceinline__ float silu_f(float x) { return x * frcp(1.0f + __expf(-x)); }
__device__ __forceinline__ float swiglu_f(float g, float u, float k1, float s2) { return (g * u) * (s2 * frcp(1.0f + __builtin_amdgcn_exp2f(g * k1))); }
__device__ __forceinline__ float row_scale(const float* rs, int r, int mode) {
    if (!mode) return rs[r];
    const f32x4* p = (const f32x4*)(rs + (size_t)r * 32); float s = 0.f;
#pragma unroll
    for (int i = 0; i < 8; ++i) { const f32x4 v = p[i]; s += (v[0] + v[1]) + (v[2] + v[3]); }
    return rsqrt_f(s * (1.0f / 2048.0f) + 1e-6f);
}
__device__ __forceinline__ void row_scales8(const float* rs, int row0, int fr, int fq, int mode, float (&sc)[2][4]) {
    if (!mode) {
#pragma unroll
        for (int ai = 0; ai < 2; ++ai)
#pragma unroll
            for (int m = 0; m < 4; ++m) sc[ai][m] = rs[row0 + ai * HALF + m * 16];
    } else {
        const int lane = fr + 16 * fq; f32x4 pa[2][4][2];
#pragma unroll
        for (int ai = 0; ai < 2; ++ai)
#pragma unroll
            for (int m = 0; m < 4; ++m) { const f32x4* p = (const f32x4*)(rs + (size_t)(row0 + ai * HALF + m * 16) * 32 + fq * 8); pa[ai][m][0] = p[0]; pa[ai][m][1] = p[1]; }
#pragma unroll
        for (int ai = 0; ai < 2; ++ai)
#pragma unroll
            for (int m = 0; m < 4; ++m) { const f32x4 a = pa[ai][m][0], b = pa[ai][m][1]; float t = ((a[0] + a[1]) + (a[2] + a[3])) + ((b[0] + b[1]) + (b[2] + b[3]));
                t += __int_as_float(__builtin_amdgcn_ds_bpermute((lane ^ 16) << 2, __float_as_int(t)));
                t += __int_as_float(__builtin_amdgcn_ds_bpermute((lane ^ 32) << 2, __float_as_int(t)));
                sc[ai][m] = rsqrt_f(t * (1.0f / 2048.0f) + 1e-6f); }
    }
}
struct EpiScaleBf16 {
    static constexpr bool PERM = true, AFTER_DRAIN = false;
    bf16_t* O; const float* rs; int ldc; int pad;
    __device__ __forceinline__ void operator()(const f32x4 (&acc)[2][2][4][2], const Unit& u, int wr, int wc, int fr, int fq) const {
        const int row0 = u.pm * BM + wr * 64 + fr, col0 = u.pn * BM + wc * 32 + 8 * fq;
        float sc[2][4]; row_scales8(rs, row0, fr, fq, pad, sc);
#pragma unroll
        for (int ai = 0; ai < 2; ++ai)
#pragma unroll
            for (int m = 0; m < 4; ++m) { const int r = row0 + ai * HALF + m * 16; const float s = sc[ai][m]; bf16_t* rowp = O + (size_t)r * ldc + col0;
#pragma unroll
                for (int bj = 0; bj < 2; ++bj) { const f32x4 v0 = acc[ai][bj][m][0] * s, v1 = acc[ai][bj][m][1] * s;
                    u32x4 w; w.x = cvt_pk_bf16(v0[0], v0[1]); w.y = cvt_pk_bf16(v0[2], v0[3]); w.z = cvt_pk_bf16(v1[0], v1[1]); w.w = cvt_pk_bf16(v1[2], v1[3]);
                    *(u32x4*)(rowp + bj * HALF) = w; } }
    }
};
struct EpiSwiGLU {
    static constexpr bool PERM = true, AFTER_DRAIN = false;
    bf16_t* O; const float* rs; int ldc; int pad;
    __device__ __forceinline__ void operator()(const f32x4 (&acc)[2][2][4][2], const Unit& u, int wr, int wc, int fr, int fq) const {
        const int row0 = u.pm * BM + wr * 64 + fr, col0 = u.pn * HALF + wc * 32 + 8 * fq;
        float sc[2][4]; row_scales8(rs, row0, fr, fq, pad, sc);
#pragma unroll
        for (int ai = 0; ai < 2; ++ai)
#pragma unroll
            for (int m = 0; m < 4; ++m) { const int r = row0 + ai * HALF + m * 16; const float s = sc[ai][m], k1 = s * -1.4426950408889634f, s2 = s * s; bf16_t* rowp = O + (size_t)r * ldc + col0;
                f32x4 h0, h1;
#pragma unroll
                for (int j = 0; j < 4; ++j) { h0[j] = swiglu_f(acc[ai][0][m][0][j], acc[ai][1][m][0][j], k1, s2); h1[j] = swiglu_f(acc[ai][0][m][1][j], acc[ai][1][m][1][j], k1, s2); }
                u32x4 w; w.x = cvt_pk_bf16(h0[0], h0[1]); w.y = cvt_pk_bf16(h0[2], h0[3]); w.z = cvt_pk_bf16(h1[0], h1[1]); w.w = cvt_pk_bf16(h1[2], h1[3]);
                *(u32x4*)rowp = w; }
    }
};
struct EpiResidual {
    static constexpr bool PERM = false, AFTER_DRAIN = false;
    const float* base; float* out; const float* roww; int ldc; int pad;
    __device__ __forceinline__ void operator()(const f32x4 (&acc)[2][2][4][2], const Unit& u, int wr, int wc, int fr, int fq) const {
        const int row0 = u.pm * BM + wr * 64 + fr, col0 = u.pn * BM + wc * 32 + 4 * fq;
#pragma unroll
        for (int ai = 0; ai < 2; ++ai)
#pragma unroll
            for (int m = 0; m < 4; ++m) { const int r = row0 + ai * HALF + m * 16; const float w = roww ? roww[r] : 1.0f; const size_t off = (size_t)r * ldc + col0;
#pragma unroll
                for (int bj = 0; bj < 2; ++bj)
#pragma unroll
                    for (int n = 0; n < 2; ++n) { const f32x4 bs = *(const f32x4*)(base + off + bj * HALF + n * 16); *(f32x4*)(out + off + bj * HALF + n * 16) = bs + acc[ai][bj][m][n] * w; } }
    }
};

struct EpiSwiGLUMoe {
    static constexpr bool PERM = true, AFTER_DRAIN = false;
    bf16_t* O; const float* rs; const int* list; int ldc; int pad;
    __device__ __forceinline__ void operator()(const f32x4 (&acc)[2][2][4][2], const Unit& u, int wr, int wc, int fr, int fq) const {
        const int rl0 = wr * 64 + fr, col0 = u.pn * HALF + wc * 32 + 8 * fq;
#pragma unroll
        for (int ai = 0; ai < 2; ++ai)
#pragma unroll
            for (int m = 0; m < 4; ++m) { const int rl = rl0 + ai * HALF + m * 16; const int tok = rl < u.nvalid ? (list[u.lbase + rl] & 0xffff) : 0; const float s = rs[tok], k1 = s * -1.4426950408889634f, s2 = s * s;
                bf16_t* rowp = O + (size_t)(u.pm * BM + rl) * ldc + col0;
                f32x4 h0, h1;
#pragma unroll
                for (int j = 0; j < 4; ++j) { h0[j] = swiglu_f(acc[ai][0][m][0][j], acc[ai][1][m][0][j], k1, s2); h1[j] = swiglu_f(acc[ai][0][m][1][j], acc[ai][1][m][1][j], k1, s2); }
                u32x4 w; w.x = cvt_pk_bf16(h0[0], h0[1]); w.y = cvt_pk_bf16(h0[2], h0[3]); w.z = cvt_pk_bf16(h1[0], h1[1]); w.w = cvt_pk_bf16(h1[2], h1[3]);
                *(u32x4*)rowp = w; }
    }
};
__device__ __forceinline__ unsigned cvt_pk4_fp8(float a, float b, float c, float d) {
    int w = 0;
    w = __builtin_amdgcn_cvt_pk_fp8_f32(__builtin_amdgcn_fmed3f(a, 448.f, -448.f), __builtin_amdgcn_fmed3f(b, 448.f, -448.f), w, false);
    w = __builtin_amdgcn_cvt_pk_fp8_f32(__builtin_amdgcn_fmed3f(c, 448.f, -448.f), __builtin_amdgcn_fmed3f(d, 448.f, -448.f), w, true);
    return (unsigned)w;
}
struct EpiSwiGLUMoe8 {
    static constexpr bool PERM = true, AFTER_DRAIN = false;
    unsigned char* O; const float* rs; const int* list; int ldc; float hs;
    __device__ __forceinline__ void operator()(const f32x4 (&acc)[2][2][4][2], const Unit& u, int wr, int wc, int fr, int fq) const {
        const int rl0 = wr * 64 + fr, col0 = u.pn * HALF + wc * 32 + 8 * fq;
#pragma unroll
        for (int ai = 0; ai < 2; ++ai)
#pragma unroll
            for (int m = 0; m < 4; ++m) { const int rl = rl0 + ai * HALF + m * 16; const int tok = rl < u.nvalid ? (list[u.lbase + rl] & 0xffff) : 0; const float s = rs[tok], k1 = s * -1.4426950408889634f, s2 = s * s * hs;
                unsigned char* rowp = O + (size_t)(u.pm * BM + rl) * ldc + col0;
                f32x4 h0, h1;
#pragma unroll
                for (int j = 0; j < 4; ++j) { h0[j] = swiglu_f(acc[ai][0][m][0][j], acc[ai][1][m][0][j], k1, s2); h1[j] = swiglu_f(acc[ai][0][m][1][j], acc[ai][1][m][1][j], k1, s2); }
                u32x2_t w; w.x = cvt_pk4_fp8(h0[0], h0[1], h0[2], h0[3]); w.y = cvt_pk4_fp8(h1[0], h1[1], h1[2], h1[3]);
                *(u32x2_t*)rowp = w; }
    }
};
struct EpiMoeDown {
    static constexpr bool PERM = true, AFTER_DRAIN = false;
    bf16_t* Y0; bf16_t* Y1; const int* list; const float* lw; int ldc; int pad;
    __device__ __forceinline__ void operator()(const f32x4 (&acc)[2][2][4][2], const Unit& u, int wr, int wc, int fr, int fq) const {
        const int rl0 = wr * 64 + fr, col0 = u.pn * BM + wc * 32 + 8 * fq;
#pragma unroll
        for (int ai = 0; ai < 2; ++ai)
#pragma unroll
            for (int m = 0; m < 4; ++m) { const int rl = rl0 + ai * HALF + m * 16;
                if (rl < u.nvalid) { const int en = list[u.lbase + rl]; const float w = lw[u.lbase + rl]; bf16_t* rowp = ((en >> 16) ? Y1 : Y0) + (size_t)(en & 0xffff) * ldc + col0;
#pragma unroll
                    for (int bj = 0; bj < 2; ++bj) { const f32x4 v0 = acc[ai][bj][m][0] * w, v1 = acc[ai][bj][m][1] * w;
                        u32x4 o; o.x = cvt_pk_bf16(v0[0], v0[1]); o.y = cvt_pk_bf16(v0[2], v0[3]); o.z = cvt_pk_bf16(v1[0], v1[1]); o.w = cvt_pk_bf16(v1[2], v1[3]);
                        *(u32x4*)(rowp + bj * HALF) = o; } } }
    }
};

struct EpiResidualNorm {
    static constexpr bool PERM = true, AFTER_DRAIN = false;
    const float* base; float* out; bf16_t* xb; float* ssq; int ldc; int pad;
    __device__ __forceinline__ void operator()(const f32x4 (&acc)[2][2][4][2], const Unit& u, int wr, int wc, int fr, int fq) const {
        const int row0 = u.pm * BM + wr * 64 + fr, col0 = u.pn * BM + wc * 32 + 8 * fq, lane = fr + 16 * fq;
#pragma unroll
        for (int ai = 0; ai < 2; ++ai)
#pragma unroll
            for (int m = 0; m < 4; ++m) { const int r = row0 + ai * HALF + m * 16; const size_t off = (size_t)r * ldc + col0; float part = 0.f;
#pragma unroll
                for (int bj = 0; bj < 2; ++bj) { const f32x4 b0 = *(const f32x4*)(base + off + bj * HALF), b1 = *(const f32x4*)(base + off + bj * HALF + 4);
                    const f32x4 v0 = b0 + acc[ai][bj][m][0], v1 = b1 + acc[ai][bj][m][1];
                    *(f32x4*)(out + off + bj * HALF) = v0; *(f32x4*)(out + off + bj * HALF + 4) = v1;
                    u32x4 w; w.x = cvt_pk_bf16(v0[0], v0[1]); w.y = cvt_pk_bf16(v0[2], v0[3]); w.z = cvt_pk_bf16(v1[0], v1[1]); w.w = cvt_pk_bf16(v1[2], v1[3]);
                    *(u32x4*)(xb + off + bj * HALF) = w;
                    part += (v0[0] * v0[0] + v0[1] * v0[1]) + (v0[2] * v0[2] + v0[3] * v0[3]) + (v1[0] * v1[0] + v1[1] * v1[1]) + (v1[2] * v1[2] + v1[3] * v1[3]); }
                part += __int_as_float(__builtin_amdgcn_ds_bpermute((lane ^ 16) << 2, __float_as_int(part)));
                part += __int_as_float(__builtin_amdgcn_ds_bpermute((lane ^ 32) << 2, __float_as_int(part)));
                if (fq == 0) ssq[(size_t)r * 32 + u.pn * 4 + wc] = part; }
    }
};
typedef int i32x4_t __attribute__((ext_vector_type(4)));
typedef int i32x8_t __attribute__((ext_vector_type(8)));
__device__ __forceinline__ i32x8_t cat8(bf16x8 a, bf16x8 b) { const i32x4_t x = __builtin_bit_cast(i32x4_t, a), y = __builtin_bit_cast(i32x4_t, b); return __builtin_shufflevector(x, y, 0, 1, 2, 3, 4, 5, 6, 7); }
__device__ __forceinline__ void mfma_f8(f32x4& acc, const i32x8_t& a, const i32x8_t& b) { asm volatile("v_mfma_f32_16x16x128_f8f6f4 %0, %1, %2, %0" : "+v"(acc) : "v"(a), "v"(b)); }
template <class Epi, class Sched, bool ALIGN_EPI = false, bool GATHER = false, bool F8 = false>
__device__ __forceinline__ void gemm_phase(PG8_LAS unsigned char* lds, const Gemm g, const Sched& S, const Epi& E) {
    int tid_o = threadIdx.x; asm volatile("" : "+v"(tid_o));
    const int tid = tid_o, wid = __builtin_amdgcn_readfirstlane(tid >> 6), lane = tid & 63, wr = wid >> 2, wc = wid & 3, fr = lane & 15, fq = lane >> 4;
    const int K = g.K, nt = K / BK;
    const size_t kstep = (size_t)(BK * 2);
    const size_t hstep = (size_t)HALF * K * 2;
    const size_t tstep = 2 * hstep;
    unsigned voffA[2], voffB[2], oA[2][2], oN[2][2];
#pragma unroll
    for (int i = 0; i < 2; ++i) { int R, C; stage_rc(tid * 16 + i * 8192, R, C); const int Rb = Epi::PERM ? ((R & ~31) + perm32(R & 31)) : R; voffA[i] = (unsigned)(R * K + C) * 2u; voffB[i] = (unsigned)(Rb * K + C) * 2u; }
    const unsigned ldsw = (unsigned)wid * 1024u;
    const int aoff = lds_byte(wr * 64 + fr, fq * 8), boff = lds_byte(wc * 32 + fr, fq * 8);
#define PG8_SA(b, h) (((b) * 2 + (h)) * HTB)
#define PG8_SB(b, h) ((4 + (b) * 2 + (h)) * HTB)
#define PG8_STAGE(bufoff, gbase, voff) do { _Pragma("unroll") for (int _i = 0; _i < 2; ++_i) \
        __builtin_amdgcn_global_load_lds((const unsigned*)((const char*)(gbase) + (voff)[_i]), (PG8_LAS unsigned*)(lds + (bufoff) + ldsw + _i * 8192), 16, 0, 0); } while (0)
#define PG8_LDA(dst, b, h) do { _Pragma("unroll") for (int m = 0; m < 4; ++m) { if constexpr (F8) dst##8[m] = cat8(*(const PG8_LAS bf16x8*)(lds + PG8_SA(b, h) + aoff + m * 2048), *(const PG8_LAS bf16x8*)(lds + PG8_SA(b, h) + aoff + m * 2048 + 1024)); \
        else { _Pragma("unroll") for (int k = 0; k < 2; ++k) dst[m][k] = *(const PG8_LAS bf16x8*)(lds + PG8_SA(b, h) + aoff + m * 2048 + k * 1024); } } } while (0)
#define PG8_LDB(dst, b, h) do { _Pragma("unroll") for (int n = 0; n < 2; ++n) { if constexpr (F8) dst##8[n] = cat8(*(const PG8_LAS bf16x8*)(lds + PG8_SB(b, h) + boff + n * 2048), *(const PG8_LAS bf16x8*)(lds + PG8_SB(b, h) + boff + n * 2048 + 1024)); \
        else { _Pragma("unroll") for (int k = 0; k < 2; ++k) dst[n][k] = *(const PG8_LAS bf16x8*)(lds + PG8_SB(b, h) + boff + n * 2048 + k * 1024); } } } while (0)
#define PG8_MMA(ai, bj, At, Bt) do { __builtin_amdgcn_s_setprio(1); _Pragma("unroll") for (int m = 0; m < 4; ++m) _Pragma("unroll") for (int n = 0; n < 2; ++n) { \
        if constexpr (F8) mfma_f8(acc[ai][bj][m][n], Bt##8[n], At##8[m]); \
        else { _Pragma("unroll") for (int k = 0; k < 2; ++k) acc[ai][bj][m][n] = __builtin_amdgcn_mfma_f32_16x16x32_bf16(Bt[n][k], At[m][k], acc[ai][bj][m][n], 0, 0, 0); } } __builtin_amdgcn_s_setprio(0); } while (0)
#define PG8_WAIT_V(n) asm volatile("s_waitcnt vmcnt(" #n ")" ::: "memory")
#define PG8_WAIT_L(n) asm volatile("s_waitcnt lgkmcnt(" #n ")" ::: "memory")
#define PG8_BAR __builtin_amdgcn_s_barrier()
#define PG8_SCHED __builtin_amdgcn_sched_barrier(0)
#define PG8_AOFF(dst, u) do { _Pragma("unroll") for (int _i = 0; _i < 2; ++_i) { int _R, _C; stage_rc(tid * 16 + _i * 8192, _R, _C); _Pragma("unroll") for (int _h = 0; _h < 2; ++_h) \
        dst[_h][_i] = (unsigned)(S.arow(u, _h * HALF + _R) * K + _C) * 2u; } } while (0)
#define PG8_STAGE_A(bufoff, gbase, h, usenext) do { _Pragma("unroll") for (int _i = 0; _i < 2; ++_i) { const unsigned _o = GATHER ? ((usenext) ? oN[h][_i] : oA[h][_i]) : voffA[_i]; \
        __builtin_amdgcn_global_load_lds((const unsigned*)((const char*)(gbase) + (GATHER ? (size_t)0 : (size_t)(h) * hstep) + _o), (PG8_LAS unsigned*)(lds + (bufoff) + ldsw + _i * 8192), 16, 0, 0); } } while (0)
    Unit cur, nxt; int ui = 0;
    if (!S.next(0, cur)) return;
    f32x4 acc[2][2][4][2];
#pragma unroll
    for (int a = 0; a < 2; ++a)
#pragma unroll
        for (int b = 0; b < 2; ++b)
#pragma unroll
            for (int m = 0; m < 4; ++m)
#pragma unroll
                for (int n = 0; n < 2; ++n) acc[a][b][m][n] = (f32x4){0.f, 0.f, 0.f, 0.f};
    bf16x8 At[4][2], B0[2][2], B1[2][2]; i32x8_t At8[4], B08[2], B18[2];
    const char* cA = (const char*)g.A + (GATHER ? (size_t)0 : (size_t)cur.pm * tstep); const char* cB = (const char*)g.Bt + (size_t)cur.pb * tstep;
    S.a_ready(cur);
    if constexpr (GATHER) { PG8_AOFF(oA, cur); PG8_WAIT_V(0); }
    PG8_STAGE(PG8_SB(0, 0), cB, voffB); PG8_STAGE(PG8_SB(0, 1), cB + hstep, voffB); PG8_STAGE_A(PG8_SA(0, 0), cA, 0, false); PG8_STAGE_A(PG8_SA(0, 1), cA, 1, false);
    if (wr == 1) PG8_BAR;
    PG8_WAIT_V(2); PG8_BAR;
    PG8_STAGE(PG8_SB(1, 0), cB + kstep, voffB); PG8_STAGE_A(PG8_SA(1, 0), cA + kstep, 0, false); PG8_STAGE(PG8_SB(1, 1), cB + hstep + kstep, voffB);
    PG8_WAIT_V(6); PG8_BAR;
    for (;;) {
        const bool has_next = S.next(ui + 1, nxt);
        const char* nA = has_next ? (const char*)g.A + (GATHER ? (size_t)0 : (size_t)nxt.pm * tstep) : cA; const char* nB = has_next ? (const char*)g.Bt + (size_t)nxt.pb * tstep : cB;
        if constexpr (GATHER) { if (has_next) { PG8_AOFF(oN, nxt); } else {
#pragma unroll
            for (int _h = 0; _h < 2; ++_h) { oN[_h][0] = oA[_h][0]; oN[_h][1] = oA[_h][1]; } } }
        for (int t = 0; t < nt; t += 2) {
            const bool last = (t == nt - 2);
            const char* a1 = cA + (size_t)(t + 1) * kstep;
            const char* a2 = last ? nA : cA + (size_t)(t + 2) * kstep; const char* b2 = last ? nB : cB + (size_t)(t + 2) * kstep;
            const char* a3 = a2 + kstep; const char* b3 = b2 + kstep;
            if (last && has_next) S.a_ready(nxt);
            PG8_LDB(B0, 0, 0); PG8_LDB(B1, 0, 1); PG8_SCHED; PG8_LDA(At, 0, 0); PG8_STAGE_A(PG8_SA(1, 1), a1, 1, false);
            PG8_WAIT_V(8); PG8_WAIT_L(0); PG8_BAR; PG8_MMA(0, 0, At, B0); PG8_MMA(0, 1, At, B1); PG8_BAR; PG8_SCHED;
            PG8_LDA(At, 0, 1); PG8_STAGE(PG8_SB(0, 0), b2, voffB); PG8_STAGE(PG8_SB(0, 1), b2 + hstep, voffB); PG8_STAGE_A(PG8_SA(0, 0), a2, 0, last);
            PG8_WAIT_V(8); PG8_WAIT_L(0); PG8_BAR; PG8_MMA(1, 0, At, B0); PG8_MMA(1, 1, At, B1); PG8_BAR; PG8_SCHED;
            PG8_LDB(B0, 1, 0); PG8_LDB(B1, 1, 1); PG8_SCHED; PG8_LDA(At, 1, 0); PG8_STAGE_A(PG8_SA(0, 1), a2, 1, last);
            PG8_WAIT_V(8); PG8_WAIT_L(0); PG8_BAR; PG8_MMA(0, 0, At, B0); PG8_MMA(0, 1, At, B1); PG8_BAR; PG8_SCHED;
            PG8_LDA(At, 1, 1); PG8_STAGE(PG8_SB(1, 0), b3, voffB); PG8_STAGE(PG8_SB(1, 1), b3 + hstep, voffB); PG8_STAGE_A(PG8_SA(1, 0), a3, 0, last);
            PG8_WAIT_V(8); PG8_WAIT_L(0); PG8_BAR; PG8_MMA(1, 0, At, B0); PG8_MMA(1, 1, At, B1); PG8_BAR; PG8_SCHED;
        }
        if constexpr (ALIGN_EPI) { if (wr == 0) PG8_BAR; }
        if constexpr (F8) { asm volatile("s_nop 15\n\ts_nop 7" ::: "memory"); PG8_SCHED; }
        E(acc, cur, wr, wc, fr, fq); S.done(cur);
        if (!has_next) break;
#pragma unroll
        for (int a = 0; a < 2; ++a)
#pragma unroll
            for (int b = 0; b < 2; ++b)
#pragma unroll
                for (int m = 0; m < 4; ++m)
#pragma unroll
                    for (int n = 0; n < 2; ++n) acc[a][b][m][n] = (f32x4){0.f, 0.f, 0.f, 0.f};
        cur = nxt; cA = nA; cB = nB; ++ui;
        if constexpr (GATHER) {
#pragma unroll
            for (int _h = 0; _h < 2; ++_h) { oA[_h][0] = oN[_h][0]; oA[_h][1] = oN[_h][1]; } }
        if constexpr (ALIGN_EPI) { if (wr == 1) PG8_BAR; }
    }
    PG8_WAIT_V(0);
    if constexpr (!ALIGN_EPI) { if (wr == 0) PG8_BAR; }
    PG8_BAR;
#undef PG8_SA
#undef PG8_SB
#undef PG8_STAGE
#undef PG8_LDA
#undef PG8_LDB
#undef PG8_MMA
#undef PG8_WAIT_V
#undef PG8_WAIT_L
#undef PG8_BAR
#undef PG8_SCHED
#undef PG8_AOFF
#undef PG8_STAGE_A
}
}

#define GAS __attribute__((address_space(1)))
#define LAS __attribute__((address_space(3)))
#define XB_TMO      128
#define XB_XCNT(j)  (256  + 64 * (j))
#define XB_XSUB(j)  (1280 + 64 * (j))
#define XB_XGEN(j)  (2304 + 64 * (j))
#define XB_TOP      3328
#define XB_TOPGEN   3392
#define XCD_BAR_WORDS 3456
#define XB_SPIN_CAP (1u << 23)

__device__ __forceinline__ unsigned xb_ld(unsigned* p)              { return __hip_atomic_load(p, __ATOMIC_RELAXED, __HIP_MEMORY_SCOPE_AGENT); }
__device__ __forceinline__ unsigned xb_add(unsigned* p, unsigned v) { return __hip_atomic_fetch_add(p, v, __ATOMIC_RELAXED, __HIP_MEMORY_SCOPE_AGENT); }
__device__ __forceinline__ unsigned xb_xcc_id() { return (unsigned)__builtin_amdgcn_s_getreg((3 << 11) | 20) & 0xFu; }
#define XB_SPIN(cond, bar) do { unsigned _sp = 0; while (cond) { __builtin_amdgcn_s_sleep(1); \
    if ((++_sp & 255u) == 0u) { if (xb_ld(&(bar)[XB_TMO])) break; if (_sp > XB_SPIN_CAP) { atomicAdd(&(bar)[XB_TMO], 1u); break; } } } } while (0)

struct XcdBarrier {
    unsigned* bar; unsigned x;
    volatile LAS unsigned* st;
};

__device__ __forceinline__ XcdBarrier xcd_barrier_post(unsigned* bar, volatile LAS unsigned* st) {
    XcdBarrier b; b.bar = bar; b.x = xb_xcc_id(); b.st = st;
    if (threadIdx.x == 0) (void)xb_add(&bar[XB_XCNT(b.x)], 1u);
    return b;
}
__device__ __forceinline__ void xcd_barrier_complete(unsigned* bar, unsigned x, unsigned& nloc, unsigned& nx) {
    const unsigned G = gridDim.x * gridDim.y * gridDim.z;
    unsigned sum, cnt, mine, sp = 0u;
    for (;;) {
        sum = 0u; cnt = 0u; mine = 0u;
#pragma unroll
        for (unsigned j = 0; j < 16; ++j) { const unsigned c = xb_ld(&bar[XB_XCNT(j)]); sum += c; cnt += (c > 0u) ? 1u : 0u; mine = (j == x) ? c : mine; }
        if (sum == G) break;
        __builtin_amdgcn_s_sleep(1);
        if ((++sp & 255u) == 0u) { if (xb_ld(&bar[XB_TMO])) break; if (sp > XB_SPIN_CAP) { atomicAdd(&bar[XB_TMO], 1u); break; } }
    }
    nloc = mine > 0u ? mine : 1u; nx = cnt > 0u ? cnt : 1u;
}

__device__ __forceinline__ void xcd_barrier(const XcdBarrier& b) {
    asm volatile("s_waitcnt vmcnt(0)" ::: "memory");
    __syncthreads();
    if (threadIdx.x == 0) {
        unsigned* bar = b.bar; asm volatile("" : "+s"(bar));
        __builtin_amdgcn_s_waitcnt(0);
        unsigned nloc = b.st[0], nx = b.st[1];
        if (nloc == 0u) { xcd_barrier_complete(bar, b.x, nloc, nx); b.st[0] = nloc; b.st[1] = nx; }
        const unsigned old = xb_add(&bar[XB_XSUB(b.x)], 1u);
        const unsigned gen = old / nloc;
        if (old + 1u == (gen + 1u) * nloc) {
            __builtin_amdgcn_fence(__ATOMIC_RELEASE, "agent");
            asm volatile("s_waitcnt vmcnt(0)" ::: "memory");
            const unsigned og = xb_add(&bar[XB_TOP], 1u);
            const unsigned tg = og / nx;
            if (og + 1u == (tg + 1u) * nx) xb_add(&bar[XB_TOPGEN], 1u);
            else XB_SPIN(xb_ld(&bar[XB_TOPGEN]) == tg, bar);
            __builtin_amdgcn_fence(__ATOMIC_ACQUIRE, "agent");
            xb_add(&bar[XB_XGEN(b.x)], 1u);
            asm volatile("s_waitcnt vmcnt(0)" ::: "memory");
        } else {
            XB_SPIN(xb_ld(&bar[XB_XGEN(b.x)]) == gen, bar);
            __builtin_amdgcn_fence(__ATOMIC_ACQUIRE, "agent");
            asm volatile("s_waitcnt vmcnt(0)" ::: "memory");
        }
    }
    __syncthreads();
}

constexpr int T = 16384, SEQ = 8192, D = 2048, DLRU = 1024, DDN = 1024, NH = 8, HD = 128, NPROJ = 6144, DIN = 6160;
constexpr int DFF = 6144, NEXP = 8, DFFE = 3072;
constexpr float EPS = 1e-6f;
typedef unsigned short bf16;
typedef float f32x4 __attribute__((ext_vector_type(4)));
typedef unsigned u32x4 __attribute__((ext_vector_type(4)));
typedef unsigned u32x2 __attribute__((ext_vector_type(2)));
#define LDS_WAIT() asm volatile("s_waitcnt lgkmcnt(0)" ::: "memory")
#define LDS_BARRIER() do { asm volatile("s_waitcnt lgkmcnt(0)" ::: "memory"); __builtin_amdgcn_s_barrier(); asm volatile("" ::: "memory"); } while (0)

__device__ __forceinline__ float bf2f(bf16 b) { return __uint_as_float(((unsigned)b) << 16); }
__device__ __forceinline__ unsigned f2bf(float f) { return pg8::cvt_pk_bf16(f, f) & 0xffffu; }
__device__ __forceinline__ unsigned pk2(float lo, float hi) { return pg8::cvt_pk_bf16(lo, hi); }
__device__ __forceinline__ float shfl_xor_l(float v, int o, int lane) { return __int_as_float(__builtin_amdgcn_ds_bpermute((lane ^ o) << 2, __float_as_int(v))); }
__device__ __forceinline__ float shfl_up_l(float v, int d, int lane) { return __int_as_float(__builtin_amdgcn_ds_bpermute((lane - d) << 2, __float_as_int(v))); }
__device__ __forceinline__ float shfl_idx_l(float v, int src) { return __int_as_float(__builtin_amdgcn_ds_bpermute(src << 2, __float_as_int(v))); }
__device__ __forceinline__ float wave_sum(float v, int lane) {
#pragma unroll
    for (int o = 1; o < 64; o <<= 1) v += shfl_xor_l(v, o, lane);
    return v;
}
using pg8::silu_f;
using pg8::frcp; using pg8::rsqrt_f;
__device__ __forceinline__ float sigmoid_f(float x) { return frcp(1.0f + __expf(-x)); }
__device__ __forceinline__ float softplus_f(float x) { return fmaxf(x, 0.0f) + log1pf(__expf(-fabsf(x))); }
__device__ __forceinline__ float gelu_tanh_f(float x) { const float u = 0.7978845608028654f * (x + 0.044715f * x * x * x); return x * frcp(1.0f + __expf(-2.0f * u)); }

constexpr size_t MiB = 1u << 20;
constexpr size_t al(size_t x) { return (x + MiB - 1) / MiB * MiB; }
constexpr size_t WS_CTL = 0, CTL_ZERO_BYTES = 1 * MiB;
constexpr int CW_BAR = 4096, CW_CNT = 8192;
constexpr size_t WS_WGU = 1 * MiB;
constexpr size_t WS_WD = WS_WGU + al((size_t)2 * DFF * D * 2);
constexpr size_t WS_WIN = WS_WD + al((size_t)D * DFF * 2);
constexpr size_t WS_WBA = WS_WIN + al((size_t)2 * NPROJ * D * 2);
constexpr size_t WS_WOUT = WS_WBA + al((size_t)2 * 16 * D * 4 + 2 * 16 * D * 2);
static_assert(WS_WIN + (size_t)NPROJ * D * 2 - WS_WGU >= (size_t)NEXP * D * DFFE * 2, "MoE down weights overlay");
constexpr size_t WS_XB = WS_WOUT + al((size_t)2 * D * D * 2);
constexpr size_t WS_RSTD = WS_XB + al((size_t)T * D * 2);
constexpr size_t WS_BA = WS_RSTD + 5 * MiB;
constexpr size_t WS_BETA = WS_BA + al((size_t)T * 16 * 4);
constexpr size_t WS_G = WS_BETA + al((size_t)T * 8 * 4);
constexpr size_t WS_ROWW = WS_G + al((size_t)T * 8 * 4);
constexpr int NSLOT = 2 * T + NEXP * 256;
constexpr size_t WS_PROJ = WS_ROWW + al((size_t)2 * 8 * T * 4);
constexpr size_t WS_YMIX = WS_PROJ + al((size_t)NSLOT * DFFE * 2);
constexpr size_t WS_MG0 = WS_YMIX + al((size_t)T * D * 2);
constexpr size_t WS_C = WS_MG0 + (size_t)96 * MiB;
constexpr size_t WS_WRT = WS_C + (size_t)388 * MiB;
constexpr size_t WS_END = WS_WRT + 1 * MiB;
static_assert(WS_END <= (size_t)975 * MiB, "d_ws map exceeds the guaranteed workspace");
static_assert((size_t)4 * 2 * DFFE * D * 2 == (size_t)96 * MiB, "experts 0-3 fill the region in front of the mixer scratch exactly");
constexpr int RING_BYTES = 131072, LDSCTL_OFF = RING_BYTES, MISC_OFF = LDSCTL_OFF + 320, LDS_BYTES = 147456;

__device__ __forceinline__ void transpose_item(const float* W, int ldw, int col_off, int K, int nblk, const float* gain, bf16* WT, int blk, int blk_stride, int row_off, int item, int lane) {
    const int kb = item / nblk, nb = item % nblk, k0 = 64 * kb + (lane >> 4) * 16, n0 = 64 * nb + (lane & 15) * 4;
    const float* src = W + (size_t)k0 * ldw + col_off + n0;
    f32x4 v[16];
#pragma unroll
    for (int j = 0; j < 16; ++j) v[j] = __builtin_nontemporal_load((const f32x4*)(src + (size_t)j * ldw));
    if (gain) {
#pragma unroll
        for (int q = 0; q < 4; ++q) { const f32x4 g = *(const f32x4*)(gain + k0 + 4 * q);
#pragma unroll
            for (int c = 0; c < 4; ++c) v[4 * q + c] = v[4 * q + c] * g[c]; }
    }
#pragma unroll
    for (int i = 0; i < 4; ++i) { const int n = n0 + i, drow = (n / blk) * blk_stride + (n % blk) + row_off;
        u32x4 o0, o1;
        o0.x = pk2(v[0][i], v[1][i]); o0.y = pk2(v[2][i], v[3][i]); o0.z = pk2(v[4][i], v[5][i]); o0.w = pk2(v[6][i], v[7][i]);
        o1.x = pk2(v[8][i], v[9][i]); o1.y = pk2(v[10][i], v[11][i]); o1.z = pk2(v[12][i], v[13][i]); o1.w = pk2(v[14][i], v[15][i]);
        u32x4* dst = (u32x4*)(WT + (size_t)drow * K + k0); dst[0] = o0; dst[1] = o1; }
}
__device__ __forceinline__ void convert_matrix(const float* W, int ldw, int col_off, int K, int N, const float* gain, bf16* WT, int blk, int blk_stride, int row_off, LAS float* scr, int gw, int NGW, int lane) {
    const int nblk = N / 64, nitems = (K / 64) * nblk; (void)scr;
    for (int it = gw; it < nitems; it += NGW) transpose_item(W, ldw, col_off, K, nblk, gain, WT, blk, blk_stride, row_off, it, lane);
}
__device__ __forceinline__ void transpose_item8(const float* W, int ldw, int K, int nblk, const float* gain, float scale, unsigned char* WT, int blk, int blk_stride, int row_off, int item, int lane) {
    const int kb = item / nblk, nb = item % nblk, k0 = 64 * kb + (lane >> 4) * 16, n0 = 64 * nb + (lane & 15) * 4;
    const float* src = W + (size_t)k0 * ldw + n0;
    f32x4 v[16];
#pragma unroll
    for (int j = 0; j < 16; ++j) v[j] = __builtin_nontemporal_load((const f32x4*)(src + (size_t)j * ldw));
#pragma unroll
    for (int q = 0; q < 4; ++q) { f32x4 g = {scale, scale, scale, scale}; if (gain) g = *(const f32x4*)(gain + k0 + 4 * q) * scale;
#pragma unroll
        for (int c = 0; c < 4; ++c) v[4 * q + c] = v[4 * q + c] * g[c]; }
#pragma unroll
    for (int i = 0; i < 4; ++i) { const int n = n0 + i, drow = (n / blk) * blk_stride + (n % blk) + row_off;
        u32x4 o;
        o.x = pg8::cvt_pk4_fp8(v[0][i], v[1][i], v[2][i], v[3][i]); o.y = pg8::cvt_pk4_fp8(v[4][i], v[5][i], v[6][i], v[7][i]);
        o.z = pg8::cvt_pk4_fp8(v[8][i], v[9][i], v[10][i], v[11][i]); o.w = pg8::cvt_pk4_fp8(v[12][i], v[13][i], v[14][i], v[15][i]);
        *(u32x4*)(WT + (size_t)drow * K + k0) = o; }
}
__device__ __forceinline__ void convert_matrix8(const float* W, int ldw, int K, int N, const float* gain, float scale, unsigned char* WT, int blk, int blk_stride, int row_off, int gw, int NGW, int lane) {
    const int nblk = N / 64, nitems = (K / 64) * nblk;
    for (int it = gw; it < nitems; it += NGW) transpose_item8(W, ldw, K, nblk, gain, scale, WT, blk, blk_stride, row_off, it, lane);
}
__device__ __forceinline__ void rowprep_row(const float* x, bf16* xb, float* rstd, const float* Wba, float* ba, int row, int lane) {
    const f32x4* xr = (const f32x4*)(x + (size_t)row * D) + lane;
    f32x4 v[8]; float ss = 0.f;
#pragma unroll
    for (int j = 0; j < 8; ++j) { v[j] = xr[64 * j]; ss += (v[j][0] * v[j][0] + v[j][1] * v[j][1]) + (v[j][2] * v[j][2] + v[j][3] * v[j][3]); }
    ss = wave_sum(ss, lane);
    const float rs = rsqrt_f(ss * (1.0f / D) + EPS);
    u32x2* o = (u32x2*)(xb + (size_t)row * D) + lane;
#pragma unroll
    for (int j = 0; j < 8; ++j) { u32x2 w; w.x = pk2(v[j][0], v[j][1]); w.y = pk2(v[j][2], v[j][3]); o[64 * j] = w; }
    if (lane == 0) rstd[row] = rs;
    if (Wba) {
        for (int c = 0; c < 16; ++c) { const f32x4* wr = (const f32x4*)(Wba + (size_t)c * D) + lane; float a = 0.f;
#pragma unroll
            for (int j = 0; j < 8; ++j) { const f32x4 w = wr[64 * j]; a += (v[j][0] * w[0] + v[j][1] * w[1]) + (v[j][2] * w[2] + v[j][3] * w[3]); }
            a = wave_sum(a, lane); if (lane == 0) ba[(size_t)row * 16 + c] = a * rs; }
    }
}
__device__ __forceinline__ void lru_conv_elem(const bf16* proj, const float* cw, const float* cb, float* xc, size_t idx) {
    const int t = (int)(idx / DLRU), ch = (int)(idx % DLRU), s = t % SEQ;
    float a = cb[ch];
#pragma unroll
    for (int k = 0; k < 4; ++k) { const int sp = s - 3 + k; if (sp >= 0) a += cw[k * DLRU + ch] * bf2f(proj[(size_t)(t - 3 + k) * NPROJ + ch]); }
    xc[idx] = a;
}
__device__ __forceinline__ void lru_gate_elem(const float* xc, const float* w_r, const float* b_r, const float* w_i, const float* b_i, const float* lam, float* av, float* bv, size_t idx) {
    const int t = (int)(idx / DLRU), ch = (int)(idx % DLRU), n = ch >> 7, d = ch & 127;
    float ar = b_r[ch], ai = b_i[ch];
    const float* xr = xc + (size_t)t * DLRU + n * 128; const float* wr = w_r + (size_t)n * 128 * 128 + d; const float* wi = w_i + (size_t)n * 128 * 128 + d;
    for (int c = 0; c < 128; ++c) { const float xv = xr[c]; ar += xv * wr[c * 128]; ai += xv * wi[c * 128]; }
    const float r = sigmoid_f(ar), ig = sigmoid_f(ai);
    const float log_a = -8.0f * r * softplus_f(-lam[ch]);
    const float a = expf(log_a), mult = sqrtf(-expm1f(2.0f * log_a));
    av[idx] = a; bv[idx] = mult * (ig * xc[idx]);
}
__device__ __forceinline__ void lru_scan_chan(float* av, const float* bv, const bf16* proj, int idx) {
    const int b = idx / DLRU, ch = idx % DLRU;
    float h = 0.f;
    for (int s0 = 0; s0 < SEQ; s0 += 8) {
        float a8[8], b8[8], g8[8];
#pragma unroll
        for (int j = 0; j < 8; ++j) { const size_t t = (size_t)b * SEQ + s0 + j; a8[j] = av[t * DLRU + ch]; b8[j] = bv[t * DLRU + ch]; g8[j] = bf2f(proj[t * NPROJ + DLRU + ch]); }
#pragma unroll
        for (int j = 0; j < 8; ++j) { const size_t t = (size_t)b * SEQ + s0 + j; h = a8[j] * h + b8[j]; av[t * DLRU + ch] = h * gelu_tanh_f(g8[j]); }
    }
}
__device__ __forceinline__ void lru_norm_row(const float* y, const float* gain, bf16* ymix, int row, int lane) {
    const f32x4* yr = (const f32x4*)(y + (size_t)row * DLRU) + lane; const f32x4* gr = (const f32x4*)gain + lane;
    f32x4 v[4]; float ss = 0.f;
#pragma unroll
    for (int j = 0; j < 4; ++j) { v[j] = yr[64 * j]; ss += (v[j][0] * v[j][0] + v[j][1] * v[j][1]) + (v[j][2] * v[j][2] + v[j][3] * v[j][3]); }
    ss = wave_sum(ss, lane); const float rs = rsqrt_f(ss * (1.0f / DLRU) + EPS);
    u32x2* o = (u32x2*)(ymix + (size_t)row * D) + lane;
#pragma unroll
    for (int j = 0; j < 4; ++j) { const f32x4 g = gr[64 * j]; u32x2 w; w.x = pk2(v[j][0] * rs * g[0], v[j][1] * rs * g[1]); w.y = pk2(v[j][2] * rs * g[2], v[j][3] * rs * g[3]); o[64 * j] = w; }
}
__device__ __forceinline__ void dn_prep_item(const bf16* proj, const float* cw, const float* ba, const float* a_log, const float* dt_bias, float* qn, float* kn, float* vn, float* beta, float* gg, int w, int lane) {
    const int t = w >> 3, h = w & 7, s = t % SEQ;
    float val[3][2];
#pragma unroll
    for (int p = 0; p < 3; ++p)
#pragma unroll
        for (int e = 0; e < 2; ++e) { const int d = lane * 2 + e, c = p * DDN + h * HD + d; float a = 0.f;
#pragma unroll
            for (int k = 0; k < 4; ++k) { const int sp = s - 3 + k; if (sp >= 0) a += cw[k * 3 * DDN + c] * bf2f(proj[(size_t)(t - 3 + k) * NPROJ + 2048 + c]); }
            val[p][e] = silu_f(a); }
    const float sq = wave_sum(val[0][0] * val[0][0] + val[0][1] * val[0][1], lane), sk = wave_sum(val[1][0] * val[1][0] + val[1][1] * val[1][1], lane);
    const float rq = rsqrt_f(sq + EPS) * 0.08838834764831845f, rk = rsqrt_f(sk + EPS);
    const size_t o = ((size_t)t * NH + h) * HD + lane * 2;
    qn[o] = val[0][0] * rq; qn[o + 1] = val[0][1] * rq; kn[o] = val[1][0] * rk; kn[o + 1] = val[1][1] * rk; vn[o] = val[2][0]; vn[o + 1] = val[2][1];
    if (lane == 0) { beta[t * NH + h] = sigmoid_f(ba[(size_t)t * 16 + h]); gg[t * NH + h] = -__expf(a_log[h]) * softplus_f(ba[(size_t)t * 16 + 8 + h] + dt_bias[h]); }
}
__device__ __forceinline__ void dn_rec_seq(const float* qn, const float* kn, const float* vn, const float* beta, const float* gg, float* o, int bh, LAS float* sk, LAS float* sq, LAS float* st, int tid) {
    const int b = bh >> 3, h = bh & 7, j = tid & 127; const bool act = tid < 128;
    if (act) for (int k = 0; k < 128; ++k) st[k * 128 + j] = 0.f;
    const size_t base = ((size_t)(b * SEQ) * NH + h) * HD;
    float nk = kn[base + j], nq = qn[base + j], nv = vn[base + j], nb = beta[(b * SEQ) * NH + h], ng = gg[(b * SEQ) * NH + h];
    for (int s = 0; s < SEQ; ++s) {
        const int buf = (s & 1) * 128;
        if (act) { sk[buf + j] = nk; sq[buf + j] = nq; }
        const float vj = nv, be = nb, ge = __expf(ng);
        __syncthreads();
        if (act) {
            if (s + 1 < SEQ) { const size_t nb_ = ((size_t)(b * SEQ + s + 1) * NH + h) * HD; nk = kn[nb_ + j]; nq = qn[nb_ + j]; nv = vn[nb_ + j]; nb = beta[(b * SEQ + s + 1) * NH + h]; ng = gg[(b * SEQ + s + 1) * NH + h]; }
            float ks = 0.f;
#pragma unroll 8
            for (int k = 0; k < 128; ++k) ks += sk[buf + k] * st[k * 128 + j];
            const float vnew = be * (vj - ge * ks);
            float oo = 0.f;
#pragma unroll 8
            for (int k = 0; k < 128; ++k) { const float sv = ge * st[k * 128 + j] + sk[buf + k] * vnew; st[k * 128 + j] = sv; oo += sq[buf + k] * sv; }
            o[((size_t)(b * SEQ + s) * NH + h) * HD + j] = oo;
        }
    }
    __syncthreads();
}
typedef short bf16x8 __attribute__((ext_vector_type(8)));
__device__ __forceinline__ f32x4 mfma16(bf16x8 a, bf16x8 b, f32x4 c) { return __builtin_amdgcn_mfma_f32_16x16x32_bf16(a, b, c, 0, 0, 0); }
__device__ __forceinline__ float bflo(unsigned x) { return __uint_as_float(x << 16); }
__device__ __forceinline__ float bfhi(unsigned x) { return __uint_as_float(x & 0xffff0000u); }
constexpr int DA_G = 0, DA_L = 1024, DA_KN = DA_L + 16384, DA_QN = DA_KN + 17408, DA_VBT = DA_QN + 17408, DA_KBET = DA_VBT + 18432, DA_KDT = DA_KBET + 18432, DA_TB = DA_KDT + 18432, DA_QK = DA_TB + 9216, DA_END = DA_QK + 9216;
static_assert(DA_END <= RING_BYTES, "DN-A LDS map");
#if defined(PROBE_DNA_A)
#define DNA_ST(k) do { if (threadIdx.x == 0) ((volatile LAS unsigned long long*)(lds + (RING_BYTES + 2048)))[k] = __builtin_amdgcn_s_memrealtime(); } while (0)
#else
#define DNA_ST(k) do { } while (0)
#endif
__device__ __forceinline__ void dna_unit(const bf16* proj, const float* cw, const float* ba, const float* a_log, const float* dt_bias,
                                         bf16* Wf, bf16* Qf, bf16* KdTf, bf16* QKf, bf16* Uf, float* glb, int uid, LAS unsigned char* lds, const LAS float* cwl, int tid, int lane, int wave) {
    const int h = uid & 7, n = (uid >> 3) & 127, b = uid >> 10, t0 = b * SEQ + n * 64;
    asm volatile("" : "+v"(lds));
    DNA_ST(0);
    LAS float* Gs = (LAS float*)(lds + DA_G);
    const int fr = lane & 15, fq = lane >> 4;
    float ba_b = 0.f, ba_a = 0.f;
    if (wave == 0) { const size_t t = (size_t)(t0 + lane); ba_b = ba[t * 16 + h]; ba_a = ba[t * 16 + 8 + h]; }
    DNA_ST(1);
    {
        const int r = tid >> 3, cg = tid & 7;
        float val[3][16];
#pragma unroll
        for (int p = 0; p < 3; ++p) {
            const int ccol = p * DDN + h * HD + cg * 16;
            float acc[16];
#pragma unroll
            for (int i = 0; i < 16; ++i) acc[i] = 0.f;
#pragma unroll
            for (int k = 0; k < 4; ++k) { const int row = r - 3 + k;
                if (n * 64 + row >= 0) {
                    const bf16* src = proj + (size_t)(t0 + row) * NPROJ + 2048 + ccol;
                    const u32x4 x0 = *(const u32x4*)src, x1 = *(const u32x4*)(src + 8);
                    const LAS float* wp = cwl + k * 384 + p * 128 + cg * 16;
                    const f32x4 w0 = *(const LAS f32x4*)wp, w1 = *(const LAS f32x4*)(wp + 4), w2 = *(const LAS f32x4*)(wp + 8), w3 = *(const LAS f32x4*)(wp + 12);
                    acc[0] += w0[0] * bflo(x0.x); acc[1] += w0[1] * bfhi(x0.x); acc[2] += w0[2] * bflo(x0.y); acc[3] += w0[3] * bfhi(x0.y);
                    acc[4] += w1[0] * bflo(x0.z); acc[5] += w1[1] * bfhi(x0.z); acc[6] += w1[2] * bflo(x0.w); acc[7] += w1[3] * bfhi(x0.w);
                    acc[8] += w2[0] * bflo(x1.x); acc[9] += w2[1] * bfhi(x1.x); acc[10] += w2[2] * bflo(x1.y); acc[11] += w2[3] * bfhi(x1.y);
                    acc[12] += w3[0] * bflo(x1.z); acc[13] += w3[1] * bfhi(x1.z); acc[14] += w3[2] * bflo(x1.w); acc[15] += w3[3] * bfhi(x1.w);
                } }
#pragma unroll
            for (int i = 0; i < 16; ++i) val[p][i] = silu_f(acc[i]);
        }
        float sq = 0.f, sk = 0.f;
#pragma unroll
        for (int i = 0; i < 16; ++i) { sq += val[0][i] * val[0][i]; sk += val[1][i] * val[1][i]; }
        sq += shfl_xor_l(sq, 1, lane); sq += shfl_xor_l(sq, 2, lane); sq += shfl_xor_l(sq, 4, lane);
        sk += shfl_xor_l(sk, 1, lane); sk += shfl_xor_l(sk, 2, lane); sk += shfl_xor_l(sk, 4, lane);
        const float rq = rsqrt_f(sq + EPS) * 0.08838834764831845f, rk = rsqrt_f(sk + EPS);
        if (wave == 0) {
            const float be0 = sigmoid_f(ba_b); float Gc = -__expf(a_log[h]) * softplus_f(ba_a + dt_bias[h]);
#pragma unroll
            for (int off = 1; off < 64; off <<= 1) { const float tmp = shfl_up_l(Gc, off, lane); if (lane >= off) Gc += tmp; }
            const float GL = shfl_idx_l(Gc, 63);
            Gs[lane] = Gc; Gs[64 + lane] = be0; Gs[128 + lane] = __expf(Gc); Gs[192 + lane] = __expf(GL - Gc);
            if (lane == 63) glb[uid] = __expf(Gc);
        }
        LDS_BARRIER();
        const float be = Gs[64 + r], eg = Gs[128 + r], egl = Gs[192 + r];
#pragma unroll
        for (int i = 0; i < 16; ++i) { val[0][i] *= rq; val[1][i] *= rk; }
        u32x4 o0, o1;
        o0.x = pk2(val[1][0], val[1][1]); o0.y = pk2(val[1][2], val[1][3]); o0.z = pk2(val[1][4], val[1][5]); o0.w = pk2(val[1][6], val[1][7]);
        o1.x = pk2(val[1][8], val[1][9]); o1.y = pk2(val[1][10], val[1][11]); o1.z = pk2(val[1][12], val[1][13]); o1.w = pk2(val[1][14], val[1][15]);
        *(LAS u32x4*)(lds + DA_KN + r * 272 + cg * 32) = o0; *(LAS u32x4*)(lds + DA_KN + r * 272 + cg * 32 + 16) = o1;
        o0.x = pk2(val[0][0], val[0][1]); o0.y = pk2(val[0][2], val[0][3]); o0.z = pk2(val[0][4], val[0][5]); o0.w = pk2(val[0][6], val[0][7]);
        o1.x = pk2(val[0][8], val[0][9]); o1.y = pk2(val[0][10], val[0][11]); o1.z = pk2(val[0][12], val[0][13]); o1.w = pk2(val[0][14], val[0][15]);
        *(LAS u32x4*)(lds + DA_QN + r * 272 + cg * 32) = o0; *(LAS u32x4*)(lds + DA_QN + r * 272 + cg * 32 + 16) = o1;
#pragma unroll
        for (int i = 0; i < 16; ++i) { const int f = cg * 16 + i;
            *(LAS unsigned short*)(lds + DA_VBT + f * 144 + r * 2) = (unsigned short)f2bf(val[2][i] * be);
            *(LAS unsigned short*)(lds + DA_KBET + f * 144 + r * 2) = (unsigned short)f2bf(val[1][i] * (be * eg));
            *(LAS unsigned short*)(lds + DA_KDT + f * 144 + r * 2) = (unsigned short)f2bf(val[1][i] * egl); }
    }
    LDS_BARRIER();
    DNA_ST(2);
    {
        const int p = wave >> 2, ti = wave & 3;
        const int abase = p == 0 ? DA_KN : DA_QN;
        bf16x8 af[4];
#pragma unroll
        for (int ks = 0; ks < 4; ++ks) af[ks] = *(const LAS bf16x8*)(lds + abase + (ti * 16 + fr) * 272 + (ks * 32 + fq * 8) * 2);
        for (int tj = 0; tj < 4; ++tj) {
            f32x4 acc = {0.f, 0.f, 0.f, 0.f};
            if (tj <= ti) {
#pragma unroll
                for (int ks = 0; ks < 4; ++ks) { const bf16x8 bb = *(const LAS bf16x8*)(lds + DA_KN + (tj * 16 + fr) * 272 + (ks * 32 + fq * 8) * 2); acc = mfma16(af[ks], bb, acc); }
            }
            const int j = tj * 16 + fr; const float Gj = Gs[j];
#pragma unroll
            for (int r = 0; r < 4; ++r) { const int i = ti * 16 + fq * 4 + r; float v = 0.f;
                if (p == 0) { if (i > j) v = Gs[64 + i] * acc[r] * __expf(Gs[i] - Gj); *(LAS float*)(lds + DA_L + (j * 64 + i) * 4) = v; }
                else { if (i >= j) v = acc[r] * __expf(Gs[i] - Gj); *(LAS unsigned short*)(lds + DA_QK + i * 144 + j * 2) = (unsigned short)f2bf(v); } }
        }
    }
    LDS_BARRIER();
    DNA_ST(3);
    {
        int lc = lane; asm volatile("" : "+v"(lc)); const float fl = (float)lc;
        const int blk = wave < 4 ? wave : 11 - wave;
        float Tr[8];
#pragma unroll
        for (int c = 0; c < 8; ++c) Tr[c] = fmaxf(0.f, 1.f - fabsf(fl - (float)(blk * 8 + c)));
        float lj[63];
#pragma unroll
        for (int j = 0; j < 63; ++j) lj[j] = *(const LAS float*)(lds + DA_L + (j * 64) * 4 + lc * 4);
#pragma unroll
        for (int j = 0; j < 63; ++j) {
            if (j >= blk * 8) {
#pragma unroll
                for (int c = 0; c < 8; ++c) { const float tj = __int_as_float(__builtin_amdgcn_readlane(__float_as_int(Tr[c]), j)); Tr[c] -= lj[j] * tj; }
            }
        }
        u32x4 o; o.x = pk2(Tr[0], Tr[1]); o.y = pk2(Tr[2], Tr[3]); o.z = pk2(Tr[4], Tr[5]); o.w = pk2(Tr[6], Tr[7]);
        *(LAS u32x4*)(lds + DA_TB + lc * 144 + blk * 16) = o;
    }
    {
        for (int fi = wave; fi < 40; fi += 8) {
            if (fi < 8) { const int mt = fi >> 1, ks = fi & 1;
                const u32x4 v = *(const LAS u32x4*)(lds + DA_QK + (mt * 16 + fr) * 144 + (ks * 32 + fq * 8) * 2);
                *(u32x4*)(QKf + (((size_t)uid * 4 + mt) * 2 + ks) * 512 + lane * 8) = v; }
            else if (fi < 24) { const int f2 = fi - 8, mt = f2 >> 2, ks = f2 & 3; const float eg = Gs[128 + mt * 16 + fr];
                const u32x4 v = *(const LAS u32x4*)(lds + DA_QN + (mt * 16 + fr) * 272 + (ks * 32 + fq * 8) * 2); u32x4 o;
                o.x = pk2(bflo(v.x) * eg, bfhi(v.x) * eg); o.y = pk2(bflo(v.y) * eg, bfhi(v.y) * eg); o.z = pk2(bflo(v.z) * eg, bfhi(v.z) * eg); o.w = pk2(bflo(v.w) * eg, bfhi(v.w) * eg);
                *(u32x4*)(Qf + (((size_t)uid * 4 + mt) * 4 + ks) * 512 + lane * 8) = o; }
            else { const int f2 = fi - 24, ft = f2 >> 1, ks = f2 & 1;
                const u32x4 v = *(const LAS u32x4*)(lds + DA_KDT + (ft * 16 + fr) * 144 + (ks * 32 + fq * 8) * 2);
                *(u32x4*)(KdTf + (((size_t)uid * 8 + ft) * 2 + ks) * 512 + lane * 8) = v; }
        }
    }
    LDS_BARRIER();
    DNA_ST(4);
    {
        bf16x8 ta[4][2];
#pragma unroll
        for (int mt = 0; mt < 4; ++mt)
#pragma unroll
            for (int ks = 0; ks < 2; ++ks) ta[mt][ks] = *(const LAS bf16x8*)(lds + DA_TB + (mt * 16 + fr) * 144 + (ks * 32 + fq * 8) * 2);
#pragma unroll
        for (int c2 = 0; c2 < 2; ++c2) { const int ct = wave * 2 + c2, img = ct < 8 ? DA_VBT : DA_KBET, cr = (ct & 7) * 16 + fr;
            bf16x8 bb[2];
#pragma unroll
            for (int ks = 0; ks < 2; ++ks) bb[ks] = *(const LAS bf16x8*)(lds + img + cr * 144 + (ks * 32 + fq * 8) * 2);
#pragma unroll
            for (int mt = 0; mt < 4; ++mt) { f32x4 acc = {0.f, 0.f, 0.f, 0.f};
#pragma unroll
                for (int ks = 0; ks < 2; ++ks) acc = mfma16(ta[mt][ks], bb[ks], acc);
                if (ct < 8) { u32x2 o; o.x = pk2(acc[0], acc[1]); o.y = pk2(acc[2], acc[3]); *(u32x2*)(Uf + ((((size_t)uid * 8 + ct) * 4 + mt) * 64 + lane) * 4) = o; }
                else { const int f = (ct - 8) * 16 + fr;
#pragma unroll
                    for (int r = 0; r < 4; ++r) *(LAS unsigned short*)(lds + DA_KN + (mt * 16 + fq * 4 + r) * 272 + f * 2) = (unsigned short)f2bf(acc[r]); } }
        }
    }
    LDS_BARRIER();
    DNA_ST(5);
#pragma unroll
    for (int q2 = 0; q2 < 2; ++q2) { const int fi = wave * 2 + q2, mt = fi >> 2, ks = fi & 3;
        const u32x4 v = *(const LAS u32x4*)(lds + DA_KN + (mt * 16 + fr) * 272 + (ks * 32 + fq * 8) * 2);
        *(u32x4*)(Wf + (((size_t)uid * 4 + mt) * 4 + ks) * 512 + lane * 8) = v; }
    LDS_BARRIER();
    DNA_ST(6);
}
struct DnbFrag { bf16x8 a1[4]; bf16x8 kd[2]; u32x2 u; float gl; };
__device__ __forceinline__ DnbFrag dnb_load(const bf16* Wf, const bf16* KdTf, const bf16* Uf, const float* glb, int uid, int ds, int wave, int lane) {
    DnbFrag f; const int mt = wave & 3;
#pragma unroll
    for (int ks = 0; ks < 4; ++ks) f.a1[ks] = (wave < 4) ? *(const bf16x8*)(Wf + (((size_t)uid * 4 + mt) * 4 + ks) * 512 + lane * 8) : (bf16x8){0, 0, 0, 0, 0, 0, 0, 0};
#pragma unroll
    for (int ks = 0; ks < 2; ++ks) f.kd[ks] = *(const bf16x8*)(KdTf + (((size_t)uid * 8 + wave) * 2 + ks) * 512 + lane * 8);
    f.u = (wave < 4) ? *(const u32x2*)(Uf + ((((size_t)uid * 8 + ds) * 4 + mt) * 64 + lane) * 4) : (u32x2){0u, 0u};
    f.gl = glb[uid];
    return f;
}
__device__ __forceinline__ void dnb_run(const bf16* Wf, const bf16* KdTf, const bf16* Uf, const float* glb, bf16* Sf, bf16* Vf, int bh, int ds, LAS unsigned char* lds, int tid, int lane, int wave) {
    const int b = bh >> 3, h = bh & 7, fr = lane & 15, fq = lane >> 4, mt = wave & 3;
    asm volatile("" : "+v"(lds));
    LAS unsigned char* ST = lds; LAS unsigned char* VNT = lds + 4608;
    for (int i = tid; i < 4608 / 4; i += 512) ((LAS unsigned*)ST)[i] = 0u;
    f32x4 accS = {0.f, 0.f, 0.f, 0.f};
    DnbFrag f0 = dnb_load(Wf, KdTf, Uf, glb, (b * 128 + 0) * 8 + h, ds, wave, lane), f1 = dnb_load(Wf, KdTf, Uf, glb, (b * 128 + 1) * 8 + h, ds, wave, lane);
    DnbFrag f2 = dnb_load(Wf, KdTf, Uf, glb, (b * 128 + 2) * 8 + h, ds, wave, lane), f3 = dnb_load(Wf, KdTf, Uf, glb, (b * 128 + 3) * 8 + h, ds, wave, lane);
    __syncthreads();
#define DNB_STEP(F, nn) do { const int n = (nn); const size_t uds = (size_t)((b * 128 + n) * 8 + h) * 8 + ds; \
        if (wave < 4) { f32x4 acc = {0.f, 0.f, 0.f, 0.f}; \
            _Pragma("unroll") for (int ks = 0; ks < 4; ++ks) { const bf16x8 sb = *(const LAS bf16x8*)(ST + fr * 272 + (ks * 32 + fq * 8) * 2); acc = mfma16(F.a1[ks], sb, acc); } \
            const float v0 = bflo(F.u.x) - acc[0], v1 = bfhi(F.u.x) - acc[1], v2 = bflo(F.u.y) - acc[2], v3 = bfhi(F.u.y) - acc[3]; \
            u32x2 w; w.x = pk2(v0, v1); w.y = pk2(v2, v3); *(LAS u32x2*)(VNT + fr * 144 + (mt * 16 + fq * 4) * 2) = w; } \
        else { const u32x4 sb = *(const LAS u32x4*)(ST + fr * 272 + (mt * 32 + fq * 8) * 2);     \
            *(u32x4*)(Sf + (uds * 4 + mt) * 512 + lane * 8) = sb; } \
        LDS_BARRIER(); \
        bf16x8 vb[2]; \
        _Pragma("unroll") for (int ks = 0; ks < 2; ++ks) vb[ks] = *(const LAS bf16x8*)(VNT + fr * 144 + (ks * 32 + fq * 8) * 2); \
        accS = accS * F.gl; \
        _Pragma("unroll") for (int ks = 0; ks < 2; ++ks) accS = mfma16(F.kd[ks], vb[ks], accS); \
        { u32x2 w; w.x = pk2(accS[0], accS[1]); w.y = pk2(accS[2], accS[3]); *(LAS u32x2*)(ST + fr * 272 + (wave * 16 + fq * 4) * 2) = w; } \
        if (wave == 4) *(bf16x8*)(Vf + (uds * 2 + 0) * 512 + lane * 8) = vb[0];     \
        if (wave == 5) *(bf16x8*)(Vf + (uds * 2 + 1) * 512 + lane * 8) = vb[1]; \
        F = dnb_load(Wf, KdTf, Uf, glb, (b * 128 + (n + 4 < 128 ? n + 4 : 127)) * 8 + h, ds, wave, lane);     \
        LDS_BARRIER(); } while (0)
    for (int n4 = 0; n4 < 128; n4 += 16) {
        DNB_STEP(f0, n4); DNB_STEP(f1, n4 + 1); DNB_STEP(f2, n4 + 2); DNB_STEP(f3, n4 + 3); DNB_STEP(f0, n4 + 4); DNB_STEP(f1, n4 + 5); DNB_STEP(f2, n4 + 6); DNB_STEP(f3, n4 + 7);
        DNB_STEP(f0, n4 + 8); DNB_STEP(f1, n4 + 9); DNB_STEP(f2, n4 + 10); DNB_STEP(f3, n4 + 11); DNB_STEP(f0, n4 + 12); DNB_STEP(f1, n4 + 13); DNB_STEP(f2, n4 + 14); DNB_STEP(f3, n4 + 15); }
#undef DNB_STEP
}
constexpr int DO_ABUF = 24576, DO_OT = 49152, DO_END = DO_OT + 64 * 132 * 4;
static_assert(DO_END <= RING_BYTES, "DN-O LDS map");
struct DnoOps { bf16x8 sB[4], vB[2]; u32x4 g0, g1; };
__device__ __forceinline__ DnoOps dno_request(const bf16* Qf, const bf16* QKf, const bf16* Sf, const bf16* Vf, const bf16* proj, int uid, LAS unsigned char* abuf, int tid, int lane, int wave) {
    DnoOps f; const int h = uid & 7, n = (uid >> 3) & 127, b = uid >> 10, t = b * SEQ + n * 64 + (tid >> 3), c = h * HD + (tid & 7) * 16;
#pragma unroll
    for (int i = 0; i < 3; ++i) { const int ch = wave * 3 + i;
        __builtin_amdgcn_global_load_lds((const unsigned*)((ch < 16 ? Qf + (size_t)uid * 8192 + ch * 512 : QKf + (size_t)uid * 4096 + (ch - 16) * 512) + lane * 8), (LAS unsigned*)(abuf + ch * 1024), 16, 0, 0); }
#pragma unroll
    for (int ks = 0; ks < 4; ++ks) f.sB[ks] = *(const bf16x8*)(Sf + ((((size_t)uid * 8 + wave) * 4) + ks) * 512 + lane * 8);
#pragma unroll
    for (int ks = 0; ks < 2; ++ks) f.vB[ks] = *(const bf16x8*)(Vf + ((((size_t)uid * 8 + wave) * 2) + ks) * 512 + lane * 8);
    const u32x4* gp = (const u32x4*)(proj + (size_t)t * NPROJ + 5120 + c); f.g0 = gp[0]; f.g1 = gp[1];
    return f;
}
__device__ __forceinline__ void dno_run(const bf16* Qf, const bf16* QKf, const bf16* Sf, const bf16* Vf, const float* gain, const bf16* proj, bf16* ymix, int bid, int G, LAS unsigned char* lds, int tid, int lane, int wave) {
    const int fr = lane & 15, fq = lane >> 4, cg = tid & 7, rr = tid >> 3;
    LAS unsigned char* ldu = lds;
    asm volatile("" : "+v"(lds));
    const f32x4* wp = (const f32x4*)(gain + cg * 16); const f32x4 w0 = wp[0], w1 = wp[1], w2 = wp[2], w3 = wp[3];
    int buf = 0;
    DnoOps cur = dno_request(Qf, QKf, Sf, Vf, proj, bid, ldu, tid, lane, wave);
    for (int uid = bid; uid < 2048; uid += G) {
        const int h = uid & 7, n = (uid >> 3) & 127, b = uid >> 10, t0 = b * SEQ + n * 64;
        asm volatile("s_waitcnt vmcnt(0)" ::: "memory");
        LDS_BARRIER();
        const LAS unsigned char* ab = lds + buf * DO_ABUF;
#pragma unroll
        for (int mt = 0; mt < 4; ++mt) { f32x4 acc = {0.f, 0.f, 0.f, 0.f};
#pragma unroll
            for (int ks = 0; ks < 4; ++ks) { const bf16x8 a = *(const LAS bf16x8*)(ab + (mt * 4 + ks) * 1024 + lane * 16); acc = mfma16(a, cur.sB[ks], acc); }
#pragma unroll
            for (int ks = 0; ks < 2; ++ks) { const bf16x8 a = *(const LAS bf16x8*)(ab + 16384 + (mt * 2 + ks) * 1024 + lane * 16); acc = mfma16(a, cur.vB[ks], acc); }
#pragma unroll
            for (int r = 0; r < 4; ++r) *(LAS float*)(lds + DO_OT + ((mt * 16 + fq * 4 + r) * 132 + wave * 16 + fr) * 4) = acc[r]; }
        const u32x4 g0 = cur.g0, g1 = cur.g1;
        buf ^= 1;
        cur = dno_request(Qf, QKf, Sf, Vf, proj, uid + G < 2048 ? uid + G : uid, ldu + buf * DO_ABUF, tid, lane, wave);
        LDS_BARRIER();
        {
            const int t = t0 + rr, c = h * HD + cg * 16;
            const LAS f32x4* op = (const LAS f32x4*)(lds + DO_OT + (rr * 132 + cg * 16) * 4); const f32x4 o0 = op[0], o1 = op[1], o2 = op[2], o3 = op[3];
            float ss = (o0[0] * o0[0] + o0[1] * o0[1]) + (o0[2] * o0[2] + o0[3] * o0[3]) + (o1[0] * o1[0] + o1[1] * o1[1]) + (o1[2] * o1[2] + o1[3] * o1[3])
                     + (o2[0] * o2[0] + o2[1] * o2[1]) + (o2[2] * o2[2] + o2[3] * o2[3]) + (o3[0] * o3[0] + o3[1] * o3[1]) + (o3[2] * o3[2] + o3[3] * o3[3]);
            ss += shfl_xor_l(ss, 1, lane); ss += shfl_xor_l(ss, 2, lane); ss += shfl_xor_l(ss, 4, lane);
            const float rs = rsqrt_f(ss * (1.0f / HD) + EPS);
            u32x4 r0, r1;
            r0.x = pk2(o0[0] * rs * w0[0] * silu_f(bflo(g0.x)), o0[1] * rs * w0[1] * silu_f(bfhi(g0.x))); r0.y = pk2(o0[2] * rs * w0[2] * silu_f(bflo(g0.y)), o0[3] * rs * w0[3] * silu_f(bfhi(g0.y)));
            r0.z = pk2(o1[0] * rs * w1[0] * silu_f(bflo(g0.z)), o1[1] * rs * w1[1] * silu_f(bfhi(g0.z))); r0.w = pk2(o1[2] * rs * w1[2] * silu_f(bflo(g0.w)), o1[3] * rs * w1[3] * silu_f(bfhi(g0.w)));
            r1.x = pk2(o2[0] * rs * w2[0] * silu_f(bflo(g1.x)), o2[1] * rs * w2[1] * silu_f(bfhi(g1.x))); r1.y = pk2(o2[2] * rs * w2[2] * silu_f(bflo(g1.y)), o2[3] * rs * w2[3] * silu_f(bfhi(g1.y)));
            r1.z = pk2(o3[0] * rs * w3[0] * silu_f(bflo(g1.z)), o3[1] * rs * w3[1] * silu_f(bfhi(g1.z))); r1.w = pk2(o3[2] * rs * w3[2] * silu_f(bflo(g1.w)), o3[3] * rs * w3[3] * silu_f(bfhi(g1.w)));
            u32x4* dst = (u32x4*)(ymix + (size_t)t * D + DLRU + c); dst[0] = r0; dst[1] = r1;
        }
    }
    asm volatile("s_waitcnt vmcnt(0)" ::: "memory");
    LDS_BARRIER();
}
constexpr int LA_XB = 0, LA_XF = 17408, LA_END = LA_XF + 64 * 132 * 4;
static_assert(LA_END <= RING_BYTES, "LRU-A LDS map");
struct LruConst { bf16x8 br[4], bi[4]; float brr, bii, sp8; };
__device__ __forceinline__ LruConst lrua_const(const bf16* WrT, const bf16* WiT, const float* b_r, const float* b_i, const float* lam, int nb, int lane, int wave) {
    LruConst c; const int fr = lane & 15, fq = lane >> 4, cl = wave * 16 + fr, ch = nb * 128 + cl;
#pragma unroll
    for (int ks = 0; ks < 4; ++ks) { c.br[ks] = *(const bf16x8*)(WrT + ((size_t)nb * 128 + cl) * 128 + ks * 32 + fq * 8); c.bi[ks] = *(const bf16x8*)(WiT + ((size_t)nb * 128 + cl) * 128 + ks * 32 + fq * 8); }
    c.brr = b_r[ch]; c.bii = b_i[ch]; c.sp8 = -8.0f * softplus_f(-lam[ch]);
    return c;
}
__device__ __forceinline__ void lrua_unit(const bf16* proj, const LruConst& LC,
                                          float* Hloc, float* Acum, float* summ, int unit, LAS unsigned char* lds, const LAS float* lwl, int tid, int lane, int wave) {
    const int nb = unit & 7, ct = unit >> 3, n = ct & 127, t0 = ct * 64;
    asm volatile("" : "+v"(lds));
    {
        const int r = tid >> 3, cg = tid & 7, ch0 = nb * 128 + cg * 16;
        float acc[16];
        { const LAS float* bp = lwl + 512 + cg * 16; const f32x4 c0v = *(const LAS f32x4*)bp, c1v = *(const LAS f32x4*)(bp + 4), c2v = *(const LAS f32x4*)(bp + 8), c3v = *(const LAS f32x4*)(bp + 12);
#pragma unroll
          for (int i = 0; i < 4; ++i) { acc[i] = c0v[i]; acc[4 + i] = c1v[i]; acc[8 + i] = c2v[i]; acc[12 + i] = c3v[i]; } }
#pragma unroll
        for (int k = 0; k < 4; ++k) { const int row = r - 3 + k;
            if (n * 64 + row >= 0) {
                const bf16* src = proj + (size_t)(t0 + row) * NPROJ + ch0;
                const u32x4 x0 = *(const u32x4*)src, x1 = *(const u32x4*)(src + 8);
                const LAS float* wp = lwl + k * 128 + cg * 16;
                const f32x4 w0 = *(const LAS f32x4*)wp, w1 = *(const LAS f32x4*)(wp + 4), w2 = *(const LAS f32x4*)(wp + 8), w3 = *(const LAS f32x4*)(wp + 12);
                acc[0] += w0[0] * bflo(x0.x); acc[1] += w0[1] * bfhi(x0.x); acc[2] += w0[2] * bflo(x0.y); acc[3] += w0[3] * bfhi(x0.y);
                acc[4] += w1[0] * bflo(x0.z); acc[5] += w1[1] * bfhi(x0.z); acc[6] += w1[2] * bflo(x0.w); acc[7] += w1[3] * bfhi(x0.w);
                acc[8] += w2[0] * bflo(x1.x); acc[9] += w2[1] * bfhi(x1.x); acc[10] += w2[2] * bflo(x1.y); acc[11] += w2[3] * bfhi(x1.y);
                acc[12] += w3[0] * bflo(x1.z); acc[13] += w3[1] * bfhi(x1.z); acc[14] += w3[2] * bflo(x1.w); acc[15] += w3[3] * bfhi(x1.w);
            } }
        u32x4 o0, o1;
        o0.x = pk2(acc[0], acc[1]); o0.y = pk2(acc[2], acc[3]); o0.z = pk2(acc[4], acc[5]); o0.w = pk2(acc[6], acc[7]);
        o1.x = pk2(acc[8], acc[9]); o1.y = pk2(acc[10], acc[11]); o1.z = pk2(acc[12], acc[13]); o1.w = pk2(acc[14], acc[15]);
        *(LAS u32x4*)(lds + LA_XB + r * 272 + cg * 32) = o0; *(LAS u32x4*)(lds + LA_XB + r * 272 + cg * 32 + 16) = o1;
        LAS f32x4* xf = (LAS f32x4*)(lds + LA_XF + (r * 132 + cg * 16) * 4);
        xf[0] = (f32x4){acc[0], acc[1], acc[2], acc[3]}; xf[1] = (f32x4){acc[4], acc[5], acc[6], acc[7]}; xf[2] = (f32x4){acc[8], acc[9], acc[10], acc[11]}; xf[3] = (f32x4){acc[12], acc[13], acc[14], acc[15]};
    }
    LDS_BARRIER();
    const int fr = lane & 15, fq = lane >> 4, cl = wave * 16 + fr, ch = nb * 128 + cl;
    f32x4 ar[4], ai[4];
#pragma unroll
    for (int mt = 0; mt < 4; ++mt) { ar[mt] = (f32x4){0.f, 0.f, 0.f, 0.f}; ai[mt] = (f32x4){0.f, 0.f, 0.f, 0.f};
#pragma unroll
        for (int ks = 0; ks < 4; ++ks) { const bf16x8 af = *(const LAS bf16x8*)(lds + LA_XB + (mt * 16 + fr) * 272 + (ks * 32 + fq * 8) * 2); ar[mt] = mfma16(af, LC.br[ks], ar[mt]); ai[mt] = mfma16(af, LC.bi[ks], ai[mt]); } }
    const float brr = LC.brr, bii = LC.bii, sp8 = LC.sp8;
    float Ac = 1.f, Bc = 0.f;
#pragma unroll
    for (int mt = 0; mt < 4; ++mt) {
        float P[4], H[4];
#pragma unroll
        for (int r = 0; r < 4; ++r) { const int t = mt * 16 + fq * 4 + r; const float xcv = *(const LAS float*)(lds + LA_XF + (t * 132 + cl) * 4);
            const float rr = sigmoid_f(ar[mt][r] + brr), ii = sigmoid_f(ai[mt][r] + bii), la = sp8 * rr, a = __expf(la), bb = __builtin_amdgcn_sqrtf(fmaxf(1.0f - a * a, 0.0f)) * (ii * xcv);
            if (r == 0) { P[0] = a; H[0] = bb; } else { P[r] = P[r - 1] * a; H[r] = a * H[r - 1] + bb; } }
        float Ai = P[3], Bi = H[3];
        { const float Au = shfl_up_l(Ai, 16, lane), Bu = shfl_up_l(Bi, 16, lane); if (fq >= 1) { Bi = Ai * Bu + Bi; Ai = Au * Ai; } }
        { const float Au = shfl_up_l(Ai, 32, lane), Bu = shfl_up_l(Bi, 32, lane); if (fq >= 2) { Bi = Ai * Bu + Bi; Ai = Au * Ai; } }
        float Ae = shfl_up_l(Ai, 16, lane), Be = shfl_up_l(Bi, 16, lane); if (fq == 0) { Ae = 1.f; Be = 0.f; }
        const float At = shfl_idx_l(Ai, 48 + fr), Bt = shfl_idx_l(Bi, 48 + fr);
        const float PA = Ac * Ae, PB = Ae * Bc + Be;
#pragma unroll
        for (int r = 0; r < 4; ++r) { const size_t o = (size_t)(t0 + mt * 16 + fq * 4 + r) * DLRU + ch; ((unsigned*)Hloc)[o] = pk2(P[r] * PB + H[r], PA * P[r]); }
        Bc = At * Bc + Bt; Ac = Ac * At;
    }
    if (fq == 0) { float* sp = summ + ((size_t)ct * DLRU + ch) * 2; sp[0] = Ac; sp[1] = Bc; }
    LDS_BARRIER();
}
__device__ __forceinline__ void lru_carry(const float* summ, float* carry, int idx) {
    const int b = idx >> 10, ch = idx & 1023; float c = 0.f;
    for (int n0 = 0; n0 < 128; n0 += 8) { float A[8], B[8];
#pragma unroll
        for (int j = 0; j < 8; ++j) { const float* sp = summ + ((size_t)(b * 128 + n0 + j) * DLRU + ch) * 2; A[j] = sp[0]; B[j] = sp[1]; }
#pragma unroll
        for (int j = 0; j < 8; ++j) { carry[(size_t)(b * 128 + n0 + j) * DLRU + ch] = c; c = A[j] * c + B[j]; } }
}
__device__ __forceinline__ void lrub_row(const float* Hloc, const float* Acum, const float* carry, const bf16* proj, const float* gain, bf16* ymix, int row, int lane) {
    const int ct = row >> 6; f32x4 y[4]; float ss = 0.f;
#pragma unroll
    for (int j = 0; j < 4; ++j) { const int c4 = lane * 4 + 256 * j;
        const u32x4 ha = *(const u32x4*)((const unsigned*)Hloc + (size_t)row * DLRU + c4); const f32x4 cr = *(const f32x4*)(carry + (size_t)ct * DLRU + c4);
        const u32x2 g = *(const u32x2*)(proj + (size_t)row * NPROJ + DLRU + c4);
        const f32x4 hl = {bflo(ha.x), bflo(ha.y), bflo(ha.z), bflo(ha.w)}, ac = {bfhi(ha.x), bfhi(ha.y), bfhi(ha.z), bfhi(ha.w)};
        const f32x4 hh = hl + ac * cr;
        y[j][0] = hh[0] * gelu_tanh_f(bflo(g.x)); y[j][1] = hh[1] * gelu_tanh_f(bfhi(g.x)); y[j][2] = hh[2] * gelu_tanh_f(bflo(g.y)); y[j][3] = hh[3] * gelu_tanh_f(bfhi(g.y));
        ss += (y[j][0] * y[j][0] + y[j][1] * y[j][1]) + (y[j][2] * y[j][2] + y[j][3] * y[j][3]); }
    ss = wave_sum(ss, lane); const float rs = rsqrt_f(ss * (1.0f / DLRU) + EPS);
#pragma unroll
    for (int j = 0; j < 4; ++j) { const int c4 = lane * 4 + 256 * j; const f32x4 g = *(const f32x4*)(gain + c4); u32x2 w; w.x = pk2(y[j][0] * rs * g[0], y[j][1] * rs * g[1]); w.y = pk2(y[j][2] * rs * g[2], y[j][3] * rs * g[3]);
        *(u32x2*)(ymix + (size_t)row * D + c4) = w; }
}
__device__ __forceinline__ void dn_out_row(const float* o, const float* gain, const bf16* proj, bf16* ymix, int t, int lane) {
    const int c = lane * 16;
    const f32x4* op = (const f32x4*)(o + (size_t)t * DDN + c); const f32x4 o0 = op[0], o1 = op[1], o2 = op[2], o3 = op[3];
    const u32x4* gp = (const u32x4*)(proj + (size_t)t * NPROJ + 5120 + c); const u32x4 g0 = gp[0], g1 = gp[1];
    const f32x4* wp = (const f32x4*)(gain + (c & 127)); const f32x4 w0 = wp[0], w1 = wp[1], w2 = wp[2], w3 = wp[3];
    float ss = (o0[0] * o0[0] + o0[1] * o0[1]) + (o0[2] * o0[2] + o0[3] * o0[3]) + (o1[0] * o1[0] + o1[1] * o1[1]) + (o1[2] * o1[2] + o1[3] * o1[3])
             + (o2[0] * o2[0] + o2[1] * o2[1]) + (o2[2] * o2[2] + o2[3] * o2[3]) + (o3[0] * o3[0] + o3[1] * o3[1]) + (o3[2] * o3[2] + o3[3] * o3[3]);
    ss += shfl_xor_l(ss, 1, lane); ss += shfl_xor_l(ss, 2, lane); ss += shfl_xor_l(ss, 4, lane);
    const float rs = rsqrt_f(ss * (1.0f / HD) + EPS);
    u32x4 r0, r1;
    r0.x = pk2(o0[0] * rs * w0[0] * silu_f(bflo(g0.x)), o0[1] * rs * w0[1] * silu_f(bfhi(g0.x))); r0.y = pk2(o0[2] * rs * w0[2] * silu_f(bflo(g0.y)), o0[3] * rs * w0[3] * silu_f(bfhi(g0.y)));
    r0.z = pk2(o1[0] * rs * w1[0] * silu_f(bflo(g0.z)), o1[1] * rs * w1[1] * silu_f(bfhi(g0.z))); r0.w = pk2(o1[2] * rs * w1[2] * silu_f(bflo(g0.w)), o1[3] * rs * w1[3] * silu_f(bfhi(g0.w)));
    r1.x = pk2(o2[0] * rs * w2[0] * silu_f(bflo(g1.x)), o2[1] * rs * w2[1] * silu_f(bfhi(g1.x))); r1.y = pk2(o2[2] * rs * w2[2] * silu_f(bflo(g1.y)), o2[3] * rs * w2[3] * silu_f(bfhi(g1.y)));
    r1.z = pk2(o3[0] * rs * w3[0] * silu_f(bflo(g1.z)), o3[1] * rs * w3[1] * silu_f(bfhi(g1.z))); r1.w = pk2(o3[2] * rs * w3[2] * silu_f(bflo(g1.w)), o3[3] * rs * w3[3] * silu_f(bfhi(g1.w)));
    u32x4* dst = (u32x4*)(ymix + (size_t)t * D + DLRU + c); dst[0] = r0; dst[1] = r1;
}
__device__ __forceinline__ void route_row(const float* x, const float* rstd, const float* gain, const float* router, float* roww, int row, int lane) {
    float acc[8];
#pragma unroll
    for (int e = 0; e < 8; ++e) acc[e] = 0.f;
    for (int j = 0; j < 32; ++j) { const int k = lane + 64 * j; const float xv = x[(size_t)row * D + k] * gain[k]; const f32x4 r0 = *(const f32x4*)(router + (size_t)k * 8), r1 = *(const f32x4*)(router + (size_t)k * 8 + 4);
        acc[0] += xv * r0[0]; acc[1] += xv * r0[1]; acc[2] += xv * r0[2]; acc[3] += xv * r0[3]; acc[4] += xv * r1[0]; acc[5] += xv * r1[1]; acc[6] += xv * r1[2]; acc[7] += xv * r1[3]; }
    const float rs = rstd[row];
#pragma unroll
    for (int e = 0; e < 8; ++e) acc[e] = wave_sum(acc[e], lane) * rs;
    int e1 = 0; float l1 = acc[0];
#pragma unroll
    for (int e = 1; e < 8; ++e) if (acc[e] > l1) { l1 = acc[e]; e1 = e; }
    int e2 = -1; float l2 = -3.4e38f;
#pragma unroll
    for (int e = 0; e < 8; ++e) if (e != e1 && acc[e] > l2) { l2 = acc[e]; e2 = e; }
    const float w1 = 1.0f / (1.0f + __expf(l2 - l1)), w2 = 1.0f - w1;
    if (lane < 8) roww[(size_t)lane * T + row] = lane == e1 ? w1 : (lane == e2 ? w2 : 0.0f);
}
__device__ __forceinline__ void final_row(const float* x, const float* gain, float* out, int row, int lane) {
    const f32x4* xr = (const f32x4*)(x + (size_t)row * D) + lane; const f32x4* gr = (const f32x4*)gain + lane;
    f32x4 v[8]; float ss = 0.f;
#pragma unroll
    for (int j = 0; j < 8; ++j) { v[j] = xr[64 * j]; ss += (v[j][0] * v[j][0] + v[j][1] * v[j][1]) + (v[j][2] * v[j][2] + v[j][3] * v[j][3]); }
    ss = wave_sum(ss, lane); const float rs = rsqrt_f(ss * (1.0f / D) + EPS);
    f32x4* o = (f32x4*)(out + (size_t)row * D) + lane;
#pragma unroll
    for (int j = 0; j < 8; ++j) o[64 * j] = v[j] * rs * gr[64 * j];
}

struct MoeOrder {
    const int* list; int nN, G, c; int c0, c1, c2, c3, c4, c5, c6, c7;
    __device__ __forceinline__ void init(const unsigned* cnt, const int* list_, int nN_, int G_, int c_) { list = list_; nN = nN_; G = G_; c = c_;
        c0 = __builtin_amdgcn_readfirstlane((int)cnt[0]); c1 = __builtin_amdgcn_readfirstlane((int)cnt[1]); c2 = __builtin_amdgcn_readfirstlane((int)cnt[2]); c3 = __builtin_amdgcn_readfirstlane((int)cnt[3]);
        c4 = __builtin_amdgcn_readfirstlane((int)cnt[4]); c5 = __builtin_amdgcn_readfirstlane((int)cnt[5]); c6 = __builtin_amdgcn_readfirstlane((int)cnt[6]); c7 = __builtin_amdgcn_readfirstlane((int)cnt[7]); }
    __device__ __forceinline__ bool next(int i, pg8::Unit& u) const {
        const int c8[8] = {c0, c1, c2, c3, c4, c5, c6, c7}; int nM = 0;
#pragma unroll
        for (int k = 0; k < 8; ++k) nM += (c8[k] + 255) >> 8;
        const int nwg = nM * nN; const long L = (long)i * G + c; if (L >= nwg) return false;
        int wgid = (int)L; { const int q = nwg / pg8::NXCD, r = nwg % pg8::NXCD, xcd = wgid % pg8::NXCD, off = wgid / pg8::NXCD; wgid = (xcd < r ? xcd * (q + 1) : r * (q + 1) + (xcd - r) * q) + off; }
        const int nig = pg8::WGM * nN, gid = wgid / nig, fm = gid * pg8::WGM, gsz = (nM - fm) < pg8::WGM ? (nM - fm) : pg8::WGM;
        u.pm = fm + ((wgid % nig) % gsz); u.pn = (wgid % nig) / gsz;
        int e = 0, ps = 0, ce = c8[0], run = 0;
#pragma unroll
        for (int k = 0; k < 8; ++k) { const int mk = (c8[k] + 255) >> 8; if (u.pm >= run && u.pm < run + mk) { e = k; ps = run; ce = c8[k]; } run += mk; }
        const int mtl = u.pm - ps; u.pb = e * nN + u.pn; u.lbase = e * T + mtl * 256; u.nvalid = (ce - mtl * 256) < 256 ? (ce - mtl * 256) : 256;
        return true;
    }
    __device__ __forceinline__ int arow(const pg8::Unit& u, int r) const { return r < u.nvalid ? (list[u.lbase + r] & 0xffff) : 0; }
    __device__ __forceinline__ void a_ready(const pg8::Unit&) const {}
    __device__ __forceinline__ void done(const pg8::Unit&) const {}
};
constexpr float MOE_WSC = 64.0f, MOE_HSC = 16.0f;
__device__ __forceinline__ void route_block(const float* x, const float* gain, const float* router, unsigned char* xb8, float* rstd, unsigned* cnt, int* list, float* listw, int blk, LAS unsigned char* lds, int tid, int lane, int wave) {
    asm volatile("" : "+v"(lds));
    LAS float* grt = (LAS float*)lds; LAS int* se1 = (LAS int*)(lds + 65536); LAS int* se2 = se1 + 64; LAS float* sw1 = (LAS float*)(se2 + 64); LAS float* sw2 = sw1 + 64; LAS int* lcnt = (LAS int*)(sw2 + 64); LAS int* gbase = lcnt + 8;
    for (int i = tid; i < D * 8; i += 512) grt[i] = router[i] * gain[i >> 3];
    if (tid < 8) lcnt[tid] = 0;
    __syncthreads();
    f32x4 vnx[8];
    { const f32x4* xr = (const f32x4*)(x + (size_t)(blk * 64 + wave * 8) * D) + lane;
#pragma unroll
      for (int j = 0; j < 8; ++j) vnx[j] = xr[64 * j]; }
    for (int q = 0; q < 8; ++q) { const int rloc = wave * 8 + q, row = blk * 64 + rloc;
        f32x4 v[8]; float ss = 0.f;
#pragma unroll
        for (int j = 0; j < 8; ++j) { v[j] = vnx[j]; ss += (v[j][0] * v[j][0] + v[j][1] * v[j][1]) + (v[j][2] * v[j][2] + v[j][3] * v[j][3]); }
        { const f32x4* xr = (const f32x4*)(x + (size_t)(row + (q < 7 ? 1 : 0)) * D) + lane;
#pragma unroll
          for (int j = 0; j < 8; ++j) vnx[j] = xr[64 * j]; }
        ss = wave_sum(ss, lane); const float rs = rsqrt_f(ss * (1.0f / D) + EPS);
        unsigned* o = (unsigned*)(xb8 + (size_t)row * D) + lane;
#pragma unroll
        for (int j = 0; j < 8; ++j) o[64 * j] = pg8::cvt_pk4_fp8(v[j][0], v[j][1], v[j][2], v[j][3]);
        if (lane == 0) rstd[row] = rs * (1.0f / MOE_WSC);
        float acc[8];
#pragma unroll
        for (int e = 0; e < 8; ++e) acc[e] = 0.f;
#pragma unroll
        for (int j = 0; j < 8; ++j)
#pragma unroll
            for (int c = 0; c < 4; ++c) { const int k = (lane + 64 * j) * 4 + c; const f32x4 r0 = *(const LAS f32x4*)(grt + k * 8), r1 = *(const LAS f32x4*)(grt + k * 8 + 4); const float xv = v[j][c];
                acc[0] += xv * r0[0]; acc[1] += xv * r0[1]; acc[2] += xv * r0[2]; acc[3] += xv * r0[3]; acc[4] += xv * r1[0]; acc[5] += xv * r1[1]; acc[6] += xv * r1[2]; acc[7] += xv * r1[3]; }
#pragma unroll
        for (int e = 0; e < 8; ++e) acc[e] = wave_sum(acc[e], lane) * rs;
        int e1 = 0; float l1 = acc[0];
#pragma unroll
        for (int e = 1; e < 8; ++e) if (acc[e] > l1) { l1 = acc[e]; e1 = e; }
        int e2 = -1; float l2 = -3.4e38f;
#pragma unroll
        for (int e = 0; e < 8; ++e) if (e != e1 && acc[e] > l2) { l2 = acc[e]; e2 = e; }
        const float w1 = 1.0f / (1.0f + __expf(l2 - l1));
        if (lane == 0) { se1[rloc] = e1; se2[rloc] = e2; sw1[rloc] = w1; sw2[rloc] = 1.0f - w1; }
    }
    __syncthreads();
    int e = 0, lr = 0; float w = 0.f;
    if (tid < 128) { const int rloc = tid >> 1, j = tid & 1; e = j ? se2[rloc] : se1[rloc]; w = j ? sw2[rloc] : sw1[rloc]; lr = __hip_atomic_fetch_add(lcnt + e, 1, __ATOMIC_RELAXED, __HIP_MEMORY_SCOPE_WORKGROUP); }
    __syncthreads();
    if (tid < 8) gbase[tid] = (int)__hip_atomic_fetch_add(cnt + tid, (unsigned)lcnt[tid], __ATOMIC_RELAXED, __HIP_MEMORY_SCOPE_AGENT);
    __syncthreads();
    if (tid < 128) { const int pos = gbase[e] + lr, tok = blk * 64 + (tid >> 1); list[e * T + pos] = tok | ((tid & 1) << 16); listw[e * T + pos] = w * (1.0f / (MOE_WSC * MOE_HSC)); }
    __syncthreads();
}
__device__ __forceinline__ void final_row_moe(const float* x, const bf16* y0, const bf16* y1, const float* gain, float* out, int row, int lane) {
    const f32x4* xr = (const f32x4*)(x + (size_t)row * D) + lane; const f32x4* gr = (const f32x4*)gain + lane;
    const u32x2* p0 = (const u32x2*)(y0 + (size_t)row * D) + lane; const u32x2* p1 = (const u32x2*)(y1 + (size_t)row * D) + lane;
    f32x4 v[8]; float ss = 0.f;
#pragma unroll
    for (int j = 0; j < 8; ++j) { v[j] = xr[64 * j]; const u32x2 a = p0[64 * j], b = p1[64 * j];
        v[j][0] += bflo(a.x) + bflo(b.x); v[j][1] += bfhi(a.x) + bfhi(b.x); v[j][2] += bflo(a.y) + bflo(b.y); v[j][3] += bfhi(a.y) + bfhi(b.y);
        ss += (v[j][0] * v[j][0] + v[j][1] * v[j][1]) + (v[j][2] * v[j][2] + v[j][3] * v[j][3]); }
    ss = wave_sum(ss, lane); const float rs = rsqrt_f(ss * (1.0f / D) + EPS);
    f32x4* o = (f32x4*)(out + (size_t)row * D) + lane;
#pragma unroll
    for (int j = 0; j < 8; ++j) o[64 * j] = v[j] * rs * gr[64 * j];
}
__device__ __forceinline__ void ba_tail(const bf16* xbp, const bf16* wbab, const float* ssq, int mode, float* bap, int rb, int wave, int lane) {
    if (wave < 4) { const int fr = lane & 15, fq = lane >> 4, r0 = rb * 64 + wave * 16;
        const bf16* ap = xbp + (size_t)(r0 + fr) * D + fq * 8; const bf16* bp = wbab + (size_t)fr * D + fq * 8;
        f32x4 acc = {0.f, 0.f, 0.f, 0.f};
#pragma unroll 16
        for (int ks = 0; ks < 64; ++ks) { const bf16x8 a = *(const bf16x8*)(ap + ks * 32), b = *(const bf16x8*)(bp + ks * 32); acc = mfma16(a, b, acc); }
#pragma unroll
        for (int rr = 0; rr < 4; ++rr) { const int r = r0 + fq * 4 + rr; bap[(size_t)r * 16 + fr] = acc[rr] * pg8::row_scale(ssq, r, mode); } }
}
struct Args { const float* in[25]; float* out; unsigned char* ws; int ph_lo, ph_hi; };
typedef const __attribute__((address_space(4))) unsigned long long* kaptr_t;
__device__ __forceinline__ unsigned long long ldka(int i) { kaptr_t ka = (kaptr_t)__builtin_amdgcn_kernarg_segment_ptr(); asm volatile("" : "+s"(i)); return ka[i]; }
__device__ __forceinline__ const float* ldin(const Args&, int i) { return (const float*)(const GAS float*)ldka(i); }
__device__ __forceinline__ unsigned char* ldws(const Args&) { return (unsigned char*)(GAS unsigned char*)ldka(26); }
__device__ __forceinline__ float* ldout(const Args&) { return (float*)(GAS float*)ldka(25); }
__global__ void __launch_bounds__(512, 2) mega(Args args) {
    extern __shared__ __attribute__((aligned(16))) unsigned char lds_raw[];
    LAS unsigned char* lds = (LAS unsigned char*)lds_raw;
    volatile LAS unsigned* MISC = (volatile LAS unsigned*)(lds + MISC_OFF);
    const int tid = threadIdx.x;
    const int G = gridDim.x, bid = blockIdx.x, NGW = G * 8;
    unsigned char* ws = ldws(args);
    for (int u = tid; u < (LDS_BYTES - LDSCTL_OFF) / 4; u += 512) ((LAS unsigned*)(lds + LDSCTL_OFF))[u] = 0u;
    __syncthreads();
    (void)xcd_barrier_post((unsigned*)(ws + WS_CTL) + CW_BAR, MISC + 8);
#define RUN(id) true
#if defined(PROBE_MASK)
#define STAMP() do { if (threadIdx.x == 0) { ((volatile LAS unsigned long long*)(lds + LDSCTL_OFF + 1024))[nst] = __builtin_amdgcn_s_memrealtime(); } ++nst; } while (0)
#else
#define STAMP() do { } while (0)
#endif
#define SEAM(id) do { XcdBarrier bar_; bar_.bar = (unsigned*)WSP(WS_CTL) + CW_BAR; bar_.x = xb_xcc_id(); bar_.st = (volatile LAS unsigned*)(lds + MISC_OFF) + 8; xcd_barrier(bar_); STAMP(); } while (0)
#if defined(PROBE_MASK)
    int nst = 0; STAMP();
#endif
#define INP(i) ldin(args, (i))
#define WSP(off) (ldws(args) + (off))
#define x_in INP(0)
#define norm_mix INP(1)
#define w_in INP(2)
#define conv_lru_w INP(3)
#define conv_lru_b INP(4)
#define lru_w_r INP(5)
#define lru_b_r INP(6)
#define lru_w_i INP(7)
#define lru_b_i INP(8)
#define lru_lambda INP(9)
#define lru_out_norm INP(10)
#define conv_qkv_w INP(11)
#define dn_a_log INP(12)
#define dn_dt_bias INP(13)
#define dn_out_norm INP(14)
#define w_out INP(15)
#define norm_ffn INP(16)
#define ffn_w_gate INP(17)
#define ffn_w_up INP(18)
#define ffn_w_down INP(19)
#define moe_router INP(20)
#define moe_w_gate INP(21)
#define moe_w_up INP(22)
#define moe_w_down INP(23)
#define norm_final INP(24)
#define xres (ldout(args))
#define Win ((bf16*)WSP(WS_WIN))
#define Wba ((float*)WSP(WS_WBA))
#define Wout ((bf16*)WSP(WS_WOUT))
#define Wgu ((bf16*)WSP(WS_WGU))
#define Wd ((bf16*)WSP(WS_WD))
#define Mgu ((bf16*)WSP(WS_MG0))
#define Md ((bf16*)WSP(WS_WGU))
#define Mgu8 ((unsigned char*)WSP(WS_MG0))
#define Md8 ((unsigned char*)WSP(WS_WGU))
#define xb8 ((unsigned char*)WSP(WS_XB))
#define hid8 ((unsigned char*)WSP(WS_PROJ))
#define MCNT ((unsigned*)WSP(WS_CTL) + CW_CNT)
#define MLIST ((int*)WSP(WS_ROWW))
#define MLISTW ((float*)WSP(WS_ROWW + (size_t)8 * T * 4))
#define YP0 ((bf16*)WSP(WS_XB))
#define YP1 ((bf16*)WSP(WS_YMIX))
#define xb ((bf16*)WSP(WS_XB))
#define rstd ((float*)WSP(WS_RSTD))
#define SSQA ((float*)WSP(WS_RSTD + (size_t)1 * MiB))
#define SSQB ((float*)WSP(WS_RSTD + (size_t)3 * MiB))
#define WBAB ((bf16*)WSP(WS_WBA + (size_t)2 * 16 * D * 4))
#define ba ((float*)WSP(WS_BA))
#define beta ((float*)WSP(WS_BETA))
#define gg ((float*)WSP(WS_G))
#define roww ((float*)WSP(WS_ROWW))
#define proj ((bf16*)WSP(WS_PROJ))
#define hid ((bf16*)WSP(WS_PROJ))
#define ymix ((bf16*)WSP(WS_YMIX))
#define c0 ((float*)WSP(WS_C))
#define c1 ((float*)WSP(WS_C + (size_t)T * 1024 * 4))
#define c2 ((float*)WSP(WS_C + (size_t)2 * T * 1024 * 4))
#define c3 ((float*)WSP(WS_C + (size_t)3 * T * 1024 * 4))
#define LRU_WRT ((bf16*)WSP(WS_WRT))
#define LRU_WIT ((bf16*)WSP(WS_WRT + (size_t)2 * 8 * 128 * 128 * 2))
#define LRU_H ((float*)WSP(WS_C + (size_t)256 * MiB))
#define LRU_A ((float*)WSP(WS_C + (size_t)320 * MiB))
#define LRU_SUMM ((float*)WSP(WS_C + (size_t)384 * MiB))
#define LRU_CARRY ((float*)WSP(WS_C + (size_t)386 * MiB))
#define DN_WF ((bf16*)WSP(WS_C))
#define DN_QF ((bf16*)WSP(WS_C + (size_t)32 * MiB))
#define DN_KDTF ((bf16*)WSP(WS_C + (size_t)64 * MiB))
#define DN_UF ((bf16*)WSP(WS_C + (size_t)96 * MiB))
#define DN_QKF ((bf16*)WSP(WS_C + (size_t)128 * MiB))
#define DN_GL ((float*)WSP(WS_C + (size_t)144 * MiB))
#define DN_VF ((bf16*)WSP(WS_C + (size_t)146 * MiB))
#define DN_SF ((bf16*)WSP(WS_C + (size_t)192 * MiB))
    const int BIG = 1 << 30;
#define PHL int tid_ = threadIdx.x; asm volatile("" : "+v"(tid_)); const int lane_ = tid_ & 63; int bid_ = blockIdx.x; asm volatile("" : "+s"(bid_)); const int gw_ = bid_ * 8 + __builtin_amdgcn_readfirstlane(tid_ >> 6); const size_t gt_ = (size_t)bid_ * 512 + tid_, NGT = (size_t)G * 512; LAS float* scr = (LAS float*)(lds + (gw_ & 7) * 16384);
    if (RUN(ph)) { PHL
        convert_matrix(w_in, DIN, 0, D, NPROJ, norm_mix, Win, BIG, 0, 0, scr, gw_, NGW, lane_);
        convert_matrix(w_out, D, 0, D, D, nullptr, Wout, BIG, 0, 0, scr, gw_, NGW, lane_);
        for (size_t i = gt_; i < (size_t)2 * 16 * D; i += NGT) { const int l = (int)(i / (16 * D)), j = (int)((i / D) & 15), k = (int)(i % D); WBAB[i] = (bf16)f2bf(w_in[(size_t)l * D * DIN + (size_t)k * DIN + NPROJ + j] * norm_mix[l * D + k]); }
        for (int r = gw_; r < T; r += NGW) rowprep_row(x_in, xb, rstd, nullptr, nullptr, r, lane_);
        for (int m = 0; m < 16; ++m) {
            convert_matrix(lru_w_r + (size_t)m * 128 * 128, 128, 0, 128, 128, nullptr, LRU_WRT + (size_t)m * 128 * 128, BIG, 0, 0, scr, gw_, NGW, lane_);
            convert_matrix(lru_w_i + (size_t)m * 128 * 128, 128, 0, 128, 128, nullptr, LRU_WIT + (size_t)m * 128 * 128, BIG, 0, 0, scr, gw_, NGW, lane_); }
    }
    SEAM(ph);
    int xsel = 0;
#define xcur (xsel ? (const float*)xres : x_in)
    { constexpr int l = 0;
        if (RUN(ph)) { pg8::Gemm g{xb, Win + (size_t)l * NPROJ * D, T, NPROJ, D, 0}; pg8::StaticOrder S; S.init(T, NPROJ, G, bid); pg8::EpiScaleBf16 E{proj, l == 0 ? rstd : SSQB, NPROJ, l};
            pg8::gemm_phase<pg8::EpiScaleBf16, pg8::StaticOrder, true, false>(lds, g, S, E);
            { PHL for (int rb = bid_; rb < T / 64; rb += G) ba_tail(xb, WBAB + (size_t)l * 16 * D, l == 0 ? rstd : SSQB, l, ba, rb, gw_ & 7, lane_); } }
        SEAM(ph);
        if (RUN(ph)) { PHL
            LAS float* cwl = (LAS float*)(lds + LDSCTL_OFF + 4096); LAS float* lwl = cwl + 4 * 384;
            { const int hb = bid_ & 7; const float* cq = conv_qkv_w + (size_t)l * 4 * 3 * DDN; const float* cl = conv_lru_w + (size_t)l * 4 * DLRU; const float* cbp = conv_lru_b + l * DLRU;
              for (int i = tid_; i < 4 * 384; i += 512) { const int k = i / 384, pp = (i % 384) >> 7, d = i & 127; cwl[i] = cq[k * 3 * DDN + pp * DDN + hb * HD + d]; }
              for (int i = tid_; i < 640; i += 512) { const int k = i >> 7, d = i & 127; lwl[i] = k < 4 ? cl[k * DLRU + hb * 128 + d] : cbp[hb * 128 + d]; }
              __syncthreads(); }
            { const LruConst LC = lrua_const(LRU_WRT + (size_t)l * 8 * 128 * 128, LRU_WIT + (size_t)l * 8 * 128 * 128, lru_b_r + l * DLRU, lru_b_i + l * DLRU, lru_lambda + l * DLRU, bid_ & 7, lane_, gw_ & 7);
              for (int u = bid_; u < 2048; u += G) lrua_unit(proj, LC, LRU_H, LRU_A, LRU_SUMM, u, lds, lwl, tid_, lane_, gw_ & 7); }
            STAMP();
            for (int uid = bid_; uid < 2048; uid += G) dna_unit(proj, conv_qkv_w + (size_t)l * 4 * 3 * DDN, ba, dn_a_log + l * NH, dn_dt_bias + l * NH, DN_WF, DN_QF, DN_KDTF, DN_QKF, DN_UF, DN_GL, uid, lds, cwl, tid_, lane_, gw_ & 7); }
        SEAM(ph);
        if (RUN(ph)) { PHL
            if (bid_ < 128) dnb_run(DN_WF, DN_KDTF, DN_UF, DN_GL, DN_SF, DN_VF, (bid_ & 7) + 8 * (bid_ >> 6), (bid_ >> 3) & 7, lds, tid_, lane_, gw_ & 7);
            else { if (bid_ < 136 && tid_ < 256) lru_carry(LRU_SUMM, LRU_CARRY, (bid_ - 128) * 256 + tid_);
                const int cw = gw_ - 128 * 8, CNW = NGW - 128 * 8;
                if (l == 0) {
                    convert_matrix(w_in + (size_t)D * DIN, DIN, 0, D, NPROJ, norm_mix + D, Win + (size_t)NPROJ * D, BIG, 0, 0, scr, cw, CNW, lane_);
                    convert_matrix(w_out + (size_t)D * D, D, 0, D, D, nullptr, Wout + (size_t)D * D, BIG, 0, 0, scr, cw, CNW, lane_);
                    convert_matrix(ffn_w_gate, DFF, 0, D, DFF, norm_ffn, Wgu, 128, 256, 0, scr, cw, CNW, lane_);
                    convert_matrix(ffn_w_up, DFF, 0, D, DFF, norm_ffn, Wgu, 128, 256, 128, scr, cw, CNW, lane_);
                    convert_matrix(ffn_w_down, D, 0, DFF, D, nullptr, Wd, BIG, 0, 0, scr, cw, CNW, lane_);
                } else {
                    for (int e = 0; e < NEXP; ++e) convert_matrix8(moe_w_down + (size_t)e * DFFE * D, D, DFFE, D, nullptr, MOE_WSC, Md8 + (size_t)e * D * DFFE, BIG, 0, 0, cw, CNW, lane_);
                    for (int e = 0; e < 2; ++e) {
                        convert_matrix8(moe_w_gate + (size_t)e * D * DFFE, DFFE, D, DFFE, norm_ffn + D, MOE_WSC, Mgu8 + (size_t)e * 2 * DFFE * D, 128, 256, 0, cw, CNW, lane_);
                        convert_matrix8(moe_w_up + (size_t)e * D * DFFE, DFFE, D, DFFE, norm_ffn + D, MOE_WSC, Mgu8 + (size_t)e * 2 * DFFE * D, 128, 256, 128, cw, CNW, lane_); }
                } } }
        SEAM(ph);
        if (RUN(ph)) { PHL
            for (int r = gw_; r < T; r += NGW) lrub_row(LRU_H, LRU_A, LRU_CARRY, proj, lru_out_norm + l * DLRU, ymix, r, lane_);
            dno_run(DN_QF, DN_QKF, DN_SF, DN_VF, dn_out_norm + l * HD, proj, ymix, bid_, G, lds, tid_, lane_, gw_ & 7); }
        SEAM(ph);
        if (RUN(ph)) { if (l == 0) { pg8::Gemm g{ymix, Wout, T, D, D, 0}; pg8::StaticOrder S; S.init(T, D, G, bid); pg8::EpiResidualNorm E{xcur, xres, xb, SSQA, D, 0};
            pg8::gemm_phase<pg8::EpiResidualNorm, pg8::StaticOrder, true, false>(lds, g, S, E); }
          else { pg8::Gemm g{ymix, Wout + (size_t)D * D, T, D, D, 0}; pg8::StaticOrder S; S.init(T, D, G, bid); pg8::EpiResidual E{xcur, xres, nullptr, D, 0};
            pg8::gemm_phase<pg8::EpiResidual, pg8::StaticOrder, true, false>(lds, g, S, E); }
            if (l == 1) { PHL
                for (int e = 2; e < NEXP; ++e) {
                    convert_matrix8(moe_w_gate + (size_t)e * D * DFFE, DFFE, D, DFFE, norm_ffn + D, MOE_WSC, Mgu8 + (size_t)e * 2 * DFFE * D, 128, 256, 0, gw_, NGW, lane_);
                    convert_matrix8(moe_w_up + (size_t)e * D * DFFE, DFFE, D, DFFE, norm_ffn + D, MOE_WSC, Mgu8 + (size_t)e * 2 * DFFE * D, 128, 256, 128, gw_, NGW, lane_);
 } } }
        SEAM(ph);
        xsel = 1;
        if (l == 0) {
            if (RUN(ph)) { pg8::Gemm g{xb, Wgu, T, 2 * DFF, D, 0}; pg8::StaticOrder S; S.init(T, 2 * DFF, G, bid); pg8::EpiSwiGLU E{hid, SSQA, DFF, 1};
                pg8::gemm_phase<pg8::EpiSwiGLU, pg8::StaticOrder, true, false>(lds, g, S, E); }
            SEAM(ph);
            if (RUN(ph)) { pg8::Gemm g{hid, Wd, T, D, DFF, 0}; pg8::StaticOrder S; S.init(T, D, G, bid); pg8::EpiResidualNorm E{xcur, xres, xb, SSQB, D, 0};
                pg8::gemm_phase<pg8::EpiResidualNorm, pg8::StaticOrder, true, false>(lds, g, S, E); }
            SEAM(ph);
        } else {
            if (RUN(ph)) { PHL for (int blk = bid_; blk < T / 64; blk += G) route_block(xcur, norm_ffn + D, moe_router, xb8, rstd, MCNT, MLIST, MLISTW, blk, lds, tid_, lane_, gw_ & 7); }
            SEAM(ph);
            if (RUN(ph)) { pg8::Gemm g{(const pg8::bf16_t*)xb8, (const pg8::bf16_t*)Mgu8, NSLOT, 2 * DFFE, D / 2, 0}; MoeOrder S; S.init(MCNT, MLIST, 2 * DFFE / 256, G, bid); pg8::EpiSwiGLUMoe8 E{hid8, rstd, MLIST, DFFE, MOE_HSC};
                pg8::gemm_phase<pg8::EpiSwiGLUMoe8, MoeOrder, true, true, true>(lds, g, S, E); }
            SEAM(ph);
            if (RUN(ph)) { pg8::Gemm g{(const pg8::bf16_t*)hid8, (const pg8::bf16_t*)Md8, NSLOT, D, DFFE / 2, 0}; MoeOrder S; S.init(MCNT, MLIST, D / 256, G, bid); pg8::EpiMoeDown E{YP0, YP1, MLIST, MLISTW, D, 0};
                pg8::gemm_phase<pg8::EpiMoeDown, MoeOrder, true, false, true>(lds, g, S, E); }
            SEAM(ph);
        }
    }
    { constexpr int l = 1;
        if (RUN(ph)) { pg8::Gemm g{xb, Win + (size_t)l * NPROJ * D, T, NPROJ, D, 0}; pg8::StaticOrder S; S.init(T, NPROJ, G, bid); pg8::EpiScaleBf16 E{proj, l == 0 ? rstd : SSQB, NPROJ, l};
            pg8::gemm_phase<pg8::EpiScaleBf16, pg8::StaticOrder, true, false>(lds, g, S, E);
            { PHL for (int rb = bid_; rb < T / 64; rb += G) ba_tail(xb, WBAB + (size_t)l * 16 * D, l == 0 ? rstd : SSQB, l, ba, rb, gw_ & 7, lane_); } }
        SEAM(ph);
        if (RUN(ph)) { PHL
            LAS float* cwl = (LAS float*)(lds + LDSCTL_OFF + 4096); LAS float* lwl = cwl + 4 * 384;
            { const int hb = bid_ & 7; const float* cq = conv_qkv_w + (size_t)l * 4 * 3 * DDN; const float* cl = conv_lru_w + (size_t)l * 4 * DLRU; const float* cbp = conv_lru_b + l * DLRU;
              for (int i = tid_; i < 4 * 384; i += 512) { const int k = i / 384, pp = (i % 384) >> 7, d = i & 127; cwl[i] = cq[k * 3 * DDN + pp * DDN + hb * HD + d]; }
              for (int i = tid_; i < 640; i += 512) { const int k = i >> 7, d = i & 127; lwl[i] = k < 4 ? cl[k * DLRU + hb * 128 + d] : cbp[hb * 128 + d]; }
              __syncthreads(); }
            { const LruConst LC = lrua_const(LRU_WRT + (size_t)l * 8 * 128 * 128, LRU_WIT + (size_t)l * 8 * 128 * 128, lru_b_r + l * DLRU, lru_b_i + l * DLRU, lru_lambda + l * DLRU, bid_ & 7, lane_, gw_ & 7);
              for (int u = bid_; u < 2048; u += G) lrua_unit(proj, LC, LRU_H, LRU_A, LRU_SUMM, u, lds, lwl, tid_, lane_, gw_ & 7); }
            STAMP();
            for (int uid = bid_; uid < 2048; uid += G) dna_unit(proj, conv_qkv_w + (size_t)l * 4 * 3 * DDN, ba, dn_a_log + l * NH, dn_dt_bias + l * NH, DN_WF, DN_QF, DN_KDTF, DN_QKF, DN_UF, DN_GL, uid, lds, cwl, tid_, lane_, gw_ & 7); }
        SEAM(ph);
        if (RUN(ph)) { PHL
            if (bid_ < 128) dnb_run(DN_WF, DN_KDTF, DN_UF, DN_GL, DN_SF, DN_VF, (bid_ & 7) + 8 * (bid_ >> 6), (bid_ >> 3) & 7, lds, tid_, lane_, gw_ & 7);
            else { if (bid_ < 136 && tid_ < 256) lru_carry(LRU_SUMM, LRU_CARRY, (bid_ - 128) * 256 + tid_);
                const int cw = gw_ - 128 * 8, CNW = NGW - 128 * 8;
                if (l == 0) {
                    convert_matrix(w_in + (size_t)D * DIN, DIN, 0, D, NPROJ, norm_mix + D, Win + (size_t)NPROJ * D, BIG, 0, 0, scr, cw, CNW, lane_);
                    convert_matrix(w_out + (size_t)D * D, D, 0, D, D, nullptr, Wout + (size_t)D * D, BIG, 0, 0, scr, cw, CNW, lane_);
                    convert_matrix(ffn_w_gate, DFF, 0, D, DFF, norm_ffn, Wgu, 128, 256, 0, scr, cw, CNW, lane_);
                    convert_matrix(ffn_w_up, DFF, 0, D, DFF, norm_ffn, Wgu, 128, 256, 128, scr, cw, CNW, lane_);
                    convert_matrix(ffn_w_down, D, 0, DFF, D, nullptr, Wd, BIG, 0, 0, scr, cw, CNW, lane_);
                } else {
                    for (int e = 0; e < NEXP; ++e) convert_matrix8(moe_w_down + (size_t)e * DFFE * D, D, DFFE, D, nullptr, MOE_WSC, Md8 + (size_t)e * D * DFFE, BIG, 0, 0, cw, CNW, lane_);
                    for (int e = 0; e < 2; ++e) {
                        convert_matrix8(moe_w_gate + (size_t)e * D * DFFE, DFFE, D, DFFE, norm_ffn + D, MOE_WSC, Mgu8 + (size_t)e * 2 * DFFE * D, 128, 256, 0, cw, CNW, lane_);
                        convert_matrix8(moe_w_up + (size_t)e * D * DFFE, DFFE, D, DFFE, norm_ffn + D, MOE_WSC, Mgu8 + (size_t)e * 2 * DFFE * D, 128, 256, 128, cw, CNW, lane_); }
                } } }
        SEAM(ph);
        if (RUN(ph)) { PHL
            for (int r = gw_; r < T; r += NGW) lrub_row(LRU_H, LRU_A, LRU_CARRY, proj, lru_out_norm + l * DLRU, ymix, r, lane_);
            dno_run(DN_QF, DN_QKF, DN_SF, DN_VF, dn_out_norm + l * HD, proj, ymix, bid_, G, lds, tid_, lane_, gw_ & 7); }
        SEAM(ph);
        if (RUN(ph)) { if (l == 0) { pg8::Gemm g{ymix, Wout, T, D, D, 0}; pg8::StaticOrder S; S.init(T, D, G, bid); pg8::EpiResidualNorm E{xcur, xres, xb, SSQA, D, 0};
            pg8::gemm_phase<pg8::EpiResidualNorm, pg8::StaticOrder, true, false>(lds, g, S, E); }
          else { pg8::Gemm g{ymix, Wout + (size_t)D * D, T, D, D, 0}; pg8::StaticOrder S; S.init(T, D, G, bid); pg8::EpiResidual E{xcur, xres, nullptr, D, 0};
            pg8::gemm_phase<pg8::EpiResidual, pg8::StaticOrder, true, false>(lds, g, S, E); }
            if (l == 1) { PHL
                for (int e = 2; e < NEXP; ++e) {
                    convert_matrix8(moe_w_gate + (size_t)e * D * DFFE, DFFE, D, DFFE, norm_ffn + D, MOE_WSC, Mgu8 + (size_t)e * 2 * DFFE * D, 128, 256, 0, gw_, NGW, lane_);
                    convert_matrix8(moe_w_up + (size_t)e * D * DFFE, DFFE, D, DFFE, norm_ffn + D, MOE_WSC, Mgu8 + (size_t)e * 2 * DFFE * D, 128, 256, 128, gw_, NGW, lane_);
 } } }
        SEAM(ph);
        xsel = 1;
        if (l == 0) {
            if (RUN(ph)) { pg8::Gemm g{xb, Wgu, T, 2 * DFF, D, 0}; pg8::StaticOrder S; S.init(T, 2 * DFF, G, bid); pg8::EpiSwiGLU E{hid, SSQA, DFF, 1};
                pg8::gemm_phase<pg8::EpiSwiGLU, pg8::StaticOrder, true, false>(lds, g, S, E); }
            SEAM(ph);
            if (RUN(ph)) { pg8::Gemm g{hid, Wd, T, D, DFF, 0}; pg8::StaticOrder S; S.init(T, D, G, bid); pg8::EpiResidualNorm E{xcur, xres, xb, SSQB, D, 0};
                pg8::gemm_phase<pg8::EpiResidualNorm, pg8::StaticOrder, true, false>(lds, g, S, E); }
            SEAM(ph);
        } else {
            if (RUN(ph)) { PHL for (int blk = bid_; blk < T / 64; blk += G) route_block(xcur, norm_ffn + D, moe_router, xb8, rstd, MCNT, MLIST, MLISTW, blk, lds, tid_, lane_, gw_ & 7); }
            SEAM(ph);
            if (RUN(ph)) { pg8::Gemm g{(const pg8::bf16_t*)xb8, (const pg8::bf16_t*)Mgu8, NSLOT, 2 * DFFE, D / 2, 0}; MoeOrder S; S.init(MCNT, MLIST, 2 * DFFE / 256, G, bid); pg8::EpiSwiGLUMoe8 E{hid8, rstd, MLIST, DFFE, MOE_HSC};
                pg8::gemm_phase<pg8::EpiSwiGLUMoe8, MoeOrder, true, true, true>(lds, g, S, E); }
            SEAM(ph);
            if (RUN(ph)) { pg8::Gemm g{(const pg8::bf16_t*)hid8, (const pg8::bf16_t*)Md8, NSLOT, D, DFFE / 2, 0}; MoeOrder S; S.init(MCNT, MLIST, D / 256, G, bid); pg8::EpiMoeDown E{YP0, YP1, MLIST, MLISTW, D, 0};
                pg8::gemm_phase<pg8::EpiMoeDown, MoeOrder, true, false, true>(lds, g, S, E); }
            SEAM(ph);
        }
    }
    if (RUN(ph)) { PHL for (int r = gw_; r < T; r += NGW) final_row_moe(xcur, YP0, YP1, norm_final, xres, r, lane_); }
#if defined(PROBE_MASK)
    __syncthreads(); STAMP();
    if (blockIdx.x == 0 && threadIdx.x == 0) { asm volatile("s_waitcnt vmcnt(0)" ::: "memory"); volatile LAS unsigned long long* st = (volatile LAS unsigned long long*)(lds + LDSCTL_OFF + 1024); unsigned long long tot = 0;
        for (int k = 1; k < nst; ++k) if ((PROBE_MASK >> (k - 1)) & 1ull) tot += st[k] - st[k - 1];
        xres[0] = rintf((float)tot * 0.01f * PROBE_SCALE); }
#endif
#if defined(PROBE_DNA_A)
    __syncthreads();
    if (blockIdx.x == 0 && threadIdx.x == 0) { asm volatile("s_waitcnt vmcnt(0)" ::: "memory"); volatile LAS unsigned long long* st = (volatile LAS unsigned long long*)(lds + (RING_BYTES + 2048));
        xres[0] = rintf((float)(st[PROBE_DNA_B] - st[PROBE_DNA_A]) * 0.01f * PROBE_SCALE); }
#endif
#undef RUN
#undef SEAM
}

extern "C" void kernel_launch(void* const* d_in, const int* in_sizes, int n_in, void* d_out, int out_size, void* d_ws, size_t ws_size, hipStream_t stream) {
    static int grid = 0;
    if (grid == 0) {
        if (n_in != 25 || ws_size < WS_END) { fprintf(stderr, "kernel_launch: unexpected n_in %d / ws_size %zu (need %zu)\n", n_in, ws_size, (size_t)WS_END); grid = -1; return; }
        int dev = 0, cus = 0, per_cu = 0;
        if (hipGetDevice(&dev) != hipSuccess || hipDeviceGetAttribute(&cus, hipDeviceAttributeMultiprocessorCount, dev) != hipSuccess) { grid = -1; return; }
        if (hipFuncSetAttribute((const void*)mega, hipFuncAttributeMaxDynamicSharedMemorySize, LDS_BYTES) != hipSuccess) { fprintf(stderr, "kernel_launch: hipFuncSetAttribute failed\n"); grid = -1; return; }
        if (hipOccupancyMaxActiveBlocksPerMultiprocessor(&per_cu, (const void*)mega, 512, LDS_BYTES) != hipSuccess || per_cu < 1) { fprintf(stderr, "kernel_launch: occupancy query says %d\n", per_cu); }
        (void)hipGetLastError();
        grid = cus;
    }
    if (grid < 0) return;
    if (hipMemsetAsync((char*)d_ws + WS_CTL, 0, CTL_ZERO_BYTES, stream) != hipSuccess) return;
    Args a{};
    for (int i = 0; i < 25; ++i) a.in[i] = (const float*)d_in[i];
    a.out = (float*)d_out; a.ws = (unsigned char*)d_ws; a.ph_lo = 0; a.ph_hi = 1 << 30;
    hipLaunchKernelGGL(mega, dim3(grid), dim3(512), LDS_BYTES, stream, a);
}
```

```cpp
#include <hip/hip_runtime.h>
#include <cstdio>
#include <cstdint>
namespace pg8 {
#define PG8_LAS __attribute__((address_space(3)))
typedef unsigned short bf16_t;
typedef short bf16x8 __attribute__((ext_vector_type(8)));
typedef float f32x4 __attribute__((ext_vector_type(4)));
typedef unsigned u32x4 __attribute__((ext_vector_type(4)));
constexpr int BM = 256, BK = 64, HALF = 128, HTB = HALF * BK * 2  , STAGE_BYTES = 8 * HTB, NXCD = 8, WGM = 8;

__host__ __device__ __forceinline__ int lds_byte(int r, int c) { const int st = (r >> 4) * 2 + (c >> 5), rr = r & 15, cc = c & 31, ob = rr * 64 + cc * 2; return st * 1024 + (ob ^ (((ob >> 9) & 1) << 5)); }
__host__ __device__ __forceinline__ void stage_rc(int b, int& R, int& C) { const int st = b / 1024, sb = b % 1024, swz = sb ^ (((sb >> 9) & 1) << 5); R = (st >> 1) * 16 + swz / 64; C = (st & 1) * 32 + (swz % 64) / 2; }
__host__ __device__ __forceinline__ int perm32(int rho) { const int n = rho >> 4, i = rho & 15; return 8 * (i >> 2) + 4 * n + (i & 3); }

struct Unit { int pm, pn, pb, lbase, nvalid; };
struct Gemm { const bf16_t* A; const bf16_t* Bt; int M, N, K, pad; };

struct StaticOrder {
    int nM, nN, nwg, G, c;
    __host__ __device__ void init(int M, int N, int G_, int c_) { nM = M / BM; nN = N / BM; nwg = nM * nN; G = G_; c = c_; }
    __host__ __device__ bool next(int i, Unit& u) const {
        const long L = (long)i * G + c; if (L >= nwg) return false;
        int wgid = (int)L; { const int q = nwg / NXCD, r = nwg % NXCD, xcd = wgid % NXCD, off = wgid / NXCD; wgid = (xcd < r ? xcd * (q + 1) : r * (q + 1) + (xcd - r) * q) + off; }
        const int nig = WGM * nN, gid = wgid / nig, fm = gid * WGM, gsz = (nM - fm) < WGM ? (nM - fm) : WGM;
        u.pm = fm + ((wgid % nig) % gsz); u.pn = (wgid % nig) / gsz; u.pb = u.pn; u.lbase = 0; u.nvalid = BM; return true;
    }
    __device__ __forceinline__ int arow(const Unit&, int) const { return 0; }
    __device__ __forceinline__ void a_ready(const Unit&) const {}
    __device__ __forceinline__ void done(const Unit&) const {}
};


typedef float f32x2_t __attribute__((ext_vector_type(2)));
typedef __bf16 bf16x2_t __attribute__((ext_vector_type(2)));
typedef unsigned u32x2_t __attribute__((ext_vector_type(2)));
__device__ __forceinline__ unsigned cvt_pk_bf16(float lo, float hi) { const f32x2_t v = {lo, hi}; const bf16x2_t b = __builtin_convertvector(v, bf16x2_t); return __builtin_bit_cast(unsigned, b); }
__device__ __forceinline__ float frcp(float x) { return __builtin_amdgcn_rcpf(x); }
__device__ __forceinline__ float rsqrt_f(float x) { return __builtin_amdgcn_rsqf(x); }
__device__ __forceinline__ float silu_f(float x) { return x * frcp(1.0f + __expf(-x)); }
__device__ __forceinline__ float swiglu_f(float g, float u, float k1, float s2) { return (g * u) * (s2 * frcp(1.0f + __builtin_amdgcn_exp2f(g * k1))); }
__device__ __forceinline__ float row_scale(const float* rs, int r, int mode) {
    if (!mode) return rs[r];
    const f32x4* p = (const f32x4*)(rs + (size_t)r * 32); float s = 0.f;
#pragma unroll
    for (int i = 0; i < 8; ++i) { const f32x4 v = p[i]; s += (v[0] + v[1]) + (v[2] + v[3]); }
    return rsqrt_f(s * (1.0f / 2048.0f) + 1e-6f);
}
__device__ __forceinline__ void row_scales8(const float* rs, int row0, int fr, int fq, int mode, float (&sc)[2][4]) {
    if (!mode) {
#pragma unroll
        for (int ai = 0; ai < 2; ++ai)
#pragma unroll
            for (int m = 0; m < 4; ++m) sc[ai][m] = rs[row0 + ai * HALF + m * 16];
    } else {
        const int lane = fr + 16 * fq; f32x4 pa[2][4][2];
#pragma unroll
        for (int ai = 0; ai < 2; ++ai)
#pragma unroll
            for (int m = 0; m < 4; ++m) { const f32x4* p = (const f32x4*)(rs + (size_t)(row0 + ai * HALF + m * 16) * 32 + fq * 8); pa[ai][m][0] = p[0]; pa[ai][m][1] = p[1]; }
#pragma unroll
        for (int ai = 0; ai < 2; ++ai)
#pragma unroll
            for (int m = 0; m < 4; ++m) { const f32x4 a = pa[ai][m][0], b = pa[ai][m][1]; float t = ((a[0] + a[1]) + (a[2] + a[3])) + ((b[0] + b[1]) + (b[2] + b[3]));
                t += __int_as_float(__builtin_amdgcn_ds_bpermute((lane ^ 16) << 2, __float_as_int(t)));
                t += __int_as_float(__builtin_amdgcn_ds_bpermute((lane ^ 32) << 2, __float_as_int(t)));
                sc[ai][m] = rsqrt_f(t * (1.0f / 2048.0f) + 1e-6f); }
    }
}
struct EpiScaleBf16 {
    static constexpr bool PERM = true, AFTER_DRAIN = false;
    bf16_t* O; const float* rs; int ldc; int pad;
    __device__ __forceinline__ void operator()(const f32x4 (&acc)[2][2][4][2], const Unit& u, int wr, int wc, int fr, int fq) const {
        const int row0 = u.pm * BM + wr * 64 + fr, col0 = u.pn * BM + wc * 32 + 8 * fq;
        float sc[2][4]; row_scales8(rs, row0, fr, fq, pad, sc);
#pragma unroll
        for (int ai = 0; ai < 2; ++ai)
#pragma unroll
            for (int m = 0; m < 4; ++m) { const int r = row0 + ai * HALF + m * 16; const float s = sc[ai][m]; bf16_t* rowp = O + (size_t)r * ldc + col0;
#pragma unroll
                for (int bj = 0; bj < 2; ++bj) { const f32x4 v0 = acc[ai][bj][m][0] * s, v1 = acc[ai][bj][m][1] * s;
                    u32x4 w; w.x = cvt_pk_bf16(v0[0], v0[1]); w.y = cvt_pk_bf16(v0[2], v0[3]); w.z = cvt_pk_bf16(v1[0], v1[1]); w.w = cvt_pk_bf16(v1[2], v1[3]);
                    *(u32x4*)(rowp + bj * HALF) = w; } }
    }
};
struct EpiSwiGLU {
    static constexpr bool PERM = true, AFTER_DRAIN = false;
    bf16_t* O; const float* rs; int ldc; int pad;
    __device__ __forceinline__ void operator()(const f32x4 (&acc)[2][2][4][2], const Unit& u, int wr, int wc, int fr, int fq) const {
        const int row0 = u.pm * BM + wr * 64 + fr, col0 = u.pn * HALF + wc * 32 + 8 * fq;
        float sc[2][4]; row_scales8(rs, row0, fr, fq, pad, sc);
#pragma unroll
        for (int ai = 0; ai < 2; ++ai)
#pragma unroll
            for (int m = 0; m < 4; ++m) { const int r = row0 + ai * HALF + m * 16; const float s = sc[ai][m], k1 = s * -1.4426950408889634f, s2 = s * s; bf16_t* rowp = O + (size_t)r * ldc + col0;
                f32x4 h0, h1;
#pragma unroll
                for (int j = 0; j < 4; ++j) { h0[j] = swiglu_f(acc[ai][0][m][0][j], acc[ai][1][m][0][j], k1, s2); h1[j] = swiglu_f(acc[ai][0][m][1][j], acc[ai][1][m][1][j], k1, s2); }
                u32x4 w; w.x = cvt_pk_bf16(h0[0], h0[1]); w.y = cvt_pk_bf16(h0[2], h0[3]); w.z = cvt_pk_bf16(h1[0], h1[1]); w.w = cvt_pk_bf16(h1[2], h1[3]);
                *(u32x4*)rowp = w; }
    }
};
struct EpiResidual {
    static constexpr bool PERM = false, AFTER_DRAIN = false;
    const float* base; float* out; const float* roww; int ldc; int pad;
    __device__ __forceinline__ void operator()(const f32x4 (&acc)[2][2][4][2], const Unit& u, int wr, int wc, int fr, int fq) const {
        const int row0 = u.pm * BM + wr * 64 + fr, col0 = u.pn * BM + wc * 32 + 4 * fq;
#pragma unroll
        for (int ai = 0; ai < 2; ++ai)
#pragma unroll
            for (int m = 0; m < 4; ++m) { const int r = row0 + ai * HALF + m * 16; const float w = roww ? roww[r] : 1.0f; const size_t off = (size_t)r * ldc + col0;
#pragma unroll
                for (int bj = 0; bj < 2; ++bj)
#pragma unroll
                    for (int n = 0; n < 2; ++n) { const f32x4 bs = *(const f32x4*)(base + off + bj * HALF + n * 16); *(f32x4*)(out + off + bj * HALF + n * 16) = bs + acc[ai][bj][m][n] * w; } }
    }
};

struct EpiSwiGLUMoe {
    static constexpr bool PERM = true, AFTER_DRAIN = false;
    bf16_t* O; const float* rs; const int* list; int ldc; int pad;
    __device__ __forceinline__ void operator()(const f32x4 (&acc)[2][2][4][2], const Unit& u, int wr, int wc, int fr, int fq) const {
        const int rl0 = wr * 64 + fr, col0 = u.pn * HALF + wc * 32 + 8 * fq;
#pragma unroll
        for (int ai = 0; ai < 2; ++ai)
#pragma unroll
            for (int m = 0; m < 4; ++m) { const int rl = rl0 + ai * HALF + m * 16; const int tok = rl < u.nvalid ? (list[u.lbase + rl] & 0xffff) : 0; const float s = rs[tok], k1 = s * -1.4426950408889634f, s2 = s * s;
                bf16_t* rowp = O + (size_t)(u.pm * BM + rl) * ldc + col0;
                f32x4 h0, h1;
#pragma unroll
                for (int j = 0; j < 4; ++j) { h0[j] = swiglu_f(acc[ai][0][m][0][j], acc[ai][1][m][0][j], k1, s2); h1[j] = swiglu_f(acc[ai][0][m][1][j], acc[ai][1][m][1][j], k1, s2); }
                u32x4 w; w.x = cvt_pk_bf16(h0[0], h0[1]); w.y = cvt_pk_bf16(h0[2], h0[3]); w.z = cvt_pk_bf16(h1[0], h1[1]); w.w = cvt_pk_bf16(h1[2], h1[3]);
                *(u32x4*)rowp = w; }
    }
};
__device__ __forceinline__ unsigned cvt_pk4_fp8(float a, float b, float c, float d) {
    int w = 0;
    w = __builtin_amdgcn_cvt_pk_fp8_f32(__builtin_amdgcn_fmed3f(a, 448.f, -448.f), __builtin_amdgcn_fmed3f(b, 448.f, -448.f), w, false);
    w = __builtin_amdgcn_cvt_pk_fp8_f32(__builtin_amdgcn_fmed3f(c, 448.f, -448.f), __builtin_amdgcn_fmed3f(d, 448.f, -448.f), w, true);
    return (unsigned)w;
}
struct EpiSwiGLUMoe8 {
    static constexpr bool PERM = true, AFTER_DRAIN = false;
    unsigned char* O; const float* rs; const int* list; int ldc; float hs;
    __device__ __forceinline__ void operator()(const f32x4 (&acc)[2][2][4][2], const Unit& u, int wr, int wc, int fr, int fq) const {
        const int rl0 = wr * 64 + fr, col0 = u.pn * HALF + wc * 32 + 8 * fq;
#pragma unroll
        for (int ai = 0; ai < 2; ++ai)
#pragma unroll
            for (int m = 0; m < 4; ++m) { const int rl = rl0 + ai * HALF + m * 16; const int tok = rl < u.nvalid ? (list[u.lbase + rl] & 0xffff) : 0; const float s = rs[tok], k1 = s * -1.4426950408889634f, s2 = s * s * hs;
                unsigned char* rowp = O + (size_t)(u.pm * BM + rl) * ldc + col0;
                f32x4 h0, h1;
#pragma unroll
                for (int j = 0; j < 4; ++j) { h0[j] = swiglu_f(acc[ai][0][m][0][j], acc[ai][1][m][0][j], k1, s2); h1[j] = swiglu_f(acc[ai][0][m][1][j], acc[ai][1][m][1][j], k1, s2); }
                u32x2_t w; w.x = cvt_pk4_fp8(h0[0], h0[1], h0[2], h0[3]); w.y = cvt_pk4_fp8(h1[0], h1[1], h1[2], h1[3]);
                *(u32x2_t*)rowp = w; }
    }
};
struct EpiMoeDown {
    static constexpr bool PERM = true, AFTER_DRAIN = false;
    bf16_t* Y0; bf16_t* Y1; const int* list; const float* lw; int ldc; int pad;
    __device__ __forceinline__ void operator()(const f32x4 (&acc)[2][2][4][2], const Unit& u, int wr, int wc, int fr, int fq) const {
        const int rl0 = wr * 64 + fr, col0 = u.pn * BM + wc * 32 + 8 * fq;
#pragma unroll
        for (int ai = 0; ai < 2; ++ai)
#pragma unroll
            for (int m = 0; m < 4; ++m) { const int rl = rl0 + ai * HALF + m * 16;
                if (rl < u.nvalid) { const int en = list[u.lbase + rl]; const float w = lw[u.lbase + rl]; bf16_t* rowp = ((en >> 16) ? Y1 : Y0) + (size_t)(en & 0xffff) * ldc + col0;
#pragma unroll
                    for (int bj = 0; bj < 2; ++bj) { const f32x4 v0 = acc[ai][bj][m][0] * w, v1 = acc[ai][bj][m][1] * w;
                        u32x4 o; o.x = cvt_pk_bf16(v0[0], v0[1]); o.y = cvt_pk_bf16(v0[2], v0[3]); o.z = cvt_pk_bf16(v1[0], v1[1]); o.w = cvt_pk_bf16(v1[2], v1[3]);
                        *(u32x4*)(rowp + bj * HALF) = o; } } }
    }
};

struct EpiResidualNorm {
    static constexpr bool PERM = true, AFTER_DRAIN = false;
    const float* base; float* out; bf16_t* xb; float* ssq; int ldc; int pad;
    __device__ __forceinline__ void operator()(const f32x4 (&acc)[2][2][4][2], const Unit& u, int wr, int wc, int fr, int fq) const {
        const int row0 = u.pm * BM + wr * 64 + fr, col0 = u.pn * BM + wc * 32 + 8 * fq, lane = fr + 16 * fq;
#pragma unroll
        for (int ai = 0; ai < 2; ++ai)
#pragma unroll
            for (int m = 0; m < 4; ++m) { const int r = row0 + ai * HALF + m * 16; const size_t off = (size_t)r * ldc + col0; float part = 0.f;
#pragma unroll
                for (int bj = 0; bj < 2; ++bj) { const f32x4 b0 = *(const f32x4*)(base + off + bj * HALF), b1 = *(const f32x4*)(base + off + bj * HALF + 4);
                    const f32x4 v0 = b0 + acc[ai][bj][m][0], v1 = b1 + acc[ai][bj][m][1];
                    *(f32x4*)(out + off + bj * HALF) = v0; *(f32x4*)(out + off + bj * HALF + 4) = v1;
                    u32x4 w; w.x = cvt_pk_bf16(v0[0], v0[1]); w.y = cvt_pk_bf16(v0[2], v0[3]); w.z = cvt_pk_bf16(v1[0], v1[1]); w.w = cvt_pk_bf16(v1[2], v1[3]);
                    *(u32x4*)(xb + off + bj * HALF) = w;
                    part += (v0[0] * v0[0] + v0[1] * v0[1]) + (v0[2] * v0[2] + v0[3] * v0[3]) + (v1[0] * v1[0] + v1[1] * v1[1]) + (v1[2] * v1[2] + v1[3] * v1[3]); }
                part += __int_as_float(__builtin_amdgcn_ds_bpermute((lane ^ 16) << 2, __float_as_int(part)));
                part += __int_as_float(__builtin_amdgcn_ds_bpermute((lane ^ 32) << 2, __float_as_int(part)));
                if (fq == 0) ssq[(size_t)r * 32 + u.pn * 4 + wc] = part; }
    }
};

struct EpiResidualRoute {
    static constexpr bool PERM = true, AFTER_DRAIN = false;
    const float* base; float* out; unsigned char* xb8; float* ssq; const float* grtT; float* lgp; int ldc; int pad;
    __device__ __forceinline__ void operator()(const f32x4 (&acc)[2][2][4][2], const Unit& u, int wr, int wc, int fr, int fq) const {
        const int row0 = u.pm * BM + wr * 64 + fr, col0 = u.pn * BM + wc * 32 + 8 * fq, lane = fr + 16 * fq;
        f32x4 xv[2][4][2][2];
#pragma unroll
        for (int ai = 0; ai < 2; ++ai)
#pragma unroll
            for (int m = 0; m < 4; ++m) { const int r = row0 + ai * HALF + m * 16; const size_t off = (size_t)r * ldc + col0; float part = 0.f;
#pragma unroll
                for (int bj = 0; bj < 2; ++bj) { const f32x4 b0 = *(const f32x4*)(base + off + bj * HALF), b1 = *(const f32x4*)(base + off + bj * HALF + 4);
                    const f32x4 v0 = b0 + acc[ai][bj][m][0], v1 = b1 + acc[ai][bj][m][1];
                    *(f32x4*)(out + off + bj * HALF) = v0; *(f32x4*)(out + off + bj * HALF + 4) = v1;
                    u32x2_t w; w.x = cvt_pk4_fp8(v0[0], v0[1], v0[2], v0[3]); w.y = cvt_pk4_fp8(v1[0], v1[1], v1[2], v1[3]);
                    *(u32x2_t*)(xb8 + off + bj * HALF) = w;
                    part += (v0[0] * v0[0] + v0[1] * v0[1]) + (v0[2] * v0[2] + v0[3] * v0[3]) + (v1[0] * v1[0] + v1[1] * v1[1]) + (v1[2] * v1[2] + v1[3] * v1[3]);
                    xv[ai][m][bj][0] = v0; xv[ai][m][bj][1] = v1; }
                part += __int_as_float(__builtin_amdgcn_ds_bpermute((lane ^ 16) << 2, __float_as_int(part)));
                part += __int_as_float(__builtin_amdgcn_ds_bpermute((lane ^ 32) << 2, __float_as_int(part)));
                if (fq == 0) ssq[(size_t)r * 32 + u.pn * 4 + wc] = part; }
        float keep[2][4][2];
#pragma unroll
        for (int ai = 0; ai < 2; ++ai)
#pragma unroll
            for (int m = 0; m < 4; ++m) { keep[ai][m][0] = 0.f; keep[ai][m][1] = 0.f; }
#pragma unroll
        for (int eh = 0; eh < 2; ++eh)
#pragma nounroll
            for (int e4 = 0; e4 < 4; ++e4) { const f32x4* wp = (const f32x4*)(grtT + (size_t)(eh * 4 + e4) * 2048 + col0); const f32x4 w00 = wp[0], w01 = wp[1], w10 = wp[32], w11 = wp[33];
#pragma unroll
                for (int ai = 0; ai < 2; ++ai)
#pragma unroll
                    for (int m = 0; m < 4; ++m) { const f32x4 p = xv[ai][m][0][0] * w00 + xv[ai][m][0][1] * w01 + xv[ai][m][1][0] * w10 + xv[ai][m][1][1] * w11; float s = (p[0] + p[1]) + (p[2] + p[3]);
                        s += __int_as_float(__builtin_amdgcn_ds_bpermute((lane ^ 16) << 2, __float_as_int(s)));
                        s += __int_as_float(__builtin_amdgcn_ds_bpermute((lane ^ 32) << 2, __float_as_int(s)));
                        keep[ai][m][eh] = (fq == e4) ? s : keep[ai][m][eh]; } }
#pragma unroll
        for (int ai = 0; ai < 2; ++ai)
#pragma unroll
            for (int m = 0; m < 4; ++m) { const int r = row0 + ai * HALF + m * 16; float* lp = lgp + ((size_t)r * 32 + u.pn * 4 + wc) * 8 + fq; lp[0] = keep[ai][m][0]; lp[4] = keep[ai][m][1]; }
    }
};
typedef int i32x4_t __attribute__((ext_vector_type(4)));
typedef int i32x8_t __attribute__((ext_vector_type(8)));
__device__ __forceinline__ i32x8_t cat8(bf16x8 a, bf16x8 b) { const i32x4_t x = __builtin_bit_cast(i32x4_t, a), y = __builtin_bit_cast(i32x4_t, b); return __builtin_shufflevector(x, y, 0, 1, 2, 3, 4, 5, 6, 7); }
__device__ __forceinline__ void mfma_f8(f32x4& acc, const i32x8_t& a, const i32x8_t& b) { asm volatile("v_mfma_f32_16x16x128_f8f6f4 %0, %1, %2, %0" : "+v"(acc) : "v"(a), "v"(b)); }
template <class Epi, class Sched, bool ALIGN_EPI = false, bool GATHER = false, bool F8 = false>
__device__ __forceinline__ void gemm_phase(PG8_LAS unsigned char* lds, const Gemm g, const Sched& S, const Epi& E) {
    int tid_o = threadIdx.x; asm volatile("" : "+v"(tid_o));
    const int tid = tid_o, wid = __builtin_amdgcn_readfirstlane(tid >> 6), lane = tid & 63, wr = wid >> 2, wc = wid & 3, fr = lane & 15, fq = lane >> 4;
    const int K = g.K, nt = K / BK;
    const size_t kstep = (size_t)(BK * 2);
    const size_t hstep = (size_t)HALF * K * 2;
    const size_t tstep = 2 * hstep;
    unsigned voffA[2], voffB[2], oA[2][2], oN[2][2];
#pragma unroll
    for (int i = 0; i < 2; ++i) { int R, C; stage_rc(tid * 16 + i * 8192, R, C); const int Rb = Epi::PERM ? ((R & ~31) + perm32(R & 31)) : R; voffA[i] = (unsigned)(R * K + C) * 2u; voffB[i] = (unsigned)(Rb * K + C) * 2u; }
    const unsigned ldsw = (unsigned)wid * 1024u;
    const int aoff = lds_byte(wr * 64 + fr, fq * 8), boff = lds_byte(wc * 32 + fr, fq * 8);
#define PG8_SA(b, h) (((b) * 2 + (h)) * HTB)
#define PG8_SB(b, h) ((4 + (b) * 2 + (h)) * HTB)
#define PG8_STAGE(bufoff, gbase, voff) do { _Pragma("unroll") for (int _i = 0; _i < 2; ++_i) \
        __builtin_amdgcn_global_load_lds((const unsigned*)((const char*)(gbase) + (voff)[_i]), (PG8_LAS unsigned*)(lds + (bufoff) + ldsw + _i * 8192), 16, 0, 0); } while (0)
#define PG8_LDA(dst, b, h) do { _Pragma("unroll") for (int m = 0; m < 4; ++m) { if constexpr (F8) dst##8[m] = cat8(*(const PG8_LAS bf16x8*)(lds + PG8_SA(b, h) + aoff + m * 2048), *(const PG8_LAS bf16x8*)(lds + PG8_SA(b, h) + aoff + m * 2048 + 1024)); \
        else { _Pragma("unroll") for (int k = 0; k < 2; ++k) dst[m][k] = *(const PG8_LAS bf16x8*)(lds + PG8_SA(b, h) + aoff + m * 2048 + k * 1024); } } } while (0)
#define PG8_LDB(dst, b, h) do { _Pragma("unroll") for (int n = 0; n < 2; ++n) { if constexpr (F8) dst##8[n] = cat8(*(const PG8_LAS bf16x8*)(lds + PG8_SB(b, h) + boff + n * 2048), *(const PG8_LAS bf16x8*)(lds + PG8_SB(b, h) + boff + n * 2048 + 1024)); \
        else { _Pragma("unroll") for (int k = 0; k < 2; ++k) dst[n][k] = *(const PG8_LAS bf16x8*)(lds + PG8_SB(b, h) + boff + n * 2048 + k * 1024); } } } while (0)
#define PG8_MMA(ai, bj, At, Bt) do { __builtin_amdgcn_s_setprio(1); _Pragma("unroll") for (int m = 0; m < 4; ++m) _Pragma("unroll") for (int n = 0; n < 2; ++n) { \
        if constexpr (F8) mfma_f8(acc[ai][bj][m][n], Bt##8[n], At##8[m]); \
        else { _Pragma("unroll") for (int k = 0; k < 2; ++k) acc[ai][bj][m][n] = __builtin_amdgcn_mfma_f32_16x16x32_bf16(Bt[n][k], At[m][k], acc[ai][bj][m][n], 0, 0, 0); } } __builtin_amdgcn_s_setprio(0); } while (0)
#define PG8_WAIT_V(n) asm volatile("s_waitcnt vmcnt(" #n ")" ::: "memory")
#define PG8_WAIT_L(n) asm volatile("s_waitcnt lgkmcnt(" #n ")" ::: "memory")
#define PG8_BAR __builtin_amdgcn_s_barrier()
#define PG8_SCHED __builtin_amdgcn_sched_barrier(0)
#define PG8_AOFF(dst, u) do { _Pragma("unroll") for (int _i = 0; _i < 2; ++_i) { int _R, _C; stage_rc(tid * 16 + _i * 8192, _R, _C); _Pragma("unroll") for (int _h = 0; _h < 2; ++_h) \
        dst[_h][_i] = (unsigned)(S.arow(u, _h * HALF + _R) * K + _C) * 2u; } } while (0)
#define PG8_STAGE_A(bufoff, gbase, h, usenext) do { _Pragma("unroll") for (int _i = 0; _i < 2; ++_i) { const unsigned _o = GATHER ? ((usenext) ? oN[h][_i] : oA[h][_i]) : voffA[_i]; \
        __builtin_amdgcn_global_load_lds((const unsigned*)((const char*)(gbase) + (GATHER ? (size_t)0 : (size_t)(h) * hstep) + _o), (PG8_LAS unsigned*)(lds + (bufoff) + ldsw + _i * 8192), 16, 0, 0); } } while (0)
    Unit cur, nxt; int ui = 0;
    if (!S.next(0, cur)) return;
    f32x4 acc[2][2][4][2];
#pragma unroll
    for (int a = 0; a < 2; ++a)
#pragma unroll
        for (int b = 0; b < 2; ++b)
#pragma unroll
            for (int m = 0; m < 4; ++m)
#pragma unroll
                for (int n = 0; n < 2; ++n) acc[a][b][m][n] = (f32x4){0.f, 0.f, 0.f, 0.f};
    bf16x8 At[4][2], B0[2][2], B1[2][2]; i32x8_t At8[4], B08[2], B18[2];
    const char* cA = (const char*)g.A + (GATHER ? (size_t)0 : (size_t)cur.pm * tstep); const char* cB = (const char*)g.Bt + (size_t)cur.pb * tstep;
    S.a_ready(cur);
    if constexpr (GATHER) { PG8_AOFF(oA, cur); PG8_WAIT_V(0); }
    PG8_STAGE(PG8_SB(0, 0), cB, voffB); PG8_STAGE(PG8_SB(0, 1), cB + hstep, voffB); PG8_STAGE_A(PG8_SA(0, 0), cA, 0, false); PG8_STAGE_A(PG8_SA(0, 1), cA, 1, false);
    if (wr == 1) PG8_BAR;
    PG8_WAIT_V(2); PG8_BAR;
    PG8_STAGE(PG8_SB(1, 0), cB + kstep, voffB); PG8_STAGE_A(PG8_SA(1, 0), cA + kstep, 0, false); PG8_STAGE(PG8_SB(1, 1), cB + hstep + kstep, voffB);
    PG8_WAIT_V(6); PG8_BAR;
    for (;;) {
        const bool has_next = S.next(ui + 1, nxt);
        const char* nA = has_next ? (const char*)g.A + (GATHER ? (size_t)0 : (size_t)nxt.pm * tstep) : cA; const char* nB = has_next ? (const char*)g.Bt + (size_t)nxt.pb * tstep : cB;
        if constexpr (GATHER) { if (has_next) { PG8_AOFF(oN, nxt); } else {
#pragma unroll
            for (int _h = 0; _h < 2; ++_h) { oN[_h][0] = oA[_h][0]; oN[_h][1] = oA[_h][1]; } } }
        for (int t = 0; t < nt; t += 2) {
            const bool last = (t == nt - 2);
            const char* a1 = cA + (size_t)(t + 1) * kstep;
            const char* a2 = last ? nA : cA + (size_t)(t + 2) * kstep; const char* b2 = last ? nB : cB + (size_t)(t + 2) * kstep;
            const char* a3 = a2 + kstep; const char* b3 = b2 + kstep;
            if (last && has_next) S.a_ready(nxt);
            PG8_LDB(B0, 0, 0); PG8_LDB(B1, 0, 1); PG8_SCHED; PG8_LDA(At, 0, 0); PG8_STAGE_A(PG8_SA(1, 1), a1, 1, false);
            PG8_WAIT_V(8); PG8_WAIT_L(0); PG8_BAR; PG8_MMA(0, 0, At, B0); PG8_MMA(0, 1, At, B1); PG8_BAR; PG8_SCHED;
            PG8_LDA(At, 0, 1); PG8_STAGE(PG8_SB(0, 0), b2, voffB); PG8_STAGE(PG8_SB(0, 1), b2 + hstep, voffB); PG8_STAGE_A(PG8_SA(0, 0), a2, 0, last);
            PG8_WAIT_V(8); PG8_WAIT_L(0); PG8_BAR; PG8_MMA(1, 0, At, B0); PG8_MMA(1, 1, At, B1); PG8_BAR; PG8_SCHED;
            PG8_LDB(B0, 1, 0); PG8_LDB(B1, 1, 1); PG8_SCHED; PG8_LDA(At, 1, 0); PG8_STAGE_A(PG8_SA(0, 1), a2, 1, last);
            PG8_WAIT_V(8); PG8_WAIT_L(0); PG8_BAR; PG8_MMA(0, 0, At, B0); PG8_MMA(0, 1, At, B1); PG8_BAR; PG8_SCHED;
            PG8_LDA(At, 1, 1); PG8_STAGE(PG8_SB(1, 0), b3, voffB); PG8_STAGE(PG8_SB(1, 1), b3 + hstep, voffB); PG8_STAGE_A(PG8_SA(1, 0), a3, 0, last);
            PG8_WAIT_V(8); PG8_WAIT_L(0); PG8_BAR; PG8_MMA(1, 0, At, B0); PG8_MMA(1, 1, At, B1); PG8_BAR; PG8_SCHED;
        }
        if constexpr (ALIGN_EPI) { if (wr == 0) PG8_BAR; }
        if constexpr (F8) { asm volatile("s_nop 15\n\ts_nop 7" ::: "memory"); PG8_SCHED; }
        E(acc, cur, wr, wc, fr, fq); S.done(cur);
        if (!has_next) break;
#pragma unroll
        for (int a = 0; a < 2; ++a)
#pragma unroll
            for (int b = 0; b < 2; ++b)
#pragma unroll
                for (int m = 0; m < 4; ++m)
#pragma unroll
                    for (int n = 0; n < 2; ++n) acc[a][b][m][n] = (f32x4){0.f, 0.f, 0.f, 0.f};
        cur = nxt; cA = nA; cB = nB; ++ui;
        if constexpr (GATHER) {
#pragma unroll
            for (int _h = 0; _h < 2; ++_h) { oA[_h][0] = oN[_h][0]; oA[_h][1] = oN[_h][1]; } }
        if constexpr (ALIGN_EPI) { if (wr == 1) PG8_BAR; }
    }
    PG8_WAIT_V(0);
    if constexpr (!ALIGN_EPI) { if (wr == 0) PG8_BAR; }
    PG8_BAR;
#undef PG8_SA
#undef PG8_SB
#undef PG8_STAGE
#undef PG8_LDA
#undef PG8_LDB
#undef PG8_MMA
#undef PG8_WAIT_V
#undef PG8_WAIT_L
#undef PG8_BAR
#undef PG8_SCHED
#undef PG8_AOFF
#undef PG8_STAGE_A
}
}

#define GAS __attribute__((address_space(1)))
#define LAS __attribute__((address_space(3)))
#define XB_TMO      128
#define XB_XCNT(j)  (256  + 64 * (j))
#define XB_XSUB(j)  (1280 + 64 * (j))
#define XB_XGEN(j)  (2304 + 64 * (j))
#define XB_TOP      3328
#define XB_TOPGEN   3392
#define XCD_BAR_WORDS 3456
#define XB_SPIN_CAP (1u << 23)

__device__ __forceinline__ unsigned xb_ld(unsigned* p)              { return __hip_atomic_load(p, __ATOMIC_RELAXED, __HIP_MEMORY_SCOPE_AGENT); }
__device__ __forceinline__ unsigned xb_add(unsigned* p, unsigned v) { return __hip_atomic_fetch_add(p, v, __ATOMIC_RELAXED, __HIP_MEMORY_SCOPE_AGENT); }
__device__ __forceinline__ unsigned xb_xcc_id() { return (unsigned)__builtin_amdgcn_s_getreg((3 << 11) | 20) & 0xFu; }
#define XB_SPIN(cond, bar) do { unsigned _sp = 0; while (cond) { __builtin_amdgcn_s_sleep(1); \
    if ((++_sp & 255u) == 0u) { if (xb_ld(&(bar)[XB_TMO])) break; if (_sp > XB_SPIN_CAP) { atomicAdd(&(bar)[XB_TMO], 1u); break; } } } } while (0)

struct XcdBarrier {
    unsigned* bar; unsigned x;
    volatile LAS unsigned* st;
};

__device__ __forceinline__ XcdBarrier xcd_barrier_post(unsigned* bar, volatile LAS unsigned* st) {
    XcdBarrier b; b.bar = bar; b.x = xb_xcc_id(); b.st = st;
    if (threadIdx.x == 0) (void)xb_add(&bar[XB_XCNT(b.x)], 1u);
    return b;
}
__device__ __forceinline__ void xcd_barrier_complete(unsigned* bar, unsigned x, unsigned& nloc, unsigned& nx) {
    const unsigned G = gridDim.x * gridDim.y * gridDim.z;
    unsigned sum, cnt, mine, sp = 0u;
    for (;;) {
        sum = 0u; cnt = 0u; mine = 0u;
#pragma unroll
        for (unsigned j = 0; j < 16; ++j) { const unsigned c = xb_ld(&bar[XB_XCNT(j)]); sum += c; cnt += (c > 0u) ? 1u : 0u; mine = (j == x) ? c : mine; }
        if (sum == G) break;
        __builtin_amdgcn_s_sleep(1);
        if ((++sp & 255u) == 0u) { if (xb_ld(&bar[XB_TMO])) break; if (sp > XB_SPIN_CAP) { atomicAdd(&bar[XB_TMO], 1u); break; } }
    }
    nloc = mine > 0u ? mine : 1u; nx = cnt > 0u ? cnt : 1u;
}

__device__ __forceinline__ void xcd_barrier(const XcdBarrier& b) {
    asm volatile("s_waitcnt vmcnt(0)" ::: "memory");
    __syncthreads();
    if (threadIdx.x == 0) {
        unsigned* bar = b.bar; asm volatile("" : "+s"(bar));
        __builtin_amdgcn_s_waitcnt(0);
        unsigned nloc = b.st[0], nx = b.st[1];
        if (nloc == 0u) { xcd_barrier_complete(bar, b.x, nloc, nx); b.st[0] = nloc; b.st[1] = nx; }
        const unsigned old = xb_add(&bar[XB_XSUB(b.x)], 1u);
        const unsigned gen = old / nloc;
        if (old + 1u == (gen + 1u) * nloc) {
            __builtin_amdgcn_fence(__ATOMIC_RELEASE, "agent");
            asm volatile("s_waitcnt vmcnt(0)" ::: "memory");
            const unsigned og = xb_add(&bar[XB_TOP], 1u);
            const unsigned tg = og / nx;
            if (og + 1u == (tg + 1u) * nx) xb_add(&bar[XB_TOPGEN], 1u);
            else XB_SPIN(xb_ld(&bar[XB_TOPGEN]) == tg, bar);
            __builtin_amdgcn_fence(__ATOMIC_ACQUIRE, "agent");
            xb_add(&bar[XB_XGEN(b.x)], 1u);
            asm volatile("s_waitcnt vmcnt(0)" ::: "memory");
        } else {
            XB_SPIN(xb_ld(&bar[XB_XGEN(b.x)]) == gen, bar);
            __builtin_amdgcn_fence(__ATOMIC_ACQUIRE, "agent");
            asm volatile("s_waitcnt vmcnt(0)" ::: "memory");
        }
    }
    __syncthreads();
}

constexpr int T = 16384, SEQ = 8192, D = 2048, DLRU = 1024, DDN = 1024, NH = 8, HD = 128, NPROJ = 6144, DIN = 6160;
constexpr int DFF = 6144, NEXP = 8, DFFE = 3072;
constexpr float EPS = 1e-6f;
typedef unsigned short bf16;
typedef float f32x4 __attribute__((ext_vector_type(4)));
typedef unsigned u32x4 __attribute__((ext_vector_type(4)));
typedef unsigned u32x2 __attribute__((ext_vector_type(2)));
#define LDS_WAIT() asm volatile("s_waitcnt lgkmcnt(0)" ::: "memory")
#define LDS_BARRIER() do { asm volatile("s_waitcnt lgkmcnt(0)" ::: "memory"); __builtin_amdgcn_s_barrier(); asm volatile("" ::: "memory"); } while (0)

__device__ __forceinline__ float bf2f(bf16 b) { return __uint_as_float(((unsigned)b) << 16); }
__device__ __forceinline__ unsigned f2bf(float f) { return pg8::cvt_pk_bf16(f, f) & 0xffffu; }
__device__ __forceinline__ unsigned pk2(float lo, float hi) { return pg8::cvt_pk_bf16(lo, hi); }
__device__ __forceinline__ float shfl_xor_l(float v, int o, int lane) { return __int_as_float(__builtin_amdgcn_ds_bpermute((lane ^ o) << 2, __float_as_int(v))); }
__device__ __forceinline__ float shfl_up_l(float v, int d, int lane) { return __int_as_float(__builtin_amdgcn_ds_bpermute((lane - d) << 2, __float_as_int(v))); }
__device__ __forceinline__ float shfl_idx_l(float v, int src) { return __int_as_float(__builtin_amdgcn_ds_bpermute(src << 2, __float_as_int(v))); }
__device__ __forceinline__ float wave_sum(float v, int lane) {
#pragma unroll
    for (int o = 1; o < 64; o <<= 1) v += shfl_xor_l(v, o, lane);
    return v;
}
using pg8::silu_f;
using pg8::frcp; using pg8::rsqrt_f;
__device__ __forceinline__ float sigmoid_f(float x) { return frcp(1.0f + __expf(-x)); }
__device__ __forceinline__ float softplus_f(float x) { return fmaxf(x, 0.0f) + log1pf(__expf(-fabsf(x))); }
__device__ __forceinline__ float gelu_tanh_f(float x) { const float u = 0.7978845608028654f * (x + 0.044715f * x * x * x); return x * frcp(1.0f + __expf(-2.0f * u)); }

constexpr size_t MiB = 1u << 20;
constexpr size_t al(size_t x) { return (x + MiB - 1) / MiB * MiB; }
constexpr size_t WS_CTL = 0, CTL_ZERO_BYTES = 1 * MiB;
constexpr int CW_BAR = 4096, CW_CNT = 8192;
constexpr size_t WS_WGU = 1 * MiB;
constexpr size_t WS_WD = WS_WGU + al((size_t)2 * DFF * D * 2);
constexpr size_t WS_WIN = WS_WD + al((size_t)D * DFF * 2);
constexpr size_t WS_WBA = WS_WIN + al((size_t)2 * NPROJ * D * 2);
constexpr size_t WS_WOUT = WS_WBA + al((size_t)2 * 16 * D * 4 + 2 * 16 * D * 2);
static_assert(WS_WIN + (size_t)NPROJ * D * 2 - WS_WGU >= (size_t)NEXP * D * DFFE * 2, "MoE down weights overlay");
constexpr size_t WS_XB = WS_WOUT + al((size_t)2 * D * D * 2);
constexpr size_t WS_RSTD = WS_XB + al((size_t)T * D * 2);
constexpr size_t WS_BA = WS_RSTD + 5 * MiB;
constexpr size_t WS_BETA = WS_BA + al((size_t)T * 16 * 4);
constexpr size_t WS_G = WS_BETA + al((size_t)T * 8 * 4);
constexpr size_t WS_ROWW = WS_G + al((size_t)T * 8 * 4);
constexpr int NSLOT = 2 * T + NEXP * 256;
constexpr size_t WS_PROJ = WS_ROWW + al((size_t)2 * 8 * T * 4);
constexpr size_t WS_YMIX = WS_PROJ + al((size_t)NSLOT * DFFE * 2);
constexpr size_t WS_MG0 = WS_YMIX + al((size_t)T * D * 2);
constexpr size_t WS_C = WS_MG0 + (size_t)96 * MiB;
constexpr size_t WS_WRT = WS_C + (size_t)388 * MiB;
constexpr size_t WS_END = WS_WRT + 1 * MiB;
static_assert(WS_END <= (size_t)975 * MiB, "d_ws map exceeds the guaranteed workspace");
static_assert((size_t)4 * 2 * DFFE * D * 2 == (size_t)96 * MiB, "experts 0-3 fill the region in front of the mixer scratch exactly");
constexpr int RING_BYTES = 131072, LDSCTL_OFF = RING_BYTES, MISC_OFF = LDSCTL_OFF + 320, LDS_BYTES = 147456;

__device__ __forceinline__ void transpose_item(const float* W, int ldw, int col_off, int K, int nblk, const float* gain, bf16* WT, int blk, int blk_stride, int row_off, int item, int lane) {
    const int kb = item / nblk, nb = item % nblk, k0 = 64 * kb + (lane >> 4) * 16, n0 = 64 * nb + (lane & 15) * 4;
    const float* src = W + (size_t)k0 * ldw + col_off + n0;
    f32x4 v[16];
#pragma unroll
    for (int j = 0; j < 16; ++j) v[j] = __builtin_nontemporal_load((const f32x4*)(src + (size_t)j * ldw));
    if (gain) {
#pragma unroll
        for (int q = 0; q < 4; ++q) { const f32x4 g = *(const f32x4*)(gain + k0 + 4 * q);
#pragma unroll
            for (int c = 0; c < 4; ++c) v[4 * q + c] = v[4 * q + c] * g[c]; }
    }
#pragma unroll
    for (int i = 0; i < 4; ++i) { const int n = n0 + i, drow = (n / blk) * blk_stride + (n % blk) + row_off;
        u32x4 o0, o1;
        o0.x = pk2(v[0][i], v[1][i]); o0.y = pk2(v[2][i], v[3][i]); o0.z = pk2(v[4][i], v[5][i]); o0.w = pk2(v[6][i], v[7][i]);
        o1.x = pk2(v[8][i], v[9][i]); o1.y = pk2(v[10][i], v[11][i]); o1.z = pk2(v[12][i], v[13][i]); o1.w = pk2(v[14][i], v[15][i]);
        u32x4* dst = (u32x4*)(WT + (size_t)drow * K + k0); dst[0] = o0; dst[1] = o1; }
}
__device__ __forceinline__ void convert_matrix(const float* W, int ldw, int col_off, int K, int N, const float* gain, bf16* WT, int blk, int blk_stride, int row_off, LAS float* scr, int gw, int NGW, int lane) {
    const int nblk = N / 64, nitems = (K / 64) * nblk; (void)scr;
    for (int it = gw; it < nitems; it += NGW) transpose_item(W, ldw, col_off, K, nblk, gain, WT, blk, blk_stride, row_off, it, lane);
}
__device__ __forceinline__ void transpose_item8(const float* W, int ldw, int K, int nblk, const float* gain, float scale, unsigned char* WT, int blk, int blk_stride, int row_off, int item, int lane) {
    const int kb = item / nblk, nb = item % nblk, k0 = 64 * kb + (lane >> 4) * 16, n0 = 64 * nb + (lane & 15) * 4;
    const float* src = W + (size_t)k0 * ldw + n0;
    f32x4 v[16];
#pragma unroll
    for (int j = 0; j < 16; ++j) v[j] = __builtin_nontemporal_load((const f32x4*)(src + (size_t)j * ldw));
#pragma unroll
    for (int q = 0; q < 4; ++q) { f32x4 g = {scale, scale, scale, scale}; if (gain) g = *(const f32x4*)(gain + k0 + 4 * q) * scale;
#pragma unroll
        for (int c = 0; c < 4; ++c) v[4 * q + c] = v[4 * q + c] * g[c]; }
#pragma unroll
    for (int i = 0; i < 4; ++i) { const int n = n0 + i, drow = (n / blk) * blk_stride + (n % blk) + row_off;
        u32x4 o;
        o.x = pg8::cvt_pk4_fp8(v[0][i], v[1][i], v[2][i], v[3][i]); o.y = pg8::cvt_pk4_fp8(v[4][i], v[5][i], v[6][i], v[7][i]);
        o.z = pg8::cvt_pk4_fp8(v[8][i], v[9][i], v[10][i], v[11][i]); o.w = pg8::cvt_pk4_fp8(v[12][i], v[13][i], v[14][i], v[15][i]);
        *(u32x4*)(WT + (size_t)drow * K + k0) = o; }
}
__device__ __forceinline__ void convert_matrix8(const float* W, int ldw, int K, int N, const float* gain, float scale, unsigned char* WT, int blk, int blk_stride, int row_off, int gw, int NGW, int lane) {
    const int nblk = N / 64, nitems = (K / 64) * nblk;
    for (int it = gw; it < nitems; it += NGW) transpose_item8(W, ldw, K, nblk, gain, scale, WT, blk, blk_stride, row_off, it, lane);
}
__device__ __forceinline__ void rowprep_row(const float* x, bf16* xb, float* rstd, const float* Wba, float* ba, int row, int lane) {
    const f32x4* xr = (const f32x4*)(x + (size_t)row * D) + lane;
    f32x4 v[8]; float ss = 0.f;
#pragma unroll
    for (int j = 0; j < 8; ++j) { v[j] = xr[64 * j]; ss += (v[j][0] * v[j][0] + v[j][1] * v[j][1]) + (v[j][2] * v[j][2] + v[j][3] * v[j][3]); }
    ss = wave_sum(ss, lane);
    const float rs = rsqrt_f(ss * (1.0f / D) + EPS);
    u32x2* o = (u32x2*)(xb + (size_t)row * D) + lane;
#pragma unroll
    for (int j = 0; j < 8; ++j) { u32x2 w; w.x = pk2(v[j][0], v[j][1]); w.y = pk2(v[j][2], v[j][3]); o[64 * j] = w; }
    if (lane == 0) rstd[row] = rs;
    if (Wba) {
        for (int c = 0; c < 16; ++c) { const f32x4* wr = (const f32x4*)(Wba + (size_t)c * D) + lane; float a = 0.f;
#pragma unroll
            for (int j = 0; j < 8; ++j) { const f32x4 w = wr[64 * j]; a += (v[j][0] * w[0] + v[j][1] * w[1]) + (v[j][2] * w[2] + v[j][3] * w[3]); }
            a = wave_sum(a, lane); if (lane == 0) ba[(size_t)row * 16 + c] = a * rs; }
    }
}
__device__ __forceinline__ void lru_conv_elem(const bf16* proj, const float* cw, const float* cb, float* xc, size_t idx) {
    const int t = (int)(idx / DLRU), ch = (int)(idx % DLRU), s = t % SEQ;
    float a = cb[ch];
#pragma unroll
    for (int k = 0; k < 4; ++k) { const int sp = s - 3 + k; if (sp >= 0) a += cw[k * DLRU + ch] * bf2f(proj[(size_t)(t - 3 + k) * NPROJ + ch]); }
    xc[idx] = a;
}
__device__ __forceinline__ void lru_gate_elem(const float* xc, const float* w_r, const float* b_r, const float* w_i, const float* b_i, const float* lam, float* av, float* bv, size_t idx) {
    const int t = (int)(idx / DLRU), ch = (int)(idx % DLRU), n = ch >> 7, d = ch & 127;
    float ar = b_r[ch], ai = b_i[ch];
    const float* xr = xc + (size_t)t * DLRU + n * 128; const float* wr = w_r + (size_t)n * 128 * 128 + d; const float* wi = w_i + (size_t)n * 128 * 128 + d;
    for (int c = 0; c < 128; ++c) { const float xv = xr[c]; ar += xv * wr[c * 128]; ai += xv * wi[c * 128]; }
    const float r = sigmoid_f(ar), ig = sigmoid_f(ai);
    const float log_a = -8.0f * r * softplus_f(-lam[ch]);
    const float a = expf(log_a), mult = sqrtf(-expm1f(2.0f * log_a));
    av[idx] = a; bv[idx] = mult * (ig * xc[idx]);
}
__device__ __forceinline__ void lru_scan_chan(float* av, const float* bv, const bf16* proj, int idx) {
    const int b = idx / DLRU, ch = idx % DLRU;
    float h = 0.f;
    for (int s0 = 0; s0 < SEQ; s0 += 8) {
        float a8[8], b8[8], g8[8];
#pragma unroll
        for (int j = 0; j < 8; ++j) { const size_t t = (size_t)b * SEQ + s0 + j; a8[j] = av[t * DLRU + ch]; b8[j] = bv[t * DLRU + ch]; g8[j] = bf2f(proj[t * NPROJ + DLRU + ch]); }
#pragma unroll
        for (int j = 0; j < 8; ++j) { const size_t t = (size_t)b * SEQ + s0 + j; h = a8[j] * h + b8[j]; av[t * DLRU + ch] = h * gelu_tanh_f(g8[j]); }
    }
}
__device__ __forceinline__ void lru_norm_row(const float* y, const float* gain, bf16* ymix, int row, int lane) {
    const f32x4* yr = (const f32x4*)(y + (size_t)row * DLRU) + lane; const f32x4* gr = (const f32x4*)gain + lane;
    f32x4 v[4]; float ss = 0.f;
#pragma unroll
    for (int j = 0; j < 4; ++j) { v[j] = yr[64 * j]; ss += (v[j][0] * v[j][0] + v[j][1] * v[j][1]) + (v[j][2] * v[j][2] + v[j][3] * v[j][3]); }
    ss = wave_sum(ss, lane); const float rs = rsqrt_f(ss * (1.0f / DLRU) + EPS);
    u32x2* o = (u32x2*)(ymix + (size_t)row * D) + lane;
#pragma unroll
    for (int j = 0; j < 4; ++j) { const f32x4 g = gr[64 * j]; u32x2 w; w.x = pk2(v[j][0] * rs * g[0], v[j][1] * rs * g[1]); w.y = pk2(v[j][2] * rs * g[2], v[j][3] * rs * g[3]); o[64 * j] = w; }
}
__device__ __forceinline__ void dn_prep_item(const bf16* proj, const float* cw, const float* ba, const float* a_log, const float* dt_bias, float* qn, float* kn, float* vn, float* beta, float* gg, int w, int lane) {
    const int t = w >> 3, h = w & 7, s = t % SEQ;
    float val[3][2];
#pragma unroll
    for (int p = 0; p < 3; ++p)
#pragma unroll
        for (int e = 0; e < 2; ++e) { const int d = lane * 2 + e, c = p * DDN + h * HD + d; float a = 0.f;
#pragma unroll
            for (int k = 0; k < 4; ++k) { const int sp = s - 3 + k; if (sp >= 0) a += cw[k * 3 * DDN + c] * bf2f(proj[(size_t)(t - 3 + k) * NPROJ + 2048 + c]); }
            val[p][e] = silu_f(a); }
    const float sq = wave_sum(val[0][0] * val[0][0] + val[0][1] * val[0][1], lane), sk = wave_sum(val[1][0] * val[1][0] + val[1][1] * val[1][1], lane);
    const float rq = rsqrt_f(sq + EPS) * 0.08838834764831845f, rk = rsqrt_f(sk + EPS);
    const size_t o = ((size_t)t * NH + h) * HD + lane * 2;
    qn[o] = val[0][0] * rq; qn[o + 1] = val[0][1] * rq; kn[o] = val[1][0] * rk; kn[o + 1] = val[1][1] * rk; vn[o] = val[2][0]; vn[o + 1] = val[2][1];
    if (lane == 0) { beta[t * NH + h] = sigmoid_f(ba[(size_t)t * 16 + h]); gg[t * NH + h] = -__expf(a_log[h]) * softplus_f(ba[(size_t)t * 16 + 8 + h] + dt_bias[h]); }
}
__device__ __forceinline__ void dn_rec_seq(const float* qn, const float* kn, const float* vn, const float* beta, const float* gg, float* o, int bh, LAS float* sk, LAS float* sq, LAS float* st, int tid) {
    const int b = bh >> 3, h = bh & 7, j = tid & 127; const bool act = tid < 128;
    if (act) for (int k = 0; k < 128; ++k) st[k * 128 + j] = 0.f;
    const size_t base = ((size_t)(b * SEQ) * NH + h) * HD;
    float nk = kn[base + j], nq = qn[base + j], nv = vn[base + j], nb = beta[(b * SEQ) * NH + h], ng = gg[(b * SEQ) * NH + h];
    for (int s = 0; s < SEQ; ++s) {
        const int buf = (s & 1) * 128;
        if (act) { sk[buf + j] = nk; sq[buf + j] = nq; }
        const float vj = nv, be = nb, ge = __expf(ng);
        __syncthreads();
        if (act) {
            if (s + 1 < SEQ) { const size_t nb_ = ((size_t)(b * SEQ + s + 1) * NH + h) * HD; nk = kn[nb_ + j]; nq = qn[nb_ + j]; nv = vn[nb_ + j]; nb = beta[(b * SEQ + s + 1) * NH + h]; ng = gg[(b * SEQ + s + 1) * NH + h]; }
            float ks = 0.f;
#pragma unroll 8
            for (int k = 0; k < 128; ++k) ks += sk[buf + k] * st[k * 128 + j];
            const float vnew = be * (vj - ge * ks);
            float oo = 0.f;
#pragma unroll 8
            for (int k = 0; k < 128; ++k) { const float sv = ge * st[k * 128 + j] + sk[buf + k] * vnew; st[k * 128 + j] = sv; oo += sq[buf + k] * sv; }
            o[((size_t)(b * SEQ + s) * NH + h) * HD + j] = oo;
        }
    }
    __syncthreads();
}
typedef short bf16x8 __attribute__((ext_vector_type(8)));
__device__ __forceinline__ f32x4 mfma16(bf16x8 a, bf16x8 b, f32x4 c) { return __builtin_amdgcn_mfma_f32_16x16x32_bf16(a, b, c, 0, 0, 0); }
__device__ __forceinline__ float bflo(unsigned x) { return __uint_as_float(x << 16); }
__device__ __forceinline__ float bfhi(unsigned x) { return __uint_as_float(x & 0xffff0000u); }
constexpr int DA_G = 0, DA_L = 1024, DA_KN = DA_L + 16384, DA_QN = DA_KN + 17408, DA_VBT = DA_QN + 17408, DA_KBET = DA_VBT + 18432, DA_KDT = DA_KBET + 18432, DA_TB = DA_KDT + 18432, DA_QK = DA_TB + 9216, DA_END = DA_QK + 9216;
static_assert(DA_END <= RING_BYTES, "DN-A LDS map");
#if defined(PROBE_DNA_A)
#define DNA_ST(k) do { if (threadIdx.x == 0) ((volatile LAS unsigned long long*)(lds + (RING_BYTES + 2048)))[k] = __builtin_amdgcn_s_memrealtime(); } while (0)
#else
#define DNA_ST(k) do { } while (0)
#endif
__device__ __forceinline__ void dna_unit(const bf16* proj, const float* cw, const float* ba, const float* a_log, const float* dt_bias,
                                         bf16* Wf, bf16* Qf, bf16* KdTf, bf16* QKf, bf16* Uf, float* glb, int uid, LAS unsigned char* lds, const LAS float* cwl, int tid, int lane, int wave) {
    const int h = uid & 7, n = (uid >> 3) & 127, b = uid >> 10, t0 = b * SEQ + n * 64;
    asm volatile("" : "+v"(lds));
    DNA_ST(0);
    LAS float* Gs = (LAS float*)(lds + DA_G);
    const int fr = lane & 15, fq = lane >> 4;
    float ba_b = 0.f, ba_a = 0.f;
    if (wave == 0) { const size_t t = (size_t)(t0 + lane); ba_b = ba[t * 16 + h]; ba_a = ba[t * 16 + 8 + h]; }
    DNA_ST(1);
    {
        const int r = tid >> 3, cg = tid & 7;
        float val[3][16];
#pragma unroll
        for (int p = 0; p < 3; ++p) {
            const int ccol = p * DDN + h * HD + cg * 16;
            float acc[16];
#pragma unroll
            for (int i = 0; i < 16; ++i) acc[i] = 0.f;
#pragma unroll
            for (int k = 0; k < 4; ++k) { const int row = r - 3 + k;
                if (n * 64 + row >= 0) {
                    const bf16* src = proj + (size_t)(t0 + row) * NPROJ + 2048 + ccol;
                    const u32x4 x0 = *(const u32x4*)src, x1 = *(const u32x4*)(src + 8);
                    const LAS float* wp = cwl + k * 384 + p * 128 + cg * 16;
                    const f32x4 w0 = *(const LAS f32x4*)wp, w1 = *(const LAS f32x4*)(wp + 4), w2 = *(const LAS f32x4*)(wp + 8), w3 = *(const LAS f32x4*)(wp + 12);
                    acc[0] += w0[0] * bflo(x0.x); acc[1] += w0[1] * bfhi(x0.x); acc[2] += w0[2] * bflo(x0.y); acc[3] += w0[3] * bfhi(x0.y);
                    acc[4] += w1[0] * bflo(x0.z); acc[5] += w1[1] * bfhi(x0.z); acc[6] += w1[2] * bflo(x0.w); acc[7] += w1[3] * bfhi(x0.w);
                    acc[8] += w2[0] * bflo(x1.x); acc[9] += w2[1] * bfhi(x1.x); acc[10] += w2[2] * bflo(x1.y); acc[11] += w2[3] * bfhi(x1.y);
                    acc[12] += w3[0] * bflo(x1.z); acc[13] += w3[1] * bfhi(x1.z); acc[14] += w3[2] * bflo(x1.w); acc[15] += w3[3] * bfhi(x1.w);
                } }
#pragma unroll
            for (int i = 0; i < 16; ++i) val[p][i] = silu_f(acc[i]);
        }
        float sq = 0.f, sk = 0.f;
#pragma unroll
        for (int i = 0; i < 16; ++i) { sq += val[0][i] * val[0][i]; sk += val[1][i] * val[1][i]; }
        sq += shfl_xor_l(sq, 1, lane); sq += shfl_xor_l(sq, 2, lane); sq += shfl_xor_l(sq, 4, lane);
        sk += shfl_xor_l(sk, 1, lane); sk += shfl_xor_l(sk, 2, lane); sk += shfl_xor_l(sk, 4, lane);
        const float rq = rsqrt_f(sq + EPS) * 0.08838834764831845f, rk = rsqrt_f(sk + EPS);
        if (wave == 0) {
            const float be0 = sigmoid_f(ba_b); float Gc = -__expf(a_log[h]) * softplus_f(ba_a + dt_bias[h]);
#pragma unroll
            for (int off = 1; off < 64; off <<= 1) { const float tmp = shfl_up_l(Gc, off, lane); if (lane >= off) Gc += tmp; }
            const float GL = shfl_idx_l(Gc, 63);
            Gs[lane] = Gc; Gs[64 + lane] = be0; Gs[128 + lane] = __expf(Gc); Gs[192 + lane] = __expf(GL - Gc);
            if (lane == 63) glb[uid] = __expf(Gc);
        }
        LDS_BARRIER();
        const float be = Gs[64 + r], eg = Gs[128 + r], egl = Gs[192 + r];
#pragma unroll
        for (int i = 0; i < 16; ++i) { val[0][i] *= rq; val[1][i] *= rk; }
        u32x4 o0, o1;
        o0.x = pk2(val[1][0], val[1][1]); o0.y = pk2(val[1][2], val[1][3]); o0.z = pk2(val[1][4], val[1][5]); o0.w = pk2(val[1][6], val[1][7]);
        o1.x = pk2(val[1][8], val[1][9]); o1.y = pk2(val[1][10], val[1][11]); o1.z = pk2(val[1][12], val[1][13]); o1.w = pk2(val[1][14], val[1][15]);
        *(LAS u32x4*)(lds + DA_KN + r * 272 + cg * 32) = o0; *(LAS u32x4*)(lds + DA_KN + r * 272 + cg * 32 + 16) = o1;
        o0.x = pk2(val[0][0], val[0][1]); o0.y = pk2(val[0][2], val[0][3]); o0.z = pk2(val[0][4], val[0][5]); o0.w = pk2(val[0][6], val[0][7]);
        o1.x = pk2(val[0][8], val[0][9]); o1.y = pk2(val[0][10], val[0][11]); o1.z = pk2(val[0][12], val[0][13]); o1.w = pk2(val[0][14], val[0][15]);
        *(LAS u32x4*)(lds + DA_QN + r * 272 + cg * 32) = o0; *(LAS u32x4*)(lds + DA_QN + r * 272 + cg * 32 + 16) = o1;
#pragma unroll
        for (int i = 0; i < 16; ++i) { const int f = cg * 16 + i;
            *(LAS unsigned short*)(lds + DA_VBT + f * 144 + r * 2) = (unsigned short)f2bf(val[2][i] * be);
            *(LAS unsigned short*)(lds + DA_KBET + f * 144 + r * 2) = (unsigned short)f2bf(val[1][i] * (be * eg));
            *(LAS unsigned short*)(lds + DA_KDT + f * 144 + r * 2) = (unsigned short)f2bf(val[1][i] * egl); }
    }
    LDS_BARRIER();
    DNA_ST(2);
    {
        const int p = wave >> 2, ti = wave & 3;
        const int abase = p == 0 ? DA_KN : DA_QN;
        bf16x8 af[4];
#pragma unroll
        for (int ks = 0; ks < 4; ++ks) af[ks] = *(const LAS bf16x8*)(lds + abase + (ti * 16 + fr) * 272 + (ks * 32 + fq * 8) * 2);
        for (int tj = 0; tj < 4; ++tj) {
            f32x4 acc = {0.f, 0.f, 0.f, 0.f};
            if (tj <= ti) {
#pragma unroll
                for (int ks = 0; ks < 4; ++ks) { const bf16x8 bb = *(const LAS bf16x8*)(lds + DA_KN + (tj * 16 + fr) * 272 + (ks * 32 + fq * 8) * 2); acc = mfma16(af[ks], bb, acc); }
            }
            const int j = tj * 16 + fr; const float Gj = Gs[j];
#pragma unroll
            for (int r = 0; r < 4; ++r) { const int i = ti * 16 + fq * 4 + r; float v = 0.f;
                if (p == 0) { if (i > j) v = Gs[64 + i] * acc[r] * __expf(Gs[i] - Gj); *(LAS float*)(lds + DA_L + (j * 64 + i) * 4) = v; }
                else { if (i >= j) v = acc[r] * __expf(Gs[i] - Gj); *(LAS unsigned short*)(lds + DA_QK + i * 144 + j * 2) = (unsigned short)f2bf(v); } }
        }
    }
    LDS_BARRIER();
    DNA_ST(3);
    {
        int lc = lane; asm volatile("" : "+v"(lc)); const float fl = (float)lc;
        const int blk = wave < 4 ? wave : 11 - wave;
        float Tr[8];
#pragma unroll
        for (int c = 0; c < 8; ++c) Tr[c] = fmaxf(0.f, 1.f - fabsf(fl - (float)(blk * 8 + c)));
        float lj[63];
#pragma unroll
        for (int j = 0; j < 63; ++j) lj[j] = *(const LAS float*)(lds + DA_L + (j * 64) * 4 + lc * 4);
#pragma unroll
        for (int j = 0; j < 63; ++j) {
            if (j >= blk * 8) {
#pragma unroll
                for (int c = 0; c < 8; ++c) { const float tj = __int_as_float(__builtin_amdgcn_readlane(__float_as_int(Tr[c]), j)); Tr[c] -= lj[j] * tj; }
            }
        }
        u32x4 o; o.x = pk2(Tr[0], Tr[1]); o.y = pk2(Tr[2], Tr[3]); o.z = pk2(Tr[4], Tr[5]); o.w = pk2(Tr[6], Tr[7]);
        *(LAS u32x4*)(lds + DA_TB + lc * 144 + blk * 16) = o;
    }
    {
        for (int fi = wave; fi < 40; fi += 8) {
            if (fi < 8) { const int mt = fi >> 1, ks = fi & 1;
                const u32x4 v = *(const LAS u32x4*)(lds + DA_QK + (mt * 16 + fr) * 144 + (ks * 32 + fq * 8) * 2);
                *(u32x4*)(QKf + (((size_t)uid * 4 + mt) * 2 + ks) * 512 + lane * 8) = v; }
            else if (fi < 24) { const int f2 = fi - 8, mt = f2 >> 2, ks = f2 & 3; const float eg = Gs[128 + mt * 16 + fr];
                const u32x4 v = *(const LAS u32x4*)(lds + DA_QN + (mt * 16 + fr) * 272 + (ks * 32 + fq * 8) * 2); u32x4 o;
                o.x = pk2(bflo(v.x) * eg, bfhi(v.x) * eg); o.y = pk2(bflo(v.y) * eg, bfhi(v.y) * eg); o.z = pk2(bflo(v.z) * eg, bfhi(v.z) * eg); o.w = pk2(bflo(v.w) * eg, bfhi(v.w) * eg);
                *(u32x4*)(Qf + (((size_t)uid * 4 + mt) * 4 + ks) * 512 + lane * 8) = o; }
            else { const int f2 = fi - 24, ft = f2 >> 1, ks = f2 & 1;
                const u32x4 v = *(const LAS u32x4*)(lds + DA_KDT + (ft * 16 + fr) * 144 + (ks * 32 + fq * 8) * 2);
                *(u32x4*)(KdTf + (((size_t)uid * 8 + ft) * 2 + ks) * 512 + lane * 8) = v; }
        }
    }
    LDS_BARRIER();
    DNA_ST(4);
    {
        bf16x8 ta[4][2];
#pragma unroll
        for (int mt = 0; mt < 4; ++mt)
#pragma unroll
            for (int ks = 0; ks < 2; ++ks) ta[mt][ks] = *(const LAS bf16x8*)(lds + DA_TB + (mt * 16 + fr) * 144 + (ks * 32 + fq * 8) * 2);
#pragma unroll
        for (int c2 = 0; c2 < 2; ++c2) { const int ct = wave * 2 + c2, img = ct < 8 ? DA_VBT : DA_KBET, cr = (ct & 7) * 16 + fr;
            bf16x8 bb[2];
#pragma unroll
            for (int ks = 0; ks < 2; ++ks) bb[ks] = *(const LAS bf16x8*)(lds + img + cr * 144 + (ks * 32 + fq * 8) * 2);
#pragma unroll
            for (int mt = 0; mt < 4; ++mt) { f32x4 acc = {0.f, 0.f, 0.f, 0.f};
#pragma unroll
                for (int ks = 0; ks < 2; ++ks) acc = mfma16(ta[mt][ks], bb[ks], acc);
                if (ct < 8) { u32x2 o; o.x = pk2(acc[0], acc[1]); o.y = pk2(acc[2], acc[3]); *(u32x2*)(Uf + ((((size_t)uid * 8 + ct) * 4 + mt) * 64 + lane) * 4) = o; }
                else { const int f = (ct - 8) * 16 + fr;
#pragma unroll
                    for (int r = 0; r < 4; ++r) *(LAS unsigned short*)(lds + DA_KN + (mt * 16 + fq * 4 + r) * 272 + f * 2) = (unsigned short)f2bf(acc[r]); } }
        }
    }
    LDS_BARRIER();
    DNA_ST(5);
#pragma unroll
    for (int q2 = 0; q2 < 2; ++q2) { const int fi = wave * 2 + q2, mt = fi >> 2, ks = fi & 3;
        const u32x4 v = *(const LAS u32x4*)(lds + DA_KN + (mt * 16 + fr) * 272 + (ks * 32 + fq * 8) * 2);
        *(u32x4*)(Wf + (((size_t)uid * 4 + mt) * 4 + ks) * 512 + lane * 8) = v; }
    LDS_BARRIER();
    DNA_ST(6);
}
struct DnbFrag { bf16x8 a1[4]; bf16x8 kd[2]; u32x2 u; float gl; };
__device__ __forceinline__ DnbFrag dnb_load(const bf16* Wf, const bf16* KdTf, const bf16* Uf, const float* glb, int uid, int ds, int wave, int lane) {
    DnbFrag f; const int mt = wave & 3;
#pragma unroll
    for (int ks = 0; ks < 4; ++ks) f.a1[ks] = (wave < 4) ? *(const bf16x8*)(Wf + (((size_t)uid * 4 + mt) * 4 + ks) * 512 + lane * 8) : (bf16x8){0, 0, 0, 0, 0, 0, 0, 0};
#pragma unroll
    for (int ks = 0; ks < 2; ++ks) f.kd[ks] = *(const bf16x8*)(KdTf + (((size_t)uid * 8 + wave) * 2 + ks) * 512 + lane * 8);
    f.u = (wave < 4) ? *(const u32x2*)(Uf + ((((size_t)uid * 8 + ds) * 4 + mt) * 64 + lane) * 4) : (u32x2){0u, 0u};
    f.gl = glb[uid];
    return f;
}
__device__ __forceinline__ void dnb_run(const bf16* Wf, const bf16* KdTf, const bf16* Uf, const float* glb, bf16* Sf, bf16* Vf, int bh, int ds, LAS unsigned char* lds, int tid, int lane, int wave) {
    const int b = bh >> 3, h = bh & 7, fr = lane & 15, fq = lane >> 4, mt = wave & 3;
    asm volatile("" : "+v"(lds));
    LAS unsigned char* ST = lds; LAS unsigned char* VNT = lds + 4608;
    for (int i = tid; i < 4608 / 4; i += 512) ((LAS unsigned*)ST)[i] = 0u;
    f32x4 accS = {0.f, 0.f, 0.f, 0.f};
    DnbFrag f0 = dnb_load(Wf, KdTf, Uf, glb, (b * 128 + 0) * 8 + h, ds, wave, lane), f1 = dnb_load(Wf, KdTf, Uf, glb, (b * 128 + 1) * 8 + h, ds, wave, lane);
    DnbFrag f2 = dnb_load(Wf, KdTf, Uf, glb, (b * 128 + 2) * 8 + h, ds, wave, lane), f3 = dnb_load(Wf, KdTf, Uf, glb, (b * 128 + 3) * 8 + h, ds, wave, lane);
    __syncthreads();
#define DNB_STEP(F, nn) do { const int n = (nn); const size_t uds = (size_t)((b * 128 + n) * 8 + h) * 8 + ds; \
        if (wave < 4) { f32x4 acc = {0.f, 0.f, 0.f, 0.f}; \
            _Pragma("unroll") for (int ks = 0; ks < 4; ++ks) { const bf16x8 sb = *(const LAS bf16x8*)(ST + fr * 272 + (ks * 32 + fq * 8) * 2); acc = mfma16(F.a1[ks], sb, acc); } \
            const float v0 = bflo(F.u.x) - acc[0], v1 = bfhi(F.u.x) - acc[1], v2 = bflo(F.u.y) - acc[2], v3 = bfhi(F.u.y) - acc[3]; \
            u32x2 w; w.x = pk2(v0, v1); w.y = pk2(v2, v3); *(LAS u32x2*)(VNT + fr * 144 + (mt * 16 + fq * 4) * 2) = w; } \
        else { const u32x4 sb = *(const LAS u32x4*)(ST + fr * 272 + (mt * 32 + fq * 8) * 2);     \
            *(u32x4*)(Sf + (uds * 4 + mt) * 512 + lane * 8) = sb; } \
        LDS_BARRIER(); \
        bf16x8 vb[2]; \
        _Pragma("unroll") for (int ks = 0; ks < 2; ++ks) vb[ks] = *(const LAS bf16x8*)(VNT + fr * 144 + (ks * 32 + fq * 8) * 2); \
        accS = accS * F.gl; \
        _Pragma("unroll") for (int ks = 0; ks < 2; ++ks) accS = mfma16(F.kd[ks], vb[ks], accS); \
        { u32x2 w; w.x = pk2(accS[0], accS[1]); w.y = pk2(accS[2], accS[3]); *(LAS u32x2*)(ST + fr * 272 + (wave * 16 + fq * 4) * 2) = w; } \
        if (wave == 4) *(bf16x8*)(Vf + (uds * 2 + 0) * 512 + lane * 8) = vb[0];     \
        if (wave == 5) *(bf16x8*)(Vf + (uds * 2 + 1) * 512 + lane * 8) = vb[1]; \
        F = dnb_load(Wf, KdTf, Uf, glb, (b * 128 + (n + 4 < 128 ? n + 4 : 127)) * 8 + h, ds, wave, lane);     \
        LDS_BARRIER(); } while (0)
    for (int n4 = 0; n4 < 128; n4 += 16) {
        DNB_STEP(f0, n4); DNB_STEP(f1, n4 + 1); DNB_STEP(f2, n4 + 2); DNB_STEP(f3, n4 + 3); DNB_STEP(f0, n4 + 4); DNB_STEP(f1, n4 + 5); DNB_STEP(f2, n4 + 6); DNB_STEP(f3, n4 + 7);
        DNB_STEP(f0, n4 + 8); DNB_STEP(f1, n4 + 9); DNB_STEP(f2, n4 + 10); DNB_STEP(f3, n4 + 11); DNB_STEP(f0, n4 + 12); DNB_STEP(f1, n4 + 13); DNB_STEP(f2, n4 + 14); DNB_STEP(f3, n4 + 15); }
#undef DNB_STEP
}
constexpr int DO_ABUF = 24576, DO_OT = 49152, DO_END = DO_OT + 64 * 132 * 4;
static_assert(DO_END <= RING_BYTES, "DN-O LDS map");
struct DnoOps { bf16x8 sB[4], vB[2]; u32x4 g0, g1; };
__device__ __forceinline__ DnoOps dno_request(const bf16* Qf, const bf16* QKf, const bf16* Sf, const bf16* Vf, const bf16* proj, int uid, LAS unsigned char* abuf, int tid, int lane, int wave) {
    DnoOps f; const int h = uid & 7, n = (uid >> 3) & 127, b = uid >> 10, t = b * SEQ + n * 64 + (tid >> 3), c = h * HD + (tid & 7) * 16;
#pragma unroll
    for (int i = 0; i < 3; ++i) { const int ch = wave * 3 + i;
        __builtin_amdgcn_global_load_lds((const unsigned*)((ch < 16 ? Qf + (size_t)uid * 8192 + ch * 512 : QKf + (size_t)uid * 4096 + (ch - 16) * 512) + lane * 8), (LAS unsigned*)(abuf + ch * 1024), 16, 0, 0); }
#pragma unroll
    for (int ks = 0; ks < 4; ++ks) f.sB[ks] = *(const bf16x8*)(Sf + ((((size_t)uid * 8 + wave) * 4) + ks) * 512 + lane * 8);
#pragma unroll
    for (int ks = 0; ks < 2; ++ks) f.vB[ks] = *(const bf16x8*)(Vf + ((((size_t)uid * 8 + wave) * 2) + ks) * 512 + lane * 8);
    const u32x4* gp = (const u32x4*)(proj + (size_t)t * NPROJ + 5120 + c); f.g0 = gp[0]; f.g1 = gp[1];
    return f;
}
__device__ __forceinline__ void dno_run(const bf16* Qf, const bf16* QKf, const bf16* Sf, const bf16* Vf, const float* gain, const bf16* proj, bf16* ymix, int bid, int G, LAS unsigned char* lds, int tid, int lane, int wave) {
    const int fr = lane & 15, fq = lane >> 4, cg = tid & 7, rr = tid >> 3;
    LAS unsigned char* ldu = lds;
    asm volatile("" : "+v"(lds));
    const f32x4* wp = (const f32x4*)(gain + cg * 16); const f32x4 w0 = wp[0], w1 = wp[1], w2 = wp[2], w3 = wp[3];
    int buf = 0;
    DnoOps cur = dno_request(Qf, QKf, Sf, Vf, proj, bid, ldu, tid, lane, wave);
    for (int uid = bid; uid < 2048; uid += G) {
        const int h = uid & 7, n = (uid >> 3) & 127, b = uid >> 10, t0 = b * SEQ + n * 64;
        asm volatile("s_waitcnt vmcnt(0)" ::: "memory");
        LDS_BARRIER();
        const LAS unsigned char* ab = lds + buf * DO_ABUF;
#pragma unroll
        for (int mt = 0; mt < 4; ++mt) { f32x4 acc = {0.f, 0.f, 0.f, 0.f};
#pragma unroll
            for (int ks = 0; ks < 4; ++ks) { const bf16x8 a = *(const LAS bf16x8*)(ab + (mt * 4 + ks) * 1024 + lane * 16); acc = mfma16(a, cur.sB[ks], acc); }
#pragma unroll
            for (int ks = 0; ks < 2; ++ks) { const bf16x8 a = *(const LAS bf16x8*)(ab + 16384 + (mt * 2 + ks) * 1024 + lane * 16); acc = mfma16(a, cur.vB[ks], acc); }
#pragma unroll
            for (int r = 0; r < 4; ++r) *(LAS float*)(lds + DO_OT + ((mt * 16 + fq * 4 + r) * 132 + wave * 16 + fr) * 4) = acc[r]; }
        const u32x4 g0 = cur.g0, g1 = cur.g1;
        buf ^= 1;
        cur = dno_request(Qf, QKf, Sf, Vf, proj, uid + G < 2048 ? uid + G : uid, ldu + buf * DO_ABUF, tid, lane, wave);
        LDS_BARRIER();
        {
            const int t = t0 + rr, c = h * HD + cg * 16;
            const LAS f32x4* op = (const LAS f32x4*)(lds + DO_OT + (rr * 132 + cg * 16) * 4); const f32x4 o0 = op[0], o1 = op[1], o2 = op[2], o3 = op[3];
            float ss = (o0[0] * o0[0] + o0[1] * o0[1]) + (o0[2] * o0[2] + o0[3] * o0[3]) + (o1[0] * o1[0] + o1[1] * o1[1]) + (o1[2] * o1[2] + o1[3] * o1[3])
                     + (o2[0] * o2[0] + o2[1] * o2[1]) + (o2[2] * o2[2] + o2[3] * o2[3]) + (o3[0] * o3[0] + o3[1] * o3[1]) + (o3[2] * o3[2] + o3[3] * o3[3]);
            ss += shfl_xor_l(ss, 1, lane); ss += shfl_xor_l(ss, 2, lane); ss += shfl_xor_l(ss, 4, lane);
            const float rs = rsqrt_f(ss * (1.0f / HD) + EPS);
            u32x4 r0, r1;
            r0.x = pk2(o0[0] * rs * w0[0] * silu_f(bflo(g0.x)), o0[1] * rs * w0[1] * silu_f(bfhi(g0.x))); r0.y = pk2(o0[2] * rs * w0[2] * silu_f(bflo(g0.y)), o0[3] * rs * w0[3] * silu_f(bfhi(g0.y)));
            r0.z = pk2(o1[0] * rs * w1[0] * silu_f(bflo(g0.z)), o1[1] * rs * w1[1] * silu_f(bfhi(g0.z))); r0.w = pk2(o1[2] * rs * w1[2] * silu_f(bflo(g0.w)), o1[3] * rs * w1[3] * silu_f(bfhi(g0.w)));
            r1.x = pk2(o2[0] * rs * w2[0] * silu_f(bflo(g1.x)), o2[1] * rs * w2[1] * silu_f(bfhi(g1.x))); r1.y = pk2(o2[2] * rs * w2[2] * silu_f(bflo(g1.y)), o2[3] * rs * w2[3] * silu_f(bfhi(g1.y)));
            r1.z = pk2(o3[0] * rs * w3[0] * silu_f(bflo(g1.z)), o3[1] * rs * w3[1] * silu_f(bfhi(g1.z))); r1.w = pk2(o3[2] * rs * w3[2] * silu_f(bflo(g1.w)), o3[3] * rs * w3[3] * silu_f(bfhi(g1.w)));
            u32x4* dst = (u32x4*)(ymix + (size_t)t * D + DLRU + c); dst[0] = r0; dst[1] = r1;
        }
    }
    asm volatile("s_waitcnt vmcnt(0)" ::: "memory");
    LDS_BARRIER();
}
constexpr int LA_XB = 0, LA_XF = 17408, LA_END = LA_XF + 64 * 132 * 4;
static_assert(LA_END <= RING_BYTES, "LRU-A LDS map");
struct LruConst { bf16x8 br[4], bi[4]; float brr, bii, sp8; };
__device__ __forceinline__ LruConst lrua_const(const bf16* WrT, const bf16* WiT, const float* b_r, const float* b_i, const float* lam, int nb, int lane, int wave) {
    LruConst c; const int fr = lane & 15, fq = lane >> 4, cl = wave * 16 + fr, ch = nb * 128 + cl;
#pragma unroll
    for (int ks = 0; ks < 4; ++ks) { c.br[ks] = *(const bf16x8*)(WrT + ((size_t)nb * 128 + cl) * 128 + ks * 32 + fq * 8); c.bi[ks] = *(const bf16x8*)(WiT + ((size_t)nb * 128 + cl) * 128 + ks * 32 + fq * 8); }
    c.brr = b_r[ch]; c.bii = b_i[ch]; c.sp8 = -8.0f * softplus_f(-lam[ch]);
    return c;
}
__device__ __forceinline__ void lrua_unit(const bf16* proj, const LruConst& LC,
                                          float* Hloc, float* Acum, float* summ, int unit, LAS unsigned char* lds, const LAS float* lwl, int tid, int lane, int wave) {
    const int nb = unit & 7, ct = unit >> 3, n = ct & 127, t0 = ct * 64;
    asm volatile("" : "+v"(lds));
    {
        const int r = tid >> 3, cg = tid & 7, ch0 = nb * 128 + cg * 16;
        float acc[16];
        { const LAS float* bp = lwl + 512 + cg * 16; const f32x4 c0v = *(const LAS f32x4*)bp, c1v = *(const LAS f32x4*)(bp + 4), c2v = *(const LAS f32x4*)(bp + 8), c3v = *(const LAS f32x4*)(bp + 12);
#pragma unroll
          for (int i = 0; i < 4; ++i) { acc[i] = c0v[i]; acc[4 + i] = c1v[i]; acc[8 + i] = c2v[i]; acc[12 + i] = c3v[i]; } }
#pragma unroll
        for (int k = 0; k < 4; ++k) { const int row = r - 3 + k;
            if (n * 64 + row >= 0) {
                const bf16* src = proj + (size_t)(t0 + row) * NPROJ + ch0;
                const u32x4 x0 = *(const u32x4*)src, x1 = *(const u32x4*)(src + 8);
                const LAS float* wp = lwl + k * 128 + cg * 16;
                const f32x4 w0 = *(const LAS f32x4*)wp, w1 = *(const LAS f32x4*)(wp + 4), w2 = *(const LAS f32x4*)(wp + 8), w3 = *(const LAS f32x4*)(wp + 12);
                acc[0] += w0[0] * bflo(x0.x); acc[1] += w0[1] * bfhi(x0.x); acc[2] += w0[2] * bflo(x0.y); acc[3] += w0[3] * bfhi(x0.y);
                acc[4] += w1[0] * bflo(x0.z); acc[5] += w1[1] * bfhi(x0.z); acc[6] += w1[2] * bflo(x0.w); acc[7] += w1[3] * bfhi(x0.w);
                acc[8] += w2[0] * bflo(x1.x); acc[9] += w2[1] * bfhi(x1.x); acc[10] += w2[2] * bflo(x1.y); acc[11] += w2[3] * bfhi(x1.y);
                acc[12] += w3[0] * bflo(x1.z); acc[13] += w3[1] * bfhi(x1.z); acc[14] += w3[2] * bflo(x1.w); acc[15] += w3[3] * bfhi(x1.w);
            } }
        u32x4 o0, o1;
        o0.x = pk2(acc[0], acc[1]); o0.y = pk2(acc[2], acc[3]); o0.z = pk2(acc[4], acc[5]); o0.w = pk2(acc[6], acc[7]);
        o1.x = pk2(acc[8], acc[9]); o1.y = pk2(acc[10], acc[11]); o1.z = pk2(acc[12], acc[13]); o1.w = pk2(acc[14], acc[15]);
        *(LAS u32x4*)(lds + LA_XB + r * 272 + cg * 32) = o0; *(LAS u32x4*)(lds + LA_XB + r * 272 + cg * 32 + 16) = o1;
        LAS f32x4* xf = (LAS f32x4*)(lds + LA_XF + (r * 132 + cg * 16) * 4);
        xf[0] = (f32x4){acc[0], acc[1], acc[2], acc[3]}; xf[1] = (f32x4){acc[4], acc[5], acc[6], acc[7]}; xf[2] = (f32x4){acc[8], acc[9], acc[10], acc[11]}; xf[3] = (f32x4){acc[12], acc[13], acc[14], acc[15]};
    }
    LDS_BARRIER();
    const int fr = lane & 15, fq = lane >> 4, cl = wave * 16 + fr, ch = nb * 128 + cl;
    f32x4 ar[4], ai[4];
#pragma unroll
    for (int mt = 0; mt < 4; ++mt) { ar[mt] = (f32x4){0.f, 0.f, 0.f, 0.f}; ai[mt] = (f32x4){0.f, 0.f, 0.f, 0.f};
#pragma unroll
        for (int ks = 0; ks < 4; ++ks) { const bf16x8 af = *(const LAS bf16x8*)(lds + LA_XB + (mt * 16 + fr) * 272 + (ks * 32 + fq * 8) * 2); ar[mt] = mfma16(af, LC.br[ks], ar[mt]); ai[mt] = mfma16(af, LC.bi[ks], ai[mt]); } }
    const float brr = LC.brr, bii = LC.bii, sp8 = LC.sp8;
    float Ac = 1.f, Bc = 0.f;
#pragma unroll
    for (int mt = 0; mt < 4; ++mt) {
        float P[4], H[4];
#pragma unroll
        for (int r = 0; r < 4; ++r) { const int t = mt * 16 + fq * 4 + r; const float xcv = *(const LAS float*)(lds + LA_XF + (t * 132 + cl) * 4);
            const float rr = sigmoid_f(ar[mt][r] + brr), ii = sigmoid_f(ai[mt][r] + bii), la = sp8 * rr, a = __expf(la), bb = __builtin_amdgcn_sqrtf(fmaxf(1.0f - a * a, 0.0f)) * (ii * xcv);
            if (r == 0) { P[0] = a; H[0] = bb; } else { P[r] = P[r - 1] * a; H[r] = a * H[r - 1] + bb; } }
        float Ai = P[3], Bi = H[3];
        { const float Au = shfl_up_l(Ai, 16, lane), Bu = shfl_up_l(Bi, 16, lane); if (fq >= 1) { Bi = Ai * Bu + Bi; Ai = Au * Ai; } }
        { const float Au = shfl_up_l(Ai, 32, lane), Bu = shfl_up_l(Bi, 32, lane); if (fq >= 2) { Bi = Ai * Bu + Bi; Ai = Au * Ai; } }
        float Ae = shfl_up_l(Ai, 16, lane), Be = shfl_up_l(Bi, 16, lane); if (fq == 0) { Ae = 1.f; Be = 0.f; }
        const float At = shfl_idx_l(Ai, 48 + fr), Bt = shfl_idx_l(Bi, 48 + fr);
        const float PA = Ac * Ae, PB = Ae * Bc + Be;
#pragma unroll
        for (int r = 0; r < 4; ++r) { const size_t o = (size_t)(t0 + mt * 16 + fq * 4 + r) * DLRU + ch; ((unsigned*)Hloc)[o] = pk2(P[r] * PB + H[r], PA * P[r]); }
        Bc = At * Bc + Bt; Ac = Ac * At;
    }
    if (fq == 0) { float* sp = summ + ((size_t)ct * DLRU + ch) * 2; sp[0] = Ac; sp[1] = Bc; }
    LDS_BARRIER();
}
__device__ __forceinline__ void lru_carry(const float* summ, float* carry, int idx) {
    const int b = idx >> 10, ch = idx & 1023; float c = 0.f;
    for (int n0 = 0; n0 < 128; n0 += 8) { float A[8], B[8];
#pragma unroll
        for (int j = 0; j < 8; ++j) { const float* sp = summ + ((size_t)(b * 128 + n0 + j) * DLRU + ch) * 2; A[j] = sp[0]; B[j] = sp[1]; }
#pragma unroll
        for (int j = 0; j < 8; ++j) { carry[(size_t)(b * 128 + n0 + j) * DLRU + ch] = c; c = A[j] * c + B[j]; } }
}
__device__ __forceinline__ void lrub_row(const float* Hloc, const float* Acum, const float* carry, const bf16* proj, const float* gain, bf16* ymix, int row, int lane) {
    const int ct = row >> 6; f32x4 y[4]; float ss = 0.f;
#pragma unroll
    for (int j = 0; j < 4; ++j) { const int c4 = lane * 4 + 256 * j;
        const u32x4 ha = *(const u32x4*)((const unsigned*)Hloc + (size_t)row * DLRU + c4); const f32x4 cr = *(const f32x4*)(carry + (size_t)ct * DLRU + c4);
        const u32x2 g = *(const u32x2*)(proj + (size_t)row * NPROJ + DLRU + c4);
        const f32x4 hl = {bflo(ha.x), bflo(ha.y), bflo(ha.z), bflo(ha.w)}, ac = {bfhi(ha.x), bfhi(ha.y), bfhi(ha.z), bfhi(ha.w)};
        const f32x4 hh = hl + ac * cr;
        y[j][0] = hh[0] * gelu_tanh_f(bflo(g.x)); y[j][1] = hh[1] * gelu_tanh_f(bfhi(g.x)); y[j][2] = hh[2] * gelu_tanh_f(bflo(g.y)); y[j][3] = hh[3] * gelu_tanh_f(bfhi(g.y));
        ss += (y[j][0] * y[j][0] + y[j][1] * y[j][1]) + (y[j][2] * y[j][2] + y[j][3] * y[j][3]); }
    ss = wave_sum(ss, lane); const float rs = rsqrt_f(ss * (1.0f / DLRU) + EPS);
#pragma unroll
    for (int j = 0; j < 4; ++j) { const int c4 = lane * 4 + 256 * j; const f32x4 g = *(const f32x4*)(gain + c4); u32x2 w; w.x = pk2(y[j][0] * rs * g[0], y[j][1] * rs * g[1]); w.y = pk2(y[j][2] * rs * g[2], y[j][3] * rs * g[3]);
        *(u32x2*)(ymix + (size_t)row * D + c4) = w; }
}
__device__ __forceinline__ void dn_out_row(const float* o, const float* gain, const bf16* proj, bf16* ymix, int t, int lane) {
    const int c = lane * 16;
    const f32x4* op = (const f32x4*)(o + (size_t)t * DDN + c); const f32x4 o0 = op[0], o1 = op[1], o2 = op[2], o3 = op[3];
    const u32x4* gp = (const u32x4*)(proj + (size_t)t * NPROJ + 5120 + c); const u32x4 g0 = gp[0], g1 = gp[1];
    const f32x4* wp = (const f32x4*)(gain + (c & 127)); const f32x4 w0 = wp[0], w1 = wp[1], w2 = wp[2], w3 = wp[3];
    float ss = (o0[0] * o0[0] + o0[1] * o0[1]) + (o0[2] * o0[2] + o0[3] * o0[3]) + (o1[0] * o1[0] + o1[1] * o1[1]) + (o1[2] * o1[2] + o1[3] * o1[3])
             + (o2[0] * o2[0] + o2[1] * o2[1]) + (o2[2] * o2[2] + o2[3] * o2[3]) + (o3[0] * o3[0] + o3[1] * o3[1]) + (o3[2] * o3[2] + o3[3] * o3[3]);
    ss += shfl_xor_l(ss, 1, lane); ss += shfl_xor_l(ss, 2, lane); ss += shfl_xor_l(ss, 4, lane);
    const float rs = rsqrt_f(ss * (1.0f / HD) + EPS);
    u32x4 r0, r1;
    r0.x = pk2(o0[0] * rs * w0[0] * silu_f(bflo(g0.x)), o0[1] * rs * w0[1] * silu_f(bfhi(g0.x))); r0.y = pk2(o0[2] * rs * w0[2] * silu_f(bflo(g0.y)), o0[3] * rs * w0[3] * silu_f(bfhi(g0.y)));
    r0.z = pk2(o1[0] * rs * w1[0] * silu_f(bflo(g0.z)), o1[1] * rs * w1[1] * silu_f(bfhi(g0.z))); r0.w = pk2(o1[2] * rs * w1[2] * silu_f(bflo(g0.w)), o1[3] * rs * w1[3] * silu_f(bfhi(g0.w)));
    r1.x = pk2(o2[0] * rs * w2[0] * silu_f(bflo(g1.x)), o2[1] * rs * w2[1] * silu_f(bfhi(g1.x))); r1.y = pk2(o2[2] * rs * w2[2] * silu_f(bflo(g1.y)), o2[3] * rs * w2[3] * silu_f(bfhi(g1.y)));
    r1.z = pk2(o3[0] * rs * w3[0] * silu_f(bflo(g1.z)), o3[1] * rs * w3[1] * silu_f(bfhi(g1.z))); r1.w = pk2(o3[2] * rs * w3[2] * silu_f(bflo(g1.w)), o3[3] * rs * w3[3] * silu_f(bfhi(g1.w)));
    u32x4* dst = (u32x4*)(ymix + (size_t)t * D + DLRU + c); dst[0] = r0; dst[1] = r1;
}
__device__ __forceinline__ void route_row(const float* x, const float* rstd, const float* gain, const float* router, float* roww, int row, int lane) {
    float acc[8];
#pragma unroll
    for (int e = 0; e < 8; ++e) acc[e] = 0.f;
    for (int j = 0; j < 32; ++j) { const int k = lane + 64 * j; const float xv = x[(size_t)row * D + k] * gain[k]; const f32x4 r0 = *(const f32x4*)(router + (size_t)k * 8), r1 = *(const f32x4*)(router + (size_t)k * 8 + 4);
        acc[0] += xv * r0[0]; acc[1] += xv * r0[1]; acc[2] += xv * r0[2]; acc[3] += xv * r0[3]; acc[4] += xv * r1[0]; acc[5] += xv * r1[1]; acc[6] += xv * r1[2]; acc[7] += xv * r1[3]; }
    const float rs = rstd[row];
#pragma unroll
    for (int e = 0; e < 8; ++e) acc[e] = wave_sum(acc[e], lane) * rs;
    int e1 = 0; float l1 = acc[0];
#pragma unroll
    for (int e = 1; e < 8; ++e) if (acc[e] > l1) { l1 = acc[e]; e1 = e; }
    int e2 = -1; float l2 = -3.4e38f;
#pragma unroll
    for (int e = 0; e < 8; ++e) if (e != e1 && acc[e] > l2) { l2 = acc[e]; e2 = e; }
    const float w1 = 1.0f / (1.0f + __expf(l2 - l1)), w2 = 1.0f - w1;
    if (lane < 8) roww[(size_t)lane * T + row] = lane == e1 ? w1 : (lane == e2 ? w2 : 0.0f);
}
__device__ __forceinline__ void final_row(const float* x, const float* gain, float* out, int row, int lane) {
    const f32x4* xr = (const f32x4*)(x + (size_t)row * D) + lane; const f32x4* gr = (const f32x4*)gain + lane;
    f32x4 v[8]; float ss = 0.f;
#pragma unroll
    for (int j = 0; j < 8; ++j) { v[j] = xr[64 * j]; ss += (v[j][0] * v[j][0] + v[j][1] * v[j][1]) + (v[j][2] * v[j][2] + v[j][3] * v[j][3]); }
    ss = wave_sum(ss, lane); const float rs = rsqrt_f(ss * (1.0f / D) + EPS);
    f32x4* o = (f32x4*)(out + (size_t)row * D) + lane;
#pragma unroll
    for (int j = 0; j < 8; ++j) o[64 * j] = v[j] * rs * gr[64 * j];
}

struct MoeOrder {
    const int* list; int nN, G, c; int c0, c1, c2, c3, c4, c5, c6, c7;
    __device__ __forceinline__ void init(const unsigned* cnt, const int* list_, int nN_, int G_, int c_) { list = list_; nN = nN_; G = G_; c = c_;
        c0 = __builtin_amdgcn_readfirstlane((int)cnt[0]); c1 = __builtin_amdgcn_readfirstlane((int)cnt[1]); c2 = __builtin_amdgcn_readfirstlane((int)cnt[2]); c3 = __builtin_amdgcn_readfirstlane((int)cnt[3]);
        c4 = __builtin_amdgcn_readfirstlane((int)cnt[4]); c5 = __builtin_amdgcn_readfirstlane((int)cnt[5]); c6 = __builtin_amdgcn_readfirstlane((int)cnt[6]); c7 = __builtin_amdgcn_readfirstlane((int)cnt[7]); }
    __device__ __forceinline__ bool next(int i, pg8::Unit& u) const {
        const int c8[8] = {c0, c1, c2, c3, c4, c5, c6, c7}; int nM = 0;
#pragma unroll
        for (int k = 0; k < 8; ++k) nM += (c8[k] + 255) >> 8;
        const int nwg = nM * nN; const long L = (long)i * G + c; if (L >= nwg) return false;
        int wgid = (int)L; { const int q = nwg / pg8::NXCD, r = nwg % pg8::NXCD, xcd = wgid % pg8::NXCD, off = wgid / pg8::NXCD; wgid = (xcd < r ? xcd * (q + 1) : r * (q + 1) + (xcd - r) * q) + off; }
        const int nig = pg8::WGM * nN, gid = wgid / nig, fm = gid * pg8::WGM, gsz = (nM - fm) < pg8::WGM ? (nM - fm) : pg8::WGM;
        u.pm = fm + ((wgid % nig) % gsz); u.pn = (wgid % nig) / gsz;
        int e = 0, ps = 0, ce = c8[0], run = 0;
#pragma unroll
        for (int k = 0; k < 8; ++k) { const int mk = (c8[k] + 255) >> 8; if (u.pm >= run && u.pm < run + mk) { e = k; ps = run; ce = c8[k]; } run += mk; }
        const int mtl = u.pm - ps; u.pb = e * nN + u.pn; u.lbase = e * T + mtl * 256; u.nvalid = (ce - mtl * 256) < 256 ? (ce - mtl * 256) : 256;
        return true;
    }
    __device__ __forceinline__ int arow(const pg8::Unit& u, int r) const { return r < u.nvalid ? (list[u.lbase + r] & 0xffff) : 0; }
    __device__ __forceinline__ void a_ready(const pg8::Unit&) const {}
    __device__ __forceinline__ void done(const pg8::Unit&) const {}
};
constexpr float MOE_WSC = 64.0f, MOE_HSC = 16.0f;
__device__ __forceinline__ void route_block(const float* ssq, const float* lgp, float* rstd, unsigned* cnt, int* list, float* listw, int blk, LAS unsigned char* lds, int tid, int lane, int wave) {
    asm volatile("" : "+v"(lds));
    LAS int* se1 = (LAS int*)lds; LAS int* se2 = se1 + 64; LAS float* sw1 = (LAS float*)(se2 + 64); LAS float* sw2 = sw1 + 64; LAS int* lcnt = (LAS int*)(sw2 + 64); LAS int* gbase = lcnt + 8;
    if (tid < 8) lcnt[tid] = 0;
    f32x4 lp[8]; float sp[8];
#pragma unroll
    for (int q = 0; q < 8; ++q) { const int row = blk * 64 + wave * 8 + q; lp[q] = *(const f32x4*)(lgp + (size_t)row * 256 + lane * 4); sp[q] = ssq[(size_t)row * 32 + (lane & 31)]; }
    __syncthreads();
#pragma unroll
    for (int q = 0; q < 8; ++q) { const int rloc = wave * 8 + q, row = blk * 64 + rloc;
        f32x4 v = lp[q]; float ss = sp[q];
#pragma unroll
        for (int o = 2; o < 64; o <<= 1) { v[0] += shfl_xor_l(v[0], o, lane); v[1] += shfl_xor_l(v[1], o, lane); v[2] += shfl_xor_l(v[2], o, lane); v[3] += shfl_xor_l(v[3], o, lane); }
#pragma unroll
        for (int o = 1; o < 32; o <<= 1) ss += shfl_xor_l(ss, o, lane);
        const float rs = rsqrt_f(ss * (1.0f / D) + EPS);
        if (lane == 0) rstd[row] = rs * (1.0f / MOE_WSC);
        float acc[8];
#pragma unroll
        for (int e = 0; e < 8; ++e) acc[e] = shfl_idx_l(v[e & 3], e >> 2) * rs;
        int e1 = 0; float l1 = acc[0];
#pragma unroll
        for (int e = 1; e < 8; ++e) if (acc[e] > l1) { l1 = acc[e]; e1 = e; }
        int e2 = -1; float l2 = -3.4e38f;
#pragma unroll
        for (int e = 0; e < 8; ++e) if (e != e1 && acc[e] > l2) { l2 = acc[e]; e2 = e; }
        const float w1 = 1.0f / (1.0f + __expf(l2 - l1));
        if (lane == 0) { se1[rloc] = e1; se2[rloc] = e2; sw1[rloc] = w1; sw2[rloc] = 1.0f - w1; }
    }
    __syncthreads();
    int e = 0, lr = 0; float w = 0.f;
    if (tid < 128) { const int rloc = tid >> 1, j = tid & 1; e = j ? se2[rloc] : se1[rloc]; w = j ? sw2[rloc] : sw1[rloc]; lr = __hip_atomic_fetch_add(lcnt + e, 1, __ATOMIC_RELAXED, __HIP_MEMORY_SCOPE_WORKGROUP); }
    __syncthreads();
    if (tid < 8) gbase[tid] = (int)__hip_atomic_fetch_add(cnt + tid, (unsigned)lcnt[tid], __ATOMIC_RELAXED, __HIP_MEMORY_SCOPE_AGENT);
    __syncthreads();
    if (tid < 128) { const int pos = gbase[e] + lr, tok = blk * 64 + (tid >> 1); list[e * T + pos] = tok | ((tid & 1) << 16); listw[e * T + pos] = w * (1.0f / (MOE_WSC * MOE_HSC)); }
    __syncthreads();
}
__device__ __forceinline__ void final_row_moe(const float* x, const bf16* y0, const bf16* y1, const float* gain, float* out, int row, int lane) {
    const f32x4* xr = (const f32x4*)(x + (size_t)row * D) + lane; const f32x4* gr = (const f32x4*)gain + lane;
    const u32x2* p0 = (const u32x2*)(y0 + (size_t)row * D) + lane; const u32x2* p1 = (const u32x2*)(y1 + (size_t)row * D) + lane;
    f32x4 v[8]; float ss = 0.f;
#pragma unroll
    for (int j = 0; j < 8; ++j) { v[j] = xr[64 * j]; const u32x2 a = p0[64 * j], b = p1[64 * j];
        v[j][0] += bflo(a.x) + bflo(b.x); v[j][1] += bfhi(a.x) + bfhi(b.x); v[j][2] += bflo(a.y) + bflo(b.y); v[j][3] += bfhi(a.y) + bfhi(b.y);
        ss += (v[j][0] * v[j][0] + v[j][1] * v[j][1]) + (v[j][2] * v[j][2] + v[j][3] * v[j][3]); }
    ss = wave_sum(ss, lane); const float rs = rsqrt_f(ss * (1.0f / D) + EPS);
    f32x4* o = (f32x4*)(out + (size_t)row * D) + lane;
#pragma unroll
    for (int j = 0; j < 8; ++j) o[64 * j] = v[j] * rs * gr[64 * j];
}
__device__ __forceinline__ void ba_tail(const bf16* xbp, const bf16* wbab, const float* ssq, int mode, float* bap, int rb, int wave, int lane) {
    if (wave < 4) { const int fr = lane & 15, fq = lane >> 4, r0 = rb * 64 + wave * 16;
        const bf16* ap = xbp + (size_t)(r0 + fr) * D + fq * 8; const bf16* bp = wbab + (size_t)fr * D + fq * 8;
        f32x4 acc = {0.f, 0.f, 0.f, 0.f};
#pragma unroll 16
        for (int ks = 0; ks < 64; ++ks) { const bf16x8 a = *(const bf16x8*)(ap + ks * 32), b = *(const bf16x8*)(bp + ks * 32); acc = mfma16(a, b, acc); }
#pragma unroll
        for (int rr = 0; rr < 4; ++rr) { const int r = r0 + fq * 4 + rr; bap[(size_t)r * 16 + fr] = acc[rr] * pg8::row_scale(ssq, r, mode); } }
}
struct Args { const float* in[25]; float* out; unsigned char* ws; int ph_lo, ph_hi; };
typedef const __attribute__((address_space(4))) unsigned long long* kaptr_t;
__device__ __forceinline__ unsigned long long ldka(int i) { kaptr_t ka = (kaptr_t)__builtin_amdgcn_kernarg_segment_ptr(); asm volatile("" : "+s"(i)); return ka[i]; }
__device__ __forceinline__ const float* ldin(const Args&, int i) { return (const float*)(const GAS float*)ldka(i); }
__device__ __forceinline__ unsigned char* ldws(const Args&) { return (unsigned char*)(GAS unsigned char*)ldka(26); }
__device__ __forceinline__ float* ldout(const Args&) { return (float*)(GAS float*)ldka(25); }
__global__ void __launch_bounds__(512, 2) mega(Args args) {
    extern __shared__ __attribute__((aligned(16))) unsigned char lds_raw[];
    LAS unsigned char* lds = (LAS unsigned char*)lds_raw;
    volatile LAS unsigned* MISC = (volatile LAS unsigned*)(lds + MISC_OFF);
    const int tid = threadIdx.x;
    const int G = gridDim.x, bid = blockIdx.x, NGW = G * 8;
    unsigned char* ws = ldws(args);
    for (int u = tid; u < (LDS_BYTES - LDSCTL_OFF) / 4; u += 512) ((LAS unsigned*)(lds + LDSCTL_OFF))[u] = 0u;
    __syncthreads();
    (void)xcd_barrier_post((unsigned*)(ws + WS_CTL) + CW_BAR, MISC + 8);
#define RUN(id) true
#if defined(PROBE_MASK)
#define STAMP() do { if (threadIdx.x == 0) { ((volatile LAS unsigned long long*)(lds + LDSCTL_OFF + 1024))[nst] = __builtin_amdgcn_s_memrealtime(); } ++nst; } while (0)
#else
#define STAMP() do { } while (0)
#endif
#define SEAM(id) do { XcdBarrier bar_; bar_.bar = (unsigned*)WSP(WS_CTL) + CW_BAR; bar_.x = xb_xcc_id(); bar_.st = (volatile LAS unsigned*)(lds + MISC_OFF) + 8; xcd_barrier(bar_); STAMP(); } while (0)
#if defined(PROBE_MASK)
    int nst = 0; STAMP();
#endif
#define INP(i) ldin(args, (i))
#define WSP(off) (ldws(args) + (off))
#define x_in INP(0)
#define norm_mix INP(1)
#define w_in INP(2)
#define conv_lru_w INP(3)
#define conv_lru_b INP(4)
#define lru_w_r INP(5)
#define lru_b_r INP(6)
#define lru_w_i INP(7)
#define lru_b_i INP(8)
#define lru_lambda INP(9)
#define lru_out_norm INP(10)
#define conv_qkv_w INP(11)
#define dn_a_log INP(12)
#define dn_dt_bias INP(13)
#define dn_out_norm INP(14)
#define w_out INP(15)
#define norm_ffn INP(16)
#define ffn_w_gate INP(17)
#define ffn_w_up INP(18)
#define ffn_w_down INP(19)
#define moe_router INP(20)
#define moe_w_gate INP(21)
#define moe_w_up INP(22)
#define moe_w_down INP(23)
#define norm_final INP(24)
#define xres (ldout(args))
#define Win ((bf16*)WSP(WS_WIN))
#define Wba ((float*)WSP(WS_WBA))
#define Wout ((bf16*)WSP(WS_WOUT))
#define Wgu ((bf16*)WSP(WS_WGU))
#define Wd ((bf16*)WSP(WS_WD))
#define Mgu ((bf16*)WSP(WS_MG0))
#define Md ((bf16*)WSP(WS_WGU))
#define Mgu8 ((unsigned char*)WSP(WS_MG0))
#define Md8 ((unsigned char*)WSP(WS_WGU))
#define xb8 ((unsigned char*)WSP(WS_XB))
#define hid8 ((unsigned char*)WSP(WS_PROJ))
#define MCNT ((unsigned*)WSP(WS_CTL) + CW_CNT)
#define MLIST ((int*)WSP(WS_ROWW))
#define MLISTW ((float*)WSP(WS_ROWW + (size_t)8 * T * 4))
#define YP0 ((bf16*)WSP(WS_XB))
#define YP1 ((bf16*)WSP(WS_YMIX))
#define xb ((bf16*)WSP(WS_XB))
#define rstd ((float*)WSP(WS_RSTD))
#define SSQA ((float*)WSP(WS_RSTD + (size_t)1 * MiB))
#define SSQB ((float*)WSP(WS_RSTD + (size_t)3 * MiB))
#define WBAB ((bf16*)WSP(WS_WBA + (size_t)2 * 16 * D * 4))
#define GRT ((float*)WSP(WS_RSTD + (size_t)512 * 1024))
#define LGP ((float*)WSP(WS_C))
#define ba ((float*)WSP(WS_BA))
#define beta ((float*)WSP(WS_BETA))
#define gg ((float*)WSP(WS_G))
#define roww ((float*)WSP(WS_ROWW))
#define proj ((bf16*)WSP(WS_PROJ))
#define hid ((bf16*)WSP(WS_PROJ))
#define ymix ((bf16*)WSP(WS_YMIX))
#define c0 ((float*)WSP(WS_C))
#define c1 ((float*)WSP(WS_C + (size_t)T * 1024 * 4))
#define c2 ((float*)WSP(WS_C + (size_t)2 * T * 1024 * 4))
#define c3 ((float*)WSP(WS_C + (size_t)3 * T * 1024 * 4))
#define LRU_WRT ((bf16*)WSP(WS_WRT))
#define LRU_WIT ((bf16*)WSP(WS_WRT + (size_t)2 * 8 * 128 * 128 * 2))
#define LRU_H ((float*)WSP(WS_C + (size_t)256 * MiB))
#define LRU_A ((float*)WSP(WS_C + (size_t)320 * MiB))
#define LRU_SUMM ((float*)WSP(WS_C + (size_t)384 * MiB))
#define LRU_CARRY ((float*)WSP(WS_C + (size_t)386 * MiB))
#define DN_WF ((bf16*)WSP(WS_C))
#define DN_QF ((bf16*)WSP(WS_C + (size_t)32 * MiB))
#define DN_KDTF ((bf16*)WSP(WS_C + (size_t)64 * MiB))
#define DN_UF ((bf16*)WSP(WS_C + (size_t)96 * MiB))
#define DN_QKF ((bf16*)WSP(WS_C + (size_t)128 * MiB))
#define DN_GL ((float*)WSP(WS_C + (size_t)144 * MiB))
#define DN_VF ((bf16*)WSP(WS_C + (size_t)146 * MiB))
#define DN_SF ((bf16*)WSP(WS_C + (size_t)192 * MiB))
    const int BIG = 1 << 30;
#define PHL int tid_ = threadIdx.x; asm volatile("" : "+v"(tid_)); const int lane_ = tid_ & 63; int bid_ = blockIdx.x; asm volatile("" : "+s"(bid_)); const int gw_ = bid_ * 8 + __builtin_amdgcn_readfirstlane(tid_ >> 6); const size_t gt_ = (size_t)bid_ * 512 + tid_, NGT = (size_t)G * 512; LAS float* scr = (LAS float*)(lds + (gw_ & 7) * 16384);
    if (RUN(ph)) { PHL
        convert_matrix(w_in, DIN, 0, D, NPROJ, norm_mix, Win, BIG, 0, 0, scr, gw_, NGW, lane_);
        convert_matrix(w_out, D, 0, D, D, nullptr, Wout, BIG, 0, 0, scr, gw_, NGW, lane_);
        for (size_t i = gt_; i < (size_t)2 * 16 * D; i += NGT) { const int l = (int)(i / (16 * D)), j = (int)((i / D) & 15), k = (int)(i % D); WBAB[i] = (bf16)f2bf(w_in[(size_t)l * D * DIN + (size_t)k * DIN + NPROJ + j] * norm_mix[l * D + k]); }
        for (size_t i = gt_; i < (size_t)8 * D; i += NGT) { const int e = (int)(i / D), k = (int)(i % D); GRT[i] = moe_router[(size_t)k * 8 + e] * norm_ffn[D + k]; }
        for (int r = gw_; r < T; r += NGW) rowprep_row(x_in, xb, rstd, nullptr, nullptr, r, lane_);
        for (int m = 0; m < 16; ++m) {
            convert_matrix(lru_w_r + (size_t)m * 128 * 128, 128, 0, 128, 128, nullptr, LRU_WRT + (size_t)m * 128 * 128, BIG, 0, 0, scr, gw_, NGW, lane_);
            convert_matrix(lru_w_i + (size_t)m * 128 * 128, 128, 0, 128, 128, nullptr, LRU_WIT + (size_t)m * 128 * 128, BIG, 0, 0, scr, gw_, NGW, lane_); }
    }
    SEAM(ph);
    int xsel = 0;
#define xcur (xsel ? (const float*)xres : x_in)
    { constexpr int l = 0;
        if (RUN(ph)) { pg8::Gemm g{xb, Win + (size_t)l * NPROJ * D, T, NPROJ, D, 0}; pg8::StaticOrder S; S.init(T, NPROJ, G, bid); pg8::EpiScaleBf16 E{proj, l == 0 ? rstd : SSQB, NPROJ, l};
            pg8::gemm_phase<pg8::EpiScaleBf16, pg8::StaticOrder, true, false>(lds, g, S, E);
            { PHL for (int rb = bid_; rb < T / 64; rb += G) ba_tail(xb, WBAB + (size_t)l * 16 * D, l == 0 ? rstd : SSQB, l, ba, rb, gw_ & 7, lane_); } }
        SEAM(ph);
        if (RUN(ph)) { PHL
            LAS float* cwl = (LAS float*)(lds + LDSCTL_OFF + 4096); LAS float* lwl = cwl + 4 * 384;
            { const int hb = bid_ & 7; const float* cq = conv_qkv_w + (size_t)l * 4 * 3 * DDN; const float* cl = conv_lru_w + (size_t)l * 4 * DLRU; const float* cbp = conv_lru_b + l * DLRU;
              for (int i = tid_; i < 4 * 384; i += 512) { const int k = i / 384, pp = (i % 384) >> 7, d = i & 127; cwl[i] = cq[k * 3 * DDN + pp * DDN + hb * HD + d]; }
              for (int i = tid_; i < 640; i += 512) { const int k = i >> 7, d = i & 127; lwl[i] = k < 4 ? cl[k * DLRU + hb * 128 + d] : cbp[hb * 128 + d]; }
              __syncthreads(); }
            { const LruConst LC = lrua_const(LRU_WRT + (size_t)l * 8 * 128 * 128, LRU_WIT + (size_t)l * 8 * 128 * 128, lru_b_r + l * DLRU, lru_b_i + l * DLRU, lru_lambda + l * DLRU, bid_ & 7, lane_, gw_ & 7);
              for (int u = bid_; u < 2048; u += G) lrua_unit(proj, LC, LRU_H, LRU_A, LRU_SUMM, u, lds, lwl, tid_, lane_, gw_ & 7); }
            STAMP();
            for (int uid = bid_; uid < 2048; uid += G) dna_unit(proj, conv_qkv_w + (size_t)l * 4 * 3 * DDN, ba, dn_a_log + l * NH, dn_dt_bias + l * NH, DN_WF, DN_QF, DN_KDTF, DN_QKF, DN_UF, DN_GL, uid, lds, cwl, tid_, lane_, gw_ & 7); }
        SEAM(ph);
        if (RUN(ph)) { PHL
            if (bid_ < 128) dnb_run(DN_WF, DN_KDTF, DN_UF, DN_GL, DN_SF, DN_VF, (bid_ & 7) + 8 * (bid_ >> 6), (bid_ >> 3) & 7, lds, tid_, lane_, gw_ & 7);
            else { if (bid_ < 136 && tid_ < 256) lru_carry(LRU_SUMM, LRU_CARRY, (bid_ - 128) * 256 + tid_);
                const int cw = gw_ - 128 * 8, CNW = NGW - 128 * 8;
                if (l == 0) {
                    convert_matrix(w_in + (size_t)D * DIN, DIN, 0, D, NPROJ, norm_mix + D, Win + (size_t)NPROJ * D, BIG, 0, 0, scr, cw, CNW, lane_);
                    convert_matrix(w_out + (size_t)D * D, D, 0, D, D, nullptr, Wout + (size_t)D * D, BIG, 0, 0, scr, cw, CNW, lane_);
                    convert_matrix(ffn_w_gate, DFF, 0, D, DFF, norm_ffn, Wgu, 128, 256, 0, scr, cw, CNW, lane_);
                    convert_matrix(ffn_w_up, DFF, 0, D, DFF, norm_ffn, Wgu, 128, 256, 128, scr, cw, CNW, lane_);
                    convert_matrix(ffn_w_down, D, 0, DFF, D, nullptr, Wd, BIG, 0, 0, scr, cw, CNW, lane_);
                } else {
                    for (int e = 0; e < NEXP; ++e) convert_matrix8(moe_w_down + (size_t)e * DFFE * D, D, DFFE, D, nullptr, MOE_WSC, Md8 + (size_t)e * D * DFFE, BIG, 0, 0, cw, CNW, lane_);
                    for (int e = 0; e < 2; ++e) {
                        convert_matrix8(moe_w_gate + (size_t)e * D * DFFE, DFFE, D, DFFE, norm_ffn + D, MOE_WSC, Mgu8 + (size_t)e * 2 * DFFE * D, 128, 256, 0, cw, CNW, lane_);
                        convert_matrix8(moe_w_up + (size_t)e * D * DFFE, DFFE, D, DFFE, norm_ffn + D, MOE_WSC, Mgu8 + (size_t)e * 2 * DFFE * D, 128, 256, 128, cw, CNW, lane_); }
                } } }
        SEAM(ph);
        if (RUN(ph)) { PHL
            for (int r = gw_; r < T; r += NGW) lrub_row(LRU_H, LRU_A, LRU_CARRY, proj, lru_out_norm + l * DLRU, ymix, r, lane_);
            dno_run(DN_QF, DN_QKF, DN_SF, DN_VF, dn_out_norm + l * HD, proj, ymix, bid_, G, lds, tid_, lane_, gw_ & 7); }
        SEAM(ph);
        if (RUN(ph)) { if (l == 0) { pg8::Gemm g{ymix, Wout, T, D, D, 0}; pg8::StaticOrder S; S.init(T, D, G, bid); pg8::EpiResidualNorm E{xcur, xres, xb, SSQA, D, 0};
            pg8::gemm_phase<pg8::EpiResidualNorm, pg8::StaticOrder, true, false>(lds, g, S, E); }
          else { pg8::Gemm g{ymix, Wout + (size_t)D * D, T, D, D, 0}; pg8::StaticOrder S; S.init(T, D, G, bid); pg8::EpiResidualRoute E{xcur, xres, xb8, SSQA, GRT, LGP, D, 0};
            pg8::gemm_phase<pg8::EpiResidualRoute, pg8::StaticOrder, true, false>(lds, g, S, E); }
            if (l == 1) { PHL
                for (int e = 2; e < NEXP; ++e) {
                    convert_matrix8(moe_w_gate + (size_t)e * D * DFFE, DFFE, D, DFFE, norm_ffn + D, MOE_WSC, Mgu8 + (size_t)e * 2 * DFFE * D, 128, 256, 0, gw_, NGW, lane_);
                    convert_matrix8(moe_w_up + (size_t)e * D * DFFE, DFFE, D, DFFE, norm_ffn + D, MOE_WSC, Mgu8 + (size_t)e * 2 * DFFE * D, 128, 256, 128, gw_, NGW, lane_);
 } } }
        SEAM(ph);
        xsel = 1;
        if (l == 0) {
            if (RUN(ph)) { pg8::Gemm g{xb, Wgu, T, 2 * DFF, D, 0}; pg8::StaticOrder S; S.init(T, 2 * DFF, G, bid); pg8::EpiSwiGLU E{hid, SSQA, DFF, 1};
                pg8::gemm_phase<pg8::EpiSwiGLU, pg8::StaticOrder, true, false>(lds, g, S, E); }
            SEAM(ph);
            if (RUN(ph)) { pg8::Gemm g{hid, Wd, T, D, DFF, 0}; pg8::StaticOrder S; S.init(T, D, G, bid); pg8::EpiResidualNorm E{xcur, xres, xb, SSQB, D, 0};
                pg8::gemm_phase<pg8::EpiResidualNorm, pg8::StaticOrder, true, false>(lds, g, S, E); }
            SEAM(ph);
        } else {
            if (RUN(ph)) { PHL for (int blk = bid_; blk < T / 64; blk += G) route_block(SSQA, LGP, rstd, MCNT, MLIST, MLISTW, blk, lds, tid_, lane_, gw_ & 7); }
            SEAM(ph);
            if (RUN(ph)) { pg8::Gemm g{(const pg8::bf16_t*)xb8, (const pg8::bf16_t*)Mgu8, NSLOT, 2 * DFFE, D / 2, 0}; MoeOrder S; S.init(MCNT, MLIST, 2 * DFFE / 256, G, bid); pg8::EpiSwiGLUMoe8 E{hid8, rstd, MLIST, DFFE, MOE_HSC};
                pg8::gemm_phase<pg8::EpiSwiGLUMoe8, MoeOrder, true, true, true>(lds, g, S, E); }
            SEAM(ph);
            if (RUN(ph)) { pg8::Gemm g{(const pg8::bf16_t*)hid8, (const pg8::bf16_t*)Md8, NSLOT, D, DFFE / 2, 0}; MoeOrder S; S.init(MCNT, MLIST, D / 256, G, bid); pg8::EpiMoeDown E{YP0, YP1, MLIST, MLISTW, D, 0};
                pg8::gemm_phase<pg8::EpiMoeDown, MoeOrder, true, false, true>(lds, g, S, E); }
            SEAM(ph);
        }
    }
    { constexpr int l = 1;
        if (RUN(ph)) { pg8::Gemm g{xb, Win + (size_t)l * NPROJ * D, T, NPROJ, D, 0}; pg8::StaticOrder S; S.init(T, NPROJ, G, bid); pg8::EpiScaleBf16 E{proj, l == 0 ? rstd : SSQB, NPROJ, l};
            pg8::gemm_phase<pg8::EpiScaleBf16, pg8::StaticOrder, true, false>(lds, g, S, E);
            { PHL for (int rb = bid_; rb < T / 64; rb += G) ba_tail(xb, WBAB + (size_t)l * 16 * D, l == 0 ? rstd : SSQB, l, ba, rb, gw_ & 7, lane_); } }
        SEAM(ph);
        if (RUN(ph)) { PHL
            LAS float* cwl = (LAS float*)(lds + LDSCTL_OFF + 4096); LAS float* lwl = cwl + 4 * 384;
            { const int hb = bid_ & 7; const float* cq = conv_qkv_w + (size_t)l * 4 * 3 * DDN; const float* cl = conv_lru_w + (size_t)l * 4 * DLRU; const float* cbp = conv_lru_b + l * DLRU;
              for (int i = tid_; i < 4 * 384; i += 512) { const int k = i / 384, pp = (i % 384) >> 7, d = i & 127; cwl[i] = cq[k * 3 * DDN + pp * DDN + hb * HD + d]; }
              for (int i = tid_; i < 640; i += 512) { const int k = i >> 7, d = i & 127; lwl[i] = k < 4 ? cl[k * DLRU + hb * 128 + d] : cbp[hb * 128 + d]; }
              __syncthreads(); }
            { const LruConst LC = lrua_const(LRU_WRT + (size_t)l * 8 * 128 * 128, LRU_WIT + (size_t)l * 8 * 128 * 128, lru_b_r + l * DLRU, lru_b_i + l * DLRU, lru_lambda + l * DLRU, bid_ & 7, lane_, gw_ & 7);
              for (int u = bid_; u < 2048; u += G) lrua_unit(proj, LC, LRU_H, LRU_A, LRU_SUMM, u, lds, lwl, tid_, lane_, gw_ & 7); }
            STAMP();
            for (int uid = bid_; uid < 2048; uid += G) dna_unit(proj, conv_qkv_w + (size_t)l * 4 * 3 * DDN, ba, dn_a_log + l * NH, dn_dt_bias + l * NH, DN_WF, DN_QF, DN_KDTF, DN_QKF, DN_UF, DN_GL, uid, lds, cwl, tid_, lane_, gw_ & 7); }
        SEAM(ph);
        if (RUN(ph)) { PHL
            if (bid_ < 128) dnb_run(DN_WF, DN_KDTF, DN_UF, DN_GL, DN_SF, DN_VF, (bid_ & 7) + 8 * (bid_ >> 6), (bid_ >> 3) & 7, lds, tid_, lane_, gw_ & 7);
            else { if (bid_ < 136 && tid_ < 256) lru_carry(LRU_SUMM, LRU_CARRY, (bid_ - 128) * 256 + tid_);
                const int cw = gw_ - 128 * 8, CNW = NGW - 128 * 8;
                if (l == 0) {
                    convert_matrix(w_in + (size_t)D * DIN, DIN, 0, D, NPROJ, norm_mix + D, Win + (size_t)NPROJ * D, BIG, 0, 0, scr, cw, CNW, lane_);
                    convert_matrix(w_out + (size_t)D * D, D, 0, D, D, nullptr, Wout + (size_t)D * D, BIG, 0, 0, scr, cw, CNW, lane_);
                    convert_matrix(ffn_w_gate, DFF, 0, D, DFF, norm_ffn, Wgu, 128, 256, 0, scr, cw, CNW, lane_);
                    convert_matrix(ffn_w_up, DFF, 0, D, DFF, norm_ffn, Wgu, 128, 256, 128, scr, cw, CNW, lane_);
                    convert_matrix(ffn_w_down, D, 0, DFF, D, nullptr, Wd, BIG, 0, 0, scr, cw, CNW, lane_);
                } else {
                    for (int e = 0; e < NEXP; ++e) convert_matrix8(moe_w_down + (size_t)e * DFFE * D, D, DFFE, D, nullptr, MOE_WSC, Md8 + (size_t)e * D * DFFE, BIG, 0, 0, cw, CNW, lane_);
                    for (int e = 0; e < 2; ++e) {
                        convert_matrix8(moe_w_gate + (size_t)e * D * DFFE, DFFE, D, DFFE, norm_ffn + D, MOE_WSC, Mgu8 + (size_t)e * 2 * DFFE * D, 128, 256, 0, cw, CNW, lane_);
                        convert_matrix8(moe_w_up + (size_t)e * D * DFFE, DFFE, D, DFFE, norm_ffn + D, MOE_WSC, Mgu8 + (size_t)e * 2 * DFFE * D, 128, 256, 128, cw, CNW, lane_); }
                } } }
        SEAM(ph);
        if (RUN(ph)) { PHL
            for (int r = gw_; r < T; r += NGW) lrub_row(LRU_H, LRU_A, LRU_CARRY, proj, lru_out_norm + l * DLRU, ymix, r, lane_);
            dno_run(DN_QF, DN_QKF, DN_SF, DN_VF, dn_out_norm + l * HD, proj, ymix, bid_, G, lds, tid_, lane_, gw_ & 7); }
        SEAM(ph);
        if (RUN(ph)) { if (l == 0) { pg8::Gemm g{ymix, Wout, T, D, D, 0}; pg8::StaticOrder S; S.init(T, D, G, bid); pg8::EpiResidualNorm E{xcur, xres, xb, SSQA, D, 0};
            pg8::gemm_phase<pg8::EpiResidualNorm, pg8::StaticOrder, true, false>(lds, g, S, E); }
          else { pg8::Gemm g{ymix, Wout + (size_t)D * D, T, D, D, 0}; pg8::StaticOrder S; S.init(T, D, G, bid); pg8::EpiResidualRoute E{xcur, xres, xb8, SSQA, GRT, LGP, D, 0};
            pg8::gemm_phase<pg8::EpiResidualRoute, pg8::StaticOrder, true, false>(lds, g, S, E); }
            if (l == 1) { PHL
                for (int e = 2; e < NEXP; ++e) {
                    convert_matrix8(moe_w_gate + (size_t)e * D * DFFE, DFFE, D, DFFE, norm_ffn + D, MOE_WSC, Mgu8 + (size_t)e * 2 * DFFE * D, 128, 256, 0, gw_, NGW, lane_);
                    convert_matrix8(moe_w_up + (size_t)e * D * DFFE, DFFE, D, DFFE, norm_ffn + D, MOE_WSC, Mgu8 + (size_t)e * 2 * DFFE * D, 128, 256, 128, gw_, NGW, lane_);
 } } }
        SEAM(ph);
        xsel = 1;
        if (l == 0) {
            if (RUN(ph)) { pg8::Gemm g{xb, Wgu, T, 2 * DFF, D, 0}; pg8::StaticOrder S; S.init(T, 2 * DFF, G, bid); pg8::EpiSwiGLU E{hid, SSQA, DFF, 1};
                pg8::gemm_phase<pg8::EpiSwiGLU, pg8::StaticOrder, true, false>(lds, g, S, E); }
            SEAM(ph);
            if (RUN(ph)) { pg8::Gemm g{hid, Wd, T, D, DFF, 0}; pg8::StaticOrder S; S.init(T, D, G, bid); pg8::EpiResidualNorm E{xcur, xres, xb, SSQB, D, 0};
                pg8::gemm_phase<pg8::EpiResidualNorm, pg8::StaticOrder, true, false>(lds, g, S, E); }
            SEAM(ph);
        } else {
            if (RUN(ph)) { PHL for (int blk = bid_; blk < T / 64; blk += G) route_block(SSQA, LGP, rstd, MCNT, MLIST, MLISTW, blk, lds, tid_, lane_, gw_ & 7); }
            SEAM(ph);
            if (RUN(ph)) { pg8::Gemm g{(const pg8::bf16_t*)xb8, (const pg8::bf16_t*)Mgu8, NSLOT, 2 * DFFE, D / 2, 0}; MoeOrder S; S.init(MCNT, MLIST, 2 * DFFE / 256, G, bid); pg8::EpiSwiGLUMoe8 E{hid8, rstd, MLIST, DFFE, MOE_HSC};
                pg8::gemm_phase<pg8::EpiSwiGLUMoe8, MoeOrder, true, true, true>(lds, g, S, E); }
            SEAM(ph);
            if (RUN(ph)) { pg8::Gemm g{(const pg8::bf16_t*)hid8, (const pg8::bf16_t*)Md8, NSLOT, D, DFFE / 2, 0}; MoeOrder S; S.init(MCNT, MLIST, D / 256, G, bid); pg8::EpiMoeDown E{YP0, YP1, MLIST, MLISTW, D, 0};
                pg8::gemm_phase<pg8::EpiMoeDown, MoeOrder, true, false, true>(lds, g, S, E); }
            SEAM(ph);
        }
    }
    if (RUN(ph)) { PHL for (int r = gw_; r < T; r += NGW) final_row_moe(xcur, YP0, YP1, norm_final, xres, r, lane_); }
#if defined(PROBE_MASK)
    __syncthreads(); STAMP();
    if (blockIdx.x == 0 && threadIdx.x == 0) { asm volatile("s_waitcnt vmcnt(0)" ::: "memory"); volatile LAS unsigned long long* st = (volatile LAS unsigned long long*)(lds + LDSCTL_OFF + 1024); unsigned long long tot = 0;
        for (int k = 1; k < nst; ++k) if ((PROBE_MASK >> (k - 1)) & 1ull) tot += st[k] - st[k - 1];
        xres[0] = rintf((float)tot * 0.01f * PROBE_SCALE); }
#endif
#if defined(PROBE_DNA_A)
    __syncthreads();
    if (blockIdx.x == 0 && threadIdx.x == 0) { asm volatile("s_waitcnt vmcnt(0)" ::: "memory"); volatile LAS unsigned long long* st = (volatile LAS unsigned long long*)(lds + (RING_BYTES + 2048));
        xres[0] = rintf((float)(st[PROBE_DNA_B] - st[PROBE_DNA_A]) * 0.01f * PROBE_SCALE); }
#endif
#undef RUN
#undef SEAM
}

extern "C" void kernel_launch(void* const* d_in, const int* in_sizes, int n_in, void* d_out, int out_size, void* d_ws, size_t ws_size, hipStream_t stream) {
    static int grid = 0;
    if (grid == 0) {
        if (n_in != 25 || ws_size < WS_END) { fprintf(stderr, "kernel_launch: unexpected n_in %d / ws_size %zu (need %zu)\n", n_in, ws_size, (size_t)WS_END); grid = -1; return; }
        int dev = 0, cus = 0, per_cu = 0;
        if (hipGetDevice(&dev) != hipSuccess || hipDeviceGetAttribute(&cus, hipDeviceAttributeMultiprocessorCount, dev) != hipSuccess) { grid = -1; return; }
        if (hipFuncSetAttribute((const void*)mega, hipFuncAttributeMaxDynamicSharedMemorySize, LDS_BYTES) != hipSuccess) { fprintf(stderr, "kernel_launch: hipFuncSetAttribute failed\n"); grid = -1; return; }
        if (hipOccupancyMaxActiveBlocksPerMultiprocessor(&per_cu, (const void*)mega, 512, LDS_BYTES) != hipSuccess || per_cu < 1) { fprintf(stderr, "kernel_launch: occupancy query says %d\n", per_cu); }
        (void)hipGetLastError();
        grid = cus;
    }
    if (grid < 0) return;
    if (hipMemsetAsync((char*)d_ws + WS_CTL, 0, CTL_ZERO_BYTES, stream) != hipSuccess) return;
    Args a{};
    for (int i = 0; i < 25; ++i) a.in[i] = (const float*)d_in[i];
    a.out = (float*)d_out; a.ws = (unsigned char*)d_ws; a.ph_lo = 0; a.ph_hi = 1 << 30;
    hipLaunchKernelGGL(mega, dim3(grid), dim3(512), LDS_BYTES, stream, a);
}
```

```cpp
#include <hip/hip_runtime.h>
#include <cstdio>
#include <cstdint>
namespace pg8 {
#define PG8_LAS __attribute__((address_space(3)))
typedef unsigned short bf16_t;
typedef short bf16x8 __attribute__((ext_vector_type(8)));
typedef float f32x4 __attribute__((ext_vector_type(4)));
typedef unsigned u32x4 __attribute__((ext_vector_type(4)));
constexpr int BM = 256, BK = 64, HALF = 128, HTB = HALF * BK * 2  , STAGE_BYTES = 8 * HTB, NXCD = 8, WGM = 8;

__host__ __device__ __forceinline__ int lds_byte(int r, int c) { const int st = (r >> 4) * 2 + (c >> 5), rr = r & 15, cc = c & 31, ob = rr * 64 + cc * 2; return st * 1024 + (ob ^ (((ob >> 9) & 1) << 5)); }
__host__ __device__ __forceinline__ void stage_rc(int b, int& R, int& C) { const int st = b / 1024, sb = b % 1024, swz = sb ^ (((sb >> 9) & 1) << 5); R = (st >> 1) * 16 + swz / 64; C = (st & 1) * 32 + (swz % 64) / 2; }
__host__ __device__ __forceinline__ int perm32(int rho) { const int n = rho >> 4, i = rho & 15; return 8 * (i >> 2) + 4 * n + (i & 3); }

struct Unit { int pm, pn, pb, lbase, nvalid; };
struct Gemm { const bf16_t* A; const bf16_t* Bt; int M, N, K, pad; };

struct StaticOrder {
    int nM, nN, nwg, G, c;
    __host__ __device__ void init(int M, int N, int G_, int c_) { nM = M / BM; nN = N / BM; nwg = nM * nN; G = G_; c = c_; }
    __host__ __device__ bool next(int i, Unit& u) const {
        const long L = (long)i * G + c; if (L >= nwg) return false;
        int wgid = (int)L; { const int q = nwg / NXCD, r = nwg % NXCD, xcd = wgid % NXCD, off = wgid / NXCD; wgid = (xcd < r ? xcd * (q + 1) : r * (q + 1) + (xcd - r) * q) + off; }
        const int nig = WGM * nN, gid = wgid / nig, fm = gid * WGM, gsz = (nM - fm) < WGM ? (nM - fm) : WGM;
        u.pm = fm + ((wgid % nig) % gsz); u.pn = (wgid % nig) / gsz; u.pb = u.pn; u.lbase = 0; u.nvalid = BM; return true;
    }
    __device__ __forceinline__ int arow(const Unit&, int) const { return 0; }
    __device__ __forceinline__ void a_ready(const Unit&) const {}
    __device__ __forceinline__ void done(const Unit&) const {}
};


typedef float f32x2_t __attribute__((ext_vector_type(2)));
typedef __bf16 bf16x2_t __attribute__((ext_vector_type(2)));
typedef unsigned u32x2_t __attribute__((ext_vector_type(2)));
__device__ __forceinline__ unsigned cvt_pk_bf16(float lo, float hi) { const f32x2_t v = {lo, hi}; const bf16x2_t b = __builtin_convertvector(v, bf16x2_t); return __builtin_bit_cast(unsigned, b); }
__device__ __forceinline__ float frcp(float x) { return __builtin_amdgcn_rcpf(x); }
__device__ __forceinline__ float rsqrt_f(float x) { return __builtin_amdgcn_rsqf(x); }
__device__ __forceinline__ float silu_f(float x) { return x * frcp(1.0f + __expf(-x)); }
__device__ __forceinline__ float swiglu_f(float g, float u, float k1, float s2) { return (g * u) * (s2 * frcp(1.0f + __builtin_amdgcn_exp2f(g * k1))); }
__device__ __forceinline__ float row_scale(const float* rs, int r, int mode) {
    if (!mode) return rs[r];
    const f32x4* p = (const f32x4*)(rs + (size_t)r * 32); float s = 0.f;
#pragma unroll
    for (int i = 0; i < 8; ++i) { const f32x4 v = p[i]; s += (v[0] + v[1]) + (v[2] + v[3]); }
    return rsqrt_f(s * (1.0f / 2048.0f) + 1e-6f);
}
__device__ __forceinline__ void row_scales8(const float* rs, int row0, int fr, int fq, int mode, float (&sc)[2][4]) {
    if (!mode) {
#pragma unroll
        for (int ai = 0; ai < 2; ++ai)
#pragma unroll
            for (int m = 0; m < 4; ++m) sc[ai][m] = rs[row0 + ai * HALF + m * 16];
    } else {
        const int lane = fr + 16 * fq; f32x4 pa[2][4][2];
#pragma unroll
        for (int ai = 0; ai < 2; ++ai)
#pragma unroll
            for (int m = 0; m < 4; ++m) { const f32x4* p = (const f32x4*)(rs + (size_t)(row0 + ai * HALF + m * 16) * 32 + fq * 8); pa[ai][m][0] = p[0]; pa[ai][m][1] = p[1]; }
#pragma unroll
        for (int ai = 0; ai < 2; ++ai)
#pragma unroll
            for (int m = 0; m < 4; ++m) { const f32x4 a = pa[ai][m][0], b = pa[ai][m][1]; float t = ((a[0] + a[1]) + (a[2] + a[3])) + ((b[0] + b[1]) + (b[2] + b[3]));
                t += __int_as_float(__builtin_amdgcn_ds_bpermute((lane ^ 16) << 2, __float_as_int(t)));
                t += __int_as_float(__builtin_amdgcn_ds_bpermute((lane ^ 32) << 2, __float_as_int(t)));
                sc[ai][m] = rsqrt_f(t * (1.0f / 2048.0f) + 1e-6f); }
    }
}
struct EpiScaleBf16 {
    static constexpr bool PERM = true, AFTER_DRAIN = false;
    bf16_t* O; const float* rs; int ldc; int pad;
    __device__ __forceinline__ void operator()(const f32x4 (&acc)[2][2][4][2], const Unit& u, int wr, int wc, int fr, int fq) const {
        const int row0 = u.pm * BM + wr * 64 + fr, col0 = u.pn * BM + wc * 32 + 8 * fq;
        float sc[2][4]; row_scales8(rs, row0, fr, fq, pad, sc);
#pragma unroll
        for (int ai = 0; ai < 2; ++ai)
#pragma unroll
            for (int m = 0; m < 4; ++m) { const int r = row0 + ai * HALF + m * 16; const float s = sc[ai][m]; bf16_t* rowp = O + (size_t)r * ldc + col0;
#pragma unroll
                for (int bj = 0; bj < 2; ++bj) { const f32x4 v0 = acc[ai][bj][m][0] * s, v1 = acc[ai][bj][m][1] * s;
                    u32x4 w; w.x = cvt_pk_bf16(v0[0], v0[1]); w.y = cvt_pk_bf16(v0[2], v0[3]); w.z = cvt_pk_bf16(v1[0], v1[1]); w.w = cvt_pk_bf16(v1[2], v1[3]);
                    *(u32x4*)(rowp + bj * HALF) = w; } }
    }
};
struct EpiSwiGLU {
    static constexpr bool PERM = true, AFTER_DRAIN = false;
    bf16_t* O; const float* rs; int ldc; int pad;
    __device__ __forceinline__ void operator()(const f32x4 (&acc)[2][2][4][2], const Unit& u, int wr, int wc, int fr, int fq) const {
        const int row0 = u.pm * BM + wr * 64 + fr, col0 = u.pn * HALF + wc * 32 + 8 * fq;
        float sc[2][4]; row_scales8(rs, row0, fr, fq, pad, sc);
#pragma unroll
        for (int ai = 0; ai < 2; ++ai)
#pragma unroll
            for (int m = 0; m < 4; ++m) { const int r = row0 + ai * HALF + m * 16; const float s = sc[ai][m], k1 = s * -1.4426950408889634f, s2 = s * s; bf16_t* rowp = O + (size_t)r * ldc + col0;
                f32x4 h0, h1;
#pragma unroll
                for (int j = 0; j < 4; ++j) { h0[j] = swiglu_f(acc[ai][0][m][0][j], acc[ai][1][m][0][j], k1, s2); h1[j] = swiglu_f(acc[ai][0][m][1][j], acc[ai][1][m][1][j], k1, s2); }
                u32x4 w; w.x = cvt_pk_bf16(h0[0], h0[1]); w.y = cvt_pk_bf16(h0[2], h0[3]); w.z = cvt_pk_bf16(h1[0], h1[1]); w.w = cvt_pk_bf16(h1[2], h1[3]);
                *(u32x4*)rowp = w; }
    }
};
struct EpiResidual {
    static constexpr bool PERM = false, AFTER_DRAIN = false;
    const float* base; float* out; const float* roww; int ldc; int pad;
    __device__ __forceinline__ void operator()(const f32x4 (&acc)[2][2][4][2], const Unit& u, int wr, int wc, int fr, int fq) const {
        const int row0 = u.pm * BM + wr * 64 + fr, col0 = u.pn * BM + wc * 32 + 4 * fq;
#pragma unroll
        for (int ai = 0; ai < 2; ++ai)
#pragma unroll
            for (int m = 0; m < 4; ++m) { const int r = row0 + ai * HALF + m * 16; const float w = roww ? roww[r] : 1.0f; const size_t off = (size_t)r * ldc + col0;
#pragma unroll
                for (int bj = 0; bj < 2; ++bj)
#pragma unroll
                    for (int n = 0; n < 2; ++n) { const f32x4 bs = *(const f32x4*)(base + off + bj * HALF + n * 16); *(f32x4*)(out + off + bj * HALF + n * 16) = bs + acc[ai][bj][m][n] * w; } }
    }
};

struct EpiSwiGLUMoe {
    static constexpr bool PERM = true, AFTER_DRAIN = false;
    bf16_t* O; const float* rs; const int* list; int ldc; int pad;
    __device__ __forceinline__ void operator()(const f32x4 (&acc)[2][2][4][2], const Unit& u, int wr, int wc, int fr, int fq) const {
        const int rl0 = wr * 64 + fr, col0 = u.pn * HALF + wc * 32 + 8 * fq;
#pragma unroll
        for (int ai = 0; ai < 2; ++ai)
#pragma unroll
            for (int m = 0; m < 4; ++m) { const int rl = rl0 + ai * HALF + m * 16; const int tok = rl < u.nvalid ? (list[u.lbase + rl] & 0xffff) : 0; const float s = rs[tok], k1 = s * -1.4426950408889634f, s2 = s * s;
                bf16_t* rowp = O + (size_t)(u.pm * BM + rl) * ldc + col0;
                f32x4 h0, h1;
#pragma unroll
                for (int j = 0; j < 4; ++j) { h0[j] = swiglu_f(acc[ai][0][m][0][j], acc[ai][1][m][0][j], k1, s2); h1[j] = swiglu_f(acc[ai][0][m][1][j], acc[ai][1][m][1][j], k1, s2); }
                u32x4 w; w.x = cvt_pk_bf16(h0[0], h0[1]); w.y = cvt_pk_bf16(h0[2], h0[3]); w.z = cvt_pk_bf16(h1[0], h1[1]); w.w = cvt_pk_bf16(h1[2], h1[3]);
                *(u32x4*)rowp = w; }
    }
};
__device__ __forceinline__ unsigned cvt_pk4_fp8(float a, float b, float c, float d) {
    int w = 0;
    w = __builtin_amdgcn_cvt_pk_fp8_f32(__builtin_amdgcn_fmed3f(a, 448.f, -448.f), __builtin_amdgcn_fmed3f(b, 448.f, -448.f), w, false);
    w = __builtin_amdgcn_cvt_pk_fp8_f32(__builtin_amdgcn_fmed3f(c, 448.f, -448.f), __builtin_amdgcn_fmed3f(d, 448.f, -448.f), w, true);
    return (unsigned)w;
}
struct EpiSwiGLUMoe8 {
    static constexpr bool PERM = true, AFTER_DRAIN = false;
    unsigned char* O; const float* rs; const int* list; int ldc; float hs;
    __device__ __forceinline__ void operator()(const f32x4 (&acc)[2][2][4][2], const Unit& u, int wr, int wc, int fr, int fq) const {
        const int rl0 = wr * 64 + fr, col0 = u.pn * HALF + wc * 32 + 8 * fq;
#pragma unroll
        for (int ai = 0; ai < 2; ++ai)
#pragma unroll
            for (int m = 0; m < 4; ++m) { const int rl = rl0 + ai * HALF + m * 16; const int tok = rl < u.nvalid ? (list[u.lbase + rl] & 0xffff) : 0; const float s = rs[tok], k1 = s * -1.4426950408889634f, s2 = s * s * hs;
                unsigned char* rowp = O + (size_t)(u.pm * BM + rl) * ldc + col0;
                f32x4 h0, h1;
#pragma unroll
                for (int j = 0; j < 4; ++j) { h0[j] = swiglu_f(acc[ai][0][m][0][j], acc[ai][1][m][0][j], k1, s2); h1[j] = swiglu_f(acc[ai][0][m][1][j], acc[ai][1][m][1][j], k1, s2); }
                u32x2_t w; w.x = cvt_pk4_fp8(h0[0], h0[1], h0[2], h0[3]); w.y = cvt_pk4_fp8(h1[0], h1[1], h1[2], h1[3]);
                *(u32x2_t*)rowp = w; }
    }
};
struct EpiMoeDown {
    static constexpr bool PERM = true, AFTER_DRAIN = false;
    bf16_t* Y0; bf16_t* Y1; const int* list; const float* lw; int ldc; int pad;
    __device__ __forceinline__ void operator()(const f32x4 (&acc)[2][2][4][2], const Unit& u, int wr, int wc, int fr, int fq) const {
        const int rl0 = wr * 64 + fr, col0 = u.pn * BM + wc * 32 + 8 * fq;
#pragma unroll
        for (int ai = 0; ai < 2; ++ai)
#pragma unroll
            for (int m = 0; m < 4; ++m) { const int rl = rl0 + ai * HALF + m * 16;
                if (rl < u.nvalid) { const int en = list[u.lbase + rl]; const float w = lw[u.lbase + rl]; bf16_t* rowp = ((en >> 16) ? Y1 : Y0) + (size_t)(en & 0xffff) * ldc + col0;
#pragma unroll
                    for (int bj = 0; bj < 2; ++bj) { const f32x4 v0 = acc[ai][bj][m][0] * w, v1 = acc[ai][bj][m][1] * w;
                        u32x4 o; o.x = cvt_pk_bf16(v0[0], v0[1]); o.y = cvt_pk_bf16(v0[2], v0[3]); o.z = cvt_pk_bf16(v1[0], v1[1]); o.w = cvt_pk_bf16(v1[2], v1[3]);
                        *(u32x4*)(rowp + bj * HALF) = o; } } }
    }
};

struct EpiResidualNorm {
    static constexpr bool PERM = true, AFTER_DRAIN = false;
    const float* base; float* out; bf16_t* xb; float* ssq; int ldc; int pad;
    __device__ __forceinline__ void operator()(const f32x4 (&acc)[2][2][4][2], const Unit& u, int wr, int wc, int fr, int fq) const {
        const int row0 = u.pm * BM + wr * 64 + fr, col0 = u.pn * BM + wc * 32 + 8 * fq, lane = fr + 16 * fq;
#pragma unroll
        for (int ai = 0; ai < 2; ++ai)
#pragma unroll
            for (int m = 0; m < 4; ++m) { const int r = row0 + ai * HALF + m * 16; const size_t off = (size_t)r * ldc + col0; float part = 0.f;
#pragma unroll
                for (int bj = 0; bj < 2; ++bj) { const f32x4 b0 = *(const f32x4*)(base + off + bj * HALF), b1 = *(const f32x4*)(base + off + bj * HALF + 4);
                    const f32x4 v0 = b0 + acc[ai][bj][m][0], v1 = b1 + acc[ai][bj][m][1];
                    *(f32x4*)(out + off + bj * HALF) = v0; *(f32x4*)(out + off + bj * HALF + 4) = v1;
                    u32x4 w; w.x = cvt_pk_bf16(v0[0], v0[1]); w.y = cvt_pk_bf16(v0[2], v0[3]); w.z = cvt_pk_bf16(v1[0], v1[1]); w.w = cvt_pk_bf16(v1[2], v1[3]);
                    *(u32x4*)(xb + off + bj * HALF) = w;
                    part += (v0[0] * v0[0] + v0[1] * v0[1]) + (v0[2] * v0[2] + v0[3] * v0[3]) + (v1[0] * v1[0] + v1[1] * v1[1]) + (v1[2] * v1[2] + v1[3] * v1[3]); }
                part += __int_as_float(__builtin_amdgcn_ds_bpermute((lane ^ 16) << 2, __float_as_int(part)));
                part += __int_as_float(__builtin_amdgcn_ds_bpermute((lane ^ 32) << 2, __float_as_int(part)));
                if (fq == 0) ssq[(size_t)r * 32 + u.pn * 4 + wc] = part; }
    }
};

struct EpiResidualRoute {
    static constexpr bool PERM = true, AFTER_DRAIN = false;
    const float* base; float* out; unsigned char* xb8; float* ssq; const float* grtT; float* lgp; int ldc; int pad;
    __device__ __forceinline__ void operator()(const f32x4 (&acc)[2][2][4][2], const Unit& u, int wr, int wc, int fr, int fq) const {
        const int row0 = u.pm * BM + wr * 64 + fr, col0 = u.pn * BM + wc * 32 + 8 * fq, lane = fr + 16 * fq;
        f32x4 xv[2][4][2][2];
#pragma unroll
        for (int ai = 0; ai < 2; ++ai)
#pragma unroll
            for (int m = 0; m < 4; ++m) { const int r = row0 + ai * HALF + m * 16; const size_t off = (size_t)r * ldc + col0; float part = 0.f;
#pragma unroll
                for (int bj = 0; bj < 2; ++bj) { const f32x4 b0 = *(const f32x4*)(base + off + bj * HALF), b1 = *(const f32x4*)(base + off + bj * HALF + 4);
                    const f32x4 v0 = b0 + acc[ai][bj][m][0], v1 = b1 + acc[ai][bj][m][1];
                    *(f32x4*)(out + off + bj * HALF) = v0; *(f32x4*)(out + off + bj * HALF + 4) = v1;
                    u32x2_t w; w.x = cvt_pk4_fp8(v0[0], v0[1], v0[2], v0[3]); w.y = cvt_pk4_fp8(v1[0], v1[1], v1[2], v1[3]);
                    *(u32x2_t*)(xb8 + off + bj * HALF) = w;
                    part += (v0[0] * v0[0] + v0[1] * v0[1]) + (v0[2] * v0[2] + v0[3] * v0[3]) + (v1[0] * v1[0] + v1[1] * v1[1]) + (v1[2] * v1[2] + v1[3] * v1[3]);
                    xv[ai][m][bj][0] = v0; xv[ai][m][bj][1] = v1; }
                part += __int_as_float(__builtin_amdgcn_ds_bpermute((lane ^ 16) << 2, __float_as_int(part)));
                part += __int_as_float(__builtin_amdgcn_ds_bpermute((lane ^ 32) << 2, __float_as_int(part)));
                if (fq == 0) ssq[(size_t)r * 32 + u.pn * 4 + wc] = part; }
        float keep[2][4][2];
#pragma unroll
        for (int ai = 0; ai < 2; ++ai)
#pragma unroll
            for (int m = 0; m < 4; ++m) { keep[ai][m][0] = 0.f; keep[ai][m][1] = 0.f; }
#pragma unroll
        for (int eh = 0; eh < 2; ++eh)
#pragma nounroll
            for (int e4 = 0; e4 < 4; ++e4) { const f32x4* wp = (const f32x4*)(grtT + (size_t)(eh * 4 + e4) * 2048 + col0); const f32x4 w00 = wp[0], w01 = wp[1], w10 = wp[32], w11 = wp[33];
#pragma unroll
                for (int ai = 0; ai < 2; ++ai)
#pragma unroll
                    for (int m = 0; m < 4; ++m) { const f32x4 p = xv[ai][m][0][0] * w00 + xv[ai][m][0][1] * w01 + xv[ai][m][1][0] * w10 + xv[ai][m][1][1] * w11; float s = (p[0] + p[1]) + (p[2] + p[3]);
                        s += __int_as_float(__builtin_amdgcn_ds_bpermute((lane ^ 16) << 2, __float_as_int(s)));
                        s += __int_as_float(__builtin_amdgcn_ds_bpermute((lane ^ 32) << 2, __float_as_int(s)));
                        keep[ai][m][eh] = (fq == e4) ? s : keep[ai][m][eh]; } }
#pragma unroll
        for (int ai = 0; ai < 2; ++ai)
#pragma unroll
            for (int m = 0; m < 4; ++m) { const int r = row0 + ai * HALF + m * 16; float* lp = lgp + ((size_t)r * 32 + u.pn * 4 + wc) * 8 + fq; lp[0] = keep[ai][m][0]; lp[4] = keep[ai][m][1]; }
    }
};
typedef int i32x4_t __attribute__((ext_vector_type(4)));
typedef int i32x8_t __attribute__((ext_vector_type(8)));
__device__ __forceinline__ i32x8_t cat8(bf16x8 a, bf16x8 b) { const i32x4_t x = __builtin_bit_cast(i32x4_t, a), y = __builtin_bit_cast(i32x4_t, b); return __builtin_shufflevector(x, y, 0, 1, 2, 3, 4, 5, 6, 7); }
__device__ __forceinline__ void mfma_f8(f32x4& acc, const i32x8_t& a, const i32x8_t& b) { asm volatile("v_mfma_f32_16x16x128_f8f6f4 %0, %1, %2, %0" : "+v"(acc) : "v"(a), "v"(b)); }
template <class Epi, class Sched, bool ALIGN_EPI = false, bool GATHER = false, bool F8 = false>
__device__ __forceinline__ void gemm_phase(PG8_LAS unsigned char* lds, const Gemm g, const Sched& S, const Epi& E) {
    int tid_o = threadIdx.x; asm volatile("" : "+v"(tid_o));
    const int tid = tid_o, wid = __builtin_amdgcn_readfirstlane(tid >> 6), lane = tid & 63, wr = wid >> 2, wc = wid & 3, fr = lane & 15, fq = lane >> 4;
    const int K = g.K, nt = K / BK;
    const size_t kstep = (size_t)(BK * 2);
    const size_t hstep = (size_t)HALF * K * 2;
    const size_t tstep = 2 * hstep;
    unsigned voffA[2], voffB[2], oA[2][2], oN[2][2];
#pragma unroll
    for (int i = 0; i < 2; ++i) { int R, C; stage_rc(tid * 16 + i * 8192, R, C); const int Rb = Epi::PERM ? ((R & ~31) + perm32(R & 31)) : R; voffA[i] = (unsigned)(R * K + C) * 2u; voffB[i] = (unsigned)(Rb * K + C) * 2u; }
    const unsigned ldsw = (unsigned)wid * 1024u;
    const int aoff = lds_byte(wr * 64 + fr, fq * 8), boff = lds_byte(wc * 32 + fr, fq * 8);
#define PG8_SA(b, h) (((b) * 2 + (h)) * HTB)
#define PG8_SB(b, h) ((4 + (b) * 2 + (h)) * HTB)
#define PG8_STAGE(bufoff, gbase, voff) do { _Pragma("unroll") for (int _i = 0; _i < 2; ++_i) \
        __builtin_amdgcn_global_load_lds((const unsigned*)((const char*)(gbase) + (voff)[_i]), (PG8_LAS unsigned*)(lds + (bufoff) + ldsw + _i * 8192), 16, 0, 0); } while (0)
#define PG8_LDA(dst, b, h) do { _Pragma("unroll") for (int m = 0; m < 4; ++m) { if constexpr (F8) dst##8[m] = cat8(*(const PG8_LAS bf16x8*)(lds + PG8_SA(b, h) + aoff + m * 2048), *(const PG8_LAS bf16x8*)(lds + PG8_SA(b, h) + aoff + m * 2048 + 1024)); \
        else { _Pragma("unroll") for (int k = 0; k < 2; ++k) dst[m][k] = *(const PG8_LAS bf16x8*)(lds + PG8_SA(b, h) + aoff + m * 2048 + k * 1024); } } } while (0)
#define PG8_LDB(dst, b, h) do { _Pragma("unroll") for (int n = 0; n < 2; ++n) { if constexpr (F8) dst##8[n] = cat8(*(const PG8_LAS bf16x8*)(lds + PG8_SB(b, h) + boff + n * 2048), *(const PG8_LAS bf16x8*)(lds + PG8_SB(b, h) + boff + n * 2048 + 1024)); \
        else { _Pragma("unroll") for (int k = 0; k < 2; ++k) dst[n][k] = *(const PG8_LAS bf16x8*)(lds + PG8_SB(b, h) + boff + n * 2048 + k * 1024); } } } while (0)
#define PG8_MMA(ai, bj, At, Bt) do { __builtin_amdgcn_s_setprio(1); _Pragma("unroll") for (int m = 0; m < 4; ++m) _Pragma("unroll") for (int n = 0; n < 2; ++n) { \
        if constexpr (F8) mfma_f8(acc[ai][bj][m][n], Bt##8[n], At##8[m]); \
        else { _Pragma("unroll") for (int k = 0; k < 2; ++k) acc[ai][bj][m][n] = __builtin_amdgcn_mfma_f32_16x16x32_bf16(Bt[n][k], At[m][k], acc[ai][bj][m][n], 0, 0, 0); } } __builtin_amdgcn_s_setprio(0); } while (0)
#define PG8_WAIT_V(n) asm volatile("s_waitcnt vmcnt(" #n ")" ::: "memory")
#define PG8_WAIT_L(n) asm volatile("s_waitcnt lgkmcnt(" #n ")" ::: "memory")
#define PG8_BAR __builtin_amdgcn_s_barrier()
#define PG8_SCHED __builtin_amdgcn_sched_barrier(0)
#define PG8_AOFF(dst, u) do { _Pragma("unroll") for (int _i = 0; _i < 2; ++_i) { int _R, _C; stage_rc(tid * 16 + _i * 8192, _R, _C); _Pragma("unroll") for (int _h = 0; _h < 2; ++_h) \
        dst[_h][_i] = (unsigned)(S.arow(u, _h * HALF + _R) * K + _C) * 2u; } } while (0)
#define PG8_STAGE_A(bufoff, gbase, h, usenext) do { _Pragma("unroll") for (int _i = 0; _i < 2; ++_i) { const unsigned _o = GATHER ? ((usenext) ? oN[h][_i] : oA[h][_i]) : voffA[_i]; \
        __builtin_amdgcn_global_load_lds((const unsigned*)((const char*)(gbase) + (GATHER ? (size_t)0 : (size_t)(h) * hstep) + _o), (PG8_LAS unsigned*)(lds + (bufoff) + ldsw + _i * 8192), 16, 0, 0); } } while (0)
    Unit cur, nxt; int ui = 0;
    if (!S.next(0, cur)) return;
    f32x4 acc[2][2][4][2];
#pragma unroll
    for (int a = 0; a < 2; ++a)
#pragma unroll
        for (int b = 0; b < 2; ++b)
#pragma unroll
            for (int m = 0; m < 4; ++m)
#pragma unroll
                for (int n = 0; n < 2; ++n) acc[a][b][m][n] = (f32x4){0.f, 0.f, 0.f, 0.f};
    bf16x8 At[4][2], B0[2][2], B1[2][2]; i32x8_t At8[4], B08[2], B18[2];
    const char* cA = (const char*)g.A + (GATHER ? (size_t)0 : (size_t)cur.pm * tstep); const char* cB = (const char*)g.Bt + (size_t)cur.pb * tstep;
    S.a_ready(cur);
    if constexpr (GATHER) { PG8_AOFF(oA, cur); PG8_WAIT_V(0); }
    PG8_STAGE(PG8_SB(0, 0), cB, voffB); PG8_STAGE(PG8_SB(0, 1), cB + hstep, voffB); PG8_STAGE_A(PG8_SA(0, 0), cA, 0, false); PG8_STAGE_A(PG8_SA(0, 1), cA, 1, false);
    if (wr == 1) PG8_BAR;
    PG8_WAIT_V(2); PG8_BAR;
    PG8_STAGE(PG8_SB(1, 0), cB + kstep, voffB); PG8_STAGE_A(PG8_SA(1, 0), cA + kstep, 0, false); PG8_STAGE(PG8_SB(1, 1), cB + hstep + kstep, voffB);
    PG8_WAIT_V(6); PG8_BAR;
    for (;;) {
        const bool has_next = S.next(ui + 1, nxt);
        const char* nA = has_next ? (const char*)g.A + (GATHER ? (size_t)0 : (size_t)nxt.pm * tstep) : cA; const char* nB = has_next ? (const char*)g.Bt + (size_t)nxt.pb * tstep : cB;
        if constexpr (GATHER) { if (has_next) { PG8_AOFF(oN, nxt); } else {
#pragma unroll
            for (int _h = 0; _h < 2; ++_h) { oN[_h][0] = oA[_h][0]; oN[_h][1] = oA[_h][1]; } } }
        for (int t = 0; t < nt; t += 2) {
            const bool last = (t == nt - 2);
            const char* a1 = cA + (size_t)(t + 1) * kstep;
            const char* a2 = last ? nA : cA + (size_t)(t + 2) * kstep; const char* b2 = last ? nB : cB + (size_t)(t + 2) * kstep;
            const char* a3 = a2 + kstep; const char* b3 = b2 + kstep;
            if (last && has_next) S.a_ready(nxt);
            PG8_LDB(B0, 0, 0); PG8_LDB(B1, 0, 1); PG8_SCHED; PG8_LDA(At, 0, 0); PG8_STAGE_A(PG8_SA(1, 1), a1, 1, false);
            PG8_WAIT_V(8); PG8_WAIT_L(0); PG8_BAR; PG8_MMA(0, 0, At, B0); PG8_MMA(0, 1, At, B1); PG8_BAR; PG8_SCHED;
            PG8_LDA(At, 0, 1); PG8_STAGE(PG8_SB(0, 0), b2, voffB); PG8_STAGE(PG8_SB(0, 1), b2 + hstep, voffB); PG8_STAGE_A(PG8_SA(0, 0), a2, 0, last);
            PG8_WAIT_V(8); PG8_WAIT_L(0); PG8_BAR; PG8_MMA(1, 0, At, B0); PG8_MMA(1, 1, At, B1); PG8_BAR; PG8_SCHED;
            PG8_LDB(B0, 1, 0); PG8_LDB(B1, 1, 1); PG8_SCHED; PG8_LDA(At, 1, 0); PG8_STAGE_A(PG8_SA(0, 1), a2, 1, last);
            PG8_WAIT_V(8); PG8_WAIT_L(0); PG8_BAR; PG8_MMA(0, 0, At, B0); PG8_MMA(0, 1, At, B1); PG8_BAR; PG8_SCHED;
            PG8_LDA(At, 1, 1); PG8_STAGE(PG8_SB(1, 0), b3, voffB); PG8_STAGE(PG8_SB(1, 1), b3 + hstep, voffB); PG8_STAGE_A(PG8_SA(1, 0), a3, 0, last);
            PG8_WAIT_V(8); PG8_WAIT_L(0); PG8_BAR; PG8_MMA(1, 0, At, B0); PG8_MMA(1, 1, At, B1); PG8_BAR; PG8_SCHED;
        }
        if constexpr (ALIGN_EPI) { if (wr == 0) PG8_BAR; }
        if constexpr (F8) { asm volatile("s_nop 15\n\ts_nop 7" ::: "memory"); PG8_SCHED; }
        E(acc, cur, wr, wc, fr, fq); S.done(cur);
        if (!has_next) break;
#pragma unroll
        for (int a = 0; a < 2; ++a)
#pragma unroll
            for (int b = 0; b < 2; ++b)
#pragma unroll
                for (int m = 0; m < 4; ++m)
#pragma unroll
                    for (int n = 0; n < 2; ++n) acc[a][b][m][n] = (f32x4){0.f, 0.f, 0.f, 0.f};
        cur = nxt; cA = nA; cB = nB; ++ui;
        if constexpr (GATHER) {
#pragma unroll
            for (int _h = 0; _h < 2; ++_h) { oA[_h][0] = oN[_h][0]; oA[_h][1] = oN[_h][1]; } }
        if constexpr (ALIGN_EPI) { if (wr == 1) PG8_BAR; }
    }
    PG8_WAIT_V(0);
    if constexpr (!ALIGN_EPI) { if (wr == 0) PG8_BAR; }
    PG8_BAR;
#undef PG8_SA
#undef PG8_SB
#undef PG8_STAGE
#undef PG8_LDA
#undef PG8_LDB
#undef PG8_MMA
#undef PG8_WAIT_V
#undef PG8_WAIT_L
#undef PG8_BAR
#undef PG8_SCHED
#undef PG8_AOFF
#undef PG8_STAGE_A
}
}

#define GAS __attribute__((address_space(1)))
#define LAS __attribute__((address_space(3)))
#define XB_TMO      128
#define XB_XCNT(j)  (256  + 64 * (j))
#define XB_XSUB(j)  (1280 + 64 * (j))
#define XB_XGEN(j)  (2304 + 64 * (j))
#define XB_TOP      3328
#define XB_TOPGEN   3392
#define XCD_BAR_WORDS 3456
#define XB_SPIN_CAP (1u << 23)

__device__ __forceinline__ unsigned xb_ld(unsigned* p)              { return __hip_atomic_load(p, __ATOMIC_RELAXED, __HIP_MEMORY_SCOPE_AGENT); }
__device__ __forceinline__ unsigned xb_add(unsigned* p, unsigned v) { return __hip_atomic_fetch_add(p, v, __ATOMIC_RELAXED, __HIP_MEMORY_SCOPE_AGENT); }
__device__ __forceinline__ unsigned xb_xcc_id() { return (unsigned)__builtin_amdgcn_s_getreg((3 << 11) | 20) & 0xFu; }
#define XB_SPIN(cond, bar) do { unsigned _sp = 0; while (cond) { __builtin_amdgcn_s_sleep(1); \
    if ((++_sp & 255u) == 0u) { if (xb_ld(&(bar)[XB_TMO])) break; if (_sp > XB_SPIN_CAP) { atomicAdd(&(bar)[XB_TMO], 1u); break; } } } } while (0)

struct XcdBarrier {
    unsigned* bar; unsigned x;
    volatile LAS unsigned* st;
};

__device__ __forceinline__ XcdBarrier xcd_barrier_post(unsigned* bar, volatile LAS unsigned* st) {
    XcdBarrier b; b.bar = bar; b.x = xb_xcc_id(); b.st = st;
    if (threadIdx.x == 0) (void)xb_add(&bar[XB_XCNT(b.x)], 1u);
    return b;
}
__device__ __forceinline__ void xcd_barrier_complete(unsigned* bar, unsigned x, unsigned& nloc, unsigned& nx) {
    const unsigned G = gridDim.x * gridDim.y * gridDim.z;
    unsigned sum, cnt, mine, sp = 0u;
    for (;;) {
        sum = 0u; cnt = 0u; mine = 0u;
#pragma unroll
        for (unsigned j = 0; j < 16; ++j) { const unsigned c = xb_ld(&bar[XB_XCNT(j)]); sum += c; cnt += (c > 0u) ? 1u : 0u; mine = (j == x) ? c : mine; }
        if (sum == G) break;
        __builtin_amdgcn_s_sleep(1);
        if ((++sp & 255u) == 0u) { if (xb_ld(&bar[XB_TMO])) break; if (sp > XB_SPIN_CAP) { atomicAdd(&bar[XB_TMO], 1u); break; } }
    }
    nloc = mine > 0u ? mine : 1u; nx = cnt > 0u ? cnt : 1u;
}

__device__ __forceinline__ void xcd_barrier(const XcdBarrier& b) {
    asm volatile("s_waitcnt vmcnt(0)" ::: "memory");
    __syncthreads();
    if (threadIdx.x == 0) {
        unsigned* bar = b.bar; asm volatile("" : "+s"(bar));
        __builtin_amdgcn_s_waitcnt(0);
        unsigned nloc = b.st[0], nx = b.st[1];
        if (nloc == 0u) { xcd_barrier_complete(bar, b.x, nloc, nx); b.st[0] = nloc; b.st[1] = nx; }
        const unsigned old = xb_add(&bar[XB_XSUB(b.x)], 1u);
        const unsigned gen = old / nloc;
        if (old + 1u == (gen + 1u) * nloc) {
            __builtin_amdgcn_fence(__ATOMIC_RELEASE, "agent");
            asm volatile("s_waitcnt vmcnt(0)" ::: "memory");
            const unsigned og = xb_add(&bar[XB_TOP], 1u);
            const unsigned tg = og / nx;
            if (og + 1u == (tg + 1u) * nx) xb_add(&bar[XB_TOPGEN], 1u);
            else XB_SPIN(xb_ld(&bar[XB_TOPGEN]) == tg, bar);
            __builtin_amdgcn_fence(__ATOMIC_ACQUIRE, "agent");
            xb_add(&bar[XB_XGEN(b.x)], 1u);
            asm volatile("s_waitcnt vmcnt(0)" ::: "memory");
        } else {
            XB_SPIN(xb_ld(&bar[XB_XGEN(b.x)]) == gen, bar);
            __builtin_amdgcn_fence(__ATOMIC_ACQUIRE, "agent");
            asm volatile("s_waitcnt vmcnt(0)" ::: "memory");
        }
    }
    __syncthreads();
}

constexpr int T = 16384, SEQ = 8192, D = 2048, DLRU = 1024, DDN = 1024, NH = 8, HD = 128, NPROJ = 6144, DIN = 6160;
constexpr int DFF = 6144, NEXP = 8, DFFE = 3072;
constexpr float EPS = 1e-6f;
typedef unsigned short bf16;
typedef float f32x4 __attribute__((ext_vector_type(4)));
typedef unsigned u32x4 __attribute__((ext_vector_type(4)));
typedef unsigned u32x2 __attribute__((ext_vector_type(2)));
#define LDS_WAIT() asm volatile("s_waitcnt lgkmcnt(0)" ::: "memory")
#define LDS_BARRIER() do { asm volatile("s_waitcnt lgkmcnt(0)" ::: "memory"); __builtin_amdgcn_s_barrier(); asm volatile("" ::: "memory"); } while (0)

__device__ __forceinline__ float bf2f(bf16 b) { return __uint_as_float(((unsigned)b) << 16); }
__device__ __forceinline__ unsigned f2bf(float f) { return pg8::cvt_pk_bf16(f, f) & 0xffffu; }
__device__ __forceinline__ unsigned pk2(float lo, float hi) { return pg8::cvt_pk_bf16(lo, hi); }
__device__ __forceinline__ float shfl_xor_l(float v, int o, int lane) { return __int_as_float(__builtin_amdgcn_ds_bpermute((lane ^ o) << 2, __float_as_int(v))); }
__device__ __forceinline__ float shfl_up_l(float v, int d, int lane) { return __int_as_float(__builtin_amdgcn_ds_bpermute((lane - d) << 2, __float_as_int(v))); }
__device__ __forceinline__ float shfl_idx_l(float v, int src) { return __int_as_float(__builtin_amdgcn_ds_bpermute(src << 2, __float_as_int(v))); }
__device__ __forceinline__ float wave_sum(float v, int lane) {
#pragma unroll
    for (int o = 1; o < 64; o <<= 1) v += shfl_xor_l(v, o, lane);
    return v;
}
using pg8::silu_f;
using pg8::frcp; using pg8::rsqrt_f;
__device__ __forceinline__ float sigmoid_f(float x) { return frcp(1.0f + __expf(-x)); }
__device__ __forceinline__ float softplus_f(float x) { return fmaxf(x, 0.0f) + log1pf(__expf(-fabsf(x))); }
__device__ __forceinline__ float gelu_tanh_f(float x) { const float u = 0.7978845608028654f * (x + 0.044715f * x * x * x); return x * frcp(1.0f + __expf(-2.0f * u)); }

constexpr size_t MiB = 1u << 20;
constexpr size_t al(size_t x) { return (x + MiB - 1) / MiB * MiB; }
constexpr size_t WS_CTL = 0, CTL_ZERO_BYTES = 1 * MiB;
constexpr int CW_BAR = 4096, CW_CNT = 8192;
constexpr size_t WS_WGU = 1 * MiB;
constexpr size_t WS_WD = WS_WGU + al((size_t)2 * DFF * D * 2);
constexpr size_t WS_WIN = WS_WD + al((size_t)D * DFF * 2);
constexpr size_t WS_WBA = WS_WIN + al((size_t)2 * NPROJ * D * 2);
constexpr size_t WS_WOUT = WS_WBA + al((size_t)2 * 16 * D * 4 + 2 * 16 * D * 2);
static_assert(WS_WIN + (size_t)NPROJ * D * 2 - WS_WGU >= (size_t)NEXP * D * DFFE * 2, "MoE down weights overlay");
constexpr size_t WS_XB = WS_WOUT + al((size_t)2 * D * D * 2);
constexpr size_t WS_RSTD = WS_XB + al((size_t)T * D * 2);
constexpr size_t WS_BA = WS_RSTD + 5 * MiB;
constexpr size_t WS_BETA = WS_BA + al((size_t)T * 16 * 4);
constexpr size_t WS_G = WS_BETA + al((size_t)T * 8 * 4);
constexpr size_t WS_ROWW = WS_G + al((size_t)T * 8 * 4);
constexpr int NSLOT = 2 * T + NEXP * 256;
constexpr size_t WS_PROJ = WS_ROWW + al((size_t)2 * 8 * T * 4);
constexpr size_t WS_YMIX = WS_PROJ + al((size_t)NSLOT * DFFE * 2);
constexpr size_t WS_MG0 = WS_YMIX + al((size_t)T * D * 2);
constexpr size_t WS_C = WS_MG0 + (size_t)96 * MiB;
constexpr size_t WS_WRT = WS_C + (size_t)388 * MiB;
constexpr size_t WS_END = WS_WRT + 1 * MiB;
static_assert(WS_END <= (size_t)975 * MiB, "d_ws map exceeds the guaranteed workspace");
static_assert((size_t)4 * 2 * DFFE * D * 2 == (size_t)96 * MiB, "experts 0-3 fill the region in front of the mixer scratch exactly");
constexpr int RING_BYTES = 131072, LDSCTL_OFF = RING_BYTES, MISC_OFF = LDSCTL_OFF + 320, LDS_BYTES = 147456;

__device__ __forceinline__ void transpose_item(const float* W, int ldw, int col_off, int K, int nblk, const float* gain, bf16* WT, int blk, int blk_stride, int row_off, int item, int lane) {
    const int kb = item / nblk, nb = item % nblk, k0 = 64 * kb + (lane >> 4) * 16, n0 = 64 * nb + (lane & 15) * 4;
    const float* src = W + (size_t)k0 * ldw + col_off + n0;
    f32x4 v[16];
#pragma unroll
    for (int j = 0; j < 16; ++j) v[j] = __builtin_nontemporal_load((const f32x4*)(src + (size_t)j * ldw));
    if (gain) {
#pragma unroll
        for (int q = 0; q < 4; ++q) { const f32x4 g = *(const f32x4*)(gain + k0 + 4 * q);
#pragma unroll
            for (int c = 0; c < 4; ++c) v[4 * q + c] = v[4 * q + c] * g[c]; }
    }
#pragma unroll
    for (int i = 0; i < 4; ++i) { const int n = n0 + i, drow = (n / blk) * blk_stride + (n % blk) + row_off;
        u32x4 o0, o1;
        o0.x = pk2(v[0][i], v[1][i]); o0.y = pk2(v[2][i], v[3][i]); o0.z = pk2(v[4][i], v[5][i]); o0.w = pk2(v[6][i], v[7][i]);
        o1.x = pk2(v[8][i], v[9][i]); o1.y = pk2(v[10][i], v[11][i]); o1.z = pk2(v[12][i], v[13][i]); o1.w = pk2(v[14][i], v[15][i]);
        u32x4* dst = (u32x4*)(WT + (size_t)drow * K + k0); dst[0] = o0; dst[1] = o1; }
}
__device__ __forceinline__ void convert_matrix(const float* W, int ldw, int col_off, int K, int N, const float* gain, bf16* WT, int blk, int blk_stride, int row_off, LAS float* scr, int gw, int NGW, int lane) {
    const int nblk = N / 64, nitems = (K / 64) * nblk; (void)scr;
    for (int it = gw; it < nitems; it += NGW) transpose_item(W, ldw, col_off, K, nblk, gain, WT, blk, blk_stride, row_off, it, lane);
}
constexpr float MOE_WSC = 64.0f, MOE_HSC = 16.0f;
struct CvTile { f32x4 v[16]; };
__device__ __forceinline__ CvTile tr8_load(const float* W, int ldw, int nblk, int item, int lane) {
    const int kb = item / nblk, nb = item % nblk, k0 = 64 * kb + (lane >> 4) * 16, n0 = 64 * nb + (lane & 15) * 4;
    const float* src = W + (size_t)k0 * ldw + n0;
    CvTile t;
#pragma unroll
    for (int j = 0; j < 16; ++j) t.v[j] = __builtin_nontemporal_load((const f32x4*)(src + (size_t)j * ldw));
    return t;
}
__device__ __forceinline__ void tr8_store(const CvTile& t, int K, int nblk, const float* gain, float scale, unsigned char* WT, int blk, int blk_stride, int row_off, int item, int lane) {
    const int kb = item / nblk, nb = item % nblk, k0 = 64 * kb + (lane >> 4) * 16, n0 = 64 * nb + (lane & 15) * 4;
    f32x4 v[16];
#pragma unroll
    for (int q = 0; q < 4; ++q) { f32x4 g = {scale, scale, scale, scale}; if (gain) g = *(const f32x4*)(gain + k0 + 4 * q) * scale;
#pragma unroll
        for (int c = 0; c < 4; ++c) v[4 * q + c] = t.v[4 * q + c] * g[c]; }
#pragma unroll
    for (int i = 0; i < 4; ++i) { const int n = n0 + i, drow = (n / blk) * blk_stride + (n % blk) + row_off;
        u32x4 o;
        o.x = pg8::cvt_pk4_fp8(v[0][i], v[1][i], v[2][i], v[3][i]); o.y = pg8::cvt_pk4_fp8(v[4][i], v[5][i], v[6][i], v[7][i]);
        o.z = pg8::cvt_pk4_fp8(v[8][i], v[9][i], v[10][i], v[11][i]); o.w = pg8::cvt_pk4_fp8(v[12][i], v[13][i], v[14][i], v[15][i]);
        *(u32x4*)(WT + (size_t)drow * K + k0) = o; }
}
__device__ __forceinline__ void convert_matrix8(const float* W, int ldw, int K, int N, const float* gain, float scale, unsigned char* WT, int blk, int blk_stride, int row_off, int gw, int NGW, int lane) {
    const int nblk = N / 64, nitems = (K / 64) * nblk;
    for (int it = gw; it < nitems; it += NGW) { const CvTile t = tr8_load(W, ldw, nblk, it, lane); tr8_store(t, K, nblk, gain, scale, WT, blk, blk_stride, row_off, it, lane); }
}
__device__ __forceinline__ CvTile moe_cv_load(const float* wg, const float* wu, int idx, int lane) {
    const int e = idx / 3072, r = idx % 3072, up = r >= 1536 ? 1 : 0; return tr8_load((up ? wu : wg) + (size_t)e * D * DFFE, DFFE, DFFE / 64, r - up * 1536, lane);
}
__device__ __forceinline__ void moe_cv_store(const CvTile& t, const float* gain, unsigned char* mgu8, int idx, int lane) {
    const int e = idx / 3072, r = idx % 3072, up = r >= 1536 ? 1 : 0; tr8_store(t, D, DFFE / 64, gain, MOE_WSC, mgu8 + (size_t)e * 2 * DFFE * D, 128, 256, up * 128, r - up * 1536, lane);
}
__device__ __forceinline__ void rowprep_row(const float* x, bf16* xb, float* rstd, const float* Wba, float* ba, int row, int lane) {
    const f32x4* xr = (const f32x4*)(x + (size_t)row * D) + lane;
    f32x4 v[8]; float ss = 0.f;
#pragma unroll
    for (int j = 0; j < 8; ++j) { v[j] = xr[64 * j]; ss += (v[j][0] * v[j][0] + v[j][1] * v[j][1]) + (v[j][2] * v[j][2] + v[j][3] * v[j][3]); }
    ss = wave_sum(ss, lane);
    const float rs = rsqrt_f(ss * (1.0f / D) + EPS);
    u32x2* o = (u32x2*)(xb + (size_t)row * D) + lane;
#pragma unroll
    for (int j = 0; j < 8; ++j) { u32x2 w; w.x = pk2(v[j][0], v[j][1]); w.y = pk2(v[j][2], v[j][3]); o[64 * j] = w; }
    if (lane == 0) rstd[row] = rs;
    if (Wba) {
        for (int c = 0; c < 16; ++c) { const f32x4* wr = (const f32x4*)(Wba + (size_t)c * D) + lane; float a = 0.f;
#pragma unroll
            for (int j = 0; j < 8; ++j) { const f32x4 w = wr[64 * j]; a += (v[j][0] * w[0] + v[j][1] * w[1]) + (v[j][2] * w[2] + v[j][3] * w[3]); }
            a = wave_sum(a, lane); if (lane == 0) ba[(size_t)row * 16 + c] = a * rs; }
    }
}
__device__ __forceinline__ void lru_conv_elem(const bf16* proj, const float* cw, const float* cb, float* xc, size_t idx) {
    const int t = (int)(idx / DLRU), ch = (int)(idx % DLRU), s = t % SEQ;
    float a = cb[ch];
#pragma unroll
    for (int k = 0; k < 4; ++k) { const int sp = s - 3 + k; if (sp >= 0) a += cw[k * DLRU + ch] * bf2f(proj[(size_t)(t - 3 + k) * NPROJ + ch]); }
    xc[idx] = a;
}
__device__ __forceinline__ void lru_gate_elem(const float* xc, const float* w_r, const float* b_r, const float* w_i, const float* b_i, const float* lam, float* av, float* bv, size_t idx) {
    const int t = (int)(idx / DLRU), ch = (int)(idx % DLRU), n = ch >> 7, d = ch & 127;
    float ar = b_r[ch], ai = b_i[ch];
    const float* xr = xc + (size_t)t * DLRU + n * 128; const float* wr = w_r + (size_t)n * 128 * 128 + d; const float* wi = w_i + (size_t)n * 128 * 128 + d;
    for (int c = 0; c < 128; ++c) { const float xv = xr[c]; ar += xv * wr[c * 128]; ai += xv * wi[c * 128]; }
    const float r = sigmoid_f(ar), ig = sigmoid_f(ai);
    const float log_a = -8.0f * r * softplus_f(-lam[ch]);
    const float a = expf(log_a), mult = sqrtf(-expm1f(2.0f * log_a));
    av[idx] = a; bv[idx] = mult * (ig * xc[idx]);
}
__device__ __forceinline__ void lru_scan_chan(float* av, const float* bv, const bf16* proj, int idx) {
    const int b = idx / DLRU, ch = idx % DLRU;
    float h = 0.f;
    for (int s0 = 0; s0 < SEQ; s0 += 8) {
        float a8[8], b8[8], g8[8];
#pragma unroll
        for (int j = 0; j < 8; ++j) { const size_t t = (size_t)b * SEQ + s0 + j; a8[j] = av[t * DLRU + ch]; b8[j] = bv[t * DLRU + ch]; g8[j] = bf2f(proj[t * NPROJ + DLRU + ch]); }
#pragma unroll
        for (int j = 0; j < 8; ++j) { const size_t t = (size_t)b * SEQ + s0 + j; h = a8[j] * h + b8[j]; av[t * DLRU + ch] = h * gelu_tanh_f(g8[j]); }
    }
}
__device__ __forceinline__ void lru_norm_row(const float* y, const float* gain, bf16* ymix, int row, int lane) {
    const f32x4* yr = (const f32x4*)(y + (size_t)row * DLRU) + lane; const f32x4* gr = (const f32x4*)gain + lane;
    f32x4 v[4]; float ss = 0.f;
#pragma unroll
    for (int j = 0; j < 4; ++j) { v[j] = yr[64 * j]; ss += (v[j][0] * v[j][0] + v[j][1] * v[j][1]) + (v[j][2] * v[j][2] + v[j][3] * v[j][3]); }
    ss = wave_sum(ss, lane); const float rs = rsqrt_f(ss * (1.0f / DLRU) + EPS);
    u32x2* o = (u32x2*)(ymix + (size_t)row * D) + lane;
#pragma unroll
    for (int j = 0; j < 4; ++j) { const f32x4 g = gr[64 * j]; u32x2 w; w.x = pk2(v[j][0] * rs * g[0], v[j][1] * rs * g[1]); w.y = pk2(v[j][2] * rs * g[2], v[j][3] * rs * g[3]); o[64 * j] = w; }
}
__device__ __forceinline__ void dn_prep_item(const bf16* proj, const float* cw, const float* ba, const float* a_log, const float* dt_bias, float* qn, float* kn, float* vn, float* beta, float* gg, int w, int lane) {
    const int t = w >> 3, h = w & 7, s = t % SEQ;
    float val[3][2];
#pragma unroll
    for (int p = 0; p < 3; ++p)
#pragma unroll
        for (int e = 0; e < 2; ++e) { const int d = lane * 2 + e, c = p * DDN + h * HD + d; float a = 0.f;
#pragma unroll
            for (int k = 0; k < 4; ++k) { const int sp = s - 3 + k; if (sp >= 0) a += cw[k * 3 * DDN + c] * bf2f(proj[(size_t)(t - 3 + k) * NPROJ + 2048 + c]); }
            val[p][e] = silu_f(a); }
    const float sq = wave_sum(val[0][0] * val[0][0] + val[0][1] * val[0][1], lane), sk = wave_sum(val[1][0] * val[1][0] + val[1][1] * val[1][1], lane);
    const float rq = rsqrt_f(sq + EPS) * 0.08838834764831845f, rk = rsqrt_f(sk + EPS);
    const size_t o = ((size_t)t * NH + h) * HD + lane * 2;
    qn[o] = val[0][0] * rq; qn[o + 1] = val[0][1] * rq; kn[o] = val[1][0] * rk; kn[o + 1] = val[1][1] * rk; vn[o] = val[2][0]; vn[o + 1] = val[2][1];
    if (lane == 0) { beta[t * NH + h] = sigmoid_f(ba[(size_t)t * 16 + h]); gg[t * NH + h] = -__expf(a_log[h]) * softplus_f(ba[(size_t)t * 16 + 8 + h] + dt_bias[h]); }
}
__device__ __forceinline__ void dn_rec_seq(const float* qn, const float* kn, const float* vn, const float* beta, const float* gg, float* o, int bh, LAS float* sk, LAS float* sq, LAS float* st, int tid) {
    const int b = bh >> 3, h = bh & 7, j = tid & 127; const bool act = tid < 128;
    if (act) for (int k = 0; k < 128; ++k) st[k * 128 + j] = 0.f;
    const size_t base = ((size_t)(b * SEQ) * NH + h) * HD;
    float nk = kn[base + j], nq = qn[base + j], nv = vn[base + j], nb = beta[(b * SEQ) * NH + h], ng = gg[(b * SEQ) * NH + h];
    for (int s = 0; s < SEQ; ++s) {
        const int buf = (s & 1) * 128;
        if (act) { sk[buf + j] = nk; sq[buf + j] = nq; }
        const float vj = nv, be = nb, ge = __expf(ng);
        __syncthreads();
        if (act) {
            if (s + 1 < SEQ) { const size_t nb_ = ((size_t)(b * SEQ + s + 1) * NH + h) * HD; nk = kn[nb_ + j]; nq = qn[nb_ + j]; nv = vn[nb_ + j]; nb = beta[(b * SEQ + s + 1) * NH + h]; ng = gg[(b * SEQ + s + 1) * NH + h]; }
            float ks = 0.f;
#pragma unroll 8
            for (int k = 0; k < 128; ++k) ks += sk[buf + k] * st[k * 128 + j];
            const float vnew = be * (vj - ge * ks);
            float oo = 0.f;
#pragma unroll 8
            for (int k = 0; k < 128; ++k) { const float sv = ge * st[k * 128 + j] + sk[buf + k] * vnew; st[k * 128 + j] = sv; oo += sq[buf + k] * sv; }
            o[((size_t)(b * SEQ + s) * NH + h) * HD + j] = oo;
        }
    }
    __syncthreads();
}
typedef short bf16x8 __attribute__((ext_vector_type(8)));
__device__ __forceinline__ f32x4 mfma16(bf16x8 a, bf16x8 b, f32x4 c) { return __builtin_amdgcn_mfma_f32_16x16x32_bf16(a, b, c, 0, 0, 0); }
__device__ __forceinline__ float bflo(unsigned x) { return __uint_as_float(x << 16); }
__device__ __forceinline__ float bfhi(unsigned x) { return __uint_as_float(x & 0xffff0000u); }
constexpr int DA_G = 0, DA_L = 1024, DA_KN = DA_L + 16384, DA_QN = DA_KN + 17408, DA_VBT = DA_QN + 17408, DA_KBET = DA_VBT + 18432, DA_KDT = DA_KBET + 18432, DA_TB = DA_KDT + 18432, DA_QK = DA_TB + 9216, DA_END = DA_QK + 9216;
static_assert(DA_END <= RING_BYTES, "DN-A LDS map");
#if defined(PROBE_DNA_A)
#define DNA_ST(k) do { if (threadIdx.x == 0) ((volatile LAS unsigned long long*)(lds + (RING_BYTES + 2048)))[k] = __builtin_amdgcn_s_memrealtime(); } while (0)
#else
#define DNA_ST(k) do { } while (0)
#endif
__device__ __forceinline__ void dna_unit(const bf16* proj, const float* cw, const float* ba, const float* a_log, const float* dt_bias,
                                         bf16* Wf, bf16* Qf, bf16* KdTf, bf16* QKf, bf16* Uf, float* glb, int uid, LAS unsigned char* lds, const LAS float* cwl, int tid, int lane, int wave,
                                         const float* mwg, const float* mwu, const float* mgain, unsigned char* mgu8, int cvidx) {
    const int h = uid & 7, n = (uid >> 3) & 127, b = uid >> 10, t0 = b * SEQ + n * 64;
    asm volatile("" : "+v"(lds));
    DNA_ST(0);
    LAS float* Gs = (LAS float*)(lds + DA_G);
    const int fr = lane & 15, fq = lane >> 4;
    float ba_b = 0.f, ba_a = 0.f;
    if (wave == 0) { const size_t t = (size_t)(t0 + lane); ba_b = ba[t * 16 + h]; ba_a = ba[t * 16 + 8 + h]; }
    DNA_ST(1);
    {
        const int r = tid >> 3, cg = tid & 7;
        float val[3][16];
#pragma unroll
        for (int p = 0; p < 3; ++p) {
            const int ccol = p * DDN + h * HD + cg * 16;
            float acc[16];
#pragma unroll
            for (int i = 0; i < 16; ++i) acc[i] = 0.f;
#pragma unroll
            for (int k = 0; k < 4; ++k) { const int row = r - 3 + k;
                if (n * 64 + row >= 0) {
                    const bf16* src = proj + (size_t)(t0 + row) * NPROJ + 2048 + ccol;
                    const u32x4 x0 = *(const u32x4*)src, x1 = *(const u32x4*)(src + 8);
                    const LAS float* wp = cwl + k * 384 + p * 128 + cg * 16;
                    const f32x4 w0 = *(const LAS f32x4*)wp, w1 = *(const LAS f32x4*)(wp + 4), w2 = *(const LAS f32x4*)(wp + 8), w3 = *(const LAS f32x4*)(wp + 12);
                    acc[0] += w0[0] * bflo(x0.x); acc[1] += w0[1] * bfhi(x0.x); acc[2] += w0[2] * bflo(x0.y); acc[3] += w0[3] * bfhi(x0.y);
                    acc[4] += w1[0] * bflo(x0.z); acc[5] += w1[1] * bfhi(x0.z); acc[6] += w1[2] * bflo(x0.w); acc[7] += w1[3] * bfhi(x0.w);
                    acc[8] += w2[0] * bflo(x1.x); acc[9] += w2[1] * bfhi(x1.x); acc[10] += w2[2] * bflo(x1.y); acc[11] += w2[3] * bfhi(x1.y);
                    acc[12] += w3[0] * bflo(x1.z); acc[13] += w3[1] * bfhi(x1.z); acc[14] += w3[2] * bflo(x1.w); acc[15] += w3[3] * bfhi(x1.w);
                } }
#pragma unroll
            for (int i = 0; i < 16; ++i) val[p][i] = silu_f(acc[i]);
        }
        float sq = 0.f, sk = 0.f;
#pragma unroll
        for (int i = 0; i < 16; ++i) { sq += val[0][i] * val[0][i]; sk += val[1][i] * val[1][i]; }
        sq += shfl_xor_l(sq, 1, lane); sq += shfl_xor_l(sq, 2, lane); sq += shfl_xor_l(sq, 4, lane);
        sk += shfl_xor_l(sk, 1, lane); sk += shfl_xor_l(sk, 2, lane); sk += shfl_xor_l(sk, 4, lane);
        const float rq = rsqrt_f(sq + EPS) * 0.08838834764831845f, rk = rsqrt_f(sk + EPS);
        if (wave == 0) {
            const float be0 = sigmoid_f(ba_b); float Gc = -__expf(a_log[h]) * softplus_f(ba_a + dt_bias[h]);
#pragma unroll
            for (int off = 1; off < 64; off <<= 1) { const float tmp = shfl_up_l(Gc, off, lane); if (lane >= off) Gc += tmp; }
            const float GL = shfl_idx_l(Gc, 63);
            Gs[lane] = Gc; Gs[64 + lane] = be0; Gs[128 + lane] = __expf(Gc); Gs[192 + lane] = __expf(GL - Gc);
            if (lane == 63) glb[uid] = __expf(Gc);
        }
        LDS_BARRIER();
        const float be = Gs[64 + r], eg = Gs[128 + r], egl = Gs[192 + r];
#pragma unroll
        for (int i = 0; i < 16; ++i) { val[0][i] *= rq; val[1][i] *= rk; }
        u32x4 o0, o1;
        o0.x = pk2(val[1][0], val[1][1]); o0.y = pk2(val[1][2], val[1][3]); o0.z = pk2(val[1][4], val[1][5]); o0.w = pk2(val[1][6], val[1][7]);
        o1.x = pk2(val[1][8], val[1][9]); o1.y = pk2(val[1][10], val[1][11]); o1.z = pk2(val[1][12], val[1][13]); o1.w = pk2(val[1][14], val[1][15]);
        *(LAS u32x4*)(lds + DA_KN + r * 272 + cg * 32) = o0; *(LAS u32x4*)(lds + DA_KN + r * 272 + cg * 32 + 16) = o1;
        o0.x = pk2(val[0][0], val[0][1]); o0.y = pk2(val[0][2], val[0][3]); o0.z = pk2(val[0][4], val[0][5]); o0.w = pk2(val[0][6], val[0][7]);
        o1.x = pk2(val[0][8], val[0][9]); o1.y = pk2(val[0][10], val[0][11]); o1.z = pk2(val[0][12], val[0][13]); o1.w = pk2(val[0][14], val[0][15]);
        *(LAS u32x4*)(lds + DA_QN + r * 272 + cg * 32) = o0; *(LAS u32x4*)(lds + DA_QN + r * 272 + cg * 32 + 16) = o1;
#pragma unroll
        for (int i = 0; i < 16; ++i) { const int f = cg * 16 + i;
            *(LAS unsigned short*)(lds + DA_VBT + f * 144 + r * 2) = (unsigned short)f2bf(val[2][i] * be);
            *(LAS unsigned short*)(lds + DA_KBET + f * 144 + r * 2) = (unsigned short)f2bf(val[1][i] * (be * eg));
            *(LAS unsigned short*)(lds + DA_KDT + f * 144 + r * 2) = (unsigned short)f2bf(val[1][i] * egl); }
    }
    LDS_BARRIER();
    DNA_ST(2);
    {
        const int p = wave >> 2, ti = wave & 3;
        const int abase = p == 0 ? DA_KN : DA_QN;
        bf16x8 af[4];
#pragma unroll
        for (int ks = 0; ks < 4; ++ks) af[ks] = *(const LAS bf16x8*)(lds + abase + (ti * 16 + fr) * 272 + (ks * 32 + fq * 8) * 2);
        for (int tj = 0; tj < 4; ++tj) {
            f32x4 acc = {0.f, 0.f, 0.f, 0.f};
            if (tj <= ti) {
#pragma unroll
                for (int ks = 0; ks < 4; ++ks) { const bf16x8 bb = *(const LAS bf16x8*)(lds + DA_KN + (tj * 16 + fr) * 272 + (ks * 32 + fq * 8) * 2); acc = mfma16(af[ks], bb, acc); }
            }
            const int j = tj * 16 + fr; const float Gj = Gs[j];
#pragma unroll
            for (int r = 0; r < 4; ++r) { const int i = ti * 16 + fq * 4 + r; float v = 0.f;
                if (p == 0) { if (i > j) v = Gs[64 + i] * acc[r] * __expf(Gs[i] - Gj); *(LAS float*)(lds + DA_L + (j * 64 + i) * 4) = v; }
                else { if (i >= j) v = acc[r] * __expf(Gs[i] - Gj); *(LAS unsigned short*)(lds + DA_QK + i * 144 + j * 2) = (unsigned short)f2bf(v); } }
        }
    }
    LDS_BARRIER();
    DNA_ST(3);
    {
        CvTile cvt; if (cvidx >= 0) cvt = moe_cv_load(mwg, mwu, cvidx, lane);
        int lc = lane; asm volatile("" : "+v"(lc)); const float fl = (float)lc;
        const int blk = wave < 4 ? wave : 11 - wave;
        float Tr[8];
#pragma unroll
        for (int c = 0; c < 8; ++c) Tr[c] = fmaxf(0.f, 1.f - fabsf(fl - (float)(blk * 8 + c)));
        float lj[63];
#pragma unroll
        for (int j = 0; j < 63; ++j) lj[j] = *(const LAS float*)(lds + DA_L + (j * 64) * 4 + lc * 4);
#pragma unroll
        for (int j = 0; j < 63; ++j) {
            if (j >= blk * 8) {
#pragma unroll
                for (int c = 0; c < 8; ++c) { const float tj = __int_as_float(__builtin_amdgcn_readlane(__float_as_int(Tr[c]), j)); Tr[c] -= lj[j] * tj; }
            }
        }
        u32x4 o; o.x = pk2(Tr[0], Tr[1]); o.y = pk2(Tr[2], Tr[3]); o.z = pk2(Tr[4], Tr[5]); o.w = pk2(Tr[6], Tr[7]);
        *(LAS u32x4*)(lds + DA_TB + lc * 144 + blk * 16) = o;
        if (cvidx >= 0) moe_cv_store(cvt, mgain, mgu8, cvidx, lane);
    }
    {
        for (int fi = wave; fi < 40; fi += 8) {
            if (fi < 8) { const int mt = fi >> 1, ks = fi & 1;
                const u32x4 v = *(const LAS u32x4*)(lds + DA_QK + (mt * 16 + fr) * 144 + (ks * 32 + fq * 8) * 2);
                *(u32x4*)(QKf + (((size_t)uid * 4 + mt) * 2 + ks) * 512 + lane * 8) = v; }
            else if (fi < 24) { const int f2 = fi - 8, mt = f2 >> 2, ks = f2 & 3; const float eg = Gs[128 + mt * 16 + fr];
                const u32x4 v = *(const LAS u32x4*)(lds + DA_QN + (mt * 16 + fr) * 272 + (ks * 32 + fq * 8) * 2); u32x4 o;
                o.x = pk2(bflo(v.x) * eg, bfhi(v.x) * eg); o.y = pk2(bflo(v.y) * eg, bfhi(v.y) * eg); o.z = pk2(bflo(v.z) * eg, bfhi(v.z) * eg); o.w = pk2(bflo(v.w) * eg, bfhi(v.w) * eg);
                *(u32x4*)(Qf + (((size_t)uid * 4 + mt) * 4 + ks) * 512 + lane * 8) = o; }
            else { const int f2 = fi - 24, ft = f2 >> 1, ks = f2 & 1;
                const u32x4 v = *(const LAS u32x4*)(lds + DA_KDT + (ft * 16 + fr) * 144 + (ks * 32 + fq * 8) * 2);
                *(u32x4*)(KdTf + (((size_t)uid * 8 + ft) * 2 + ks) * 512 + lane * 8) = v; }
        }
    }
    LDS_BARRIER();
    DNA_ST(4);
    {
        bf16x8 ta[4][2];
#pragma unroll
        for (int mt = 0; mt < 4; ++mt)
#pragma unroll
            for (int ks = 0; ks < 2; ++ks) ta[mt][ks] = *(const LAS bf16x8*)(lds + DA_TB + (mt * 16 + fr) * 144 + (ks * 32 + fq * 8) * 2);
#pragma unroll
        for (int c2 = 0; c2 < 2; ++c2) { const int ct = wave * 2 + c2, img = ct < 8 ? DA_VBT : DA_KBET, cr = (ct & 7) * 16 + fr;
            bf16x8 bb[2];
#pragma unroll
            for (int ks = 0; ks < 2; ++ks) bb[ks] = *(const LAS bf16x8*)(lds + img + cr * 144 + (ks * 32 + fq * 8) * 2);
#pragma unroll
            for (int mt = 0; mt < 4; ++mt) { f32x4 acc = {0.f, 0.f, 0.f, 0.f};
#pragma unroll
                for (int ks = 0; ks < 2; ++ks) acc = mfma16(ta[mt][ks], bb[ks], acc);
                if (ct < 8) { u32x2 o; o.x = pk2(acc[0], acc[1]); o.y = pk2(acc[2], acc[3]); *(u32x2*)(Uf + ((((size_t)uid * 8 + ct) * 4 + mt) * 64 + lane) * 4) = o; }
                else { const int f = (ct - 8) * 16 + fr;
#pragma unroll
                    for (int r = 0; r < 4; ++r) *(LAS unsigned short*)(lds + DA_KN + (mt * 16 + fq * 4 + r) * 272 + f * 2) = (unsigned short)f2bf(acc[r]); } }
        }
    }
    LDS_BARRIER();
    DNA_ST(5);
#pragma unroll
    for (int q2 = 0; q2 < 2; ++q2) { const int fi = wave * 2 + q2, mt = fi >> 2, ks = fi & 3;
        const u32x4 v = *(const LAS u32x4*)(lds + DA_KN + (mt * 16 + fr) * 272 + (ks * 32 + fq * 8) * 2);
        *(u32x4*)(Wf + (((size_t)uid * 4 + mt) * 4 + ks) * 512 + lane * 8) = v; }
    LDS_BARRIER();
    DNA_ST(6);
}
struct DnbFrag { bf16x8 a1[4]; bf16x8 kd[2]; u32x2 u; float gl; };
__device__ __forceinline__ DnbFrag dnb_load(const bf16* Wf, const bf16* KdTf, const bf16* Uf, const float* glb, int uid, int ds, int wave, int lane) {
    DnbFrag f; const int mt = wave & 3;
#pragma unroll
    for (int ks = 0; ks < 4; ++ks) f.a1[ks] = (wave < 4) ? *(const bf16x8*)(Wf + (((size_t)uid * 4 + mt) * 4 + ks) * 512 + lane * 8) : (bf16x8){0, 0, 0, 0, 0, 0, 0, 0};
#pragma unroll
    for (int ks = 0; ks < 2; ++ks) f.kd[ks] = *(const bf16x8*)(KdTf + (((size_t)uid * 8 + wave) * 2 + ks) * 512 + lane * 8);
    f.u = (wave < 4) ? *(const u32x2*)(Uf + ((((size_t)uid * 8 + ds) * 4 + mt) * 64 + lane) * 4) : (u32x2){0u, 0u};
    f.gl = glb[uid];
    return f;
}
__device__ __forceinline__ void dnb_run(const bf16* Wf, const bf16* KdTf, const bf16* Uf, const float* glb, bf16* Sf, bf16* Vf, int bh, int ds, LAS unsigned char* lds, int tid, int lane, int wave) {
    const int b = bh >> 3, h = bh & 7, fr = lane & 15, fq = lane >> 4, mt = wave & 3;
    asm volatile("" : "+v"(lds));
    LAS unsigned char* ST = lds; LAS unsigned char* VNT = lds + 4608;
    for (int i = tid; i < 4608 / 4; i += 512) ((LAS unsigned*)ST)[i] = 0u;
    f32x4 accS = {0.f, 0.f, 0.f, 0.f};
    DnbFrag f0 = dnb_load(Wf, KdTf, Uf, glb, (b * 128 + 0) * 8 + h, ds, wave, lane), f1 = dnb_load(Wf, KdTf, Uf, glb, (b * 128 + 1) * 8 + h, ds, wave, lane);
    DnbFrag f2 = dnb_load(Wf, KdTf, Uf, glb, (b * 128 + 2) * 8 + h, ds, wave, lane), f3 = dnb_load(Wf, KdTf, Uf, glb, (b * 128 + 3) * 8 + h, ds, wave, lane);
    __syncthreads();
#define DNB_STEP(F, nn) do { const int n = (nn); const size_t uds = (size_t)((b * 128 + n) * 8 + h) * 8 + ds; \
        if (wave < 4) { f32x4 acc = {0.f, 0.f, 0.f, 0.f}; \
            _Pragma("unroll") for (int ks = 0; ks < 4; ++ks) { const bf16x8 sb = *(const LAS bf16x8*)(ST + fr * 272 + (ks * 32 + fq * 8) * 2); acc = mfma16(F.a1[ks], sb, acc); } \
            const float v0 = bflo(F.u.x) - acc[0], v1 = bfhi(F.u.x) - acc[1], v2 = bflo(F.u.y) - acc[2], v3 = bfhi(F.u.y) - acc[3]; \
            u32x2 w; w.x = pk2(v0, v1); w.y = pk2(v2, v3); *(LAS u32x2*)(VNT + fr * 144 + (mt * 16 + fq * 4) * 2) = w; } \
        else { const u32x4 sb = *(const LAS u32x4*)(ST + fr * 272 + (mt * 32 + fq * 8) * 2);     \
            *(u32x4*)(Sf + (uds * 4 + mt) * 512 + lane * 8) = sb; } \
        LDS_BARRIER(); \
        bf16x8 vb[2]; \
        _Pragma("unroll") for (int ks = 0; ks < 2; ++ks) vb[ks] = *(const LAS bf16x8*)(VNT + fr * 144 + (ks * 32 + fq * 8) * 2); \
        accS = accS * F.gl; \
        _Pragma("unroll") for (int ks = 0; ks < 2; ++ks) accS = mfma16(F.kd[ks], vb[ks], accS); \
        { u32x2 w; w.x = pk2(accS[0], accS[1]); w.y = pk2(accS[2], accS[3]); *(LAS u32x2*)(ST + fr * 272 + (wave * 16 + fq * 4) * 2) = w; } \
        if (wave == 4) *(bf16x8*)(Vf + (uds * 2 + 0) * 512 + lane * 8) = vb[0];     \
        if (wave == 5) *(bf16x8*)(Vf + (uds * 2 + 1) * 512 + lane * 8) = vb[1]; \
        F = dnb_load(Wf, KdTf, Uf, glb, (b * 128 + (n + 4 < 128 ? n + 4 : 127)) * 8 + h, ds, wave, lane);     \
        LDS_BARRIER(); } while (0)
    for (int n4 = 0; n4 < 128; n4 += 16) {
        DNB_STEP(f0, n4); DNB_STEP(f1, n4 + 1); DNB_STEP(f2, n4 + 2); DNB_STEP(f3, n4 + 3); DNB_STEP(f0, n4 + 4); DNB_STEP(f1, n4 + 5); DNB_STEP(f2, n4 + 6); DNB_STEP(f3, n4 + 7);
        DNB_STEP(f0, n4 + 8); DNB_STEP(f1, n4 + 9); DNB_STEP(f2, n4 + 10); DNB_STEP(f3, n4 + 11); DNB_STEP(f0, n4 + 12); DNB_STEP(f1, n4 + 13); DNB_STEP(f2, n4 + 14); DNB_STEP(f3, n4 + 15); }
#undef DNB_STEP
}
constexpr int DO_ABUF = 24576, DO_OT = 49152, DO_END = DO_OT + 64 * 132 * 4;
static_assert(DO_END <= RING_BYTES, "DN-O LDS map");
struct DnoOps { bf16x8 sB[4], vB[2]; u32x4 g0, g1; };
__device__ __forceinline__ DnoOps dno_request(const bf16* Qf, const bf16* QKf, const bf16* Sf, const bf16* Vf, const bf16* proj, int uid, LAS unsigned char* abuf, int tid, int lane, int wave) {
    DnoOps f; const int h = uid & 7, n = (uid >> 3) & 127, b = uid >> 10, t = b * SEQ + n * 64 + (tid >> 3), c = h * HD + (tid & 7) * 16;
#pragma unroll
    for (int i = 0; i < 3; ++i) { const int ch = wave * 3 + i;
        __builtin_amdgcn_global_load_lds((const unsigned*)((ch < 16 ? Qf + (size_t)uid * 8192 + ch * 512 : QKf + (size_t)uid * 4096 + (ch - 16) * 512) + lane * 8), (LAS unsigned*)(abuf + ch * 1024), 16, 0, 0); }
#pragma unroll
    for (int ks = 0; ks < 4; ++ks) f.sB[ks] = *(const bf16x8*)(Sf + ((((size_t)uid * 8 + wave) * 4) + ks) * 512 + lane * 8);
#pragma unroll
    for (int ks = 0; ks < 2; ++ks) f.vB[ks] = *(const bf16x8*)(Vf + ((((size_t)uid * 8 + wave) * 2) + ks) * 512 + lane * 8);
    const u32x4* gp = (const u32x4*)(proj + (size_t)t * NPROJ + 5120 + c); f.g0 = gp[0]; f.g1 = gp[1];
    return f;
}
__device__ __forceinline__ void dno_run(const bf16* Qf, const bf16* QKf, const bf16* Sf, const bf16* Vf, const float* gain, const bf16* proj, bf16* ymix, int bid, int G, LAS unsigned char* lds, int tid, int lane, int wave) {
    const int fr = lane & 15, fq = lane >> 4, cg = tid & 7, rr = tid >> 3;
    LAS unsigned char* ldu = lds;
    asm volatile("" : "+v"(lds));
    const f32x4* wp = (const f32x4*)(gain + cg * 16); const f32x4 w0 = wp[0], w1 = wp[1], w2 = wp[2], w3 = wp[3];
    int buf = 0;
    DnoOps cur = dno_request(Qf, QKf, Sf, Vf, proj, bid, ldu, tid, lane, wave);
    for (int uid = bid; uid < 2048; uid += G) {
        const int h = uid & 7, n = (uid >> 3) & 127, b = uid >> 10, t0 = b * SEQ + n * 64;
        asm volatile("s_waitcnt vmcnt(0)" ::: "memory");
        LDS_BARRIER();
        const LAS unsigned char* ab = lds + buf * DO_ABUF;
#pragma unroll
        for (int mt = 0; mt < 4; ++mt) { f32x4 acc = {0.f, 0.f, 0.f, 0.f};
#pragma unroll
            for (int ks = 0; ks < 4; ++ks) { const bf16x8 a = *(const LAS bf16x8*)(ab + (mt * 4 + ks) * 1024 + lane * 16); acc = mfma16(a, cur.sB[ks], acc); }
#pragma unroll
            for (int ks = 0; ks < 2; ++ks) { const bf16x8 a = *(const LAS bf16x8*)(ab + 16384 + (mt * 2 + ks) * 1024 + lane * 16); acc = mfma16(a, cur.vB[ks], acc); }
#pragma unroll
            for (int r = 0; r < 4; ++r) *(LAS float*)(lds + DO_OT + ((mt * 16 + fq * 4 + r) * 132 + wave * 16 + fr) * 4) = acc[r]; }
        const u32x4 g0 = cur.g0, g1 = cur.g1;
        buf ^= 1;
        cur = dno_request(Qf, QKf, Sf, Vf, proj, uid + G < 2048 ? uid + G : uid, ldu + buf * DO_ABUF, tid, lane, wave);
        LDS_BARRIER();
        {
            const int t = t0 + rr, c = h * HD + cg * 16;
            const LAS f32x4* op = (const LAS f32x4*)(lds + DO_OT + (rr * 132 + cg * 16) * 4); const f32x4 o0 = op[0], o1 = op[1], o2 = op[2], o3 = op[3];
            float ss = (o0[0] * o0[0] + o0[1] * o0[1]) + (o0[2] * o0[2] + o0[3] * o0[3]) + (o1[0] * o1[0] + o1[1] * o1[1]) + (o1[2] * o1[2] + o1[3] * o1[3])
                     + (o2[0] * o2[0] + o2[1] * o2[1]) + (o2[2] * o2[2] + o2[3] * o2[3]) + (o3[0] * o3[0] + o3[1] * o3[1]) + (o3[2] * o3[2] + o3[3] * o3[3]);
            ss += shfl_xor_l(ss, 1, lane); ss += shfl_xor_l(ss, 2, lane); ss += shfl_xor_l(ss, 4, lane);
            const float rs = rsqrt_f(ss * (1.0f / HD) + EPS);
            u32x4 r0, r1;
            r0.x = pk2(o0[0] * rs * w0[0] * silu_f(bflo(g0.x)), o0[1] * rs * w0[1] * silu_f(bfhi(g0.x))); r0.y = pk2(o0[2] * rs * w0[2] * silu_f(bflo(g0.y)), o0[3] * rs * w0[3] * silu_f(bfhi(g0.y)));
            r0.z = pk2(o1[0] * rs * w1[0] * silu_f(bflo(g0.z)), o1[1] * rs * w1[1] * silu_f(bfhi(g0.z))); r0.w = pk2(o1[2] * rs * w1[2] * silu_f(bflo(g0.w)), o1[3] * rs * w1[3] * silu_f(bfhi(g0.w)));
            r1.x = pk2(o2[0] * rs * w2[0] * silu_f(bflo(g1.x)), o2[1] * rs * w2[1] * silu_f(bfhi(g1.x))); r1.y = pk2(o2[2] * rs * w2[2] * silu_f(bflo(g1.y)), o2[3] * rs * w2[3] * silu_f(bfhi(g1.y)));
            r1.z = pk2(o3[0] * rs * w3[0] * silu_f(bflo(g1.z)), o3[1] * rs * w3[1] * silu_f(bfhi(g1.z))); r1.w = pk2(o3[2] * rs * w3[2] * silu_f(bflo(g1.w)), o3[3] * rs * w3[3] * silu_f(bfhi(g1.w)));
            u32x4* dst = (u32x4*)(ymix + (size_t)t * D + DLRU + c); dst[0] = r0; dst[1] = r1;
        }
    }
    asm volatile("s_waitcnt vmcnt(0)" ::: "memory");
    LDS_BARRIER();
}
constexpr int LA_XB = 0, LA_XF = 17408, LA_END = LA_XF + 64 * 132 * 4;
static_assert(LA_END <= RING_BYTES, "LRU-A LDS map");
struct LruConst { bf16x8 br[4], bi[4]; float brr, bii, sp8; };
__device__ __forceinline__ LruConst lrua_const(const bf16* WrT, const bf16* WiT, const float* b_r, const float* b_i, const float* lam, int nb, int lane, int wave) {
    LruConst c; const int fr = lane & 15, fq = lane >> 4, cl = wave * 16 + fr, ch = nb * 128 + cl;
#pragma unroll
    for (int ks = 0; ks < 4; ++ks) { c.br[ks] = *(const bf16x8*)(WrT + ((size_t)nb * 128 + cl) * 128 + ks * 32 + fq * 8); c.bi[ks] = *(const bf16x8*)(WiT + ((size_t)nb * 128 + cl) * 128 + ks * 32 + fq * 8); }
    c.brr = b_r[ch]; c.bii = b_i[ch]; c.sp8 = -8.0f * softplus_f(-lam[ch]);
    return c;
}
__device__ __forceinline__ void lrua_unit(const bf16* proj, const LruConst& LC,
                                          float* Hloc, float* Acum, float* summ, int unit, LAS unsigned char* lds, const LAS float* lwl, int tid, int lane, int wave) {
    const int nb = unit & 7, ct = unit >> 3, n = ct & 127, t0 = ct * 64;
    asm volatile("" : "+v"(lds));
    {
        const int r = tid >> 3, cg = tid & 7, ch0 = nb * 128 + cg * 16;
        float acc[16];
        { const LAS float* bp = lwl + 512 + cg * 16; const f32x4 c0v = *(const LAS f32x4*)bp, c1v = *(const LAS f32x4*)(bp + 4), c2v = *(const LAS f32x4*)(bp + 8), c3v = *(const LAS f32x4*)(bp + 12);
#pragma unroll
          for (int i = 0; i < 4; ++i) { acc[i] = c0v[i]; acc[4 + i] = c1v[i]; acc[8 + i] = c2v[i]; acc[12 + i] = c3v[i]; } }
#pragma unroll
        for (int k = 0; k < 4; ++k) { const int row = r - 3 + k;
            if (n * 64 + row >= 0) {
                const bf16* src = proj + (size_t)(t0 + row) * NPROJ + ch0;
                const u32x4 x0 = *(const u32x4*)src, x1 = *(const u32x4*)(src + 8);
                const LAS float* wp = lwl + k * 128 + cg * 16;
                const f32x4 w0 = *(const LAS f32x4*)wp, w1 = *(const LAS f32x4*)(wp + 4), w2 = *(const LAS f32x4*)(wp + 8), w3 = *(const LAS f32x4*)(wp + 12);
                acc[0] += w0[0] * bflo(x0.x); acc[1] += w0[1] * bfhi(x0.x); acc[2] += w0[2] * bflo(x0.y); acc[3] += w0[3] * bfhi(x0.y);
                acc[4] += w1[0] * bflo(x0.z); acc[5] += w1[1] * bfhi(x0.z); acc[6] += w1[2] * bflo(x0.w); acc[7] += w1[3] * bfhi(x0.w);
                acc[8] += w2[0] * bflo(x1.x); acc[9] += w2[1] * bfhi(x1.x); acc[10] += w2[2] * bflo(x1.y); acc[11] += w2[3] * bfhi(x1.y);
                acc[12] += w3[0] * bflo(x1.z); acc[13] += w3[1] * bfhi(x1.z); acc[14] += w3[2] * bflo(x1.w); acc[15] += w3[3] * bfhi(x1.w);
            } }
        u32x4 o0, o1;
        o0.x = pk2(acc[0], acc[1]); o0.y = pk2(acc[2], acc[3]); o0.z = pk2(acc[4], acc[5]); o0.w = pk2(acc[6], acc[7]);
        o1.x = pk2(acc[8], acc[9]); o1.y = pk2(acc[10], acc[11]); o1.z = pk2(acc[12], acc[13]); o1.w = pk2(acc[14], acc[15]);
        *(LAS u32x4*)(lds + LA_XB + r * 272 + cg * 32) = o0; *(LAS u32x4*)(lds + LA_XB + r * 272 + cg * 32 + 16) = o1;
        LAS f32x4* xf = (LAS f32x4*)(lds + LA_XF + (r * 132 + cg * 16) * 4);
        xf[0] = (f32x4){acc[0], acc[1], acc[2], acc[3]}; xf[1] = (f32x4){acc[4], acc[5], acc[6], acc[7]}; xf[2] = (f32x4){acc[8], acc[9], acc[10], acc[11]}; xf[3] = (f32x4){acc[12], acc[13], acc[14], acc[15]};
    }
    LDS_BARRIER();
    const int fr = lane & 15, fq = lane >> 4, cl = wave * 16 + fr, ch = nb * 128 + cl;
    f32x4 ar[4], ai[4];
#pragma unroll
    for (int mt = 0; mt < 4; ++mt) { ar[mt] = (f32x4){0.f, 0.f, 0.f, 0.f}; ai[mt] = (f32x4){0.f, 0.f, 0.f, 0.f};
#pragma unroll
        for (int ks = 0; ks < 4; ++ks) { const bf16x8 af = *(const LAS bf16x8*)(lds + LA_XB + (mt * 16 + fr) * 272 + (ks * 32 + fq * 8) * 2); ar[mt] = mfma16(af, LC.br[ks], ar[mt]); ai[mt] = mfma16(af, LC.bi[ks], ai[mt]); } }
    const float brr = LC.brr, bii = LC.bii, sp8 = LC.sp8;
    float Ac = 1.f, Bc = 0.f;
#pragma unroll
    for (int mt = 0; mt < 4; ++mt) {
        float P[4], H[4];
#pragma unroll
        for (int r = 0; r < 4; ++r) { const int t = mt * 16 + fq * 4 + r; const float xcv = *(const LAS float*)(lds + LA_XF + (t * 132 + cl) * 4);
            const float rr = sigmoid_f(ar[mt][r] + brr), ii = sigmoid_f(ai[mt][r] + bii), la = sp8 * rr, a = __expf(la), bb = __builtin_amdgcn_sqrtf(fmaxf(1.0f - a * a, 0.0f)) * (ii * xcv);
            if (r == 0) { P[0] = a; H[0] = bb; } else { P[r] = P[r - 1] * a; H[r] = a * H[r - 1] + bb; } }
        float Ai = P[3], Bi = H[3];
        { const float Au = shfl_up_l(Ai, 16, lane), Bu = shfl_up_l(Bi, 16, lane); if (fq >= 1) { Bi = Ai * Bu + Bi; Ai = Au * Ai; } }
        { const float Au = shfl_up_l(Ai, 32, lane), Bu = shfl_up_l(Bi, 32, lane); if (fq >= 2) { Bi = Ai * Bu + Bi; Ai = Au * Ai; } }
        float Ae = shfl_up_l(Ai, 16, lane), Be = shfl_up_l(Bi, 16, lane); if (fq == 0) { Ae = 1.f; Be = 0.f; }
        const float At = shfl_idx_l(Ai, 48 + fr), Bt = shfl_idx_l(Bi, 48 + fr);
        const float PA = Ac * Ae, PB = Ae * Bc + Be;
#pragma unroll
        for (int r = 0; r < 4; ++r) { const size_t o = (size_t)(t0 + mt * 16 + fq * 4 + r) * DLRU + ch; ((unsigned*)Hloc)[o] = pk2(P[r] * PB + H[r], PA * P[r]); }
        Bc = At * Bc + Bt; Ac = Ac * At;
    }
    if (fq == 0) { float* sp = summ + ((size_t)ct * DLRU + ch) * 2; sp[0] = Ac; sp[1] = Bc; }
    LDS_BARRIER();
}
__device__ __forceinline__ void lru_carry(const float* summ, float* carry, int idx) {
    const int b = idx >> 10, ch = idx & 1023; float c = 0.f;
    for (int n0 = 0; n0 < 128; n0 += 8) { float A[8], B[8];
#pragma unroll
        for (int j = 0; j < 8; ++j) { const float* sp = summ + ((size_t)(b * 128 + n0 + j) * DLRU + ch) * 2; A[j] = sp[0]; B[j] = sp[1]; }
#pragma unroll
        for (int j = 0; j < 8; ++j) { carry[(size_t)(b * 128 + n0 + j) * DLRU + ch] = c; c = A[j] * c + B[j]; } }
}
__device__ __forceinline__ void lrub_row(const float* Hloc, const float* Acum, const float* carry, const bf16* proj, const float* gain, bf16* ymix, int row, int lane) {
    const int ct = row >> 6; f32x4 y[4]; float ss = 0.f;
#pragma unroll
    for (int j = 0; j < 4; ++j) { const int c4 = lane * 4 + 256 * j;
        const u32x4 ha = *(const u32x4*)((const unsigned*)Hloc + (size_t)row * DLRU + c4); const f32x4 cr = *(const f32x4*)(carry + (size_t)ct * DLRU + c4);
        const u32x2 g = *(const u32x2*)(proj + (size_t)row * NPROJ + DLRU + c4);
        const f32x4 hl = {bflo(ha.x), bflo(ha.y), bflo(ha.z), bflo(ha.w)}, ac = {bfhi(ha.x), bfhi(ha.y), bfhi(ha.z), bfhi(ha.w)};
        const f32x4 hh = hl + ac * cr;
        y[j][0] = hh[0] * gelu_tanh_f(bflo(g.x)); y[j][1] = hh[1] * gelu_tanh_f(bfhi(g.x)); y[j][2] = hh[2] * gelu_tanh_f(bflo(g.y)); y[j][3] = hh[3] * gelu_tanh_f(bfhi(g.y));
        ss += (y[j][0] * y[j][0] + y[j][1] * y[j][1]) + (y[j][2] * y[j][2] + y[j][3] * y[j][3]); }
    ss = wave_sum(ss, lane); const float rs = rsqrt_f(ss * (1.0f / DLRU) + EPS);
#pragma unroll
    for (int j = 0; j < 4; ++j) { const int c4 = lane * 4 + 256 * j; const f32x4 g = *(const f32x4*)(gain + c4); u32x2 w; w.x = pk2(y[j][0] * rs * g[0], y[j][1] * rs * g[1]); w.y = pk2(y[j][2] * rs * g[2], y[j][3] * rs * g[3]);
        *(u32x2*)(ymix + (size_t)row * D + c4) = w; }
}
__device__ __forceinline__ void dn_out_row(const float* o, const float* gain, const bf16* proj, bf16* ymix, int t, int lane) {
    const int c = lane * 16;
    const f32x4* op = (const f32x4*)(o + (size_t)t * DDN + c); const f32x4 o0 = op[0], o1 = op[1], o2 = op[2], o3 = op[3];
    const u32x4* gp = (const u32x4*)(proj + (size_t)t * NPROJ + 5120 + c); const u32x4 g0 = gp[0], g1 = gp[1];
    const f32x4* wp = (const f32x4*)(gain + (c & 127)); const f32x4 w0 = wp[0], w1 = wp[1], w2 = wp[2], w3 = wp[3];
    float ss = (o0[0] * o0[0] + o0[1] * o0[1]) + (o0[2] * o0[2] + o0[3] * o0[3]) + (o1[0] * o1[0] + o1[1] * o1[1]) + (o1[2] * o1[2] + o1[3] * o1[3])
             + (o2[0] * o2[0] + o2[1] * o2[1]) + (o2[2] * o2[2] + o2[3] * o2[3]) + (o3[0] * o3[0] + o3[1] * o3[1]) + (o3[2] * o3[2] + o3[3] * o3[3]);
    ss += shfl_xor_l(ss, 1, lane); ss += shfl_xor_l(ss, 2, lane); ss += shfl_xor_l(ss, 4, lane);
    const float rs = rsqrt_f(ss * (1.0f / HD) + EPS);
    u32x4 r0, r1;
    r0.x = pk2(o0[0] * rs * w0[0] * silu_f(bflo(g0.x)), o0[1] * rs * w0[1] * silu_f(bfhi(g0.x))); r0.y = pk2(o0[2] * rs * w0[2] * silu_f(bflo(g0.y)), o0[3] * rs * w0[3] * silu_f(bfhi(g0.y)));
    r0.z = pk2(o1[0] * rs * w1[0] * silu_f(bflo(g0.z)), o1[1] * rs * w1[1] * silu_f(bfhi(g0.z))); r0.w = pk2(o1[2] * rs * w1[2] * silu_f(bflo(g0.w)), o1[3] * rs * w1[3] * silu_f(bfhi(g0.w)));
    r1.x = pk2(o2[0] * rs * w2[0] * silu_f(bflo(g1.x)), o2[1] * rs * w2[1] * silu_f(bfhi(g1.x))); r1.y = pk2(o2[2] * rs * w2[2] * silu_f(bflo(g1.y)), o2[3] * rs * w2[3] * silu_f(bfhi(g1.y)));
    r1.z = pk2(o3[0] * rs * w3[0] * silu_f(bflo(g1.z)), o3[1] * rs * w3[1] * silu_f(bfhi(g1.z))); r1.w = pk2(o3[2] * rs * w3[2] * silu_f(bflo(g1.w)), o3[3] * rs * w3[3] * silu_f(bfhi(g1.w)));
    u32x4* dst = (u32x4*)(ymix + (size_t)t * D + DLRU + c); dst[0] = r0; dst[1] = r1;
}
__device__ __forceinline__ void route_row(const float* x, const float* rstd, const float* gain, const float* router, float* roww, int row, int lane) {
    float acc[8];
#pragma unroll
    for (int e = 0; e < 8; ++e) acc[e] = 0.f;
    for (int j = 0; j < 32; ++j) { const int k = lane + 64 * j; const float xv = x[(size_t)row * D + k] * gain[k]; const f32x4 r0 = *(const f32x4*)(router + (size_t)k * 8), r1 = *(const f32x4*)(router + (size_t)k * 8 + 4);
        acc[0] += xv * r0[0]; acc[1] += xv * r0[1]; acc[2] += xv * r0[2]; acc[3] += xv * r0[3]; acc[4] += xv * r1[0]; acc[5] += xv * r1[1]; acc[6] += xv * r1[2]; acc[7] += xv * r1[3]; }
    const float rs = rstd[row];
#pragma unroll
    for (int e = 0; e < 8; ++e) acc[e] = wave_sum(acc[e], lane) * rs;
    int e1 = 0; float l1 = acc[0];
#pragma unroll
    for (int e = 1; e < 8; ++e) if (acc[e] > l1) { l1 = acc[e]; e1 = e; }
    int e2 = -1; float l2 = -3.4e38f;
#pragma unroll
    for (int e = 0; e < 8; ++e) if (e != e1 && acc[e] > l2) { l2 = acc[e]; e2 = e; }
    const float w1 = 1.0f / (1.0f + __expf(l2 - l1)), w2 = 1.0f - w1;
    if (lane < 8) roww[(size_t)lane * T + row] = lane == e1 ? w1 : (lane == e2 ? w2 : 0.0f);
}
__device__ __forceinline__ void final_row(const float* x, const float* gain, float* out, int row, int lane) {
    const f32x4* xr = (const f32x4*)(x + (size_t)row * D) + lane; const f32x4* gr = (const f32x4*)gain + lane;
    f32x4 v[8]; float ss = 0.f;
#pragma unroll
    for (int j = 0; j < 8; ++j) { v[j] = xr[64 * j]; ss += (v[j][0] * v[j][0] + v[j][1] * v[j][1]) + (v[j][2] * v[j][2] + v[j][3] * v[j][3]); }
    ss = wave_sum(ss, lane); const float rs = rsqrt_f(ss * (1.0f / D) + EPS);
    f32x4* o = (f32x4*)(out + (size_t)row * D) + lane;
#pragma unroll
    for (int j = 0; j < 8; ++j) o[64 * j] = v[j] * rs * gr[64 * j];
}

struct MoeOrder {
    const int* list; int nN, G, c; int c0, c1, c2, c3, c4, c5, c6, c7;
    __device__ __forceinline__ void init(const unsigned* cnt, const int* list_, int nN_, int G_, int c_) { list = list_; nN = nN_; G = G_; c = c_;
        c0 = __builtin_amdgcn_readfirstlane((int)cnt[0]); c1 = __builtin_amdgcn_readfirstlane((int)cnt[1]); c2 = __builtin_amdgcn_readfirstlane((int)cnt[2]); c3 = __builtin_amdgcn_readfirstlane((int)cnt[3]);
        c4 = __builtin_amdgcn_readfirstlane((int)cnt[4]); c5 = __builtin_amdgcn_readfirstlane((int)cnt[5]); c6 = __builtin_amdgcn_readfirstlane((int)cnt[6]); c7 = __builtin_amdgcn_readfirstlane((int)cnt[7]); }
    __device__ __forceinline__ bool next(int i, pg8::Unit& u) const {
        const int c8[8] = {c0, c1, c2, c3, c4, c5, c6, c7}; int nM = 0;
#pragma unroll
        for (int k = 0; k < 8; ++k) nM += (c8[k] + 255) >> 8;
        const int nwg = nM * nN; const long L = (long)i * G + c; if (L >= nwg) return false;
        int wgid = (int)L; { const int q = nwg / pg8::NXCD, r = nwg % pg8::NXCD, xcd = wgid % pg8::NXCD, off = wgid / pg8::NXCD; wgid = (xcd < r ? xcd * (q + 1) : r * (q + 1) + (xcd - r) * q) + off; }
        const int nig = pg8::WGM * nN, gid = wgid / nig, fm = gid * pg8::WGM, gsz = (nM - fm) < pg8::WGM ? (nM - fm) : pg8::WGM;
        u.pm = fm + ((wgid % nig) % gsz); u.pn = (wgid % nig) / gsz;
        int e = 0, ps = 0, ce = c8[0], run = 0;
#pragma unroll
        for (int k = 0; k < 8; ++k) { const int mk = (c8[k] + 255) >> 8; if (u.pm >= run && u.pm < run + mk) { e = k; ps = run; ce = c8[k]; } run += mk; }
        const int mtl = u.pm - ps; u.pb = e * nN + u.pn; u.lbase = e * T + mtl * 256; u.nvalid = (ce - mtl * 256) < 256 ? (ce - mtl * 256) : 256;
        return true;
    }
    __device__ __forceinline__ int arow(const pg8::Unit& u, int r) const { return r < u.nvalid ? (list[u.lbase + r] & 0xffff) : 0; }
    __device__ __forceinline__ void a_ready(const pg8::Unit&) const {}
    __device__ __forceinline__ void done(const pg8::Unit&) const {}
};
__device__ __forceinline__ void route_block(const float* ssq, const float* lgp, float* rstd, unsigned* cnt, int* list, float* listw, int blk, LAS unsigned char* lds, int tid, int lane, int wave) {
    asm volatile("" : "+v"(lds));
    LAS int* se1 = (LAS int*)lds; LAS int* se2 = se1 + 64; LAS float* sw1 = (LAS float*)(se2 + 64); LAS float* sw2 = sw1 + 64; LAS int* lcnt = (LAS int*)(sw2 + 64); LAS int* gbase = lcnt + 8;
    if (tid < 8) lcnt[tid] = 0;
    f32x4 lp[8]; float sp[8];
#pragma unroll
    for (int q = 0; q < 8; ++q) { const int row = blk * 64 + wave * 8 + q; lp[q] = *(const f32x4*)(lgp + (size_t)row * 256 + lane * 4); sp[q] = ssq[(size_t)row * 32 + (lane & 31)]; }
    __syncthreads();
#pragma unroll
    for (int q = 0; q < 8; ++q) { const int rloc = wave * 8 + q, row = blk * 64 + rloc;
        f32x4 v = lp[q]; float ss = sp[q];
#pragma unroll
        for (int o = 2; o < 64; o <<= 1) { v[0] += shfl_xor_l(v[0], o, lane); v[1] += shfl_xor_l(v[1], o, lane); v[2] += shfl_xor_l(v[2], o, lane); v[3] += shfl_xor_l(v[3], o, lane); }
#pragma unroll
        for (int o = 1; o < 32; o <<= 1) ss += shfl_xor_l(ss, o, lane);
        const float rs = rsqrt_f(ss * (1.0f / D) + EPS);
        if (lane == 0) rstd[row] = rs * (1.0f / MOE_WSC);
        float acc[8];
#pragma unroll
        for (int e = 0; e < 8; ++e) acc[e] = shfl_idx_l(v[e & 3], e >> 2) * rs;
        int e1 = 0; float l1 = acc[0];
#pragma unroll
        for (int e = 1; e < 8; ++e) if (acc[e] > l1) { l1 = acc[e]; e1 = e; }
        int e2 = -1; float l2 = -3.4e38f;
#pragma unroll
        for (int e = 0; e < 8; ++e) if (e != e1 && acc[e] > l2) { l2 = acc[e]; e2 = e; }
        const float w1 = 1.0f / (1.0f + __expf(l2 - l1));
        if (lane == 0) { se1[rloc] = e1; se2[rloc] = e2; sw1[rloc] = w1; sw2[rloc] = 1.0f - w1; }
    }
    __syncthreads();
    int e = 0, lr = 0; float w = 0.f;
    if (tid < 128) { const int rloc = tid >> 1, j = tid & 1; e = j ? se2[rloc] : se1[rloc]; w = j ? sw2[rloc] : sw1[rloc]; lr = __hip_atomic_fetch_add(lcnt + e, 1, __ATOMIC_RELAXED, __HIP_MEMORY_SCOPE_WORKGROUP); }
    __syncthreads();
    if (tid < 8) gbase[tid] = (int)__hip_atomic_fetch_add(cnt + tid, (unsigned)lcnt[tid], __ATOMIC_RELAXED, __HIP_MEMORY_SCOPE_AGENT);
    __syncthreads();
    if (tid < 128) { const int pos = gbase[e] + lr, tok = blk * 64 + (tid >> 1); list[e * T + pos] = tok | ((tid & 1) << 16); listw[e * T + pos] = w * (1.0f / (MOE_WSC * MOE_HSC)); }
    __syncthreads();
}
__device__ __forceinline__ void final_row_moe(const float* x, const bf16* y0, const bf16* y1, const float* gain, float* out, int row, int lane) {
    const f32x4* xr = (const f32x4*)(x + (size_t)row * D) + lane; const f32x4* gr = (const f32x4*)gain + lane;
    const u32x2* p0 = (const u32x2*)(y0 + (size_t)row * D) + lane; const u32x2* p1 = (const u32x2*)(y1 + (size_t)row * D) + lane;
    f32x4 v[8]; float ss = 0.f;
#pragma unroll
    for (int j = 0; j < 8; ++j) { v[j] = xr[64 * j]; const u32x2 a = p0[64 * j], b = p1[64 * j];
        v[j][0] += bflo(a.x) + bflo(b.x); v[j][1] += bfhi(a.x) + bfhi(b.x); v[j][2] += bflo(a.y) + bflo(b.y); v[j][3] += bfhi(a.y) + bfhi(b.y);
        ss += (v[j][0] * v[j][0] + v[j][1] * v[j][1]) + (v[j][2] * v[j][2] + v[j][3] * v[j][3]); }
    ss = wave_sum(ss, lane); const float rs = rsqrt_f(ss * (1.0f / D) + EPS);
    f32x4* o = (f32x4*)(out + (size_t)row * D) + lane;
#pragma unroll
    for (int j = 0; j < 8; ++j) o[64 * j] = v[j] * rs * gr[64 * j];
}
__device__ __forceinline__ void ba_tail(const bf16* xbp, const bf16* wbab, const float* ssq, int mode, float* bap, int rb, int wave, int lane) {
    if (wave < 4) { const int fr = lane & 15, fq = lane >> 4, r0 = rb * 64 + wave * 16;
        const bf16* ap = xbp + (size_t)(r0 + fr) * D + fq * 8; const bf16* bp = wbab + (size_t)fr * D + fq * 8;
        f32x4 acc = {0.f, 0.f, 0.f, 0.f};
#pragma unroll 16
        for (int ks = 0; ks < 64; ++ks) { const bf16x8 a = *(const bf16x8*)(ap + ks * 32), b = *(const bf16x8*)(bp + ks * 32); acc = mfma16(a, b, acc); }
#pragma unroll
        for (int rr = 0; rr < 4; ++rr) { const int r = r0 + fq * 4 + rr; bap[(size_t)r * 16 + fr] = acc[rr] * pg8::row_scale(ssq, r, mode); } }
}
struct Args { const float* in[25]; float* out; unsigned char* ws; int ph_lo, ph_hi; };
typedef const __attribute__((address_space(4))) unsigned long long* kaptr_t;
__device__ __forceinline__ unsigned long long ldka(int i) { kaptr_t ka = (kaptr_t)__builtin_amdgcn_kernarg_segment_ptr(); asm volatile("" : "+s"(i)); return ka[i]; }
__device__ __forceinline__ const float* ldin(const Args&, int i) { return (const float*)(const GAS float*)ldka(i); }
__device__ __forceinline__ unsigned char* ldws(const Args&) { return (unsigned char*)(GAS unsigned char*)ldka(26); }
__device__ __forceinline__ float* ldout(const Args&) { return (float*)(GAS float*)ldka(25); }
__global__ void __launch_bounds__(512, 2) mega(Args args) {
    extern __shared__ __attribute__((aligned(16))) unsigned char lds_raw[];
    LAS unsigned char* lds = (LAS unsigned char*)lds_raw;
    volatile LAS unsigned* MISC = (volatile LAS unsigned*)(lds + MISC_OFF);
    const int tid = threadIdx.x;
    const int G = gridDim.x, bid = blockIdx.x, NGW = G * 8;
    unsigned char* ws = ldws(args);
    for (int u = tid; u < (LDS_BYTES - LDSCTL_OFF) / 4; u += 512) ((LAS unsigned*)(lds + LDSCTL_OFF))[u] = 0u;
    __syncthreads();
    (void)xcd_barrier_post((unsigned*)(ws + WS_CTL) + CW_BAR, MISC + 8);
#define RUN(id) true
#if defined(PROBE_MASK)
#define STAMP() do { if (threadIdx.x == 0) { ((volatile LAS unsigned long long*)(lds + LDSCTL_OFF + 1024))[nst] = __builtin_amdgcn_s_memrealtime(); } ++nst; } while (0)
#else
#define STAMP() do { } while (0)
#endif
#define SEAM(id) do { XcdBarrier bar_; bar_.bar = (unsigned*)WSP(WS_CTL) + CW_BAR; bar_.x = xb_xcc_id(); bar_.st = (volatile LAS unsigned*)(lds + MISC_OFF) + 8; xcd_barrier(bar_); STAMP(); } while (0)
#if defined(PROBE_MASK)
    int nst = 0; STAMP();
#endif
#define INP(i) ldin(args, (i))
#define WSP(off) (ldws(args) + (off))
#define x_in INP(0)
#define norm_mix INP(1)
#define w_in INP(2)
#define conv_lru_w INP(3)
#define conv_lru_b INP(4)
#define lru_w_r INP(5)
#define lru_b_r INP(6)
#define lru_w_i INP(7)
#define lru_b_i INP(8)
#define lru_lambda INP(9)
#define lru_out_norm INP(10)
#define conv_qkv_w INP(11)
#define dn_a_log INP(12)
#define dn_dt_bias INP(13)
#define dn_out_norm INP(14)
#define w_out INP(15)
#define norm_ffn INP(16)
#define ffn_w_gate INP(17)
#define ffn_w_up INP(18)
#define ffn_w_down INP(19)
#define moe_router INP(20)
#define moe_w_gate INP(21)
#define moe_w_up INP(22)
#define moe_w_down INP(23)
#define norm_final INP(24)
#define xres (ldout(args))
#define Win ((bf16*)WSP(WS_WIN))
#define Wba ((float*)WSP(WS_WBA))
#define Wout ((bf16*)WSP(WS_WOUT))
#define Wgu ((bf16*)WSP(WS_WGU))
#define Wd ((bf16*)WSP(WS_WD))
#define Mgu ((bf16*)WSP(WS_MG0))
#define Md ((bf16*)WSP(WS_WGU))
#define Mgu8 ((unsigned char*)WSP(WS_MG0))
#define Md8 ((unsigned char*)WSP(WS_WGU))
#define xb8 ((unsigned char*)WSP(WS_XB))
#define hid8 ((unsigned char*)WSP(WS_PROJ))
#define MCNT ((unsigned*)WSP(WS_CTL) + CW_CNT)
#define MLIST ((int*)WSP(WS_ROWW))
#define MLISTW ((float*)WSP(WS_ROWW + (size_t)8 * T * 4))
#define YP0 ((bf16*)WSP(WS_XB))
#define YP1 ((bf16*)WSP(WS_YMIX))
#define xb ((bf16*)WSP(WS_XB))
#define rstd ((float*)WSP(WS_RSTD))
#define SSQA ((float*)WSP(WS_RSTD + (size_t)1 * MiB))
#define SSQB ((float*)WSP(WS_RSTD + (size_t)3 * MiB))
#define WBAB ((bf16*)WSP(WS_WBA + (size_t)2 * 16 * D * 4))
#define GRT ((float*)WSP(WS_RSTD + (size_t)512 * 1024))
#define LGP ((float*)WSP(WS_C))
#define ba ((float*)WSP(WS_BA))
#define beta ((float*)WSP(WS_BETA))
#define gg ((float*)WSP(WS_G))
#define roww ((float*)WSP(WS_ROWW))
#define proj ((bf16*)WSP(WS_PROJ))
#define hid ((bf16*)WSP(WS_PROJ))
#define ymix ((bf16*)WSP(WS_YMIX))
#define c0 ((float*)WSP(WS_C))
#define c1 ((float*)WSP(WS_C + (size_t)T * 1024 * 4))
#define c2 ((float*)WSP(WS_C + (size_t)2 * T * 1024 * 4))
#define c3 ((float*)WSP(WS_C + (size_t)3 * T * 1024 * 4))
#define LRU_WRT ((bf16*)WSP(WS_WRT))
#define LRU_WIT ((bf16*)WSP(WS_WRT + (size_t)2 * 8 * 128 * 128 * 2))
#define LRU_H ((float*)WSP(WS_C + (size_t)256 * MiB))
#define LRU_A ((float*)WSP(WS_C + (size_t)320 * MiB))
#define LRU_SUMM ((float*)WSP(WS_C + (size_t)384 * MiB))
#define LRU_CARRY ((float*)WSP(WS_C + (size_t)386 * MiB))
#define DN_WF ((bf16*)WSP(WS_C))
#define DN_QF ((bf16*)WSP(WS_C + (size_t)32 * MiB))
#define DN_KDTF ((bf16*)WSP(WS_C + (size_t)64 * MiB))
#define DN_UF ((bf16*)WSP(WS_C + (size_t)96 * MiB))
#define DN_QKF ((bf16*)WSP(WS_C + (size_t)128 * MiB))
#define DN_GL ((float*)WSP(WS_C + (size_t)144 * MiB))
#define DN_VF ((bf16*)WSP(WS_C + (size_t)146 * MiB))
#define DN_SF ((bf16*)WSP(WS_C + (size_t)192 * MiB))
    const int BIG = 1 << 30;
#define PHL int tid_ = threadIdx.x; asm volatile("" : "+v"(tid_)); const int lane_ = tid_ & 63; int bid_ = blockIdx.x; asm volatile("" : "+s"(bid_)); const int gw_ = bid_ * 8 + __builtin_amdgcn_readfirstlane(tid_ >> 6); const size_t gt_ = (size_t)bid_ * 512 + tid_, NGT = (size_t)G * 512; LAS float* scr = (LAS float*)(lds + (gw_ & 7) * 16384);
    if (RUN(ph)) { PHL
        convert_matrix(w_in, DIN, 0, D, NPROJ, norm_mix, Win, BIG, 0, 0, scr, gw_, NGW, lane_);
        convert_matrix(w_out, D, 0, D, D, nullptr, Wout, BIG, 0, 0, scr, gw_, NGW, lane_);
        for (size_t i = gt_; i < (size_t)2 * 16 * D; i += NGT) { const int l = (int)(i / (16 * D)), j = (int)((i / D) & 15), k = (int)(i % D); WBAB[i] = (bf16)f2bf(w_in[(size_t)l * D * DIN + (size_t)k * DIN + NPROJ + j] * norm_mix[l * D + k]); }
        for (size_t i = gt_; i < (size_t)8 * D; i += NGT) { const int e = (int)(i / D), k = (int)(i % D); GRT[i] = moe_router[(size_t)k * 8 + e] * norm_ffn[D + k]; }
        for (int r = gw_; r < T; r += NGW) rowprep_row(x_in, xb, rstd, nullptr, nullptr, r, lane_);
        for (int m = 0; m < 16; ++m) {
            convert_matrix(lru_w_r + (size_t)m * 128 * 128, 128, 0, 128, 128, nullptr, LRU_WRT + (size_t)m * 128 * 128, BIG, 0, 0, scr, gw_, NGW, lane_);
            convert_matrix(lru_w_i + (size_t)m * 128 * 128, 128, 0, 128, 128, nullptr, LRU_WIT + (size_t)m * 128 * 128, BIG, 0, 0, scr, gw_, NGW, lane_); }
    }
    SEAM(ph);
    int xsel = 0;
#define xcur (xsel ? (const float*)xres : x_in)
    { constexpr int l = 0;
        if (RUN(ph)) { pg8::Gemm g{xb, Win + (size_t)l * NPROJ * D, T, NPROJ, D, 0}; pg8::StaticOrder S; S.init(T, NPROJ, G, bid); pg8::EpiScaleBf16 E{proj, l == 0 ? rstd : SSQB, NPROJ, l};
            pg8::gemm_phase<pg8::EpiScaleBf16, pg8::StaticOrder, true, false>(lds, g, S, E);
            { PHL for (int rb = bid_; rb < T / 64; rb += G) ba_tail(xb, WBAB + (size_t)l * 16 * D, l == 0 ? rstd : SSQB, l, ba, rb, gw_ & 7, lane_); } }
        SEAM(ph);
        if (RUN(ph)) { PHL
            LAS float* cwl = (LAS float*)(lds + LDSCTL_OFF + 4096); LAS float* lwl = cwl + 4 * 384;
            { const int hb = bid_ & 7; const float* cq = conv_qkv_w + (size_t)l * 4 * 3 * DDN; const float* cl = conv_lru_w + (size_t)l * 4 * DLRU; const float* cbp = conv_lru_b + l * DLRU;
              for (int i = tid_; i < 4 * 384; i += 512) { const int k = i / 384, pp = (i % 384) >> 7, d = i & 127; cwl[i] = cq[k * 3 * DDN + pp * DDN + hb * HD + d]; }
              for (int i = tid_; i < 640; i += 512) { const int k = i >> 7, d = i & 127; lwl[i] = k < 4 ? cl[k * DLRU + hb * 128 + d] : cbp[hb * 128 + d]; }
              __syncthreads(); }
            { const LruConst LC = lrua_const(LRU_WRT + (size_t)l * 8 * 128 * 128, LRU_WIT + (size_t)l * 8 * 128 * 128, lru_b_r + l * DLRU, lru_b_i + l * DLRU, lru_lambda + l * DLRU, bid_ & 7, lane_, gw_ & 7);
              for (int u = bid_; u < 2048; u += G) lrua_unit(proj, LC, LRU_H, LRU_A, LRU_SUMM, u, lds, lwl, tid_, lane_, gw_ & 7); }
            STAMP();
            for (int uid = bid_; uid < 2048; uid += G) dna_unit(proj, conv_qkv_w + (size_t)l * 4 * 3 * DDN, ba, dn_a_log + l * NH, dn_dt_bias + l * NH, DN_WF, DN_QF, DN_KDTF, DN_QKF, DN_UF, DN_GL, uid, lds, cwl, tid_, lane_, gw_ & 7,
                    moe_w_gate, moe_w_up, norm_ffn + D, Mgu8, (l == 0 ? ((gw_ & 7) >= 3 ? 6144 + uid * 5 + (gw_ & 7) - 3 : -1) : ((gw_ & 7) >= 4 ? 16384 + uid * 4 + (gw_ & 7) - 4 : -1))); }
        SEAM(ph);
        if (RUN(ph)) { PHL
            if (bid_ < 128) dnb_run(DN_WF, DN_KDTF, DN_UF, DN_GL, DN_SF, DN_VF, (bid_ & 7) + 8 * (bid_ >> 6), (bid_ >> 3) & 7, lds, tid_, lane_, gw_ & 7);
            else { if (bid_ < 136 && tid_ < 256) lru_carry(LRU_SUMM, LRU_CARRY, (bid_ - 128) * 256 + tid_);
                const int cw = gw_ - 128 * 8, CNW = NGW - 128 * 8;
                if (l == 0) {
                    convert_matrix(w_in + (size_t)D * DIN, DIN, 0, D, NPROJ, norm_mix + D, Win + (size_t)NPROJ * D, BIG, 0, 0, scr, cw, CNW, lane_);
                    convert_matrix(w_out + (size_t)D * D, D, 0, D, D, nullptr, Wout + (size_t)D * D, BIG, 0, 0, scr, cw, CNW, lane_);
                    convert_matrix(ffn_w_gate, DFF, 0, D, DFF, norm_ffn, Wgu, 128, 256, 0, scr, cw, CNW, lane_);
                    convert_matrix(ffn_w_up, DFF, 0, D, DFF, norm_ffn, Wgu, 128, 256, 128, scr, cw, CNW, lane_);
                    convert_matrix(ffn_w_down, D, 0, DFF, D, nullptr, Wd, BIG, 0, 0, scr, cw, CNW, lane_);
                } else {
                    for (int e = 0; e < NEXP; ++e) convert_matrix8(moe_w_down + (size_t)e * DFFE * D, D, DFFE, D, nullptr, MOE_WSC, Md8 + (size_t)e * D * DFFE, BIG, 0, 0, cw, CNW, lane_);
                    for (int e = 0; e < 2; ++e) {
                        convert_matrix8(moe_w_gate + (size_t)e * D * DFFE, DFFE, D, DFFE, norm_ffn + D, MOE_WSC, Mgu8 + (size_t)e * 2 * DFFE * D, 128, 256, 0, cw, CNW, lane_);
                        convert_matrix8(moe_w_up + (size_t)e * D * DFFE, DFFE, D, DFFE, norm_ffn + D, MOE_WSC, Mgu8 + (size_t)e * 2 * DFFE * D, 128, 256, 128, cw, CNW, lane_); }
                } } }
        SEAM(ph);
        if (RUN(ph)) { PHL
            for (int r = gw_; r < T; r += NGW) lrub_row(LRU_H, LRU_A, LRU_CARRY, proj, lru_out_norm + l * DLRU, ymix, r, lane_);
            dno_run(DN_QF, DN_QKF, DN_SF, DN_VF, dn_out_norm + l * HD, proj, ymix, bid_, G, lds, tid_, lane_, gw_ & 7); }
        SEAM(ph);
        if (RUN(ph)) { if (l == 0) { pg8::Gemm g{ymix, Wout, T, D, D, 0}; pg8::StaticOrder S; S.init(T, D, G, bid); pg8::EpiResidualNorm E{xcur, xres, xb, SSQA, D, 0};
            pg8::gemm_phase<pg8::EpiResidualNorm, pg8::StaticOrder, true, false>(lds, g, S, E); }
          else { pg8::Gemm g{ymix, Wout + (size_t)D * D, T, D, D, 0}; pg8::StaticOrder S; S.init(T, D, G, bid); pg8::EpiResidualRoute E{xcur, xres, xb8, SSQA, GRT, LGP, D, 0};
            pg8::gemm_phase<pg8::EpiResidualRoute, pg8::StaticOrder, true, false>(lds, g, S, E); } }
        SEAM(ph);
        xsel = 1;
        if (l == 0) {
            if (RUN(ph)) { pg8::Gemm g{xb, Wgu, T, 2 * DFF, D, 0}; pg8::StaticOrder S; S.init(T, 2 * DFF, G, bid); pg8::EpiSwiGLU E{hid, SSQA, DFF, 1};
                pg8::gemm_phase<pg8::EpiSwiGLU, pg8::StaticOrder, true, false>(lds, g, S, E); }
            SEAM(ph);
            if (RUN(ph)) { pg8::Gemm g{hid, Wd, T, D, DFF, 0}; pg8::StaticOrder S; S.init(T, D, G, bid); pg8::EpiResidualNorm E{xcur, xres, xb, SSQB, D, 0};
                pg8::gemm_phase<pg8::EpiResidualNorm, pg8::StaticOrder, true, false>(lds, g, S, E); }
            SEAM(ph);
        } else {
            if (RUN(ph)) { PHL for (int blk = bid_; blk < T / 64; blk += G) route_block(SSQA, LGP, rstd, MCNT, MLIST, MLISTW, blk, lds, tid_, lane_, gw_ & 7); }
            SEAM(ph);
            if (RUN(ph)) { pg8::Gemm g{(const pg8::bf16_t*)xb8, (const pg8::bf16_t*)Mgu8, NSLOT, 2 * DFFE, D / 2, 0}; MoeOrder S; S.init(MCNT, MLIST, 2 * DFFE / 256, G, bid); pg8::EpiSwiGLUMoe8 E{hid8, rstd, MLIST, DFFE, MOE_HSC};
                pg8::gemm_phase<pg8::EpiSwiGLUMoe8, MoeOrder, true, true, true>(lds, g, S, E); }
            SEAM(ph);
            if (RUN(ph)) { pg8::Gemm g{(const pg8::bf16_t*)hid8, (const pg8::bf16_t*)Md8, NSLOT, D, DFFE / 2, 0}; MoeOrder S; S.init(MCNT, MLIST, D / 256, G, bid); pg8::EpiMoeDown E{YP0, YP1, MLIST, MLISTW, D, 0};
                pg8::gemm_phase<pg8::EpiMoeDown, MoeOrder, true, false, true>(lds, g, S, E); }
            SEAM(ph);
        }
    }
    { constexpr int l = 1;
        if (RUN(ph)) { pg8::Gemm g{xb, Win + (size_t)l * NPROJ * D, T, NPROJ, D, 0}; pg8::StaticOrder S; S.init(T, NPROJ, G, bid); pg8::EpiScaleBf16 E{proj, l == 0 ? rstd : SSQB, NPROJ, l};
            pg8::gemm_phase<pg8::EpiScaleBf16, pg8::StaticOrder, true, false>(lds, g, S, E);
            { PHL for (int rb = bid_; rb < T / 64; rb += G) ba_tail(xb, WBAB + (size_t)l * 16 * D, l == 0 ? rstd : SSQB, l, ba, rb, gw_ & 7, lane_); } }
        SEAM(ph);
        if (RUN(ph)) { PHL
            LAS float* cwl = (LAS float*)(lds + LDSCTL_OFF + 4096); LAS float* lwl = cwl + 4 * 384;
            { const int hb = bid_ & 7; const float* cq = conv_qkv_w + (size_t)l * 4 * 3 * DDN; const float* cl = conv_lru_w + (size_t)l * 4 * DLRU; const float* cbp = conv_lru_b + l * DLRU;
              for (int i = tid_; i < 4 * 384; i += 512) { const int k = i / 384, pp = (i % 384) >> 7, d = i & 127; cwl[i] = cq[k * 3 * DDN + pp * DDN + hb * HD + d]; }
              for (int i = tid_; i < 640; i += 512) { const int k = i >> 7, d = i & 127; lwl[i] = k < 4 ? cl[k * DLRU + hb * 128 + d] : cbp[hb * 128 + d]; }
              __syncthreads(); }
            { const LruConst LC = lrua_const(LRU_WRT + (size_t)l * 8 * 128 * 128, LRU_WIT + (size_t)l * 8 * 128 * 128, lru_b_r + l * DLRU, lru_b_i + l * DLRU, lru_lambda + l * DLRU, bid_ & 7, lane_, gw_ & 7);
              for (int u = bid_; u < 2048; u += G) lrua_unit(proj, LC, LRU_H, LRU_A, LRU_SUMM, u, lds, lwl, tid_, lane_, gw_ & 7); }
            STAMP();
            for (int uid = bid_; uid < 2048; uid += G) dna_unit(proj, conv_qkv_w + (size_t)l * 4 * 3 * DDN, ba, dn_a_log + l * NH, dn_dt_bias + l * NH, DN_WF, DN_QF, DN_KDTF, DN_QKF, DN_UF, DN_GL, uid, lds, cwl, tid_, lane_, gw_ & 7,
                    moe_w_gate, moe_w_up, norm_ffn + D, Mgu8, (l == 0 ? ((gw_ & 7) >= 3 ? 6144 + uid * 5 + (gw_ & 7) - 3 : -1) : ((gw_ & 7) >= 4 ? 16384 + uid * 4 + (gw_ & 7) - 4 : -1))); }
        SEAM(ph);
        if (RUN(ph)) { PHL
            if (bid_ < 128) dnb_run(DN_WF, DN_KDTF, DN_UF, DN_GL, DN_SF, DN_VF, (bid_ & 7) + 8 * (bid_ >> 6), (bid_ >> 3) & 7, lds, tid_, lane_, gw_ & 7);
            else { if (bid_ < 136 && tid_ < 256) lru_carry(LRU_SUMM, LRU_CARRY, (bid_ - 128) * 256 + tid_);
                const int cw = gw_ - 128 * 8, CNW = NGW - 128 * 8;
                if (l == 0) {
                    convert_matrix(w_in + (size_t)D * DIN, DIN, 0, D, NPROJ, norm_mix + D, Win + (size_t)NPROJ * D, BIG, 0, 0, scr, cw, CNW, lane_);
                    convert_matrix(w_out + (size_t)D * D, D, 0, D, D, nullptr, Wout + (size_t)D * D, BIG, 0, 0, scr, cw, CNW, lane_);
                    convert_matrix(ffn_w_gate, DFF, 0, D, DFF, norm_ffn, Wgu, 128, 256, 0, scr, cw, CNW, lane_);
                    convert_matrix(ffn_w_up, DFF, 0, D, DFF, norm_ffn, Wgu, 128, 256, 128, scr, cw, CNW, lane_);
                    convert_matrix(ffn_w_down, D, 0, DFF, D, nullptr, Wd, BIG, 0, 0, scr, cw, CNW, lane_);
                } else {
                    for (int e = 0; e < NEXP; ++e) convert_matrix8(moe_w_down + (size_t)e * DFFE * D, D, DFFE, D, nullptr, MOE_WSC, Md8 + (size_t)e * D * DFFE, BIG, 0, 0, cw, CNW, lane_);
                    for (int e = 0; e < 2; ++e) {
                        convert_matrix8(moe_w_gate + (size_t)e * D * DFFE, DFFE, D, DFFE, norm_ffn + D, MOE_WSC, Mgu8 + (size_t)e * 2 * DFFE * D, 128, 256, 0, cw, CNW, lane_);
                        convert_matrix8(moe_w_up + (size_t)e * D * DFFE, DFFE, D, DFFE, norm_ffn + D, MOE_WSC, Mgu8 + (size_t)e * 2 * DFFE * D, 128, 256, 128, cw, CNW, lane_); }
                } } }
        SEAM(ph);
        if (RUN(ph)) { PHL
            for (int r = gw_; r < T; r += NGW) lrub_row(LRU_H, LRU_A, LRU_CARRY, proj, lru_out_norm + l * DLRU, ymix, r, lane_);
            dno_run(DN_QF, DN_QKF, DN_SF, DN_VF, dn_out_norm + l * HD, proj, ymix, bid_, G, lds, tid_, lane_, gw_ & 7); }
        SEAM(ph);
        if (RUN(ph)) { if (l == 0) { pg8::Gemm g{ymix, Wout, T, D, D, 0}; pg8::StaticOrder S; S.init(T, D, G, bid); pg8::EpiResidualNorm E{xcur, xres, xb, SSQA, D, 0};
            pg8::gemm_phase<pg8::EpiResidualNorm, pg8::StaticOrder, true, false>(lds, g, S, E); }
          else { pg8::Gemm g{ymix, Wout + (size_t)D * D, T, D, D, 0}; pg8::StaticOrder S; S.init(T, D, G, bid); pg8::EpiResidualRoute E{xcur, xres, xb8, SSQA, GRT, LGP, D, 0};
            pg8::gemm_phase<pg8::EpiResidualRoute, pg8::StaticOrder, true, false>(lds, g, S, E); } }
        SEAM(ph);
        xsel = 1;
        if (l == 0) {
            if (RUN(ph)) { pg8::Gemm g{xb, Wgu, T, 2 * DFF, D, 0}; pg8::StaticOrder S; S.init(T, 2 * DFF, G, bid); pg8::EpiSwiGLU E{hid, SSQA, DFF, 1};
                pg8::gemm_phase<pg8::EpiSwiGLU, pg8::StaticOrder, true, false>(lds, g, S, E); }
            SEAM(ph);
            if (RUN(ph)) { pg8::Gemm g{hid, Wd, T, D, DFF, 0}; pg8::StaticOrder S; S.init(T, D, G, bid); pg8::EpiResidualNorm E{xcur, xres, xb, SSQB, D, 0};
                pg8::gemm_phase<pg8::EpiResidualNorm, pg8::StaticOrder, true, false>(lds, g, S, E); }
            SEAM(ph);
        } else {
            if (RUN(ph)) { PHL for (int blk = bid_; blk < T / 64; blk += G) route_block(SSQA, LGP, rstd, MCNT, MLIST, MLISTW, blk, lds, tid_, lane_, gw_ & 7); }
            SEAM(ph);
            if (RUN(ph)) { pg8::Gemm g{(const pg8::bf16_t*)xb8, (const pg8::bf16_t*)Mgu8, NSLOT, 2 * DFFE, D / 2, 0}; MoeOrder S; S.init(MCNT, MLIST, 2 * DFFE / 256, G, bid); pg8::EpiSwiGLUMoe8 E{hid8, rstd, MLIST, DFFE, MOE_HSC};
                pg8::gemm_phase<pg8::EpiSwiGLUMoe8, MoeOrder, true, true, true>(lds, g, S, E); }
            SEAM(ph);
            if (RUN(ph)) { pg8::Gemm g{(const pg8::bf16_t*)hid8, (const pg8::bf16_t*)Md8, NSLOT, D, DFFE / 2, 0}; MoeOrder S; S.init(MCNT, MLIST, D / 256, G, bid); pg8::EpiMoeDown E{YP0, YP1, MLIST, MLISTW, D, 0};
                pg8::gemm_phase<pg8::EpiMoeDown, MoeOrder, true, false, true>(lds, g, S, E); }
            SEAM(ph);
        }
    }
    if (RUN(ph)) { PHL for (int r = gw_; r < T; r += NGW) final_row_moe(xcur, YP0, YP1, norm_final, xres, r, lane_); }
#if defined(PROBE_MASK)
    __syncthreads(); STAMP();
    if (blockIdx.x == 0 && threadIdx.x == 0) { asm volatile("s_waitcnt vmcnt(0)" ::: "memory"); volatile LAS unsigned long long* st = (volatile LAS unsigned long long*)(lds + LDSCTL_OFF + 1024); unsigned long long tot = 0;
        for (int k = 1; k < nst; ++k) if ((PROBE_MASK >> (k - 1)) & 1ull) tot += st[k] - st[k - 1];
        xres[0] = rintf((float)tot * 0.01f * PROBE_SCALE); }
#endif
#if defined(PROBE_DNA_A)
    __syncthreads();
    if (blockIdx.x == 0 && threadIdx.x == 0) { asm volatile("s_waitcnt vmcnt(0)" ::: "memory"); volatile LAS unsigned long long* st = (volatile LAS unsigned long long*)(lds + (RING_BYTES + 2048));
        xres[0] = rintf((float)(st[PROBE_DNA_B] - st[PROBE_DNA_A]) * 0.01f * PROBE_SCALE); }
#endif
#undef RUN
#undef SEAM
}

extern "C" void kernel_launch(void* const* d_in, const int* in_sizes, int n_in, void* d_out, int out_size, void* d_ws, size_t ws_size, hipStream_t stream) {
    static int grid = 0;
    if (grid == 0) {
        if (n_in != 25 || ws_size < WS_END) { fprintf(stderr, "kernel_launch: unexpected n_in %d / ws_size %zu (need %zu)\n", n_in, ws_size, (size_t)WS_END); grid = -1; return; }
        int dev = 0, cus = 0, per_cu = 0;
        if (hipGetDevice(&dev) != hipSuccess || hipDeviceGetAttribute(&cus, hipDeviceAttributeMultiprocessorCount, dev) != hipSuccess) { grid = -1; return; }
        if (hipFuncSetAttribute((const void*)mega, hipFuncAttributeMaxDynamicSharedMemorySize, LDS_BYTES) != hipSuccess) { fprintf(stderr, "kernel_launch: hipFuncSetAttribute failed\n"); grid = -1; return; }
        if (hipOccupancyMaxActiveBlocksPerMultiprocessor(&per_cu, (const void*)mega, 512, LDS_BYTES) != hipSuccess || per_cu < 1) { fprintf(stderr, "kernel_launch: occupancy query says %d\n", per_cu); }
        (void)hipGetLastError();
        grid = cus;
    }
    if (grid < 0) return;
    if (hipMemsetAsync((char*)d_ws + WS_CTL, 0, CTL_ZERO_BYTES, stream) != hipSuccess) return;
    Args a{};
    for (int i = 0; i < 25; ++i) a.in[i] = (const float*)d_in[i];
    a.out = (float*)d_out; a.ws = (unsigned char*)d_ws; a.ph_lo = 0; a.ph_hi = 1 << 30;
    hipLaunchKernelGGL(mega, dim3(grid), dim3(512), LDS_BYTES, stream, a);
}
```
